# Optimizing an MI355X kernel written in HIP

```python
import math
import jax, jax.numpy as jnp
from jax import lax
import numpy as np

D_MODEL = 1024
BATCH = 8
SEQ = 2048
DEPTH = 2

GRID_W = 64
CTX_LEN = 256
N_EVEN = (DEPTH + 1) // 2
N_ODD = DEPTH // 2
N_MOD = 6
EPS = 1e-6

HY_C = D_MODEL // 2
HY_ORDER = 2
HY_EMB = 33
HY_BANDS = (HY_EMB - 1) // 2
HY_FILT_W = 64
HY_SHORT = 3
HY_DECAY_SHORT_PCT = 0.3
HY_DECAY_LONG_PCT = 1.5
HY_TARGET = 1e-2
HEAD_DIM = 64
N_Q_HEADS = (D_MODEL // 2) // HEAD_DIM
N_KV_HEADS = N_Q_HEADS // 4
GQA_GROUP = N_Q_HEADS // N_KV_HEADS
WINDOW = 128
ATTN_BLK = 128
ROPE_BASE = 10000.0
AB_IN = 3 * HY_C + (N_Q_HEADS + 2 * N_KV_HEADS) * HEAD_DIM
AB_OUT = HY_C + N_Q_HEADS * HEAD_DIM

HG_HEADS = 8
HG_DK = D_MODEL // HG_HEADS
HG_DV = D_MODEL // HG_HEADS
HG_F = HG_HEADS * HG_DK
HG_IN = 3 * HG_F + 2 * HG_HEADS * HG_DV
HG_CHUNK = 64

PEER_HEADS = 8
PEER_TOPK = 16
N_KEYS = 128
N_EXPERTS = N_KEYS * N_KEYS
PEER_QDIM = 256
PEER_TOK_BLK = 128

kernel_name = "hybrid_hyena_swa_hgrn2_peer_dit"

F32 = jnp.float32


def rmsnorm(x, g):
    x32 = x.astype(F32)
    y = x32 * lax.rsqrt(jnp.mean(x32 * x32, axis=-1, keepdims=True) + EPS)
    return y.astype(x.dtype) * g


def modulate(x, shift, scale):
    return x * (1 + scale) + shift


def axial_rope_cos_sin(L):
    rows = L // GRID_W
    r = jnp.broadcast_to(jnp.arange(rows)[:, None], (rows, GRID_W)).reshape(-1).astype(F32)
    col = jnp.broadcast_to(jnp.arange(GRID_W)[None, :], (rows, GRID_W)).reshape(-1).astype(F32)
    nf = HEAD_DIM // 4
    inv = ROPE_BASE ** (-jnp.arange(nf, dtype=F32) / nf)
    ang = jnp.concatenate([r[:, None] * inv, col[:, None] * inv], axis=-1)
    return jnp.cos(ang), jnp.sin(ang)


def apply_rope(x, cos, sin):
    shp = x.shape
    nf = HEAD_DIM // 4
    xa = x.reshape(shp[:-1] + (2, 2, nf))
    bshape = (1, shp[1]) + (1,) * (x.ndim - 3) + (2, nf)
    c = cos.reshape(bshape).astype(x.dtype)
    s = sin.reshape(bshape).astype(x.dtype)
    a, b = xa[..., 0, :], xa[..., 1, :]
    out = jnp.stack([a * c - b * s, b * c + a * s], axis=-2)
    return out.reshape(shp)


def hyena_filters(L, w1, b1, w2, b2, w3, freq):
    t = jnp.linspace(0.0, 1.0, L, dtype=F32)[:, None]
    w = 2.0 * math.pi * jnp.arange(L, dtype=F32)[:, None] / L
    f = jnp.linspace(1e-4, HY_BANDS - 1, HY_BANDS, dtype=F32)[None, :]
    z = jnp.concatenate([t, jnp.cos(f * w), -jnp.sin(f * w)], axis=-1)
    fr = freq.astype(F32)
    hdn = jnp.sin(fr * (z @ w1.astype(F32) + b1.astype(F32)))
    hdn = jnp.sin(fr * (hdn @ w2.astype(F32) + b2.astype(F32)))
    h = (hdn @ w3.astype(F32)).reshape(L, HY_ORDER, 2, HY_C)
    max_decay = math.log(HY_TARGET) / HY_DECAY_SHORT_PCT
    min_decay = math.log(HY_TARGET) / HY_DECAY_LONG_PCT
    deltas = jnp.abs(jnp.linspace(min_decay, max_decay, HY_C, dtype=F32))
    h = h * jnp.exp(-t * deltas)[:, None, None, :]
    return h / jnp.sum(jnp.abs(h), axis=(0, 2), keepdims=True)


def hyena_mixer(u, conv_w, conv_b, w1, b1, w2, b2, w3, freq, d_skip):
    L = u.shape[1]
    up = jnp.pad(u, ((0, 0), (1, 1), (0, 0)))
    u = up[:, :-2] * conv_w[0] + up[:, 1:-1] * conv_w[1] + up[:, 2:] * conv_w[2] + conv_b
    v, x1, x2 = jnp.split(u, 3, axis=-1)
    h = hyena_filters(L, w1, b1, w2, b2, w3, freq)
    two_sided = jnp.concatenate([h[:, :, 0], jnp.zeros((1, HY_ORDER, HY_C), F32), h[:0:-1, :, 1]], axis=0)
    hf = jnp.fft.rfft(two_sided, axis=0)
    z = v
    for n, gate in enumerate((x1, x2)):
        zf = jnp.fft.rfft(z.astype(F32), n=2 * L, axis=1)
        conv = jnp.fft.irfft(zf * hf[None, :, n, :], n=2 * L, axis=1)[:, :L]
        z = gate * (conv.astype(z.dtype) + d_skip[n] * z)
    return z


def window_attention(q, k, v, kc, vc, sink):
    B, L = q.shape[:2]
    nb = L // ATTN_BLK
    scale = HEAD_DIM ** -0.5
    qb = q.reshape(B, nb, ATTN_BLK, N_KV_HEADS, GQA_GROUP, HEAD_DIM)

    def band(t):
        tp = jnp.pad(t, ((0, 0), (ATTN_BLK, ATTN_BLK), (0, 0), (0, 0)))
        tp = tp.reshape(B, nb + 2, ATTN_BLK, N_KV_HEADS, HEAD_DIM)
        return jnp.concatenate([tp[:, :-2], tp[:, 1:-1], tp[:, 2:]], axis=2)

    kw, vw = band(k), band(v)
    s_win = jnp.einsum('bnqhgd,bnkhd->bnhgqk', qb, kw).astype(F32) * scale
    qpos = jnp.arange(nb)[:, None, None] * ATTN_BLK + jnp.arange(ATTN_BLK)[None, :, None]
    kpos = jnp.arange(nb)[:, None, None] * ATTN_BLK - ATTN_BLK + jnp.arange(3 * ATTN_BLK)[None, None, :]
    valid = (kpos >= 0) & (kpos < L) & (jnp.abs(qpos - kpos) <= WINDOW)
    s_win = jnp.where(valid[None, :, None, None], s_win, -jnp.inf)
    s_ctx = jnp.einsum('bnqhgd,bchd->bnhgqc', qb, kc).astype(F32) * scale
    s_sink = jnp.broadcast_to(sink.astype(F32)[None, None, :, :, None, None], s_win.shape[:-1] + (1,))
    p = jax.nn.softmax(jnp.concatenate([s_sink, s_win, s_ctx], axis=-1), axis=-1).astype(q.dtype)
    nw = 3 * ATTN_BLK
    o = (jnp.einsum('bnhgqk,bnkhd->bnqhgd', p[..., 1:1 + nw], vw)
         + jnp.einsum('bnhgqc,bchd->bnqhgd', p[..., 1 + nw:], vc))
    return o.reshape(B, L, N_Q_HEADS * HEAD_DIM)


def context_attention(qc, kc, vc, sink):
    B, Lc = qc.shape[:2]
    s = jnp.einsum('bqhgd,bkhd->bhgqk', qc, kc).astype(F32) * (HEAD_DIM ** -0.5)
    s_sink = jnp.broadcast_to(sink.astype(F32)[None, :, :, None, None], s.shape[:-1] + (1,))
    p = jax.nn.softmax(jnp.concatenate([s_sink, s], axis=-1), axis=-1).astype(qc.dtype)
    o = jnp.einsum('bhgqk,bkhd->bqhgd', p[..., 1:], vc)
    return o.reshape(B, Lc, N_Q_HEADS * HEAD_DIM)


def hyena_attention_mixer(a_lat, a_ctx, w_in, w_out, conv_w, conv_b, fw1, fb1, fw2, fb2, fw3, ffreq,
                          d_skip, sink, need_ctx):
    B, L, _ = a_lat.shape
    o_q = 3 * HY_C
    o_k = o_q + N_Q_HEADS * HEAD_DIM
    o_v = o_k + N_KV_HEADS * HEAD_DIM

    def split(p):
        Lx = p.shape[1]
        q = p[..., o_q:o_k].reshape(B, Lx, N_KV_HEADS, GQA_GROUP, HEAD_DIM)
        k = p[..., o_k:o_v].reshape(B, Lx, N_KV_HEADS, HEAD_DIM)
        v = p[..., o_v:].reshape(B, Lx, N_KV_HEADS, HEAD_DIM)
        return p[..., :o_q], q, k, v

    hy_l, q_l, k_l, v_l = split(a_lat @ w_in)
    hy_c, q_c, k_c, v_c = split(a_ctx @ w_in)
    cos, sin = axial_rope_cos_sin(L)
    q_l = apply_rope(q_l, cos, sin)
    k_l = apply_rope(k_l, cos, sin)
    sink = sink.reshape(N_KV_HEADS, GQA_GROUP)
    hy_p = (conv_w, conv_b, fw1, fb1, fw2, fb2, fw3, ffreq, d_skip)
    y_lat = jnp.concatenate([hyena_mixer(hy_l, *hy_p),
                             window_attention(q_l, k_l, v_l, k_c, v_c, sink)], axis=-1) @ w_out
    y_ctx = None
    if need_ctx:
        y_ctx = jnp.concatenate([hyena_mixer(hy_c, *hy_p),
                                 context_attention(q_c, k_c, v_c, sink)], axis=-1) @ w_out
    return y_lat, y_ctx


def gla_chunk_scan(q, k, v, logf, S0):
    B, H, L, dk = q.shape
    dv = v.shape[-1]
    nc = L // HG_CHUNK
    tri = jnp.tril(jnp.ones((HG_CHUNK, HG_CHUNK), dtype=bool))

    def to_chunks(t):
        return jnp.moveaxis(t.reshape(B, H, nc, HG_CHUNK, t.shape[-1]), 2, 0)

    def step(S, inp):
        qc, kc, vc, gc = inp
        b = jnp.cumsum(gc, axis=2)
        o_inter = jnp.einsum('bhtk,bhkv->bhtv', qc * jnp.exp(b), S)
        diff = jnp.where(tri[:, :, None], b[:, :, :, None, :] - b[:, :, None, :, :], -jnp.inf)
        A = jnp.einsum('bhtk,bhtsk,bhsk->bhts', qc, jnp.exp(diff), kc)
        o = o_inter + jnp.einsum('bhts,bhsv->bhtv', A, vc)
        b_last = b[:, :, -1:, :]
        S = jnp.exp(b_last[:, :, 0, :, None]) * S + jnp.einsum('bhsk,bhsv->bhkv', kc * jnp.exp(b_last - b), vc)
        return S, o

    S, o = lax.scan(step, S0, (to_chunks(q), to_chunks(k), to_chunks(v), to_chunks(logf)))
    return S, jnp.moveaxis(o, 0, 2).reshape(B, H, L, dv)


def hgrn2_mixer(a_lat, a_ctx, w_in, w_out, lb, onorm_g, need_ctx):
    def proj(a):
        p = (a @ w_in).astype(F32)
        B, Lx, _ = p.shape
        q, f_f, f_b, i, g = jnp.split(p, [HG_F, 2 * HG_F, 3 * HG_F, 3 * HG_F + HG_HEADS * HG_DV], axis=-1)

        def heads(t, d):
            return t.reshape(B, Lx, HG_HEADS, d).transpose(0, 2, 1, 3)

        def gates(f, lbd):
            fg = lbd + (1.0 - lbd) * jax.nn.sigmoid(f)
            return heads(1.0 - fg, HG_DK), heads(jnp.log(fg), HG_DK)

        return heads(jax.nn.silu(q), HG_DK), heads(i, HG_DV), g, gates(f_f, lb[0]), gates(f_b, lb[1])

    def flip(t):
        return t[:, :, ::-1]

    def readout(o, g, like):
        B, H, Lx, _ = o.shape
        o = rmsnorm(o.transpose(0, 2, 1, 3), onorm_g.astype(F32)).reshape(B, Lx, H * HG_DV)
        return (o * jax.nn.silu(g)).astype(like.dtype) @ w_out

    B = a_lat.shape[0]
    S0 = jnp.zeros((B, HG_HEADS, HG_DK, HG_DV), F32)
    qc, ic, gc, (kcf, lcf), (kcb, lcb) = proj(a_ctx)
    S_cf, o_cf = gla_chunk_scan(qc, kcf, ic, lcf, S0)
    S_cb, o_cb = gla_chunk_scan(flip(qc), flip(kcb), flip(ic), flip(lcb), S0)
    ql, il, gl, (klf, llf), (klb, llb) = proj(a_lat)
    _, o_lf = gla_chunk_scan(ql, klf, il, llf, S_cf)
    _, o_lb = gla_chunk_scan(flip(ql), flip(klb), flip(il), flip(llb), S_cb)
    y_lat = readout(o_lf + flip(o_lb), gl, a_lat)
    y_ctx = readout(o_cf + flip(o_cb), gc, a_ctx) if need_ctx else None
    return y_lat, y_ctx


def peer_ffn(x, wq, keys, U, V):
    B, L, D = x.shape
    K = PEER_TOPK
    q = (x @ wq).reshape(B, L, PEER_HEADS, 2, PEER_QDIM // 2)
    s = jnp.einsum('blhpd,hpnd->blhpn', q, keys).astype(F32)
    s1, i1 = lax.top_k(s[..., 0, :], K)
    s2, i2 = lax.top_k(s[..., 1, :], K)
    cand = (s1[..., :, None] + s2[..., None, :]).reshape(B, L, PEER_HEADS, K * K)
    top_s, top_j = lax.top_k(cand, K)
    e1 = jnp.take_along_axis(i1, top_j // K, axis=-1)
    e2 = jnp.take_along_axis(i2, top_j % K, axis=-1)
    idx = e1 * N_KEYS + e2
    gate = jax.nn.softmax(top_s, axis=-1).astype(x.dtype)
    nblk = (B * L) // PEER_TOK_BLK
    xb = x.reshape(nblk, PEER_TOK_BLK, D)
    ib = idx.reshape(nblk, PEER_TOK_BLK, PEER_HEADS * K)
    gb = gate.reshape(nblk, PEER_TOK_BLK, PEER_HEADS * K)

    def block(args):
        xt, it, gt = args
        act = jax.nn.gelu(jnp.einsum('tkd,td->tk', U[it], xt), approximate=False) * gt
        return jnp.einsum('tk,tkd->td', act, V[it])

    return lax.map(block, (xb, ib, gb)).reshape(B, L, D)


def setup_inputs(seed: int = 0) -> dict:
    key = jax.random.key(seed)
    ks = iter(jax.random.split(key, 40))
    D = D_MODEL

    def nrm(shape, s):
        return jax.random.normal(next(ks), shape, F32) * s

    return {
        "x": nrm((BATCH, SEQ, D), 1.0),
        "c": nrm((BATCH, D), 1.0),
        "ctx": nrm((BATCH, CTX_LEN, D), 1.0),
        "c_ctx": nrm((D,), 1.0),
        "ada_w": nrm((DEPTH, D, N_MOD * D), 0.5 * D ** -0.5),
        "ada_b": nrm((DEPTH, N_MOD * D), 0.01),
        "norm1_g": 1.0 + nrm((DEPTH, D), 0.05),
        "norm2_g": 1.0 + nrm((DEPTH, D), 0.05),
        "final_g": 1.0 + nrm((D,), 0.05),
        "ab_w_in": nrm((N_EVEN, D, AB_IN), D ** -0.5),
        "ab_w_out": nrm((N_EVEN, AB_OUT, D), AB_OUT ** -0.5),
        "hy_conv_w": nrm((N_EVEN, HY_SHORT, 3 * HY_C), HY_SHORT ** -0.5),
        "hy_conv_b": nrm((N_EVEN, 3 * HY_C), 0.01),
        "hy_filt_w1": nrm((N_EVEN, HY_EMB, HY_FILT_W), HY_EMB ** -0.5),
        "hy_filt_b1": nrm((N_EVEN, HY_FILT_W), 0.02),
        "hy_filt_w2": nrm((N_EVEN, HY_FILT_W, HY_FILT_W), HY_FILT_W ** -0.5),
        "hy_filt_b2": nrm((N_EVEN, HY_FILT_W), 0.02),
        "hy_filt_w3": nrm((N_EVEN, HY_FILT_W, HY_ORDER * 2 * HY_C), HY_FILT_W ** -0.5),
        "hy_filt_freq": 1.0 + nrm((N_EVEN, HY_FILT_W), 0.1),
        "hy_skip": nrm((N_EVEN, HY_ORDER, HY_C), 0.5),
        "attn_sink": nrm((N_EVEN, N_Q_HEADS), 0.5),
        "hg_w_in": nrm((N_ODD, D, HG_IN), D ** -0.5),
        "hg_w_out": nrm((N_ODD, HG_HEADS * HG_DV, D), (HG_HEADS * HG_DV) ** -0.5),
        "hg_lb_logits": nrm((DEPTH, 2, HG_F), 0.5),
        "hg_onorm_g": 1.0 + nrm((N_ODD, HG_DV), 0.05),
        "peer_wq": nrm((DEPTH, D, PEER_HEADS * PEER_QDIM), D ** -0.5),
        "peer_keys": nrm((DEPTH, PEER_HEADS, 2, N_KEYS, PEER_QDIM // 2), (PEER_QDIM // 2) ** -0.5),
        "peer_u": nrm((DEPTH, N_EXPERTS, D), D ** -0.5),
        "peer_v": nrm((DEPTH, N_EXPERTS, D), 1.0),
    }


def reference(x, c, ctx, c_ctx, ada_w, ada_b, norm1_g, norm2_g, final_g, ab_w_in, ab_w_out,
              hy_conv_w, hy_conv_b, hy_filt_w1, hy_filt_b1, hy_filt_w2, hy_filt_b2, hy_filt_w3,
              hy_filt_freq, hy_skip, attn_sink, hg_w_in, hg_w_out, hg_lb_logits, hg_onorm_g,
              peer_wq, peer_keys, peer_u, peer_v):
    lb_p = jax.nn.softmax(hg_lb_logits.astype(F32), axis=0)
    lb_all = jnp.cumsum(lb_p, axis=0) - lb_p[0:1]
    h_lat, h_ctx = x, ctx
    for l in range(DEPTH):
        need_ctx = l < DEPTH - 1
        mod_l = (jax.nn.silu(c) @ ada_w[l] + ada_b[l])[:, None, :]
        mod_c = jax.nn.silu(c_ctx) @ ada_w[l] + ada_b[l]
        sh1, sc1, g1, sh2, sc2, g2 = jnp.split(mod_l, N_MOD, axis=-1)
        sh1c, sc1c, g1c, sh2c, sc2c, g2c = jnp.split(mod_c, N_MOD, axis=-1)
        a_lat = modulate(rmsnorm(h_lat, norm1_g[l]), sh1, sc1)
        a_ctx = modulate(rmsnorm(h_ctx, norm1_g[l]), sh1c, sc1c)
        j = l // 2
        if l % 2 == 0:
            y_lat, y_ctx = hyena_attention_mixer(
                a_lat, a_ctx, ab_w_in[j], ab_w_out[j], hy_conv_w[j], hy_conv_b[j],
                hy_filt_w1[j], hy_filt_b1[j], hy_filt_w2[j], hy_filt_b2[j], hy_filt_w3[j],
                hy_filt_freq[j], hy_skip[j], attn_sink[j], need_ctx)
        else:
            y_lat, y_ctx = hgrn2_mixer(a_lat, a_ctx, hg_w_in[j], hg_w_out[j], lb_all[l].astype(a_lat.dtype),
                                       hg_onorm_g[j], need_ctx)
        h_lat = h_lat + g1 * y_lat
        h_lat = h_lat + g2 * peer_ffn(modulate(rmsnorm(h_lat, norm2_g[l]), sh2, sc2),
                                      peer_wq[l], peer_keys[l], peer_u[l], peer_v[l])
        if need_ctx:
            h_ctx = h_ctx + g1c * y_ctx
            h_ctx = h_ctx + g2c * peer_ffn(modulate(rmsnorm(h_ctx, norm2_g[l]), sh2c, sc2c),
                                           peer_wq[l], peer_keys[l], peer_u[l], peer_v[l])
    return rmsnorm(h_lat, final_g)
```

```cpp
#ifndef HOST_EMU
#include <hip/hip_runtime.h>
#include <hip/hip_cooperative_groups.h>
#include <cstdio>
namespace cg = cooperative_groups;
#endif

#define MULTI_LAUNCH 1
#ifndef CFG_B
#define CFG_B 8
#define CFG_L 2048
#define CFG_LC 256
#endif
#define DEV __device__ __forceinline__
#ifdef HOST_EMU
#define __expf expf
#define __sinf sinf
#define __cosf cosf
#endif

typedef unsigned short bf16_t;
typedef short bf16x8 __attribute__((ext_vector_type(8)));
typedef float f32x16 __attribute__((ext_vector_type(16)));
typedef float f32x4 __attribute__((ext_vector_type(4)));
typedef unsigned u32x4 __attribute__((ext_vector_type(4)));
typedef unsigned u32x2 __attribute__((ext_vector_type(2)));
struct cf2 { float x, y; };

constexpr int NB = CFG_B, L = CFG_L, LC = CFG_LC, D = 1024;
constexpr int TL = NB * L, TC = NB * LC, T = TL + TC;
constexpr int NT = 512;
constexpr int NR = NB + 1;
constexpr int log4ceil(int n) { int s = 0, v = 1; while (v < n) { v *= 4; ++s; } return s; }
constexpr int FS_LAT = log4ceil(2 * L - 1), FS_CTX = log4ceil(2 * LC - 1);
constexpr int NF_LAT = 1 << (2 * FS_LAT), NF_CTX = 1 << (2 * FS_CTX);
static_assert(T % 256 == 0 && TL % 256 == 0 && L % 128 == 0 && LC % 128 == 0 && NB % 2 == 0, "shape");

constexpr size_t al256(size_t x) { return (x + 255) & ~(size_t)255; }
constexpr size_t WS_CTRL = 0, CTRL_BYTES = 65536;
constexpr size_t CTRL_HYNORM = 4096;
constexpr size_t WS_MOD = WS_CTRL + CTRL_BYTES;
constexpr size_t WS_H = al256(WS_MOD + (size_t)2 * NR * 6144 * 4);
constexpr size_t WS_A = al256(WS_H + (size_t)T * 1024 * 4);
constexpr size_t WS_P = al256(WS_A + (size_t)T * 1024 * 2);
constexpr size_t P_BYTES = (size_t)T * 5120 * 2;
constexpr size_t P_HYT_LAT = 0;
constexpr size_t P_HYT_CTX = P_HYT_LAT + (size_t)NB * 1536 * L * 2;
constexpr size_t P_Q0 = P_HYT_CTX + (size_t)NB * 1536 * LC * 2;
constexpr size_t P_K0 = P_Q0 + (size_t)T * 512 * 2;
constexpr size_t P_VT_LAT = P_K0 + (size_t)T * 128 * 2;
constexpr size_t P_VT_CTX = P_VT_LAT + (size_t)NB * 128 * L * 2;
static_assert(P_VT_CTX + (size_t)NB * 128 * LC * 2 <= P_BYTES, "P region");
constexpr size_t WS_M = al256(WS_P + P_BYTES);
constexpr size_t WS_IDX = al256(WS_M + (size_t)T * 1024 * 2);
constexpr size_t WS_GATE = al256(WS_IDX + (size_t)T * 128 * 4);
constexpr size_t WS_UB = al256(WS_GATE + (size_t)T * 128 * 4);
constexpr size_t WS_VB = WS_UB + (size_t)16384 * 1024 * 2;
constexpr size_t WS_W = WS_VB + (size_t)16384 * 1024 * 2;
constexpr size_t W_IN0 = 0, W_OUT0 = W_IN0 + (size_t)2304 * 1024 * 2, W_IN1 = W_OUT0 + (size_t)1024 * 1024 * 2,
                 W_OUT1 = W_IN1 + (size_t)5120 * 1024 * 2, W_Q0 = W_OUT1 + (size_t)1024 * 1024 * 2, W_Q1 = W_Q0 + (size_t)2048 * 1024 * 2,
                 W_KEYS = W_Q1 + (size_t)2048 * 1024 * 2, W_BYTES = W_KEYS + (size_t)2 * 8 * 2 * 128 * 128 * 2;
constexpr size_t WS_F = al256(WS_W + W_BYTES);
constexpr size_t F_HRAW_LAT = 0;
constexpr size_t F_HRAW_CTX = F_HRAW_LAT + (size_t)2048 * L * 4;
constexpr size_t F_HF_LAT = F_HRAW_CTX + (size_t)2048 * LC * 4;
constexpr size_t F_HF_CTX = F_HF_LAT + (size_t)1024 * NF_LAT * 8;
constexpr size_t F_END = F_HF_CTX + (size_t)1024 * NF_CTX * 8;
constexpr size_t F_OF = 0, F_OB = (size_t)TL * 1024 * 2;
constexpr size_t F_BYTES = F_END > 2 * F_OB ? F_END : 2 * F_OB;
constexpr size_t WS_END = al256(WS_F + F_BYTES);

struct Params { const float* in[29]; float* out; unsigned char* ws; int ph_lo, ph_hi; };
enum { I_X = 0, I_C, I_CTX, I_CCTX, I_ADAW, I_ADAB, I_N1G, I_N2G, I_FG, I_ABWIN, I_ABWOUT, I_HYCW, I_HYCB, I_HYW1, I_HYB1, I_HYW2, I_HYB2, I_HYW3,
       I_HYFREQ, I_HYSKIP, I_SINK, I_HGWIN, I_HGWOUT, I_HGLB, I_HGON, I_PWQ, I_PKEYS, I_PU, I_PV };

constexpr int SMEM_BYTES = 131072;

#ifndef HOST_EMU
DEV int tidx() { int t = threadIdx.x; asm volatile("" : "+v"(t)); return t; }
#else
DEV int tidx() { return (int)threadIdx.x; }
#endif
DEV unsigned f2bf(float f) { unsigned u = __builtin_bit_cast(unsigned, f); return (u + 0x7fffu + ((u >> 16) & 1u)) >> 16; }
DEV float bf2f(unsigned h) { return __builtin_bit_cast(float, (h & 0xffffu) << 16); }
DEV unsigned pk2(float lo, float hi) { return f2bf(lo) | (f2bf(hi) << 16); }
DEV float bflo(unsigned u) { return __builtin_bit_cast(float, u << 16); }
DEV float bfhi(unsigned u) { return __builtin_bit_cast(float, u & 0xffff0000u); }
DEV float silu_f(float x) { return x / (1.f + __expf(-x)); }
DEV float sigmoid_f(float x) { return 1.f / (1.f + __expf(-x)); }
DEV float wave_sum(float v) {
#pragma unroll
    for (int m = 32; m >= 1; m >>= 1) v += __shfl_xor(v, m);
    return v;
}
DEV int mod_row(int tok) { return tok < TL ? tok / L : NB; }

DEV void p0_mod(const Params& p, int item, unsigned char* smem) {
    const int l = item / 96, col0 = (item % 96) * 64, tid = tidx();
    float* sc = (float*)smem;
    float* red = sc + NR * 1024;
    for (int i = tid; i < NR * 1024; i += NT) { const int r = i >> 10, k = i & 1023; const float c = r < NB ? p.in[I_C][r * 1024 + k] : p.in[I_CCTX][k]; sc[i] = c / (1.f + expf(-c)); }
    __syncthreads();
    const int kq = tid >> 6, col = tid & 63;
    float acc[NR];
#pragma unroll
    for (int r = 0; r < NR; ++r) acc[r] = 0.f;
    const float* w = p.in[I_ADAW] + (size_t)l * 1024 * 6144 + col0 + col;
#pragma unroll 4
    for (int k = kq * 128; k < kq * 128 + 128; ++k) {
        const float wv = w[(size_t)k * 6144];
#pragma unroll
        for (int r = 0; r < NR; ++r) acc[r] += sc[r * 1024 + k] * wv;
    }
#pragma unroll
    for (int r = 0; r < NR; ++r) red[(kq * NR + r) * 64 + col] = acc[r];
    __syncthreads();
    float* mod = (float*)(p.ws + WS_MOD);
    for (int i = tid; i < NR * 64; i += NT) {
        const int r = i >> 6, c = i & 63; float s = 0.f;
        for (int q = 0; q < 8; ++q) s += red[(q * NR + r) * 64 + c];
        mod[((size_t)l * NR + r) * 6144 + col0 + c] = s + p.in[I_ADAB][l * 6144 + col0 + c];
    }
    __syncthreads();
}
DEV void p0_transpose(const float* W, bf16_t* Wt, int N, int tile, unsigned char* smem) {
    float* ts = (float*)smem;
    const int ntn = N / 64, kt = tile / ntn, nt = tile % ntn, k0 = kt * 64, n0 = nt * 64, tid = tidx();
    for (int i = tid; i < 4096; i += NT) { const int kk = i >> 6, nn = i & 63; ts[kk * 65 + nn] = W[(size_t)(k0 + kk) * N + n0 + nn]; }
    __syncthreads();
    for (int i = tid; i < 4096; i += NT) { const int nn = i >> 6, kk = i & 63; Wt[(size_t)(n0 + nn) * 1024 + k0 + kk] = (bf16_t)f2bf(ts[kk * 65 + nn]); }
    __syncthreads();
}
DEV void p0_convert(const float* src, bf16_t* dst, int item) {
    const int tid = tidx();
#pragma unroll
    for (int i = 0; i < 8; ++i) {
        const size_t e = (size_t)item * 16384 + (size_t)(i * NT + tid) * 4;
        const f32x4 v = *(const f32x4*)(src + e);
        u32x2 o; o[0] = pk2(v[0], v[1]); o[1] = pk2(v[2], v[3]);
        *(u32x2*)(dst + e) = o;
    }
}
DEV void p0_filter(const Params& p, int set, int chunk, unsigned char* smem) {
    const int Ls = set ? LC : L, l0 = chunk * 64, tid = tidx();
    float* z = (float*)smem;
    float* hd1 = z + 64 * 34;
    float* hd2 = hd1 + 64 * 65;
    const float* w1 = p.in[I_HYW1]; const float* b1 = p.in[I_HYB1]; const float* w2 = p.in[I_HYW2]; const float* b2 = p.in[I_HYB2];
    const float* w3 = p.in[I_HYW3]; const float* fq = p.in[I_HYFREQ];
    for (int i = tid; i < 64 * 33; i += NT) {
        const int pp = i / 33, f = i % 33, l = l0 + pp; float val;
        if (f == 0) val = (float)l / (float)(Ls - 1);
        else { const int jb = (f - 1) & 15; const float fj = 1e-4f + (float)jb * ((15.f - 1e-4f) / 15.f); const float a = fj * (6.283185307179586f * (float)l / (float)Ls); val = f <= 16 ? __cosf(a) : -__sinf(a); }
        z[pp * 34 + f] = val;
    }
    __syncthreads();
    for (int i = tid; i < 4096; i += NT) {
        const int pp = i >> 6, j = i & 63; float s = b1[j];
#pragma unroll 4
        for (int f = 0; f < 33; ++f) s += z[pp * 34 + f] * w1[f * 64 + j];
        hd1[pp * 65 + j] = __sinf(fq[j] * s);
    }
    __syncthreads();
    for (int i = tid; i < 4096; i += NT) {
        const int pp = i >> 6, j = i & 63; float s = b2[j];
#pragma unroll 4
        for (int f = 0; f < 64; ++f) s += hd1[pp * 65 + f] * w2[f * 64 + j];
        hd2[pp * 65 + j] = __sinf(fq[j] * s);
    }
    __syncthreads();
    const int lane = tid & 63, w = __builtin_amdgcn_readfirstlane(tid >> 6);
    const float tl = (float)(l0 + lane) / (float)(Ls - 1);
    const float max_decay = -15.350567286626973f, min_decay = -3.0701134573253945f;
    float* hraw = (float*)(p.ws + WS_F + (set ? F_HRAW_CTX : F_HRAW_LAT));
    float* hyn = (float*)(p.ws + WS_CTRL + CTRL_HYNORM) + set * 2048;
    for (int oc = 0; oc < 256; ++oc) {
        const int o = w * 256 + oc; float s = 0.f;
#pragma unroll 8
        for (int j = 0; j < 64; ++j) s += hd2[lane * 65 + j] * w3[j * 2048 + o];
        const int c = o & 511; const float delta = fabsf(min_decay + (float)c * ((max_decay - min_decay) / 511.f));
        const float val = s * expf(-tl * delta);
        hraw[(size_t)o * Ls + l0 + lane] = val;
        const float a = wave_sum(fabsf(val));
        if (lane == 0) atomicAdd(&hyn[o], a);
    }
    __syncthreads();
}

constexpr int P0_MOD = 192, P0_TR_IN0 = 16 * 36, P0_TR_OUT0 = 256, P0_TR_IN1 = 16 * 80, P0_TR_OUT1 = 256, P0_TR_Q = 16 * 32, P0_KEYS = 32, P0_TAB = 1024,
              P0_FILT = L / 64 + LC / 64;
DEV void phase0(const Params& p, unsigned char* smem) {
    bf16_t* W = (bf16_t*)(p.ws + WS_W);
    const int total = P0_MOD + P0_FILT + P0_TR_IN0 + P0_TR_OUT0 + P0_TR_IN1 + P0_TR_OUT1 + 2 * P0_TR_Q + P0_KEYS + 2 * P0_TAB;
    for (int it = blockIdx.x; it < total; it += gridDim.x) {
        int i = it;
        if (i < P0_MOD) { p0_mod(p, i, smem); continue; } i -= P0_MOD;
        if (i < P0_FILT) { if (i < L / 64) p0_filter(p, 0, i, smem); else p0_filter(p, 1, i - L / 64, smem); continue; } i -= P0_FILT;
        if (i < P0_TR_IN0) { p0_transpose(p.in[I_ABWIN], W + W_IN0 / 2, 2304, i, smem); continue; } i -= P0_TR_IN0;
        if (i < P0_TR_OUT0) { p0_transpose(p.in[I_ABWOUT], W + W_OUT0 / 2, 1024, i, smem); continue; } i -= P0_TR_OUT0;
        if (i < P0_TR_IN1) { p0_transpose(p.in[I_HGWIN], W + W_IN1 / 2, 5120, i, smem); continue; } i -= P0_TR_IN1;
        if (i < P0_TR_OUT1) { p0_transpose(p.in[I_HGWOUT], W + W_OUT1 / 2, 1024, i, smem); continue; } i -= P0_TR_OUT1;
        if (i < P0_TR_Q) { p0_transpose(p.in[I_PWQ], W + W_Q0 / 2, 2048, i, smem); continue; } i -= P0_TR_Q;
        if (i < P0_TR_Q) { p0_transpose(p.in[I_PWQ] + (size_t)1024 * 2048, W + W_Q1 / 2, 2048, i, smem); continue; } i -= P0_TR_Q;
        if (i < P0_KEYS) { p0_convert(p.in[I_PKEYS], W + W_KEYS / 2, i); continue; } i -= P0_KEYS;
        if (i < P0_TAB) { p0_convert(p.in[I_PU], (bf16_t*)(p.ws + WS_UB), i); continue; } i -= P0_TAB;
        p0_convert(p.in[I_PV], (bf16_t*)(p.ws + WS_VB), i);
    }
}
DEV void tables_layer1(const Params& p, int i) {
    if (i < P0_TAB) p0_convert(p.in[I_PU] + (size_t)16384 * 1024, (bf16_t*)(p.ws + WS_UB), i);
    else p0_convert(p.in[I_PV] + (size_t)16384 * 1024, (bf16_t*)(p.ws + WS_VB), i - P0_TAB);
}

DEV const float* h_row(const Params& p, int layer_src_inputs, int tok) {
    if (layer_src_inputs) return tok < TL ? p.in[I_X] + (size_t)tok * 1024 : p.in[I_CTX] + (size_t)(tok - TL) * 1024;
    return (const float*)(p.ws + WS_H) + (size_t)tok * 1024;
}
DEV void norm_row_store(const Params& p, const f32x4 (&v)[4], int tok, const float* g, int layer, int sh_off, int lane) {
    float ss = 0.f;
#pragma unroll
    for (int i = 0; i < 4; ++i) ss += v[i][0] * v[i][0] + v[i][1] * v[i][1] + v[i][2] * v[i][2] + v[i][3] * v[i][3];
    ss = wave_sum(ss);
    const float rstd = rsqrtf(ss * (1.f / 1024.f) + 1e-6f);
    const float* mod = (const float*)(p.ws + WS_MOD) + ((size_t)layer * NR + mod_row(tok)) * 6144 + sh_off;
    bf16_t* A = (bf16_t*)(p.ws + WS_A) + (size_t)tok * 1024;
#pragma unroll
    for (int i = 0; i < 4; ++i) {
        const int c = i * 256 + lane * 4;
        const f32x4 gg = *(const f32x4*)(g + c), sh = *(const f32x4*)(mod + c), sc = *(const f32x4*)(mod + 1024 + c);
        u32x2 o;
        o[0] = pk2(v[i][0] * rstd * gg[0] * (1.f + sc[0]) + sh[0], v[i][1] * rstd * gg[1] * (1.f + sc[1]) + sh[1]);
        o[1] = pk2(v[i][2] * rstd * gg[2] * (1.f + sc[2]) + sh[2], v[i][3] * rstd * gg[3] * (1.f + sc[3]) + sh[3]);
        *(u32x2*)(A + c) = o;
    }
}
DEV void norm_rows_item(const Params& p, int item, int from_inputs, const float* g, int layer, int sh_off) {
    const int tok = item * 8 + (tidx() >> 6), lane = tidx() & 63;
    const float* src = h_row(p, from_inputs, tok);
    f32x4 v[4];
#pragma unroll
    for (int i = 0; i < 4; ++i) v[i] = *(const f32x4*)(src + i * 256 + lane * 4);
    norm_row_store(p, v, tok, g, layer, sh_off, lane);
}

DEV cf2 cmul(cf2 a, cf2 b) { cf2 r; r.x = a.x * b.x - a.y * b.y; r.y = a.x * b.y + a.y * b.x; return r; }
DEV cf2 twid(int k, float invN) { cf2 r; const float a = (float)k * invN; r.x = __builtin_amdgcn_cosf(a); r.y = -__builtin_amdgcn_sinf(a); return r; }
DEV void fft_fwd(cf2* buf, int S, int g, int G) {
    const int N = 1 << (2 * S); const float invN = 1.f / (float)N;
    for (int s = 0; s < S; ++s) {
        const int lm = 2 * (S - s), m = 1 << lm, q = m >> 2;
        for (int bf = g; bf < (N >> 2); bf += G) {
            const int j = bf & (q - 1), base = ((bf >> (lm - 2)) << lm) + j;
            const cf2 a0 = buf[base], a1 = buf[base + q], a2 = buf[base + 2 * q], a3 = buf[base + 3 * q];
            cf2 t0, t1, t2, t3; t0.x = a0.x + a2.x; t0.y = a0.y + a2.y; t1.x = a0.x - a2.x; t1.y = a0.y - a2.y; t2.x = a1.x + a3.x; t2.y = a1.y + a3.y;
            const float dx = a1.x - a3.x, dy = a1.y - a3.y; t3.x = dy; t3.y = -dx;
            cf2 y0, y1, y2, y3; y0.x = t0.x + t2.x; y0.y = t0.y + t2.y; y1.x = t1.x + t3.x; y1.y = t1.y + t3.y; y2.x = t0.x - t2.x; y2.y = t0.y - t2.y; y3.x = t1.x - t3.x; y3.y = t1.y - t3.y;
            const int tw = j << (2 * s);
            buf[base] = y0; buf[base + q] = cmul(y1, twid(tw, invN)); buf[base + 2 * q] = cmul(y2, twid(2 * tw, invN)); buf[base + 3 * q] = cmul(y3, twid(3 * tw, invN));
        }
        __syncthreads();
    }
}
DEV void fft_inv(cf2* buf, int S, int g, int G) {
    const int N = 1 << (2 * S); const float invN = 1.f / (float)N;
    for (int s = S - 1; s >= 0; --s) {
        const int lm = 2 * (S - s), m = 1 << lm, q = m >> 2;
        for (int bf = g; bf < (N >> 2); bf += G) {
            const int j = bf & (q - 1), base = ((bf >> (lm - 2)) << lm) + j;
            const int tw = j << (2 * s);
            cf2 w1 = twid(tw, invN), w2 = twid(2 * tw, invN), w3 = twid(3 * tw, invN); w1.y = -w1.y; w2.y = -w2.y; w3.y = -w3.y;
            const cf2 c0 = buf[base], c1 = cmul(buf[base + q], w1), c2 = cmul(buf[base + 2 * q], w2), c3 = cmul(buf[base + 3 * q], w3);
            cf2 t0, t1, t2, t3; t0.x = c0.x + c2.x; t0.y = c0.y + c2.y; t1.x = c0.x - c2.x; t1.y = c0.y - c2.y; t2.x = c1.x + c3.x; t2.y = c1.y + c3.y;
            const float dx = c1.x - c3.x, dy = c1.y - c3.y; t3.x = -dy; t3.y = dx;
            cf2 a0, a1, a2, a3; a0.x = t0.x + t2.x; a0.y = t0.y + t2.y; a1.x = t1.x + t3.x; a1.y = t1.y + t3.y; a2.x = t0.x - t2.x; a2.y = t0.y - t2.y; a3.x = t1.x - t3.x; a3.y = t1.y - t3.y;
            buf[base] = a0; buf[base + q] = a1; buf[base + 2 * q] = a2; buf[base + 3 * q] = a3;
        }
        __syncthreads();
    }
}
DEV void hf_item(const Params& p, int set, int pi, unsigned char* smem) {
    const int Ls = set ? LC : L, S = set ? FS_CTX : FS_LAT, N = 1 << (2 * S);
    const int gi = tidx() >> 8, g = tidx() & 255, idx = pi * 2 + gi, o = idx >> 9, c = idx & 511;
    cf2* buf = (cf2*)smem + (size_t)gi * N;
    const float* hraw = (const float*)(p.ws + WS_F + (set ? F_HRAW_CTX : F_HRAW_LAT));
    const float* hyn = (const float*)(p.ws + WS_CTRL + CTRL_HYNORM) + set * 2048;
    const float inv = 1.f / (hyn[o * 1024 + c] + hyn[o * 1024 + 512 + c]);
    const float* hf = hraw + (size_t)(o * 1024 + c) * Ls; const float* hb = hraw + (size_t)(o * 1024 + 512 + c) * Ls;
    for (int k = g; k < N; k += 256) { float re = 0.f; if (k < Ls) re = hf[k] * inv; else if (k > N - Ls) re = hb[N - k] * inv; cf2 v; v.x = re; v.y = 0.f; buf[k] = v; }
    __syncthreads();
    fft_fwd(buf, S, g, 256);
    cf2* HF = (cf2*)(p.ws + WS_F + (set ? F_HF_CTX : F_HF_LAT)) + (size_t)(o * 512 + c) * N;
    for (int k = g; k < N; k += 256) HF[k] = buf[k];
    __syncthreads();
}
constexpr int P1_NORM = T / 8, P1_HF = 512;
DEV void phase1(const Params& p, unsigned char* smem) {
    const int total = P1_NORM + 2 * P1_HF;
    for (int it = blockIdx.x; it < total; it += gridDim.x) {
        if (it < P1_NORM) norm_rows_item(p, it, 1, p.in[I_N1G], 0, 0);
        else if (it < P1_NORM + P1_HF) hf_item(p, 0, it - P1_NORM, smem);
        else hf_item(p, 1, it - P1_NORM - P1_HF, smem);
    }
}

constexpr int G_LDA = 72;
template <class Epi>
DEV void gemm_tile(const bf16_t* __restrict__ A, const bf16_t* __restrict__ Wt, int m0, int n0, unsigned char* smem, const Epi& epi) {
    bf16_t* As = (bf16_t*)smem;
    bf16_t* Bs = As + 2 * 256 * G_LDA;
    const int tid = tidx(), lane = tid & 63, w = tid >> 6, wm = w >> 1, wn = w & 1;
    f32x16 acc[2][2];
#pragma unroll
    for (int i = 0; i < 2; ++i)
#pragma unroll
        for (int j = 0; j < 2; ++j)
#pragma unroll
            for (int r = 0; r < 16; ++r) acc[i][j][r] = 0.f;
    u32x4 ra[4], rb[2];
    const bf16_t* Ag = A + (size_t)m0 * 1024; const bf16_t* Bg = Wt + (size_t)n0 * 1024;
#define GLOAD(k0) do { \
        _Pragma("unroll") for (int i = 0; i < 4; ++i) { const int id = tid + NT * i, row = id >> 3, kc = id & 7; ra[i] = *(const u32x4*)(Ag + (size_t)row * 1024 + (k0) + kc * 8); } \
        _Pragma("unroll") for (int i = 0; i < 2; ++i) { const int id = tid + NT * i, row = id >> 3, kc = id & 7; rb[i] = *(const u32x4*)(Bg + (size_t)row * 1024 + (k0) + kc * 8); } } while (0)
#define LSTORE(buf_) do { \
        _Pragma("unroll") for (int i = 0; i < 4; ++i) { const int id = tid + NT * i, row = id >> 3, kc = id & 7; *(u32x4*)(As + ((buf_) * 256 + row) * G_LDA + kc * 8) = ra[i]; } \
        _Pragma("unroll") for (int i = 0; i < 2; ++i) { const int id = tid + NT * i, row = id >> 3, kc = id & 7; *(u32x4*)(Bs + ((buf_) * 128 + row) * G_LDA + kc * 8) = rb[i]; } } while (0)
    GLOAD(0); LSTORE(0); __syncthreads();
    for (int kt = 0; kt < 16; ++kt) {
        const int buf = kt & 1;
        if (kt + 1 < 16) GLOAD((kt + 1) * 64);
        const bf16_t* as = As + (buf * 256 + wm * 64 + (lane & 31)) * G_LDA + 8 * (lane >> 5);
        const bf16_t* bs = Bs + (buf * 128 + wn * 64 + (lane & 31)) * G_LDA + 8 * (lane >> 5);
#pragma unroll
        for (int kk = 0; kk < 4; ++kk) {
            const bf16x8 a0 = *(const bf16x8*)(as + kk * 16), a1 = *(const bf16x8*)(as + 32 * G_LDA + kk * 16);
            const bf16x8 b0 = *(const bf16x8*)(bs + kk * 16), b1 = *(const bf16x8*)(bs + 32 * G_LDA + kk * 16);
            acc[0][0] = __builtin_amdgcn_mfma_f32_32x32x16_bf16(a0, b0, acc[0][0], 0, 0, 0);
            acc[0][1] = __builtin_amdgcn_mfma_f32_32x32x16_bf16(a0, b1, acc[0][1], 0, 0, 0);
            acc[1][0] = __builtin_amdgcn_mfma_f32_32x32x16_bf16(a1, b0, acc[1][0], 0, 0, 0);
            acc[1][1] = __builtin_amdgcn_mfma_f32_32x32x16_bf16(a1, b1, acc[1][1], 0, 0, 0);
        }
        if (kt + 1 < 16) LSTORE(buf ^ 1);
        __syncthreads();
    }
#pragma unroll
    for (int mi = 0; mi < 2; ++mi)
#pragma unroll
        for (int ni = 0; ni < 2; ++ni)
#pragma unroll
            for (int rg = 0; rg < 4; ++rg) {
                const int row = m0 + wm * 64 + mi * 32 + 8 * rg + 4 * (lane >> 5), col = n0 + wn * 64 + ni * 32 + (lane & 31);
                epi(row, col, acc[mi][ni][rg * 4 + 0], acc[mi][ni][rg * 4 + 1], acc[mi][ni][rg * 4 + 2], acc[mi][ni][rg * 4 + 3]);
            }
}
struct EpiL0In {
    unsigned char* ws;
    DEV void operator()(int row, int col, float v0, float v1, float v2, float v3) const {
        u32x2 o; o[0] = pk2(v0, v1); o[1] = pk2(v2, v3);
        const bool lat = row < TL; const int b = lat ? row / L : (row - TL) / LC, t = lat ? row - b * L : (row - TL) - b * LC, Lx = lat ? L : LC;
        if (col < 1536) { bf16_t* d = (bf16_t*)(ws + WS_P + (lat ? P_HYT_LAT : P_HYT_CTX)) + ((size_t)b * 1536 + col) * Lx + t; *(u32x2*)d = o; }
        else if (col < 2048) { bf16_t* d = (bf16_t*)(ws + WS_P + P_Q0) + (size_t)row * 512 + (col - 1536); d[0] = (bf16_t)f2bf(v0); d[512] = (bf16_t)f2bf(v1); d[1024] = (bf16_t)f2bf(v2); d[1536] = (bf16_t)f2bf(v3); }
        else if (col < 2176) { bf16_t* d = (bf16_t*)(ws + WS_P + P_K0) + (size_t)row * 128 + (col - 2048); d[0] = (bf16_t)f2bf(v0); d[128] = (bf16_t)f2bf(v1); d[256] = (bf16_t)f2bf(v2); d[384] = (bf16_t)f2bf(v3); }
        else { bf16_t* d = (bf16_t*)(ws + WS_P + (lat ? P_VT_LAT : P_VT_CTX)) + ((size_t)b * 128 + (col - 2176)) * Lx + t; *(u32x2*)d = o; }
    }
};
struct EpiBf16 {
    bf16_t* out; int ld;
    DEV void operator()(int row, int col, float v0, float v1, float v2, float v3) const {
        bf16_t* d = out + (size_t)row * ld + col; d[0] = (bf16_t)f2bf(v0); d[ld] = (bf16_t)f2bf(v1); d[2 * ld] = (bf16_t)f2bf(v2); d[3 * ld] = (bf16_t)f2bf(v3);
    }
};
struct EpiRes {
    const Params* p; int from_inputs, layer, goff;
    DEV void operator()(int row, int col, float v0, float v1, float v2, float v3) const {
        const float vv[4] = {v0, v1, v2, v3};
        float* H = (float*)(p->ws + WS_H);
        const float* mod = (const float*)(p->ws + WS_MOD) + (size_t)layer * NR * 6144 + goff + col;
#pragma unroll
        for (int i = 0; i < 4; ++i) { const int r = row + i; H[(size_t)r * 1024 + col] = h_row(*p, from_inputs, r)[col] + mod[(size_t)mod_row(r) * 6144] * vv[i]; }
    }
};

DEV float hy_u(const bf16_t* row, int t, int Lx, float w0, float w1, float w2, float b) {
    const float xm = t > 0 ? bf2f(row[t - 1]) : 0.f, x0 = bf2f(row[t]), xp = t + 1 < Lx ? bf2f(row[t + 1]) : 0.f;
    return w0 * xm + w1 * x0 + w2 * xp + b;
}
DEV void hyena_item(const Params& p, int set, int item, unsigned char* smem) {
    const int Ls = set ? LC : L, S = set ? FS_CTX : FS_LAT, N = 1 << (2 * S);
    const int gi = tidx() >> 8, g = tidx() & 255;
    const int bp = item >> 8, c = (item & 255) * 2 + gi, ba = bp * 2, bb = ba + 1;
    cf2* buf = (cf2*)smem + (size_t)gi * N;
    cf2* zk = (cf2*)smem + (size_t)2 * N + (size_t)gi * Ls;
    const bf16_t* hy = (const bf16_t*)(p.ws + WS_P + (set ? P_HYT_CTX : P_HYT_LAT));
    const float* cw = p.in[I_HYCW]; const float* cb = p.in[I_HYCB];
    const cf2* HF = (const cf2*)(p.ws + WS_F + (set ? F_HF_CTX : F_HF_LAT));
    const float invN = 1.f / (float)N;
    {
        const float w0 = cw[c], w1 = cw[1536 + c], w2 = cw[3072 + c], b = cb[c];
        const bf16_t* ra = hy + ((size_t)ba * 1536 + c) * Ls; const bf16_t* rb = hy + ((size_t)bb * 1536 + c) * Ls;
        for (int t = g; t < N; t += 256) { cf2 v; v.x = 0.f; v.y = 0.f; if (t < Ls) { v.x = hy_u(ra, t, Ls, w0, w1, w2, b); v.y = hy_u(rb, t, Ls, w0, w1, w2, b); zk[t] = v; } buf[t] = v; }
    }
    __syncthreads();
    for (int n = 0; n < 2; ++n) {
        fft_fwd(buf, S, g, 256);
        const cf2* hf = HF + (size_t)(n * 512 + c) * N;
        for (int k = g; k < N; k += 256) buf[k] = cmul(buf[k], hf[k]);
        __syncthreads();
        fft_inv(buf, S, g, 256);
        const int gc = (n + 1) * 512 + c;
        const float w0 = cw[gc], w1 = cw[1536 + gc], w2 = cw[3072 + gc], b = cb[gc], dsk = p.in[I_HYSKIP][n * 512 + c];
        const bf16_t* ra = hy + ((size_t)ba * 1536 + gc) * Ls; const bf16_t* rb = hy + ((size_t)bb * 1536 + gc) * Ls;
        bf16_t* M = (bf16_t*)(p.ws + WS_M);
        for (int t = g; t < N; t += 256) {
            cf2 v; v.x = 0.f; v.y = 0.f;
            if (t < Ls) {
                const cf2 cv = buf[t], zo = zk[t];
                v.x = hy_u(ra, t, Ls, w0, w1, w2, b) * (cv.x * invN + dsk * zo.x); v.y = hy_u(rb, t, Ls, w0, w1, w2, b) * (cv.y * invN + dsk * zo.y);
                if (n == 0) zk[t] = v;
                else { const size_t ta = set ? (size_t)TL + (size_t)ba * LC + t : (size_t)ba * L + t, tb = set ? (size_t)TL + (size_t)bb * LC + t : (size_t)bb * L + t;
                       M[ta * 1024 + c] = (bf16_t)f2bf(v.x); M[tb * 1024 + c] = (bf16_t)f2bf(v.y); }
            }
            if (n == 0) buf[t] = v;
        }
        __syncthreads();
    }
}
DEV void rope_store(const bf16_t* src, bf16_t* dst, int pos, bool rope, float scale, int ph, int sub) {
    const u32x4 ua = *(const u32x4*)(src + ph * 32 + sub * 8), ub = *(const u32x4*)(src + ph * 32 + 16 + sub * 8);
    float a[8], b[8];
#pragma unroll
    for (int i = 0; i < 4; ++i) { a[2 * i] = bflo(ua[i]); a[2 * i + 1] = bfhi(ua[i]); b[2 * i] = bflo(ub[i]); b[2 * i + 1] = bfhi(ub[i]); }
    if (rope) {
        const float pv = (float)(ph == 0 ? pos / 64 : pos % 64);
#pragma unroll
        for (int e = 0; e < 8; ++e) {
            const float inv = exp2f(-(float)(sub * 8 + e) * (13.287712379549449f / 16.f));
            const float ang = pv * inv, cs = __cosf(ang), sn = __sinf(ang);
            const float na = a[e] * cs - b[e] * sn, nb = b[e] * cs + a[e] * sn; a[e] = na; b[e] = nb;
        }
    }
    u32x4 oa, ob;
#pragma unroll
    for (int i = 0; i < 4; ++i) { oa[i] = pk2(a[2 * i] * scale, a[2 * i + 1] * scale); ob[i] = pk2(b[2 * i] * scale, b[2 * i + 1] * scale); }
    *(u32x4*)(dst + ph * 32 + sub * 8) = oa; *(u32x4*)(dst + ph * 32 + 16 + sub * 8) = ob;
}
constexpr int A_LDQ = 72, A_LDV = 136;
DEV void attn_item(const Params& p, int set, int item, unsigned char* smem) {
    bf16_t* Qs = (bf16_t*)smem;
    bf16_t* Ks = Qs + 128 * A_LDQ;
    bf16_t* Vt = Ks + 128 * A_LDQ;
    const int tid = tidx(), lane = tid & 63, w = tid >> 6, l15 = lane & 15, lg = lane >> 4;
    const int nqb = set ? LC / 128 : L / 128;
    const int h = item & 7, qb = (item >> 3) % nqb, b = (item >> 3) / nqb, kvh = h >> 2;
    const bf16_t* Q0 = (const bf16_t*)(p.ws + WS_P + P_Q0); const bf16_t* K0 = (const bf16_t*)(p.ws + WS_P + P_K0);
    const int qtok0 = set ? TL + b * LC + qb * 128 : b * L + qb * 128;
    { const int row = tid >> 2, ph = (tid >> 1) & 1, sub = tid & 1;
      rope_store(Q0 + (size_t)(qtok0 + row) * 512 + h * 64, Qs + row * A_LDQ, qb * 128 + row, set == 0, 0.125f, ph, sub); }
    __syncthreads();
    bf16x8 qf[2];
    qf[0] = *(const bf16x8*)(Qs + (w * 16 + l15) * A_LDQ + 8 * lg); qf[1] = *(const bf16x8*)(Qs + (w * 16 + l15) * A_LDQ + 32 + 8 * lg);
    float m_run = p.in[I_SINK][h], l_run = 1.f;
    f32x4 O[4];
#pragma unroll
    for (int i = 0; i < 4; ++i) O[i] = (f32x4){0.f, 0.f, 0.f, 0.f};
    const int nwin = set ? 0 : 3, nctx = LC / 128;
    for (int kbi = 0; kbi < nwin + nctx; ++kbi) {
        const bool win = kbi < nwin; const int kb = win ? qb - 1 + kbi : kbi - nwin;
        if (win && (kb < 0 || kb >= L / 128)) continue;
        const int ktok0 = win ? b * L + kb * 128 : TL + b * LC + kb * 128;
        __syncthreads();
        { const int row = tid >> 2, ph = (tid >> 1) & 1, sub = tid & 1;
          rope_store(K0 + (size_t)(ktok0 + row) * 128 + kvh * 64, Ks + row * A_LDQ, kb * 128 + row, win, 1.f, ph, sub); }
        { const bf16_t* vt = (const bf16_t*)(p.ws + WS_P + (win ? P_VT_LAT : P_VT_CTX)); const int Lx = win ? L : LC;
#pragma unroll
          for (int i = 0; i < 2; ++i) { const int id = tid + NT * i, d = id >> 4, kc = id & 15;
              *(u32x4*)(Vt + d * A_LDV + kc * 8) = *(const u32x4*)(vt + ((size_t)b * 128 + kvh * 64 + d) * Lx + kb * 128 + kc * 8); } }
        __syncthreads();
#pragma unroll
        for (int ch = 0; ch < 2; ++ch) {
            f32x4 st[4];
#pragma unroll
            for (int u = 0; u < 4; ++u) {
                const bf16_t* kr = Ks + ((ch * 4 + u) * 16 + l15) * A_LDQ + 8 * lg;
                f32x4 z = (f32x4){0.f, 0.f, 0.f, 0.f};
                z = __builtin_amdgcn_mfma_f32_16x16x32_bf16(*(const bf16x8*)kr, qf[0], z, 0, 0, 0);
                z = __builtin_amdgcn_mfma_f32_16x16x32_bf16(*(const bf16x8*)(kr + 32), qf[1], z, 0, 0, 0);
                st[u] = z;
            }
            float cmax = -INFINITY;
            if (win) {
                const int qpos = qb * 128 + w * 16 + l15;
#pragma unroll
                for (int u = 0; u < 4; ++u)
#pragma unroll
                    for (int r = 0; r < 4; ++r) { const int kpos = kb * 128 + (ch * 4 + u) * 16 + 4 * lg + r; const int dd = qpos - kpos; if (dd > 128 || dd < -128) st[u][r] = -INFINITY; }
            }
#pragma unroll
            for (int u = 0; u < 4; ++u)
#pragma unroll
                for (int r = 0; r < 4; ++r) cmax = fmaxf(cmax, st[u][r]);
            cmax = fmaxf(cmax, __shfl_xor(cmax, 16)); cmax = fmaxf(cmax, __shfl_xor(cmax, 32));
            const float m_new = fmaxf(m_run, cmax), alpha = __expf(m_run - m_new);
            float ls = 0.f;
#pragma unroll
            for (int u = 0; u < 4; ++u)
#pragma unroll
                for (int r = 0; r < 4; ++r) { const float e = __expf(st[u][r] - m_new); st[u][r] = e; ls += e; }
            ls += __shfl_xor(ls, 16); ls += __shfl_xor(ls, 32);
            l_run = l_run * alpha + ls; m_run = m_new;
#pragma unroll
            for (int i = 0; i < 4; ++i) { O[i][0] *= alpha; O[i][1] *= alpha; O[i][2] *= alpha; O[i][3] *= alpha; }
#pragma unroll
            for (int ss = 0; ss < 2; ++ss) {
                u32x4 pu; pu[0] = pk2(st[2 * ss][0], st[2 * ss][1]); pu[1] = pk2(st[2 * ss][2], st[2 * ss][3]); pu[2] = pk2(st[2 * ss + 1][0], st[2 * ss + 1][1]); pu[3] = pk2(st[2 * ss + 1][2], st[2 * ss + 1][3]);
                const bf16x8 pf = __builtin_bit_cast(bf16x8, pu);
                const int key0 = (ch * 4 + 2 * ss) * 16 + 4 * lg;
#pragma unroll
                for (int dt = 0; dt < 4; ++dt) {
                    const bf16_t* vr = Vt + (dt * 16 + l15) * A_LDV + key0;
                    u32x4 vu; const u32x2 v0 = *(const u32x2*)vr, v1 = *(const u32x2*)(vr + 16); vu[0] = v0[0]; vu[1] = v0[1]; vu[2] = v1[0]; vu[3] = v1[1];
                    O[dt] = __builtin_amdgcn_mfma_f32_16x16x32_bf16(__builtin_bit_cast(bf16x8, vu), pf, O[dt], 0, 0, 0);
                }
            }
        }
    }
    const float il = 1.f / l_run;
    bf16_t* M = (bf16_t*)(p.ws + WS_M) + (size_t)(qtok0 + w * 16 + l15) * 1024 + 512 + h * 64;
#pragma unroll
    for (int dt = 0; dt < 4; ++dt) { u32x2 o; o[0] = pk2(O[dt][0] * il, O[dt][1] * il); o[1] = pk2(O[dt][2] * il, O[dt][3] * il); *(u32x2*)(M + dt * 16 + 4 * lg) = o; }
    __syncthreads();
}
constexpr int P3_HY_LAT = (NB / 2) * 256, P3_HY_CTX = (NB / 2) * 256, P3_AT_LAT = NB * (L / 128) * 8, P3_AT_CTX = NB * (LC / 128) * 8;
DEV void phase3(const Params& p, unsigned char* smem) {
    const int total = P3_HY_LAT + P3_AT_LAT + P3_HY_CTX + P3_AT_CTX;
    for (int it = blockIdx.x; it < total; it += gridDim.x) {
        int i = it;
        if (i < P3_HY_LAT) { hyena_item(p, 0, i, smem); continue; } i -= P3_HY_LAT;
        if (i < P3_AT_LAT) { attn_item(p, 0, i, smem); continue; } i -= P3_AT_LAT;
        if (i < P3_HY_CTX) { hyena_item(p, 1, i, smem); continue; } i -= P3_HY_CTX;
        attn_item(p, 1, i, smem);
    }
}

constexpr int K_LDQ = 264, K_LDK = 136, K_LDS = 129;
DEV void topk_item(const Params& p, int layer, int item, unsigned char* smem) {
    bf16_t* Qs = (bf16_t*)smem;
    bf16_t* Ks = Qs + 64 * K_LDQ;
    float* Sc = (float*)(Ks + 128 * K_LDK);
    float* s12 = Sc + 64 * K_LDS;
    int* i12 = (int*)(s12 + 64 * 32);
    float* tops = (float*)(i12 + 64 * 32);
    int* topi = (int*)(tops + 64 * 16);
    const int tid = tidx(), lane = tid & 63, w = tid >> 6;
    const int h = item & 7, tok0 = (item >> 3) * 64;
    const bf16_t* PQ = (const bf16_t*)(p.ws + WS_P);
    const bf16_t* keys = (const bf16_t*)(p.ws + WS_W + W_KEYS) + (size_t)layer * 262144 + (size_t)h * 32768;
#pragma unroll
    for (int i = 0; i < 4; ++i) { const int id = tid + NT * i, row = id >> 5, kc = id & 31; *(u32x4*)(Qs + row * K_LDQ + kc * 8) = *(const u32x4*)(PQ + (size_t)(tok0 + row) * 2048 + h * 256 + kc * 8); }
    for (int part = 0; part < 2; ++part) {
        __syncthreads();
#pragma unroll
        for (int i = 0; i < 4; ++i) { const int id = tid + NT * i, row = id >> 4, kc = id & 15; *(u32x4*)(Ks + row * K_LDK + kc * 8) = *(const u32x4*)(keys + (size_t)part * 16384 + row * 128 + kc * 8); }
        __syncthreads();
        { const int mi = w >> 2, ni = w & 3;
          f32x16 acc;
#pragma unroll
          for (int r = 0; r < 16; ++r) acc[r] = 0.f;
          const bf16_t* as = Qs + (mi * 32 + (lane & 31)) * K_LDQ + part * 128 + 8 * (lane >> 5);
          const bf16_t* bs = Ks + (ni * 32 + (lane & 31)) * K_LDK + 8 * (lane >> 5);
#pragma unroll
          for (int kk = 0; kk < 8; ++kk) acc = __builtin_amdgcn_mfma_f32_32x32x16_bf16(*(const bf16x8*)(as + kk * 16), *(const bf16x8*)(bs + kk * 16), acc, 0, 0, 0);
#pragma unroll
          for (int r = 0; r < 16; ++r) Sc[(mi * 32 + (r & 3) + 8 * (r >> 2) + 4 * (lane >> 5)) * K_LDS + ni * 32 + (lane & 31)] = acc[r]; }
        __syncthreads();
        { const int row = tid >> 3, n0 = (tid & 7) * 16;
          float mine[16]; int rank[16];
#pragma unroll
          for (int i = 0; i < 16; ++i) { mine[i] = Sc[row * K_LDS + n0 + i]; rank[i] = 0; }
          for (int mm = 0; mm < 128; ++mm) {
              const float o = Sc[row * K_LDS + mm];
#pragma unroll
              for (int i = 0; i < 16; ++i) rank[i] += (o > mine[i] || (o == mine[i] && mm < n0 + i)) ? 1 : 0;
          }
#pragma unroll
          for (int i = 0; i < 16; ++i) if (rank[i] < 16) { s12[(row * 2 + part) * 16 + rank[i]] = mine[i]; i12[(row * 2 + part) * 16 + rank[i]] = n0 + i; } }
    }
    __syncthreads();
    {
        const int row = tid >> 3, sub = tid & 7;
        const float* s1 = s12 + row * 32; const float* s2 = s1 + 16;
        for (int cc = sub; cc < 50; cc += 8) {
            int ci = 0, cj = 0, cnt = 0;
            for (int i = 0; i < 16; ++i) { const int nj = 16 / (i + 1); if (cc < cnt + nj) { ci = i; cj = cc - cnt; break; } cnt += nj; }
            const float mine = s1[ci] + s2[cj]; const int myflat = ci * 16 + cj; int rank = 0;
            for (int i = 0; i < 16; ++i) { const int nj = 16 / (i + 1); for (int j = 0; j < nj; ++j) { const float o = s1[i] + s2[j]; rank += (o > mine || (o == mine && (i * 16 + j) < myflat)) ? 1 : 0; } }
            if (rank < 16) { tops[row * 16 + rank] = mine; topi[row * 16 + rank] = i12[row * 32 + ci] * 128 + i12[row * 32 + 16 + cj]; }
        }
    }
    __syncthreads();
    if (tid < 64) {
        const int row = tid; float mx = -INFINITY, e[16], sum = 0.f;
#pragma unroll
        for (int i = 0; i < 16; ++i) mx = fmaxf(mx, tops[row * 16 + i]);
#pragma unroll
        for (int i = 0; i < 16; ++i) { e[i] = expf(tops[row * 16 + i] - mx); sum += e[i]; }
        const float inv = 1.f / sum;
        int* IDX = (int*)(p.ws + WS_IDX) + (size_t)(tok0 + row) * 128 + h * 16; float* GT = (float*)(p.ws + WS_GATE) + (size_t)(tok0 + row) * 128 + h * 16;
#pragma unroll
        for (int i = 0; i < 16; ++i) { IDX[i] = topi[row * 16 + i]; GT[i] = e[i] * inv; }
    }
    __syncthreads();
}

DEV float gelu_f(float x) { return 0.5f * x * (1.f + erff(x * 0.70710678118654752f)); }
DEV void peer_item(const Params& p, int layer, int item) {
    const int tok = item * 8 + (tidx() >> 6), lane = tidx() & 63;
    const bf16_t* A = (const bf16_t*)(p.ws + WS_A) + (size_t)tok * 1024 + lane * 16;
    const bf16_t* UB = (const bf16_t*)(p.ws + WS_UB) + lane * 16; const bf16_t* VB = (const bf16_t*)(p.ws + WS_VB) + lane * 16;
    float x[16], y[16];
    { const u32x4 a0 = *(const u32x4*)A, a1 = *(const u32x4*)(A + 8);
#pragma unroll
      for (int i = 0; i < 4; ++i) { x[2 * i] = bflo(a0[i]); x[2 * i + 1] = bfhi(a0[i]); x[8 + 2 * i] = bflo(a1[i]); x[8 + 2 * i + 1] = bfhi(a1[i]); } }
#pragma unroll
    for (int i = 0; i < 16; ++i) y[i] = 0.f;
    const int* IDX = (const int*)(p.ws + WS_IDX) + (size_t)tok * 128; const float* GT = (const float*)(p.ws + WS_GATE) + (size_t)tok * 128;
    const int i_lo = IDX[lane], i_hi = IDX[64 + lane]; const float g_lo = GT[lane], g_hi = GT[64 + lane];
    for (int k = 0; k < 128; ++k) {
        const int e = __shfl(k < 64 ? i_lo : i_hi, k & 63); const float gt = __shfl(k < 64 ? g_lo : g_hi, k & 63);
        const u32x4 u0 = *(const u32x4*)(UB + (size_t)e * 1024), u1 = *(const u32x4*)(UB + (size_t)e * 1024 + 8);
        const u32x4 v0 = *(const u32x4*)(VB + (size_t)e * 1024), v1 = *(const u32x4*)(VB + (size_t)e * 1024 + 8);
        float d = 0.f;
#pragma unroll
        for (int i = 0; i < 4; ++i) { d += bflo(u0[i]) * x[2 * i] + bfhi(u0[i]) * x[2 * i + 1] + bflo(u1[i]) * x[8 + 2 * i] + bfhi(u1[i]) * x[8 + 2 * i + 1]; }
        d = wave_sum(d);
        const float act = gelu_f(d) * gt;
#pragma unroll
        for (int i = 0; i < 4; ++i) { y[2 * i] += act * bflo(v0[i]); y[2 * i + 1] += act * bfhi(v0[i]); y[8 + 2 * i] += act * bflo(v1[i]); y[8 + 2 * i + 1] += act * bfhi(v1[i]); }
    }
    float* H = (float*)(p.ws + WS_H) + (size_t)tok * 1024 + lane * 16;
    const float* g2 = (const float*)(p.ws + WS_MOD) + ((size_t)layer * NR + mod_row(tok)) * 6144 + 5120 + lane * 16;
    float hv[16]; float ss = 0.f;
#pragma unroll
    for (int i = 0; i < 4; ++i) { const f32x4 hh = *(const f32x4*)(H + 4 * i), gg = *(const f32x4*)(g2 + 4 * i);
#pragma unroll
        for (int j = 0; j < 4; ++j) { const float v = hh[j] + gg[j] * y[4 * i + j]; hv[4 * i + j] = v; ss += v * v; } }
    ss = wave_sum(ss);
    const float rstd = rsqrtf(ss * (1.f / 1024.f) + 1e-6f);
    if (layer == 0) {
#pragma unroll
        for (int i = 0; i < 4; ++i) { f32x4 o; o[0] = hv[4 * i]; o[1] = hv[4 * i + 1]; o[2] = hv[4 * i + 2]; o[3] = hv[4 * i + 3]; *(f32x4*)(H + 4 * i) = o; }
        const float* g = p.in[I_N1G] + 1024 + lane * 16;
        const float* mod = (const float*)(p.ws + WS_MOD) + ((size_t)1 * NR + mod_row(tok)) * 6144 + lane * 16;
        bf16_t* Ao = (bf16_t*)(p.ws + WS_A) + (size_t)tok * 1024 + lane * 16;
        u32x4 o0, o1; float r[16];
#pragma unroll
        for (int i = 0; i < 16; ++i) r[i] = hv[i] * rstd * g[i] * (1.f + mod[1024 + i]) + mod[i];
#pragma unroll
        for (int i = 0; i < 4; ++i) { o0[i] = pk2(r[2 * i], r[2 * i + 1]); o1[i] = pk2(r[8 + 2 * i], r[8 + 2 * i + 1]); }
        *(u32x4*)Ao = o0; *(u32x4*)(Ao + 8) = o1;
    } else {
        const float* g = p.in[I_FG] + lane * 16; float* out = p.out + (size_t)tok * 1024 + lane * 16;
#pragma unroll
        for (int i = 0; i < 4; ++i) { f32x4 o; o[0] = hv[4 * i] * rstd * g[4 * i]; o[1] = hv[4 * i + 1] * rstd * g[4 * i + 1]; o[2] = hv[4 * i + 2] * rstd * g[4 * i + 2]; o[3] = hv[4 * i + 3] * rstd * g[4 * i + 3]; *(f32x4*)(out + 4 * i) = o; }
    }
}

DEV void scan_wave(const Params& p, int wi) {
    const int lane = tidx() & 63;
    const int vo = wi & 15, dir = (wi >> 4) & 1, h = (wi >> 5) & 7, b = wi >> 8;
    const bf16_t* P1 = (const bf16_t*)(p.ws + WS_P);
    bf16_t* Oo = (bf16_t*)(p.ws + WS_F + (dir ? F_OB : F_OF));
    const float* lg = p.in[I_HGLB];
    float lb[2];
#pragma unroll
    for (int i = 0; i < 2; ++i) { const int c = h * 128 + 2 * lane + i; lb[i] = 1.f / (1.f + expf(lg[dir * 1024 + c] - lg[2048 + dir * 1024 + c])); }
    float S[2][8];
#pragma unroll
    for (int i = 0; i < 2; ++i)
#pragma unroll
        for (int j = 0; j < 8; ++j) S[i][j] = 0.f;
    const int qoff = h * 128 + 2 * lane, foff = 1024 * (1 + dir) + h * 128 + 2 * lane, voff = 3072 + h * 128 + vo * 8;
    for (int step = 0; step < LC + L; ++step) {
        const bool isctx = step < LC; const int tt = isctx ? step : step - LC;
        const int tok = isctx ? TL + b * LC + (dir ? LC - 1 - tt : tt) : b * L + (dir ? L - 1 - tt : tt);
        const bf16_t* row = P1 + (size_t)tok * 5120;
        const unsigned fu = *(const unsigned*)(row + foff); const u32x4 vu = *(const u32x4*)(row + voff);
        float fg[2] = {lb[0] + (1.f - lb[0]) * sigmoid_f(bflo(fu)), lb[1] + (1.f - lb[1]) * sigmoid_f(bfhi(fu))};
        float vv[8];
#pragma unroll
        for (int j = 0; j < 4; ++j) { vv[2 * j] = bflo(vu[j]); vv[2 * j + 1] = bfhi(vu[j]); }
#pragma unroll
        for (int i = 0; i < 2; ++i)
#pragma unroll
            for (int j = 0; j < 8; ++j) S[i][j] = fg[i] * S[i][j] + (1.f - fg[i]) * vv[j];
        if (!isctx) {
            const unsigned qu = *(const unsigned*)(row + qoff); const float q0 = silu_f(bflo(qu)), q1 = silu_f(bfhi(qu));
            float o[8];
#pragma unroll
            for (int j = 0; j < 8; ++j) o[j] = q0 * S[0][j] + q1 * S[1][j];
            float r4[4];
            { const bool hi = (lane & 32) != 0;
#pragma unroll
              for (int j = 0; j < 4; ++j) { const float send = hi ? o[j] : o[4 + j], keep = hi ? o[4 + j] : o[j]; r4[j] = keep + __shfl_xor(send, 32); } }
            float r2[2];
            { const bool hi = (lane & 16) != 0;
#pragma unroll
              for (int j = 0; j < 2; ++j) { const float send = hi ? r4[j] : r4[2 + j], keep = hi ? r4[2 + j] : r4[j]; r2[j] = keep + __shfl_xor(send, 16); } }
            float r1;
            { const bool hi = (lane & 8) != 0; const float send = hi ? r2[0] : r2[1], keep = hi ? r2[1] : r2[0]; r1 = keep + __shfl_xor(send, 8); }
            r1 += __shfl_xor(r1, 4); r1 += __shfl_xor(r1, 2); r1 += __shfl_xor(r1, 1);
            if ((lane & 7) == 0) { const int j = ((lane >> 5) & 1) * 4 + ((lane >> 4) & 1) * 2 + ((lane >> 3) & 1); Oo[(size_t)tok * 1024 + h * 128 + vo * 8 + j] = (bf16_t)f2bf(r1); }
        }
    }
}
DEV void readout_item(const Params& p, int item) {
    const int tok = item * 8 + (tidx() >> 6), lane = tidx() & 63;
    const bf16_t* of = (const bf16_t*)(p.ws + WS_F + F_OF) + (size_t)tok * 1024 + lane * 16; const bf16_t* ob = (const bf16_t*)(p.ws + WS_F + F_OB) + (size_t)tok * 1024 + lane * 16;
    const bf16_t* gp = (const bf16_t*)(p.ws + WS_P) + (size_t)tok * 5120 + 4096 + lane * 16;
    const float* on = p.in[I_HGON] + (lane & 7) * 16;
    float o[16], gg[16]; float ss = 0.f;
    { const u32x4 a0 = *(const u32x4*)of, a1 = *(const u32x4*)(of + 8), b0 = *(const u32x4*)ob, b1 = *(const u32x4*)(ob + 8), g0 = *(const u32x4*)gp, g1 = *(const u32x4*)(gp + 8);
#pragma unroll
      for (int i = 0; i < 4; ++i) { o[2 * i] = bflo(a0[i]) + bflo(b0[i]); o[2 * i + 1] = bfhi(a0[i]) + bfhi(b0[i]); o[8 + 2 * i] = bflo(a1[i]) + bflo(b1[i]); o[8 + 2 * i + 1] = bfhi(a1[i]) + bfhi(b1[i]);
          gg[2 * i] = bflo(g0[i]); gg[2 * i + 1] = bfhi(g0[i]); gg[8 + 2 * i] = bflo(g1[i]); gg[8 + 2 * i + 1] = bfhi(g1[i]); } }
#pragma unroll
    for (int i = 0; i < 16; ++i) ss += o[i] * o[i];
    ss += __shfl_xor(ss, 1); ss += __shfl_xor(ss, 2); ss += __shfl_xor(ss, 4);
    const float rstd = rsqrtf(ss * (1.f / 128.f) + 1e-6f);
    bf16_t* M = (bf16_t*)(p.ws + WS_M) + (size_t)tok * 1024 + lane * 16;
    u32x4 o0, o1; float r[16];
#pragma unroll
    for (int i = 0; i < 16; ++i) r[i] = o[i] * rstd * on[i] * silu_f(gg[i]);
#pragma unroll
    for (int i = 0; i < 4; ++i) { o0[i] = pk2(r[2 * i], r[2 * i + 1]); o1[i] = pk2(r[8 + 2 * i], r[8 + 2 * i + 1]); }
    *(u32x4*)M = o0; *(u32x4*)(M + 8) = o1;
}

#ifdef NOINLINE_PHASES
#define NOINL __device__ __attribute__((noinline))
#else
#define NOINL __device__ __forceinline__
#endif
__shared__ __attribute__((aligned(16))) unsigned char g_smem[SMEM_BYTES];
#define PH_COMMON const int G = gridDim.x, bid = blockIdx.x; unsigned char* smem = g_smem; (void)smem; (void)G; (void)bid; \
    const bf16_t* A = (const bf16_t*)(p.ws + WS_A); const bf16_t* Mx = (const bf16_t*)(p.ws + WS_M); const bf16_t* W = (const bf16_t*)(p.ws + WS_W); (void)A; (void)Mx; (void)W;
NOINL void ph0(const Params& p) { PH_COMMON phase0(p, smem); }
NOINL void ph1(const Params& p) { PH_COMMON phase1(p, smem); }
NOINL void ph2(const Params& p) { PH_COMMON EpiL0In e{p.ws}; for (int t = bid; t < (T / 256) * 18; t += G) gemm_tile(A, W + W_IN0 / 2, (t / 18) * 256, (t % 18) * 128, smem, e); }
NOINL void ph3(const Params& p) { PH_COMMON phase3(p, smem); }
NOINL void ph4(const Params& p) { PH_COMMON EpiRes e{&p, 1, 0, 2048}; for (int t = bid; t < (T / 256) * 8; t += G) gemm_tile(Mx, W + W_OUT0 / 2, (t / 8) * 256, (t % 8) * 128, smem, e); }
NOINL void ph5(const Params& p) { PH_COMMON for (int it = bid; it < T / 8; it += G) norm_rows_item(p, it, 0, p.in[I_N2G], 0, 3072); }
NOINL void ph6(const Params& p) { PH_COMMON EpiBf16 e{(bf16_t*)(p.ws + WS_P), 2048}; for (int t = bid; t < (T / 256) * 16; t += G) gemm_tile(A, W + W_Q0 / 2, (t / 16) * 256, (t % 16) * 128, smem, e); }
NOINL void ph7(const Params& p) { PH_COMMON for (int it = bid; it < (T / 64) * 8; it += G) topk_item(p, 0, it, smem); }
NOINL void ph8(const Params& p) { PH_COMMON for (int it = bid; it < T / 8; it += G) peer_item(p, 0, it); }
NOINL void ph9(const Params& p) { PH_COMMON EpiBf16 e{(bf16_t*)(p.ws + WS_P), 5120};
    for (int t = bid; t < (T / 256) * 40; t += G) { const int mt = t / 40, nt = t % 40; if (mt >= TL / 256 && (nt < 8 || nt >= 32)) continue; gemm_tile(A, W + W_IN1 / 2, mt * 256, nt * 128, smem, e); } }
NOINL void ph10(const Params& p) { PH_COMMON for (int wi = bid * 8 + (tidx() >> 6); wi < NB * 256; wi += G * 8) scan_wave(p, wi); }
NOINL void ph11(const Params& p) { PH_COMMON for (int it = bid; it < TL / 8 + 2 * P0_TAB; it += G) { if (it < TL / 8) readout_item(p, it); else tables_layer1(p, it - TL / 8); } }
NOINL void ph12(const Params& p) { PH_COMMON EpiRes e{&p, 0, 1, 2048}; for (int t = bid; t < (TL / 256) * 8; t += G) gemm_tile(Mx, W + W_OUT1 / 2, (t / 8) * 256, (t % 8) * 128, smem, e); }
NOINL void ph13(const Params& p) { PH_COMMON for (int it = bid; it < TL / 8; it += G) norm_rows_item(p, it, 0, p.in[I_N2G] + 1024, 1, 3072); }
NOINL void ph14(const Params& p) { PH_COMMON EpiBf16 e{(bf16_t*)(p.ws + WS_P), 2048}; for (int t = bid; t < (TL / 256) * 16; t += G) gemm_tile(A, W + W_Q1 / 2, (t / 16) * 256, (t % 16) * 128, smem, e); }
NOINL void ph15(const Params& p) { PH_COMMON for (int it = bid; it < (TL / 64) * 8; it += G) topk_item(p, 1, it, smem); }
NOINL void ph16(const Params& p) { PH_COMMON for (int it = bid; it < TL / 8; it += G) peer_item(p, 1, it); }

constexpr int NPHASE = 17;
__global__ void __launch_bounds__(NT, 2) mega(Params p_in) {
    const int ph_lo = p_in.ph_lo, ph_hi = p_in.ph_hi;
    for (int ph = ph_lo; ph < ph_hi; ++ph) {
        if (ph > ph_lo) {
#ifndef HOST_EMU
            cg::this_grid().sync();
#endif
        }
#ifndef HOST_EMU
        unsigned long long kp = (unsigned long long)__builtin_amdgcn_kernarg_segment_ptr();
        asm volatile("" : "+s"(kp) :: "memory");
        const Params& p = *(const Params*)(const __attribute__((address_space(4))) Params*)kp;
#else
        const Params& p = p_in;
#endif
#ifdef ONLY_PHASE
        if (ph != ONLY_PHASE) continue;
#endif
        switch (ph) {
        case 0: ph0(p); break; case 1: ph1(p); break; case 2: ph2(p); break; case 3: ph3(p); break; case 4: ph4(p); break; case 5: ph5(p); break;
        case 6: ph6(p); break; case 7: ph7(p); break; case 8: ph8(p); break; case 9: ph9(p); break; case 10: ph10(p); break; case 11: ph11(p); break;
        case 12: ph12(p); break; case 13: ph13(p); break; case 14: ph14(p); break; case 15: ph15(p); break; case 16: ph16(p); break;
        default: break;
        }
    }
}

#ifndef HOST_EMU
extern "C" void kernel_launch(void* const* d_in, const int* in_sizes, int n_in, void* d_out, int out_size, void* d_ws, size_t ws_size, hipStream_t stream) {
    if (n_in != 29 || ws_size < WS_END || out_size != TL * 1024) { fprintf(stderr, "kernel_launch: unexpected sizes (n_in %d, ws %zu need %zu, out %d)\n", n_in, ws_size, (size_t)WS_END, out_size); return; }
    static int grid = 0;
    if (!grid) { int dev = 0, cus = 0; hipGetDevice(&dev); hipDeviceGetAttribute(&cus, hipDeviceAttributeMultiprocessorCount, dev); grid = cus > 0 ? cus : 256; }
    hipMemsetAsync((unsigned char*)d_ws + WS_CTRL, 0, CTRL_BYTES, stream);
    Params p{};
    for (int i = 0; i < 29; ++i) p.in[i] = (const float*)d_in[i];
    p.out = (float*)d_out; p.ws = (unsigned char*)d_ws;
#ifdef MULTI_LAUNCH
    for (int ph = 0; ph < NPHASE; ++ph) { p.ph_lo = ph; p.ph_hi = ph + 1; hipLaunchKernelGGL(mega, dim3(grid), dim3(NT), 0, stream, p); }
#else
    p.ph_lo = 0; p.ph_hi = NPHASE;
    void* args[] = {&p};
    hipError_t e = hipLaunchCooperativeKernel((void*)mega, dim3(grid), dim3(NT), args, 0, stream);
    if (e != hipSuccess) fprintf(stderr, "cooperative launch failed: %s (grid %d)\n", hipGetErrorString(e), grid);
#endif
}
#endif
```

```cpp
#ifndef HOST_EMU
#include <hip/hip_runtime.h>
#include <hip/hip_cooperative_groups.h>
#include <cstdio>
namespace cg = cooperative_groups;
#endif

#ifndef CFG_B
#define CFG_B 8
#define CFG_L 2048
#define CFG_LC 256
#endif
#define DEV __device__ __forceinline__
#ifdef HOST_EMU
#define __expf expf
#define __sinf sinf
#define __cosf cosf
#endif

typedef unsigned short bf16_t;
typedef short bf16x8 __attribute__((ext_vector_type(8)));
typedef float f32x16 __attribute__((ext_vector_type(16)));
typedef float f32x4 __attribute__((ext_vector_type(4)));
typedef unsigned u32x4 __attribute__((ext_vector_type(4)));
typedef unsigned u32x2 __attribute__((ext_vector_type(2)));
struct cf2 { float x, y; };

constexpr int NB = CFG_B, L = CFG_L, LC = CFG_LC, D = 1024;
constexpr int TL = NB * L, TC = NB * LC, T = TL + TC;
constexpr int NT = 512;
constexpr int NR = NB + 1;
constexpr int log4ceil(int n) { int s = 0, v = 1; while (v < n) { v *= 4; ++s; } return s; }
constexpr int FS_LAT = log4ceil(2 * L - 1), FS_CTX = log4ceil(2 * LC - 1);
constexpr int NF_LAT = 1 << (2 * FS_LAT), NF_CTX = 1 << (2 * FS_CTX);
static_assert(T % 256 == 0 && TL % 256 == 0 && L % 128 == 0 && LC % 128 == 0 && NB % 2 == 0, "shape");

constexpr size_t al256(size_t x) { return (x + 255) & ~(size_t)255; }
constexpr size_t WS_CTRL = 0, CTRL_BYTES = 65536;
constexpr size_t CTRL_HYNORM = 4096;
constexpr size_t WS_MOD = WS_CTRL + CTRL_BYTES;
constexpr size_t WS_H = al256(WS_MOD + (size_t)2 * NR * 6144 * 4);
constexpr size_t WS_A = al256(WS_H + (size_t)T * 1024 * 4);
constexpr size_t WS_P = al256(WS_A + (size_t)T * 1024 * 2);
constexpr size_t P_BYTES = (size_t)T * 5120 * 2;
constexpr size_t P_HYT_LAT = 0;
constexpr size_t P_HYT_CTX = P_HYT_LAT + (size_t)NB * 1536 * L * 2;
constexpr size_t P_Q0 = P_HYT_CTX + (size_t)NB * 1536 * LC * 2;
constexpr size_t P_K0 = P_Q0 + (size_t)T * 512 * 2;
constexpr size_t P_VT_LAT = P_K0 + (size_t)T * 128 * 2;
constexpr size_t P_VT_CTX = P_VT_LAT + (size_t)NB * 128 * L * 2;
static_assert(P_VT_CTX + (size_t)NB * 128 * LC * 2 <= P_BYTES, "P region");
constexpr size_t WS_M = al256(WS_P + P_BYTES);
constexpr size_t WS_IDX = al256(WS_M + (size_t)T * 1024 * 2);
constexpr size_t WS_GATE = al256(WS_IDX + (size_t)T * 128 * 4);
constexpr size_t WS_UB = al256(WS_GATE + (size_t)T * 128 * 4);
constexpr size_t WS_VB = WS_UB + (size_t)16384 * 1024 * 2;
constexpr size_t WS_W = WS_VB + (size_t)16384 * 1024 * 2;
constexpr size_t W_IN0 = 0, W_OUT0 = W_IN0 + (size_t)2304 * 1024 * 2, W_IN1 = W_OUT0 + (size_t)1024 * 1024 * 2,
                 W_OUT1 = W_IN1 + (size_t)5120 * 1024 * 2, W_Q0 = W_OUT1 + (size_t)1024 * 1024 * 2, W_Q1 = W_Q0 + (size_t)2048 * 1024 * 2,
                 W_KEYS = W_Q1 + (size_t)2048 * 1024 * 2, W_BYTES = W_KEYS + (size_t)2 * 8 * 2 * 128 * 128 * 2;
constexpr size_t WS_F = al256(WS_W + W_BYTES);
constexpr size_t F_HRAW_LAT = 0;
constexpr size_t F_HRAW_CTX = F_HRAW_LAT + (size_t)2048 * L * 4;
constexpr size_t F_HF_LAT = F_HRAW_CTX + (size_t)2048 * LC * 4;
constexpr size_t F_HF_CTX = F_HF_LAT + (size_t)1024 * NF_LAT * 8;
constexpr size_t F_HYP_LAT = F_HF_CTX + (size_t)1024 * NF_CTX * 8;
constexpr size_t F_HYP_CTX = F_HYP_LAT + (size_t)(L / 64) * 2048 * 4;
constexpr size_t F_END = F_HYP_CTX + (size_t)(LC / 64) * 2048 * 4;
constexpr size_t F_OF = 0, F_OB = (size_t)TL * 1024 * 2;
constexpr size_t F_BYTES = F_END > 2 * F_OB ? F_END : 2 * F_OB;
constexpr size_t WS_END = al256(WS_F + F_BYTES);

struct Params { const float* in[29]; float* out; unsigned char* ws; int ph_lo, ph_hi; };
enum { I_X = 0, I_C, I_CTX, I_CCTX, I_ADAW, I_ADAB, I_N1G, I_N2G, I_FG, I_ABWIN, I_ABWOUT, I_HYCW, I_HYCB, I_HYW1, I_HYB1, I_HYW2, I_HYB2, I_HYW3,
       I_HYFREQ, I_HYSKIP, I_SINK, I_HGWIN, I_HGWOUT, I_HGLB, I_HGON, I_PWQ, I_PKEYS, I_PU, I_PV };

constexpr int SMEM_BYTES = 131072;

#ifndef HOST_EMU
DEV int tidx() { int t = threadIdx.x; asm volatile("" : "+v"(t)); return t; }
#else
DEV int tidx() { return (int)threadIdx.x; }
#endif
DEV unsigned f2bf(float f) { unsigned u = __builtin_bit_cast(unsigned, f); return (u + 0x7fffu + ((u >> 16) & 1u)) >> 16; }
DEV float bf2f(unsigned h) { return __builtin_bit_cast(float, (h & 0xffffu) << 16); }
DEV unsigned pk2(float lo, float hi) { return f2bf(lo) | (f2bf(hi) << 16); }
DEV float bflo(unsigned u) { return __builtin_bit_cast(float, u << 16); }
DEV float bfhi(unsigned u) { return __builtin_bit_cast(float, u & 0xffff0000u); }
DEV float silu_f(float x) { return x / (1.f + __expf(-x)); }
DEV float sigmoid_f(float x) { return 1.f / (1.f + __expf(-x)); }
DEV float wave_sum(float v) {
#pragma unroll
    for (int m = 32; m >= 1; m >>= 1) v += __shfl_xor(v, m);
    return v;
}
DEV int mod_row(int tok) { return tok < TL ? tok / L : NB; }

DEV void p0_mod(const Params& p, int item, unsigned char* smem) {
    const int l = item / 96, col0 = (item % 96) * 64, tid = tidx();
    float* sc = (float*)smem;
    float* red = sc + NR * 1024;
    for (int i = tid; i < NR * 1024; i += NT) { const int r = i >> 10, k = i & 1023; const float c = r < NB ? p.in[I_C][r * 1024 + k] : p.in[I_CCTX][k]; sc[i] = c / (1.f + expf(-c)); }
    __syncthreads();
    const int kq = tid >> 6, col = tid & 63;
    float acc[NR];
#pragma unroll
    for (int r = 0; r < NR; ++r) acc[r] = 0.f;
    const float* w = p.in[I_ADAW] + (size_t)l * 1024 * 6144 + col0 + col;
#pragma unroll 4
    for (int k = kq * 128; k < kq * 128 + 128; ++k) {
        const float wv = w[(size_t)k * 6144];
#pragma unroll
        for (int r = 0; r < NR; ++r) acc[r] += sc[r * 1024 + k] * wv;
    }
#pragma unroll
    for (int r = 0; r < NR; ++r) red[(kq * NR + r) * 64 + col] = acc[r];
    __syncthreads();
    float* mod = (float*)(p.ws + WS_MOD);
    for (int i = tid; i < NR * 64; i += NT) {
        const int r = i >> 6, c = i & 63; float s = 0.f;
        for (int q = 0; q < 8; ++q) s += red[(q * NR + r) * 64 + c];
        mod[((size_t)l * NR + r) * 6144 + col0 + c] = s + p.in[I_ADAB][l * 6144 + col0 + c];
    }
    __syncthreads();
}
DEV void p0_transpose(const float* W, bf16_t* Wt, int N, int tile, unsigned char* smem) {
    float* ts = (float*)smem;
    const int ntn = N / 64, kt = tile / ntn, nt = tile % ntn, k0 = kt * 64, n0 = nt * 64, tid = tidx();
    for (int i = tid; i < 4096; i += NT) { const int kk = i >> 6, nn = i & 63; ts[kk * 65 + nn] = W[(size_t)(k0 + kk) * N + n0 + nn]; }
    __syncthreads();
    for (int i = tid; i < 4096; i += NT) { const int nn = i >> 6, kk = i & 63; Wt[(size_t)(n0 + nn) * 1024 + k0 + kk] = (bf16_t)f2bf(ts[kk * 65 + nn]); }
    __syncthreads();
}
DEV void p0_convert(const float* src, bf16_t* dst, int item) {
    const int tid = tidx();
#pragma unroll
    for (int i = 0; i < 8; ++i) {
        const size_t e = (size_t)item * 16384 + (size_t)(i * NT + tid) * 4;
        const f32x4 v = *(const f32x4*)(src + e);
        u32x2 o; o[0] = pk2(v[0], v[1]); o[1] = pk2(v[2], v[3]);
        *(u32x2*)(dst + e) = o;
    }
}
DEV void p0_filter(const Params& p, int set, int chunk, unsigned char* smem) {
    const int Ls = set ? LC : L, l0 = chunk * 64, tid = tidx();
    float* z = (float*)smem;
    float* hd1 = z + 64 * 34;
    float* hd2 = hd1 + 64 * 65;
    const float* w1 = p.in[I_HYW1]; const float* b1 = p.in[I_HYB1]; const float* w2 = p.in[I_HYW2]; const float* b2 = p.in[I_HYB2];
    const float* w3 = p.in[I_HYW3]; const float* fq = p.in[I_HYFREQ];
    for (int i = tid; i < 64 * 33; i += NT) {
        const int pp = i / 33, f = i % 33, l = l0 + pp; float val;
        if (f == 0) val = (float)l / (float)(Ls - 1);
        else { const int jb = (f - 1) & 15; const float fj = 1e-4f + (float)jb * ((15.f - 1e-4f) / 15.f); const float a = fj * (6.283185307179586f * (float)l / (float)Ls); val = f <= 16 ? __cosf(a) : -__sinf(a); }
        z[pp * 34 + f] = val;
    }
    __syncthreads();
    for (int i = tid; i < 4096; i += NT) {
        const int pp = i >> 6, j = i & 63; float s = b1[j];
#pragma unroll 4
        for (int f = 0; f < 33; ++f) s += z[pp * 34 + f] * w1[f * 64 + j];
        hd1[pp * 65 + j] = __sinf(fq[j] * s);
    }
    __syncthreads();
    for (int i = tid; i < 4096; i += NT) {
        const int pp = i >> 6, j = i & 63; float s = b2[j];
#pragma unroll 4
        for (int f = 0; f < 64; ++f) s += hd1[pp * 65 + f] * w2[f * 64 + j];
        hd2[pp * 65 + j] = __sinf(fq[j] * s);
    }
    __syncthreads();
    const int lane = tid & 63, w = __builtin_amdgcn_readfirstlane(tid >> 6);
    const float tl = (float)(l0 + lane) / (float)(Ls - 1);
    const float max_decay = -15.350567286626973f, min_decay = -3.0701134573253945f;
    float* hraw = (float*)(p.ws + WS_F + (set ? F_HRAW_CTX : F_HRAW_LAT));
    float* hyn = (float*)(p.ws + WS_F + (set ? F_HYP_CTX : F_HYP_LAT)) + (size_t)chunk * 2048;
    for (int oc = 0; oc < 256; ++oc) {
        const int o = w * 256 + oc; float s = 0.f;
#pragma unroll 8
        for (int j = 0; j < 64; ++j) s += hd2[lane * 65 + j] * w3[j * 2048 + o];
        const int c = o & 511; const float delta = fabsf(min_decay + (float)c * ((max_decay - min_decay) / 511.f));
        const float val = s * expf(-tl * delta);
        hraw[(size_t)o * Ls + l0 + lane] = val;
        const float a = wave_sum(fabsf(val));
        if (lane == 0) hyn[o] = a;
    }
    __syncthreads();
}

constexpr int P0_MOD = 192, P0_TR_IN0 = 16 * 36, P0_TR_OUT0 = 256, P0_TR_IN1 = 16 * 80, P0_TR_OUT1 = 256, P0_TR_Q = 16 * 32, P0_KEYS = 32, P0_TAB = 1024,
              P0_FILT = L / 64 + LC / 64;
DEV void phase0(const Params& p, unsigned char* smem) {
    bf16_t* W = (bf16_t*)(p.ws + WS_W);
    const int total = P0_MOD + P0_FILT + P0_TR_IN0 + P0_TR_OUT0 + P0_TR_IN1 + P0_TR_OUT1 + 2 * P0_TR_Q + P0_KEYS + 2 * P0_TAB;
    for (int it = blockIdx.x; it < total; it += gridDim.x) {
        int i = it;
        if (i < P0_MOD) { p0_mod(p, i, smem); continue; } i -= P0_MOD;
        if (i < P0_FILT) { if (i < L / 64) p0_filter(p, 0, i, smem); else p0_filter(p, 1, i - L / 64, smem); continue; } i -= P0_FILT;
        if (i < P0_TR_IN0) { p0_transpose(p.in[I_ABWIN], W + W_IN0 / 2, 2304, i, smem); continue; } i -= P0_TR_IN0;
        if (i < P0_TR_OUT0) { p0_transpose(p.in[I_ABWOUT], W + W_OUT0 / 2, 1024, i, smem); continue; } i -= P0_TR_OUT0;
        if (i < P0_TR_IN1) { p0_transpose(p.in[I_HGWIN], W + W_IN1 / 2, 5120, i, smem); continue; } i -= P0_TR_IN1;
        if (i < P0_TR_OUT1) { p0_transpose(p.in[I_HGWOUT], W + W_OUT1 / 2, 1024, i, smem); continue; } i -= P0_TR_OUT1;
        if (i < P0_TR_Q) { p0_transpose(p.in[I_PWQ], W + W_Q0 / 2, 2048, i, smem); continue; } i -= P0_TR_Q;
        if (i < P0_TR_Q) { p0_transpose(p.in[I_PWQ] + (size_t)1024 * 2048, W + W_Q1 / 2, 2048, i, smem); continue; } i -= P0_TR_Q;
        if (i < P0_KEYS) { p0_convert(p.in[I_PKEYS], W + W_KEYS / 2, i); continue; } i -= P0_KEYS;
        if (i < P0_TAB) { p0_convert(p.in[I_PU], (bf16_t*)(p.ws + WS_UB), i); continue; } i -= P0_TAB;
        p0_convert(p.in[I_PV], (bf16_t*)(p.ws + WS_VB), i);
    }
}
DEV void tables_layer1(const Params& p, int i) {
    if (i < P0_TAB) p0_convert(p.in[I_PU] + (size_t)16384 * 1024, (bf16_t*)(p.ws + WS_UB), i);
    else p0_convert(p.in[I_PV] + (size_t)16384 * 1024, (bf16_t*)(p.ws + WS_VB), i - P0_TAB);
}

DEV const float* h_row(const Params& p, int layer_src_inputs, int tok) {
    if (layer_src_inputs) return tok < TL ? p.in[I_X] + (size_t)tok * 1024 : p.in[I_CTX] + (size_t)(tok - TL) * 1024;
    return (const float*)(p.ws + WS_H) + (size_t)tok * 1024;
}
DEV void norm_row_store(const Params& p, const f32x4 (&v)[4], int tok, const float* g, int layer, int sh_off, int lane) {
    float ss = 0.f;
#pragma unroll
    for (int i = 0; i < 4; ++i) ss += v[i][0] * v[i][0] + v[i][1] * v[i][1] + v[i][2] * v[i][2] + v[i][3] * v[i][3];
    ss = wave_sum(ss);
    const float rstd = rsqrtf(ss * (1.f / 1024.f) + 1e-6f);
    const float* mod = (const float*)(p.ws + WS_MOD) + ((size_t)layer * NR + mod_row(tok)) * 6144 + sh_off;
    bf16_t* A = (bf16_t*)(p.ws + WS_A) + (size_t)tok * 1024;
#pragma unroll
    for (int i = 0; i < 4; ++i) {
        const int c = i * 256 + lane * 4;
        const f32x4 gg = *(const f32x4*)(g + c), sh = *(const f32x4*)(mod + c), sc = *(const f32x4*)(mod + 1024 + c);
        u32x2 o;
        o[0] = pk2(v[i][0] * rstd * gg[0] * (1.f + sc[0]) + sh[0], v[i][1] * rstd * gg[1] * (1.f + sc[1]) + sh[1]);
        o[1] = pk2(v[i][2] * rstd * gg[2] * (1.f + sc[2]) + sh[2], v[i][3] * rstd * gg[3] * (1.f + sc[3]) + sh[3]);
        *(u32x2*)(A + c) = o;
    }
}
DEV void norm_rows_item(const Params& p, int item, int from_inputs, const float* g, int layer, int sh_off) {
    const int tok = item * 8 + (tidx() >> 6), lane = tidx() & 63;
    const float* src = h_row(p, from_inputs, tok);
    f32x4 v[4];
#pragma unroll
    for (int i = 0; i < 4; ++i) v[i] = *(const f32x4*)(src + i * 256 + lane * 4);
    norm_row_store(p, v, tok, g, layer, sh_off, lane);
}

DEV cf2 cmul(cf2 a, cf2 b) { cf2 r; r.x = a.x * b.x - a.y * b.y; r.y = a.x * b.y + a.y * b.x; return r; }
DEV cf2 twid(int k, float invN) { cf2 r; const float a = (float)k * invN; r.x = __builtin_amdgcn_cosf(a); r.y = -__builtin_amdgcn_sinf(a); return r; }
DEV void fft_fwd(cf2* buf, int S, int g, int G) {
    const int N = 1 << (2 * S); const float invN = 1.f / (float)N;
    for (int s = 0; s < S; ++s) {
        const int lm = 2 * (S - s), m = 1 << lm, q = m >> 2;
        for (int bf = g; bf < (N >> 2); bf += G) {
            const int j = bf & (q - 1), base = ((bf >> (lm - 2)) << lm) + j;
            const cf2 a0 = buf[base], a1 = buf[base + q], a2 = buf[base + 2 * q], a3 = buf[base + 3 * q];
            cf2 t0, t1, t2, t3; t0.x = a0.x + a2.x; t0.y = a0.y + a2.y; t1.x = a0.x - a2.x; t1.y = a0.y - a2.y; t2.x = a1.x + a3.x; t2.y = a1.y + a3.y;
            const float dx = a1.x - a3.x, dy = a1.y - a3.y; t3.x = dy; t3.y = -dx;
            cf2 y0, y1, y2, y3; y0.x = t0.x + t2.x; y0.y = t0.y + t2.y; y1.x = t1.x + t3.x; y1.y = t1.y + t3.y; y2.x = t0.x - t2.x; y2.y = t0.y - t2.y; y3.x = t1.x - t3.x; y3.y = t1.y - t3.y;
            const int tw = j << (2 * s);
            buf[base] = y0; buf[base + q] = cmul(y1, twid(tw, invN)); buf[base + 2 * q] = cmul(y2, twid(2 * tw, invN)); buf[base + 3 * q] = cmul(y3, twid(3 * tw, invN));
        }
        __syncthreads();
    }
}
DEV void fft_inv(cf2* buf, int S, int g, int G) {
    const int N = 1 << (2 * S); const float invN = 1.f / (float)N;
    for (int s = S - 1; s >= 0; --s) {
        const int lm = 2 * (S - s), m = 1 << lm, q = m >> 2;
        for (int bf = g; bf < (N >> 2); bf += G) {
            const int j = bf & (q - 1), base = ((bf >> (lm - 2)) << lm) + j;
            const int tw = j << (2 * s);
            cf2 w1 = twid(tw, invN), w2 = twid(2 * tw, invN), w3 = twid(3 * tw, invN); w1.y = -w1.y; w2.y = -w2.y; w3.y = -w3.y;
            const cf2 c0 = buf[base], c1 = cmul(buf[base + q], w1), c2 = cmul(buf[base + 2 * q], w2), c3 = cmul(buf[base + 3 * q], w3);
            cf2 t0, t1, t2, t3; t0.x = c0.x + c2.x; t0.y = c0.y + c2.y; t1.x = c0.x - c2.x; t1.y = c0.y - c2.y; t2.x = c1.x + c3.x; t2.y = c1.y + c3.y;
            const float dx = c1.x - c3.x, dy = c1.y - c3.y; t3.x = -dy; t3.y = dx;
            cf2 a0, a1, a2, a3; a0.x = t0.x + t2.x; a0.y = t0.y + t2.y; a1.x = t1.x + t3.x; a1.y = t1.y + t3.y; a2.x = t0.x - t2.x; a2.y = t0.y - t2.y; a3.x = t1.x - t3.x; a3.y = t1.y - t3.y;
            buf[base] = a0; buf[base + q] = a1; buf[base + 2 * q] = a2; buf[base + 3 * q] = a3;
        }
        __syncthreads();
    }
}
DEV void hf_item(const Params& p, int set, int pi, unsigned char* smem) {
    const int Ls = set ? LC : L, S = set ? FS_CTX : FS_LAT, N = 1 << (2 * S);
    const int gi = tidx() >> 8, g = tidx() & 255, idx = pi * 2 + gi, o = idx >> 9, c = idx & 511;
    cf2* buf = (cf2*)smem + (size_t)gi * N;
    const float* hraw = (const float*)(p.ws + WS_F + (set ? F_HRAW_CTX : F_HRAW_LAT));
    const float* hyn = (const float*)(p.ws + WS_F + (set ? F_HYP_CTX : F_HYP_LAT));
    float nsum = 0.f;
    for (int ch = 0; ch < Ls / 64; ++ch) nsum += hyn[(size_t)ch * 2048 + o * 1024 + c] + hyn[(size_t)ch * 2048 + o * 1024 + 512 + c];
    const float inv = 1.f / nsum;
    const float* hf = hraw + (size_t)(o * 1024 + c) * Ls; const float* hb = hraw + (size_t)(o * 1024 + 512 + c) * Ls;
    for (int k = g; k < N; k += 256) { float re = 0.f; if (k < Ls) re = hf[k] * inv; else if (k > N - Ls) re = hb[N - k] * inv; cf2 v; v.x = re; v.y = 0.f; buf[k] = v; }
    __syncthreads();
    fft_fwd(buf, S, g, 256);
    cf2* HF = (cf2*)(p.ws + WS_F + (set ? F_HF_CTX : F_HF_LAT)) + (size_t)(o * 512 + c) * N;
    for (int k = g; k < N; k += 256) HF[k] = buf[k];
    __syncthreads();
}
constexpr int P1_NORM = T / 8, P1_HF = 512;
DEV void phase1(const Params& p, unsigned char* smem) {
    const int total = P1_NORM + 2 * P1_HF;
    for (int it = blockIdx.x; it < total; it += gridDim.x) {
        if (it < P1_NORM) norm_rows_item(p, it, 1, p.in[I_N1G], 0, 0);
        else if (it < P1_NORM + P1_HF) hf_item(p, 0, it - P1_NORM, smem);
        else hf_item(p, 1, it - P1_NORM - P1_HF, smem);
    }
}

constexpr int G_LDA = 72;
template <class Epi>
DEV void gemm_tile(const bf16_t* __restrict__ A, const bf16_t* __restrict__ Wt, int m0, int n0, unsigned char* smem, const Epi& epi) {
    bf16_t* As = (bf16_t*)smem;
    bf16_t* Bs = As + 2 * 256 * G_LDA;
    const int tid = tidx(), lane = tid & 63, w = tid >> 6, wm = w >> 1, wn = w & 1;
    f32x16 acc[2][2];
#pragma unroll
    for (int i = 0; i < 2; ++i)
#pragma unroll
        for (int j = 0; j < 2; ++j)
#pragma unroll
            for (int r = 0; r < 16; ++r) acc[i][j][r] = 0.f;
    u32x4 ra[4], rb[2];
    const bf16_t* Ag = A + (size_t)m0 * 1024; const bf16_t* Bg = Wt + (size_t)n0 * 1024;
#define GLOAD(k0) do { \
        _Pragma("unroll") for (int i = 0; i < 4; ++i) { const int id = tid + NT * i, row = id >> 3, kc = id & 7; ra[i] = *(const u32x4*)(Ag + (size_t)row * 1024 + (k0) + kc * 8); } \
        _Pragma("unroll") for (int i = 0; i < 2; ++i) { const int id = tid + NT * i, row = id >> 3, kc = id & 7; rb[i] = *(const u32x4*)(Bg + (size_t)row * 1024 + (k0) + kc * 8); } } while (0)
#define LSTORE(buf_) do { \
        _Pragma("unroll") for (int i = 0; i < 4; ++i) { const int id = tid + NT * i, row = id >> 3, kc = id & 7; *(u32x4*)(As + ((buf_) * 256 + row) * G_LDA + kc * 8) = ra[i]; } \
        _Pragma("unroll") for (int i = 0; i < 2; ++i) { const int id = tid + NT * i, row = id >> 3, kc = id & 7; *(u32x4*)(Bs + ((buf_) * 128 + row) * G_LDA + kc * 8) = rb[i]; } } while (0)
    GLOAD(0); LSTORE(0); __syncthreads();
    for (int kt = 0; kt < 16; ++kt) {
        const int buf = kt & 1;
        if (kt + 1 < 16) GLOAD((kt + 1) * 64);
        const bf16_t* as = As + (buf * 256 + wm * 64 + (lane & 31)) * G_LDA + 8 * (lane >> 5);
        const bf16_t* bs = Bs + (buf * 128 + wn * 64 + (lane & 31)) * G_LDA + 8 * (lane >> 5);
#pragma unroll
        for (int kk = 0; kk < 4; ++kk) {
            const bf16x8 a0 = *(const bf16x8*)(as + kk * 16), a1 = *(const bf16x8*)(as + 32 * G_LDA + kk * 16);
            const bf16x8 b0 = *(const bf16x8*)(bs + kk * 16), b1 = *(const bf16x8*)(bs + 32 * G_LDA + kk * 16);
            acc[0][0] = __builtin_amdgcn_mfma_f32_32x32x16_bf16(a0, b0, acc[0][0], 0, 0, 0);
            acc[0][1] = __builtin_amdgcn_mfma_f32_32x32x16_bf16(a0, b1, acc[0][1], 0, 0, 0);
            acc[1][0] = __builtin_amdgcn_mfma_f32_32x32x16_bf16(a1, b0, acc[1][0], 0, 0, 0);
            acc[1][1] = __builtin_amdgcn_mfma_f32_32x32x16_bf16(a1, b1, acc[1][1], 0, 0, 0);
        }
        if (kt + 1 < 16) LSTORE(buf ^ 1);
        __syncthreads();
    }
#pragma unroll
    for (int mi = 0; mi < 2; ++mi)
#pragma unroll
        for (int ni = 0; ni < 2; ++ni)
#pragma unroll
            for (int rg = 0; rg < 4; ++rg) {
                const int row = m0 + wm * 64 + mi * 32 + 8 * rg + 4 * (lane >> 5), col = n0 + wn * 64 + ni * 32 + (lane & 31);
                epi(row, col, acc[mi][ni][rg * 4 + 0], acc[mi][ni][rg * 4 + 1], acc[mi][ni][rg * 4 + 2], acc[mi][ni][rg * 4 + 3]);
            }
}
struct EpiL0In {
    unsigned char* ws;
    DEV void operator()(int row, int col, float v0, float v1, float v2, float v3) const {
        u32x2 o; o[0] = pk2(v0, v1); o[1] = pk2(v2, v3);
        const bool lat = row < TL; const int b = lat ? row / L : (row - TL) / LC, t = lat ? row - b * L : (row - TL) - b * LC, Lx = lat ? L : LC;
        if (col < 1536) { bf16_t* d = (bf16_t*)(ws + WS_P + (lat ? P_HYT_LAT : P_HYT_CTX)) + ((size_t)b * 1536 + col) * Lx + t; *(u32x2*)d = o; }
        else if (col < 2048) { bf16_t* d = (bf16_t*)(ws + WS_P + P_Q0) + (size_t)row * 512 + (col - 1536); d[0] = (bf16_t)f2bf(v0); d[512] = (bf16_t)f2bf(v1); d[1024] = (bf16_t)f2bf(v2); d[1536] = (bf16_t)f2bf(v3); }
        else if (col < 2176) { bf16_t* d = (bf16_t*)(ws + WS_P + P_K0) + (size_t)row * 128 + (col - 2048); d[0] = (bf16_t)f2bf(v0); d[128] = (bf16_t)f2bf(v1); d[256] = (bf16_t)f2bf(v2); d[384] = (bf16_t)f2bf(v3); }
        else { bf16_t* d = (bf16_t*)(ws + WS_P + (lat ? P_VT_LAT : P_VT_CTX)) + ((size_t)b * 128 + (col - 2176)) * Lx + t; *(u32x2*)d = o; }
    }
};
struct EpiBf16 {
    bf16_t* out; int ld;
    DEV void operator()(int row, int col, float v0, float v1, float v2, float v3) const {
        bf16_t* d = out + (size_t)row * ld + col; d[0] = (bf16_t)f2bf(v0); d[ld] = (bf16_t)f2bf(v1); d[2 * ld] = (bf16_t)f2bf(v2); d[3 * ld] = (bf16_t)f2bf(v3);
    }
};
struct EpiRes {
    const Params* p; int from_inputs, layer, goff;
    DEV void operator()(int row, int col, float v0, float v1, float v2, float v3) const {
        const float vv[4] = {v0, v1, v2, v3};
        float* H = (float*)(p->ws + WS_H);
        const float* mod = (const float*)(p->ws + WS_MOD) + (size_t)layer * NR * 6144 + goff + col;
#pragma unroll
        for (int i = 0; i < 4; ++i) { const int r = row + i; H[(size_t)r * 1024 + col] = h_row(*p, from_inputs, r)[col] + mod[(size_t)mod_row(r) * 6144] * vv[i]; }
    }
};

DEV float hy_u(const bf16_t* row, int t, int Lx, float w0, float w1, float w2, float b) {
    const float xm = t > 0 ? bf2f(row[t - 1]) : 0.f, x0 = bf2f(row[t]), xp = t + 1 < Lx ? bf2f(row[t + 1]) : 0.f;
    return w0 * xm + w1 * x0 + w2 * xp + b;
}
DEV void hyena_item(const Params& p, int set, int item, unsigned char* smem) {
    const int Ls = set ? LC : L, S = set ? FS_CTX : FS_LAT, N = 1 << (2 * S);
    const int gi = tidx() >> 8, g = tidx() & 255;
    const int bp = item >> 8, c = (item & 255) * 2 + gi, ba = bp * 2, bb = ba + 1;
    cf2* buf = (cf2*)smem + (size_t)gi * N;
    cf2* zk = (cf2*)smem + (size_t)2 * N + (size_t)gi * Ls;
    const bf16_t* hy = (const bf16_t*)(p.ws + WS_P + (set ? P_HYT_CTX : P_HYT_LAT));
    const float* cw = p.in[I_HYCW]; const float* cb = p.in[I_HYCB];
    const cf2* HF = (const cf2*)(p.ws + WS_F + (set ? F_HF_CTX : F_HF_LAT));
    const float invN = 1.f / (float)N;
    {
        const float w0 = cw[c], w1 = cw[1536 + c], w2 = cw[3072 + c], b = cb[c];
        const bf16_t* ra = hy + ((size_t)ba * 1536 + c) * Ls; const bf16_t* rb = hy + ((size_t)bb * 1536 + c) * Ls;
        for (int t = g; t < N; t += 256) { cf2 v; v.x = 0.f; v.y = 0.f; if (t < Ls) { v.x = hy_u(ra, t, Ls, w0, w1, w2, b); v.y = hy_u(rb, t, Ls, w0, w1, w2, b); zk[t] = v; } buf[t] = v; }
    }
    __syncthreads();
    for (int n = 0; n < 2; ++n) {
        fft_fwd(buf, S, g, 256);
        const cf2* hf = HF + (size_t)(n * 512 + c) * N;
        for (int k = g; k < N; k += 256) buf[k] = cmul(buf[k], hf[k]);
        __syncthreads();
        fft_inv(buf, S, g, 256);
        const int gc = (n + 1) * 512 + c;
        const float w0 = cw[gc], w1 = cw[1536 + gc], w2 = cw[3072 + gc], b = cb[gc], dsk = p.in[I_HYSKIP][n * 512 + c];
        const bf16_t* ra = hy + ((size_t)ba * 1536 + gc) * Ls; const bf16_t* rb = hy + ((size_t)bb * 1536 + gc) * Ls;
        bf16_t* M = (bf16_t*)(p.ws + WS_M);
        for (int t = g; t < N; t += 256) {
            cf2 v; v.x = 0.f; v.y = 0.f;
            if (t < Ls) {
                const cf2 cv = buf[t], zo = zk[t];
                v.x = hy_u(ra, t, Ls, w0, w1, w2, b) * (cv.x * invN + dsk * zo.x); v.y = hy_u(rb, t, Ls, w0, w1, w2, b) * (cv.y * invN + dsk * zo.y);
                if (n == 0) zk[t] = v;
                else { const size_t ta = set ? (size_t)TL + (size_t)ba * LC + t : (size_t)ba * L + t, tb = set ? (size_t)TL + (size_t)bb * LC + t : (size_t)bb * L + t;
                       M[ta * 1024 + c] = (bf16_t)f2bf(v.x); M[tb * 1024 + c] = (bf16_t)f2bf(v.y); }
            }
            if (n == 0) buf[t] = v;
        }
        __syncthreads();
    }
}
DEV void rope_store(const bf16_t* src, bf16_t* dst, int pos, bool rope, float scale, int ph, int sub) {
    const u32x4 ua = *(const u32x4*)(src + ph * 32 + sub * 8), ub = *(const u32x4*)(src + ph * 32 + 16 + sub * 8);
    float a[8], b[8];
#pragma unroll
    for (int i = 0; i < 4; ++i) { a[2 * i] = bflo(ua[i]); a[2 * i + 1] = bfhi(ua[i]); b[2 * i] = bflo(ub[i]); b[2 * i + 1] = bfhi(ub[i]); }
    if (rope) {
        const float pv = (float)(ph == 0 ? pos / 64 : pos % 64);
#pragma unroll
        for (int e = 0; e < 8; ++e) {
            const float inv = exp2f(-(float)(sub * 8 + e) * (13.287712379549449f / 16.f));
            const float ang = pv * inv, cs = __cosf(ang), sn = __sinf(ang);
            const float na = a[e] * cs - b[e] * sn, nb = b[e] * cs + a[e] * sn; a[e] = na; b[e] = nb;
        }
    }
    u32x4 oa, ob;
#pragma unroll
    for (int i = 0; i < 4; ++i) { oa[i] = pk2(a[2 * i] * scale, a[2 * i + 1] * scale); ob[i] = pk2(b[2 * i] * scale, b[2 * i + 1] * scale); }
    *(u32x4*)(dst + ph * 32 + sub * 8) = oa; *(u32x4*)(dst + ph * 32 + 16 + sub * 8) = ob;
}
constexpr int A_LDQ = 72, A_LDV = 136;
DEV void attn_item(const Params& p, int set, int item, unsigned char* smem) {
    bf16_t* Qs = (bf16_t*)smem;
    bf16_t* Ks = Qs + 128 * A_LDQ;
    bf16_t* Vt = Ks + 128 * A_LDQ;
    const int tid = tidx(), lane = tid & 63, w = tid >> 6, l15 = lane & 15, lg = lane >> 4;
    const int nqb = set ? LC / 128 : L / 128;
    const int h = item & 7, qb = (item >> 3) % nqb, b = (item >> 3) / nqb, kvh = h >> 2;
    const bf16_t* Q0 = (const bf16_t*)(p.ws + WS_P + P_Q0); const bf16_t* K0 = (const bf16_t*)(p.ws + WS_P + P_K0);
    const int qtok0 = set ? TL + b * LC + qb * 128 : b * L + qb * 128;
    { const int row = tid >> 2, ph = (tid >> 1) & 1, sub = tid & 1;
      rope_store(Q0 + (size_t)(qtok0 + row) * 512 + h * 64, Qs + row * A_LDQ, qb * 128 + row, set == 0, 0.125f, ph, sub); }
    __syncthreads();
    bf16x8 qf[2];
    qf[0] = *(const bf16x8*)(Qs + (w * 16 + l15) * A_LDQ + 8 * lg); qf[1] = *(const bf16x8*)(Qs + (w * 16 + l15) * A_LDQ + 32 + 8 * lg);
    float m_run = p.in[I_SINK][h], l_run = 1.f;
    f32x4 O[4];
#pragma unroll
    for (int i = 0; i < 4; ++i) O[i] = (f32x4){0.f, 0.f, 0.f, 0.f};
    const int nwin = set ? 0 : 3, nctx = LC / 128;
    for (int kbi = 0; kbi < nwin + nctx; ++kbi) {
        const bool win = kbi < nwin; const int kb = win ? qb - 1 + kbi : kbi - nwin;
        if (win && (kb < 0 || kb >= L / 128)) continue;
        const int ktok0 = win ? b * L + kb * 128 : TL + b * LC + kb * 128;
        __syncthreads();
        { const int row = tid >> 2, ph = (tid >> 1) & 1, sub = tid & 1;
          rope_store(K0 + (size_t)(ktok0 + row) * 128 + kvh * 64, Ks + row * A_LDQ, kb * 128 + row, win, 1.f, ph, sub); }
        { const bf16_t* vt = (const bf16_t*)(p.ws + WS_P + (win ? P_VT_LAT : P_VT_CTX)); const int Lx = win ? L : LC;
#pragma unroll
          for (int i = 0; i < 2; ++i) { const int id = tid + NT * i, d = id >> 4, kc = id & 15;
              *(u32x4*)(Vt + d * A_LDV + kc * 8) = *(const u32x4*)(vt + ((size_t)b * 128 + kvh * 64 + d) * Lx + kb * 128 + kc * 8); } }
        __syncthreads();
#pragma unroll
        for (int ch = 0; ch < 2; ++ch) {
            f32x4 st[4];
#pragma unroll
            for (int u = 0; u < 4; ++u) {
                const bf16_t* kr = Ks + ((ch * 4 + u) * 16 + l15) * A_LDQ + 8 * lg;
                f32x4 z = (f32x4){0.f, 0.f, 0.f, 0.f};
                z = __builtin_amdgcn_mfma_f32_16x16x32_bf16(*(const bf16x8*)kr, qf[0], z, 0, 0, 0);
                z = __builtin_amdgcn_mfma_f32_16x16x32_bf16(*(const bf16x8*)(kr + 32), qf[1], z, 0, 0, 0);
                st[u] = z;
            }
            float cmax = -INFINITY;
            if (win) {
                const int qpos = qb * 128 + w * 16 + l15;
#pragma unroll
                for (int u = 0; u < 4; ++u)
#pragma unroll
                    for (int r = 0; r < 4; ++r) { const int kpos = kb * 128 + (ch * 4 + u) * 16 + 4 * lg + r; const int dd = qpos - kpos; if (dd > 128 || dd < -128) st[u][r] = -INFINITY; }
            }
#pragma unroll
            for (int u = 0; u < 4; ++u)
#pragma unroll
                for (int r = 0; r < 4; ++r) cmax = fmaxf(cmax, st[u][r]);
            cmax = fmaxf(cmax, __shfl_xor(cmax, 16)); cmax = fmaxf(cmax, __shfl_xor(cmax, 32));
            const float m_new = fmaxf(m_run, cmax), alpha = __expf(m_run - m_new);
            float ls = 0.f;
#pragma unroll
            for (int u = 0; u < 4; ++u)
#pragma unroll
                for (int r = 0; r < 4; ++r) { const float e = __expf(st[u][r] - m_new); st[u][r] = e; ls += e; }
            ls += __shfl_xor(ls, 16); ls += __shfl_xor(ls, 32);
            l_run = l_run * alpha + ls; m_run = m_new;
#pragma unroll
            for (int i = 0; i < 4; ++i) { O[i][0] *= alpha; O[i][1] *= alpha; O[i][2] *= alpha; O[i][3] *= alpha; }
#pragma unroll
            for (int ss = 0; ss < 2; ++ss) {
                u32x4 pu; pu[0] = pk2(st[2 * ss][0], st[2 * ss][1]); pu[1] = pk2(st[2 * ss][2], st[2 * ss][3]); pu[2] = pk2(st[2 * ss + 1][0], st[2 * ss + 1][1]); pu[3] = pk2(st[2 * ss + 1][2], st[2 * ss + 1][3]);
                const bf16x8 pf = __builtin_bit_cast(bf16x8, pu);
                const int key0 = (ch * 4 + 2 * ss) * 16 + 4 * lg;
#pragma unroll
                for (int dt = 0; dt < 4; ++dt) {
                    const bf16_t* vr = Vt + (dt * 16 + l15) * A_LDV + key0;
                    u32x4 vu; const u32x2 v0 = *(const u32x2*)vr, v1 = *(const u32x2*)(vr + 16); vu[0] = v0[0]; vu[1] = v0[1]; vu[2] = v1[0]; vu[3] = v1[1];
                    O[dt] = __builtin_amdgcn_mfma_f32_16x16x32_bf16(__builtin_bit_cast(bf16x8, vu), pf, O[dt], 0, 0, 0);
                }
            }
        }
    }
    const float il = 1.f / l_run;
    bf16_t* M = (bf16_t*)(p.ws + WS_M) + (size_t)(qtok0 + w * 16 + l15) * 1024 + 512 + h * 64;
#pragma unroll
    for (int dt = 0; dt < 4; ++dt) { u32x2 o; o[0] = pk2(O[dt][0] * il, O[dt][1] * il); o[1] = pk2(O[dt][2] * il, O[dt][3] * il); *(u32x2*)(M + dt * 16 + 4 * lg) = o; }
    __syncthreads();
}
constexpr int P3_HY_LAT = (NB / 2) * 256, P3_HY_CTX = (NB / 2) * 256, P3_AT_LAT = NB * (L / 128) * 8, P3_AT_CTX = NB * (LC / 128) * 8;
DEV void phase3(const Params& p, unsigned char* smem) {
    const int total = P3_HY_LAT + P3_AT_LAT + P3_HY_CTX + P3_AT_CTX;
    for (int it = blockIdx.x; it < total; it += gridDim.x) {
        int i = it;
        if (i < P3_HY_LAT) { hyena_item(p, 0, i, smem); continue; } i -= P3_HY_LAT;
        if (i < P3_AT_LAT) { attn_item(p, 0, i, smem); continue; } i -= P3_AT_LAT;
        if (i < P3_HY_CTX) { hyena_item(p, 1, i, smem); continue; } i -= P3_HY_CTX;
        attn_item(p, 1, i, smem);
    }
}

constexpr int K_LDQ = 264, K_LDK = 136, K_LDS = 129;
DEV void topk_item(const Params& p, int layer, int item, unsigned char* smem) {
    bf16_t* Qs = (bf16_t*)smem;
    bf16_t* Ks = Qs + 64 * K_LDQ;
    float* Sc = (float*)(Ks + 128 * K_LDK);
    float* s12 = Sc + 64 * K_LDS;
    int* i12 = (int*)(s12 + 64 * 32);
    float* tops = (float*)(i12 + 64 * 32);
    int* topi = (int*)(tops + 64 * 16);
    const int tid = tidx(), lane = tid & 63, w = tid >> 6;
    const int h = item & 7, tok0 = (item >> 3) * 64;
    const bf16_t* PQ = (const bf16_t*)(p.ws + WS_P);
    const bf16_t* keys = (const bf16_t*)(p.ws + WS_W + W_KEYS) + (size_t)layer * 262144 + (size_t)h * 32768;
#pragma unroll
    for (int i = 0; i < 4; ++i) { const int id = tid + NT * i, row = id >> 5, kc = id & 31; *(u32x4*)(Qs + row * K_LDQ + kc * 8) = *(const u32x4*)(PQ + (size_t)(tok0 + row) * 2048 + h * 256 + kc * 8); }
    for (int part = 0; part < 2; ++part) {
        __syncthreads();
#pragma unroll
        for (int i = 0; i < 4; ++i) { const int id = tid + NT * i, row = id >> 4, kc = id & 15; *(u32x4*)(Ks + row * K_LDK + kc * 8) = *(const u32x4*)(keys + (size_t)part * 16384 + row * 128 + kc * 8); }
        __syncthreads();
        { const int mi = w >> 2, ni = w & 3;
          f32x16 acc;
#pragma unroll
          for (int r = 0; r < 16; ++r) acc[r] = 0.f;
          const bf16_t* as = Qs + (mi * 32 + (lane & 31)) * K_LDQ + part * 128 + 8 * (lane >> 5);
          const bf16_t* bs = Ks + (ni * 32 + (lane & 31)) * K_LDK + 8 * (lane >> 5);
#pragma unroll
          for (int kk = 0; kk < 8; ++kk) acc = __builtin_amdgcn_mfma_f32_32x32x16_bf16(*(const bf16x8*)(as + kk * 16), *(const bf16x8*)(bs + kk * 16), acc, 0, 0, 0);
#pragma unroll
          for (int r = 0; r < 16; ++r) Sc[(mi * 32 + (r & 3) + 8 * (r >> 2) + 4 * (lane >> 5)) * K_LDS + ni * 32 + (lane & 31)] = acc[r]; }
        __syncthreads();
        { const int row = tid >> 3, n0 = (tid & 7) * 16;
          float mine[16]; int rank[16];
#pragma unroll
          for (int i = 0; i < 16; ++i) { mine[i] = Sc[row * K_LDS + n0 + i]; rank[i] = 0; }
          for (int mm = 0; mm < 128; ++mm) {
              const float o = Sc[row * K_LDS + mm];
#pragma unroll
              for (int i = 0; i < 16; ++i) rank[i] += (o > mine[i] || (o == mine[i] && mm < n0 + i)) ? 1 : 0;
          }
#pragma unroll
          for (int i = 0; i < 16; ++i) if (rank[i] < 16) { s12[(row * 2 + part) * 16 + rank[i]] = mine[i]; i12[(row * 2 + part) * 16 + rank[i]] = n0 + i; } }
    }
    __syncthreads();
    {
        const int row = tid >> 3, sub = tid & 7;
        const float* s1 = s12 + row * 32; const float* s2 = s1 + 16;
        for (int cc = sub; cc < 50; cc += 8) {
            int ci = 0, cj = 0, cnt = 0;
            for (int i = 0; i < 16; ++i) { const int nj = 16 / (i + 1); if (cc < cnt + nj) { ci = i; cj = cc - cnt; break; } cnt += nj; }
            const float mine = s1[ci] + s2[cj]; const int myflat = ci * 16 + cj; int rank = 0;
            for (int i = 0; i < 16; ++i) { const int nj = 16 / (i + 1); for (int j = 0; j < nj; ++j) { const float o = s1[i] + s2[j]; rank += (o > mine || (o == mine && (i * 16 + j) < myflat)) ? 1 : 0; } }
            if (rank < 16) { tops[row * 16 + rank] = mine; topi[row * 16 + rank] = i12[row * 32 + ci] * 128 + i12[row * 32 + 16 + cj]; }
        }
    }
    __syncthreads();
    if (tid < 64) {
        const int row = tid; float mx = -INFINITY, e[16], sum = 0.f;
#pragma unroll
        for (int i = 0; i < 16; ++i) mx = fmaxf(mx, tops[row * 16 + i]);
#pragma unroll
        for (int i = 0; i < 16; ++i) { e[i] = expf(tops[row * 16 + i] - mx); sum += e[i]; }
        const float inv = 1.f / sum;
        int* IDX = (int*)(p.ws + WS_IDX) + (size_t)(tok0 + row) * 128 + h * 16; float* GT = (float*)(p.ws + WS_GATE) + (size_t)(tok0 + row) * 128 + h * 16;
#pragma unroll
        for (int i = 0; i < 16; ++i) { IDX[i] = topi[row * 16 + i]; GT[i] = e[i] * inv; }
    }
    __syncthreads();
}

DEV float gelu_f(float x) { return 0.5f * x * (1.f + erff(x * 0.70710678118654752f)); }
DEV void peer_item(const Params& p, int layer, int item) {
    const int tok = item * 8 + (tidx() >> 6), lane = tidx() & 63;
    const bf16_t* A = (const bf16_t*)(p.ws + WS_A) + (size_t)tok * 1024 + lane * 16;
    const bf16_t* UB = (const bf16_t*)(p.ws + WS_UB) + lane * 16; const bf16_t* VB = (const bf16_t*)(p.ws + WS_VB) + lane * 16;
    float x[16], y[16];
    { const u32x4 a0 = *(const u32x4*)A, a1 = *(const u32x4*)(A + 8);
#pragma unroll
      for (int i = 0; i < 4; ++i) { x[2 * i] = bflo(a0[i]); x[2 * i + 1] = bfhi(a0[i]); x[8 + 2 * i] = bflo(a1[i]); x[8 + 2 * i + 1] = bfhi(a1[i]); } }
#pragma unroll
    for (int i = 0; i < 16; ++i) y[i] = 0.f;
    const int* IDX = (const int*)(p.ws + WS_IDX) + (size_t)tok * 128; const float* GT = (const float*)(p.ws + WS_GATE) + (size_t)tok * 128;
    const int i_lo = IDX[lane], i_hi = IDX[64 + lane]; const float g_lo = GT[lane], g_hi = GT[64 + lane];
    for (int k = 0; k < 128; ++k) {
        const int e = __shfl(k < 64 ? i_lo : i_hi, k & 63); const float gt = __shfl(k < 64 ? g_lo : g_hi, k & 63);
        const u32x4 u0 = *(const u32x4*)(UB + (size_t)e * 1024), u1 = *(const u32x4*)(UB + (size_t)e * 1024 + 8);
        const u32x4 v0 = *(const u32x4*)(VB + (size_t)e * 1024), v1 = *(const u32x4*)(VB + (size_t)e * 1024 + 8);
        float d = 0.f;
#pragma unroll
        for (int i = 0; i < 4; ++i) { d += bflo(u0[i]) * x[2 * i] + bfhi(u0[i]) * x[2 * i + 1] + bflo(u1[i]) * x[8 + 2 * i] + bfhi(u1[i]) * x[8 + 2 * i + 1]; }
        d = wave_sum(d);
        const float act = gelu_f(d) * gt;
#pragma unroll
        for (int i = 0; i < 4; ++i) { y[2 * i] += act * bflo(v0[i]); y[2 * i + 1] += act * bfhi(v0[i]); y[8 + 2 * i] += act * bflo(v1[i]); y[8 + 2 * i + 1] += act * bfhi(v1[i]); }
    }
    float* H = (float*)(p.ws + WS_H) + (size_t)tok * 1024 + lane * 16;
    const float* g2 = (const float*)(p.ws + WS_MOD) + ((size_t)layer * NR + mod_row(tok)) * 6144 + 5120 + lane * 16;
    float hv[16]; float ss = 0.f;
#pragma unroll
    for (int i = 0; i < 4; ++i) { const f32x4 hh = *(const f32x4*)(H + 4 * i), gg = *(const f32x4*)(g2 + 4 * i);
#pragma unroll
        for (int j = 0; j < 4; ++j) { const float v = hh[j] + gg[j] * y[4 * i + j]; hv[4 * i + j] = v; ss += v * v; } }
    ss = wave_sum(ss);
    const float rstd = rsqrtf(ss * (1.f / 1024.f) + 1e-6f);
    if (layer == 0) {
#pragma unroll
        for (int i = 0; i < 4; ++i) { f32x4 o; o[0] = hv[4 * i]; o[1] = hv[4 * i + 1]; o[2] = hv[4 * i + 2]; o[3] = hv[4 * i + 3]; *(f32x4*)(H + 4 * i) = o; }
        const float* g = p.in[I_N1G] + 1024 + lane * 16;
        const float* mod = (const float*)(p.ws + WS_MOD) + ((size_t)1 * NR + mod_row(tok)) * 6144 + lane * 16;
        bf16_t* Ao = (bf16_t*)(p.ws + WS_A) + (size_t)tok * 1024 + lane * 16;
        u32x4 o0, o1; float r[16];
#pragma unroll
        for (int i = 0; i < 16; ++i) r[i] = hv[i] * rstd * g[i] * (1.f + mod[1024 + i]) + mod[i];
#pragma unroll
        for (int i = 0; i < 4; ++i) { o0[i] = pk2(r[2 * i], r[2 * i + 1]); o1[i] = pk2(r[8 + 2 * i], r[8 + 2 * i + 1]); }
        *(u32x4*)Ao = o0; *(u32x4*)(Ao + 8) = o1;
    } else {
        const float* g = p.in[I_FG] + lane * 16; float* out = p.out + (size_t)tok * 1024 + lane * 16;
#pragma unroll
        for (int i = 0; i < 4; ++i) { f32x4 o; o[0] = hv[4 * i] * rstd * g[4 * i]; o[1] = hv[4 * i + 1] * rstd * g[4 * i + 1]; o[2] = hv[4 * i + 2] * rstd * g[4 * i + 2]; o[3] = hv[4 * i + 3] * rstd * g[4 * i + 3]; *(f32x4*)(out + 4 * i) = o; }
    }
}

DEV void scan_wave(const Params& p, int wi) {
    const int lane = tidx() & 63;
    const int vo = wi & 15, dir = (wi >> 4) & 1, h = (wi >> 5) & 7, b = wi >> 8;
    const bf16_t* P1 = (const bf16_t*)(p.ws + WS_P);
    bf16_t* Oo = (bf16_t*)(p.ws + WS_F + (dir ? F_OB : F_OF));
    const float* lg = p.in[I_HGLB];
    float lb[2];
#pragma unroll
    for (int i = 0; i < 2; ++i) { const int c = h * 128 + 2 * lane + i; lb[i] = 1.f / (1.f + expf(lg[dir * 1024 + c] - lg[2048 + dir * 1024 + c])); }
    float S[2][8];
#pragma unroll
    for (int i = 0; i < 2; ++i)
#pragma unroll
        for (int j = 0; j < 8; ++j) S[i][j] = 0.f;
    const int qoff = h * 128 + 2 * lane, foff = 1024 * (1 + dir) + h * 128 + 2 * lane, voff = 3072 + h * 128 + vo * 8;
    for (int step = 0; step < LC + L; ++step) {
        const bool isctx = step < LC; const int tt = isctx ? step : step - LC;
        const int tok = isctx ? TL + b * LC + (dir ? LC - 1 - tt : tt) : b * L + (dir ? L - 1 - tt : tt);
        const bf16_t* row = P1 + (size_t)tok * 5120;
        const unsigned fu = *(const unsigned*)(row + foff); const u32x4 vu = *(const u32x4*)(row + voff);
        float fg[2] = {lb[0] + (1.f - lb[0]) * sigmoid_f(bflo(fu)), lb[1] + (1.f - lb[1]) * sigmoid_f(bfhi(fu))};
        float vv[8];
#pragma unroll
        for (int j = 0; j < 4; ++j) { vv[2 * j] = bflo(vu[j]); vv[2 * j + 1] = bfhi(vu[j]); }
#pragma unroll
        for (int i = 0; i < 2; ++i)
#pragma unroll
            for (int j = 0; j < 8; ++j) S[i][j] = fg[i] * S[i][j] + (1.f - fg[i]) * vv[j];
        if (!isctx) {
            const unsigned qu = *(const unsigned*)(row + qoff); const float q0 = silu_f(bflo(qu)), q1 = silu_f(bfhi(qu));
            float o[8];
#pragma unroll
            for (int j = 0; j < 8; ++j) o[j] = q0 * S[0][j] + q1 * S[1][j];
            float r4[4];
            { const bool hi = (lane & 32) != 0;
#pragma unroll
              for (int j = 0; j < 4; ++j) { const float send = hi ? o[j] : o[4 + j], keep = hi ? o[4 + j] : o[j]; r4[j] = keep + __shfl_xor(send, 32); } }
            float r2[2];
            { const bool hi = (lane & 16) != 0;
#pragma unroll
              for (int j = 0; j < 2; ++j) { const float send = hi ? r4[j] : r4[2 + j], keep = hi ? r4[2 + j] : r4[j]; r2[j] = keep + __shfl_xor(send, 16); } }
            float r1;
            { const bool hi = (lane & 8) != 0; const float send = hi ? r2[0] : r2[1], keep = hi ? r2[1] : r2[0]; r1 = keep + __shfl_xor(send, 8); }
            r1 += __shfl_xor(r1, 4); r1 += __shfl_xor(r1, 2); r1 += __shfl_xor(r1, 1);
            if ((lane & 7) == 0) { const int j = ((lane >> 5) & 1) * 4 + ((lane >> 4) & 1) * 2 + ((lane >> 3) & 1); Oo[(size_t)tok * 1024 + h * 128 + vo * 8 + j] = (bf16_t)f2bf(r1); }
        }
    }
}
DEV void readout_item(const Params& p, int item) {
    const int tok = item * 8 + (tidx() >> 6), lane = tidx() & 63;
    const bf16_t* of = (const bf16_t*)(p.ws + WS_F + F_OF) + (size_t)tok * 1024 + lane * 16; const bf16_t* ob = (const bf16_t*)(p.ws + WS_F + F_OB) + (size_t)tok * 1024 + lane * 16;
    const bf16_t* gp = (const bf16_t*)(p.ws + WS_P) + (size_t)tok * 5120 + 4096 + lane * 16;
    const float* on = p.in[I_HGON] + (lane & 7) * 16;
    float o[16], gg[16]; float ss = 0.f;
    { const u32x4 a0 = *(const u32x4*)of, a1 = *(const u32x4*)(of + 8), b0 = *(const u32x4*)ob, b1 = *(const u32x4*)(ob + 8), g0 = *(const u32x4*)gp, g1 = *(const u32x4*)(gp + 8);
#pragma unroll
      for (int i = 0; i < 4; ++i) { o[2 * i] = bflo(a0[i]) + bflo(b0[i]); o[2 * i + 1] = bfhi(a0[i]) + bfhi(b0[i]); o[8 + 2 * i] = bflo(a1[i]) + bflo(b1[i]); o[8 + 2 * i + 1] = bfhi(a1[i]) + bfhi(b1[i]);
          gg[2 * i] = bflo(g0[i]); gg[2 * i + 1] = bfhi(g0[i]); gg[8 + 2 * i] = bflo(g1[i]); gg[8 + 2 * i + 1] = bfhi(g1[i]); } }
#pragma unroll
    for (int i = 0; i < 16; ++i) ss += o[i] * o[i];
    ss += __shfl_xor(ss, 1); ss += __shfl_xor(ss, 2); ss += __shfl_xor(ss, 4);
    const float rstd = rsqrtf(ss * (1.f / 128.f) + 1e-6f);
    bf16_t* M = (bf16_t*)(p.ws + WS_M) + (size_t)tok * 1024 + lane * 16;
    u32x4 o0, o1; float r[16];
#pragma unroll
    for (int i = 0; i < 16; ++i) r[i] = o[i] * rstd * on[i] * silu_f(gg[i]);
#pragma unroll
    for (int i = 0; i < 4; ++i) { o0[i] = pk2(r[2 * i], r[2 * i + 1]); o1[i] = pk2(r[8 + 2 * i], r[8 + 2 * i + 1]); }
    *(u32x4*)M = o0; *(u32x4*)(M + 8) = o1;
}

#ifdef NOINLINE_PHASES
#define NOINL __device__ __attribute__((noinline))
#else
#define NOINL __device__ __forceinline__
#endif
__shared__ __attribute__((aligned(16))) unsigned char g_smem[SMEM_BYTES];
#define PH_COMMON const int G = gridDim.x, bid = blockIdx.x; unsigned char* smem = g_smem; (void)smem; (void)G; (void)bid; \
    const bf16_t* A = (const bf16_t*)(p.ws + WS_A); const bf16_t* Mx = (const bf16_t*)(p.ws + WS_M); const bf16_t* W = (const bf16_t*)(p.ws + WS_W); (void)A; (void)Mx; (void)W;
NOINL void ph0(const Params& p) { PH_COMMON phase0(p, smem); }
NOINL void ph1(const Params& p) { PH_COMMON phase1(p, smem); }
NOINL void ph2(const Params& p) { PH_COMMON EpiL0In e{p.ws}; for (int t = bid; t < (T / 256) * 18; t += G) gemm_tile(A, W + W_IN0 / 2, (t / 18) * 256, (t % 18) * 128, smem, e); }
NOINL void ph3(const Params& p) { PH_COMMON phase3(p, smem); }
NOINL void ph4(const Params& p) { PH_COMMON EpiRes e{&p, 1, 0, 2048}; for (int t = bid; t < (T / 256) * 8; t += G) gemm_tile(Mx, W + W_OUT0 / 2, (t / 8) * 256, (t % 8) * 128, smem, e); }
NOINL void ph5(const Params& p) { PH_COMMON for (int it = bid; it < T / 8; it += G) norm_rows_item(p, it, 0, p.in[I_N2G], 0, 3072); }
NOINL void ph6(const Params& p) { PH_COMMON EpiBf16 e{(bf16_t*)(p.ws + WS_P), 2048}; for (int t = bid; t < (T / 256) * 16; t += G) gemm_tile(A, W + W_Q0 / 2, (t / 16) * 256, (t % 16) * 128, smem, e); }
NOINL void ph7(const Params& p) { PH_COMMON for (int it = bid; it < (T / 64) * 8; it += G) topk_item(p, 0, it, smem); }
NOINL void ph8(const Params& p) { PH_COMMON for (int it = bid; it < T / 8; it += G) peer_item(p, 0, it); }
NOINL void ph9(const Params& p) { PH_COMMON EpiBf16 e{(bf16_t*)(p.ws + WS_P), 5120};
    for (int t = bid; t < (T / 256) * 40; t += G) { const int mt = t / 40, nt = t % 40; if (mt >= TL / 256 && (nt < 8 || nt >= 32)) continue; gemm_tile(A, W + W_IN1 / 2, mt * 256, nt * 128, smem, e); } }
NOINL void ph10(const Params& p) { PH_COMMON for (int wi = bid * 8 + (tidx() >> 6); wi < NB * 256; wi += G * 8) scan_wave(p, wi); }
NOINL void ph11(const Params& p) { PH_COMMON for (int it = bid; it < TL / 8 + 2 * P0_TAB; it += G) { if (it < TL / 8) readout_item(p, it); else tables_layer1(p, it - TL / 8); } }
NOINL void ph12(const Params& p) { PH_COMMON EpiRes e{&p, 0, 1, 2048}; for (int t = bid; t < (TL / 256) * 8; t += G) gemm_tile(Mx, W + W_OUT1 / 2, (t / 8) * 256, (t % 8) * 128, smem, e); }
NOINL void ph13(const Params& p) { PH_COMMON for (int it = bid; it < TL / 8; it += G) norm_rows_item(p, it, 0, p.in[I_N2G] + 1024, 1, 3072); }
NOINL void ph14(const Params& p) { PH_COMMON EpiBf16 e{(bf16_t*)(p.ws + WS_P), 2048}; for (int t = bid; t < (TL / 256) * 16; t += G) gemm_tile(A, W + W_Q1 / 2, (t / 16) * 256, (t % 16) * 128, smem, e); }
NOINL void ph15(const Params& p) { PH_COMMON for (int it = bid; it < (TL / 64) * 8; it += G) topk_item(p, 1, it, smem); }
NOINL void ph16(const Params& p) { PH_COMMON for (int it = bid; it < TL / 8; it += G) peer_item(p, 1, it); }

constexpr int NPHASE = 17;
__global__ void __launch_bounds__(NT, 2) mega(Params p_in) {
    const int ph_lo = p_in.ph_lo, ph_hi = p_in.ph_hi;
    for (int ph = ph_lo; ph < ph_hi; ++ph) {
        if (ph > ph_lo) {
#ifndef HOST_EMU
            cg::this_grid().sync();
#endif
        }
#ifndef HOST_EMU
        unsigned long long kp = (unsigned long long)__builtin_amdgcn_kernarg_segment_ptr();
        asm volatile("" : "+s"(kp) :: "memory");
        const Params& p = *(const Params*)(const __attribute__((address_space(4))) Params*)kp;
#else
        const Params& p = p_in;
#endif
#ifdef ONLY_PHASE
        if (ph != ONLY_PHASE) continue;
#endif
        switch (ph) {
        case 0: ph0(p); break; case 1: ph1(p); break; case 2: ph2(p); break; case 3: ph3(p); break; case 4: ph4(p); break; case 5: ph5(p); break;
        case 6: ph6(p); break; case 7: ph7(p); break; case 8: ph8(p); break; case 9: ph9(p); break; case 10: ph10(p); break; case 11: ph11(p); break;
        case 12: ph12(p); break; case 13: ph13(p); break; case 14: ph14(p); break; case 15: ph15(p); break; case 16: ph16(p); break;
        default: break;
        }
    }
}

#ifndef HOST_EMU
extern "C" void kernel_launch(void* const* d_in, const int* in_sizes, int n_in, void* d_out, int out_size, void* d_ws, size_t ws_size, hipStream_t stream) {
    if (n_in != 29 || ws_size < WS_END || out_size != TL * 1024) { fprintf(stderr, "kernel_launch: unexpected sizes (n_in %d, ws %zu need %zu, out %d)\n", n_in, ws_size, (size_t)WS_END, out_size); return; }
    static int grid = 0;
    if (!grid) { int dev = 0, cus = 0; hipGetDevice(&dev); hipDeviceGetAttribute(&cus, hipDeviceAttributeMultiprocessorCount, dev); grid = cus > 0 ? cus : 256; }
    hipMemsetAsync((unsigned char*)d_ws + WS_CTRL, 0, CTRL_BYTES, stream);
    Params p{};
    for (int i = 0; i < 29; ++i) p.in[i] = (const float*)d_in[i];
    p.out = (float*)d_out; p.ws = (unsigned char*)d_ws;
#ifdef MULTI_LAUNCH
    for (int ph = 0; ph < NPHASE; ++ph) { p.ph_lo = ph; p.ph_hi = ph + 1; hipLaunchKernelGGL(mega, dim3(grid), dim3(NT), 0, stream, p); }
#else
    p.ph_lo = 0; p.ph_hi = NPHASE;
    void* args[] = {&p};
    hipError_t e = hipLaunchCooperativeKernel((void*)mega, dim3(grid), dim3(NT), args, 0, stream);
    if (e != hipSuccess) fprintf(stderr, "cooperative launch failed: %s (grid %d)\n", hipGetErrorString(e), grid);
#endif
}
#endif
```

```cpp
#ifndef HOST_EMU
#include <hip/hip_runtime.h>
#include <hip/hip_cooperative_groups.h>
#include <cstdio>
namespace cg = cooperative_groups;
#endif

#ifndef CFG_B
#define CFG_B 8
#define CFG_L 2048
#define CFG_LC 256
#endif
#define DEV __device__ __forceinline__
#ifdef HOST_EMU
#define __expf expf
#define __sinf sinf
#define __cosf cosf
#endif

typedef unsigned short bf16_t;
typedef short bf16x8 __attribute__((ext_vector_type(8)));
typedef float f32x16 __attribute__((ext_vector_type(16)));
typedef float f32x4 __attribute__((ext_vector_type(4)));
typedef unsigned u32x4 __attribute__((ext_vector_type(4)));
typedef unsigned u32x2 __attribute__((ext_vector_type(2)));
struct cf2 { float x, y; };

constexpr int NB = CFG_B, L = CFG_L, LC = CFG_LC, D = 1024;
constexpr int TL = NB * L, TC = NB * LC, T = TL + TC;
constexpr int NT = 512;
constexpr int NR = NB + 1;
constexpr int log4ceil(int n) { int s = 0, v = 1; while (v < n) { v *= 4; ++s; } return s; }
constexpr int FS_LAT = log4ceil(2 * L - 1), FS_CTX = log4ceil(2 * LC - 1);
constexpr int NF_LAT = 1 << (2 * FS_LAT), NF_CTX = 1 << (2 * FS_CTX);
static_assert(T % 256 == 0 && TL % 256 == 0 && L % 128 == 0 && LC % 128 == 0 && NB % 2 == 0, "shape");

constexpr size_t al256(size_t x) { return (x + 255) & ~(size_t)255; }
constexpr size_t WS_CTRL = 0, CTRL_BYTES = 65536;
constexpr size_t CTRL_HYNORM = 4096;
constexpr size_t WS_MOD = WS_CTRL + CTRL_BYTES;
constexpr size_t WS_H = al256(WS_MOD + (size_t)2 * NR * 6144 * 4);
constexpr size_t WS_A = al256(WS_H + (size_t)T * 1024 * 4);
constexpr size_t WS_P = al256(WS_A + (size_t)T * 1024 * 2);
constexpr size_t P_BYTES = (size_t)T * 5120 * 2;
constexpr size_t P_HYT_LAT = 0;
constexpr size_t P_HYT_CTX = P_HYT_LAT + (size_t)NB * 1536 * L * 2;
constexpr size_t P_Q0 = P_HYT_CTX + (size_t)NB * 1536 * LC * 2;
constexpr size_t P_K0 = P_Q0 + (size_t)T * 512 * 2;
constexpr size_t P_VT_LAT = P_K0 + (size_t)T * 128 * 2;
constexpr size_t P_VT_CTX = P_VT_LAT + (size_t)NB * 128 * L * 2;
static_assert(P_VT_CTX + (size_t)NB * 128 * LC * 2 <= P_BYTES, "P region");
constexpr size_t WS_M = al256(WS_P + P_BYTES);
constexpr size_t WS_IDX = al256(WS_M + (size_t)T * 1024 * 2);
constexpr size_t WS_GATE = al256(WS_IDX + (size_t)T * 128 * 4);
constexpr size_t WS_UB = al256(WS_GATE + (size_t)T * 128 * 4);
constexpr size_t WS_VB = WS_UB + (size_t)16384 * 1024 * 2;
constexpr size_t WS_W = WS_VB + (size_t)16384 * 1024 * 2;
constexpr size_t W_IN0 = 0, W_OUT0 = W_IN0 + (size_t)2304 * 1024 * 2, W_IN1 = W_OUT0 + (size_t)1024 * 1024 * 2,
                 W_OUT1 = W_IN1 + (size_t)5120 * 1024 * 2, W_Q0 = W_OUT1 + (size_t)1024 * 1024 * 2, W_Q1 = W_Q0 + (size_t)2048 * 1024 * 2,
                 W_KEYS = W_Q1 + (size_t)2048 * 1024 * 2, W_BYTES = W_KEYS + (size_t)2 * 8 * 2 * 128 * 128 * 2;
constexpr size_t WS_F = al256(WS_W + W_BYTES);
constexpr size_t F_HRAW_LAT = 0;
constexpr size_t F_HRAW_CTX = F_HRAW_LAT + (size_t)2048 * L * 4;
constexpr size_t F_HF_LAT = F_HRAW_CTX + (size_t)2048 * LC * 4;
constexpr size_t F_HF_CTX = F_HF_LAT + (size_t)1024 * NF_LAT * 8;
constexpr size_t F_HYP_LAT = F_HF_CTX + (size_t)1024 * NF_CTX * 8;
constexpr size_t F_HYP_CTX = F_HYP_LAT + (size_t)(L / 64) * 2048 * 4;
constexpr size_t F_END = F_HYP_CTX + (size_t)(LC / 64) * 2048 * 4;
constexpr size_t F_OF = 0, F_OB = (size_t)TL * 1024 * 2;
constexpr size_t F_BYTES = F_END > 2 * F_OB ? F_END : 2 * F_OB;
constexpr size_t WS_END = al256(WS_F + F_BYTES);

struct Params { const float* in[29]; float* out; unsigned char* ws; int ph_lo, ph_hi; };
enum { I_X = 0, I_C, I_CTX, I_CCTX, I_ADAW, I_ADAB, I_N1G, I_N2G, I_FG, I_ABWIN, I_ABWOUT, I_HYCW, I_HYCB, I_HYW1, I_HYB1, I_HYW2, I_HYB2, I_HYW3,
       I_HYFREQ, I_HYSKIP, I_SINK, I_HGWIN, I_HGWOUT, I_HGLB, I_HGON, I_PWQ, I_PKEYS, I_PU, I_PV };

constexpr int SMEM_BYTES = 147456;

#ifndef HOST_EMU
DEV int tidx() { int t = threadIdx.x; asm volatile("" : "+v"(t)); return t; }
#else
DEV int tidx() { return (int)threadIdx.x; }
#endif
DEV unsigned f2bf(float f) { unsigned u = __builtin_bit_cast(unsigned, f); return (u + 0x7fffu + ((u >> 16) & 1u)) >> 16; }
DEV float bf2f(unsigned h) { return __builtin_bit_cast(float, (h & 0xffffu) << 16); }
DEV unsigned pk2(float lo, float hi) { return f2bf(lo) | (f2bf(hi) << 16); }
DEV float bflo(unsigned u) { return __builtin_bit_cast(float, u << 16); }
DEV float bfhi(unsigned u) { return __builtin_bit_cast(float, u & 0xffff0000u); }
DEV float silu_f(float x) { return x / (1.f + __expf(-x)); }
DEV float sigmoid_f(float x) { return 1.f / (1.f + __expf(-x)); }
DEV float wave_sum(float v) {
#pragma unroll
    for (int m = 32; m >= 1; m >>= 1) v += __shfl_xor(v, m);
    return v;
}
DEV int mod_row(int tok) { return tok < TL ? tok / L : NB; }

DEV void p0_mod(const Params& p, int item, unsigned char* smem) {
    const int l = item / 96, col0 = (item % 96) * 64, tid = tidx();
    float* sc = (float*)smem;
    float* red = sc + NR * 1024;
    for (int i = tid; i < NR * 1024; i += NT) { const int r = i >> 10, k = i & 1023; const float c = r < NB ? p.in[I_C][r * 1024 + k] : p.in[I_CCTX][k]; sc[i] = c / (1.f + expf(-c)); }
    __syncthreads();
    const int kq = tid >> 6, col = tid & 63;
    float acc[NR];
#pragma unroll
    for (int r = 0; r < NR; ++r) acc[r] = 0.f;
    const float* w = p.in[I_ADAW] + (size_t)l * 1024 * 6144 + col0 + col;
#pragma unroll 4
    for (int k = kq * 128; k < kq * 128 + 128; ++k) {
        const float wv = w[(size_t)k * 6144];
#pragma unroll
        for (int r = 0; r < NR; ++r) acc[r] += sc[r * 1024 + k] * wv;
    }
#pragma unroll
    for (int r = 0; r < NR; ++r) red[(kq * NR + r) * 64 + col] = acc[r];
    __syncthreads();
    float* mod = (float*)(p.ws + WS_MOD);
    for (int i = tid; i < NR * 64; i += NT) {
        const int r = i >> 6, c = i & 63; float s = 0.f;
        for (int q = 0; q < 8; ++q) s += red[(q * NR + r) * 64 + c];
        mod[((size_t)l * NR + r) * 6144 + col0 + c] = s + p.in[I_ADAB][l * 6144 + col0 + c];
    }
    __syncthreads();
}
DEV void p0_transpose(const float* W, bf16_t* Wt, int N, int tile, unsigned char* smem) {
    float* ts = (float*)smem;
    const int ntn = N / 64, kt = tile / ntn, nt = tile % ntn, k0 = kt * 64, n0 = nt * 64, tid = tidx();
    for (int i = tid; i < 4096; i += NT) { const int kk = i >> 6, nn = i & 63; ts[kk * 65 + nn] = W[(size_t)(k0 + kk) * N + n0 + nn]; }
    __syncthreads();
    for (int i = tid; i < 4096; i += NT) { const int nn = i >> 6, kk = i & 63; Wt[(size_t)(n0 + nn) * 1024 + k0 + kk] = (bf16_t)f2bf(ts[kk * 65 + nn]); }
    __syncthreads();
}
DEV void p0_convert(const float* src, bf16_t* dst, int item) {
    const int tid = tidx();
#pragma unroll
    for (int i = 0; i < 8; ++i) {
        const size_t e = (size_t)item * 16384 + (size_t)(i * NT + tid) * 4;
        const f32x4 v = *(const f32x4*)(src + e);
        u32x2 o; o[0] = pk2(v[0], v[1]); o[1] = pk2(v[2], v[3]);
        *(u32x2*)(dst + e) = o;
    }
}
DEV void p0_filter(const Params& p, int set, int chunk, unsigned char* smem) {
    const int Ls = set ? LC : L, l0 = chunk * 64, tid = tidx();
    float* z = (float*)smem;
    float* hd1 = z + 64 * 34;
    float* hd2 = hd1 + 64 * 65;
    const float* w1 = p.in[I_HYW1]; const float* b1 = p.in[I_HYB1]; const float* w2 = p.in[I_HYW2]; const float* b2 = p.in[I_HYB2];
    const float* w3 = p.in[I_HYW3]; const float* fq = p.in[I_HYFREQ];
    for (int i = tid; i < 64 * 33; i += NT) {
        const int pp = i / 33, f = i % 33, l = l0 + pp; float val;
        if (f == 0) val = (float)l / (float)(Ls - 1);
        else { const int jb = (f - 1) & 15; const float fj = 1e-4f + (float)jb * ((15.f - 1e-4f) / 15.f); const float a = fj * (6.283185307179586f * (float)l / (float)Ls); val = f <= 16 ? __cosf(a) : -__sinf(a); }
        z[pp * 34 + f] = val;
    }
    __syncthreads();
    for (int i = tid; i < 4096; i += NT) {
        const int pp = i >> 6, j = i & 63; float s = b1[j];
#pragma unroll 4
        for (int f = 0; f < 33; ++f) s += z[pp * 34 + f] * w1[f * 64 + j];
        hd1[pp * 65 + j] = __sinf(fq[j] * s);
    }
    __syncthreads();
    for (int i = tid; i < 4096; i += NT) {
        const int pp = i >> 6, j = i & 63; float s = b2[j];
#pragma unroll 4
        for (int f = 0; f < 64; ++f) s += hd1[pp * 65 + f] * w2[f * 64 + j];
        hd2[pp * 65 + j] = __sinf(fq[j] * s);
    }
    __syncthreads();
    const int lane = tid & 63, w = __builtin_amdgcn_readfirstlane(tid >> 6);
    const float tl = (float)(l0 + lane) / (float)(Ls - 1);
    const float max_decay = -15.350567286626973f, min_decay = -3.0701134573253945f;
    float* hraw = (float*)(p.ws + WS_F + (set ? F_HRAW_CTX : F_HRAW_LAT));
    float* hyn = (float*)(p.ws + WS_F + (set ? F_HYP_CTX : F_HYP_LAT)) + (size_t)chunk * 2048;
    for (int oc = 0; oc < 256; ++oc) {
        const int o = w * 256 + oc; float s = 0.f;
#pragma unroll 8
        for (int j = 0; j < 64; ++j) s += hd2[lane * 65 + j] * w3[j * 2048 + o];
        const int c = o & 511; const float delta = fabsf(min_decay + (float)c * ((max_decay - min_decay) / 511.f));
        const float val = s * expf(-tl * delta);
        hraw[(size_t)o * Ls + l0 + lane] = val;
        const float a = wave_sum(fabsf(val));
        if (lane == 0) hyn[o] = a;
    }
    __syncthreads();
}

constexpr int P0_MOD = 192, P0_TR_IN0 = 16 * 36, P0_TR_OUT0 = 256, P0_TR_IN1 = 16 * 80, P0_TR_OUT1 = 256, P0_TR_Q = 16 * 32, P0_KEYS = 32, P0_TAB = 1024,
              P0_FILT = L / 64 + LC / 64;
DEV void phase0(const Params& p, unsigned char* smem) {
    bf16_t* W = (bf16_t*)(p.ws + WS_W);
    const int total = P0_MOD + P0_FILT + P0_TR_IN0 + P0_TR_OUT0 + P0_TR_IN1 + P0_TR_OUT1 + 2 * P0_TR_Q + P0_KEYS + 2 * P0_TAB;
    for (int it = blockIdx.x; it < total; it += gridDim.x) {
        int i = it;
        if (i < P0_MOD) { p0_mod(p, i, smem); continue; } i -= P0_MOD;
        if (i < P0_FILT) { if (i < L / 64) p0_filter(p, 0, i, smem); else p0_filter(p, 1, i - L / 64, smem); continue; } i -= P0_FILT;
        if (i < P0_TR_IN0) { p0_transpose(p.in[I_ABWIN], W + W_IN0 / 2, 2304, i, smem); continue; } i -= P0_TR_IN0;
        if (i < P0_TR_OUT0) { p0_transpose(p.in[I_ABWOUT], W + W_OUT0 / 2, 1024, i, smem); continue; } i -= P0_TR_OUT0;
        if (i < P0_TR_IN1) { p0_transpose(p.in[I_HGWIN], W + W_IN1 / 2, 5120, i, smem); continue; } i -= P0_TR_IN1;
        if (i < P0_TR_OUT1) { p0_transpose(p.in[I_HGWOUT], W + W_OUT1 / 2, 1024, i, smem); continue; } i -= P0_TR_OUT1;
        if (i < P0_TR_Q) { p0_transpose(p.in[I_PWQ], W + W_Q0 / 2, 2048, i, smem); continue; } i -= P0_TR_Q;
        if (i < P0_TR_Q) { p0_transpose(p.in[I_PWQ] + (size_t)1024 * 2048, W + W_Q1 / 2, 2048, i, smem); continue; } i -= P0_TR_Q;
        if (i < P0_KEYS) { p0_convert(p.in[I_PKEYS], W + W_KEYS / 2, i); continue; } i -= P0_KEYS;
        if (i < P0_TAB) { p0_convert(p.in[I_PU], (bf16_t*)(p.ws + WS_UB), i); continue; } i -= P0_TAB;
        p0_convert(p.in[I_PV], (bf16_t*)(p.ws + WS_VB), i);
    }
}
DEV void tables_layer1(const Params& p, int i) {
    if (i < P0_TAB) p0_convert(p.in[I_PU] + (size_t)16384 * 1024, (bf16_t*)(p.ws + WS_UB), i);
    else p0_convert(p.in[I_PV] + (size_t)16384 * 1024, (bf16_t*)(p.ws + WS_VB), i - P0_TAB);
}

DEV const float* h_row(const Params& p, int layer_src_inputs, int tok) {
    if (layer_src_inputs) return tok < TL ? p.in[I_X] + (size_t)tok * 1024 : p.in[I_CTX] + (size_t)(tok - TL) * 1024;
    return (const float*)(p.ws + WS_H) + (size_t)tok * 1024;
}
DEV void norm_row_store(const Params& p, const f32x4 (&v)[4], int tok, const float* g, int layer, int sh_off, int lane) {
    float ss = 0.f;
#pragma unroll
    for (int i = 0; i < 4; ++i) ss += v[i][0] * v[i][0] + v[i][1] * v[i][1] + v[i][2] * v[i][2] + v[i][3] * v[i][3];
    ss = wave_sum(ss);
    const float rstd = rsqrtf(ss * (1.f / 1024.f) + 1e-6f);
    const float* mod = (const float*)(p.ws + WS_MOD) + ((size_t)layer * NR + mod_row(tok)) * 6144 + sh_off;
    bf16_t* A = (bf16_t*)(p.ws + WS_A) + (size_t)tok * 1024;
#pragma unroll
    for (int i = 0; i < 4; ++i) {
        const int c = i * 256 + lane * 4;
        const f32x4 gg = *(const f32x4*)(g + c), sh = *(const f32x4*)(mod + c), sc = *(const f32x4*)(mod + 1024 + c);
        u32x2 o;
        o[0] = pk2(v[i][0] * rstd * gg[0] * (1.f + sc[0]) + sh[0], v[i][1] * rstd * gg[1] * (1.f + sc[1]) + sh[1]);
        o[1] = pk2(v[i][2] * rstd * gg[2] * (1.f + sc[2]) + sh[2], v[i][3] * rstd * gg[3] * (1.f + sc[3]) + sh[3]);
        *(u32x2*)(A + c) = o;
    }
}
DEV void norm_rows_item(const Params& p, int item, int from_inputs, const float* g, int layer, int sh_off) {
    const int tok = item * 8 + (tidx() >> 6), lane = tidx() & 63;
    const float* src = h_row(p, from_inputs, tok);
    f32x4 v[4];
#pragma unroll
    for (int i = 0; i < 4; ++i) v[i] = *(const f32x4*)(src + i * 256 + lane * 4);
    norm_row_store(p, v, tok, g, layer, sh_off, lane);
}

DEV cf2 cmul(cf2 a, cf2 b) { cf2 r; r.x = a.x * b.x - a.y * b.y; r.y = a.x * b.y + a.y * b.x; return r; }
DEV cf2 twid(int k, float invN) { cf2 r; const float a = (float)k * invN; r.x = __builtin_amdgcn_cosf(a); r.y = -__builtin_amdgcn_sinf(a); return r; }
DEV void fft_fwd(cf2* buf, int S, int g, int G) {
    const int N = 1 << (2 * S); const float invN = 1.f / (float)N;
    for (int s = 0; s < S; ++s) {
        const int lm = 2 * (S - s), m = 1 << lm, q = m >> 2;
        for (int bf = g; bf < (N >> 2); bf += G) {
            const int j = bf & (q - 1), base = ((bf >> (lm - 2)) << lm) + j;
            const cf2 a0 = buf[base], a1 = buf[base + q], a2 = buf[base + 2 * q], a3 = buf[base + 3 * q];
            cf2 t0, t1, t2, t3; t0.x = a0.x + a2.x; t0.y = a0.y + a2.y; t1.x = a0.x - a2.x; t1.y = a0.y - a2.y; t2.x = a1.x + a3.x; t2.y = a1.y + a3.y;
            const float dx = a1.x - a3.x, dy = a1.y - a3.y; t3.x = dy; t3.y = -dx;
            cf2 y0, y1, y2, y3; y0.x = t0.x + t2.x; y0.y = t0.y + t2.y; y1.x = t1.x + t3.x; y1.y = t1.y + t3.y; y2.x = t0.x - t2.x; y2.y = t0.y - t2.y; y3.x = t1.x - t3.x; y3.y = t1.y - t3.y;
            const int tw = j << (2 * s);
            buf[base] = y0; buf[base + q] = cmul(y1, twid(tw, invN)); buf[base + 2 * q] = cmul(y2, twid(2 * tw, invN)); buf[base + 3 * q] = cmul(y3, twid(3 * tw, invN));
        }
        __syncthreads();
    }
}
DEV void fft_inv(cf2* buf, int S, int g, int G) {
    const int N = 1 << (2 * S); const float invN = 1.f / (float)N;
    for (int s = S - 1; s >= 0; --s) {
        const int lm = 2 * (S - s), m = 1 << lm, q = m >> 2;
        for (int bf = g; bf < (N >> 2); bf += G) {
            const int j = bf & (q - 1), base = ((bf >> (lm - 2)) << lm) + j;
            const int tw = j << (2 * s);
            cf2 w1 = twid(tw, invN), w2 = twid(2 * tw, invN), w3 = twid(3 * tw, invN); w1.y = -w1.y; w2.y = -w2.y; w3.y = -w3.y;
            const cf2 c0 = buf[base], c1 = cmul(buf[base + q], w1), c2 = cmul(buf[base + 2 * q], w2), c3 = cmul(buf[base + 3 * q], w3);
            cf2 t0, t1, t2, t3; t0.x = c0.x + c2.x; t0.y = c0.y + c2.y; t1.x = c0.x - c2.x; t1.y = c0.y - c2.y; t2.x = c1.x + c3.x; t2.y = c1.y + c3.y;
            const float dx = c1.x - c3.x, dy = c1.y - c3.y; t3.x = -dy; t3.y = dx;
            cf2 a0, a1, a2, a3; a0.x = t0.x + t2.x; a0.y = t0.y + t2.y; a1.x = t1.x + t3.x; a1.y = t1.y + t3.y; a2.x = t0.x - t2.x; a2.y = t0.y - t2.y; a3.x = t1.x - t3.x; a3.y = t1.y - t3.y;
            buf[base] = a0; buf[base + q] = a1; buf[base + 2 * q] = a2; buf[base + 3 * q] = a3;
        }
        __syncthreads();
    }
}
DEV void hf_item(const Params& p, int set, int pi, unsigned char* smem) {
    const int Ls = set ? LC : L, S = set ? FS_CTX : FS_LAT, N = 1 << (2 * S);
    const int gi = tidx() >> 8, g = tidx() & 255, idx = pi * 2 + gi, o = idx >> 9, c = idx & 511;
    cf2* buf = (cf2*)smem + (size_t)gi * N;
    const float* hraw = (const float*)(p.ws + WS_F + (set ? F_HRAW_CTX : F_HRAW_LAT));
    const float* hyn = (const float*)(p.ws + WS_F + (set ? F_HYP_CTX : F_HYP_LAT));
    float nsum = 0.f;
    for (int ch = 0; ch < Ls / 64; ++ch) nsum += hyn[(size_t)ch * 2048 + o * 1024 + c] + hyn[(size_t)ch * 2048 + o * 1024 + 512 + c];
    const float inv = 1.f / nsum;
    const float* hf = hraw + (size_t)(o * 1024 + c) * Ls; const float* hb = hraw + (size_t)(o * 1024 + 512 + c) * Ls;
    for (int k = g; k < N; k += 256) { float re = 0.f; if (k < Ls) re = hf[k] * inv; else if (k > N - Ls) re = hb[N - k] * inv; cf2 v; v.x = re; v.y = 0.f; buf[k] = v; }
    __syncthreads();
    fft_fwd(buf, S, g, 256);
    cf2* HF = (cf2*)(p.ws + WS_F + (set ? F_HF_CTX : F_HF_LAT)) + (size_t)(o * 512 + c) * N;
    for (int k = g; k < N; k += 256) HF[k] = buf[k];
    __syncthreads();
}
constexpr int P1_NORM = T / 8, P1_HF = 512;
DEV void phase1(const Params& p, unsigned char* smem) {
    const int total = P1_NORM + 2 * P1_HF;
    for (int it = blockIdx.x; it < total; it += gridDim.x) {
        if (it < P1_NORM) norm_rows_item(p, it, 1, p.in[I_N1G], 0, 0);
        else if (it < P1_NORM + P1_HF) hf_item(p, 0, it - P1_NORM, smem);
        else hf_item(p, 1, it - P1_NORM - P1_HF, smem);
    }
}

constexpr int G_LDA = 72;
template <class Epi>
DEV void gemm_tile(const bf16_t* __restrict__ A, const bf16_t* __restrict__ Wt, int m0, int n0, unsigned char* smem, const Epi& epi) {
    bf16_t* As = (bf16_t*)smem;
    bf16_t* Bs = As + 2 * 256 * G_LDA;
    const int tid = tidx(), lane = tid & 63, w = tid >> 6, wm = w >> 1, wn = w & 1;
    f32x16 acc[2][2];
#pragma unroll
    for (int i = 0; i < 2; ++i)
#pragma unroll
        for (int j = 0; j < 2; ++j)
#pragma unroll
            for (int r = 0; r < 16; ++r) acc[i][j][r] = 0.f;
    u32x4 ra[4], rb[2];
    const bf16_t* Ag = A + (size_t)m0 * 1024; const bf16_t* Bg = Wt + (size_t)n0 * 1024;
#define GLOAD(k0) do { \
        _Pragma("unroll") for (int i = 0; i < 4; ++i) { const int id = tid + NT * i, row = id >> 3, kc = id & 7; ra[i] = *(const u32x4*)(Ag + (size_t)row * 1024 + (k0) + kc * 8); } \
        _Pragma("unroll") for (int i = 0; i < 2; ++i) { const int id = tid + NT * i, row = id >> 3, kc = id & 7; rb[i] = *(const u32x4*)(Bg + (size_t)row * 1024 + (k0) + kc * 8); } } while (0)
#define LSTORE(buf_) do { \
        _Pragma("unroll") for (int i = 0; i < 4; ++i) { const int id = tid + NT * i, row = id >> 3, kc = id & 7; *(u32x4*)(As + ((buf_) * 256 + row) * G_LDA + kc * 8) = ra[i]; } \
        _Pragma("unroll") for (int i = 0; i < 2; ++i) { const int id = tid + NT * i, row = id >> 3, kc = id & 7; *(u32x4*)(Bs + ((buf_) * 128 + row) * G_LDA + kc * 8) = rb[i]; } } while (0)
    GLOAD(0); LSTORE(0); __syncthreads();
    for (int kt = 0; kt < 16; ++kt) {
        const int buf = kt & 1;
        if (kt + 1 < 16) GLOAD((kt + 1) * 64);
        const bf16_t* as = As + (buf * 256 + wm * 64 + (lane & 31)) * G_LDA + 8 * (lane >> 5);
        const bf16_t* bs = Bs + (buf * 128 + wn * 64 + (lane & 31)) * G_LDA + 8 * (lane >> 5);
#pragma unroll
        for (int kk = 0; kk < 4; ++kk) {
            const bf16x8 a0 = *(const bf16x8*)(as + kk * 16), a1 = *(const bf16x8*)(as + 32 * G_LDA + kk * 16);
            const bf16x8 b0 = *(const bf16x8*)(bs + kk * 16), b1 = *(const bf16x8*)(bs + 32 * G_LDA + kk * 16);
            acc[0][0] = __builtin_amdgcn_mfma_f32_32x32x16_bf16(a0, b0, acc[0][0], 0, 0, 0);
            acc[0][1] = __builtin_amdgcn_mfma_f32_32x32x16_bf16(a0, b1, acc[0][1], 0, 0, 0);
            acc[1][0] = __builtin_amdgcn_mfma_f32_32x32x16_bf16(a1, b0, acc[1][0], 0, 0, 0);
            acc[1][1] = __builtin_amdgcn_mfma_f32_32x32x16_bf16(a1, b1, acc[1][1], 0, 0, 0);
        }
        if (kt + 1 < 16) LSTORE(buf ^ 1);
        __syncthreads();
    }
#pragma unroll
    for (int mi = 0; mi < 2; ++mi)
#pragma unroll
        for (int ni = 0; ni < 2; ++ni)
#pragma unroll
            for (int rg = 0; rg < 4; ++rg) {
                const int row = m0 + wm * 64 + mi * 32 + 8 * rg + 4 * (lane >> 5), col = n0 + wn * 64 + ni * 32 + (lane & 31);
                epi(row, col, acc[mi][ni][rg * 4 + 0], acc[mi][ni][rg * 4 + 1], acc[mi][ni][rg * 4 + 2], acc[mi][ni][rg * 4 + 3]);
            }
}
struct EpiL0In {
    unsigned char* ws;
    DEV void operator()(int row, int col, float v0, float v1, float v2, float v3) const {
        u32x2 o; o[0] = pk2(v0, v1); o[1] = pk2(v2, v3);
        const bool lat = row < TL; const int b = lat ? row / L : (row - TL) / LC, t = lat ? row - b * L : (row - TL) - b * LC, Lx = lat ? L : LC;
        if (col < 1536) { bf16_t* d = (bf16_t*)(ws + WS_P + (lat ? P_HYT_LAT : P_HYT_CTX)) + ((size_t)b * 1536 + col) * Lx + t; *(u32x2*)d = o; }
        else if (col < 2048) { bf16_t* d = (bf16_t*)(ws + WS_P + P_Q0) + (size_t)row * 512 + (col - 1536); d[0] = (bf16_t)f2bf(v0); d[512] = (bf16_t)f2bf(v1); d[1024] = (bf16_t)f2bf(v2); d[1536] = (bf16_t)f2bf(v3); }
        else if (col < 2176) { bf16_t* d = (bf16_t*)(ws + WS_P + P_K0) + (size_t)row * 128 + (col - 2048); d[0] = (bf16_t)f2bf(v0); d[128] = (bf16_t)f2bf(v1); d[256] = (bf16_t)f2bf(v2); d[384] = (bf16_t)f2bf(v3); }
        else { bf16_t* d = (bf16_t*)(ws + WS_P + (lat ? P_VT_LAT : P_VT_CTX)) + ((size_t)b * 128 + (col - 2176)) * Lx + t; *(u32x2*)d = o; }
    }
};
struct EpiBf16 {
    bf16_t* out; int ld;
    DEV void operator()(int row, int col, float v0, float v1, float v2, float v3) const {
        bf16_t* d = out + (size_t)row * ld + col; d[0] = (bf16_t)f2bf(v0); d[ld] = (bf16_t)f2bf(v1); d[2 * ld] = (bf16_t)f2bf(v2); d[3 * ld] = (bf16_t)f2bf(v3);
    }
};
struct EpiHg {
    bf16_t* out; const float* lg;
    DEV void operator()(int row, int col, float v0, float v1, float v2, float v3) const {
        float vv[4] = {v0, v1, v2, v3};
        if (col < 1024 || col >= 4096) {
#pragma unroll
            for (int i = 0; i < 4; ++i) vv[i] = silu_f(vv[i]);
        } else if (col < 3072) {
            const int c = col - 1024;
            const float oml = 1.f - 1.f / (1.f + __expf(lg[c] - lg[2048 + c]));
#pragma unroll
            for (int i = 0; i < 4; ++i) vv[i] = oml / (1.f + __expf(vv[i]));
        }
        bf16_t* d = out + (size_t)row * 5120 + col; d[0] = (bf16_t)f2bf(vv[0]); d[5120] = (bf16_t)f2bf(vv[1]); d[2 * 5120] = (bf16_t)f2bf(vv[2]); d[3 * 5120] = (bf16_t)f2bf(vv[3]);
    }
};
struct EpiRes {
    const Params* p; int from_inputs, layer, goff;
    DEV void operator()(int row, int col, float v0, float v1, float v2, float v3) const {
        const float vv[4] = {v0, v1, v2, v3};
        float* H = (float*)(p->ws + WS_H);
        const float* mod = (const float*)(p->ws + WS_MOD) + (size_t)layer * NR * 6144 + goff + col;
#pragma unroll
        for (int i = 0; i < 4; ++i) { const int r = row + i; H[(size_t)r * 1024 + col] = h_row(*p, from_inputs, r)[col] + mod[(size_t)mod_row(r) * 6144] * vv[i]; }
    }
};

DEV float hy_u(const bf16_t* row, int t, int Lx, float w0, float w1, float w2, float b) {
    const float xm = t > 0 ? bf2f(row[t - 1]) : 0.f, x0 = bf2f(row[t]), xp = t + 1 < Lx ? bf2f(row[t + 1]) : 0.f;
    return w0 * xm + w1 * x0 + w2 * xp + b;
}
DEV void hyena_item(const Params& p, int set, int item, unsigned char* smem) {
    const int Ls = set ? LC : L, S = set ? FS_CTX : FS_LAT, N = 1 << (2 * S);
    const int gi = tidx() >> 8, g = tidx() & 255;
    const int bp = item >> 8, c = (item & 255) * 2 + gi, ba = bp * 2, bb = ba + 1;
    cf2* buf = (cf2*)smem + (size_t)gi * N;
    cf2* zk = (cf2*)smem + (size_t)2 * N + (size_t)gi * Ls;
    const bf16_t* hy = (const bf16_t*)(p.ws + WS_P + (set ? P_HYT_CTX : P_HYT_LAT));
    const float* cw = p.in[I_HYCW]; const float* cb = p.in[I_HYCB];
    const cf2* HF = (const cf2*)(p.ws + WS_F + (set ? F_HF_CTX : F_HF_LAT));
    const float invN = 1.f / (float)N;
    {
        const float w0 = cw[c], w1 = cw[1536 + c], w2 = cw[3072 + c], b = cb[c];
        const bf16_t* ra = hy + ((size_t)ba * 1536 + c) * Ls; const bf16_t* rb = hy + ((size_t)bb * 1536 + c) * Ls;
        for (int t = g; t < N; t += 256) { cf2 v; v.x = 0.f; v.y = 0.f; if (t < Ls) { v.x = hy_u(ra, t, Ls, w0, w1, w2, b); v.y = hy_u(rb, t, Ls, w0, w1, w2, b); zk[t] = v; } buf[t] = v; }
    }
    __syncthreads();
    for (int n = 0; n < 2; ++n) {
        fft_fwd(buf, S, g, 256);
        const cf2* hf = HF + (size_t)(n * 512 + c) * N;
        for (int k = g; k < N; k += 256) buf[k] = cmul(buf[k], hf[k]);
        __syncthreads();
        fft_inv(buf, S, g, 256);
        const int gc = (n + 1) * 512 + c;
        const float w0 = cw[gc], w1 = cw[1536 + gc], w2 = cw[3072 + gc], b = cb[gc], dsk = p.in[I_HYSKIP][n * 512 + c];
        const bf16_t* ra = hy + ((size_t)ba * 1536 + gc) * Ls; const bf16_t* rb = hy + ((size_t)bb * 1536 + gc) * Ls;
        bf16_t* M = (bf16_t*)(p.ws + WS_M);
        for (int t = g; t < N; t += 256) {
            cf2 v; v.x = 0.f; v.y = 0.f;
            if (t < Ls) {
                const cf2 cv = buf[t], zo = zk[t];
                v.x = hy_u(ra, t, Ls, w0, w1, w2, b) * (cv.x * invN + dsk * zo.x); v.y = hy_u(rb, t, Ls, w0, w1, w2, b) * (cv.y * invN + dsk * zo.y);
                if (n == 0) zk[t] = v;
                else { const size_t ta = set ? (size_t)TL + (size_t)ba * LC + t : (size_t)ba * L + t, tb = set ? (size_t)TL + (size_t)bb * LC + t : (size_t)bb * L + t;
                       M[ta * 1024 + c] = (bf16_t)f2bf(v.x); M[tb * 1024 + c] = (bf16_t)f2bf(v.y); }
            }
            if (n == 0) buf[t] = v;
        }
        __syncthreads();
    }
}
DEV void rope_store(const bf16_t* src, bf16_t* dst, int pos, bool rope, float scale, int ph, int sub) {
    const u32x4 ua = *(const u32x4*)(src + ph * 32 + sub * 8), ub = *(const u32x4*)(src + ph * 32 + 16 + sub * 8);
    float a[8], b[8];
#pragma unroll
    for (int i = 0; i < 4; ++i) { a[2 * i] = bflo(ua[i]); a[2 * i + 1] = bfhi(ua[i]); b[2 * i] = bflo(ub[i]); b[2 * i + 1] = bfhi(ub[i]); }
    if (rope) {
        const float pv = (float)(ph == 0 ? pos / 64 : pos % 64);
#pragma unroll
        for (int e = 0; e < 8; ++e) {
            const float inv = exp2f(-(float)(sub * 8 + e) * (13.287712379549449f / 16.f));
            const float ang = pv * inv, cs = __cosf(ang), sn = __sinf(ang);
            const float na = a[e] * cs - b[e] * sn, nb = b[e] * cs + a[e] * sn; a[e] = na; b[e] = nb;
        }
    }
    u32x4 oa, ob;
#pragma unroll
    for (int i = 0; i < 4; ++i) { oa[i] = pk2(a[2 * i] * scale, a[2 * i + 1] * scale); ob[i] = pk2(b[2 * i] * scale, b[2 * i + 1] * scale); }
    *(u32x4*)(dst + ph * 32 + sub * 8) = oa; *(u32x4*)(dst + ph * 32 + 16 + sub * 8) = ob;
}
constexpr int A_LDQ = 72, A_LDV = 136;
DEV void attn_item(const Params& p, int set, int item, unsigned char* smem) {
    bf16_t* Qs = (bf16_t*)smem;
    bf16_t* Ks = Qs + 128 * A_LDQ;
    bf16_t* Vt = Ks + 128 * A_LDQ;
    const int tid = tidx(), lane = tid & 63, w = tid >> 6, l15 = lane & 15, lg = lane >> 4;
    const int nqb = set ? LC / 128 : L / 128;
    const int h = item & 7, qb = (item >> 3) % nqb, b = (item >> 3) / nqb, kvh = h >> 2;
    const bf16_t* Q0 = (const bf16_t*)(p.ws + WS_P + P_Q0); const bf16_t* K0 = (const bf16_t*)(p.ws + WS_P + P_K0);
    const int qtok0 = set ? TL + b * LC + qb * 128 : b * L + qb * 128;
    { const int row = tid >> 2, ph = (tid >> 1) & 1, sub = tid & 1;
      rope_store(Q0 + (size_t)(qtok0 + row) * 512 + h * 64, Qs + row * A_LDQ, qb * 128 + row, set == 0, 0.125f, ph, sub); }
    __syncthreads();
    bf16x8 qf[2];
    qf[0] = *(const bf16x8*)(Qs + (w * 16 + l15) * A_LDQ + 8 * lg); qf[1] = *(const bf16x8*)(Qs + (w * 16 + l15) * A_LDQ + 32 + 8 * lg);
    float m_run = p.in[I_SINK][h], l_run = 1.f;
    f32x4 O[4];
#pragma unroll
    for (int i = 0; i < 4; ++i) O[i] = (f32x4){0.f, 0.f, 0.f, 0.f};
    const int nwin = set ? 0 : 3, nctx = LC / 128;
    for (int kbi = 0; kbi < nwin + nctx; ++kbi) {
        const bool win = kbi < nwin; const int kb = win ? qb - 1 + kbi : kbi - nwin;
        if (win && (kb < 0 || kb >= L / 128)) continue;
        const int ktok0 = win ? b * L + kb * 128 : TL + b * LC + kb * 128;
        __syncthreads();
        { const int row = tid >> 2, ph = (tid >> 1) & 1, sub = tid & 1;
          rope_store(K0 + (size_t)(ktok0 + row) * 128 + kvh * 64, Ks + row * A_LDQ, kb * 128 + row, win, 1.f, ph, sub); }
        { const bf16_t* vt = (const bf16_t*)(p.ws + WS_P + (win ? P_VT_LAT : P_VT_CTX)); const int Lx = win ? L : LC;
#pragma unroll
          for (int i = 0; i < 2; ++i) { const int id = tid + NT * i, d = id >> 4, kc = id & 15;
              *(u32x4*)(Vt + d * A_LDV + kc * 8) = *(const u32x4*)(vt + ((size_t)b * 128 + kvh * 64 + d) * Lx + kb * 128 + kc * 8); } }
        __syncthreads();
#pragma unroll
        for (int ch = 0; ch < 2; ++ch) {
            f32x4 st[4];
#pragma unroll
            for (int u = 0; u < 4; ++u) {
                const bf16_t* kr = Ks + ((ch * 4 + u) * 16 + l15) * A_LDQ + 8 * lg;
                f32x4 z = (f32x4){0.f, 0.f, 0.f, 0.f};
                z = __builtin_amdgcn_mfma_f32_16x16x32_bf16(*(const bf16x8*)kr, qf[0], z, 0, 0, 0);
                z = __builtin_amdgcn_mfma_f32_16x16x32_bf16(*(const bf16x8*)(kr + 32), qf[1], z, 0, 0, 0);
                st[u] = z;
            }
            float cmax = -INFINITY;
            if (win) {
                const int qpos = qb * 128 + w * 16 + l15;
#pragma unroll
                for (int u = 0; u < 4; ++u)
#pragma unroll
                    for (int r = 0; r < 4; ++r) { const int kpos = kb * 128 + (ch * 4 + u) * 16 + 4 * lg + r; const int dd = qpos - kpos; if (dd > 128 || dd < -128) st[u][r] = -INFINITY; }
            }
#pragma unroll
            for (int u = 0; u < 4; ++u)
#pragma unroll
                for (int r = 0; r < 4; ++r) cmax = fmaxf(cmax, st[u][r]);
            cmax = fmaxf(cmax, __shfl_xor(cmax, 16)); cmax = fmaxf(cmax, __shfl_xor(cmax, 32));
            const float m_new = fmaxf(m_run, cmax), alpha = __expf(m_run - m_new);
            float ls = 0.f;
#pragma unroll
            for (int u = 0; u < 4; ++u)
#pragma unroll
                for (int r = 0; r < 4; ++r) { const float e = __expf(st[u][r] - m_new); st[u][r] = e; ls += e; }
            ls += __shfl_xor(ls, 16); ls += __shfl_xor(ls, 32);
            l_run = l_run * alpha + ls; m_run = m_new;
#pragma unroll
            for (int i = 0; i < 4; ++i) { O[i][0] *= alpha; O[i][1] *= alpha; O[i][2] *= alpha; O[i][3] *= alpha; }
#pragma unroll
            for (int ss = 0; ss < 2; ++ss) {
                u32x4 pu; pu[0] = pk2(st[2 * ss][0], st[2 * ss][1]); pu[1] = pk2(st[2 * ss][2], st[2 * ss][3]); pu[2] = pk2(st[2 * ss + 1][0], st[2 * ss + 1][1]); pu[3] = pk2(st[2 * ss + 1][2], st[2 * ss + 1][3]);
                const bf16x8 pf = __builtin_bit_cast(bf16x8, pu);
                const int key0 = (ch * 4 + 2 * ss) * 16 + 4 * lg;
#pragma unroll
                for (int dt = 0; dt < 4; ++dt) {
                    const bf16_t* vr = Vt + (dt * 16 + l15) * A_LDV + key0;
                    u32x4 vu; const u32x2 v0 = *(const u32x2*)vr, v1 = *(const u32x2*)(vr + 16); vu[0] = v0[0]; vu[1] = v0[1]; vu[2] = v1[0]; vu[3] = v1[1];
                    O[dt] = __builtin_amdgcn_mfma_f32_16x16x32_bf16(__builtin_bit_cast(bf16x8, vu), pf, O[dt], 0, 0, 0);
                }
            }
        }
    }
    const float il = 1.f / l_run;
    bf16_t* M = (bf16_t*)(p.ws + WS_M) + (size_t)(qtok0 + w * 16 + l15) * 1024 + 512 + h * 64;
#pragma unroll
    for (int dt = 0; dt < 4; ++dt) { u32x2 o; o[0] = pk2(O[dt][0] * il, O[dt][1] * il); o[1] = pk2(O[dt][2] * il, O[dt][3] * il); *(u32x2*)(M + dt * 16 + 4 * lg) = o; }
    __syncthreads();
}
constexpr int P3_HY_LAT = (NB / 2) * 256, P3_HY_CTX = (NB / 2) * 256, P3_AT_LAT = NB * (L / 128) * 8, P3_AT_CTX = NB * (LC / 128) * 8;
DEV void phase3(const Params& p, unsigned char* smem) {
    const int total = P3_HY_LAT + P3_AT_LAT + P3_HY_CTX + P3_AT_CTX;
    for (int it = blockIdx.x; it < total; it += gridDim.x) {
        int i = it;
        if (i < P3_HY_LAT) { hyena_item(p, 0, i, smem); continue; } i -= P3_HY_LAT;
        if (i < P3_AT_LAT) { attn_item(p, 0, i, smem); continue; } i -= P3_AT_LAT;
        if (i < P3_HY_CTX) { hyena_item(p, 1, i, smem); continue; } i -= P3_HY_CTX;
        attn_item(p, 1, i, smem);
    }
}

constexpr int K_LDK = 136, K_LDS = 129, K_LDC = 52;
DEV unsigned fkey(float f) { const unsigned u = __builtin_bit_cast(unsigned, f); return (u & 0x80000000u) ? ~u : (u | 0x80000000u); }
constexpr int cand_off(int i) { int o = 0; for (int k = 0; k < i; ++k) o += 16 / (k + 1); return o; }
DEV void topk_load_keys(const Params& p, int layer, int h, unsigned char* smem) {
    bf16_t* Ks = (bf16_t*)smem;
    const bf16_t* keys = (const bf16_t*)(p.ws + WS_W + W_KEYS) + (size_t)layer * 262144 + (size_t)h * 32768;
    const int tid = tidx();
#pragma unroll
    for (int i = 0; i < 8; ++i) { const int id = tid + NT * i, row = id >> 4, kc = id & 15; *(u32x4*)(Ks + row * K_LDK + kc * 8) = *(const u32x4*)(keys + (size_t)row * 128 + kc * 8); }
    __syncthreads();
}
DEV void topk_item(const Params& p, int h, int tok0, unsigned char* smem) {
    bf16_t* Ks = (bf16_t*)smem;
    float* Sc = (float*)(Ks + 2 * 128 * K_LDK);
    float* s12 = Sc + 64 * K_LDS;
    int* i12 = (int*)(s12 + 64 * 32);
    unsigned* ck = (unsigned*)(i12 + 64 * 32);
    float* tops = (float*)(ck + 64 * K_LDC);
    int* topi = (int*)(tops + 64 * 16);
    const int tid = tidx(), lane = tid & 63, w = tid >> 6;
    const bf16_t* PQ = (const bf16_t*)(p.ws + WS_P);
    for (int part = 0; part < 2; ++part) {
        { const int mi = w >> 2, ni = w & 3;
          f32x16 acc;
#pragma unroll
          for (int r = 0; r < 16; ++r) acc[r] = 0.f;
          const bf16_t* ag = PQ + (size_t)(tok0 + mi * 32 + (lane & 31)) * 2048 + h * 256 + part * 128 + 8 * (lane >> 5);
          const bf16_t* bs = Ks + (part * 128 + ni * 32 + (lane & 31)) * K_LDK + 8 * (lane >> 5);
          bf16x8 af[8];
#pragma unroll
          for (int kk = 0; kk < 8; ++kk) af[kk] = *(const bf16x8*)(ag + kk * 16);
#pragma unroll
          for (int kk = 0; kk < 8; ++kk) acc = __builtin_amdgcn_mfma_f32_32x32x16_bf16(af[kk], *(const bf16x8*)(bs + kk * 16), acc, 0, 0, 0);
#pragma unroll
          for (int r = 0; r < 16; ++r) Sc[(mi * 32 + (r & 3) + 8 * (r >> 2) + 4 * (lane >> 5)) * K_LDS + ni * 32 + (lane & 31)] = acc[r]; }
        __syncthreads();
        const int row = tid >> 3, n0 = (tid & 7) * 16;
        float mine[16]; unsigned mk[16], rank[16];
#pragma unroll
        for (int i = 0; i < 16; ++i) { mine[i] = Sc[row * K_LDS + n0 + i]; mk[i] = (fkey(mine[i]) & ~127u) | (unsigned)(127 - (n0 + i)); rank[i] = 0u; }
        __syncthreads();
        unsigned* Sk = (unsigned*)Sc;
#pragma unroll
        for (int i = 0; i < 16; ++i) Sk[row * K_LDS + n0 + i] = mk[i];
        __syncthreads();
#pragma unroll 4
        for (int mm = 0; mm < 128; ++mm) {
            const unsigned o = Sk[row * K_LDS + mm];
#pragma unroll
            for (int i = 0; i < 16; ++i) rank[i] += (o > mk[i]) ? 1u : 0u;
        }
#pragma unroll
        for (int i = 0; i < 16; ++i) if (rank[i] < 16u) { s12[(row * 2 + part) * 16 + rank[i]] = mine[i]; i12[(row * 2 + part) * 16 + rank[i]] = n0 + i; }
        __syncthreads();
    }
    {
        const int row = tid >> 3, sub = tid & 7;
        const float* s1 = s12 + row * 32; const float* s2 = s1 + 16;
        float cval[7]; unsigned ckey[7]; int cidx[7];
#pragma unroll
        for (int m = 0; m < 7; ++m) {
            const int cc = sub + 8 * m; int ci = 0, off = 0;
#pragma unroll
            for (int i = 0; i < 15; ++i) { const bool ge = cc >= cand_off(i + 1); ci += ge ? 1 : 0; off += ge ? 16 / (i + 1) : 0; }
            const int cj = cc - off;
            if (cc < 50) { cval[m] = s1[ci] + s2[cj]; ckey[m] = (fkey(cval[m]) & ~255u) | (unsigned)(255 - (ci * 16 + cj)); cidx[m] = i12[row * 32 + ci] * 128 + i12[row * 32 + 16 + cj]; ck[row * K_LDC + cc] = ckey[m]; }
            else { cval[m] = 0.f; ckey[m] = 0u; cidx[m] = 0; }
        }
        __syncthreads();
        unsigned rk[7];
#pragma unroll
        for (int m = 0; m < 7; ++m) rk[m] = 0u;
        for (int o = 0; o < 50; ++o) {
            const unsigned ko = ck[row * K_LDC + o];
#pragma unroll
            for (int m = 0; m < 7; ++m) rk[m] += (ko > ckey[m]) ? 1u : 0u;
        }
#pragma unroll
        for (int m = 0; m < 7; ++m) if (sub + 8 * m < 50 && rk[m] < 16u) { tops[row * 16 + rk[m]] = cval[m]; topi[row * 16 + rk[m]] = cidx[m]; }
    }
    __syncthreads();
    {
        const int row = tid >> 3, sub = tid & 7;
        const float a = tops[row * 16 + 2 * sub], b = tops[row * 16 + 2 * sub + 1];
        float mx = fmaxf(a, b); mx = fmaxf(mx, __shfl_xor(mx, 1)); mx = fmaxf(mx, __shfl_xor(mx, 2)); mx = fmaxf(mx, __shfl_xor(mx, 4));
        const float ea = __expf(a - mx), eb = __expf(b - mx);
        float sm = ea + eb; sm += __shfl_xor(sm, 1); sm += __shfl_xor(sm, 2); sm += __shfl_xor(sm, 4);
        const float inv = 1.f / sm;
        int* IDX = (int*)(p.ws + WS_IDX) + (size_t)(tok0 + row) * 128 + h * 16 + 2 * sub; float* GT = (float*)(p.ws + WS_GATE) + (size_t)(tok0 + row) * 128 + h * 16 + 2 * sub;
        IDX[0] = topi[row * 16 + 2 * sub]; IDX[1] = topi[row * 16 + 2 * sub + 1]; GT[0] = ea * inv; GT[1] = eb * inv;
    }
    __syncthreads();
}
DEV void topk_phase(const Params& p, int layer, int ntok, unsigned char* smem) {
    const int G = gridDim.x, bid = blockIdx.x, h = bid & 7;
    const int nt = ntok / 64;
    if ((G & 7) == 0) {
        if ((bid >> 3) < nt) topk_load_keys(p, layer, h, smem);
        for (int tt = bid >> 3; tt < nt; tt += (G >> 3)) topk_item(p, h, tt * 64, smem);
    } else {
        for (int it = bid; it < nt * 8; it += G) { __syncthreads(); topk_load_keys(p, layer, it & 7, smem); topk_item(p, it & 7, (it >> 3) * 64, smem); }
    }
}

DEV float gelu_f(float x) { return 0.5f * x * (1.f + erff(x * 0.70710678118654752f)); }
DEV void peer_item(const Params& p, int layer, int item) {
    const int tok = item * 8 + (tidx() >> 6), lane = tidx() & 63;
    const bf16_t* A = (const bf16_t*)(p.ws + WS_A) + (size_t)tok * 1024 + lane * 16;
    const bf16_t* UB = (const bf16_t*)(p.ws + WS_UB) + lane * 16; const bf16_t* VB = (const bf16_t*)(p.ws + WS_VB) + lane * 16;
    float x[16], y[16];
    { const u32x4 a0 = *(const u32x4*)A, a1 = *(const u32x4*)(A + 8);
#pragma unroll
      for (int i = 0; i < 4; ++i) { x[2 * i] = bflo(a0[i]); x[2 * i + 1] = bfhi(a0[i]); x[8 + 2 * i] = bflo(a1[i]); x[8 + 2 * i + 1] = bfhi(a1[i]); } }
#pragma unroll
    for (int i = 0; i < 16; ++i) y[i] = 0.f;
    const int* IDX = (const int*)(p.ws + WS_IDX) + (size_t)tok * 128; const float* GT = (const float*)(p.ws + WS_GATE) + (size_t)tok * 128;
    const int i_lo = IDX[lane], i_hi = IDX[64 + lane]; const float g_lo = GT[lane], g_hi = GT[64 + lane];
    for (int k = 0; k < 128; ++k) {
        const int e = __shfl(k < 64 ? i_lo : i_hi, k & 63); const float gt = __shfl(k < 64 ? g_lo : g_hi, k & 63);
        const u32x4 u0 = *(const u32x4*)(UB + (size_t)e * 1024), u1 = *(const u32x4*)(UB + (size_t)e * 1024 + 8);
        const u32x4 v0 = *(const u32x4*)(VB + (size_t)e * 1024), v1 = *(const u32x4*)(VB + (size_t)e * 1024 + 8);
        float d = 0.f;
#pragma unroll
        for (int i = 0; i < 4; ++i) { d += bflo(u0[i]) * x[2 * i] + bfhi(u0[i]) * x[2 * i + 1] + bflo(u1[i]) * x[8 + 2 * i] + bfhi(u1[i]) * x[8 + 2 * i + 1]; }
        d = wave_sum(d);
        const float act = gelu_f(d) * gt;
#pragma unroll
        for (int i = 0; i < 4; ++i) { y[2 * i] += act * bflo(v0[i]); y[2 * i + 1] += act * bfhi(v0[i]); y[8 + 2 * i] += act * bflo(v1[i]); y[8 + 2 * i + 1] += act * bfhi(v1[i]); }
    }
    float* H = (float*)(p.ws + WS_H) + (size_t)tok * 1024 + lane * 16;
    const float* g2 = (const float*)(p.ws + WS_MOD) + ((size_t)layer * NR + mod_row(tok)) * 6144 + 5120 + lane * 16;
    float hv[16]; float ss = 0.f;
#pragma unroll
    for (int i = 0; i < 4; ++i) { const f32x4 hh = *(const f32x4*)(H + 4 * i), gg = *(const f32x4*)(g2 + 4 * i);
#pragma unroll
        for (int j = 0; j < 4; ++j) { const float v = hh[j] + gg[j] * y[4 * i + j]; hv[4 * i + j] = v; ss += v * v; } }
    ss = wave_sum(ss);
    const float rstd = rsqrtf(ss * (1.f / 1024.f) + 1e-6f);
    if (layer == 0) {
#pragma unroll
        for (int i = 0; i < 4; ++i) { f32x4 o; o[0] = hv[4 * i]; o[1] = hv[4 * i + 1]; o[2] = hv[4 * i + 2]; o[3] = hv[4 * i + 3]; *(f32x4*)(H + 4 * i) = o; }
        const float* g = p.in[I_N1G] + 1024 + lane * 16;
        const float* mod = (const float*)(p.ws + WS_MOD) + ((size_t)1 * NR + mod_row(tok)) * 6144 + lane * 16;
        bf16_t* Ao = (bf16_t*)(p.ws + WS_A) + (size_t)tok * 1024 + lane * 16;
        u32x4 o0, o1; float r[16];
#pragma unroll
        for (int i = 0; i < 16; ++i) r[i] = hv[i] * rstd * g[i] * (1.f + mod[1024 + i]) + mod[i];
#pragma unroll
        for (int i = 0; i < 4; ++i) { o0[i] = pk2(r[2 * i], r[2 * i + 1]); o1[i] = pk2(r[8 + 2 * i], r[8 + 2 * i + 1]); }
        *(u32x4*)Ao = o0; *(u32x4*)(Ao + 8) = o1;
    } else {
        const float* g = p.in[I_FG] + lane * 16; float* out = p.out + (size_t)tok * 1024 + lane * 16;
#pragma unroll
        for (int i = 0; i < 4; ++i) { f32x4 o; o[0] = hv[4 * i] * rstd * g[4 * i]; o[1] = hv[4 * i + 1] * rstd * g[4 * i + 1]; o[2] = hv[4 * i + 2] * rstd * g[4 * i + 2]; o[3] = hv[4 * i + 3] * rstd * g[4 * i + 3]; *(f32x4*)(out + 4 * i) = o; }
    }
}

constexpr int SC_CH = 64, SC_KB = SC_CH * 128 * 2, SC_VB = SC_CH * 64 * 2, SC_BUF = 2 * SC_KB + SC_VB, SC_OB = SC_CH * 64 * 2;
DEV void scan_block(const Params& p, int bi, unsigned char* smem) {
    const int tid = tidx(), lane = tid & 63, w = tid >> 6, vq = lane & 3, kg = lane >> 2;
    const int half = bi & 1, dir = (bi >> 1) & 1, h = (bi >> 2) & 7, b = bi >> 5;
    const bf16_t* P1 = (const bf16_t*)(p.ws + WS_P);
    bf16_t* Oo = (bf16_t*)(p.ws + WS_F + (dir ? F_OB : F_OF));
    const int NCH = (LC + L) / SC_CH;
    float S[8][2];
#pragma unroll
    for (int i = 0; i < 8; ++i) { S[i][0] = 0.f; S[i][1] = 0.f; }
    u32x4 rk[2], rq[2], rv;
    const int kcol = 1024 * (1 + dir) + h * 128, qcol = h * 128, vcol = 3072 + h * 128 + half * 64;
#define SC_TOK(step) ((step) < LC ? TL + b * LC + (dir ? LC - 1 - (step) : (step)) : b * L + (dir ? L - 1 - ((step) - LC) : ((step) - LC)))
#define SC_LOAD(c) do { const bool lat_ = (c) * SC_CH >= LC; \
        _Pragma("unroll") for (int i = 0; i < 2; ++i) { const int id = tid + NT * i, r = id >> 4, cc = id & 15; const bf16_t* row = P1 + (size_t)SC_TOK((c) * SC_CH + r) * 5120; \
            rk[i] = *(const u32x4*)(row + kcol + cc * 8); if (lat_) rq[i] = *(const u32x4*)(row + qcol + cc * 8); } \
        { const int r = tid >> 3, cc = tid & 7; rv = *(const u32x4*)(P1 + (size_t)SC_TOK((c) * SC_CH + r) * 5120 + vcol + cc * 8); } } while (0)
#define SC_STORE(buf) do { unsigned char* base_ = smem + (buf) * SC_BUF; \
        _Pragma("unroll") for (int i = 0; i < 2; ++i) { const int id = tid + NT * i; *(u32x4*)(base_ + id * 16) = rk[i]; *(u32x4*)(base_ + SC_KB + id * 16) = rq[i]; } \
        *(u32x4*)(base_ + 2 * SC_KB + tid * 16) = rv; } while (0)
    rq[0] = (u32x4){0u, 0u, 0u, 0u}; rq[1] = rq[0];
    SC_LOAD(0); SC_STORE(0); __syncthreads();
    for (int c = 0; c < NCH; ++c) {
        const int buf = c & 1; const bool lat = c * SC_CH >= LC;
        if (c + 1 < NCH) SC_LOAD(c + 1);
        const unsigned char* kb = smem + buf * SC_BUF + kg * 16; const unsigned char* qb = kb + SC_KB; const unsigned char* vb = smem + buf * SC_BUF + 2 * SC_KB + (w * 8 + 2 * vq) * 2;
        bf16_t* ob = (bf16_t*)(smem + 2 * SC_BUF + buf * SC_OB);
        for (int r = 0; r < SC_CH; ++r) {
            const u32x4 ku = *(const u32x4*)(kb + r * 256); const unsigned vu = *(const unsigned*)(vb + r * 128);
            const float v0 = bflo(vu), v1 = bfhi(vu);
            float kf[8];
#pragma unroll
            for (int i = 0; i < 4; ++i) { kf[2 * i] = bflo(ku[i]); kf[2 * i + 1] = bfhi(ku[i]); }
#pragma unroll
            for (int i = 0; i < 8; ++i) { S[i][0] = fmaf(kf[i], v0 - S[i][0], S[i][0]); S[i][1] = fmaf(kf[i], v1 - S[i][1], S[i][1]); }
            if (lat) {
                const u32x4 qu = *(const u32x4*)(qb + r * 256);
                float o0 = 0.f, o1 = 0.f;
#pragma unroll
                for (int i = 0; i < 4; ++i) { const float qa = bflo(qu[i]), qc = bfhi(qu[i]); o0 = fmaf(qa, S[2 * i][0], o0); o1 = fmaf(qa, S[2 * i][1], o1); o0 = fmaf(qc, S[2 * i + 1][0], o0); o1 = fmaf(qc, S[2 * i + 1][1], o1); }
                const bool hi = (lane & 4) != 0; const float send = hi ? o0 : o1, keep = hi ? o1 : o0;
                float rr = keep + __shfl_xor(send, 4);
                rr += __shfl_xor(rr, 8); rr += __shfl_xor(rr, 16); rr += __shfl_xor(rr, 32);
                if (lane < 8) ob[r * 64 + w * 8 + 2 * (lane & 3) + (lane >> 2)] = (bf16_t)f2bf(rr);
            }
        }
        if (c + 1 < NCH) SC_STORE(buf ^ 1);
        __syncthreads();
        if (lat) { const int r = tid >> 3, cc = tid & 7; *(u32x4*)(Oo + (size_t)SC_TOK(c * SC_CH + r) * 1024 + h * 128 + half * 64 + cc * 8) = *(const u32x4*)(ob + r * 64 + cc * 8); }
    }
    __syncthreads();
#undef SC_TOK
#undef SC_LOAD
#undef SC_STORE
}
DEV void readout_item(const Params& p, int item) {
    const int tok = item * 8 + (tidx() >> 6), lane = tidx() & 63;
    const bf16_t* of = (const bf16_t*)(p.ws + WS_F + F_OF) + (size_t)tok * 1024 + lane * 16; const bf16_t* ob = (const bf16_t*)(p.ws + WS_F + F_OB) + (size_t)tok * 1024 + lane * 16;
    const bf16_t* gp = (const bf16_t*)(p.ws + WS_P) + (size_t)tok * 5120 + 4096 + lane * 16;
    const float* on = p.in[I_HGON] + (lane & 7) * 16;
    float o[16], gg[16]; float ss = 0.f;
    { const u32x4 a0 = *(const u32x4*)of, a1 = *(const u32x4*)(of + 8), b0 = *(const u32x4*)ob, b1 = *(const u32x4*)(ob + 8), g0 = *(const u32x4*)gp, g1 = *(const u32x4*)(gp + 8);
#pragma unroll
      for (int i = 0; i < 4; ++i) { o[2 * i] = bflo(a0[i]) + bflo(b0[i]); o[2 * i + 1] = bfhi(a0[i]) + bfhi(b0[i]); o[8 + 2 * i] = bflo(a1[i]) + bflo(b1[i]); o[8 + 2 * i + 1] = bfhi(a1[i]) + bfhi(b1[i]);
          gg[2 * i] = bflo(g0[i]); gg[2 * i + 1] = bfhi(g0[i]); gg[8 + 2 * i] = bflo(g1[i]); gg[8 + 2 * i + 1] = bfhi(g1[i]); } }
#pragma unroll
    for (int i = 0; i < 16; ++i) ss += o[i] * o[i];
    ss += __shfl_xor(ss, 1); ss += __shfl_xor(ss, 2); ss += __shfl_xor(ss, 4);
    const float rstd = rsqrtf(ss * (1.f / 128.f) + 1e-6f);
    bf16_t* M = (bf16_t*)(p.ws + WS_M) + (size_t)tok * 1024 + lane * 16;
    u32x4 o0, o1; float r[16];
#pragma unroll
    for (int i = 0; i < 16; ++i) r[i] = o[i] * rstd * on[i] * gg[i];
#pragma unroll
    for (int i = 0; i < 4; ++i) { o0[i] = pk2(r[2 * i], r[2 * i + 1]); o1[i] = pk2(r[8 + 2 * i], r[8 + 2 * i + 1]); }
    *(u32x4*)M = o0; *(u32x4*)(M + 8) = o1;
}

#ifdef NOINLINE_PHASES
#define NOINL __device__ __attribute__((noinline))
#else
#define NOINL __device__ __forceinline__
#endif
__shared__ __attribute__((aligned(16))) unsigned char g_smem[SMEM_BYTES];
#define PH_COMMON const int G = gridDim.x, bid = blockIdx.x; unsigned char* smem = g_smem; (void)smem; (void)G; (void)bid; \
    const bf16_t* A = (const bf16_t*)(p.ws + WS_A); const bf16_t* Mx = (const bf16_t*)(p.ws + WS_M); const bf16_t* W = (const bf16_t*)(p.ws + WS_W); (void)A; (void)Mx; (void)W;
NOINL void ph0(const Params& p) { PH_COMMON phase0(p, smem); }
NOINL void ph1(const Params& p) { PH_COMMON phase1(p, smem); }
NOINL void ph2(const Params& p) { PH_COMMON EpiL0In e{p.ws}; for (int t = bid; t < (T / 256) * 18; t += G) gemm_tile(A, W + W_IN0 / 2, (t / 18) * 256, (t % 18) * 128, smem, e); }
NOINL void ph3(const Params& p) { PH_COMMON phase3(p, smem); }
NOINL void ph4(const Params& p) { PH_COMMON EpiRes e{&p, 1, 0, 2048}; for (int t = bid; t < (T / 256) * 8; t += G) gemm_tile(Mx, W + W_OUT0 / 2, (t / 8) * 256, (t % 8) * 128, smem, e); }
NOINL void ph5(const Params& p) { PH_COMMON for (int it = bid; it < T / 8; it += G) norm_rows_item(p, it, 0, p.in[I_N2G], 0, 3072); }
NOINL void ph6(const Params& p) { PH_COMMON EpiBf16 e{(bf16_t*)(p.ws + WS_P), 2048}; for (int t = bid; t < (T / 256) * 16; t += G) gemm_tile(A, W + W_Q0 / 2, (t / 16) * 256, (t % 16) * 128, smem, e); }
NOINL void ph7(const Params& p) { PH_COMMON topk_phase(p, 0, T, smem); }
NOINL void ph8(const Params& p) { PH_COMMON for (int it = bid; it < T / 8; it += G) peer_item(p, 0, it); }
NOINL void ph9(const Params& p) { PH_COMMON EpiHg e{(bf16_t*)(p.ws + WS_P), p.in[I_HGLB]};
    for (int t = bid; t < (T / 256) * 40; t += G) { const int mt = t / 40, nt = t % 40; if (mt >= TL / 256 && (nt < 8 || nt >= 32)) continue; gemm_tile(A, W + W_IN1 / 2, mt * 256, nt * 128, smem, e); } }
NOINL void ph10(const Params& p) { PH_COMMON for (int bi = bid; bi < NB * 32; bi += G) scan_block(p, bi, smem); }
NOINL void ph11(const Params& p) { PH_COMMON for (int it = bid; it < TL / 8 + 2 * P0_TAB; it += G) { if (it < TL / 8) readout_item(p, it); else tables_layer1(p, it - TL / 8); } }
NOINL void ph12(const Params& p) { PH_COMMON EpiRes e{&p, 0, 1, 2048}; for (int t = bid; t < (TL / 256) * 8; t += G) gemm_tile(Mx, W + W_OUT1 / 2, (t / 8) * 256, (t % 8) * 128, smem, e); }
NOINL void ph13(const Params& p) { PH_COMMON for (int it = bid; it < TL / 8; it += G) norm_rows_item(p, it, 0, p.in[I_N2G] + 1024, 1, 3072); }
NOINL void ph14(const Params& p) { PH_COMMON EpiBf16 e{(bf16_t*)(p.ws + WS_P), 2048}; for (int t = bid; t < (TL / 256) * 16; t += G) gemm_tile(A, W + W_Q1 / 2, (t / 16) * 256, (t % 16) * 128, smem, e); }
NOINL void ph15(const Params& p) { PH_COMMON topk_phase(p, 1, TL, smem); }
NOINL void ph16(const Params& p) { PH_COMMON for (int it = bid; it < TL / 8; it += G) peer_item(p, 1, it); }

constexpr int NPHASE = 17;
__global__ void __launch_bounds__(NT, 2) mega(Params p_in) {
    const int ph_lo = p_in.ph_lo, ph_hi = p_in.ph_hi;
    for (int ph = ph_lo; ph < ph_hi; ++ph) {
        if (ph > ph_lo) {
#ifndef HOST_EMU
            cg::this_grid().sync();
#endif
        }
#ifndef HOST_EMU
        unsigned long long kp = (unsigned long long)__builtin_amdgcn_kernarg_segment_ptr();
        asm volatile("" : "+s"(kp) :: "memory");
        const Params& p = *(const Params*)(const __attribute__((address_space(4))) Params*)kp;
#else
        const Params& p = p_in;
#endif
#ifdef ONLY_PHASE
        if (ph != ONLY_PHASE) continue;
#endif
#ifdef REPEAT_MASK
        for (int rep_ = ((REPEAT_MASK >> ph) & 1); rep_ >= 0; --rep_) { if (rep_ == 0 && ((REPEAT_MASK >> ph) & 1)) cg::this_grid().sync();
#else
        {
#endif
        switch (ph) {
        case 0: ph0(p); break; case 1: ph1(p); break; case 2: ph2(p); break; case 3: ph3(p); break; case 4: ph4(p); break; case 5: ph5(p); break;
        case 6: ph6(p); break; case 7: ph7(p); break; case 8: ph8(p); break; case 9: ph9(p); break; case 10: ph10(p); break; case 11: ph11(p); break;
        case 12: ph12(p); break; case 13: ph13(p); break; case 14: ph14(p); break; case 15: ph15(p); break; case 16: ph16(p); break;
        default: break;
        }
        }
    }
}

#ifndef HOST_EMU
extern "C" void kernel_launch(void* const* d_in, const int* in_sizes, int n_in, void* d_out, int out_size, void* d_ws, size_t ws_size, hipStream_t stream) {
    if (n_in != 29 || ws_size < WS_END || out_size != TL * 1024) { fprintf(stderr, "kernel_launch: unexpected sizes (n_in %d, ws %zu need %zu, out %d)\n", n_in, ws_size, (size_t)WS_END, out_size); return; }
    static int grid = 0;
    if (!grid) { int dev = 0, cus = 0; hipGetDevice(&dev); hipDeviceGetAttribute(&cus, hipDeviceAttributeMultiprocessorCount, dev); grid = cus > 0 ? cus : 256; }
    hipMemsetAsync((unsigned char*)d_ws + WS_CTRL, 0, CTRL_BYTES, stream);
    Params p{};
    for (int i = 0; i < 29; ++i) p.in[i] = (const float*)d_in[i];
    p.out = (float*)d_out; p.ws = (unsigned char*)d_ws;
#ifdef MULTI_LAUNCH
    for (int ph = 0; ph < NPHASE; ++ph) { p.ph_lo = ph; p.ph_hi = ph + 1; hipLaunchKernelGGL(mega, dim3(grid), dim3(NT), 0, stream, p); }
#else
    p.ph_lo = 0; p.ph_hi = NPHASE;
    void* args[] = {&p};
    hipError_t e = hipLaunchCooperativeKernel((void*)mega, dim3(grid), dim3(NT), args, 0, stream);
    if (e != hipSuccess) fprintf(stderr, "cooperative launch failed: %s (grid %d)\n", hipGetErrorString(e), grid);
#endif
}
#endif
```

```cpp
#ifndef HOST_EMU
#include <hip/hip_runtime.h>
#include <cstdio>
#endif

#ifndef CFG_B
#define CFG_B 8
#define CFG_L 2048
#define CFG_LC 256
#endif
#define DEV __device__ __forceinline__
#ifdef HOST_EMU
#define __expf expf
#define __sinf sinf
#define __cosf cosf
#endif

typedef unsigned short bf16_t;
typedef short bf16x8 __attribute__((ext_vector_type(8)));
typedef float f32x16 __attribute__((ext_vector_type(16)));
typedef float f32x4 __attribute__((ext_vector_type(4)));
typedef unsigned u32x4 __attribute__((ext_vector_type(4)));
typedef unsigned u32x2 __attribute__((ext_vector_type(2)));
struct cf2 { float x, y; };

constexpr int NB = CFG_B, L = CFG_L, LC = CFG_LC, D = 1024;
constexpr int TL = NB * L, TC = NB * LC, T = TL + TC;
constexpr int NT = 512;
constexpr int NR = NB + 1;
constexpr int log4ceil(int n) { int s = 0, v = 1; while (v < n) { v *= 4; ++s; } return s; }
constexpr int FS_LAT = log4ceil(2 * L - 1), FS_CTX = log4ceil(2 * LC - 1);
constexpr int NF_LAT = 1 << (2 * FS_LAT), NF_CTX = 1 << (2 * FS_CTX);
static_assert(T % 256 == 0 && TL % 256 == 0 && L % 128 == 0 && LC % 128 == 0 && NB % 2 == 0, "shape");

constexpr size_t al256(size_t x) { return (x + 255) & ~(size_t)255; }
constexpr size_t WS_CTRL = 0, CTRL_BYTES = 65536;
constexpr size_t CTRL_HYNORM = 4096;
constexpr size_t WS_MOD = WS_CTRL + CTRL_BYTES;
constexpr size_t WS_H = al256(WS_MOD + (size_t)2 * NR * 6144 * 4);
constexpr size_t WS_A = al256(WS_H + (size_t)T * 1024 * 4);
constexpr size_t WS_P = al256(WS_A + (size_t)T * 1024 * 2);
constexpr size_t P_BYTES = (size_t)T * 5120 * 2;
constexpr size_t P_HYT_LAT = 0;
constexpr size_t P_HYT_CTX = P_HYT_LAT + (size_t)NB * 1536 * L * 2;
constexpr size_t P_Q0 = P_HYT_CTX + (size_t)NB * 1536 * LC * 2;
constexpr size_t P_K0 = P_Q0 + (size_t)T * 512 * 2;
constexpr size_t P_VT_LAT = P_K0 + (size_t)T * 128 * 2;
constexpr size_t P_VT_CTX = P_VT_LAT + (size_t)NB * 128 * L * 2;
static_assert(P_VT_CTX + (size_t)NB * 128 * LC * 2 <= P_BYTES, "P region");
constexpr size_t WS_M = al256(WS_P + P_BYTES);
constexpr size_t WS_IDX = al256(WS_M + (size_t)T * 1024 * 2);
constexpr size_t WS_GATE = al256(WS_IDX + (size_t)T * 128 * 4);
constexpr size_t WS_UB = al256(WS_GATE + (size_t)T * 128 * 4);
constexpr size_t WS_VB = WS_UB + (size_t)16384 * 1024 * 2;
constexpr size_t WS_W = WS_VB + (size_t)16384 * 1024 * 2;
constexpr size_t W_IN0 = 0, W_OUT0 = W_IN0 + (size_t)2304 * 1024 * 2, W_IN1 = W_OUT0 + (size_t)1024 * 1024 * 2,
                 W_OUT1 = W_IN1 + (size_t)5120 * 1024 * 2, W_Q0 = W_OUT1 + (size_t)1024 * 1024 * 2, W_Q1 = W_Q0 + (size_t)2048 * 1024 * 2,
                 W_KEYS = W_Q1 + (size_t)2048 * 1024 * 2, W_BYTES = W_KEYS + (size_t)2 * 8 * 2 * 128 * 128 * 2;
constexpr size_t WS_F = al256(WS_W + W_BYTES);
constexpr size_t F_HRAW_LAT = 0;
constexpr size_t F_HRAW_CTX = F_HRAW_LAT + (size_t)2048 * L * 4;
constexpr size_t F_HF_LAT = F_HRAW_CTX + (size_t)2048 * LC * 4;
constexpr size_t F_HF_CTX = F_HF_LAT + (size_t)1024 * NF_LAT * 8;
constexpr size_t F_HYP_LAT = F_HF_CTX + (size_t)1024 * NF_CTX * 8;
constexpr size_t F_HYP_CTX = F_HYP_LAT + (size_t)(L / 64) * 2048 * 4;
constexpr size_t F_END = F_HYP_CTX + (size_t)(LC / 64) * 2048 * 4;
constexpr size_t F_OF = 0, F_OB = (size_t)TL * 1024 * 2;
constexpr size_t F_BYTES = F_END > 2 * F_OB ? F_END : 2 * F_OB;
constexpr size_t WS_END = al256(WS_F + F_BYTES);

struct Params { const float* in[29]; float* out; unsigned char* ws; int ph_lo, ph_hi; };
enum { I_X = 0, I_C, I_CTX, I_CCTX, I_ADAW, I_ADAB, I_N1G, I_N2G, I_FG, I_ABWIN, I_ABWOUT, I_HYCW, I_HYCB, I_HYW1, I_HYB1, I_HYW2, I_HYB2, I_HYW3,
       I_HYFREQ, I_HYSKIP, I_SINK, I_HGWIN, I_HGWOUT, I_HGLB, I_HGON, I_PWQ, I_PKEYS, I_PU, I_PV };

constexpr int SMEM_BYTES = 147456;

#ifndef HOST_EMU
DEV int tidx() { int t = threadIdx.x; asm volatile("" : "+v"(t)); return t; }
#else
DEV int tidx() { return (int)threadIdx.x; }
#endif
DEV unsigned f2bf(float f) { unsigned u = __builtin_bit_cast(unsigned, f); return (u + 0x7fffu + ((u >> 16) & 1u)) >> 16; }
DEV float bf2f(unsigned h) { return __builtin_bit_cast(float, (h & 0xffffu) << 16); }
DEV unsigned pk2(float lo, float hi) { return f2bf(lo) | (f2bf(hi) << 16); }
DEV float bflo(unsigned u) { return __builtin_bit_cast(float, u << 16); }
DEV float bfhi(unsigned u) { return __builtin_bit_cast(float, u & 0xffff0000u); }
DEV float silu_f(float x) { return x / (1.f + __expf(-x)); }
DEV float sigmoid_f(float x) { return 1.f / (1.f + __expf(-x)); }
DEV float wave_sum(float v) {
#pragma unroll
    for (int m = 32; m >= 1; m >>= 1) v += __shfl_xor(v, m);
    return v;
}
DEV int mod_row(int tok) { return tok < TL ? tok / L : NB; }

DEV void p0_mod(const Params& p, int item, unsigned char* smem) {
    const int l = item / 96, col0 = (item % 96) * 64, tid = tidx();
    float* sc = (float*)smem;
    float* red = sc + NR * 1024;
    for (int i = tid; i < NR * 1024; i += NT) { const int r = i >> 10, k = i & 1023; const float c = r < NB ? p.in[I_C][r * 1024 + k] : p.in[I_CCTX][k]; sc[i] = c / (1.f + expf(-c)); }
    __syncthreads();
    const int kq = tid >> 6, col = tid & 63;
    float acc[NR];
#pragma unroll
    for (int r = 0; r < NR; ++r) acc[r] = 0.f;
    const float* w = p.in[I_ADAW] + (size_t)l * 1024 * 6144 + col0 + col;
#pragma unroll 4
    for (int k = kq * 128; k < kq * 128 + 128; ++k) {
        const float wv = w[(size_t)k * 6144];
#pragma unroll
        for (int r = 0; r < NR; ++r) acc[r] += sc[r * 1024 + k] * wv;
    }
#pragma unroll
    for (int r = 0; r < NR; ++r) red[(kq * NR + r) * 64 + col] = acc[r];
    __syncthreads();
    float* mod = (float*)(p.ws + WS_MOD);
    for (int i = tid; i < NR * 64; i += NT) {
        const int r = i >> 6, c = i & 63; float s = 0.f;
        for (int q = 0; q < 8; ++q) s += red[(q * NR + r) * 64 + c];
        mod[((size_t)l * NR + r) * 6144 + col0 + c] = s + p.in[I_ADAB][l * 6144 + col0 + c];
    }
    __syncthreads();
}
DEV void p0_transpose(const float* W, bf16_t* Wt, int N, int tile, unsigned char* smem) {
    float* ts = (float*)smem;
    const int ntn = N / 64, kt = tile / ntn, nt = tile % ntn, k0 = kt * 64, n0 = nt * 64, tid = tidx();
    for (int i = tid; i < 4096; i += NT) { const int kk = i >> 6, nn = i & 63; ts[kk * 65 + nn] = W[(size_t)(k0 + kk) * N + n0 + nn]; }
    __syncthreads();
    for (int i = tid; i < 4096; i += NT) { const int nn = i >> 6, kk = i & 63; Wt[(size_t)(n0 + nn) * 1024 + k0 + kk] = (bf16_t)f2bf(ts[kk * 65 + nn]); }
    __syncthreads();
}
DEV void p0_convert(const float* src, bf16_t* dst, int item) {
    const int tid = tidx();
#pragma unroll
    for (int i = 0; i < 8; ++i) {
        const size_t e = (size_t)item * 16384 + (size_t)(i * NT + tid) * 4;
        const f32x4 v = *(const f32x4*)(src + e);
        u32x2 o; o[0] = pk2(v[0], v[1]); o[1] = pk2(v[2], v[3]);
        *(u32x2*)(dst + e) = o;
    }
}
DEV void p0_filter(const Params& p, int set, int chunk, unsigned char* smem) {
    const int Ls = set ? LC : L, l0 = chunk * 64, tid = tidx();
    float* z = (float*)smem;
    float* hd1 = z + 64 * 34;
    float* hd2 = hd1 + 64 * 65;
    const float* w1 = p.in[I_HYW1]; const float* b1 = p.in[I_HYB1]; const float* w2 = p.in[I_HYW2]; const float* b2 = p.in[I_HYB2];
    const float* w3 = p.in[I_HYW3]; const float* fq = p.in[I_HYFREQ];
    for (int i = tid; i < 64 * 33; i += NT) {
        const int pp = i / 33, f = i % 33, l = l0 + pp; float val;
        if (f == 0) val = (float)l / (float)(Ls - 1);
        else { const int jb = (f - 1) & 15; const float fj = 1e-4f + (float)jb * ((15.f - 1e-4f) / 15.f); const float a = fj * (6.283185307179586f * (float)l / (float)Ls); val = f <= 16 ? __cosf(a) : -__sinf(a); }
        z[pp * 34 + f] = val;
    }
    __syncthreads();
    for (int i = tid; i < 4096; i += NT) {
        const int pp = i >> 6, j = i & 63; float s = b1[j];
#pragma unroll 4
        for (int f = 0; f < 33; ++f) s += z[pp * 34 + f] * w1[f * 64 + j];
        hd1[pp * 65 + j] = __sinf(fq[j] * s);
    }
    __syncthreads();
    for (int i = tid; i < 4096; i += NT) {
        const int pp = i >> 6, j = i & 63; float s = b2[j];
#pragma unroll 4
        for (int f = 0; f < 64; ++f) s += hd1[pp * 65 + f] * w2[f * 64 + j];
        hd2[pp * 65 + j] = __sinf(fq[j] * s);
    }
    __syncthreads();
    const int lane = tid & 63, w = __builtin_amdgcn_readfirstlane(tid >> 6);
    const float tl = (float)(l0 + lane) / (float)(Ls - 1);
    const float max_decay = -15.350567286626973f, min_decay = -3.0701134573253945f;
    float* hraw = (float*)(p.ws + WS_F + (set ? F_HRAW_CTX : F_HRAW_LAT));
    float* hyn = (float*)(p.ws + WS_F + (set ? F_HYP_CTX : F_HYP_LAT)) + (size_t)chunk * 2048;
    for (int oc = 0; oc < 256; ++oc) {
        const int o = w * 256 + oc; float s = 0.f;
#pragma unroll 8
        for (int j = 0; j < 64; ++j) s += hd2[lane * 65 + j] * w3[j * 2048 + o];
        const int c = o & 511; const float delta = fabsf(min_decay + (float)c * ((max_decay - min_decay) / 511.f));
        const float val = s * expf(-tl * delta);
        hraw[(size_t)o * Ls + l0 + lane] = val;
        const float a = wave_sum(fabsf(val));
        if (lane == 0) hyn[o] = a;
    }
    __syncthreads();
}

constexpr int P0_MOD = 192, P0_TR_IN0 = 16 * 36, P0_TR_OUT0 = 256, P0_TR_IN1 = 16 * 80, P0_TR_OUT1 = 256, P0_TR_Q = 16 * 32, P0_KEYS = 32, P0_TAB = 1024,
              P0_FILT = L / 64 + LC / 64;
DEV void phase0(const Params& p, unsigned char* smem) {
    bf16_t* W = (bf16_t*)(p.ws + WS_W);
    const int total = P0_MOD + P0_FILT + P0_TR_IN0 + P0_TR_OUT0 + P0_TR_IN1 + P0_TR_OUT1 + 2 * P0_TR_Q + P0_KEYS + 2 * P0_TAB;
    for (int it = blockIdx.x; it < total; it += gridDim.x) {
        int i = it;
        if (i < P0_MOD) { p0_mod(p, i, smem); continue; } i -= P0_MOD;
        if (i < P0_FILT) { if (i < L / 64) p0_filter(p, 0, i, smem); else p0_filter(p, 1, i - L / 64, smem); continue; } i -= P0_FILT;
        if (i < P0_TR_IN0) { p0_transpose(p.in[I_ABWIN], W + W_IN0 / 2, 2304, i, smem); continue; } i -= P0_TR_IN0;
        if (i < P0_TR_OUT0) { p0_transpose(p.in[I_ABWOUT], W + W_OUT0 / 2, 1024, i, smem); continue; } i -= P0_TR_OUT0;
        if (i < P0_TR_IN1) { p0_transpose(p.in[I_HGWIN], W + W_IN1 / 2, 5120, i, smem); continue; } i -= P0_TR_IN1;
        if (i < P0_TR_OUT1) { p0_transpose(p.in[I_HGWOUT], W + W_OUT1 / 2, 1024, i, smem); continue; } i -= P0_TR_OUT1;
        if (i < P0_TR_Q) { p0_transpose(p.in[I_PWQ], W + W_Q0 / 2, 2048, i, smem); continue; } i -= P0_TR_Q;
        if (i < P0_TR_Q) { p0_transpose(p.in[I_PWQ] + (size_t)1024 * 2048, W + W_Q1 / 2, 2048, i, smem); continue; } i -= P0_TR_Q;
        if (i < P0_KEYS) { p0_convert(p.in[I_PKEYS], W + W_KEYS / 2, i); continue; } i -= P0_KEYS;
        if (i < P0_TAB) { p0_convert(p.in[I_PU], (bf16_t*)(p.ws + WS_UB), i); continue; } i -= P0_TAB;
        p0_convert(p.in[I_PV], (bf16_t*)(p.ws + WS_VB), i);
    }
}
DEV void tables_layer1(const Params& p, int i) {
    if (i < P0_TAB) p0_convert(p.in[I_PU] + (size_t)16384 * 1024, (bf16_t*)(p.ws + WS_UB), i);
    else p0_convert(p.in[I_PV] + (size_t)16384 * 1024, (bf16_t*)(p.ws + WS_VB), i - P0_TAB);
}

DEV const float* h_row(const Params& p, int layer_src_inputs, int tok) {
    if (layer_src_inputs) return tok < TL ? p.in[I_X] + (size_t)tok * 1024 : p.in[I_CTX] + (size_t)(tok - TL) * 1024;
    return (const float*)(p.ws + WS_H) + (size_t)tok * 1024;
}
DEV void norm_row_store(const Params& p, const f32x4 (&v)[4], int tok, const float* g, int layer, int sh_off, int lane) {
    float ss = 0.f;
#pragma unroll
    for (int i = 0; i < 4; ++i) ss += v[i][0] * v[i][0] + v[i][1] * v[i][1] + v[i][2] * v[i][2] + v[i][3] * v[i][3];
    ss = wave_sum(ss);
    const float rstd = rsqrtf(ss * (1.f / 1024.f) + 1e-6f);
    const float* mod = (const float*)(p.ws + WS_MOD) + ((size_t)layer * NR + mod_row(tok)) * 6144 + sh_off;
    bf16_t* A = (bf16_t*)(p.ws + WS_A) + (size_t)tok * 1024;
#pragma unroll
    for (int i = 0; i < 4; ++i) {
        const int c = i * 256 + lane * 4;
        const f32x4 gg = *(const f32x4*)(g + c), sh = *(const f32x4*)(mod + c), sc = *(const f32x4*)(mod + 1024 + c);
        u32x2 o;
        o[0] = pk2(v[i][0] * rstd * gg[0] * (1.f + sc[0]) + sh[0], v[i][1] * rstd * gg[1] * (1.f + sc[1]) + sh[1]);
        o[1] = pk2(v[i][2] * rstd * gg[2] * (1.f + sc[2]) + sh[2], v[i][3] * rstd * gg[3] * (1.f + sc[3]) + sh[3]);
        *(u32x2*)(A + c) = o;
    }
}
DEV void norm_rows_item(const Params& p, int item, int from_inputs, const float* g, int layer, int sh_off) {
    const int tok = item * 8 + (tidx() >> 6), lane = tidx() & 63;
    const float* src = h_row(p, from_inputs, tok);
    f32x4 v[4];
#pragma unroll
    for (int i = 0; i < 4; ++i) v[i] = *(const f32x4*)(src + i * 256 + lane * 4);
    norm_row_store(p, v, tok, g, layer, sh_off, lane);
}

DEV cf2 cmul(cf2 a, cf2 b) { cf2 r; r.x = a.x * b.x - a.y * b.y; r.y = a.x * b.y + a.y * b.x; return r; }
DEV cf2 twid(int k, float invN) { cf2 r; const float a = (float)k * invN; r.x = __builtin_amdgcn_cosf(a); r.y = -__builtin_amdgcn_sinf(a); return r; }
DEV void fft_fwd(cf2* buf, int S, int g, int G) {
    const int N = 1 << (2 * S); const float invN = 1.f / (float)N;
    for (int s = 0; s < S; ++s) {
        const int lm = 2 * (S - s), m = 1 << lm, q = m >> 2;
        for (int bf = g; bf < (N >> 2); bf += G) {
            const int j = bf & (q - 1), base = ((bf >> (lm - 2)) << lm) + j;
            const cf2 a0 = buf[base], a1 = buf[base + q], a2 = buf[base + 2 * q], a3 = buf[base + 3 * q];
            cf2 t0, t1, t2, t3; t0.x = a0.x + a2.x; t0.y = a0.y + a2.y; t1.x = a0.x - a2.x; t1.y = a0.y - a2.y; t2.x = a1.x + a3.x; t2.y = a1.y + a3.y;
            const float dx = a1.x - a3.x, dy = a1.y - a3.y; t3.x = dy; t3.y = -dx;
            cf2 y0, y1, y2, y3; y0.x = t0.x + t2.x; y0.y = t0.y + t2.y; y1.x = t1.x + t3.x; y1.y = t1.y + t3.y; y2.x = t0.x - t2.x; y2.y = t0.y - t2.y; y3.x = t1.x - t3.x; y3.y = t1.y - t3.y;
            const int tw = j << (2 * s);
            buf[base] = y0; buf[base + q] = cmul(y1, twid(tw, invN)); buf[base + 2 * q] = cmul(y2, twid(2 * tw, invN)); buf[base + 3 * q] = cmul(y3, twid(3 * tw, invN));
        }
        __syncthreads();
    }
}
DEV void fft_inv(cf2* buf, int S, int g, int G) {
    const int N = 1 << (2 * S); const float invN = 1.f / (float)N;
    for (int s = S - 1; s >= 0; --s) {
        const int lm = 2 * (S - s), m = 1 << lm, q = m >> 2;
        for (int bf = g; bf < (N >> 2); bf += G) {
            const int j = bf & (q - 1), base = ((bf >> (lm - 2)) << lm) + j;
            const int tw = j << (2 * s);
            cf2 w1 = twid(tw, invN), w2 = twid(2 * tw, invN), w3 = twid(3 * tw, invN); w1.y = -w1.y; w2.y = -w2.y; w3.y = -w3.y;
            const cf2 c0 = buf[base], c1 = cmul(buf[base + q], w1), c2 = cmul(buf[base + 2 * q], w2), c3 = cmul(buf[base + 3 * q], w3);
            cf2 t0, t1, t2, t3; t0.x = c0.x + c2.x; t0.y = c0.y + c2.y; t1.x = c0.x - c2.x; t1.y = c0.y - c2.y; t2.x = c1.x + c3.x; t2.y = c1.y + c3.y;
            const float dx = c1.x - c3.x, dy = c1.y - c3.y; t3.x = -dy; t3.y = dx;
            cf2 a0, a1, a2, a3; a0.x = t0.x + t2.x; a0.y = t0.y + t2.y; a1.x = t1.x + t3.x; a1.y = t1.y + t3.y; a2.x = t0.x - t2.x; a2.y = t0.y - t2.y; a3.x = t1.x - t3.x; a3.y = t1.y - t3.y;
            buf[base] = a0; buf[base + q] = a1; buf[base + 2 * q] = a2; buf[base + 3 * q] = a3;
        }
        __syncthreads();
    }
}
DEV void hf_item(const Params& p, int set, int pi, unsigned char* smem) {
    const int Ls = set ? LC : L, S = set ? FS_CTX : FS_LAT, N = 1 << (2 * S);
    const int gi = tidx() >> 8, g = tidx() & 255, idx = pi * 2 + gi, o = idx >> 9, c = idx & 511;
    cf2* buf = (cf2*)smem + (size_t)gi * N;
    const float* hraw = (const float*)(p.ws + WS_F + (set ? F_HRAW_CTX : F_HRAW_LAT));
    const float* hyn = (const float*)(p.ws + WS_F + (set ? F_HYP_CTX : F_HYP_LAT));
    float nsum = 0.f;
    for (int ch = 0; ch < Ls / 64; ++ch) nsum += hyn[(size_t)ch * 2048 + o * 1024 + c] + hyn[(size_t)ch * 2048 + o * 1024 + 512 + c];
    const float inv = 1.f / nsum;
    const float* hf = hraw + (size_t)(o * 1024 + c) * Ls; const float* hb = hraw + (size_t)(o * 1024 + 512 + c) * Ls;
    for (int k = g; k < N; k += 256) { float re = 0.f; if (k < Ls) re = hf[k] * inv; else if (k > N - Ls) re = hb[N - k] * inv; cf2 v; v.x = re; v.y = 0.f; buf[k] = v; }
    __syncthreads();
    fft_fwd(buf, S, g, 256);
    cf2* HF = (cf2*)(p.ws + WS_F + (set ? F_HF_CTX : F_HF_LAT)) + (size_t)(o * 512 + c) * N;
    for (int k = g; k < N; k += 256) HF[k] = buf[k];
    __syncthreads();
}
constexpr int P1_NORM = T / 8, P1_HF = 512;
DEV void phase1(const Params& p, unsigned char* smem) {
    const int total = P1_NORM + 2 * P1_HF;
    for (int it = blockIdx.x; it < total; it += gridDim.x) {
        if (it < P1_NORM) norm_rows_item(p, it, 1, p.in[I_N1G], 0, 0);
        else if (it < P1_NORM + P1_HF) hf_item(p, 0, it - P1_NORM, smem);
        else hf_item(p, 1, it - P1_NORM - P1_HF, smem);
    }
}

constexpr int G_LDA = 72;
template <class Epi>
DEV void gemm_tile(const bf16_t* __restrict__ A, const bf16_t* __restrict__ Wt, int m0, int n0, unsigned char* smem, const Epi& epi) {
    bf16_t* As = (bf16_t*)smem;
    bf16_t* Bs = As + 2 * 256 * G_LDA;
    const int tid = tidx(), lane = tid & 63, w = tid >> 6, wm = w >> 1, wn = w & 1;
    f32x16 acc[2][2];
#pragma unroll
    for (int i = 0; i < 2; ++i)
#pragma unroll
        for (int j = 0; j < 2; ++j)
#pragma unroll
            for (int r = 0; r < 16; ++r) acc[i][j][r] = 0.f;
    u32x4 ra[4], rb[2];
    const bf16_t* Ag = A + (size_t)m0 * 1024; const bf16_t* Bg = Wt + (size_t)n0 * 1024;
#define GLOAD(k0) do { \
        _Pragma("unroll") for (int i = 0; i < 4; ++i) { const int id = tid + NT * i, row = id >> 3, kc = id & 7; ra[i] = *(const u32x4*)(Ag + (size_t)row * 1024 + (k0) + kc * 8); } \
        _Pragma("unroll") for (int i = 0; i < 2; ++i) { const int id = tid + NT * i, row = id >> 3, kc = id & 7; rb[i] = *(const u32x4*)(Bg + (size_t)row * 1024 + (k0) + kc * 8); } } while (0)
#define LSTORE(buf_) do { \
        _Pragma("unroll") for (int i = 0; i < 4; ++i) { const int id = tid + NT * i, row = id >> 3, kc = id & 7; *(u32x4*)(As + ((buf_) * 256 + row) * G_LDA + kc * 8) = ra[i]; } \
        _Pragma("unroll") for (int i = 0; i < 2; ++i) { const int id = tid + NT * i, row = id >> 3, kc = id & 7; *(u32x4*)(Bs + ((buf_) * 128 + row) * G_LDA + kc * 8) = rb[i]; } } while (0)
    GLOAD(0); LSTORE(0); __syncthreads();
    for (int kt = 0; kt < 16; ++kt) {
        const int buf = kt & 1;
        if (kt + 1 < 16) GLOAD((kt + 1) * 64);
        const bf16_t* as = As + (buf * 256 + wm * 64 + (lane & 31)) * G_LDA + 8 * (lane >> 5);
        const bf16_t* bs = Bs + (buf * 128 + wn * 64 + (lane & 31)) * G_LDA + 8 * (lane >> 5);
#pragma unroll
        for (int kk = 0; kk < 4; ++kk) {
            const bf16x8 a0 = *(const bf16x8*)(as + kk * 16), a1 = *(const bf16x8*)(as + 32 * G_LDA + kk * 16);
            const bf16x8 b0 = *(const bf16x8*)(bs + kk * 16), b1 = *(const bf16x8*)(bs + 32 * G_LDA + kk * 16);
            acc[0][0] = __builtin_amdgcn_mfma_f32_32x32x16_bf16(a0, b0, acc[0][0], 0, 0, 0);
            acc[0][1] = __builtin_amdgcn_mfma_f32_32x32x16_bf16(a0, b1, acc[0][1], 0, 0, 0);
            acc[1][0] = __builtin_amdgcn_mfma_f32_32x32x16_bf16(a1, b0, acc[1][0], 0, 0, 0);
            acc[1][1] = __builtin_amdgcn_mfma_f32_32x32x16_bf16(a1, b1, acc[1][1], 0, 0, 0);
        }
        if (kt + 1 < 16) LSTORE(buf ^ 1);
        __syncthreads();
    }
#pragma unroll
    for (int mi = 0; mi < 2; ++mi)
#pragma unroll
        for (int ni = 0; ni < 2; ++ni)
#pragma unroll
            for (int rg = 0; rg < 4; ++rg) {
                const int row = m0 + wm * 64 + mi * 32 + 8 * rg + 4 * (lane >> 5), col = n0 + wn * 64 + ni * 32 + (lane & 31);
                epi(row, col, acc[mi][ni][rg * 4 + 0], acc[mi][ni][rg * 4 + 1], acc[mi][ni][rg * 4 + 2], acc[mi][ni][rg * 4 + 3]);
            }
}
struct EpiL0In {
    unsigned char* ws;
    DEV void operator()(int row, int col, float v0, float v1, float v2, float v3) const {
        u32x2 o; o[0] = pk2(v0, v1); o[1] = pk2(v2, v3);
        const bool lat = row < TL; const int b = lat ? row / L : (row - TL) / LC, t = lat ? row - b * L : (row - TL) - b * LC, Lx = lat ? L : LC;
        if (col < 1536) { bf16_t* d = (bf16_t*)(ws + WS_P + (lat ? P_HYT_LAT : P_HYT_CTX)) + ((size_t)b * 1536 + col) * Lx + t; *(u32x2*)d = o; }
        else if (col < 2048) { bf16_t* d = (bf16_t*)(ws + WS_P + P_Q0) + (size_t)row * 512 + (col - 1536); d[0] = (bf16_t)f2bf(v0); d[512] = (bf16_t)f2bf(v1); d[1024] = (bf16_t)f2bf(v2); d[1536] = (bf16_t)f2bf(v3); }
        else if (col < 2176) { bf16_t* d = (bf16_t*)(ws + WS_P + P_K0) + (size_t)row * 128 + (col - 2048); d[0] = (bf16_t)f2bf(v0); d[128] = (bf16_t)f2bf(v1); d[256] = (bf16_t)f2bf(v2); d[384] = (bf16_t)f2bf(v3); }
        else { bf16_t* d = (bf16_t*)(ws + WS_P + (lat ? P_VT_LAT : P_VT_CTX)) + ((size_t)b * 128 + (col - 2176)) * Lx + t; *(u32x2*)d = o; }
    }
};
struct EpiBf16 {
    bf16_t* out; int ld;
    DEV void operator()(int row, int col, float v0, float v1, float v2, float v3) const {
        bf16_t* d = out + (size_t)row * ld + col; d[0] = (bf16_t)f2bf(v0); d[ld] = (bf16_t)f2bf(v1); d[2 * ld] = (bf16_t)f2bf(v2); d[3 * ld] = (bf16_t)f2bf(v3);
    }
};
struct EpiHg {
    bf16_t* out; const float* lg;
    DEV void operator()(int row, int col, float v0, float v1, float v2, float v3) const {
        float vv[4] = {v0, v1, v2, v3};
        if (col < 1024 || col >= 4096) {
#pragma unroll
            for (int i = 0; i < 4; ++i) vv[i] = silu_f(vv[i]);
        } else if (col < 3072) {
            const int c = col - 1024;
            const float oml = 1.f - 1.f / (1.f + __expf(lg[c] - lg[2048 + c]));
#pragma unroll
            for (int i = 0; i < 4; ++i) vv[i] = oml / (1.f + __expf(vv[i]));
        }
        bf16_t* d = out + (size_t)row * 5120 + col; d[0] = (bf16_t)f2bf(vv[0]); d[5120] = (bf16_t)f2bf(vv[1]); d[2 * 5120] = (bf16_t)f2bf(vv[2]); d[3 * 5120] = (bf16_t)f2bf(vv[3]);
    }
};
struct EpiRes {
    const Params* p; int from_inputs, layer, goff;
    DEV void operator()(int row, int col, float v0, float v1, float v2, float v3) const {
        const float vv[4] = {v0, v1, v2, v3};
        float* H = (float*)(p->ws + WS_H);
        const float* mod = (const float*)(p->ws + WS_MOD) + (size_t)layer * NR * 6144 + goff + col;
#pragma unroll
        for (int i = 0; i < 4; ++i) { const int r = row + i; H[(size_t)r * 1024 + col] = h_row(*p, from_inputs, r)[col] + mod[(size_t)mod_row(r) * 6144] * vv[i]; }
    }
};

DEV float hy_u(const bf16_t* row, int t, int Lx, float w0, float w1, float w2, float b) {
    const float xm = t > 0 ? bf2f(row[t - 1]) : 0.f, x0 = bf2f(row[t]), xp = t + 1 < Lx ? bf2f(row[t + 1]) : 0.f;
    return w0 * xm + w1 * x0 + w2 * xp + b;
}
DEV void hyena_item(const Params& p, int set, int item, unsigned char* smem) {
    const int Ls = set ? LC : L, S = set ? FS_CTX : FS_LAT, N = 1 << (2 * S);
    const int gi = tidx() >> 8, g = tidx() & 255;
    const int bp = item >> 8, c = (item & 255) * 2 + gi, ba = bp * 2, bb = ba + 1;
    cf2* buf = (cf2*)smem + (size_t)gi * N;
    cf2* zk = (cf2*)smem + (size_t)2 * N + (size_t)gi * Ls;
    const bf16_t* hy = (const bf16_t*)(p.ws + WS_P + (set ? P_HYT_CTX : P_HYT_LAT));
    const float* cw = p.in[I_HYCW]; const float* cb = p.in[I_HYCB];
    const cf2* HF = (const cf2*)(p.ws + WS_F + (set ? F_HF_CTX : F_HF_LAT));
    const float invN = 1.f / (float)N;
    {
        const float w0 = cw[c], w1 = cw[1536 + c], w2 = cw[3072 + c], b = cb[c];
        const bf16_t* ra = hy + ((size_t)ba * 1536 + c) * Ls; const bf16_t* rb = hy + ((size_t)bb * 1536 + c) * Ls;
        for (int t = g; t < N; t += 256) { cf2 v; v.x = 0.f; v.y = 0.f; if (t < Ls) { v.x = hy_u(ra, t, Ls, w0, w1, w2, b); v.y = hy_u(rb, t, Ls, w0, w1, w2, b); zk[t] = v; } buf[t] = v; }
    }
    __syncthreads();
    for (int n = 0; n < 2; ++n) {
        fft_fwd(buf, S, g, 256);
        const cf2* hf = HF + (size_t)(n * 512 + c) * N;
        for (int k = g; k < N; k += 256) buf[k] = cmul(buf[k], hf[k]);
        __syncthreads();
        fft_inv(buf, S, g, 256);
        const int gc = (n + 1) * 512 + c;
        const float w0 = cw[gc], w1 = cw[1536 + gc], w2 = cw[3072 + gc], b = cb[gc], dsk = p.in[I_HYSKIP][n * 512 + c];
        const bf16_t* ra = hy + ((size_t)ba * 1536 + gc) * Ls; const bf16_t* rb = hy + ((size_t)bb * 1536 + gc) * Ls;
        bf16_t* M = (bf16_t*)(p.ws + WS_M);
        for (int t = g; t < N; t += 256) {
            cf2 v; v.x = 0.f; v.y = 0.f;
            if (t < Ls) {
                const cf2 cv = buf[t], zo = zk[t];
                v.x = hy_u(ra, t, Ls, w0, w1, w2, b) * (cv.x * invN + dsk * zo.x); v.y = hy_u(rb, t, Ls, w0, w1, w2, b) * (cv.y * invN + dsk * zo.y);
                if (n == 0) zk[t] = v;
                else { const size_t ta = set ? (size_t)TL + (size_t)ba * LC + t : (size_t)ba * L + t, tb = set ? (size_t)TL + (size_t)bb * LC + t : (size_t)bb * L + t;
                       M[ta * 1024 + c] = (bf16_t)f2bf(v.x); M[tb * 1024 + c] = (bf16_t)f2bf(v.y); }
            }
            if (n == 0) buf[t] = v;
        }
        __syncthreads();
    }
}
DEV void rope_store(const bf16_t* src, bf16_t* dst, int pos, bool rope, float scale, int ph, int sub) {
    const u32x4 ua = *(const u32x4*)(src + ph * 32 + sub * 8), ub = *(const u32x4*)(src + ph * 32 + 16 + sub * 8);
    float a[8], b[8];
#pragma unroll
    for (int i = 0; i < 4; ++i) { a[2 * i] = bflo(ua[i]); a[2 * i + 1] = bfhi(ua[i]); b[2 * i] = bflo(ub[i]); b[2 * i + 1] = bfhi(ub[i]); }
    if (rope) {
        const float pv = (float)(ph == 0 ? pos / 64 : pos % 64);
#pragma unroll
        for (int e = 0; e < 8; ++e) {
            const float inv = exp2f(-(float)(sub * 8 + e) * (13.287712379549449f / 16.f));
            const float ang = pv * inv, cs = __cosf(ang), sn = __sinf(ang);
            const float na = a[e] * cs - b[e] * sn, nb = b[e] * cs + a[e] * sn; a[e] = na; b[e] = nb;
        }
    }
    u32x4 oa, ob;
#pragma unroll
    for (int i = 0; i < 4; ++i) { oa[i] = pk2(a[2 * i] * scale, a[2 * i + 1] * scale); ob[i] = pk2(b[2 * i] * scale, b[2 * i + 1] * scale); }
    *(u32x4*)(dst + ph * 32 + sub * 8) = oa; *(u32x4*)(dst + ph * 32 + 16 + sub * 8) = ob;
}
constexpr int A_LDQ = 72, A_LDV = 136;
DEV void attn_item(const Params& p, int set, int item, unsigned char* smem) {
    bf16_t* Qs = (bf16_t*)smem;
    bf16_t* Ks = Qs + 128 * A_LDQ;
    bf16_t* Vt = Ks + 128 * A_LDQ;
    const int tid = tidx(), lane = tid & 63, w = tid >> 6, l15 = lane & 15, lg = lane >> 4;
    const int nqb = set ? LC / 128 : L / 128;
    const int h = item & 7, qb = (item >> 3) % nqb, b = (item >> 3) / nqb, kvh = h >> 2;
    const bf16_t* Q0 = (const bf16_t*)(p.ws + WS_P + P_Q0); const bf16_t* K0 = (const bf16_t*)(p.ws + WS_P + P_K0);
    const int qtok0 = set ? TL + b * LC + qb * 128 : b * L + qb * 128;
    { const int row = tid >> 2, ph = (tid >> 1) & 1, sub = tid & 1;
      rope_store(Q0 + (size_t)(qtok0 + row) * 512 + h * 64, Qs + row * A_LDQ, qb * 128 + row, set == 0, 0.125f, ph, sub); }
    __syncthreads();
    bf16x8 qf[2];
    qf[0] = *(const bf16x8*)(Qs + (w * 16 + l15) * A_LDQ + 8 * lg); qf[1] = *(const bf16x8*)(Qs + (w * 16 + l15) * A_LDQ + 32 + 8 * lg);
    float m_run = p.in[I_SINK][h], l_run = 1.f;
    f32x4 O[4];
#pragma unroll
    for (int i = 0; i < 4; ++i) O[i] = (f32x4){0.f, 0.f, 0.f, 0.f};
    const int nwin = set ? 0 : 3, nctx = LC / 128;
    for (int kbi = 0; kbi < nwin + nctx; ++kbi) {
        const bool win = kbi < nwin; const int kb = win ? qb - 1 + kbi : kbi - nwin;
        if (win && (kb < 0 || kb >= L / 128)) continue;
        const int ktok0 = win ? b * L + kb * 128 : TL + b * LC + kb * 128;
        __syncthreads();
        { const int row = tid >> 2, ph = (tid >> 1) & 1, sub = tid & 1;
          rope_store(K0 + (size_t)(ktok0 + row) * 128 + kvh * 64, Ks + row * A_LDQ, kb * 128 + row, win, 1.f, ph, sub); }
        { const bf16_t* vt = (const bf16_t*)(p.ws + WS_P + (win ? P_VT_LAT : P_VT_CTX)); const int Lx = win ? L : LC;
#pragma unroll
          for (int i = 0; i < 2; ++i) { const int id = tid + NT * i, d = id >> 4, kc = id & 15;
              *(u32x4*)(Vt + d * A_LDV + kc * 8) = *(const u32x4*)(vt + ((size_t)b * 128 + kvh * 64 + d) * Lx + kb * 128 + kc * 8); } }
        __syncthreads();
#pragma unroll
        for (int ch = 0; ch < 2; ++ch) {
            f32x4 st[4];
#pragma unroll
            for (int u = 0; u < 4; ++u) {
                const bf16_t* kr = Ks + ((ch * 4 + u) * 16 + l15) * A_LDQ + 8 * lg;
                f32x4 z = (f32x4){0.f, 0.f, 0.f, 0.f};
                z = __builtin_amdgcn_mfma_f32_16x16x32_bf16(*(const bf16x8*)kr, qf[0], z, 0, 0, 0);
                z = __builtin_amdgcn_mfma_f32_16x16x32_bf16(*(const bf16x8*)(kr + 32), qf[1], z, 0, 0, 0);
                st[u] = z;
            }
            float cmax = -INFINITY;
            if (win) {
                const int qpos = qb * 128 + w * 16 + l15;
#pragma unroll
                for (int u = 0; u < 4; ++u)
#pragma unroll
                    for (int r = 0; r < 4; ++r) { const int kpos = kb * 128 + (ch * 4 + u) * 16 + 4 * lg + r; const int dd = qpos - kpos; if (dd > 128 || dd < -128) st[u][r] = -INFINITY; }
            }
#pragma unroll
            for (int u = 0; u < 4; ++u)
#pragma unroll
                for (int r = 0; r < 4; ++r) cmax = fmaxf(cmax, st[u][r]);
            cmax = fmaxf(cmax, __shfl_xor(cmax, 16)); cmax = fmaxf(cmax, __shfl_xor(cmax, 32));
            const float m_new = fmaxf(m_run, cmax), alpha = __expf(m_run - m_new);
            float ls = 0.f;
#pragma unroll
            for (int u = 0; u < 4; ++u)
#pragma unroll
                for (int r = 0; r < 4; ++r) { const float e = __expf(st[u][r] - m_new); st[u][r] = e; ls += e; }
            ls += __shfl_xor(ls, 16); ls += __shfl_xor(ls, 32);
            l_run = l_run * alpha + ls; m_run = m_new;
#pragma unroll
            for (int i = 0; i < 4; ++i) { O[i][0] *= alpha; O[i][1] *= alpha; O[i][2] *= alpha; O[i][3] *= alpha; }
#pragma unroll
            for (int ss = 0; ss < 2; ++ss) {
                u32x4 pu; pu[0] = pk2(st[2 * ss][0], st[2 * ss][1]); pu[1] = pk2(st[2 * ss][2], st[2 * ss][3]); pu[2] = pk2(st[2 * ss + 1][0], st[2 * ss + 1][1]); pu[3] = pk2(st[2 * ss + 1][2], st[2 * ss + 1][3]);
                const bf16x8 pf = __builtin_bit_cast(bf16x8, pu);
                const int key0 = (ch * 4 + 2 * ss) * 16 + 4 * lg;
#pragma unroll
                for (int dt = 0; dt < 4; ++dt) {
                    const bf16_t* vr = Vt + (dt * 16 + l15) * A_LDV + key0;
                    u32x4 vu; const u32x2 v0 = *(const u32x2*)vr, v1 = *(const u32x2*)(vr + 16); vu[0] = v0[0]; vu[1] = v0[1]; vu[2] = v1[0]; vu[3] = v1[1];
                    O[dt] = __builtin_amdgcn_mfma_f32_16x16x32_bf16(__builtin_bit_cast(bf16x8, vu), pf, O[dt], 0, 0, 0);
                }
            }
        }
    }
    const float il = 1.f / l_run;
    bf16_t* M = (bf16_t*)(p.ws + WS_M) + (size_t)(qtok0 + w * 16 + l15) * 1024 + 512 + h * 64;
#pragma unroll
    for (int dt = 0; dt < 4; ++dt) { u32x2 o; o[0] = pk2(O[dt][0] * il, O[dt][1] * il); o[1] = pk2(O[dt][2] * il, O[dt][3] * il); *(u32x2*)(M + dt * 16 + 4 * lg) = o; }
    __syncthreads();
}
constexpr int P3_HY_LAT = (NB / 2) * 256, P3_HY_CTX = (NB / 2) * 256, P3_AT_LAT = NB * (L / 128) * 8, P3_AT_CTX = NB * (LC / 128) * 8;
DEV void phase3(const Params& p, unsigned char* smem) {
    const int total = P3_HY_LAT + P3_AT_LAT + P3_HY_CTX + P3_AT_CTX;
    for (int it = blockIdx.x; it < total; it += gridDim.x) {
        int i = it;
        if (i < P3_HY_LAT) { hyena_item(p, 0, i, smem); continue; } i -= P3_HY_LAT;
        if (i < P3_AT_LAT) { attn_item(p, 0, i, smem); continue; } i -= P3_AT_LAT;
        if (i < P3_HY_CTX) { hyena_item(p, 1, i, smem); continue; } i -= P3_HY_CTX;
        attn_item(p, 1, i, smem);
    }
}

constexpr int K_LDK = 136, K_LDS = 129, K_LDC = 52;
DEV unsigned fkey(float f) { const unsigned u = __builtin_bit_cast(unsigned, f); return (u & 0x80000000u) ? ~u : (u | 0x80000000u); }
constexpr int cand_off(int i) { int o = 0; for (int k = 0; k < i; ++k) o += 16 / (k + 1); return o; }
DEV void topk_load_keys(const Params& p, int layer, int h, unsigned char* smem) {
    bf16_t* Ks = (bf16_t*)smem;
    const bf16_t* keys = (const bf16_t*)(p.ws + WS_W + W_KEYS) + (size_t)layer * 262144 + (size_t)h * 32768;
    const int tid = tidx();
#pragma unroll
    for (int i = 0; i < 8; ++i) { const int id = tid + NT * i, row = id >> 4, kc = id & 15; *(u32x4*)(Ks + row * K_LDK + kc * 8) = *(const u32x4*)(keys + (size_t)row * 128 + kc * 8); }
    __syncthreads();
}
DEV void topk_item(const Params& p, int h, int tok0, unsigned char* smem) {
    bf16_t* Ks = (bf16_t*)smem;
    float* Sc = (float*)(Ks + 2 * 128 * K_LDK);
    float* s12 = Sc + 64 * K_LDS;
    int* i12 = (int*)(s12 + 64 * 32);
    unsigned* ck = (unsigned*)(i12 + 64 * 32);
    float* tops = (float*)(ck + 64 * K_LDC);
    int* topi = (int*)(tops + 64 * 16);
    const int tid = tidx(), lane = tid & 63, w = tid >> 6;
    const bf16_t* PQ = (const bf16_t*)(p.ws + WS_P);
    for (int part = 0; part < 2; ++part) {
        { const int mi = w >> 2, ni = w & 3;
          f32x16 acc;
#pragma unroll
          for (int r = 0; r < 16; ++r) acc[r] = 0.f;
          const bf16_t* ag = PQ + (size_t)(tok0 + mi * 32 + (lane & 31)) * 2048 + h * 256 + part * 128 + 8 * (lane >> 5);
          const bf16_t* bs = Ks + (part * 128 + ni * 32 + (lane & 31)) * K_LDK + 8 * (lane >> 5);
          bf16x8 af[8];
#pragma unroll
          for (int kk = 0; kk < 8; ++kk) af[kk] = *(const bf16x8*)(ag + kk * 16);
#pragma unroll
          for (int kk = 0; kk < 8; ++kk) acc = __builtin_amdgcn_mfma_f32_32x32x16_bf16(af[kk], *(const bf16x8*)(bs + kk * 16), acc, 0, 0, 0);
#pragma unroll
          for (int r = 0; r < 16; ++r) Sc[(mi * 32 + (r & 3) + 8 * (r >> 2) + 4 * (lane >> 5)) * K_LDS + ni * 32 + (lane & 31)] = acc[r]; }
        __syncthreads();
        const int row = tid >> 3, n0 = (tid & 7) * 16;
        float mine[16]; unsigned mk[16], rank[16];
#pragma unroll
        for (int i = 0; i < 16; ++i) { mine[i] = Sc[row * K_LDS + n0 + i]; mk[i] = (fkey(mine[i]) & ~127u) | (unsigned)(127 - (n0 + i)); rank[i] = 0u; }
        __syncthreads();
        unsigned* Sk = (unsigned*)Sc;
#pragma unroll
        for (int i = 0; i < 16; ++i) Sk[row * K_LDS + n0 + i] = mk[i];
        __syncthreads();
#pragma unroll 4
        for (int mm = 0; mm < 128; ++mm) {
            const unsigned o = Sk[row * K_LDS + mm];
#pragma unroll
            for (int i = 0; i < 16; ++i) rank[i] += (o > mk[i]) ? 1u : 0u;
        }
#pragma unroll
        for (int i = 0; i < 16; ++i) if (rank[i] < 16u) { s12[(row * 2 + part) * 16 + rank[i]] = mine[i]; i12[(row * 2 + part) * 16 + rank[i]] = n0 + i; }
        __syncthreads();
    }
    {
        const int row = tid >> 3, sub = tid & 7;
        const float* s1 = s12 + row * 32; const float* s2 = s1 + 16;
        float cval[7]; unsigned ckey[7]; int cidx[7];
#pragma unroll
        for (int m = 0; m < 7; ++m) {
            const int cc = sub + 8 * m; int ci = 0, off = 0;
#pragma unroll
            for (int i = 0; i < 15; ++i) { const bool ge = cc >= cand_off(i + 1); ci += ge ? 1 : 0; off += ge ? 16 / (i + 1) : 0; }
            const int cj = cc - off;
            if (cc < 50) { cval[m] = s1[ci] + s2[cj]; ckey[m] = (fkey(cval[m]) & ~255u) | (unsigned)(255 - (ci * 16 + cj)); cidx[m] = i12[row * 32 + ci] * 128 + i12[row * 32 + 16 + cj]; ck[row * K_LDC + cc] = ckey[m]; }
            else { cval[m] = 0.f; ckey[m] = 0u; cidx[m] = 0; }
        }
        __syncthreads();
        unsigned rk[7];
#pragma unroll
        for (int m = 0; m < 7; ++m) rk[m] = 0u;
        for (int o = 0; o < 50; ++o) {
            const unsigned ko = ck[row * K_LDC + o];
#pragma unroll
            for (int m = 0; m < 7; ++m) rk[m] += (ko > ckey[m]) ? 1u : 0u;
        }
#pragma unroll
        for (int m = 0; m < 7; ++m) if (sub + 8 * m < 50 && rk[m] < 16u) { tops[row * 16 + rk[m]] = cval[m]; topi[row * 16 + rk[m]] = cidx[m]; }
    }
    __syncthreads();
    {
        const int row = tid >> 3, sub = tid & 7;
        const float a = tops[row * 16 + 2 * sub], b = tops[row * 16 + 2 * sub + 1];
        float mx = fmaxf(a, b); mx = fmaxf(mx, __shfl_xor(mx, 1)); mx = fmaxf(mx, __shfl_xor(mx, 2)); mx = fmaxf(mx, __shfl_xor(mx, 4));
        const float ea = __expf(a - mx), eb = __expf(b - mx);
        float sm = ea + eb; sm += __shfl_xor(sm, 1); sm += __shfl_xor(sm, 2); sm += __shfl_xor(sm, 4);
        const float inv = 1.f / sm;
        int* IDX = (int*)(p.ws + WS_IDX) + (size_t)(tok0 + row) * 128 + h * 16 + 2 * sub; float* GT = (float*)(p.ws + WS_GATE) + (size_t)(tok0 + row) * 128 + h * 16 + 2 * sub;
        IDX[0] = topi[row * 16 + 2 * sub]; IDX[1] = topi[row * 16 + 2 * sub + 1]; GT[0] = ea * inv; GT[1] = eb * inv;
    }
    __syncthreads();
}
DEV void topk_phase(const Params& p, int layer, int ntok, unsigned char* smem) {
    const int G = gridDim.x, bid = blockIdx.x, h = bid & 7;
    const int nt = ntok / 64;
    if ((G & 7) == 0) {
        if ((bid >> 3) < nt) topk_load_keys(p, layer, h, smem);
        for (int tt = bid >> 3; tt < nt; tt += (G >> 3)) topk_item(p, h, tt * 64, smem);
    } else {
        for (int it = bid; it < nt * 8; it += G) { __syncthreads(); topk_load_keys(p, layer, it & 7, smem); topk_item(p, it & 7, (it >> 3) * 64, smem); }
    }
}

DEV float gelu_f(float x) { return 0.5f * x * (1.f + erff(x * 0.70710678118654752f)); }
DEV void peer_item(const Params& p, int layer, int item) {
    const int tok = item * 8 + (tidx() >> 6), lane = tidx() & 63;
    const bf16_t* A = (const bf16_t*)(p.ws + WS_A) + (size_t)tok * 1024 + lane * 16;
    const bf16_t* UB = (const bf16_t*)(p.ws + WS_UB) + lane * 16; const bf16_t* VB = (const bf16_t*)(p.ws + WS_VB) + lane * 16;
    float x[16], y[16];
    { const u32x4 a0 = *(const u32x4*)A, a1 = *(const u32x4*)(A + 8);
#pragma unroll
      for (int i = 0; i < 4; ++i) { x[2 * i] = bflo(a0[i]); x[2 * i + 1] = bfhi(a0[i]); x[8 + 2 * i] = bflo(a1[i]); x[8 + 2 * i + 1] = bfhi(a1[i]); } }
#pragma unroll
    for (int i = 0; i < 16; ++i) y[i] = 0.f;
    const int* IDX = (const int*)(p.ws + WS_IDX) + (size_t)tok * 128; const float* GT = (const float*)(p.ws + WS_GATE) + (size_t)tok * 128;
    const int i_lo = IDX[lane], i_hi = IDX[64 + lane]; const float g_lo = GT[lane], g_hi = GT[64 + lane];
    for (int k = 0; k < 128; ++k) {
        const int e = __shfl(k < 64 ? i_lo : i_hi, k & 63); const float gt = __shfl(k < 64 ? g_lo : g_hi, k & 63);
        const u32x4 u0 = *(const u32x4*)(UB + (size_t)e * 1024), u1 = *(const u32x4*)(UB + (size_t)e * 1024 + 8);
        const u32x4 v0 = *(const u32x4*)(VB + (size_t)e * 1024), v1 = *(const u32x4*)(VB + (size_t)e * 1024 + 8);
        float d = 0.f;
#pragma unroll
        for (int i = 0; i < 4; ++i) { d += bflo(u0[i]) * x[2 * i] + bfhi(u0[i]) * x[2 * i + 1] + bflo(u1[i]) * x[8 + 2 * i] + bfhi(u1[i]) * x[8 + 2 * i + 1]; }
        d = wave_sum(d);
        const float act = gelu_f(d) * gt;
#pragma unroll
        for (int i = 0; i < 4; ++i) { y[2 * i] += act * bflo(v0[i]); y[2 * i + 1] += act * bfhi(v0[i]); y[8 + 2 * i] += act * bflo(v1[i]); y[8 + 2 * i + 1] += act * bfhi(v1[i]); }
    }
    float* H = (float*)(p.ws + WS_H) + (size_t)tok * 1024 + lane * 16;
    const float* g2 = (const float*)(p.ws + WS_MOD) + ((size_t)layer * NR + mod_row(tok)) * 6144 + 5120 + lane * 16;
    float hv[16]; float ss = 0.f;
#pragma unroll
    for (int i = 0; i < 4; ++i) { const f32x4 hh = *(const f32x4*)(H + 4 * i), gg = *(const f32x4*)(g2 + 4 * i);
#pragma unroll
        for (int j = 0; j < 4; ++j) { const float v = hh[j] + gg[j] * y[4 * i + j]; hv[4 * i + j] = v; ss += v * v; } }
    ss = wave_sum(ss);
    const float rstd = rsqrtf(ss * (1.f / 1024.f) + 1e-6f);
    if (layer == 0) {
#pragma unroll
        for (int i = 0; i < 4; ++i) { f32x4 o; o[0] = hv[4 * i]; o[1] = hv[4 * i + 1]; o[2] = hv[4 * i + 2]; o[3] = hv[4 * i + 3]; *(f32x4*)(H + 4 * i) = o; }
        const float* g = p.in[I_N1G] + 1024 + lane * 16;
        const float* mod = (const float*)(p.ws + WS_MOD) + ((size_t)1 * NR + mod_row(tok)) * 6144 + lane * 16;
        bf16_t* Ao = (bf16_t*)(p.ws + WS_A) + (size_t)tok * 1024 + lane * 16;
        u32x4 o0, o1; float r[16];
#pragma unroll
        for (int i = 0; i < 16; ++i) r[i] = hv[i] * rstd * g[i] * (1.f + mod[1024 + i]) + mod[i];
#pragma unroll
        for (int i = 0; i < 4; ++i) { o0[i] = pk2(r[2 * i], r[2 * i + 1]); o1[i] = pk2(r[8 + 2 * i], r[8 + 2 * i + 1]); }
        *(u32x4*)Ao = o0; *(u32x4*)(Ao + 8) = o1;
    } else {
        const float* g = p.in[I_FG] + lane * 16; float* out = p.out + (size_t)tok * 1024 + lane * 16;
#pragma unroll
        for (int i = 0; i < 4; ++i) { f32x4 o; o[0] = hv[4 * i] * rstd * g[4 * i]; o[1] = hv[4 * i + 1] * rstd * g[4 * i + 1]; o[2] = hv[4 * i + 2] * rstd * g[4 * i + 2]; o[3] = hv[4 * i + 3] * rstd * g[4 * i + 3]; *(f32x4*)(out + 4 * i) = o; }
    }
}

constexpr int SC_CH = 64, SC_KB = SC_CH * 128 * 2, SC_VB = SC_CH * 64 * 2, SC_BUF = 2 * SC_KB + SC_VB, SC_OB = SC_CH * 64 * 2;
DEV void scan_block(const Params& p, int bi, unsigned char* smem) {
    const int tid = tidx(), lane = tid & 63, w = tid >> 6, vq = lane & 3, kg = lane >> 2;
    const int half = bi & 1, dir = (bi >> 1) & 1, h = (bi >> 2) & 7, b = bi >> 5;
    const bf16_t* P1 = (const bf16_t*)(p.ws + WS_P);
    bf16_t* Oo = (bf16_t*)(p.ws + WS_F + (dir ? F_OB : F_OF));
    const int NCH = (LC + L) / SC_CH;
    float S[8][2];
#pragma unroll
    for (int i = 0; i < 8; ++i) { S[i][0] = 0.f; S[i][1] = 0.f; }
    u32x4 rk[2], rq[2], rv;
    const int kcol = 1024 * (1 + dir) + h * 128, qcol = h * 128, vcol = 3072 + h * 128 + half * 64;
#define SC_TOK(step) ((step) < LC ? TL + b * LC + (dir ? LC - 1 - (step) : (step)) : b * L + (dir ? L - 1 - ((step) - LC) : ((step) - LC)))
#define SC_LOAD(c) do { const bool lat_ = (c) * SC_CH >= LC; \
        _Pragma("unroll") for (int i = 0; i < 2; ++i) { const int id = tid + NT * i, r = id >> 4, cc = id & 15; const bf16_t* row = P1 + (size_t)SC_TOK((c) * SC_CH + r) * 5120; \
            rk[i] = *(const u32x4*)(row + kcol + cc * 8); if (lat_) rq[i] = *(const u32x4*)(row + qcol + cc * 8); } \
        { const int r = tid >> 3, cc = tid & 7; rv = *(const u32x4*)(P1 + (size_t)SC_TOK((c) * SC_CH + r) * 5120 + vcol + cc * 8); } } while (0)
#define SC_STORE(buf) do { unsigned char* base_ = smem + (buf) * SC_BUF; \
        _Pragma("unroll") for (int i = 0; i < 2; ++i) { const int id = tid + NT * i; *(u32x4*)(base_ + id * 16) = rk[i]; *(u32x4*)(base_ + SC_KB + id * 16) = rq[i]; } \
        *(u32x4*)(base_ + 2 * SC_KB + tid * 16) = rv; } while (0)
    rq[0] = (u32x4){0u, 0u, 0u, 0u}; rq[1] = rq[0];
    SC_LOAD(0); SC_STORE(0); __syncthreads();
    for (int c = 0; c < NCH; ++c) {
        const int buf = c & 1; const bool lat = c * SC_CH >= LC;
        if (c + 1 < NCH) SC_LOAD(c + 1);
        const unsigned char* kb = smem + buf * SC_BUF + kg * 16; const unsigned char* qb = kb + SC_KB; const unsigned char* vb = smem + buf * SC_BUF + 2 * SC_KB + (w * 8 + 2 * vq) * 2;
        bf16_t* ob = (bf16_t*)(smem + 2 * SC_BUF + buf * SC_OB);
        for (int r0 = 0; r0 < SC_CH; r0 += 8) {
            float oo[16];
            u32x4 ku8[8], qu8[8]; unsigned vu8[8];
#pragma unroll
            for (int sst = 0; sst < 8; ++sst) { ku8[sst] = *(const u32x4*)(kb + (r0 + sst) * 256); vu8[sst] = *(const unsigned*)(vb + (r0 + sst) * 128); qu8[sst] = *(const u32x4*)(qb + (r0 + sst) * 256); }
#pragma unroll
            for (int sst = 0; sst < 8; ++sst) {
                const u32x4 ku = ku8[sst], qu = qu8[sst];
                const float v0 = bflo(vu8[sst]), v1 = bfhi(vu8[sst]);
                float kf[8];
#pragma unroll
                for (int i = 0; i < 4; ++i) { kf[2 * i] = bflo(ku[i]); kf[2 * i + 1] = bfhi(ku[i]); }
#pragma unroll
                for (int i = 0; i < 8; ++i) { S[i][0] = fmaf(kf[i], v0 - S[i][0], S[i][0]); S[i][1] = fmaf(kf[i], v1 - S[i][1], S[i][1]); }
                float o0 = 0.f, o1 = 0.f;
#pragma unroll
                for (int i = 0; i < 4; ++i) { const float qa = bflo(qu[i]), qc = bfhi(qu[i]); o0 = fmaf(qa, S[2 * i][0], o0); o1 = fmaf(qa, S[2 * i][1], o1); o0 = fmaf(qc, S[2 * i + 1][0], o0); o1 = fmaf(qc, S[2 * i + 1][1], o1); }
                oo[2 * sst] = o0; oo[2 * sst + 1] = o1;
            }
            if (lat) {
                float r8[8], r4[4], r2[2], r1;
                { const bool hi = (lane & 4) != 0;
#pragma unroll
                  for (int j = 0; j < 8; ++j) { const float send = hi ? oo[j] : oo[8 + j], keep = hi ? oo[8 + j] : oo[j]; r8[j] = keep + __shfl_xor(send, 4); } }
                { const bool hi = (lane & 8) != 0;
#pragma unroll
                  for (int j = 0; j < 4; ++j) { const float send = hi ? r8[j] : r8[4 + j], keep = hi ? r8[4 + j] : r8[j]; r4[j] = keep + __shfl_xor(send, 8); } }
                { const bool hi = (lane & 16) != 0;
#pragma unroll
                  for (int j = 0; j < 2; ++j) { const float send = hi ? r4[j] : r4[2 + j], keep = hi ? r4[2 + j] : r4[j]; r2[j] = keep + __shfl_xor(send, 16); } }
                { const bool hi = (lane & 32) != 0; const float send = hi ? r2[0] : r2[1], keep = hi ? r2[1] : r2[0]; r1 = keep + __shfl_xor(send, 32); }
                const int idx = ((lane >> 2) & 1) * 8 + ((lane >> 3) & 1) * 4 + ((lane >> 4) & 1) * 2 + ((lane >> 5) & 1);
                ob[(r0 + (idx >> 1)) * 64 + w * 8 + 2 * vq + (idx & 1)] = (bf16_t)f2bf(r1);
            }
        }
        if (c + 1 < NCH) SC_STORE(buf ^ 1);
        __syncthreads();
        if (lat) { const int r = tid >> 3, cc = tid & 7; *(u32x4*)(Oo + (size_t)SC_TOK(c * SC_CH + r) * 1024 + h * 128 + half * 64 + cc * 8) = *(const u32x4*)(ob + r * 64 + cc * 8); }
    }
    __syncthreads();
#undef SC_TOK
#undef SC_LOAD
#undef SC_STORE
}
DEV void readout_item(const Params& p, int item) {
    const int tok = item * 8 + (tidx() >> 6), lane = tidx() & 63;
    const bf16_t* of = (const bf16_t*)(p.ws + WS_F + F_OF) + (size_t)tok * 1024 + lane * 16; const bf16_t* ob = (const bf16_t*)(p.ws + WS_F + F_OB) + (size_t)tok * 1024 + lane * 16;
    const bf16_t* gp = (const bf16_t*)(p.ws + WS_P) + (size_t)tok * 5120 + 4096 + lane * 16;
    const float* on = p.in[I_HGON] + (lane & 7) * 16;
    float o[16], gg[16]; float ss = 0.f;
    { const u32x4 a0 = *(const u32x4*)of, a1 = *(const u32x4*)(of + 8), b0 = *(const u32x4*)ob, b1 = *(const u32x4*)(ob + 8), g0 = *(const u32x4*)gp, g1 = *(const u32x4*)(gp + 8);
#pragma unroll
      for (int i = 0; i < 4; ++i) { o[2 * i] = bflo(a0[i]) + bflo(b0[i]); o[2 * i + 1] = bfhi(a0[i]) + bfhi(b0[i]); o[8 + 2 * i] = bflo(a1[i]) + bflo(b1[i]); o[8 + 2 * i + 1] = bfhi(a1[i]) + bfhi(b1[i]);
          gg[2 * i] = bflo(g0[i]); gg[2 * i + 1] = bfhi(g0[i]); gg[8 + 2 * i] = bflo(g1[i]); gg[8 + 2 * i + 1] = bfhi(g1[i]); } }
#pragma unroll
    for (int i = 0; i < 16; ++i) ss += o[i] * o[i];
    ss += __shfl_xor(ss, 1); ss += __shfl_xor(ss, 2); ss += __shfl_xor(ss, 4);
    const float rstd = rsqrtf(ss * (1.f / 128.f) + 1e-6f);
    bf16_t* M = (bf16_t*)(p.ws + WS_M) + (size_t)tok * 1024 + lane * 16;
    u32x4 o0, o1; float r[16];
#pragma unroll
    for (int i = 0; i < 16; ++i) r[i] = o[i] * rstd * on[i] * gg[i];
#pragma unroll
    for (int i = 0; i < 4; ++i) { o0[i] = pk2(r[2 * i], r[2 * i + 1]); o1[i] = pk2(r[8 + 2 * i], r[8 + 2 * i + 1]); }
    *(u32x4*)M = o0; *(u32x4*)(M + 8) = o1;
}

#ifndef HOST_EMU
#define XB_TMO      128
#define XB_XCNT(j)  (256  + 64 * (j))
#define XB_XSUB(j)  (1280 + 64 * (j))
#define XB_XGEN(j)  (2304 + 64 * (j))
#define XB_TOP      3328
#define XB_TOPGEN   3392
#define XCD_BAR_WORDS 3456
#define XB_SPIN_CAP (1u << 18)
#define LAS __attribute__((address_space(3)))

__device__ __forceinline__ unsigned xb_ld(unsigned* p)              { return __hip_atomic_load(p, __ATOMIC_RELAXED, __HIP_MEMORY_SCOPE_AGENT); }
__device__ __forceinline__ unsigned xb_add(unsigned* p, unsigned v) { return __hip_atomic_fetch_add(p, v, __ATOMIC_RELAXED, __HIP_MEMORY_SCOPE_AGENT); }
__device__ __forceinline__ unsigned xb_xcc_id() { return (unsigned)__builtin_amdgcn_s_getreg((3 << 11) | 20) & 0xFu; }
#define XB_SPIN(cond, bar) do { unsigned _sp = 0; while (cond) { __builtin_amdgcn_s_sleep(1); \
    if ((++_sp & 255u) == 0u) { if (xb_ld(&(bar)[XB_TMO])) break; if (_sp > XB_SPIN_CAP) { atomicAdd(&(bar)[XB_TMO], 1u); break; } } } } while (0)

struct XcdBarrier {
    unsigned* bar; unsigned x;
    volatile LAS unsigned* st;
};

__device__ __forceinline__ XcdBarrier xcd_barrier_post(unsigned* bar, volatile LAS unsigned* st) {
    XcdBarrier b; b.bar = bar; b.x = xb_xcc_id(); b.st = st;
    if (threadIdx.x == 0) (void)xb_add(&bar[XB_XCNT(b.x)], 1u);
    return b;
}
__device__ __forceinline__ void xcd_barrier_complete(unsigned* bar, unsigned x, unsigned& nloc, unsigned& nx) {
    const unsigned G = gridDim.x * gridDim.y * gridDim.z;
    unsigned sum, cnt, mine, sp = 0u;
    for (;;) {
        sum = 0u; cnt = 0u; mine = 0u;
#pragma unroll
        for (unsigned j = 0; j < 16; ++j) { const unsigned c = xb_ld(&bar[XB_XCNT(j)]); sum += c; cnt += (c > 0u) ? 1u : 0u; mine = (j == x) ? c : mine; }
        if (sum == G) break;
        __builtin_amdgcn_s_sleep(1);
        if ((++sp & 255u) == 0u) { if (xb_ld(&bar[XB_TMO])) break; if (sp > XB_SPIN_CAP) { atomicAdd(&bar[XB_TMO], 1u); break; } }
    }
    nloc = mine > 0u ? mine : 1u; nx = cnt > 0u ? cnt : 1u;
}

__device__ __forceinline__ void xcd_barrier(const XcdBarrier& b) {
    asm volatile("s_waitcnt vmcnt(0)" ::: "memory");
    __syncthreads();
    if (threadIdx.x == 0) {
        unsigned* bar = b.bar;
        __builtin_amdgcn_s_waitcnt(0);
        unsigned nloc = b.st[0], nx = b.st[1];
        if (nloc == 0u) { xcd_barrier_complete(bar, b.x, nloc, nx); b.st[0] = nloc; b.st[1] = nx; }
        const unsigned old = xb_add(&bar[XB_XSUB(b.x)], 1u);
        const unsigned gen = old / nloc;
        if (old + 1u == (gen + 1u) * nloc) {
            __builtin_amdgcn_fence(__ATOMIC_RELEASE, "agent");
            asm volatile("s_waitcnt vmcnt(0)" ::: "memory");
            const unsigned og = xb_add(&bar[XB_TOP], 1u);
            const unsigned tg = og / nx;
            if (og + 1u == (tg + 1u) * nx) xb_add(&bar[XB_TOPGEN], 1u);
            else XB_SPIN(xb_ld(&bar[XB_TOPGEN]) == tg, bar);
            __builtin_amdgcn_fence(__ATOMIC_ACQUIRE, "agent");
            xb_add(&bar[XB_XGEN(b.x)], 1u);
            asm volatile("s_waitcnt vmcnt(0)" ::: "memory");
        } else {
            XB_SPIN(xb_ld(&bar[XB_XGEN(b.x)]) == gen, bar);
            __builtin_amdgcn_fence(__ATOMIC_ACQUIRE, "agent");
            asm volatile("s_waitcnt vmcnt(0)" ::: "memory");
        }
    }
    __syncthreads();
}

#endif
#ifdef NOINLINE_PHASES
#define NOINL __device__ __attribute__((noinline))
#else
#define NOINL __device__ __forceinline__
#endif
__shared__ __attribute__((aligned(16))) unsigned char g_smem[SMEM_BYTES + 16];
#define PH_COMMON const int G = gridDim.x, bid = blockIdx.x; unsigned char* smem = g_smem; (void)smem; (void)G; (void)bid; \
    const bf16_t* A = (const bf16_t*)(p.ws + WS_A); const bf16_t* Mx = (const bf16_t*)(p.ws + WS_M); const bf16_t* W = (const bf16_t*)(p.ws + WS_W); (void)A; (void)Mx; (void)W;
NOINL void ph0(const Params& p) { PH_COMMON phase0(p, smem); }
NOINL void ph1(const Params& p) { PH_COMMON phase1(p, smem); }
NOINL void ph2(const Params& p) { PH_COMMON EpiL0In e{p.ws}; for (int t = bid; t < (T / 256) * 18; t += G) gemm_tile(A, W + W_IN0 / 2, (t / 18) * 256, (t % 18) * 128, smem, e); }
NOINL void ph3(const Params& p) { PH_COMMON phase3(p, smem); }
NOINL void ph4(const Params& p) { PH_COMMON EpiRes e{&p, 1, 0, 2048}; for (int t = bid; t < (T / 256) * 8; t += G) gemm_tile(Mx, W + W_OUT0 / 2, (t / 8) * 256, (t % 8) * 128, smem, e); }
NOINL void ph5(const Params& p) { PH_COMMON for (int it = bid; it < T / 8; it += G) norm_rows_item(p, it, 0, p.in[I_N2G], 0, 3072); }
NOINL void ph6(const Params& p) { PH_COMMON EpiBf16 e{(bf16_t*)(p.ws + WS_P), 2048}; for (int t = bid; t < (T / 256) * 16; t += G) gemm_tile(A, W + W_Q0 / 2, (t / 16) * 256, (t % 16) * 128, smem, e); }
NOINL void ph7(const Params& p) { PH_COMMON topk_phase(p, 0, T, smem); }
NOINL void ph8(const Params& p) { PH_COMMON for (int it = bid; it < T / 8; it += G) peer_item(p, 0, it); }
NOINL void ph9(const Params& p) { PH_COMMON EpiHg e{(bf16_t*)(p.ws + WS_P), p.in[I_HGLB]};
    for (int t = bid; t < (T / 256) * 40; t += G) { const int mt = t / 40, nt = t % 40; if (mt >= TL / 256 && (nt < 8 || nt >= 32)) continue; gemm_tile(A, W + W_IN1 / 2, mt * 256, nt * 128, smem, e); } }
NOINL void ph10(const Params& p) { PH_COMMON for (int bi = bid; bi < NB * 32; bi += G) scan_block(p, bi, smem); }
NOINL void ph11(const Params& p) { PH_COMMON for (int it = bid; it < TL / 8 + 2 * P0_TAB; it += G) { if (it < TL / 8) readout_item(p, it); else tables_layer1(p, it - TL / 8); } }
NOINL void ph12(const Params& p) { PH_COMMON EpiRes e{&p, 0, 1, 2048}; for (int t = bid; t < (TL / 256) * 8; t += G) gemm_tile(Mx, W + W_OUT1 / 2, (t / 8) * 256, (t % 8) * 128, smem, e); }
NOINL void ph13(const Params& p) { PH_COMMON for (int it = bid; it < TL / 8; it += G) norm_rows_item(p, it, 0, p.in[I_N2G] + 1024, 1, 3072); }
NOINL void ph14(const Params& p) { PH_COMMON EpiBf16 e{(bf16_t*)(p.ws + WS_P), 2048}; for (int t = bid; t < (TL / 256) * 16; t += G) gemm_tile(A, W + W_Q1 / 2, (t / 16) * 256, (t % 16) * 128, smem, e); }
NOINL void ph15(const Params& p) { PH_COMMON topk_phase(p, 1, TL, smem); }
NOINL void ph16(const Params& p) { PH_COMMON for (int it = bid; it < TL / 8; it += G) peer_item(p, 1, it); }

constexpr int NPHASE = 17;
__global__ void __launch_bounds__(NT, 2) mega(Params p_in) {
    const int ph_lo = p_in.ph_lo, ph_hi = p_in.ph_hi;
#ifndef HOST_EMU
#define GBAR_MAKE() XcdBarrier gbar; gbar.bar = (unsigned*)(p_in.ws + WS_CTRL); gbar.x = xb_xcc_id(); gbar.st = (volatile LAS unsigned*)(LAS unsigned char*)(g_smem + SMEM_BYTES);
    if (ph_hi - ph_lo > 1) {
        volatile LAS unsigned* st = (volatile LAS unsigned*)(LAS unsigned char*)(g_smem + SMEM_BYTES);
        if (threadIdx.x == 0) { st[0] = 0u; st[1] = 0u; }
        __syncthreads();
        (void)xcd_barrier_post((unsigned*)(p_in.ws + WS_CTRL), st);
    }
#endif
    for (int ph = ph_lo; ph < ph_hi; ++ph) {
        if (ph > ph_lo) {
#ifndef HOST_EMU
            { GBAR_MAKE(); xcd_barrier(gbar); }
#endif
        }
#ifndef HOST_EMU
        unsigned long long kp = (unsigned long long)__builtin_amdgcn_kernarg_segment_ptr();
        asm volatile("" : "+s"(kp) :: "memory");
        const Params& p = *(const Params*)(const __attribute__((address_space(4))) Params*)kp;
#else
        const Params& p = p_in;
#endif
#ifdef ONLY_PHASE
        if (ph != ONLY_PHASE) continue;
#endif
#ifdef REPEAT_MASK
        for (int rep_ = ((REPEAT_MASK >> ph) & 1); rep_ >= 0; --rep_) { if (rep_ == 0 && ((REPEAT_MASK >> ph) & 1)) { GBAR_MAKE(); xcd_barrier(gbar); }
#else
        {
#endif
        switch (ph) {
        case 0: ph0(p); break; case 1: ph1(p); break; case 2: ph2(p); break; case 3: ph3(p); break; case 4: ph4(p); break; case 5: ph5(p); break;
        case 6: ph6(p); break; case 7: ph7(p); break; case 8: ph8(p); break; case 9: ph9(p); break; case 10: ph10(p); break; case 11: ph11(p); break;
        case 12: ph12(p); break; case 13: ph13(p); break; case 14: ph14(p); break; case 15: ph15(p); break; case 16: ph16(p); break;
        default: break;
        }
        }
    }
}

#ifndef HOST_EMU
extern "C" void kernel_launch(void* const* d_in, const int* in_sizes, int n_in, void* d_out, int out_size, void* d_ws, size_t ws_size, hipStream_t stream) {
    if (n_in != 29 || ws_size < WS_END || out_size != TL * 1024) { fprintf(stderr, "kernel_launch: unexpected sizes (n_in %d, ws %zu need %zu, out %d)\n", n_in, ws_size, (size_t)WS_END, out_size); return; }
    static int grid = 0;
    if (!grid) { int dev = 0, cus = 0; hipGetDevice(&dev); hipDeviceGetAttribute(&cus, hipDeviceAttributeMultiprocessorCount, dev); grid = cus > 0 ? cus : 256; }
    hipMemsetAsync((unsigned char*)d_ws + WS_CTRL, 0, CTRL_BYTES, stream);
    Params p{};
    for (int i = 0; i < 29; ++i) p.in[i] = (const float*)d_in[i];
    p.out = (float*)d_out; p.ws = (unsigned char*)d_ws;
#ifdef MULTI_LAUNCH
    for (int ph = 0; ph < NPHASE; ++ph) { p.ph_lo = ph; p.ph_hi = ph + 1; hipLaunchKernelGGL(mega, dim3(grid), dim3(NT), 0, stream, p); }
#else
    p.ph_lo = 0; p.ph_hi = NPHASE;
    hipLaunchKernelGGL(mega, dim3(grid), dim3(NT), 0, stream, p);
#endif
}
#endif
```

```cpp
#ifndef HOST_EMU
#include <hip/hip_runtime.h>
#include <cstdio>
#endif

#ifndef CFG_B
#define CFG_B 8
#define CFG_L 2048
#define CFG_LC 256
#endif
#define DEV __device__ __forceinline__
#ifndef HOST_EMU
#define SCHED_FENCE() __builtin_amdgcn_sched_barrier(0)
#endif
#ifdef HOST_EMU
#define SCHED_FENCE() do {} while (0)
#define __expf expf
#define __sinf sinf
#define __cosf cosf
#endif

typedef unsigned short bf16_t;
typedef short bf16x8 __attribute__((ext_vector_type(8)));
typedef float f32x16 __attribute__((ext_vector_type(16)));
typedef float f32x4 __attribute__((ext_vector_type(4)));
typedef unsigned u32x4 __attribute__((ext_vector_type(4)));
typedef unsigned u32x2 __attribute__((ext_vector_type(2)));
struct cf2 { float x, y; };

constexpr int NB = CFG_B, L = CFG_L, LC = CFG_LC, D = 1024;
constexpr int TL = NB * L, TC = NB * LC, T = TL + TC;
constexpr int NT = 512;
constexpr int NR = NB + 1;
constexpr int log4ceil(int n) { int s = 0, v = 1; while (v < n) { v *= 4; ++s; } return s; }
constexpr int FS_LAT = log4ceil(2 * L - 1), FS_CTX = log4ceil(2 * LC - 1);
constexpr int NF_LAT = 1 << (2 * FS_LAT), NF_CTX = 1 << (2 * FS_CTX);
static_assert(T % 256 == 0 && TL % 256 == 0 && L % 128 == 0 && LC % 128 == 0 && NB % 2 == 0, "shape");

constexpr size_t al256(size_t x) { return (x + 255) & ~(size_t)255; }
constexpr size_t WS_CTRL = 0, CTRL_BYTES = 65536;
constexpr size_t CTRL_HYNORM = 4096;
constexpr size_t WS_MOD = WS_CTRL + CTRL_BYTES;
constexpr size_t WS_H = al256(WS_MOD + (size_t)2 * NR * 6144 * 4);
constexpr size_t WS_A = al256(WS_H + (size_t)T * 1024 * 4);
constexpr size_t WS_P = al256(WS_A + (size_t)T * 1024 * 2);
constexpr size_t P_BYTES = (size_t)T * 5120 * 2;
constexpr size_t P_HYT_LAT = 0;
constexpr size_t P_HYT_CTX = P_HYT_LAT + (size_t)NB * 1536 * L * 2;
constexpr size_t P_Q0 = P_HYT_CTX + (size_t)NB * 1536 * LC * 2;
constexpr size_t P_K0 = P_Q0 + (size_t)T * 512 * 2;
constexpr size_t P_VT_LAT = P_K0 + (size_t)T * 128 * 2;
constexpr size_t P_VT_CTX = P_VT_LAT + (size_t)NB * 128 * L * 2;
static_assert(P_VT_CTX + (size_t)NB * 128 * LC * 2 <= P_BYTES, "P region");
constexpr size_t WS_M = al256(WS_P + P_BYTES);
constexpr size_t WS_IDX = al256(WS_M + (size_t)T * 1024 * 2);
constexpr size_t WS_GATE = al256(WS_IDX + (size_t)T * 128 * 4);
constexpr size_t WS_T8 = al256(WS_GATE + (size_t)T * 128 * 4);
constexpr size_t WS_S8 = WS_T8 + (size_t)4 * 16384 * 1024;
constexpr size_t WS_W = al256(WS_S8 + (size_t)4 * 16384 * 4);
constexpr size_t W_IN0 = 0, W_OUT0 = W_IN0 + (size_t)2304 * 1024 * 2, W_IN1 = W_OUT0 + (size_t)1024 * 1024 * 2,
                 W_OUT1 = W_IN1 + (size_t)5120 * 1024 * 2, W_Q0 = W_OUT1 + (size_t)1024 * 1024 * 2, W_Q1 = W_Q0 + (size_t)2048 * 1024 * 2,
                 W_KEYS = W_Q1 + (size_t)2048 * 1024 * 2, W_BYTES = W_KEYS + (size_t)2 * 8 * 2 * 128 * 128 * 2;
constexpr size_t WS_F = al256(WS_W + W_BYTES);
constexpr size_t F_HRAW_LAT = 0;
constexpr size_t F_HRAW_CTX = F_HRAW_LAT + (size_t)2048 * L * 4;
constexpr size_t F_HF_LAT = F_HRAW_CTX + (size_t)2048 * LC * 4;
constexpr size_t F_HF_CTX = F_HF_LAT + (size_t)1024 * NF_LAT * 8;
constexpr size_t F_HYP_LAT = F_HF_CTX + (size_t)1024 * NF_CTX * 8;
constexpr size_t F_HYP_CTX = F_HYP_LAT + (size_t)(L / 64) * 2048 * 4;
constexpr size_t F_END = F_HYP_CTX + (size_t)(LC / 64) * 2048 * 4;
constexpr size_t F_OF = 0, F_OB = (size_t)TL * 1024 * 2;
constexpr size_t F_BYTES = F_END > 2 * F_OB ? F_END : 2 * F_OB;
constexpr size_t WS_END = al256(WS_F + F_BYTES);

struct Params { const float* in[29]; float* out; unsigned char* ws; int ph_lo, ph_hi; };
enum { I_X = 0, I_C, I_CTX, I_CCTX, I_ADAW, I_ADAB, I_N1G, I_N2G, I_FG, I_ABWIN, I_ABWOUT, I_HYCW, I_HYCB, I_HYW1, I_HYB1, I_HYW2, I_HYB2, I_HYW3,
       I_HYFREQ, I_HYSKIP, I_SINK, I_HGWIN, I_HGWOUT, I_HGLB, I_HGON, I_PWQ, I_PKEYS, I_PU, I_PV };

constexpr int SMEM_BYTES = 147456;

#ifndef HOST_EMU
DEV int tidx() { int t = threadIdx.x; asm volatile("" : "+v"(t)); return t; }
#else
DEV int tidx() { return (int)threadIdx.x; }
#endif
DEV unsigned f2bf(float f) { unsigned u = __builtin_bit_cast(unsigned, f); return (u + 0x7fffu + ((u >> 16) & 1u)) >> 16; }
DEV float bf2f(unsigned h) { return __builtin_bit_cast(float, (h & 0xffffu) << 16); }
DEV unsigned pk2(float lo, float hi) { return f2bf(lo) | (f2bf(hi) << 16); }
DEV float bflo(unsigned u) { return __builtin_bit_cast(float, u << 16); }
DEV float bfhi(unsigned u) { return __builtin_bit_cast(float, u & 0xffff0000u); }
DEV float silu_f(float x) { return x / (1.f + __expf(-x)); }
DEV float sigmoid_f(float x) { return 1.f / (1.f + __expf(-x)); }
DEV float wave_sum(float v) {
#pragma unroll
    for (int m = 32; m >= 1; m >>= 1) v += __shfl_xor(v, m);
    return v;
}
DEV int mod_row(int tok) { return tok < TL ? tok / L : NB; }

DEV void p0_mod(const Params& p, int item, unsigned char* smem) {
    const int l = item / 96, col0 = (item % 96) * 64, tid = tidx();
    float* sc = (float*)smem;
    float* red = sc + NR * 1024;
    for (int i = tid; i < NR * 1024; i += NT) { const int r = i >> 10, k = i & 1023; const float c = r < NB ? p.in[I_C][r * 1024 + k] : p.in[I_CCTX][k]; sc[i] = c / (1.f + expf(-c)); }
    __syncthreads();
    const int kq = tid >> 6, col = tid & 63;
    float acc[NR];
#pragma unroll
    for (int r = 0; r < NR; ++r) acc[r] = 0.f;
    const float* w = p.in[I_ADAW] + (size_t)l * 1024 * 6144 + col0 + col;
#pragma unroll 4
    for (int k = kq * 128; k < kq * 128 + 128; ++k) {
        const float wv = w[(size_t)k * 6144];
#pragma unroll
        for (int r = 0; r < NR; ++r) acc[r] += sc[r * 1024 + k] * wv;
    }
#pragma unroll
    for (int r = 0; r < NR; ++r) red[(kq * NR + r) * 64 + col] = acc[r];
    __syncthreads();
    float* mod = (float*)(p.ws + WS_MOD);
    for (int i = tid; i < NR * 64; i += NT) {
        const int r = i >> 6, c = i & 63; float s = 0.f;
        for (int q = 0; q < 8; ++q) s += red[(q * NR + r) * 64 + c];
        mod[((size_t)l * NR + r) * 6144 + col0 + c] = s + p.in[I_ADAB][l * 6144 + col0 + c];
    }
    __syncthreads();
}
DEV void p0_transpose(const float* W, bf16_t* Wt, int N, int tile, unsigned char* smem) {
    float* ts = (float*)smem;
    const int ntn = N / 64, kt = tile / ntn, nt = tile % ntn, k0 = kt * 64, n0 = nt * 64, tid = tidx();
    for (int i = tid; i < 4096; i += NT) { const int kk = i >> 6, nn = i & 63; ts[kk * 65 + nn] = W[(size_t)(k0 + kk) * N + n0 + nn]; }
    __syncthreads();
    for (int i = tid; i < 4096; i += NT) { const int nn = i >> 6, kk = i & 63; Wt[(size_t)(n0 + nn) * 1024 + k0 + kk] = (bf16_t)f2bf(ts[kk * 65 + nn]); }
    __syncthreads();
}
DEV void p0_convert(const float* src, bf16_t* dst, int item) {
    const int tid = tidx();
#pragma unroll
    for (int i = 0; i < 8; ++i) {
        const size_t e = (size_t)item * 16384 + (size_t)(i * NT + tid) * 4;
        const f32x4 v = *(const f32x4*)(src + e);
        u32x2 o; o[0] = pk2(v[0], v[1]); o[1] = pk2(v[2], v[3]);
        *(u32x2*)(dst + e) = o;
    }
}
DEV void p0_table8(const Params& p, int tab, int item) {
    const int row = item * 8 + (tidx() >> 6), lane = tidx() & 63;
    const float* src = (tab & 1 ? p.in[I_PV] : p.in[I_PU]) + ((size_t)(tab >> 1) * 16384 + row) * 1024 + lane * 16;
    f32x4 v[4]; float mx = 0.f;
#pragma unroll
    for (int i = 0; i < 4; ++i) { v[i] = *(const f32x4*)(src + 4 * i); mx = fmaxf(mx, fmaxf(fmaxf(fabsf(v[i][0]), fabsf(v[i][1])), fmaxf(fabsf(v[i][2]), fabsf(v[i][3])))); }
#pragma unroll
    for (int m = 32; m >= 1; m >>= 1) mx = fmaxf(mx, __shfl_xor(mx, m));
    const float sc = mx > 0.f ? 240.f / mx : 1.f;
    u32x4 o;
#pragma unroll
    for (int i = 0; i < 4; ++i) { int w = __builtin_amdgcn_cvt_pk_fp8_f32(v[i][0] * sc, v[i][1] * sc, 0, false); w = __builtin_amdgcn_cvt_pk_fp8_f32(v[i][2] * sc, v[i][3] * sc, w, true); o[i] = (unsigned)w; }
    *(u32x4*)(p.ws + WS_T8 + ((size_t)tab * 16384 + row) * 1024 + lane * 16) = o;
    if (lane == 0) ((float*)(p.ws + WS_S8))[tab * 16384 + row] = mx > 0.f ? mx * (1.f / 240.f) : 1.f;
}
DEV void p0_filter(const Params& p, int set, int chunk, unsigned char* smem) {
    const int Ls = set ? LC : L, l0 = chunk * 64, tid = tidx();
    float* z = (float*)smem;
    float* hd1 = z + 64 * 34;
    float* hd2 = hd1 + 64 * 65;
    const float* w1 = p.in[I_HYW1]; const float* b1 = p.in[I_HYB1]; const float* w2 = p.in[I_HYW2]; const float* b2 = p.in[I_HYB2];
    const float* w3 = p.in[I_HYW3]; const float* fq = p.in[I_HYFREQ];
    for (int i = tid; i < 64 * 33; i += NT) {
        const int pp = i / 33, f = i % 33, l = l0 + pp; float val;
        if (f == 0) val = (float)l / (float)(Ls - 1);
        else { const int jb = (f - 1) & 15; const float fj = 1e-4f + (float)jb * ((15.f - 1e-4f) / 15.f); const float a = fj * (6.283185307179586f * (float)l / (float)Ls); val = f <= 16 ? __cosf(a) : -__sinf(a); }
        z[pp * 34 + f] = val;
    }
    __syncthreads();
    for (int i = tid; i < 4096; i += NT) {
        const int pp = i >> 6, j = i & 63; float s = b1[j];
#pragma unroll 4
        for (int f = 0; f < 33; ++f) s += z[pp * 34 + f] * w1[f * 64 + j];
        hd1[pp * 65 + j] = __sinf(fq[j] * s);
    }
    __syncthreads();
    for (int i = tid; i < 4096; i += NT) {
        const int pp = i >> 6, j = i & 63; float s = b2[j];
#pragma unroll 4
        for (int f = 0; f < 64; ++f) s += hd1[pp * 65 + f] * w2[f * 64 + j];
        hd2[pp * 65 + j] = __sinf(fq[j] * s);
    }
    __syncthreads();
    const float max_decay = -15.350567286626973f, min_decay = -3.0701134573253945f;
    float* hraw = (float*)(p.ws + WS_F + (set ? F_HRAW_CTX : F_HRAW_LAT));
    float* hyn = (float*)(p.ws + WS_F + (set ? F_HYP_CTX : F_HYP_LAT)) + (size_t)chunk * 2048;
    for (int cb = 0; cb < 4; ++cb) {
        const int o = cb * NT + tid;
        const int c = o & 511; const float delta = fabsf(min_decay + (float)c * ((max_decay - min_decay) / 511.f));
        float asum = 0.f;
        float* dst = hraw + (size_t)o * Ls + l0;
        for (int ph = 0; ph < 2; ++ph) {
            float acc[32];
#pragma unroll
            for (int pp = 0; pp < 32; ++pp) acc[pp] = 0.f;
#pragma unroll 2
            for (int j = 0; j < 64; ++j) {
                const float wv = w3[j * 2048 + o];
#pragma unroll
                for (int pp = 0; pp < 32; ++pp) acc[pp] = fmaf(hd2[(ph * 32 + pp) * 65 + j], wv, acc[pp]);
            }
#pragma unroll
            for (int q4 = 0; q4 < 8; ++q4) {
                f32x4 v;
#pragma unroll
                for (int e = 0; e < 4; ++e) { const int pp = q4 * 4 + e; const float tl = (float)(l0 + ph * 32 + pp) / (float)(Ls - 1); const float val = acc[pp] * expf(-tl * delta); v[e] = val; asum += fabsf(val); }
                *(f32x4*)(dst + ph * 32 + q4 * 4) = v;
            }
        }
        hyn[o] = asum;
    }
    __syncthreads();
}

constexpr int P0_MOD = 192, P0_TR_IN0 = 16 * 36, P0_TR_OUT0 = 256, P0_TR_IN1 = 16 * 80, P0_TR_OUT1 = 256, P0_TR_Q = 16 * 32, P0_KEYS = 32, P0_TAB = 2048,
              P0_FILT = L / 64 + LC / 64;
DEV void phase0(const Params& p, unsigned char* smem) {
    bf16_t* W = (bf16_t*)(p.ws + WS_W);
    const int total = P0_MOD + P0_FILT + P0_TR_IN0 + P0_TR_OUT0 + P0_TR_IN1 + P0_TR_OUT1 + 2 * P0_TR_Q + P0_KEYS + 4 * P0_TAB;
    for (int it = blockIdx.x; it < total; it += gridDim.x) {
        int i = it;
        if (i < P0_MOD) { p0_mod(p, i, smem); continue; } i -= P0_MOD;
        if (i < P0_FILT) { if (i < L / 64) p0_filter(p, 0, i, smem); else p0_filter(p, 1, i - L / 64, smem); continue; } i -= P0_FILT;
        if (i < P0_TR_IN0) { p0_transpose(p.in[I_ABWIN], W + W_IN0 / 2, 2304, i, smem); continue; } i -= P0_TR_IN0;
        if (i < P0_TR_OUT0) { p0_transpose(p.in[I_ABWOUT], W + W_OUT0 / 2, 1024, i, smem); continue; } i -= P0_TR_OUT0;
        if (i < P0_TR_IN1) { p0_transpose(p.in[I_HGWIN], W + W_IN1 / 2, 5120, i, smem); continue; } i -= P0_TR_IN1;
        if (i < P0_TR_OUT1) { p0_transpose(p.in[I_HGWOUT], W + W_OUT1 / 2, 1024, i, smem); continue; } i -= P0_TR_OUT1;
        if (i < P0_TR_Q) { p0_transpose(p.in[I_PWQ], W + W_Q0 / 2, 2048, i, smem); continue; } i -= P0_TR_Q;
        if (i < P0_TR_Q) { p0_transpose(p.in[I_PWQ] + (size_t)1024 * 2048, W + W_Q1 / 2, 2048, i, smem); continue; } i -= P0_TR_Q;
        if (i < P0_KEYS) { p0_convert(p.in[I_PKEYS], W + W_KEYS / 2, i); continue; } i -= P0_KEYS;
        p0_table8(p, i / P0_TAB, i % P0_TAB);
    }
}

DEV const float* h_row(const Params& p, int layer_src_inputs, int tok) {
    if (layer_src_inputs) return tok < TL ? p.in[I_X] + (size_t)tok * 1024 : p.in[I_CTX] + (size_t)(tok - TL) * 1024;
    return (const float*)(p.ws + WS_H) + (size_t)tok * 1024;
}
DEV void norm_row_store(const Params& p, const f32x4 (&v)[4], int tok, const float* g, int layer, int sh_off, int lane) {
    float ss = 0.f;
#pragma unroll
    for (int i = 0; i < 4; ++i) ss += v[i][0] * v[i][0] + v[i][1] * v[i][1] + v[i][2] * v[i][2] + v[i][3] * v[i][3];
    ss = wave_sum(ss);
    const float rstd = rsqrtf(ss * (1.f / 1024.f) + 1e-6f);
    const float* mod = (const float*)(p.ws + WS_MOD) + ((size_t)layer * NR + mod_row(tok)) * 6144 + sh_off;
    bf16_t* A = (bf16_t*)(p.ws + WS_A) + (size_t)tok * 1024;
#pragma unroll
    for (int i = 0; i < 4; ++i) {
        const int c = i * 256 + lane * 4;
        const f32x4 gg = *(const f32x4*)(g + c), sh = *(const f32x4*)(mod + c), sc = *(const f32x4*)(mod + 1024 + c);
        u32x2 o;
        o[0] = pk2(v[i][0] * rstd * gg[0] * (1.f + sc[0]) + sh[0], v[i][1] * rstd * gg[1] * (1.f + sc[1]) + sh[1]);
        o[1] = pk2(v[i][2] * rstd * gg[2] * (1.f + sc[2]) + sh[2], v[i][3] * rstd * gg[3] * (1.f + sc[3]) + sh[3]);
        *(u32x2*)(A + c) = o;
    }
}
DEV void norm_rows_item(const Params& p, int item, int from_inputs, const float* g, int layer, int sh_off) {
    const int tok = item * 8 + (tidx() >> 6), lane = tidx() & 63;
    const float* src = h_row(p, from_inputs, tok);
    f32x4 v[4];
#pragma unroll
    for (int i = 0; i < 4; ++i) v[i] = *(const f32x4*)(src + i * 256 + lane * 4);
    norm_row_store(p, v, tok, g, layer, sh_off, lane);
}

DEV cf2 cmul(cf2 a, cf2 b) { cf2 r; r.x = a.x * b.x - a.y * b.y; r.y = a.x * b.y + a.y * b.x; return r; }
DEV cf2 twid(int k, float invN) { cf2 r; const float a = (float)k * invN; r.x = __builtin_amdgcn_cosf(a); r.y = -__builtin_amdgcn_sinf(a); return r; }
DEV void fft_fwd(cf2* buf, int S, int g, int G) {
    const int N = 1 << (2 * S); const float invN = 1.f / (float)N;
    for (int s = 0; s < S; ++s) {
        const int lm = 2 * (S - s), m = 1 << lm, q = m >> 2;
        for (int bf = g; bf < (N >> 2); bf += G) {
            const int j = bf & (q - 1), base = ((bf >> (lm - 2)) << lm) + j;
            const cf2 a0 = buf[base], a1 = buf[base + q], a2 = buf[base + 2 * q], a3 = buf[base + 3 * q];
            cf2 t0, t1, t2, t3; t0.x = a0.x + a2.x; t0.y = a0.y + a2.y; t1.x = a0.x - a2.x; t1.y = a0.y - a2.y; t2.x = a1.x + a3.x; t2.y = a1.y + a3.y;
            const float dx = a1.x - a3.x, dy = a1.y - a3.y; t3.x = dy; t3.y = -dx;
            cf2 y0, y1, y2, y3; y0.x = t0.x + t2.x; y0.y = t0.y + t2.y; y1.x = t1.x + t3.x; y1.y = t1.y + t3.y; y2.x = t0.x - t2.x; y2.y = t0.y - t2.y; y3.x = t1.x - t3.x; y3.y = t1.y - t3.y;
            const int tw = j << (2 * s);
            buf[base] = y0; buf[base + q] = cmul(y1, twid(tw, invN)); buf[base + 2 * q] = cmul(y2, twid(2 * tw, invN)); buf[base + 3 * q] = cmul(y3, twid(3 * tw, invN));
        }
        __syncthreads();
    }
}
DEV void fft_inv(cf2* buf, int S, int g, int G) {
    const int N = 1 << (2 * S); const float invN = 1.f / (float)N;
    for (int s = S - 1; s >= 0; --s) {
        const int lm = 2 * (S - s), m = 1 << lm, q = m >> 2;
        for (int bf = g; bf < (N >> 2); bf += G) {
            const int j = bf & (q - 1), base = ((bf >> (lm - 2)) << lm) + j;
            const int tw = j << (2 * s);
            cf2 w1 = twid(tw, invN), w2 = twid(2 * tw, invN), w3 = twid(3 * tw, invN); w1.y = -w1.y; w2.y = -w2.y; w3.y = -w3.y;
            const cf2 c0 = buf[base], c1 = cmul(buf[base + q], w1), c2 = cmul(buf[base + 2 * q], w2), c3 = cmul(buf[base + 3 * q], w3);
            cf2 t0, t1, t2, t3; t0.x = c0.x + c2.x; t0.y = c0.y + c2.y; t1.x = c0.x - c2.x; t1.y = c0.y - c2.y; t2.x = c1.x + c3.x; t2.y = c1.y + c3.y;
            const float dx = c1.x - c3.x, dy = c1.y - c3.y; t3.x = -dy; t3.y = dx;
            cf2 a0, a1, a2, a3; a0.x = t0.x + t2.x; a0.y = t0.y + t2.y; a1.x = t1.x + t3.x; a1.y = t1.y + t3.y; a2.x = t0.x - t2.x; a2.y = t0.y - t2.y; a3.x = t1.x - t3.x; a3.y = t1.y - t3.y;
            buf[base] = a0; buf[base + q] = a1; buf[base + 2 * q] = a2; buf[base + 3 * q] = a3;
        }
        __syncthreads();
    }
}
DEV void hf_item(const Params& p, int set, int pi, unsigned char* smem) {
    const int Ls = set ? LC : L, S = set ? FS_CTX : FS_LAT, N = 1 << (2 * S);
    const int gi = tidx() >> 8, g = tidx() & 255, idx = pi * 2 + gi, o = idx >> 9, c = idx & 511;
    cf2* buf = (cf2*)smem + (size_t)gi * N;
    const float* hraw = (const float*)(p.ws + WS_F + (set ? F_HRAW_CTX : F_HRAW_LAT));
    const float* hyn = (const float*)(p.ws + WS_F + (set ? F_HYP_CTX : F_HYP_LAT));
    float nsum = 0.f;
    for (int ch = 0; ch < Ls / 64; ++ch) nsum += hyn[(size_t)ch * 2048 + o * 1024 + c] + hyn[(size_t)ch * 2048 + o * 1024 + 512 + c];
    const float inv = 1.f / nsum;
    const float* hf = hraw + (size_t)(o * 1024 + c) * Ls; const float* hb = hraw + (size_t)(o * 1024 + 512 + c) * Ls;
    for (int k = g; k < N; k += 256) { float re = 0.f; if (k < Ls) re = hf[k] * inv; else if (k > N - Ls) re = hb[N - k] * inv; cf2 v; v.x = re; v.y = 0.f; buf[k] = v; }
    __syncthreads();
    fft_fwd(buf, S, g, 256);
    cf2* HF = (cf2*)(p.ws + WS_F + (set ? F_HF_CTX : F_HF_LAT)) + (size_t)(o * 512 + c) * N;
    for (int k = g; k < N; k += 256) HF[k] = buf[k];
    __syncthreads();
}
constexpr int P1_NORM = T / 8, P1_HF = 512;
DEV void phase1(const Params& p, unsigned char* smem) {
    const int total = P1_NORM + 2 * P1_HF;
    for (int it = blockIdx.x; it < total; it += gridDim.x) {
        if (it < P1_NORM) norm_rows_item(p, it, 1, p.in[I_N1G], 0, 0);
        else if (it < P1_NORM + P1_HF) hf_item(p, 0, it - P1_NORM, smem);
        else hf_item(p, 1, it - P1_NORM - P1_HF, smem);
    }
}

constexpr int G_LDA = 72;
template <class Epi>
DEV void gemm_tile(const bf16_t* __restrict__ A, const bf16_t* __restrict__ Wt, int m0, int n0, unsigned char* smem, const Epi& epi) {
    bf16_t* As = (bf16_t*)smem;
    bf16_t* Bs = As + 2 * 256 * G_LDA;
    const int tid = tidx(), lane = tid & 63, w = tid >> 6, wm = w >> 1, wn = w & 1;
    f32x16 acc[2][2];
#pragma unroll
    for (int i = 0; i < 2; ++i)
#pragma unroll
        for (int j = 0; j < 2; ++j)
#pragma unroll
            for (int r = 0; r < 16; ++r) acc[i][j][r] = 0.f;
    u32x4 ra[4], rb[2];
    const bf16_t* Ag = A + (size_t)m0 * 1024; const bf16_t* Bg = Wt + (size_t)n0 * 1024;
#define GLOAD(k0) do { \
        _Pragma("unroll") for (int i = 0; i < 4; ++i) { const int id = tid + NT * i, row = id >> 3, kc = id & 7; ra[i] = *(const u32x4*)(Ag + (size_t)row * 1024 + (k0) + kc * 8); } \
        _Pragma("unroll") for (int i = 0; i < 2; ++i) { const int id = tid + NT * i, row = id >> 3, kc = id & 7; rb[i] = *(const u32x4*)(Bg + (size_t)row * 1024 + (k0) + kc * 8); } } while (0)
#define LSTORE(buf_) do { \
        _Pragma("unroll") for (int i = 0; i < 4; ++i) { const int id = tid + NT * i, row = id >> 3, kc = id & 7; *(u32x4*)(As + ((buf_) * 256 + row) * G_LDA + kc * 8) = ra[i]; } \
        _Pragma("unroll") for (int i = 0; i < 2; ++i) { const int id = tid + NT * i, row = id >> 3, kc = id & 7; *(u32x4*)(Bs + ((buf_) * 128 + row) * G_LDA + kc * 8) = rb[i]; } } while (0)
    GLOAD(0); LSTORE(0); __syncthreads();
    for (int kt = 0; kt < 16; ++kt) {
        const int buf = kt & 1;
        if (kt + 1 < 16) GLOAD((kt + 1) * 64);
        const bf16_t* as = As + (buf * 256 + wm * 64 + (lane & 31)) * G_LDA + 8 * (lane >> 5);
        const bf16_t* bs = Bs + (buf * 128 + wn * 64 + (lane & 31)) * G_LDA + 8 * (lane >> 5);
#pragma unroll
        for (int kk = 0; kk < 4; ++kk) {
            const bf16x8 a0 = *(const bf16x8*)(as + kk * 16), a1 = *(const bf16x8*)(as + 32 * G_LDA + kk * 16);
            const bf16x8 b0 = *(const bf16x8*)(bs + kk * 16), b1 = *(const bf16x8*)(bs + 32 * G_LDA + kk * 16);
            acc[0][0] = __builtin_amdgcn_mfma_f32_32x32x16_bf16(a0, b0, acc[0][0], 0, 0, 0);
            acc[0][1] = __builtin_amdgcn_mfma_f32_32x32x16_bf16(a0, b1, acc[0][1], 0, 0, 0);
            acc[1][0] = __builtin_amdgcn_mfma_f32_32x32x16_bf16(a1, b0, acc[1][0], 0, 0, 0);
            acc[1][1] = __builtin_amdgcn_mfma_f32_32x32x16_bf16(a1, b1, acc[1][1], 0, 0, 0);
        }
        if (kt + 1 < 16) LSTORE(buf ^ 1);
        __syncthreads();
    }
#pragma unroll
    for (int mi = 0; mi < 2; ++mi)
#pragma unroll
        for (int ni = 0; ni < 2; ++ni)
#pragma unroll
            for (int rg = 0; rg < 4; ++rg) {
                const int row = m0 + wm * 64 + mi * 32 + 8 * rg + 4 * (lane >> 5), col = n0 + wn * 64 + ni * 32 + (lane & 31);
                epi(row, col, acc[mi][ni][rg * 4 + 0], acc[mi][ni][rg * 4 + 1], acc[mi][ni][rg * 4 + 2], acc[mi][ni][rg * 4 + 3]);
            }
}
struct EpiL0In {
    unsigned char* ws;
    DEV void operator()(int row, int col, float v0, float v1, float v2, float v3) const {
        u32x2 o; o[0] = pk2(v0, v1); o[1] = pk2(v2, v3);
        const bool lat = row < TL; const int b = lat ? row / L : (row - TL) / LC, t = lat ? row - b * L : (row - TL) - b * LC, Lx = lat ? L : LC;
        if (col < 1536) { bf16_t* d = (bf16_t*)(ws + WS_P + (lat ? P_HYT_LAT : P_HYT_CTX)) + ((size_t)b * 1536 + col) * Lx + t; *(u32x2*)d = o; }
        else if (col < 2048) { bf16_t* d = (bf16_t*)(ws + WS_P + P_Q0) + (size_t)row * 512 + (col - 1536); d[0] = (bf16_t)f2bf(v0); d[512] = (bf16_t)f2bf(v1); d[1024] = (bf16_t)f2bf(v2); d[1536] = (bf16_t)f2bf(v3); }
        else if (col < 2176) { bf16_t* d = (bf16_t*)(ws + WS_P + P_K0) + (size_t)row * 128 + (col - 2048); d[0] = (bf16_t)f2bf(v0); d[128] = (bf16_t)f2bf(v1); d[256] = (bf16_t)f2bf(v2); d[384] = (bf16_t)f2bf(v3); }
        else { bf16_t* d = (bf16_t*)(ws + WS_P + (lat ? P_VT_LAT : P_VT_CTX)) + ((size_t)b * 128 + (col - 2176)) * Lx + t; *(u32x2*)d = o; }
    }
};
struct EpiBf16 {
    bf16_t* out; int ld;
    DEV void operator()(int row, int col, float v0, float v1, float v2, float v3) const {
        bf16_t* d = out + (size_t)row * ld + col; d[0] = (bf16_t)f2bf(v0); d[ld] = (bf16_t)f2bf(v1); d[2 * ld] = (bf16_t)f2bf(v2); d[3 * ld] = (bf16_t)f2bf(v3);
    }
};
struct EpiHg {
    bf16_t* out; const float* lg;
    DEV void operator()(int row, int col, float v0, float v1, float v2, float v3) const {
        float vv[4] = {v0, v1, v2, v3};
        if (col < 1024 || col >= 4096) {
#pragma unroll
            for (int i = 0; i < 4; ++i) vv[i] = silu_f(vv[i]);
        } else if (col < 3072) {
            const int c = col - 1024;
            const float oml = 1.f - 1.f / (1.f + __expf(lg[c] - lg[2048 + c]));
#pragma unroll
            for (int i = 0; i < 4; ++i) vv[i] = oml / (1.f + __expf(vv[i]));
        }
        bf16_t* d = out + (size_t)row * 5120 + col; d[0] = (bf16_t)f2bf(vv[0]); d[5120] = (bf16_t)f2bf(vv[1]); d[2 * 5120] = (bf16_t)f2bf(vv[2]); d[3 * 5120] = (bf16_t)f2bf(vv[3]);
    }
};
struct EpiRes {
    const Params* p; int from_inputs, layer, goff;
    DEV void operator()(int row, int col, float v0, float v1, float v2, float v3) const {
        const float vv[4] = {v0, v1, v2, v3};
        float* H = (float*)(p->ws + WS_H);
        const float* mod = (const float*)(p->ws + WS_MOD) + (size_t)layer * NR * 6144 + goff + col;
#pragma unroll
        for (int i = 0; i < 4; ++i) { const int r = row + i; H[(size_t)r * 1024 + col] = h_row(*p, from_inputs, r)[col] + mod[(size_t)mod_row(r) * 6144] * vv[i]; }
    }
};

DEV float hy_u(const bf16_t* row, int t, int Lx, float w0, float w1, float w2, float b) {
    const float xm = t > 0 ? bf2f(row[t - 1]) : 0.f, x0 = bf2f(row[t]), xp = t + 1 < Lx ? bf2f(row[t + 1]) : 0.f;
    return w0 * xm + w1 * x0 + w2 * xp + b;
}
DEV void hyena_item(const Params& p, int set, int item, unsigned char* smem) {
    const int Ls = set ? LC : L, S = set ? FS_CTX : FS_LAT, N = 1 << (2 * S);
    const int gi = tidx() >> 8, g = tidx() & 255;
    const int bp = item >> 8, c = (item & 255) * 2 + gi, ba = bp * 2, bb = ba + 1;
    cf2* buf = (cf2*)smem + (size_t)gi * N;
    cf2* zk = (cf2*)smem + (size_t)2 * N + (size_t)gi * Ls;
    const bf16_t* hy = (const bf16_t*)(p.ws + WS_P + (set ? P_HYT_CTX : P_HYT_LAT));
    const float* cw = p.in[I_HYCW]; const float* cb = p.in[I_HYCB];
    const cf2* HF = (const cf2*)(p.ws + WS_F + (set ? F_HF_CTX : F_HF_LAT));
    const float invN = 1.f / (float)N;
    {
        const float w0 = cw[c], w1 = cw[1536 + c], w2 = cw[3072 + c], b = cb[c];
        const bf16_t* ra = hy + ((size_t)ba * 1536 + c) * Ls; const bf16_t* rb = hy + ((size_t)bb * 1536 + c) * Ls;
        for (int t = g; t < N; t += 256) { cf2 v; v.x = 0.f; v.y = 0.f; if (t < Ls) { v.x = hy_u(ra, t, Ls, w0, w1, w2, b); v.y = hy_u(rb, t, Ls, w0, w1, w2, b); zk[t] = v; } buf[t] = v; }
    }
    __syncthreads();
    for (int n = 0; n < 2; ++n) {
        fft_fwd(buf, S, g, 256);
        const cf2* hf = HF + (size_t)(n * 512 + c) * N;
        for (int k = g; k < N; k += 256) buf[k] = cmul(buf[k], hf[k]);
        __syncthreads();
        fft_inv(buf, S, g, 256);
        const int gc = (n + 1) * 512 + c;
        const float w0 = cw[gc], w1 = cw[1536 + gc], w2 = cw[3072 + gc], b = cb[gc], dsk = p.in[I_HYSKIP][n * 512 + c];
        const bf16_t* ra = hy + ((size_t)ba * 1536 + gc) * Ls; const bf16_t* rb = hy + ((size_t)bb * 1536 + gc) * Ls;
        bf16_t* M = (bf16_t*)(p.ws + WS_M);
        for (int t = g; t < N; t += 256) {
            cf2 v; v.x = 0.f; v.y = 0.f;
            if (t < Ls) {
                const cf2 cv = buf[t], zo = zk[t];
                v.x = hy_u(ra, t, Ls, w0, w1, w2, b) * (cv.x * invN + dsk * zo.x); v.y = hy_u(rb, t, Ls, w0, w1, w2, b) * (cv.y * invN + dsk * zo.y);
                if (n == 0) zk[t] = v;
                else { const size_t ta = set ? (size_t)TL + (size_t)ba * LC + t : (size_t)ba * L + t, tb = set ? (size_t)TL + (size_t)bb * LC + t : (size_t)bb * L + t;
                       M[ta * 1024 + c] = (bf16_t)f2bf(v.x); M[tb * 1024 + c] = (bf16_t)f2bf(v.y); }
            }
            if (n == 0) buf[t] = v;
        }
        __syncthreads();
    }
}
DEV void rope_store(const bf16_t* src, bf16_t* dst, int pos, bool rope, float scale, int ph, int sub) {
    const u32x4 ua = *(const u32x4*)(src + ph * 32 + sub * 8), ub = *(const u32x4*)(src + ph * 32 + 16 + sub * 8);
    float a[8], b[8];
#pragma unroll
    for (int i = 0; i < 4; ++i) { a[2 * i] = bflo(ua[i]); a[2 * i + 1] = bfhi(ua[i]); b[2 * i] = bflo(ub[i]); b[2 * i + 1] = bfhi(ub[i]); }
    if (rope) {
        const float pv = (float)(ph == 0 ? pos / 64 : pos % 64);
#pragma unroll
        for (int e = 0; e < 8; ++e) {
            const float inv = exp2f(-(float)(sub * 8 + e) * (13.287712379549449f / 16.f));
            const float ang = pv * inv, cs = __cosf(ang), sn = __sinf(ang);
            const float na = a[e] * cs - b[e] * sn, nb = b[e] * cs + a[e] * sn; a[e] = na; b[e] = nb;
        }
    }
    u32x4 oa, ob;
#pragma unroll
    for (int i = 0; i < 4; ++i) { oa[i] = pk2(a[2 * i] * scale, a[2 * i + 1] * scale); ob[i] = pk2(b[2 * i] * scale, b[2 * i + 1] * scale); }
    *(u32x4*)(dst + ph * 32 + sub * 8) = oa; *(u32x4*)(dst + ph * 32 + 16 + sub * 8) = ob;
}
constexpr int A_LDQ = 72, A_LDV = 136;
DEV void attn_item(const Params& p, int set, int item, unsigned char* smem) {
    bf16_t* Qs = (bf16_t*)smem;
    bf16_t* Ks = Qs + 128 * A_LDQ;
    bf16_t* Vt = Ks + 128 * A_LDQ;
    const int tid = tidx(), lane = tid & 63, w = tid >> 6, l15 = lane & 15, lg = lane >> 4;
    const int nqb = set ? LC / 128 : L / 128;
    const int h = item & 7, qb = (item >> 3) % nqb, b = (item >> 3) / nqb, kvh = h >> 2;
    const bf16_t* Q0 = (const bf16_t*)(p.ws + WS_P + P_Q0); const bf16_t* K0 = (const bf16_t*)(p.ws + WS_P + P_K0);
    const int qtok0 = set ? TL + b * LC + qb * 128 : b * L + qb * 128;
    { const int row = tid >> 2, ph = (tid >> 1) & 1, sub = tid & 1;
      rope_store(Q0 + (size_t)(qtok0 + row) * 512 + h * 64, Qs + row * A_LDQ, qb * 128 + row, set == 0, 0.125f, ph, sub); }
    __syncthreads();
    bf16x8 qf[2];
    qf[0] = *(const bf16x8*)(Qs + (w * 16 + l15) * A_LDQ + 8 * lg); qf[1] = *(const bf16x8*)(Qs + (w * 16 + l15) * A_LDQ + 32 + 8 * lg);
    float m_run = p.in[I_SINK][h], l_run = 1.f;
    f32x4 O[4];
#pragma unroll
    for (int i = 0; i < 4; ++i) O[i] = (f32x4){0.f, 0.f, 0.f, 0.f};
    const int nwin = set ? 0 : 3, nctx = LC / 128;
    for (int kbi = 0; kbi < nwin + nctx; ++kbi) {
        const bool win = kbi < nwin; const int kb = win ? qb - 1 + kbi : kbi - nwin;
        if (win && (kb < 0 || kb >= L / 128)) continue;
        const int ktok0 = win ? b * L + kb * 128 : TL + b * LC + kb * 128;
        __syncthreads();
        { const int row = tid >> 2, ph = (tid >> 1) & 1, sub = tid & 1;
          rope_store(K0 + (size_t)(ktok0 + row) * 128 + kvh * 64, Ks + row * A_LDQ, kb * 128 + row, win, 1.f, ph, sub); }
        { const bf16_t* vt = (const bf16_t*)(p.ws + WS_P + (win ? P_VT_LAT : P_VT_CTX)); const int Lx = win ? L : LC;
#pragma unroll
          for (int i = 0; i < 2; ++i) { const int id = tid + NT * i, d = id >> 4, kc = id & 15;
              *(u32x4*)(Vt + d * A_LDV + kc * 8) = *(const u32x4*)(vt + ((size_t)b * 128 + kvh * 64 + d) * Lx + kb * 128 + kc * 8); } }
        __syncthreads();
#pragma unroll
        for (int ch = 0; ch < 2; ++ch) {
            f32x4 st[4];
#pragma unroll
            for (int u = 0; u < 4; ++u) {
                const bf16_t* kr = Ks + ((ch * 4 + u) * 16 + l15) * A_LDQ + 8 * lg;
                f32x4 z = (f32x4){0.f, 0.f, 0.f, 0.f};
                z = __builtin_amdgcn_mfma_f32_16x16x32_bf16(*(const bf16x8*)kr, qf[0], z, 0, 0, 0);
                z = __builtin_amdgcn_mfma_f32_16x16x32_bf16(*(const bf16x8*)(kr + 32), qf[1], z, 0, 0, 0);
                st[u] = z;
            }
            float cmax = -INFINITY;
            if (win) {
                const int qpos = qb * 128 + w * 16 + l15;
#pragma unroll
                for (int u = 0; u < 4; ++u)
#pragma unroll
                    for (int r = 0; r < 4; ++r) { const int kpos = kb * 128 + (ch * 4 + u) * 16 + 4 * lg + r; const int dd = qpos - kpos; if (dd > 128 || dd < -128) st[u][r] = -INFINITY; }
            }
#pragma unroll
            for (int u = 0; u < 4; ++u)
#pragma unroll
                for (int r = 0; r < 4; ++r) cmax = fmaxf(cmax, st[u][r]);
            cmax = fmaxf(cmax, __shfl_xor(cmax, 16)); cmax = fmaxf(cmax, __shfl_xor(cmax, 32));
            const float m_new = fmaxf(m_run, cmax), alpha = __expf(m_run - m_new);
            float ls = 0.f;
#pragma unroll
            for (int u = 0; u < 4; ++u)
#pragma unroll
                for (int r = 0; r < 4; ++r) { const float e = __expf(st[u][r] - m_new); st[u][r] = e; ls += e; }
            ls += __shfl_xor(ls, 16); ls += __shfl_xor(ls, 32);
            l_run = l_run * alpha + ls; m_run = m_new;
#pragma unroll
            for (int i = 0; i < 4; ++i) { O[i][0] *= alpha; O[i][1] *= alpha; O[i][2] *= alpha; O[i][3] *= alpha; }
#pragma unroll
            for (int ss = 0; ss < 2; ++ss) {
                u32x4 pu; pu[0] = pk2(st[2 * ss][0], st[2 * ss][1]); pu[1] = pk2(st[2 * ss][2], st[2 * ss][3]); pu[2] = pk2(st[2 * ss + 1][0], st[2 * ss + 1][1]); pu[3] = pk2(st[2 * ss + 1][2], st[2 * ss + 1][3]);
                const bf16x8 pf = __builtin_bit_cast(bf16x8, pu);
                const int key0 = (ch * 4 + 2 * ss) * 16 + 4 * lg;
#pragma unroll
                for (int dt = 0; dt < 4; ++dt) {
                    const bf16_t* vr = Vt + (dt * 16 + l15) * A_LDV + key0;
                    u32x4 vu; const u32x2 v0 = *(const u32x2*)vr, v1 = *(const u32x2*)(vr + 16); vu[0] = v0[0]; vu[1] = v0[1]; vu[2] = v1[0]; vu[3] = v1[1];
                    O[dt] = __builtin_amdgcn_mfma_f32_16x16x32_bf16(__builtin_bit_cast(bf16x8, vu), pf, O[dt], 0, 0, 0);
                }
            }
        }
    }
    const float il = 1.f / l_run;
    bf16_t* M = (bf16_t*)(p.ws + WS_M) + (size_t)(qtok0 + w * 16 + l15) * 1024 + 512 + h * 64;
#pragma unroll
    for (int dt = 0; dt < 4; ++dt) { u32x2 o; o[0] = pk2(O[dt][0] * il, O[dt][1] * il); o[1] = pk2(O[dt][2] * il, O[dt][3] * il); *(u32x2*)(M + dt * 16 + 4 * lg) = o; }
    __syncthreads();
}
constexpr int P3_HY_LAT = (NB / 2) * 256, P3_HY_CTX = (NB / 2) * 256, P3_AT_LAT = NB * (L / 128) * 8, P3_AT_CTX = NB * (LC / 128) * 8;
DEV void phase3(const Params& p, unsigned char* smem) {
    const int total = P3_HY_LAT + P3_AT_LAT + P3_HY_CTX + P3_AT_CTX;
    for (int it = blockIdx.x; it < total; it += gridDim.x) {
        int i = it;
        if (i < P3_HY_LAT) { hyena_item(p, 0, i, smem); continue; } i -= P3_HY_LAT;
        if (i < P3_AT_LAT) { attn_item(p, 0, i, smem); continue; } i -= P3_AT_LAT;
        if (i < P3_HY_CTX) { hyena_item(p, 1, i, smem); continue; } i -= P3_HY_CTX;
        attn_item(p, 1, i, smem);
    }
}

constexpr int K_LDK = 136, K_LDS = 129, K_LDC = 52;
DEV unsigned fkey(float f) { const unsigned u = __builtin_bit_cast(unsigned, f); return (u & 0x80000000u) ? ~u : (u | 0x80000000u); }
constexpr int cand_off(int i) { int o = 0; for (int k = 0; k < i; ++k) o += 16 / (k + 1); return o; }
DEV void topk_load_keys(const Params& p, int layer, int h, unsigned char* smem) {
    bf16_t* Ks = (bf16_t*)smem;
    const bf16_t* keys = (const bf16_t*)(p.ws + WS_W + W_KEYS) + (size_t)layer * 262144 + (size_t)h * 32768;
    const int tid = tidx();
#pragma unroll
    for (int i = 0; i < 8; ++i) { const int id = tid + NT * i, row = id >> 4, kc = id & 15; *(u32x4*)(Ks + row * K_LDK + kc * 8) = *(const u32x4*)(keys + (size_t)row * 128 + kc * 8); }
    __syncthreads();
}
DEV void topk_item(const Params& p, int h, int tok0, unsigned char* smem) {
    bf16_t* Ks = (bf16_t*)smem;
    float* Sc = (float*)(Ks + 2 * 128 * K_LDK);
    float* s12 = Sc + 64 * K_LDS;
    int* i12 = (int*)(s12 + 64 * 32);
    unsigned* ck = (unsigned*)(i12 + 64 * 32);
    float* tops = (float*)(ck + 64 * K_LDC);
    int* topi = (int*)(tops + 64 * 16);
    const int tid = tidx(), lane = tid & 63, w = tid >> 6;
    const bf16_t* PQ = (const bf16_t*)(p.ws + WS_P);
    for (int part = 0; part < 2; ++part) {
        { const int mi = w >> 2, ni = w & 3;
          f32x16 acc;
#pragma unroll
          for (int r = 0; r < 16; ++r) acc[r] = 0.f;
          const bf16_t* ag = PQ + (size_t)(tok0 + mi * 32 + (lane & 31)) * 2048 + h * 256 + part * 128 + 8 * (lane >> 5);
          const bf16_t* bs = Ks + (part * 128 + ni * 32 + (lane & 31)) * K_LDK + 8 * (lane >> 5);
          bf16x8 af[8];
#pragma unroll
          for (int kk = 0; kk < 8; ++kk) af[kk] = *(const bf16x8*)(ag + kk * 16);
#pragma unroll
          for (int kk = 0; kk < 8; ++kk) acc = __builtin_amdgcn_mfma_f32_32x32x16_bf16(af[kk], *(const bf16x8*)(bs + kk * 16), acc, 0, 0, 0);
#pragma unroll
          for (int r = 0; r < 16; ++r) Sc[(mi * 32 + (r & 3) + 8 * (r >> 2) + 4 * (lane >> 5)) * K_LDS + ni * 32 + (lane & 31)] = acc[r]; }
        __syncthreads();
        const int row = tid >> 3, n0 = (tid & 7) * 16;
        float mine[16]; unsigned mk[16], rank[16];
#pragma unroll
        for (int i = 0; i < 16; ++i) { mine[i] = Sc[row * K_LDS + n0 + i]; mk[i] = (fkey(mine[i]) & ~127u) | (unsigned)(127 - (n0 + i)); rank[i] = 0u; }
        __syncthreads();
        unsigned* Sk = (unsigned*)Sc;
#pragma unroll
        for (int i = 0; i < 16; ++i) Sk[row * K_LDS + n0 + i] = mk[i];
        __syncthreads();
#pragma unroll 4
        for (int mm = 0; mm < 128; ++mm) {
            const unsigned o = Sk[row * K_LDS + mm];
#pragma unroll
            for (int i = 0; i < 16; ++i) rank[i] += (o > mk[i]) ? 1u : 0u;
        }
#pragma unroll
        for (int i = 0; i < 16; ++i) if (rank[i] < 16u) { s12[(row * 2 + part) * 16 + rank[i]] = mine[i]; i12[(row * 2 + part) * 16 + rank[i]] = n0 + i; }
        __syncthreads();
    }
    {
        const int row = tid >> 3, sub = tid & 7;
        const float* s1 = s12 + row * 32; const float* s2 = s1 + 16;
        float cval[7]; unsigned ckey[7]; int cidx[7];
#pragma unroll
        for (int m = 0; m < 7; ++m) {
            const int cc = sub + 8 * m; int ci = 0, off = 0;
#pragma unroll
            for (int i = 0; i < 15; ++i) { const bool ge = cc >= cand_off(i + 1); ci += ge ? 1 : 0; off += ge ? 16 / (i + 1) : 0; }
            const int cj = cc - off;
            if (cc < 50) { cval[m] = s1[ci] + s2[cj]; ckey[m] = (fkey(cval[m]) & ~255u) | (unsigned)(255 - (ci * 16 + cj)); cidx[m] = i12[row * 32 + ci] * 128 + i12[row * 32 + 16 + cj]; ck[row * K_LDC + cc] = ckey[m]; }
            else { cval[m] = 0.f; ckey[m] = 0u; cidx[m] = 0; }
        }
        __syncthreads();
        unsigned rk[7];
#pragma unroll
        for (int m = 0; m < 7; ++m) rk[m] = 0u;
        for (int o = 0; o < 50; ++o) {
            const unsigned ko = ck[row * K_LDC + o];
#pragma unroll
            for (int m = 0; m < 7; ++m) rk[m] += (ko > ckey[m]) ? 1u : 0u;
        }
#pragma unroll
        for (int m = 0; m < 7; ++m) if (sub + 8 * m < 50 && rk[m] < 16u) { tops[row * 16 + rk[m]] = cval[m]; topi[row * 16 + rk[m]] = cidx[m]; }
    }
    __syncthreads();
    {
        const int row = tid >> 3, sub = tid & 7;
        const float a = tops[row * 16 + 2 * sub], b = tops[row * 16 + 2 * sub + 1];
        float mx = fmaxf(a, b); mx = fmaxf(mx, __shfl_xor(mx, 1)); mx = fmaxf(mx, __shfl_xor(mx, 2)); mx = fmaxf(mx, __shfl_xor(mx, 4));
        const float ea = __expf(a - mx), eb = __expf(b - mx);
        float sm = ea + eb; sm += __shfl_xor(sm, 1); sm += __shfl_xor(sm, 2); sm += __shfl_xor(sm, 4);
        const float inv = 1.f / sm;
        int* IDX = (int*)(p.ws + WS_IDX) + (size_t)(tok0 + row) * 128 + h * 16 + 2 * sub; float* GT = (float*)(p.ws + WS_GATE) + (size_t)(tok0 + row) * 128 + h * 16 + 2 * sub;
        IDX[0] = topi[row * 16 + 2 * sub]; IDX[1] = topi[row * 16 + 2 * sub + 1]; GT[0] = ea * inv; GT[1] = eb * inv;
    }
    __syncthreads();
}
DEV void topk_phase(const Params& p, int layer, int ntok, unsigned char* smem) {
    const int G = gridDim.x, bid = blockIdx.x, h = bid & 7;
    const int nt = ntok / 64;
    if ((G & 7) == 0) {
        if ((bid >> 3) < nt) topk_load_keys(p, layer, h, smem);
        for (int tt = bid >> 3; tt < nt; tt += (G >> 3)) topk_item(p, h, tt * 64, smem);
    } else {
        for (int it = bid; it < nt * 8; it += G) { __syncthreads(); topk_load_keys(p, layer, it & 7, smem); topk_item(p, it & 7, (it >> 3) * 64, smem); }
    }
}

DEV float gelu_f(float x) { return 0.5f * x * (1.f + erff(x * 0.70710678118654752f)); }
typedef float f32x2 __attribute__((ext_vector_type(2)));
DEV void fp8x16_to_f32(const u32x4& r, float (&f)[16]) {
#pragma unroll
    for (int i = 0; i < 4; ++i) { const f32x2 lo = __builtin_amdgcn_cvt_pk_f32_fp8((int)r[i], false), hi = __builtin_amdgcn_cvt_pk_f32_fp8((int)r[i], true); f[4 * i] = lo[0]; f[4 * i + 1] = lo[1]; f[4 * i + 2] = hi[0]; f[4 * i + 3] = hi[1]; }
}
DEV void peer_item(const Params& p, int layer, int item) {
    const int tok = item * 8 + (tidx() >> 6), lane = tidx() & 63;
    const bf16_t* A = (const bf16_t*)(p.ws + WS_A) + (size_t)tok * 1024 + lane * 16;
    const unsigned char* U8 = p.ws + WS_T8 + (size_t)(layer * 2) * 16384 * 1024; const unsigned char* V8 = U8 + (size_t)16384 * 1024; const int voff = lane * 16;
    const float* SU = (const float*)(p.ws + WS_S8) + (size_t)(layer * 2) * 16384; const float* SV = SU + 16384;
    float x[16], y[16];
    { const u32x4 a0 = *(const u32x4*)A, a1 = *(const u32x4*)(A + 8);
#pragma unroll
      for (int i = 0; i < 4; ++i) { x[2 * i] = bflo(a0[i]); x[2 * i + 1] = bfhi(a0[i]); x[8 + 2 * i] = bflo(a1[i]); x[8 + 2 * i + 1] = bfhi(a1[i]); } }
#pragma unroll
    for (int i = 0; i < 16; ++i) y[i] = 0.f;
    const int* IDX = (const int*)(p.ws + WS_IDX) + (size_t)tok * 128; const float* GT = (const float*)(p.ws + WS_GATE) + (size_t)tok * 128;
    const int i_lo = IDX[lane], i_hi = IDX[64 + lane]; const float g_lo = GT[lane], g_hi = GT[64 + lane];
    const int jl = ((lane >> 5) & 1) * 4 + ((lane >> 4) & 1) * 2 + ((lane >> 3) & 1);
    u32x4 ur[8], vr[8];
#define PG_LOADU(g) do { const int src_ = (g) < 8 ? i_lo : i_hi; \
        _Pragma("unroll") for (int j = 0; j < 8; ++j) { const int e_ = __builtin_amdgcn_readlane(src_, (((g) & 7) << 3) + j); ur[j] = *(const u32x4*)(U8 + (size_t)e_ * 1024 + voff); } } while (0)
#define PG_LOADV(g) do { const int src_ = (g) < 8 ? i_lo : i_hi; \
        _Pragma("unroll") for (int j = 0; j < 8; ++j) { const int e_ = __builtin_amdgcn_readlane(src_, (((g) & 7) << 3) + j); vr[j] = *(const u32x4*)(V8 + (size_t)e_ * 1024 + voff); } } while (0)
    PG_LOADU(0); PG_LOADV(0);
    for (int g = 0; g < 16; ++g) {
        const int mk = ((g & 7) << 3) + jl; const int me = __shfl(g < 8 ? i_lo : i_hi, mk); const float mg = __shfl(g < 8 ? g_lo : g_hi, mk);
        const float su = SU[me], sv = SV[me];
        float d[8];
#pragma unroll
        for (int j = 0; j < 8; ++j) { float f[16]; fp8x16_to_f32(ur[j], f); float a = 0.f;
#pragma unroll
            for (int i = 0; i < 16; ++i) a = fmaf(f[i], x[i], a);
            d[j] = a; SCHED_FENCE(); }
        if (g + 1 < 16) PG_LOADU(g + 1);
        float r4[4], r2[2], r1;
        { const bool hi = (lane & 32) != 0;
#pragma unroll
          for (int j = 0; j < 4; ++j) { const float send = hi ? d[j] : d[4 + j], keep = hi ? d[4 + j] : d[j]; r4[j] = keep + __shfl_xor(send, 32); } }
        { const bool hi = (lane & 16) != 0;
#pragma unroll
          for (int j = 0; j < 2; ++j) { const float send = hi ? r4[j] : r4[2 + j], keep = hi ? r4[2 + j] : r4[j]; r2[j] = keep + __shfl_xor(send, 16); } }
        { const bool hi = (lane & 8) != 0; const float send = hi ? r2[0] : r2[1], keep = hi ? r2[1] : r2[0]; r1 = keep + __shfl_xor(send, 8); }
        r1 += __shfl_xor(r1, 4); r1 += __shfl_xor(r1, 2); r1 += __shfl_xor(r1, 1);
        const float act = gelu_f(r1 * su) * mg * sv;
#pragma unroll
        for (int j = 0; j < 8; ++j) {
            const float aj = __builtin_bit_cast(float, __builtin_amdgcn_readlane(__builtin_bit_cast(int, act), ((j >> 2) & 1) * 32 + ((j >> 1) & 1) * 16 + (j & 1) * 8));
            float f[16]; fp8x16_to_f32(vr[j], f);
#pragma unroll
            for (int i = 0; i < 16; ++i) y[i] = fmaf(aj, f[i], y[i]);
            SCHED_FENCE(); }
        if (g + 1 < 16) PG_LOADV(g + 1);
    }
#undef PG_LOADU
#undef PG_LOADV
    float* H = (float*)(p.ws + WS_H) + (size_t)tok * 1024 + lane * 16;
    const float* g2 = (const float*)(p.ws + WS_MOD) + ((size_t)layer * NR + mod_row(tok)) * 6144 + 5120 + lane * 16;
    float hv[16]; float ss = 0.f;
#pragma unroll
    for (int i = 0; i < 4; ++i) { const f32x4 hh = *(const f32x4*)(H + 4 * i), gg = *(const f32x4*)(g2 + 4 * i);
#pragma unroll
        for (int j = 0; j < 4; ++j) { const float v = hh[j] + gg[j] * y[4 * i + j]; hv[4 * i + j] = v; ss += v * v; } }
    ss = wave_sum(ss);
    const float rstd = rsqrtf(ss * (1.f / 1024.f) + 1e-6f);
    if (layer == 0) {
#pragma unroll
        for (int i = 0; i < 4; ++i) { f32x4 o; o[0] = hv[4 * i]; o[1] = hv[4 * i + 1]; o[2] = hv[4 * i + 2]; o[3] = hv[4 * i + 3]; *(f32x4*)(H + 4 * i) = o; }
        const float* g = p.in[I_N1G] + 1024 + lane * 16;
        const float* mod = (const float*)(p.ws + WS_MOD) + ((size_t)1 * NR + mod_row(tok)) * 6144 + lane * 16;
        bf16_t* Ao = (bf16_t*)(p.ws + WS_A) + (size_t)tok * 1024 + lane * 16;
        u32x4 o0, o1; float r[16];
#pragma unroll
        for (int i = 0; i < 16; ++i) r[i] = hv[i] * rstd * g[i] * (1.f + mod[1024 + i]) + mod[i];
#pragma unroll
        for (int i = 0; i < 4; ++i) { o0[i] = pk2(r[2 * i], r[2 * i + 1]); o1[i] = pk2(r[8 + 2 * i], r[8 + 2 * i + 1]); }
        *(u32x4*)Ao = o0; *(u32x4*)(Ao + 8) = o1;
    } else {
        const float* g = p.in[I_FG] + lane * 16; float* out = p.out + (size_t)tok * 1024 + lane * 16;
#pragma unroll
        for (int i = 0; i < 4; ++i) { f32x4 o; o[0] = hv[4 * i] * rstd * g[4 * i]; o[1] = hv[4 * i + 1] * rstd * g[4 * i + 1]; o[2] = hv[4 * i + 2] * rstd * g[4 * i + 2]; o[3] = hv[4 * i + 3] * rstd * g[4 * i + 3]; *(f32x4*)(out + 4 * i) = o; }
    }
}

constexpr int SC_CH = 64, SC_KB = SC_CH * 128 * 2, SC_VB = SC_CH * 64 * 2, SC_BUF = 2 * SC_KB + SC_VB, SC_OB = SC_CH * 64 * 2;
DEV void scan_block(const Params& p, int bi, unsigned char* smem) {
    const int tid = tidx(), lane = tid & 63, w = tid >> 6, vq = lane & 3, kg = lane >> 2;
    const int half = bi & 1, dir = (bi >> 1) & 1, h = (bi >> 2) & 7, b = bi >> 5;
    const bf16_t* P1 = (const bf16_t*)(p.ws + WS_P);
    bf16_t* Oo = (bf16_t*)(p.ws + WS_F + (dir ? F_OB : F_OF));
    const int NCH = (LC + L) / SC_CH;
    float S[8][2];
#pragma unroll
    for (int i = 0; i < 8; ++i) { S[i][0] = 0.f; S[i][1] = 0.f; }
    u32x4 rk[2], rq[2], rv;
    const int kcol = 1024 * (1 + dir) + h * 128, qcol = h * 128, vcol = 3072 + h * 128 + half * 64;
#define SC_TOK(step) ((step) < LC ? TL + b * LC + (dir ? LC - 1 - (step) : (step)) : b * L + (dir ? L - 1 - ((step) - LC) : ((step) - LC)))
#define SC_LOAD(c) do { const bool lat_ = (c) * SC_CH >= LC; \
        _Pragma("unroll") for (int i = 0; i < 2; ++i) { const int id = tid + NT * i, r = id >> 4, cc = id & 15; const bf16_t* row = P1 + (size_t)SC_TOK((c) * SC_CH + r) * 5120; \
            rk[i] = *(const u32x4*)(row + kcol + cc * 8); if (lat_) rq[i] = *(const u32x4*)(row + qcol + cc * 8); } \
        { const int r = tid >> 3, cc = tid & 7; rv = *(const u32x4*)(P1 + (size_t)SC_TOK((c) * SC_CH + r) * 5120 + vcol + cc * 8); } } while (0)
#define SC_STORE(buf) do { unsigned char* base_ = smem + (buf) * SC_BUF; \
        _Pragma("unroll") for (int i = 0; i < 2; ++i) { const int id = tid + NT * i; *(u32x4*)(base_ + id * 16) = rk[i]; *(u32x4*)(base_ + SC_KB + id * 16) = rq[i]; } \
        *(u32x4*)(base_ + 2 * SC_KB + tid * 16) = rv; } while (0)
    rq[0] = (u32x4){0u, 0u, 0u, 0u}; rq[1] = rq[0];
    SC_LOAD(0); SC_STORE(0); __syncthreads();
    for (int c = 0; c < NCH; ++c) {
        const int buf = c & 1; const bool lat = c * SC_CH >= LC;
        if (c + 1 < NCH) SC_LOAD(c + 1);
        const unsigned char* kb = smem + buf * SC_BUF + kg * 16; const unsigned char* qb = kb + SC_KB; const unsigned char* vb = smem + buf * SC_BUF + 2 * SC_KB + (w * 8 + 2 * vq) * 2;
        bf16_t* ob = (bf16_t*)(smem + 2 * SC_BUF + buf * SC_OB);
        for (int r0 = 0; r0 < SC_CH; r0 += 8) {
            float oo[16];
            u32x4 ku8[8], qu8[8]; unsigned vu8[8];
#pragma unroll
            for (int sst = 0; sst < 8; ++sst) { ku8[sst] = *(const u32x4*)(kb + (r0 + sst) * 256); vu8[sst] = *(const unsigned*)(vb + (r0 + sst) * 128); qu8[sst] = *(const u32x4*)(qb + (r0 + sst) * 256); }
#pragma unroll
            for (int sst = 0; sst < 8; ++sst) {
                const u32x4 ku = ku8[sst], qu = qu8[sst];
                const float v0 = bflo(vu8[sst]), v1 = bfhi(vu8[sst]);
                float kf[8];
#pragma unroll
                for (int i = 0; i < 4; ++i) { kf[2 * i] = bflo(ku[i]); kf[2 * i + 1] = bfhi(ku[i]); }
#pragma unroll
                for (int i = 0; i < 8; ++i) { S[i][0] = fmaf(kf[i], v0 - S[i][0], S[i][0]); S[i][1] = fmaf(kf[i], v1 - S[i][1], S[i][1]); }
                float o0 = 0.f, o1 = 0.f;
#pragma unroll
                for (int i = 0; i < 4; ++i) { const float qa = bflo(qu[i]), qc = bfhi(qu[i]); o0 = fmaf(qa, S[2 * i][0], o0); o1 = fmaf(qa, S[2 * i][1], o1); o0 = fmaf(qc, S[2 * i + 1][0], o0); o1 = fmaf(qc, S[2 * i + 1][1], o1); }
                oo[2 * sst] = o0; oo[2 * sst + 1] = o1;
            }
            if (lat) {
                float r8[8], r4[4], r2[2], r1;
                { const bool hi = (lane & 4) != 0;
#pragma unroll
                  for (int j = 0; j < 8; ++j) { const float send = hi ? oo[j] : oo[8 + j], keep = hi ? oo[8 + j] : oo[j]; r8[j] = keep + __shfl_xor(send, 4); } }
                { const bool hi = (lane & 8) != 0;
#pragma unroll
                  for (int j = 0; j < 4; ++j) { const float send = hi ? r8[j] : r8[4 + j], keep = hi ? r8[4 + j] : r8[j]; r4[j] = keep + __shfl_xor(send, 8); } }
                { const bool hi = (lane & 16) != 0;
#pragma unroll
                  for (int j = 0; j < 2; ++j) { const float send = hi ? r4[j] : r4[2 + j], keep = hi ? r4[2 + j] : r4[j]; r2[j] = keep + __shfl_xor(send, 16); } }
                { const bool hi = (lane & 32) != 0; const float send = hi ? r2[0] : r2[1], keep = hi ? r2[1] : r2[0]; r1 = keep + __shfl_xor(send, 32); }
                const int idx = ((lane >> 2) & 1) * 8 + ((lane >> 3) & 1) * 4 + ((lane >> 4) & 1) * 2 + ((lane >> 5) & 1);
                ob[(r0 + (idx >> 1)) * 64 + w * 8 + 2 * vq + (idx & 1)] = (bf16_t)f2bf(r1);
            }
        }
        if (c + 1 < NCH) SC_STORE(buf ^ 1);
        __syncthreads();
        if (lat) { const int r = tid >> 3, cc = tid & 7; *(u32x4*)(Oo + (size_t)SC_TOK(c * SC_CH + r) * 1024 + h * 128 + half * 64 + cc * 8) = *(const u32x4*)(ob + r * 64 + cc * 8); }
    }
    __syncthreads();
#undef SC_TOK
#undef SC_LOAD
#undef SC_STORE
}
DEV void readout_item(const Params& p, int item) {
    const int tok = item * 8 + (tidx() >> 6), lane = tidx() & 63;
    const bf16_t* of = (const bf16_t*)(p.ws + WS_F + F_OF) + (size_t)tok * 1024 + lane * 16; const bf16_t* ob = (const bf16_t*)(p.ws + WS_F + F_OB) + (size_t)tok * 1024 + lane * 16;
    const bf16_t* gp = (const bf16_t*)(p.ws + WS_P) + (size_t)tok * 5120 + 4096 + lane * 16;
    const float* on = p.in[I_HGON] + (lane & 7) * 16;
    float o[16], gg[16]; float ss = 0.f;
    { const u32x4 a0 = *(const u32x4*)of, a1 = *(const u32x4*)(of + 8), b0 = *(const u32x4*)ob, b1 = *(const u32x4*)(ob + 8), g0 = *(const u32x4*)gp, g1 = *(const u32x4*)(gp + 8);
#pragma unroll
      for (int i = 0; i < 4; ++i) { o[2 * i] = bflo(a0[i]) + bflo(b0[i]); o[2 * i + 1] = bfhi(a0[i]) + bfhi(b0[i]); o[8 + 2 * i] = bflo(a1[i]) + bflo(b1[i]); o[8 + 2 * i + 1] = bfhi(a1[i]) + bfhi(b1[i]);
          gg[2 * i] = bflo(g0[i]); gg[2 * i + 1] = bfhi(g0[i]); gg[8 + 2 * i] = bflo(g1[i]); gg[8 + 2 * i + 1] = bfhi(g1[i]); } }
#pragma unroll
    for (int i = 0; i < 16; ++i) ss += o[i] * o[i];
    ss += __shfl_xor(ss, 1); ss += __shfl_xor(ss, 2); ss += __shfl_xor(ss, 4);
    const float rstd = rsqrtf(ss * (1.f / 128.f) + 1e-6f);
    bf16_t* M = (bf16_t*)(p.ws + WS_M) + (size_t)tok * 1024 + lane * 16;
    u32x4 o0, o1; float r[16];
#pragma unroll
    for (int i = 0; i < 16; ++i) r[i] = o[i] * rstd * on[i] * gg[i];
#pragma unroll
    for (int i = 0; i < 4; ++i) { o0[i] = pk2(r[2 * i], r[2 * i + 1]); o1[i] = pk2(r[8 + 2 * i], r[8 + 2 * i + 1]); }
    *(u32x4*)M = o0; *(u32x4*)(M + 8) = o1;
}

#ifndef HOST_EMU
#define XB_TMO      128
#define XB_XCNT(j)  (256  + 64 * (j))
#define XB_XSUB(j)  (1280 + 64 * (j))
#define XB_XGEN(j)  (2304 + 64 * (j))
#define XB_TOP      3328
#define XB_TOPGEN   3392
#define XCD_BAR_WORDS 3456
#define XB_SPIN_CAP (1u << 18)
#define LAS __attribute__((address_space(3)))

__device__ __forceinline__ unsigned xb_ld(unsigned* p)              { return __hip_atomic_load(p, __ATOMIC_RELAXED, __HIP_MEMORY_SCOPE_AGENT); }
__device__ __forceinline__ unsigned xb_add(unsigned* p, unsigned v) { return __hip_atomic_fetch_add(p, v, __ATOMIC_RELAXED, __HIP_MEMORY_SCOPE_AGENT); }
__device__ __forceinline__ unsigned xb_xcc_id() { return (unsigned)__builtin_amdgcn_s_getreg((3 << 11) | 20) & 0xFu; }
#define XB_SPIN(cond, bar) do { unsigned _sp = 0; while (cond) { __builtin_amdgcn_s_sleep(1); \
    if ((++_sp & 255u) == 0u) { if (xb_ld(&(bar)[XB_TMO])) break; if (_sp > XB_SPIN_CAP) { atomicAdd(&(bar)[XB_TMO], 1u); break; } } } } while (0)

struct XcdBarrier {
    unsigned* bar; unsigned x;
    volatile LAS unsigned* st;
};

__device__ __forceinline__ XcdBarrier xcd_barrier_post(unsigned* bar, volatile LAS unsigned* st) {
    XcdBarrier b; b.bar = bar; b.x = xb_xcc_id(); b.st = st;
    if (threadIdx.x == 0) (void)xb_add(&bar[XB_XCNT(b.x)], 1u);
    return b;
}
__device__ __forceinline__ void xcd_barrier_complete(unsigned* bar, unsigned x, unsigned& nloc, unsigned& nx) {
    const unsigned G = gridDim.x * gridDim.y * gridDim.z;
    unsigned sum, cnt, mine, sp = 0u;
    for (;;) {
        sum = 0u; cnt = 0u; mine = 0u;
#pragma unroll
        for (unsigned j = 0; j < 16; ++j) { const unsigned c = xb_ld(&bar[XB_XCNT(j)]); sum += c; cnt += (c > 0u) ? 1u : 0u; mine = (j == x) ? c : mine; }
        if (sum == G) break;
        __builtin_amdgcn_s_sleep(1);
        if ((++sp & 255u) == 0u) { if (xb_ld(&bar[XB_TMO])) break; if (sp > XB_SPIN_CAP) { atomicAdd(&bar[XB_TMO], 1u); break; } }
    }
    nloc = mine > 0u ? mine : 1u; nx = cnt > 0u ? cnt : 1u;
}

__device__ __forceinline__ void xcd_barrier(const XcdBarrier& b) {
    asm volatile("s_waitcnt vmcnt(0)" ::: "memory");
    __syncthreads();
    if (threadIdx.x == 0) {
        unsigned* bar = b.bar;
        __builtin_amdgcn_s_waitcnt(0);
        unsigned nloc = b.st[0], nx = b.st[1];
        if (nloc == 0u) { xcd_barrier_complete(bar, b.x, nloc, nx); b.st[0] = nloc; b.st[1] = nx; }
        const unsigned old = xb_add(&bar[XB_XSUB(b.x)], 1u);
        const unsigned gen = old / nloc;
        if (old + 1u == (gen + 1u) * nloc) {
            __builtin_amdgcn_fence(__ATOMIC_RELEASE, "agent");
            asm volatile("s_waitcnt vmcnt(0)" ::: "memory");
            const unsigned og = xb_add(&bar[XB_TOP], 1u);
            const unsigned tg = og / nx;
            if (og + 1u == (tg + 1u) * nx) xb_add(&bar[XB_TOPGEN], 1u);
            else XB_SPIN(xb_ld(&bar[XB_TOPGEN]) == tg, bar);
            __builtin_amdgcn_fence(__ATOMIC_ACQUIRE, "agent");
            xb_add(&bar[XB_XGEN(b.x)], 1u);
            asm volatile("s_waitcnt vmcnt(0)" ::: "memory");
        } else {
            XB_SPIN(xb_ld(&bar[XB_XGEN(b.x)]) == gen, bar);
            __builtin_amdgcn_fence(__ATOMIC_ACQUIRE, "agent");
            asm volatile("s_waitcnt vmcnt(0)" ::: "memory");
        }
    }
    __syncthreads();
}

#endif
#ifdef NOINLINE_PHASES
#define NOINL __device__ __attribute__((noinline))
#else
#define NOINL __device__ __forceinline__
#endif
__shared__ __attribute__((aligned(16))) unsigned char g_smem[SMEM_BYTES + 16];
#define PH_COMMON const int G = gridDim.x, bid = blockIdx.x; unsigned char* smem = g_smem; (void)smem; (void)G; (void)bid; \
    const bf16_t* A = (const bf16_t*)(p.ws + WS_A); const bf16_t* Mx = (const bf16_t*)(p.ws + WS_M); const bf16_t* W = (const bf16_t*)(p.ws + WS_W); (void)A; (void)Mx; (void)W;
NOINL void ph0(const Params& p) { PH_COMMON phase0(p, smem); }
NOINL void ph1(const Params& p) { PH_COMMON phase1(p, smem); }
NOINL void ph2(const Params& p) { PH_COMMON EpiL0In e{p.ws}; for (int t = bid; t < (T / 256) * 18; t += G) gemm_tile(A, W + W_IN0 / 2, (t / 18) * 256, (t % 18) * 128, smem, e); }
NOINL void ph3(const Params& p) { PH_COMMON phase3(p, smem); }
NOINL void ph4(const Params& p) { PH_COMMON EpiRes e{&p, 1, 0, 2048}; for (int t = bid; t < (T / 256) * 8; t += G) gemm_tile(Mx, W + W_OUT0 / 2, (t / 8) * 256, (t % 8) * 128, smem, e); }
NOINL void ph5(const Params& p) { PH_COMMON for (int it = bid; it < T / 8; it += G) norm_rows_item(p, it, 0, p.in[I_N2G], 0, 3072); }
NOINL void ph6(const Params& p) { PH_COMMON EpiBf16 e{(bf16_t*)(p.ws + WS_P), 2048}; for (int t = bid; t < (T / 256) * 16; t += G) gemm_tile(A, W + W_Q0 / 2, (t / 16) * 256, (t % 16) * 128, smem, e); }
NOINL void ph7(const Params& p) { PH_COMMON topk_phase(p, 0, T, smem); }
NOINL void ph8(const Params& p) { PH_COMMON for (int it = bid; it < T / 8; it += G) peer_item(p, 0, it); }
NOINL void ph9(const Params& p) { PH_COMMON EpiHg e{(bf16_t*)(p.ws + WS_P), p.in[I_HGLB]};
    for (int t = bid; t < (T / 256) * 40; t += G) { const int mt = t / 40, nt = t % 40; if (mt >= TL / 256 && (nt < 8 || nt >= 32)) continue; gemm_tile(A, W + W_IN1 / 2, mt * 256, nt * 128, smem, e); } }
NOINL void ph10(const Params& p) { PH_COMMON for (int bi = bid; bi < NB * 32; bi += G) scan_block(p, bi, smem); }
NOINL void ph11(const Params& p) { PH_COMMON for (int it = bid; it < TL / 8; it += G) readout_item(p, it); }
NOINL void ph12(const Params& p) { PH_COMMON EpiRes e{&p, 0, 1, 2048}; for (int t = bid; t < (TL / 256) * 8; t += G) gemm_tile(Mx, W + W_OUT1 / 2, (t / 8) * 256, (t % 8) * 128, smem, e); }
NOINL void ph13(const Params& p) { PH_COMMON for (int it = bid; it < TL / 8; it += G) norm_rows_item(p, it, 0, p.in[I_N2G] + 1024, 1, 3072); }
NOINL void ph14(const Params& p) { PH_COMMON EpiBf16 e{(bf16_t*)(p.ws + WS_P), 2048}; for (int t = bid; t < (TL / 256) * 16; t += G) gemm_tile(A, W + W_Q1 / 2, (t / 16) * 256, (t % 16) * 128, smem, e); }
NOINL void ph15(const Params& p) { PH_COMMON topk_phase(p, 1, TL, smem); }
NOINL void ph16(const Params& p) { PH_COMMON for (int it = bid; it < TL / 8; it += G) peer_item(p, 1, it); }

constexpr int NPHASE = 17;
__global__ void __launch_bounds__(NT, 2) mega(Params p_in) {
    const int ph_lo = p_in.ph_lo, ph_hi = p_in.ph_hi;
#ifndef HOST_EMU
#define GBAR_MAKE() XcdBarrier gbar; gbar.bar = (unsigned*)(p_in.ws + WS_CTRL); gbar.x = xb_xcc_id(); gbar.st = (volatile LAS unsigned*)(LAS unsigned char*)(g_smem + SMEM_BYTES);
    if (ph_hi - ph_lo > 1) {
        volatile LAS unsigned* st = (volatile LAS unsigned*)(LAS unsigned char*)(g_smem + SMEM_BYTES);
        if (threadIdx.x == 0) { st[0] = 0u; st[1] = 0u; }
        __syncthreads();
        (void)xcd_barrier_post((unsigned*)(p_in.ws + WS_CTRL), st);
    }
#endif
    for (int ph = ph_lo; ph < ph_hi; ++ph) {
        if (ph > ph_lo) {
#ifndef HOST_EMU
            { GBAR_MAKE(); xcd_barrier(gbar); }
#endif
        }
#ifndef HOST_EMU
        unsigned long long kp = (unsigned long long)__builtin_amdgcn_kernarg_segment_ptr();
        asm volatile("" : "+s"(kp) :: "memory");
        const Params& p = *(const Params*)(const __attribute__((address_space(4))) Params*)kp;
#else
        const Params& p = p_in;
#endif
#ifdef REPEAT_MASK
        for (int rep_ = ((REPEAT_MASK >> ph) & 1); rep_ >= 0; --rep_) { if (rep_ == 0 && ((REPEAT_MASK >> ph) & 1)) { GBAR_MAKE(); xcd_barrier(gbar); }
#else
        {
#endif
#ifdef ONLY_PHASE
        if (ph != ONLY_PHASE) continue;
        switch (ONLY_PHASE) {
#else
        switch (ph) {
#endif
        case 0: ph0(p); break; case 1: ph1(p); break; case 2: ph2(p); break; case 3: ph3(p); break; case 4: ph4(p); break; case 5: ph5(p); break;
        case 6: ph6(p); break; case 7: ph7(p); break; case 8: ph8(p); break; case 9: ph9(p); break; case 10: ph10(p); break; case 11: ph11(p); break;
        case 12: ph12(p); break; case 13: ph13(p); break; case 14: ph14(p); break; case 15: ph15(p); break; case 16: ph16(p); break;
        default: break;
        }
        }
    }
}

#ifndef HOST_EMU
extern "C" void kernel_launch(void* const* d_in, const int* in_sizes, int n_in, void* d_out, int out_size, void* d_ws, size_t ws_size, hipStream_t stream) {
    if (n_in != 29 || ws_size < WS_END || out_size != TL * 1024) { fprintf(stderr, "kernel_launch: unexpected sizes (n_in %d, ws %zu need %zu, out %d)\n", n_in, ws_size, (size_t)WS_END, out_size); return; }
    static int grid = 0;
    if (!grid) { int dev = 0, cus = 0; hipGetDevice(&dev); hipDeviceGetAttribute(&cus, hipDeviceAttributeMultiprocessorCount, dev); grid = cus > 0 ? cus : 256; }
    hipMemsetAsync((unsigned char*)d_ws + WS_CTRL, 0, CTRL_BYTES, stream);
    Params p{};
    for (int i = 0; i < 29; ++i) p.in[i] = (const float*)d_in[i];
    p.out = (float*)d_out; p.ws = (unsigned char*)d_ws;
#ifdef MULTI_LAUNCH
    for (int ph = 0; ph < NPHASE; ++ph) { p.ph_lo = ph; p.ph_hi = ph + 1; hipLaunchKernelGGL(mega, dim3(grid), dim3(NT), 0, stream, p); }
#else
    p.ph_lo = 0; p.ph_hi = NPHASE;
    hipLaunchKernelGGL(mega, dim3(grid), dim3(NT), 0, stream, p);
#endif
}
#endif
```

```cpp
#ifndef HOST_EMU
#include <hip/hip_runtime.h>
#include <cstdio>
#endif

#ifndef CFG_B
#define CFG_B 8
#define CFG_L 2048
#define CFG_LC 256
#endif
#define DEV __device__ __forceinline__
#ifndef HOST_EMU
#define SCHED_FENCE() __builtin_amdgcn_sched_barrier(0)
#endif
#ifdef HOST_EMU
#define SCHED_FENCE() do {} while (0)
#define __expf expf
#define __sinf sinf
#define __cosf cosf
#endif

typedef unsigned short bf16_t;
typedef short bf16x8 __attribute__((ext_vector_type(8)));
typedef float f32x16 __attribute__((ext_vector_type(16)));
typedef float f32x4 __attribute__((ext_vector_type(4)));
typedef unsigned u32x4 __attribute__((ext_vector_type(4)));
typedef unsigned u32x2 __attribute__((ext_vector_type(2)));
struct cf2 { float x, y; };

constexpr int NB = CFG_B, L = CFG_L, LC = CFG_LC, D = 1024;
constexpr int TL = NB * L, TC = NB * LC, T = TL + TC;
constexpr int NT = 512;
constexpr int NR = NB + 1;
constexpr int log4ceil(int n) { int s = 0, v = 1; while (v < n) { v *= 4; ++s; } return s; }
constexpr int FS_LAT = log4ceil(2 * L - 1), FS_CTX = log4ceil(2 * LC - 1);
constexpr int NF_LAT = 1 << (2 * FS_LAT), NF_CTX = 1 << (2 * FS_CTX);
static_assert(T % 256 == 0 && TL % 256 == 0 && L % 128 == 0 && LC % 128 == 0 && NB % 2 == 0, "shape");

constexpr size_t al256(size_t x) { return (x + 255) & ~(size_t)255; }
constexpr size_t WS_CTRL = 0, CTRL_BYTES = 65536;
constexpr size_t CTRL_HYNORM = 4096;
constexpr size_t WS_MOD = WS_CTRL + CTRL_BYTES;
constexpr size_t WS_H = al256(WS_MOD + (size_t)2 * NR * 6144 * 4);
constexpr size_t WS_A = al256(WS_H + (size_t)T * 1024 * 4);
constexpr size_t WS_P = al256(WS_A + (size_t)T * 1024 * 2);
constexpr size_t P_BYTES = (size_t)T * 5120 * 2;
constexpr size_t P_HYT_LAT = 0;
constexpr size_t P_HYT_CTX = P_HYT_LAT + (size_t)NB * 1536 * L * 2;
constexpr size_t P_Q0 = P_HYT_CTX + (size_t)NB * 1536 * LC * 2;
constexpr size_t P_K0 = P_Q0 + (size_t)T * 512 * 2;
constexpr size_t P_VT_LAT = P_K0 + (size_t)T * 128 * 2;
constexpr size_t P_VT_CTX = P_VT_LAT + (size_t)NB * 128 * L * 2;
static_assert(P_VT_CTX + (size_t)NB * 128 * LC * 2 <= P_BYTES, "P region");
constexpr size_t WS_M = al256(WS_P + P_BYTES);
constexpr size_t WS_IDX = al256(WS_M + (size_t)T * 1024 * 2);
constexpr size_t WS_GATE = al256(WS_IDX + (size_t)T * 128 * 4);
constexpr size_t WS_T8 = al256(WS_GATE + (size_t)T * 128 * 4);
constexpr size_t WS_S8 = WS_T8 + (size_t)4 * 16384 * 1024;
constexpr size_t WS_W = al256(WS_S8 + (size_t)4 * 16384 * 4);
constexpr size_t W_IN0 = 0, W_OUT0 = W_IN0 + (size_t)2304 * 1024 * 2, W_IN1 = W_OUT0 + (size_t)1024 * 1024 * 2,
                 W_OUT1 = W_IN1 + (size_t)5120 * 1024 * 2, W_Q0 = W_OUT1 + (size_t)1024 * 1024 * 2, W_Q1 = W_Q0 + (size_t)2048 * 1024 * 2,
                 W_KEYS = W_Q1 + (size_t)2048 * 1024 * 2, W_BYTES = W_KEYS + (size_t)2 * 8 * 2 * 128 * 128 * 2;
constexpr size_t WS_F = al256(WS_W + W_BYTES);
constexpr size_t F_HRAW_LAT = 0;
constexpr size_t F_HRAW_CTX = F_HRAW_LAT + (size_t)2048 * L * 4;
constexpr size_t F_HF_LAT = F_HRAW_CTX + (size_t)2048 * LC * 4;
constexpr size_t F_HF_CTX = F_HF_LAT + (size_t)1024 * NF_LAT * 8;
constexpr size_t F_HYP_LAT = F_HF_CTX + (size_t)1024 * NF_CTX * 8;
constexpr size_t F_HYP_CTX = F_HYP_LAT + (size_t)(L / 64) * 2048 * 4;
constexpr size_t F_END = F_HYP_CTX + (size_t)(LC / 64) * 2048 * 4;
constexpr size_t F_OF = 0, F_OB = (size_t)TL * 1024 * 2;
constexpr size_t F_BYTES = F_END > 2 * F_OB ? F_END : 2 * F_OB;
constexpr size_t WS_END = al256(WS_F + F_BYTES);

struct Params { const float* in[29]; float* out; unsigned char* ws; int ph_lo, ph_hi; };
enum { I_X = 0, I_C, I_CTX, I_CCTX, I_ADAW, I_ADAB, I_N1G, I_N2G, I_FG, I_ABWIN, I_ABWOUT, I_HYCW, I_HYCB, I_HYW1, I_HYB1, I_HYW2, I_HYB2, I_HYW3,
       I_HYFREQ, I_HYSKIP, I_SINK, I_HGWIN, I_HGWOUT, I_HGLB, I_HGON, I_PWQ, I_PKEYS, I_PU, I_PV };

constexpr int SMEM_BYTES = 147456;

#ifndef HOST_EMU
DEV int tidx() { int t = threadIdx.x; asm volatile("" : "+v"(t)); return t; }
#else
DEV int tidx() { return (int)threadIdx.x; }
#endif
DEV unsigned f2bf(float f) { unsigned u = __builtin_bit_cast(unsigned, f); return (u + 0x7fffu + ((u >> 16) & 1u)) >> 16; }
DEV float bf2f(unsigned h) { return __builtin_bit_cast(float, (h & 0xffffu) << 16); }
DEV unsigned pk2(float lo, float hi) { return f2bf(lo) | (f2bf(hi) << 16); }
DEV float bflo(unsigned u) { return __builtin_bit_cast(float, u << 16); }
DEV float bfhi(unsigned u) { return __builtin_bit_cast(float, u & 0xffff0000u); }
DEV float silu_f(float x) { return x / (1.f + __expf(-x)); }
DEV float sigmoid_f(float x) { return 1.f / (1.f + __expf(-x)); }
DEV float wave_sum(float v) {
#pragma unroll
    for (int m = 32; m >= 1; m >>= 1) v += __shfl_xor(v, m);
    return v;
}
DEV int mod_row(int tok) { return tok < TL ? tok / L : NB; }

DEV void p0_mod(const Params& p, int item, unsigned char* smem) {
    const int l = item / 96, col0 = (item % 96) * 64, tid = tidx();
    float* sc = (float*)smem;
    float* red = sc + NR * 1024;
    for (int i = tid; i < NR * 1024; i += NT) { const int r = i >> 10, k = i & 1023; const float c = r < NB ? p.in[I_C][r * 1024 + k] : p.in[I_CCTX][k]; sc[i] = c / (1.f + expf(-c)); }
    __syncthreads();
    const int kq = tid >> 6, col = tid & 63;
    float acc[NR];
#pragma unroll
    for (int r = 0; r < NR; ++r) acc[r] = 0.f;
    const float* w = p.in[I_ADAW] + (size_t)l * 1024 * 6144 + col0 + col;
#pragma unroll 4
    for (int k = kq * 128; k < kq * 128 + 128; ++k) {
        const float wv = w[(size_t)k * 6144];
#pragma unroll
        for (int r = 0; r < NR; ++r) acc[r] += sc[r * 1024 + k] * wv;
    }
#pragma unroll
    for (int r = 0; r < NR; ++r) red[(kq * NR + r) * 64 + col] = acc[r];
    __syncthreads();
    float* mod = (float*)(p.ws + WS_MOD);
    for (int i = tid; i < NR * 64; i += NT) {
        const int r = i >> 6, c = i & 63; float s = 0.f;
        for (int q = 0; q < 8; ++q) s += red[(q * NR + r) * 64 + c];
        mod[((size_t)l * NR + r) * 6144 + col0 + c] = s + p.in[I_ADAB][l * 6144 + col0 + c];
    }
    __syncthreads();
}
DEV void p0_transpose(const float* W, bf16_t* Wt, int N, int tile, unsigned char* smem) {
    float* ts = (float*)smem;
    const int ntn = N / 64, kt = tile / ntn, nt = tile % ntn, k0 = kt * 64, n0 = nt * 64, tid = tidx();
    for (int i = tid; i < 4096; i += NT) { const int kk = i >> 6, nn = i & 63; ts[kk * 65 + nn] = W[(size_t)(k0 + kk) * N + n0 + nn]; }
    __syncthreads();
    for (int i = tid; i < 4096; i += NT) { const int nn = i >> 6, kk = i & 63; Wt[(size_t)(n0 + nn) * 1024 + k0 + kk] = (bf16_t)f2bf(ts[kk * 65 + nn]); }
    __syncthreads();
}
DEV void p0_convert(const float* src, bf16_t* dst, int item) {
    const int tid = tidx();
#pragma unroll
    for (int i = 0; i < 8; ++i) {
        const size_t e = (size_t)item * 16384 + (size_t)(i * NT + tid) * 4;
        const f32x4 v = *(const f32x4*)(src + e);
        u32x2 o; o[0] = pk2(v[0], v[1]); o[1] = pk2(v[2], v[3]);
        *(u32x2*)(dst + e) = o;
    }
}
DEV void p0_table8(const Params& p, int tab, int item) {
    const int row = item * 8 + (tidx() >> 6), lane = tidx() & 63;
    const float* src = (tab & 1 ? p.in[I_PV] : p.in[I_PU]) + ((size_t)(tab >> 1) * 16384 + row) * 1024 + lane * 16;
    f32x4 v[4]; float mx = 0.f;
#pragma unroll
    for (int i = 0; i < 4; ++i) { v[i] = *(const f32x4*)(src + 4 * i); mx = fmaxf(mx, fmaxf(fmaxf(fabsf(v[i][0]), fabsf(v[i][1])), fmaxf(fabsf(v[i][2]), fabsf(v[i][3])))); }
#pragma unroll
    for (int m = 32; m >= 1; m >>= 1) mx = fmaxf(mx, __shfl_xor(mx, m));
    const float sc = mx > 0.f ? 240.f / mx : 1.f;
    u32x4 o;
#pragma unroll
    for (int i = 0; i < 4; ++i) { int w = __builtin_amdgcn_cvt_pk_fp8_f32(v[i][0] * sc, v[i][1] * sc, 0, false); w = __builtin_amdgcn_cvt_pk_fp8_f32(v[i][2] * sc, v[i][3] * sc, w, true); o[i] = (unsigned)w; }
    *(u32x4*)(p.ws + WS_T8 + ((size_t)tab * 16384 + row) * 1024 + lane * 16) = o;
    if (lane == 0) ((float*)(p.ws + WS_S8))[tab * 16384 + row] = mx > 0.f ? mx * (1.f / 240.f) : 1.f;
}
DEV void p0_filter(const Params& p, int set, int chunk, unsigned char* smem) {
    const int Ls = set ? LC : L, l0 = chunk * 64, tid = tidx();
    float* z = (float*)smem;
    float* hd1 = z + 64 * 34;
    float* hd2 = hd1 + 64 * 65;
    const float* w1 = p.in[I_HYW1]; const float* b1 = p.in[I_HYB1]; const float* w2 = p.in[I_HYW2]; const float* b2 = p.in[I_HYB2];
    const float* w3 = p.in[I_HYW3]; const float* fq = p.in[I_HYFREQ];
    for (int i = tid; i < 64 * 33; i += NT) {
        const int pp = i / 33, f = i % 33, l = l0 + pp; float val;
        if (f == 0) val = (float)l / (float)(Ls - 1);
        else { const int jb = (f - 1) & 15; const float fj = 1e-4f + (float)jb * ((15.f - 1e-4f) / 15.f); const float a = fj * (6.283185307179586f * (float)l / (float)Ls); val = f <= 16 ? __cosf(a) : -__sinf(a); }
        z[pp * 34 + f] = val;
    }
    __syncthreads();
    for (int i = tid; i < 4096; i += NT) {
        const int pp = i >> 6, j = i & 63; float s = b1[j];
#pragma unroll 4
        for (int f = 0; f < 33; ++f) s += z[pp * 34 + f] * w1[f * 64 + j];
        hd1[pp * 65 + j] = __sinf(fq[j] * s);
    }
    __syncthreads();
    for (int i = tid; i < 4096; i += NT) {
        const int pp = i >> 6, j = i & 63; float s = b2[j];
#pragma unroll 4
        for (int f = 0; f < 64; ++f) s += hd1[pp * 65 + f] * w2[f * 64 + j];
        hd2[pp * 65 + j] = __sinf(fq[j] * s);
    }
    __syncthreads();
    const float max_decay = -15.350567286626973f, min_decay = -3.0701134573253945f;
    float* hraw = (float*)(p.ws + WS_F + (set ? F_HRAW_CTX : F_HRAW_LAT));
    float* hyn = (float*)(p.ws + WS_F + (set ? F_HYP_CTX : F_HYP_LAT)) + (size_t)chunk * 2048;
    for (int cb = 0; cb < 4; ++cb) {
        const int o = cb * NT + tid;
        const int c = o & 511; const float delta = fabsf(min_decay + (float)c * ((max_decay - min_decay) / 511.f));
        float asum = 0.f;
        float* dst = hraw + (size_t)o * Ls + l0;
        for (int ph = 0; ph < 2; ++ph) {
            float acc[32];
#pragma unroll
            for (int pp = 0; pp < 32; ++pp) acc[pp] = 0.f;
#pragma unroll 2
            for (int j = 0; j < 64; ++j) {
                const float wv = w3[j * 2048 + o];
#pragma unroll
                for (int pp = 0; pp < 32; ++pp) acc[pp] = fmaf(hd2[(ph * 32 + pp) * 65 + j], wv, acc[pp]);
            }
#pragma unroll
            for (int q4 = 0; q4 < 8; ++q4) {
                f32x4 v;
#pragma unroll
                for (int e = 0; e < 4; ++e) { const int pp = q4 * 4 + e; const float tl = (float)(l0 + ph * 32 + pp) / (float)(Ls - 1); const float val = acc[pp] * expf(-tl * delta); v[e] = val; asum += fabsf(val); }
                *(f32x4*)(dst + ph * 32 + q4 * 4) = v;
            }
        }
        hyn[o] = asum;
    }
    __syncthreads();
}

constexpr int P0_MOD = 192, P0_TR_IN0 = 16 * 36, P0_TR_OUT0 = 256, P0_TR_IN1 = 16 * 80, P0_TR_OUT1 = 256, P0_TR_Q = 16 * 32, P0_KEYS = 32, P0_TAB = 2048,
              P0_FILT = L / 64 + LC / 64;
DEV void phase0(const Params& p, unsigned char* smem) {
    bf16_t* W = (bf16_t*)(p.ws + WS_W);
    const int total = P0_MOD + P0_FILT + P0_TR_IN0 + P0_TR_OUT0 + P0_TR_IN1 + P0_TR_OUT1 + 2 * P0_TR_Q + P0_KEYS + 4 * P0_TAB;
    for (int it = blockIdx.x; it < total; it += gridDim.x) {
        int i = it;
        if (i < P0_MOD) { p0_mod(p, i, smem); continue; } i -= P0_MOD;
        if (i < P0_FILT) { if (i < L / 64) p0_filter(p, 0, i, smem); else p0_filter(p, 1, i - L / 64, smem); continue; } i -= P0_FILT;
        if (i < P0_TR_IN0) { p0_transpose(p.in[I_ABWIN], W + W_IN0 / 2, 2304, i, smem); continue; } i -= P0_TR_IN0;
        if (i < P0_TR_OUT0) { p0_transpose(p.in[I_ABWOUT], W + W_OUT0 / 2, 1024, i, smem); continue; } i -= P0_TR_OUT0;
        if (i < P0_TR_IN1) { p0_transpose(p.in[I_HGWIN], W + W_IN1 / 2, 5120, i, smem); continue; } i -= P0_TR_IN1;
        if (i < P0_TR_OUT1) { p0_transpose(p.in[I_HGWOUT], W + W_OUT1 / 2, 1024, i, smem); continue; } i -= P0_TR_OUT1;
        if (i < P0_TR_Q) { p0_transpose(p.in[I_PWQ], W + W_Q0 / 2, 2048, i, smem); continue; } i -= P0_TR_Q;
        if (i < P0_TR_Q) { p0_transpose(p.in[I_PWQ] + (size_t)1024 * 2048, W + W_Q1 / 2, 2048, i, smem); continue; } i -= P0_TR_Q;
        if (i < P0_KEYS) { p0_convert(p.in[I_PKEYS], W + W_KEYS / 2, i); continue; } i -= P0_KEYS;
        p0_table8(p, i / P0_TAB, i % P0_TAB);
    }
}

DEV const float* h_row(const Params& p, int layer_src_inputs, int tok) {
    if (layer_src_inputs) return tok < TL ? p.in[I_X] + (size_t)tok * 1024 : p.in[I_CTX] + (size_t)(tok - TL) * 1024;
    return (const float*)(p.ws + WS_H) + (size_t)tok * 1024;
}
DEV void norm_row_store(const Params& p, const f32x4 (&v)[4], int tok, const float* g, int layer, int sh_off, int lane) {
    float ss = 0.f;
#pragma unroll
    for (int i = 0; i < 4; ++i) ss += v[i][0] * v[i][0] + v[i][1] * v[i][1] + v[i][2] * v[i][2] + v[i][3] * v[i][3];
    ss = wave_sum(ss);
    const float rstd = rsqrtf(ss * (1.f / 1024.f) + 1e-6f);
    const float* mod = (const float*)(p.ws + WS_MOD) + ((size_t)layer * NR + mod_row(tok)) * 6144 + sh_off;
    bf16_t* A = (bf16_t*)(p.ws + WS_A) + (size_t)tok * 1024;
#pragma unroll
    for (int i = 0; i < 4; ++i) {
        const int c = i * 256 + lane * 4;
        const f32x4 gg = *(const f32x4*)(g + c), sh = *(const f32x4*)(mod + c), sc = *(const f32x4*)(mod + 1024 + c);
        u32x2 o;
        o[0] = pk2(v[i][0] * rstd * gg[0] * (1.f + sc[0]) + sh[0], v[i][1] * rstd * gg[1] * (1.f + sc[1]) + sh[1]);
        o[1] = pk2(v[i][2] * rstd * gg[2] * (1.f + sc[2]) + sh[2], v[i][3] * rstd * gg[3] * (1.f + sc[3]) + sh[3]);
        *(u32x2*)(A + c) = o;
    }
}
DEV void norm_rows_item(const Params& p, int item, int from_inputs, const float* g, int layer, int sh_off) {
    const int tok = item * 8 + (tidx() >> 6), lane = tidx() & 63;
    const float* src = h_row(p, from_inputs, tok);
    f32x4 v[4];
#pragma unroll
    for (int i = 0; i < 4; ++i) v[i] = *(const f32x4*)(src + i * 256 + lane * 4);
    norm_row_store(p, v, tok, g, layer, sh_off, lane);
}

DEV cf2 cmul(cf2 a, cf2 b) { cf2 r; r.x = a.x * b.x - a.y * b.y; r.y = a.x * b.y + a.y * b.x; return r; }
DEV cf2 twid(int k, float invN) { cf2 r; const float a = (float)k * invN; r.x = __builtin_amdgcn_cosf(a); r.y = -__builtin_amdgcn_sinf(a); return r; }
DEV void fft_fwd(cf2* buf, int S, int g, int G) {
    const int N = 1 << (2 * S); const float invN = 1.f / (float)N;
    for (int s = 0; s < S; ++s) {
        const int lm = 2 * (S - s), m = 1 << lm, q = m >> 2;
        for (int bf = g; bf < (N >> 2); bf += G) {
            const int j = bf & (q - 1), base = ((bf >> (lm - 2)) << lm) + j;
            const cf2 a0 = buf[base], a1 = buf[base + q], a2 = buf[base + 2 * q], a3 = buf[base + 3 * q];
            cf2 t0, t1, t2, t3; t0.x = a0.x + a2.x; t0.y = a0.y + a2.y; t1.x = a0.x - a2.x; t1.y = a0.y - a2.y; t2.x = a1.x + a3.x; t2.y = a1.y + a3.y;
            const float dx = a1.x - a3.x, dy = a1.y - a3.y; t3.x = dy; t3.y = -dx;
            cf2 y0, y1, y2, y3; y0.x = t0.x + t2.x; y0.y = t0.y + t2.y; y1.x = t1.x + t3.x; y1.y = t1.y + t3.y; y2.x = t0.x - t2.x; y2.y = t0.y - t2.y; y3.x = t1.x - t3.x; y3.y = t1.y - t3.y;
            const int tw = j << (2 * s);
            buf[base] = y0; buf[base + q] = cmul(y1, twid(tw, invN)); buf[base + 2 * q] = cmul(y2, twid(2 * tw, invN)); buf[base + 3 * q] = cmul(y3, twid(3 * tw, invN));
        }
        __syncthreads();
    }
}
DEV void fft_inv(cf2* buf, int S, int g, int G) {
    const int N = 1 << (2 * S); const float invN = 1.f / (float)N;
    for (int s = S - 1; s >= 0; --s) {
        const int lm = 2 * (S - s), m = 1 << lm, q = m >> 2;
        for (int bf = g; bf < (N >> 2); bf += G) {
            const int j = bf & (q - 1), base = ((bf >> (lm - 2)) << lm) + j;
            const int tw = j << (2 * s);
            cf2 w1 = twid(tw, invN), w2 = twid(2 * tw, invN), w3 = twid(3 * tw, invN); w1.y = -w1.y; w2.y = -w2.y; w3.y = -w3.y;
            const cf2 c0 = buf[base], c1 = cmul(buf[base + q], w1), c2 = cmul(buf[base + 2 * q], w2), c3 = cmul(buf[base + 3 * q], w3);
            cf2 t0, t1, t2, t3; t0.x = c0.x + c2.x; t0.y = c0.y + c2.y; t1.x = c0.x - c2.x; t1.y = c0.y - c2.y; t2.x = c1.x + c3.x; t2.y = c1.y + c3.y;
            const float dx = c1.x - c3.x, dy = c1.y - c3.y; t3.x = -dy; t3.y = dx;
            cf2 a0, a1, a2, a3; a0.x = t0.x + t2.x; a0.y = t0.y + t2.y; a1.x = t1.x + t3.x; a1.y = t1.y + t3.y; a2.x = t0.x - t2.x; a2.y = t0.y - t2.y; a3.x = t1.x - t3.x; a3.y = t1.y - t3.y;
            buf[base] = a0; buf[base + q] = a1; buf[base + 2 * q] = a2; buf[base + 3 * q] = a3;
        }
        __syncthreads();
    }
}
DEV void hf_item(const Params& p, int set, int pi, unsigned char* smem) {
    const int Ls = set ? LC : L, S = set ? FS_CTX : FS_LAT, N = 1 << (2 * S);
    const int gi = tidx() >> 8, g = tidx() & 255, idx = pi * 2 + gi, o = idx >> 9, c = idx & 511;
    cf2* buf = (cf2*)smem + (size_t)gi * N;
    const float* hraw = (const float*)(p.ws + WS_F + (set ? F_HRAW_CTX : F_HRAW_LAT));
    const float* hyn = (const float*)(p.ws + WS_F + (set ? F_HYP_CTX : F_HYP_LAT));
    float nsum = 0.f;
    for (int ch = 0; ch < Ls / 64; ++ch) nsum += hyn[(size_t)ch * 2048 + o * 1024 + c] + hyn[(size_t)ch * 2048 + o * 1024 + 512 + c];
    const float inv = 1.f / nsum;
    const float* hf = hraw + (size_t)(o * 1024 + c) * Ls; const float* hb = hraw + (size_t)(o * 1024 + 512 + c) * Ls;
    for (int k = g; k < N; k += 256) { float re = 0.f; if (k < Ls) re = hf[k] * inv; else if (k > N - Ls) re = hb[N - k] * inv; cf2 v; v.x = re; v.y = 0.f; buf[k] = v; }
    __syncthreads();
    fft_fwd(buf, S, g, 256);
    cf2* HF = (cf2*)(p.ws + WS_F + (set ? F_HF_CTX : F_HF_LAT)) + (size_t)(o * 512 + c) * N;
    for (int k = g; k < N; k += 256) HF[k] = buf[k];
    __syncthreads();
}
constexpr int P1_NORM = T / 8, P1_HF = 512;
DEV void phase1(const Params& p, unsigned char* smem) {
    const int total = P1_NORM + 2 * P1_HF;
    for (int it = blockIdx.x; it < total; it += gridDim.x) {
        if (it < P1_NORM) norm_rows_item(p, it, 1, p.in[I_N1G], 0, 0);
        else if (it < P1_NORM + P1_HF) hf_item(p, 0, it - P1_NORM, smem);
        else hf_item(p, 1, it - P1_NORM - P1_HF, smem);
    }
}

constexpr int G_LDA = 72;
template <class Epi>
DEV void gemm_tile(const bf16_t* __restrict__ A, const bf16_t* __restrict__ Wt, int m0, int n0, unsigned char* smem, const Epi& epi) {
    bf16_t* As = (bf16_t*)smem;
    bf16_t* Bs = As + 2 * 256 * G_LDA;
    const int tid = tidx(), lane = tid & 63, w = tid >> 6, wm = w >> 1, wn = w & 1;
    f32x16 acc[2][2];
#pragma unroll
    for (int i = 0; i < 2; ++i)
#pragma unroll
        for (int j = 0; j < 2; ++j)
#pragma unroll
            for (int r = 0; r < 16; ++r) acc[i][j][r] = 0.f;
    u32x4 ra[4], rb[2];
    const bf16_t* Ag = A + (size_t)m0 * 1024; const bf16_t* Bg = Wt + (size_t)n0 * 1024;
#define GLOAD(k0) do { \
        _Pragma("unroll") for (int i = 0; i < 4; ++i) { const int id = tid + NT * i, row = id >> 3, kc = id & 7; ra[i] = *(const u32x4*)(Ag + (size_t)row * 1024 + (k0) + kc * 8); } \
        _Pragma("unroll") for (int i = 0; i < 2; ++i) { const int id = tid + NT * i, row = id >> 3, kc = id & 7; rb[i] = *(const u32x4*)(Bg + (size_t)row * 1024 + (k0) + kc * 8); } } while (0)
#define LSTORE(buf_) do { \
        _Pragma("unroll") for (int i = 0; i < 4; ++i) { const int id = tid + NT * i, row = id >> 3, kc = id & 7; *(u32x4*)(As + ((buf_) * 256 + row) * G_LDA + kc * 8) = ra[i]; } \
        _Pragma("unroll") for (int i = 0; i < 2; ++i) { const int id = tid + NT * i, row = id >> 3, kc = id & 7; *(u32x4*)(Bs + ((buf_) * 128 + row) * G_LDA + kc * 8) = rb[i]; } } while (0)
    GLOAD(0); LSTORE(0); __syncthreads();
    for (int kt = 0; kt < 16; ++kt) {
        const int buf = kt & 1;
        if (kt + 1 < 16) GLOAD((kt + 1) * 64);
        const bf16_t* as = As + (buf * 256 + wm * 64 + (lane & 31)) * G_LDA + 8 * (lane >> 5);
        const bf16_t* bs = Bs + (buf * 128 + wn * 64 + (lane & 31)) * G_LDA + 8 * (lane >> 5);
#pragma unroll
        for (int kk = 0; kk < 4; ++kk) {
            const bf16x8 a0 = *(const bf16x8*)(as + kk * 16), a1 = *(const bf16x8*)(as + 32 * G_LDA + kk * 16);
            const bf16x8 b0 = *(const bf16x8*)(bs + kk * 16), b1 = *(const bf16x8*)(bs + 32 * G_LDA + kk * 16);
            acc[0][0] = __builtin_amdgcn_mfma_f32_32x32x16_bf16(a0, b0, acc[0][0], 0, 0, 0);
            acc[0][1] = __builtin_amdgcn_mfma_f32_32x32x16_bf16(a0, b1, acc[0][1], 0, 0, 0);
            acc[1][0] = __builtin_amdgcn_mfma_f32_32x32x16_bf16(a1, b0, acc[1][0], 0, 0, 0);
            acc[1][1] = __builtin_amdgcn_mfma_f32_32x32x16_bf16(a1, b1, acc[1][1], 0, 0, 0);
        }
        if (kt + 1 < 16) LSTORE(buf ^ 1);
        __syncthreads();
    }
#pragma unroll
    for (int mi = 0; mi < 2; ++mi)
#pragma unroll
        for (int ni = 0; ni < 2; ++ni)
#pragma unroll
            for (int rg = 0; rg < 4; ++rg) {
                const int row = m0 + wm * 64 + mi * 32 + 8 * rg + 4 * (lane >> 5), col = n0 + wn * 64 + ni * 32 + (lane & 31);
                epi(row, col, acc[mi][ni][rg * 4 + 0], acc[mi][ni][rg * 4 + 1], acc[mi][ni][rg * 4 + 2], acc[mi][ni][rg * 4 + 3]);
            }
}
struct EpiL0In {
    unsigned char* ws;
    DEV void operator()(int row, int col, float v0, float v1, float v2, float v3) const {
        u32x2 o; o[0] = pk2(v0, v1); o[1] = pk2(v2, v3);
        const bool lat = row < TL; const int b = lat ? row / L : (row - TL) / LC, t = lat ? row - b * L : (row - TL) - b * LC, Lx = lat ? L : LC;
        if (col < 1536) { bf16_t* d = (bf16_t*)(ws + WS_P + (lat ? P_HYT_LAT : P_HYT_CTX)) + ((size_t)b * 1536 + col) * Lx + t; *(u32x2*)d = o; }
        else if (col < 2048) { bf16_t* d = (bf16_t*)(ws + WS_P + P_Q0) + (size_t)row * 512 + (col - 1536); d[0] = (bf16_t)f2bf(v0); d[512] = (bf16_t)f2bf(v1); d[1024] = (bf16_t)f2bf(v2); d[1536] = (bf16_t)f2bf(v3); }
        else if (col < 2176) { bf16_t* d = (bf16_t*)(ws + WS_P + P_K0) + (size_t)row * 128 + (col - 2048); d[0] = (bf16_t)f2bf(v0); d[128] = (bf16_t)f2bf(v1); d[256] = (bf16_t)f2bf(v2); d[384] = (bf16_t)f2bf(v3); }
        else { bf16_t* d = (bf16_t*)(ws + WS_P + (lat ? P_VT_LAT : P_VT_CTX)) + ((size_t)b * 128 + (col - 2176)) * Lx + t; *(u32x2*)d = o; }
    }
};
struct EpiBf16 {
    bf16_t* out; int ld;
    DEV void operator()(int row, int col, float v0, float v1, float v2, float v3) const {
        bf16_t* d = out + (size_t)row * ld + col; d[0] = (bf16_t)f2bf(v0); d[ld] = (bf16_t)f2bf(v1); d[2 * ld] = (bf16_t)f2bf(v2); d[3 * ld] = (bf16_t)f2bf(v3);
    }
};
struct EpiHg {
    bf16_t* out; const float* lg;
    DEV void operator()(int row, int col, float v0, float v1, float v2, float v3) const {
        float vv[4] = {v0, v1, v2, v3};
        if (col < 1024 || col >= 4096) {
#pragma unroll
            for (int i = 0; i < 4; ++i) vv[i] = silu_f(vv[i]);
        } else if (col < 3072) {
            const int c = col - 1024;
            const float oml = 1.f - 1.f / (1.f + __expf(lg[c] - lg[2048 + c]));
#pragma unroll
            for (int i = 0; i < 4; ++i) vv[i] = oml / (1.f + __expf(vv[i]));
        }
        bf16_t* d = out + (size_t)row * 5120 + col; d[0] = (bf16_t)f2bf(vv[0]); d[5120] = (bf16_t)f2bf(vv[1]); d[2 * 5120] = (bf16_t)f2bf(vv[2]); d[3 * 5120] = (bf16_t)f2bf(vv[3]);
    }
};
struct EpiRes {
    const Params* p; int from_inputs, layer, goff;
    DEV void operator()(int row, int col, float v0, float v1, float v2, float v3) const {
        const float vv[4] = {v0, v1, v2, v3};
        float* H = (float*)(p->ws + WS_H);
        const float* mod = (const float*)(p->ws + WS_MOD) + (size_t)layer * NR * 6144 + goff + col;
#pragma unroll
        for (int i = 0; i < 4; ++i) { const int r = row + i; H[(size_t)r * 1024 + col] = h_row(*p, from_inputs, r)[col] + mod[(size_t)mod_row(r) * 6144] * vv[i]; }
    }
};

DEV float hy_u(const bf16_t* row, int t, int Lx, float w0, float w1, float w2, float b) {
    const float xm = t > 0 ? bf2f(row[t - 1]) : 0.f, x0 = bf2f(row[t]), xp = t + 1 < Lx ? bf2f(row[t + 1]) : 0.f;
    return w0 * xm + w1 * x0 + w2 * xp + b;
}
DEV void hyena_item(const Params& p, int set, int item, unsigned char* smem) {
    const int Ls = set ? LC : L, S = set ? FS_CTX : FS_LAT, N = 1 << (2 * S);
    const int gi = tidx() >> 8, g = tidx() & 255;
    const int bp = item >> 8, c = (item & 255) * 2 + gi, ba = bp * 2, bb = ba + 1;
    cf2* buf = (cf2*)smem + (size_t)gi * N;
    cf2* zk = (cf2*)smem + (size_t)2 * N + (size_t)gi * Ls;
    const bf16_t* hy = (const bf16_t*)(p.ws + WS_P + (set ? P_HYT_CTX : P_HYT_LAT));
    const float* cw = p.in[I_HYCW]; const float* cb = p.in[I_HYCB];
    const cf2* HF = (const cf2*)(p.ws + WS_F + (set ? F_HF_CTX : F_HF_LAT));
    const float invN = 1.f / (float)N;
    {
        const float w0 = cw[c], w1 = cw[1536 + c], w2 = cw[3072 + c], b = cb[c];
        const bf16_t* ra = hy + ((size_t)ba * 1536 + c) * Ls; const bf16_t* rb = hy + ((size_t)bb * 1536 + c) * Ls;
        for (int t = g; t < N; t += 256) { cf2 v; v.x = 0.f; v.y = 0.f; if (t < Ls) { v.x = hy_u(ra, t, Ls, w0, w1, w2, b); v.y = hy_u(rb, t, Ls, w0, w1, w2, b); zk[t] = v; } buf[t] = v; }
    }
    __syncthreads();
    for (int n = 0; n < 2; ++n) {
        fft_fwd(buf, S, g, 256);
        const cf2* hf = HF + (size_t)(n * 512 + c) * N;
        for (int k = g; k < N; k += 256) buf[k] = cmul(buf[k], hf[k]);
        __syncthreads();
        fft_inv(buf, S, g, 256);
        const int gc = (n + 1) * 512 + c;
        const float w0 = cw[gc], w1 = cw[1536 + gc], w2 = cw[3072 + gc], b = cb[gc], dsk = p.in[I_HYSKIP][n * 512 + c];
        const bf16_t* ra = hy + ((size_t)ba * 1536 + gc) * Ls; const bf16_t* rb = hy + ((size_t)bb * 1536 + gc) * Ls;
        bf16_t* M = (bf16_t*)(p.ws + WS_M);
        for (int t = g; t < N; t += 256) {
            cf2 v; v.x = 0.f; v.y = 0.f;
            if (t < Ls) {
                const cf2 cv = buf[t], zo = zk[t];
                v.x = hy_u(ra, t, Ls, w0, w1, w2, b) * (cv.x * invN + dsk * zo.x); v.y = hy_u(rb, t, Ls, w0, w1, w2, b) * (cv.y * invN + dsk * zo.y);
                if (n == 0) zk[t] = v;
                else { const size_t ta = set ? (size_t)TL + (size_t)ba * LC + t : (size_t)ba * L + t, tb = set ? (size_t)TL + (size_t)bb * LC + t : (size_t)bb * L + t;
                       M[ta * 1024 + c] = (bf16_t)f2bf(v.x); M[tb * 1024 + c] = (bf16_t)f2bf(v.y); }
            }
            if (n == 0) buf[t] = v;
        }
        __syncthreads();
    }
}
DEV void rope_store(const bf16_t* src, bf16_t* dst, int pos, bool rope, float scale, int ph, int sub) {
    const u32x4 ua = *(const u32x4*)(src + ph * 32 + sub * 8), ub = *(const u32x4*)(src + ph * 32 + 16 + sub * 8);
    float a[8], b[8];
#pragma unroll
    for (int i = 0; i < 4; ++i) { a[2 * i] = bflo(ua[i]); a[2 * i + 1] = bfhi(ua[i]); b[2 * i] = bflo(ub[i]); b[2 * i + 1] = bfhi(ub[i]); }
    if (rope) {
        const float pv = (float)(ph == 0 ? pos / 64 : pos % 64);
#pragma unroll
        for (int e = 0; e < 8; ++e) {
            const float inv = exp2f(-(float)(sub * 8 + e) * (13.287712379549449f / 16.f));
            const float ang = pv * inv, cs = __cosf(ang), sn = __sinf(ang);
            const float na = a[e] * cs - b[e] * sn, nb = b[e] * cs + a[e] * sn; a[e] = na; b[e] = nb;
        }
    }
    u32x4 oa, ob;
#pragma unroll
    for (int i = 0; i < 4; ++i) { oa[i] = pk2(a[2 * i] * scale, a[2 * i + 1] * scale); ob[i] = pk2(b[2 * i] * scale, b[2 * i + 1] * scale); }
    *(u32x4*)(dst + ph * 32 + sub * 8) = oa; *(u32x4*)(dst + ph * 32 + 16 + sub * 8) = ob;
}
constexpr int A_LDQ = 72, A_LDV = 136;
DEV void attn_item(const Params& p, int set, int item, unsigned char* smem) {
    bf16_t* Qs = (bf16_t*)smem;
    bf16_t* Ks = Qs + 128 * A_LDQ;
    bf16_t* Vt = Ks + 128 * A_LDQ;
    const int tid = tidx(), lane = tid & 63, w = tid >> 6, l15 = lane & 15, lg = lane >> 4;
    const int nqb = set ? LC / 128 : L / 128;
    const int h = item & 7, qb = (item >> 3) % nqb, b = (item >> 3) / nqb, kvh = h >> 2;
    const bf16_t* Q0 = (const bf16_t*)(p.ws + WS_P + P_Q0); const bf16_t* K0 = (const bf16_t*)(p.ws + WS_P + P_K0);
    const int qtok0 = set ? TL + b * LC + qb * 128 : b * L + qb * 128;
    { const int row = tid >> 2, ph = (tid >> 1) & 1, sub = tid & 1;
      rope_store(Q0 + (size_t)(qtok0 + row) * 512 + h * 64, Qs + row * A_LDQ, qb * 128 + row, set == 0, 0.125f, ph, sub); }
    __syncthreads();
    bf16x8 qf[2];
    qf[0] = *(const bf16x8*)(Qs + (w * 16 + l15) * A_LDQ + 8 * lg); qf[1] = *(const bf16x8*)(Qs + (w * 16 + l15) * A_LDQ + 32 + 8 * lg);
    float m_run = p.in[I_SINK][h], l_run = 1.f;
    f32x4 O[4];
#pragma unroll
    for (int i = 0; i < 4; ++i) O[i] = (f32x4){0.f, 0.f, 0.f, 0.f};
    const int nwin = set ? 0 : 3, nctx = LC / 128;
    for (int kbi = 0; kbi < nwin + nctx; ++kbi) {
        const bool win = kbi < nwin; const int kb = win ? qb - 1 + kbi : kbi - nwin;
        if (win && (kb < 0 || kb >= L / 128)) continue;
        const int ktok0 = win ? b * L + kb * 128 : TL + b * LC + kb * 128;
        __syncthreads();
        { const int row = tid >> 2, ph = (tid >> 1) & 1, sub = tid & 1;
          rope_store(K0 + (size_t)(ktok0 + row) * 128 + kvh * 64, Ks + row * A_LDQ, kb * 128 + row, win, 1.f, ph, sub); }
        { const bf16_t* vt = (const bf16_t*)(p.ws + WS_P + (win ? P_VT_LAT : P_VT_CTX)); const int Lx = win ? L : LC;
#pragma unroll
          for (int i = 0; i < 2; ++i) { const int id = tid + NT * i, d = id >> 4, kc = id & 15;
              *(u32x4*)(Vt + d * A_LDV + kc * 8) = *(const u32x4*)(vt + ((size_t)b * 128 + kvh * 64 + d) * Lx + kb * 128 + kc * 8); } }
        __syncthreads();
#pragma unroll
        for (int ch = 0; ch < 2; ++ch) {
            f32x4 st[4];
#pragma unroll
            for (int u = 0; u < 4; ++u) {
                const bf16_t* kr = Ks + ((ch * 4 + u) * 16 + l15) * A_LDQ + 8 * lg;
                f32x4 z = (f32x4){0.f, 0.f, 0.f, 0.f};
                z = __builtin_amdgcn_mfma_f32_16x16x32_bf16(*(const bf16x8*)kr, qf[0], z, 0, 0, 0);
                z = __builtin_amdgcn_mfma_f32_16x16x32_bf16(*(const bf16x8*)(kr + 32), qf[1], z, 0, 0, 0);
                st[u] = z;
            }
            float cmax = -INFINITY;
            if (win) {
                const int qpos = qb * 128 + w * 16 + l15;
#pragma unroll
                for (int u = 0; u < 4; ++u)
#pragma unroll
                    for (int r = 0; r < 4; ++r) { const int kpos = kb * 128 + (ch * 4 + u) * 16 + 4 * lg + r; const int dd = qpos - kpos; if (dd > 128 || dd < -128) st[u][r] = -INFINITY; }
            }
#pragma unroll
            for (int u = 0; u < 4; ++u)
#pragma unroll
                for (int r = 0; r < 4; ++r) cmax = fmaxf(cmax, st[u][r]);
            cmax = fmaxf(cmax, __shfl_xor(cmax, 16)); cmax = fmaxf(cmax, __shfl_xor(cmax, 32));
            const float m_new = fmaxf(m_run, cmax), alpha = __expf(m_run - m_new);
            float ls = 0.f;
#pragma unroll
            for (int u = 0; u < 4; ++u)
#pragma unroll
                for (int r = 0; r < 4; ++r) { const float e = __expf(st[u][r] - m_new); st[u][r] = e; ls += e; }
            ls += __shfl_xor(ls, 16); ls += __shfl_xor(ls, 32);
            l_run = l_run * alpha + ls; m_run = m_new;
#pragma unroll
            for (int i = 0; i < 4; ++i) { O[i][0] *= alpha; O[i][1] *= alpha; O[i][2] *= alpha; O[i][3] *= alpha; }
#pragma unroll
            for (int ss = 0; ss < 2; ++ss) {
                u32x4 pu; pu[0] = pk2(st[2 * ss][0], st[2 * ss][1]); pu[1] = pk2(st[2 * ss][2], st[2 * ss][3]); pu[2] = pk2(st[2 * ss + 1][0], st[2 * ss + 1][1]); pu[3] = pk2(st[2 * ss + 1][2], st[2 * ss + 1][3]);
                const bf16x8 pf = __builtin_bit_cast(bf16x8, pu);
                const int key0 = (ch * 4 + 2 * ss) * 16 + 4 * lg;
#pragma unroll
                for (int dt = 0; dt < 4; ++dt) {
                    const bf16_t* vr = Vt + (dt * 16 + l15) * A_LDV + key0;
                    u32x4 vu; const u32x2 v0 = *(const u32x2*)vr, v1 = *(const u32x2*)(vr + 16); vu[0] = v0[0]; vu[1] = v0[1]; vu[2] = v1[0]; vu[3] = v1[1];
                    O[dt] = __builtin_amdgcn_mfma_f32_16x16x32_bf16(__builtin_bit_cast(bf16x8, vu), pf, O[dt], 0, 0, 0);
                }
            }
        }
    }
    const float il = 1.f / l_run;
    bf16_t* M = (bf16_t*)(p.ws + WS_M) + (size_t)(qtok0 + w * 16 + l15) * 1024 + 512 + h * 64;
#pragma unroll
    for (int dt = 0; dt < 4; ++dt) { u32x2 o; o[0] = pk2(O[dt][0] * il, O[dt][1] * il); o[1] = pk2(O[dt][2] * il, O[dt][3] * il); *(u32x2*)(M + dt * 16 + 4 * lg) = o; }
    __syncthreads();
}
constexpr int P3_HY_LAT = (NB / 2) * 256, P3_HY_CTX = (NB / 2) * 256, P3_AT_LAT = NB * (L / 128) * 8, P3_AT_CTX = NB * (LC / 128) * 8;
DEV void phase3(const Params& p, unsigned char* smem) {
    const int total = P3_HY_LAT + P3_AT_LAT + P3_HY_CTX + P3_AT_CTX;
    for (int it = blockIdx.x; it < total; it += gridDim.x) {
        int i = it;
        if (i < P3_HY_LAT) { hyena_item(p, 0, i, smem); continue; } i -= P3_HY_LAT;
        if (i < P3_AT_LAT) { attn_item(p, 0, i, smem); continue; } i -= P3_AT_LAT;
        if (i < P3_HY_CTX) { hyena_item(p, 1, i, smem); continue; } i -= P3_HY_CTX;
        attn_item(p, 1, i, smem);
    }
}

constexpr int K_LDK = 136, K_LDS = 129, K_LDC = 52;
DEV unsigned fkey(float f) { const unsigned u = __builtin_bit_cast(unsigned, f); return (u & 0x80000000u) ? ~u : (u | 0x80000000u); }
constexpr int cand_off(int i) { int o = 0; for (int k = 0; k < i; ++k) o += 16 / (k + 1); return o; }
DEV void topk_load_keys(const Params& p, int layer, int h, unsigned char* smem) {
    bf16_t* Ks = (bf16_t*)smem;
    const bf16_t* keys = (const bf16_t*)(p.ws + WS_W + W_KEYS) + (size_t)layer * 262144 + (size_t)h * 32768;
    const int tid = tidx();
#pragma unroll
    for (int i = 0; i < 8; ++i) { const int id = tid + NT * i, row = id >> 4, kc = id & 15; *(u32x4*)(Ks + row * K_LDK + kc * 8) = *(const u32x4*)(keys + (size_t)row * 128 + kc * 8); }
    __syncthreads();
}
#ifndef HOST_EMU
template <int CTRL> DEV unsigned dpp_u32(unsigned v) { return (unsigned)__builtin_amdgcn_update_dpp(0, (int)v, CTRL, 0xF, 0xF, true); }
#else
template <int CTRL> DEV unsigned dpp_u32(unsigned v) { const int lane = tidx() & 63; const int src = CTRL == 0xB1 ? (lane ^ 1) : CTRL == 0x4E ? (lane ^ 2) : ((lane & ~7) | (7 - (lane & 7))); return emu_shfl(v, src); }
#endif
DEV unsigned max8_u32(unsigned v) { unsigned t = dpp_u32<0xB1>(v); v = v > t ? v : t; t = dpp_u32<0x4E>(v); v = v > t ? v : t; t = dpp_u32<0x141>(v); return v > t ? v : t; }
DEV float sum8_f32(float v) { v += __builtin_bit_cast(float, dpp_u32<0xB1>(__builtin_bit_cast(unsigned, v))); v += __builtin_bit_cast(float, dpp_u32<0x4E>(__builtin_bit_cast(unsigned, v))); v += __builtin_bit_cast(float, dpp_u32<0x141>(__builtin_bit_cast(unsigned, v))); return v; }
DEV float unkey(unsigned k) { const unsigned u = (k & 0x80000000u) ? (k & 0x7fffffffu) : ~k; return __builtin_bit_cast(float, u); }
template <int N> DEV void bitonic_desc(unsigned (&a)[N]) {
#pragma unroll
    for (int k = 2; k <= N; k <<= 1)
#pragma unroll
        for (int j = k >> 1; j > 0; j >>= 1)
#pragma unroll
            for (int i = 0; i < N; ++i) { const int l = i ^ j; if (l > i) { const unsigned x = a[i], y = a[l]; const unsigned hi = x > y ? x : y, lo = x > y ? y : x; if ((i & k) == 0) { a[i] = hi; a[l] = lo; } else { a[i] = lo; a[l] = hi; } } }
}
DEV void merge16(const unsigned* lst, int nlist, unsigned first, int sub, unsigned& r0, unsigned& r1) {
    unsigned cur = first; int head = 0; r0 = 0u; r1 = 0u;
#pragma unroll
    for (int it = 0; it < 16; ++it) {
        const unsigned m = max8_u32(cur);
        if (sub == (it & 7)) { if (it < 8) r0 = m; else r1 = m; }
        if (cur == m) { ++head; cur = head < nlist ? lst[head] : 0u; }
    }
}
DEV void topk_item(const Params& p, int h, int tok0, unsigned char* smem) {
    bf16_t* Ks = (bf16_t*)smem;
    float* Sc = (float*)(Ks + 2 * 128 * K_LDK);
    unsigned* s12 = (unsigned*)Sc + 64 * 8 * 17;
    unsigned* cl = s12 + 64 * 32;
    const int tid = tidx(), lane = tid & 63, w = tid >> 6;
    const int row = tid >> 3, sub = tid & 7;
    const bf16_t* PQ = (const bf16_t*)(p.ws + WS_P);
    for (int part = 0; part < 2; ++part) {
        { const int mi = w >> 2, ni = w & 3;
          f32x16 acc;
#pragma unroll
          for (int r = 0; r < 16; ++r) acc[r] = 0.f;
          const bf16_t* ag = PQ + (size_t)(tok0 + mi * 32 + (lane & 31)) * 2048 + h * 256 + part * 128 + 8 * (lane >> 5);
          const bf16_t* bs = Ks + (part * 128 + ni * 32 + (lane & 31)) * K_LDK + 8 * (lane >> 5);
          bf16x8 af[8];
#pragma unroll
          for (int kk = 0; kk < 8; ++kk) af[kk] = *(const bf16x8*)(ag + kk * 16);
#pragma unroll
          for (int kk = 0; kk < 8; ++kk) acc = __builtin_amdgcn_mfma_f32_32x32x16_bf16(af[kk], *(const bf16x8*)(bs + kk * 16), acc, 0, 0, 0);
#pragma unroll
          for (int r = 0; r < 16; ++r) Sc[(mi * 32 + (r & 3) + 8 * (r >> 2) + 4 * (lane >> 5)) * K_LDS + ni * 32 + (lane & 31)] = acc[r]; }
        __syncthreads();
        unsigned mk[16];
#pragma unroll
        for (int i = 0; i < 16; ++i) mk[i] = (fkey(Sc[row * K_LDS + sub * 16 + i]) & ~127u) | (unsigned)(127 - (sub * 16 + i));
        bitonic_desc<16>(mk);
        __syncthreads();
        unsigned* lst = (unsigned*)Sc + (row * 8 + sub) * 17;
#pragma unroll
        for (int i = 0; i < 16; ++i) lst[i] = mk[i];
        unsigned r0, r1;
        merge16(lst, 16, mk[0], sub, r0, r1);
        s12[(row * 2 + part) * 16 + sub] = r0; s12[(row * 2 + part) * 16 + 8 + sub] = r1;
        __syncthreads();
    }
    {
        const unsigned* k1 = s12 + row * 32; const unsigned* k2 = k1 + 16;
        unsigned ck[8];
#pragma unroll
        for (int m = 0; m < 8; ++m) {
            const int cc = sub + 8 * m; int ci = 0, off = 0;
#pragma unroll
            for (int i = 0; i < 15; ++i) { const bool ge = cc >= cand_off(i + 1); ci += ge ? 1 : 0; off += ge ? 16 / (i + 1) : 0; }
            const int cj = cc - off;
            ck[m] = 0u;
            if (cc < 50) ck[m] = (fkey(unkey((k1[ci] & ~127u) | 64u) + unkey((k2[cj] & ~127u) | 64u)) & ~63u) | (unsigned)(63 - cc);
        }
        bitonic_desc<8>(ck);
        unsigned* lst = cl + (row * 8 + sub) * 9;
#pragma unroll
        for (int m = 0; m < 8; ++m) lst[m] = ck[m];
        unsigned r0, r1;
        merge16(lst, 8, ck[0], sub, r0, r1);
        const float a = unkey((r0 & ~63u) | 32u), b = unkey((r1 & ~63u) | 32u);
        const unsigned kmax = max8_u32(r0 > r1 ? r0 : r1); const float vmax = unkey((kmax & ~63u) | 32u);
        const float ea = __expf(a - vmax), eb = __expf(b - vmax);
        const float inv = 1.f / sum8_f32(ea + eb);
        int eidx[2];
#pragma unroll
        for (int q = 0; q < 2; ++q) {
            const int cc = 63 - (int)((q ? r1 : r0) & 63u); int ci = 0, off = 0;
#pragma unroll
            for (int i = 0; i < 15; ++i) { const bool ge = cc >= cand_off(i + 1); ci += ge ? 1 : 0; off += ge ? 16 / (i + 1) : 0; }
            const int cj = cc - off;
            eidx[q] = (127 - (int)(k1[ci] & 127u)) * 128 + (127 - (int)(k2[cj] & 127u));
        }
        int* IDX = (int*)(p.ws + WS_IDX) + (size_t)(tok0 + row) * 128 + h * 16; float* GT = (float*)(p.ws + WS_GATE) + (size_t)(tok0 + row) * 128 + h * 16;
        IDX[sub] = eidx[0]; IDX[8 + sub] = eidx[1]; GT[sub] = ea * inv; GT[8 + sub] = eb * inv;
    }
    __syncthreads();
}
DEV void topk_phase(const Params& p, int layer, int ntok, unsigned char* smem) {
    const int G = gridDim.x, bid = blockIdx.x, h = bid & 7;
    const int nt = ntok / 64;
    if ((G & 7) == 0) {
        if ((bid >> 3) < nt) topk_load_keys(p, layer, h, smem);
        for (int tt = bid >> 3; tt < nt; tt += (G >> 3)) topk_item(p, h, tt * 64, smem);
    } else {
        for (int it = bid; it < nt * 8; it += G) { __syncthreads(); topk_load_keys(p, layer, it & 7, smem); topk_item(p, it & 7, (it >> 3) * 64, smem); }
    }
}

DEV float gelu_f(float x) { return 0.5f * x * (1.f + erff(x * 0.70710678118654752f)); }
typedef float f32x2 __attribute__((ext_vector_type(2)));
DEV void fp8x16_to_f32(const u32x4& r, float (&f)[16]) {
#pragma unroll
    for (int i = 0; i < 4; ++i) { const f32x2 lo = __builtin_amdgcn_cvt_pk_f32_fp8((int)r[i], false), hi = __builtin_amdgcn_cvt_pk_f32_fp8((int)r[i], true); f[4 * i] = lo[0]; f[4 * i + 1] = lo[1]; f[4 * i + 2] = hi[0]; f[4 * i + 3] = hi[1]; }
}
DEV void peer_item(const Params& p, int layer, int item) {
    const int tok = item * 8 + (tidx() >> 6), lane = tidx() & 63;
    const bf16_t* A = (const bf16_t*)(p.ws + WS_A) + (size_t)tok * 1024 + lane * 16;
    const unsigned char* U8 = p.ws + WS_T8 + (size_t)(layer * 2) * 16384 * 1024; const unsigned char* V8 = U8 + (size_t)16384 * 1024; const int voff = lane * 16;
    const float* SU = (const float*)(p.ws + WS_S8) + (size_t)(layer * 2) * 16384; const float* SV = SU + 16384;
    float x[16], y[16];
    { const u32x4 a0 = *(const u32x4*)A, a1 = *(const u32x4*)(A + 8);
#pragma unroll
      for (int i = 0; i < 4; ++i) { x[2 * i] = bflo(a0[i]); x[2 * i + 1] = bfhi(a0[i]); x[8 + 2 * i] = bflo(a1[i]); x[8 + 2 * i + 1] = bfhi(a1[i]); } }
#pragma unroll
    for (int i = 0; i < 16; ++i) y[i] = 0.f;
    const int* IDX = (const int*)(p.ws + WS_IDX) + (size_t)tok * 128; const float* GT = (const float*)(p.ws + WS_GATE) + (size_t)tok * 128;
    const int i_lo = IDX[lane], i_hi = IDX[64 + lane]; const float g_lo = GT[lane], g_hi = GT[64 + lane];
    const int jl = ((lane >> 5) & 1) * 4 + ((lane >> 4) & 1) * 2 + ((lane >> 3) & 1);
    u32x4 ur[8], vr[8];
#define PG_LOADU(g) do { const int src_ = (g) < 8 ? i_lo : i_hi; \
        _Pragma("unroll") for (int j = 0; j < 8; ++j) { const int e_ = __builtin_amdgcn_readlane(src_, (((g) & 7) << 3) + j); ur[j] = *(const u32x4*)(U8 + (size_t)e_ * 1024 + voff); } } while (0)
#define PG_LOADV(g) do { const int src_ = (g) < 8 ? i_lo : i_hi; \
        _Pragma("unroll") for (int j = 0; j < 8; ++j) { const int e_ = __builtin_amdgcn_readlane(src_, (((g) & 7) << 3) + j); vr[j] = *(const u32x4*)(V8 + (size_t)e_ * 1024 + voff); } } while (0)
    PG_LOADU(0); PG_LOADV(0);
    for (int g = 0; g < 16; ++g) {
        const int mk = ((g & 7) << 3) + jl; const int me = __shfl(g < 8 ? i_lo : i_hi, mk); const float mg = __shfl(g < 8 ? g_lo : g_hi, mk);
        const float su = SU[me], sv = SV[me];
        float d[8];
#pragma unroll
        for (int j = 0; j < 8; ++j) { float f[16]; fp8x16_to_f32(ur[j], f); float a = 0.f;
#pragma unroll
            for (int i = 0; i < 16; ++i) a = fmaf(f[i], x[i], a);
            d[j] = a; SCHED_FENCE(); }
        if (g + 1 < 16) PG_LOADU(g + 1);
        float r4[4], r2[2], r1;
        { const bool hi = (lane & 32) != 0;
#pragma unroll
          for (int j = 0; j < 4; ++j) { const float send = hi ? d[j] : d[4 + j], keep = hi ? d[4 + j] : d[j]; r4[j] = keep + __shfl_xor(send, 32); } }
        { const bool hi = (lane & 16) != 0;
#pragma unroll
          for (int j = 0; j < 2; ++j) { const float send = hi ? r4[j] : r4[2 + j], keep = hi ? r4[2 + j] : r4[j]; r2[j] = keep + __shfl_xor(send, 16); } }
        { const bool hi = (lane & 8) != 0; const float send = hi ? r2[0] : r2[1], keep = hi ? r2[1] : r2[0]; r1 = keep + __shfl_xor(send, 8); }
        r1 += __shfl_xor(r1, 4); r1 += __shfl_xor(r1, 2); r1 += __shfl_xor(r1, 1);
        const float act = gelu_f(r1 * su) * mg * sv;
#pragma unroll
        for (int j = 0; j < 8; ++j) {
            const float aj = __builtin_bit_cast(float, __builtin_amdgcn_readlane(__builtin_bit_cast(int, act), ((j >> 2) & 1) * 32 + ((j >> 1) & 1) * 16 + (j & 1) * 8));
            float f[16]; fp8x16_to_f32(vr[j], f);
#pragma unroll
            for (int i = 0; i < 16; ++i) y[i] = fmaf(aj, f[i], y[i]);
            SCHED_FENCE(); }
        if (g + 1 < 16) PG_LOADV(g + 1);
    }
#undef PG_LOADU
#undef PG_LOADV
    float* H = (float*)(p.ws + WS_H) + (size_t)tok * 1024 + lane * 16;
    const float* g2 = (const float*)(p.ws + WS_MOD) + ((size_t)layer * NR + mod_row(tok)) * 6144 + 5120 + lane * 16;
    float hv[16]; float ss = 0.f;
#pragma unroll
    for (int i = 0; i < 4; ++i) { const f32x4 hh = *(const f32x4*)(H + 4 * i), gg = *(const f32x4*)(g2 + 4 * i);
#pragma unroll
        for (int j = 0; j < 4; ++j) { const float v = hh[j] + gg[j] * y[4 * i + j]; hv[4 * i + j] = v; ss += v * v; } }
    ss = wave_sum(ss);
    const float rstd = rsqrtf(ss * (1.f / 1024.f) + 1e-6f);
    if (layer == 0) {
#pragma unroll
        for (int i = 0; i < 4; ++i) { f32x4 o; o[0] = hv[4 * i]; o[1] = hv[4 * i + 1]; o[2] = hv[4 * i + 2]; o[3] = hv[4 * i + 3]; *(f32x4*)(H + 4 * i) = o; }
        const float* g = p.in[I_N1G] + 1024 + lane * 16;
        const float* mod = (const float*)(p.ws + WS_MOD) + ((size_t)1 * NR + mod_row(tok)) * 6144 + lane * 16;
        bf16_t* Ao = (bf16_t*)(p.ws + WS_A) + (size_t)tok * 1024 + lane * 16;
        u32x4 o0, o1; float r[16];
#pragma unroll
        for (int i = 0; i < 16; ++i) r[i] = hv[i] * rstd * g[i] * (1.f + mod[1024 + i]) + mod[i];
#pragma unroll
        for (int i = 0; i < 4; ++i) { o0[i] = pk2(r[2 * i], r[2 * i + 1]); o1[i] = pk2(r[8 + 2 * i], r[8 + 2 * i + 1]); }
        *(u32x4*)Ao = o0; *(u32x4*)(Ao + 8) = o1;
    } else {
        const float* g = p.in[I_FG] + lane * 16; float* out = p.out + (size_t)tok * 1024 + lane * 16;
#pragma unroll
        for (int i = 0; i < 4; ++i) { f32x4 o; o[0] = hv[4 * i] * rstd * g[4 * i]; o[1] = hv[4 * i + 1] * rstd * g[4 * i + 1]; o[2] = hv[4 * i + 2] * rstd * g[4 * i + 2]; o[3] = hv[4 * i + 3] * rstd * g[4 * i + 3]; *(f32x4*)(out + 4 * i) = o; }
    }
}

constexpr int SC_CH = 64, SC_KB = SC_CH * 128 * 2, SC_VB = SC_CH * 64 * 2, SC_BUF = 2 * SC_KB + SC_VB, SC_OB = SC_CH * 64 * 2;
DEV void scan_block(const Params& p, int bi, unsigned char* smem) {
    const int tid = tidx(), lane = tid & 63, w = tid >> 6, vq = lane & 3, kg = lane >> 2;
    const int half = bi & 1, dir = (bi >> 1) & 1, h = (bi >> 2) & 7, b = bi >> 5;
    const bf16_t* P1 = (const bf16_t*)(p.ws + WS_P);
    bf16_t* Oo = (bf16_t*)(p.ws + WS_F + (dir ? F_OB : F_OF));
    const int NCH = (LC + L) / SC_CH;
    float S[8][2];
#pragma unroll
    for (int i = 0; i < 8; ++i) { S[i][0] = 0.f; S[i][1] = 0.f; }
    u32x4 rk[2], rq[2], rv;
    const int kcol = 1024 * (1 + dir) + h * 128, qcol = h * 128, vcol = 3072 + h * 128 + half * 64;
#define SC_TOK(step) ((step) < LC ? TL + b * LC + (dir ? LC - 1 - (step) : (step)) : b * L + (dir ? L - 1 - ((step) - LC) : ((step) - LC)))
#define SC_LOAD(c) do { const bool lat_ = (c) * SC_CH >= LC; \
        _Pragma("unroll") for (int i = 0; i < 2; ++i) { const int id = tid + NT * i, r = id >> 4, cc = id & 15; const bf16_t* row = P1 + (size_t)SC_TOK((c) * SC_CH + r) * 5120; \
            rk[i] = *(const u32x4*)(row + kcol + cc * 8); if (lat_) rq[i] = *(const u32x4*)(row + qcol + cc * 8); } \
        { const int r = tid >> 3, cc = tid & 7; rv = *(const u32x4*)(P1 + (size_t)SC_TOK((c) * SC_CH + r) * 5120 + vcol + cc * 8); } } while (0)
#define SC_STORE(buf) do { unsigned char* base_ = smem + (buf) * SC_BUF; \
        _Pragma("unroll") for (int i = 0; i < 2; ++i) { const int id = tid + NT * i; *(u32x4*)(base_ + id * 16) = rk[i]; *(u32x4*)(base_ + SC_KB + id * 16) = rq[i]; } \
        *(u32x4*)(base_ + 2 * SC_KB + tid * 16) = rv; } while (0)
    rq[0] = (u32x4){0u, 0u, 0u, 0u}; rq[1] = rq[0];
    SC_LOAD(0); SC_STORE(0); __syncthreads();
    for (int c = 0; c < NCH; ++c) {
        const int buf = c & 1; const bool lat = c * SC_CH >= LC;
        if (c + 1 < NCH) SC_LOAD(c + 1);
        const unsigned char* kb = smem + buf * SC_BUF + kg * 16; const unsigned char* qb = kb + SC_KB; const unsigned char* vb = smem + buf * SC_BUF + 2 * SC_KB + (w * 8 + 2 * vq) * 2;
        bf16_t* ob = (bf16_t*)(smem + 2 * SC_BUF + buf * SC_OB);
        for (int r0 = 0; r0 < SC_CH; r0 += 8) {
            float oo[16];
            u32x4 ku8[8], qu8[8]; unsigned vu8[8];
#pragma unroll
            for (int sst = 0; sst < 8; ++sst) { ku8[sst] = *(const u32x4*)(kb + (r0 + sst) * 256); vu8[sst] = *(const unsigned*)(vb + (r0 + sst) * 128); qu8[sst] = *(const u32x4*)(qb + (r0 + sst) * 256); }
#pragma unroll
            for (int sst = 0; sst < 8; ++sst) {
                const u32x4 ku = ku8[sst], qu = qu8[sst];
                const float v0 = bflo(vu8[sst]), v1 = bfhi(vu8[sst]);
                float kf[8];
#pragma unroll
                for (int i = 0; i < 4; ++i) { kf[2 * i] = bflo(ku[i]); kf[2 * i + 1] = bfhi(ku[i]); }
#pragma unroll
                for (int i = 0; i < 8; ++i) { S[i][0] = fmaf(kf[i], v0 - S[i][0], S[i][0]); S[i][1] = fmaf(kf[i], v1 - S[i][1], S[i][1]); }
                float o0 = 0.f, o1 = 0.f;
#pragma unroll
                for (int i = 0; i < 4; ++i) { const float qa = bflo(qu[i]), qc = bfhi(qu[i]); o0 = fmaf(qa, S[2 * i][0], o0); o1 = fmaf(qa, S[2 * i][1], o1); o0 = fmaf(qc, S[2 * i + 1][0], o0); o1 = fmaf(qc, S[2 * i + 1][1], o1); }
                oo[2 * sst] = o0; oo[2 * sst + 1] = o1;
            }
            if (lat) {
                float r8[8], r4[4], r2[2], r1;
                { const bool hi = (lane & 4) != 0;
#pragma unroll
                  for (int j = 0; j < 8; ++j) { const float send = hi ? oo[j] : oo[8 + j], keep = hi ? oo[8 + j] : oo[j]; r8[j] = keep + __shfl_xor(send, 4); } }
                { const bool hi = (lane & 8) != 0;
#pragma unroll
                  for (int j = 0; j < 4; ++j) { const float send = hi ? r8[j] : r8[4 + j], keep = hi ? r8[4 + j] : r8[j]; r4[j] = keep + __shfl_xor(send, 8); } }
                { const bool hi = (lane & 16) != 0;
#pragma unroll
                  for (int j = 0; j < 2; ++j) { const float send = hi ? r4[j] : r4[2 + j], keep = hi ? r4[2 + j] : r4[j]; r2[j] = keep + __shfl_xor(send, 16); } }
                { const bool hi = (lane & 32) != 0; const float send = hi ? r2[0] : r2[1], keep = hi ? r2[1] : r2[0]; r1 = keep + __shfl_xor(send, 32); }
                const int idx = ((lane >> 2) & 1) * 8 + ((lane >> 3) & 1) * 4 + ((lane >> 4) & 1) * 2 + ((lane >> 5) & 1);
                ob[(r0 + (idx >> 1)) * 64 + w * 8 + 2 * vq + (idx & 1)] = (bf16_t)f2bf(r1);
            }
        }
        if (c + 1 < NCH) SC_STORE(buf ^ 1);
        __syncthreads();
        if (lat) { const int r = tid >> 3, cc = tid & 7; *(u32x4*)(Oo + (size_t)SC_TOK(c * SC_CH + r) * 1024 + h * 128 + half * 64 + cc * 8) = *(const u32x4*)(ob + r * 64 + cc * 8); }
    }
    __syncthreads();
#undef SC_TOK
#undef SC_LOAD
#undef SC_STORE
}
DEV void readout_item(const Params& p, int item) {
    const int tok = item * 8 + (tidx() >> 6), lane = tidx() & 63;
    const bf16_t* of = (const bf16_t*)(p.ws + WS_F + F_OF) + (size_t)tok * 1024 + lane * 16; const bf16_t* ob = (const bf16_t*)(p.ws + WS_F + F_OB) + (size_t)tok * 1024 + lane * 16;
    const bf16_t* gp = (const bf16_t*)(p.ws + WS_P) + (size_t)tok * 5120 + 4096 + lane * 16;
    const float* on = p.in[I_HGON] + (lane & 7) * 16;
    float o[16], gg[16]; float ss = 0.f;
    { const u32x4 a0 = *(const u32x4*)of, a1 = *(const u32x4*)(of + 8), b0 = *(const u32x4*)ob, b1 = *(const u32x4*)(ob + 8), g0 = *(const u32x4*)gp, g1 = *(const u32x4*)(gp + 8);
#pragma unroll
      for (int i = 0; i < 4; ++i) { o[2 * i] = bflo(a0[i]) + bflo(b0[i]); o[2 * i + 1] = bfhi(a0[i]) + bfhi(b0[i]); o[8 + 2 * i] = bflo(a1[i]) + bflo(b1[i]); o[8 + 2 * i + 1] = bfhi(a1[i]) + bfhi(b1[i]);
          gg[2 * i] = bflo(g0[i]); gg[2 * i + 1] = bfhi(g0[i]); gg[8 + 2 * i] = bflo(g1[i]); gg[8 + 2 * i + 1] = bfhi(g1[i]); } }
#pragma unroll
    for (int i = 0; i < 16; ++i) ss += o[i] * o[i];
    ss += __shfl_xor(ss, 1); ss += __shfl_xor(ss, 2); ss += __shfl_xor(ss, 4);
    const float rstd = rsqrtf(ss * (1.f / 128.f) + 1e-6f);
    bf16_t* M = (bf16_t*)(p.ws + WS_M) + (size_t)tok * 1024 + lane * 16;
    u32x4 o0, o1; float r[16];
#pragma unroll
    for (int i = 0; i < 16; ++i) r[i] = o[i] * rstd * on[i] * gg[i];
#pragma unroll
    for (int i = 0; i < 4; ++i) { o0[i] = pk2(r[2 * i], r[2 * i + 1]); o1[i] = pk2(r[8 + 2 * i], r[8 + 2 * i + 1]); }
    *(u32x4*)M = o0; *(u32x4*)(M + 8) = o1;
}

#ifndef HOST_EMU
#define XB_TMO      128
#define XB_XCNT(j)  (256  + 64 * (j))
#define XB_XSUB(j)  (1280 + 64 * (j))
#define XB_XGEN(j)  (2304 + 64 * (j))
#define XB_TOP      3328
#define XB_TOPGEN   3392
#define XCD_BAR_WORDS 3456
#define XB_SPIN_CAP (1u << 18)
#define LAS __attribute__((address_space(3)))

__device__ __forceinline__ unsigned xb_ld(unsigned* p)              { return __hip_atomic_load(p, __ATOMIC_RELAXED, __HIP_MEMORY_SCOPE_AGENT); }
__device__ __forceinline__ unsigned xb_add(unsigned* p, unsigned v) { return __hip_atomic_fetch_add(p, v, __ATOMIC_RELAXED, __HIP_MEMORY_SCOPE_AGENT); }
__device__ __forceinline__ unsigned xb_xcc_id() { return (unsigned)__builtin_amdgcn_s_getreg((3 << 11) | 20) & 0xFu; }
#define XB_SPIN(cond, bar) do { unsigned _sp = 0; while (cond) { __builtin_amdgcn_s_sleep(1); \
    if ((++_sp & 255u) == 0u) { if (xb_ld(&(bar)[XB_TMO])) break; if (_sp > XB_SPIN_CAP) { atomicAdd(&(bar)[XB_TMO], 1u); break; } } } } while (0)

struct XcdBarrier {
    unsigned* bar; unsigned x;
    volatile LAS unsigned* st;
};

__device__ __forceinline__ XcdBarrier xcd_barrier_post(unsigned* bar, volatile LAS unsigned* st) {
    XcdBarrier b; b.bar = bar; b.x = xb_xcc_id(); b.st = st;
    if (threadIdx.x == 0) (void)xb_add(&bar[XB_XCNT(b.x)], 1u);
    return b;
}
__device__ __forceinline__ void xcd_barrier_complete(unsigned* bar, unsigned x, unsigned& nloc, unsigned& nx) {
    const unsigned G = gridDim.x * gridDim.y * gridDim.z;
    unsigned sum, cnt, mine, sp = 0u;
    for (;;) {
        sum = 0u; cnt = 0u; mine = 0u;
#pragma unroll
        for (unsigned j = 0; j < 16; ++j) { const unsigned c = xb_ld(&bar[XB_XCNT(j)]); sum += c; cnt += (c > 0u) ? 1u : 0u; mine = (j == x) ? c : mine; }
        if (sum == G) break;
        __builtin_amdgcn_s_sleep(1);
        if ((++sp & 255u) == 0u) { if (xb_ld(&bar[XB_TMO])) break; if (sp > XB_SPIN_CAP) { atomicAdd(&bar[XB_TMO], 1u); break; } }
    }
    nloc = mine > 0u ? mine : 1u; nx = cnt > 0u ? cnt : 1u;
}

__device__ __forceinline__ void xcd_barrier(const XcdBarrier& b) {
    asm volatile("s_waitcnt vmcnt(0)" ::: "memory");
    __syncthreads();
    if (threadIdx.x == 0) {
        unsigned* bar = b.bar;
        __builtin_amdgcn_s_waitcnt(0);
        unsigned nloc = b.st[0], nx = b.st[1];
        if (nloc == 0u) { xcd_barrier_complete(bar, b.x, nloc, nx); b.st[0] = nloc; b.st[1] = nx; }
        const unsigned old = xb_add(&bar[XB_XSUB(b.x)], 1u);
        const unsigned gen = old / nloc;
        if (old + 1u == (gen + 1u) * nloc) {
            __builtin_amdgcn_fence(__ATOMIC_RELEASE, "agent");
            asm volatile("s_waitcnt vmcnt(0)" ::: "memory");
            const unsigned og = xb_add(&bar[XB_TOP], 1u);
            const unsigned tg = og / nx;
            if (og + 1u == (tg + 1u) * nx) xb_add(&bar[XB_TOPGEN], 1u);
            else XB_SPIN(xb_ld(&bar[XB_TOPGEN]) == tg, bar);
            __builtin_amdgcn_fence(__ATOMIC_ACQUIRE, "agent");
            xb_add(&bar[XB_XGEN(b.x)], 1u);
            asm volatile("s_waitcnt vmcnt(0)" ::: "memory");
        } else {
            XB_SPIN(xb_ld(&bar[XB_XGEN(b.x)]) == gen, bar);
            __builtin_amdgcn_fence(__ATOMIC_ACQUIRE, "agent");
            asm volatile("s_waitcnt vmcnt(0)" ::: "memory");
        }
    }
    __syncthreads();
}

#endif
#ifdef NOINLINE_PHASES
#define NOINL __device__ __attribute__((noinline))
#else
#define NOINL __device__ __forceinline__
#endif
__shared__ __attribute__((aligned(16))) unsigned char g_smem[SMEM_BYTES + 16];
#define PH_COMMON const int G = gridDim.x, bid = blockIdx.x; unsigned char* smem = g_smem; (void)smem; (void)G; (void)bid; \
    const bf16_t* A = (const bf16_t*)(p.ws + WS_A); const bf16_t* Mx = (const bf16_t*)(p.ws + WS_M); const bf16_t* W = (const bf16_t*)(p.ws + WS_W); (void)A; (void)Mx; (void)W;
NOINL void ph0(const Params& p) { PH_COMMON phase0(p, smem); }
NOINL void ph1(const Params& p) { PH_COMMON phase1(p, smem); }
NOINL void ph2(const Params& p) { PH_COMMON EpiL0In e{p.ws}; for (int t = bid; t < (T / 256) * 18; t += G) gemm_tile(A, W + W_IN0 / 2, (t / 18) * 256, (t % 18) * 128, smem, e); }
NOINL void ph3(const Params& p) { PH_COMMON phase3(p, smem); }
NOINL void ph4(const Params& p) { PH_COMMON EpiRes e{&p, 1, 0, 2048}; for (int t = bid; t < (T / 256) * 8; t += G) gemm_tile(Mx, W + W_OUT0 / 2, (t / 8) * 256, (t % 8) * 128, smem, e); }
NOINL void ph5(const Params& p) { PH_COMMON for (int it = bid; it < T / 8; it += G) norm_rows_item(p, it, 0, p.in[I_N2G], 0, 3072); }
NOINL void ph6(const Params& p) { PH_COMMON EpiBf16 e{(bf16_t*)(p.ws + WS_P), 2048}; for (int t = bid; t < (T / 256) * 16; t += G) gemm_tile(A, W + W_Q0 / 2, (t / 16) * 256, (t % 16) * 128, smem, e); }
NOINL void ph7(const Params& p) { PH_COMMON topk_phase(p, 0, T, smem); }
NOINL void ph8(const Params& p) { PH_COMMON for (int it = bid; it < T / 8; it += G) peer_item(p, 0, it); }
NOINL void ph9(const Params& p) { PH_COMMON EpiHg e{(bf16_t*)(p.ws + WS_P), p.in[I_HGLB]};
    for (int t = bid; t < (T / 256) * 40; t += G) { const int mt = t / 40, nt = t % 40; if (mt >= TL / 256 && (nt < 8 || nt >= 32)) continue; gemm_tile(A, W + W_IN1 / 2, mt * 256, nt * 128, smem, e); } }
NOINL void ph10(const Params& p) { PH_COMMON for (int bi = bid; bi < NB * 32; bi += G) scan_block(p, bi, smem); }
NOINL void ph11(const Params& p) { PH_COMMON for (int it = bid; it < TL / 8; it += G) readout_item(p, it); }
NOINL void ph12(const Params& p) { PH_COMMON EpiRes e{&p, 0, 1, 2048}; for (int t = bid; t < (TL / 256) * 8; t += G) gemm_tile(Mx, W + W_OUT1 / 2, (t / 8) * 256, (t % 8) * 128, smem, e); }
NOINL void ph13(const Params& p) { PH_COMMON for (int it = bid; it < TL / 8; it += G) norm_rows_item(p, it, 0, p.in[I_N2G] + 1024, 1, 3072); }
NOINL void ph14(const Params& p) { PH_COMMON EpiBf16 e{(bf16_t*)(p.ws + WS_P), 2048}; for (int t = bid; t < (TL / 256) * 16; t += G) gemm_tile(A, W + W_Q1 / 2, (t / 16) * 256, (t % 16) * 128, smem, e); }
NOINL void ph15(const Params& p) { PH_COMMON topk_phase(p, 1, TL, smem); }
NOINL void ph16(const Params& p) { PH_COMMON for (int it = bid; it < TL / 8; it += G) peer_item(p, 1, it); }

constexpr int NPHASE = 17;
__global__ void __launch_bounds__(NT, 2) mega(Params p_in) {
    const int ph_lo = p_in.ph_lo, ph_hi = p_in.ph_hi;
#ifndef HOST_EMU
#define GBAR_MAKE() XcdBarrier gbar; gbar.bar = (unsigned*)(p_in.ws + WS_CTRL); gbar.x = xb_xcc_id(); gbar.st = (volatile LAS unsigned*)(LAS unsigned char*)(g_smem + SMEM_BYTES);
    if (ph_hi - ph_lo > 1) {
        volatile LAS unsigned* st = (volatile LAS unsigned*)(LAS unsigned char*)(g_smem + SMEM_BYTES);
        if (threadIdx.x == 0) { st[0] = 0u; st[1] = 0u; }
        __syncthreads();
        (void)xcd_barrier_post((unsigned*)(p_in.ws + WS_CTRL), st);
    }
#endif
    for (int ph = ph_lo; ph < ph_hi; ++ph) {
        if (ph > ph_lo) {
#ifndef HOST_EMU
            { GBAR_MAKE(); xcd_barrier(gbar); }
#endif
        }
#ifndef HOST_EMU
        unsigned long long kp = (unsigned long long)__builtin_amdgcn_kernarg_segment_ptr();
        asm volatile("" : "+s"(kp) :: "memory");
        const Params& p = *(const Params*)(const __attribute__((address_space(4))) Params*)kp;
#else
        const Params& p = p_in;
#endif
#ifdef REPEAT_MASK
        for (int rep_ = ((REPEAT_MASK >> ph) & 1); rep_ >= 0; --rep_) { if (rep_ == 0 && ((REPEAT_MASK >> ph) & 1)) { GBAR_MAKE(); xcd_barrier(gbar); }
#else
        {
#endif
#ifdef ONLY_PHASE
        if (ph != ONLY_PHASE) continue;
        switch (ONLY_PHASE) {
#else
        switch (ph) {
#endif
        case 0: ph0(p); break; case 1: ph1(p); break; case 2: ph2(p); break; case 3: ph3(p); break; case 4: ph4(p); break; case 5: ph5(p); break;
        case 6: ph6(p); break; case 7: ph7(p); break; case 8: ph8(p); break; case 9: ph9(p); break; case 10: ph10(p); break; case 11: ph11(p); break;
        case 12: ph12(p); break; case 13: ph13(p); break; case 14: ph14(p); break; case 15: ph15(p); break; case 16: ph16(p); break;
        default: break;
        }
        }
    }
}

#ifndef HOST_EMU
extern "C" void kernel_launch(void* const* d_in, const int* in_sizes, int n_in, void* d_out, int out_size, void* d_ws, size_t ws_size, hipStream_t stream) {
    if (n_in != 29 || ws_size < WS_END || out_size != TL * 1024) { fprintf(stderr, "kernel_launch: unexpected sizes (n_in %d, ws %zu need %zu, out %d)\n", n_in, ws_size, (size_t)WS_END, out_size); return; }
    static int grid = 0;
    if (!grid) { int dev = 0, cus = 0; hipGetDevice(&dev); hipDeviceGetAttribute(&cus, hipDeviceAttributeMultiprocessorCount, dev); grid = cus > 0 ? cus : 256; }
    hipMemsetAsync((unsigned char*)d_ws + WS_CTRL, 0, CTRL_BYTES, stream);
    Params p{};
    for (int i = 0; i < 29; ++i) p.in[i] = (const float*)d_in[i];
    p.out = (float*)d_out; p.ws = (unsigned char*)d_ws;
#ifdef MULTI_LAUNCH
    for (int ph = 0; ph < NPHASE; ++ph) { p.ph_lo = ph; p.ph_hi = ph + 1; hipLaunchKernelGGL(mega, dim3(grid), dim3(NT), 0, stream, p); }
#else
    p.ph_lo = 0; p.ph_hi = NPHASE;
    hipLaunchKernelGGL(mega, dim3(grid), dim3(NT), 0, stream, p);
#endif
}
#endif
```

```cpp
#ifndef HOST_EMU
#include <hip/hip_runtime.h>
#include <cstdio>
#endif

#ifndef CFG_B
#define CFG_B 8
#define CFG_L 2048
#define CFG_LC 256
#endif
#define DEV __device__ __forceinline__
#ifndef HOST_EMU
#define SCHED_FENCE() __builtin_amdgcn_sched_barrier(0)
#endif
#ifdef HOST_EMU
#define SCHED_FENCE() do {} while (0)
#define __expf expf
#define __logf logf
#define __sinf sinf
#define __cosf cosf
#endif

typedef unsigned short bf16_t;
typedef short bf16x8 __attribute__((ext_vector_type(8)));
typedef float f32x16 __attribute__((ext_vector_type(16)));
typedef float f32x4 __attribute__((ext_vector_type(4)));
typedef unsigned u32x4 __attribute__((ext_vector_type(4)));
typedef unsigned u32x2 __attribute__((ext_vector_type(2)));
struct cf2 { float x, y; };

constexpr int NB = CFG_B, L = CFG_L, LC = CFG_LC, D = 1024;
constexpr int TL = NB * L, TC = NB * LC, T = TL + TC;
constexpr int NT = 512;
constexpr int NR = NB + 1;
constexpr int log4ceil(int n) { int s = 0, v = 1; while (v < n) { v *= 4; ++s; } return s; }
constexpr int FS_LAT = log4ceil(2 * L - 1), FS_CTX = log4ceil(2 * LC - 1);
constexpr int NF_LAT = 1 << (2 * FS_LAT), NF_CTX = 1 << (2 * FS_CTX);
static_assert(T % 256 == 0 && TL % 256 == 0 && L % 128 == 0 && LC % 128 == 0 && NB % 2 == 0, "shape");

constexpr size_t al256(size_t x) { return (x + 255) & ~(size_t)255; }
constexpr size_t WS_CTRL = 0, CTRL_BYTES = 65536;
constexpr size_t CTRL_HYNORM = 4096;
constexpr size_t WS_MOD = WS_CTRL + CTRL_BYTES;
constexpr size_t WS_H = al256(WS_MOD + (size_t)2 * NR * 6144 * 4);
constexpr size_t WS_A = al256(WS_H + (size_t)T * 1024 * 4);
constexpr size_t WS_P = al256(WS_A + (size_t)T * 1024 * 2);
constexpr size_t P_BYTES = (size_t)T * 5120 * 2;
constexpr size_t P_HYT_LAT = 0;
constexpr size_t P_HYT_CTX = P_HYT_LAT + (size_t)NB * 1536 * L * 2;
constexpr size_t P_Q0 = P_HYT_CTX + (size_t)NB * 1536 * LC * 2;
constexpr size_t P_K0 = P_Q0 + (size_t)T * 512 * 2;
constexpr size_t P_VT_LAT = P_K0 + (size_t)T * 128 * 2;
constexpr size_t P_VT_CTX = P_VT_LAT + (size_t)NB * 128 * L * 2;
static_assert(P_VT_CTX + (size_t)NB * 128 * LC * 2 <= P_BYTES, "P region");
constexpr size_t WS_M = al256(WS_P + P_BYTES);
constexpr size_t WS_IDX = al256(WS_M + (size_t)T * 1024 * 2);
constexpr size_t WS_GATE = al256(WS_IDX + (size_t)T * 128 * 4);
constexpr size_t WS_T8 = al256(WS_GATE + (size_t)T * 128 * 4);
constexpr size_t WS_S8 = WS_T8 + (size_t)4 * 16384 * 1024;
constexpr size_t WS_W = al256(WS_S8 + (size_t)4 * 16384 * 4);
constexpr size_t W_IN0 = 0, W_OUT0 = W_IN0 + (size_t)2304 * 1024 * 2, W_IN1 = W_OUT0 + (size_t)1024 * 1024 * 2,
                 W_OUT1 = W_IN1 + (size_t)5120 * 1024 * 2, W_Q0 = W_OUT1 + (size_t)1024 * 1024 * 2, W_Q1 = W_Q0 + (size_t)2048 * 1024 * 2,
                 W_KEYS = W_Q1 + (size_t)2048 * 1024 * 2, W_BYTES = W_KEYS + (size_t)2 * 8 * 2 * 128 * 128 * 2;
constexpr size_t WS_F = al256(WS_W + W_BYTES);
constexpr size_t F_HRAW_LAT = 0;
constexpr size_t F_HRAW_CTX = F_HRAW_LAT + (size_t)2048 * L * 4;
constexpr size_t F_HF_LAT = F_HRAW_CTX + (size_t)2048 * LC * 4;
constexpr size_t F_HF_CTX = F_HF_LAT + (size_t)1024 * NF_LAT * 8;
constexpr size_t F_HYP_LAT = F_HF_CTX + (size_t)1024 * NF_CTX * 8;
constexpr size_t F_HYP_CTX = F_HYP_LAT + (size_t)(L / 64) * 2048 * 4;
constexpr size_t F_END = F_HYP_CTX + (size_t)(LC / 64) * 2048 * 4;
constexpr size_t F_OF = 0, F_OB = (size_t)TL * 1024 * 2;
constexpr size_t F_BYTES = F_END > 2 * F_OB ? F_END : 2 * F_OB;
constexpr size_t WS_END = al256(WS_F + F_BYTES);

struct Params { const float* in[29]; float* out; unsigned char* ws; int ph_lo, ph_hi; };
enum { I_X = 0, I_C, I_CTX, I_CCTX, I_ADAW, I_ADAB, I_N1G, I_N2G, I_FG, I_ABWIN, I_ABWOUT, I_HYCW, I_HYCB, I_HYW1, I_HYB1, I_HYW2, I_HYB2, I_HYW3,
       I_HYFREQ, I_HYSKIP, I_SINK, I_HGWIN, I_HGWOUT, I_HGLB, I_HGON, I_PWQ, I_PKEYS, I_PU, I_PV };

constexpr int SMEM_BYTES = 147456;

#ifndef HOST_EMU
DEV int tidx() { int t = threadIdx.x; asm volatile("" : "+v"(t)); return t; }
#else
DEV int tidx() { return (int)threadIdx.x; }
#endif
DEV unsigned f2bf(float f) { unsigned u = __builtin_bit_cast(unsigned, f); return (u + 0x7fffu + ((u >> 16) & 1u)) >> 16; }
DEV float bf2f(unsigned h) { return __builtin_bit_cast(float, (h & 0xffffu) << 16); }
DEV unsigned pk2(float lo, float hi) { return f2bf(lo) | (f2bf(hi) << 16); }
DEV float bflo(unsigned u) { return __builtin_bit_cast(float, u << 16); }
DEV float bfhi(unsigned u) { return __builtin_bit_cast(float, u & 0xffff0000u); }
DEV float silu_f(float x) { return x / (1.f + __expf(-x)); }
DEV float sigmoid_f(float x) { return 1.f / (1.f + __expf(-x)); }
DEV float wave_sum(float v) {
#pragma unroll
    for (int m = 32; m >= 1; m >>= 1) v += __shfl_xor(v, m);
    return v;
}
DEV int mod_row(int tok) { return tok < TL ? tok / L : NB; }

DEV void p0_mod(const Params& p, int item, unsigned char* smem) {
    const int l = item / 96, col0 = (item % 96) * 64, tid = tidx();
    float* sc = (float*)smem;
    float* red = sc + NR * 1024;
    for (int i = tid; i < NR * 1024; i += NT) { const int r = i >> 10, k = i & 1023; const float c = r < NB ? p.in[I_C][r * 1024 + k] : p.in[I_CCTX][k]; sc[i] = c / (1.f + expf(-c)); }
    __syncthreads();
    const int kq = tid >> 6, col = tid & 63;
    float acc[NR];
#pragma unroll
    for (int r = 0; r < NR; ++r) acc[r] = 0.f;
    const float* w = p.in[I_ADAW] + (size_t)l * 1024 * 6144 + col0 + col;
#pragma unroll 4
    for (int k = kq * 128; k < kq * 128 + 128; ++k) {
        const float wv = w[(size_t)k * 6144];
#pragma unroll
        for (int r = 0; r < NR; ++r) acc[r] += sc[r * 1024 + k] * wv;
    }
#pragma unroll
    for (int r = 0; r < NR; ++r) red[(kq * NR + r) * 64 + col] = acc[r];
    __syncthreads();
    float* mod = (float*)(p.ws + WS_MOD);
    for (int i = tid; i < NR * 64; i += NT) {
        const int r = i >> 6, c = i & 63; float s = 0.f;
        for (int q = 0; q < 8; ++q) s += red[(q * NR + r) * 64 + c];
        mod[((size_t)l * NR + r) * 6144 + col0 + c] = s + p.in[I_ADAB][l * 6144 + col0 + c];
    }
    __syncthreads();
}
DEV void p0_transpose(const float* W, bf16_t* Wt, int N, int tile, unsigned char* smem) {
    float* ts = (float*)smem;
    const int ntn = N / 64, kt = tile / ntn, nt = tile % ntn, k0 = kt * 64, n0 = nt * 64, tid = tidx();
    float rv[8];
#pragma unroll
    for (int m = 0; m < 8; ++m) { const int i = tid + NT * m, kk = i >> 6, nn = i & 63; rv[m] = W[(size_t)(k0 + kk) * N + n0 + nn]; }
#pragma unroll
    for (int m = 0; m < 8; ++m) { const int i = tid + NT * m, kk = i >> 6, nn = i & 63; ts[kk * 65 + nn] = rv[m]; }
    __syncthreads();
#pragma unroll
    for (int m = 0; m < 8; ++m) { const int i = tid + NT * m, nn = i >> 6, kk = i & 63; Wt[(size_t)(n0 + nn) * 1024 + k0 + kk] = (bf16_t)f2bf(ts[kk * 65 + nn]); }
    __syncthreads();
}
DEV void p0_convert(const float* src, bf16_t* dst, int item) {
    const int tid = tidx();
#pragma unroll
    for (int i = 0; i < 8; ++i) {
        const size_t e = (size_t)item * 16384 + (size_t)(i * NT + tid) * 4;
        const f32x4 v = *(const f32x4*)(src + e);
        u32x2 o; o[0] = pk2(v[0], v[1]); o[1] = pk2(v[2], v[3]);
        *(u32x2*)(dst + e) = o;
    }
}
DEV void p0_table8(const Params& p, int tab, int item) {
    const int row0 = item * 32 + (tidx() >> 6), lane = tidx() & 63;
    const float* src = (tab & 1 ? p.in[I_PV] : p.in[I_PU]) + ((size_t)(tab >> 1) * 16384 + row0) * 1024 + lane * 16;
    f32x4 v[4][4];
#pragma unroll
    for (int r = 0; r < 4; ++r)
#pragma unroll
        for (int i = 0; i < 4; ++i) v[r][i] = *(const f32x4*)(src + (size_t)r * 8 * 1024 + 4 * i);
#pragma unroll
    for (int r = 0; r < 4; ++r) {
        float mx = 0.f;
#pragma unroll
        for (int i = 0; i < 4; ++i) mx = fmaxf(mx, fmaxf(fmaxf(fabsf(v[r][i][0]), fabsf(v[r][i][1])), fmaxf(fabsf(v[r][i][2]), fabsf(v[r][i][3]))));
#pragma unroll
        for (int m = 32; m >= 1; m >>= 1) mx = fmaxf(mx, __shfl_xor(mx, m));
        const float sc = mx > 0.f ? 240.f / mx : 1.f;
        u32x4 o;
#pragma unroll
        for (int i = 0; i < 4; ++i) { int w = __builtin_amdgcn_cvt_pk_fp8_f32(v[r][i][0] * sc, v[r][i][1] * sc, 0, false); w = __builtin_amdgcn_cvt_pk_fp8_f32(v[r][i][2] * sc, v[r][i][3] * sc, w, true); o[i] = (unsigned)w; }
        const int row = row0 + r * 8;
        *(u32x4*)(p.ws + WS_T8 + ((size_t)tab * 16384 + row) * 1024 + lane * 16) = o;
        if (lane == 0) ((float*)(p.ws + WS_S8))[tab * 16384 + row] = mx > 0.f ? mx * (1.f / 240.f) : 1.f;
    }
}
DEV void p0_filter(const Params& p, int set, int chunk, unsigned char* smem) {
    const int Ls = set ? LC : L, l0 = chunk * 64, tid = tidx();
    float* z = (float*)smem;
    float* hd1 = z + 64 * 34;
    float* hd2 = hd1 + 64 * 65;
    const float* w1 = p.in[I_HYW1]; const float* b1 = p.in[I_HYB1]; const float* w2 = p.in[I_HYW2]; const float* b2 = p.in[I_HYB2];
    const float* w3 = p.in[I_HYW3]; const float* fq = p.in[I_HYFREQ];
    for (int i = tid; i < 64 * 33; i += NT) {
        const int pp = i / 33, f = i % 33, l = l0 + pp; float val;
        if (f == 0) val = (float)l / (float)(Ls - 1);
        else { const int jb = (f - 1) & 15; const float fj = 1e-4f + (float)jb * ((15.f - 1e-4f) / 15.f); const float a = fj * (6.283185307179586f * (float)l / (float)Ls); val = f <= 16 ? __cosf(a) : -__sinf(a); }
        z[pp * 34 + f] = val;
    }
    __syncthreads();
    {
        const int j = tid & 63, p0 = tid >> 6;
        float wc[64], acc[8];
#pragma unroll
        for (int f = 0; f < 33; ++f) wc[f] = w1[f * 64 + j];
#pragma unroll
        for (int m = 0; m < 8; ++m) { float sacc = b1[j];
#pragma unroll
            for (int f = 0; f < 33; ++f) sacc = fmaf(z[(p0 + 8 * m) * 34 + f], wc[f], sacc);
            acc[m] = sacc; }
#pragma unroll
        for (int m = 0; m < 8; ++m) hd1[(p0 + 8 * m) * 65 + j] = __sinf(fq[j] * acc[m]);
        __syncthreads();
#pragma unroll
        for (int f = 0; f < 64; ++f) wc[f] = w2[f * 64 + j];
#pragma unroll
        for (int m = 0; m < 8; ++m) { float sacc = b2[j];
#pragma unroll
            for (int f = 0; f < 64; ++f) sacc = fmaf(hd1[(p0 + 8 * m) * 65 + f], wc[f], sacc);
            acc[m] = sacc; }
#pragma unroll
        for (int m = 0; m < 8; ++m) hd2[(p0 + 8 * m) * 65 + j] = __sinf(fq[j] * acc[m]);
        __syncthreads();
    }
    const float max_decay = -15.350567286626973f, min_decay = -3.0701134573253945f;
    float* hraw = (float*)(p.ws + WS_F + (set ? F_HRAW_CTX : F_HRAW_LAT));
    float* hyn = (float*)(p.ws + WS_F + (set ? F_HYP_CTX : F_HYP_LAT)) + (size_t)chunk * 2048;
    for (int cb = 0; cb < 4; ++cb) {
        const int o = cb * NT + tid;
        const int c = o & 511; const float delta = fabsf(min_decay + (float)c * ((max_decay - min_decay) / 511.f));
        float asum = 0.f;
        float* dst = hraw + (size_t)o * Ls + l0;
        for (int ph = 0; ph < 2; ++ph) {
            float acc[32];
#pragma unroll
            for (int pp = 0; pp < 32; ++pp) acc[pp] = 0.f;
#pragma unroll 1
            for (int j0 = 0; j0 < 64; j0 += 16) {
                float wv[16];
#pragma unroll
                for (int j = 0; j < 16; ++j) wv[j] = w3[(j0 + j) * 2048 + o];
#pragma unroll
                for (int j = 0; j < 16; ++j) {
#pragma unroll
                    for (int pp = 0; pp < 32; ++pp) acc[pp] = fmaf(hd2[(ph * 32 + pp) * 65 + j0 + j], wv[j], acc[pp]);
                    SCHED_FENCE();
                }
            }
#pragma unroll
            for (int q4 = 0; q4 < 8; ++q4) {
                f32x4 v;
#pragma unroll
                for (int e = 0; e < 4; ++e) { const int pp = q4 * 4 + e; const float tl = (float)(l0 + ph * 32 + pp) / (float)(Ls - 1); const float val = acc[pp] * expf(-tl * delta); v[e] = val; asum += fabsf(val); }
                *(f32x4*)(dst + ph * 32 + q4 * 4) = v;
            }
        }
        hyn[o] = asum;
    }
    __syncthreads();
}

constexpr int P0_MOD = 192, P0_TR_IN0 = 16 * 36, P0_TR_OUT0 = 256, P0_TR_IN1 = 16 * 80, P0_TR_OUT1 = 256, P0_TR_Q = 16 * 32, P0_KEYS = 32, P0_TAB = 512,
              P0_FILT = L / 64 + LC / 64;
DEV void phase0(const Params& p, unsigned char* smem) {
    bf16_t* W = (bf16_t*)(p.ws + WS_W);
    const int total = P0_MOD + P0_FILT + P0_TR_IN0 + P0_TR_OUT0 + P0_TR_IN1 + P0_TR_OUT1 + 2 * P0_TR_Q + P0_KEYS + 4 * P0_TAB;
    for (int it = blockIdx.x; it < total; it += gridDim.x) {
        int i = it;
        if (i < P0_MOD) { p0_mod(p, i, smem); continue; } i -= P0_MOD;
        if (i < P0_FILT) { if (i < L / 64) p0_filter(p, 0, i, smem); else p0_filter(p, 1, i - L / 64, smem); continue; } i -= P0_FILT;
        if (i < P0_TR_IN0) { p0_transpose(p.in[I_ABWIN], W + W_IN0 / 2, 2304, i, smem); continue; } i -= P0_TR_IN0;
        if (i < P0_TR_OUT0) { p0_transpose(p.in[I_ABWOUT], W + W_OUT0 / 2, 1024, i, smem); continue; } i -= P0_TR_OUT0;
        if (i < P0_TR_IN1) { p0_transpose(p.in[I_HGWIN], W + W_IN1 / 2, 5120, i, smem); continue; } i -= P0_TR_IN1;
        if (i < P0_TR_OUT1) { p0_transpose(p.in[I_HGWOUT], W + W_OUT1 / 2, 1024, i, smem); continue; } i -= P0_TR_OUT1;
        if (i < P0_TR_Q) { p0_transpose(p.in[I_PWQ], W + W_Q0 / 2, 2048, i, smem); continue; } i -= P0_TR_Q;
        if (i < P0_TR_Q) { p0_transpose(p.in[I_PWQ] + (size_t)1024 * 2048, W + W_Q1 / 2, 2048, i, smem); continue; } i -= P0_TR_Q;
        if (i < P0_KEYS) { p0_convert(p.in[I_PKEYS], W + W_KEYS / 2, i); continue; } i -= P0_KEYS;
        p0_table8(p, i / P0_TAB, i % P0_TAB);
    }
}

DEV const float* h_row(const Params& p, int layer_src_inputs, int tok) {
    if (layer_src_inputs) return tok < TL ? p.in[I_X] + (size_t)tok * 1024 : p.in[I_CTX] + (size_t)(tok - TL) * 1024;
    return (const float*)(p.ws + WS_H) + (size_t)tok * 1024;
}
DEV void norm_row_store(const Params& p, const f32x4 (&v)[4], int tok, const float* g, int layer, int sh_off, int lane) {
    float ss = 0.f;
#pragma unroll
    for (int i = 0; i < 4; ++i) ss += v[i][0] * v[i][0] + v[i][1] * v[i][1] + v[i][2] * v[i][2] + v[i][3] * v[i][3];
    ss = wave_sum(ss);
    const float rstd = rsqrtf(ss * (1.f / 1024.f) + 1e-6f);
    const float* mod = (const float*)(p.ws + WS_MOD) + ((size_t)layer * NR + mod_row(tok)) * 6144 + sh_off;
    bf16_t* A = (bf16_t*)(p.ws + WS_A) + (size_t)tok * 1024;
#pragma unroll
    for (int i = 0; i < 4; ++i) {
        const int c = i * 256 + lane * 4;
        const f32x4 gg = *(const f32x4*)(g + c), sh = *(const f32x4*)(mod + c), sc = *(const f32x4*)(mod + 1024 + c);
        u32x2 o;
        o[0] = pk2(v[i][0] * rstd * gg[0] * (1.f + sc[0]) + sh[0], v[i][1] * rstd * gg[1] * (1.f + sc[1]) + sh[1]);
        o[1] = pk2(v[i][2] * rstd * gg[2] * (1.f + sc[2]) + sh[2], v[i][3] * rstd * gg[3] * (1.f + sc[3]) + sh[3]);
        *(u32x2*)(A + c) = o;
    }
}
DEV void norm_rows_item(const Params& p, int item, int from_inputs, const float* g, int layer, int sh_off) {
    const int tok = item * 8 + (tidx() >> 6), lane = tidx() & 63;
    const float* src = h_row(p, from_inputs, tok);
    f32x4 v[4];
#pragma unroll
    for (int i = 0; i < 4; ++i) v[i] = *(const f32x4*)(src + i * 256 + lane * 4);
    norm_row_store(p, v, tok, g, layer, sh_off, lane);
}

DEV cf2 cmul(cf2 a, cf2 b) { cf2 r; r.x = a.x * b.x - a.y * b.y; r.y = a.x * b.y + a.y * b.x; return r; }
DEV cf2 twid(int k, float invN) { cf2 r; const float a = (float)k * invN; r.x = __builtin_amdgcn_cosf(a); r.y = -__builtin_amdgcn_sinf(a); return r; }
DEV void fft_fwd(cf2* buf, int S, int g, int G) {
    const int N = 1 << (2 * S); const float invN = 1.f / (float)N;
    for (int s = 0; s < S; ++s) {
        const int lm = 2 * (S - s), m = 1 << lm, q = m >> 2;
        for (int bf = g; bf < (N >> 2); bf += G) {
            const int j = bf & (q - 1), base = ((bf >> (lm - 2)) << lm) + j;
            const cf2 a0 = buf[base], a1 = buf[base + q], a2 = buf[base + 2 * q], a3 = buf[base + 3 * q];
            cf2 t0, t1, t2, t3; t0.x = a0.x + a2.x; t0.y = a0.y + a2.y; t1.x = a0.x - a2.x; t1.y = a0.y - a2.y; t2.x = a1.x + a3.x; t2.y = a1.y + a3.y;
            const float dx = a1.x - a3.x, dy = a1.y - a3.y; t3.x = dy; t3.y = -dx;
            cf2 y0, y1, y2, y3; y0.x = t0.x + t2.x; y0.y = t0.y + t2.y; y1.x = t1.x + t3.x; y1.y = t1.y + t3.y; y2.x = t0.x - t2.x; y2.y = t0.y - t2.y; y3.x = t1.x - t3.x; y3.y = t1.y - t3.y;
            const int tw = j << (2 * s);
            buf[base] = y0; buf[base + q] = cmul(y1, twid(tw, invN)); buf[base + 2 * q] = cmul(y2, twid(2 * tw, invN)); buf[base + 3 * q] = cmul(y3, twid(3 * tw, invN));
        }
        __syncthreads();
    }
}
DEV void fft_inv(cf2* buf, int S, int g, int G) {
    const int N = 1 << (2 * S); const float invN = 1.f / (float)N;
    for (int s = S - 1; s >= 0; --s) {
        const int lm = 2 * (S - s), m = 1 << lm, q = m >> 2;
        for (int bf = g; bf < (N >> 2); bf += G) {
            const int j = bf & (q - 1), base = ((bf >> (lm - 2)) << lm) + j;
            const int tw = j << (2 * s);
            cf2 w1 = twid(tw, invN), w2 = twid(2 * tw, invN), w3 = twid(3 * tw, invN); w1.y = -w1.y; w2.y = -w2.y; w3.y = -w3.y;
            const cf2 c0 = buf[base], c1 = cmul(buf[base + q], w1), c2 = cmul(buf[base + 2 * q], w2), c3 = cmul(buf[base + 3 * q], w3);
            cf2 t0, t1, t2, t3; t0.x = c0.x + c2.x; t0.y = c0.y + c2.y; t1.x = c0.x - c2.x; t1.y = c0.y - c2.y; t2.x = c1.x + c3.x; t2.y = c1.y + c3.y;
            const float dx = c1.x - c3.x, dy = c1.y - c3.y; t3.x = -dy; t3.y = dx;
            cf2 a0, a1, a2, a3; a0.x = t0.x + t2.x; a0.y = t0.y + t2.y; a1.x = t1.x + t3.x; a1.y = t1.y + t3.y; a2.x = t0.x - t2.x; a2.y = t0.y - t2.y; a3.x = t1.x - t3.x; a3.y = t1.y - t3.y;
            buf[base] = a0; buf[base + q] = a1; buf[base + 2 * q] = a2; buf[base + 3 * q] = a3;
        }
        __syncthreads();
    }
}
DEV void hf_item(const Params& p, int set, int pi, unsigned char* smem) {
    const int Ls = set ? LC : L, S = set ? FS_CTX : FS_LAT, N = 1 << (2 * S);
    const int gi = tidx() >> 8, g = tidx() & 255, idx = pi * 2 + gi, o = idx >> 9, c = idx & 511;
    cf2* buf = (cf2*)smem + (size_t)gi * N;
    const float* hraw = (const float*)(p.ws + WS_F + (set ? F_HRAW_CTX : F_HRAW_LAT));
    const float* hyn = (const float*)(p.ws + WS_F + (set ? F_HYP_CTX : F_HYP_LAT));
    float nsum = 0.f;
    for (int ch = 0; ch < Ls / 64; ++ch) nsum += hyn[(size_t)ch * 2048 + o * 1024 + c] + hyn[(size_t)ch * 2048 + o * 1024 + 512 + c];
    const float inv = 1.f / nsum;
    const float* hf = hraw + (size_t)(o * 1024 + c) * Ls; const float* hb = hraw + (size_t)(o * 1024 + 512 + c) * Ls;
    for (int k = g; k < N; k += 256) { float re = 0.f; if (k < Ls) re = hf[k] * inv; else if (k > N - Ls) re = hb[N - k] * inv; cf2 v; v.x = re; v.y = 0.f; buf[k] = v; }
    __syncthreads();
    fft_fwd(buf, S, g, 256);
    cf2* HF = (cf2*)(p.ws + WS_F + (set ? F_HF_CTX : F_HF_LAT)) + (size_t)(o * 512 + c) * N;
    for (int k = g; k < N; k += 256) HF[k] = buf[k];
    __syncthreads();
}
constexpr int P1_NORM = T / 8, P1_HF = 512;
DEV void phase1(const Params& p, unsigned char* smem) {
    const int total = P1_NORM + 2 * P1_HF;
    for (int it = blockIdx.x; it < total; it += gridDim.x) {
        if (it < P1_NORM) norm_rows_item(p, it, 1, p.in[I_N1G], 0, 0);
        else if (it < P1_NORM + P1_HF) hf_item(p, 0, it - P1_NORM, smem);
        else hf_item(p, 1, it - P1_NORM - P1_HF, smem);
    }
}

constexpr int G_LDA = 72;
template <class Epi>
DEV void gemm_tile(const bf16_t* __restrict__ A, const bf16_t* __restrict__ Wt, int m0, int n0, unsigned char* smem, const Epi& epi) {
    bf16_t* As = (bf16_t*)smem;
    bf16_t* Bs = As + 2 * 256 * G_LDA;
    const int tid = tidx(), lane = tid & 63, w = tid >> 6, wm = w >> 1, wn = w & 1;
    f32x16 acc[2][2];
#pragma unroll
    for (int i = 0; i < 2; ++i)
#pragma unroll
        for (int j = 0; j < 2; ++j)
#pragma unroll
            for (int r = 0; r < 16; ++r) acc[i][j][r] = 0.f;
    u32x4 ra[4], rb[2];
    const bf16_t* Ag = A + (size_t)m0 * 1024; const bf16_t* Bg = Wt + (size_t)n0 * 1024;
#define GLOAD(k0) do { \
        _Pragma("unroll") for (int i = 0; i < 4; ++i) { const int id = tid + NT * i, row = id >> 3, kc = id & 7; ra[i] = *(const u32x4*)(Ag + (size_t)row * 1024 + (k0) + kc * 8); } \
        _Pragma("unroll") for (int i = 0; i < 2; ++i) { const int id = tid + NT * i, row = id >> 3, kc = id & 7; rb[i] = *(const u32x4*)(Bg + (size_t)row * 1024 + (k0) + kc * 8); } } while (0)
#define LSTORE(buf_) do { \
        _Pragma("unroll") for (int i = 0; i < 4; ++i) { const int id = tid + NT * i, row = id >> 3, kc = id & 7; *(u32x4*)(As + ((buf_) * 256 + row) * G_LDA + kc * 8) = ra[i]; } \
        _Pragma("unroll") for (int i = 0; i < 2; ++i) { const int id = tid + NT * i, row = id >> 3, kc = id & 7; *(u32x4*)(Bs + ((buf_) * 128 + row) * G_LDA + kc * 8) = rb[i]; } } while (0)
    GLOAD(0); LSTORE(0); __syncthreads();
    for (int kt = 0; kt < 16; ++kt) {
        const int buf = kt & 1;
        if (kt + 1 < 16) GLOAD((kt + 1) * 64);
        const bf16_t* as = As + (buf * 256 + wm * 64 + (lane & 31)) * G_LDA + 8 * (lane >> 5);
        const bf16_t* bs = Bs + (buf * 128 + wn * 64 + (lane & 31)) * G_LDA + 8 * (lane >> 5);
#pragma unroll
        for (int kk = 0; kk < 4; ++kk) {
            const bf16x8 a0 = *(const bf16x8*)(as + kk * 16), a1 = *(const bf16x8*)(as + 32 * G_LDA + kk * 16);
            const bf16x8 b0 = *(const bf16x8*)(bs + kk * 16), b1 = *(const bf16x8*)(bs + 32 * G_LDA + kk * 16);
            acc[0][0] = __builtin_amdgcn_mfma_f32_32x32x16_bf16(a0, b0, acc[0][0], 0, 0, 0);
            acc[0][1] = __builtin_amdgcn_mfma_f32_32x32x16_bf16(a0, b1, acc[0][1], 0, 0, 0);
            acc[1][0] = __builtin_amdgcn_mfma_f32_32x32x16_bf16(a1, b0, acc[1][0], 0, 0, 0);
            acc[1][1] = __builtin_amdgcn_mfma_f32_32x32x16_bf16(a1, b1, acc[1][1], 0, 0, 0);
        }
        if (kt + 1 < 16) LSTORE(buf ^ 1);
        __syncthreads();
    }
#pragma unroll
    for (int mi = 0; mi < 2; ++mi)
#pragma unroll
        for (int ni = 0; ni < 2; ++ni)
#pragma unroll
            for (int rg = 0; rg < 4; ++rg) {
                const int row = m0 + wm * 64 + mi * 32 + 8 * rg + 4 * (lane >> 5), col = n0 + wn * 64 + ni * 32 + (lane & 31);
                epi(row, col, acc[mi][ni][rg * 4 + 0], acc[mi][ni][rg * 4 + 1], acc[mi][ni][rg * 4 + 2], acc[mi][ni][rg * 4 + 3]);
            }
}
struct EpiL0In {
    unsigned char* ws;
    DEV void operator()(int row, int col, float v0, float v1, float v2, float v3) const {
        u32x2 o; o[0] = pk2(v0, v1); o[1] = pk2(v2, v3);
        const bool lat = row < TL; const int b = lat ? row / L : (row - TL) / LC, t = lat ? row - b * L : (row - TL) - b * LC, Lx = lat ? L : LC;
        if (col < 1536) { bf16_t* d = (bf16_t*)(ws + WS_P + (lat ? P_HYT_LAT : P_HYT_CTX)) + ((size_t)b * 1536 + col) * Lx + t; *(u32x2*)d = o; }
        else if (col < 2048) { bf16_t* d = (bf16_t*)(ws + WS_P + P_Q0) + (size_t)row * 512 + (col - 1536); d[0] = (bf16_t)f2bf(v0); d[512] = (bf16_t)f2bf(v1); d[1024] = (bf16_t)f2bf(v2); d[1536] = (bf16_t)f2bf(v3); }
        else if (col < 2176) { bf16_t* d = (bf16_t*)(ws + WS_P + P_K0) + (size_t)row * 128 + (col - 2048); d[0] = (bf16_t)f2bf(v0); d[128] = (bf16_t)f2bf(v1); d[256] = (bf16_t)f2bf(v2); d[384] = (bf16_t)f2bf(v3); }
        else { bf16_t* d = (bf16_t*)(ws + WS_P + (lat ? P_VT_LAT : P_VT_CTX)) + ((size_t)b * 128 + (col - 2176)) * Lx + t; *(u32x2*)d = o; }
    }
};
struct EpiBf16 {
    bf16_t* out; int ld;
    DEV void operator()(int row, int col, float v0, float v1, float v2, float v3) const {
        bf16_t* d = out + (size_t)row * ld + col; d[0] = (bf16_t)f2bf(v0); d[ld] = (bf16_t)f2bf(v1); d[2 * ld] = (bf16_t)f2bf(v2); d[3 * ld] = (bf16_t)f2bf(v3);
    }
};
struct EpiHg {
    unsigned char* ws; const float* lg;
    DEV void operator()(int row, int col, float v0, float v1, float v2, float v3) const {
        float vv[4] = {v0, v1, v2, v3};
        if (col >= 3072 && col < 4096) {
            const bool lat = row < TL; const int b = lat ? row / L : (row - TL) / LC, t = lat ? row - b * L : (row - TL) - b * LC, Lx = lat ? L : LC;
            bf16_t* d = (bf16_t*)(ws + WS_M) + (lat ? (size_t)0 : (size_t)NB * 1024 * L) + ((size_t)b * 1024 + (col - 3072)) * Lx + t;
            u32x2 o; o[0] = pk2(v0, v1); o[1] = pk2(v2, v3); *(u32x2*)d = o;
            return;
        }
        if (col < 1024 || col >= 4096) {
#pragma unroll
            for (int i = 0; i < 4; ++i) vv[i] = silu_f(vv[i]);
        } else {
            const int c = col - 1024;
            const float oml = 1.f - 1.f / (1.f + __expf(lg[c] - lg[2048 + c]));
#pragma unroll
            for (int i = 0; i < 4; ++i) vv[i] = oml / (1.f + __expf(vv[i]));
        }
        bf16_t* d = (bf16_t*)(ws + WS_P) + (size_t)row * 5120 + col; d[0] = (bf16_t)f2bf(vv[0]); d[5120] = (bf16_t)f2bf(vv[1]); d[2 * 5120] = (bf16_t)f2bf(vv[2]); d[3 * 5120] = (bf16_t)f2bf(vv[3]);
    }
};
struct EpiRes {
    const Params* p; int from_inputs, layer, goff;
    DEV void operator()(int row, int col, float v0, float v1, float v2, float v3) const {
        const float vv[4] = {v0, v1, v2, v3};
        float* H = (float*)(p->ws + WS_H);
        const float* mod = (const float*)(p->ws + WS_MOD) + (size_t)layer * NR * 6144 + goff + col;
#pragma unroll
        for (int i = 0; i < 4; ++i) { const int r = row + i; H[(size_t)r * 1024 + col] = h_row(*p, from_inputs, r)[col] + mod[(size_t)mod_row(r) * 6144] * vv[i]; }
    }
};

DEV float hy_u(const bf16_t* row, int t, int Lx, float w0, float w1, float w2, float b) {
    const float xm = t > 0 ? bf2f(row[t - 1]) : 0.f, x0 = bf2f(row[t]), xp = t + 1 < Lx ? bf2f(row[t + 1]) : 0.f;
    return w0 * xm + w1 * x0 + w2 * xp + b;
}
DEV void hyena_item(const Params& p, int set, int item, unsigned char* smem) {
    const int Ls = set ? LC : L, S = set ? FS_CTX : FS_LAT, N = 1 << (2 * S);
    const int gi = tidx() >> 8, g = tidx() & 255;
    const int bp = item >> 8, c = (item & 255) * 2 + gi, ba = bp * 2, bb = ba + 1;
    cf2* buf = (cf2*)smem + (size_t)gi * N;
    cf2* zk = (cf2*)smem + (size_t)2 * N + (size_t)gi * Ls;
    const bf16_t* hy = (const bf16_t*)(p.ws + WS_P + (set ? P_HYT_CTX : P_HYT_LAT));
    const float* cw = p.in[I_HYCW]; const float* cb = p.in[I_HYCB];
    const cf2* HF = (const cf2*)(p.ws + WS_F + (set ? F_HF_CTX : F_HF_LAT));
    const float invN = 1.f / (float)N;
    {
        const float w0 = cw[c], w1 = cw[1536 + c], w2 = cw[3072 + c], b = cb[c];
        const bf16_t* ra = hy + ((size_t)ba * 1536 + c) * Ls; const bf16_t* rb = hy + ((size_t)bb * 1536 + c) * Ls;
        for (int t = g; t < N; t += 256) { cf2 v; v.x = 0.f; v.y = 0.f; if (t < Ls) { v.x = hy_u(ra, t, Ls, w0, w1, w2, b); v.y = hy_u(rb, t, Ls, w0, w1, w2, b); zk[t] = v; } buf[t] = v; }
    }
    __syncthreads();
    for (int n = 0; n < 2; ++n) {
        fft_fwd(buf, S, g, 256);
        const cf2* hf = HF + (size_t)(n * 512 + c) * N;
        for (int k = g; k < N; k += 256) buf[k] = cmul(buf[k], hf[k]);
        __syncthreads();
        fft_inv(buf, S, g, 256);
        const int gc = (n + 1) * 512 + c;
        const float w0 = cw[gc], w1 = cw[1536 + gc], w2 = cw[3072 + gc], b = cb[gc], dsk = p.in[I_HYSKIP][n * 512 + c];
        const bf16_t* ra = hy + ((size_t)ba * 1536 + gc) * Ls; const bf16_t* rb = hy + ((size_t)bb * 1536 + gc) * Ls;
        bf16_t* M = (bf16_t*)(p.ws + WS_M);
        for (int t = g; t < N; t += 256) {
            cf2 v; v.x = 0.f; v.y = 0.f;
            if (t < Ls) {
                const cf2 cv = buf[t], zo = zk[t];
                v.x = hy_u(ra, t, Ls, w0, w1, w2, b) * (cv.x * invN + dsk * zo.x); v.y = hy_u(rb, t, Ls, w0, w1, w2, b) * (cv.y * invN + dsk * zo.y);
                if (n == 0) zk[t] = v;
                else { const size_t ta = set ? (size_t)TL + (size_t)ba * LC + t : (size_t)ba * L + t, tb = set ? (size_t)TL + (size_t)bb * LC + t : (size_t)bb * L + t;
                       M[ta * 1024 + c] = (bf16_t)f2bf(v.x); M[tb * 1024 + c] = (bf16_t)f2bf(v.y); }
            }
            if (n == 0) buf[t] = v;
        }
        __syncthreads();
    }
}
DEV void rope_store(const bf16_t* src, bf16_t* dst, int pos, bool rope, float scale, int ph, int sub) {
    const u32x4 ua = *(const u32x4*)(src + ph * 32 + sub * 8), ub = *(const u32x4*)(src + ph * 32 + 16 + sub * 8);
    float a[8], b[8];
#pragma unroll
    for (int i = 0; i < 4; ++i) { a[2 * i] = bflo(ua[i]); a[2 * i + 1] = bfhi(ua[i]); b[2 * i] = bflo(ub[i]); b[2 * i + 1] = bfhi(ub[i]); }
    if (rope) {
        const float pv = (float)(ph == 0 ? pos / 64 : pos % 64);
#pragma unroll
        for (int e = 0; e < 8; ++e) {
            const float inv = exp2f(-(float)(sub * 8 + e) * (13.287712379549449f / 16.f));
            const float ang = pv * inv, cs = __cosf(ang), sn = __sinf(ang);
            const float na = a[e] * cs - b[e] * sn, nb = b[e] * cs + a[e] * sn; a[e] = na; b[e] = nb;
        }
    }
    u32x4 oa, ob;
#pragma unroll
    for (int i = 0; i < 4; ++i) { oa[i] = pk2(a[2 * i] * scale, a[2 * i + 1] * scale); ob[i] = pk2(b[2 * i] * scale, b[2 * i + 1] * scale); }
    *(u32x4*)(dst + ph * 32 + sub * 8) = oa; *(u32x4*)(dst + ph * 32 + 16 + sub * 8) = ob;
}
constexpr int A_LDQ = 72, A_LDV = 136;
DEV void attn_item(const Params& p, int set, int item, unsigned char* smem) {
    bf16_t* Qs = (bf16_t*)smem;
    bf16_t* Ks = Qs + 128 * A_LDQ;
    bf16_t* Vt = Ks + 128 * A_LDQ;
    const int tid = tidx(), lane = tid & 63, w = tid >> 6, l15 = lane & 15, lg = lane >> 4;
    const int nqb = set ? LC / 128 : L / 128;
    const int h = item & 7, qb = (item >> 3) % nqb, b = (item >> 3) / nqb, kvh = h >> 2;
    const bf16_t* Q0 = (const bf16_t*)(p.ws + WS_P + P_Q0); const bf16_t* K0 = (const bf16_t*)(p.ws + WS_P + P_K0);
    const int qtok0 = set ? TL + b * LC + qb * 128 : b * L + qb * 128;
    { const int row = tid >> 2, ph = (tid >> 1) & 1, sub = tid & 1;
      rope_store(Q0 + (size_t)(qtok0 + row) * 512 + h * 64, Qs + row * A_LDQ, qb * 128 + row, set == 0, 0.125f, ph, sub); }
    __syncthreads();
    bf16x8 qf[2];
    qf[0] = *(const bf16x8*)(Qs + (w * 16 + l15) * A_LDQ + 8 * lg); qf[1] = *(const bf16x8*)(Qs + (w * 16 + l15) * A_LDQ + 32 + 8 * lg);
    float m_run = p.in[I_SINK][h], l_run = 1.f;
    f32x4 O[4];
#pragma unroll
    for (int i = 0; i < 4; ++i) O[i] = (f32x4){0.f, 0.f, 0.f, 0.f};
    const int nwin = set ? 0 : 3, nctx = LC / 128;
    for (int kbi = 0; kbi < nwin + nctx; ++kbi) {
        const bool win = kbi < nwin; const int kb = win ? qb - 1 + kbi : kbi - nwin;
        if (win && (kb < 0 || kb >= L / 128)) continue;
        const int ktok0 = win ? b * L + kb * 128 : TL + b * LC + kb * 128;
        __syncthreads();
        { const int row = tid >> 2, ph = (tid >> 1) & 1, sub = tid & 1;
          rope_store(K0 + (size_t)(ktok0 + row) * 128 + kvh * 64, Ks + row * A_LDQ, kb * 128 + row, win, 1.f, ph, sub); }
        { const bf16_t* vt = (const bf16_t*)(p.ws + WS_P + (win ? P_VT_LAT : P_VT_CTX)); const int Lx = win ? L : LC;
#pragma unroll
          for (int i = 0; i < 2; ++i) { const int id = tid + NT * i, d = id >> 4, kc = id & 15;
              *(u32x4*)(Vt + d * A_LDV + kc * 8) = *(const u32x4*)(vt + ((size_t)b * 128 + kvh * 64 + d) * Lx + kb * 128 + kc * 8); } }
        __syncthreads();
#pragma unroll
        for (int ch = 0; ch < 2; ++ch) {
            f32x4 st[4];
#pragma unroll
            for (int u = 0; u < 4; ++u) {
                const bf16_t* kr = Ks + ((ch * 4 + u) * 16 + l15) * A_LDQ + 8 * lg;
                f32x4 z = (f32x4){0.f, 0.f, 0.f, 0.f};
                z = __builtin_amdgcn_mfma_f32_16x16x32_bf16(*(const bf16x8*)kr, qf[0], z, 0, 0, 0);
                z = __builtin_amdgcn_mfma_f32_16x16x32_bf16(*(const bf16x8*)(kr + 32), qf[1], z, 0, 0, 0);
                st[u] = z;
            }
            float cmax = -INFINITY;
            if (win) {
                const int qpos = qb * 128 + w * 16 + l15;
#pragma unroll
                for (int u = 0; u < 4; ++u)
#pragma unroll
                    for (int r = 0; r < 4; ++r) { const int kpos = kb * 128 + (ch * 4 + u) * 16 + 4 * lg + r; const int dd = qpos - kpos; if (dd > 128 || dd < -128) st[u][r] = -INFINITY; }
            }
#pragma unroll
            for (int u = 0; u < 4; ++u)
#pragma unroll
                for (int r = 0; r < 4; ++r) cmax = fmaxf(cmax, st[u][r]);
            cmax = fmaxf(cmax, __shfl_xor(cmax, 16)); cmax = fmaxf(cmax, __shfl_xor(cmax, 32));
            const float m_new = fmaxf(m_run, cmax), alpha = __expf(m_run - m_new);
            float ls = 0.f;
#pragma unroll
            for (int u = 0; u < 4; ++u)
#pragma unroll
                for (int r = 0; r < 4; ++r) { const float e = __expf(st[u][r] - m_new); st[u][r] = e; ls += e; }
            ls += __shfl_xor(ls, 16); ls += __shfl_xor(ls, 32);
            l_run = l_run * alpha + ls; m_run = m_new;
#pragma unroll
            for (int i = 0; i < 4; ++i) { O[i][0] *= alpha; O[i][1] *= alpha; O[i][2] *= alpha; O[i][3] *= alpha; }
#pragma unroll
            for (int ss = 0; ss < 2; ++ss) {
                u32x4 pu; pu[0] = pk2(st[2 * ss][0], st[2 * ss][1]); pu[1] = pk2(st[2 * ss][2], st[2 * ss][3]); pu[2] = pk2(st[2 * ss + 1][0], st[2 * ss + 1][1]); pu[3] = pk2(st[2 * ss + 1][2], st[2 * ss + 1][3]);
                const bf16x8 pf = __builtin_bit_cast(bf16x8, pu);
                const int key0 = (ch * 4 + 2 * ss) * 16 + 4 * lg;
#pragma unroll
                for (int dt = 0; dt < 4; ++dt) {
                    const bf16_t* vr = Vt + (dt * 16 + l15) * A_LDV + key0;
                    u32x4 vu; const u32x2 v0 = *(const u32x2*)vr, v1 = *(const u32x2*)(vr + 16); vu[0] = v0[0]; vu[1] = v0[1]; vu[2] = v1[0]; vu[3] = v1[1];
                    O[dt] = __builtin_amdgcn_mfma_f32_16x16x32_bf16(__builtin_bit_cast(bf16x8, vu), pf, O[dt], 0, 0, 0);
                }
            }
        }
    }
    const float il = 1.f / l_run;
    bf16_t* M = (bf16_t*)(p.ws + WS_M) + (size_t)(qtok0 + w * 16 + l15) * 1024 + 512 + h * 64;
#pragma unroll
    for (int dt = 0; dt < 4; ++dt) { u32x2 o; o[0] = pk2(O[dt][0] * il, O[dt][1] * il); o[1] = pk2(O[dt][2] * il, O[dt][3] * il); *(u32x2*)(M + dt * 16 + 4 * lg) = o; }
    __syncthreads();
}
constexpr int P3_HY_LAT = (NB / 2) * 256, P3_HY_CTX = (NB / 2) * 256, P3_AT_LAT = NB * (L / 128) * 8, P3_AT_CTX = NB * (LC / 128) * 8;
DEV void phase3(const Params& p, unsigned char* smem) {
    const int total = P3_HY_LAT + P3_AT_LAT + P3_HY_CTX + P3_AT_CTX;
    for (int it = blockIdx.x; it < total; it += gridDim.x) {
        int i = it;
        if (i < P3_HY_LAT) { hyena_item(p, 0, i, smem); continue; } i -= P3_HY_LAT;
        if (i < P3_AT_LAT) { attn_item(p, 0, i, smem); continue; } i -= P3_AT_LAT;
        if (i < P3_HY_CTX) { hyena_item(p, 1, i, smem); continue; } i -= P3_HY_CTX;
        attn_item(p, 1, i, smem);
    }
}

constexpr int K_LDK = 136, K_LDS = 129, K_LDC = 52;
DEV unsigned fkey(float f) { const unsigned u = __builtin_bit_cast(unsigned, f); return (u & 0x80000000u) ? ~u : (u | 0x80000000u); }
constexpr int cand_off(int i) { int o = 0; for (int k = 0; k < i; ++k) o += 16 / (k + 1); return o; }
DEV void topk_load_keys(const Params& p, int layer, int h, unsigned char* smem) {
    bf16_t* Ks = (bf16_t*)smem;
    const bf16_t* keys = (const bf16_t*)(p.ws + WS_W + W_KEYS) + (size_t)layer * 262144 + (size_t)h * 32768;
    const int tid = tidx();
#pragma unroll
    for (int i = 0; i < 8; ++i) { const int id = tid + NT * i, row = id >> 4, kc = id & 15; *(u32x4*)(Ks + row * K_LDK + kc * 8) = *(const u32x4*)(keys + (size_t)row * 128 + kc * 8); }
    __syncthreads();
}
#ifndef HOST_EMU
template <int CTRL> DEV unsigned dpp_u32(unsigned v) { return (unsigned)__builtin_amdgcn_update_dpp(0, (int)v, CTRL, 0xF, 0xF, true); }
#else
template <int CTRL> DEV unsigned dpp_u32(unsigned v) { const int lane = tidx() & 63; const int src = CTRL == 0xB1 ? (lane ^ 1) : CTRL == 0x4E ? (lane ^ 2) : ((lane & ~7) | (7 - (lane & 7))); return emu_shfl(v, src); }
#endif
DEV unsigned max8_u32(unsigned v) { unsigned t = dpp_u32<0xB1>(v); v = v > t ? v : t; t = dpp_u32<0x4E>(v); v = v > t ? v : t; t = dpp_u32<0x141>(v); return v > t ? v : t; }
DEV float sum8_f32(float v) { v += __builtin_bit_cast(float, dpp_u32<0xB1>(__builtin_bit_cast(unsigned, v))); v += __builtin_bit_cast(float, dpp_u32<0x4E>(__builtin_bit_cast(unsigned, v))); v += __builtin_bit_cast(float, dpp_u32<0x141>(__builtin_bit_cast(unsigned, v))); return v; }
DEV float unkey(unsigned k) { const unsigned u = (k & 0x80000000u) ? (k & 0x7fffffffu) : ~k; return __builtin_bit_cast(float, u); }
template <int N> DEV void bitonic_desc(unsigned (&a)[N]) {
#pragma unroll
    for (int k = 2; k <= N; k <<= 1)
#pragma unroll
        for (int j = k >> 1; j > 0; j >>= 1)
#pragma unroll
            for (int i = 0; i < N; ++i) { const int l = i ^ j; if (l > i) { const unsigned x = a[i], y = a[l]; const unsigned hi = x > y ? x : y, lo = x > y ? y : x; if ((i & k) == 0) { a[i] = hi; a[l] = lo; } else { a[i] = lo; a[l] = hi; } } }
}
DEV void merge16(const unsigned* lst, int nlist, unsigned first, int sub, unsigned& r0, unsigned& r1) {
    unsigned cur = first; int head = 0; r0 = 0u; r1 = 0u;
#pragma unroll
    for (int it = 0; it < 16; ++it) {
        const unsigned m = max8_u32(cur);
        if (sub == (it & 7)) { if (it < 8) r0 = m; else r1 = m; }
        if (cur == m) { ++head; cur = head < nlist ? lst[head] : 0u; }
    }
}
DEV void topk_item(const Params& p, int h, int tok0, unsigned char* smem) {
    bf16_t* Ks = (bf16_t*)smem;
    float* Sc = (float*)(Ks + 2 * 128 * K_LDK);
    unsigned* s12 = (unsigned*)Sc + 64 * 8 * 17;
    unsigned* cl = s12 + 64 * 32;
    const int tid = tidx(), lane = tid & 63, w = tid >> 6;
    const int row = tid >> 3, sub = tid & 7;
    const bf16_t* PQ = (const bf16_t*)(p.ws + WS_P);
    for (int part = 0; part < 2; ++part) {
        { const int mi = w >> 2, ni = w & 3;
          f32x16 acc;
#pragma unroll
          for (int r = 0; r < 16; ++r) acc[r] = 0.f;
          const bf16_t* ag = PQ + (size_t)(tok0 + mi * 32 + (lane & 31)) * 2048 + h * 256 + part * 128 + 8 * (lane >> 5);
          const bf16_t* bs = Ks + (part * 128 + ni * 32 + (lane & 31)) * K_LDK + 8 * (lane >> 5);
          bf16x8 af[8];
#pragma unroll
          for (int kk = 0; kk < 8; ++kk) af[kk] = *(const bf16x8*)(ag + kk * 16);
#pragma unroll
          for (int kk = 0; kk < 8; ++kk) acc = __builtin_amdgcn_mfma_f32_32x32x16_bf16(af[kk], *(const bf16x8*)(bs + kk * 16), acc, 0, 0, 0);
#pragma unroll
          for (int r = 0; r < 16; ++r) Sc[(mi * 32 + (r & 3) + 8 * (r >> 2) + 4 * (lane >> 5)) * K_LDS + ni * 32 + (lane & 31)] = acc[r]; }
        __syncthreads();
        unsigned mk[16];
#pragma unroll
        for (int i = 0; i < 16; ++i) mk[i] = (fkey(Sc[row * K_LDS + sub * 16 + i]) & ~127u) | (unsigned)(127 - (sub * 16 + i));
        bitonic_desc<16>(mk);
        __syncthreads();
        unsigned* lst = (unsigned*)Sc + (row * 8 + sub) * 17;
#pragma unroll
        for (int i = 0; i < 16; ++i) lst[i] = mk[i];
        unsigned r0, r1;
        merge16(lst, 16, mk[0], sub, r0, r1);
        s12[(row * 2 + part) * 16 + sub] = r0; s12[(row * 2 + part) * 16 + 8 + sub] = r1;
        __syncthreads();
    }
    {
        const unsigned* k1 = s12 + row * 32; const unsigned* k2 = k1 + 16;
        unsigned ck[8];
#pragma unroll
        for (int m = 0; m < 8; ++m) {
            const int cc = sub + 8 * m; int ci = 0, off = 0;
#pragma unroll
            for (int i = 0; i < 15; ++i) { const bool ge = cc >= cand_off(i + 1); ci += ge ? 1 : 0; off += ge ? 16 / (i + 1) : 0; }
            const int cj = cc - off;
            ck[m] = 0u;
            if (cc < 50) ck[m] = (fkey(unkey((k1[ci] & ~127u) | 64u) + unkey((k2[cj] & ~127u) | 64u)) & ~63u) | (unsigned)(63 - cc);
        }
        bitonic_desc<8>(ck);
        unsigned* lst = cl + (row * 8 + sub) * 9;
#pragma unroll
        for (int m = 0; m < 8; ++m) lst[m] = ck[m];
        unsigned r0, r1;
        merge16(lst, 8, ck[0], sub, r0, r1);
        const float a = unkey((r0 & ~63u) | 32u), b = unkey((r1 & ~63u) | 32u);
        const unsigned kmax = max8_u32(r0 > r1 ? r0 : r1); const float vmax = unkey((kmax & ~63u) | 32u);
        const float ea = __expf(a - vmax), eb = __expf(b - vmax);
        const float inv = 1.f / sum8_f32(ea + eb);
        int eidx[2];
#pragma unroll
        for (int q = 0; q < 2; ++q) {
            const int cc = 63 - (int)((q ? r1 : r0) & 63u); int ci = 0, off = 0;
#pragma unroll
            for (int i = 0; i < 15; ++i) { const bool ge = cc >= cand_off(i + 1); ci += ge ? 1 : 0; off += ge ? 16 / (i + 1) : 0; }
            const int cj = cc - off;
            eidx[q] = (127 - (int)(k1[ci] & 127u)) * 128 + (127 - (int)(k2[cj] & 127u));
        }
        int* IDX = (int*)(p.ws + WS_IDX) + (size_t)(tok0 + row) * 128 + h * 16; float* GT = (float*)(p.ws + WS_GATE) + (size_t)(tok0 + row) * 128 + h * 16;
        IDX[sub] = eidx[0]; IDX[8 + sub] = eidx[1]; GT[sub] = ea * inv; GT[8 + sub] = eb * inv;
    }
    __syncthreads();
}
DEV void topk_phase(const Params& p, int layer, int ntok, unsigned char* smem) {
    const int G = gridDim.x, bid = blockIdx.x, h = bid & 7;
    const int nt = ntok / 64;
    if ((G & 7) == 0) {
        if ((bid >> 3) < nt) topk_load_keys(p, layer, h, smem);
        for (int tt = bid >> 3; tt < nt; tt += (G >> 3)) topk_item(p, h, tt * 64, smem);
    } else {
        for (int it = bid; it < nt * 8; it += G) { __syncthreads(); topk_load_keys(p, layer, it & 7, smem); topk_item(p, it & 7, (it >> 3) * 64, smem); }
    }
}

DEV float gelu_f(float x) { return 0.5f * x * (1.f + erff(x * 0.70710678118654752f)); }
typedef float f32x2 __attribute__((ext_vector_type(2)));
DEV void fp8x16_to_f32(const u32x4& r, float (&f)[16]) {
#pragma unroll
    for (int i = 0; i < 4; ++i) { const f32x2 lo = __builtin_amdgcn_cvt_pk_f32_fp8((int)r[i], false), hi = __builtin_amdgcn_cvt_pk_f32_fp8((int)r[i], true); f[4 * i] = lo[0]; f[4 * i + 1] = lo[1]; f[4 * i + 2] = hi[0]; f[4 * i + 3] = hi[1]; }
}
DEV void peer_item(const Params& p, int layer, int item) {
    const int tok = item * 8 + (tidx() >> 6), lane = tidx() & 63;
    const bf16_t* A = (const bf16_t*)(p.ws + WS_A) + (size_t)tok * 1024 + lane * 16;
    const unsigned char* U8 = p.ws + WS_T8 + (size_t)(layer * 2) * 16384 * 1024; const unsigned char* V8 = U8 + (size_t)16384 * 1024; const int voff = lane * 16;
    const float* SU = (const float*)(p.ws + WS_S8) + (size_t)(layer * 2) * 16384; const float* SV = SU + 16384;
    float x[16], y[16];
    { const u32x4 a0 = *(const u32x4*)A, a1 = *(const u32x4*)(A + 8);
#pragma unroll
      for (int i = 0; i < 4; ++i) { x[2 * i] = bflo(a0[i]); x[2 * i + 1] = bfhi(a0[i]); x[8 + 2 * i] = bflo(a1[i]); x[8 + 2 * i + 1] = bfhi(a1[i]); } }
#pragma unroll
    for (int i = 0; i < 16; ++i) y[i] = 0.f;
    const int* IDX = (const int*)(p.ws + WS_IDX) + (size_t)tok * 128; const float* GT = (const float*)(p.ws + WS_GATE) + (size_t)tok * 128;
    const int i_lo = IDX[lane], i_hi = IDX[64 + lane]; const float g_lo = GT[lane], g_hi = GT[64 + lane];
    const int jl = ((lane >> 5) & 1) * 4 + ((lane >> 4) & 1) * 2 + ((lane >> 3) & 1);
    u32x4 ur[8], vr[8];
#define PG_LOADU(g) do { const int src_ = (g) < 8 ? i_lo : i_hi; \
        _Pragma("unroll") for (int j = 0; j < 8; ++j) { const int e_ = __builtin_amdgcn_readlane(src_, (((g) & 7) << 3) + j); ur[j] = *(const u32x4*)(U8 + (size_t)e_ * 1024 + voff); } } while (0)
#define PG_LOADV(g) do { const int src_ = (g) < 8 ? i_lo : i_hi; \
        _Pragma("unroll") for (int j = 0; j < 8; ++j) { const int e_ = __builtin_amdgcn_readlane(src_, (((g) & 7) << 3) + j); vr[j] = *(const u32x4*)(V8 + (size_t)e_ * 1024 + voff); } } while (0)
    PG_LOADU(0); PG_LOADV(0);
    for (int g = 0; g < 16; ++g) {
        const int mk = ((g & 7) << 3) + jl; const int me = __shfl(g < 8 ? i_lo : i_hi, mk); const float mg = __shfl(g < 8 ? g_lo : g_hi, mk);
        const float su = SU[me], sv = SV[me];
        float d[8];
#pragma unroll
        for (int j = 0; j < 8; ++j) { float f[16]; fp8x16_to_f32(ur[j], f); float a = 0.f;
#pragma unroll
            for (int i = 0; i < 16; ++i) a = fmaf(f[i], x[i], a);
            d[j] = a; SCHED_FENCE(); }
        if (g + 1 < 16) PG_LOADU(g + 1);
        float r4[4], r2[2], r1;
        { const bool hi = (lane & 32) != 0;
#pragma unroll
          for (int j = 0; j < 4; ++j) { const float send = hi ? d[j] : d[4 + j], keep = hi ? d[4 + j] : d[j]; r4[j] = keep + __shfl_xor(send, 32); } }
        { const bool hi = (lane & 16) != 0;
#pragma unroll
          for (int j = 0; j < 2; ++j) { const float send = hi ? r4[j] : r4[2 + j], keep = hi ? r4[2 + j] : r4[j]; r2[j] = keep + __shfl_xor(send, 16); } }
        { const bool hi = (lane & 8) != 0; const float send = hi ? r2[0] : r2[1], keep = hi ? r2[1] : r2[0]; r1 = keep + __shfl_xor(send, 8); }
        r1 += __shfl_xor(r1, 4); r1 += __shfl_xor(r1, 2); r1 += __shfl_xor(r1, 1);
        const float act = gelu_f(r1 * su) * mg * sv;
#pragma unroll
        for (int j = 0; j < 8; ++j) {
            const float aj = __builtin_bit_cast(float, __builtin_amdgcn_readlane(__builtin_bit_cast(int, act), ((j >> 2) & 1) * 32 + ((j >> 1) & 1) * 16 + (j & 1) * 8));
            float f[16]; fp8x16_to_f32(vr[j], f);
#pragma unroll
            for (int i = 0; i < 16; ++i) y[i] = fmaf(aj, f[i], y[i]);
            SCHED_FENCE(); }
        if (g + 1 < 16) PG_LOADV(g + 1);
    }
#undef PG_LOADU
#undef PG_LOADV
    float* H = (float*)(p.ws + WS_H) + (size_t)tok * 1024 + lane * 16;
    const float* g2 = (const float*)(p.ws + WS_MOD) + ((size_t)layer * NR + mod_row(tok)) * 6144 + 5120 + lane * 16;
    float hv[16]; float ss = 0.f;
#pragma unroll
    for (int i = 0; i < 4; ++i) { const f32x4 hh = *(const f32x4*)(H + 4 * i), gg = *(const f32x4*)(g2 + 4 * i);
#pragma unroll
        for (int j = 0; j < 4; ++j) { const float v = hh[j] + gg[j] * y[4 * i + j]; hv[4 * i + j] = v; ss += v * v; } }
    ss = wave_sum(ss);
    const float rstd = rsqrtf(ss * (1.f / 1024.f) + 1e-6f);
    if (layer == 0) {
#pragma unroll
        for (int i = 0; i < 4; ++i) { f32x4 o; o[0] = hv[4 * i]; o[1] = hv[4 * i + 1]; o[2] = hv[4 * i + 2]; o[3] = hv[4 * i + 3]; *(f32x4*)(H + 4 * i) = o; }
        const float* g = p.in[I_N1G] + 1024 + lane * 16;
        const float* mod = (const float*)(p.ws + WS_MOD) + ((size_t)1 * NR + mod_row(tok)) * 6144 + lane * 16;
        bf16_t* Ao = (bf16_t*)(p.ws + WS_A) + (size_t)tok * 1024 + lane * 16;
        u32x4 o0, o1; float r[16];
#pragma unroll
        for (int i = 0; i < 16; ++i) r[i] = hv[i] * rstd * g[i] * (1.f + mod[1024 + i]) + mod[i];
#pragma unroll
        for (int i = 0; i < 4; ++i) { o0[i] = pk2(r[2 * i], r[2 * i + 1]); o1[i] = pk2(r[8 + 2 * i], r[8 + 2 * i + 1]); }
        *(u32x4*)Ao = o0; *(u32x4*)(Ao + 8) = o1;
    } else {
        const float* g = p.in[I_FG] + lane * 16; float* out = p.out + (size_t)tok * 1024 + lane * 16;
#pragma unroll
        for (int i = 0; i < 4; ++i) { f32x4 o; o[0] = hv[4 * i] * rstd * g[4 * i]; o[1] = hv[4 * i + 1] * rstd * g[4 * i + 1]; o[2] = hv[4 * i + 2] * rstd * g[4 * i + 2]; o[3] = hv[4 * i + 3] * rstd * g[4 * i + 3]; *(f32x4*)(out + 4 * i) = o; }
    }
}

constexpr int S3_LD = 136, S3_LDT = 24, S3_LDV = 72;
constexpr int S3_Q = 0, S3_K = S3_Q + 64 * S3_LD * 2, S3_KT = S3_K + 64 * S3_LD * 2, S3_D = S3_KT + 4 * 128 * S3_LDT * 2, S3_V = S3_D + 4 * 128 * 4, S3_ST = S3_V + 64 * S3_LDV * 2,
              S3_P = S3_ST + 2 * 64 * S3_LD * 2, S3_END = S3_P + 4 * 16 * S3_LDT * 2;
static_assert(S3_END <= SMEM_BYTES, "scan LDS");
DEV void scan_block(const Params& p, int bi, unsigned char* smem) {
    const int tid = tidx(), lane = tid & 63, w = tid >> 6, l15 = lane & 15, lg4 = lane >> 4, l31 = lane & 31, lh = lane >> 5;
    const int half = bi & 1, dir = (bi >> 1) & 1, h = (bi >> 2) & 7, b = bi >> 5;
    const bf16_t* P1 = (const bf16_t*)(p.ws + WS_P);
    const bf16_t* IT = (const bf16_t*)(p.ws + WS_M);
    bf16_t* Oo = (bf16_t*)(p.ws + WS_F + (dir ? F_OB : F_OF));
    bf16_t* Qs = (bf16_t*)(smem + S3_Q); bf16_t* Ks = (bf16_t*)(smem + S3_K); bf16_t* KT = (bf16_t*)(smem + S3_KT); float* Ds = (float*)(smem + S3_D);
    bf16_t* Vs = (bf16_t*)(smem + S3_V); bf16_t* ST = (bf16_t*)(smem + S3_ST); bf16_t* Ps = (bf16_t*)(smem + S3_P);
    const int NCH = (LC + L) / 64;
    const int kt = w >> 1, vt = w & 1;
    f32x16 S;
#pragma unroll
    for (int r = 0; r < 16; ++r) S[r] = 0.f;
    for (int i = tid; i < 64 * S3_LD / 2; i += NT) ((unsigned*)ST)[i] = 0u;
    const int pk = tid & 127, pblk = tid >> 7;
    unsigned short kr[16], qr[16]; u32x4 vr;
    const int kcol = 1024 * (1 + dir) + h * 128 + pk, qcol = h * 128 + pk;
#define S3_T0(c) ((c) * 64 < LC ? (dir ? LC - 64 - (c) * 64 : (c) * 64) : (dir ? L - 64 - ((c) * 64 - LC) : (c) * 64 - LC))
#define S3_LOAD(c) do { const bool lat_ = (c) * 64 >= LC; const int t0_ = S3_T0(c); const size_t tokb_ = lat_ ? (size_t)b * L + t0_ : (size_t)TL + (size_t)b * LC + t0_; \
        _Pragma("unroll") for (int i = 0; i < 16; ++i) { const bf16_t* row_ = P1 + (tokb_ + pblk * 16 + i) * 5120; kr[i] = row_[kcol]; qr[i] = lat_ ? row_[qcol] : (unsigned short)0; } \
        { const int v_ = tid >> 3, c8_ = tid & 7; const bf16_t* it_ = IT + (lat_ ? (size_t)0 : (size_t)NB * 1024 * L) + ((size_t)b * 1024 + h * 128 + half * 64 + v_) * (lat_ ? L : LC) + t0_ + c8_ * 8; vr = *(const u32x4*)it_; } } while (0)
    S3_LOAD(0);
    for (int c = 0; c < NCH; ++c) {
        const bool lat = c * 64 >= LC; const int t0 = S3_T0(c); const size_t tokb = lat ? (size_t)b * L + t0 : (size_t)TL + (size_t)b * LC + t0;
        __syncthreads();
        {
            float bsum = 0.f; unsigned short kt16[16];
#pragma unroll
            for (int rr = 0; rr < 16; ++rr) {
                const int tl = dir ? 15 - rr : rr;
                const float kv = bf2f(dir ? kr[15 - rr] : kr[rr]), qv = bf2f(dir ? qr[15 - rr] : qr[rr]);
                bsum += __logf(1.f - kv);
                const float eb = __expf(bsum), ieb = __expf(fminf(-bsum, 80.f));
                const unsigned short qt = (unsigned short)f2bf(qv * eb), ktv = (unsigned short)f2bf(kv * ieb);
                Qs[(pblk * 16 + tl) * S3_LD + pk] = qt; Ks[(pblk * 16 + tl) * S3_LD + pk] = ktv;
                if (dir) kt16[15 - rr] = ktv; else kt16[rr] = ktv;
            }
            u32x4 o0, o1;
#pragma unroll
            for (int i = 0; i < 4; ++i) { o0[i] = (unsigned)kt16[2 * i] | ((unsigned)kt16[2 * i + 1] << 16); o1[i] = (unsigned)kt16[8 + 2 * i] | ((unsigned)kt16[8 + 2 * i + 1] << 16); }
            *(u32x4*)(KT + (pblk * 128 + pk) * S3_LDT) = o0; *(u32x4*)(KT + (pblk * 128 + pk) * S3_LDT + 8) = o1;
            Ds[pblk * 128 + pk] = __expf(bsum);
            { const int v_ = tid >> 3, c8_ = tid & 7; *(u32x4*)(Vs + v_ * S3_LDV + c8_ * 8) = vr; }
        }
        if (c + 1 < NCH) S3_LOAD(c + 1);
        __syncthreads();
        if (lat && w < 4) {
            f32x4 pt = (f32x4){0.f, 0.f, 0.f, 0.f};
#pragma unroll
            for (int kk = 0; kk < 4; ++kk)
                pt = __builtin_amdgcn_mfma_f32_16x16x32_bf16(*(const bf16x8*)(Ks + (w * 16 + l15) * S3_LD + kk * 32 + 8 * lg4), *(const bf16x8*)(Qs + (w * 16 + l15) * S3_LD + kk * 32 + 8 * lg4), pt, 0, 0, 0);
            float pm[4];
#pragma unroll
            for (int r = 0; r < 4; ++r) { const int sl = 4 * lg4 + r; const bool keep = dir ? (sl >= l15) : (sl <= l15); pm[r] = keep ? pt[r] : 0.f; }
            u32x2 o; o[0] = pk2(pm[0], pm[1]); o[1] = pk2(pm[2], pm[3]);
            *(u32x2*)(Ps + (w * 16 + l15) * S3_LDT + 4 * lg4) = o;
        }
        __syncthreads();
        for (int ib = 0; ib < 4; ++ib) {
            const int blk = dir ? 3 - ib : ib;
            const int cur = (c * 4 + ib) & 1;
            { const bf16x8 a = *(const bf16x8*)(KT + (blk * 128 + 32 * kt + l31) * S3_LDT + 8 * lh);
              const bf16x8 bb = *(const bf16x8*)(Vs + (32 * vt + l31) * S3_LDV + blk * 16 + 8 * lh);
              S = __builtin_amdgcn_mfma_f32_32x32x16_bf16(a, bb, S, 0, 0, 0);
#pragma unroll
              for (int g = 0; g < 4; ++g) { const f32x4 dv = *(const f32x4*)(Ds + blk * 128 + 32 * kt + 8 * g + 4 * lh);
                  S[4 * g] *= dv[0]; S[4 * g + 1] *= dv[1]; S[4 * g + 2] *= dv[2]; S[4 * g + 3] *= dv[3];
                  u32x2 o; o[0] = pk2(S[4 * g], S[4 * g + 1]); o[1] = pk2(S[4 * g + 2], S[4 * g + 3]);
                  *(u32x2*)(ST + ((cur ^ 1) * 64 + 32 * vt + l31) * S3_LD + 32 * kt + 8 * g + 4 * lh) = o; } }
            if (lat && w < 4) {
                f32x4 o = (f32x4){0.f, 0.f, 0.f, 0.f};
#pragma unroll
                for (int kk = 0; kk < 4; ++kk)
                    o = __builtin_amdgcn_mfma_f32_16x16x32_bf16(*(const bf16x8*)(ST + (cur * 64 + 16 * w + l15) * S3_LD + kk * 32 + 8 * lg4), *(const bf16x8*)(Qs + (blk * 16 + l15) * S3_LD + kk * 32 + 8 * lg4), o, 0, 0, 0);
                bf16x8 va = (bf16x8){0, 0, 0, 0, 0, 0, 0, 0}, pb = va;
                if (lg4 < 2) { va = *(const bf16x8*)(Vs + (16 * w + l15) * S3_LDV + blk * 16 + 8 * lg4); pb = *(const bf16x8*)(Ps + (blk * 16 + l15) * S3_LDT + 8 * lg4); }
                o = __builtin_amdgcn_mfma_f32_16x16x32_bf16(va, pb, o, 0, 0, 0);
                u32x2 ou; ou[0] = pk2(o[0], o[1]); ou[1] = pk2(o[2], o[3]);
                *(u32x2*)(Oo + (tokb + blk * 16 + l15) * 1024 + h * 128 + half * 64 + 16 * w + 4 * lg4) = ou;
            }
            __syncthreads();
        }
    }
    __syncthreads();
#undef S3_T0
#undef S3_LOAD
}
DEV void readout_item(const Params& p, int item) {
    const int tok = item * 8 + (tidx() >> 6), lane = tidx() & 63;
    const bf16_t* of = (const bf16_t*)(p.ws + WS_F + F_OF) + (size_t)tok * 1024 + lane * 16; const bf16_t* ob = (const bf16_t*)(p.ws + WS_F + F_OB) + (size_t)tok * 1024 + lane * 16;
    const bf16_t* gp = (const bf16_t*)(p.ws + WS_P) + (size_t)tok * 5120 + 4096 + lane * 16;
    const float* on = p.in[I_HGON] + (lane & 7) * 16;
    float o[16], gg[16]; float ss = 0.f;
    { const u32x4 a0 = *(const u32x4*)of, a1 = *(const u32x4*)(of + 8), b0 = *(const u32x4*)ob, b1 = *(const u32x4*)(ob + 8), g0 = *(const u32x4*)gp, g1 = *(const u32x4*)(gp + 8);
#pragma unroll
      for (int i = 0; i < 4; ++i) { o[2 * i] = bflo(a0[i]) + bflo(b0[i]); o[2 * i + 1] = bfhi(a0[i]) + bfhi(b0[i]); o[8 + 2 * i] = bflo(a1[i]) + bflo(b1[i]); o[8 + 2 * i + 1] = bfhi(a1[i]) + bfhi(b1[i]);
          gg[2 * i] = bflo(g0[i]); gg[2 * i + 1] = bfhi(g0[i]); gg[8 + 2 * i] = bflo(g1[i]); gg[8 + 2 * i + 1] = bfhi(g1[i]); } }
#pragma unroll
    for (int i = 0; i < 16; ++i) ss += o[i] * o[i];
    ss += __shfl_xor(ss, 1); ss += __shfl_xor(ss, 2); ss += __shfl_xor(ss, 4);
    const float rstd = rsqrtf(ss * (1.f / 128.f) + 1e-6f);
    bf16_t* M = (bf16_t*)(p.ws + WS_M) + (size_t)tok * 1024 + lane * 16;
    u32x4 o0, o1; float r[16];
#pragma unroll
    for (int i = 0; i < 16; ++i) r[i] = o[i] * rstd * on[i] * gg[i];
#pragma unroll
    for (int i = 0; i < 4; ++i) { o0[i] = pk2(r[2 * i], r[2 * i + 1]); o1[i] = pk2(r[8 + 2 * i], r[8 + 2 * i + 1]); }
    *(u32x4*)M = o0; *(u32x4*)(M + 8) = o1;
}

#ifndef HOST_EMU
#define XB_TMO      128
#define XB_XCNT(j)  (256  + 64 * (j))
#define XB_XSUB(j)  (1280 + 64 * (j))
#define XB_XGEN(j)  (2304 + 64 * (j))
#define XB_TOP      3328
#define XB_TOPGEN   3392
#define XCD_BAR_WORDS 3456
#define XB_SPIN_CAP (1u << 18)
#define LAS __attribute__((address_space(3)))

__device__ __forceinline__ unsigned xb_ld(unsigned* p)              { return __hip_atomic_load(p, __ATOMIC_RELAXED, __HIP_MEMORY_SCOPE_AGENT); }
__device__ __forceinline__ unsigned xb_add(unsigned* p, unsigned v) { return __hip_atomic_fetch_add(p, v, __ATOMIC_RELAXED, __HIP_MEMORY_SCOPE_AGENT); }
__device__ __forceinline__ unsigned xb_xcc_id() { return (unsigned)__builtin_amdgcn_s_getreg((3 << 11) | 20) & 0xFu; }
#define XB_SPIN(cond, bar) do { unsigned _sp = 0; while (cond) { __builtin_amdgcn_s_sleep(1); \
    if ((++_sp & 255u) == 0u) { if (xb_ld(&(bar)[XB_TMO])) break; if (_sp > XB_SPIN_CAP) { atomicAdd(&(bar)[XB_TMO], 1u); break; } } } } while (0)

struct XcdBarrier {
    unsigned* bar; unsigned x;
    volatile LAS unsigned* st;
};

__device__ __forceinline__ XcdBarrier xcd_barrier_post(unsigned* bar, volatile LAS unsigned* st) {
    XcdBarrier b; b.bar = bar; b.x = xb_xcc_id(); b.st = st;
    if (threadIdx.x == 0) (void)xb_add(&bar[XB_XCNT(b.x)], 1u);
    return b;
}
__device__ __forceinline__ void xcd_barrier_complete(unsigned* bar, unsigned x, unsigned& nloc, unsigned& nx) {
    const unsigned G = gridDim.x * gridDim.y * gridDim.z;
    unsigned sum, cnt, mine, sp = 0u;
    for (;;) {
        sum = 0u; cnt = 0u; mine = 0u;
#pragma unroll
        for (unsigned j = 0; j < 16; ++j) { const unsigned c = xb_ld(&bar[XB_XCNT(j)]); sum += c; cnt += (c > 0u) ? 1u : 0u; mine = (j == x) ? c : mine; }
        if (sum == G) break;
        __builtin_amdgcn_s_sleep(1);
        if ((++sp & 255u) == 0u) { if (xb_ld(&bar[XB_TMO])) break; if (sp > XB_SPIN_CAP) { atomicAdd(&bar[XB_TMO], 1u); break; } }
    }
    nloc = mine > 0u ? mine : 1u; nx = cnt > 0u ? cnt : 1u;
}

__device__ __forceinline__ void xcd_barrier(const XcdBarrier& b) {
    asm volatile("s_waitcnt vmcnt(0)" ::: "memory");
    __syncthreads();
    if (threadIdx.x == 0) {
        unsigned* bar = b.bar;
        __builtin_amdgcn_s_waitcnt(0);
        unsigned nloc = b.st[0], nx = b.st[1];
        if (nloc == 0u) { xcd_barrier_complete(bar, b.x, nloc, nx); b.st[0] = nloc; b.st[1] = nx; }
        const unsigned old = xb_add(&bar[XB_XSUB(b.x)], 1u);
        const unsigned gen = old / nloc;
        if (old + 1u == (gen + 1u) * nloc) {
            __builtin_amdgcn_fence(__ATOMIC_RELEASE, "agent");
            asm volatile("s_waitcnt vmcnt(0)" ::: "memory");
            const unsigned og = xb_add(&bar[XB_TOP], 1u);
            const unsigned tg = og / nx;
            if (og + 1u == (tg + 1u) * nx) xb_add(&bar[XB_TOPGEN], 1u);
            else XB_SPIN(xb_ld(&bar[XB_TOPGEN]) == tg, bar);
            __builtin_amdgcn_fence(__ATOMIC_ACQUIRE, "agent");
            xb_add(&bar[XB_XGEN(b.x)], 1u);
            asm volatile("s_waitcnt vmcnt(0)" ::: "memory");
        } else {
            XB_SPIN(xb_ld(&bar[XB_XGEN(b.x)]) == gen, bar);
            __builtin_amdgcn_fence(__ATOMIC_ACQUIRE, "agent");
            asm volatile("s_waitcnt vmcnt(0)" ::: "memory");
        }
    }
    __syncthreads();
}

#endif
#ifdef NOINLINE_PHASES
#define NOINL __device__ __attribute__((noinline))
#else
#define NOINL __device__ __forceinline__
#endif
__shared__ __attribute__((aligned(16))) unsigned char g_smem[SMEM_BYTES + 16];
#define PH_COMMON const int G = gridDim.x, bid = blockIdx.x; unsigned char* smem = g_smem; (void)smem; (void)G; (void)bid; \
    const bf16_t* A = (const bf16_t*)(p.ws + WS_A); const bf16_t* Mx = (const bf16_t*)(p.ws + WS_M); const bf16_t* W = (const bf16_t*)(p.ws + WS_W); (void)A; (void)Mx; (void)W;
NOINL void ph0(const Params& p) { PH_COMMON phase0(p, smem); }
NOINL void ph1(const Params& p) { PH_COMMON phase1(p, smem); }
NOINL void ph2(const Params& p) { PH_COMMON EpiL0In e{p.ws}; for (int t = bid; t < (T / 256) * 18; t += G) gemm_tile(A, W + W_IN0 / 2, (t / 18) * 256, (t % 18) * 128, smem, e); }
NOINL void ph3(const Params& p) { PH_COMMON phase3(p, smem); }
NOINL void ph4(const Params& p) { PH_COMMON EpiRes e{&p, 1, 0, 2048}; for (int t = bid; t < (T / 256) * 8; t += G) gemm_tile(Mx, W + W_OUT0 / 2, (t / 8) * 256, (t % 8) * 128, smem, e); }
NOINL void ph5(const Params& p) { PH_COMMON for (int it = bid; it < T / 8; it += G) norm_rows_item(p, it, 0, p.in[I_N2G], 0, 3072); }
NOINL void ph6(const Params& p) { PH_COMMON EpiBf16 e{(bf16_t*)(p.ws + WS_P), 2048}; for (int t = bid; t < (T / 256) * 16; t += G) gemm_tile(A, W + W_Q0 / 2, (t / 16) * 256, (t % 16) * 128, smem, e); }
NOINL void ph7(const Params& p) { PH_COMMON topk_phase(p, 0, T, smem); }
NOINL void ph8(const Params& p) { PH_COMMON for (int it = bid; it < T / 8; it += G) peer_item(p, 0, it); }
NOINL void ph9(const Params& p) { PH_COMMON EpiHg e{p.ws, p.in[I_HGLB]};
    for (int t = bid; t < (T / 256) * 40; t += G) { const int mt = t / 40, nt = t % 40; if (mt >= TL / 256 && (nt < 8 || nt >= 32)) continue; gemm_tile(A, W + W_IN1 / 2, mt * 256, nt * 128, smem, e); } }
NOINL void ph10(const Params& p) { PH_COMMON for (int bi = bid; bi < NB * 32; bi += G) scan_block(p, bi, smem); }
NOINL void ph11(const Params& p) { PH_COMMON for (int it = bid; it < TL / 8; it += G) readout_item(p, it); }
NOINL void ph12(const Params& p) { PH_COMMON EpiRes e{&p, 0, 1, 2048}; for (int t = bid; t < (TL / 256) * 8; t += G) gemm_tile(Mx, W + W_OUT1 / 2, (t / 8) * 256, (t % 8) * 128, smem, e); }
NOINL void ph13(const Params& p) { PH_COMMON for (int it = bid; it < TL / 8; it += G) norm_rows_item(p, it, 0, p.in[I_N2G] + 1024, 1, 3072); }
NOINL void ph14(const Params& p) { PH_COMMON EpiBf16 e{(bf16_t*)(p.ws + WS_P), 2048}; for (int t = bid; t < (TL / 256) * 16; t += G) gemm_tile(A, W + W_Q1 / 2, (t / 16) * 256, (t % 16) * 128, smem, e); }
NOINL void ph15(const Params& p) { PH_COMMON topk_phase(p, 1, TL, smem); }
NOINL void ph16(const Params& p) { PH_COMMON for (int it = bid; it < TL / 8; it += G) peer_item(p, 1, it); }

constexpr int NPHASE = 17;
__global__ void __launch_bounds__(NT, 2) mega(Params p_in) {
    const int ph_lo = p_in.ph_lo, ph_hi = p_in.ph_hi;
#ifndef HOST_EMU
#define GBAR_MAKE() XcdBarrier gbar; gbar.bar = (unsigned*)(p_in.ws + WS_CTRL); gbar.x = xb_xcc_id(); gbar.st = (volatile LAS unsigned*)(LAS unsigned char*)(g_smem + SMEM_BYTES);
    if (ph_hi - ph_lo > 1) {
        volatile LAS unsigned* st = (volatile LAS unsigned*)(LAS unsigned char*)(g_smem + SMEM_BYTES);
        if (threadIdx.x == 0) { st[0] = 0u; st[1] = 0u; }
        __syncthreads();
        (void)xcd_barrier_post((unsigned*)(p_in.ws + WS_CTRL), st);
    }
#endif
    for (int ph = ph_lo; ph < ph_hi; ++ph) {
        if (ph > ph_lo) {
#ifndef HOST_EMU
            { GBAR_MAKE(); xcd_barrier(gbar); }
#endif
        }
#ifndef HOST_EMU
        unsigned long long kp = (unsigned long long)__builtin_amdgcn_kernarg_segment_ptr();
        asm volatile("" : "+s"(kp) :: "memory");
        const Params& p = *(const Params*)(const __attribute__((address_space(4))) Params*)kp;
#else
        const Params& p = p_in;
#endif
#ifdef REPEAT_MASK
        for (int rep_ = ((REPEAT_MASK >> ph) & 1); rep_ >= 0; --rep_) { if (rep_ == 0 && ((REPEAT_MASK >> ph) & 1)) { GBAR_MAKE(); xcd_barrier(gbar); }
#else
        {
#endif
#ifdef ONLY_PHASE
        if (ph != ONLY_PHASE) continue;
        switch (ONLY_PHASE) {
#else
        switch (ph) {
#endif
        case 0: ph0(p); break; case 1: ph1(p); break; case 2: ph2(p); break; case 3: ph3(p); break; case 4: ph4(p); break; case 5: ph5(p); break;
        case 6: ph6(p); break; case 7: ph7(p); break; case 8: ph8(p); break; case 9: ph9(p); break; case 10: ph10(p); break; case 11: ph11(p); break;
        case 12: ph12(p); break; case 13: ph13(p); break; case 14: ph14(p); break; case 15: ph15(p); break; case 16: ph16(p); break;
        default: break;
        }
        }
    }
}

#ifndef HOST_EMU
extern "C" void kernel_launch(void* const* d_in, const int* in_sizes, int n_in, void* d_out, int out_size, void* d_ws, size_t ws_size, hipStream_t stream) {
    if (n_in != 29 || ws_size < WS_END || out_size != TL * 1024) { fprintf(stderr, "kernel_launch: unexpected sizes (n_in %d, ws %zu need %zu, out %d)\n", n_in, ws_size, (size_t)WS_END, out_size); return; }
    static int grid = 0;
    if (!grid) { int dev = 0, cus = 0; hipGetDevice(&dev); hipDeviceGetAttribute(&cus, hipDeviceAttributeMultiprocessorCount, dev); grid = cus > 0 ? cus : 256; }
    hipMemsetAsync((unsigned char*)d_ws + WS_CTRL, 0, CTRL_BYTES, stream);
    Params p{};
    for (int i = 0; i < 29; ++i) p.in[i] = (const float*)d_in[i];
    p.out = (float*)d_out; p.ws = (unsigned char*)d_ws;
#ifdef MULTI_LAUNCH
    for (int ph = 0; ph < NPHASE; ++ph) { p.ph_lo = ph; p.ph_hi = ph + 1; hipLaunchKernelGGL(mega, dim3(grid), dim3(NT), 0, stream, p); }
#else
    p.ph_lo = 0; p.ph_hi = NPHASE;
    hipLaunchKernelGGL(mega, dim3(grid), dim3(NT), 0, stream, p);
#endif
}
#endif
```

```cpp
#ifndef HOST_EMU
#include <hip/hip_runtime.h>
#include <cstdio>
#endif

#ifndef CFG_B
#define CFG_B 8
#define CFG_L 2048
#define CFG_LC 256
#endif
#define DEV __device__ __forceinline__
#ifndef HOST_EMU
#define SCHED_FENCE() __builtin_amdgcn_sched_barrier(0)
#endif
#ifdef HOST_EMU
#define SCHED_FENCE() do {} while (0)
#define __expf expf
#define __logf logf
#define __sinf sinf
#define __cosf cosf
#endif

typedef unsigned short bf16_t;
typedef short bf16x8 __attribute__((ext_vector_type(8)));
typedef float f32x16 __attribute__((ext_vector_type(16)));
typedef float f32x4 __attribute__((ext_vector_type(4)));
typedef unsigned u32x4 __attribute__((ext_vector_type(4)));
typedef unsigned u32x2 __attribute__((ext_vector_type(2)));
struct cf2 { float x, y; };

constexpr int NB = CFG_B, L = CFG_L, LC = CFG_LC, D = 1024;
constexpr int TL = NB * L, TC = NB * LC, T = TL + TC;
constexpr int NT = 512;
constexpr int NR = NB + 1;
constexpr int log4ceil(int n) { int s = 0, v = 1; while (v < n) { v *= 4; ++s; } return s; }
constexpr int FS_LAT = log4ceil(2 * L - 1), FS_CTX = log4ceil(2 * LC - 1);
constexpr int NF_LAT = 1 << (2 * FS_LAT), NF_CTX = 1 << (2 * FS_CTX);
static_assert(T % 256 == 0 && TL % 256 == 0 && L % 128 == 0 && LC % 128 == 0 && NB % 2 == 0, "shape");

constexpr size_t al256(size_t x) { return (x + 255) & ~(size_t)255; }
constexpr size_t WS_CTRL = 0, CTRL_BYTES = 65536;
constexpr size_t CTRL_HYNORM = 4096;
constexpr size_t WS_MOD = WS_CTRL + CTRL_BYTES;
constexpr size_t WS_H = al256(WS_MOD + (size_t)2 * NR * 6144 * 4);
constexpr size_t WS_A = al256(WS_H + (size_t)T * 1024 * 4);
constexpr size_t WS_P = al256(WS_A + (size_t)T * 1024 * 2);
constexpr size_t P_BYTES = (size_t)T * 5120 * 2;
constexpr size_t P_HYT_LAT = 0;
constexpr size_t P_HYT_CTX = P_HYT_LAT + (size_t)NB * 1536 * L * 2;
constexpr size_t P_Q0 = P_HYT_CTX + (size_t)NB * 1536 * LC * 2;
constexpr size_t P_K0 = P_Q0 + (size_t)T * 512 * 2;
constexpr size_t P_VT_LAT = P_K0 + (size_t)T * 128 * 2;
constexpr size_t P_VT_CTX = P_VT_LAT + (size_t)NB * 128 * L * 2;
static_assert(P_VT_CTX + (size_t)NB * 128 * LC * 2 <= P_BYTES, "P region");
constexpr size_t P1_KQT_LAT = 0;
constexpr size_t P1_KQT_CTX = P1_KQT_LAT + (size_t)NB * 3072 * L * 2;
constexpr size_t P1_G = P1_KQT_CTX + (size_t)NB * 3072 * LC * 2;
static_assert(P1_G + (size_t)TL * 1024 * 2 <= P_BYTES, "P region (layer 1)");
constexpr size_t WS_M = al256(WS_P + P_BYTES);
constexpr size_t WS_IDX = al256(WS_M + (size_t)T * 1024 * 2);
constexpr size_t WS_GATE = al256(WS_IDX + (size_t)T * 128 * 4);
constexpr size_t WS_T8 = al256(WS_GATE + (size_t)T * 128 * 4);
constexpr size_t WS_S8 = WS_T8 + (size_t)4 * 16384 * 1024;
constexpr size_t WS_W = al256(WS_S8 + (size_t)4 * 16384 * 4);
constexpr size_t W_IN0 = 0, W_OUT0 = W_IN0 + (size_t)2304 * 1024 * 2, W_IN1 = W_OUT0 + (size_t)1024 * 1024 * 2,
                 W_OUT1 = W_IN1 + (size_t)5120 * 1024 * 2, W_Q0 = W_OUT1 + (size_t)1024 * 1024 * 2, W_Q1 = W_Q0 + (size_t)2048 * 1024 * 2,
                 W_KEYS = W_Q1 + (size_t)2048 * 1024 * 2, W_BYTES = W_KEYS + (size_t)2 * 8 * 2 * 128 * 128 * 2;
constexpr size_t WS_F = al256(WS_W + W_BYTES);
constexpr size_t F_HRAW_LAT = 0;
constexpr size_t F_HRAW_CTX = F_HRAW_LAT + (size_t)2048 * L * 4;
constexpr size_t F_HF_LAT = F_HRAW_CTX + (size_t)2048 * LC * 4;
constexpr size_t F_HF_CTX = F_HF_LAT + (size_t)1024 * NF_LAT * 8;
constexpr size_t F_HYP_LAT = F_HF_CTX + (size_t)1024 * NF_CTX * 8;
constexpr size_t F_HYP_CTX = F_HYP_LAT + (size_t)(L / 64) * 2048 * 4;
constexpr size_t F_END = F_HYP_CTX + (size_t)(LC / 64) * 2048 * 4;
constexpr size_t F_OF = 0, F_OB = (size_t)TL * 1024 * 2;
constexpr size_t F_BYTES = F_END > 2 * F_OB ? F_END : 2 * F_OB;
constexpr size_t WS_END = al256(WS_F + F_BYTES);

struct Params { const float* in[29]; float* out; unsigned char* ws; int ph_lo, ph_hi; };
enum { I_X = 0, I_C, I_CTX, I_CCTX, I_ADAW, I_ADAB, I_N1G, I_N2G, I_FG, I_ABWIN, I_ABWOUT, I_HYCW, I_HYCB, I_HYW1, I_HYB1, I_HYW2, I_HYB2, I_HYW3,
       I_HYFREQ, I_HYSKIP, I_SINK, I_HGWIN, I_HGWOUT, I_HGLB, I_HGON, I_PWQ, I_PKEYS, I_PU, I_PV };

constexpr int SMEM_BYTES = 147456;

#ifndef HOST_EMU
DEV int tidx() { int t = threadIdx.x; asm volatile("" : "+v"(t)); return t; }
#else
DEV int tidx() { return (int)threadIdx.x; }
#endif
#ifndef HOST_EMU
DEV void lds_barrier() { asm volatile("s_waitcnt lgkmcnt(0)" ::: "memory"); __builtin_amdgcn_s_barrier(); asm volatile("" ::: "memory"); }
#else
DEV void lds_barrier() { __syncthreads(); }
#endif
#ifndef HOST_EMU
typedef __bf16 bf16n2 __attribute__((ext_vector_type(2)));
DEV unsigned pk2(float lo, float hi) { bf16n2 v; v[0] = (__bf16)lo; v[1] = (__bf16)hi; return __builtin_bit_cast(unsigned, v); }
DEV unsigned f2bf(float f) { return (unsigned)__builtin_bit_cast(unsigned short, (__bf16)f); }
#else
DEV unsigned f2bf(float f) { unsigned u = __builtin_bit_cast(unsigned, f); return (u + 0x7fffu + ((u >> 16) & 1u)) >> 16; }
DEV unsigned pk2(float lo, float hi) { return f2bf(lo) | (f2bf(hi) << 16); }
#endif
DEV float bf2f(unsigned h) { return __builtin_bit_cast(float, (h & 0xffffu) << 16); }
DEV float bflo(unsigned u) { return __builtin_bit_cast(float, u << 16); }
DEV float bfhi(unsigned u) { return __builtin_bit_cast(float, u & 0xffff0000u); }
DEV float silu_f(float x) { return x / (1.f + __expf(-x)); }
DEV float sigmoid_f(float x) { return 1.f / (1.f + __expf(-x)); }
DEV float wave_sum(float v) {
#pragma unroll
    for (int m = 32; m >= 1; m >>= 1) v += __shfl_xor(v, m);
    return v;
}
DEV int mod_row(int tok) { return tok < TL ? tok / L : NB; }

DEV void p0_mod(const Params& p, int item, unsigned char* smem) {
    const int l = item / 96, col0 = (item % 96) * 64, tid = tidx();
    float* sc = (float*)smem;
    float* red = sc + NR * 1024;
    for (int i = tid; i < NR * 1024; i += NT) { const int r = i >> 10, k = i & 1023; const float c = r < NB ? p.in[I_C][r * 1024 + k] : p.in[I_CCTX][k]; sc[i] = c / (1.f + expf(-c)); }
    __syncthreads();
    const int kq = tid >> 6, col = tid & 63;
    float acc[NR];
#pragma unroll
    for (int r = 0; r < NR; ++r) acc[r] = 0.f;
    const float* w = p.in[I_ADAW] + (size_t)l * 1024 * 6144 + col0 + col;
#pragma unroll 4
    for (int k = kq * 128; k < kq * 128 + 128; ++k) {
        const float wv = w[(size_t)k * 6144];
#pragma unroll
        for (int r = 0; r < NR; ++r) acc[r] += sc[r * 1024 + k] * wv;
    }
#pragma unroll
    for (int r = 0; r < NR; ++r) red[(kq * NR + r) * 64 + col] = acc[r];
    __syncthreads();
    float* mod = (float*)(p.ws + WS_MOD);
    for (int i = tid; i < NR * 64; i += NT) {
        const int r = i >> 6, c = i & 63; float s = 0.f;
        for (int q = 0; q < 8; ++q) s += red[(q * NR + r) * 64 + c];
        mod[((size_t)l * NR + r) * 6144 + col0 + c] = s + p.in[I_ADAB][l * 6144 + col0 + c];
    }
    __syncthreads();
}
DEV void p0_transpose(const float* W, bf16_t* Wt, int N, int tile, unsigned char* smem) {
    float* ts = (float*)smem;
    const int ntn = N / 64, kt = tile / ntn, nt = tile % ntn, k0 = kt * 64, n0 = nt * 64, tid = tidx();
    float rv[8];
#pragma unroll
    for (int m = 0; m < 8; ++m) { const int i = tid + NT * m, kk = i >> 6, nn = i & 63; rv[m] = W[(size_t)(k0 + kk) * N + n0 + nn]; }
#pragma unroll
    for (int m = 0; m < 8; ++m) { const int i = tid + NT * m, kk = i >> 6, nn = i & 63; ts[kk * 65 + nn] = rv[m]; }
    __syncthreads();
#pragma unroll
    for (int m = 0; m < 8; ++m) { const int i = tid + NT * m, nn = i >> 6, kk = i & 63; Wt[(size_t)(n0 + nn) * 1024 + k0 + kk] = (bf16_t)f2bf(ts[kk * 65 + nn]); }
    __syncthreads();
}
DEV void p0_convert(const float* src, bf16_t* dst, int item) {
    const int tid = tidx();
#pragma unroll
    for (int i = 0; i < 8; ++i) {
        const size_t e = (size_t)item * 16384 + (size_t)(i * NT + tid) * 4;
        const f32x4 v = *(const f32x4*)(src + e);
        u32x2 o; o[0] = pk2(v[0], v[1]); o[1] = pk2(v[2], v[3]);
        *(u32x2*)(dst + e) = o;
    }
}
DEV void p0_table8(const Params& p, int tab, int item) {
    const int row0 = item * 32 + (tidx() >> 6), lane = tidx() & 63;
    const float* src = (tab & 1 ? p.in[I_PV] : p.in[I_PU]) + ((size_t)(tab >> 1) * 16384 + row0) * 1024 + lane * 16;
    f32x4 v[4][4];
#pragma unroll
    for (int r = 0; r < 4; ++r)
#pragma unroll
        for (int i = 0; i < 4; ++i) v[r][i] = *(const f32x4*)(src + (size_t)r * 8 * 1024 + 4 * i);
#pragma unroll
    for (int r = 0; r < 4; ++r) {
        float mx = 0.f;
#pragma unroll
        for (int i = 0; i < 4; ++i) mx = fmaxf(mx, fmaxf(fmaxf(fabsf(v[r][i][0]), fabsf(v[r][i][1])), fmaxf(fabsf(v[r][i][2]), fabsf(v[r][i][3]))));
#pragma unroll
        for (int m = 32; m >= 1; m >>= 1) mx = fmaxf(mx, __shfl_xor(mx, m));
        const float sc = mx > 0.f ? 240.f / mx : 1.f;
        u32x4 o;
#pragma unroll
        for (int i = 0; i < 4; ++i) { int w = __builtin_amdgcn_cvt_pk_fp8_f32(v[r][i][0] * sc, v[r][i][1] * sc, 0, false); w = __builtin_amdgcn_cvt_pk_fp8_f32(v[r][i][2] * sc, v[r][i][3] * sc, w, true); o[i] = (unsigned)w; }
        const int row = row0 + r * 8;
        *(u32x4*)(p.ws + WS_T8 + ((size_t)tab * 16384 + row) * 1024 + lane * 16) = o;
        if (lane == 0) ((float*)(p.ws + WS_S8))[tab * 16384 + row] = mx > 0.f ? mx * (1.f / 240.f) : 1.f;
    }
}
DEV void p0_filter(const Params& p, int set, int chunk, unsigned char* smem) {
    const int Ls = set ? LC : L, l0 = chunk * 64, tid = tidx();
    float* z = (float*)smem;
    float* hd1 = z + 64 * 34;
    float* hd2 = hd1 + 64 * 65;
    const float* w1 = p.in[I_HYW1]; const float* b1 = p.in[I_HYB1]; const float* w2 = p.in[I_HYW2]; const float* b2 = p.in[I_HYB2];
    const float* w3 = p.in[I_HYW3]; const float* fq = p.in[I_HYFREQ];
    for (int i = tid; i < 64 * 33; i += NT) {
        const int pp = i / 33, f = i % 33, l = l0 + pp; float val;
        if (f == 0) val = (float)l / (float)(Ls - 1);
        else { const int jb = (f - 1) & 15; const float fj = 1e-4f + (float)jb * ((15.f - 1e-4f) / 15.f); const float a = fj * (6.283185307179586f * (float)l / (float)Ls); val = f <= 16 ? __cosf(a) : -__sinf(a); }
        z[pp * 34 + f] = val;
    }
    __syncthreads();
    {
        const int j = tid & 63, p0 = tid >> 6;
        float wc[64], acc[8];
#pragma unroll
        for (int f = 0; f < 33; ++f) wc[f] = w1[f * 64 + j];
#pragma unroll
        for (int m = 0; m < 8; ++m) { float sacc = b1[j];
#pragma unroll
            for (int f = 0; f < 33; ++f) sacc = fmaf(z[(p0 + 8 * m) * 34 + f], wc[f], sacc);
            acc[m] = sacc; }
#pragma unroll
        for (int m = 0; m < 8; ++m) hd1[(p0 + 8 * m) * 65 + j] = __sinf(fq[j] * acc[m]);
        __syncthreads();
#pragma unroll
        for (int f = 0; f < 64; ++f) wc[f] = w2[f * 64 + j];
#pragma unroll
        for (int m = 0; m < 8; ++m) { float sacc = b2[j];
#pragma unroll
            for (int f = 0; f < 64; ++f) sacc = fmaf(hd1[(p0 + 8 * m) * 65 + f], wc[f], sacc);
            acc[m] = sacc; }
#pragma unroll
        for (int m = 0; m < 8; ++m) hd2[(p0 + 8 * m) * 65 + j] = __sinf(fq[j] * acc[m]);
        __syncthreads();
    }
    const float max_decay = -15.350567286626973f, min_decay = -3.0701134573253945f;
    float* hraw = (float*)(p.ws + WS_F + (set ? F_HRAW_CTX : F_HRAW_LAT));
    float* hyn = (float*)(p.ws + WS_F + (set ? F_HYP_CTX : F_HYP_LAT)) + (size_t)chunk * 2048;
    for (int cb = 0; cb < 4; ++cb) {
        const int o = cb * NT + tid;
        const int c = o & 511; const float delta = fabsf(min_decay + (float)c * ((max_decay - min_decay) / 511.f));
        float asum = 0.f;
        float* dst = hraw + (size_t)o * Ls + l0;
        for (int ph = 0; ph < 2; ++ph) {
            float acc[32];
#pragma unroll
            for (int pp = 0; pp < 32; ++pp) acc[pp] = 0.f;
#pragma unroll 1
            for (int j0 = 0; j0 < 64; j0 += 16) {
                float wv[16];
#pragma unroll
                for (int j = 0; j < 16; ++j) wv[j] = w3[(j0 + j) * 2048 + o];
#pragma unroll
                for (int j = 0; j < 16; ++j) {
#pragma unroll
                    for (int pp = 0; pp < 32; ++pp) acc[pp] = fmaf(hd2[(ph * 32 + pp) * 65 + j0 + j], wv[j], acc[pp]);
                    SCHED_FENCE();
                }
            }
#pragma unroll
            for (int q4 = 0; q4 < 8; ++q4) {
                f32x4 v;
#pragma unroll
                for (int e = 0; e < 4; ++e) { const int pp = q4 * 4 + e; const float tl = (float)(l0 + ph * 32 + pp) / (float)(Ls - 1); const float val = acc[pp] * expf(-tl * delta); v[e] = val; asum += fabsf(val); }
                *(f32x4*)(dst + ph * 32 + q4 * 4) = v;
            }
        }
        hyn[o] = asum;
    }
    __syncthreads();
}

constexpr int P0_MOD = 192, P0_TR_IN0 = 16 * 36, P0_TR_OUT0 = 256, P0_TR_IN1 = 16 * 80, P0_TR_OUT1 = 256, P0_TR_Q = 16 * 32, P0_KEYS = 32, P0_TAB = 512,
              P0_FILT = L / 64 + LC / 64;
DEV void phase0(const Params& p, unsigned char* smem) {
    bf16_t* W = (bf16_t*)(p.ws + WS_W);
    const int total = P0_MOD + P0_FILT + P0_TR_IN0 + P0_TR_OUT0 + P0_TR_IN1 + P0_TR_OUT1 + 2 * P0_TR_Q + P0_KEYS + 4 * P0_TAB;
    for (int it = blockIdx.x; it < total; it += gridDim.x) {
        int i = it;
        if (i < P0_MOD) { p0_mod(p, i, smem); continue; } i -= P0_MOD;
        if (i < P0_FILT) { if (i < L / 64) p0_filter(p, 0, i, smem); else p0_filter(p, 1, i - L / 64, smem); continue; } i -= P0_FILT;
        if (i < P0_TR_IN0) { p0_transpose(p.in[I_ABWIN], W + W_IN0 / 2, 2304, i, smem); continue; } i -= P0_TR_IN0;
        if (i < P0_TR_OUT0) { p0_transpose(p.in[I_ABWOUT], W + W_OUT0 / 2, 1024, i, smem); continue; } i -= P0_TR_OUT0;
        if (i < P0_TR_IN1) { p0_transpose(p.in[I_HGWIN], W + W_IN1 / 2, 5120, i, smem); continue; } i -= P0_TR_IN1;
        if (i < P0_TR_OUT1) { p0_transpose(p.in[I_HGWOUT], W + W_OUT1 / 2, 1024, i, smem); continue; } i -= P0_TR_OUT1;
        if (i < P0_TR_Q) { p0_transpose(p.in[I_PWQ], W + W_Q0 / 2, 2048, i, smem); continue; } i -= P0_TR_Q;
        if (i < P0_TR_Q) { p0_transpose(p.in[I_PWQ] + (size_t)1024 * 2048, W + W_Q1 / 2, 2048, i, smem); continue; } i -= P0_TR_Q;
        if (i < P0_KEYS) { p0_convert(p.in[I_PKEYS], W + W_KEYS / 2, i); continue; } i -= P0_KEYS;
        p0_table8(p, i / P0_TAB, i % P0_TAB);
    }
}

DEV const float* h_row(const Params& p, int layer_src_inputs, int tok) {
    if (layer_src_inputs) return tok < TL ? p.in[I_X] + (size_t)tok * 1024 : p.in[I_CTX] + (size_t)(tok - TL) * 1024;
    return (const float*)(p.ws + WS_H) + (size_t)tok * 1024;
}
DEV void norm_row_store(const Params& p, const f32x4 (&v)[4], int tok, const float* g, int layer, int sh_off, int lane) {
    float ss = 0.f;
#pragma unroll
    for (int i = 0; i < 4; ++i) ss += v[i][0] * v[i][0] + v[i][1] * v[i][1] + v[i][2] * v[i][2] + v[i][3] * v[i][3];
    ss = wave_sum(ss);
    const float rstd = rsqrtf(ss * (1.f / 1024.f) + 1e-6f);
    const float* mod = (const float*)(p.ws + WS_MOD) + ((size_t)layer * NR + mod_row(tok)) * 6144 + sh_off;
    bf16_t* A = (bf16_t*)(p.ws + WS_A) + (size_t)tok * 1024;
#pragma unroll
    for (int i = 0; i < 4; ++i) {
        const int c = i * 256 + lane * 4;
        const f32x4 gg = *(const f32x4*)(g + c), sh = *(const f32x4*)(mod + c), sc = *(const f32x4*)(mod + 1024 + c);
        u32x2 o;
        o[0] = pk2(v[i][0] * rstd * gg[0] * (1.f + sc[0]) + sh[0], v[i][1] * rstd * gg[1] * (1.f + sc[1]) + sh[1]);
        o[1] = pk2(v[i][2] * rstd * gg[2] * (1.f + sc[2]) + sh[2], v[i][3] * rstd * gg[3] * (1.f + sc[3]) + sh[3]);
        *(u32x2*)(A + c) = o;
    }
}
DEV void norm_rows_item(const Params& p, int item, int from_inputs, const float* g, int layer, int sh_off) {
    const int tok = item * 8 + (tidx() >> 6), lane = tidx() & 63;
    const float* src = h_row(p, from_inputs, tok);
    f32x4 v[4];
#pragma unroll
    for (int i = 0; i < 4; ++i) v[i] = *(const f32x4*)(src + i * 256 + lane * 4);
    norm_row_store(p, v, tok, g, layer, sh_off, lane);
}

DEV cf2 cmul(cf2 a, cf2 b) { cf2 r; r.x = a.x * b.x - a.y * b.y; r.y = a.x * b.y + a.y * b.x; return r; }
DEV cf2 twid(int k, float invN) { cf2 r; const float a = (float)k * invN; r.x = __builtin_amdgcn_cosf(a); r.y = -__builtin_amdgcn_sinf(a); return r; }
DEV void fft_fwd(cf2* buf, int S, int g, int G) {
    const int N = 1 << (2 * S); const float invN = 1.f / (float)N;
    for (int s = 0; s < S; ++s) {
        const int lm = 2 * (S - s), m = 1 << lm, q = m >> 2;
        for (int bf = g; bf < (N >> 2); bf += G) {
            const int j = bf & (q - 1), base = ((bf >> (lm - 2)) << lm) + j;
            const cf2 a0 = buf[base], a1 = buf[base + q], a2 = buf[base + 2 * q], a3 = buf[base + 3 * q];
            cf2 t0, t1, t2, t3; t0.x = a0.x + a2.x; t0.y = a0.y + a2.y; t1.x = a0.x - a2.x; t1.y = a0.y - a2.y; t2.x = a1.x + a3.x; t2.y = a1.y + a3.y;
            const float dx = a1.x - a3.x, dy = a1.y - a3.y; t3.x = dy; t3.y = -dx;
            cf2 y0, y1, y2, y3; y0.x = t0.x + t2.x; y0.y = t0.y + t2.y; y1.x = t1.x + t3.x; y1.y = t1.y + t3.y; y2.x = t0.x - t2.x; y2.y = t0.y - t2.y; y3.x = t1.x - t3.x; y3.y = t1.y - t3.y;
            const int tw = j << (2 * s);
            buf[base] = y0; buf[base + q] = cmul(y1, twid(tw, invN)); buf[base + 2 * q] = cmul(y2, twid(2 * tw, invN)); buf[base + 3 * q] = cmul(y3, twid(3 * tw, invN));
        }
        __syncthreads();
    }
}
DEV void fft_inv(cf2* buf, int S, int g, int G) {
    const int N = 1 << (2 * S); const float invN = 1.f / (float)N;
    for (int s = S - 1; s >= 0; --s) {
        const int lm = 2 * (S - s), m = 1 << lm, q = m >> 2;
        for (int bf = g; bf < (N >> 2); bf += G) {
            const int j = bf & (q - 1), base = ((bf >> (lm - 2)) << lm) + j;
            const int tw = j << (2 * s);
            cf2 w1 = twid(tw, invN), w2 = twid(2 * tw, invN), w3 = twid(3 * tw, invN); w1.y = -w1.y; w2.y = -w2.y; w3.y = -w3.y;
            const cf2 c0 = buf[base], c1 = cmul(buf[base + q], w1), c2 = cmul(buf[base + 2 * q], w2), c3 = cmul(buf[base + 3 * q], w3);
            cf2 t0, t1, t2, t3; t0.x = c0.x + c2.x; t0.y = c0.y + c2.y; t1.x = c0.x - c2.x; t1.y = c0.y - c2.y; t2.x = c1.x + c3.x; t2.y = c1.y + c3.y;
            const float dx = c1.x - c3.x, dy = c1.y - c3.y; t3.x = -dy; t3.y = dx;
            cf2 a0, a1, a2, a3; a0.x = t0.x + t2.x; a0.y = t0.y + t2.y; a1.x = t1.x + t3.x; a1.y = t1.y + t3.y; a2.x = t0.x - t2.x; a2.y = t0.y - t2.y; a3.x = t1.x - t3.x; a3.y = t1.y - t3.y;
            buf[base] = a0; buf[base + q] = a1; buf[base + 2 * q] = a2; buf[base + 3 * q] = a3;
        }
        __syncthreads();
    }
}
DEV void hf_item(const Params& p, int set, int pi, unsigned char* smem) {
    const int Ls = set ? LC : L, S = set ? FS_CTX : FS_LAT, N = 1 << (2 * S);
    const int gi = tidx() >> 8, g = tidx() & 255, idx = pi * 2 + gi, o = idx >> 9, c = idx & 511;
    cf2* buf = (cf2*)smem + (size_t)gi * N;
    const float* hraw = (const float*)(p.ws + WS_F + (set ? F_HRAW_CTX : F_HRAW_LAT));
    const float* hyn = (const float*)(p.ws + WS_F + (set ? F_HYP_CTX : F_HYP_LAT));
    float nsum = 0.f;
    for (int ch = 0; ch < Ls / 64; ++ch) nsum += hyn[(size_t)ch * 2048 + o * 1024 + c] + hyn[(size_t)ch * 2048 + o * 1024 + 512 + c];
    const float inv = 1.f / nsum;
    const float* hf = hraw + (size_t)(o * 1024 + c) * Ls; const float* hb = hraw + (size_t)(o * 1024 + 512 + c) * Ls;
    for (int k = g; k < N; k += 256) { float re = 0.f; if (k < Ls) re = hf[k] * inv; else if (k > N - Ls) re = hb[N - k] * inv; cf2 v; v.x = re; v.y = 0.f; buf[k] = v; }
    __syncthreads();
    fft_fwd(buf, S, g, 256);
    cf2* HF = (cf2*)(p.ws + WS_F + (set ? F_HF_CTX : F_HF_LAT)) + (size_t)(o * 512 + c) * N;
    for (int k = g; k < N; k += 256) HF[k] = buf[k];
    __syncthreads();
}
constexpr int P1_NORM = T / 8, P1_HF = 512;
DEV void phase1(const Params& p, unsigned char* smem) {
    const int total = P1_NORM + 2 * P1_HF;
    for (int it = blockIdx.x; it < total; it += gridDim.x) {
        if (it < P1_NORM) norm_rows_item(p, it, 1, p.in[I_N1G], 0, 0);
        else if (it < P1_NORM + P1_HF) hf_item(p, 0, it - P1_NORM, smem);
        else hf_item(p, 1, it - P1_NORM - P1_HF, smem);
    }
}

constexpr int G_LDA = 72;
template <class Epi>
DEV void gemm_tile(const bf16_t* __restrict__ A, const bf16_t* __restrict__ Wt, int m0, int n0, unsigned char* smem, const Epi& epi) {
    bf16_t* As = (bf16_t*)smem;
    bf16_t* Bs = As + 2 * 256 * G_LDA;
    const int tid = tidx(), lane = tid & 63, w = tid >> 6, wm = w >> 1, wn = w & 1;
    f32x16 acc[2][2];
#pragma unroll
    for (int i = 0; i < 2; ++i)
#pragma unroll
        for (int j = 0; j < 2; ++j)
#pragma unroll
            for (int r = 0; r < 16; ++r) acc[i][j][r] = 0.f;
    u32x4 ra[4], rb[2];
    const bf16_t* Ag = A + (size_t)m0 * 1024; const bf16_t* Bg = Wt + (size_t)n0 * 1024;
#define GLOAD(k0) do { \
        _Pragma("unroll") for (int i = 0; i < 4; ++i) { const int id = tid + NT * i, row = id >> 3, kc = id & 7; ra[i] = *(const u32x4*)(Ag + (size_t)row * 1024 + (k0) + kc * 8); } \
        _Pragma("unroll") for (int i = 0; i < 2; ++i) { const int id = tid + NT * i, row = id >> 3, kc = id & 7; rb[i] = *(const u32x4*)(Bg + (size_t)row * 1024 + (k0) + kc * 8); } } while (0)
#define LSTORE(buf_) do { \
        _Pragma("unroll") for (int i = 0; i < 4; ++i) { const int id = tid + NT * i, row = id >> 3, kc = id & 7; *(u32x4*)(As + ((buf_) * 256 + row) * G_LDA + kc * 8) = ra[i]; } \
        _Pragma("unroll") for (int i = 0; i < 2; ++i) { const int id = tid + NT * i, row = id >> 3, kc = id & 7; *(u32x4*)(Bs + ((buf_) * 128 + row) * G_LDA + kc * 8) = rb[i]; } } while (0)
    GLOAD(0); LSTORE(0); __syncthreads();
    for (int kt = 0; kt < 16; ++kt) {
        const int buf = kt & 1;
        if (kt + 1 < 16) GLOAD((kt + 1) * 64);
        const bf16_t* as = As + (buf * 256 + wm * 64 + (lane & 31)) * G_LDA + 8 * (lane >> 5);
        const bf16_t* bs = Bs + (buf * 128 + wn * 64 + (lane & 31)) * G_LDA + 8 * (lane >> 5);
#pragma unroll
        for (int kk = 0; kk < 4; ++kk) {
            const bf16x8 a0 = *(const bf16x8*)(as + kk * 16), a1 = *(const bf16x8*)(as + 32 * G_LDA + kk * 16);
            const bf16x8 b0 = *(const bf16x8*)(bs + kk * 16), b1 = *(const bf16x8*)(bs + 32 * G_LDA + kk * 16);
            acc[0][0] = __builtin_amdgcn_mfma_f32_32x32x16_bf16(a0, b0, acc[0][0], 0, 0, 0);
            acc[0][1] = __builtin_amdgcn_mfma_f32_32x32x16_bf16(a0, b1, acc[0][1], 0, 0, 0);
            acc[1][0] = __builtin_amdgcn_mfma_f32_32x32x16_bf16(a1, b0, acc[1][0], 0, 0, 0);
            acc[1][1] = __builtin_amdgcn_mfma_f32_32x32x16_bf16(a1, b1, acc[1][1], 0, 0, 0);
        }
        if (kt + 1 < 16) LSTORE(buf ^ 1);
        __syncthreads();
    }
#pragma unroll
    for (int mi = 0; mi < 2; ++mi)
#pragma unroll
        for (int ni = 0; ni < 2; ++ni)
#pragma unroll
            for (int rg = 0; rg < 4; ++rg) {
                const int row = m0 + wm * 64 + mi * 32 + 8 * rg + 4 * (lane >> 5), col = n0 + wn * 64 + ni * 32 + (lane & 31);
                epi(row, col, acc[mi][ni][rg * 4 + 0], acc[mi][ni][rg * 4 + 1], acc[mi][ni][rg * 4 + 2], acc[mi][ni][rg * 4 + 3]);
            }
}
struct EpiL0In {
    unsigned char* ws;
    DEV void operator()(int row, int col, float v0, float v1, float v2, float v3) const {
        u32x2 o; o[0] = pk2(v0, v1); o[1] = pk2(v2, v3);
        const bool lat = row < TL; const int b = lat ? row / L : (row - TL) / LC, t = lat ? row - b * L : (row - TL) - b * LC, Lx = lat ? L : LC;
        if (col < 1536) { bf16_t* d = (bf16_t*)(ws + WS_P + (lat ? P_HYT_LAT : P_HYT_CTX)) + ((size_t)b * 1536 + col) * Lx + t; *(u32x2*)d = o; }
        else if (col < 2048) { bf16_t* d = (bf16_t*)(ws + WS_P + P_Q0) + (size_t)row * 512 + (col - 1536); d[0] = (bf16_t)f2bf(v0); d[512] = (bf16_t)f2bf(v1); d[1024] = (bf16_t)f2bf(v2); d[1536] = (bf16_t)f2bf(v3); }
        else if (col < 2176) { bf16_t* d = (bf16_t*)(ws + WS_P + P_K0) + (size_t)row * 128 + (col - 2048); d[0] = (bf16_t)f2bf(v0); d[128] = (bf16_t)f2bf(v1); d[256] = (bf16_t)f2bf(v2); d[384] = (bf16_t)f2bf(v3); }
        else { bf16_t* d = (bf16_t*)(ws + WS_P + (lat ? P_VT_LAT : P_VT_CTX)) + ((size_t)b * 128 + (col - 2176)) * Lx + t; *(u32x2*)d = o; }
    }
};
struct EpiBf16 {
    bf16_t* out; int ld;
    DEV void operator()(int row, int col, float v0, float v1, float v2, float v3) const {
        bf16_t* d = out + (size_t)row * ld + col; d[0] = (bf16_t)f2bf(v0); d[ld] = (bf16_t)f2bf(v1); d[2 * ld] = (bf16_t)f2bf(v2); d[3 * ld] = (bf16_t)f2bf(v3);
    }
};
struct EpiHg {
    unsigned char* ws; const float* lg;
    DEV void operator()(int row, int col, float v0, float v1, float v2, float v3) const {
        float vv[4] = {v0, v1, v2, v3};
        const bool lat = row < TL; const int b = lat ? row / L : (row - TL) / LC, t = lat ? row - b * L : (row - TL) - b * LC, Lx = lat ? L : LC;
        if (col >= 3072 && col < 4096) {
            bf16_t* d = (bf16_t*)(ws + WS_M) + (lat ? (size_t)0 : (size_t)NB * 1024 * L) + ((size_t)b * 1024 + (col - 3072)) * Lx + t;
            u32x2 o; o[0] = pk2(v0, v1); o[1] = pk2(v2, v3); *(u32x2*)d = o;
            return;
        }
        if (col < 1024 || col >= 4096) {
#pragma unroll
            for (int i = 0; i < 4; ++i) vv[i] = silu_f(vv[i]);
        } else {
            const int c = col - 1024;
            const float oml = 1.f - 1.f / (1.f + __expf(lg[c] - lg[2048 + c]));
#pragma unroll
            for (int i = 0; i < 4; ++i) vv[i] = oml / (1.f + __expf(vv[i]));
        }
        if (col < 3072) {
            bf16_t* d = (bf16_t*)(ws + WS_P + (lat ? P1_KQT_LAT : P1_KQT_CTX)) + ((size_t)b * 3072 + col) * Lx + t;
            u32x2 o; o[0] = pk2(vv[0], vv[1]); o[1] = pk2(vv[2], vv[3]); *(u32x2*)d = o;
        } else {
            bf16_t* d = (bf16_t*)(ws + WS_P + P1_G) + (size_t)row * 1024 + (col - 4096); d[0] = (bf16_t)f2bf(vv[0]); d[1024] = (bf16_t)f2bf(vv[1]); d[2048] = (bf16_t)f2bf(vv[2]); d[3072] = (bf16_t)f2bf(vv[3]);
        }
    }
};
struct EpiRes {
    const Params* p; int from_inputs, layer, goff;
    DEV void operator()(int row, int col, float v0, float v1, float v2, float v3) const {
        const float vv[4] = {v0, v1, v2, v3};
        float* H = (float*)(p->ws + WS_H);
        const float* mod = (const float*)(p->ws + WS_MOD) + (size_t)layer * NR * 6144 + goff + col;
#pragma unroll
        for (int i = 0; i < 4; ++i) { const int r = row + i; H[(size_t)r * 1024 + col] = h_row(*p, from_inputs, r)[col] + mod[(size_t)mod_row(r) * 6144] * vv[i]; }
    }
};

DEV float hy_u(const bf16_t* row, int t, int Lx, float w0, float w1, float w2, float b) {
    const float xm = t > 0 ? bf2f(row[t - 1]) : 0.f, x0 = bf2f(row[t]), xp = t + 1 < Lx ? bf2f(row[t + 1]) : 0.f;
    return w0 * xm + w1 * x0 + w2 * xp + b;
}
DEV void hyena_item(const Params& p, int set, int item, unsigned char* smem) {
    const int Ls = set ? LC : L, S = set ? FS_CTX : FS_LAT, N = 1 << (2 * S);
    const int gi = tidx() >> 8, g = tidx() & 255;
    const int bp = item >> 8, c = (item & 255) * 2 + gi, ba = bp * 2, bb = ba + 1;
    cf2* buf = (cf2*)smem + (size_t)gi * N;
    cf2* zk = (cf2*)smem + (size_t)2 * N + (size_t)gi * Ls;
    const bf16_t* hy = (const bf16_t*)(p.ws + WS_P + (set ? P_HYT_CTX : P_HYT_LAT));
    const float* cw = p.in[I_HYCW]; const float* cb = p.in[I_HYCB];
    const cf2* HF = (const cf2*)(p.ws + WS_F + (set ? F_HF_CTX : F_HF_LAT));
    const float invN = 1.f / (float)N;
    {
        const float w0 = cw[c], w1 = cw[1536 + c], w2 = cw[3072 + c], b = cb[c];
        const bf16_t* ra = hy + ((size_t)ba * 1536 + c) * Ls; const bf16_t* rb = hy + ((size_t)bb * 1536 + c) * Ls;
        for (int t = g; t < N; t += 256) { cf2 v; v.x = 0.f; v.y = 0.f; if (t < Ls) { v.x = hy_u(ra, t, Ls, w0, w1, w2, b); v.y = hy_u(rb, t, Ls, w0, w1, w2, b); zk[t] = v; } buf[t] = v; }
    }
    __syncthreads();
    for (int n = 0; n < 2; ++n) {
        fft_fwd(buf, S, g, 256);
        const cf2* hf = HF + (size_t)(n * 512 + c) * N;
        for (int k = g; k < N; k += 256) buf[k] = cmul(buf[k], hf[k]);
        __syncthreads();
        fft_inv(buf, S, g, 256);
        const int gc = (n + 1) * 512 + c;
        const float w0 = cw[gc], w1 = cw[1536 + gc], w2 = cw[3072 + gc], b = cb[gc], dsk = p.in[I_HYSKIP][n * 512 + c];
        const bf16_t* ra = hy + ((size_t)ba * 1536 + gc) * Ls; const bf16_t* rb = hy + ((size_t)bb * 1536 + gc) * Ls;
        bf16_t* M = (bf16_t*)(p.ws + WS_M);
        for (int t = g; t < N; t += 256) {
            cf2 v; v.x = 0.f; v.y = 0.f;
            if (t < Ls) {
                const cf2 cv = buf[t], zo = zk[t];
                v.x = hy_u(ra, t, Ls, w0, w1, w2, b) * (cv.x * invN + dsk * zo.x); v.y = hy_u(rb, t, Ls, w0, w1, w2, b) * (cv.y * invN + dsk * zo.y);
                if (n == 0) zk[t] = v;
                else { const size_t ta = set ? (size_t)TL + (size_t)ba * LC + t : (size_t)ba * L + t, tb = set ? (size_t)TL + (size_t)bb * LC + t : (size_t)bb * L + t;
                       M[ta * 1024 + c] = (bf16_t)f2bf(v.x); M[tb * 1024 + c] = (bf16_t)f2bf(v.y); }
            }
            if (n == 0) buf[t] = v;
        }
        __syncthreads();
    }
}
DEV void rope_store(const bf16_t* src, bf16_t* dst, int pos, bool rope, float scale, int ph, int sub) {
    const u32x4 ua = *(const u32x4*)(src + ph * 32 + sub * 8), ub = *(const u32x4*)(src + ph * 32 + 16 + sub * 8);
    float a[8], b[8];
#pragma unroll
    for (int i = 0; i < 4; ++i) { a[2 * i] = bflo(ua[i]); a[2 * i + 1] = bfhi(ua[i]); b[2 * i] = bflo(ub[i]); b[2 * i + 1] = bfhi(ub[i]); }
    if (rope) {
        const float pv = (float)(ph == 0 ? pos / 64 : pos % 64);
#pragma unroll
        for (int e = 0; e < 8; ++e) {
            const float inv = exp2f(-(float)(sub * 8 + e) * (13.287712379549449f / 16.f));
            const float ang = pv * inv, cs = __cosf(ang), sn = __sinf(ang);
            const float na = a[e] * cs - b[e] * sn, nb = b[e] * cs + a[e] * sn; a[e] = na; b[e] = nb;
        }
    }
    u32x4 oa, ob;
#pragma unroll
    for (int i = 0; i < 4; ++i) { oa[i] = pk2(a[2 * i] * scale, a[2 * i + 1] * scale); ob[i] = pk2(b[2 * i] * scale, b[2 * i + 1] * scale); }
    *(u32x4*)(dst + ph * 32 + sub * 8) = oa; *(u32x4*)(dst + ph * 32 + 16 + sub * 8) = ob;
}
constexpr int A_LDQ = 72, A_LDV = 136;
DEV void attn_item(const Params& p, int set, int item, unsigned char* smem) {
    bf16_t* Qs = (bf16_t*)smem;
    bf16_t* Ks = Qs + 128 * A_LDQ;
    bf16_t* Vt = Ks + 128 * A_LDQ;
    const int tid = tidx(), lane = tid & 63, w = tid >> 6, l15 = lane & 15, lg = lane >> 4;
    const int nqb = set ? LC / 128 : L / 128;
    const int h = item & 7, qb = (item >> 3) % nqb, b = (item >> 3) / nqb, kvh = h >> 2;
    const bf16_t* Q0 = (const bf16_t*)(p.ws + WS_P + P_Q0); const bf16_t* K0 = (const bf16_t*)(p.ws + WS_P + P_K0);
    const int qtok0 = set ? TL + b * LC + qb * 128 : b * L + qb * 128;
    { const int row = tid >> 2, ph = (tid >> 1) & 1, sub = tid & 1;
      rope_store(Q0 + (size_t)(qtok0 + row) * 512 + h * 64, Qs + row * A_LDQ, qb * 128 + row, set == 0, 0.125f, ph, sub); }
    __syncthreads();
    bf16x8 qf[2];
    qf[0] = *(const bf16x8*)(Qs + (w * 16 + l15) * A_LDQ + 8 * lg); qf[1] = *(const bf16x8*)(Qs + (w * 16 + l15) * A_LDQ + 32 + 8 * lg);
    float m_run = p.in[I_SINK][h], l_run = 1.f;
    f32x4 O[4];
#pragma unroll
    for (int i = 0; i < 4; ++i) O[i] = (f32x4){0.f, 0.f, 0.f, 0.f};
    const int nwin = set ? 0 : 3, nctx = LC / 128;
    for (int kbi = 0; kbi < nwin + nctx; ++kbi) {
        const bool win = kbi < nwin; const int kb = win ? qb - 1 + kbi : kbi - nwin;
        if (win && (kb < 0 || kb >= L / 128)) continue;
        const int ktok0 = win ? b * L + kb * 128 : TL + b * LC + kb * 128;
        __syncthreads();
        { const int row = tid >> 2, ph = (tid >> 1) & 1, sub = tid & 1;
          rope_store(K0 + (size_t)(ktok0 + row) * 128 + kvh * 64, Ks + row * A_LDQ, kb * 128 + row, win, 1.f, ph, sub); }
        { const bf16_t* vt = (const bf16_t*)(p.ws + WS_P + (win ? P_VT_LAT : P_VT_CTX)); const int Lx = win ? L : LC;
#pragma unroll
          for (int i = 0; i < 2; ++i) { const int id = tid + NT * i, d = id >> 4, kc = id & 15;
              *(u32x4*)(Vt + d * A_LDV + kc * 8) = *(const u32x4*)(vt + ((size_t)b * 128 + kvh * 64 + d) * Lx + kb * 128 + kc * 8); } }
        __syncthreads();
#pragma unroll
        for (int ch = 0; ch < 2; ++ch) {
            f32x4 st[4];
#pragma unroll
            for (int u = 0; u < 4; ++u) {
                const bf16_t* kr = Ks + ((ch * 4 + u) * 16 + l15) * A_LDQ + 8 * lg;
                f32x4 z = (f32x4){0.f, 0.f, 0.f, 0.f};
                z = __builtin_amdgcn_mfma_f32_16x16x32_bf16(*(const bf16x8*)kr, qf[0], z, 0, 0, 0);
                z = __builtin_amdgcn_mfma_f32_16x16x32_bf16(*(const bf16x8*)(kr + 32), qf[1], z, 0, 0, 0);
                st[u] = z;
            }
            float cmax = -INFINITY;
            if (win) {
                const int qpos = qb * 128 + w * 16 + l15;
#pragma unroll
                for (int u = 0; u < 4; ++u)
#pragma unroll
                    for (int r = 0; r < 4; ++r) { const int kpos = kb * 128 + (ch * 4 + u) * 16 + 4 * lg + r; const int dd = qpos - kpos; if (dd > 128 || dd < -128) st[u][r] = -INFINITY; }
            }
#pragma unroll
            for (int u = 0; u < 4; ++u)
#pragma unroll
                for (int r = 0; r < 4; ++r) cmax = fmaxf(cmax, st[u][r]);
            cmax = fmaxf(cmax, __shfl_xor(cmax, 16)); cmax = fmaxf(cmax, __shfl_xor(cmax, 32));
            const float m_new = fmaxf(m_run, cmax), alpha = __expf(m_run - m_new);
            float ls = 0.f;
#pragma unroll
            for (int u = 0; u < 4; ++u)
#pragma unroll
                for (int r = 0; r < 4; ++r) { const float e = __expf(st[u][r] - m_new); st[u][r] = e; ls += e; }
            ls += __shfl_xor(ls, 16); ls += __shfl_xor(ls, 32);
            l_run = l_run * alpha + ls; m_run = m_new;
#pragma unroll
            for (int i = 0; i < 4; ++i) { O[i][0] *= alpha; O[i][1] *= alpha; O[i][2] *= alpha; O[i][3] *= alpha; }
#pragma unroll
            for (int ss = 0; ss < 2; ++ss) {
                u32x4 pu; pu[0] = pk2(st[2 * ss][0], st[2 * ss][1]); pu[1] = pk2(st[2 * ss][2], st[2 * ss][3]); pu[2] = pk2(st[2 * ss + 1][0], st[2 * ss + 1][1]); pu[3] = pk2(st[2 * ss + 1][2], st[2 * ss + 1][3]);
                const bf16x8 pf = __builtin_bit_cast(bf16x8, pu);
                const int key0 = (ch * 4 + 2 * ss) * 16 + 4 * lg;
#pragma unroll
                for (int dt = 0; dt < 4; ++dt) {
                    const bf16_t* vr = Vt + (dt * 16 + l15) * A_LDV + key0;
                    u32x4 vu; const u32x2 v0 = *(const u32x2*)vr, v1 = *(const u32x2*)(vr + 16); vu[0] = v0[0]; vu[1] = v0[1]; vu[2] = v1[0]; vu[3] = v1[1];
                    O[dt] = __builtin_amdgcn_mfma_f32_16x16x32_bf16(__builtin_bit_cast(bf16x8, vu), pf, O[dt], 0, 0, 0);
                }
            }
        }
    }
    const float il = 1.f / l_run;
    bf16_t* M = (bf16_t*)(p.ws + WS_M) + (size_t)(qtok0 + w * 16 + l15) * 1024 + 512 + h * 64;
#pragma unroll
    for (int dt = 0; dt < 4; ++dt) { u32x2 o; o[0] = pk2(O[dt][0] * il, O[dt][1] * il); o[1] = pk2(O[dt][2] * il, O[dt][3] * il); *(u32x2*)(M + dt * 16 + 4 * lg) = o; }
    __syncthreads();
}
constexpr int P3_HY_LAT = (NB / 2) * 256, P3_HY_CTX = (NB / 2) * 256, P3_AT_LAT = NB * (L / 128) * 8, P3_AT_CTX = NB * (LC / 128) * 8;
DEV void phase3(const Params& p, unsigned char* smem) {
    const int total = P3_HY_LAT + P3_AT_LAT + P3_HY_CTX + P3_AT_CTX;
    for (int it = blockIdx.x; it < total; it += gridDim.x) {
        int i = it;
        if (i < P3_HY_LAT) { hyena_item(p, 0, i, smem); continue; } i -= P3_HY_LAT;
        if (i < P3_AT_LAT) { attn_item(p, 0, i, smem); continue; } i -= P3_AT_LAT;
        if (i < P3_HY_CTX) { hyena_item(p, 1, i, smem); continue; } i -= P3_HY_CTX;
        attn_item(p, 1, i, smem);
    }
}

constexpr int K_LDK = 136, K_LDS = 129, K_LDC = 52;
DEV unsigned fkey(float f) { const unsigned u = __builtin_bit_cast(unsigned, f); return (u & 0x80000000u) ? ~u : (u | 0x80000000u); }
constexpr int cand_off(int i) { int o = 0; for (int k = 0; k < i; ++k) o += 16 / (k + 1); return o; }
DEV void topk_load_keys(const Params& p, int layer, int h, unsigned char* smem) {
    bf16_t* Ks = (bf16_t*)smem;
    const bf16_t* keys = (const bf16_t*)(p.ws + WS_W + W_KEYS) + (size_t)layer * 262144 + (size_t)h * 32768;
    const int tid = tidx();
#pragma unroll
    for (int i = 0; i < 8; ++i) { const int id = tid + NT * i, row = id >> 4, kc = id & 15; *(u32x4*)(Ks + row * K_LDK + kc * 8) = *(const u32x4*)(keys + (size_t)row * 128 + kc * 8); }
    __syncthreads();
}
#ifndef HOST_EMU
template <int CTRL> DEV unsigned dpp_u32(unsigned v) { return (unsigned)__builtin_amdgcn_update_dpp(0, (int)v, CTRL, 0xF, 0xF, true); }
#else
template <int CTRL> DEV unsigned dpp_u32(unsigned v) { const int lane = tidx() & 63; const int src = CTRL == 0xB1 ? (lane ^ 1) : CTRL == 0x4E ? (lane ^ 2) : ((lane & ~7) | (7 - (lane & 7))); return emu_shfl(v, src); }
#endif
DEV unsigned max8_u32(unsigned v) { unsigned t = dpp_u32<0xB1>(v); v = v > t ? v : t; t = dpp_u32<0x4E>(v); v = v > t ? v : t; t = dpp_u32<0x141>(v); return v > t ? v : t; }
DEV float sum8_f32(float v) { v += __builtin_bit_cast(float, dpp_u32<0xB1>(__builtin_bit_cast(unsigned, v))); v += __builtin_bit_cast(float, dpp_u32<0x4E>(__builtin_bit_cast(unsigned, v))); v += __builtin_bit_cast(float, dpp_u32<0x141>(__builtin_bit_cast(unsigned, v))); return v; }
DEV float unkey(unsigned k) { const unsigned u = (k & 0x80000000u) ? (k & 0x7fffffffu) : ~k; return __builtin_bit_cast(float, u); }
template <int N> DEV void bitonic_desc(unsigned (&a)[N]) {
#pragma unroll
    for (int k = 2; k <= N; k <<= 1)
#pragma unroll
        for (int j = k >> 1; j > 0; j >>= 1)
#pragma unroll
            for (int i = 0; i < N; ++i) { const int l = i ^ j; if (l > i) { const unsigned x = a[i], y = a[l]; const unsigned hi = x > y ? x : y, lo = x > y ? y : x; if ((i & k) == 0) { a[i] = hi; a[l] = lo; } else { a[i] = lo; a[l] = hi; } } }
}
DEV void merge16(const unsigned* lst, int nlist, unsigned first, int sub, unsigned& r0, unsigned& r1) {
    unsigned cur = first; int head = 0; r0 = 0u; r1 = 0u;
#pragma unroll
    for (int it = 0; it < 16; ++it) {
        const unsigned m = max8_u32(cur);
        if (sub == (it & 7)) { if (it < 8) r0 = m; else r1 = m; }
        if (cur == m) { ++head; cur = head < nlist ? lst[head] : 0u; }
    }
}
DEV void topk_item(const Params& p, int h, int tok0, unsigned char* smem) {
    bf16_t* Ks = (bf16_t*)smem;
    float* Sc = (float*)(Ks + 2 * 128 * K_LDK);
    unsigned* s12 = (unsigned*)Sc + 64 * 8 * 17;
    unsigned* cl = s12 + 64 * 32;
    const int tid = tidx(), lane = tid & 63, w = tid >> 6;
    const int row = tid >> 3, sub = tid & 7;
    const bf16_t* PQ = (const bf16_t*)(p.ws + WS_P);
    for (int part = 0; part < 2; ++part) {
        { const int mi = w >> 2, ni = w & 3;
          f32x16 acc;
#pragma unroll
          for (int r = 0; r < 16; ++r) acc[r] = 0.f;
          const bf16_t* ag = PQ + (size_t)(tok0 + mi * 32 + (lane & 31)) * 2048 + h * 256 + part * 128 + 8 * (lane >> 5);
          const bf16_t* bs = Ks + (part * 128 + ni * 32 + (lane & 31)) * K_LDK + 8 * (lane >> 5);
          bf16x8 af[8];
#pragma unroll
          for (int kk = 0; kk < 8; ++kk) af[kk] = *(const bf16x8*)(ag + kk * 16);
#pragma unroll
          for (int kk = 0; kk < 8; ++kk) acc = __builtin_amdgcn_mfma_f32_32x32x16_bf16(af[kk], *(const bf16x8*)(bs + kk * 16), acc, 0, 0, 0);
#pragma unroll
          for (int r = 0; r < 16; ++r) Sc[(mi * 32 + (r & 3) + 8 * (r >> 2) + 4 * (lane >> 5)) * K_LDS + ni * 32 + (lane & 31)] = acc[r]; }
        __syncthreads();
        unsigned mk[16];
#pragma unroll
        for (int i = 0; i < 16; ++i) mk[i] = (fkey(Sc[row * K_LDS + sub * 16 + i]) & ~127u) | (unsigned)(127 - (sub * 16 + i));
        bitonic_desc<16>(mk);
        __syncthreads();
        unsigned* lst = (unsigned*)Sc + (row * 8 + sub) * 17;
#pragma unroll
        for (int i = 0; i < 16; ++i) lst[i] = mk[i];
        unsigned r0, r1;
        merge16(lst, 16, mk[0], sub, r0, r1);
        s12[(row * 2 + part) * 16 + sub] = r0; s12[(row * 2 + part) * 16 + 8 + sub] = r1;
        __syncthreads();
    }
    {
        const unsigned* k1 = s12 + row * 32; const unsigned* k2 = k1 + 16;
        unsigned ck[8];
#pragma unroll
        for (int m = 0; m < 8; ++m) {
            const int cc = sub + 8 * m; int ci = 0, off = 0;
#pragma unroll
            for (int i = 0; i < 15; ++i) { const bool ge = cc >= cand_off(i + 1); ci += ge ? 1 : 0; off += ge ? 16 / (i + 1) : 0; }
            const int cj = cc - off;
            ck[m] = 0u;
            if (cc < 50) ck[m] = (fkey(unkey((k1[ci] & ~127u) | 64u) + unkey((k2[cj] & ~127u) | 64u)) & ~63u) | (unsigned)(63 - cc);
        }
        bitonic_desc<8>(ck);
        unsigned* lst = cl + (row * 8 + sub) * 9;
#pragma unroll
        for (int m = 0; m < 8; ++m) lst[m] = ck[m];
        unsigned r0, r1;
        merge16(lst, 8, ck[0], sub, r0, r1);
        const float a = unkey((r0 & ~63u) | 32u), b = unkey((r1 & ~63u) | 32u);
        const unsigned kmax = max8_u32(r0 > r1 ? r0 : r1); const float vmax = unkey((kmax & ~63u) | 32u);
        const float ea = __expf(a - vmax), eb = __expf(b - vmax);
        const float inv = 1.f / sum8_f32(ea + eb);
        int eidx[2];
#pragma unroll
        for (int q = 0; q < 2; ++q) {
            const int cc = 63 - (int)((q ? r1 : r0) & 63u); int ci = 0, off = 0;
#pragma unroll
            for (int i = 0; i < 15; ++i) { const bool ge = cc >= cand_off(i + 1); ci += ge ? 1 : 0; off += ge ? 16 / (i + 1) : 0; }
            const int cj = cc - off;
            eidx[q] = (127 - (int)(k1[ci] & 127u)) * 128 + (127 - (int)(k2[cj] & 127u));
        }
        int* IDX = (int*)(p.ws + WS_IDX) + (size_t)(tok0 + row) * 128 + h * 16; float* GT = (float*)(p.ws + WS_GATE) + (size_t)(tok0 + row) * 128 + h * 16;
        IDX[sub] = eidx[0]; IDX[8 + sub] = eidx[1]; GT[sub] = ea * inv; GT[8 + sub] = eb * inv;
    }
    __syncthreads();
}
DEV void topk_phase(const Params& p, int layer, int ntok, unsigned char* smem) {
    const int G = gridDim.x, bid = blockIdx.x, h = bid & 7;
    const int nt = ntok / 64;
    if ((G & 7) == 0) {
        if ((bid >> 3) < nt) topk_load_keys(p, layer, h, smem);
        for (int tt = bid >> 3; tt < nt; tt += (G >> 3)) topk_item(p, h, tt * 64, smem);
    } else {
        for (int it = bid; it < nt * 8; it += G) { __syncthreads(); topk_load_keys(p, layer, it & 7, smem); topk_item(p, it & 7, (it >> 3) * 64, smem); }
    }
}

DEV float gelu_f(float x) { return 0.5f * x * (1.f + erff(x * 0.70710678118654752f)); }
typedef float f32x2 __attribute__((ext_vector_type(2)));
DEV void fp8x16_to_f32(const u32x4& r, float (&f)[16]) {
#pragma unroll
    for (int i = 0; i < 4; ++i) { const f32x2 lo = __builtin_amdgcn_cvt_pk_f32_fp8((int)r[i], false), hi = __builtin_amdgcn_cvt_pk_f32_fp8((int)r[i], true); f[4 * i] = lo[0]; f[4 * i + 1] = lo[1]; f[4 * i + 2] = hi[0]; f[4 * i + 3] = hi[1]; }
}
DEV void peer_item(const Params& p, int layer, int item) {
    const int tok = item * 8 + (tidx() >> 6), lane = tidx() & 63;
    const bf16_t* A = (const bf16_t*)(p.ws + WS_A) + (size_t)tok * 1024 + lane * 16;
    const unsigned char* U8 = p.ws + WS_T8 + (size_t)(layer * 2) * 16384 * 1024; const unsigned char* V8 = U8 + (size_t)16384 * 1024; const int voff = lane * 16;
    const float* SU = (const float*)(p.ws + WS_S8) + (size_t)(layer * 2) * 16384; const float* SV = SU + 16384;
    float x[16], y[16];
    { const u32x4 a0 = *(const u32x4*)A, a1 = *(const u32x4*)(A + 8);
#pragma unroll
      for (int i = 0; i < 4; ++i) { x[2 * i] = bflo(a0[i]); x[2 * i + 1] = bfhi(a0[i]); x[8 + 2 * i] = bflo(a1[i]); x[8 + 2 * i + 1] = bfhi(a1[i]); } }
#pragma unroll
    for (int i = 0; i < 16; ++i) y[i] = 0.f;
    const int* IDX = (const int*)(p.ws + WS_IDX) + (size_t)tok * 128; const float* GT = (const float*)(p.ws + WS_GATE) + (size_t)tok * 128;
    const int i_lo = IDX[lane], i_hi = IDX[64 + lane]; const float g_lo = GT[lane], g_hi = GT[64 + lane];
    const int jl = ((lane >> 5) & 1) * 4 + ((lane >> 4) & 1) * 2 + ((lane >> 3) & 1);
    u32x4 ur[8], vr[8];
#define PG_LOADU(g) do { const int src_ = (g) < 8 ? i_lo : i_hi; \
        _Pragma("unroll") for (int j = 0; j < 8; ++j) { const int e_ = __builtin_amdgcn_readlane(src_, (((g) & 7) << 3) + j); ur[j] = *(const u32x4*)(U8 + (size_t)e_ * 1024 + voff); } } while (0)
#define PG_LOADV(g) do { const int src_ = (g) < 8 ? i_lo : i_hi; \
        _Pragma("unroll") for (int j = 0; j < 8; ++j) { const int e_ = __builtin_amdgcn_readlane(src_, (((g) & 7) << 3) + j); vr[j] = *(const u32x4*)(V8 + (size_t)e_ * 1024 + voff); } } while (0)
    PG_LOADU(0); PG_LOADV(0);
    for (int g = 0; g < 16; ++g) {
        const int mk = ((g & 7) << 3) + jl; const int me = __shfl(g < 8 ? i_lo : i_hi, mk); const float mg = __shfl(g < 8 ? g_lo : g_hi, mk);
        const float su = SU[me], sv = SV[me];
        float d[8];
#pragma unroll
        for (int j = 0; j < 8; ++j) { float f[16]; fp8x16_to_f32(ur[j], f); float a = 0.f;
#pragma unroll
            for (int i = 0; i < 16; ++i) a = fmaf(f[i], x[i], a);
            d[j] = a; SCHED_FENCE(); }
        if (g + 1 < 16) PG_LOADU(g + 1);
        float r4[4], r2[2], r1;
        { const bool hi = (lane & 32) != 0;
#pragma unroll
          for (int j = 0; j < 4; ++j) { const float send = hi ? d[j] : d[4 + j], keep = hi ? d[4 + j] : d[j]; r4[j] = keep + __shfl_xor(send, 32); } }
        { const bool hi = (lane & 16) != 0;
#pragma unroll
          for (int j = 0; j < 2; ++j) { const float send = hi ? r4[j] : r4[2 + j], keep = hi ? r4[2 + j] : r4[j]; r2[j] = keep + __shfl_xor(send, 16); } }
        { const bool hi = (lane & 8) != 0; const float send = hi ? r2[0] : r2[1], keep = hi ? r2[1] : r2[0]; r1 = keep + __shfl_xor(send, 8); }
        r1 += __shfl_xor(r1, 4); r1 += __shfl_xor(r1, 2); r1 += __shfl_xor(r1, 1);
        const float act = gelu_f(r1 * su) * mg * sv;
#pragma unroll
        for (int j = 0; j < 8; ++j) {
            const float aj = __builtin_bit_cast(float, __builtin_amdgcn_readlane(__builtin_bit_cast(int, act), ((j >> 2) & 1) * 32 + ((j >> 1) & 1) * 16 + (j & 1) * 8));
            float f[16]; fp8x16_to_f32(vr[j], f);
#pragma unroll
            for (int i = 0; i < 16; ++i) y[i] = fmaf(aj, f[i], y[i]);
            SCHED_FENCE(); }
        if (g + 1 < 16) PG_LOADV(g + 1);
    }
#undef PG_LOADU
#undef PG_LOADV
    float* H = (float*)(p.ws + WS_H) + (size_t)tok * 1024 + lane * 16;
    const float* g2 = (const float*)(p.ws + WS_MOD) + ((size_t)layer * NR + mod_row(tok)) * 6144 + 5120 + lane * 16;
    float hv[16]; float ss = 0.f;
#pragma unroll
    for (int i = 0; i < 4; ++i) { const f32x4 hh = *(const f32x4*)(H + 4 * i), gg = *(const f32x4*)(g2 + 4 * i);
#pragma unroll
        for (int j = 0; j < 4; ++j) { const float v = hh[j] + gg[j] * y[4 * i + j]; hv[4 * i + j] = v; ss += v * v; } }
    ss = wave_sum(ss);
    const float rstd = rsqrtf(ss * (1.f / 1024.f) + 1e-6f);
    if (layer == 0) {
#pragma unroll
        for (int i = 0; i < 4; ++i) { f32x4 o; o[0] = hv[4 * i]; o[1] = hv[4 * i + 1]; o[2] = hv[4 * i + 2]; o[3] = hv[4 * i + 3]; *(f32x4*)(H + 4 * i) = o; }
        const float* g = p.in[I_N1G] + 1024 + lane * 16;
        const float* mod = (const float*)(p.ws + WS_MOD) + ((size_t)1 * NR + mod_row(tok)) * 6144 + lane * 16;
        bf16_t* Ao = (bf16_t*)(p.ws + WS_A) + (size_t)tok * 1024 + lane * 16;
        u32x4 o0, o1; float r[16];
#pragma unroll
        for (int i = 0; i < 16; ++i) r[i] = hv[i] * rstd * g[i] * (1.f + mod[1024 + i]) + mod[i];
#pragma unroll
        for (int i = 0; i < 4; ++i) { o0[i] = pk2(r[2 * i], r[2 * i + 1]); o1[i] = pk2(r[8 + 2 * i], r[8 + 2 * i + 1]); }
        *(u32x4*)Ao = o0; *(u32x4*)(Ao + 8) = o1;
    } else {
        const float* g = p.in[I_FG] + lane * 16; float* out = p.out + (size_t)tok * 1024 + lane * 16;
#pragma unroll
        for (int i = 0; i < 4; ++i) { f32x4 o; o[0] = hv[4 * i] * rstd * g[4 * i]; o[1] = hv[4 * i + 1] * rstd * g[4 * i + 1]; o[2] = hv[4 * i + 2] * rstd * g[4 * i + 2]; o[3] = hv[4 * i + 3] * rstd * g[4 * i + 3]; *(f32x4*)(out + 4 * i) = o; }
    }
}

constexpr int S3_LD = 136, S3_LDT = 24, S3_LDV = 72;
constexpr int S3_Q = 0, S3_K = S3_Q + 64 * S3_LD * 2, S3_KT = S3_K + 64 * S3_LD * 2, S3_D = S3_KT + 4 * 128 * S3_LDT * 2, S3_V = S3_D + 4 * 128 * 4, S3_ST = S3_V + 64 * S3_LDV * 2,
              S3_P = S3_ST + 2 * 64 * S3_LD * 2, S3_END = S3_P + 4 * 16 * S3_LDT * 2;
static_assert(S3_END <= SMEM_BYTES, "scan LDS");
DEV void scan_block(const Params& p, int bi, unsigned char* smem, int var = 0) {
    const int tid = tidx(), lane = tid & 63, w = tid >> 6, l15 = lane & 15, lg4 = lane >> 4, l31 = lane & 31, lh = lane >> 5;
    const int half = bi & 1, dir = (bi >> 1) & 1, h = (bi >> 2) & 7, b = bi >> 5;
    const bf16_t* P1 = (const bf16_t*)(p.ws + WS_P);
    const bf16_t* IT = (const bf16_t*)(p.ws + WS_M);
    bf16_t* Oo = (bf16_t*)(p.ws + WS_F + (dir ? F_OB : F_OF));
    bf16_t* Qs = (bf16_t*)(smem + S3_Q); bf16_t* Ks = (bf16_t*)(smem + S3_K); bf16_t* KT = (bf16_t*)(smem + S3_KT); float* Ds = (float*)(smem + S3_D);
    bf16_t* Vs = (bf16_t*)(smem + S3_V); bf16_t* ST = (bf16_t*)(smem + S3_ST); bf16_t* Ps = (bf16_t*)(smem + S3_P);
    const int NCH = (LC + L) / 64;
    const int kt = w >> 1, vt = w & 1;
    f32x16 S;
#pragma unroll
    for (int r = 0; r < 16; ++r) S[r] = 0.f;
    for (int i = tid; i < 64 * S3_LD / 2; i += NT) ((unsigned*)ST)[i] = 0u;
    const int pk = tid & 127, pblk = tid >> 7;
    u32x4 ka[2], qa[2], va, kb2[2], qb2[2], vb2;
    const int kcol = 1024 * (1 + dir) + h * 128 + pk, qcol = h * 128 + pk;
#define S3_T0(c) ((c) * 64 < LC ? (dir ? LC - 64 - (c) * 64 : (c) * 64) : (dir ? L - 64 - ((c) * 64 - LC) : (c) * 64 - LC))
#define S3_LOAD(c, KR, QR, VR) do { const bool lat_ = (c) * 64 >= LC; const int t0_ = S3_T0(c); const int Lx_ = lat_ ? L : LC; \
        const bf16_t* kq_ = (const bf16_t*)(p.ws + WS_P + (lat_ ? P1_KQT_LAT : P1_KQT_CTX)) + (size_t)b * 3072 * Lx_ + t0_ + pblk * 16; \
        KR[0] = *(const u32x4*)(kq_ + (size_t)kcol * Lx_); KR[1] = *(const u32x4*)(kq_ + (size_t)kcol * Lx_ + 8); \
        if (lat_) { QR[0] = *(const u32x4*)(kq_ + (size_t)qcol * Lx_); QR[1] = *(const u32x4*)(kq_ + (size_t)qcol * Lx_ + 8); } else { QR[0] = (u32x4){0u, 0u, 0u, 0u}; QR[1] = QR[0]; } \
        { const int v_ = tid >> 3, c8_ = tid & 7; const bf16_t* it_ = IT + (lat_ ? (size_t)0 : (size_t)NB * 1024 * L) + ((size_t)b * 1024 + h * 128 + half * 64 + v_) * Lx_ + t0_ + c8_ * 8; VR = *(const u32x4*)it_; } } while (0)
#define S3_PREP(KR, QR, VR) do { \
            float bsum = 0.f; unsigned short kt16[16]; \
            _Pragma("unroll") for (int rr = 0; rr < 16; ++rr) { \
                const int tl = dir ? 15 - rr : rr; \
                const unsigned ku_ = dir ? KR[(15 - rr) >> 3][((15 - rr) & 7) >> 1] : KR[rr >> 3][(rr & 7) >> 1]; const unsigned qu_ = dir ? QR[(15 - rr) >> 3][((15 - rr) & 7) >> 1] : QR[rr >> 3][(rr & 7) >> 1]; \
                const bool odd_ = dir ? (((15 - rr) & 1) != 0) : ((rr & 1) != 0); \
                const float kv = odd_ ? bfhi(ku_) : bflo(ku_), qv = odd_ ? bfhi(qu_) : bflo(qu_); \
                bsum += __logf(1.f - kv); \
                const float eb = __expf(bsum), ieb = __expf(fminf(-bsum, 80.f)); \
                const unsigned short qt = (unsigned short)f2bf(qv * eb), ktv = (unsigned short)f2bf(kv * ieb); \
                Qs[(pblk * 16 + tl) * S3_LD + pk] = qt; Ks[(pblk * 16 + tl) * S3_LD + pk] = ktv; \
                if (dir) kt16[15 - rr] = ktv; else kt16[rr] = ktv; \
            } \
            u32x4 o0, o1; \
            _Pragma("unroll") for (int i = 0; i < 4; ++i) { o0[i] = (unsigned)kt16[2 * i] | ((unsigned)kt16[2 * i + 1] << 16); o1[i] = (unsigned)kt16[8 + 2 * i] | ((unsigned)kt16[8 + 2 * i + 1] << 16); } \
            *(u32x4*)(KT + (pblk * 128 + pk) * S3_LDT) = o0; *(u32x4*)(KT + (pblk * 128 + pk) * S3_LDT + 8) = o1; \
            Ds[pblk * 128 + pk] = __expf(bsum); \
            { const int v_ = tid >> 3, c8_ = tid & 7; *(u32x4*)(Vs + v_ * S3_LDV + c8_ * 8) = VR; } } while (0)
    S3_LOAD(0, ka, qa, va);
    for (int c = 0; c < NCH; ++c) {
        const bool lat = c * 64 >= LC; const int t0 = S3_T0(c); const size_t tokb = lat ? (size_t)b * L + t0 : (size_t)TL + (size_t)b * LC + t0;
        if ((c & 1) == 0) { if (c + 1 < NCH) S3_LOAD(c + 1, kb2, qb2, vb2); } else { if (c + 1 < NCH) S3_LOAD(c + 1, ka, qa, va); }
        lds_barrier();
        if (var != 1) { if ((c & 1) == 0) S3_PREP(ka, qa, va); else S3_PREP(kb2, qb2, vb2); }
        lds_barrier();

        if (lat && w < 4) {
            f32x4 pt = (f32x4){0.f, 0.f, 0.f, 0.f};
#pragma unroll
            for (int kk = 0; kk < 4; ++kk)
                pt = __builtin_amdgcn_mfma_f32_16x16x32_bf16(*(const bf16x8*)(Ks + (w * 16 + l15) * S3_LD + kk * 32 + 8 * lg4), *(const bf16x8*)(Qs + (w * 16 + l15) * S3_LD + kk * 32 + 8 * lg4), pt, 0, 0, 0);
            float pm[4];
#pragma unroll
            for (int r = 0; r < 4; ++r) { const int sl = 4 * lg4 + r; const bool keep = dir ? (sl >= l15) : (sl <= l15); pm[r] = keep ? pt[r] : 0.f; }
            u32x2 o; o[0] = pk2(pm[0], pm[1]); o[1] = pk2(pm[2], pm[3]);
            *(u32x2*)(Ps + (w * 16 + l15) * S3_LDT + 4 * lg4) = o;
        }
        lds_barrier();
        for (int ib = 0; ib < (var == 2 ? 0 : 4); ++ib) {
            const int blk = dir ? 3 - ib : ib;
            const int cur = (c * 4 + ib) & 1;
            { const bf16x8 a = *(const bf16x8*)(KT + (blk * 128 + 32 * kt + l31) * S3_LDT + 8 * lh);
              const bf16x8 bb = *(const bf16x8*)(Vs + (32 * vt + l31) * S3_LDV + blk * 16 + 8 * lh);
              S = __builtin_amdgcn_mfma_f32_32x32x16_bf16(a, bb, S, 0, 0, 0);
#pragma unroll
              for (int g = 0; g < 4; ++g) { const f32x4 dv = *(const f32x4*)(Ds + blk * 128 + 32 * kt + 8 * g + 4 * lh);
                  S[4 * g] *= dv[0]; S[4 * g + 1] *= dv[1]; S[4 * g + 2] *= dv[2]; S[4 * g + 3] *= dv[3];
                  u32x2 o; o[0] = pk2(S[4 * g], S[4 * g + 1]); o[1] = pk2(S[4 * g + 2], S[4 * g + 3]);
                  *(u32x2*)(ST + ((cur ^ 1) * 64 + 32 * vt + l31) * S3_LD + 32 * kt + 8 * g + 4 * lh) = o; } }
            if (lat && w < 4) {
                f32x4 o = (f32x4){0.f, 0.f, 0.f, 0.f};
#pragma unroll
                for (int kk = 0; kk < 4; ++kk)
                    o = __builtin_amdgcn_mfma_f32_16x16x32_bf16(*(const bf16x8*)(ST + (cur * 64 + 16 * w + l15) * S3_LD + kk * 32 + 8 * lg4), *(const bf16x8*)(Qs + (blk * 16 + l15) * S3_LD + kk * 32 + 8 * lg4), o, 0, 0, 0);
                bf16x8 va = (bf16x8){0, 0, 0, 0, 0, 0, 0, 0}, pb = va;
                if (lg4 < 2) { va = *(const bf16x8*)(Vs + (16 * w + l15) * S3_LDV + blk * 16 + 8 * lg4); pb = *(const bf16x8*)(Ps + (blk * 16 + l15) * S3_LDT + 8 * lg4); }
                o = __builtin_amdgcn_mfma_f32_16x16x32_bf16(va, pb, o, 0, 0, 0);
                u32x2 ou; ou[0] = pk2(o[0], o[1]); ou[1] = pk2(o[2], o[3]);
                *(u32x2*)(Oo + (tokb + blk * 16 + l15) * 1024 + h * 128 + half * 64 + 16 * w + 4 * lg4) = ou;
            }
            lds_barrier();
        }
    }
    lds_barrier();
#undef S3_T0
#undef S3_LOAD
#undef S3_PREP
}
DEV void readout_item(const Params& p, int item) {
    const int tok = item * 8 + (tidx() >> 6), lane = tidx() & 63;
    const bf16_t* of = (const bf16_t*)(p.ws + WS_F + F_OF) + (size_t)tok * 1024 + lane * 16; const bf16_t* ob = (const bf16_t*)(p.ws + WS_F + F_OB) + (size_t)tok * 1024 + lane * 16;
    const bf16_t* gp = (const bf16_t*)(p.ws + WS_P + P1_G) + (size_t)tok * 1024 + lane * 16;
    const float* on = p.in[I_HGON] + (lane & 7) * 16;
    float o[16], gg[16]; float ss = 0.f;
    { const u32x4 a0 = *(const u32x4*)of, a1 = *(const u32x4*)(of + 8), b0 = *(const u32x4*)ob, b1 = *(const u32x4*)(ob + 8), g0 = *(const u32x4*)gp, g1 = *(const u32x4*)(gp + 8);
#pragma unroll
      for (int i = 0; i < 4; ++i) { o[2 * i] = bflo(a0[i]) + bflo(b0[i]); o[2 * i + 1] = bfhi(a0[i]) + bfhi(b0[i]); o[8 + 2 * i] = bflo(a1[i]) + bflo(b1[i]); o[8 + 2 * i + 1] = bfhi(a1[i]) + bfhi(b1[i]);
          gg[2 * i] = bflo(g0[i]); gg[2 * i + 1] = bfhi(g0[i]); gg[8 + 2 * i] = bflo(g1[i]); gg[8 + 2 * i + 1] = bfhi(g1[i]); } }
#pragma unroll
    for (int i = 0; i < 16; ++i) ss += o[i] * o[i];
    ss += __shfl_xor(ss, 1); ss += __shfl_xor(ss, 2); ss += __shfl_xor(ss, 4);
    const float rstd = rsqrtf(ss * (1.f / 128.f) + 1e-6f);
    bf16_t* M = (bf16_t*)(p.ws + WS_M) + (size_t)tok * 1024 + lane * 16;
    u32x4 o0, o1; float r[16];
#pragma unroll
    for (int i = 0; i < 16; ++i) r[i] = o[i] * rstd * on[i] * gg[i];
#pragma unroll
    for (int i = 0; i < 4; ++i) { o0[i] = pk2(r[2 * i], r[2 * i + 1]); o1[i] = pk2(r[8 + 2 * i], r[8 + 2 * i + 1]); }
    *(u32x4*)M = o0; *(u32x4*)(M + 8) = o1;
}

#ifndef HOST_EMU
#define XB_TMO      128
#define XB_XCNT(j)  (256  + 64 * (j))
#define XB_XSUB(j)  (1280 + 64 * (j))
#define XB_XGEN(j)  (2304 + 64 * (j))
#define XB_TOP      3328
#define XB_TOPGEN   3392
#define XCD_BAR_WORDS 3456
#define XB_SPIN_CAP (1u << 18)
#define LAS __attribute__((address_space(3)))

__device__ __forceinline__ unsigned xb_ld(unsigned* p)              { return __hip_atomic_load(p, __ATOMIC_RELAXED, __HIP_MEMORY_SCOPE_AGENT); }
__device__ __forceinline__ unsigned xb_add(unsigned* p, unsigned v) { return __hip_atomic_fetch_add(p, v, __ATOMIC_RELAXED, __HIP_MEMORY_SCOPE_AGENT); }
__device__ __forceinline__ unsigned xb_xcc_id() { return (unsigned)__builtin_amdgcn_s_getreg((3 << 11) | 20) & 0xFu; }
#define XB_SPIN(cond, bar) do { unsigned _sp = 0; while (cond) { __builtin_amdgcn_s_sleep(1); \
    if ((++_sp & 255u) == 0u) { if (xb_ld(&(bar)[XB_TMO])) break; if (_sp > XB_SPIN_CAP) { atomicAdd(&(bar)[XB_TMO], 1u); break; } } } } while (0)

struct XcdBarrier {
    unsigned* bar; unsigned x;
    volatile LAS unsigned* st;
};

__device__ __forceinline__ XcdBarrier xcd_barrier_post(unsigned* bar, volatile LAS unsigned* st) {
    XcdBarrier b; b.bar = bar; b.x = xb_xcc_id(); b.st = st;
    if (threadIdx.x == 0) (void)xb_add(&bar[XB_XCNT(b.x)], 1u);
    return b;
}
__device__ __forceinline__ void xcd_barrier_complete(unsigned* bar, unsigned x, unsigned& nloc, unsigned& nx) {
    const unsigned G = gridDim.x * gridDim.y * gridDim.z;
    unsigned sum, cnt, mine, sp = 0u;
    for (;;) {
        sum = 0u; cnt = 0u; mine = 0u;
#pragma unroll
        for (unsigned j = 0; j < 16; ++j) { const unsigned c = xb_ld(&bar[XB_XCNT(j)]); sum += c; cnt += (c > 0u) ? 1u : 0u; mine = (j == x) ? c : mine; }
        if (sum == G) break;
        __builtin_amdgcn_s_sleep(1);
        if ((++sp & 255u) == 0u) { if (xb_ld(&bar[XB_TMO])) break; if (sp > XB_SPIN_CAP) { atomicAdd(&bar[XB_TMO], 1u); break; } }
    }
    nloc = mine > 0u ? mine : 1u; nx = cnt > 0u ? cnt : 1u;
}

__device__ __forceinline__ void xcd_barrier(const XcdBarrier& b) {
    asm volatile("s_waitcnt vmcnt(0)" ::: "memory");
    __syncthreads();
    if (threadIdx.x == 0) {
        unsigned* bar = b.bar;
        __builtin_amdgcn_s_waitcnt(0);
        unsigned nloc = b.st[0], nx = b.st[1];
        if (nloc == 0u) { xcd_barrier_complete(bar, b.x, nloc, nx); b.st[0] = nloc; b.st[1] = nx; }
        const unsigned old = xb_add(&bar[XB_XSUB(b.x)], 1u);
        const unsigned gen = old / nloc;
        if (old + 1u == (gen + 1u) * nloc) {
            __builtin_amdgcn_fence(__ATOMIC_RELEASE, "agent");
            asm volatile("s_waitcnt vmcnt(0)" ::: "memory");
            const unsigned og = xb_add(&bar[XB_TOP], 1u);
            const unsigned tg = og / nx;
            if (og + 1u == (tg + 1u) * nx) xb_add(&bar[XB_TOPGEN], 1u);
            else XB_SPIN(xb_ld(&bar[XB_TOPGEN]) == tg, bar);
            __builtin_amdgcn_fence(__ATOMIC_ACQUIRE, "agent");
            xb_add(&bar[XB_XGEN(b.x)], 1u);
            asm volatile("s_waitcnt vmcnt(0)" ::: "memory");
        } else {
            XB_SPIN(xb_ld(&bar[XB_XGEN(b.x)]) == gen, bar);
            __builtin_amdgcn_fence(__ATOMIC_ACQUIRE, "agent");
            asm volatile("s_waitcnt vmcnt(0)" ::: "memory");
        }
    }
    __syncthreads();
}

#endif
#ifdef NOINLINE_PHASES
#define NOINL __device__ __attribute__((noinline))
#else
#define NOINL __device__ __forceinline__
#endif
__shared__ __attribute__((aligned(16))) unsigned char g_smem[SMEM_BYTES + 16];
#define PH_COMMON const int G = gridDim.x, bid = blockIdx.x; unsigned char* smem = g_smem; (void)smem; (void)G; (void)bid; \
    const bf16_t* A = (const bf16_t*)(p.ws + WS_A); const bf16_t* Mx = (const bf16_t*)(p.ws + WS_M); const bf16_t* W = (const bf16_t*)(p.ws + WS_W); (void)A; (void)Mx; (void)W;
NOINL void ph0(const Params& p) { PH_COMMON phase0(p, smem); }
NOINL void ph1(const Params& p) { PH_COMMON phase1(p, smem); }
NOINL void ph2(const Params& p) { PH_COMMON EpiL0In e{p.ws}; for (int t = bid; t < (T / 256) * 18; t += G) gemm_tile(A, W + W_IN0 / 2, (t / 18) * 256, (t % 18) * 128, smem, e); }
NOINL void ph3(const Params& p) { PH_COMMON phase3(p, smem); }
NOINL void ph4(const Params& p) { PH_COMMON EpiRes e{&p, 1, 0, 2048}; for (int t = bid; t < (T / 256) * 8; t += G) gemm_tile(Mx, W + W_OUT0 / 2, (t / 8) * 256, (t % 8) * 128, smem, e); }
NOINL void ph5(const Params& p) { PH_COMMON for (int it = bid; it < T / 8; it += G) norm_rows_item(p, it, 0, p.in[I_N2G], 0, 3072); }
NOINL void ph6(const Params& p) { PH_COMMON EpiBf16 e{(bf16_t*)(p.ws + WS_P), 2048}; for (int t = bid; t < (T / 256) * 16; t += G) gemm_tile(A, W + W_Q0 / 2, (t / 16) * 256, (t % 16) * 128, smem, e); }
NOINL void ph7(const Params& p) { PH_COMMON topk_phase(p, 0, T, smem); }
NOINL void ph8(const Params& p) { PH_COMMON for (int it = bid; it < T / 8; it += G) peer_item(p, 0, it); }
NOINL void ph9(const Params& p) { PH_COMMON EpiHg e{p.ws, p.in[I_HGLB]};
    for (int t = bid; t < (T / 256) * 40; t += G) { const int mt = t / 40, nt = t % 40; if (mt >= TL / 256 && (nt < 8 || nt >= 32)) continue; gemm_tile(A, W + W_IN1 / 2, mt * 256, nt * 128, smem, e); } }
NOINL void ph10(const Params& p, int var = 0) { PH_COMMON for (int bi = bid; bi < NB * 32; bi += G) scan_block(p, bi, smem, var); }
NOINL void ph11(const Params& p) { PH_COMMON for (int it = bid; it < TL / 8; it += G) readout_item(p, it); }
NOINL void ph12(const Params& p) { PH_COMMON EpiRes e{&p, 0, 1, 2048}; for (int t = bid; t < (TL / 256) * 8; t += G) gemm_tile(Mx, W + W_OUT1 / 2, (t / 8) * 256, (t % 8) * 128, smem, e); }
NOINL void ph13(const Params& p) { PH_COMMON for (int it = bid; it < TL / 8; it += G) norm_rows_item(p, it, 0, p.in[I_N2G] + 1024, 1, 3072); }
NOINL void ph14(const Params& p) { PH_COMMON EpiBf16 e{(bf16_t*)(p.ws + WS_P), 2048}; for (int t = bid; t < (TL / 256) * 16; t += G) gemm_tile(A, W + W_Q1 / 2, (t / 16) * 256, (t % 16) * 128, smem, e); }
NOINL void ph15(const Params& p) { PH_COMMON topk_phase(p, 1, TL, smem); }
NOINL void ph16(const Params& p) { PH_COMMON for (int it = bid; it < TL / 8; it += G) peer_item(p, 1, it); }

constexpr int NPHASE = 17;
__global__ void __launch_bounds__(NT, 2) mega(Params p_in) {
    const int ph_lo = p_in.ph_lo, ph_hi = p_in.ph_hi;
#ifndef HOST_EMU
#define GBAR_MAKE() XcdBarrier gbar; gbar.bar = (unsigned*)(p_in.ws + WS_CTRL); gbar.x = xb_xcc_id(); gbar.st = (volatile LAS unsigned*)(LAS unsigned char*)(g_smem + SMEM_BYTES);
    if (ph_hi - ph_lo > 1) {
        volatile LAS unsigned* st = (volatile LAS unsigned*)(LAS unsigned char*)(g_smem + SMEM_BYTES);
        if (threadIdx.x == 0) { st[0] = 0u; st[1] = 0u; }
        __syncthreads();
        (void)xcd_barrier_post((unsigned*)(p_in.ws + WS_CTRL), st);
    }
#endif
    for (int ph = ph_lo; ph < ph_hi; ++ph) {
        if (ph > ph_lo) {
#ifndef HOST_EMU
            { GBAR_MAKE(); xcd_barrier(gbar); }
#endif
        }
#ifndef HOST_EMU
        unsigned long long kp = (unsigned long long)__builtin_amdgcn_kernarg_segment_ptr();
        asm volatile("" : "+s"(kp) :: "memory");
        const Params& p = *(const Params*)(const __attribute__((address_space(4))) Params*)kp;
#else
        const Params& p = p_in;
#endif
#ifdef REPEAT_MASK
        for (int rep_ = ((REPEAT_MASK >> ph) & 1); rep_ >= 0; --rep_) { if (rep_ == 0 && ((REPEAT_MASK >> ph) & 1)) { GBAR_MAKE(); xcd_barrier(gbar); }
#else
        {
#endif
#ifdef ONLY_PHASE
        if (ph != ONLY_PHASE) continue;
        switch (ONLY_PHASE) {
#else
        switch (ph) {
#endif
        case 0: ph0(p); break; case 1: ph1(p); break; case 2: ph2(p); break; case 3: ph3(p); break; case 4: ph4(p); break; case 5: ph5(p); break;
        case 6: ph6(p); break; case 7: ph7(p); break; case 8: ph8(p); break; case 9: ph9(p); break; case 10:
#if defined(REPEAT_MASK) && defined(SCAN_VAR)
            ph10(p, rep_ == 1 ? SCAN_VAR : 0);
#else
            ph10(p);
#endif
            break; case 11: ph11(p); break;
        case 12: ph12(p); break; case 13: ph13(p); break; case 14: ph14(p); break; case 15: ph15(p); break; case 16: ph16(p); break;
        default: break;
        }
        }
    }
}

#ifndef HOST_EMU
extern "C" void kernel_launch(void* const* d_in, const int* in_sizes, int n_in, void* d_out, int out_size, void* d_ws, size_t ws_size, hipStream_t stream) {
    if (n_in != 29 || ws_size < WS_END || out_size != TL * 1024) { fprintf(stderr, "kernel_launch: unexpected sizes (n_in %d, ws %zu need %zu, out %d)\n", n_in, ws_size, (size_t)WS_END, out_size); return; }
    static int grid = 0;
    if (!grid) { int dev = 0, cus = 0; hipGetDevice(&dev); hipDeviceGetAttribute(&cus, hipDeviceAttributeMultiprocessorCount, dev); grid = cus > 0 ? cus : 256; }
    hipMemsetAsync((unsigned char*)d_ws + WS_CTRL, 0, CTRL_BYTES, stream);
    Params p{};
    for (int i = 0; i < 29; ++i) p.in[i] = (const float*)d_in[i];
    p.out = (float*)d_out; p.ws = (unsigned char*)d_ws;
#ifdef MULTI_LAUNCH
    for (int ph = 0; ph < NPHASE; ++ph) { p.ph_lo = ph; p.ph_hi = ph + 1; hipLaunchKernelGGL(mega, dim3(grid), dim3(NT), 0, stream, p); }
#else
    p.ph_lo = 0; p.ph_hi = NPHASE;
    hipLaunchKernelGGL(mega, dim3(grid), dim3(NT), 0, stream, p);
#endif
}
#endif
```

```cpp
#ifndef HOST_EMU
#include <hip/hip_runtime.h>
#include <cstdio>
#endif

#ifndef CFG_B
#define CFG_B 8
#define CFG_L 2048
#define CFG_LC 256
#endif
#define DEV __device__ __forceinline__
#ifndef HOST_EMU
#define SCHED_FENCE() __builtin_amdgcn_sched_barrier(0)
#endif
#ifdef HOST_EMU
#define SCHED_FENCE() do {} while (0)
#define __expf expf
#define __logf logf
#define __sinf sinf
#define __cosf cosf
#endif

typedef unsigned short bf16_t;
typedef short bf16x8 __attribute__((ext_vector_type(8)));
typedef float f32x16 __attribute__((ext_vector_type(16)));
typedef float f32x4 __attribute__((ext_vector_type(4)));
typedef unsigned u32x4 __attribute__((ext_vector_type(4)));
typedef unsigned u32x2 __attribute__((ext_vector_type(2)));
struct cf2 { float x, y; };

constexpr int NB = CFG_B, L = CFG_L, LC = CFG_LC, D = 1024;
constexpr int TL = NB * L, TC = NB * LC, T = TL + TC;
constexpr int NT = 512;
constexpr int NR = NB + 1;
constexpr int log4ceil(int n) { int s = 0, v = 1; while (v < n) { v *= 4; ++s; } return s; }
constexpr int FS_LAT = log4ceil(2 * L - 1), FS_CTX = log4ceil(2 * LC - 1);
constexpr int NF_LAT = 1 << (2 * FS_LAT), NF_CTX = 1 << (2 * FS_CTX);
static_assert(T % 256 == 0 && TL % 256 == 0 && L % 128 == 0 && LC % 128 == 0 && NB % 2 == 0, "shape");

constexpr size_t al256(size_t x) { return (x + 255) & ~(size_t)255; }
constexpr size_t WS_CTRL = 0, CTRL_BYTES = 65536;
constexpr size_t CTRL_HYNORM = 4096;
constexpr size_t WS_MOD = WS_CTRL + CTRL_BYTES;
constexpr size_t WS_H = al256(WS_MOD + (size_t)2 * NR * 6144 * 4);
constexpr size_t WS_A = al256(WS_H + (size_t)T * 1024 * 4);
constexpr size_t WS_P = al256(WS_A + (size_t)T * 1024 * 2);
constexpr size_t P_BYTES = (size_t)T * 5120 * 2;
constexpr size_t P_HYT_LAT = 0;
constexpr size_t P_HYT_CTX = P_HYT_LAT + (size_t)NB * 1536 * L * 2;
constexpr size_t P_Q0 = P_HYT_CTX + (size_t)NB * 1536 * LC * 2;
constexpr size_t P_K0 = P_Q0 + (size_t)T * 512 * 2;
constexpr size_t P_VT_LAT = P_K0 + (size_t)T * 128 * 2;
constexpr size_t P_VT_CTX = P_VT_LAT + (size_t)NB * 128 * L * 2;
static_assert(P_VT_CTX + (size_t)NB * 128 * LC * 2 <= P_BYTES, "P region");
constexpr size_t P1_KQT_LAT = 0;
constexpr size_t P1_KQT_CTX = P1_KQT_LAT + (size_t)NB * 3072 * L * 2;
constexpr size_t P1_G = P1_KQT_CTX + (size_t)NB * 3072 * LC * 2;
static_assert(P1_G + (size_t)TL * 1024 * 2 <= P_BYTES, "P region (layer 1)");
constexpr size_t WS_M = al256(WS_P + P_BYTES);
constexpr size_t WS_IDX = al256(WS_M + (size_t)T * 1024 * 2);
constexpr size_t WS_GATE = al256(WS_IDX + (size_t)T * 128 * 4);
constexpr size_t WS_T8 = al256(WS_GATE + (size_t)T * 128 * 4);
constexpr size_t WS_S8 = WS_T8 + (size_t)4 * 16384 * 1024;
constexpr size_t WS_W = al256(WS_S8 + (size_t)4 * 16384 * 4);
constexpr size_t W_IN0 = 0, W_OUT0 = W_IN0 + (size_t)2304 * 1024 * 2, W_IN1 = W_OUT0 + (size_t)1024 * 1024 * 2,
                 W_OUT1 = W_IN1 + (size_t)5120 * 1024 * 2, W_Q0 = W_OUT1 + (size_t)1024 * 1024 * 2, W_Q1 = W_Q0 + (size_t)2048 * 1024 * 2,
                 W_KEYS = W_Q1 + (size_t)2048 * 1024 * 2, W_BYTES = W_KEYS + (size_t)2 * 8 * 2 * 128 * 128 * 2;
constexpr size_t WS_F = al256(WS_W + W_BYTES);
constexpr size_t F_HRAW_LAT = 0;
constexpr size_t F_HRAW_CTX = F_HRAW_LAT + (size_t)2048 * L * 4;
constexpr size_t F_HF_LAT = F_HRAW_CTX + (size_t)2048 * LC * 4;
constexpr size_t F_HF_CTX = F_HF_LAT + (size_t)1024 * NF_LAT * 8;
constexpr size_t F_HYP_LAT = F_HF_CTX + (size_t)1024 * NF_CTX * 8;
constexpr size_t F_HYP_CTX = F_HYP_LAT + (size_t)(L / 64) * 2048 * 4;
constexpr size_t F_END = F_HYP_CTX + (size_t)(LC / 64) * 2048 * 4;
constexpr size_t F_OF = 0, F_OB = (size_t)TL * 1024 * 2;
constexpr size_t F_BYTES = F_END > 2 * F_OB ? F_END : 2 * F_OB;
constexpr size_t WS_END = al256(WS_F + F_BYTES);

struct Params { const float* in[29]; float* out; unsigned char* ws; int ph_lo, ph_hi; };
enum { I_X = 0, I_C, I_CTX, I_CCTX, I_ADAW, I_ADAB, I_N1G, I_N2G, I_FG, I_ABWIN, I_ABWOUT, I_HYCW, I_HYCB, I_HYW1, I_HYB1, I_HYW2, I_HYB2, I_HYW3,
       I_HYFREQ, I_HYSKIP, I_SINK, I_HGWIN, I_HGWOUT, I_HGLB, I_HGON, I_PWQ, I_PKEYS, I_PU, I_PV };

constexpr int SMEM_BYTES = 147456;

#ifndef HOST_EMU
DEV int tidx() { int t = threadIdx.x; asm volatile("" : "+v"(t)); return t; }
#else
DEV int tidx() { return (int)threadIdx.x; }
#endif
#ifndef HOST_EMU
DEV void lds_barrier() { asm volatile("s_waitcnt lgkmcnt(0)" ::: "memory"); __builtin_amdgcn_s_barrier(); asm volatile("" ::: "memory"); }
#else
DEV void lds_barrier() { __syncthreads(); }
#endif
#ifndef HOST_EMU
typedef __bf16 bf16n2 __attribute__((ext_vector_type(2)));
DEV unsigned pk2(float lo, float hi) { bf16n2 v; v[0] = (__bf16)lo; v[1] = (__bf16)hi; return __builtin_bit_cast(unsigned, v); }
DEV unsigned f2bf(float f) { return (unsigned)__builtin_bit_cast(unsigned short, (__bf16)f); }
#else
DEV unsigned f2bf(float f) { unsigned u = __builtin_bit_cast(unsigned, f); return (u + 0x7fffu + ((u >> 16) & 1u)) >> 16; }
DEV unsigned pk2(float lo, float hi) { return f2bf(lo) | (f2bf(hi) << 16); }
#endif
DEV float bf2f(unsigned h) { return __builtin_bit_cast(float, (h & 0xffffu) << 16); }
DEV float bflo(unsigned u) { return __builtin_bit_cast(float, u << 16); }
DEV float bfhi(unsigned u) { return __builtin_bit_cast(float, u & 0xffff0000u); }
DEV float silu_f(float x) { return x / (1.f + __expf(-x)); }
DEV float sigmoid_f(float x) { return 1.f / (1.f + __expf(-x)); }
DEV float wave_sum(float v) {
#pragma unroll
    for (int m = 32; m >= 1; m >>= 1) v += __shfl_xor(v, m);
    return v;
}
DEV int mod_row(int tok) { return tok < TL ? tok / L : NB; }

DEV void p0_mod(const Params& p, int item, unsigned char* smem) {
    const int l = item / 96, col0 = (item % 96) * 64, tid = tidx();
    float* sc = (float*)smem;
    float* red = sc + NR * 1024;
    for (int i = tid; i < NR * 1024; i += NT) { const int r = i >> 10, k = i & 1023; const float c = r < NB ? p.in[I_C][r * 1024 + k] : p.in[I_CCTX][k]; sc[i] = c / (1.f + expf(-c)); }
    __syncthreads();
    const int kq = tid >> 6, col = tid & 63;
    float acc[NR];
#pragma unroll
    for (int r = 0; r < NR; ++r) acc[r] = 0.f;
    const float* w = p.in[I_ADAW] + (size_t)l * 1024 * 6144 + col0 + col;
#pragma unroll 16
    for (int k = kq * 128; k < kq * 128 + 128; ++k) {
        const float wv = w[(size_t)k * 6144];
#pragma unroll
        for (int r = 0; r < NR; ++r) acc[r] += sc[r * 1024 + k] * wv;
    }
#pragma unroll
    for (int r = 0; r < NR; ++r) red[(kq * NR + r) * 64 + col] = acc[r];
    __syncthreads();
    float* mod = (float*)(p.ws + WS_MOD);
    for (int i = tid; i < NR * 64; i += NT) {
        const int r = i >> 6, c = i & 63; float s = 0.f;
        for (int q = 0; q < 8; ++q) s += red[(q * NR + r) * 64 + c];
        mod[((size_t)l * NR + r) * 6144 + col0 + c] = s + p.in[I_ADAB][l * 6144 + col0 + c];
    }
    __syncthreads();
}
DEV void p0_transpose(const float* W, bf16_t* Wt, int N, int tile, unsigned char* smem) {
    float* ts = (float*)smem;
    const int ntn = N / 64, kt = tile / ntn, nt = tile % ntn, k0 = kt * 64, n0 = nt * 64, tid = tidx();
    float rv[8];
#pragma unroll
    for (int m = 0; m < 8; ++m) { const int i = tid + NT * m, kk = i >> 6, nn = i & 63; rv[m] = W[(size_t)(k0 + kk) * N + n0 + nn]; }
#pragma unroll
    for (int m = 0; m < 8; ++m) { const int i = tid + NT * m, kk = i >> 6, nn = i & 63; ts[kk * 65 + nn] = rv[m]; }
    __syncthreads();
#pragma unroll
    for (int m = 0; m < 8; ++m) { const int i = tid + NT * m, nn = i >> 6, kk = i & 63; Wt[(size_t)(n0 + nn) * 1024 + k0 + kk] = (bf16_t)f2bf(ts[kk * 65 + nn]); }
    __syncthreads();
}
DEV void p0_convert(const float* src, bf16_t* dst, int item) {
    const int tid = tidx();
#pragma unroll
    for (int i = 0; i < 8; ++i) {
        const size_t e = (size_t)item * 16384 + (size_t)(i * NT + tid) * 4;
        const f32x4 v = *(const f32x4*)(src + e);
        u32x2 o; o[0] = pk2(v[0], v[1]); o[1] = pk2(v[2], v[3]);
        *(u32x2*)(dst + e) = o;
    }
}
DEV void p0_table8(const Params& p, int tab, int item) {
    const int row0 = item * 32 + (tidx() >> 6), lane = tidx() & 63;
    const float* src = (tab & 1 ? p.in[I_PV] : p.in[I_PU]) + ((size_t)(tab >> 1) * 16384 + row0) * 1024 + lane * 16;
    f32x4 v[4][4];
#pragma unroll
    for (int r = 0; r < 4; ++r)
#pragma unroll
        for (int i = 0; i < 4; ++i) v[r][i] = *(const f32x4*)(src + (size_t)r * 8 * 1024 + 4 * i);
#pragma unroll
    for (int r = 0; r < 4; ++r) {
        float mx = 0.f;
#pragma unroll
        for (int i = 0; i < 4; ++i) mx = fmaxf(mx, fmaxf(fmaxf(fabsf(v[r][i][0]), fabsf(v[r][i][1])), fmaxf(fabsf(v[r][i][2]), fabsf(v[r][i][3]))));
#pragma unroll
        for (int m = 32; m >= 1; m >>= 1) mx = fmaxf(mx, __shfl_xor(mx, m));
        const float sc = mx > 0.f ? 240.f / mx : 1.f;
        u32x4 o;
#pragma unroll
        for (int i = 0; i < 4; ++i) { int w = __builtin_amdgcn_cvt_pk_fp8_f32(v[r][i][0] * sc, v[r][i][1] * sc, 0, false); w = __builtin_amdgcn_cvt_pk_fp8_f32(v[r][i][2] * sc, v[r][i][3] * sc, w, true); o[i] = (unsigned)w; }
        const int row = row0 + r * 8;
        *(u32x4*)(p.ws + WS_T8 + ((size_t)tab * 16384 + row) * 1024 + lane * 16) = o;
        if (lane == 0) ((float*)(p.ws + WS_S8))[tab * 16384 + row] = mx > 0.f ? mx * (1.f / 240.f) : 1.f;
    }
}
DEV void p0_filter(const Params& p, int set, int chunk, unsigned char* smem) {
    const int Ls = set ? LC : L, l0 = chunk * 64, tid = tidx();
    float* z = (float*)smem;
    float* hd1 = z + 64 * 34;
    float* hd2 = hd1 + 64 * 65;
    const float* w1 = p.in[I_HYW1]; const float* b1 = p.in[I_HYB1]; const float* w2 = p.in[I_HYW2]; const float* b2 = p.in[I_HYB2];
    const float* w3 = p.in[I_HYW3]; const float* fq = p.in[I_HYFREQ];
    for (int i = tid; i < 64 * 33; i += NT) {
        const int pp = i / 33, f = i % 33, l = l0 + pp; float val;
        if (f == 0) val = (float)l / (float)(Ls - 1);
        else { const int jb = (f - 1) & 15; const float fj = 1e-4f + (float)jb * ((15.f - 1e-4f) / 15.f); const float a = fj * (6.283185307179586f * (float)l / (float)Ls); val = f <= 16 ? __cosf(a) : -__sinf(a); }
        z[pp * 34 + f] = val;
    }
    __syncthreads();
    {
        const int j = tid & 63, p0 = tid >> 6;
        float wc[64], acc[8];
#pragma unroll
        for (int f = 0; f < 33; ++f) wc[f] = w1[f * 64 + j];
#pragma unroll
        for (int m = 0; m < 8; ++m) { float sacc = b1[j];
#pragma unroll
            for (int f = 0; f < 33; ++f) sacc = fmaf(z[(p0 + 8 * m) * 34 + f], wc[f], sacc);
            acc[m] = sacc; }
#pragma unroll
        for (int m = 0; m < 8; ++m) hd1[(p0 + 8 * m) * 65 + j] = __sinf(fq[j] * acc[m]);
        __syncthreads();
#pragma unroll
        for (int f = 0; f < 64; ++f) wc[f] = w2[f * 64 + j];
#pragma unroll
        for (int m = 0; m < 8; ++m) { float sacc = b2[j];
#pragma unroll
            for (int f = 0; f < 64; ++f) sacc = fmaf(hd1[(p0 + 8 * m) * 65 + f], wc[f], sacc);
            acc[m] = sacc; }
#pragma unroll
        for (int m = 0; m < 8; ++m) hd2[(p0 + 8 * m) * 65 + j] = __sinf(fq[j] * acc[m]);
        __syncthreads();
    }
    const float max_decay = -15.350567286626973f, min_decay = -3.0701134573253945f;
    float* hraw = (float*)(p.ws + WS_F + (set ? F_HRAW_CTX : F_HRAW_LAT));
    float* hyn = (float*)(p.ws + WS_F + (set ? F_HYP_CTX : F_HYP_LAT)) + (size_t)chunk * 2048;
    for (int cb = 0; cb < 4; ++cb) {
        const int o = cb * NT + tid;
        const int c = o & 511; const float delta = fabsf(min_decay + (float)c * ((max_decay - min_decay) / 511.f));
        float asum = 0.f;
        float* dst = hraw + (size_t)o * Ls + l0;
        for (int ph = 0; ph < 2; ++ph) {
            float acc[32];
#pragma unroll
            for (int pp = 0; pp < 32; ++pp) acc[pp] = 0.f;
#pragma unroll 1
            for (int j0 = 0; j0 < 64; j0 += 16) {
                float wv[16];
#pragma unroll
                for (int j = 0; j < 16; ++j) wv[j] = w3[(j0 + j) * 2048 + o];
#pragma unroll
                for (int j = 0; j < 16; ++j) {
#pragma unroll
                    for (int pp = 0; pp < 32; ++pp) acc[pp] = fmaf(hd2[(ph * 32 + pp) * 65 + j0 + j], wv[j], acc[pp]);
                    SCHED_FENCE();
                }
            }
#pragma unroll
            for (int q4 = 0; q4 < 8; ++q4) {
                f32x4 v;
#pragma unroll
                for (int e = 0; e < 4; ++e) { const int pp = q4 * 4 + e; const float tl = (float)(l0 + ph * 32 + pp) / (float)(Ls - 1); const float val = acc[pp] * expf(-tl * delta); v[e] = val; asum += fabsf(val); }
                *(f32x4*)(dst + ph * 32 + q4 * 4) = v;
            }
        }
        hyn[o] = asum;
    }
    __syncthreads();
}

constexpr int P0_MOD = 192, P0_TR_IN0 = 16 * 36, P0_TR_OUT0 = 256, P0_TR_IN1 = 16 * 80, P0_TR_OUT1 = 256, P0_TR_Q = 16 * 32, P0_KEYS = 32, P0_TAB = 512,
              P0_FILT = L / 64 + LC / 64;
DEV void phase0(const Params& p, unsigned char* smem) {
    bf16_t* W = (bf16_t*)(p.ws + WS_W);
    const int total = P0_MOD + P0_FILT + P0_TR_IN0 + P0_TR_OUT0 + P0_TR_IN1 + P0_TR_OUT1 + 2 * P0_TR_Q + P0_KEYS + 4 * P0_TAB;
    for (int it = blockIdx.x; it < total; it += gridDim.x) {
        int i = it;
        if (i < P0_MOD) { p0_mod(p, i, smem); continue; } i -= P0_MOD;
        if (i < P0_FILT) { if (i < L / 64) p0_filter(p, 0, i, smem); else p0_filter(p, 1, i - L / 64, smem); continue; } i -= P0_FILT;
        if (i < P0_TR_IN0) { p0_transpose(p.in[I_ABWIN], W + W_IN0 / 2, 2304, i, smem); continue; } i -= P0_TR_IN0;
        if (i < P0_TR_OUT0) { p0_transpose(p.in[I_ABWOUT], W + W_OUT0 / 2, 1024, i, smem); continue; } i -= P0_TR_OUT0;
        if (i < P0_TR_IN1) { p0_transpose(p.in[I_HGWIN], W + W_IN1 / 2, 5120, i, smem); continue; } i -= P0_TR_IN1;
        if (i < P0_TR_OUT1) { p0_transpose(p.in[I_HGWOUT], W + W_OUT1 / 2, 1024, i, smem); continue; } i -= P0_TR_OUT1;
        if (i < P0_TR_Q) { p0_transpose(p.in[I_PWQ], W + W_Q0 / 2, 2048, i, smem); continue; } i -= P0_TR_Q;
        if (i < P0_TR_Q) { p0_transpose(p.in[I_PWQ] + (size_t)1024 * 2048, W + W_Q1 / 2, 2048, i, smem); continue; } i -= P0_TR_Q;
        if (i < P0_KEYS) { p0_convert(p.in[I_PKEYS], W + W_KEYS / 2, i); continue; } i -= P0_KEYS;
        p0_table8(p, i / P0_TAB, i % P0_TAB);
    }
}

DEV const float* h_row(const Params& p, int layer_src_inputs, int tok) {
    if (layer_src_inputs) return tok < TL ? p.in[I_X] + (size_t)tok * 1024 : p.in[I_CTX] + (size_t)(tok - TL) * 1024;
    return (const float*)(p.ws + WS_H) + (size_t)tok * 1024;
}
DEV void norm_row_store(const Params& p, const f32x4 (&v)[4], int tok, const float* g, int layer, int sh_off, int lane) {
    float ss = 0.f;
#pragma unroll
    for (int i = 0; i < 4; ++i) ss += v[i][0] * v[i][0] + v[i][1] * v[i][1] + v[i][2] * v[i][2] + v[i][3] * v[i][3];
    ss = wave_sum(ss);
    const float rstd = rsqrtf(ss * (1.f / 1024.f) + 1e-6f);
    const float* mod = (const float*)(p.ws + WS_MOD) + ((size_t)layer * NR + mod_row(tok)) * 6144 + sh_off;
    bf16_t* A = (bf16_t*)(p.ws + WS_A) + (size_t)tok * 1024;
#pragma unroll
    for (int i = 0; i < 4; ++i) {
        const int c = i * 256 + lane * 4;
        const f32x4 gg = *(const f32x4*)(g + c), sh = *(const f32x4*)(mod + c), sc = *(const f32x4*)(mod + 1024 + c);
        u32x2 o;
        o[0] = pk2(v[i][0] * rstd * gg[0] * (1.f + sc[0]) + sh[0], v[i][1] * rstd * gg[1] * (1.f + sc[1]) + sh[1]);
        o[1] = pk2(v[i][2] * rstd * gg[2] * (1.f + sc[2]) + sh[2], v[i][3] * rstd * gg[3] * (1.f + sc[3]) + sh[3]);
        *(u32x2*)(A + c) = o;
    }
}
DEV void norm_rows_item(const Params& p, int item, int from_inputs, const float* g, int layer, int sh_off) {
    const int tok = item * 8 + (tidx() >> 6), lane = tidx() & 63;
    const float* src = h_row(p, from_inputs, tok);
    f32x4 v[4];
#pragma unroll
    for (int i = 0; i < 4; ++i) v[i] = *(const f32x4*)(src + i * 256 + lane * 4);
    norm_row_store(p, v, tok, g, layer, sh_off, lane);
}

DEV cf2 cmul(cf2 a, cf2 b) { cf2 r; r.x = a.x * b.x - a.y * b.y; r.y = a.x * b.y + a.y * b.x; return r; }
DEV cf2 twid(int k, float invN) { cf2 r; const float a = (float)k * invN; r.x = __builtin_amdgcn_cosf(a); r.y = -__builtin_amdgcn_sinf(a); return r; }
DEV int fsw(int i) { return i ^ ((i >> 4) & 15) ^ (((i >> 8) & 1) << 4); }
DEV void bfly4_fwd(cf2& a0, cf2& a1, cf2& a2, cf2& a3) {
    cf2 t0, t1, t2, t3; t0.x = a0.x + a2.x; t0.y = a0.y + a2.y; t1.x = a0.x - a2.x; t1.y = a0.y - a2.y; t2.x = a1.x + a3.x; t2.y = a1.y + a3.y;
    const float dx = a1.x - a3.x, dy = a1.y - a3.y; t3.x = dy; t3.y = -dx;
    a0.x = t0.x + t2.x; a0.y = t0.y + t2.y; a1.x = t1.x + t3.x; a1.y = t1.y + t3.y; a2.x = t0.x - t2.x; a2.y = t0.y - t2.y; a3.x = t1.x - t3.x; a3.y = t1.y - t3.y;
}
DEV void bfly4_inv(cf2& c0, cf2& c1, cf2& c2, cf2& c3) {
    cf2 t0, t1, t2, t3; t0.x = c0.x + c2.x; t0.y = c0.y + c2.y; t1.x = c0.x - c2.x; t1.y = c0.y - c2.y; t2.x = c1.x + c3.x; t2.y = c1.y + c3.y;
    const float dx = c1.x - c3.x, dy = c1.y - c3.y; t3.x = -dy; t3.y = dx;
    c0.x = t0.x + t2.x; c0.y = t0.y + t2.y; c1.x = t1.x + t3.x; c1.y = t1.y + t3.y; c2.x = t0.x - t2.x; c2.y = t0.y - t2.y; c3.x = t1.x - t3.x; c3.y = t1.y - t3.y;
}
DEV void fft_stage4(cf2* buf, int S, int s, int g, int G, bool inv) {
    const int N = 1 << (2 * S); const float invN = 1.f / (float)N;
    const int lm = 2 * (S - s), m = 1 << lm, q = m >> 2;
    for (int bf = g; bf < (N >> 2); bf += G) {
        const int j = bf & (q - 1), base = ((bf >> (lm - 2)) << lm) + j, tw = j << (2 * s);
        cf2 a0 = buf[fsw(base)], a1 = buf[fsw(base + q)], a2 = buf[fsw(base + 2 * q)], a3 = buf[fsw(base + 3 * q)];
        if (!inv) { bfly4_fwd(a0, a1, a2, a3); a1 = cmul(a1, twid(tw, invN)); a2 = cmul(a2, twid(2 * tw, invN)); a3 = cmul(a3, twid(3 * tw, invN)); }
        else { cf2 w1 = twid(tw, invN), w2 = twid(2 * tw, invN), w3 = twid(3 * tw, invN); w1.y = -w1.y; w2.y = -w2.y; w3.y = -w3.y; a1 = cmul(a1, w1); a2 = cmul(a2, w2); a3 = cmul(a3, w3); bfly4_inv(a0, a1, a2, a3); }
        buf[fsw(base)] = a0; buf[fsw(base + q)] = a1; buf[fsw(base + 2 * q)] = a2; buf[fsw(base + 3 * q)] = a3;
    }
}
DEV void fft_stage16(cf2* buf, int S, int s, int g, int G, bool inv) {
    const int N = 1 << (2 * S); const float invN = 1.f / (float)N;
    const int lm = 2 * (S - s), m = 1 << lm, q = m >> 2, q2 = q >> 2;
    for (int u = g; u < (N >> 4); u += G) {
        const int j2 = u & (q2 - 1), base = ((u >> (lm - 4)) << lm) + j2;
        cf2 x[4][4];
#pragma unroll
        for (int c = 0; c < 4; ++c)
#pragma unroll
            for (int c2 = 0; c2 < 4; ++c2) x[c][c2] = buf[fsw(base + c * q + c2 * q2)];
        if (!inv) {
#pragma unroll
            for (int c2 = 0; c2 < 4; ++c2) {
                const int tw = (j2 + c2 * q2) << (2 * s);
                bfly4_fwd(x[0][c2], x[1][c2], x[2][c2], x[3][c2]);
                x[1][c2] = cmul(x[1][c2], twid(tw, invN)); x[2][c2] = cmul(x[2][c2], twid(2 * tw, invN)); x[3][c2] = cmul(x[3][c2], twid(3 * tw, invN));
            }
            const int tw2 = j2 << (2 * (s + 1));
            const cf2 v1 = twid(tw2, invN), v2 = twid(2 * tw2, invN), v3 = twid(3 * tw2, invN);
#pragma unroll
            for (int c = 0; c < 4; ++c) {
                bfly4_fwd(x[c][0], x[c][1], x[c][2], x[c][3]);
                x[c][1] = cmul(x[c][1], v1); x[c][2] = cmul(x[c][2], v2); x[c][3] = cmul(x[c][3], v3);
            }
        } else {
            const int tw2 = j2 << (2 * (s + 1));
            cf2 v1 = twid(tw2, invN), v2 = twid(2 * tw2, invN), v3 = twid(3 * tw2, invN); v1.y = -v1.y; v2.y = -v2.y; v3.y = -v3.y;
#pragma unroll
            for (int c = 0; c < 4; ++c) {
                x[c][1] = cmul(x[c][1], v1); x[c][2] = cmul(x[c][2], v2); x[c][3] = cmul(x[c][3], v3);
                bfly4_inv(x[c][0], x[c][1], x[c][2], x[c][3]);
            }
#pragma unroll
            for (int c2 = 0; c2 < 4; ++c2) {
                const int tw = (j2 + c2 * q2) << (2 * s);
                cf2 w1 = twid(tw, invN), w2 = twid(2 * tw, invN), w3 = twid(3 * tw, invN); w1.y = -w1.y; w2.y = -w2.y; w3.y = -w3.y;
                x[1][c2] = cmul(x[1][c2], w1); x[2][c2] = cmul(x[2][c2], w2); x[3][c2] = cmul(x[3][c2], w3);
                bfly4_inv(x[0][c2], x[1][c2], x[2][c2], x[3][c2]);
            }
        }
#pragma unroll
        for (int c = 0; c < 4; ++c)
#pragma unroll
            for (int c2 = 0; c2 < 4; ++c2) buf[fsw(base + c * q + c2 * q2)] = x[c][c2];
    }
}
DEV void fft_fwd(cf2* buf, int S, int g, int G) {
    int s = 0;
    for (; s + 1 < S; s += 2) { fft_stage16(buf, S, s, g, G, false); __syncthreads(); }
    if (s < S) { fft_stage4(buf, S, s, g, G, false); __syncthreads(); }
}
DEV void fft_inv(cf2* buf, int S, int g, int G) {
    int s = S - 1;
    if (S & 1) { fft_stage4(buf, S, s, g, G, true); __syncthreads(); --s; }
    for (; s >= 1; s -= 2) { fft_stage16(buf, S, s - 1, g, G, true); __syncthreads(); }
}
DEV void hf_item(const Params& p, int set, int pi, unsigned char* smem) {
    const int Ls = set ? LC : L, S = set ? FS_CTX : FS_LAT, N = 1 << (2 * S);
    const int gi = tidx() >> 8, g = tidx() & 255, idx = pi * 2 + gi, o = idx >> 9, c = idx & 511;
    cf2* buf = (cf2*)smem + (size_t)gi * N;
    const float* hraw = (const float*)(p.ws + WS_F + (set ? F_HRAW_CTX : F_HRAW_LAT));
    const float* hyn = (const float*)(p.ws + WS_F + (set ? F_HYP_CTX : F_HYP_LAT));
    float nsum = 0.f;
    for (int ch = 0; ch < Ls / 64; ++ch) nsum += hyn[(size_t)ch * 2048 + o * 1024 + c] + hyn[(size_t)ch * 2048 + o * 1024 + 512 + c];
    const float inv = 1.f / nsum;
    const float* hf = hraw + (size_t)(o * 1024 + c) * Ls; const float* hb = hraw + (size_t)(o * 1024 + 512 + c) * Ls;
#pragma unroll 4
    for (int k = g; k < N; k += 256) { float re = 0.f; if (k < Ls) re = hf[k] * inv; else if (k > N - Ls) re = hb[N - k] * inv; cf2 v; v.x = re; v.y = 0.f; buf[fsw(k)] = v; }
    __syncthreads();
    fft_fwd(buf, S, g, 256);
    cf2* HF = (cf2*)(p.ws + WS_F + (set ? F_HF_CTX : F_HF_LAT)) + (size_t)(o * 512 + c) * N;
    for (int k = g; k < N; k += 256) HF[k] = buf[fsw(k)];
    __syncthreads();
}
constexpr int P1_NORM = T / 8, P1_HF = 512;
DEV void phase1(const Params& p, unsigned char* smem) {
    const int total = P1_NORM + 2 * P1_HF;
    for (int it = blockIdx.x; it < total; it += gridDim.x) {
        if (it < P1_NORM) norm_rows_item(p, it, 1, p.in[I_N1G], 0, 0);
        else if (it < P1_NORM + P1_HF) hf_item(p, 0, it - P1_NORM, smem);
        else hf_item(p, 1, it - P1_NORM - P1_HF, smem);
    }
}

constexpr int G_LDA = 72;
template <class Epi>
DEV void gemm_tile(const bf16_t* __restrict__ A, const bf16_t* __restrict__ Wt, int m0, int n0, unsigned char* smem, const Epi& epi, int var = 0) {
    bf16_t* As = (bf16_t*)smem;
    bf16_t* Bs = As + 2 * 256 * G_LDA;
    const int tid = tidx(), lane = tid & 63, w = tid >> 6, wm = w >> 1, wn = w & 1;
    f32x16 acc[2][2];
#pragma unroll
    for (int i = 0; i < 2; ++i)
#pragma unroll
        for (int j = 0; j < 2; ++j)
#pragma unroll
            for (int r = 0; r < 16; ++r) acc[i][j][r] = 0.f;
    u32x4 ra[4], rb[2];
    const bf16_t* Ag = A + (size_t)m0 * 1024; const bf16_t* Bg = Wt + (size_t)n0 * 1024;
#define GLOAD(k0) do { \
        _Pragma("unroll") for (int i = 0; i < 4; ++i) { const int id = tid + NT * i, row = id >> 3, kc = id & 7; ra[i] = *(const u32x4*)(Ag + (size_t)row * 1024 + (k0) + kc * 8); } \
        _Pragma("unroll") for (int i = 0; i < 2; ++i) { const int id = tid + NT * i, row = id >> 3, kc = id & 7; rb[i] = *(const u32x4*)(Bg + (size_t)row * 1024 + (k0) + kc * 8); } } while (0)
#define LSTORE(buf_) do { \
        _Pragma("unroll") for (int i = 0; i < 4; ++i) { const int id = tid + NT * i, row = id >> 3, kc = id & 7; *(u32x4*)(As + ((buf_) * 256 + row) * G_LDA + kc * 8) = ra[i]; } \
        _Pragma("unroll") for (int i = 0; i < 2; ++i) { const int id = tid + NT * i, row = id >> 3, kc = id & 7; *(u32x4*)(Bs + ((buf_) * 128 + row) * G_LDA + kc * 8) = rb[i]; } } while (0)
    GLOAD(0); LSTORE(0); __syncthreads();
    for (int kt = 0; kt < (var == 2 ? 1 : 16); ++kt) {
        const int buf = kt & 1;
        if (kt + 1 < 16) GLOAD((kt + 1) * 64);
        const bf16_t* as = As + (buf * 256 + wm * 64 + (lane & 31)) * G_LDA + 8 * (lane >> 5);
        const bf16_t* bs = Bs + (buf * 128 + wn * 64 + (lane & 31)) * G_LDA + 8 * (lane >> 5);
#pragma unroll
        for (int kk = 0; kk < 4; ++kk) {
            const bf16x8 a0 = *(const bf16x8*)(as + kk * 16), a1 = *(const bf16x8*)(as + 32 * G_LDA + kk * 16);
            const bf16x8 b0 = *(const bf16x8*)(bs + kk * 16), b1 = *(const bf16x8*)(bs + 32 * G_LDA + kk * 16);
            acc[0][0] = __builtin_amdgcn_mfma_f32_32x32x16_bf16(a0, b0, acc[0][0], 0, 0, 0);
            acc[0][1] = __builtin_amdgcn_mfma_f32_32x32x16_bf16(a0, b1, acc[0][1], 0, 0, 0);
            acc[1][0] = __builtin_amdgcn_mfma_f32_32x32x16_bf16(a1, b0, acc[1][0], 0, 0, 0);
            acc[1][1] = __builtin_amdgcn_mfma_f32_32x32x16_bf16(a1, b1, acc[1][1], 0, 0, 0);
        }
        if (kt + 1 < 16) LSTORE(buf ^ 1);
        __syncthreads();
    }
#ifndef HOST_EMU
    if (var == 1) { asm volatile("" :: "v"(acc[0][0]), "v"(acc[0][1]), "v"(acc[1][0]), "v"(acc[1][1])); return; }
#endif
#pragma unroll
    for (int mi = 0; mi < 2; ++mi)
#pragma unroll
        for (int ni = 0; ni < 2; ++ni)
#pragma unroll
            for (int rg = 0; rg < 4; ++rg) {
                const int row = m0 + wm * 64 + mi * 32 + 8 * rg + 4 * (lane >> 5), col = n0 + wn * 64 + ni * 32 + (lane & 31);
                epi(row, col, acc[mi][ni][rg * 4 + 0], acc[mi][ni][rg * 4 + 1], acc[mi][ni][rg * 4 + 2], acc[mi][ni][rg * 4 + 3]);
            }
}
template <class Epi>
DEV void gemm_tile256(const bf16_t* __restrict__ A, const bf16_t* __restrict__ Wt, int m0, int n0, unsigned char* smem, const Epi& epi) {
    bf16_t* As = (bf16_t*)smem;
    bf16_t* Bs = As + 2 * 256 * G_LDA;
    const int tid = tidx(), lane = tid & 63, w = tid >> 6, wm = w >> 2, wn = w & 3;
    f32x16 acc[4][2];
#pragma unroll
    for (int i = 0; i < 4; ++i)
#pragma unroll
        for (int j = 0; j < 2; ++j)
#pragma unroll
            for (int r = 0; r < 16; ++r) acc[i][j][r] = 0.f;
    u32x4 ra[4], rb[4];
    const bf16_t* Ag = A + (size_t)m0 * 1024; const bf16_t* Bg = Wt + (size_t)n0 * 1024;
#define GLOAD2(k0) do { \
        _Pragma("unroll") for (int i = 0; i < 4; ++i) { const int id = tid + NT * i, row = id >> 3, kc = id & 7; ra[i] = *(const u32x4*)(Ag + (size_t)row * 1024 + (k0) + kc * 8); rb[i] = *(const u32x4*)(Bg + (size_t)row * 1024 + (k0) + kc * 8); } } while (0)
#define LSTORE2(buf_) do { \
        _Pragma("unroll") for (int i = 0; i < 4; ++i) { const int id = tid + NT * i, row = id >> 3, kc = id & 7; *(u32x4*)(As + ((buf_) * 256 + row) * G_LDA + kc * 8) = ra[i]; *(u32x4*)(Bs + ((buf_) * 256 + row) * G_LDA + kc * 8) = rb[i]; } } while (0)
    GLOAD2(0); LSTORE2(0); __syncthreads();
    for (int kt = 0; kt < 16; ++kt) {
        const int buf = kt & 1;
        if (kt + 1 < 16) GLOAD2((kt + 1) * 64);
        const bf16_t* as = As + (buf * 256 + wm * 128 + (lane & 31)) * G_LDA + 8 * (lane >> 5);
        const bf16_t* bs = Bs + (buf * 256 + wn * 64 + (lane & 31)) * G_LDA + 8 * (lane >> 5);
#pragma unroll
        for (int kk = 0; kk < 4; ++kk) {
            bf16x8 af[4], bfr[2];
#pragma unroll
            for (int i = 0; i < 4; ++i) af[i] = *(const bf16x8*)(as + i * 32 * G_LDA + kk * 16);
#pragma unroll
            for (int j = 0; j < 2; ++j) bfr[j] = *(const bf16x8*)(bs + j * 32 * G_LDA + kk * 16);
#pragma unroll
            for (int i = 0; i < 4; ++i)
#pragma unroll
                for (int j = 0; j < 2; ++j) acc[i][j] = __builtin_amdgcn_mfma_f32_32x32x16_bf16(af[i], bfr[j], acc[i][j], 0, 0, 0);
        }
        if (kt + 1 < 16) LSTORE2(buf ^ 1);
        __syncthreads();
    }
#undef GLOAD2
#undef LSTORE2
#pragma unroll
    for (int mi = 0; mi < 4; ++mi)
#pragma unroll
        for (int ni = 0; ni < 2; ++ni)
#pragma unroll
            for (int rg = 0; rg < 4; ++rg) {
                const int row = m0 + wm * 128 + mi * 32 + 8 * rg + 4 * (lane >> 5), col = n0 + wn * 64 + ni * 32 + (lane & 31);
                epi(row, col, acc[mi][ni][rg * 4 + 0], acc[mi][ni][rg * 4 + 1], acc[mi][ni][rg * 4 + 2], acc[mi][ni][rg * 4 + 3]);
            }
}
struct EpiL0In {
    unsigned char* ws;
    DEV void operator()(int row, int col, float v0, float v1, float v2, float v3) const {
        u32x2 o; o[0] = pk2(v0, v1); o[1] = pk2(v2, v3);
        const bool lat = row < TL; const int b = lat ? row / L : (row - TL) / LC, t = lat ? row - b * L : (row - TL) - b * LC, Lx = lat ? L : LC;
        if (col < 1536) { bf16_t* d = (bf16_t*)(ws + WS_P + (lat ? P_HYT_LAT : P_HYT_CTX)) + ((size_t)b * 1536 + col) * Lx + t; *(u32x2*)d = o; }
        else if (col < 2048) { bf16_t* d = (bf16_t*)(ws + WS_P + P_Q0) + (size_t)row * 512 + (col - 1536); d[0] = (bf16_t)f2bf(v0); d[512] = (bf16_t)f2bf(v1); d[1024] = (bf16_t)f2bf(v2); d[1536] = (bf16_t)f2bf(v3); }
        else if (col < 2176) { bf16_t* d = (bf16_t*)(ws + WS_P + P_K0) + (size_t)row * 128 + (col - 2048); d[0] = (bf16_t)f2bf(v0); d[128] = (bf16_t)f2bf(v1); d[256] = (bf16_t)f2bf(v2); d[384] = (bf16_t)f2bf(v3); }
        else { bf16_t* d = (bf16_t*)(ws + WS_P + (lat ? P_VT_LAT : P_VT_CTX)) + ((size_t)b * 128 + (col - 2176)) * Lx + t; *(u32x2*)d = o; }
    }
};
struct EpiBf16 {
    bf16_t* out; int ld;
    DEV void operator()(int row, int col, float v0, float v1, float v2, float v3) const {
        bf16_t* d = out + (size_t)row * ld + col; d[0] = (bf16_t)f2bf(v0); d[ld] = (bf16_t)f2bf(v1); d[2 * ld] = (bf16_t)f2bf(v2); d[3 * ld] = (bf16_t)f2bf(v3);
    }
};
struct EpiHg {
    unsigned char* ws; const float* lg;
    DEV void operator()(int row, int col, float v0, float v1, float v2, float v3) const {
        float vv[4] = {v0, v1, v2, v3};
        const bool lat = row < TL; const int b = lat ? row / L : (row - TL) / LC, t = lat ? row - b * L : (row - TL) - b * LC, Lx = lat ? L : LC;
        if (col >= 3072 && col < 4096) {
            bf16_t* d = (bf16_t*)(ws + WS_M) + (lat ? (size_t)0 : (size_t)NB * 1024 * L) + ((size_t)b * 1024 + (col - 3072)) * Lx + t;
            u32x2 o; o[0] = pk2(v0, v1); o[1] = pk2(v2, v3); *(u32x2*)d = o;
            return;
        }
        if (col < 1024 || col >= 4096) {
#pragma unroll
            for (int i = 0; i < 4; ++i) vv[i] = silu_f(vv[i]);
        } else {
            const int c = col - 1024;
            const float oml = 1.f - 1.f / (1.f + __expf(lg[c] - lg[2048 + c]));
#pragma unroll
            for (int i = 0; i < 4; ++i) vv[i] = oml / (1.f + __expf(vv[i]));
        }
        if (col < 3072) {
            bf16_t* d = (bf16_t*)(ws + WS_P + (lat ? P1_KQT_LAT : P1_KQT_CTX)) + ((size_t)b * 3072 + col) * Lx + t;
            u32x2 o; o[0] = pk2(vv[0], vv[1]); o[1] = pk2(vv[2], vv[3]); *(u32x2*)d = o;
        } else {
            bf16_t* d = (bf16_t*)(ws + WS_P + P1_G) + (size_t)row * 1024 + (col - 4096); d[0] = (bf16_t)f2bf(vv[0]); d[1024] = (bf16_t)f2bf(vv[1]); d[2048] = (bf16_t)f2bf(vv[2]); d[3072] = (bf16_t)f2bf(vv[3]);
        }
    }
};
struct EpiRes {
    const Params* p; int from_inputs, layer, goff;
    DEV void operator()(int row, int col, float v0, float v1, float v2, float v3) const {
        const float vv[4] = {v0, v1, v2, v3};
        float* H = (float*)(p->ws + WS_H);
        const float* mod = (const float*)(p->ws + WS_MOD) + (size_t)layer * NR * 6144 + goff + col;
#pragma unroll
        for (int i = 0; i < 4; ++i) { const int r = row + i; H[(size_t)r * 1024 + col] = h_row(*p, from_inputs, r)[col] + mod[(size_t)mod_row(r) * 6144] * vv[i]; }
    }
};

DEV float hy_u(const bf16_t* row, int t, int Lx, float w0, float w1, float w2, float b) {
    const float xm = t > 0 ? bf2f(row[t - 1]) : 0.f, x0 = bf2f(row[t]), xp = t + 1 < Lx ? bf2f(row[t + 1]) : 0.f;
    return w0 * xm + w1 * x0 + w2 * xp + b;
}
DEV void hyena_item(const Params& p, int set, int item, unsigned char* smem) {
    const int Ls = set ? LC : L, S = set ? FS_CTX : FS_LAT, N = 1 << (2 * S);
    const int gi = tidx() >> 8, g = tidx() & 255;
    const int bp = item >> 8, c = (item & 255) * 2 + gi, ba = bp * 2, bb = ba + 1;
    cf2* buf = (cf2*)smem + (size_t)gi * N;
    cf2* zk = (cf2*)smem + (size_t)2 * N + (size_t)gi * Ls;
    const bf16_t* hy = (const bf16_t*)(p.ws + WS_P + (set ? P_HYT_CTX : P_HYT_LAT));
    const float* cw = p.in[I_HYCW]; const float* cb = p.in[I_HYCB];
    const cf2* HF = (const cf2*)(p.ws + WS_F + (set ? F_HF_CTX : F_HF_LAT));
    const float invN = 1.f / (float)N;
    {
        const float w0 = cw[c], w1 = cw[1536 + c], w2 = cw[3072 + c], b = cb[c];
        const bf16_t* ra = hy + ((size_t)ba * 1536 + c) * Ls; const bf16_t* rb = hy + ((size_t)bb * 1536 + c) * Ls;
#pragma unroll 4
        for (int t = g; t < N; t += 256) { cf2 v; v.x = 0.f; v.y = 0.f; if (t < Ls) { v.x = hy_u(ra, t, Ls, w0, w1, w2, b); v.y = hy_u(rb, t, Ls, w0, w1, w2, b); zk[t] = v; } buf[fsw(t)] = v; }
    }
    __syncthreads();
    for (int n = 0; n < 2; ++n) {
        fft_fwd(buf, S, g, 256);
        const cf2* hf = HF + (size_t)(n * 512 + c) * N;
        for (int k0 = g; k0 < N; k0 += 1024) {
            cf2 hv[4];
#pragma unroll
            for (int u = 0; u < 4; ++u) { hv[u].x = 0.f; hv[u].y = 0.f; if (k0 + 256 * u < N) hv[u] = hf[k0 + 256 * u]; }
#pragma unroll
            for (int u = 0; u < 4; ++u) { const int k = k0 + 256 * u; if (k < N) buf[fsw(k)] = cmul(buf[fsw(k)], hv[u]); }
        }
        __syncthreads();
        fft_inv(buf, S, g, 256);
        const int gc = (n + 1) * 512 + c;
        const float w0 = cw[gc], w1 = cw[1536 + gc], w2 = cw[3072 + gc], b = cb[gc], dsk = p.in[I_HYSKIP][n * 512 + c];
        const bf16_t* ra = hy + ((size_t)ba * 1536 + gc) * Ls; const bf16_t* rb = hy + ((size_t)bb * 1536 + gc) * Ls;
        bf16_t* M = (bf16_t*)(p.ws + WS_M);
#pragma unroll 4
        for (int t = g; t < N; t += 256) {
            cf2 v; v.x = 0.f; v.y = 0.f;
            if (t < Ls) {
                const cf2 cv = buf[fsw(t)], zo = zk[t];
                v.x = hy_u(ra, t, Ls, w0, w1, w2, b) * (cv.x * invN + dsk * zo.x); v.y = hy_u(rb, t, Ls, w0, w1, w2, b) * (cv.y * invN + dsk * zo.y);
                if (n == 0) zk[t] = v;
                else { const size_t ta = set ? (size_t)TL + (size_t)ba * LC + t : (size_t)ba * L + t, tb = set ? (size_t)TL + (size_t)bb * LC + t : (size_t)bb * L + t;
                       M[ta * 1024 + c] = (bf16_t)f2bf(v.x); M[tb * 1024 + c] = (bf16_t)f2bf(v.y); }
            }
            if (n == 0) buf[fsw(t)] = v;
        }
        __syncthreads();
    }
}
DEV void rope_store(const bf16_t* src, bf16_t* dst, int pos, bool rope, float scale, int ph, int sub) {
    const u32x4 ua = *(const u32x4*)(src + ph * 32 + sub * 8), ub = *(const u32x4*)(src + ph * 32 + 16 + sub * 8);
    float a[8], b[8];
#pragma unroll
    for (int i = 0; i < 4; ++i) { a[2 * i] = bflo(ua[i]); a[2 * i + 1] = bfhi(ua[i]); b[2 * i] = bflo(ub[i]); b[2 * i + 1] = bfhi(ub[i]); }
    if (rope) {
        const float pv = (float)(ph == 0 ? pos / 64 : pos % 64);
#pragma unroll
        for (int e = 0; e < 8; ++e) {
            const float inv = exp2f(-(float)(sub * 8 + e) * (13.287712379549449f / 16.f));
            const float ang = pv * inv, cs = __cosf(ang), sn = __sinf(ang);
            const float na = a[e] * cs - b[e] * sn, nb = b[e] * cs + a[e] * sn; a[e] = na; b[e] = nb;
        }
    }
    u32x4 oa, ob;
#pragma unroll
    for (int i = 0; i < 4; ++i) { oa[i] = pk2(a[2 * i] * scale, a[2 * i + 1] * scale); ob[i] = pk2(b[2 * i] * scale, b[2 * i + 1] * scale); }
    *(u32x4*)(dst + ph * 32 + sub * 8) = oa; *(u32x4*)(dst + ph * 32 + 16 + sub * 8) = ob;
}
constexpr int A_LDQ = 72, A_LDV = 136;
DEV void attn_item(const Params& p, int set, int item, unsigned char* smem) {
    bf16_t* Qs = (bf16_t*)smem;
    bf16_t* Ks = Qs + 128 * A_LDQ;
    bf16_t* Vt = Ks + 128 * A_LDQ;
    const int tid = tidx(), lane = tid & 63, w = tid >> 6, l15 = lane & 15, lg = lane >> 4;
    const int nqb = set ? LC / 128 : L / 128;
    const int h = item & 7, qb = (item >> 3) % nqb, b = (item >> 3) / nqb, kvh = h >> 2;
    const bf16_t* Q0 = (const bf16_t*)(p.ws + WS_P + P_Q0); const bf16_t* K0 = (const bf16_t*)(p.ws + WS_P + P_K0);
    const int qtok0 = set ? TL + b * LC + qb * 128 : b * L + qb * 128;
    { const int row = tid >> 2, ph = (tid >> 1) & 1, sub = tid & 1;
      rope_store(Q0 + (size_t)(qtok0 + row) * 512 + h * 64, Qs + row * A_LDQ, qb * 128 + row, set == 0, 0.125f, ph, sub); }
    __syncthreads();
    bf16x8 qf[2];
    qf[0] = *(const bf16x8*)(Qs + (w * 16 + l15) * A_LDQ + 8 * lg); qf[1] = *(const bf16x8*)(Qs + (w * 16 + l15) * A_LDQ + 32 + 8 * lg);
    float m_run = p.in[I_SINK][h], l_run = 1.f;
    f32x4 O[4];
#pragma unroll
    for (int i = 0; i < 4; ++i) O[i] = (f32x4){0.f, 0.f, 0.f, 0.f};
    const int nwin = set ? 0 : 3, nctx = LC / 128;
    for (int kbi = 0; kbi < nwin + nctx; ++kbi) {
        const bool win = kbi < nwin; const int kb = win ? qb - 1 + kbi : kbi - nwin;
        if (win && (kb < 0 || kb >= L / 128)) continue;
        const int ktok0 = win ? b * L + kb * 128 : TL + b * LC + kb * 128;
        __syncthreads();
        { const int row = tid >> 2, ph = (tid >> 1) & 1, sub = tid & 1;
          rope_store(K0 + (size_t)(ktok0 + row) * 128 + kvh * 64, Ks + row * A_LDQ, kb * 128 + row, win, 1.f, ph, sub); }
        { const bf16_t* vt = (const bf16_t*)(p.ws + WS_P + (win ? P_VT_LAT : P_VT_CTX)); const int Lx = win ? L : LC;
#pragma unroll
          for (int i = 0; i < 2; ++i) { const int id = tid + NT * i, d = id >> 4, kc = id & 15;
              *(u32x4*)(Vt + d * A_LDV + kc * 8) = *(const u32x4*)(vt + ((size_t)b * 128 + kvh * 64 + d) * Lx + kb * 128 + kc * 8); } }
        __syncthreads();
#pragma unroll
        for (int ch = 0; ch < 2; ++ch) {
            f32x4 st[4];
#pragma unroll
            for (int u = 0; u < 4; ++u) {
                const bf16_t* kr = Ks + ((ch * 4 + u) * 16 + l15) * A_LDQ + 8 * lg;
                f32x4 z = (f32x4){0.f, 0.f, 0.f, 0.f};
                z = __builtin_amdgcn_mfma_f32_16x16x32_bf16(*(const bf16x8*)kr, qf[0], z, 0, 0, 0);
                z = __builtin_amdgcn_mfma_f32_16x16x32_bf16(*(const bf16x8*)(kr + 32), qf[1], z, 0, 0, 0);
                st[u] = z;
            }
            float cmax = -INFINITY;
            if (win) {
                const int qpos = qb * 128 + w * 16 + l15;
#pragma unroll
                for (int u = 0; u < 4; ++u)
#pragma unroll
                    for (int r = 0; r < 4; ++r) { const int kpos = kb * 128 + (ch * 4 + u) * 16 + 4 * lg + r; const int dd = qpos - kpos; if (dd > 128 || dd < -128) st[u][r] = -INFINITY; }
            }
#pragma unroll
            for (int u = 0; u < 4; ++u)
#pragma unroll
                for (int r = 0; r < 4; ++r) cmax = fmaxf(cmax, st[u][r]);
            cmax = fmaxf(cmax, __shfl_xor(cmax, 16)); cmax = fmaxf(cmax, __shfl_xor(cmax, 32));
            const float m_new = fmaxf(m_run, cmax), alpha = __expf(m_run - m_new);
            float ls = 0.f;
#pragma unroll
            for (int u = 0; u < 4; ++u)
#pragma unroll
                for (int r = 0; r < 4; ++r) { const float e = __expf(st[u][r] - m_new); st[u][r] = e; ls += e; }
            ls += __shfl_xor(ls, 16); ls += __shfl_xor(ls, 32);
            l_run = l_run * alpha + ls; m_run = m_new;
#pragma unroll
            for (int i = 0; i < 4; ++i) { O[i][0] *= alpha; O[i][1] *= alpha; O[i][2] *= alpha; O[i][3] *= alpha; }
#pragma unroll
            for (int ss = 0; ss < 2; ++ss) {
                u32x4 pu; pu[0] = pk2(st[2 * ss][0], st[2 * ss][1]); pu[1] = pk2(st[2 * ss][2], st[2 * ss][3]); pu[2] = pk2(st[2 * ss + 1][0], st[2 * ss + 1][1]); pu[3] = pk2(st[2 * ss + 1][2], st[2 * ss + 1][3]);
                const bf16x8 pf = __builtin_bit_cast(bf16x8, pu);
                const int key0 = (ch * 4 + 2 * ss) * 16 + 4 * lg;
#pragma unroll
                for (int dt = 0; dt < 4; ++dt) {
                    const bf16_t* vr = Vt + (dt * 16 + l15) * A_LDV + key0;
                    u32x4 vu; const u32x2 v0 = *(const u32x2*)vr, v1 = *(const u32x2*)(vr + 16); vu[0] = v0[0]; vu[1] = v0[1]; vu[2] = v1[0]; vu[3] = v1[1];
                    O[dt] = __builtin_amdgcn_mfma_f32_16x16x32_bf16(__builtin_bit_cast(bf16x8, vu), pf, O[dt], 0, 0, 0);
                }
            }
        }
    }
    const float il = 1.f / l_run;
    bf16_t* M = (bf16_t*)(p.ws + WS_M) + (size_t)(qtok0 + w * 16 + l15) * 1024 + 512 + h * 64;
#pragma unroll
    for (int dt = 0; dt < 4; ++dt) { u32x2 o; o[0] = pk2(O[dt][0] * il, O[dt][1] * il); o[1] = pk2(O[dt][2] * il, O[dt][3] * il); *(u32x2*)(M + dt * 16 + 4 * lg) = o; }
    __syncthreads();
}
constexpr int P3_HY_LAT = (NB / 2) * 256, P3_HY_CTX = (NB / 2) * 256, P3_AT_LAT = NB * (L / 128) * 8, P3_AT_CTX = NB * (LC / 128) * 8;
DEV void phase3(const Params& p, unsigned char* smem, int var = 0) {
    const int total = P3_HY_LAT + P3_AT_LAT + P3_HY_CTX + P3_AT_CTX;
    for (int it = blockIdx.x; it < total; it += gridDim.x) {
        int i = it;
        if (var == 1 && !(i < P3_HY_LAT || (i >= P3_HY_LAT + P3_AT_LAT && i < P3_HY_LAT + P3_AT_LAT + P3_HY_CTX))) continue;
        if (var == 2 && (i < P3_HY_LAT || (i >= P3_HY_LAT + P3_AT_LAT && i < P3_HY_LAT + P3_AT_LAT + P3_HY_CTX))) continue;
        if (i < P3_HY_LAT) { hyena_item(p, 0, i, smem); continue; } i -= P3_HY_LAT;
        if (i < P3_AT_LAT) { attn_item(p, 0, i, smem); continue; } i -= P3_AT_LAT;
        if (i < P3_HY_CTX) { hyena_item(p, 1, i, smem); continue; } i -= P3_HY_CTX;
        attn_item(p, 1, i, smem);
    }
}

constexpr int K_LDK = 136, K_LDS = 129, K_LDC = 52;
DEV unsigned fkey(float f) { const unsigned u = __builtin_bit_cast(unsigned, f); return (u & 0x80000000u) ? ~u : (u | 0x80000000u); }
constexpr int cand_off(int i) { int o = 0; for (int k = 0; k < i; ++k) o += 16 / (k + 1); return o; }
DEV void topk_load_keys(const Params& p, int layer, int h, unsigned char* smem) {
    bf16_t* Ks = (bf16_t*)smem;
    const bf16_t* keys = (const bf16_t*)(p.ws + WS_W + W_KEYS) + (size_t)layer * 262144 + (size_t)h * 32768;
    const int tid = tidx();
#pragma unroll
    for (int i = 0; i < 8; ++i) { const int id = tid + NT * i, row = id >> 4, kc = id & 15; *(u32x4*)(Ks + row * K_LDK + kc * 8) = *(const u32x4*)(keys + (size_t)row * 128 + kc * 8); }
    __syncthreads();
}
#ifndef HOST_EMU
template <int CTRL> DEV unsigned dpp_u32(unsigned v) { return (unsigned)__builtin_amdgcn_update_dpp(0, (int)v, CTRL, 0xF, 0xF, true); }
#else
template <int CTRL> DEV unsigned dpp_u32(unsigned v) { const int lane = tidx() & 63; const int src = CTRL == 0xB1 ? (lane ^ 1) : CTRL == 0x4E ? (lane ^ 2) : ((lane & ~7) | (7 - (lane & 7))); return emu_shfl(v, src); }
#endif
DEV unsigned max8_u32(unsigned v) { unsigned t = dpp_u32<0xB1>(v); v = v > t ? v : t; t = dpp_u32<0x4E>(v); v = v > t ? v : t; t = dpp_u32<0x141>(v); return v > t ? v : t; }
DEV float sum8_f32(float v) { v += __builtin_bit_cast(float, dpp_u32<0xB1>(__builtin_bit_cast(unsigned, v))); v += __builtin_bit_cast(float, dpp_u32<0x4E>(__builtin_bit_cast(unsigned, v))); v += __builtin_bit_cast(float, dpp_u32<0x141>(__builtin_bit_cast(unsigned, v))); return v; }
DEV float unkey(unsigned k) { const unsigned u = (k & 0x80000000u) ? (k & 0x7fffffffu) : ~k; return __builtin_bit_cast(float, u); }
template <int N> DEV void bitonic_desc(unsigned (&a)[N]) {
#pragma unroll
    for (int k = 2; k <= N; k <<= 1)
#pragma unroll
        for (int j = k >> 1; j > 0; j >>= 1)
#pragma unroll
            for (int i = 0; i < N; ++i) { const int l = i ^ j; if (l > i) { const unsigned x = a[i], y = a[l]; const unsigned hi = x > y ? x : y, lo = x > y ? y : x; if ((i & k) == 0) { a[i] = hi; a[l] = lo; } else { a[i] = lo; a[l] = hi; } } }
}
DEV void merge16(const unsigned* lst, int nlist, unsigned first, int sub, unsigned& r0, unsigned& r1) {
    unsigned cur = first; int head = 0; r0 = 0u; r1 = 0u;
#pragma unroll
    for (int it = 0; it < 16; ++it) {
        const unsigned m = max8_u32(cur);
        if (sub == (it & 7)) { if (it < 8) r0 = m; else r1 = m; }
        if (cur == m) { ++head; cur = head < nlist ? lst[head] : 0u; }
    }
}
DEV void topk_item(const Params& p, int h, int tok0, unsigned char* smem) {
    bf16_t* Ks = (bf16_t*)smem;
    float* Sc = (float*)(Ks + 2 * 128 * K_LDK);
    unsigned* s12 = (unsigned*)Sc + 64 * 8 * 17;
    unsigned* cl = s12 + 64 * 32;
    const int tid = tidx(), lane = tid & 63, w = tid >> 6;
    const int row = tid >> 3, sub = tid & 7;
    const bf16_t* PQ = (const bf16_t*)(p.ws + WS_P);
    for (int part = 0; part < 2; ++part) {
        { const int mi = w >> 2, ni = w & 3;
          f32x16 acc;
#pragma unroll
          for (int r = 0; r < 16; ++r) acc[r] = 0.f;
          const bf16_t* ag = PQ + (size_t)(tok0 + mi * 32 + (lane & 31)) * 2048 + h * 256 + part * 128 + 8 * (lane >> 5);
          const bf16_t* bs = Ks + (part * 128 + ni * 32 + (lane & 31)) * K_LDK + 8 * (lane >> 5);
          bf16x8 af[8];
#pragma unroll
          for (int kk = 0; kk < 8; ++kk) af[kk] = *(const bf16x8*)(ag + kk * 16);
#pragma unroll
          for (int kk = 0; kk < 8; ++kk) acc = __builtin_amdgcn_mfma_f32_32x32x16_bf16(af[kk], *(const bf16x8*)(bs + kk * 16), acc, 0, 0, 0);
#pragma unroll
          for (int r = 0; r < 16; ++r) Sc[(mi * 32 + (r & 3) + 8 * (r >> 2) + 4 * (lane >> 5)) * K_LDS + ni * 32 + (lane & 31)] = acc[r]; }
        __syncthreads();
        unsigned mk[16];
#pragma unroll
        for (int i = 0; i < 16; ++i) mk[i] = (fkey(Sc[row * K_LDS + sub * 16 + i]) & ~127u) | (unsigned)(127 - (sub * 16 + i));
        bitonic_desc<16>(mk);
        __syncthreads();
        unsigned* lst = (unsigned*)Sc + (row * 8 + sub) * 17;
#pragma unroll
        for (int i = 0; i < 16; ++i) lst[i] = mk[i];
        unsigned r0, r1;
        merge16(lst, 16, mk[0], sub, r0, r1);
        s12[(row * 2 + part) * 16 + sub] = r0; s12[(row * 2 + part) * 16 + 8 + sub] = r1;
        __syncthreads();
    }
    {
        const unsigned* k1 = s12 + row * 32; const unsigned* k2 = k1 + 16;
        unsigned ck[8];
#pragma unroll
        for (int m = 0; m < 8; ++m) {
            const int cc = sub + 8 * m; int ci = 0, off = 0;
#pragma unroll
            for (int i = 0; i < 15; ++i) { const bool ge = cc >= cand_off(i + 1); ci += ge ? 1 : 0; off += ge ? 16 / (i + 1) : 0; }
            const int cj = cc - off;
            ck[m] = 0u;
            if (cc < 50) ck[m] = (fkey(unkey((k1[ci] & ~127u) | 64u) + unkey((k2[cj] & ~127u) | 64u)) & ~63u) | (unsigned)(63 - cc);
        }
        bitonic_desc<8>(ck);
        unsigned* lst = cl + (row * 8 + sub) * 9;
#pragma unroll
        for (int m = 0; m < 8; ++m) lst[m] = ck[m];
        unsigned r0, r1;
        merge16(lst, 8, ck[0], sub, r0, r1);
        const float a = unkey((r0 & ~63u) | 32u), b = unkey((r1 & ~63u) | 32u);
        const unsigned kmax = max8_u32(r0 > r1 ? r0 : r1); const float vmax = unkey((kmax & ~63u) | 32u);
        const float ea = __expf(a - vmax), eb = __expf(b - vmax);
        const float inv = 1.f / sum8_f32(ea + eb);
        int eidx[2];
#pragma unroll
        for (int q = 0; q < 2; ++q) {
            const int cc = 63 - (int)((q ? r1 : r0) & 63u); int ci = 0, off = 0;
#pragma unroll
            for (int i = 0; i < 15; ++i) { const bool ge = cc >= cand_off(i + 1); ci += ge ? 1 : 0; off += ge ? 16 / (i + 1) : 0; }
            const int cj = cc - off;
            eidx[q] = (127 - (int)(k1[ci] & 127u)) * 128 + (127 - (int)(k2[cj] & 127u));
        }
        int* IDX = (int*)(p.ws + WS_IDX) + (size_t)(tok0 + row) * 128 + h * 16; float* GT = (float*)(p.ws + WS_GATE) + (size_t)(tok0 + row) * 128 + h * 16;
        IDX[sub] = eidx[0]; IDX[8 + sub] = eidx[1]; GT[sub] = ea * inv; GT[8 + sub] = eb * inv;
    }
    __syncthreads();
}
DEV void topk_phase(const Params& p, int layer, int ntok, unsigned char* smem) {
    const int G = gridDim.x, bid = blockIdx.x, h = bid & 7;
    const int nt = ntok / 64;
    if ((G & 7) == 0) {
        if ((bid >> 3) < nt) topk_load_keys(p, layer, h, smem);
        for (int tt = bid >> 3; tt < nt; tt += (G >> 3)) topk_item(p, h, tt * 64, smem);
    } else {
        for (int it = bid; it < nt * 8; it += G) { __syncthreads(); topk_load_keys(p, layer, it & 7, smem); topk_item(p, it & 7, (it >> 3) * 64, smem); }
    }
}

DEV float gelu_f(float x) { return 0.5f * x * (1.f + erff(x * 0.70710678118654752f)); }
typedef float f32x2 __attribute__((ext_vector_type(2)));
DEV void fp8x16_to_f32(const u32x4& r, float (&f)[16]) {
#pragma unroll
    for (int i = 0; i < 4; ++i) { const f32x2 lo = __builtin_amdgcn_cvt_pk_f32_fp8((int)r[i], false), hi = __builtin_amdgcn_cvt_pk_f32_fp8((int)r[i], true); f[4 * i] = lo[0]; f[4 * i + 1] = lo[1]; f[4 * i + 2] = hi[0]; f[4 * i + 3] = hi[1]; }
}
DEV void peer_item(const Params& p, int layer, int item, int var = 0) {
    const int tok = item * 8 + (tidx() >> 6), lane = tidx() & 63;
    const bf16_t* A = (const bf16_t*)(p.ws + WS_A) + (size_t)tok * 1024 + lane * 16;
    const unsigned char* U8 = p.ws + WS_T8 + (size_t)(layer * 2) * 16384 * 1024; const unsigned char* V8 = U8 + (size_t)16384 * 1024; const int voff = lane * 16;
    const float* SU = (const float*)(p.ws + WS_S8) + (size_t)(layer * 2) * 16384; const float* SV = SU + 16384;
    float x[16], y[16];
    { const u32x4 a0 = *(const u32x4*)A, a1 = *(const u32x4*)(A + 8);
#pragma unroll
      for (int i = 0; i < 4; ++i) { x[2 * i] = bflo(a0[i]); x[2 * i + 1] = bfhi(a0[i]); x[8 + 2 * i] = bflo(a1[i]); x[8 + 2 * i + 1] = bfhi(a1[i]); } }
#pragma unroll
    for (int i = 0; i < 16; ++i) y[i] = 0.f;
    const int* IDX = (const int*)(p.ws + WS_IDX) + (size_t)tok * 128; const float* GT = (const float*)(p.ws + WS_GATE) + (size_t)tok * 128;
    const int i_lo = IDX[lane], i_hi = IDX[64 + lane]; const float g_lo = GT[lane], g_hi = GT[64 + lane];
    const int jl = ((lane >> 5) & 1) * 4 + ((lane >> 4) & 1) * 2 + ((lane >> 3) & 1);
    u32x4 ur[8], vr[8];
#define PG_LOADU(g) do { const int src_ = (g) < 8 ? i_lo : i_hi; \
        _Pragma("unroll") for (int j = 0; j < 8; ++j) { const int e_ = __builtin_amdgcn_readlane(src_, (((g) & 7) << 3) + j); ur[j] = *(const u32x4*)(U8 + (size_t)e_ * 1024 + voff); } } while (0)
#define PG_LOADV(g) do { const int src_ = (g) < 8 ? i_lo : i_hi; \
        _Pragma("unroll") for (int j = 0; j < 8; ++j) { const int e_ = __builtin_amdgcn_readlane(src_, (((g) & 7) << 3) + j); vr[j] = *(const u32x4*)(V8 + (size_t)e_ * 1024 + voff); } } while (0)
#pragma unroll
    for (int j = 0; j < 8; ++j) { ur[j] = (u32x4){0x38383838u, 0x38383838u, 0x38383838u, 0x38383838u}; vr[j] = ur[j]; }
    if (var != 1) { PG_LOADU(0); PG_LOADV(0); }
    for (int g = 0; g < 16; ++g) {
        if (var == 2) { if (g + 1 < 16) { PG_LOADU(g + 1); PG_LOADV(g + 1); }
#ifndef HOST_EMU
#pragma unroll
            for (int j = 0; j < 8; ++j) asm volatile("" :: "v"(ur[j]), "v"(vr[j]));
#endif
            continue; }
        const int mk = ((g & 7) << 3) + jl; const int me = __shfl(g < 8 ? i_lo : i_hi, mk); const float mg = __shfl(g < 8 ? g_lo : g_hi, mk);
        const float su = SU[me], sv = SV[me];
        float d[8];
#pragma unroll
        for (int j = 0; j < 8; ++j) { float f[16]; fp8x16_to_f32(ur[j], f); float a = 0.f;
#pragma unroll
            for (int i = 0; i < 16; ++i) a = fmaf(f[i], x[i], a);
            d[j] = a; SCHED_FENCE(); }
        if (g + 1 < 16 && var != 1) PG_LOADU(g + 1);
        float r4[4], r2[2], r1;
        { const bool hi = (lane & 32) != 0;
#pragma unroll
          for (int j = 0; j < 4; ++j) { const float send = hi ? d[j] : d[4 + j], keep = hi ? d[4 + j] : d[j]; r4[j] = keep + __shfl_xor(send, 32); } }
        { const bool hi = (lane & 16) != 0;
#pragma unroll
          for (int j = 0; j < 2; ++j) { const float send = hi ? r4[j] : r4[2 + j], keep = hi ? r4[2 + j] : r4[j]; r2[j] = keep + __shfl_xor(send, 16); } }
        { const bool hi = (lane & 8) != 0; const float send = hi ? r2[0] : r2[1], keep = hi ? r2[1] : r2[0]; r1 = keep + __shfl_xor(send, 8); }
        r1 += __shfl_xor(r1, 4); r1 += __shfl_xor(r1, 2); r1 += __shfl_xor(r1, 1);
        const float act = gelu_f(r1 * su) * mg * sv;
#pragma unroll
        for (int j = 0; j < 8; ++j) {
            const float aj = __builtin_bit_cast(float, __builtin_amdgcn_readlane(__builtin_bit_cast(int, act), ((j >> 2) & 1) * 32 + ((j >> 1) & 1) * 16 + (j & 1) * 8));
            float f[16]; fp8x16_to_f32(vr[j], f);
#pragma unroll
            for (int i = 0; i < 16; ++i) y[i] = fmaf(aj, f[i], y[i]);
            SCHED_FENCE(); }
        if (g + 1 < 16 && var != 1) PG_LOADV(g + 1);
    }
#undef PG_LOADU
#undef PG_LOADV
    float* H = (float*)(p.ws + WS_H) + (size_t)tok * 1024 + lane * 16;
    const float* g2 = (const float*)(p.ws + WS_MOD) + ((size_t)layer * NR + mod_row(tok)) * 6144 + 5120 + lane * 16;
    float hv[16]; float ss = 0.f;
#pragma unroll
    for (int i = 0; i < 4; ++i) { const f32x4 hh = *(const f32x4*)(H + 4 * i), gg = *(const f32x4*)(g2 + 4 * i);
#pragma unroll
        for (int j = 0; j < 4; ++j) { const float v = hh[j] + gg[j] * y[4 * i + j]; hv[4 * i + j] = v; ss += v * v; } }
    ss = wave_sum(ss);
    const float rstd = rsqrtf(ss * (1.f / 1024.f) + 1e-6f);
    if (layer == 0) {
#pragma unroll
        for (int i = 0; i < 4; ++i) { f32x4 o; o[0] = hv[4 * i]; o[1] = hv[4 * i + 1]; o[2] = hv[4 * i + 2]; o[3] = hv[4 * i + 3]; *(f32x4*)(H + 4 * i) = o; }
        const float* g = p.in[I_N1G] + 1024 + lane * 16;
        const float* mod = (const float*)(p.ws + WS_MOD) + ((size_t)1 * NR + mod_row(tok)) * 6144 + lane * 16;
        bf16_t* Ao = (bf16_t*)(p.ws + WS_A) + (size_t)tok * 1024 + lane * 16;
        u32x4 o0, o1; float r[16];
#pragma unroll
        for (int i = 0; i < 16; ++i) r[i] = hv[i] * rstd * g[i] * (1.f + mod[1024 + i]) + mod[i];
#pragma unroll
        for (int i = 0; i < 4; ++i) { o0[i] = pk2(r[2 * i], r[2 * i + 1]); o1[i] = pk2(r[8 + 2 * i], r[8 + 2 * i + 1]); }
        *(u32x4*)Ao = o0; *(u32x4*)(Ao + 8) = o1;
    } else {
        const float* g = p.in[I_FG] + lane * 16; float* out = p.out + (size_t)tok * 1024 + lane * 16;
#pragma unroll
        for (int i = 0; i < 4; ++i) { f32x4 o; o[0] = hv[4 * i] * rstd * g[4 * i]; o[1] = hv[4 * i + 1] * rstd * g[4 * i + 1]; o[2] = hv[4 * i + 2] * rstd * g[4 * i + 2]; o[3] = hv[4 * i + 3] * rstd * g[4 * i + 3]; *(f32x4*)(out + 4 * i) = o; }
    }
}

constexpr int S3_LD = 136, S3_LDT = 24, S3_LDV = 72;
constexpr int S3_Q = 0, S3_K = S3_Q + 64 * S3_LD * 2, S3_KT = S3_K + 64 * S3_LD * 2, S3_D = S3_KT + 4 * 128 * S3_LDT * 2, S3_V = S3_D + 4 * 128 * 4, S3_ST = S3_V + 64 * S3_LDV * 2,
              S3_P = S3_ST + 2 * 64 * S3_LD * 2, S3_END = S3_P + 4 * 16 * S3_LDT * 2;
static_assert(S3_END <= SMEM_BYTES, "scan LDS");
DEV void scan_block(const Params& p, int bi, unsigned char* smem, int var = 0) {
    const int tid = tidx(), lane = tid & 63, w = tid >> 6, l15 = lane & 15, lg4 = lane >> 4, l31 = lane & 31, lh = lane >> 5;
    const int half = bi & 1, dir = (bi >> 1) & 1, h = (bi >> 2) & 7, b = bi >> 5;
    const bf16_t* P1 = (const bf16_t*)(p.ws + WS_P);
    const bf16_t* IT = (const bf16_t*)(p.ws + WS_M);
    bf16_t* Oo = (bf16_t*)(p.ws + WS_F + (dir ? F_OB : F_OF));
    bf16_t* Qs = (bf16_t*)(smem + S3_Q); bf16_t* Ks = (bf16_t*)(smem + S3_K); bf16_t* KT = (bf16_t*)(smem + S3_KT); float* Ds = (float*)(smem + S3_D);
    bf16_t* Vs = (bf16_t*)(smem + S3_V); bf16_t* ST = (bf16_t*)(smem + S3_ST); bf16_t* Ps = (bf16_t*)(smem + S3_P);
    const int NCH = (LC + L) / 64;
    const int kt = w >> 1, vt = w & 1;
    f32x16 S;
#pragma unroll
    for (int r = 0; r < 16; ++r) S[r] = 0.f;
    for (int i = tid; i < 64 * S3_LD / 2; i += NT) ((unsigned*)ST)[i] = 0u;
    const int pk = tid & 127, pblk = tid >> 7;
    u32x4 ka[2], qa[2], va, kb2[2], qb2[2], vb2;
    const int kcol = 1024 * (1 + dir) + h * 128 + pk, qcol = h * 128 + pk;
#define S3_T0(c) ((c) * 64 < LC ? (dir ? LC - 64 - (c) * 64 : (c) * 64) : (dir ? L - 64 - ((c) * 64 - LC) : (c) * 64 - LC))
#define S3_LOAD(c, KR, QR, VR) do { const bool lat_ = (c) * 64 >= LC; const int t0_ = S3_T0(c); const int Lx_ = lat_ ? L : LC; \
        const bf16_t* kq_ = (const bf16_t*)(p.ws + WS_P + (lat_ ? P1_KQT_LAT : P1_KQT_CTX)) + (size_t)b * 3072 * Lx_ + t0_ + pblk * 16; \
        KR[0] = *(const u32x4*)(kq_ + (size_t)kcol * Lx_); KR[1] = *(const u32x4*)(kq_ + (size_t)kcol * Lx_ + 8); \
        if (lat_) { QR[0] = *(const u32x4*)(kq_ + (size_t)qcol * Lx_); QR[1] = *(const u32x4*)(kq_ + (size_t)qcol * Lx_ + 8); } else { QR[0] = (u32x4){0u, 0u, 0u, 0u}; QR[1] = QR[0]; } \
        { const int v_ = tid >> 3, c8_ = tid & 7; const bf16_t* it_ = IT + (lat_ ? (size_t)0 : (size_t)NB * 1024 * L) + ((size_t)b * 1024 + h * 128 + half * 64 + v_) * Lx_ + t0_ + c8_ * 8; VR = *(const u32x4*)it_; } } while (0)
#define S3_PREP(KR, QR, VR) do { \
            float bsum = 0.f; unsigned short kt16[16]; \
            _Pragma("unroll") for (int rr = 0; rr < 16; ++rr) { \
                const int tl = dir ? 15 - rr : rr; \
                const unsigned ku_ = dir ? KR[(15 - rr) >> 3][((15 - rr) & 7) >> 1] : KR[rr >> 3][(rr & 7) >> 1]; const unsigned qu_ = dir ? QR[(15 - rr) >> 3][((15 - rr) & 7) >> 1] : QR[rr >> 3][(rr & 7) >> 1]; \
                const bool odd_ = dir ? (((15 - rr) & 1) != 0) : ((rr & 1) != 0); \
                const float kv = odd_ ? bfhi(ku_) : bflo(ku_), qv = odd_ ? bfhi(qu_) : bflo(qu_); \
                bsum += __logf(1.f - kv); \
                const float eb = __expf(bsum), ieb = __expf(fminf(-bsum, 80.f)); \
                const unsigned short qt = (unsigned short)f2bf(qv * eb), ktv = (unsigned short)f2bf(kv * ieb); \
                Qs[(pblk * 16 + tl) * S3_LD + pk] = qt; Ks[(pblk * 16 + tl) * S3_LD + pk] = ktv; \
                if (dir) kt16[15 - rr] = ktv; else kt16[rr] = ktv; \
            } \
            u32x4 o0, o1; \
            _Pragma("unroll") for (int i = 0; i < 4; ++i) { o0[i] = (unsigned)kt16[2 * i] | ((unsigned)kt16[2 * i + 1] << 16); o1[i] = (unsigned)kt16[8 + 2 * i] | ((unsigned)kt16[8 + 2 * i + 1] << 16); } \
            *(u32x4*)(KT + (pblk * 128 + pk) * S3_LDT) = o0; *(u32x4*)(KT + (pblk * 128 + pk) * S3_LDT + 8) = o1; \
            Ds[pblk * 128 + pk] = __expf(bsum); \
            { const int v_ = tid >> 3, c8_ = tid & 7; *(u32x4*)(Vs + v_ * S3_LDV + c8_ * 8) = VR; } } while (0)
    S3_LOAD(0, ka, qa, va);
    for (int c = 0; c < NCH; ++c) {
        const bool lat = c * 64 >= LC; const int t0 = S3_T0(c); const size_t tokb = lat ? (size_t)b * L + t0 : (size_t)TL + (size_t)b * LC + t0;
        if ((c & 1) == 0) { if (c + 1 < NCH) S3_LOAD(c + 1, kb2, qb2, vb2); } else { if (c + 1 < NCH) S3_LOAD(c + 1, ka, qa, va); }
        lds_barrier();
        if (var != 1) { if ((c & 1) == 0) S3_PREP(ka, qa, va); else S3_PREP(kb2, qb2, vb2); }
        lds_barrier();

        if (lat && w < 4) {
            f32x4 pt = (f32x4){0.f, 0.f, 0.f, 0.f};
#pragma unroll
            for (int kk = 0; kk < 4; ++kk)
                pt = __builtin_amdgcn_mfma_f32_16x16x32_bf16(*(const bf16x8*)(Ks + (w * 16 + l15) * S3_LD + kk * 32 + 8 * lg4), *(const bf16x8*)(Qs + (w * 16 + l15) * S3_LD + kk * 32 + 8 * lg4), pt, 0, 0, 0);
            float pm[4];
#pragma unroll
            for (int r = 0; r < 4; ++r) { const int sl = 4 * lg4 + r; const bool keep = dir ? (sl >= l15) : (sl <= l15); pm[r] = keep ? pt[r] : 0.f; }
            u32x2 o; o[0] = pk2(pm[0], pm[1]); o[1] = pk2(pm[2], pm[3]);
            *(u32x2*)(Ps + (w * 16 + l15) * S3_LDT + 4 * lg4) = o;
        }
        lds_barrier();
        for (int ib = 0; ib < (var == 2 ? 0 : 4); ++ib) {
            const int blk = dir ? 3 - ib : ib;
            const int cur = (c * 4 + ib) & 1;
            { const bf16x8 a = *(const bf16x8*)(KT + (blk * 128 + 32 * kt + l31) * S3_LDT + 8 * lh);
              const bf16x8 bb = *(const bf16x8*)(Vs + (32 * vt + l31) * S3_LDV + blk * 16 + 8 * lh);
              S = __builtin_amdgcn_mfma_f32_32x32x16_bf16(a, bb, S, 0, 0, 0);
#pragma unroll
              for (int g = 0; g < 4; ++g) { const f32x4 dv = *(const f32x4*)(Ds + blk * 128 + 32 * kt + 8 * g + 4 * lh);
                  S[4 * g] *= dv[0]; S[4 * g + 1] *= dv[1]; S[4 * g + 2] *= dv[2]; S[4 * g + 3] *= dv[3];
                  u32x2 o; o[0] = pk2(S[4 * g], S[4 * g + 1]); o[1] = pk2(S[4 * g + 2], S[4 * g + 3]);
                  *(u32x2*)(ST + ((cur ^ 1) * 64 + 32 * vt + l31) * S3_LD + 32 * kt + 8 * g + 4 * lh) = o; } }
            if (lat && w < 4) {
                f32x4 o = (f32x4){0.f, 0.f, 0.f, 0.f};
#pragma unroll
                for (int kk = 0; kk < 4; ++kk)
                    o = __builtin_amdgcn_mfma_f32_16x16x32_bf16(*(const bf16x8*)(ST + (cur * 64 + 16 * w + l15) * S3_LD + kk * 32 + 8 * lg4), *(const bf16x8*)(Qs + (blk * 16 + l15) * S3_LD + kk * 32 + 8 * lg4), o, 0, 0, 0);
                bf16x8 va = (bf16x8){0, 0, 0, 0, 0, 0, 0, 0}, pb = va;
                if (lg4 < 2) { va = *(const bf16x8*)(Vs + (16 * w + l15) * S3_LDV + blk * 16 + 8 * lg4); pb = *(const bf16x8*)(Ps + (blk * 16 + l15) * S3_LDT + 8 * lg4); }
                o = __builtin_amdgcn_mfma_f32_16x16x32_bf16(va, pb, o, 0, 0, 0);
                u32x2 ou; ou[0] = pk2(o[0], o[1]); ou[1] = pk2(o[2], o[3]);
                *(u32x2*)(Oo + (tokb + blk * 16 + l15) * 1024 + h * 128 + half * 64 + 16 * w + 4 * lg4) = ou;
            }
            lds_barrier();
        }
    }
    lds_barrier();
#undef S3_T0
#undef S3_LOAD
#undef S3_PREP
}
DEV void readout_item(const Params& p, int item) {
    const int tok = item * 8 + (tidx() >> 6), lane = tidx() & 63;
    const bf16_t* of = (const bf16_t*)(p.ws + WS_F + F_OF) + (size_t)tok * 1024 + lane * 16; const bf16_t* ob = (const bf16_t*)(p.ws + WS_F + F_OB) + (size_t)tok * 1024 + lane * 16;
    const bf16_t* gp = (const bf16_t*)(p.ws + WS_P + P1_G) + (size_t)tok * 1024 + lane * 16;
    const float* on = p.in[I_HGON] + (lane & 7) * 16;
    float o[16], gg[16]; float ss = 0.f;
    { const u32x4 a0 = *(const u32x4*)of, a1 = *(const u32x4*)(of + 8), b0 = *(const u32x4*)ob, b1 = *(const u32x4*)(ob + 8), g0 = *(const u32x4*)gp, g1 = *(const u32x4*)(gp + 8);
#pragma unroll
      for (int i = 0; i < 4; ++i) { o[2 * i] = bflo(a0[i]) + bflo(b0[i]); o[2 * i + 1] = bfhi(a0[i]) + bfhi(b0[i]); o[8 + 2 * i] = bflo(a1[i]) + bflo(b1[i]); o[8 + 2 * i + 1] = bfhi(a1[i]) + bfhi(b1[i]);
          gg[2 * i] = bflo(g0[i]); gg[2 * i + 1] = bfhi(g0[i]); gg[8 + 2 * i] = bflo(g1[i]); gg[8 + 2 * i + 1] = bfhi(g1[i]); } }
#pragma unroll
    for (int i = 0; i < 16; ++i) ss += o[i] * o[i];
    ss += __shfl_xor(ss, 1); ss += __shfl_xor(ss, 2); ss += __shfl_xor(ss, 4);
    const float rstd = rsqrtf(ss * (1.f / 128.f) + 1e-6f);
    bf16_t* M = (bf16_t*)(p.ws + WS_M) + (size_t)tok * 1024 + lane * 16;
    u32x4 o0, o1; float r[16];
#pragma unroll
    for (int i = 0; i < 16; ++i) r[i] = o[i] * rstd * on[i] * gg[i];
#pragma unroll
    for (int i = 0; i < 4; ++i) { o0[i] = pk2(r[2 * i], r[2 * i + 1]); o1[i] = pk2(r[8 + 2 * i], r[8 + 2 * i + 1]); }
    *(u32x4*)M = o0; *(u32x4*)(M + 8) = o1;
}

#ifndef HOST_EMU
#define XB_TMO      128
#define XB_XCNT(j)  (256  + 64 * (j))
#define XB_XSUB(j)  (1280 + 64 * (j))
#define XB_XGEN(j)  (2304 + 64 * (j))
#define XB_TOP      3328
#define XB_TOPGEN   3392
#define XCD_BAR_WORDS 3456
#define XB_SPIN_CAP (1u << 18)
#define LAS __attribute__((address_space(3)))

__device__ __forceinline__ unsigned xb_ld(unsigned* p)              { return __hip_atomic_load(p, __ATOMIC_RELAXED, __HIP_MEMORY_SCOPE_AGENT); }
__device__ __forceinline__ unsigned xb_add(unsigned* p, unsigned v) { return __hip_atomic_fetch_add(p, v, __ATOMIC_RELAXED, __HIP_MEMORY_SCOPE_AGENT); }
__device__ __forceinline__ unsigned xb_xcc_id() { return (unsigned)__builtin_amdgcn_s_getreg((3 << 11) | 20) & 0xFu; }
#define XB_SPIN(cond, bar) do { unsigned _sp = 0; while (cond) { __builtin_amdgcn_s_sleep(1); \
    if ((++_sp & 255u) == 0u) { if (xb_ld(&(bar)[XB_TMO])) break; if (_sp > XB_SPIN_CAP) { atomicAdd(&(bar)[XB_TMO], 1u); break; } } } } while (0)

struct XcdBarrier {
    unsigned* bar; unsigned x;
    volatile LAS unsigned* st;
};

__device__ __forceinline__ XcdBarrier xcd_barrier_post(unsigned* bar, volatile LAS unsigned* st) {
    XcdBarrier b; b.bar = bar; b.x = xb_xcc_id(); b.st = st;
    if (threadIdx.x == 0) (void)xb_add(&bar[XB_XCNT(b.x)], 1u);
    return b;
}
__device__ __forceinline__ void xcd_barrier_complete(unsigned* bar, unsigned x, unsigned& nloc, unsigned& nx) {
    const unsigned G = gridDim.x * gridDim.y * gridDim.z;
    unsigned sum, cnt, mine, sp = 0u;
    for (;;) {
        sum = 0u; cnt = 0u; mine = 0u;
#pragma unroll
        for (unsigned j = 0; j < 16; ++j) { const unsigned c = xb_ld(&bar[XB_XCNT(j)]); sum += c; cnt += (c > 0u) ? 1u : 0u; mine = (j == x) ? c : mine; }
        if (sum == G) break;
        __builtin_amdgcn_s_sleep(1);
        if ((++sp & 255u) == 0u) { if (xb_ld(&bar[XB_TMO])) break; if (sp > XB_SPIN_CAP) { atomicAdd(&bar[XB_TMO], 1u); break; } }
    }
    nloc = mine > 0u ? mine : 1u; nx = cnt > 0u ? cnt : 1u;
}

__device__ __forceinline__ void xcd_barrier(const XcdBarrier& b) {
    asm volatile("s_waitcnt vmcnt(0)" ::: "memory");
    __syncthreads();
    if (threadIdx.x == 0) {
        unsigned* bar = b.bar;
        __builtin_amdgcn_s_waitcnt(0);
        unsigned nloc = b.st[0], nx = b.st[1];
        if (nloc == 0u) { xcd_barrier_complete(bar, b.x, nloc, nx); b.st[0] = nloc; b.st[1] = nx; }
        const unsigned old = xb_add(&bar[XB_XSUB(b.x)], 1u);
        const unsigned gen = old / nloc;
        if (old + 1u == (gen + 1u) * nloc) {
            __builtin_amdgcn_fence(__ATOMIC_RELEASE, "agent");
            asm volatile("s_waitcnt vmcnt(0)" ::: "memory");
            const unsigned og = xb_add(&bar[XB_TOP], 1u);
            const unsigned tg = og / nx;
            if (og + 1u == (tg + 1u) * nx) xb_add(&bar[XB_TOPGEN], 1u);
            else XB_SPIN(xb_ld(&bar[XB_TOPGEN]) == tg, bar);
            __builtin_amdgcn_fence(__ATOMIC_ACQUIRE, "agent");
            xb_add(&bar[XB_XGEN(b.x)], 1u);
            asm volatile("s_waitcnt vmcnt(0)" ::: "memory");
        } else {
            XB_SPIN(xb_ld(&bar[XB_XGEN(b.x)]) == gen, bar);
            __builtin_amdgcn_fence(__ATOMIC_ACQUIRE, "agent");
            asm volatile("s_waitcnt vmcnt(0)" ::: "memory");
        }
    }
    __syncthreads();
}

#endif
#ifdef NOINLINE_PHASES
#define NOINL __device__ __attribute__((noinline))
#else
#define NOINL __device__ __forceinline__
#endif
__shared__ __attribute__((aligned(16))) unsigned char g_smem[SMEM_BYTES + 16];
#define PH_COMMON const int G = gridDim.x, bid = blockIdx.x; unsigned char* smem = g_smem; (void)smem; (void)G; (void)bid; \
    const bf16_t* A = (const bf16_t*)(p.ws + WS_A); const bf16_t* Mx = (const bf16_t*)(p.ws + WS_M); const bf16_t* W = (const bf16_t*)(p.ws + WS_W); (void)A; (void)Mx; (void)W;
NOINL void ph0(const Params& p) { PH_COMMON phase0(p, smem); }
NOINL void ph1(const Params& p) { PH_COMMON phase1(p, smem); }
NOINL void ph2(const Params& p) { PH_COMMON EpiL0In e{p.ws}; for (int t = bid; t < (T / 256) * 9; t += G) gemm_tile256(A, W + W_IN0 / 2, (t / 9) * 256, (t % 9) * 256, smem, e); }
NOINL void ph3(const Params& p, int var = 0) { PH_COMMON phase3(p, smem, var); }
NOINL void ph4(const Params& p) { PH_COMMON EpiRes e{&p, 1, 0, 2048}; for (int t = bid; t < (T / 256) * 8; t += G) gemm_tile(Mx, W + W_OUT0 / 2, (t / 8) * 256, (t % 8) * 128, smem, e); }
NOINL void ph5(const Params& p) { PH_COMMON for (int it = bid; it < T / 8; it += G) norm_rows_item(p, it, 0, p.in[I_N2G], 0, 3072); }
NOINL void ph6(const Params& p, int var = 0) { PH_COMMON EpiBf16 e{(bf16_t*)(p.ws + WS_P), 2048}; for (int t = bid; t < (T / 256) * 16; t += G) gemm_tile(A, W + W_Q0 / 2, (t / 16) * 256, (t % 16) * 128, smem, e, var); }
NOINL void ph7(const Params& p) { PH_COMMON topk_phase(p, 0, T, smem); }
NOINL void ph8(const Params& p) { PH_COMMON for (int it = bid; it < T / 8; it += G) peer_item(p, 0, it); }
NOINL void ph9(const Params& p) { PH_COMMON EpiHg e{p.ws, p.in[I_HGLB]};
    for (int t = bid; t < (T / 256) * 20; t += G) { const int mt = t / 20, nt = t % 20; if (mt >= TL / 256 && (nt < 4 || nt >= 16)) continue; gemm_tile256(A, W + W_IN1 / 2, mt * 256, nt * 256, smem, e); } }
NOINL void ph10(const Params& p, int var = 0) { PH_COMMON for (int bi = bid; bi < NB * 32; bi += G) scan_block(p, bi, smem, var); }
NOINL void ph11(const Params& p) { PH_COMMON for (int it = bid; it < TL / 8; it += G) readout_item(p, it); }
NOINL void ph12(const Params& p) { PH_COMMON EpiRes e{&p, 0, 1, 2048}; for (int t = bid; t < (TL / 256) * 4; t += G) gemm_tile256(Mx, W + W_OUT1 / 2, (t / 4) * 256, (t % 4) * 256, smem, e); }
NOINL void ph13(const Params& p) { PH_COMMON for (int it = bid; it < TL / 8; it += G) norm_rows_item(p, it, 0, p.in[I_N2G] + 1024, 1, 3072); }
NOINL void ph14(const Params& p) { PH_COMMON EpiBf16 e{(bf16_t*)(p.ws + WS_P), 2048}; for (int t = bid; t < (TL / 256) * 8; t += G) gemm_tile256(A, W + W_Q1 / 2, (t / 8) * 256, (t % 8) * 256, smem, e); }
NOINL void ph15(const Params& p) { PH_COMMON topk_phase(p, 1, TL, smem); }
NOINL void ph16(const Params& p, int var = 0) { PH_COMMON for (int it = bid; it < TL / 8; it += G) peer_item(p, 1, it, var); }

constexpr int NPHASE = 17;
__global__ void __launch_bounds__(NT, 2) mega(Params p_in) {
    const int ph_lo = p_in.ph_lo, ph_hi = p_in.ph_hi;
#ifndef HOST_EMU
#define GBAR_MAKE() XcdBarrier gbar; gbar.bar = (unsigned*)(p_in.ws + WS_CTRL); gbar.x = xb_xcc_id(); gbar.st = (volatile LAS unsigned*)(LAS unsigned char*)(g_smem + SMEM_BYTES);
    if (ph_hi - ph_lo > 1) {
        volatile LAS unsigned* st = (volatile LAS unsigned*)(LAS unsigned char*)(g_smem + SMEM_BYTES);
        if (threadIdx.x == 0) { st[0] = 0u; st[1] = 0u; }
        __syncthreads();
        (void)xcd_barrier_post((unsigned*)(p_in.ws + WS_CTRL), st);
    }
#endif
    for (int ph = ph_lo; ph < ph_hi; ++ph) {
        if (ph > ph_lo) {
#ifndef HOST_EMU
            { GBAR_MAKE(); xcd_barrier(gbar); }
#endif
        }
#ifndef HOST_EMU
        unsigned long long kp = (unsigned long long)__builtin_amdgcn_kernarg_segment_ptr();
        asm volatile("" : "+s"(kp) :: "memory");
        const Params& p = *(const Params*)(const __attribute__((address_space(4))) Params*)kp;
#else
        const Params& p = p_in;
#endif
#ifdef REPEAT_MASK
        for (int rep_ = ((REPEAT_MASK >> ph) & 1); rep_ >= 0; --rep_) { if (rep_ == 0 && ((REPEAT_MASK >> ph) & 1)) { GBAR_MAKE(); xcd_barrier(gbar); }
#else
        {
#endif
#ifdef ONLY_PHASE
        if (ph != ONLY_PHASE) continue;
        switch (ONLY_PHASE) {
#else
        switch (ph) {
#endif
        case 0: ph0(p); break; case 1: ph1(p); break; case 2: ph2(p); break; case 3:
#if defined(REPEAT_MASK) && defined(P3_VAR)
            ph3(p, rep_ == 1 ? P3_VAR : 0);
#else
            ph3(p);
#endif
            break; case 4: ph4(p); break; case 5: ph5(p); break;
        case 6:
#if defined(REPEAT_MASK) && defined(G_VAR)
            ph6(p, rep_ == 1 ? G_VAR : 0);
#else
            ph6(p);
#endif
            break; case 7: ph7(p); break; case 8: ph8(p); break; case 9: ph9(p); break; case 10:
#if defined(REPEAT_MASK) && defined(SCAN_VAR)
            ph10(p, rep_ == 1 ? SCAN_VAR : 0);
#else
            ph10(p);
#endif
            break; case 11: ph11(p); break;
        case 12: ph12(p); break; case 13: ph13(p); break; case 14: ph14(p); break; case 15: ph15(p); break; case 16:
#if defined(REPEAT_MASK) && defined(PG_VAR)
            ph16(p, rep_ == 1 ? PG_VAR : 0);
#else
            ph16(p);
#endif
            break;
        default: break;
        }
        }
    }
}

#ifndef HOST_EMU
extern "C" void kernel_launch(void* const* d_in, const int* in_sizes, int n_in, void* d_out, int out_size, void* d_ws, size_t ws_size, hipStream_t stream) {
    if (n_in != 29 || ws_size < WS_END || out_size != TL * 1024) { fprintf(stderr, "kernel_launch: unexpected sizes (n_in %d, ws %zu need %zu, out %d)\n", n_in, ws_size, (size_t)WS_END, out_size); return; }
    static int grid = 0;
    if (!grid) { int dev = 0, cus = 0; hipGetDevice(&dev); hipDeviceGetAttribute(&cus, hipDeviceAttributeMultiprocessorCount, dev); grid = cus > 0 ? cus : 256; }
    hipMemsetAsync((unsigned char*)d_ws + WS_CTRL, 0, CTRL_BYTES, stream);
    Params p{};
    for (int i = 0; i < 29; ++i) p.in[i] = (const float*)d_in[i];
    p.out = (float*)d_out; p.ws = (unsigned char*)d_ws;
#ifdef MULTI_LAUNCH
    for (int ph = 0; ph < NPHASE; ++ph) { p.ph_lo = ph; p.ph_hi = ph + 1; hipLaunchKernelGGL(mega, dim3(grid), dim3(NT), 0, stream, p); }
#else
    p.ph_lo = 0; p.ph_hi = NPHASE;
    hipLaunchKernelGGL(mega, dim3(grid), dim3(NT), 0, stream, p);
#endif
}
#endif
```

```cpp
#ifndef HOST_EMU
#include <hip/hip_runtime.h>
#include <cstdio>
#endif

#ifndef CFG_B
#define CFG_B 8
#define CFG_L 2048
#define CFG_LC 256
#endif
#define DEV __device__ __forceinline__
#ifndef HOST_EMU
#define SCHED_FENCE() __builtin_amdgcn_sched_barrier(0)
#endif
#ifdef HOST_EMU
#define SCHED_FENCE() do {} while (0)
#define __expf expf
#define __logf logf
#define __sinf sinf
#define __cosf cosf
#endif

typedef unsigned short bf16_t;
typedef short bf16x8 __attribute__((ext_vector_type(8)));
typedef float f32x16 __attribute__((ext_vector_type(16)));
typedef float f32x4 __attribute__((ext_vector_type(4)));
typedef unsigned u32x4 __attribute__((ext_vector_type(4)));
typedef unsigned u32x2 __attribute__((ext_vector_type(2)));
struct cf2 { float x, y; };

constexpr int NB = CFG_B, L = CFG_L, LC = CFG_LC, D = 1024;
constexpr int TL = NB * L, TC = NB * LC, T = TL + TC;
constexpr int NT = 512;
constexpr int NR = NB + 1;
constexpr int log4ceil(int n) { int s = 0, v = 1; while (v < n) { v *= 4; ++s; } return s; }
constexpr int FS_LAT = log4ceil(2 * L - 1), FS_CTX = log4ceil(2 * LC - 1);
constexpr int NF_LAT = 1 << (2 * FS_LAT), NF_CTX = 1 << (2 * FS_CTX);
static_assert(T % 256 == 0 && TL % 256 == 0 && L % 128 == 0 && LC % 128 == 0 && NB % 2 == 0, "shape");

constexpr size_t al256(size_t x) { return (x + 255) & ~(size_t)255; }
constexpr size_t WS_CTRL = 0, CTRL_BYTES = 65536;
constexpr size_t CTRL_HYNORM = 4096;
constexpr size_t WS_MOD = WS_CTRL + CTRL_BYTES;
constexpr size_t WS_H = al256(WS_MOD + (size_t)2 * NR * 6144 * 4);
constexpr size_t WS_A = al256(WS_H + (size_t)T * 1024 * 4);
constexpr size_t WS_P = al256(WS_A + (size_t)T * 1024 * 2);
constexpr size_t P_BYTES = (size_t)T * 5120 * 2;
constexpr size_t P_HYT_LAT = 0;
constexpr size_t P_HYT_CTX = P_HYT_LAT + (size_t)NB * 1536 * L * 2;
constexpr size_t P_Q0 = P_HYT_CTX + (size_t)NB * 1536 * LC * 2;
constexpr size_t P_K0 = P_Q0 + (size_t)T * 512 * 2;
constexpr size_t P_VT_LAT = P_K0 + (size_t)T * 128 * 2;
constexpr size_t P_VT_CTX = P_VT_LAT + (size_t)NB * 128 * L * 2;
static_assert(P_VT_CTX + (size_t)NB * 128 * LC * 2 <= P_BYTES, "P region");
constexpr size_t P1_KQT_LAT = 0;
constexpr size_t P1_KQT_CTX = P1_KQT_LAT + (size_t)NB * 3072 * L * 2;
constexpr size_t P1_G = P1_KQT_CTX + (size_t)NB * 3072 * LC * 2;
static_assert(P1_G + (size_t)TL * 1024 * 2 <= P_BYTES, "P region (layer 1)");
constexpr size_t WS_M = al256(WS_P + P_BYTES);
constexpr size_t WS_IDX = al256(WS_M + (size_t)T * 1024 * 2);
constexpr size_t WS_GATE = al256(WS_IDX + (size_t)T * 128 * 4);
constexpr size_t WS_U6 = al256(WS_GATE + (size_t)T * 128 * 4);
constexpr size_t WS_V4 = WS_U6 + (size_t)2 * 16384 * 768;
constexpr size_t WS_S8 = WS_V4 + (size_t)2 * 16384 * 512;
constexpr size_t WS_W = al256(WS_S8 + (size_t)4 * 16384 * 4);
constexpr size_t W_IN0 = 0, W_OUT0 = W_IN0 + (size_t)2304 * 1024 * 2, W_IN1 = W_OUT0 + (size_t)1024 * 1024 * 2,
                 W_OUT1 = W_IN1 + (size_t)5120 * 1024 * 2, W_Q0 = W_OUT1 + (size_t)1024 * 1024 * 2, W_Q1 = W_Q0 + (size_t)2048 * 1024 * 2,
                 W_KEYS = W_Q1 + (size_t)2048 * 1024 * 2, W_BYTES = W_KEYS + (size_t)2 * 8 * 2 * 128 * 128 * 2;
constexpr size_t WS_F = al256(WS_W + W_BYTES);
constexpr size_t F_HRAW_LAT = 0;
constexpr size_t F_HRAW_CTX = F_HRAW_LAT + (size_t)2048 * L * 4;
constexpr size_t F_HF_LAT = F_HRAW_CTX + (size_t)2048 * LC * 4;
constexpr size_t F_HF_CTX = F_HF_LAT + (size_t)1024 * NF_LAT * 8;
constexpr size_t F_HYP_LAT = F_HF_CTX + (size_t)1024 * NF_CTX * 8;
constexpr size_t F_HYP_CTX = F_HYP_LAT + (size_t)(L / 64) * 2048 * 4;
constexpr size_t F_END = F_HYP_CTX + (size_t)(LC / 64) * 2048 * 4;
constexpr size_t F_OF = 0, F_OB = (size_t)TL * 1024 * 2;
constexpr size_t F_BYTES = F_END > 2 * F_OB ? F_END : 2 * F_OB;
constexpr size_t WS_END = al256(WS_F + F_BYTES);

struct Params { const float* in[29]; float* out; unsigned char* ws; int ph_lo, ph_hi; };
enum { I_X = 0, I_C, I_CTX, I_CCTX, I_ADAW, I_ADAB, I_N1G, I_N2G, I_FG, I_ABWIN, I_ABWOUT, I_HYCW, I_HYCB, I_HYW1, I_HYB1, I_HYW2, I_HYB2, I_HYW3,
       I_HYFREQ, I_HYSKIP, I_SINK, I_HGWIN, I_HGWOUT, I_HGLB, I_HGON, I_PWQ, I_PKEYS, I_PU, I_PV };

constexpr int SMEM_BYTES = 147456;

#ifndef HOST_EMU
DEV int tidx() { int t = threadIdx.x; asm volatile("" : "+v"(t)); return t; }
#else
DEV int tidx() { return (int)threadIdx.x; }
#endif
#ifndef HOST_EMU
DEV void lds_barrier() { asm volatile("s_waitcnt lgkmcnt(0)" ::: "memory"); __builtin_amdgcn_s_barrier(); asm volatile("" ::: "memory"); }
#else
DEV void lds_barrier() { __syncthreads(); }
#endif
#ifndef HOST_EMU
typedef __bf16 bf16n2 __attribute__((ext_vector_type(2)));
DEV unsigned pk2(float lo, float hi) { bf16n2 v; v[0] = (__bf16)lo; v[1] = (__bf16)hi; return __builtin_bit_cast(unsigned, v); }
DEV unsigned f2bf(float f) { return (unsigned)__builtin_bit_cast(unsigned short, (__bf16)f); }
#else
DEV unsigned f2bf(float f) { unsigned u = __builtin_bit_cast(unsigned, f); return (u + 0x7fffu + ((u >> 16) & 1u)) >> 16; }
DEV unsigned pk2(float lo, float hi) { return f2bf(lo) | (f2bf(hi) << 16); }
#endif
DEV float bf2f(unsigned h) { return __builtin_bit_cast(float, (h & 0xffffu) << 16); }
DEV float bflo(unsigned u) { return __builtin_bit_cast(float, u << 16); }
DEV float bfhi(unsigned u) { return __builtin_bit_cast(float, u & 0xffff0000u); }
DEV float silu_f(float x) { return x / (1.f + __expf(-x)); }
DEV float sigmoid_f(float x) { return 1.f / (1.f + __expf(-x)); }
DEV float wave_sum(float v) {
#pragma unroll
    for (int m = 32; m >= 1; m >>= 1) v += __shfl_xor(v, m);
    return v;
}
DEV int mod_row(int tok) { return tok < TL ? tok / L : NB; }

DEV void p0_mod(const Params& p, int item, unsigned char* smem) {
    const int l = item / 96, col0 = (item % 96) * 64, tid = tidx();
    float* sc = (float*)smem;
    float* red = sc + NR * 1024;
    for (int i = tid; i < NR * 1024; i += NT) { const int r = i >> 10, k = i & 1023; const float c = r < NB ? p.in[I_C][r * 1024 + k] : p.in[I_CCTX][k]; sc[i] = c / (1.f + expf(-c)); }
    __syncthreads();
    const int kq = tid >> 6, col = tid & 63;
    float acc[NR];
#pragma unroll
    for (int r = 0; r < NR; ++r) acc[r] = 0.f;
    const float* w = p.in[I_ADAW] + (size_t)l * 1024 * 6144 + col0 + col;
#pragma unroll 16
    for (int k = kq * 128; k < kq * 128 + 128; ++k) {
        const float wv = w[(size_t)k * 6144];
#pragma unroll
        for (int r = 0; r < NR; ++r) acc[r] += sc[r * 1024 + k] * wv;
    }
#pragma unroll
    for (int r = 0; r < NR; ++r) red[(kq * NR + r) * 64 + col] = acc[r];
    __syncthreads();
    float* mod = (float*)(p.ws + WS_MOD);
    for (int i = tid; i < NR * 64; i += NT) {
        const int r = i >> 6, c = i & 63; float s = 0.f;
        for (int q = 0; q < 8; ++q) s += red[(q * NR + r) * 64 + c];
        mod[((size_t)l * NR + r) * 6144 + col0 + c] = s + p.in[I_ADAB][l * 6144 + col0 + c];
    }
    __syncthreads();
}
DEV void p0_transpose(const float* W, bf16_t* Wt, int N, int tile, unsigned char* smem) {
    float* ts = (float*)smem;
    const int ntn = N / 64, kt = tile / ntn, nt = tile % ntn, k0 = kt * 64, n0 = nt * 64, tid = tidx();
    float rv[8];
#pragma unroll
    for (int m = 0; m < 8; ++m) { const int i = tid + NT * m, kk = i >> 6, nn = i & 63; rv[m] = W[(size_t)(k0 + kk) * N + n0 + nn]; }
#pragma unroll
    for (int m = 0; m < 8; ++m) { const int i = tid + NT * m, kk = i >> 6, nn = i & 63; ts[kk * 65 + nn] = rv[m]; }
    __syncthreads();
#pragma unroll
    for (int m = 0; m < 8; ++m) { const int i = tid + NT * m, nn = i >> 6, kk = i & 63; Wt[(size_t)(n0 + nn) * 1024 + k0 + kk] = (bf16_t)f2bf(ts[kk * 65 + nn]); }
    __syncthreads();
}
DEV void p0_convert(const float* src, bf16_t* dst, int item) {
    const int tid = tidx();
#pragma unroll
    for (int i = 0; i < 8; ++i) {
        const size_t e = (size_t)item * 16384 + (size_t)(i * NT + tid) * 4;
        const f32x4 v = *(const f32x4*)(src + e);
        u32x2 o; o[0] = pk2(v[0], v[1]); o[1] = pk2(v[2], v[3]);
        *(u32x2*)(dst + e) = o;
    }
}
typedef float f32x2 __attribute__((ext_vector_type(2)));
typedef float f32x32 __attribute__((ext_vector_type(32)));
typedef unsigned u32x6 __attribute__((ext_vector_type(6)));
DEV void p0_table(const Params& p, int tab, int item) {
    const int lane = tidx() & 63, li = lane & 31, half = lane >> 5, layer = tab >> 1, isv = tab & 1;
#pragma unroll 1
    for (int pass = 0; pass < 2; ++pass) {
        const int row = item * 32 + pass * 16 + (tidx() >> 6) * 2 + half;
        const float* src = (isv ? p.in[I_PV] : p.in[I_PU]) + ((size_t)layer * 16384 + row) * 1024 + li * 32;
        f32x4 v[8]; float mx = 0.f;
#pragma unroll
        for (int i = 0; i < 8; ++i) { v[i] = *(const f32x4*)(src + 4 * i); mx = fmaxf(mx, fmaxf(fmaxf(fabsf(v[i][0]), fabsf(v[i][1])), fmaxf(fabsf(v[i][2]), fabsf(v[i][3])))); }
#pragma unroll
        for (int m = 16; m >= 1; m >>= 1) mx = fmaxf(mx, __shfl_xor(mx, m));
        const float top = isv ? 6.f : 7.5f;
        const float sc = mx > 0.f ? top / mx : 1.f;
        if (!isv) {
            f32x16 pa, pb;
#pragma unroll
            for (int i = 0; i < 16; ++i) { pa[i] = 0.f; pb[i] = 0.f; }
            pa[1] = 1.0f;
            const f32x32 pr = __builtin_amdgcn_cvt_scalef32_pk32_f32_fp6(__builtin_amdgcn_cvt_scalef32_2xpk16_fp6_f32(pa, pb, 1.0f), 1.0f);
            const bool inter = pr[2] == 1.0f;
            f32x16 lo, hi;
#pragma unroll
            for (int i = 0; i < 4; ++i)
#pragma unroll
                for (int e = 0; e < 4; ++e) {
                    const int j = 4 * i + e;
                    const float lin_lo = v[i][e], lin_hi = v[4 + i][e];
                    const float il_lo = v[(2 * j) >> 2][(2 * j) & 3], il_hi = v[(2 * j + 1) >> 2][(2 * j + 1) & 3];
                    lo[j] = (inter ? il_lo : lin_lo) * sc; hi[j] = (inter ? il_hi : lin_hi) * sc;
                }
            const u32x6 w = __builtin_amdgcn_cvt_scalef32_2xpk16_fp6_f32(lo, hi, 1.0f);
            unsigned char* dst = p.ws + WS_U6 + ((size_t)layer * 16384 + row) * 768;
            u32x4 w0; w0[0] = w[0]; w0[1] = w[1]; w0[2] = w[2]; w0[3] = w[3]; u32x2 w1; w1[0] = w[4]; w1[1] = w[5];
            *(u32x4*)(dst + li * 16) = w0; *(u32x2*)(dst + 512 + li * 8) = w1;
        } else {
            const f32x2 pr4 = __builtin_amdgcn_cvt_scalef32_pk_f32_fp4(__builtin_amdgcn_cvt_scalef32_pk_fp4_f32(0u, 1.0f, 0.0f, 1.0f, 0), 1.0f, 0);
            const bool swp = pr4[0] != 1.0f;
            u32x4 w;
#pragma unroll
            for (int d = 0; d < 4; ++d) { unsigned x = 0u;
                x = __builtin_amdgcn_cvt_scalef32_pk_fp4_f32(x, (swp ? v[2 * d][1] : v[2 * d][0]) * sc, (swp ? v[2 * d][0] : v[2 * d][1]) * sc, 1.0f, 0);
                x = __builtin_amdgcn_cvt_scalef32_pk_fp4_f32(x, (swp ? v[2 * d][3] : v[2 * d][2]) * sc, (swp ? v[2 * d][2] : v[2 * d][3]) * sc, 1.0f, 1);
                x = __builtin_amdgcn_cvt_scalef32_pk_fp4_f32(x, (swp ? v[2 * d + 1][1] : v[2 * d + 1][0]) * sc, (swp ? v[2 * d + 1][0] : v[2 * d + 1][1]) * sc, 1.0f, 2);
                x = __builtin_amdgcn_cvt_scalef32_pk_fp4_f32(x, (swp ? v[2 * d + 1][3] : v[2 * d + 1][2]) * sc, (swp ? v[2 * d + 1][2] : v[2 * d + 1][3]) * sc, 1.0f, 3);
                w[d] = x; }
            *(u32x4*)(p.ws + WS_V4 + ((size_t)layer * 16384 + row) * 512 + li * 16) = w;
        }
        if (li == 0) ((float*)(p.ws + WS_S8))[tab * 16384 + row] = mx > 0.f ? mx / top : 1.f;
    }
}
DEV void p0_filter(const Params& p, int set, int chunk, unsigned char* smem) {
    const int Ls = set ? LC : L, l0 = chunk * 64, tid = tidx();
    float* z = (float*)smem;
    float* hd1 = z + 64 * 34;
    float* hd2 = hd1 + 64 * 65;
    const float* w1 = p.in[I_HYW1]; const float* b1 = p.in[I_HYB1]; const float* w2 = p.in[I_HYW2]; const float* b2 = p.in[I_HYB2];
    const float* w3 = p.in[I_HYW3]; const float* fq = p.in[I_HYFREQ];
    for (int i = tid; i < 64 * 33; i += NT) {
        const int pp = i / 33, f = i % 33, l = l0 + pp; float val;
        if (f == 0) val = (float)l / (float)(Ls - 1);
        else { const int jb = (f - 1) & 15; const float fj = 1e-4f + (float)jb * ((15.f - 1e-4f) / 15.f); const float a = fj * (6.283185307179586f * (float)l / (float)Ls); val = f <= 16 ? __cosf(a) : -__sinf(a); }
        z[pp * 34 + f] = val;
    }
    __syncthreads();
    {
        const int j = tid & 63, p0 = tid >> 6;
        float wc[64], acc[8];
#pragma unroll
        for (int f = 0; f < 33; ++f) wc[f] = w1[f * 64 + j];
#pragma unroll
        for (int m = 0; m < 8; ++m) { float sacc = b1[j];
#pragma unroll
            for (int f = 0; f < 33; ++f) sacc = fmaf(z[(p0 + 8 * m) * 34 + f], wc[f], sacc);
            acc[m] = sacc; }
#pragma unroll
        for (int m = 0; m < 8; ++m) hd1[(p0 + 8 * m) * 65 + j] = __sinf(fq[j] * acc[m]);
        __syncthreads();
#pragma unroll
        for (int f = 0; f < 64; ++f) wc[f] = w2[f * 64 + j];
#pragma unroll
        for (int m = 0; m < 8; ++m) { float sacc = b2[j];
#pragma unroll
            for (int f = 0; f < 64; ++f) sacc = fmaf(hd1[(p0 + 8 * m) * 65 + f], wc[f], sacc);
            acc[m] = sacc; }
#pragma unroll
        for (int m = 0; m < 8; ++m) hd2[(p0 + 8 * m) * 65 + j] = __sinf(fq[j] * acc[m]);
        __syncthreads();
    }
    const float max_decay = -15.350567286626973f, min_decay = -3.0701134573253945f;
    float* hraw = (float*)(p.ws + WS_F + (set ? F_HRAW_CTX : F_HRAW_LAT));
    float* hyn = (float*)(p.ws + WS_F + (set ? F_HYP_CTX : F_HYP_LAT)) + (size_t)chunk * 2048;
    for (int cb = 0; cb < 4; ++cb) {
        const int o = cb * NT + tid;
        const int c = o & 511; const float delta = fabsf(min_decay + (float)c * ((max_decay - min_decay) / 511.f));
        float asum = 0.f;
        float* dst = hraw + (size_t)o * Ls + l0;
        for (int ph = 0; ph < 2; ++ph) {
            float acc[32];
#pragma unroll
            for (int pp = 0; pp < 32; ++pp) acc[pp] = 0.f;
#pragma unroll 1
            for (int j0 = 0; j0 < 64; j0 += 16) {
                float wv[16];
#pragma unroll
                for (int j = 0; j < 16; ++j) wv[j] = w3[(j0 + j) * 2048 + o];
#pragma unroll
                for (int j = 0; j < 16; ++j) {
#pragma unroll
                    for (int pp = 0; pp < 32; ++pp) acc[pp] = fmaf(hd2[(ph * 32 + pp) * 65 + j0 + j], wv[j], acc[pp]);
                    SCHED_FENCE();
                }
            }
#pragma unroll
            for (int q4 = 0; q4 < 8; ++q4) {
                f32x4 v;
#pragma unroll
                for (int e = 0; e < 4; ++e) { const int pp = q4 * 4 + e; const float tl = (float)(l0 + ph * 32 + pp) / (float)(Ls - 1); const float val = acc[pp] * expf(-tl * delta); v[e] = val; asum += fabsf(val); }
                *(f32x4*)(dst + ph * 32 + q4 * 4) = v;
            }
        }
        hyn[o] = asum;
    }
    __syncthreads();
}

constexpr int P0_MOD = 192, P0_TR_IN0 = 16 * 36, P0_TR_OUT0 = 256, P0_TR_IN1 = 16 * 80, P0_TR_OUT1 = 256, P0_TR_Q = 16 * 32, P0_KEYS = 32, P0_TAB = 512,
              P0_FILT = L / 64 + LC / 64;
DEV void phase0(const Params& p, unsigned char* smem) {
    bf16_t* W = (bf16_t*)(p.ws + WS_W);
    const int total = P0_MOD + P0_FILT + P0_TR_IN0 + P0_TR_OUT0 + P0_TR_IN1 + P0_TR_OUT1 + 2 * P0_TR_Q + P0_KEYS + 4 * P0_TAB;
    for (int it = blockIdx.x; it < total; it += gridDim.x) {
        int i = it;
        if (i < P0_MOD) { p0_mod(p, i, smem); continue; } i -= P0_MOD;
        if (i < P0_FILT) { if (i < L / 64) p0_filter(p, 0, i, smem); else p0_filter(p, 1, i - L / 64, smem); continue; } i -= P0_FILT;
        if (i < P0_TR_IN0) { p0_transpose(p.in[I_ABWIN], W + W_IN0 / 2, 2304, i, smem); continue; } i -= P0_TR_IN0;
        if (i < P0_TR_OUT0) { p0_transpose(p.in[I_ABWOUT], W + W_OUT0 / 2, 1024, i, smem); continue; } i -= P0_TR_OUT0;
        if (i < P0_TR_IN1) { p0_transpose(p.in[I_HGWIN], W + W_IN1 / 2, 5120, i, smem); continue; } i -= P0_TR_IN1;
        if (i < P0_TR_OUT1) { p0_transpose(p.in[I_HGWOUT], W + W_OUT1 / 2, 1024, i, smem); continue; } i -= P0_TR_OUT1;
        if (i < P0_TR_Q) { p0_transpose(p.in[I_PWQ], W + W_Q0 / 2, 2048, i, smem); continue; } i -= P0_TR_Q;
        if (i < P0_TR_Q) { p0_transpose(p.in[I_PWQ] + (size_t)1024 * 2048, W + W_Q1 / 2, 2048, i, smem); continue; } i -= P0_TR_Q;
        if (i < P0_KEYS) { p0_convert(p.in[I_PKEYS], W + W_KEYS / 2, i); continue; } i -= P0_KEYS;
        p0_table(p, i / P0_TAB, i % P0_TAB);
    }
}

DEV const float* h_row(const Params& p, int layer_src_inputs, int tok) {
    if (layer_src_inputs) return tok < TL ? p.in[I_X] + (size_t)tok * 1024 : p.in[I_CTX] + (size_t)(tok - TL) * 1024;
    return (const float*)(p.ws + WS_H) + (size_t)tok * 1024;
}
DEV void norm_row_store(const Params& p, const f32x4 (&v)[4], int tok, const float* g, int layer, int sh_off, int lane) {
    float ss = 0.f;
#pragma unroll
    for (int i = 0; i < 4; ++i) ss += v[i][0] * v[i][0] + v[i][1] * v[i][1] + v[i][2] * v[i][2] + v[i][3] * v[i][3];
    ss = wave_sum(ss);
    const float rstd = rsqrtf(ss * (1.f / 1024.f) + 1e-6f);
    const float* mod = (const float*)(p.ws + WS_MOD) + ((size_t)layer * NR + mod_row(tok)) * 6144 + sh_off;
    bf16_t* A = (bf16_t*)(p.ws + WS_A) + (size_t)tok * 1024;
#pragma unroll
    for (int i = 0; i < 4; ++i) {
        const int c = i * 256 + lane * 4;
        const f32x4 gg = *(const f32x4*)(g + c), sh = *(const f32x4*)(mod + c), sc = *(const f32x4*)(mod + 1024 + c);
        u32x2 o;
        o[0] = pk2(v[i][0] * rstd * gg[0] * (1.f + sc[0]) + sh[0], v[i][1] * rstd * gg[1] * (1.f + sc[1]) + sh[1]);
        o[1] = pk2(v[i][2] * rstd * gg[2] * (1.f + sc[2]) + sh[2], v[i][3] * rstd * gg[3] * (1.f + sc[3]) + sh[3]);
        *(u32x2*)(A + c) = o;
    }
}
DEV void norm_rows_item(const Params& p, int item, int from_inputs, const float* g, int layer, int sh_off) {
    const int tok = item * 8 + (tidx() >> 6), lane = tidx() & 63;
    const float* src = h_row(p, from_inputs, tok);
    f32x4 v[4];
#pragma unroll
    for (int i = 0; i < 4; ++i) v[i] = *(const f32x4*)(src + i * 256 + lane * 4);
    norm_row_store(p, v, tok, g, layer, sh_off, lane);
}

DEV cf2 cmul(cf2 a, cf2 b) { cf2 r; r.x = a.x * b.x - a.y * b.y; r.y = a.x * b.y + a.y * b.x; return r; }
DEV cf2 twid(int k, float invN) { cf2 r; const float a = (float)k * invN; r.x = __builtin_amdgcn_cosf(a); r.y = -__builtin_amdgcn_sinf(a); return r; }
DEV int fsw(int i) { return i ^ ((i >> 4) & 15) ^ (((i >> 8) & 1) << 4); }
DEV void bfly4_fwd(cf2& a0, cf2& a1, cf2& a2, cf2& a3) {
    cf2 t0, t1, t2, t3; t0.x = a0.x + a2.x; t0.y = a0.y + a2.y; t1.x = a0.x - a2.x; t1.y = a0.y - a2.y; t2.x = a1.x + a3.x; t2.y = a1.y + a3.y;
    const float dx = a1.x - a3.x, dy = a1.y - a3.y; t3.x = dy; t3.y = -dx;
    a0.x = t0.x + t2.x; a0.y = t0.y + t2.y; a1.x = t1.x + t3.x; a1.y = t1.y + t3.y; a2.x = t0.x - t2.x; a2.y = t0.y - t2.y; a3.x = t1.x - t3.x; a3.y = t1.y - t3.y;
}
DEV void bfly4_inv(cf2& c0, cf2& c1, cf2& c2, cf2& c3) {
    cf2 t0, t1, t2, t3; t0.x = c0.x + c2.x; t0.y = c0.y + c2.y; t1.x = c0.x - c2.x; t1.y = c0.y - c2.y; t2.x = c1.x + c3.x; t2.y = c1.y + c3.y;
    const float dx = c1.x - c3.x, dy = c1.y - c3.y; t3.x = -dy; t3.y = dx;
    c0.x = t0.x + t2.x; c0.y = t0.y + t2.y; c1.x = t1.x + t3.x; c1.y = t1.y + t3.y; c2.x = t0.x - t2.x; c2.y = t0.y - t2.y; c3.x = t1.x - t3.x; c3.y = t1.y - t3.y;
}
DEV void fft_stage4(cf2* buf, int S, int s, int g, int G, bool inv) {
    const int N = 1 << (2 * S); const float invN = 1.f / (float)N;
    const int lm = 2 * (S - s), m = 1 << lm, q = m >> 2;
    for (int bf = g; bf < (N >> 2); bf += G) {
        const int j = bf & (q - 1), base = ((bf >> (lm - 2)) << lm) + j, tw = j << (2 * s);
        cf2 a0 = buf[fsw(base)], a1 = buf[fsw(base + q)], a2 = buf[fsw(base + 2 * q)], a3 = buf[fsw(base + 3 * q)];
        if (!inv) { bfly4_fwd(a0, a1, a2, a3); a1 = cmul(a1, twid(tw, invN)); a2 = cmul(a2, twid(2 * tw, invN)); a3 = cmul(a3, twid(3 * tw, invN)); }
        else { cf2 w1 = twid(tw, invN), w2 = twid(2 * tw, invN), w3 = twid(3 * tw, invN); w1.y = -w1.y; w2.y = -w2.y; w3.y = -w3.y; a1 = cmul(a1, w1); a2 = cmul(a2, w2); a3 = cmul(a3, w3); bfly4_inv(a0, a1, a2, a3); }
        buf[fsw(base)] = a0; buf[fsw(base + q)] = a1; buf[fsw(base + 2 * q)] = a2; buf[fsw(base + 3 * q)] = a3;
    }
}
DEV void fft_stage16(cf2* buf, int S, int s, int g, int G, bool inv) {
    const int N = 1 << (2 * S); const float invN = 1.f / (float)N;
    const int lm = 2 * (S - s), m = 1 << lm, q = m >> 2, q2 = q >> 2;
    for (int u = g; u < (N >> 4); u += G) {
        const int j2 = u & (q2 - 1), base = ((u >> (lm - 4)) << lm) + j2;
        cf2 x[4][4];
#pragma unroll
        for (int c = 0; c < 4; ++c)
#pragma unroll
            for (int c2 = 0; c2 < 4; ++c2) x[c][c2] = buf[fsw(base + c * q + c2 * q2)];
        if (!inv) {
#pragma unroll
            for (int c2 = 0; c2 < 4; ++c2) {
                const int tw = (j2 + c2 * q2) << (2 * s);
                bfly4_fwd(x[0][c2], x[1][c2], x[2][c2], x[3][c2]);
                x[1][c2] = cmul(x[1][c2], twid(tw, invN)); x[2][c2] = cmul(x[2][c2], twid(2 * tw, invN)); x[3][c2] = cmul(x[3][c2], twid(3 * tw, invN));
            }
            const int tw2 = j2 << (2 * (s + 1));
            const cf2 v1 = twid(tw2, invN), v2 = twid(2 * tw2, invN), v3 = twid(3 * tw2, invN);
#pragma unroll
            for (int c = 0; c < 4; ++c) {
                bfly4_fwd(x[c][0], x[c][1], x[c][2], x[c][3]);
                x[c][1] = cmul(x[c][1], v1); x[c][2] = cmul(x[c][2], v2); x[c][3] = cmul(x[c][3], v3);
            }
        } else {
            const int tw2 = j2 << (2 * (s + 1));
            cf2 v1 = twid(tw2, invN), v2 = twid(2 * tw2, invN), v3 = twid(3 * tw2, invN); v1.y = -v1.y; v2.y = -v2.y; v3.y = -v3.y;
#pragma unroll
            for (int c = 0; c < 4; ++c) {
                x[c][1] = cmul(x[c][1], v1); x[c][2] = cmul(x[c][2], v2); x[c][3] = cmul(x[c][3], v3);
                bfly4_inv(x[c][0], x[c][1], x[c][2], x[c][3]);
            }
#pragma unroll
            for (int c2 = 0; c2 < 4; ++c2) {
                const int tw = (j2 + c2 * q2) << (2 * s);
                cf2 w1 = twid(tw, invN), w2 = twid(2 * tw, invN), w3 = twid(3 * tw, invN); w1.y = -w1.y; w2.y = -w2.y; w3.y = -w3.y;
                x[1][c2] = cmul(x[1][c2], w1); x[2][c2] = cmul(x[2][c2], w2); x[3][c2] = cmul(x[3][c2], w3);
                bfly4_inv(x[0][c2], x[1][c2], x[2][c2], x[3][c2]);
            }
        }
#pragma unroll
        for (int c = 0; c < 4; ++c)
#pragma unroll
            for (int c2 = 0; c2 < 4; ++c2) buf[fsw(base + c * q + c2 * q2)] = x[c][c2];
    }
}
DEV void fft_fwd(cf2* buf, int S, int g, int G) {
    int s = 0;
    for (; s + 1 < S; s += 2) { fft_stage16(buf, S, s, g, G, false); __syncthreads(); }
    if (s < S) { fft_stage4(buf, S, s, g, G, false); __syncthreads(); }
}
DEV void fft_inv(cf2* buf, int S, int g, int G) {
    int s = S - 1;
    if (S & 1) { fft_stage4(buf, S, s, g, G, true); __syncthreads(); --s; }
    for (; s >= 1; s -= 2) { fft_stage16(buf, S, s - 1, g, G, true); __syncthreads(); }
}
DEV void hf_item(const Params& p, int set, int pi, unsigned char* smem) {
    const int Ls = set ? LC : L, S = set ? FS_CTX : FS_LAT, N = 1 << (2 * S);
    const int gi = tidx() >> 8, g = tidx() & 255, idx = pi * 2 + gi, o = idx >> 9, c = idx & 511;
    cf2* buf = (cf2*)smem + (size_t)gi * N;
    const float* hraw = (const float*)(p.ws + WS_F + (set ? F_HRAW_CTX : F_HRAW_LAT));
    const float* hyn = (const float*)(p.ws + WS_F + (set ? F_HYP_CTX : F_HYP_LAT));
    float nsum = 0.f;
    for (int ch = 0; ch < Ls / 64; ++ch) nsum += hyn[(size_t)ch * 2048 + o * 1024 + c] + hyn[(size_t)ch * 2048 + o * 1024 + 512 + c];
    const float inv = 1.f / nsum;
    const float* hf = hraw + (size_t)(o * 1024 + c) * Ls; const float* hb = hraw + (size_t)(o * 1024 + 512 + c) * Ls;
#pragma unroll 4
    for (int k = g; k < N; k += 256) { float re = 0.f; if (k < Ls) re = hf[k] * inv; else if (k > N - Ls) re = hb[N - k] * inv; cf2 v; v.x = re; v.y = 0.f; buf[fsw(k)] = v; }
    __syncthreads();
    fft_fwd(buf, S, g, 256);
    cf2* HF = (cf2*)(p.ws + WS_F + (set ? F_HF_CTX : F_HF_LAT)) + (size_t)(o * 512 + c) * N;
    for (int k = g; k < N; k += 256) HF[k] = buf[fsw(k)];
    __syncthreads();
}
constexpr int P1_NORM = T / 8, P1_HF = 512;
DEV void phase1(const Params& p, unsigned char* smem) {
    const int total = P1_NORM + 2 * P1_HF;
    for (int it = blockIdx.x; it < total; it += gridDim.x) {
        if (it < P1_NORM) norm_rows_item(p, it, 1, p.in[I_N1G], 0, 0);
        else if (it < P1_NORM + P1_HF) hf_item(p, 0, it - P1_NORM, smem);
        else hf_item(p, 1, it - P1_NORM - P1_HF, smem);
    }
}

constexpr int G_LDA = 72;
template <class Epi>
DEV void gemm_tile(const bf16_t* __restrict__ A, const bf16_t* __restrict__ Wt, int m0, int n0, unsigned char* smem, const Epi& epi, int var = 0) {
    bf16_t* As = (bf16_t*)smem;
    bf16_t* Bs = As + 2 * 256 * G_LDA;
    const int tid = tidx(), lane = tid & 63, w = tid >> 6, wm = w >> 1, wn = w & 1;
    f32x16 acc[2][2];
#pragma unroll
    for (int i = 0; i < 2; ++i)
#pragma unroll
        for (int j = 0; j < 2; ++j)
#pragma unroll
            for (int r = 0; r < 16; ++r) acc[i][j][r] = 0.f;
    u32x4 ra[4], rb[2];
    const bf16_t* Ag = A + (size_t)m0 * 1024; const bf16_t* Bg = Wt + (size_t)n0 * 1024;
#define GLOAD(k0) do { \
        _Pragma("unroll") for (int i = 0; i < 4; ++i) { const int id = tid + NT * i, row = id >> 3, kc = id & 7; ra[i] = *(const u32x4*)(Ag + (size_t)row * 1024 + (k0) + kc * 8); } \
        _Pragma("unroll") for (int i = 0; i < 2; ++i) { const int id = tid + NT * i, row = id >> 3, kc = id & 7; rb[i] = *(const u32x4*)(Bg + (size_t)row * 1024 + (k0) + kc * 8); } } while (0)
#define LSTORE(buf_) do { \
        _Pragma("unroll") for (int i = 0; i < 4; ++i) { const int id = tid + NT * i, row = id >> 3, kc = id & 7; *(u32x4*)(As + ((buf_) * 256 + row) * G_LDA + kc * 8) = ra[i]; } \
        _Pragma("unroll") for (int i = 0; i < 2; ++i) { const int id = tid + NT * i, row = id >> 3, kc = id & 7; *(u32x4*)(Bs + ((buf_) * 128 + row) * G_LDA + kc * 8) = rb[i]; } } while (0)
    GLOAD(0); LSTORE(0); __syncthreads();
    for (int kt = 0; kt < (var == 2 ? 1 : 16); ++kt) {
        const int buf = kt & 1;
        if (kt + 1 < 16) GLOAD((kt + 1) * 64);
        const bf16_t* as = As + (buf * 256 + wm * 64 + (lane & 31)) * G_LDA + 8 * (lane >> 5);
        const bf16_t* bs = Bs + (buf * 128 + wn * 64 + (lane & 31)) * G_LDA + 8 * (lane >> 5);
#pragma unroll
        for (int kk = 0; kk < 4; ++kk) {
            const bf16x8 a0 = *(const bf16x8*)(as + kk * 16), a1 = *(const bf16x8*)(as + 32 * G_LDA + kk * 16);
            const bf16x8 b0 = *(const bf16x8*)(bs + kk * 16), b1 = *(const bf16x8*)(bs + 32 * G_LDA + kk * 16);
            acc[0][0] = __builtin_amdgcn_mfma_f32_32x32x16_bf16(a0, b0, acc[0][0], 0, 0, 0);
            acc[0][1] = __builtin_amdgcn_mfma_f32_32x32x16_bf16(a0, b1, acc[0][1], 0, 0, 0);
            acc[1][0] = __builtin_amdgcn_mfma_f32_32x32x16_bf16(a1, b0, acc[1][0], 0, 0, 0);
            acc[1][1] = __builtin_amdgcn_mfma_f32_32x32x16_bf16(a1, b1, acc[1][1], 0, 0, 0);
        }
        if (kt + 1 < 16) LSTORE(buf ^ 1);
        __syncthreads();
    }
#ifndef HOST_EMU
    if (var == 1) { asm volatile("" :: "v"(acc[0][0]), "v"(acc[0][1]), "v"(acc[1][0]), "v"(acc[1][1])); return; }
#endif
#pragma unroll
    for (int mi = 0; mi < 2; ++mi)
#pragma unroll
        for (int ni = 0; ni < 2; ++ni)
#pragma unroll
            for (int rg = 0; rg < 4; ++rg) {
                const int row = m0 + wm * 64 + mi * 32 + 8 * rg + 4 * (lane >> 5), col = n0 + wn * 64 + ni * 32 + (lane & 31);
                epi(row, col, acc[mi][ni][rg * 4 + 0], acc[mi][ni][rg * 4 + 1], acc[mi][ni][rg * 4 + 2], acc[mi][ni][rg * 4 + 3]);
            }
}
template <class Epi>
DEV void gemm_tile256(const bf16_t* __restrict__ A, const bf16_t* __restrict__ Wt, int m0, int n0, unsigned char* smem, const Epi& epi) {
    bf16_t* As = (bf16_t*)smem;
    bf16_t* Bs = As + 2 * 256 * G_LDA;
    const int tid = tidx(), lane = tid & 63, w = tid >> 6, wm = w >> 2, wn = w & 3;
    f32x16 acc[4][2];
#pragma unroll
    for (int i = 0; i < 4; ++i)
#pragma unroll
        for (int j = 0; j < 2; ++j)
#pragma unroll
            for (int r = 0; r < 16; ++r) acc[i][j][r] = 0.f;
    u32x4 ra[4], rb[4];
    const bf16_t* Ag = A + (size_t)m0 * 1024; const bf16_t* Bg = Wt + (size_t)n0 * 1024;
#define GLOAD2(k0) do { \
        _Pragma("unroll") for (int i = 0; i < 4; ++i) { const int id = tid + NT * i, row = id >> 3, kc = id & 7; ra[i] = *(const u32x4*)(Ag + (size_t)row * 1024 + (k0) + kc * 8); rb[i] = *(const u32x4*)(Bg + (size_t)row * 1024 + (k0) + kc * 8); } } while (0)
#define LSTORE2(buf_) do { \
        _Pragma("unroll") for (int i = 0; i < 4; ++i) { const int id = tid + NT * i, row = id >> 3, kc = id & 7; *(u32x4*)(As + ((buf_) * 256 + row) * G_LDA + kc * 8) = ra[i]; *(u32x4*)(Bs + ((buf_) * 256 + row) * G_LDA + kc * 8) = rb[i]; } } while (0)
    GLOAD2(0); LSTORE2(0); __syncthreads();
    for (int kt = 0; kt < 16; ++kt) {
        const int buf = kt & 1;
        if (kt + 1 < 16) GLOAD2((kt + 1) * 64);
        const bf16_t* as = As + (buf * 256 + wm * 128 + (lane & 31)) * G_LDA + 8 * (lane >> 5);
        const bf16_t* bs = Bs + (buf * 256 + wn * 64 + (lane & 31)) * G_LDA + 8 * (lane >> 5);
#pragma unroll
        for (int kk = 0; kk < 4; ++kk) {
            bf16x8 af[4], bfr[2];
#pragma unroll
            for (int i = 0; i < 4; ++i) af[i] = *(const bf16x8*)(as + i * 32 * G_LDA + kk * 16);
#pragma unroll
            for (int j = 0; j < 2; ++j) bfr[j] = *(const bf16x8*)(bs + j * 32 * G_LDA + kk * 16);
#pragma unroll
            for (int i = 0; i < 4; ++i)
#pragma unroll
                for (int j = 0; j < 2; ++j) acc[i][j] = __builtin_amdgcn_mfma_f32_32x32x16_bf16(af[i], bfr[j], acc[i][j], 0, 0, 0);
        }
        if (kt + 1 < 16) LSTORE2(buf ^ 1);
        __syncthreads();
    }
#undef GLOAD2
#undef LSTORE2
#pragma unroll
    for (int mi = 0; mi < 4; ++mi)
#pragma unroll
        for (int ni = 0; ni < 2; ++ni)
#pragma unroll
            for (int rg = 0; rg < 4; ++rg) {
                const int row = m0 + wm * 128 + mi * 32 + 8 * rg + 4 * (lane >> 5), col = n0 + wn * 64 + ni * 32 + (lane & 31);
                epi(row, col, acc[mi][ni][rg * 4 + 0], acc[mi][ni][rg * 4 + 1], acc[mi][ni][rg * 4 + 2], acc[mi][ni][rg * 4 + 3]);
            }
}
struct EpiL0In {
    unsigned char* ws;
    DEV void operator()(int row, int col, float v0, float v1, float v2, float v3) const {
        u32x2 o; o[0] = pk2(v0, v1); o[1] = pk2(v2, v3);
        const bool lat = row < TL; const int b = lat ? row / L : (row - TL) / LC, t = lat ? row - b * L : (row - TL) - b * LC, Lx = lat ? L : LC;
        if (col < 1536) { bf16_t* d = (bf16_t*)(ws + WS_P + (lat ? P_HYT_LAT : P_HYT_CTX)) + ((size_t)b * 1536 + col) * Lx + t; *(u32x2*)d = o; }
        else if (col < 2048) { bf16_t* d = (bf16_t*)(ws + WS_P + P_Q0) + (size_t)row * 512 + (col - 1536); d[0] = (bf16_t)f2bf(v0); d[512] = (bf16_t)f2bf(v1); d[1024] = (bf16_t)f2bf(v2); d[1536] = (bf16_t)f2bf(v3); }
        else if (col < 2176) { bf16_t* d = (bf16_t*)(ws + WS_P + P_K0) + (size_t)row * 128 + (col - 2048); d[0] = (bf16_t)f2bf(v0); d[128] = (bf16_t)f2bf(v1); d[256] = (bf16_t)f2bf(v2); d[384] = (bf16_t)f2bf(v3); }
        else { bf16_t* d = (bf16_t*)(ws + WS_P + (lat ? P_VT_LAT : P_VT_CTX)) + ((size_t)b * 128 + (col - 2176)) * Lx + t; *(u32x2*)d = o; }
    }
};
struct EpiBf16 {
    bf16_t* out; int ld;
    DEV void operator()(int row, int col, float v0, float v1, float v2, float v3) const {
        bf16_t* d = out + (size_t)row * ld + col; d[0] = (bf16_t)f2bf(v0); d[ld] = (bf16_t)f2bf(v1); d[2 * ld] = (bf16_t)f2bf(v2); d[3 * ld] = (bf16_t)f2bf(v3);
    }
};
struct EpiHg {
    unsigned char* ws; const float* lg;
    DEV void operator()(int row, int col, float v0, float v1, float v2, float v3) const {
        float vv[4] = {v0, v1, v2, v3};
        const bool lat = row < TL; const int b = lat ? row / L : (row - TL) / LC, t = lat ? row - b * L : (row - TL) - b * LC, Lx = lat ? L : LC;
        if (col >= 3072 && col < 4096) {
            bf16_t* d = (bf16_t*)(ws + WS_M) + (lat ? (size_t)0 : (size_t)NB * 1024 * L) + ((size_t)b * 1024 + (col - 3072)) * Lx + t;
            u32x2 o; o[0] = pk2(v0, v1); o[1] = pk2(v2, v3); *(u32x2*)d = o;
            return;
        }
        if (col < 1024 || col >= 4096) {
#pragma unroll
            for (int i = 0; i < 4; ++i) vv[i] = silu_f(vv[i]);
        } else {
            const int c = col - 1024;
            const float oml = 1.f - 1.f / (1.f + __expf(lg[c] - lg[2048 + c]));
#pragma unroll
            for (int i = 0; i < 4; ++i) vv[i] = oml / (1.f + __expf(vv[i]));
        }
        if (col < 3072) {
            bf16_t* d = (bf16_t*)(ws + WS_P + (lat ? P1_KQT_LAT : P1_KQT_CTX)) + ((size_t)b * 3072 + col) * Lx + t;
            u32x2 o; o[0] = pk2(vv[0], vv[1]); o[1] = pk2(vv[2], vv[3]); *(u32x2*)d = o;
        } else {
            bf16_t* d = (bf16_t*)(ws + WS_P + P1_G) + (size_t)row * 1024 + (col - 4096); d[0] = (bf16_t)f2bf(vv[0]); d[1024] = (bf16_t)f2bf(vv[1]); d[2048] = (bf16_t)f2bf(vv[2]); d[3072] = (bf16_t)f2bf(vv[3]);
        }
    }
};
struct EpiRes {
    const Params* p; int from_inputs, layer, goff;
    DEV void operator()(int row, int col, float v0, float v1, float v2, float v3) const {
        const float vv[4] = {v0, v1, v2, v3};
        float* H = (float*)(p->ws + WS_H);
        const float* mod = (const float*)(p->ws + WS_MOD) + (size_t)layer * NR * 6144 + goff + col;
#pragma unroll
        for (int i = 0; i < 4; ++i) { const int r = row + i; H[(size_t)r * 1024 + col] = h_row(*p, from_inputs, r)[col] + mod[(size_t)mod_row(r) * 6144] * vv[i]; }
    }
};

DEV float hy_u(const bf16_t* row, int t, int Lx, float w0, float w1, float w2, float b) {
    const float xm = t > 0 ? bf2f(row[t - 1]) : 0.f, x0 = bf2f(row[t]), xp = t + 1 < Lx ? bf2f(row[t + 1]) : 0.f;
    return w0 * xm + w1 * x0 + w2 * xp + b;
}
DEV void hyena_item(const Params& p, int set, int item, unsigned char* smem) {
    const int Ls = set ? LC : L, S = set ? FS_CTX : FS_LAT, N = 1 << (2 * S);
    const int gi = tidx() >> 8, g = tidx() & 255;
    const int bp = item >> 8, c = (item & 255) * 2 + gi, ba = bp * 2, bb = ba + 1;
    cf2* buf = (cf2*)smem + (size_t)gi * N;
    cf2* zk = (cf2*)smem + (size_t)2 * N + (size_t)gi * Ls;
    const bf16_t* hy = (const bf16_t*)(p.ws + WS_P + (set ? P_HYT_CTX : P_HYT_LAT));
    const float* cw = p.in[I_HYCW]; const float* cb = p.in[I_HYCB];
    const cf2* HF = (const cf2*)(p.ws + WS_F + (set ? F_HF_CTX : F_HF_LAT));
    const float invN = 1.f / (float)N;
    {
        const float w0 = cw[c], w1 = cw[1536 + c], w2 = cw[3072 + c], b = cb[c];
        const bf16_t* ra = hy + ((size_t)ba * 1536 + c) * Ls; const bf16_t* rb = hy + ((size_t)bb * 1536 + c) * Ls;
#pragma unroll 4
        for (int t = g; t < N; t += 256) { cf2 v; v.x = 0.f; v.y = 0.f; if (t < Ls) { v.x = hy_u(ra, t, Ls, w0, w1, w2, b); v.y = hy_u(rb, t, Ls, w0, w1, w2, b); zk[t] = v; } buf[fsw(t)] = v; }
    }
    __syncthreads();
    for (int n = 0; n < 2; ++n) {
        fft_fwd(buf, S, g, 256);
        const cf2* hf = HF + (size_t)(n * 512 + c) * N;
        for (int k0 = g; k0 < N; k0 += 1024) {
            cf2 hv[4];
#pragma unroll
            for (int u = 0; u < 4; ++u) { hv[u].x = 0.f; hv[u].y = 0.f; if (k0 + 256 * u < N) hv[u] = hf[k0 + 256 * u]; }
#pragma unroll
            for (int u = 0; u < 4; ++u) { const int k = k0 + 256 * u; if (k < N) buf[fsw(k)] = cmul(buf[fsw(k)], hv[u]); }
        }
        __syncthreads();
        fft_inv(buf, S, g, 256);
        const int gc = (n + 1) * 512 + c;
        const float w0 = cw[gc], w1 = cw[1536 + gc], w2 = cw[3072 + gc], b = cb[gc], dsk = p.in[I_HYSKIP][n * 512 + c];
        const bf16_t* ra = hy + ((size_t)ba * 1536 + gc) * Ls; const bf16_t* rb = hy + ((size_t)bb * 1536 + gc) * Ls;
        bf16_t* M = (bf16_t*)(p.ws + WS_M);
#pragma unroll 4
        for (int t = g; t < N; t += 256) {
            cf2 v; v.x = 0.f; v.y = 0.f;
            if (t < Ls) {
                const cf2 cv = buf[fsw(t)], zo = zk[t];
                v.x = hy_u(ra, t, Ls, w0, w1, w2, b) * (cv.x * invN + dsk * zo.x); v.y = hy_u(rb, t, Ls, w0, w1, w2, b) * (cv.y * invN + dsk * zo.y);
                if (n == 0) zk[t] = v;
                else { const size_t ta = set ? (size_t)TL + (size_t)ba * LC + t : (size_t)ba * L + t, tb = set ? (size_t)TL + (size_t)bb * LC + t : (size_t)bb * L + t;
                       M[ta * 1024 + c] = (bf16_t)f2bf(v.x); M[tb * 1024 + c] = (bf16_t)f2bf(v.y); }
            }
            if (n == 0) buf[fsw(t)] = v;
        }
        __syncthreads();
    }
}
DEV void rope_store(const bf16_t* src, bf16_t* dst, int pos, bool rope, float scale, int ph, int sub) {
    const u32x4 ua = *(const u32x4*)(src + ph * 32 + sub * 8), ub = *(const u32x4*)(src + ph * 32 + 16 + sub * 8);
    float a[8], b[8];
#pragma unroll
    for (int i = 0; i < 4; ++i) { a[2 * i] = bflo(ua[i]); a[2 * i + 1] = bfhi(ua[i]); b[2 * i] = bflo(ub[i]); b[2 * i + 1] = bfhi(ub[i]); }
    if (rope) {
        const float pv = (float)(ph == 0 ? pos / 64 : pos % 64);
#pragma unroll
        for (int e = 0; e < 8; ++e) {
            const float inv = exp2f(-(float)(sub * 8 + e) * (13.287712379549449f / 16.f));
            const float ang = pv * inv, cs = __cosf(ang), sn = __sinf(ang);
            const float na = a[e] * cs - b[e] * sn, nb = b[e] * cs + a[e] * sn; a[e] = na; b[e] = nb;
        }
    }
    u32x4 oa, ob;
#pragma unroll
    for (int i = 0; i < 4; ++i) { oa[i] = pk2(a[2 * i] * scale, a[2 * i + 1] * scale); ob[i] = pk2(b[2 * i] * scale, b[2 * i + 1] * scale); }
    *(u32x4*)(dst + ph * 32 + sub * 8) = oa; *(u32x4*)(dst + ph * 32 + 16 + sub * 8) = ob;
}
constexpr int A_LDQ = 72, A_LDV = 136;
DEV void attn_item(const Params& p, int set, int item, unsigned char* smem) {
    bf16_t* Qs = (bf16_t*)smem;
    bf16_t* Ks = Qs + 128 * A_LDQ;
    bf16_t* Vt = Ks + 128 * A_LDQ;
    const int tid = tidx(), lane = tid & 63, w = tid >> 6, l15 = lane & 15, lg = lane >> 4;
    const int nqb = set ? LC / 128 : L / 128;
    const int h = item & 7, qb = (item >> 3) % nqb, b = (item >> 3) / nqb, kvh = h >> 2;
    const bf16_t* Q0 = (const bf16_t*)(p.ws + WS_P + P_Q0); const bf16_t* K0 = (const bf16_t*)(p.ws + WS_P + P_K0);
    const int qtok0 = set ? TL + b * LC + qb * 128 : b * L + qb * 128;
    { const int row = tid >> 2, ph = (tid >> 1) & 1, sub = tid & 1;
      rope_store(Q0 + (size_t)(qtok0 + row) * 512 + h * 64, Qs + row * A_LDQ, qb * 128 + row, set == 0, 0.125f, ph, sub); }
    __syncthreads();
    bf16x8 qf[2];
    qf[0] = *(const bf16x8*)(Qs + (w * 16 + l15) * A_LDQ + 8 * lg); qf[1] = *(const bf16x8*)(Qs + (w * 16 + l15) * A_LDQ + 32 + 8 * lg);
    float m_run = p.in[I_SINK][h], l_run = 1.f;
    f32x4 O[4];
#pragma unroll
    for (int i = 0; i < 4; ++i) O[i] = (f32x4){0.f, 0.f, 0.f, 0.f};
    const int nwin = set ? 0 : 3, nctx = LC / 128;
    for (int kbi = 0; kbi < nwin + nctx; ++kbi) {
        const bool win = kbi < nwin; const int kb = win ? qb - 1 + kbi : kbi - nwin;
        if (win && (kb < 0 || kb >= L / 128)) continue;
        const int ktok0 = win ? b * L + kb * 128 : TL + b * LC + kb * 128;
        __syncthreads();
        { const int row = tid >> 2, ph = (tid >> 1) & 1, sub = tid & 1;
          rope_store(K0 + (size_t)(ktok0 + row) * 128 + kvh * 64, Ks + row * A_LDQ, kb * 128 + row, win, 1.f, ph, sub); }
        { const bf16_t* vt = (const bf16_t*)(p.ws + WS_P + (win ? P_VT_LAT : P_VT_CTX)); const int Lx = win ? L : LC;
#pragma unroll
          for (int i = 0; i < 2; ++i) { const int id = tid + NT * i, d = id >> 4, kc = id & 15;
              *(u32x4*)(Vt + d * A_LDV + kc * 8) = *(const u32x4*)(vt + ((size_t)b * 128 + kvh * 64 + d) * Lx + kb * 128 + kc * 8); } }
        __syncthreads();
#pragma unroll
        for (int ch = 0; ch < 2; ++ch) {
            f32x4 st[4];
#pragma unroll
            for (int u = 0; u < 4; ++u) {
                const bf16_t* kr = Ks + ((ch * 4 + u) * 16 + l15) * A_LDQ + 8 * lg;
                f32x4 z = (f32x4){0.f, 0.f, 0.f, 0.f};
                z = __builtin_amdgcn_mfma_f32_16x16x32_bf16(*(const bf16x8*)kr, qf[0], z, 0, 0, 0);
                z = __builtin_amdgcn_mfma_f32_16x16x32_bf16(*(const bf16x8*)(kr + 32), qf[1], z, 0, 0, 0);
                st[u] = z;
            }
            float cmax = -INFINITY;
            if (win) {
                const int qpos = qb * 128 + w * 16 + l15;
#pragma unroll
                for (int u = 0; u < 4; ++u)
#pragma unroll
                    for (int r = 0; r < 4; ++r) { const int kpos = kb * 128 + (ch * 4 + u) * 16 + 4 * lg + r; const int dd = qpos - kpos; if (dd > 128 || dd < -128) st[u][r] = -INFINITY; }
            }
#pragma unroll
            for (int u = 0; u < 4; ++u)
#pragma unroll
                for (int r = 0; r < 4; ++r) cmax = fmaxf(cmax, st[u][r]);
            cmax = fmaxf(cmax, __shfl_xor(cmax, 16)); cmax = fmaxf(cmax, __shfl_xor(cmax, 32));
            const float m_new = fmaxf(m_run, cmax), alpha = __expf(m_run - m_new);
            float ls = 0.f;
#pragma unroll
            for (int u = 0; u < 4; ++u)
#pragma unroll
                for (int r = 0; r < 4; ++r) { const float e = __expf(st[u][r] - m_new); st[u][r] = e; ls += e; }
            ls += __shfl_xor(ls, 16); ls += __shfl_xor(ls, 32);
            l_run = l_run * alpha + ls; m_run = m_new;
#pragma unroll
            for (int i = 0; i < 4; ++i) { O[i][0] *= alpha; O[i][1] *= alpha; O[i][2] *= alpha; O[i][3] *= alpha; }
#pragma unroll
            for (int ss = 0; ss < 2; ++ss) {
                u32x4 pu; pu[0] = pk2(st[2 * ss][0], st[2 * ss][1]); pu[1] = pk2(st[2 * ss][2], st[2 * ss][3]); pu[2] = pk2(st[2 * ss + 1][0], st[2 * ss + 1][1]); pu[3] = pk2(st[2 * ss + 1][2], st[2 * ss + 1][3]);
                const bf16x8 pf = __builtin_bit_cast(bf16x8, pu);
                const int key0 = (ch * 4 + 2 * ss) * 16 + 4 * lg;
#pragma unroll
                for (int dt = 0; dt < 4; ++dt) {
                    const bf16_t* vr = Vt + (dt * 16 + l15) * A_LDV + key0;
                    u32x4 vu; const u32x2 v0 = *(const u32x2*)vr, v1 = *(const u32x2*)(vr + 16); vu[0] = v0[0]; vu[1] = v0[1]; vu[2] = v1[0]; vu[3] = v1[1];
                    O[dt] = __builtin_amdgcn_mfma_f32_16x16x32_bf16(__builtin_bit_cast(bf16x8, vu), pf, O[dt], 0, 0, 0);
                }
            }
        }
    }
    const float il = 1.f / l_run;
    bf16_t* M = (bf16_t*)(p.ws + WS_M) + (size_t)(qtok0 + w * 16 + l15) * 1024 + 512 + h * 64;
#pragma unroll
    for (int dt = 0; dt < 4; ++dt) { u32x2 o; o[0] = pk2(O[dt][0] * il, O[dt][1] * il); o[1] = pk2(O[dt][2] * il, O[dt][3] * il); *(u32x2*)(M + dt * 16 + 4 * lg) = o; }
    __syncthreads();
}
constexpr int P3_HY_LAT = (NB / 2) * 256, P3_HY_CTX = (NB / 2) * 256, P3_AT_LAT = NB * (L / 128) * 8, P3_AT_CTX = NB * (LC / 128) * 8;
DEV void phase3(const Params& p, unsigned char* smem, int var = 0) {
    const int total = P3_HY_LAT + P3_AT_LAT + P3_HY_CTX + P3_AT_CTX;
    for (int it = blockIdx.x; it < total; it += gridDim.x) {
        int i = it;
        if (var == 1 && !(i < P3_HY_LAT || (i >= P3_HY_LAT + P3_AT_LAT && i < P3_HY_LAT + P3_AT_LAT + P3_HY_CTX))) continue;
        if (var == 2 && (i < P3_HY_LAT || (i >= P3_HY_LAT + P3_AT_LAT && i < P3_HY_LAT + P3_AT_LAT + P3_HY_CTX))) continue;
        if (i < P3_HY_LAT) { hyena_item(p, 0, i, smem); continue; } i -= P3_HY_LAT;
        if (i < P3_AT_LAT) { attn_item(p, 0, i, smem); continue; } i -= P3_AT_LAT;
        if (i < P3_HY_CTX) { hyena_item(p, 1, i, smem); continue; } i -= P3_HY_CTX;
        attn_item(p, 1, i, smem);
    }
}

constexpr int K_LDK = 136, K_LDS = 129, K_LDC = 52;
DEV unsigned fkey(float f) { const unsigned u = __builtin_bit_cast(unsigned, f); return (u & 0x80000000u) ? ~u : (u | 0x80000000u); }
constexpr int cand_off(int i) { int o = 0; for (int k = 0; k < i; ++k) o += 16 / (k + 1); return o; }
DEV void topk_load_keys(const Params& p, int layer, int h, unsigned char* smem) {
    bf16_t* Ks = (bf16_t*)smem;
    const bf16_t* keys = (const bf16_t*)(p.ws + WS_W + W_KEYS) + (size_t)layer * 262144 + (size_t)h * 32768;
    const int tid = tidx();
#pragma unroll
    for (int i = 0; i < 8; ++i) { const int id = tid + NT * i, row = id >> 4, kc = id & 15; *(u32x4*)(Ks + row * K_LDK + kc * 8) = *(const u32x4*)(keys + (size_t)row * 128 + kc * 8); }
    __syncthreads();
}
#ifndef HOST_EMU
template <int CTRL> DEV unsigned dpp_u32(unsigned v) { return (unsigned)__builtin_amdgcn_update_dpp(0, (int)v, CTRL, 0xF, 0xF, true); }
#else
template <int CTRL> DEV unsigned dpp_u32(unsigned v) { const int lane = tidx() & 63; const int src = CTRL == 0xB1 ? (lane ^ 1) : CTRL == 0x4E ? (lane ^ 2) : ((lane & ~7) | (7 - (lane & 7))); return emu_shfl(v, src); }
#endif
DEV unsigned max8_u32(unsigned v) { unsigned t = dpp_u32<0xB1>(v); v = v > t ? v : t; t = dpp_u32<0x4E>(v); v = v > t ? v : t; t = dpp_u32<0x141>(v); return v > t ? v : t; }
DEV float sum8_f32(float v) { v += __builtin_bit_cast(float, dpp_u32<0xB1>(__builtin_bit_cast(unsigned, v))); v += __builtin_bit_cast(float, dpp_u32<0x4E>(__builtin_bit_cast(unsigned, v))); v += __builtin_bit_cast(float, dpp_u32<0x141>(__builtin_bit_cast(unsigned, v))); return v; }
DEV float unkey(unsigned k) { const unsigned u = (k & 0x80000000u) ? (k & 0x7fffffffu) : ~k; return __builtin_bit_cast(float, u); }
template <int N> DEV void bitonic_desc(unsigned (&a)[N]) {
#pragma unroll
    for (int k = 2; k <= N; k <<= 1)
#pragma unroll
        for (int j = k >> 1; j > 0; j >>= 1)
#pragma unroll
            for (int i = 0; i < N; ++i) { const int l = i ^ j; if (l > i) { const unsigned x = a[i], y = a[l]; const unsigned hi = x > y ? x : y, lo = x > y ? y : x; if ((i & k) == 0) { a[i] = hi; a[l] = lo; } else { a[i] = lo; a[l] = hi; } } }
}
DEV void merge16(const unsigned* lst, int nlist, unsigned first, int sub, unsigned& r0, unsigned& r1) {
    unsigned cur = first; int head = 0; r0 = 0u; r1 = 0u;
#pragma unroll
    for (int it = 0; it < 16; ++it) {
        const unsigned m = max8_u32(cur);
        if (sub == (it & 7)) { if (it < 8) r0 = m; else r1 = m; }
        if (cur == m) { ++head; cur = head < nlist ? lst[head] : 0u; }
    }
}
DEV void topk_item(const Params& p, int h, int tok0, unsigned char* smem) {
    bf16_t* Ks = (bf16_t*)smem;
    float* Sc = (float*)(Ks + 2 * 128 * K_LDK);
    unsigned* s12 = (unsigned*)Sc + 64 * 8 * 17;
    unsigned* cl = s12 + 64 * 32;
    const int tid = tidx(), lane = tid & 63, w = tid >> 6;
    const int row = tid >> 3, sub = tid & 7;
    const bf16_t* PQ = (const bf16_t*)(p.ws + WS_P);
    for (int part = 0; part < 2; ++part) {
        { const int mi = w >> 2, ni = w & 3;
          f32x16 acc;
#pragma unroll
          for (int r = 0; r < 16; ++r) acc[r] = 0.f;
          const bf16_t* ag = PQ + (size_t)(tok0 + mi * 32 + (lane & 31)) * 2048 + h * 256 + part * 128 + 8 * (lane >> 5);
          const bf16_t* bs = Ks + (part * 128 + ni * 32 + (lane & 31)) * K_LDK + 8 * (lane >> 5);
          bf16x8 af[8];
#pragma unroll
          for (int kk = 0; kk < 8; ++kk) af[kk] = *(const bf16x8*)(ag + kk * 16);
#pragma unroll
          for (int kk = 0; kk < 8; ++kk) acc = __builtin_amdgcn_mfma_f32_32x32x16_bf16(af[kk], *(const bf16x8*)(bs + kk * 16), acc, 0, 0, 0);
#pragma unroll
          for (int r = 0; r < 16; ++r) Sc[(mi * 32 + (r & 3) + 8 * (r >> 2) + 4 * (lane >> 5)) * K_LDS + ni * 32 + (lane & 31)] = acc[r]; }
        __syncthreads();
        unsigned mk[16];
#pragma unroll
        for (int i = 0; i < 16; ++i) mk[i] = (fkey(Sc[row * K_LDS + sub * 16 + i]) & ~127u) | (unsigned)(127 - (sub * 16 + i));
        bitonic_desc<16>(mk);
        __syncthreads();
        unsigned* lst = (unsigned*)Sc + (row * 8 + sub) * 17;
#pragma unroll
        for (int i = 0; i < 16; ++i) lst[i] = mk[i];
        unsigned r0, r1;
        merge16(lst, 16, mk[0], sub, r0, r1);
        s12[(row * 2 + part) * 16 + sub] = r0; s12[(row * 2 + part) * 16 + 8 + sub] = r1;
        __syncthreads();
    }
    {
        const unsigned* k1 = s12 + row * 32; const unsigned* k2 = k1 + 16;
        unsigned ck[8];
#pragma unroll
        for (int m = 0; m < 8; ++m) {
            const int cc = sub + 8 * m; int ci = 0, off = 0;
#pragma unroll
            for (int i = 0; i < 15; ++i) { const bool ge = cc >= cand_off(i + 1); ci += ge ? 1 : 0; off += ge ? 16 / (i + 1) : 0; }
            const int cj = cc - off;
            ck[m] = 0u;
            if (cc < 50) ck[m] = (fkey(unkey((k1[ci] & ~127u) | 64u) + unkey((k2[cj] & ~127u) | 64u)) & ~63u) | (unsigned)(63 - cc);
        }
        bitonic_desc<8>(ck);
        unsigned* lst = cl + (row * 8 + sub) * 9;
#pragma unroll
        for (int m = 0; m < 8; ++m) lst[m] = ck[m];
        unsigned r0, r1;
        merge16(lst, 8, ck[0], sub, r0, r1);
        const float a = unkey((r0 & ~63u) | 32u), b = unkey((r1 & ~63u) | 32u);
        const unsigned kmax = max8_u32(r0 > r1 ? r0 : r1); const float vmax = unkey((kmax & ~63u) | 32u);
        const float ea = __expf(a - vmax), eb = __expf(b - vmax);
        const float inv = 1.f / sum8_f32(ea + eb);
        int eidx[2];
#pragma unroll
        for (int q = 0; q < 2; ++q) {
            const int cc = 63 - (int)((q ? r1 : r0) & 63u); int ci = 0, off = 0;
#pragma unroll
            for (int i = 0; i < 15; ++i) { const bool ge = cc >= cand_off(i + 1); ci += ge ? 1 : 0; off += ge ? 16 / (i + 1) : 0; }
            const int cj = cc - off;
            eidx[q] = (127 - (int)(k1[ci] & 127u)) * 128 + (127 - (int)(k2[cj] & 127u));
        }
        int* IDX = (int*)(p.ws + WS_IDX) + (size_t)(tok0 + row) * 128 + h * 16; float* GT = (float*)(p.ws + WS_GATE) + (size_t)(tok0 + row) * 128 + h * 16;
        IDX[sub] = eidx[0]; IDX[8 + sub] = eidx[1]; GT[sub] = ea * inv; GT[8 + sub] = eb * inv;
    }
    __syncthreads();
}
DEV void topk_phase(const Params& p, int layer, int ntok, unsigned char* smem) {
    const int G = gridDim.x, bid = blockIdx.x, h = bid & 7;
    const int nt = ntok / 64;
    if ((G & 7) == 0) {
        if ((bid >> 3) < nt) topk_load_keys(p, layer, h, smem);
        for (int tt = bid >> 3; tt < nt; tt += (G >> 3)) topk_item(p, h, tt * 64, smem);
    } else {
        for (int it = bid; it < nt * 8; it += G) { __syncthreads(); topk_load_keys(p, layer, it & 7, smem); topk_item(p, it & 7, (it >> 3) * 64, smem); }
    }
}

DEV float gelu_f(float x) { return 0.5f * x * (1.f + erff(x * 0.70710678118654752f)); }
DEV void peer_item(const Params& p, int layer, int item, int var = 0) {
    (void)var;
    const int tok = item * 8 + (tidx() >> 6), lane = tidx() & 63, li = lane & 31, half = lane >> 5;
    const bf16_t* A = (const bf16_t*)(p.ws + WS_A) + (size_t)tok * 1024 + li * 32;
    const unsigned char* U6 = p.ws + WS_U6 + (size_t)layer * 16384 * 768; const unsigned char* V4 = p.ws + WS_V4 + (size_t)layer * 16384 * 512;
    const float* SU = (const float*)(p.ws + WS_S8) + (size_t)(layer * 2) * 16384; const float* SV = SU + 16384;
    float x[32], y[32];
#pragma unroll
    for (int q = 0; q < 4; ++q) { const u32x4 a = *(const u32x4*)(A + 8 * q);
#pragma unroll
        for (int i = 0; i < 4; ++i) { x[8 * q + 2 * i] = bflo(a[i]); x[8 * q + 2 * i + 1] = bfhi(a[i]); } }
#pragma unroll
    for (int i = 0; i < 32; ++i) y[i] = 0.f;
    const int* IDX = (const int*)(p.ws + WS_IDX) + (size_t)tok * 128; const float* GT = (const float*)(p.ws + WS_GATE) + (size_t)tok * 128;
    const int i_lo = IDX[lane], i_hi = IDX[64 + lane]; const float g_lo = GT[lane], g_hi = GT[64 + lane];
    const int sl = ((li >> 4) & 1) * 2 + ((li >> 3) & 1);
    u32x4 ulo[4], vq[4]; u32x2 uhi[4];
#define PG_LOADU(g) do { _Pragma("unroll") for (int s_ = 0; s_ < 4; ++s_) { const int e_ = __shfl((g) < 8 ? i_lo : i_hi, (((g) & 7) << 3) + 2 * s_ + half); \
        const unsigned char* r_ = U6 + (size_t)e_ * 768; ulo[s_] = *(const u32x4*)(r_ + li * 16); uhi[s_] = *(const u32x2*)(r_ + 512 + li * 8); } } while (0)
#define PG_LOADV(g) do { _Pragma("unroll") for (int s_ = 0; s_ < 4; ++s_) { const int e_ = __shfl((g) < 8 ? i_lo : i_hi, (((g) & 7) << 3) + 2 * s_ + half); \
        vq[s_] = *(const u32x4*)(V4 + (size_t)e_ * 512 + li * 16); } } while (0)
    PG_LOADU(0); PG_LOADV(0);
    for (int g = 0; g < 16; ++g) {
        const int mk = ((g & 7) << 3) + 2 * sl + half; const int me = __shfl(g < 8 ? i_lo : i_hi, mk); const float mg = __shfl(g < 8 ? g_lo : g_hi, mk);
        const float su = SU[me], sv = SV[me];
        float d[4];
#pragma unroll
        for (int s4 = 0; s4 < 4; ++s4) {
            u32x6 w; w[0] = ulo[s4][0]; w[1] = ulo[s4][1]; w[2] = ulo[s4][2]; w[3] = ulo[s4][3]; w[4] = uhi[s4][0]; w[5] = uhi[s4][1];
            const f32x32 f = __builtin_amdgcn_cvt_scalef32_pk32_f32_fp6(w, 1.0f);
            float a = 0.f;
#pragma unroll
            for (int i = 0; i < 32; ++i) a = fmaf(f[i], x[i], a);
            d[s4] = a; SCHED_FENCE(); }
        if (g + 1 < 16) PG_LOADU(g + 1);
        float r2[2], r1;
        { const bool hi = (li & 16) != 0;
#pragma unroll
          for (int j = 0; j < 2; ++j) { const float send = hi ? d[j] : d[2 + j], keep = hi ? d[2 + j] : d[j]; r2[j] = keep + __shfl_xor(send, 16); } }
        { const bool hi = (li & 8) != 0; const float send = hi ? r2[0] : r2[1], keep = hi ? r2[1] : r2[0]; r1 = keep + __shfl_xor(send, 8); }
        r1 += __shfl_xor(r1, 4); r1 += __shfl_xor(r1, 2); r1 += __shfl_xor(r1, 1);
        const float act = gelu_f(r1 * su) * mg * sv;
#pragma unroll
        for (int s4 = 0; s4 < 4; ++s4) {
            const float aj = __shfl(act, (lane & 32) + 16 * (s4 >> 1) + 8 * (s4 & 1));
#pragma unroll
            for (int dw = 0; dw < 4; ++dw) {
                const f32x2 f0 = __builtin_amdgcn_cvt_scalef32_pk_f32_fp4(vq[s4][dw], 1.0f, 0), f1 = __builtin_amdgcn_cvt_scalef32_pk_f32_fp4(vq[s4][dw], 1.0f, 1),
                            f2 = __builtin_amdgcn_cvt_scalef32_pk_f32_fp4(vq[s4][dw], 1.0f, 2), f3 = __builtin_amdgcn_cvt_scalef32_pk_f32_fp4(vq[s4][dw], 1.0f, 3);
                const int e0 = dw * 8;
                y[e0] = fmaf(aj, f0[0], y[e0]); y[e0 + 1] = fmaf(aj, f0[1], y[e0 + 1]); y[e0 + 2] = fmaf(aj, f1[0], y[e0 + 2]); y[e0 + 3] = fmaf(aj, f1[1], y[e0 + 3]);
                y[e0 + 4] = fmaf(aj, f2[0], y[e0 + 4]); y[e0 + 5] = fmaf(aj, f2[1], y[e0 + 5]); y[e0 + 6] = fmaf(aj, f3[0], y[e0 + 6]); y[e0 + 7] = fmaf(aj, f3[1], y[e0 + 7]);
            }
            SCHED_FENCE(); }
        if (g + 1 < 16) PG_LOADV(g + 1);
    }
#undef PG_LOADU
#undef PG_LOADV
    float yy[16];
#pragma unroll
    for (int i = 0; i < 16; ++i) { const float send = half ? y[i] : y[16 + i], keep = half ? y[16 + i] : y[i]; yy[i] = keep + __shfl_xor(send, 32); }
    const int c0 = li * 32 + half * 16;
    float* H = (float*)(p.ws + WS_H) + (size_t)tok * 1024 + c0;
    const float* g2 = (const float*)(p.ws + WS_MOD) + ((size_t)layer * NR + mod_row(tok)) * 6144 + 5120 + c0;
    float hv[16]; float ss = 0.f;
#pragma unroll
    for (int i = 0; i < 4; ++i) { const f32x4 hh = *(const f32x4*)(H + 4 * i), gg = *(const f32x4*)(g2 + 4 * i);
#pragma unroll
        for (int j = 0; j < 4; ++j) { const float v = hh[j] + gg[j] * yy[4 * i + j]; hv[4 * i + j] = v; ss += v * v; } }
    ss = wave_sum(ss);
    const float rstd = rsqrtf(ss * (1.f / 1024.f) + 1e-6f);
    if (layer == 0) {
#pragma unroll
        for (int i = 0; i < 4; ++i) { f32x4 o; o[0] = hv[4 * i]; o[1] = hv[4 * i + 1]; o[2] = hv[4 * i + 2]; o[3] = hv[4 * i + 3]; *(f32x4*)(H + 4 * i) = o; }
        const float* g = p.in[I_N1G] + 1024 + c0;
        const float* mod = (const float*)(p.ws + WS_MOD) + ((size_t)1 * NR + mod_row(tok)) * 6144 + c0;
        bf16_t* Ao = (bf16_t*)(p.ws + WS_A) + (size_t)tok * 1024 + c0;
        u32x4 o0, o1; float r[16];
#pragma unroll
        for (int i = 0; i < 16; ++i) r[i] = hv[i] * rstd * g[i] * (1.f + mod[1024 + i]) + mod[i];
#pragma unroll
        for (int i = 0; i < 4; ++i) { o0[i] = pk2(r[2 * i], r[2 * i + 1]); o1[i] = pk2(r[8 + 2 * i], r[8 + 2 * i + 1]); }
        *(u32x4*)Ao = o0; *(u32x4*)(Ao + 8) = o1;
    } else {
        const float* g = p.in[I_FG] + c0; float* out = p.out + (size_t)tok * 1024 + c0;
#pragma unroll
        for (int i = 0; i < 4; ++i) { f32x4 o; o[0] = hv[4 * i] * rstd * g[4 * i]; o[1] = hv[4 * i + 1] * rstd * g[4 * i + 1]; o[2] = hv[4 * i + 2] * rstd * g[4 * i + 2]; o[3] = hv[4 * i + 3] * rstd * g[4 * i + 3]; *(f32x4*)(out + 4 * i) = o; }
    }
}

constexpr int S3_LD = 136, S3_LDT = 24, S3_LDV = 72;
constexpr int S3_Q = 0, S3_K = S3_Q + 64 * S3_LD * 2, S3_KT = S3_K + 64 * S3_LD * 2, S3_D = S3_KT + 4 * 128 * S3_LDT * 2, S3_V = S3_D + 4 * 128 * 4, S3_ST = S3_V + 64 * S3_LDV * 2,
              S3_P = S3_ST + 2 * 64 * S3_LD * 2, S3_END = S3_P + 4 * 16 * S3_LDT * 2;
static_assert(S3_END <= SMEM_BYTES, "scan LDS");
DEV void scan_block(const Params& p, int bi, unsigned char* smem, int var = 0) {
    const int tid = tidx(), lane = tid & 63, w = tid >> 6, l15 = lane & 15, lg4 = lane >> 4, l31 = lane & 31, lh = lane >> 5;
    const int half = bi & 1, dir = (bi >> 1) & 1, h = (bi >> 2) & 7, b = bi >> 5;
    const bf16_t* P1 = (const bf16_t*)(p.ws + WS_P);
    const bf16_t* IT = (const bf16_t*)(p.ws + WS_M);
    bf16_t* Oo = (bf16_t*)(p.ws + WS_F + (dir ? F_OB : F_OF));
    bf16_t* Qs = (bf16_t*)(smem + S3_Q); bf16_t* Ks = (bf16_t*)(smem + S3_K); bf16_t* KT = (bf16_t*)(smem + S3_KT); float* Ds = (float*)(smem + S3_D);
    bf16_t* Vs = (bf16_t*)(smem + S3_V); bf16_t* ST = (bf16_t*)(smem + S3_ST); bf16_t* Ps = (bf16_t*)(smem + S3_P);
    const int NCH = (LC + L) / 64;
    const int kt = w >> 1, vt = w & 1;
    f32x16 S;
#pragma unroll
    for (int r = 0; r < 16; ++r) S[r] = 0.f;
    for (int i = tid; i < 64 * S3_LD / 2; i += NT) ((unsigned*)ST)[i] = 0u;
    const int pk = tid & 127, pblk = tid >> 7;
    u32x4 ka[2], qa[2], va, kb2[2], qb2[2], vb2;
    const int kcol = 1024 * (1 + dir) + h * 128 + pk, qcol = h * 128 + pk;
#define S3_T0(c) ((c) * 64 < LC ? (dir ? LC - 64 - (c) * 64 : (c) * 64) : (dir ? L - 64 - ((c) * 64 - LC) : (c) * 64 - LC))
#define S3_LOAD(c, KR, QR, VR) do { const bool lat_ = (c) * 64 >= LC; const int t0_ = S3_T0(c); const int Lx_ = lat_ ? L : LC; \
        const bf16_t* kq_ = (const bf16_t*)(p.ws + WS_P + (lat_ ? P1_KQT_LAT : P1_KQT_CTX)) + (size_t)b * 3072 * Lx_ + t0_ + pblk * 16; \
        KR[0] = *(const u32x4*)(kq_ + (size_t)kcol * Lx_); KR[1] = *(const u32x4*)(kq_ + (size_t)kcol * Lx_ + 8); \
        if (lat_) { QR[0] = *(const u32x4*)(kq_ + (size_t)qcol * Lx_); QR[1] = *(const u32x4*)(kq_ + (size_t)qcol * Lx_ + 8); } else { QR[0] = (u32x4){0u, 0u, 0u, 0u}; QR[1] = QR[0]; } \
        { const int v_ = tid >> 3, c8_ = tid & 7; const bf16_t* it_ = IT + (lat_ ? (size_t)0 : (size_t)NB * 1024 * L) + ((size_t)b * 1024 + h * 128 + half * 64 + v_) * Lx_ + t0_ + c8_ * 8; VR = *(const u32x4*)it_; } } while (0)
#define S3_PREP(KR, QR, VR) do { \
            float bsum = 0.f; unsigned short kt16[16]; \
            _Pragma("unroll") for (int rr = 0; rr < 16; ++rr) { \
                const int tl = dir ? 15 - rr : rr; \
                const unsigned ku_ = dir ? KR[(15 - rr) >> 3][((15 - rr) & 7) >> 1] : KR[rr >> 3][(rr & 7) >> 1]; const unsigned qu_ = dir ? QR[(15 - rr) >> 3][((15 - rr) & 7) >> 1] : QR[rr >> 3][(rr & 7) >> 1]; \
                const bool odd_ = dir ? (((15 - rr) & 1) != 0) : ((rr & 1) != 0); \
                const float kv = odd_ ? bfhi(ku_) : bflo(ku_), qv = odd_ ? bfhi(qu_) : bflo(qu_); \
                bsum += __logf(1.f - kv); \
                const float eb = __expf(bsum), ieb = __expf(fminf(-bsum, 80.f)); \
                const unsigned short qt = (unsigned short)f2bf(qv * eb), ktv = (unsigned short)f2bf(kv * ieb); \
                Qs[(pblk * 16 + tl) * S3_LD + pk] = qt; Ks[(pblk * 16 + tl) * S3_LD + pk] = ktv; \
                if (dir) kt16[15 - rr] = ktv; else kt16[rr] = ktv; \
            } \
            u32x4 o0, o1; \
            _Pragma("unroll") for (int i = 0; i < 4; ++i) { o0[i] = (unsigned)kt16[2 * i] | ((unsigned)kt16[2 * i + 1] << 16); o1[i] = (unsigned)kt16[8 + 2 * i] | ((unsigned)kt16[8 + 2 * i + 1] << 16); } \
            *(u32x4*)(KT + (pblk * 128 + pk) * S3_LDT) = o0; *(u32x4*)(KT + (pblk * 128 + pk) * S3_LDT + 8) = o1; \
            Ds[pblk * 128 + pk] = __expf(bsum); \
            { const int v_ = tid >> 3, c8_ = tid & 7; *(u32x4*)(Vs + v_ * S3_LDV + c8_ * 8) = VR; } } while (0)
    S3_LOAD(0, ka, qa, va);
    for (int c = 0; c < NCH; ++c) {
        const bool lat = c * 64 >= LC; const int t0 = S3_T0(c); const size_t tokb = lat ? (size_t)b * L + t0 : (size_t)TL + (size_t)b * LC + t0;
        if ((c & 1) == 0) { if (c + 1 < NCH) S3_LOAD(c + 1, kb2, qb2, vb2); } else { if (c + 1 < NCH) S3_LOAD(c + 1, ka, qa, va); }
        lds_barrier();
        if (var != 1) { if ((c & 1) == 0) S3_PREP(ka, qa, va); else S3_PREP(kb2, qb2, vb2); }
        lds_barrier();

        if (lat && w < 4) {
            f32x4 pt = (f32x4){0.f, 0.f, 0.f, 0.f};
#pragma unroll
            for (int kk = 0; kk < 4; ++kk)
                pt = __builtin_amdgcn_mfma_f32_16x16x32_bf16(*(const bf16x8*)(Ks + (w * 16 + l15) * S3_LD + kk * 32 + 8 * lg4), *(const bf16x8*)(Qs + (w * 16 + l15) * S3_LD + kk * 32 + 8 * lg4), pt, 0, 0, 0);
            float pm[4];
#pragma unroll
            for (int r = 0; r < 4; ++r) { const int sl = 4 * lg4 + r; const bool keep = dir ? (sl >= l15) : (sl <= l15); pm[r] = keep ? pt[r] : 0.f; }
            u32x2 o; o[0] = pk2(pm[0], pm[1]); o[1] = pk2(pm[2], pm[3]);
            *(u32x2*)(Ps + (w * 16 + l15) * S3_LDT + 4 * lg4) = o;
        }
        lds_barrier();
        for (int ib = 0; ib < (var == 2 ? 0 : 4); ++ib) {
            const int blk = dir ? 3 - ib : ib;
            const int cur = (c * 4 + ib) & 1;
            { const bf16x8 a = *(const bf16x8*)(KT + (blk * 128 + 32 * kt + l31) * S3_LDT + 8 * lh);
              const bf16x8 bb = *(const bf16x8*)(Vs + (32 * vt + l31) * S3_LDV + blk * 16 + 8 * lh);
              S = __builtin_amdgcn_mfma_f32_32x32x16_bf16(a, bb, S, 0, 0, 0);
#pragma unroll
              for (int g = 0; g < 4; ++g) { const f32x4 dv = *(const f32x4*)(Ds + blk * 128 + 32 * kt + 8 * g + 4 * lh);
                  S[4 * g] *= dv[0]; S[4 * g + 1] *= dv[1]; S[4 * g + 2] *= dv[2]; S[4 * g + 3] *= dv[3];
                  u32x2 o; o[0] = pk2(S[4 * g], S[4 * g + 1]); o[1] = pk2(S[4 * g + 2], S[4 * g + 3]);
                  *(u32x2*)(ST + ((cur ^ 1) * 64 + 32 * vt + l31) * S3_LD + 32 * kt + 8 * g + 4 * lh) = o; } }
            if (lat && w < 4) {
                f32x4 o = (f32x4){0.f, 0.f, 0.f, 0.f};
#pragma unroll
                for (int kk = 0; kk < 4; ++kk)
                    o = __builtin_amdgcn_mfma_f32_16x16x32_bf16(*(const bf16x8*)(ST + (cur * 64 + 16 * w + l15) * S3_LD + kk * 32 + 8 * lg4), *(const bf16x8*)(Qs + (blk * 16 + l15) * S3_LD + kk * 32 + 8 * lg4), o, 0, 0, 0);
                bf16x8 va = (bf16x8){0, 0, 0, 0, 0, 0, 0, 0}, pb = va;
                if (lg4 < 2) { va = *(const bf16x8*)(Vs + (16 * w + l15) * S3_LDV + blk * 16 + 8 * lg4); pb = *(const bf16x8*)(Ps + (blk * 16 + l15) * S3_LDT + 8 * lg4); }
                o = __builtin_amdgcn_mfma_f32_16x16x32_bf16(va, pb, o, 0, 0, 0);
                u32x2 ou; ou[0] = pk2(o[0], o[1]); ou[1] = pk2(o[2], o[3]);
                *(u32x2*)(Oo + (tokb + blk * 16 + l15) * 1024 + h * 128 + half * 64 + 16 * w + 4 * lg4) = ou;
            }
            lds_barrier();
        }
    }
    lds_barrier();
#undef S3_T0
#undef S3_LOAD
#undef S3_PREP
}
DEV void readout_item(const Params& p, int item) {
    const int tok = item * 8 + (tidx() >> 6), lane = tidx() & 63;
    const bf16_t* of = (const bf16_t*)(p.ws + WS_F + F_OF) + (size_t)tok * 1024 + lane * 16; const bf16_t* ob = (const bf16_t*)(p.ws + WS_F + F_OB) + (size_t)tok * 1024 + lane * 16;
    const bf16_t* gp = (const bf16_t*)(p.ws + WS_P + P1_G) + (size_t)tok * 1024 + lane * 16;
    const float* on = p.in[I_HGON] + (lane & 7) * 16;
    float o[16], gg[16]; float ss = 0.f;
    { const u32x4 a0 = *(const u32x4*)of, a1 = *(const u32x4*)(of + 8), b0 = *(const u32x4*)ob, b1 = *(const u32x4*)(ob + 8), g0 = *(const u32x4*)gp, g1 = *(const u32x4*)(gp + 8);
#pragma unroll
      for (int i = 0; i < 4; ++i) { o[2 * i] = bflo(a0[i]) + bflo(b0[i]); o[2 * i + 1] = bfhi(a0[i]) + bfhi(b0[i]); o[8 + 2 * i] = bflo(a1[i]) + bflo(b1[i]); o[8 + 2 * i + 1] = bfhi(a1[i]) + bfhi(b1[i]);
          gg[2 * i] = bflo(g0[i]); gg[2 * i + 1] = bfhi(g0[i]); gg[8 + 2 * i] = bflo(g1[i]); gg[8 + 2 * i + 1] = bfhi(g1[i]); } }
#pragma unroll
    for (int i = 0; i < 16; ++i) ss += o[i] * o[i];
    ss += __shfl_xor(ss, 1); ss += __shfl_xor(ss, 2); ss += __shfl_xor(ss, 4);
    const float rstd = rsqrtf(ss * (1.f / 128.f) + 1e-6f);
    bf16_t* M = (bf16_t*)(p.ws + WS_M) + (size_t)tok * 1024 + lane * 16;
    u32x4 o0, o1; float r[16];
#pragma unroll
    for (int i = 0; i < 16; ++i) r[i] = o[i] * rstd * on[i] * gg[i];
#pragma unroll
    for (int i = 0; i < 4; ++i) { o0[i] = pk2(r[2 * i], r[2 * i + 1]); o1[i] = pk2(r[8 + 2 * i], r[8 + 2 * i + 1]); }
    *(u32x4*)M = o0; *(u32x4*)(M + 8) = o1;
}

#ifndef HOST_EMU
#define XB_TMO      128
#define XB_XCNT(j)  (256  + 64 * (j))
#define XB_XSUB(j)  (1280 + 64 * (j))
#define XB_XGEN(j)  (2304 + 64 * (j))
#define XB_TOP      3328
#define XB_TOPGEN   3392
#define XCD_BAR_WORDS 3456
#define XB_SPIN_CAP (1u << 18)
#define LAS __attribute__((address_space(3)))

__device__ __forceinline__ unsigned xb_ld(unsigned* p)              { return __hip_atomic_load(p, __ATOMIC_RELAXED, __HIP_MEMORY_SCOPE_AGENT); }
__device__ __forceinline__ unsigned xb_add(unsigned* p, unsigned v) { return __hip_atomic_fetch_add(p, v, __ATOMIC_RELAXED, __HIP_MEMORY_SCOPE_AGENT); }
__device__ __forceinline__ unsigned xb_xcc_id() { return (unsigned)__builtin_amdgcn_s_getreg((3 << 11) | 20) & 0xFu; }
#define XB_SPIN(cond, bar) do { unsigned _sp = 0; while (cond) { __builtin_amdgcn_s_sleep(1); \
    if ((++_sp & 255u) == 0u) { if (xb_ld(&(bar)[XB_TMO])) break; if (_sp > XB_SPIN_CAP) { atomicAdd(&(bar)[XB_TMO], 1u); break; } } } } while (0)

struct XcdBarrier {
    unsigned* bar; unsigned x;
    volatile LAS unsigned* st;
};

__device__ __forceinline__ XcdBarrier xcd_barrier_post(unsigned* bar, volatile LAS unsigned* st) {
    XcdBarrier b; b.bar = bar; b.x = xb_xcc_id(); b.st = st;
    if (threadIdx.x == 0) (void)xb_add(&bar[XB_XCNT(b.x)], 1u);
    return b;
}
__device__ __forceinline__ void xcd_barrier_complete(unsigned* bar, unsigned x, unsigned& nloc, unsigned& nx) {
    const unsigned G = gridDim.x * gridDim.y * gridDim.z;
    unsigned sum, cnt, mine, sp = 0u;
    for (;;) {
        sum = 0u; cnt = 0u; mine = 0u;
#pragma unroll
        for (unsigned j = 0; j < 16; ++j) { const unsigned c = xb_ld(&bar[XB_XCNT(j)]); sum += c; cnt += (c > 0u) ? 1u : 0u; mine = (j == x) ? c : mine; }
        if (sum == G) break;
        __builtin_amdgcn_s_sleep(1);
        if ((++sp & 255u) == 0u) { if (xb_ld(&bar[XB_TMO])) break; if (sp > XB_SPIN_CAP) { atomicAdd(&bar[XB_TMO], 1u); break; } }
    }
    nloc = mine > 0u ? mine : 1u; nx = cnt > 0u ? cnt : 1u;
}

__device__ __forceinline__ void xcd_barrier(const XcdBarrier& b) {
    asm volatile("s_waitcnt vmcnt(0)" ::: "memory");
    __syncthreads();
    if (threadIdx.x == 0) {
        unsigned* bar = b.bar;
        __builtin_amdgcn_s_waitcnt(0);
        unsigned nloc = b.st[0], nx = b.st[1];
        if (nloc == 0u) { xcd_barrier_complete(bar, b.x, nloc, nx); b.st[0] = nloc; b.st[1] = nx; }
        const unsigned old = xb_add(&bar[XB_XSUB(b.x)], 1u);
        const unsigned gen = old / nloc;
        if (old + 1u == (gen + 1u) * nloc) {
            __builtin_amdgcn_fence(__ATOMIC_RELEASE, "agent");
            asm volatile("s_waitcnt vmcnt(0)" ::: "memory");
            const unsigned og = xb_add(&bar[XB_TOP], 1u);
            const unsigned tg = og / nx;
            if (og + 1u == (tg + 1u) * nx) xb_add(&bar[XB_TOPGEN], 1u);
            else XB_SPIN(xb_ld(&bar[XB_TOPGEN]) == tg, bar);
            __builtin_amdgcn_fence(__ATOMIC_ACQUIRE, "agent");
            xb_add(&bar[XB_XGEN(b.x)], 1u);
            asm volatile("s_waitcnt vmcnt(0)" ::: "memory");
        } else {
            XB_SPIN(xb_ld(&bar[XB_XGEN(b.x)]) == gen, bar);
            __builtin_amdgcn_fence(__ATOMIC_ACQUIRE, "agent");
            asm volatile("s_waitcnt vmcnt(0)" ::: "memory");
        }
    }
    __syncthreads();
}

#endif
#ifdef NOINLINE_PHASES
#define NOINL __device__ __attribute__((noinline))
#else
#define NOINL __device__ __forceinline__
#endif
__shared__ __attribute__((aligned(16))) unsigned char g_smem[SMEM_BYTES + 16];
#define PH_COMMON const int G = gridDim.x, bid = blockIdx.x; unsigned char* smem = g_smem; (void)smem; (void)G; (void)bid; \
    const bf16_t* A = (const bf16_t*)(p.ws + WS_A); const bf16_t* Mx = (const bf16_t*)(p.ws + WS_M); const bf16_t* W = (const bf16_t*)(p.ws + WS_W); (void)A; (void)Mx; (void)W;
NOINL void ph0(const Params& p) { PH_COMMON phase0(p, smem); }
NOINL void ph1(const Params& p) { PH_COMMON phase1(p, smem); }
NOINL void ph2(const Params& p) { PH_COMMON EpiL0In e{p.ws}; for (int t = bid; t < (T / 256) * 9; t += G) gemm_tile256(A, W + W_IN0 / 2, (t / 9) * 256, (t % 9) * 256, smem, e); }
NOINL void ph3(const Params& p, int var = 0) { PH_COMMON phase3(p, smem, var); }
NOINL void ph4(const Params& p) { PH_COMMON EpiRes e{&p, 1, 0, 2048}; for (int t = bid; t < (T / 256) * 8; t += G) gemm_tile(Mx, W + W_OUT0 / 2, (t / 8) * 256, (t % 8) * 128, smem, e); }
NOINL void ph5(const Params& p) { PH_COMMON for (int it = bid; it < T / 8; it += G) norm_rows_item(p, it, 0, p.in[I_N2G], 0, 3072); }
NOINL void ph6(const Params& p, int var = 0) { PH_COMMON EpiBf16 e{(bf16_t*)(p.ws + WS_P), 2048}; for (int t = bid; t < (T / 256) * 16; t += G) gemm_tile(A, W + W_Q0 / 2, (t / 16) * 256, (t % 16) * 128, smem, e, var); }
NOINL void ph7(const Params& p) { PH_COMMON topk_phase(p, 0, T, smem); }
NOINL void ph8(const Params& p) { PH_COMMON for (int it = bid; it < T / 8; it += G) peer_item(p, 0, it); }
NOINL void ph9(const Params& p) { PH_COMMON EpiHg e{p.ws, p.in[I_HGLB]};
    for (int t = bid; t < (T / 256) * 20; t += G) { const int mt = t / 20, nt = t % 20; if (mt >= TL / 256 && (nt < 4 || nt >= 16)) continue; gemm_tile256(A, W + W_IN1 / 2, mt * 256, nt * 256, smem, e); } }
NOINL void ph10(const Params& p, int var = 0) { PH_COMMON for (int bi = bid; bi < NB * 32; bi += G) scan_block(p, bi, smem, var); }
NOINL void ph11(const Params& p) { PH_COMMON for (int it = bid; it < TL / 8; it += G) readout_item(p, it); }
NOINL void ph12(const Params& p) { PH_COMMON EpiRes e{&p, 0, 1, 2048}; for (int t = bid; t < (TL / 256) * 4; t += G) gemm_tile256(Mx, W + W_OUT1 / 2, (t / 4) * 256, (t % 4) * 256, smem, e); }
NOINL void ph13(const Params& p) { PH_COMMON for (int it = bid; it < TL / 8; it += G) norm_rows_item(p, it, 0, p.in[I_N2G] + 1024, 1, 3072); }
NOINL void ph14(const Params& p) { PH_COMMON EpiBf16 e{(bf16_t*)(p.ws + WS_P), 2048}; for (int t = bid; t < (TL / 256) * 8; t += G) gemm_tile256(A, W + W_Q1 / 2, (t / 8) * 256, (t % 8) * 256, smem, e); }
NOINL void ph15(const Params& p) { PH_COMMON topk_phase(p, 1, TL, smem); }
NOINL void ph16(const Params& p, int var = 0) { PH_COMMON for (int it = bid; it < TL / 8; it += G) peer_item(p, 1, it, var); }

constexpr int NPHASE = 17;
__global__ void __launch_bounds__(NT, 2) mega(Params p_in) {
    const int ph_lo = p_in.ph_lo, ph_hi = p_in.ph_hi;
#ifndef HOST_EMU
#define GBAR_MAKE() XcdBarrier gbar; gbar.bar = (unsigned*)(p_in.ws + WS_CTRL); gbar.x = xb_xcc_id(); gbar.st = (volatile LAS unsigned*)(LAS unsigned char*)(g_smem + SMEM_BYTES);
    if (ph_hi - ph_lo > 1) {
        volatile LAS unsigned* st = (volatile LAS unsigned*)(LAS unsigned char*)(g_smem + SMEM_BYTES);
        if (threadIdx.x == 0) { st[0] = 0u; st[1] = 0u; }
        __syncthreads();
        (void)xcd_barrier_post((unsigned*)(p_in.ws + WS_CTRL), st);
    }
#endif
    for (int ph = ph_lo; ph < ph_hi; ++ph) {
        if (ph > ph_lo) {
#ifndef HOST_EMU
            { GBAR_MAKE(); xcd_barrier(gbar); }
#endif
        }
#ifndef HOST_EMU
        unsigned long long kp = (unsigned long long)__builtin_amdgcn_kernarg_segment_ptr();
        asm volatile("" : "+s"(kp) :: "memory");
        const Params& p = *(const Params*)(const __attribute__((address_space(4))) Params*)kp;
#else
        const Params& p = p_in;
#endif
#ifdef REPEAT_MASK
        for (int rep_ = ((REPEAT_MASK >> ph) & 1); rep_ >= 0; --rep_) { if (rep_ == 0 && ((REPEAT_MASK >> ph) & 1)) { GBAR_MAKE(); xcd_barrier(gbar); }
#else
        {
#endif
#ifdef ONLY_PHASE
        if (ph != ONLY_PHASE) continue;
        switch (ONLY_PHASE) {
#else
        switch (ph) {
#endif
        case 0: ph0(p); break; case 1: ph1(p); break; case 2: ph2(p); break; case 3:
#if defined(REPEAT_MASK) && defined(P3_VAR)
            ph3(p, rep_ == 1 ? P3_VAR : 0);
#else
            ph3(p);
#endif
            break; case 4: ph4(p); break; case 5: ph5(p); break;
        case 6:
#if defined(REPEAT_MASK) && defined(G_VAR)
            ph6(p, rep_ == 1 ? G_VAR : 0);
#else
            ph6(p);
#endif
            break; case 7: ph7(p); break; case 8: ph8(p); break; case 9: ph9(p); break; case 10:
#if defined(REPEAT_MASK) && defined(SCAN_VAR)
            ph10(p, rep_ == 1 ? SCAN_VAR : 0);
#else
            ph10(p);
#endif
            break; case 11: ph11(p); break;
        case 12: ph12(p); break; case 13: ph13(p); break; case 14: ph14(p); break; case 15: ph15(p); break; case 16:
#if defined(REPEAT_MASK) && defined(PG_VAR)
            ph16(p, rep_ == 1 ? PG_VAR : 0);
#else
            ph16(p);
#endif
            break;
        default: break;
        }
        }
    }
}

#ifndef HOST_EMU
extern "C" void kernel_launch(void* const* d_in, const int* in_sizes, int n_in, void* d_out, int out_size, void* d_ws, size_t ws_size, hipStream_t stream) {
    if (n_in != 29 || ws_size < WS_END || out_size != TL * 1024) { fprintf(stderr, "kernel_launch: unexpected sizes (n_in %d, ws %zu need %zu, out %d)\n", n_in, ws_size, (size_t)WS_END, out_size); return; }
    static int grid = 0;
    if (!grid) { int dev = 0, cus = 0; hipGetDevice(&dev); hipDeviceGetAttribute(&cus, hipDeviceAttributeMultiprocessorCount, dev); grid = cus > 0 ? cus : 256; }
    hipMemsetAsync((unsigned char*)d_ws + WS_CTRL, 0, CTRL_BYTES, stream);
    Params p{};
    for (int i = 0; i < 29; ++i) p.in[i] = (const float*)d_in[i];
    p.out = (float*)d_out; p.ws = (unsigned char*)d_ws;
#ifdef MULTI_LAUNCH
    for (int ph = 0; ph < NPHASE; ++ph) { p.ph_lo = ph; p.ph_hi = ph + 1; hipLaunchKernelGGL(mega, dim3(grid), dim3(NT), 0, stream, p); }
#else
    p.ph_lo = 0; p.ph_hi = NPHASE;
    hipLaunchKernelGGL(mega, dim3(grid), dim3(NT), 0, stream, p);
#endif
}
#endif
```

```cpp
#ifndef HOST_EMU
#include <hip/hip_runtime.h>
#include <cstdio>
#endif

#ifndef CFG_B
#define CFG_B 8
#define CFG_L 2048
#define CFG_LC 256
#endif
#define DEV __device__ __forceinline__
#ifndef HOST_EMU
#define SCHED_FENCE() __builtin_amdgcn_sched_barrier(0)
#endif
#ifdef HOST_EMU
#define SCHED_FENCE() do {} while (0)
#define __expf expf
#define __logf logf
#define __sinf sinf
#define __cosf cosf
#endif

typedef unsigned short bf16_t;
typedef short bf16x8 __attribute__((ext_vector_type(8)));
typedef float f32x16 __attribute__((ext_vector_type(16)));
typedef float f32x4 __attribute__((ext_vector_type(4)));
typedef unsigned u32x4 __attribute__((ext_vector_type(4)));
typedef unsigned u32x2 __attribute__((ext_vector_type(2)));
struct cf2 { float x, y; };

constexpr int NB = CFG_B, L = CFG_L, LC = CFG_LC, D = 1024;
constexpr int TL = NB * L, TC = NB * LC, T = TL + TC;
constexpr int NT = 512;
constexpr int NR = NB + 1;
constexpr int log4ceil(int n) { int s = 0, v = 1; while (v < n) { v *= 4; ++s; } return s; }
constexpr int FS_LAT = log4ceil(2 * L - 1), FS_CTX = log4ceil(2 * LC - 1);
constexpr int NF_LAT = 1 << (2 * FS_LAT), NF_CTX = 1 << (2 * FS_CTX);
static_assert(T % 256 == 0 && TL % 256 == 0 && L % 128 == 0 && LC % 128 == 0 && NB % 2 == 0, "shape");

constexpr size_t al256(size_t x) { return (x + 255) & ~(size_t)255; }
constexpr size_t WS_CTRL = 0, CTRL_BYTES = 65536;
constexpr size_t CTRL_HYNORM = 4096;
constexpr size_t WS_MOD = WS_CTRL + CTRL_BYTES;
constexpr size_t WS_H = al256(WS_MOD + (size_t)2 * NR * 6144 * 4);
constexpr size_t WS_A = al256(WS_H + (size_t)T * 1024 * 4);
constexpr size_t WS_P = al256(WS_A + (size_t)T * 1024 * 2);
constexpr size_t P_BYTES = (size_t)T * 5120 * 2;
constexpr size_t P_HYT_LAT = 0;
constexpr size_t P_HYT_CTX = P_HYT_LAT + (size_t)NB * 1536 * L * 2;
constexpr size_t P_Q0 = P_HYT_CTX + (size_t)NB * 1536 * LC * 2;
constexpr size_t P_K0 = P_Q0 + (size_t)T * 512 * 2;
constexpr size_t P_VT_LAT = P_K0 + (size_t)T * 128 * 2;
constexpr size_t P_VT_CTX = P_VT_LAT + (size_t)NB * 128 * L * 2;
static_assert(P_VT_CTX + (size_t)NB * 128 * LC * 2 <= P_BYTES, "P region");
constexpr size_t P1_KQT_LAT = 0;
constexpr size_t P1_KQT_CTX = P1_KQT_LAT + (size_t)NB * 3072 * L * 2;
constexpr size_t P1_G = P1_KQT_CTX + (size_t)NB * 3072 * LC * 2;
static_assert(P1_G + (size_t)TL * 1024 * 2 <= P_BYTES, "P region (layer 1)");
constexpr size_t WS_M = al256(WS_P + P_BYTES);
constexpr size_t WS_IDX = al256(WS_M + (size_t)T * 1024 * 2);
constexpr size_t WS_GATE = al256(WS_IDX + (size_t)T * 128 * 4);
constexpr size_t WS_U6 = al256(WS_GATE + (size_t)T * 128 * 4);
constexpr size_t WS_V4 = WS_U6 + (size_t)2 * 16384 * 768;
constexpr size_t WS_S8 = WS_V4 + (size_t)2 * 16384 * 512;
constexpr size_t WS_W = al256(WS_S8 + (size_t)4 * 16384 * 4);
constexpr size_t W_IN0 = 0, W_OUT0 = W_IN0 + (size_t)2304 * 1024 * 2, W_IN1 = W_OUT0 + (size_t)1024 * 1024 * 2,
                 W_OUT1 = W_IN1 + (size_t)5120 * 1024 * 2, W_Q0 = W_OUT1 + (size_t)1024 * 1024 * 2, W_Q1 = W_Q0 + (size_t)2048 * 1024 * 2,
                 W_KEYS = W_Q1 + (size_t)2048 * 1024 * 2, W_BYTES = W_KEYS + (size_t)2 * 8 * 2 * 128 * 128 * 2;
constexpr size_t WS_F = al256(WS_W + W_BYTES);
constexpr size_t F_HRAW_LAT = 0;
constexpr size_t F_HRAW_CTX = F_HRAW_LAT + (size_t)2048 * L * 4;
constexpr size_t F_HF_LAT = F_HRAW_CTX + (size_t)2048 * LC * 4;
constexpr size_t F_HF_CTX = F_HF_LAT + (size_t)1024 * NF_LAT * 8;
constexpr size_t F_HYP_LAT = F_HF_CTX + (size_t)1024 * NF_CTX * 8;
constexpr size_t F_HYP_CTX = F_HYP_LAT + (size_t)(L / 64) * 2048 * 4;
constexpr size_t F_END = F_HYP_CTX + (size_t)(LC / 64) * 2048 * 4;
constexpr size_t F_OF = 0, F_OB = (size_t)TL * 1024 * 2;
constexpr size_t F_BYTES = F_END > 2 * F_OB ? F_END : 2 * F_OB;
constexpr size_t WS_END = al256(WS_F + F_BYTES);

struct Params { const float* in[29]; float* out; unsigned char* ws; int ph_lo, ph_hi; };
enum { I_X = 0, I_C, I_CTX, I_CCTX, I_ADAW, I_ADAB, I_N1G, I_N2G, I_FG, I_ABWIN, I_ABWOUT, I_HYCW, I_HYCB, I_HYW1, I_HYB1, I_HYW2, I_HYB2, I_HYW3,
       I_HYFREQ, I_HYSKIP, I_SINK, I_HGWIN, I_HGWOUT, I_HGLB, I_HGON, I_PWQ, I_PKEYS, I_PU, I_PV };

constexpr int SMEM_BYTES = 147456;

#ifndef HOST_EMU
DEV int tidx() { int t = threadIdx.x; asm volatile("" : "+v"(t)); return t; }
#else
DEV int tidx() { return (int)threadIdx.x; }
#endif
#ifndef HOST_EMU
DEV void lds_barrier() { asm volatile("s_waitcnt lgkmcnt(0)" ::: "memory"); __builtin_amdgcn_s_barrier(); asm volatile("" ::: "memory"); }
#else
DEV void lds_barrier() { __syncthreads(); }
#endif
#ifndef HOST_EMU
typedef __bf16 bf16n2 __attribute__((ext_vector_type(2)));
DEV unsigned pk2(float lo, float hi) { bf16n2 v; v[0] = (__bf16)lo; v[1] = (__bf16)hi; return __builtin_bit_cast(unsigned, v); }
DEV unsigned f2bf(float f) { return (unsigned)__builtin_bit_cast(unsigned short, (__bf16)f); }
#else
DEV unsigned f2bf(float f) { unsigned u = __builtin_bit_cast(unsigned, f); return (u + 0x7fffu + ((u >> 16) & 1u)) >> 16; }
DEV unsigned pk2(float lo, float hi) { return f2bf(lo) | (f2bf(hi) << 16); }
#endif
DEV float bf2f(unsigned h) { return __builtin_bit_cast(float, (h & 0xffffu) << 16); }
DEV float bflo(unsigned u) { return __builtin_bit_cast(float, u << 16); }
DEV float bfhi(unsigned u) { return __builtin_bit_cast(float, u & 0xffff0000u); }
DEV float silu_f(float x) { return x / (1.f + __expf(-x)); }
DEV float sigmoid_f(float x) { return 1.f / (1.f + __expf(-x)); }
DEV float wave_sum(float v) {
#pragma unroll
    for (int m = 32; m >= 1; m >>= 1) v += __shfl_xor(v, m);
    return v;
}
DEV int mod_row(int tok) { return tok < TL ? tok / L : NB; }

DEV void p0_mod(const Params& p, int item, unsigned char* smem) {
    const int l = item / 96, col0 = (item % 96) * 64, tid = tidx();
    float* sc = (float*)smem;
    float* red = sc + NR * 1024;
    for (int i = tid; i < NR * 1024; i += NT) { const int r = i >> 10, k = i & 1023; const float c = r < NB ? p.in[I_C][r * 1024 + k] : p.in[I_CCTX][k]; sc[i] = c / (1.f + expf(-c)); }
    __syncthreads();
    const int kq = tid >> 6, col = tid & 63;
    float acc[NR];
#pragma unroll
    for (int r = 0; r < NR; ++r) acc[r] = 0.f;
    const float* w = p.in[I_ADAW] + (size_t)l * 1024 * 6144 + col0 + col;
#pragma unroll 16
    for (int k = kq * 128; k < kq * 128 + 128; ++k) {
        const float wv = w[(size_t)k * 6144];
#pragma unroll
        for (int r = 0; r < NR; ++r) acc[r] += sc[r * 1024 + k] * wv;
    }
#pragma unroll
    for (int r = 0; r < NR; ++r) red[(kq * NR + r) * 64 + col] = acc[r];
    __syncthreads();
    float* mod = (float*)(p.ws + WS_MOD);
    for (int i = tid; i < NR * 64; i += NT) {
        const int r = i >> 6, c = i & 63; float s = 0.f;
        for (int q = 0; q < 8; ++q) s += red[(q * NR + r) * 64 + c];
        mod[((size_t)l * NR + r) * 6144 + col0 + c] = s + p.in[I_ADAB][l * 6144 + col0 + c];
    }
    __syncthreads();
}
DEV void p0_transpose(const float* W, bf16_t* Wt, int N, int tile, unsigned char* smem) {
    float* ts = (float*)smem;
    const int ntn = N / 64, kt = tile / ntn, nt = tile % ntn, k0 = kt * 64, n0 = nt * 64, tid = tidx();
    float rv[8];
#pragma unroll
    for (int m = 0; m < 8; ++m) { const int i = tid + NT * m, kk = i >> 6, nn = i & 63; rv[m] = W[(size_t)(k0 + kk) * N + n0 + nn]; }
#pragma unroll
    for (int m = 0; m < 8; ++m) { const int i = tid + NT * m, kk = i >> 6, nn = i & 63; ts[kk * 65 + nn] = rv[m]; }
    __syncthreads();
#pragma unroll
    for (int m = 0; m < 8; ++m) { const int i = tid + NT * m, nn = i >> 6, kk = i & 63; Wt[(size_t)(n0 + nn) * 1024 + k0 + kk] = (bf16_t)f2bf(ts[kk * 65 + nn]); }
    __syncthreads();
}
DEV void p0_convert(const float* src, bf16_t* dst, int item) {
    const int tid = tidx();
#pragma unroll
    for (int i = 0; i < 8; ++i) {
        const size_t e = (size_t)item * 16384 + (size_t)(i * NT + tid) * 4;
        const f32x4 v = *(const f32x4*)(src + e);
        u32x2 o; o[0] = pk2(v[0], v[1]); o[1] = pk2(v[2], v[3]);
        *(u32x2*)(dst + e) = o;
    }
}
typedef float f32x2 __attribute__((ext_vector_type(2)));
typedef float f32x32 __attribute__((ext_vector_type(32)));
typedef unsigned u32x6 __attribute__((ext_vector_type(6)));
DEV void p0_table(const Params& p, int tab, int item) {
    const int lane = tidx() & 63, li = lane & 31, half = lane >> 5, layer = tab >> 1, isv = tab & 1;
#pragma unroll 1
    for (int pass = 0; pass < 2; ++pass) {
        const int row = item * 32 + pass * 16 + (tidx() >> 6) * 2 + half;
        const float* src = (isv ? p.in[I_PV] : p.in[I_PU]) + ((size_t)layer * 16384 + row) * 1024 + li * 32;
        f32x4 v[8]; float mx = 0.f;
#pragma unroll
        for (int i = 0; i < 8; ++i) { v[i] = *(const f32x4*)(src + 4 * i); mx = fmaxf(mx, fmaxf(fmaxf(fabsf(v[i][0]), fabsf(v[i][1])), fmaxf(fabsf(v[i][2]), fabsf(v[i][3])))); }
#pragma unroll
        for (int m = 16; m >= 1; m >>= 1) mx = fmaxf(mx, __shfl_xor(mx, m));
        const float top = isv ? 6.f : 7.5f;
        const float sc = mx > 0.f ? top / mx : 1.f;
        if (!isv) {
            f32x16 pa, pb;
#pragma unroll
            for (int i = 0; i < 16; ++i) { pa[i] = 0.f; pb[i] = 0.f; }
            pa[1] = 1.0f;
            const f32x32 pr = __builtin_amdgcn_cvt_scalef32_pk32_f32_fp6(__builtin_amdgcn_cvt_scalef32_2xpk16_fp6_f32(pa, pb, 1.0f), 1.0f);
            const bool inter = pr[2] == 1.0f;
            f32x16 lo, hi;
#pragma unroll
            for (int i = 0; i < 4; ++i)
#pragma unroll
                for (int e = 0; e < 4; ++e) {
                    const int j = 4 * i + e;
                    const float lin_lo = v[i][e], lin_hi = v[4 + i][e];
                    const float il_lo = v[(2 * j) >> 2][(2 * j) & 3], il_hi = v[(2 * j + 1) >> 2][(2 * j + 1) & 3];
                    lo[j] = (inter ? il_lo : lin_lo) * sc; hi[j] = (inter ? il_hi : lin_hi) * sc;
                }
            const u32x6 w = __builtin_amdgcn_cvt_scalef32_2xpk16_fp6_f32(lo, hi, 1.0f);
            unsigned char* dst = p.ws + WS_U6 + ((size_t)layer * 16384 + row) * 768;
            u32x4 w0; w0[0] = w[0]; w0[1] = w[1]; w0[2] = w[2]; w0[3] = w[3]; u32x2 w1; w1[0] = w[4]; w1[1] = w[5];
            *(u32x4*)(dst + li * 16) = w0; *(u32x2*)(dst + 512 + li * 8) = w1;
        } else {
            const f32x2 pr4 = __builtin_amdgcn_cvt_scalef32_pk_f32_fp4(__builtin_amdgcn_cvt_scalef32_pk_fp4_f32(0u, 1.0f, 0.0f, 1.0f, 0), 1.0f, 0);
            const bool swp = pr4[0] != 1.0f;
            u32x4 w;
#pragma unroll
            for (int d = 0; d < 4; ++d) { unsigned x = 0u;
                x = __builtin_amdgcn_cvt_scalef32_pk_fp4_f32(x, (swp ? v[2 * d][1] : v[2 * d][0]) * sc, (swp ? v[2 * d][0] : v[2 * d][1]) * sc, 1.0f, 0);
                x = __builtin_amdgcn_cvt_scalef32_pk_fp4_f32(x, (swp ? v[2 * d][3] : v[2 * d][2]) * sc, (swp ? v[2 * d][2] : v[2 * d][3]) * sc, 1.0f, 1);
                x = __builtin_amdgcn_cvt_scalef32_pk_fp4_f32(x, (swp ? v[2 * d + 1][1] : v[2 * d + 1][0]) * sc, (swp ? v[2 * d + 1][0] : v[2 * d + 1][1]) * sc, 1.0f, 2);
                x = __builtin_amdgcn_cvt_scalef32_pk_fp4_f32(x, (swp ? v[2 * d + 1][3] : v[2 * d + 1][2]) * sc, (swp ? v[2 * d + 1][2] : v[2 * d + 1][3]) * sc, 1.0f, 3);
                w[d] = x; }
            *(u32x4*)(p.ws + WS_V4 + ((size_t)layer * 16384 + row) * 512 + li * 16) = w;
        }
        if (li == 0) ((float*)(p.ws + WS_S8))[tab * 16384 + row] = mx > 0.f ? mx / top : 1.f;
    }
}
DEV void p0_filter(const Params& p, int set, int chunk, unsigned char* smem) {
    const int Ls = set ? LC : L, l0 = chunk * 64, tid = tidx();
    float* z = (float*)smem;
    float* hd1 = z + 64 * 34;
    float* hd2 = hd1 + 64 * 65;
    const float* w1 = p.in[I_HYW1]; const float* b1 = p.in[I_HYB1]; const float* w2 = p.in[I_HYW2]; const float* b2 = p.in[I_HYB2];
    const float* w3 = p.in[I_HYW3]; const float* fq = p.in[I_HYFREQ];
    for (int i = tid; i < 64 * 33; i += NT) {
        const int pp = i / 33, f = i % 33, l = l0 + pp; float val;
        if (f == 0) val = (float)l / (float)(Ls - 1);
        else { const int jb = (f - 1) & 15; const float fj = 1e-4f + (float)jb * ((15.f - 1e-4f) / 15.f); const float a = fj * (6.283185307179586f * (float)l / (float)Ls); val = f <= 16 ? __cosf(a) : -__sinf(a); }
        z[pp * 34 + f] = val;
    }
    __syncthreads();
    {
        const int j = tid & 63, p0 = tid >> 6;
        float wc[64], acc[8];
#pragma unroll
        for (int f = 0; f < 33; ++f) wc[f] = w1[f * 64 + j];
#pragma unroll
        for (int m = 0; m < 8; ++m) { float sacc = b1[j];
#pragma unroll
            for (int f = 0; f < 33; ++f) sacc = fmaf(z[(p0 + 8 * m) * 34 + f], wc[f], sacc);
            acc[m] = sacc; }
#pragma unroll
        for (int m = 0; m < 8; ++m) hd1[(p0 + 8 * m) * 65 + j] = __sinf(fq[j] * acc[m]);
        __syncthreads();
#pragma unroll
        for (int f = 0; f < 64; ++f) wc[f] = w2[f * 64 + j];
#pragma unroll
        for (int m = 0; m < 8; ++m) { float sacc = b2[j];
#pragma unroll
            for (int f = 0; f < 64; ++f) sacc = fmaf(hd1[(p0 + 8 * m) * 65 + f], wc[f], sacc);
            acc[m] = sacc; }
#pragma unroll
        for (int m = 0; m < 8; ++m) hd2[(p0 + 8 * m) * 65 + j] = __sinf(fq[j] * acc[m]);
        __syncthreads();
    }
    const float max_decay = -15.350567286626973f, min_decay = -3.0701134573253945f;
    float* hraw = (float*)(p.ws + WS_F + (set ? F_HRAW_CTX : F_HRAW_LAT));
    float* hyn = (float*)(p.ws + WS_F + (set ? F_HYP_CTX : F_HYP_LAT)) + (size_t)chunk * 2048;
    for (int cb = 0; cb < 4; ++cb) {
        const int o = cb * NT + tid;
        const int c = o & 511; const float delta = fabsf(min_decay + (float)c * ((max_decay - min_decay) / 511.f));
        float asum = 0.f;
        float* dst = hraw + (size_t)o * Ls + l0;
        for (int ph = 0; ph < 2; ++ph) {
            float acc[32];
#pragma unroll
            for (int pp = 0; pp < 32; ++pp) acc[pp] = 0.f;
#pragma unroll 1
            for (int j0 = 0; j0 < 64; j0 += 16) {
                float wv[16];
#pragma unroll
                for (int j = 0; j < 16; ++j) wv[j] = w3[(j0 + j) * 2048 + o];
#pragma unroll
                for (int j = 0; j < 16; ++j) {
#pragma unroll
                    for (int pp = 0; pp < 32; ++pp) acc[pp] = fmaf(hd2[(ph * 32 + pp) * 65 + j0 + j], wv[j], acc[pp]);
                    SCHED_FENCE();
                }
            }
#pragma unroll
            for (int q4 = 0; q4 < 8; ++q4) {
                f32x4 v;
#pragma unroll
                for (int e = 0; e < 4; ++e) { const int pp = q4 * 4 + e; const float tl = (float)(l0 + ph * 32 + pp) / (float)(Ls - 1); const float val = acc[pp] * expf(-tl * delta); v[e] = val; asum += fabsf(val); }
                *(f32x4*)(dst + ph * 32 + q4 * 4) = v;
            }
        }
        hyn[o] = asum;
    }
    __syncthreads();
}

constexpr int P0_MOD = 192, P0_TR_IN0 = 16 * 36, P0_TR_OUT0 = 256, P0_TR_IN1 = 16 * 80, P0_TR_OUT1 = 256, P0_TR_Q = 16 * 32, P0_KEYS = 32, P0_TAB = 512,
              P0_FILT = L / 64 + LC / 64;
DEV void phase0(const Params& p, unsigned char* smem) {
    bf16_t* W = (bf16_t*)(p.ws + WS_W);
    const int total = P0_MOD + P0_FILT + P0_TR_IN0 + P0_TR_OUT0 + P0_TR_IN1 + P0_TR_OUT1 + 2 * P0_TR_Q + P0_KEYS + 4 * P0_TAB;
    for (int it = blockIdx.x; it < total; it += gridDim.x) {
        int i = it;
        if (i < P0_MOD) { p0_mod(p, i, smem); continue; } i -= P0_MOD;
        if (i < P0_FILT) { if (i < L / 64) p0_filter(p, 0, i, smem); else p0_filter(p, 1, i - L / 64, smem); continue; } i -= P0_FILT;
        if (i < P0_TR_IN0) { p0_transpose(p.in[I_ABWIN], W + W_IN0 / 2, 2304, i, smem); continue; } i -= P0_TR_IN0;
        if (i < P0_TR_OUT0) { p0_transpose(p.in[I_ABWOUT], W + W_OUT0 / 2, 1024, i, smem); continue; } i -= P0_TR_OUT0;
        if (i < P0_TR_IN1) { p0_transpose(p.in[I_HGWIN], W + W_IN1 / 2, 5120, i, smem); continue; } i -= P0_TR_IN1;
        if (i < P0_TR_OUT1) { p0_transpose(p.in[I_HGWOUT], W + W_OUT1 / 2, 1024, i, smem); continue; } i -= P0_TR_OUT1;
        if (i < P0_TR_Q) { p0_transpose(p.in[I_PWQ], W + W_Q0 / 2, 2048, i, smem); continue; } i -= P0_TR_Q;
        if (i < P0_TR_Q) { p0_transpose(p.in[I_PWQ] + (size_t)1024 * 2048, W + W_Q1 / 2, 2048, i, smem); continue; } i -= P0_TR_Q;
        if (i < P0_KEYS) { p0_convert(p.in[I_PKEYS], W + W_KEYS / 2, i); continue; } i -= P0_KEYS;
        p0_table(p, i / P0_TAB, i % P0_TAB);
    }
}

DEV const float* h_row(const Params& p, int layer_src_inputs, int tok) {
    if (layer_src_inputs) return tok < TL ? p.in[I_X] + (size_t)tok * 1024 : p.in[I_CTX] + (size_t)(tok - TL) * 1024;
    return (const float*)(p.ws + WS_H) + (size_t)tok * 1024;
}
DEV void norm_row_store(const Params& p, const f32x4 (&v)[4], int tok, const float* g, int layer, int sh_off, int lane) {
    float ss = 0.f;
#pragma unroll
    for (int i = 0; i < 4; ++i) ss += v[i][0] * v[i][0] + v[i][1] * v[i][1] + v[i][2] * v[i][2] + v[i][3] * v[i][3];
    ss = wave_sum(ss);
    const float rstd = rsqrtf(ss * (1.f / 1024.f) + 1e-6f);
    const float* mod = (const float*)(p.ws + WS_MOD) + ((size_t)layer * NR + mod_row(tok)) * 6144 + sh_off;
    bf16_t* A = (bf16_t*)(p.ws + WS_A) + (size_t)tok * 1024;
#pragma unroll
    for (int i = 0; i < 4; ++i) {
        const int c = i * 256 + lane * 4;
        const f32x4 gg = *(const f32x4*)(g + c), sh = *(const f32x4*)(mod + c), sc = *(const f32x4*)(mod + 1024 + c);
        u32x2 o;
        o[0] = pk2(v[i][0] * rstd * gg[0] * (1.f + sc[0]) + sh[0], v[i][1] * rstd * gg[1] * (1.f + sc[1]) + sh[1]);
        o[1] = pk2(v[i][2] * rstd * gg[2] * (1.f + sc[2]) + sh[2], v[i][3] * rstd * gg[3] * (1.f + sc[3]) + sh[3]);
        *(u32x2*)(A + c) = o;
    }
}
DEV void norm_rows_item(const Params& p, int item, int from_inputs, const float* g, int layer, int sh_off) {
    const int tok = item * 8 + (tidx() >> 6), lane = tidx() & 63;
    const float* src = h_row(p, from_inputs, tok);
    f32x4 v[4];
#pragma unroll
    for (int i = 0; i < 4; ++i) v[i] = *(const f32x4*)(src + i * 256 + lane * 4);
    norm_row_store(p, v, tok, g, layer, sh_off, lane);
}

DEV cf2 cmul(cf2 a, cf2 b) { cf2 r; r.x = a.x * b.x - a.y * b.y; r.y = a.x * b.y + a.y * b.x; return r; }
DEV cf2 twid(int k, float invN) { cf2 r; const float a = (float)k * invN; r.x = __builtin_amdgcn_cosf(a); r.y = -__builtin_amdgcn_sinf(a); return r; }
DEV int fsw(int i) { return i ^ ((i >> 4) & 15) ^ (((i >> 8) & 1) << 4); }
DEV void bfly4_fwd(cf2& a0, cf2& a1, cf2& a2, cf2& a3) {
    cf2 t0, t1, t2, t3; t0.x = a0.x + a2.x; t0.y = a0.y + a2.y; t1.x = a0.x - a2.x; t1.y = a0.y - a2.y; t2.x = a1.x + a3.x; t2.y = a1.y + a3.y;
    const float dx = a1.x - a3.x, dy = a1.y - a3.y; t3.x = dy; t3.y = -dx;
    a0.x = t0.x + t2.x; a0.y = t0.y + t2.y; a1.x = t1.x + t3.x; a1.y = t1.y + t3.y; a2.x = t0.x - t2.x; a2.y = t0.y - t2.y; a3.x = t1.x - t3.x; a3.y = t1.y - t3.y;
}
DEV void bfly4_inv(cf2& c0, cf2& c1, cf2& c2, cf2& c3) {
    cf2 t0, t1, t2, t3; t0.x = c0.x + c2.x; t0.y = c0.y + c2.y; t1.x = c0.x - c2.x; t1.y = c0.y - c2.y; t2.x = c1.x + c3.x; t2.y = c1.y + c3.y;
    const float dx = c1.x - c3.x, dy = c1.y - c3.y; t3.x = -dy; t3.y = dx;
    c0.x = t0.x + t2.x; c0.y = t0.y + t2.y; c1.x = t1.x + t3.x; c1.y = t1.y + t3.y; c2.x = t0.x - t2.x; c2.y = t0.y - t2.y; c3.x = t1.x - t3.x; c3.y = t1.y - t3.y;
}
DEV void fft_stage4(cf2* buf, int S, int s, int g, int G, bool inv) {
    const int N = 1 << (2 * S); const float invN = 1.f / (float)N;
    const int lm = 2 * (S - s), m = 1 << lm, q = m >> 2;
    for (int bf = g; bf < (N >> 2); bf += G) {
        const int j = bf & (q - 1), base = ((bf >> (lm - 2)) << lm) + j, tw = j << (2 * s);
        cf2 a0 = buf[fsw(base)], a1 = buf[fsw(base + q)], a2 = buf[fsw(base + 2 * q)], a3 = buf[fsw(base + 3 * q)];
        if (!inv) { bfly4_fwd(a0, a1, a2, a3); a1 = cmul(a1, twid(tw, invN)); a2 = cmul(a2, twid(2 * tw, invN)); a3 = cmul(a3, twid(3 * tw, invN)); }
        else { cf2 w1 = twid(tw, invN), w2 = twid(2 * tw, invN), w3 = twid(3 * tw, invN); w1.y = -w1.y; w2.y = -w2.y; w3.y = -w3.y; a1 = cmul(a1, w1); a2 = cmul(a2, w2); a3 = cmul(a3, w3); bfly4_inv(a0, a1, a2, a3); }
        buf[fsw(base)] = a0; buf[fsw(base + q)] = a1; buf[fsw(base + 2 * q)] = a2; buf[fsw(base + 3 * q)] = a3;
    }
}
DEV void fft_stage16(cf2* buf, int S, int s, int g, int G, bool inv) {
    const int N = 1 << (2 * S); const float invN = 1.f / (float)N;
    const int lm = 2 * (S - s), m = 1 << lm, q = m >> 2, q2 = q >> 2;
    for (int u = g; u < (N >> 4); u += G) {
        const int j2 = u & (q2 - 1), base = ((u >> (lm - 4)) << lm) + j2;
        cf2 x[4][4];
#pragma unroll
        for (int c = 0; c < 4; ++c)
#pragma unroll
            for (int c2 = 0; c2 < 4; ++c2) x[c][c2] = buf[fsw(base + c * q + c2 * q2)];
        if (!inv) {
#pragma unroll
            for (int c2 = 0; c2 < 4; ++c2) {
                const int tw = (j2 + c2 * q2) << (2 * s);
                bfly4_fwd(x[0][c2], x[1][c2], x[2][c2], x[3][c2]);
                x[1][c2] = cmul(x[1][c2], twid(tw, invN)); x[2][c2] = cmul(x[2][c2], twid(2 * tw, invN)); x[3][c2] = cmul(x[3][c2], twid(3 * tw, invN));
            }
            const int tw2 = j2 << (2 * (s + 1));
            const cf2 v1 = twid(tw2, invN), v2 = twid(2 * tw2, invN), v3 = twid(3 * tw2, invN);
#pragma unroll
            for (int c = 0; c < 4; ++c) {
                bfly4_fwd(x[c][0], x[c][1], x[c][2], x[c][3]);
                x[c][1] = cmul(x[c][1], v1); x[c][2] = cmul(x[c][2], v2); x[c][3] = cmul(x[c][3], v3);
            }
        } else {
            const int tw2 = j2 << (2 * (s + 1));
            cf2 v1 = twid(tw2, invN), v2 = twid(2 * tw2, invN), v3 = twid(3 * tw2, invN); v1.y = -v1.y; v2.y = -v2.y; v3.y = -v3.y;
#pragma unroll
            for (int c = 0; c < 4; ++c) {
                x[c][1] = cmul(x[c][1], v1); x[c][2] = cmul(x[c][2], v2); x[c][3] = cmul(x[c][3], v3);
                bfly4_inv(x[c][0], x[c][1], x[c][2], x[c][3]);
            }
#pragma unroll
            for (int c2 = 0; c2 < 4; ++c2) {
                const int tw = (j2 + c2 * q2) << (2 * s);
                cf2 w1 = twid(tw, invN), w2 = twid(2 * tw, invN), w3 = twid(3 * tw, invN); w1.y = -w1.y; w2.y = -w2.y; w3.y = -w3.y;
                x[1][c2] = cmul(x[1][c2], w1); x[2][c2] = cmul(x[2][c2], w2); x[3][c2] = cmul(x[3][c2], w3);
                bfly4_inv(x[0][c2], x[1][c2], x[2][c2], x[3][c2]);
            }
        }
#pragma unroll
        for (int c = 0; c < 4; ++c)
#pragma unroll
            for (int c2 = 0; c2 < 4; ++c2) buf[fsw(base + c * q + c2 * q2)] = x[c][c2];
    }
}
DEV void fft_fwd(cf2* buf, int S, int g, int G) {
    int s = 0;
    for (; s + 1 < S; s += 2) { fft_stage16(buf, S, s, g, G, false); __syncthreads(); }
    if (s < S) { fft_stage4(buf, S, s, g, G, false); __syncthreads(); }
}
DEV void fft_inv(cf2* buf, int S, int g, int G) {
    int s = S - 1;
    if (S & 1) { fft_stage4(buf, S, s, g, G, true); __syncthreads(); --s; }
    for (; s >= 1; s -= 2) { fft_stage16(buf, S, s - 1, g, G, true); __syncthreads(); }
}
DEV void hf_item(const Params& p, int set, int pi, unsigned char* smem) {
    const int Ls = set ? LC : L, S = set ? FS_CTX : FS_LAT, N = 1 << (2 * S);
    const int gi = tidx() >> 8, g = tidx() & 255, idx = pi * 2 + gi, o = idx >> 9, c = idx & 511;
    cf2* buf = (cf2*)smem + (size_t)gi * N;
    const float* hraw = (const float*)(p.ws + WS_F + (set ? F_HRAW_CTX : F_HRAW_LAT));
    const float* hyn = (const float*)(p.ws + WS_F + (set ? F_HYP_CTX : F_HYP_LAT));
    float nsum = 0.f;
    for (int ch = 0; ch < Ls / 64; ++ch) nsum += hyn[(size_t)ch * 2048 + o * 1024 + c] + hyn[(size_t)ch * 2048 + o * 1024 + 512 + c];
    const float inv = 1.f / nsum;
    const float* hf = hraw + (size_t)(o * 1024 + c) * Ls; const float* hb = hraw + (size_t)(o * 1024 + 512 + c) * Ls;
#pragma unroll 4
    for (int k = g; k < N; k += 256) { float re = 0.f; if (k < Ls) re = hf[k] * inv; else if (k > N - Ls) re = hb[N - k] * inv; cf2 v; v.x = re; v.y = 0.f; buf[fsw(k)] = v; }
    __syncthreads();
    fft_fwd(buf, S, g, 256);
    cf2* HF = (cf2*)(p.ws + WS_F + (set ? F_HF_CTX : F_HF_LAT)) + (size_t)(o * 512 + c) * N;
    for (int k = g; k < N; k += 256) HF[k] = buf[fsw(k)];
    __syncthreads();
}
constexpr int P1_NORM = T / 8, P1_HF = 512;
DEV void phase1(const Params& p, unsigned char* smem) {
    const int total = P1_NORM + 2 * P1_HF;
    for (int it = blockIdx.x; it < total; it += gridDim.x) {
        if (it < P1_NORM) norm_rows_item(p, it, 1, p.in[I_N1G], 0, 0);
        else if (it < P1_NORM + P1_HF) hf_item(p, 0, it - P1_NORM, smem);
        else hf_item(p, 1, it - P1_NORM - P1_HF, smem);
    }
}

constexpr int G_LDA = 72;
template <class Epi>
DEV void gemm_tile(const bf16_t* __restrict__ A, const bf16_t* __restrict__ Wt, int m0, int n0, unsigned char* smem, const Epi& epi, int var = 0) {
    bf16_t* As = (bf16_t*)smem;
    bf16_t* Bs = As + 2 * 256 * G_LDA;
    const int tid = tidx(), lane = tid & 63, w = tid >> 6, wm = w >> 1, wn = w & 1;
    f32x16 acc[2][2];
#pragma unroll
    for (int i = 0; i < 2; ++i)
#pragma unroll
        for (int j = 0; j < 2; ++j)
#pragma unroll
            for (int r = 0; r < 16; ++r) acc[i][j][r] = 0.f;
    u32x4 ra[4], rb[2];
    const bf16_t* Ag = A + (size_t)m0 * 1024; const bf16_t* Bg = Wt + (size_t)n0 * 1024;
#define GLOAD(k0) do { \
        _Pragma("unroll") for (int i = 0; i < 4; ++i) { const int id = tid + NT * i, row = id >> 3, kc = id & 7; ra[i] = *(const u32x4*)(Ag + (size_t)row * 1024 + (k0) + kc * 8); } \
        _Pragma("unroll") for (int i = 0; i < 2; ++i) { const int id = tid + NT * i, row = id >> 3, kc = id & 7; rb[i] = *(const u32x4*)(Bg + (size_t)row * 1024 + (k0) + kc * 8); } } while (0)
#define LSTORE(buf_) do { \
        _Pragma("unroll") for (int i = 0; i < 4; ++i) { const int id = tid + NT * i, row = id >> 3, kc = id & 7; *(u32x4*)(As + ((buf_) * 256 + row) * G_LDA + kc * 8) = ra[i]; } \
        _Pragma("unroll") for (int i = 0; i < 2; ++i) { const int id = tid + NT * i, row = id >> 3, kc = id & 7; *(u32x4*)(Bs + ((buf_) * 128 + row) * G_LDA + kc * 8) = rb[i]; } } while (0)
    GLOAD(0); LSTORE(0); __syncthreads();
    for (int kt = 0; kt < (var == 2 ? 1 : 16); ++kt) {
        const int buf = kt & 1;
        if (kt + 1 < 16) GLOAD((kt + 1) * 64);
        const bf16_t* as = As + (buf * 256 + wm * 64 + (lane & 31)) * G_LDA + 8 * (lane >> 5);
        const bf16_t* bs = Bs + (buf * 128 + wn * 64 + (lane & 31)) * G_LDA + 8 * (lane >> 5);
#pragma unroll
        for (int kk = 0; kk < 4; ++kk) {
            const bf16x8 a0 = *(const bf16x8*)(as + kk * 16), a1 = *(const bf16x8*)(as + 32 * G_LDA + kk * 16);
            const bf16x8 b0 = *(const bf16x8*)(bs + kk * 16), b1 = *(const bf16x8*)(bs + 32 * G_LDA + kk * 16);
            acc[0][0] = __builtin_amdgcn_mfma_f32_32x32x16_bf16(a0, b0, acc[0][0], 0, 0, 0);
            acc[0][1] = __builtin_amdgcn_mfma_f32_32x32x16_bf16(a0, b1, acc[0][1], 0, 0, 0);
            acc[1][0] = __builtin_amdgcn_mfma_f32_32x32x16_bf16(a1, b0, acc[1][0], 0, 0, 0);
            acc[1][1] = __builtin_amdgcn_mfma_f32_32x32x16_bf16(a1, b1, acc[1][1], 0, 0, 0);
        }
        if (kt + 1 < 16) LSTORE(buf ^ 1);
        __syncthreads();
    }
#ifndef HOST_EMU
    if (var == 1) { asm volatile("" :: "v"(acc[0][0]), "v"(acc[0][1]), "v"(acc[1][0]), "v"(acc[1][1])); return; }
#endif
#pragma unroll
    for (int mi = 0; mi < 2; ++mi)
#pragma unroll
        for (int ni = 0; ni < 2; ++ni)
#pragma unroll
            for (int rg = 0; rg < 4; ++rg) {
                const int row = m0 + wm * 64 + mi * 32 + 8 * rg + 4 * (lane >> 5), col = n0 + wn * 64 + ni * 32 + (lane & 31);
                epi(row, col, acc[mi][ni][rg * 4 + 0], acc[mi][ni][rg * 4 + 1], acc[mi][ni][rg * 4 + 2], acc[mi][ni][rg * 4 + 3]);
            }
}
template <class Epi>
DEV void gemm_tile256(const bf16_t* __restrict__ A, const bf16_t* __restrict__ Wt, int m0, int n0, unsigned char* smem, const Epi& epi) {
    bf16_t* As = (bf16_t*)smem;
    bf16_t* Bs = As + 2 * 256 * G_LDA;
    const int tid = tidx(), lane = tid & 63, w = tid >> 6, wm = w >> 2, wn = w & 3;
    f32x16 acc[4][2];
#pragma unroll
    for (int i = 0; i < 4; ++i)
#pragma unroll
        for (int j = 0; j < 2; ++j)
#pragma unroll
            for (int r = 0; r < 16; ++r) acc[i][j][r] = 0.f;
    u32x4 ra[4], rb[4];
    const bf16_t* Ag = A + (size_t)m0 * 1024; const bf16_t* Bg = Wt + (size_t)n0 * 1024;
#define GLOAD2(k0) do { \
        _Pragma("unroll") for (int i = 0; i < 4; ++i) { const int id = tid + NT * i, row = id >> 3, kc = id & 7; ra[i] = *(const u32x4*)(Ag + (size_t)row * 1024 + (k0) + kc * 8); rb[i] = *(const u32x4*)(Bg + (size_t)row * 1024 + (k0) + kc * 8); } } while (0)
#define LSTORE2(buf_) do { \
        _Pragma("unroll") for (int i = 0; i < 4; ++i) { const int id = tid + NT * i, row = id >> 3, kc = id & 7; *(u32x4*)(As + ((buf_) * 256 + row) * G_LDA + kc * 8) = ra[i]; *(u32x4*)(Bs + ((buf_) * 256 + row) * G_LDA + kc * 8) = rb[i]; } } while (0)
    GLOAD2(0); LSTORE2(0); __syncthreads();
    for (int kt = 0; kt < 16; ++kt) {
        const int buf = kt & 1;
        if (kt + 1 < 16) GLOAD2((kt + 1) * 64);
        const bf16_t* as = As + (buf * 256 + wm * 128 + (lane & 31)) * G_LDA + 8 * (lane >> 5);
        const bf16_t* bs = Bs + (buf * 256 + wn * 64 + (lane & 31)) * G_LDA + 8 * (lane >> 5);
#pragma unroll
        for (int kk = 0; kk < 4; ++kk) {
            bf16x8 af[4], bfr[2];
#pragma unroll
            for (int i = 0; i < 4; ++i) af[i] = *(const bf16x8*)(as + i * 32 * G_LDA + kk * 16);
#pragma unroll
            for (int j = 0; j < 2; ++j) bfr[j] = *(const bf16x8*)(bs + j * 32 * G_LDA + kk * 16);
#pragma unroll
            for (int i = 0; i < 4; ++i)
#pragma unroll
                for (int j = 0; j < 2; ++j) acc[i][j] = __builtin_amdgcn_mfma_f32_32x32x16_bf16(af[i], bfr[j], acc[i][j], 0, 0, 0);
        }
        if (kt + 1 < 16) LSTORE2(buf ^ 1);
        __syncthreads();
    }
#undef GLOAD2
#undef LSTORE2
#pragma unroll
    for (int mi = 0; mi < 4; ++mi)
#pragma unroll
        for (int ni = 0; ni < 2; ++ni)
#pragma unroll
            for (int rg = 0; rg < 4; ++rg) {
                const int row = m0 + wm * 128 + mi * 32 + 8 * rg + 4 * (lane >> 5), col = n0 + wn * 64 + ni * 32 + (lane & 31);
                epi(row, col, acc[mi][ni][rg * 4 + 0], acc[mi][ni][rg * 4 + 1], acc[mi][ni][rg * 4 + 2], acc[mi][ni][rg * 4 + 3]);
            }
}
namespace pg8 {
#ifndef HOST_EMU
#define PG8_LAS __attribute__((address_space(3)))
#else
#define PG8_LAS
#endif
typedef unsigned short bf16_t;
constexpr int BM = 256, BK = 64, HALF = 128, HTB = HALF * BK * 2  , STAGE_BYTES = 8 * HTB, NXCD = 8, WGM = 8;

__host__ __device__ __forceinline__ int lds_byte(int r, int c) { const int st = (r >> 4) * 2 + (c >> 5), rr = r & 15, cc = c & 31, ob = rr * 64 + cc * 2; return st * 1024 + (ob ^ (((ob >> 9) & 1) << 5)); }
__host__ __device__ __forceinline__ void stage_rc(int b, int& R, int& C) { const int st = b / 1024, sb = b % 1024, swz = sb ^ (((sb >> 9) & 1) << 5); R = (st >> 1) * 16 + swz / 64; C = (st & 1) * 32 + (swz % 64) / 2; }
__host__ __device__ __forceinline__ int perm32(int rho) { const int n = rho >> 4, i = rho & 15; return 8 * (i >> 2) + 4 * n + (i & 3); }

struct Unit { int pm, pn; };
struct Gemm { const bf16_t* A; const bf16_t* Bt; int M, N, K; };

struct StaticOrder {
    int nM, nN, nwg, G, c;
    __host__ __device__ void init(int M, int N, int G_, int c_) { nM = M / BM; nN = N / BM; nwg = nM * nN; G = G_; c = c_; }
    __host__ __device__ bool next(int i, Unit& u) const {
        const long L = (long)i * G + c; if (L >= nwg) return false;
        int wgid = (int)L; { const int q = nwg / NXCD, r = nwg % NXCD, xcd = wgid % NXCD, off = wgid / NXCD; wgid = (xcd < r ? xcd * (q + 1) : r * (q + 1) + (xcd - r) * q) + off; }
        const int nig = WGM * nN, gid = wgid / nig, fm = gid * WGM, gsz = (nM - fm) < WGM ? (nM - fm) : WGM;
        u.pm = fm + ((wgid % nig) % gsz); u.pn = (wgid % nig) / gsz; return true;
    }
    __device__ __forceinline__ void a_ready(const Unit&) const {}
    __device__ __forceinline__ void done(const Unit&) const {}
};
template <class Epi, class Sched, bool STAMP = false>
__device__ __forceinline__ void gemm_phase(PG8_LAS unsigned char* lds, const Gemm g, const Sched& S, const Epi& E, unsigned long long* stamps = nullptr) {
    const int tid = tidx(), wid = __builtin_amdgcn_readfirstlane(tid >> 6), lane = tid & 63, wr = wid >> 2, wc = wid & 3, fr = lane & 15, fq = lane >> 4;
    const int K = g.K, nt = K / BK;
    int ts_lo = 0, ts_hi = 0, nts = 0; const unsigned long long rt_entry = 0ull; (void)rt_entry; (void)ts_lo; (void)ts_hi; (void)nts;
#define PG8_STAMP() do { if (STAMP && wid == 0 && nts < 64) { const unsigned long long _c = 0ull; \
        ts_lo = (lane == nts) ? (int)(unsigned)_c : ts_lo; ts_hi = (lane == nts) ? (int)(unsigned)(_c >> 32) : ts_hi; ++nts; } } while (0)
    PG8_STAMP();
    unsigned voffA[2], voffB[2];
#pragma unroll
    for (int i = 0; i < 2; ++i) { int R, C; stage_rc(tid * 16 + i * 8192, R, C); const int Rb = Epi::PERM ? ((R & ~31) + perm32(R & 31)) : R;
        voffA[i] = (unsigned)(R * K + C) * 2u; voffB[i] = (unsigned)(Rb * K + C) * 2u; }
    const size_t kstep = (size_t)(BK * 2);
    const size_t hstep = (size_t)HALF * K * 2;
    const size_t tstep = 2 * hstep;
    const unsigned ldsw = (unsigned)wid * 1024u;
    const int aoff = lds_byte(wr * 64 + fr, fq * 8), boff = lds_byte(wc * 32 + fr, fq * 8);
#define PG8_SA(b, h) (((b) * 2 + (h)) * HTB)
#define PG8_SB(b, h) ((4 + (b) * 2 + (h)) * HTB)
#define PG8_STAGE(bufoff, gbase, voff) do { _Pragma("unroll") for (int _i = 0; _i < 2; ++_i) \
        __builtin_amdgcn_global_load_lds((const unsigned*)((const char*)(gbase) + (voff)[_i]), (PG8_LAS unsigned*)(lds + (bufoff) + ldsw + _i * 8192), 16, 0, 0); } while (0)
#define PG8_LDA(dst, b, h) do { _Pragma("unroll") for (int m = 0; m < 4; ++m) _Pragma("unroll") for (int k = 0; k < 2; ++k) dst[m][k] = *(const PG8_LAS bf16x8*)(lds + PG8_SA(b, h) + aoff + m * 2048 + k * 1024); } while (0)
#define PG8_LDB(dst, b, h) do { _Pragma("unroll") for (int n = 0; n < 2; ++n) _Pragma("unroll") for (int k = 0; k < 2; ++k) dst[n][k] = *(const PG8_LAS bf16x8*)(lds + PG8_SB(b, h) + boff + n * 2048 + k * 1024); } while (0)
#define PG8_MMA(ai, bj, At, Bt) do { __builtin_amdgcn_s_setprio(1); _Pragma("unroll") for (int m = 0; m < 4; ++m) _Pragma("unroll") for (int n = 0; n < 2; ++n) _Pragma("unroll") for (int k = 0; k < 2; ++k) \
        acc[ai][bj][m][n] = __builtin_amdgcn_mfma_f32_16x16x32_bf16(Bt[n][k], At[m][k], acc[ai][bj][m][n], 0, 0, 0); __builtin_amdgcn_s_setprio(0); } while (0)
#ifndef HOST_EMU
#define PG8_WAIT_V(n) asm volatile("s_waitcnt vmcnt(" #n ")" ::: "memory")
#define PG8_WAIT_L(n) asm volatile("s_waitcnt lgkmcnt(" #n ")" ::: "memory")
#else
#define PG8_WAIT_V(n) do {} while (0)
#define PG8_WAIT_L(n) do {} while (0)
#endif
#define PG8_BAR __builtin_amdgcn_s_barrier()
#define PG8_SCHED __builtin_amdgcn_sched_barrier(0)
    Unit cur, nxt; int ui = 0;
    if (!S.next(0, cur)) return;
    f32x4 acc[2][2][4][2];
#pragma unroll
    for (int a = 0; a < 2; ++a)
#pragma unroll
        for (int b = 0; b < 2; ++b)
#pragma unroll
            for (int m = 0; m < 4; ++m)
#pragma unroll
                for (int n = 0; n < 2; ++n) acc[a][b][m][n] = (f32x4){0.f, 0.f, 0.f, 0.f};
    bf16x8 At[4][2], B0[2][2], B1[2][2];
    const char* cA = (const char*)g.A + (size_t)cur.pm * tstep; const char* cB = (const char*)g.Bt + (size_t)cur.pn * tstep;
    S.a_ready(cur);
    PG8_STAGE(PG8_SB(0, 0), cB, voffB); PG8_STAGE(PG8_SA(0, 0), cA, voffA); PG8_STAGE(PG8_SB(0, 1), cB + hstep, voffB); PG8_STAGE(PG8_SA(0, 1), cA + hstep, voffA);
    if (wr == 1) PG8_BAR;
    PG8_WAIT_V(4); PG8_BAR;
    PG8_STAGE(PG8_SB(1, 0), cB + kstep, voffB); PG8_STAGE(PG8_SA(1, 0), cA + kstep, voffA); PG8_STAGE(PG8_SB(1, 1), cB + hstep + kstep, voffB);
    PG8_WAIT_V(6); PG8_BAR;
    PG8_STAMP();
    for (;;) {
        const bool has_next = S.next(ui + 1, nxt);
        const char* nA = has_next ? (const char*)g.A + (size_t)nxt.pm * tstep : cA; const char* nB = has_next ? (const char*)g.Bt + (size_t)nxt.pn * tstep : cB;
        for (int t = 0; t < nt; t += 2) {
            const bool last = (t == nt - 2);
            const char* a1 = cA + (size_t)(t + 1) * kstep;
            const char* a2 = last ? nA : cA + (size_t)(t + 2) * kstep; const char* b2 = last ? nB : cB + (size_t)(t + 2) * kstep;
            const char* a3 = a2 + kstep; const char* b3 = b2 + kstep;
            if (last && has_next) S.a_ready(nxt);
            PG8_LDB(B0, 0, 0); PG8_SCHED; PG8_LDA(At, 0, 0); PG8_STAGE(PG8_SA(1, 1), a1 + hstep, voffA);
            PG8_WAIT_L(8); PG8_BAR; PG8_WAIT_L(0); PG8_MMA(0, 0, At, B0); PG8_BAR; PG8_SCHED;
            PG8_LDB(B1, 0, 1); PG8_STAGE(PG8_SB(0, 0), b2, voffB);
            PG8_BAR; PG8_WAIT_L(0); PG8_MMA(0, 1, At, B1); PG8_BAR;
            PG8_LDA(At, 0, 1); PG8_STAGE(PG8_SA(0, 0), a2, voffA);
            PG8_BAR; PG8_WAIT_L(0); PG8_MMA(1, 0, At, B0); PG8_BAR; PG8_SCHED;
            PG8_STAGE(PG8_SB(0, 1), b2 + hstep, voffB);
            PG8_WAIT_V(6); PG8_BAR; PG8_MMA(1, 1, At, B1); PG8_BAR;
            PG8_LDB(B0, 1, 0); PG8_SCHED; PG8_LDA(At, 1, 0); PG8_STAGE(PG8_SA(0, 1), a2 + hstep, voffA);
            PG8_WAIT_L(8); PG8_BAR; PG8_WAIT_L(0); PG8_MMA(0, 0, At, B0); PG8_BAR; PG8_SCHED;
            PG8_LDB(B1, 1, 1); PG8_STAGE(PG8_SB(1, 0), b3, voffB);
            PG8_BAR; PG8_WAIT_L(0); PG8_MMA(0, 1, At, B1); PG8_BAR;
            PG8_LDA(At, 1, 1); PG8_STAGE(PG8_SA(1, 0), a3, voffA);
            PG8_BAR; PG8_WAIT_L(0); PG8_MMA(1, 0, At, B0); PG8_BAR; PG8_SCHED;
            PG8_STAGE(PG8_SB(1, 1), b3 + hstep, voffB);
            PG8_WAIT_V(6); PG8_BAR; PG8_MMA(1, 1, At, B1); PG8_BAR;
        }
        PG8_STAMP();
        if constexpr (!Epi::AFTER_DRAIN) { E(acc, cur, wr, wc, fr, fq); S.done(cur); }
        PG8_STAMP();
        if (!has_next) break;
#pragma unroll
        for (int a = 0; a < 2; ++a)
#pragma unroll
            for (int b = 0; b < 2; ++b)
#pragma unroll
                for (int m = 0; m < 4; ++m)
#pragma unroll
                    for (int n = 0; n < 2; ++n) acc[a][b][m][n] = (f32x4){0.f, 0.f, 0.f, 0.f};
        cur = nxt; cA = nA; cB = nB; ++ui;
    }
    PG8_WAIT_V(0);
    if (wr == 0) PG8_BAR;
    PG8_BAR;
    if constexpr (Epi::AFTER_DRAIN) { E.fused(acc, cur, wr, wc, fr, fq, lds, wid, lane); S.done(cur); }
    PG8_STAMP();
    if (STAMP && wid == 0) { stamps[lane] = lane < nts ? (((unsigned long long)(unsigned)ts_hi << 32) | (unsigned)ts_lo) : 0ull;
        if (lane == 62) stamps[62] = rt_entry; if (lane == 63) stamps[63] = 0ull; }
#undef PG8_STAMP
#undef PG8_SA
#undef PG8_SB
#undef PG8_STAGE
#undef PG8_LDA
#undef PG8_LDB
#undef PG8_MMA
#undef PG8_WAIT_V
#undef PG8_WAIT_L
#undef PG8_BAR
#undef PG8_SCHED
}
}
template <class Epi> struct PgEpi {
    static constexpr bool PERM = false, AFTER_DRAIN = false;
    Epi e;
    DEV void operator()(const f32x4 (&acc)[2][2][4][2], const pg8::Unit& u, int wr, int wc, int fr, int fq) const {
#pragma unroll
        for (int ai = 0; ai < 2; ++ai)
#pragma unroll
            for (int m = 0; m < 4; ++m)
#pragma unroll
                for (int bj = 0; bj < 2; ++bj)
#pragma unroll
                    for (int n = 0; n < 2; ++n) {
                        const int wcol = u.pm * 256 + ai * 128 + wr * 64 + m * 16 + fr, tok0 = u.pn * 256 + bj * 128 + wc * 32 + n * 16 + 4 * fq;
                        e(tok0, wcol, acc[ai][bj][m][n][0], acc[ai][bj][m][n][1], acc[ai][bj][m][n][2], acc[ai][bj][m][n][3]);
                        SCHED_FENCE();
                    }
    }
};
template <class Epi>
DEV void gemm_pg8(const bf16_t* A, const bf16_t* Wt, int Mtok, int N, unsigned char* smem, const Epi& epi) {
    pg8::Gemm g{Wt, A, N, Mtok, 1024};
    pg8::StaticOrder S; S.init(N, Mtok, (int)gridDim.x, (int)blockIdx.x);
    PgEpi<Epi> E{epi};
    pg8::gemm_phase<PgEpi<Epi>, pg8::StaticOrder, false>((PG8_LAS unsigned char*)smem, g, S, E);
    __syncthreads();
}
struct EpiL0In {
    unsigned char* ws;
    DEV void operator()(int row, int col, float v0, float v1, float v2, float v3) const {
        u32x2 o; o[0] = pk2(v0, v1); o[1] = pk2(v2, v3);
        const bool lat = row < TL; const int b = lat ? row / L : (row - TL) / LC, t = lat ? row - b * L : (row - TL) - b * LC, Lx = lat ? L : LC;
        if (col < 1536) { bf16_t* d = (bf16_t*)(ws + WS_P + (lat ? P_HYT_LAT : P_HYT_CTX)) + ((size_t)b * 1536 + col) * Lx + t; *(u32x2*)d = o; }
        else if (col < 2048) { bf16_t* d = (bf16_t*)(ws + WS_P + P_Q0) + (size_t)row * 512 + (col - 1536); d[0] = (bf16_t)f2bf(v0); d[512] = (bf16_t)f2bf(v1); d[1024] = (bf16_t)f2bf(v2); d[1536] = (bf16_t)f2bf(v3); }
        else if (col < 2176) { bf16_t* d = (bf16_t*)(ws + WS_P + P_K0) + (size_t)row * 128 + (col - 2048); d[0] = (bf16_t)f2bf(v0); d[128] = (bf16_t)f2bf(v1); d[256] = (bf16_t)f2bf(v2); d[384] = (bf16_t)f2bf(v3); }
        else { bf16_t* d = (bf16_t*)(ws + WS_P + (lat ? P_VT_LAT : P_VT_CTX)) + ((size_t)b * 128 + (col - 2176)) * Lx + t; *(u32x2*)d = o; }
    }
};
struct EpiBf16 {
    bf16_t* out; int ld;
    DEV void operator()(int row, int col, float v0, float v1, float v2, float v3) const {
        bf16_t* d = out + (size_t)row * ld + col; d[0] = (bf16_t)f2bf(v0); d[ld] = (bf16_t)f2bf(v1); d[2 * ld] = (bf16_t)f2bf(v2); d[3 * ld] = (bf16_t)f2bf(v3);
    }
};
struct EpiHg {
    unsigned char* ws; const float* lg;
    DEV void operator()(int row, int col, float v0, float v1, float v2, float v3) const {
        float vv[4] = {v0, v1, v2, v3};
        const bool lat = row < TL; const int b = lat ? row / L : (row - TL) / LC, t = lat ? row - b * L : (row - TL) - b * LC, Lx = lat ? L : LC;
        if (col >= 3072 && col < 4096) {
            bf16_t* d = (bf16_t*)(ws + WS_M) + (lat ? (size_t)0 : (size_t)NB * 1024 * L) + ((size_t)b * 1024 + (col - 3072)) * Lx + t;
            u32x2 o; o[0] = pk2(v0, v1); o[1] = pk2(v2, v3); *(u32x2*)d = o;
            return;
        }
        if (col < 1024 || col >= 4096) {
#pragma unroll
            for (int i = 0; i < 4; ++i) vv[i] = silu_f(vv[i]);
        } else {
            const int c = col - 1024;
            const float oml = 1.f - 1.f / (1.f + __expf(lg[c] - lg[2048 + c]));
#pragma unroll
            for (int i = 0; i < 4; ++i) vv[i] = oml / (1.f + __expf(vv[i]));
        }
        if (col < 3072) {
            bf16_t* d = (bf16_t*)(ws + WS_P + (lat ? P1_KQT_LAT : P1_KQT_CTX)) + ((size_t)b * 3072 + col) * Lx + t;
            u32x2 o; o[0] = pk2(vv[0], vv[1]); o[1] = pk2(vv[2], vv[3]); *(u32x2*)d = o;
        } else {
            if (!lat) return;
            bf16_t* d = (bf16_t*)(ws + WS_P + P1_G) + (size_t)row * 1024 + (col - 4096); d[0] = (bf16_t)f2bf(vv[0]); d[1024] = (bf16_t)f2bf(vv[1]); d[2048] = (bf16_t)f2bf(vv[2]); d[3072] = (bf16_t)f2bf(vv[3]);
        }
    }
};
struct EpiRes {
    const Params* p; int from_inputs, layer, goff;
    DEV void operator()(int row, int col, float v0, float v1, float v2, float v3) const {
        float* H = (float*)(p->ws + WS_H) + (size_t)row * 1024 + col;
        const float* hin = h_row(*p, from_inputs, row) + col;
        const float gt = ((const float*)(p->ws + WS_MOD))[((size_t)layer * NR + mod_row(row)) * 6144 + goff + col];
        const float h0 = hin[0], h1 = hin[1024], h2 = hin[2048], h3 = hin[3072];
        H[0] = h0 + gt * v0; H[1024] = h1 + gt * v1; H[2048] = h2 + gt * v2; H[3072] = h3 + gt * v3;
    }
};

DEV float hy_u(const bf16_t* row, int t, int Lx, float w0, float w1, float w2, float b) {
    const float xm = t > 0 ? bf2f(row[t - 1]) : 0.f, x0 = bf2f(row[t]), xp = t + 1 < Lx ? bf2f(row[t + 1]) : 0.f;
    return w0 * xm + w1 * x0 + w2 * xp + b;
}
DEV void hyena_item(const Params& p, int set, int item, unsigned char* smem) {
    const int Ls = set ? LC : L, S = set ? FS_CTX : FS_LAT, N = 1 << (2 * S);
    const int gi = tidx() >> 8, g = tidx() & 255;
    const int bp = item >> 8, c = (item & 255) * 2 + gi, ba = bp * 2, bb = ba + 1;
    cf2* buf = (cf2*)smem + (size_t)gi * N;
    cf2* zk = (cf2*)smem + (size_t)2 * N + (size_t)gi * Ls;
    const bf16_t* hy = (const bf16_t*)(p.ws + WS_P + (set ? P_HYT_CTX : P_HYT_LAT));
    const float* cw = p.in[I_HYCW]; const float* cb = p.in[I_HYCB];
    const cf2* HF = (const cf2*)(p.ws + WS_F + (set ? F_HF_CTX : F_HF_LAT));
    const float invN = 1.f / (float)N;
    {
        const float w0 = cw[c], w1 = cw[1536 + c], w2 = cw[3072 + c], b = cb[c];
        const bf16_t* ra = hy + ((size_t)ba * 1536 + c) * Ls; const bf16_t* rb = hy + ((size_t)bb * 1536 + c) * Ls;
#pragma unroll 4
        for (int t = g; t < N; t += 256) { cf2 v; v.x = 0.f; v.y = 0.f; if (t < Ls) { v.x = hy_u(ra, t, Ls, w0, w1, w2, b); v.y = hy_u(rb, t, Ls, w0, w1, w2, b); zk[t] = v; } buf[fsw(t)] = v; }
    }
    __syncthreads();
    for (int n = 0; n < 2; ++n) {
        fft_fwd(buf, S, g, 256);
        const cf2* hf = HF + (size_t)(n * 512 + c) * N;
        for (int k0 = g; k0 < N; k0 += 1024) {
            cf2 hv[4];
#pragma unroll
            for (int u = 0; u < 4; ++u) { hv[u].x = 0.f; hv[u].y = 0.f; if (k0 + 256 * u < N) hv[u] = hf[k0 + 256 * u]; }
#pragma unroll
            for (int u = 0; u < 4; ++u) { const int k = k0 + 256 * u; if (k < N) buf[fsw(k)] = cmul(buf[fsw(k)], hv[u]); }
        }
        __syncthreads();
        fft_inv(buf, S, g, 256);
        const int gc = (n + 1) * 512 + c;
        const float w0 = cw[gc], w1 = cw[1536 + gc], w2 = cw[3072 + gc], b = cb[gc], dsk = p.in[I_HYSKIP][n * 512 + c];
        const bf16_t* ra = hy + ((size_t)ba * 1536 + gc) * Ls; const bf16_t* rb = hy + ((size_t)bb * 1536 + gc) * Ls;
        bf16_t* M = (bf16_t*)(p.ws + WS_M);
#pragma unroll 4
        for (int t = g; t < N; t += 256) {
            cf2 v; v.x = 0.f; v.y = 0.f;
            if (t < Ls) {
                const cf2 cv = buf[fsw(t)], zo = zk[t];
                v.x = hy_u(ra, t, Ls, w0, w1, w2, b) * (cv.x * invN + dsk * zo.x); v.y = hy_u(rb, t, Ls, w0, w1, w2, b) * (cv.y * invN + dsk * zo.y);
                if (n == 0) zk[t] = v;
                else { const size_t ta = set ? (size_t)TL + (size_t)ba * LC + t : (size_t)ba * L + t, tb = set ? (size_t)TL + (size_t)bb * LC + t : (size_t)bb * L + t;
                       M[ta * 1024 + c] = (bf16_t)f2bf(v.x); M[tb * 1024 + c] = (bf16_t)f2bf(v.y); }
            }
            if (n == 0) buf[fsw(t)] = v;
        }
        __syncthreads();
    }
}
DEV void rope_store(const bf16_t* src, bf16_t* dst, int pos, bool rope, float scale, int ph, int sub) {
    const u32x4 ua = *(const u32x4*)(src + ph * 32 + sub * 8), ub = *(const u32x4*)(src + ph * 32 + 16 + sub * 8);
    float a[8], b[8];
#pragma unroll
    for (int i = 0; i < 4; ++i) { a[2 * i] = bflo(ua[i]); a[2 * i + 1] = bfhi(ua[i]); b[2 * i] = bflo(ub[i]); b[2 * i + 1] = bfhi(ub[i]); }
    if (rope) {
        const float pv = (float)(ph == 0 ? pos / 64 : pos % 64);
#pragma unroll
        for (int e = 0; e < 8; ++e) {
            const float inv = exp2f(-(float)(sub * 8 + e) * (13.287712379549449f / 16.f));
            const float ang = pv * inv, cs = __cosf(ang), sn = __sinf(ang);
            const float na = a[e] * cs - b[e] * sn, nb = b[e] * cs + a[e] * sn; a[e] = na; b[e] = nb;
        }
    }
    u32x4 oa, ob;
#pragma unroll
    for (int i = 0; i < 4; ++i) { oa[i] = pk2(a[2 * i] * scale, a[2 * i + 1] * scale); ob[i] = pk2(b[2 * i] * scale, b[2 * i + 1] * scale); }
    *(u32x4*)(dst + ph * 32 + sub * 8) = oa; *(u32x4*)(dst + ph * 32 + 16 + sub * 8) = ob;
}
constexpr int A_LDQ = 72, A_LDV = 136;
DEV void attn_item(const Params& p, int set, int item, unsigned char* smem) {
    bf16_t* Qs = (bf16_t*)smem;
    bf16_t* Ks = Qs + 128 * A_LDQ;
    bf16_t* Vt = Ks + 128 * A_LDQ;
    const int tid = tidx(), lane = tid & 63, w = tid >> 6, l15 = lane & 15, lg = lane >> 4;
    const int nqb = set ? LC / 128 : L / 128;
    const int h = item & 7, qb = (item >> 3) % nqb, b = (item >> 3) / nqb, kvh = h >> 2;
    const bf16_t* Q0 = (const bf16_t*)(p.ws + WS_P + P_Q0); const bf16_t* K0 = (const bf16_t*)(p.ws + WS_P + P_K0);
    const int qtok0 = set ? TL + b * LC + qb * 128 : b * L + qb * 128;
    { const int row = tid >> 2, ph = (tid >> 1) & 1, sub = tid & 1;
      rope_store(Q0 + (size_t)(qtok0 + row) * 512 + h * 64, Qs + row * A_LDQ, qb * 128 + row, set == 0, 0.125f, ph, sub); }
    __syncthreads();
    bf16x8 qf[2];
    qf[0] = *(const bf16x8*)(Qs + (w * 16 + l15) * A_LDQ + 8 * lg); qf[1] = *(const bf16x8*)(Qs + (w * 16 + l15) * A_LDQ + 32 + 8 * lg);
    float m_run = p.in[I_SINK][h], l_run = 1.f;
    f32x4 O[4];
#pragma unroll
    for (int i = 0; i < 4; ++i) O[i] = (f32x4){0.f, 0.f, 0.f, 0.f};
    const int nwin = set ? 0 : 3, nctx = LC / 128;
    for (int kbi = 0; kbi < nwin + nctx; ++kbi) {
        const bool win = kbi < nwin; const int kb = win ? qb - 1 + kbi : kbi - nwin;
        if (win && (kb < 0 || kb >= L / 128)) continue;
        const int ktok0 = win ? b * L + kb * 128 : TL + b * LC + kb * 128;
        __syncthreads();
        { const int row = tid >> 2, ph = (tid >> 1) & 1, sub = tid & 1;
          rope_store(K0 + (size_t)(ktok0 + row) * 128 + kvh * 64, Ks + row * A_LDQ, kb * 128 + row, win, 1.f, ph, sub); }
        { const bf16_t* vt = (const bf16_t*)(p.ws + WS_P + (win ? P_VT_LAT : P_VT_CTX)); const int Lx = win ? L : LC;
#pragma unroll
          for (int i = 0; i < 2; ++i) { const int id = tid + NT * i, d = id >> 4, kc = id & 15;
              *(u32x4*)(Vt + d * A_LDV + kc * 8) = *(const u32x4*)(vt + ((size_t)b * 128 + kvh * 64 + d) * Lx + kb * 128 + kc * 8); } }
        __syncthreads();
#pragma unroll
        for (int ch = 0; ch < 2; ++ch) {
            f32x4 st[4];
#pragma unroll
            for (int u = 0; u < 4; ++u) {
                const bf16_t* kr = Ks + ((ch * 4 + u) * 16 + l15) * A_LDQ + 8 * lg;
                f32x4 z = (f32x4){0.f, 0.f, 0.f, 0.f};
                z = __builtin_amdgcn_mfma_f32_16x16x32_bf16(*(const bf16x8*)kr, qf[0], z, 0, 0, 0);
                z = __builtin_amdgcn_mfma_f32_16x16x32_bf16(*(const bf16x8*)(kr + 32), qf[1], z, 0, 0, 0);
                st[u] = z;
            }
            float cmax = -INFINITY;
            if (win) {
                const int qpos = qb * 128 + w * 16 + l15;
#pragma unroll
                for (int u = 0; u < 4; ++u)
#pragma unroll
                    for (int r = 0; r < 4; ++r) { const int kpos = kb * 128 + (ch * 4 + u) * 16 + 4 * lg + r; const int dd = qpos - kpos; if (dd > 128 || dd < -128) st[u][r] = -INFINITY; }
            }
#pragma unroll
            for (int u = 0; u < 4; ++u)
#pragma unroll
                for (int r = 0; r < 4; ++r) cmax = fmaxf(cmax, st[u][r]);
            cmax = fmaxf(cmax, __shfl_xor(cmax, 16)); cmax = fmaxf(cmax, __shfl_xor(cmax, 32));
            const float m_new = fmaxf(m_run, cmax), alpha = __expf(m_run - m_new);
            float ls = 0.f;
#pragma unroll
            for (int u = 0; u < 4; ++u)
#pragma unroll
                for (int r = 0; r < 4; ++r) { const float e = __expf(st[u][r] - m_new); st[u][r] = e; ls += e; }
            ls += __shfl_xor(ls, 16); ls += __shfl_xor(ls, 32);
            l_run = l_run * alpha + ls; m_run = m_new;
#pragma unroll
            for (int i = 0; i < 4; ++i) { O[i][0] *= alpha; O[i][1] *= alpha; O[i][2] *= alpha; O[i][3] *= alpha; }
#pragma unroll
            for (int ss = 0; ss < 2; ++ss) {
                u32x4 pu; pu[0] = pk2(st[2 * ss][0], st[2 * ss][1]); pu[1] = pk2(st[2 * ss][2], st[2 * ss][3]); pu[2] = pk2(st[2 * ss + 1][0], st[2 * ss + 1][1]); pu[3] = pk2(st[2 * ss + 1][2], st[2 * ss + 1][3]);
                const bf16x8 pf = __builtin_bit_cast(bf16x8, pu);
                const int key0 = (ch * 4 + 2 * ss) * 16 + 4 * lg;
#pragma unroll
                for (int dt = 0; dt < 4; ++dt) {
                    const bf16_t* vr = Vt + (dt * 16 + l15) * A_LDV + key0;
                    u32x4 vu; const u32x2 v0 = *(const u32x2*)vr, v1 = *(const u32x2*)(vr + 16); vu[0] = v0[0]; vu[1] = v0[1]; vu[2] = v1[0]; vu[3] = v1[1];
                    O[dt] = __builtin_amdgcn_mfma_f32_16x16x32_bf16(__builtin_bit_cast(bf16x8, vu), pf, O[dt], 0, 0, 0);
                }
            }
        }
    }
    const float il = 1.f / l_run;
    bf16_t* M = (bf16_t*)(p.ws + WS_M) + (size_t)(qtok0 + w * 16 + l15) * 1024 + 512 + h * 64;
#pragma unroll
    for (int dt = 0; dt < 4; ++dt) { u32x2 o; o[0] = pk2(O[dt][0] * il, O[dt][1] * il); o[1] = pk2(O[dt][2] * il, O[dt][3] * il); *(u32x2*)(M + dt * 16 + 4 * lg) = o; }
    __syncthreads();
}
constexpr int P3_HY_LAT = (NB / 2) * 256, P3_HY_CTX = (NB / 2) * 256, P3_AT_LAT = NB * (L / 128) * 8, P3_AT_CTX = NB * (LC / 128) * 8;
DEV void phase3(const Params& p, unsigned char* smem, int var = 0) {
    const int total = P3_HY_LAT + P3_AT_LAT + P3_HY_CTX + P3_AT_CTX;
    for (int it = blockIdx.x; it < total; it += gridDim.x) {
        int i = it;
        if (var == 1 && !(i < P3_HY_LAT || (i >= P3_HY_LAT + P3_AT_LAT && i < P3_HY_LAT + P3_AT_LAT + P3_HY_CTX))) continue;
        if (var == 2 && (i < P3_HY_LAT || (i >= P3_HY_LAT + P3_AT_LAT && i < P3_HY_LAT + P3_AT_LAT + P3_HY_CTX))) continue;
        if (i < P3_HY_LAT) { hyena_item(p, 0, i, smem); continue; } i -= P3_HY_LAT;
        if (i < P3_AT_LAT) { attn_item(p, 0, i, smem); continue; } i -= P3_AT_LAT;
        if (i < P3_HY_CTX) { hyena_item(p, 1, i, smem); continue; } i -= P3_HY_CTX;
        attn_item(p, 1, i, smem);
    }
}

constexpr int K_LDK = 136, K_LDS = 129, K_LDC = 52;
DEV unsigned fkey(float f) { const unsigned u = __builtin_bit_cast(unsigned, f); return (u & 0x80000000u) ? ~u : (u | 0x80000000u); }
constexpr int cand_off(int i) { int o = 0; for (int k = 0; k < i; ++k) o += 16 / (k + 1); return o; }
DEV void topk_load_keys(const Params& p, int layer, int h, unsigned char* smem) {
    bf16_t* Ks = (bf16_t*)smem;
    const bf16_t* keys = (const bf16_t*)(p.ws + WS_W + W_KEYS) + (size_t)layer * 262144 + (size_t)h * 32768;
    const int tid = tidx();
#pragma unroll
    for (int i = 0; i < 8; ++i) { const int id = tid + NT * i, row = id >> 4, kc = id & 15; *(u32x4*)(Ks + row * K_LDK + kc * 8) = *(const u32x4*)(keys + (size_t)row * 128 + kc * 8); }
    __syncthreads();
}
#ifndef HOST_EMU
template <int CTRL> DEV unsigned dpp_u32(unsigned v) { return (unsigned)__builtin_amdgcn_update_dpp(0, (int)v, CTRL, 0xF, 0xF, true); }
#else
template <int CTRL> DEV unsigned dpp_u32(unsigned v) { const int lane = tidx() & 63; const int src = CTRL == 0xB1 ? (lane ^ 1) : CTRL == 0x4E ? (lane ^ 2) : ((lane & ~7) | (7 - (lane & 7))); return emu_shfl(v, src); }
#endif
DEV unsigned max8_u32(unsigned v) { unsigned t = dpp_u32<0xB1>(v); v = v > t ? v : t; t = dpp_u32<0x4E>(v); v = v > t ? v : t; t = dpp_u32<0x141>(v); return v > t ? v : t; }
DEV float sum8_f32(float v) { v += __builtin_bit_cast(float, dpp_u32<0xB1>(__builtin_bit_cast(unsigned, v))); v += __builtin_bit_cast(float, dpp_u32<0x4E>(__builtin_bit_cast(unsigned, v))); v += __builtin_bit_cast(float, dpp_u32<0x141>(__builtin_bit_cast(unsigned, v))); return v; }
DEV float unkey(unsigned k) { const unsigned u = (k & 0x80000000u) ? (k & 0x7fffffffu) : ~k; return __builtin_bit_cast(float, u); }
template <int N> DEV void bitonic_desc(unsigned (&a)[N]) {
#pragma unroll
    for (int k = 2; k <= N; k <<= 1)
#pragma unroll
        for (int j = k >> 1; j > 0; j >>= 1)
#pragma unroll
            for (int i = 0; i < N; ++i) { const int l = i ^ j; if (l > i) { const unsigned x = a[i], y = a[l]; const unsigned hi = x > y ? x : y, lo = x > y ? y : x; if ((i & k) == 0) { a[i] = hi; a[l] = lo; } else { a[i] = lo; a[l] = hi; } } }
}
DEV void merge16(const unsigned* lst, int nlist, unsigned first, int sub, unsigned& r0, unsigned& r1) {
    unsigned cur = first; int head = 0; r0 = 0u; r1 = 0u;
#pragma unroll
    for (int it = 0; it < 16; ++it) {
        const unsigned m = max8_u32(cur);
        if (sub == (it & 7)) { if (it < 8) r0 = m; else r1 = m; }
        if (cur == m) { ++head; cur = head < nlist ? lst[head] : 0u; }
    }
}
DEV void topk_item(const Params& p, int h, int tok0, unsigned char* smem) {
    bf16_t* Ks = (bf16_t*)smem;
    float* Sc = (float*)(Ks + 2 * 128 * K_LDK);
    unsigned* s12 = (unsigned*)Sc + 64 * 8 * 17;
    unsigned* cl = s12 + 64 * 32;
    const int tid = tidx(), lane = tid & 63, w = tid >> 6;
    const int row = tid >> 3, sub = tid & 7;
    const bf16_t* PQ = (const bf16_t*)(p.ws + WS_P);
    for (int part = 0; part < 2; ++part) {
        { const int mi = w >> 2, ni = w & 3;
          f32x16 acc;
#pragma unroll
          for (int r = 0; r < 16; ++r) acc[r] = 0.f;
          const bf16_t* ag = PQ + (size_t)(tok0 + mi * 32 + (lane & 31)) * 2048 + h * 256 + part * 128 + 8 * (lane >> 5);
          const bf16_t* bs = Ks + (part * 128 + ni * 32 + (lane & 31)) * K_LDK + 8 * (lane >> 5);
          bf16x8 af[8];
#pragma unroll
          for (int kk = 0; kk < 8; ++kk) af[kk] = *(const bf16x8*)(ag + kk * 16);
#pragma unroll
          for (int kk = 0; kk < 8; ++kk) acc = __builtin_amdgcn_mfma_f32_32x32x16_bf16(af[kk], *(const bf16x8*)(bs + kk * 16), acc, 0, 0, 0);
#pragma unroll
          for (int r = 0; r < 16; ++r) Sc[(mi * 32 + (r & 3) + 8 * (r >> 2) + 4 * (lane >> 5)) * K_LDS + ni * 32 + (lane & 31)] = acc[r]; }
        __syncthreads();
        unsigned mk[16];
#pragma unroll
        for (int i = 0; i < 16; ++i) mk[i] = (fkey(Sc[row * K_LDS + sub * 16 + i]) & ~127u) | (unsigned)(127 - (sub * 16 + i));
        bitonic_desc<16>(mk);
        __syncthreads();
        unsigned* lst = (unsigned*)Sc + (row * 8 + sub) * 17;
#pragma unroll
        for (int i = 0; i < 16; ++i) lst[i] = mk[i];
        unsigned r0, r1;
        merge16(lst, 16, mk[0], sub, r0, r1);
        s12[(row * 2 + part) * 16 + sub] = r0; s12[(row * 2 + part) * 16 + 8 + sub] = r1;
        __syncthreads();
    }
    {
        const unsigned* k1 = s12 + row * 32; const unsigned* k2 = k1 + 16;
        unsigned ck[8];
#pragma unroll
        for (int m = 0; m < 8; ++m) {
            const int cc = sub + 8 * m; int ci = 0, off = 0;
#pragma unroll
            for (int i = 0; i < 15; ++i) { const bool ge = cc >= cand_off(i + 1); ci += ge ? 1 : 0; off += ge ? 16 / (i + 1) : 0; }
            const int cj = cc - off;
            ck[m] = 0u;
            if (cc < 50) ck[m] = (fkey(unkey((k1[ci] & ~127u) | 64u) + unkey((k2[cj] & ~127u) | 64u)) & ~63u) | (unsigned)(63 - cc);
        }
        bitonic_desc<8>(ck);
        unsigned* lst = cl + (row * 8 + sub) * 9;
#pragma unroll
        for (int m = 0; m < 8; ++m) lst[m] = ck[m];
        unsigned r0, r1;
        merge16(lst, 8, ck[0], sub, r0, r1);
        const float a = unkey((r0 & ~63u) | 32u), b = unkey((r1 & ~63u) | 32u);
        const unsigned kmax = max8_u32(r0 > r1 ? r0 : r1); const float vmax = unkey((kmax & ~63u) | 32u);
        const float ea = __expf(a - vmax), eb = __expf(b - vmax);
        const float inv = 1.f / sum8_f32(ea + eb);
        int eidx[2];
#pragma unroll
        for (int q = 0; q < 2; ++q) {
            const int cc = 63 - (int)((q ? r1 : r0) & 63u); int ci = 0, off = 0;
#pragma unroll
            for (int i = 0; i < 15; ++i) { const bool ge = cc >= cand_off(i + 1); ci += ge ? 1 : 0; off += ge ? 16 / (i + 1) : 0; }
            const int cj = cc - off;
            eidx[q] = (127 - (int)(k1[ci] & 127u)) * 128 + (127 - (int)(k2[cj] & 127u));
        }
        int* IDX = (int*)(p.ws + WS_IDX) + (size_t)(tok0 + row) * 128 + h * 16; float* GT = (float*)(p.ws + WS_GATE) + (size_t)(tok0 + row) * 128 + h * 16;
        IDX[sub] = eidx[0]; IDX[8 + sub] = eidx[1]; GT[sub] = ea * inv; GT[8 + sub] = eb * inv;
    }
    __syncthreads();
}
DEV void topk_phase(const Params& p, int layer, int ntok, unsigned char* smem) {
    const int G = gridDim.x, bid = blockIdx.x, h = bid & 7;
    const int nt = ntok / 64;
    if ((G & 7) == 0) {
        if ((bid >> 3) < nt) topk_load_keys(p, layer, h, smem);
        for (int tt = bid >> 3; tt < nt; tt += (G >> 3)) topk_item(p, h, tt * 64, smem);
    } else {
        for (int it = bid; it < nt * 8; it += G) { __syncthreads(); topk_load_keys(p, layer, it & 7, smem); topk_item(p, it & 7, (it >> 3) * 64, smem); }
    }
}

DEV float gelu_f(float x) { return 0.5f * x * (1.f + erff(x * 0.70710678118654752f)); }
DEV void peer_item(const Params& p, int layer, int item, int var = 0) {
    (void)var;
    const int tok = item * 8 + (tidx() >> 6), lane = tidx() & 63, li = lane & 31, half = lane >> 5;
    const bf16_t* A = (const bf16_t*)(p.ws + WS_A) + (size_t)tok * 1024 + li * 32;
    const unsigned char* U6 = p.ws + WS_U6 + (size_t)layer * 16384 * 768; const unsigned char* V4 = p.ws + WS_V4 + (size_t)layer * 16384 * 512;
    const float* SU = (const float*)(p.ws + WS_S8) + (size_t)(layer * 2) * 16384; const float* SV = SU + 16384;
    float x[32], y[32];
#pragma unroll
    for (int q = 0; q < 4; ++q) { const u32x4 a = *(const u32x4*)(A + 8 * q);
#pragma unroll
        for (int i = 0; i < 4; ++i) { x[8 * q + 2 * i] = bflo(a[i]); x[8 * q + 2 * i + 1] = bfhi(a[i]); } }
#pragma unroll
    for (int i = 0; i < 32; ++i) y[i] = 0.f;
    const int* IDX = (const int*)(p.ws + WS_IDX) + (size_t)tok * 128; const float* GT = (const float*)(p.ws + WS_GATE) + (size_t)tok * 128;
    const int i_lo = IDX[lane], i_hi = IDX[64 + lane]; const float g_lo = GT[lane], g_hi = GT[64 + lane];
    const int sl = ((li >> 4) & 1) * 2 + ((li >> 3) & 1);
    u32x4 ulo[4], vq[4]; u32x2 uhi[4];
#define PG_LOADU(g) do { _Pragma("unroll") for (int s_ = 0; s_ < 4; ++s_) { const int e_ = __shfl((g) < 8 ? i_lo : i_hi, (((g) & 7) << 3) + 2 * s_ + half); \
        const unsigned char* r_ = U6 + (size_t)e_ * 768; ulo[s_] = *(const u32x4*)(r_ + li * 16); uhi[s_] = *(const u32x2*)(r_ + 512 + li * 8); } } while (0)
#define PG_LOADV(g) do { _Pragma("unroll") for (int s_ = 0; s_ < 4; ++s_) { const int e_ = __shfl((g) < 8 ? i_lo : i_hi, (((g) & 7) << 3) + 2 * s_ + half); \
        vq[s_] = *(const u32x4*)(V4 + (size_t)e_ * 512 + li * 16); } } while (0)
    PG_LOADU(0); PG_LOADV(0);
    for (int g = 0; g < 16; ++g) {
        const int mk = ((g & 7) << 3) + 2 * sl + half; const int me = __shfl(g < 8 ? i_lo : i_hi, mk); const float mg = __shfl(g < 8 ? g_lo : g_hi, mk);
        const float su = SU[me], sv = SV[me];
        float d[4];
#pragma unroll
        for (int s4 = 0; s4 < 4; ++s4) {
            u32x6 w; w[0] = ulo[s4][0]; w[1] = ulo[s4][1]; w[2] = ulo[s4][2]; w[3] = ulo[s4][3]; w[4] = uhi[s4][0]; w[5] = uhi[s4][1];
            const f32x32 f = __builtin_amdgcn_cvt_scalef32_pk32_f32_fp6(w, 1.0f);
            float a = 0.f;
#pragma unroll
            for (int i = 0; i < 32; ++i) a = fmaf(f[i], x[i], a);
            d[s4] = a; SCHED_FENCE(); }
        if (g + 1 < 16) PG_LOADU(g + 1);
        float r2[2], r1;
        { const bool hi = (li & 16) != 0;
#pragma unroll
          for (int j = 0; j < 2; ++j) { const float send = hi ? d[j] : d[2 + j], keep = hi ? d[2 + j] : d[j]; r2[j] = keep + __shfl_xor(send, 16); } }
        { const bool hi = (li & 8) != 0; const float send = hi ? r2[0] : r2[1], keep = hi ? r2[1] : r2[0]; r1 = keep + __shfl_xor(send, 8); }
        r1 += __shfl_xor(r1, 4); r1 += __shfl_xor(r1, 2); r1 += __shfl_xor(r1, 1);
        const float act = gelu_f(r1 * su) * mg * sv;
#pragma unroll
        for (int s4 = 0; s4 < 4; ++s4) {
            const float aj = __shfl(act, (lane & 32) + 16 * (s4 >> 1) + 8 * (s4 & 1));
#pragma unroll
            for (int dw = 0; dw < 4; ++dw) {
                const f32x2 f0 = __builtin_amdgcn_cvt_scalef32_pk_f32_fp4(vq[s4][dw], 1.0f, 0), f1 = __builtin_amdgcn_cvt_scalef32_pk_f32_fp4(vq[s4][dw], 1.0f, 1),
                            f2 = __builtin_amdgcn_cvt_scalef32_pk_f32_fp4(vq[s4][dw], 1.0f, 2), f3 = __builtin_amdgcn_cvt_scalef32_pk_f32_fp4(vq[s4][dw], 1.0f, 3);
                const int e0 = dw * 8;
                y[e0] = fmaf(aj, f0[0], y[e0]); y[e0 + 1] = fmaf(aj, f0[1], y[e0 + 1]); y[e0 + 2] = fmaf(aj, f1[0], y[e0 + 2]); y[e0 + 3] = fmaf(aj, f1[1], y[e0 + 3]);
                y[e0 + 4] = fmaf(aj, f2[0], y[e0 + 4]); y[e0 + 5] = fmaf(aj, f2[1], y[e0 + 5]); y[e0 + 6] = fmaf(aj, f3[0], y[e0 + 6]); y[e0 + 7] = fmaf(aj, f3[1], y[e0 + 7]);
            }
            SCHED_FENCE(); }
        if (g + 1 < 16) PG_LOADV(g + 1);
    }
#undef PG_LOADU
#undef PG_LOADV
    float yy[16];
#pragma unroll
    for (int i = 0; i < 16; ++i) { const float send = half ? y[i] : y[16 + i], keep = half ? y[16 + i] : y[i]; yy[i] = keep + __shfl_xor(send, 32); }
    const int c0 = li * 32 + half * 16;
    float* H = (float*)(p.ws + WS_H) + (size_t)tok * 1024 + c0;
    const float* g2 = (const float*)(p.ws + WS_MOD) + ((size_t)layer * NR + mod_row(tok)) * 6144 + 5120 + c0;
    float hv[16]; float ss = 0.f;
#pragma unroll
    for (int i = 0; i < 4; ++i) { const f32x4 hh = *(const f32x4*)(H + 4 * i), gg = *(const f32x4*)(g2 + 4 * i);
#pragma unroll
        for (int j = 0; j < 4; ++j) { const float v = hh[j] + gg[j] * yy[4 * i + j]; hv[4 * i + j] = v; ss += v * v; } }
    ss = wave_sum(ss);
    const float rstd = rsqrtf(ss * (1.f / 1024.f) + 1e-6f);
    if (layer == 0) {
#pragma unroll
        for (int i = 0; i < 4; ++i) { f32x4 o; o[0] = hv[4 * i]; o[1] = hv[4 * i + 1]; o[2] = hv[4 * i + 2]; o[3] = hv[4 * i + 3]; *(f32x4*)(H + 4 * i) = o; }
        const float* g = p.in[I_N1G] + 1024 + c0;
        const float* mod = (const float*)(p.ws + WS_MOD) + ((size_t)1 * NR + mod_row(tok)) * 6144 + c0;
        bf16_t* Ao = (bf16_t*)(p.ws + WS_A) + (size_t)tok * 1024 + c0;
        u32x4 o0, o1; float r[16];
#pragma unroll
        for (int i = 0; i < 16; ++i) r[i] = hv[i] * rstd * g[i] * (1.f + mod[1024 + i]) + mod[i];
#pragma unroll
        for (int i = 0; i < 4; ++i) { o0[i] = pk2(r[2 * i], r[2 * i + 1]); o1[i] = pk2(r[8 + 2 * i], r[8 + 2 * i + 1]); }
        *(u32x4*)Ao = o0; *(u32x4*)(Ao + 8) = o1;
    } else {
        const float* g = p.in[I_FG] + c0; float* out = p.out + (size_t)tok * 1024 + c0;
#pragma unroll
        for (int i = 0; i < 4; ++i) { f32x4 o; o[0] = hv[4 * i] * rstd * g[4 * i]; o[1] = hv[4 * i + 1] * rstd * g[4 * i + 1]; o[2] = hv[4 * i + 2] * rstd * g[4 * i + 2]; o[3] = hv[4 * i + 3] * rstd * g[4 * i + 3]; *(f32x4*)(out + 4 * i) = o; }
    }
}

constexpr int S3_LD = 136, S3_LDT = 24, S3_LDV = 72;
constexpr int S3_Q = 0, S3_K = S3_Q + 64 * S3_LD * 2, S3_KT = S3_K + 64 * S3_LD * 2, S3_D = S3_KT + 4 * 128 * S3_LDT * 2, S3_V = S3_D + 4 * 128 * 4, S3_ST = S3_V + 64 * S3_LDV * 2,
              S3_P = S3_ST + 2 * 64 * S3_LD * 2, S3_END = S3_P + 4 * 16 * S3_LDT * 2;
static_assert(S3_END <= SMEM_BYTES, "scan LDS");
DEV void scan_block(const Params& p, int bi, unsigned char* smem, int var = 0) {
    const int tid = tidx(), lane = tid & 63, w = tid >> 6, l15 = lane & 15, lg4 = lane >> 4, l31 = lane & 31, lh = lane >> 5;
    const int half = bi & 1, dir = (bi >> 1) & 1, h = (bi >> 2) & 7, b = bi >> 5;
    const bf16_t* P1 = (const bf16_t*)(p.ws + WS_P);
    const bf16_t* IT = (const bf16_t*)(p.ws + WS_M);
    bf16_t* Oo = (bf16_t*)(p.ws + WS_F + (dir ? F_OB : F_OF));
    bf16_t* Qs = (bf16_t*)(smem + S3_Q); bf16_t* Ks = (bf16_t*)(smem + S3_K); bf16_t* KT = (bf16_t*)(smem + S3_KT); float* Ds = (float*)(smem + S3_D);
    bf16_t* Vs = (bf16_t*)(smem + S3_V); bf16_t* ST = (bf16_t*)(smem + S3_ST); bf16_t* Ps = (bf16_t*)(smem + S3_P);
    const int NCH = (LC + L) / 64;
    const int kt = w >> 1, vt = w & 1;
    f32x16 S;
#pragma unroll
    for (int r = 0; r < 16; ++r) S[r] = 0.f;
    for (int i = tid; i < 64 * S3_LD / 2; i += NT) ((unsigned*)ST)[i] = 0u;
    const int pk = tid & 127, pblk = tid >> 7;
    u32x4 ka[2], qa[2], va, kb2[2], qb2[2], vb2;
    const int kcol = 1024 * (1 + dir) + h * 128 + pk, qcol = h * 128 + pk;
#define S3_T0(c) ((c) * 64 < LC ? (dir ? LC - 64 - (c) * 64 : (c) * 64) : (dir ? L - 64 - ((c) * 64 - LC) : (c) * 64 - LC))
#define S3_LOAD(c, KR, QR, VR) do { const bool lat_ = (c) * 64 >= LC; const int t0_ = S3_T0(c); const int Lx_ = lat_ ? L : LC; \
        const bf16_t* kq_ = (const bf16_t*)(p.ws + WS_P + (lat_ ? P1_KQT_LAT : P1_KQT_CTX)) + (size_t)b * 3072 * Lx_ + t0_ + pblk * 16; \
        KR[0] = *(const u32x4*)(kq_ + (size_t)kcol * Lx_); KR[1] = *(const u32x4*)(kq_ + (size_t)kcol * Lx_ + 8); \
        if (lat_) { QR[0] = *(const u32x4*)(kq_ + (size_t)qcol * Lx_); QR[1] = *(const u32x4*)(kq_ + (size_t)qcol * Lx_ + 8); } else { QR[0] = (u32x4){0u, 0u, 0u, 0u}; QR[1] = QR[0]; } \
        { const int v_ = tid >> 3, c8_ = tid & 7; const bf16_t* it_ = IT + (lat_ ? (size_t)0 : (size_t)NB * 1024 * L) + ((size_t)b * 1024 + h * 128 + half * 64 + v_) * Lx_ + t0_ + c8_ * 8; VR = *(const u32x4*)it_; } } while (0)
#define S3_PREP(KR, QR, VR) do { \
            float bsum = 0.f; unsigned short kt16[16]; \
            _Pragma("unroll") for (int rr = 0; rr < 16; ++rr) { \
                const int tl = dir ? 15 - rr : rr; \
                const unsigned ku_ = dir ? KR[(15 - rr) >> 3][((15 - rr) & 7) >> 1] : KR[rr >> 3][(rr & 7) >> 1]; const unsigned qu_ = dir ? QR[(15 - rr) >> 3][((15 - rr) & 7) >> 1] : QR[rr >> 3][(rr & 7) >> 1]; \
                const bool odd_ = dir ? (((15 - rr) & 1) != 0) : ((rr & 1) != 0); \
                const float kv = odd_ ? bfhi(ku_) : bflo(ku_), qv = odd_ ? bfhi(qu_) : bflo(qu_); \
                bsum += __logf(1.f - kv); \
                const float eb = __expf(bsum), ieb = __expf(fminf(-bsum, 80.f)); \
                const unsigned short qt = (unsigned short)f2bf(qv * eb), ktv = (unsigned short)f2bf(kv * ieb); \
                Qs[(pblk * 16 + tl) * S3_LD + pk] = qt; Ks[(pblk * 16 + tl) * S3_LD + pk] = ktv; \
                if (dir) kt16[15 - rr] = ktv; else kt16[rr] = ktv; \
            } \
            u32x4 o0, o1; \
            _Pragma("unroll") for (int i = 0; i < 4; ++i) { o0[i] = (unsigned)kt16[2 * i] | ((unsigned)kt16[2 * i + 1] << 16); o1[i] = (unsigned)kt16[8 + 2 * i] | ((unsigned)kt16[8 + 2 * i + 1] << 16); } \
            *(u32x4*)(KT + (pblk * 128 + pk) * S3_LDT) = o0; *(u32x4*)(KT + (pblk * 128 + pk) * S3_LDT + 8) = o1; \
            Ds[pblk * 128 + pk] = __expf(bsum); \
            { const int v_ = tid >> 3, c8_ = tid & 7; *(u32x4*)(Vs + v_ * S3_LDV + c8_ * 8) = VR; } } while (0)
    S3_LOAD(0, ka, qa, va);
    for (int c = 0; c < NCH; ++c) {
        const bool lat = c * 64 >= LC; const int t0 = S3_T0(c); const size_t tokb = lat ? (size_t)b * L + t0 : (size_t)TL + (size_t)b * LC + t0;
        if ((c & 1) == 0) { if (c + 1 < NCH) S3_LOAD(c + 1, kb2, qb2, vb2); } else { if (c + 1 < NCH) S3_LOAD(c + 1, ka, qa, va); }
        lds_barrier();
        if (var != 1) { if ((c & 1) == 0) S3_PREP(ka, qa, va); else S3_PREP(kb2, qb2, vb2); }
        lds_barrier();

        if (lat && w < 4) {
            f32x4 pt = (f32x4){0.f, 0.f, 0.f, 0.f};
#pragma unroll
            for (int kk = 0; kk < 4; ++kk)
                pt = __builtin_amdgcn_mfma_f32_16x16x32_bf16(*(const bf16x8*)(Ks + (w * 16 + l15) * S3_LD + kk * 32 + 8 * lg4), *(const bf16x8*)(Qs + (w * 16 + l15) * S3_LD + kk * 32 + 8 * lg4), pt, 0, 0, 0);
            float pm[4];
#pragma unroll
            for (int r = 0; r < 4; ++r) { const int sl = 4 * lg4 + r; const bool keep = dir ? (sl >= l15) : (sl <= l15); pm[r] = keep ? pt[r] : 0.f; }
            u32x2 o; o[0] = pk2(pm[0], pm[1]); o[1] = pk2(pm[2], pm[3]);
            *(u32x2*)(Ps + (w * 16 + l15) * S3_LDT + 4 * lg4) = o;
        }
        lds_barrier();
        for (int ib = 0; ib < (var == 2 ? 0 : 4); ++ib) {
            const int blk = dir ? 3 - ib : ib;
            const int cur = (c * 4 + ib) & 1;
            { const bf16x8 a = *(const bf16x8*)(KT + (blk * 128 + 32 * kt + l31) * S3_LDT + 8 * lh);
              const bf16x8 bb = *(const bf16x8*)(Vs + (32 * vt + l31) * S3_LDV + blk * 16 + 8 * lh);
              S = __builtin_amdgcn_mfma_f32_32x32x16_bf16(a, bb, S, 0, 0, 0);
#pragma unroll
              for (int g = 0; g < 4; ++g) { const f32x4 dv = *(const f32x4*)(Ds + blk * 128 + 32 * kt + 8 * g + 4 * lh);
                  S[4 * g] *= dv[0]; S[4 * g + 1] *= dv[1]; S[4 * g + 2] *= dv[2]; S[4 * g + 3] *= dv[3];
                  u32x2 o; o[0] = pk2(S[4 * g], S[4 * g + 1]); o[1] = pk2(S[4 * g + 2], S[4 * g + 3]);
                  *(u32x2*)(ST + ((cur ^ 1) * 64 + 32 * vt + l31) * S3_LD + 32 * kt + 8 * g + 4 * lh) = o; } }
            if (lat && w < 4) {
                f32x4 o = (f32x4){0.f, 0.f, 0.f, 0.f};
#pragma unroll
                for (int kk = 0; kk < 4; ++kk)
                    o = __builtin_amdgcn_mfma_f32_16x16x32_bf16(*(const bf16x8*)(ST + (cur * 64 + 16 * w + l15) * S3_LD + kk * 32 + 8 * lg4), *(const bf16x8*)(Qs + (blk * 16 + l15) * S3_LD + kk * 32 + 8 * lg4), o, 0, 0, 0);
                bf16x8 va = (bf16x8){0, 0, 0, 0, 0, 0, 0, 0}, pb = va;
                if (lg4 < 2) { va = *(const bf16x8*)(Vs + (16 * w + l15) * S3_LDV + blk * 16 + 8 * lg4); pb = *(const bf16x8*)(Ps + (blk * 16 + l15) * S3_LDT + 8 * lg4); }
                o = __builtin_amdgcn_mfma_f32_16x16x32_bf16(va, pb, o, 0, 0, 0);
                u32x2 ou; ou[0] = pk2(o[0], o[1]); ou[1] = pk2(o[2], o[3]);
                *(u32x2*)(Oo + (tokb + blk * 16 + l15) * 1024 + h * 128 + half * 64 + 16 * w + 4 * lg4) = ou;
            }
            lds_barrier();
        }
    }
    lds_barrier();
#undef S3_T0
#undef S3_LOAD
#undef S3_PREP
}
DEV void readout_item(const Params& p, int item) {
    const int tok = item * 8 + (tidx() >> 6), lane = tidx() & 63;
    const bf16_t* of = (const bf16_t*)(p.ws + WS_F + F_OF) + (size_t)tok * 1024 + lane * 16; const bf16_t* ob = (const bf16_t*)(p.ws + WS_F + F_OB) + (size_t)tok * 1024 + lane * 16;
    const bf16_t* gp = (const bf16_t*)(p.ws + WS_P + P1_G) + (size_t)tok * 1024 + lane * 16;
    const float* on = p.in[I_HGON] + (lane & 7) * 16;
    float o[16], gg[16]; float ss = 0.f;
    { const u32x4 a0 = *(const u32x4*)of, a1 = *(const u32x4*)(of + 8), b0 = *(const u32x4*)ob, b1 = *(const u32x4*)(ob + 8), g0 = *(const u32x4*)gp, g1 = *(const u32x4*)(gp + 8);
#pragma unroll
      for (int i = 0; i < 4; ++i) { o[2 * i] = bflo(a0[i]) + bflo(b0[i]); o[2 * i + 1] = bfhi(a0[i]) + bfhi(b0[i]); o[8 + 2 * i] = bflo(a1[i]) + bflo(b1[i]); o[8 + 2 * i + 1] = bfhi(a1[i]) + bfhi(b1[i]);
          gg[2 * i] = bflo(g0[i]); gg[2 * i + 1] = bfhi(g0[i]); gg[8 + 2 * i] = bflo(g1[i]); gg[8 + 2 * i + 1] = bfhi(g1[i]); } }
#pragma unroll
    for (int i = 0; i < 16; ++i) ss += o[i] * o[i];
    ss += __shfl_xor(ss, 1); ss += __shfl_xor(ss, 2); ss += __shfl_xor(ss, 4);
    const float rstd = rsqrtf(ss * (1.f / 128.f) + 1e-6f);
    bf16_t* M = (bf16_t*)(p.ws + WS_M) + (size_t)tok * 1024 + lane * 16;
    u32x4 o0, o1; float r[16];
#pragma unroll
    for (int i = 0; i < 16; ++i) r[i] = o[i] * rstd * on[i] * gg[i];
#pragma unroll
    for (int i = 0; i < 4; ++i) { o0[i] = pk2(r[2 * i], r[2 * i + 1]); o1[i] = pk2(r[8 + 2 * i], r[8 + 2 * i + 1]); }
    *(u32x4*)M = o0; *(u32x4*)(M + 8) = o1;
}

#ifndef HOST_EMU
#define XB_TMO      128
#define XB_XCNT(j)  (256  + 64 * (j))
#define XB_XSUB(j)  (1280 + 64 * (j))
#define XB_XGEN(j)  (2304 + 64 * (j))
#define XB_TOP      3328
#define XB_TOPGEN   3392
#define XCD_BAR_WORDS 3456
#define XB_SPIN_CAP (1u << 18)
#define LAS __attribute__((address_space(3)))

__device__ __forceinline__ unsigned xb_ld(unsigned* p)              { return __hip_atomic_load(p, __ATOMIC_RELAXED, __HIP_MEMORY_SCOPE_AGENT); }
__device__ __forceinline__ unsigned xb_add(unsigned* p, unsigned v) { return __hip_atomic_fetch_add(p, v, __ATOMIC_RELAXED, __HIP_MEMORY_SCOPE_AGENT); }
__device__ __forceinline__ unsigned xb_xcc_id() { return (unsigned)__builtin_amdgcn_s_getreg((3 << 11) | 20) & 0xFu; }
#define XB_SPIN(cond, bar) do { unsigned _sp = 0; while (cond) { __builtin_amdgcn_s_sleep(1); \
    if ((++_sp & 255u) == 0u) { if (xb_ld(&(bar)[XB_TMO])) break; if (_sp > XB_SPIN_CAP) { atomicAdd(&(bar)[XB_TMO], 1u); break; } } } } while (0)

struct XcdBarrier {
    unsigned* bar; unsigned x;
    volatile LAS unsigned* st;
};

__device__ __forceinline__ XcdBarrier xcd_barrier_post(unsigned* bar, volatile LAS unsigned* st) {
    XcdBarrier b; b.bar = bar; b.x = xb_xcc_id(); b.st = st;
    if (threadIdx.x == 0) (void)xb_add(&bar[XB_XCNT(b.x)], 1u);
    return b;
}
__device__ __forceinline__ void xcd_barrier_complete(unsigned* bar, unsigned x, unsigned& nloc, unsigned& nx) {
    const unsigned G = gridDim.x * gridDim.y * gridDim.z;
    unsigned sum, cnt, mine, sp = 0u;
    for (;;) {
        sum = 0u; cnt = 0u; mine = 0u;
#pragma unroll
        for (unsigned j = 0; j < 16; ++j) { const unsigned c = xb_ld(&bar[XB_XCNT(j)]); sum += c; cnt += (c > 0u) ? 1u : 0u; mine = (j == x) ? c : mine; }
        if (sum == G) break;
        __builtin_amdgcn_s_sleep(1);
        if ((++sp & 255u) == 0u) { if (xb_ld(&bar[XB_TMO])) break; if (sp > XB_SPIN_CAP) { atomicAdd(&bar[XB_TMO], 1u); break; } }
    }
    nloc = mine > 0u ? mine : 1u; nx = cnt > 0u ? cnt : 1u;
}

__device__ __forceinline__ void xcd_barrier(const XcdBarrier& b) {
    asm volatile("s_waitcnt vmcnt(0)" ::: "memory");
    __syncthreads();
    if (threadIdx.x == 0) {
        unsigned* bar = b.bar;
        __builtin_amdgcn_s_waitcnt(0);
        unsigned nloc = b.st[0], nx = b.st[1];
        if (nloc == 0u) { xcd_barrier_complete(bar, b.x, nloc, nx); b.st[0] = nloc; b.st[1] = nx; }
        const unsigned old = xb_add(&bar[XB_XSUB(b.x)], 1u);
        const unsigned gen = old / nloc;
        if (old + 1u == (gen + 1u) * nloc) {
            __builtin_amdgcn_fence(__ATOMIC_RELEASE, "agent");
            asm volatile("s_waitcnt vmcnt(0)" ::: "memory");
            const unsigned og = xb_add(&bar[XB_TOP], 1u);
            const unsigned tg = og / nx;
            if (og + 1u == (tg + 1u) * nx) xb_add(&bar[XB_TOPGEN], 1u);
            else XB_SPIN(xb_ld(&bar[XB_TOPGEN]) == tg, bar);
            __builtin_amdgcn_fence(__ATOMIC_ACQUIRE, "agent");
            xb_add(&bar[XB_XGEN(b.x)], 1u);
            asm volatile("s_waitcnt vmcnt(0)" ::: "memory");
        } else {
            XB_SPIN(xb_ld(&bar[XB_XGEN(b.x)]) == gen, bar);
            __builtin_amdgcn_fence(__ATOMIC_ACQUIRE, "agent");
            asm volatile("s_waitcnt vmcnt(0)" ::: "memory");
        }
    }
    __syncthreads();
}

#endif
#ifdef NOINLINE_PHASES
#define NOINL __device__ __attribute__((noinline))
#else
#define NOINL __device__ __forceinline__
#endif
__shared__ __attribute__((aligned(16))) unsigned char g_smem[SMEM_BYTES + 16];
#define PH_COMMON const int G = gridDim.x, bid = blockIdx.x; unsigned char* smem = g_smem; (void)smem; (void)G; (void)bid; \
    const bf16_t* A = (const bf16_t*)(p.ws + WS_A); const bf16_t* Mx = (const bf16_t*)(p.ws + WS_M); const bf16_t* W = (const bf16_t*)(p.ws + WS_W); (void)A; (void)Mx; (void)W;
NOINL void ph0(const Params& p) { PH_COMMON phase0(p, smem); }
NOINL void ph1(const Params& p) { PH_COMMON phase1(p, smem); }
NOINL void ph2(const Params& p) { PH_COMMON EpiL0In e{p.ws}; gemm_pg8(A, W + W_IN0 / 2, T, 2304, smem, e); }
NOINL void ph3(const Params& p, int var = 0) { PH_COMMON phase3(p, smem, var); }
NOINL void ph4(const Params& p) { PH_COMMON EpiRes e{&p, 1, 0, 2048}; for (int t = bid; t < (T / 256) * 8; t += G) gemm_tile(Mx, W + W_OUT0 / 2, (t / 8) * 256, (t % 8) * 128, smem, e); }
NOINL void ph5(const Params& p) { PH_COMMON for (int it = bid; it < T / 8; it += G) norm_rows_item(p, it, 0, p.in[I_N2G], 0, 3072); }
NOINL void ph6(const Params& p, int var = 0) { PH_COMMON (void)var; EpiBf16 e{(bf16_t*)(p.ws + WS_P), 2048}; gemm_pg8(A, W + W_Q0 / 2, T, 2048, smem, e); }
NOINL void ph7(const Params& p) { PH_COMMON topk_phase(p, 0, T, smem); }
NOINL void ph8(const Params& p) { PH_COMMON for (int it = bid; it < T / 8; it += G) peer_item(p, 0, it); }
NOINL void ph9(const Params& p) { PH_COMMON EpiHg e{p.ws, p.in[I_HGLB]}; gemm_pg8(A, W + W_IN1 / 2, T, 5120, smem, e); }
NOINL void ph10(const Params& p, int var = 0) { PH_COMMON for (int bi = bid; bi < NB * 32; bi += G) scan_block(p, bi, smem, var); }
NOINL void ph11(const Params& p) { PH_COMMON for (int it = bid; it < TL / 8; it += G) readout_item(p, it); }
NOINL void ph12(const Params& p) { PH_COMMON EpiRes e{&p, 0, 1, 2048}; gemm_pg8(Mx, W + W_OUT1 / 2, TL, 1024, smem, e); }
NOINL void ph13(const Params& p) { PH_COMMON for (int it = bid; it < TL / 8; it += G) norm_rows_item(p, it, 0, p.in[I_N2G] + 1024, 1, 3072); }
NOINL void ph14(const Params& p) { PH_COMMON EpiBf16 e{(bf16_t*)(p.ws + WS_P), 2048}; gemm_pg8(A, W + W_Q1 / 2, TL, 2048, smem, e); }
NOINL void ph15(const Params& p) { PH_COMMON topk_phase(p, 1, TL, smem); }
NOINL void ph16(const Params& p, int var = 0) { PH_COMMON for (int it = bid; it < TL / 8; it += G) peer_item(p, 1, it, var); }

constexpr int NPHASE = 17;
__global__ void __launch_bounds__(NT, 2) mega(Params p_in) {
    const int ph_lo = p_in.ph_lo, ph_hi = p_in.ph_hi;
#ifndef HOST_EMU
#define GBAR_MAKE() XcdBarrier gbar; gbar.bar = (unsigned*)(p_in.ws + WS_CTRL); gbar.x = xb_xcc_id(); gbar.st = (volatile LAS unsigned*)(LAS unsigned char*)(g_smem + SMEM_BYTES);
    if (ph_hi - ph_lo > 1) {
        volatile LAS unsigned* st = (volatile LAS unsigned*)(LAS unsigned char*)(g_smem + SMEM_BYTES);
        if (threadIdx.x == 0) { st[0] = 0u; st[1] = 0u; }
        __syncthreads();
        (void)xcd_barrier_post((unsigned*)(p_in.ws + WS_CTRL), st);
    }
#endif
    for (int ph = ph_lo; ph < ph_hi; ++ph) {
        if (ph > ph_lo) {
#ifndef HOST_EMU
            { GBAR_MAKE(); xcd_barrier(gbar); }
#endif
        }
#ifndef HOST_EMU
        unsigned long long kp = (unsigned long long)__builtin_amdgcn_kernarg_segment_ptr();
        asm volatile("" : "+s"(kp) :: "memory");
        const Params& p = *(const Params*)(const __attribute__((address_space(4))) Params*)kp;
#else
        const Params& p = p_in;
#endif
#ifdef REPEAT_MASK
        for (int rep_ = ((REPEAT_MASK >> ph) & 1); rep_ >= 0; --rep_) { if (rep_ == 0 && ((REPEAT_MASK >> ph) & 1)) { GBAR_MAKE(); xcd_barrier(gbar); }
#else
        {
#endif
#ifdef ONLY_PHASE
        if (ph != ONLY_PHASE) continue;
        switch (ONLY_PHASE) {
#else
        switch (ph) {
#endif
        case 0: ph0(p); break; case 1: ph1(p); break; case 2: ph2(p); break; case 3:
#if defined(REPEAT_MASK) && defined(P3_VAR)
            ph3(p, rep_ == 1 ? P3_VAR : 0);
#else
            ph3(p);
#endif
            break; case 4: ph4(p); break; case 5: ph5(p); break;
        case 6:
#if defined(REPEAT_MASK) && defined(G_VAR)
            ph6(p, rep_ == 1 ? G_VAR : 0);
#else
            ph6(p);
#endif
            break; case 7: ph7(p); break; case 8: ph8(p); break; case 9: ph9(p); break; case 10:
#if defined(REPEAT_MASK) && defined(SCAN_VAR)
            ph10(p, rep_ == 1 ? SCAN_VAR : 0);
#else
            ph10(p);
#endif
            break; case 11: ph11(p); break;
        case 12: ph12(p); break; case 13: ph13(p); break; case 14: ph14(p); break; case 15: ph15(p); break; case 16:
#if defined(REPEAT_MASK) && defined(PG_VAR)
            ph16(p, rep_ == 1 ? PG_VAR : 0);
#else
            ph16(p);
#endif
            break;
        default: break;
        }
        }
    }
}

#ifndef HOST_EMU
extern "C" void kernel_launch(void* const* d_in, const int* in_sizes, int n_in, void* d_out, int out_size, void* d_ws, size_t ws_size, hipStream_t stream) {
    if (n_in != 29 || ws_size < WS_END || out_size != TL * 1024) { fprintf(stderr, "kernel_launch: unexpected sizes (n_in %d, ws %zu need %zu, out %d)\n", n_in, ws_size, (size_t)WS_END, out_size); return; }
    static int grid = 0;
    if (!grid) { int dev = 0, cus = 0; hipGetDevice(&dev); hipDeviceGetAttribute(&cus, hipDeviceAttributeMultiprocessorCount, dev); grid = cus > 0 ? cus : 256; }
    hipMemsetAsync((unsigned char*)d_ws + WS_CTRL, 0, CTRL_BYTES, stream);
    Params p{};
    for (int i = 0; i < 29; ++i) p.in[i] = (const float*)d_in[i];
    p.out = (float*)d_out; p.ws = (unsigned char*)d_ws;
#ifdef MULTI_LAUNCH
    for (int ph = 0; ph < NPHASE; ++ph) { p.ph_lo = ph; p.ph_hi = ph + 1; hipLaunchKernelGGL(mega, dim3(grid), dim3(NT), 0, stream, p); }
#else
    p.ph_lo = 0; p.ph_hi = NPHASE;
    hipLaunchKernelGGL(mega, dim3(grid), dim3(NT), 0, stream, p);
#endif
}
#endif
```

```cpp
#ifndef HOST_EMU
#include <hip/hip_runtime.h>
#include <cstdio>
#endif

#ifndef CFG_B
#define CFG_B 8
#define CFG_L 2048
#define CFG_LC 256
#endif
#define DEV __device__ __forceinline__
#ifndef HOST_EMU
#define SCHED_FENCE() __builtin_amdgcn_sched_barrier(0)
#endif
#ifdef HOST_EMU
#define SCHED_FENCE() do {} while (0)
#define __expf expf
#define __logf logf
#define __sinf sinf
#define __cosf cosf
#endif

typedef unsigned short bf16_t;
typedef short bf16x8 __attribute__((ext_vector_type(8)));
typedef float f32x16 __attribute__((ext_vector_type(16)));
typedef float f32x4 __attribute__((ext_vector_type(4)));
typedef unsigned u32x4 __attribute__((ext_vector_type(4)));
typedef unsigned u32x2 __attribute__((ext_vector_type(2)));
struct cf2 { float x, y; };

constexpr int NB = CFG_B, L = CFG_L, LC = CFG_LC, D = 1024;
constexpr int TL = NB * L, TC = NB * LC, T = TL + TC;
constexpr int NT = 512;
constexpr int NR = NB + 1;
constexpr int log4ceil(int n) { int s = 0, v = 1; while (v < n) { v *= 4; ++s; } return s; }
constexpr int FS_LAT = log4ceil(2 * L - 1), FS_CTX = log4ceil(2 * LC - 1);
constexpr int NF_LAT = 1 << (2 * FS_LAT), NF_CTX = 1 << (2 * FS_CTX);
static_assert(T % 256 == 0 && TL % 256 == 0 && L % 128 == 0 && LC % 128 == 0 && NB % 2 == 0, "shape");

constexpr size_t al256(size_t x) { return (x + 255) & ~(size_t)255; }
constexpr size_t WS_CTRL = 0, CTRL_BYTES = 65536;
constexpr size_t CTRL_HYNORM = 4096;
constexpr size_t WS_MOD = WS_CTRL + CTRL_BYTES;
constexpr size_t WS_H = al256(WS_MOD + (size_t)2 * NR * 6144 * 4);
constexpr size_t WS_A = al256(WS_H + (size_t)T * 1024 * 4);
constexpr size_t WS_P = al256(WS_A + (size_t)T * 1024 * 2);
constexpr size_t P_BYTES = (size_t)T * 5120 * 2;
constexpr size_t P_HYT_LAT = 0;
constexpr size_t P_HYT_CTX = P_HYT_LAT + (size_t)NB * 1536 * L * 2;
constexpr size_t P_Q0 = P_HYT_CTX + (size_t)NB * 1536 * LC * 2;
constexpr size_t P_K0 = P_Q0 + (size_t)T * 512 * 2;
constexpr size_t P_VT_LAT = P_K0 + (size_t)T * 128 * 2;
constexpr size_t P_VT_CTX = P_VT_LAT + (size_t)NB * 128 * L * 2;
static_assert(P_VT_CTX + (size_t)NB * 128 * LC * 2 <= P_BYTES, "P region");
constexpr size_t P1_KQT_LAT = 0;
constexpr size_t P1_KQT_CTX = P1_KQT_LAT + (size_t)NB * 3072 * L * 2;
constexpr size_t P1_G = P1_KQT_CTX + (size_t)NB * 3072 * LC * 2;
static_assert(P1_G + (size_t)TL * 1024 * 2 <= P_BYTES, "P region (layer 1)");
constexpr size_t WS_M = al256(WS_P + P_BYTES);
constexpr size_t WS_IDX = al256(WS_M + (size_t)T * 1024 * 2);
constexpr size_t WS_GATE = al256(WS_IDX + (size_t)T * 128 * 4);
constexpr size_t WS_U6 = al256(WS_GATE + (size_t)T * 128 * 4);
constexpr size_t WS_V4 = WS_U6 + (size_t)2 * 16384 * 768;
constexpr size_t WS_S8 = WS_V4 + (size_t)2 * 16384 * 512;
constexpr size_t WS_W = al256(WS_S8 + (size_t)4 * 16384 * 4);
constexpr size_t W_IN0 = 0, W_OUT0 = W_IN0 + (size_t)2304 * 1024 * 2, W_IN1 = W_OUT0 + (size_t)1024 * 1024 * 2,
                 W_OUT1 = W_IN1 + (size_t)5120 * 1024 * 2, W_Q0 = W_OUT1 + (size_t)1024 * 1024 * 2, W_Q1 = W_Q0 + (size_t)2048 * 1024 * 2,
                 W_KEYS = W_Q1 + (size_t)2048 * 1024 * 2, W_BYTES = W_KEYS + (size_t)2 * 8 * 2 * 128 * 128 * 2;
constexpr size_t WS_F = al256(WS_W + W_BYTES);
constexpr size_t F_HRAW_LAT = 0;
constexpr size_t F_HRAW_CTX = F_HRAW_LAT + (size_t)2048 * L * 4;
constexpr size_t F_HF_LAT = F_HRAW_CTX + (size_t)2048 * LC * 4;
constexpr size_t F_HF_CTX = F_HF_LAT + (size_t)1024 * NF_LAT * 8;
constexpr size_t F_HYP_LAT = F_HF_CTX + (size_t)1024 * NF_CTX * 8;
constexpr size_t F_HYP_CTX = F_HYP_LAT + (size_t)(L / 64) * 2048 * 4;
constexpr size_t F_END = F_HYP_CTX + (size_t)(LC / 64) * 2048 * 4;
constexpr size_t F_OF = 0, F_OB = (size_t)TL * 1024 * 2;
constexpr size_t F_BYTES = F_END > 2 * F_OB ? F_END : 2 * F_OB;
constexpr size_t WS_END = al256(WS_F + F_BYTES);

struct Params { const float* in[29]; float* out; unsigned char* ws; int ph_lo, ph_hi; };
enum { I_X = 0, I_C, I_CTX, I_CCTX, I_ADAW, I_ADAB, I_N1G, I_N2G, I_FG, I_ABWIN, I_ABWOUT, I_HYCW, I_HYCB, I_HYW1, I_HYB1, I_HYW2, I_HYB2, I_HYW3,
       I_HYFREQ, I_HYSKIP, I_SINK, I_HGWIN, I_HGWOUT, I_HGLB, I_HGON, I_PWQ, I_PKEYS, I_PU, I_PV };

constexpr int SMEM_BYTES = 147456;

#ifndef HOST_EMU
DEV int tidx() { int t = threadIdx.x; asm volatile("" : "+v"(t)); return t; }
#else
DEV int tidx() { return (int)threadIdx.x; }
#endif
#ifndef HOST_EMU
DEV void lds_barrier() { asm volatile("s_waitcnt lgkmcnt(0)" ::: "memory"); __builtin_amdgcn_s_barrier(); asm volatile("" ::: "memory"); }
#else
DEV void lds_barrier() { __syncthreads(); }
#endif
#ifndef HOST_EMU
typedef __bf16 bf16n2 __attribute__((ext_vector_type(2)));
DEV unsigned pk2(float lo, float hi) { bf16n2 v; v[0] = (__bf16)lo; v[1] = (__bf16)hi; return __builtin_bit_cast(unsigned, v); }
DEV unsigned f2bf(float f) { return (unsigned)__builtin_bit_cast(unsigned short, (__bf16)f); }
#else
DEV unsigned f2bf(float f) { unsigned u = __builtin_bit_cast(unsigned, f); return (u + 0x7fffu + ((u >> 16) & 1u)) >> 16; }
DEV unsigned pk2(float lo, float hi) { return f2bf(lo) | (f2bf(hi) << 16); }
#endif
DEV float bf2f(unsigned h) { return __builtin_bit_cast(float, (h & 0xffffu) << 16); }
DEV float bflo(unsigned u) { return __builtin_bit_cast(float, u << 16); }
DEV float bfhi(unsigned u) { return __builtin_bit_cast(float, u & 0xffff0000u); }
DEV float silu_f(float x) { return x / (1.f + __expf(-x)); }
DEV float sigmoid_f(float x) { return 1.f / (1.f + __expf(-x)); }
DEV float wave_sum(float v) {
#pragma unroll
    for (int m = 32; m >= 1; m >>= 1) v += __shfl_xor(v, m);
    return v;
}
DEV int mod_row(int tok) { return tok < TL ? tok / L : NB; }

DEV void p0_mod(const Params& p, int item, unsigned char* smem) {
    const int l = item / 96, col0 = (item % 96) * 64, tid = tidx();
    float* sc = (float*)smem;
    float* red = sc + NR * 1024;
    for (int i = tid; i < NR * 1024; i += NT) { const int r = i >> 10, k = i & 1023; const float c = r < NB ? p.in[I_C][r * 1024 + k] : p.in[I_CCTX][k]; sc[i] = c / (1.f + expf(-c)); }
    __syncthreads();
    const int kq = tid >> 6, col = tid & 63;
    float acc[NR];
#pragma unroll
    for (int r = 0; r < NR; ++r) acc[r] = 0.f;
    const float* w = p.in[I_ADAW] + (size_t)l * 1024 * 6144 + col0 + col;
#pragma unroll 16
    for (int k = kq * 128; k < kq * 128 + 128; ++k) {
        const float wv = w[(size_t)k * 6144];
#pragma unroll
        for (int r = 0; r < NR; ++r) acc[r] += sc[r * 1024 + k] * wv;
    }
#pragma unroll
    for (int r = 0; r < NR; ++r) red[(kq * NR + r) * 64 + col] = acc[r];
    __syncthreads();
    float* mod = (float*)(p.ws + WS_MOD);
    for (int i = tid; i < NR * 64; i += NT) {
        const int r = i >> 6, c = i & 63; float s = 0.f;
        for (int q = 0; q < 8; ++q) s += red[(q * NR + r) * 64 + c];
        mod[((size_t)l * NR + r) * 6144 + col0 + c] = s + p.in[I_ADAB][l * 6144 + col0 + c];
    }
    __syncthreads();
}
DEV void p0_transpose(const float* W, bf16_t* Wt, int N, int tile, unsigned char* smem) {
    float* ts = (float*)smem;
    const int ntn = N / 64, kt = tile / ntn, nt = tile % ntn, k0 = kt * 64, n0 = nt * 64, tid = tidx();
    float rv[8];
#pragma unroll
    for (int m = 0; m < 8; ++m) { const int i = tid + NT * m, kk = i >> 6, nn = i & 63; rv[m] = W[(size_t)(k0 + kk) * N + n0 + nn]; }
#pragma unroll
    for (int m = 0; m < 8; ++m) { const int i = tid + NT * m, kk = i >> 6, nn = i & 63; ts[kk * 65 + nn] = rv[m]; }
    __syncthreads();
#pragma unroll
    for (int m = 0; m < 8; ++m) { const int i = tid + NT * m, nn = i >> 6, kk = i & 63; Wt[(size_t)(n0 + nn) * 1024 + k0 + kk] = (bf16_t)f2bf(ts[kk * 65 + nn]); }
    __syncthreads();
}
DEV void p0_convert(const float* src, bf16_t* dst, int item) {
    const int tid = tidx();
#pragma unroll
    for (int i = 0; i < 8; ++i) {
        const size_t e = (size_t)item * 16384 + (size_t)(i * NT + tid) * 4;
        const f32x4 v = *(const f32x4*)(src + e);
        u32x2 o; o[0] = pk2(v[0], v[1]); o[1] = pk2(v[2], v[3]);
        *(u32x2*)(dst + e) = o;
    }
}
typedef float f32x2 __attribute__((ext_vector_type(2)));
typedef float f32x32 __attribute__((ext_vector_type(32)));
typedef unsigned u32x6 __attribute__((ext_vector_type(6)));
DEV void p0_table(const Params& p, int tab, int item) {
    const int lane = tidx() & 63, li = lane & 31, half = lane >> 5, layer = tab >> 1, isv = tab & 1;
#pragma unroll 1
    for (int pass = 0; pass < 2; ++pass) {
        const int row = item * 32 + pass * 16 + (tidx() >> 6) * 2 + half;
        const float* src = (isv ? p.in[I_PV] : p.in[I_PU]) + ((size_t)layer * 16384 + row) * 1024 + li * 32;
        f32x4 v[8]; float mx = 0.f;
#pragma unroll
        for (int i = 0; i < 8; ++i) { v[i] = *(const f32x4*)(src + 4 * i); mx = fmaxf(mx, fmaxf(fmaxf(fabsf(v[i][0]), fabsf(v[i][1])), fmaxf(fabsf(v[i][2]), fabsf(v[i][3])))); }
#pragma unroll
        for (int m = 16; m >= 1; m >>= 1) mx = fmaxf(mx, __shfl_xor(mx, m));
        const float top = isv ? 6.f : 7.5f;
        const float sc = mx > 0.f ? top / mx : 1.f;
        if (!isv) {
            f32x16 pa, pb;
#pragma unroll
            for (int i = 0; i < 16; ++i) { pa[i] = 0.f; pb[i] = 0.f; }
            pa[1] = 1.0f;
            const f32x32 pr = __builtin_amdgcn_cvt_scalef32_pk32_f32_fp6(__builtin_amdgcn_cvt_scalef32_2xpk16_fp6_f32(pa, pb, 1.0f), 1.0f);
            const bool inter = pr[2] == 1.0f;
            f32x16 lo, hi;
#pragma unroll
            for (int i = 0; i < 4; ++i)
#pragma unroll
                for (int e = 0; e < 4; ++e) {
                    const int j = 4 * i + e;
                    const float lin_lo = v[i][e], lin_hi = v[4 + i][e];
                    const float il_lo = v[(2 * j) >> 2][(2 * j) & 3], il_hi = v[(2 * j + 1) >> 2][(2 * j + 1) & 3];
                    lo[j] = (inter ? il_lo : lin_lo) * sc; hi[j] = (inter ? il_hi : lin_hi) * sc;
                }
            const u32x6 w = __builtin_amdgcn_cvt_scalef32_2xpk16_fp6_f32(lo, hi, 1.0f);
            unsigned char* dst = p.ws + WS_U6 + ((size_t)layer * 16384 + row) * 768;
            u32x4 w0; w0[0] = w[0]; w0[1] = w[1]; w0[2] = w[2]; w0[3] = w[3]; u32x2 w1; w1[0] = w[4]; w1[1] = w[5];
            *(u32x4*)(dst + li * 16) = w0; *(u32x2*)(dst + 512 + li * 8) = w1;
        } else {
            const f32x2 pr4 = __builtin_amdgcn_cvt_scalef32_pk_f32_fp4(__builtin_amdgcn_cvt_scalef32_pk_fp4_f32(0u, 1.0f, 0.0f, 1.0f, 0), 1.0f, 0);
            const bool swp = pr4[0] != 1.0f;
            u32x4 w;
#pragma unroll
            for (int d = 0; d < 4; ++d) { unsigned x = 0u;
                x = __builtin_amdgcn_cvt_scalef32_pk_fp4_f32(x, (swp ? v[2 * d][1] : v[2 * d][0]) * sc, (swp ? v[2 * d][0] : v[2 * d][1]) * sc, 1.0f, 0);
                x = __builtin_amdgcn_cvt_scalef32_pk_fp4_f32(x, (swp ? v[2 * d][3] : v[2 * d][2]) * sc, (swp ? v[2 * d][2] : v[2 * d][3]) * sc, 1.0f, 1);
                x = __builtin_amdgcn_cvt_scalef32_pk_fp4_f32(x, (swp ? v[2 * d + 1][1] : v[2 * d + 1][0]) * sc, (swp ? v[2 * d + 1][0] : v[2 * d + 1][1]) * sc, 1.0f, 2);
                x = __builtin_amdgcn_cvt_scalef32_pk_fp4_f32(x, (swp ? v[2 * d + 1][3] : v[2 * d + 1][2]) * sc, (swp ? v[2 * d + 1][2] : v[2 * d + 1][3]) * sc, 1.0f, 3);
                w[d] = x; }
            *(u32x4*)(p.ws + WS_V4 + ((size_t)layer * 16384 + row) * 512 + li * 16) = w;
        }
        if (li == 0) ((float*)(p.ws + WS_S8))[tab * 16384 + row] = mx > 0.f ? mx / top : 1.f;
    }
}
DEV void p0_filter(const Params& p, int set, int chunk, unsigned char* smem) {
    const int Ls = set ? LC : L, l0 = chunk * 64, tid = tidx();
    float* z = (float*)smem;
    float* hd1 = z + 64 * 34;
    float* hd2 = hd1 + 64 * 65;
    const float* w1 = p.in[I_HYW1]; const float* b1 = p.in[I_HYB1]; const float* w2 = p.in[I_HYW2]; const float* b2 = p.in[I_HYB2];
    const float* w3 = p.in[I_HYW3]; const float* fq = p.in[I_HYFREQ];
    for (int i = tid; i < 64 * 33; i += NT) {
        const int pp = i / 33, f = i % 33, l = l0 + pp; float val;
        if (f == 0) val = (float)l / (float)(Ls - 1);
        else { const int jb = (f - 1) & 15; const float fj = 1e-4f + (float)jb * ((15.f - 1e-4f) / 15.f); const float a = fj * (6.283185307179586f * (float)l / (float)Ls); val = f <= 16 ? __cosf(a) : -__sinf(a); }
        z[pp * 34 + f] = val;
    }
    __syncthreads();
    {
        const int j = tid & 63, p0 = tid >> 6;
        float wc[64], acc[8];
#pragma unroll
        for (int f = 0; f < 33; ++f) wc[f] = w1[f * 64 + j];
#pragma unroll
        for (int m = 0; m < 8; ++m) { float sacc = b1[j];
#pragma unroll
            for (int f = 0; f < 33; ++f) sacc = fmaf(z[(p0 + 8 * m) * 34 + f], wc[f], sacc);
            acc[m] = sacc; }
#pragma unroll
        for (int m = 0; m < 8; ++m) hd1[(p0 + 8 * m) * 65 + j] = __sinf(fq[j] * acc[m]);
        __syncthreads();
#pragma unroll
        for (int f = 0; f < 64; ++f) wc[f] = w2[f * 64 + j];
#pragma unroll
        for (int m = 0; m < 8; ++m) { float sacc = b2[j];
#pragma unroll
            for (int f = 0; f < 64; ++f) sacc = fmaf(hd1[(p0 + 8 * m) * 65 + f], wc[f], sacc);
            acc[m] = sacc; }
#pragma unroll
        for (int m = 0; m < 8; ++m) hd2[(p0 + 8 * m) * 65 + j] = __sinf(fq[j] * acc[m]);
        __syncthreads();
    }
    const float max_decay = -15.350567286626973f, min_decay = -3.0701134573253945f;
    float* hraw = (float*)(p.ws + WS_F + (set ? F_HRAW_CTX : F_HRAW_LAT));
    float* hyn = (float*)(p.ws + WS_F + (set ? F_HYP_CTX : F_HYP_LAT)) + (size_t)chunk * 2048;
    for (int cb = 0; cb < 4; ++cb) {
        const int o = cb * NT + tid;
        const int c = o & 511; const float delta = fabsf(min_decay + (float)c * ((max_decay - min_decay) / 511.f));
        float asum = 0.f;
        float* dst = hraw + (size_t)o * Ls + l0;
        for (int ph = 0; ph < 2; ++ph) {
            float acc[32];
#pragma unroll
            for (int pp = 0; pp < 32; ++pp) acc[pp] = 0.f;
#pragma unroll 1
            for (int j0 = 0; j0 < 64; j0 += 16) {
                float wv[16];
#pragma unroll
                for (int j = 0; j < 16; ++j) wv[j] = w3[(j0 + j) * 2048 + o];
#pragma unroll
                for (int j = 0; j < 16; ++j) {
#pragma unroll
                    for (int pp = 0; pp < 32; ++pp) acc[pp] = fmaf(hd2[(ph * 32 + pp) * 65 + j0 + j], wv[j], acc[pp]);
                    SCHED_FENCE();
                }
            }
#pragma unroll
            for (int q4 = 0; q4 < 8; ++q4) {
                f32x4 v;
#pragma unroll
                for (int e = 0; e < 4; ++e) { const int pp = q4 * 4 + e; const float tl = (float)(l0 + ph * 32 + pp) / (float)(Ls - 1); const float val = acc[pp] * expf(-tl * delta); v[e] = val; asum += fabsf(val); }
                *(f32x4*)(dst + ph * 32 + q4 * 4) = v;
            }
        }
        hyn[o] = asum;
    }
    __syncthreads();
}

constexpr int P0_MOD = 192, P0_TR_IN0 = 16 * 36, P0_TR_OUT0 = 256, P0_TR_IN1 = 16 * 80, P0_TR_OUT1 = 256, P0_TR_Q = 16 * 32, P0_KEYS = 32, P0_TAB = 512,
              P0_FILT = L / 64 + LC / 64;
DEV void phase0(const Params& p, unsigned char* smem) {
    bf16_t* W = (bf16_t*)(p.ws + WS_W);
    const int total = P0_MOD + P0_FILT + P0_TR_IN0 + P0_TR_OUT0 + P0_TR_IN1 + P0_TR_OUT1 + 2 * P0_TR_Q + P0_KEYS + 4 * P0_TAB;
    for (int it = blockIdx.x; it < total; it += gridDim.x) {
        int i = it;
        if (i < P0_MOD) { p0_mod(p, i, smem); continue; } i -= P0_MOD;
        if (i < P0_FILT) { if (i < L / 64) p0_filter(p, 0, i, smem); else p0_filter(p, 1, i - L / 64, smem); continue; } i -= P0_FILT;
        if (i < P0_TR_IN0) { p0_transpose(p.in[I_ABWIN], W + W_IN0 / 2, 2304, i, smem); continue; } i -= P0_TR_IN0;
        if (i < P0_TR_OUT0) { p0_transpose(p.in[I_ABWOUT], W + W_OUT0 / 2, 1024, i, smem); continue; } i -= P0_TR_OUT0;
        if (i < P0_TR_IN1) { p0_transpose(p.in[I_HGWIN], W + W_IN1 / 2, 5120, i, smem); continue; } i -= P0_TR_IN1;
        if (i < P0_TR_OUT1) { p0_transpose(p.in[I_HGWOUT], W + W_OUT1 / 2, 1024, i, smem); continue; } i -= P0_TR_OUT1;
        if (i < P0_TR_Q) { p0_transpose(p.in[I_PWQ], W + W_Q0 / 2, 2048, i, smem); continue; } i -= P0_TR_Q;
        if (i < P0_TR_Q) { p0_transpose(p.in[I_PWQ] + (size_t)1024 * 2048, W + W_Q1 / 2, 2048, i, smem); continue; } i -= P0_TR_Q;
        if (i < P0_KEYS) { p0_convert(p.in[I_PKEYS], W + W_KEYS / 2, i); continue; } i -= P0_KEYS;
        p0_table(p, i / P0_TAB, i % P0_TAB);
    }
}

DEV const float* h_row(const Params& p, int layer_src_inputs, int tok) {
    if (layer_src_inputs) return tok < TL ? p.in[I_X] + (size_t)tok * 1024 : p.in[I_CTX] + (size_t)(tok - TL) * 1024;
    return (const float*)(p.ws + WS_H) + (size_t)tok * 1024;
}
DEV void norm_row_store(const Params& p, const f32x4 (&v)[4], int tok, const float* g, int layer, int sh_off, int lane) {
    float ss = 0.f;
#pragma unroll
    for (int i = 0; i < 4; ++i) ss += v[i][0] * v[i][0] + v[i][1] * v[i][1] + v[i][2] * v[i][2] + v[i][3] * v[i][3];
    ss = wave_sum(ss);
    const float rstd = rsqrtf(ss * (1.f / 1024.f) + 1e-6f);
    const float* mod = (const float*)(p.ws + WS_MOD) + ((size_t)layer * NR + mod_row(tok)) * 6144 + sh_off;
    bf16_t* A = (bf16_t*)(p.ws + WS_A) + (size_t)tok * 1024;
#pragma unroll
    for (int i = 0; i < 4; ++i) {
        const int c = i * 256 + lane * 4;
        const f32x4 gg = *(const f32x4*)(g + c), sh = *(const f32x4*)(mod + c), sc = *(const f32x4*)(mod + 1024 + c);
        u32x2 o;
        o[0] = pk2(v[i][0] * rstd * gg[0] * (1.f + sc[0]) + sh[0], v[i][1] * rstd * gg[1] * (1.f + sc[1]) + sh[1]);
        o[1] = pk2(v[i][2] * rstd * gg[2] * (1.f + sc[2]) + sh[2], v[i][3] * rstd * gg[3] * (1.f + sc[3]) + sh[3]);
        *(u32x2*)(A + c) = o;
    }
}
DEV void norm_rows_item(const Params& p, int item, int from_inputs, const float* g, int layer, int sh_off) {
    const int tok = item * 8 + (tidx() >> 6), lane = tidx() & 63;
    const float* src = h_row(p, from_inputs, tok);
    f32x4 v[4];
#pragma unroll
    for (int i = 0; i < 4; ++i) v[i] = *(const f32x4*)(src + i * 256 + lane * 4);
    norm_row_store(p, v, tok, g, layer, sh_off, lane);
}

DEV cf2 cmul(cf2 a, cf2 b) { cf2 r; r.x = a.x * b.x - a.y * b.y; r.y = a.x * b.y + a.y * b.x; return r; }
DEV cf2 twid(int k, float invN) { cf2 r; const float a = (float)k * invN; r.x = __builtin_amdgcn_cosf(a); r.y = -__builtin_amdgcn_sinf(a); return r; }
DEV int fsw(int i) { return i ^ ((i >> 4) & 15) ^ (((i >> 8) & 1) << 4); }
DEV void bfly4_fwd(cf2& a0, cf2& a1, cf2& a2, cf2& a3) {
    cf2 t0, t1, t2, t3; t0.x = a0.x + a2.x; t0.y = a0.y + a2.y; t1.x = a0.x - a2.x; t1.y = a0.y - a2.y; t2.x = a1.x + a3.x; t2.y = a1.y + a3.y;
    const float dx = a1.x - a3.x, dy = a1.y - a3.y; t3.x = dy; t3.y = -dx;
    a0.x = t0.x + t2.x; a0.y = t0.y + t2.y; a1.x = t1.x + t3.x; a1.y = t1.y + t3.y; a2.x = t0.x - t2.x; a2.y = t0.y - t2.y; a3.x = t1.x - t3.x; a3.y = t1.y - t3.y;
}
DEV void bfly4_inv(cf2& c0, cf2& c1, cf2& c2, cf2& c3) {
    cf2 t0, t1, t2, t3; t0.x = c0.x + c2.x; t0.y = c0.y + c2.y; t1.x = c0.x - c2.x; t1.y = c0.y - c2.y; t2.x = c1.x + c3.x; t2.y = c1.y + c3.y;
    const float dx = c1.x - c3.x, dy = c1.y - c3.y; t3.x = -dy; t3.y = dx;
    c0.x = t0.x + t2.x; c0.y = t0.y + t2.y; c1.x = t1.x + t3.x; c1.y = t1.y + t3.y; c2.x = t0.x - t2.x; c2.y = t0.y - t2.y; c3.x = t1.x - t3.x; c3.y = t1.y - t3.y;
}
DEV void fft_stage4(cf2* buf, int S, int s, int g, int G, bool inv) {
    const int N = 1 << (2 * S); const float invN = 1.f / (float)N;
    const int lm = 2 * (S - s), m = 1 << lm, q = m >> 2;
    for (int bf = g; bf < (N >> 2); bf += G) {
        const int j = bf & (q - 1), base = ((bf >> (lm - 2)) << lm) + j, tw = j << (2 * s);
        cf2 a0 = buf[fsw(base)], a1 = buf[fsw(base + q)], a2 = buf[fsw(base + 2 * q)], a3 = buf[fsw(base + 3 * q)];
        if (!inv) { bfly4_fwd(a0, a1, a2, a3); a1 = cmul(a1, twid(tw, invN)); a2 = cmul(a2, twid(2 * tw, invN)); a3 = cmul(a3, twid(3 * tw, invN)); }
        else { cf2 w1 = twid(tw, invN), w2 = twid(2 * tw, invN), w3 = twid(3 * tw, invN); w1.y = -w1.y; w2.y = -w2.y; w3.y = -w3.y; a1 = cmul(a1, w1); a2 = cmul(a2, w2); a3 = cmul(a3, w3); bfly4_inv(a0, a1, a2, a3); }
        buf[fsw(base)] = a0; buf[fsw(base + q)] = a1; buf[fsw(base + 2 * q)] = a2; buf[fsw(base + 3 * q)] = a3;
    }
}
DEV void fft_stage16(cf2* buf, int S, int s, int g, int G, bool inv) {
    const int N = 1 << (2 * S); const float invN = 1.f / (float)N;
    const int lm = 2 * (S - s), m = 1 << lm, q = m >> 2, q2 = q >> 2;
    for (int u = g; u < (N >> 4); u += G) {
        const int j2 = u & (q2 - 1), base = ((u >> (lm - 4)) << lm) + j2;
        cf2 x[4][4];
#pragma unroll
        for (int c = 0; c < 4; ++c)
#pragma unroll
            for (int c2 = 0; c2 < 4; ++c2) x[c][c2] = buf[fsw(base + c * q + c2 * q2)];
        if (!inv) {
#pragma unroll
            for (int c2 = 0; c2 < 4; ++c2) {
                const int tw = (j2 + c2 * q2) << (2 * s);
                bfly4_fwd(x[0][c2], x[1][c2], x[2][c2], x[3][c2]);
                x[1][c2] = cmul(x[1][c2], twid(tw, invN)); x[2][c2] = cmul(x[2][c2], twid(2 * tw, invN)); x[3][c2] = cmul(x[3][c2], twid(3 * tw, invN));
            }
            const int tw2 = j2 << (2 * (s + 1));
            const cf2 v1 = twid(tw2, invN), v2 = twid(2 * tw2, invN), v3 = twid(3 * tw2, invN);
#pragma unroll
            for (int c = 0; c < 4; ++c) {
                bfly4_fwd(x[c][0], x[c][1], x[c][2], x[c][3]);
                x[c][1] = cmul(x[c][1], v1); x[c][2] = cmul(x[c][2], v2); x[c][3] = cmul(x[c][3], v3);
            }
        } else {
            const int tw2 = j2 << (2 * (s + 1));
            cf2 v1 = twid(tw2, invN), v2 = twid(2 * tw2, invN), v3 = twid(3 * tw2, invN); v1.y = -v1.y; v2.y = -v2.y; v3.y = -v3.y;
#pragma unroll
            for (int c = 0; c < 4; ++c) {
                x[c][1] = cmul(x[c][1], v1); x[c][2] = cmul(x[c][2], v2); x[c][3] = cmul(x[c][3], v3);
                bfly4_inv(x[c][0], x[c][1], x[c][2], x[c][3]);
            }
#pragma unroll
            for (int c2 = 0; c2 < 4; ++c2) {
                const int tw = (j2 + c2 * q2) << (2 * s);
                cf2 w1 = twid(tw, invN), w2 = twid(2 * tw, invN), w3 = twid(3 * tw, invN); w1.y = -w1.y; w2.y = -w2.y; w3.y = -w3.y;
                x[1][c2] = cmul(x[1][c2], w1); x[2][c2] = cmul(x[2][c2], w2); x[3][c2] = cmul(x[3][c2], w3);
                bfly4_inv(x[0][c2], x[1][c2], x[2][c2], x[3][c2]);
            }
        }
#pragma unroll
        for (int c = 0; c < 4; ++c)
#pragma unroll
            for (int c2 = 0; c2 < 4; ++c2) buf[fsw(base + c * q + c2 * q2)] = x[c][c2];
    }
}
DEV void fft_fwd(cf2* buf, int S, int g, int G) {
    int s = 0;
    for (; s + 1 < S; s += 2) { fft_stage16(buf, S, s, g, G, false); __syncthreads(); }
    if (s < S) { fft_stage4(buf, S, s, g, G, false); __syncthreads(); }
}
DEV void fft_inv(cf2* buf, int S, int g, int G) {
    int s = S - 1;
    if (S & 1) { fft_stage4(buf, S, s, g, G, true); __syncthreads(); --s; }
    for (; s >= 1; s -= 2) { fft_stage16(buf, S, s - 1, g, G, true); __syncthreads(); }
}
DEV void hf_item(const Params& p, int set, int pi, unsigned char* smem) {
    const int Ls = set ? LC : L, S = set ? FS_CTX : FS_LAT, N = 1 << (2 * S);
    const int gi = tidx() >> 8, g = tidx() & 255, idx = pi * 2 + gi, o = idx >> 9, c = idx & 511;
    cf2* buf = (cf2*)smem + (size_t)gi * N;
    const float* hraw = (const float*)(p.ws + WS_F + (set ? F_HRAW_CTX : F_HRAW_LAT));
    const float* hyn = (const float*)(p.ws + WS_F + (set ? F_HYP_CTX : F_HYP_LAT));
    float nsum = 0.f;
    for (int ch = 0; ch < Ls / 64; ++ch) nsum += hyn[(size_t)ch * 2048 + o * 1024 + c] + hyn[(size_t)ch * 2048 + o * 1024 + 512 + c];
    const float inv = 1.f / nsum;
    const float* hf = hraw + (size_t)(o * 1024 + c) * Ls; const float* hb = hraw + (size_t)(o * 1024 + 512 + c) * Ls;
#pragma unroll 4
    for (int k = g; k < N; k += 256) { float re = 0.f; if (k < Ls) re = hf[k] * inv; else if (k > N - Ls) re = hb[N - k] * inv; cf2 v; v.x = re; v.y = 0.f; buf[fsw(k)] = v; }
    __syncthreads();
    fft_fwd(buf, S, g, 256);
    cf2* HF = (cf2*)(p.ws + WS_F + (set ? F_HF_CTX : F_HF_LAT)) + (size_t)(o * 512 + c) * N;
    for (int k = g; k < N; k += 256) HF[k] = buf[fsw(k)];
    __syncthreads();
}
constexpr int P1_NORM = T / 8, P1_HF = 512;
DEV void phase1(const Params& p, unsigned char* smem) {
    const int total = P1_NORM + 2 * P1_HF;
    for (int it = blockIdx.x; it < total; it += gridDim.x) {
        if (it < P1_NORM) norm_rows_item(p, it, 1, p.in[I_N1G], 0, 0);
        else if (it < P1_NORM + P1_HF) hf_item(p, 0, it - P1_NORM, smem);
        else hf_item(p, 1, it - P1_NORM - P1_HF, smem);
    }
}

constexpr int G_LDA = 72;
template <class Epi>
DEV void gemm_tile(const bf16_t* __restrict__ A, const bf16_t* __restrict__ Wt, int m0, int n0, unsigned char* smem, const Epi& epi, int var = 0) {
    bf16_t* As = (bf16_t*)smem;
    bf16_t* Bs = As + 2 * 256 * G_LDA;
    const int tid = tidx(), lane = tid & 63, w = tid >> 6, wm = w >> 1, wn = w & 1;
    f32x16 acc[2][2];
#pragma unroll
    for (int i = 0; i < 2; ++i)
#pragma unroll
        for (int j = 0; j < 2; ++j)
#pragma unroll
            for (int r = 0; r < 16; ++r) acc[i][j][r] = 0.f;
    u32x4 ra[4], rb[2];
    const bf16_t* Ag = A + (size_t)m0 * 1024; const bf16_t* Bg = Wt + (size_t)n0 * 1024;
#define GLOAD(k0) do { \
        _Pragma("unroll") for (int i = 0; i < 4; ++i) { const int id = tid + NT * i, row = id >> 3, kc = id & 7; ra[i] = *(const u32x4*)(Ag + (size_t)row * 1024 + (k0) + kc * 8); } \
        _Pragma("unroll") for (int i = 0; i < 2; ++i) { const int id = tid + NT * i, row = id >> 3, kc = id & 7; rb[i] = *(const u32x4*)(Bg + (size_t)row * 1024 + (k0) + kc * 8); } } while (0)
#define LSTORE(buf_) do { \
        _Pragma("unroll") for (int i = 0; i < 4; ++i) { const int id = tid + NT * i, row = id >> 3, kc = id & 7; *(u32x4*)(As + ((buf_) * 256 + row) * G_LDA + kc * 8) = ra[i]; } \
        _Pragma("unroll") for (int i = 0; i < 2; ++i) { const int id = tid + NT * i, row = id >> 3, kc = id & 7; *(u32x4*)(Bs + ((buf_) * 128 + row) * G_LDA + kc * 8) = rb[i]; } } while (0)
    GLOAD(0); LSTORE(0); __syncthreads();
    for (int kt = 0; kt < (var == 2 ? 1 : 16); ++kt) {
        const int buf = kt & 1;
        if (kt + 1 < 16) GLOAD((kt + 1) * 64);
        const bf16_t* as = As + (buf * 256 + wm * 64 + (lane & 31)) * G_LDA + 8 * (lane >> 5);
        const bf16_t* bs = Bs + (buf * 128 + wn * 64 + (lane & 31)) * G_LDA + 8 * (lane >> 5);
#pragma unroll
        for (int kk = 0; kk < 4; ++kk) {
            const bf16x8 a0 = *(const bf16x8*)(as + kk * 16), a1 = *(const bf16x8*)(as + 32 * G_LDA + kk * 16);
            const bf16x8 b0 = *(const bf16x8*)(bs + kk * 16), b1 = *(const bf16x8*)(bs + 32 * G_LDA + kk * 16);
            acc[0][0] = __builtin_amdgcn_mfma_f32_32x32x16_bf16(a0, b0, acc[0][0], 0, 0, 0);
            acc[0][1] = __builtin_amdgcn_mfma_f32_32x32x16_bf16(a0, b1, acc[0][1], 0, 0, 0);
            acc[1][0] = __builtin_amdgcn_mfma_f32_32x32x16_bf16(a1, b0, acc[1][0], 0, 0, 0);
            acc[1][1] = __builtin_amdgcn_mfma_f32_32x32x16_bf16(a1, b1, acc[1][1], 0, 0, 0);
        }
        if (kt + 1 < 16) LSTORE(buf ^ 1);
        __syncthreads();
    }
#ifndef HOST_EMU
    if (var == 1) { asm volatile("" :: "v"(acc[0][0]), "v"(acc[0][1]), "v"(acc[1][0]), "v"(acc[1][1])); return; }
#endif
#pragma unroll
    for (int mi = 0; mi < 2; ++mi)
#pragma unroll
        for (int ni = 0; ni < 2; ++ni)
#pragma unroll
            for (int rg = 0; rg < 4; ++rg) {
                const int row = m0 + wm * 64 + mi * 32 + 8 * rg + 4 * (lane >> 5), col = n0 + wn * 64 + ni * 32 + (lane & 31);
                epi(row, col, acc[mi][ni][rg * 4 + 0], acc[mi][ni][rg * 4 + 1], acc[mi][ni][rg * 4 + 2], acc[mi][ni][rg * 4 + 3]);
            }
}
template <class Epi>
DEV void gemm_tile256(const bf16_t* __restrict__ A, const bf16_t* __restrict__ Wt, int m0, int n0, unsigned char* smem, const Epi& epi) {
    bf16_t* As = (bf16_t*)smem;
    bf16_t* Bs = As + 2 * 256 * G_LDA;
    const int tid = tidx(), lane = tid & 63, w = tid >> 6, wm = w >> 2, wn = w & 3;
    f32x16 acc[4][2];
#pragma unroll
    for (int i = 0; i < 4; ++i)
#pragma unroll
        for (int j = 0; j < 2; ++j)
#pragma unroll
            for (int r = 0; r < 16; ++r) acc[i][j][r] = 0.f;
    u32x4 ra[4], rb[4];
    const bf16_t* Ag = A + (size_t)m0 * 1024; const bf16_t* Bg = Wt + (size_t)n0 * 1024;
#define GLOAD2(k0) do { \
        _Pragma("unroll") for (int i = 0; i < 4; ++i) { const int id = tid + NT * i, row = id >> 3, kc = id & 7; ra[i] = *(const u32x4*)(Ag + (size_t)row * 1024 + (k0) + kc * 8); rb[i] = *(const u32x4*)(Bg + (size_t)row * 1024 + (k0) + kc * 8); } } while (0)
#define LSTORE2(buf_) do { \
        _Pragma("unroll") for (int i = 0; i < 4; ++i) { const int id = tid + NT * i, row = id >> 3, kc = id & 7; *(u32x4*)(As + ((buf_) * 256 + row) * G_LDA + kc * 8) = ra[i]; *(u32x4*)(Bs + ((buf_) * 256 + row) * G_LDA + kc * 8) = rb[i]; } } while (0)
    GLOAD2(0); LSTORE2(0); __syncthreads();
    for (int kt = 0; kt < 16; ++kt) {
        const int buf = kt & 1;
        if (kt + 1 < 16) GLOAD2((kt + 1) * 64);
        const bf16_t* as = As + (buf * 256 + wm * 128 + (lane & 31)) * G_LDA + 8 * (lane >> 5);
        const bf16_t* bs = Bs + (buf * 256 + wn * 64 + (lane & 31)) * G_LDA + 8 * (lane >> 5);
#pragma unroll
        for (int kk = 0; kk < 4; ++kk) {
            bf16x8 af[4], bfr[2];
#pragma unroll
            for (int i = 0; i < 4; ++i) af[i] = *(const bf16x8*)(as + i * 32 * G_LDA + kk * 16);
#pragma unroll
            for (int j = 0; j < 2; ++j) bfr[j] = *(const bf16x8*)(bs + j * 32 * G_LDA + kk * 16);
#pragma unroll
            for (int i = 0; i < 4; ++i)
#pragma unroll
                for (int j = 0; j < 2; ++j) acc[i][j] = __builtin_amdgcn_mfma_f32_32x32x16_bf16(af[i], bfr[j], acc[i][j], 0, 0, 0);
        }
        if (kt + 1 < 16) LSTORE2(buf ^ 1);
        __syncthreads();
    }
#undef GLOAD2
#undef LSTORE2
#pragma unroll
    for (int mi = 0; mi < 4; ++mi)
#pragma unroll
        for (int ni = 0; ni < 2; ++ni)
#pragma unroll
            for (int rg = 0; rg < 4; ++rg) {
                const int row = m0 + wm * 128 + mi * 32 + 8 * rg + 4 * (lane >> 5), col = n0 + wn * 64 + ni * 32 + (lane & 31);
                epi(row, col, acc[mi][ni][rg * 4 + 0], acc[mi][ni][rg * 4 + 1], acc[mi][ni][rg * 4 + 2], acc[mi][ni][rg * 4 + 3]);
            }
}
namespace pg8 {
#ifndef HOST_EMU
#define PG8_LAS __attribute__((address_space(3)))
#else
#define PG8_LAS
#endif
typedef unsigned short bf16_t;
constexpr int BM = 256, BK = 64, HALF = 128, HTB = HALF * BK * 2  , STAGE_BYTES = 8 * HTB, NXCD = 8, WGM = 8;

__host__ __device__ __forceinline__ int lds_byte(int r, int c) { const int st = (r >> 4) * 2 + (c >> 5), rr = r & 15, cc = c & 31, ob = rr * 64 + cc * 2; return st * 1024 + (ob ^ (((ob >> 9) & 1) << 5)); }
__host__ __device__ __forceinline__ void stage_rc(int b, int& R, int& C) { const int st = b / 1024, sb = b % 1024, swz = sb ^ (((sb >> 9) & 1) << 5); R = (st >> 1) * 16 + swz / 64; C = (st & 1) * 32 + (swz % 64) / 2; }
__host__ __device__ __forceinline__ int perm32(int rho) { const int n = rho >> 4, i = rho & 15; return 8 * (i >> 2) + 4 * n + (i & 3); }

struct Unit { int pm, pn; };
struct Gemm { const bf16_t* A; const bf16_t* Bt; int M, N, K; };

struct StaticOrder {
    int nM, nN, nwg, G, c;
    __host__ __device__ void init(int M, int N, int G_, int c_) { nM = M / BM; nN = N / BM; nwg = nM * nN; G = G_; c = c_; }
    __host__ __device__ bool next(int i, Unit& u) const {
        const long L = (long)i * G + c; if (L >= nwg) return false;
        int wgid = (int)L; { const int q = nwg / NXCD, r = nwg % NXCD, xcd = wgid % NXCD, off = wgid / NXCD; wgid = (xcd < r ? xcd * (q + 1) : r * (q + 1) + (xcd - r) * q) + off; }
        const int nig = WGM * nN, gid = wgid / nig, fm = gid * WGM, gsz = (nM - fm) < WGM ? (nM - fm) : WGM;
        u.pm = fm + ((wgid % nig) % gsz); u.pn = (wgid % nig) / gsz; return true;
    }
    __device__ __forceinline__ void a_ready(const Unit&) const {}
    __device__ __forceinline__ void done(const Unit&) const {}
};
template <class Epi, class Sched, bool STAMP = false>
__device__ __forceinline__ void gemm_phase(PG8_LAS unsigned char* lds, const Gemm g, const Sched& S, const Epi& E, unsigned long long* stamps = nullptr) {
    const int tid = tidx(), wid = __builtin_amdgcn_readfirstlane(tid >> 6), lane = tid & 63, wr = wid >> 2, wc = wid & 3, fr = lane & 15, fq = lane >> 4;
    const int K = g.K, nt = K / BK;
    int ts_lo = 0, ts_hi = 0, nts = 0; const unsigned long long rt_entry = 0ull; (void)rt_entry; (void)ts_lo; (void)ts_hi; (void)nts;
#define PG8_STAMP() do { if (STAMP && wid == 0 && nts < 64) { const unsigned long long _c = 0ull; \
        ts_lo = (lane == nts) ? (int)(unsigned)_c : ts_lo; ts_hi = (lane == nts) ? (int)(unsigned)(_c >> 32) : ts_hi; ++nts; } } while (0)
    PG8_STAMP();
    unsigned voffA[2], voffB[2];
#pragma unroll
    for (int i = 0; i < 2; ++i) { int R, C; stage_rc(tid * 16 + i * 8192, R, C); const int Rb = Epi::PERM ? ((R & ~31) + perm32(R & 31)) : R;
        voffA[i] = (unsigned)(R * K + C) * 2u; voffB[i] = (unsigned)(Rb * K + C) * 2u; }
    const size_t kstep = (size_t)(BK * 2);
    const size_t hstep = (size_t)HALF * K * 2;
    const size_t tstep = 2 * hstep;
    const unsigned ldsw = (unsigned)wid * 1024u;
    const int aoff = lds_byte(wr * 64 + fr, fq * 8), boff = lds_byte(wc * 32 + fr, fq * 8);
#define PG8_SA(b, h) (((b) * 2 + (h)) * HTB)
#define PG8_SB(b, h) ((4 + (b) * 2 + (h)) * HTB)
#define PG8_STAGE(bufoff, gbase, voff) do { _Pragma("unroll") for (int _i = 0; _i < 2; ++_i) \
        __builtin_amdgcn_global_load_lds((const unsigned*)((const char*)(gbase) + (voff)[_i]), (PG8_LAS unsigned*)(lds + (bufoff) + ldsw + _i * 8192), 16, 0, 0); } while (0)
#define PG8_LDA(dst, b, h) do { _Pragma("unroll") for (int m = 0; m < 4; ++m) _Pragma("unroll") for (int k = 0; k < 2; ++k) dst[m][k] = *(const PG8_LAS bf16x8*)(lds + PG8_SA(b, h) + aoff + m * 2048 + k * 1024); } while (0)
#define PG8_LDB(dst, b, h) do { _Pragma("unroll") for (int n = 0; n < 2; ++n) _Pragma("unroll") for (int k = 0; k < 2; ++k) dst[n][k] = *(const PG8_LAS bf16x8*)(lds + PG8_SB(b, h) + boff + n * 2048 + k * 1024); } while (0)
#define PG8_MMA(ai, bj, At, Bt) do { __builtin_amdgcn_s_setprio(1); _Pragma("unroll") for (int m = 0; m < 4; ++m) _Pragma("unroll") for (int n = 0; n < 2; ++n) _Pragma("unroll") for (int k = 0; k < 2; ++k) \
        acc[ai][bj][m][n] = __builtin_amdgcn_mfma_f32_16x16x32_bf16(Bt[n][k], At[m][k], acc[ai][bj][m][n], 0, 0, 0); __builtin_amdgcn_s_setprio(0); } while (0)
#ifndef HOST_EMU
#define PG8_WAIT_V(n) asm volatile("s_waitcnt vmcnt(" #n ")" ::: "memory")
#define PG8_WAIT_L(n) asm volatile("s_waitcnt lgkmcnt(" #n ")" ::: "memory")
#else
#define PG8_WAIT_V(n) do {} while (0)
#define PG8_WAIT_L(n) do {} while (0)
#endif
#define PG8_BAR __builtin_amdgcn_s_barrier()
#define PG8_SCHED __builtin_amdgcn_sched_barrier(0)
    Unit cur, nxt; int ui = 0;
    if (!S.next(0, cur)) return;
    f32x4 acc[2][2][4][2];
#pragma unroll
    for (int a = 0; a < 2; ++a)
#pragma unroll
        for (int b = 0; b < 2; ++b)
#pragma unroll
            for (int m = 0; m < 4; ++m)
#pragma unroll
                for (int n = 0; n < 2; ++n) acc[a][b][m][n] = (f32x4){0.f, 0.f, 0.f, 0.f};
    bf16x8 At[4][2], B0[2][2], B1[2][2];
    const char* cA = (const char*)g.A + (size_t)cur.pm * tstep; const char* cB = (const char*)g.Bt + (size_t)cur.pn * tstep;
    S.a_ready(cur);
    PG8_STAGE(PG8_SB(0, 0), cB, voffB); PG8_STAGE(PG8_SA(0, 0), cA, voffA); PG8_STAGE(PG8_SB(0, 1), cB + hstep, voffB); PG8_STAGE(PG8_SA(0, 1), cA + hstep, voffA);
    if (wr == 1) PG8_BAR;
    PG8_WAIT_V(4); PG8_BAR;
    PG8_STAGE(PG8_SB(1, 0), cB + kstep, voffB); PG8_STAGE(PG8_SA(1, 0), cA + kstep, voffA); PG8_STAGE(PG8_SB(1, 1), cB + hstep + kstep, voffB);
    PG8_WAIT_V(6); PG8_BAR;
    PG8_STAMP();
    for (;;) {
        const bool has_next = S.next(ui + 1, nxt);
        const char* nA = has_next ? (const char*)g.A + (size_t)nxt.pm * tstep : cA; const char* nB = has_next ? (const char*)g.Bt + (size_t)nxt.pn * tstep : cB;
        for (int t = 0; t < nt; t += 2) {
            const bool last = (t == nt - 2);
            const char* a1 = cA + (size_t)(t + 1) * kstep;
            const char* a2 = last ? nA : cA + (size_t)(t + 2) * kstep; const char* b2 = last ? nB : cB + (size_t)(t + 2) * kstep;
            const char* a3 = a2 + kstep; const char* b3 = b2 + kstep;
            if (last && has_next) S.a_ready(nxt);
            PG8_LDB(B0, 0, 0); PG8_SCHED; PG8_LDA(At, 0, 0); PG8_STAGE(PG8_SA(1, 1), a1 + hstep, voffA);
            PG8_WAIT_L(8); PG8_BAR; PG8_WAIT_L(0); PG8_MMA(0, 0, At, B0); PG8_BAR; PG8_SCHED;
            PG8_LDB(B1, 0, 1); PG8_STAGE(PG8_SB(0, 0), b2, voffB);
            PG8_BAR; PG8_WAIT_L(0); PG8_MMA(0, 1, At, B1); PG8_BAR;
            PG8_LDA(At, 0, 1); PG8_STAGE(PG8_SA(0, 0), a2, voffA);
            PG8_BAR; PG8_WAIT_L(0); PG8_MMA(1, 0, At, B0); PG8_BAR; PG8_SCHED;
            PG8_STAGE(PG8_SB(0, 1), b2 + hstep, voffB);
            PG8_WAIT_V(6); PG8_BAR; PG8_MMA(1, 1, At, B1); PG8_BAR;
            PG8_LDB(B0, 1, 0); PG8_SCHED; PG8_LDA(At, 1, 0); PG8_STAGE(PG8_SA(0, 1), a2 + hstep, voffA);
            PG8_WAIT_L(8); PG8_BAR; PG8_WAIT_L(0); PG8_MMA(0, 0, At, B0); PG8_BAR; PG8_SCHED;
            PG8_LDB(B1, 1, 1); PG8_STAGE(PG8_SB(1, 0), b3, voffB);
            PG8_BAR; PG8_WAIT_L(0); PG8_MMA(0, 1, At, B1); PG8_BAR;
            PG8_LDA(At, 1, 1); PG8_STAGE(PG8_SA(1, 0), a3, voffA);
            PG8_BAR; PG8_WAIT_L(0); PG8_MMA(1, 0, At, B0); PG8_BAR; PG8_SCHED;
            PG8_STAGE(PG8_SB(1, 1), b3 + hstep, voffB);
            PG8_WAIT_V(6); PG8_BAR; PG8_MMA(1, 1, At, B1); PG8_BAR;
        }
        PG8_STAMP();
        if constexpr (!Epi::AFTER_DRAIN) { E(acc, cur, wr, wc, fr, fq); S.done(cur); }
        PG8_STAMP();
        if (!has_next) break;
#pragma unroll
        for (int a = 0; a < 2; ++a)
#pragma unroll
            for (int b = 0; b < 2; ++b)
#pragma unroll
                for (int m = 0; m < 4; ++m)
#pragma unroll
                    for (int n = 0; n < 2; ++n) acc[a][b][m][n] = (f32x4){0.f, 0.f, 0.f, 0.f};
        cur = nxt; cA = nA; cB = nB; ++ui;
    }
    PG8_WAIT_V(0);
    if (wr == 0) PG8_BAR;
    PG8_BAR;
    if constexpr (Epi::AFTER_DRAIN) { E.fused(acc, cur, wr, wc, fr, fq, lds, wid, lane); S.done(cur); }
    PG8_STAMP();
    if (STAMP && wid == 0) { stamps[lane] = lane < nts ? (((unsigned long long)(unsigned)ts_hi << 32) | (unsigned)ts_lo) : 0ull;
        if (lane == 62) stamps[62] = rt_entry; if (lane == 63) stamps[63] = 0ull; }
#undef PG8_STAMP
#undef PG8_SA
#undef PG8_SB
#undef PG8_STAGE
#undef PG8_LDA
#undef PG8_LDB
#undef PG8_MMA
#undef PG8_WAIT_V
#undef PG8_WAIT_L
#undef PG8_BAR
#undef PG8_SCHED
}
}
template <class Epi> struct PgEpiT {
    static constexpr bool PERM = true, AFTER_DRAIN = false;
    Epi e;
    DEV void operator()(const f32x4 (&acc)[2][2][4][2], const pg8::Unit& u, int wr, int wc, int fr, int fq) const {
#pragma unroll
        for (int ai = 0; ai < 2; ++ai)
#pragma unroll
            for (int m = 0; m < 4; ++m) {
#pragma unroll
                for (int bj = 0; bj < 2; ++bj) {
                    const int wcol = u.pm * 256 + ai * 128 + wr * 64 + m * 16 + fr, tok0 = u.pn * 256 + bj * 128 + wc * 32 + 8 * fq;
                    const float v[8] = {acc[ai][bj][m][0][0], acc[ai][bj][m][0][1], acc[ai][bj][m][0][2], acc[ai][bj][m][0][3], acc[ai][bj][m][1][0], acc[ai][bj][m][1][1], acc[ai][bj][m][1][2], acc[ai][bj][m][1][3]};
                    e.tok8(tok0, wcol, v);
                }
                if (m & 1) SCHED_FENCE();
            }
    }
};
template <class Epi> struct PgEpiN {
    static constexpr bool PERM = true, AFTER_DRAIN = false;
    Epi e;
    DEV void operator()(const f32x4 (&acc)[2][2][4][2], const pg8::Unit& u, int wr, int wc, int fr, int fq) const {
#pragma unroll
        for (int ai = 0; ai < 2; ++ai)
#pragma unroll
            for (int m = 0; m < 4; ++m) {
#pragma unroll
                for (int bj = 0; bj < 2; ++bj) {
                    const int tok = u.pm * 256 + ai * 128 + wr * 64 + m * 16 + fr, wcol0 = u.pn * 256 + bj * 128 + wc * 32 + 8 * fq;
                    const float v[8] = {acc[ai][bj][m][0][0], acc[ai][bj][m][0][1], acc[ai][bj][m][0][2], acc[ai][bj][m][0][3], acc[ai][bj][m][1][0], acc[ai][bj][m][1][1], acc[ai][bj][m][1][2], acc[ai][bj][m][1][3]};
                    e.col8(tok, wcol0, v);
                }
                if (m & 1) SCHED_FENCE();
            }
    }
};
template <class Epi>
DEV void gemm_pg8_T(const bf16_t* A, const bf16_t* Wt, int Mtok, int N, unsigned char* smem, const Epi& epi) {
    pg8::Gemm g{Wt, A, N, Mtok, 1024};
    pg8::StaticOrder S; S.init(N, Mtok, (int)gridDim.x, (int)blockIdx.x);
    PgEpiT<Epi> E{epi};
    pg8::gemm_phase<PgEpiT<Epi>, pg8::StaticOrder, false>((PG8_LAS unsigned char*)smem, g, S, E);
    __syncthreads();
}
template <class Epi>
DEV void gemm_pg8_N(const bf16_t* A, const bf16_t* Wt, int Mtok, int N, unsigned char* smem, const Epi& epi) {
    pg8::Gemm g{A, Wt, Mtok, N, 1024};
    pg8::StaticOrder S; S.init(Mtok, N, (int)gridDim.x, (int)blockIdx.x);
    PgEpiN<Epi> E{epi};
    pg8::gemm_phase<PgEpiN<Epi>, pg8::StaticOrder, false>((PG8_LAS unsigned char*)smem, g, S, E);
    __syncthreads();
}
struct EpiL0In {
    unsigned char* ws;
    DEV void operator()(int row, int col, float v0, float v1, float v2, float v3) const {
        u32x2 o; o[0] = pk2(v0, v1); o[1] = pk2(v2, v3);
        const bool lat = row < TL; const int b = lat ? row / L : (row - TL) / LC, t = lat ? row - b * L : (row - TL) - b * LC, Lx = lat ? L : LC;
        const int cu = __builtin_amdgcn_readfirstlane(col & ~127);
        if (cu < 1536) { bf16_t* d = (bf16_t*)(ws + WS_P + (lat ? P_HYT_LAT : P_HYT_CTX)) + ((size_t)b * 1536 + col) * Lx + t; *(u32x2*)d = o; }
        else if (cu < 2048) { bf16_t* d = (bf16_t*)(ws + WS_P + P_Q0) + (size_t)row * 512 + (col - 1536); d[0] = (bf16_t)f2bf(v0); d[512] = (bf16_t)f2bf(v1); d[1024] = (bf16_t)f2bf(v2); d[1536] = (bf16_t)f2bf(v3); }
        else if (cu < 2176) { bf16_t* d = (bf16_t*)(ws + WS_P + P_K0) + (size_t)row * 128 + (col - 2048); d[0] = (bf16_t)f2bf(v0); d[128] = (bf16_t)f2bf(v1); d[256] = (bf16_t)f2bf(v2); d[384] = (bf16_t)f2bf(v3); }
        else { bf16_t* d = (bf16_t*)(ws + WS_P + (lat ? P_VT_LAT : P_VT_CTX)) + ((size_t)b * 128 + (col - 2176)) * Lx + t; *(u32x2*)d = o; }
    }
};
struct EpiL0InT {
    unsigned char* ws;
    DEV void tok8(int row, int col, const float (&v)[8]) const {
        const bool lat = row < TL; const int b = lat ? row / L : (row - TL) / LC, t = lat ? row - b * L : (row - TL) - b * LC, Lx = lat ? L : LC;
        u32x4 o; o[0] = pk2(v[0], v[1]); o[1] = pk2(v[2], v[3]); o[2] = pk2(v[4], v[5]); o[3] = pk2(v[6], v[7]);
        if (col < 1536) { *(u32x4*)((bf16_t*)(ws + WS_P + (lat ? P_HYT_LAT : P_HYT_CTX)) + ((size_t)b * 1536 + col) * Lx + t) = o; }
        else if (col < 2048) { bf16_t* d = (bf16_t*)(ws + WS_P + P_Q0) + (size_t)row * 512 + (col - 1536);
#pragma unroll
            for (int i = 0; i < 8; ++i) d[i * 512] = (bf16_t)f2bf(v[i]); }
        else if (col < 2176) { bf16_t* d = (bf16_t*)(ws + WS_P + P_K0) + (size_t)row * 128 + (col - 2048);
#pragma unroll
            for (int i = 0; i < 8; ++i) d[i * 128] = (bf16_t)f2bf(v[i]); }
        else { *(u32x4*)((bf16_t*)(ws + WS_P + (lat ? P_VT_LAT : P_VT_CTX)) + ((size_t)b * 128 + (col - 2176)) * Lx + t) = o; }
    }
};
struct EpiBf16 {
    bf16_t* out; int ld;
    DEV void col8(int row, int col0, const float (&v)[8]) const { u32x4 o; o[0] = pk2(v[0], v[1]); o[1] = pk2(v[2], v[3]); o[2] = pk2(v[4], v[5]); o[3] = pk2(v[6], v[7]); *(u32x4*)(out + (size_t)row * ld + col0) = o; }
    DEV void operator()(int row, int col, float v0, float v1, float v2, float v3) const {
        bf16_t* d = out + (size_t)row * ld + col; d[0] = (bf16_t)f2bf(v0); d[ld] = (bf16_t)f2bf(v1); d[2 * ld] = (bf16_t)f2bf(v2); d[3 * ld] = (bf16_t)f2bf(v3);
    }
};
struct EpiHg {
    unsigned char* ws; const float* lg;
    DEV void operator()(int row, int col, float v0, float v1, float v2, float v3) const {
        float vv[4] = {v0, v1, v2, v3};
        const bool lat = row < TL; const int b = lat ? row / L : (row - TL) / LC, t = lat ? row - b * L : (row - TL) - b * LC, Lx = lat ? L : LC;
        const int cu = __builtin_amdgcn_readfirstlane(col & ~255);
        if (cu >= 3072 && cu < 4096) {
            bf16_t* d = (bf16_t*)(ws + WS_M) + (lat ? (size_t)0 : (size_t)NB * 1024 * L) + ((size_t)b * 1024 + (col - 3072)) * Lx + t;
            u32x2 o; o[0] = pk2(v0, v1); o[1] = pk2(v2, v3); *(u32x2*)d = o;
            return;
        }
        if (cu < 1024 || cu >= 4096) {
#pragma unroll
            for (int i = 0; i < 4; ++i) vv[i] = silu_f(vv[i]);
        } else {
            const int c = col - 1024;
            const float oml = 1.f - 1.f / (1.f + __expf(lg[c] - lg[2048 + c]));
#pragma unroll
            for (int i = 0; i < 4; ++i) vv[i] = oml / (1.f + __expf(vv[i]));
        }
        if (cu < 3072) {
            bf16_t* d = (bf16_t*)(ws + WS_P + (lat ? P1_KQT_LAT : P1_KQT_CTX)) + ((size_t)b * 3072 + col) * Lx + t;
            u32x2 o; o[0] = pk2(vv[0], vv[1]); o[1] = pk2(vv[2], vv[3]); *(u32x2*)d = o;
        } else {
            if (!lat) return;
            bf16_t* d = (bf16_t*)(ws + WS_P + P1_G) + (size_t)row * 1024 + (col - 4096); d[0] = (bf16_t)f2bf(vv[0]); d[1024] = (bf16_t)f2bf(vv[1]); d[2048] = (bf16_t)f2bf(vv[2]); d[3072] = (bf16_t)f2bf(vv[3]);
        }
    }
};
struct EpiHgT {
    unsigned char* ws; const float* lg;
    DEV void tok8(int row, int col, const float (&v)[8]) const {
        const bool lat = row < TL; const int b = lat ? row / L : (row - TL) / LC, t = lat ? row - b * L : (row - TL) - b * LC, Lx = lat ? L : LC;
        const int cu = __builtin_amdgcn_readfirstlane(col & ~255);
        float vv[8];
#pragma unroll
        for (int i = 0; i < 8; ++i) vv[i] = v[i];
        if (cu >= 3072 && cu < 4096) {
            u32x4 o; o[0] = pk2(vv[0], vv[1]); o[1] = pk2(vv[2], vv[3]); o[2] = pk2(vv[4], vv[5]); o[3] = pk2(vv[6], vv[7]);
            *(u32x4*)((bf16_t*)(ws + WS_M) + (lat ? (size_t)0 : (size_t)NB * 1024 * L) + ((size_t)b * 1024 + (col - 3072)) * Lx + t) = o;
            return;
        }
        if (cu < 1024 || cu >= 4096) {
#pragma unroll
            for (int i = 0; i < 8; ++i) vv[i] = silu_f(vv[i]);
        } else {
            const int c = col - 1024;
            const float oml = 1.f - 1.f / (1.f + __expf(lg[c] - lg[2048 + c]));
#pragma unroll
            for (int i = 0; i < 8; ++i) vv[i] = oml / (1.f + __expf(vv[i]));
        }
        if (cu < 3072) {
            u32x4 o; o[0] = pk2(vv[0], vv[1]); o[1] = pk2(vv[2], vv[3]); o[2] = pk2(vv[4], vv[5]); o[3] = pk2(vv[6], vv[7]);
            *(u32x4*)((bf16_t*)(ws + WS_P + (lat ? P1_KQT_LAT : P1_KQT_CTX)) + ((size_t)b * 3072 + col) * Lx + t) = o;
        } else {
            if (!lat) return;
            bf16_t* d = (bf16_t*)(ws + WS_P + P1_G) + (size_t)row * 1024 + (col - 4096);
#pragma unroll
            for (int i = 0; i < 8; ++i) d[i * 1024] = (bf16_t)f2bf(vv[i]);
        }
    }
};
struct EpiRes {
    const Params* p; int from_inputs, layer, goff;
    DEV void col8(int row, int col0, const float (&v)[8]) const {
        float* H = (float*)(p->ws + WS_H) + (size_t)row * 1024 + col0; const float* hin = h_row(*p, from_inputs, row) + col0;
        const float* gt = (const float*)(p->ws + WS_MOD) + ((size_t)layer * NR + mod_row(row)) * 6144 + goff + col0;
        const f32x4 h0 = *(const f32x4*)hin, h1 = *(const f32x4*)(hin + 4), g0 = *(const f32x4*)gt, g1 = *(const f32x4*)(gt + 4);
        f32x4 o0, o1;
#pragma unroll
        for (int i = 0; i < 4; ++i) { o0[i] = h0[i] + g0[i] * v[i]; o1[i] = h1[i] + g1[i] * v[4 + i]; }
        *(f32x4*)H = o0; *(f32x4*)(H + 4) = o1;
    }
    DEV void operator()(int row, int col, float v0, float v1, float v2, float v3) const {
        float* H = (float*)(p->ws + WS_H) + (size_t)row * 1024 + col;
        const float* hin = h_row(*p, from_inputs, row) + col;
        const float gt = ((const float*)(p->ws + WS_MOD))[((size_t)layer * NR + mod_row(row)) * 6144 + goff + col];
        const float h0 = hin[0], h1 = hin[1024], h2 = hin[2048], h3 = hin[3072];
        H[0] = h0 + gt * v0; H[1024] = h1 + gt * v1; H[2048] = h2 + gt * v2; H[3072] = h3 + gt * v3;
    }
};

DEV float hy_u(const bf16_t* row, int t, int Lx, float w0, float w1, float w2, float b) {
    const float xm = t > 0 ? bf2f(row[t - 1]) : 0.f, x0 = bf2f(row[t]), xp = t + 1 < Lx ? bf2f(row[t + 1]) : 0.f;
    return w0 * xm + w1 * x0 + w2 * xp + b;
}
DEV void hyena_item(const Params& p, int set, int item, unsigned char* smem) {
    const int Ls = set ? LC : L, S = set ? FS_CTX : FS_LAT, N = 1 << (2 * S);
    const int gi = tidx() >> 8, g = tidx() & 255;
    const int bp = item >> 8, c = (item & 255) * 2 + gi, ba = bp * 2, bb = ba + 1;
    cf2* buf = (cf2*)smem + (size_t)gi * N;
    cf2* zk = (cf2*)smem + (size_t)2 * N + (size_t)gi * Ls;
    const bf16_t* hy = (const bf16_t*)(p.ws + WS_P + (set ? P_HYT_CTX : P_HYT_LAT));
    const float* cw = p.in[I_HYCW]; const float* cb = p.in[I_HYCB];
    const cf2* HF = (const cf2*)(p.ws + WS_F + (set ? F_HF_CTX : F_HF_LAT));
    const float invN = 1.f / (float)N;
    {
        const float w0 = cw[c], w1 = cw[1536 + c], w2 = cw[3072 + c], b = cb[c];
        const bf16_t* ra = hy + ((size_t)ba * 1536 + c) * Ls; const bf16_t* rb = hy + ((size_t)bb * 1536 + c) * Ls;
#pragma unroll 4
        for (int t = g; t < N; t += 256) { cf2 v; v.x = 0.f; v.y = 0.f; if (t < Ls) { v.x = hy_u(ra, t, Ls, w0, w1, w2, b); v.y = hy_u(rb, t, Ls, w0, w1, w2, b); zk[t] = v; } buf[fsw(t)] = v; }
    }
    __syncthreads();
    for (int n = 0; n < 2; ++n) {
        fft_fwd(buf, S, g, 256);
        const cf2* hf = HF + (size_t)(n * 512 + c) * N;
        for (int k0 = g; k0 < N; k0 += 1024) {
            cf2 hv[4];
#pragma unroll
            for (int u = 0; u < 4; ++u) { hv[u].x = 0.f; hv[u].y = 0.f; if (k0 + 256 * u < N) hv[u] = hf[k0 + 256 * u]; }
#pragma unroll
            for (int u = 0; u < 4; ++u) { const int k = k0 + 256 * u; if (k < N) buf[fsw(k)] = cmul(buf[fsw(k)], hv[u]); }
        }
        __syncthreads();
        fft_inv(buf, S, g, 256);
        const int gc = (n + 1) * 512 + c;
        const float w0 = cw[gc], w1 = cw[1536 + gc], w2 = cw[3072 + gc], b = cb[gc], dsk = p.in[I_HYSKIP][n * 512 + c];
        const bf16_t* ra = hy + ((size_t)ba * 1536 + gc) * Ls; const bf16_t* rb = hy + ((size_t)bb * 1536 + gc) * Ls;
        bf16_t* M = (bf16_t*)(p.ws + WS_M);
#pragma unroll 4
        for (int t = g; t < N; t += 256) {
            cf2 v; v.x = 0.f; v.y = 0.f;
            if (t < Ls) {
                const cf2 cv = buf[fsw(t)], zo = zk[t];
                v.x = hy_u(ra, t, Ls, w0, w1, w2, b) * (cv.x * invN + dsk * zo.x); v.y = hy_u(rb, t, Ls, w0, w1, w2, b) * (cv.y * invN + dsk * zo.y);
                if (n == 0) zk[t] = v;
                else { const size_t ta = set ? (size_t)TL + (size_t)ba * LC + t : (size_t)ba * L + t, tb = set ? (size_t)TL + (size_t)bb * LC + t : (size_t)bb * L + t;
                       M[ta * 1024 + c] = (bf16_t)f2bf(v.x); M[tb * 1024 + c] = (bf16_t)f2bf(v.y); }
            }
            if (n == 0) buf[fsw(t)] = v;
        }
        __syncthreads();
    }
}
DEV void rope_store(const bf16_t* src, bf16_t* dst, int pos, bool rope, float scale, int ph, int sub) {
    const u32x4 ua = *(const u32x4*)(src + ph * 32 + sub * 8), ub = *(const u32x4*)(src + ph * 32 + 16 + sub * 8);
    float a[8], b[8];
#pragma unroll
    for (int i = 0; i < 4; ++i) { a[2 * i] = bflo(ua[i]); a[2 * i + 1] = bfhi(ua[i]); b[2 * i] = bflo(ub[i]); b[2 * i + 1] = bfhi(ub[i]); }
    if (rope) {
        const float pv = (float)(ph == 0 ? pos / 64 : pos % 64);
#pragma unroll
        for (int e = 0; e < 8; ++e) {
            const float inv = exp2f(-(float)(sub * 8 + e) * (13.287712379549449f / 16.f));
            const float ang = pv * inv, cs = __cosf(ang), sn = __sinf(ang);
            const float na = a[e] * cs - b[e] * sn, nb = b[e] * cs + a[e] * sn; a[e] = na; b[e] = nb;
        }
    }
    u32x4 oa, ob;
#pragma unroll
    for (int i = 0; i < 4; ++i) { oa[i] = pk2(a[2 * i] * scale, a[2 * i + 1] * scale); ob[i] = pk2(b[2 * i] * scale, b[2 * i + 1] * scale); }
    *(u32x4*)(dst + ph * 32 + sub * 8) = oa; *(u32x4*)(dst + ph * 32 + 16 + sub * 8) = ob;
}
constexpr int A_LDQ = 72, A_LDV = 136;
DEV void attn_item(const Params& p, int set, int item, unsigned char* smem) {
    bf16_t* Qs = (bf16_t*)smem;
    bf16_t* Ks = Qs + 128 * A_LDQ;
    bf16_t* Vt = Ks + 128 * A_LDQ;
    const int tid = tidx(), lane = tid & 63, w = tid >> 6, l15 = lane & 15, lg = lane >> 4;
    const int nqb = set ? LC / 128 : L / 128;
    const int h = item & 7, qb = (item >> 3) % nqb, b = (item >> 3) / nqb, kvh = h >> 2;
    const bf16_t* Q0 = (const bf16_t*)(p.ws + WS_P + P_Q0); const bf16_t* K0 = (const bf16_t*)(p.ws + WS_P + P_K0);
    const int qtok0 = set ? TL + b * LC + qb * 128 : b * L + qb * 128;
    { const int row = tid >> 2, ph = (tid >> 1) & 1, sub = tid & 1;
      rope_store(Q0 + (size_t)(qtok0 + row) * 512 + h * 64, Qs + row * A_LDQ, qb * 128 + row, set == 0, 0.125f, ph, sub); }
    __syncthreads();
    bf16x8 qf[2];
    qf[0] = *(const bf16x8*)(Qs + (w * 16 + l15) * A_LDQ + 8 * lg); qf[1] = *(const bf16x8*)(Qs + (w * 16 + l15) * A_LDQ + 32 + 8 * lg);
    float m_run = p.in[I_SINK][h], l_run = 1.f;
    f32x4 O[4];
#pragma unroll
    for (int i = 0; i < 4; ++i) O[i] = (f32x4){0.f, 0.f, 0.f, 0.f};
    const int nwin = set ? 0 : 3, nctx = LC / 128;
    for (int kbi = 0; kbi < nwin + nctx; ++kbi) {
        const bool win = kbi < nwin; const int kb = win ? qb - 1 + kbi : kbi - nwin;
        if (win && (kb < 0 || kb >= L / 128)) continue;
        const int ktok0 = win ? b * L + kb * 128 : TL + b * LC + kb * 128;
        __syncthreads();
        { const int row = tid >> 2, ph = (tid >> 1) & 1, sub = tid & 1;
          rope_store(K0 + (size_t)(ktok0 + row) * 128 + kvh * 64, Ks + row * A_LDQ, kb * 128 + row, win, 1.f, ph, sub); }
        { const bf16_t* vt = (const bf16_t*)(p.ws + WS_P + (win ? P_VT_LAT : P_VT_CTX)); const int Lx = win ? L : LC;
#pragma unroll
          for (int i = 0; i < 2; ++i) { const int id = tid + NT * i, d = id >> 4, kc = id & 15;
              *(u32x4*)(Vt + d * A_LDV + kc * 8) = *(const u32x4*)(vt + ((size_t)b * 128 + kvh * 64 + d) * Lx + kb * 128 + kc * 8); } }
        __syncthreads();
#pragma unroll
        for (int ch = 0; ch < 2; ++ch) {
            f32x4 st[4];
#pragma unroll
            for (int u = 0; u < 4; ++u) {
                const bf16_t* kr = Ks + ((ch * 4 + u) * 16 + l15) * A_LDQ + 8 * lg;
                f32x4 z = (f32x4){0.f, 0.f, 0.f, 0.f};
                z = __builtin_amdgcn_mfma_f32_16x16x32_bf16(*(const bf16x8*)kr, qf[0], z, 0, 0, 0);
                z = __builtin_amdgcn_mfma_f32_16x16x32_bf16(*(const bf16x8*)(kr + 32), qf[1], z, 0, 0, 0);
                st[u] = z;
            }
            float cmax = -INFINITY;
            if (win) {
                const int qpos = qb * 128 + w * 16 + l15;
#pragma unroll
                for (int u = 0; u < 4; ++u)
#pragma unroll
                    for (int r = 0; r < 4; ++r) { const int kpos = kb * 128 + (ch * 4 + u) * 16 + 4 * lg + r; const int dd = qpos - kpos; if (dd > 128 || dd < -128) st[u][r] = -INFINITY; }
            }
#pragma unroll
            for (int u = 0; u < 4; ++u)
#pragma unroll
                for (int r = 0; r < 4; ++r) cmax = fmaxf(cmax, st[u][r]);
            cmax = fmaxf(cmax, __shfl_xor(cmax, 16)); cmax = fmaxf(cmax, __shfl_xor(cmax, 32));
            const float m_new = fmaxf(m_run, cmax), alpha = __expf(m_run - m_new);
            float ls = 0.f;
#pragma unroll
            for (int u = 0; u < 4; ++u)
#pragma unroll
                for (int r = 0; r < 4; ++r) { const float e = __expf(st[u][r] - m_new); st[u][r] = e; ls += e; }
            ls += __shfl_xor(ls, 16); ls += __shfl_xor(ls, 32);
            l_run = l_run * alpha + ls; m_run = m_new;
#pragma unroll
            for (int i = 0; i < 4; ++i) { O[i][0] *= alpha; O[i][1] *= alpha; O[i][2] *= alpha; O[i][3] *= alpha; }
#pragma unroll
            for (int ss = 0; ss < 2; ++ss) {
                u32x4 pu; pu[0] = pk2(st[2 * ss][0], st[2 * ss][1]); pu[1] = pk2(st[2 * ss][2], st[2 * ss][3]); pu[2] = pk2(st[2 * ss + 1][0], st[2 * ss + 1][1]); pu[3] = pk2(st[2 * ss + 1][2], st[2 * ss + 1][3]);
                const bf16x8 pf = __builtin_bit_cast(bf16x8, pu);
                const int key0 = (ch * 4 + 2 * ss) * 16 + 4 * lg;
#pragma unroll
                for (int dt = 0; dt < 4; ++dt) {
                    const bf16_t* vr = Vt + (dt * 16 + l15) * A_LDV + key0;
                    u32x4 vu; const u32x2 v0 = *(const u32x2*)vr, v1 = *(const u32x2*)(vr + 16); vu[0] = v0[0]; vu[1] = v0[1]; vu[2] = v1[0]; vu[3] = v1[1];
                    O[dt] = __builtin_amdgcn_mfma_f32_16x16x32_bf16(__builtin_bit_cast(bf16x8, vu), pf, O[dt], 0, 0, 0);
                }
            }
        }
    }
    const float il = 1.f / l_run;
    bf16_t* M = (bf16_t*)(p.ws + WS_M) + (size_t)(qtok0 + w * 16 + l15) * 1024 + 512 + h * 64;
#pragma unroll
    for (int dt = 0; dt < 4; ++dt) { u32x2 o; o[0] = pk2(O[dt][0] * il, O[dt][1] * il); o[1] = pk2(O[dt][2] * il, O[dt][3] * il); *(u32x2*)(M + dt * 16 + 4 * lg) = o; }
    __syncthreads();
}
constexpr int P3_HY_LAT = (NB / 2) * 256, P3_HY_CTX = (NB / 2) * 256, P3_AT_LAT = NB * (L / 128) * 8, P3_AT_CTX = NB * (LC / 128) * 8;
DEV void phase3(const Params& p, unsigned char* smem, int var = 0) {
    const int total = P3_HY_LAT + P3_AT_LAT + P3_HY_CTX + P3_AT_CTX;
    for (int it = blockIdx.x; it < total; it += gridDim.x) {
        int i = it;
        if (var == 1 && !(i < P3_HY_LAT || (i >= P3_HY_LAT + P3_AT_LAT && i < P3_HY_LAT + P3_AT_LAT + P3_HY_CTX))) continue;
        if (var == 2 && (i < P3_HY_LAT || (i >= P3_HY_LAT + P3_AT_LAT && i < P3_HY_LAT + P3_AT_LAT + P3_HY_CTX))) continue;
        if (i < P3_HY_LAT) { hyena_item(p, 0, i, smem); continue; } i -= P3_HY_LAT;
        if (i < P3_AT_LAT) { attn_item(p, 0, i, smem); continue; } i -= P3_AT_LAT;
        if (i < P3_HY_CTX) { hyena_item(p, 1, i, smem); continue; } i -= P3_HY_CTX;
        attn_item(p, 1, i, smem);
    }
}

constexpr int K_LDK = 136, K_LDS = 129, K_LDC = 52;
DEV unsigned fkey(float f) { const unsigned u = __builtin_bit_cast(unsigned, f); return (u & 0x80000000u) ? ~u : (u | 0x80000000u); }
constexpr int cand_off(int i) { int o = 0; for (int k = 0; k < i; ++k) o += 16 / (k + 1); return o; }
DEV void topk_load_keys(const Params& p, int layer, int h, unsigned char* smem) {
    bf16_t* Ks = (bf16_t*)smem;
    const bf16_t* keys = (const bf16_t*)(p.ws + WS_W + W_KEYS) + (size_t)layer * 262144 + (size_t)h * 32768;
    const int tid = tidx();
#pragma unroll
    for (int i = 0; i < 8; ++i) { const int id = tid + NT * i, row = id >> 4, kc = id & 15; *(u32x4*)(Ks + row * K_LDK + kc * 8) = *(const u32x4*)(keys + (size_t)row * 128 + kc * 8); }
    __syncthreads();
}
#ifndef HOST_EMU
template <int CTRL> DEV unsigned dpp_u32(unsigned v) { return (unsigned)__builtin_amdgcn_update_dpp(0, (int)v, CTRL, 0xF, 0xF, true); }
#else
template <int CTRL> DEV unsigned dpp_u32(unsigned v) { const int lane = tidx() & 63; const int src = CTRL == 0xB1 ? (lane ^ 1) : CTRL == 0x4E ? (lane ^ 2) : ((lane & ~7) | (7 - (lane & 7))); return emu_shfl(v, src); }
#endif
DEV unsigned max8_u32(unsigned v) { unsigned t = dpp_u32<0xB1>(v); v = v > t ? v : t; t = dpp_u32<0x4E>(v); v = v > t ? v : t; t = dpp_u32<0x141>(v); return v > t ? v : t; }
DEV float sum8_f32(float v) { v += __builtin_bit_cast(float, dpp_u32<0xB1>(__builtin_bit_cast(unsigned, v))); v += __builtin_bit_cast(float, dpp_u32<0x4E>(__builtin_bit_cast(unsigned, v))); v += __builtin_bit_cast(float, dpp_u32<0x141>(__builtin_bit_cast(unsigned, v))); return v; }
DEV float unkey(unsigned k) { const unsigned u = (k & 0x80000000u) ? (k & 0x7fffffffu) : ~k; return __builtin_bit_cast(float, u); }
template <int N> DEV void bitonic_desc(unsigned (&a)[N]) {
#pragma unroll
    for (int k = 2; k <= N; k <<= 1)
#pragma unroll
        for (int j = k >> 1; j > 0; j >>= 1)
#pragma unroll
            for (int i = 0; i < N; ++i) { const int l = i ^ j; if (l > i) { const unsigned x = a[i], y = a[l]; const unsigned hi = x > y ? x : y, lo = x > y ? y : x; if ((i & k) == 0) { a[i] = hi; a[l] = lo; } else { a[i] = lo; a[l] = hi; } } }
}
DEV void merge16(const unsigned* lst, int nlist, unsigned first, int sub, unsigned& r0, unsigned& r1) {
    unsigned cur = first; int head = 0; r0 = 0u; r1 = 0u;
#pragma unroll
    for (int it = 0; it < 16; ++it) {
        const unsigned m = max8_u32(cur);
        if (sub == (it & 7)) { if (it < 8) r0 = m; else r1 = m; }
        if (cur == m) { ++head; cur = head < nlist ? lst[head] : 0u; }
    }
}
DEV void topk_item(const Params& p, int h, int tok0, unsigned char* smem) {
    bf16_t* Ks = (bf16_t*)smem;
    float* Sc = (float*)(Ks + 2 * 128 * K_LDK);
    unsigned* s12 = (unsigned*)Sc + 64 * 8 * 17;
    unsigned* cl = s12 + 64 * 32;
    const int tid = tidx(), lane = tid & 63, w = tid >> 6;
    const int row = tid >> 3, sub = tid & 7;
    const bf16_t* PQ = (const bf16_t*)(p.ws + WS_P);
    for (int part = 0; part < 2; ++part) {
        { const int mi = w >> 2, ni = w & 3;
          f32x16 acc;
#pragma unroll
          for (int r = 0; r < 16; ++r) acc[r] = 0.f;
          const bf16_t* ag = PQ + (size_t)(tok0 + mi * 32 + (lane & 31)) * 2048 + h * 256 + part * 128 + 8 * (lane >> 5);
          const bf16_t* bs = Ks + (part * 128 + ni * 32 + (lane & 31)) * K_LDK + 8 * (lane >> 5);
          bf16x8 af[8];
#pragma unroll
          for (int kk = 0; kk < 8; ++kk) af[kk] = *(const bf16x8*)(ag + kk * 16);
#pragma unroll
          for (int kk = 0; kk < 8; ++kk) acc = __builtin_amdgcn_mfma_f32_32x32x16_bf16(af[kk], *(const bf16x8*)(bs + kk * 16), acc, 0, 0, 0);
#pragma unroll
          for (int r = 0; r < 16; ++r) Sc[(mi * 32 + (r & 3) + 8 * (r >> 2) + 4 * (lane >> 5)) * K_LDS + ni * 32 + (lane & 31)] = acc[r]; }
        __syncthreads();
        unsigned mk[16];
#pragma unroll
        for (int i = 0; i < 16; ++i) mk[i] = (fkey(Sc[row * K_LDS + sub * 16 + i]) & ~127u) | (unsigned)(127 - (sub * 16 + i));
        bitonic_desc<16>(mk);
        __syncthreads();
        unsigned* lst = (unsigned*)Sc + (row * 8 + sub) * 17;
#pragma unroll
        for (int i = 0; i < 16; ++i) lst[i] = mk[i];
        unsigned r0, r1;
        merge16(lst, 16, mk[0], sub, r0, r1);
        s12[(row * 2 + part) * 16 + sub] = r0; s12[(row * 2 + part) * 16 + 8 + sub] = r1;
        __syncthreads();
    }
    {
        const unsigned* k1 = s12 + row * 32; const unsigned* k2 = k1 + 16;
        unsigned ck[8];
#pragma unroll
        for (int m = 0; m < 8; ++m) {
            const int cc = sub + 8 * m; int ci = 0, off = 0;
#pragma unroll
            for (int i = 0; i < 15; ++i) { const bool ge = cc >= cand_off(i + 1); ci += ge ? 1 : 0; off += ge ? 16 / (i + 1) : 0; }
            const int cj = cc - off;
            ck[m] = 0u;
            if (cc < 50) ck[m] = (fkey(unkey((k1[ci] & ~127u) | 64u) + unkey((k2[cj] & ~127u) | 64u)) & ~63u) | (unsigned)(63 - cc);
        }
        bitonic_desc<8>(ck);
        unsigned* lst = cl + (row * 8 + sub) * 9;
#pragma unroll
        for (int m = 0; m < 8; ++m) lst[m] = ck[m];
        unsigned r0, r1;
        merge16(lst, 8, ck[0], sub, r0, r1);
        const float a = unkey((r0 & ~63u) | 32u), b = unkey((r1 & ~63u) | 32u);
        const unsigned kmax = max8_u32(r0 > r1 ? r0 : r1); const float vmax = unkey((kmax & ~63u) | 32u);
        const float ea = __expf(a - vmax), eb = __expf(b - vmax);
        const float inv = 1.f / sum8_f32(ea + eb);
        int eidx[2];
#pragma unroll
        for (int q = 0; q < 2; ++q) {
            const int cc = 63 - (int)((q ? r1 : r0) & 63u); int ci = 0, off = 0;
#pragma unroll
            for (int i = 0; i < 15; ++i) { const bool ge = cc >= cand_off(i + 1); ci += ge ? 1 : 0; off += ge ? 16 / (i + 1) : 0; }
            const int cj = cc - off;
            eidx[q] = (127 - (int)(k1[ci] & 127u)) * 128 + (127 - (int)(k2[cj] & 127u));
        }
        int* IDX = (int*)(p.ws + WS_IDX) + (size_t)(tok0 + row) * 128 + h * 16; float* GT = (float*)(p.ws + WS_GATE) + (size_t)(tok0 + row) * 128 + h * 16;
        IDX[sub] = eidx[0]; IDX[8 + sub] = eidx[1]; GT[sub] = ea * inv; GT[8 + sub] = eb * inv;
    }
    __syncthreads();
}
DEV void topk_phase(const Params& p, int layer, int ntok, unsigned char* smem) {
    const int G = gridDim.x, bid = blockIdx.x, h = bid & 7;
    const int nt = ntok / 64;
    if ((G & 7) == 0) {
        if ((bid >> 3) < nt) topk_load_keys(p, layer, h, smem);
        for (int tt = bid >> 3; tt < nt; tt += (G >> 3)) topk_item(p, h, tt * 64, smem);
    } else {
        for (int it = bid; it < nt * 8; it += G) { __syncthreads(); topk_load_keys(p, layer, it & 7, smem); topk_item(p, it & 7, (it >> 3) * 64, smem); }
    }
}

DEV float gelu_f(float x) { return 0.5f * x * (1.f + erff(x * 0.70710678118654752f)); }
DEV void peer_item(const Params& p, int layer, int item, int var = 0) {
    (void)var;
    const int tok = item * 8 + (tidx() >> 6), lane = tidx() & 63, li = lane & 31, half = lane >> 5;
    const bf16_t* A = (const bf16_t*)(p.ws + WS_A) + (size_t)tok * 1024 + li * 32;
    const unsigned char* U6 = p.ws + WS_U6 + (size_t)layer * 16384 * 768; const unsigned char* V4 = p.ws + WS_V4 + (size_t)layer * 16384 * 512;
    const float* SU = (const float*)(p.ws + WS_S8) + (size_t)(layer * 2) * 16384; const float* SV = SU + 16384;
    float x[32], y[32];
#pragma unroll
    for (int q = 0; q < 4; ++q) { const u32x4 a = *(const u32x4*)(A + 8 * q);
#pragma unroll
        for (int i = 0; i < 4; ++i) { x[8 * q + 2 * i] = bflo(a[i]); x[8 * q + 2 * i + 1] = bfhi(a[i]); } }
#pragma unroll
    for (int i = 0; i < 32; ++i) y[i] = 0.f;
    const int* IDX = (const int*)(p.ws + WS_IDX) + (size_t)tok * 128; const float* GT = (const float*)(p.ws + WS_GATE) + (size_t)tok * 128;
    const int i_lo = IDX[lane], i_hi = IDX[64 + lane]; const float g_lo = GT[lane], g_hi = GT[64 + lane];
    const int sl = ((li >> 4) & 1) * 2 + ((li >> 3) & 1);
    u32x4 ulo[4], vq[4]; u32x2 uhi[4];
#define PG_LOADU(g) do { _Pragma("unroll") for (int s_ = 0; s_ < 4; ++s_) { const int e_ = __shfl((g) < 8 ? i_lo : i_hi, (((g) & 7) << 3) + 2 * s_ + half); \
        const unsigned char* r_ = U6 + (size_t)e_ * 768; ulo[s_] = *(const u32x4*)(r_ + li * 16); uhi[s_] = *(const u32x2*)(r_ + 512 + li * 8); } } while (0)
#define PG_LOADV(g) do { _Pragma("unroll") for (int s_ = 0; s_ < 4; ++s_) { const int e_ = __shfl((g) < 8 ? i_lo : i_hi, (((g) & 7) << 3) + 2 * s_ + half); \
        vq[s_] = *(const u32x4*)(V4 + (size_t)e_ * 512 + li * 16); } } while (0)
    PG_LOADU(0); PG_LOADV(0);
    for (int g = 0; g < 16; ++g) {
        const int mk = ((g & 7) << 3) + 2 * sl + half; const int me = __shfl(g < 8 ? i_lo : i_hi, mk); const float mg = __shfl(g < 8 ? g_lo : g_hi, mk);
        const float su = SU[me], sv = SV[me];
        float d[4];
#pragma unroll
        for (int s4 = 0; s4 < 4; ++s4) {
            u32x6 w; w[0] = ulo[s4][0]; w[1] = ulo[s4][1]; w[2] = ulo[s4][2]; w[3] = ulo[s4][3]; w[4] = uhi[s4][0]; w[5] = uhi[s4][1];
            const f32x32 f = __builtin_amdgcn_cvt_scalef32_pk32_f32_fp6(w, 1.0f);
            float a = 0.f;
#pragma unroll
            for (int i = 0; i < 32; ++i) a = fmaf(f[i], x[i], a);
            d[s4] = a; SCHED_FENCE(); }
        if (g + 1 < 16) PG_LOADU(g + 1);
        float r2[2], r1;
        { const bool hi = (li & 16) != 0;
#pragma unroll
          for (int j = 0; j < 2; ++j) { const float send = hi ? d[j] : d[2 + j], keep = hi ? d[2 + j] : d[j]; r2[j] = keep + __shfl_xor(send, 16); } }
        { const bool hi = (li & 8) != 0; const float send = hi ? r2[0] : r2[1], keep = hi ? r2[1] : r2[0]; r1 = keep + __shfl_xor(send, 8); }
        r1 += __shfl_xor(r1, 4); r1 += __shfl_xor(r1, 2); r1 += __shfl_xor(r1, 1);
        const float act = gelu_f(r1 * su) * mg * sv;
#pragma unroll
        for (int s4 = 0; s4 < 4; ++s4) {
            const float aj = __shfl(act, (lane & 32) + 16 * (s4 >> 1) + 8 * (s4 & 1));
#pragma unroll
            for (int dw = 0; dw < 4; ++dw) {
                const f32x2 f0 = __builtin_amdgcn_cvt_scalef32_pk_f32_fp4(vq[s4][dw], 1.0f, 0), f1 = __builtin_amdgcn_cvt_scalef32_pk_f32_fp4(vq[s4][dw], 1.0f, 1),
                            f2 = __builtin_amdgcn_cvt_scalef32_pk_f32_fp4(vq[s4][dw], 1.0f, 2), f3 = __builtin_amdgcn_cvt_scalef32_pk_f32_fp4(vq[s4][dw], 1.0f, 3);
                const int e0 = dw * 8;
                y[e0] = fmaf(aj, f0[0], y[e0]); y[e0 + 1] = fmaf(aj, f0[1], y[e0 + 1]); y[e0 + 2] = fmaf(aj, f1[0], y[e0 + 2]); y[e0 + 3] = fmaf(aj, f1[1], y[e0 + 3]);
                y[e0 + 4] = fmaf(aj, f2[0], y[e0 + 4]); y[e0 + 5] = fmaf(aj, f2[1], y[e0 + 5]); y[e0 + 6] = fmaf(aj, f3[0], y[e0 + 6]); y[e0 + 7] = fmaf(aj, f3[1], y[e0 + 7]);
            }
            SCHED_FENCE(); }
        if (g + 1 < 16) PG_LOADV(g + 1);
    }
#undef PG_LOADU
#undef PG_LOADV
    float yy[16];
#pragma unroll
    for (int i = 0; i < 16; ++i) { const float send = half ? y[i] : y[16 + i], keep = half ? y[16 + i] : y[i]; yy[i] = keep + __shfl_xor(send, 32); }
    const int c0 = li * 32 + half * 16;
    float* H = (float*)(p.ws + WS_H) + (size_t)tok * 1024 + c0;
    const float* g2 = (const float*)(p.ws + WS_MOD) + ((size_t)layer * NR + mod_row(tok)) * 6144 + 5120 + c0;
    float hv[16]; float ss = 0.f;
#pragma unroll
    for (int i = 0; i < 4; ++i) { const f32x4 hh = *(const f32x4*)(H + 4 * i), gg = *(const f32x4*)(g2 + 4 * i);
#pragma unroll
        for (int j = 0; j < 4; ++j) { const float v = hh[j] + gg[j] * yy[4 * i + j]; hv[4 * i + j] = v; ss += v * v; } }
    ss = wave_sum(ss);
    const float rstd = rsqrtf(ss * (1.f / 1024.f) + 1e-6f);
    if (layer == 0) {
#pragma unroll
        for (int i = 0; i < 4; ++i) { f32x4 o; o[0] = hv[4 * i]; o[1] = hv[4 * i + 1]; o[2] = hv[4 * i + 2]; o[3] = hv[4 * i + 3]; *(f32x4*)(H + 4 * i) = o; }
        const float* g = p.in[I_N1G] + 1024 + c0;
        const float* mod = (const float*)(p.ws + WS_MOD) + ((size_t)1 * NR + mod_row(tok)) * 6144 + c0;
        bf16_t* Ao = (bf16_t*)(p.ws + WS_A) + (size_t)tok * 1024 + c0;
        u32x4 o0, o1; float r[16];
#pragma unroll
        for (int i = 0; i < 16; ++i) r[i] = hv[i] * rstd * g[i] * (1.f + mod[1024 + i]) + mod[i];
#pragma unroll
        for (int i = 0; i < 4; ++i) { o0[i] = pk2(r[2 * i], r[2 * i + 1]); o1[i] = pk2(r[8 + 2 * i], r[8 + 2 * i + 1]); }
        *(u32x4*)Ao = o0; *(u32x4*)(Ao + 8) = o1;
    } else {
        const float* g = p.in[I_FG] + c0; float* out = p.out + (size_t)tok * 1024 + c0;
#pragma unroll
        for (int i = 0; i < 4; ++i) { f32x4 o; o[0] = hv[4 * i] * rstd * g[4 * i]; o[1] = hv[4 * i + 1] * rstd * g[4 * i + 1]; o[2] = hv[4 * i + 2] * rstd * g[4 * i + 2]; o[3] = hv[4 * i + 3] * rstd * g[4 * i + 3]; *(f32x4*)(out + 4 * i) = o; }
    }
}

constexpr int S3_LD = 136, S3_LDT = 24, S3_LDV = 72;
constexpr int S3_Q = 0, S3_K = S3_Q + 64 * S3_LD * 2, S3_KT = S3_K + 64 * S3_LD * 2, S3_D = S3_KT + 4 * 128 * S3_LDT * 2, S3_V = S3_D + 4 * 128 * 4, S3_ST = S3_V + 64 * S3_LDV * 2,
              S3_P = S3_ST + 2 * 64 * S3_LD * 2, S3_END = S3_P + 4 * 16 * S3_LDT * 2;
static_assert(S3_END <= SMEM_BYTES, "scan LDS");
DEV void scan_block(const Params& p, int bi, unsigned char* smem, int var = 0) {
    const int tid = tidx(), lane = tid & 63, w = tid >> 6, l15 = lane & 15, lg4 = lane >> 4, l31 = lane & 31, lh = lane >> 5;
    const int half = bi & 1, dir = (bi >> 1) & 1, h = (bi >> 2) & 7, b = bi >> 5;
    const bf16_t* P1 = (const bf16_t*)(p.ws + WS_P);
    const bf16_t* IT = (const bf16_t*)(p.ws + WS_M);
    bf16_t* Oo = (bf16_t*)(p.ws + WS_F + (dir ? F_OB : F_OF));
    bf16_t* Qs = (bf16_t*)(smem + S3_Q); bf16_t* Ks = (bf16_t*)(smem + S3_K); bf16_t* KT = (bf16_t*)(smem + S3_KT); float* Ds = (float*)(smem + S3_D);
    bf16_t* Vs = (bf16_t*)(smem + S3_V); bf16_t* ST = (bf16_t*)(smem + S3_ST); bf16_t* Ps = (bf16_t*)(smem + S3_P);
    const int NCH = (LC + L) / 64;
    const int kt = w >> 1, vt = w & 1;
    f32x16 S;
#pragma unroll
    for (int r = 0; r < 16; ++r) S[r] = 0.f;
    for (int i = tid; i < 64 * S3_LD / 2; i += NT) ((unsigned*)ST)[i] = 0u;
    const int pk = tid & 127, pblk = tid >> 7;
    u32x4 ka[2], qa[2], va, kb2[2], qb2[2], vb2;
    const int kcol = 1024 * (1 + dir) + h * 128 + pk, qcol = h * 128 + pk;
#define S3_T0(c) ((c) * 64 < LC ? (dir ? LC - 64 - (c) * 64 : (c) * 64) : (dir ? L - 64 - ((c) * 64 - LC) : (c) * 64 - LC))
#define S3_LOAD(c, KR, QR, VR) do { const bool lat_ = (c) * 64 >= LC; const int t0_ = S3_T0(c); const int Lx_ = lat_ ? L : LC; \
        const bf16_t* kq_ = (const bf16_t*)(p.ws + WS_P + (lat_ ? P1_KQT_LAT : P1_KQT_CTX)) + (size_t)b * 3072 * Lx_ + t0_ + pblk * 16; \
        KR[0] = *(const u32x4*)(kq_ + (size_t)kcol * Lx_); KR[1] = *(const u32x4*)(kq_ + (size_t)kcol * Lx_ + 8); \
        if (lat_) { QR[0] = *(const u32x4*)(kq_ + (size_t)qcol * Lx_); QR[1] = *(const u32x4*)(kq_ + (size_t)qcol * Lx_ + 8); } else { QR[0] = (u32x4){0u, 0u, 0u, 0u}; QR[1] = QR[0]; } \
        { const int v_ = tid >> 3, c8_ = tid & 7; const bf16_t* it_ = IT + (lat_ ? (size_t)0 : (size_t)NB * 1024 * L) + ((size_t)b * 1024 + h * 128 + half * 64 + v_) * Lx_ + t0_ + c8_ * 8; VR = *(const u32x4*)it_; } } while (0)
#define S3_PREP(KR, QR, VR) do { \
            float bsum = 0.f; unsigned short kt16[16]; \
            _Pragma("unroll") for (int rr = 0; rr < 16; ++rr) { \
                const int tl = dir ? 15 - rr : rr; \
                const unsigned ku_ = dir ? KR[(15 - rr) >> 3][((15 - rr) & 7) >> 1] : KR[rr >> 3][(rr & 7) >> 1]; const unsigned qu_ = dir ? QR[(15 - rr) >> 3][((15 - rr) & 7) >> 1] : QR[rr >> 3][(rr & 7) >> 1]; \
                const bool odd_ = dir ? (((15 - rr) & 1) != 0) : ((rr & 1) != 0); \
                const float kv = odd_ ? bfhi(ku_) : bflo(ku_), qv = odd_ ? bfhi(qu_) : bflo(qu_); \
                bsum += __logf(1.f - kv); \
                const float eb = __expf(bsum), ieb = __expf(fminf(-bsum, 80.f)); \
                const unsigned short qt = (unsigned short)f2bf(qv * eb), ktv = (unsigned short)f2bf(kv * ieb); \
                Qs[(pblk * 16 + tl) * S3_LD + pk] = qt; Ks[(pblk * 16 + tl) * S3_LD + pk] = ktv; \
                if (dir) kt16[15 - rr] = ktv; else kt16[rr] = ktv; \
            } \
            u32x4 o0, o1; \
            _Pragma("unroll") for (int i = 0; i < 4; ++i) { o0[i] = (unsigned)kt16[2 * i] | ((unsigned)kt16[2 * i + 1] << 16); o1[i] = (unsigned)kt16[8 + 2 * i] | ((unsigned)kt16[8 + 2 * i + 1] << 16); } \
            *(u32x4*)(KT + (pblk * 128 + pk) * S3_LDT) = o0; *(u32x4*)(KT + (pblk * 128 + pk) * S3_LDT + 8) = o1; \
            Ds[pblk * 128 + pk] = __expf(bsum); \
            { const int v_ = tid >> 3, c8_ = tid & 7; *(u32x4*)(Vs + v_ * S3_LDV + c8_ * 8) = VR; } } while (0)
    S3_LOAD(0, ka, qa, va);
    for (int c = 0; c < NCH; ++c) {
        const bool lat = c * 64 >= LC; const int t0 = S3_T0(c); const size_t tokb = lat ? (size_t)b * L + t0 : (size_t)TL + (size_t)b * LC + t0;
        if ((c & 1) == 0) { if (c + 1 < NCH) S3_LOAD(c + 1, kb2, qb2, vb2); } else { if (c + 1 < NCH) S3_LOAD(c + 1, ka, qa, va); }
        lds_barrier();
        if (var != 1) { if ((c & 1) == 0) S3_PREP(ka, qa, va); else S3_PREP(kb2, qb2, vb2); }
        lds_barrier();

        if (lat && w < 4) {
            f32x4 pt = (f32x4){0.f, 0.f, 0.f, 0.f};
#pragma unroll
            for (int kk = 0; kk < 4; ++kk)
                pt = __builtin_amdgcn_mfma_f32_16x16x32_bf16(*(const bf16x8*)(Ks + (w * 16 + l15) * S3_LD + kk * 32 + 8 * lg4), *(const bf16x8*)(Qs + (w * 16 + l15) * S3_LD + kk * 32 + 8 * lg4), pt, 0, 0, 0);
            float pm[4];
#pragma unroll
            for (int r = 0; r < 4; ++r) { const int sl = 4 * lg4 + r; const bool keep = dir ? (sl >= l15) : (sl <= l15); pm[r] = keep ? pt[r] : 0.f; }
            u32x2 o; o[0] = pk2(pm[0], pm[1]); o[1] = pk2(pm[2], pm[3]);
            *(u32x2*)(Ps + (w * 16 + l15) * S3_LDT + 4 * lg4) = o;
        }
        lds_barrier();
        for (int ib = 0; ib < (var == 2 ? 0 : 4); ++ib) {
            const int blk = dir ? 3 - ib : ib;
            const int cur = (c * 4 + ib) & 1;
            { const bf16x8 a = *(const bf16x8*)(KT + (blk * 128 + 32 * kt + l31) * S3_LDT + 8 * lh);
              const bf16x8 bb = *(const bf16x8*)(Vs + (32 * vt + l31) * S3_LDV + blk * 16 + 8 * lh);
              S = __builtin_amdgcn_mfma_f32_32x32x16_bf16(a, bb, S, 0, 0, 0);
#pragma unroll
              for (int g = 0; g < 4; ++g) { const f32x4 dv = *(const f32x4*)(Ds + blk * 128 + 32 * kt + 8 * g + 4 * lh);
                  S[4 * g] *= dv[0]; S[4 * g + 1] *= dv[1]; S[4 * g + 2] *= dv[2]; S[4 * g + 3] *= dv[3];
                  u32x2 o; o[0] = pk2(S[4 * g], S[4 * g + 1]); o[1] = pk2(S[4 * g + 2], S[4 * g + 3]);
                  *(u32x2*)(ST + ((cur ^ 1) * 64 + 32 * vt + l31) * S3_LD + 32 * kt + 8 * g + 4 * lh) = o; } }
            if (lat && w < 4) {
                f32x4 o = (f32x4){0.f, 0.f, 0.f, 0.f};
#pragma unroll
                for (int kk = 0; kk < 4; ++kk)
                    o = __builtin_amdgcn_mfma_f32_16x16x32_bf16(*(const bf16x8*)(ST + (cur * 64 + 16 * w + l15) * S3_LD + kk * 32 + 8 * lg4), *(const bf16x8*)(Qs + (blk * 16 + l15) * S3_LD + kk * 32 + 8 * lg4), o, 0, 0, 0);
                bf16x8 va = (bf16x8){0, 0, 0, 0, 0, 0, 0, 0}, pb = va;
                if (lg4 < 2) { va = *(const bf16x8*)(Vs + (16 * w + l15) * S3_LDV + blk * 16 + 8 * lg4); pb = *(const bf16x8*)(Ps + (blk * 16 + l15) * S3_LDT + 8 * lg4); }
                o = __builtin_amdgcn_mfma_f32_16x16x32_bf16(va, pb, o, 0, 0, 0);
                u32x2 ou; ou[0] = pk2(o[0], o[1]); ou[1] = pk2(o[2], o[3]);
                *(u32x2*)(Oo + (tokb + blk * 16 + l15) * 1024 + h * 128 + half * 64 + 16 * w + 4 * lg4) = ou;
            }
            lds_barrier();
        }
    }
    lds_barrier();
#undef S3_T0
#undef S3_LOAD
#undef S3_PREP
}
DEV void readout_item(const Params& p, int item) {
    const int tok = item * 8 + (tidx() >> 6), lane = tidx() & 63;
    const bf16_t* of = (const bf16_t*)(p.ws + WS_F + F_OF) + (size_t)tok * 1024 + lane * 16; const bf16_t* ob = (const bf16_t*)(p.ws + WS_F + F_OB) + (size_t)tok * 1024 + lane * 16;
    const bf16_t* gp = (const bf16_t*)(p.ws + WS_P + P1_G) + (size_t)tok * 1024 + lane * 16;
    const float* on = p.in[I_HGON] + (lane & 7) * 16;
    float o[16], gg[16]; float ss = 0.f;
    { const u32x4 a0 = *(const u32x4*)of, a1 = *(const u32x4*)(of + 8), b0 = *(const u32x4*)ob, b1 = *(const u32x4*)(ob + 8), g0 = *(const u32x4*)gp, g1 = *(const u32x4*)(gp + 8);
#pragma unroll
      for (int i = 0; i < 4; ++i) { o[2 * i] = bflo(a0[i]) + bflo(b0[i]); o[2 * i + 1] = bfhi(a0[i]) + bfhi(b0[i]); o[8 + 2 * i] = bflo(a1[i]) + bflo(b1[i]); o[8 + 2 * i + 1] = bfhi(a1[i]) + bfhi(b1[i]);
          gg[2 * i] = bflo(g0[i]); gg[2 * i + 1] = bfhi(g0[i]); gg[8 + 2 * i] = bflo(g1[i]); gg[8 + 2 * i + 1] = bfhi(g1[i]); } }
#pragma unroll
    for (int i = 0; i < 16; ++i) ss += o[i] * o[i];
    ss += __shfl_xor(ss, 1); ss += __shfl_xor(ss, 2); ss += __shfl_xor(ss, 4);
    const float rstd = rsqrtf(ss * (1.f / 128.f) + 1e-6f);
    bf16_t* M = (bf16_t*)(p.ws + WS_M) + (size_t)tok * 1024 + lane * 16;
    u32x4 o0, o1; float r[16];
#pragma unroll
    for (int i = 0; i < 16; ++i) r[i] = o[i] * rstd * on[i] * gg[i];
#pragma unroll
    for (int i = 0; i < 4; ++i) { o0[i] = pk2(r[2 * i], r[2 * i + 1]); o1[i] = pk2(r[8 + 2 * i], r[8 + 2 * i + 1]); }
    *(u32x4*)M = o0; *(u32x4*)(M + 8) = o1;
}

#ifndef HOST_EMU
#define XB_TMO      128
#define XB_XCNT(j)  (256  + 64 * (j))
#define XB_XSUB(j)  (1280 + 64 * (j))
#define XB_XGEN(j)  (2304 + 64 * (j))
#define XB_TOP      3328
#define XB_TOPGEN   3392
#define XCD_BAR_WORDS 3456
#define XB_SPIN_CAP (1u << 18)
#define LAS __attribute__((address_space(3)))

__device__ __forceinline__ unsigned xb_ld(unsigned* p)              { return __hip_atomic_load(p, __ATOMIC_RELAXED, __HIP_MEMORY_SCOPE_AGENT); }
__device__ __forceinline__ unsigned xb_add(unsigned* p, unsigned v) { return __hip_atomic_fetch_add(p, v, __ATOMIC_RELAXED, __HIP_MEMORY_SCOPE_AGENT); }
__device__ __forceinline__ unsigned xb_xcc_id() { return (unsigned)__builtin_amdgcn_s_getreg((3 << 11) | 20) & 0xFu; }
#define XB_SPIN(cond, bar) do { unsigned _sp = 0; while (cond) { __builtin_amdgcn_s_sleep(1); \
    if ((++_sp & 255u) == 0u) { if (xb_ld(&(bar)[XB_TMO])) break; if (_sp > XB_SPIN_CAP) { atomicAdd(&(bar)[XB_TMO], 1u); break; } } } } while (0)

struct XcdBarrier {
    unsigned* bar; unsigned x;
    volatile LAS unsigned* st;
};

__device__ __forceinline__ XcdBarrier xcd_barrier_post(unsigned* bar, volatile LAS unsigned* st) {
    XcdBarrier b; b.bar = bar; b.x = xb_xcc_id(); b.st = st;
    if (threadIdx.x == 0) (void)xb_add(&bar[XB_XCNT(b.x)], 1u);
    return b;
}
__device__ __forceinline__ void xcd_barrier_complete(unsigned* bar, unsigned x, unsigned& nloc, unsigned& nx) {
    const unsigned G = gridDim.x * gridDim.y * gridDim.z;
    unsigned sum, cnt, mine, sp = 0u;
    for (;;) {
        sum = 0u; cnt = 0u; mine = 0u;
#pragma unroll
        for (unsigned j = 0; j < 16; ++j) { const unsigned c = xb_ld(&bar[XB_XCNT(j)]); sum += c; cnt += (c > 0u) ? 1u : 0u; mine = (j == x) ? c : mine; }
        if (sum == G) break;
        __builtin_amdgcn_s_sleep(1);
        if ((++sp & 255u) == 0u) { if (xb_ld(&bar[XB_TMO])) break; if (sp > XB_SPIN_CAP) { atomicAdd(&bar[XB_TMO], 1u); break; } }
    }
    nloc = mine > 0u ? mine : 1u; nx = cnt > 0u ? cnt : 1u;
}

__device__ __forceinline__ void xcd_barrier(const XcdBarrier& b) {
    asm volatile("s_waitcnt vmcnt(0)" ::: "memory");
    __syncthreads();
    if (threadIdx.x == 0) {
        unsigned* bar = b.bar;
        __builtin_amdgcn_s_waitcnt(0);
        unsigned nloc = b.st[0], nx = b.st[1];
        if (nloc == 0u) { xcd_barrier_complete(bar, b.x, nloc, nx); b.st[0] = nloc; b.st[1] = nx; }
        const unsigned old = xb_add(&bar[XB_XSUB(b.x)], 1u);
        const unsigned gen = old / nloc;
        if (old + 1u == (gen + 1u) * nloc) {
            __builtin_amdgcn_fence(__ATOMIC_RELEASE, "agent");
            asm volatile("s_waitcnt vmcnt(0)" ::: "memory");
            const unsigned og = xb_add(&bar[XB_TOP], 1u);
            const unsigned tg = og / nx;
            if (og + 1u == (tg + 1u) * nx) xb_add(&bar[XB_TOPGEN], 1u);
            else XB_SPIN(xb_ld(&bar[XB_TOPGEN]) == tg, bar);
            __builtin_amdgcn_fence(__ATOMIC_ACQUIRE, "agent");
            xb_add(&bar[XB_XGEN(b.x)], 1u);
            asm volatile("s_waitcnt vmcnt(0)" ::: "memory");
        } else {
            XB_SPIN(xb_ld(&bar[XB_XGEN(b.x)]) == gen, bar);
            __builtin_amdgcn_fence(__ATOMIC_ACQUIRE, "agent");
            asm volatile("s_waitcnt vmcnt(0)" ::: "memory");
        }
    }
    __syncthreads();
}

#endif
#ifdef NOINLINE_PHASES
#define NOINL __device__ __attribute__((noinline))
#else
#define NOINL __device__ __forceinline__
#endif
__shared__ __attribute__((aligned(16))) unsigned char g_smem[SMEM_BYTES + 16];
#define PH_COMMON const int G = gridDim.x, bid = blockIdx.x; unsigned char* smem = g_smem; (void)smem; (void)G; (void)bid; \
    const bf16_t* A = (const bf16_t*)(p.ws + WS_A); const bf16_t* Mx = (const bf16_t*)(p.ws + WS_M); const bf16_t* W = (const bf16_t*)(p.ws + WS_W); (void)A; (void)Mx; (void)W;
NOINL void ph0(const Params& p) { PH_COMMON phase0(p, smem); }
NOINL void ph1(const Params& p) { PH_COMMON phase1(p, smem); }
NOINL void ph2(const Params& p) { PH_COMMON EpiL0InT e{p.ws}; gemm_pg8_T(A, W + W_IN0 / 2, T, 2304, smem, e); }
NOINL void ph3(const Params& p, int var = 0) { PH_COMMON phase3(p, smem, var); }
NOINL void ph4(const Params& p) { PH_COMMON EpiRes e{&p, 1, 0, 2048}; gemm_pg8_N(Mx, W + W_OUT0 / 2, T, 1024, smem, e); }
NOINL void ph5(const Params& p) { PH_COMMON for (int it = bid; it < T / 8; it += G) norm_rows_item(p, it, 0, p.in[I_N2G], 0, 3072); }
NOINL void ph6(const Params& p, int var = 0) { PH_COMMON (void)var; EpiBf16 e{(bf16_t*)(p.ws + WS_P), 2048}; gemm_pg8_N(A, W + W_Q0 / 2, T, 2048, smem, e); }
NOINL void ph7(const Params& p) { PH_COMMON topk_phase(p, 0, T, smem); }
NOINL void ph8(const Params& p) { PH_COMMON for (int it = bid; it < T / 8; it += G) peer_item(p, 0, it); }
NOINL void ph9(const Params& p) { PH_COMMON EpiHgT e{p.ws, p.in[I_HGLB]}; gemm_pg8_T(A, W + W_IN1 / 2, T, 5120, smem, e); }
NOINL void ph10(const Params& p, int var = 0) { PH_COMMON for (int bi = bid; bi < NB * 32; bi += G) scan_block(p, bi, smem, var); }
NOINL void ph11(const Params& p) { PH_COMMON for (int it = bid; it < TL / 8; it += G) readout_item(p, it); }
NOINL void ph12(const Params& p) { PH_COMMON EpiRes e{&p, 0, 1, 2048}; gemm_pg8_N(Mx, W + W_OUT1 / 2, TL, 1024, smem, e); }
NOINL void ph13(const Params& p) { PH_COMMON for (int it = bid; it < TL / 8; it += G) norm_rows_item(p, it, 0, p.in[I_N2G] + 1024, 1, 3072); }
NOINL void ph14(const Params& p) { PH_COMMON EpiBf16 e{(bf16_t*)(p.ws + WS_P), 2048}; gemm_pg8_N(A, W + W_Q1 / 2, TL, 2048, smem, e); }
NOINL void ph15(const Params& p) { PH_COMMON topk_phase(p, 1, TL, smem); }
NOINL void ph16(const Params& p, int var = 0) { PH_COMMON for (int it = bid; it < TL / 8; it += G) peer_item(p, 1, it, var); }

constexpr int NPHASE = 17;
__global__ void __launch_bounds__(NT, 2) mega(Params p_in) {
    const int ph_lo = p_in.ph_lo, ph_hi = p_in.ph_hi;
#ifndef HOST_EMU
#define GBAR_MAKE() XcdBarrier gbar; gbar.bar = (unsigned*)(p_in.ws + WS_CTRL); gbar.x = xb_xcc_id(); gbar.st = (volatile LAS unsigned*)(LAS unsigned char*)(g_smem + SMEM_BYTES);
    if (ph_hi - ph_lo > 1) {
        volatile LAS unsigned* st = (volatile LAS unsigned*)(LAS unsigned char*)(g_smem + SMEM_BYTES);
        if (threadIdx.x == 0) { st[0] = 0u; st[1] = 0u; }
        __syncthreads();
        (void)xcd_barrier_post((unsigned*)(p_in.ws + WS_CTRL), st);
    }
#endif
    for (int ph = ph_lo; ph < ph_hi; ++ph) {
        if (ph > ph_lo) {
#ifndef HOST_EMU
            { GBAR_MAKE(); xcd_barrier(gbar); }
#endif
        }
#ifndef HOST_EMU
        unsigned long long kp = (unsigned long long)__builtin_amdgcn_kernarg_segment_ptr();
        asm volatile("" : "+s"(kp) :: "memory");
        const Params& p = *(const Params*)(const __attribute__((address_space(4))) Params*)kp;
#else
        const Params& p = p_in;
#endif
#ifdef REPEAT_MASK
        for (int rep_ = ((REPEAT_MASK >> ph) & 1); rep_ >= 0; --rep_) { if (rep_ == 0 && ((REPEAT_MASK >> ph) & 1)) { GBAR_MAKE(); xcd_barrier(gbar); }
#else
        {
#endif
#ifdef ONLY_PHASE
        if (ph != ONLY_PHASE) continue;
        switch (ONLY_PHASE) {
#else
        switch (ph) {
#endif
        case 0: ph0(p); break; case 1: ph1(p); break; case 2: ph2(p); break; case 3:
#if defined(REPEAT_MASK) && defined(P3_VAR)
            ph3(p, rep_ == 1 ? P3_VAR : 0);
#else
            ph3(p);
#endif
            break; case 4: ph4(p); break; case 5: ph5(p); break;
        case 6:
#if defined(REPEAT_MASK) && defined(G_VAR)
            ph6(p, rep_ == 1 ? G_VAR : 0);
#else
            ph6(p);
#endif
            break; case 7: ph7(p); break; case 8: ph8(p); break; case 9: ph9(p); break; case 10:
#if defined(REPEAT_MASK) && defined(SCAN_VAR)
            ph10(p, rep_ == 1 ? SCAN_VAR : 0);
#else
            ph10(p);
#endif
            break; case 11: ph11(p); break;
        case 12: ph12(p); break; case 13: ph13(p); break; case 14: ph14(p); break; case 15: ph15(p); break; case 16:
#if defined(REPEAT_MASK) && defined(PG_VAR)
            ph16(p, rep_ == 1 ? PG_VAR : 0);
#else
            ph16(p);
#endif
            break;
        default: break;
        }
        }
    }
}

#ifndef HOST_EMU
extern "C" void kernel_launch(void* const* d_in, const int* in_sizes, int n_in, void* d_out, int out_size, void* d_ws, size_t ws_size, hipStream_t stream) {
    if (n_in != 29 || ws_size < WS_END || out_size != TL * 1024) { fprintf(stderr, "kernel_launch: unexpected sizes (n_in %d, ws %zu need %zu, out %d)\n", n_in, ws_size, (size_t)WS_END, out_size); return; }
    static int grid = 0;
    if (!grid) { int dev = 0, cus = 0; hipGetDevice(&dev); hipDeviceGetAttribute(&cus, hipDeviceAttributeMultiprocessorCount, dev); grid = cus > 0 ? cus : 256; }
    hipMemsetAsync((unsigned char*)d_ws + WS_CTRL, 0, CTRL_BYTES, stream);
    Params p{};
    for (int i = 0; i < 29; ++i) p.in[i] = (const float*)d_in[i];
    p.out = (float*)d_out; p.ws = (unsigned char*)d_ws;
#ifdef MULTI_LAUNCH
    for (int ph = 0; ph < NPHASE; ++ph) { p.ph_lo = ph; p.ph_hi = ph + 1; hipLaunchKernelGGL(mega, dim3(grid), dim3(NT), 0, stream, p); }
#else
    p.ph_lo = 0; p.ph_hi = NPHASE;
    hipLaunchKernelGGL(mega, dim3(grid), dim3(NT), 0, stream, p);
#endif
}
#endif
```

```cpp
#ifndef HOST_EMU
#include <hip/hip_runtime.h>
#include <cstdio>
#endif

#ifndef CFG_B
#define CFG_B 8
#define CFG_L 2048
#define CFG_LC 256
#endif
#define DEV __device__ __forceinline__
#ifndef HOST_EMU
#define SCHED_FENCE() __builtin_amdgcn_sched_barrier(0)
#endif
#ifdef HOST_EMU
#define SCHED_FENCE() do {} while (0)
#define __expf expf
#define __logf logf
#define __sinf sinf
#define __cosf cosf
#endif

typedef unsigned short bf16_t;
typedef short bf16x8 __attribute__((ext_vector_type(8)));
typedef float f32x16 __attribute__((ext_vector_type(16)));
typedef float f32x4 __attribute__((ext_vector_type(4)));
typedef unsigned u32x4 __attribute__((ext_vector_type(4)));
typedef unsigned u32x2 __attribute__((ext_vector_type(2)));
struct cf2 { float x, y; };

constexpr int NB = CFG_B, L = CFG_L, LC = CFG_LC, D = 1024;
constexpr int TL = NB * L, TC = NB * LC, T = TL + TC;
constexpr int NT = 512;
constexpr int NR = NB + 1;
constexpr int log4ceil(int n) { int s = 0, v = 1; while (v < n) { v *= 4; ++s; } return s; }
constexpr int FS_LAT = log4ceil(2 * L - 1), FS_CTX = log4ceil(2 * LC - 1);
constexpr int NF_LAT = 1 << (2 * FS_LAT), NF_CTX = 1 << (2 * FS_CTX);
static_assert(T % 256 == 0 && TL % 256 == 0 && L % 128 == 0 && LC % 128 == 0 && NB % 2 == 0, "shape");

constexpr size_t al256(size_t x) { return (x + 255) & ~(size_t)255; }
constexpr size_t WS_CTRL = 0, CTRL_BYTES = 65536;
constexpr size_t CTRL_HYNORM = 4096;
constexpr size_t WS_MOD = WS_CTRL + CTRL_BYTES;
constexpr size_t WS_H = al256(WS_MOD + (size_t)2 * NR * 6144 * 4);
constexpr size_t WS_A = al256(WS_H + (size_t)T * 1024 * 4);
constexpr size_t WS_P = al256(WS_A + (size_t)T * 1024 * 2);
constexpr size_t P_BYTES = (size_t)T * 5120 * 2;
constexpr size_t P_HYT_LAT = 0;
constexpr size_t P_HYT_CTX = P_HYT_LAT + (size_t)NB * 1536 * L * 2;
constexpr size_t P_Q0 = P_HYT_CTX + (size_t)NB * 1536 * LC * 2;
constexpr size_t P_K0 = P_Q0 + (size_t)T * 512 * 2;
constexpr size_t P_VT_LAT = P_K0 + (size_t)T * 128 * 2;
constexpr size_t P_VT_CTX = P_VT_LAT + (size_t)NB * 128 * L * 2;
static_assert(P_VT_CTX + (size_t)NB * 128 * LC * 2 <= P_BYTES, "P region");
constexpr size_t P1_KQT_LAT = 0;
constexpr size_t P1_KQT_CTX = P1_KQT_LAT + (size_t)NB * 3072 * L * 2;
constexpr size_t P1_G = P1_KQT_CTX + (size_t)NB * 3072 * LC * 2;
static_assert(P1_G + (size_t)TL * 1024 * 2 <= P_BYTES, "P region (layer 1)");
constexpr size_t WS_M = al256(WS_P + P_BYTES);
constexpr size_t WS_IDX = al256(WS_M + (size_t)T * 1024 * 2);
constexpr size_t WS_GATE = al256(WS_IDX + (size_t)T * 128 * 4);
constexpr size_t WS_U6 = al256(WS_GATE + (size_t)T * 128 * 4);
constexpr size_t WS_V4 = WS_U6 + (size_t)2 * 16384 * 768;
constexpr size_t WS_S8 = WS_V4 + (size_t)2 * 16384 * 512;
constexpr size_t WS_W = al256(WS_S8 + (size_t)4 * 16384 * 4);
constexpr size_t W_IN0 = 0, W_OUT0 = W_IN0 + (size_t)2304 * 1024 * 2, W_IN1 = W_OUT0 + (size_t)1024 * 1024 * 2,
                 W_OUT1 = W_IN1 + (size_t)5120 * 1024 * 2, W_Q0 = W_OUT1 + (size_t)1024 * 1024 * 2, W_Q1 = W_Q0 + (size_t)2048 * 1024 * 2,
                 W_KEYS = W_Q1 + (size_t)2048 * 1024 * 2, W_BYTES = W_KEYS + (size_t)2 * 8 * 2 * 128 * 128 * 2;
constexpr size_t WS_F = al256(WS_W + W_BYTES);
constexpr size_t F_HRAW_LAT = 0;
constexpr size_t F_HRAW_CTX = F_HRAW_LAT + (size_t)2048 * L * 4;
constexpr size_t F_HF_LAT = F_HRAW_CTX + (size_t)2048 * LC * 4;
constexpr size_t F_HF_CTX = F_HF_LAT + (size_t)1024 * NF_LAT * 8;
constexpr size_t F_HYP_LAT = F_HF_CTX + (size_t)1024 * NF_CTX * 8;
constexpr size_t F_HYP_CTX = F_HYP_LAT + (size_t)(L / 64) * 2048 * 4;
constexpr size_t F_END = F_HYP_CTX + (size_t)(LC / 64) * 2048 * 4;
constexpr size_t F_OF = 0, F_OB = (size_t)TL * 1024 * 2;
constexpr size_t F_BYTES = F_END > 2 * F_OB ? F_END : 2 * F_OB;
constexpr size_t WS_END = al256(WS_F + F_BYTES);

struct Params { const float* in[29]; float* out; unsigned char* ws; int ph_lo, ph_hi; };
enum { I_X = 0, I_C, I_CTX, I_CCTX, I_ADAW, I_ADAB, I_N1G, I_N2G, I_FG, I_ABWIN, I_ABWOUT, I_HYCW, I_HYCB, I_HYW1, I_HYB1, I_HYW2, I_HYB2, I_HYW3,
       I_HYFREQ, I_HYSKIP, I_SINK, I_HGWIN, I_HGWOUT, I_HGLB, I_HGON, I_PWQ, I_PKEYS, I_PU, I_PV };

constexpr int SMEM_BYTES = 147456;

#ifndef HOST_EMU
DEV int tidx() { int t = threadIdx.x; asm volatile("" : "+v"(t)); return t; }
#else
DEV int tidx() { return (int)threadIdx.x; }
#endif
#ifndef HOST_EMU
DEV void lds_barrier() { asm volatile("s_waitcnt lgkmcnt(0)" ::: "memory"); __builtin_amdgcn_s_barrier(); asm volatile("" ::: "memory"); }
#else
DEV void lds_barrier() { __syncthreads(); }
#endif
#ifndef HOST_EMU
typedef __bf16 bf16n2 __attribute__((ext_vector_type(2)));
DEV unsigned pk2(float lo, float hi) { bf16n2 v; v[0] = (__bf16)lo; v[1] = (__bf16)hi; return __builtin_bit_cast(unsigned, v); }
DEV unsigned f2bf(float f) { return (unsigned)__builtin_bit_cast(unsigned short, (__bf16)f); }
#else
DEV unsigned f2bf(float f) { unsigned u = __builtin_bit_cast(unsigned, f); return (u + 0x7fffu + ((u >> 16) & 1u)) >> 16; }
DEV unsigned pk2(float lo, float hi) { return f2bf(lo) | (f2bf(hi) << 16); }
#endif
DEV float bf2f(unsigned h) { return __builtin_bit_cast(float, (h & 0xffffu) << 16); }
DEV float bflo(unsigned u) { return __builtin_bit_cast(float, u << 16); }
DEV float bfhi(unsigned u) { return __builtin_bit_cast(float, u & 0xffff0000u); }
DEV float silu_f(float x) { return x / (1.f + __expf(-x)); }
DEV float sigmoid_f(float x) { return 1.f / (1.f + __expf(-x)); }
DEV float wave_sum(float v) {
#pragma unroll
    for (int m = 32; m >= 1; m >>= 1) v += __shfl_xor(v, m);
    return v;
}
DEV int mod_row(int tok) { return tok < TL ? tok / L : NB; }

DEV void p0_mod(const Params& p, int item, unsigned char* smem) {
    const int l = item / 96, col0 = (item % 96) * 64, tid = tidx();
    float* sc = (float*)smem;
    float* red = sc + NR * 1024;
    for (int i = tid; i < NR * 1024; i += NT) { const int r = i >> 10, k = i & 1023; const float c = r < NB ? p.in[I_C][r * 1024 + k] : p.in[I_CCTX][k]; sc[i] = c / (1.f + expf(-c)); }
    __syncthreads();
    const int kq = tid >> 6, col = tid & 63;
    float acc[NR];
#pragma unroll
    for (int r = 0; r < NR; ++r) acc[r] = 0.f;
    const float* w = p.in[I_ADAW] + (size_t)l * 1024 * 6144 + col0 + col;
#pragma unroll 16
    for (int k = kq * 128; k < kq * 128 + 128; ++k) {
        const float wv = w[(size_t)k * 6144];
#pragma unroll
        for (int r = 0; r < NR; ++r) acc[r] += sc[r * 1024 + k] * wv;
    }
#pragma unroll
    for (int r = 0; r < NR; ++r) red[(kq * NR + r) * 64 + col] = acc[r];
    __syncthreads();
    float* mod = (float*)(p.ws + WS_MOD);
    for (int i = tid; i < NR * 64; i += NT) {
        const int r = i >> 6, c = i & 63; float s = 0.f;
        for (int q = 0; q < 8; ++q) s += red[(q * NR + r) * 64 + c];
        mod[((size_t)l * NR + r) * 6144 + col0 + c] = s + p.in[I_ADAB][l * 6144 + col0 + c];
    }
    __syncthreads();
}
DEV void p0_transpose(const float* W, bf16_t* Wt, int N, int tile, unsigned char* smem) {
    float* ts = (float*)smem;
    const int ntn = N / 256, kt = tile / ntn, nt = tile % ntn, k0 = kt * 64, n0 = nt * 256, tid = tidx();
    f32x4 rv[8];
#pragma unroll
    for (int m = 0; m < 8; ++m) { const int i = tid + NT * m, kk = i >> 6, c4 = i & 63; rv[m] = *(const f32x4*)(W + (size_t)(k0 + kk) * N + n0 + c4 * 4); }
#pragma unroll
    for (int m = 0; m < 8; ++m) { const int i = tid + NT * m, kk = i >> 6, c4 = i & 63; *(f32x4*)(ts + kk * 260 + c4 * 4) = rv[m]; }
    __syncthreads();
#pragma unroll
    for (int m = 0; m < 4; ++m) { const int i = tid + NT * m, nn = i >> 3, k8 = i & 7;
        u32x4 o;
#pragma unroll
        for (int e = 0; e < 4; ++e) o[e] = pk2(ts[(k8 * 8 + 2 * e) * 260 + nn], ts[(k8 * 8 + 2 * e + 1) * 260 + nn]);
        *(u32x4*)(Wt + (size_t)(n0 + nn) * 1024 + k0 + k8 * 8) = o; }
    __syncthreads();
}
DEV void p0_convert(const float* src, bf16_t* dst, int item) {
    const int tid = tidx();
#pragma unroll
    for (int i = 0; i < 8; ++i) {
        const size_t e = (size_t)item * 16384 + (size_t)(i * NT + tid) * 4;
        const f32x4 v = *(const f32x4*)(src + e);
        u32x2 o; o[0] = pk2(v[0], v[1]); o[1] = pk2(v[2], v[3]);
        *(u32x2*)(dst + e) = o;
    }
}
typedef float f32x2 __attribute__((ext_vector_type(2)));
typedef float f32x32 __attribute__((ext_vector_type(32)));
typedef unsigned u32x6 __attribute__((ext_vector_type(6)));
DEV void p0_table(const Params& p, int tab, int item) {
    const int lane = tidx() & 63, li = lane & 31, half = lane >> 5, layer = tab >> 1, isv = tab & 1;
#pragma unroll 1
    for (int pass = 0; pass < 2; ++pass) {
        const int row = item * 32 + pass * 16 + (tidx() >> 6) * 2 + half;
        const float* src = (isv ? p.in[I_PV] : p.in[I_PU]) + ((size_t)layer * 16384 + row) * 1024 + li * 32;
        f32x4 v[8]; float mx = 0.f;
#pragma unroll
        for (int i = 0; i < 8; ++i) { v[i] = *(const f32x4*)(src + 4 * i); mx = fmaxf(mx, fmaxf(fmaxf(fabsf(v[i][0]), fabsf(v[i][1])), fmaxf(fabsf(v[i][2]), fabsf(v[i][3])))); }
#pragma unroll
        for (int m = 16; m >= 1; m >>= 1) mx = fmaxf(mx, __shfl_xor(mx, m));
        const float top = isv ? 6.f : 7.5f;
        const float sc = mx > 0.f ? top / mx : 1.f;
        if (!isv) {
            f32x16 pa, pb;
#pragma unroll
            for (int i = 0; i < 16; ++i) { pa[i] = 0.f; pb[i] = 0.f; }
            pa[1] = 1.0f;
            const f32x32 pr = __builtin_amdgcn_cvt_scalef32_pk32_f32_fp6(__builtin_amdgcn_cvt_scalef32_2xpk16_fp6_f32(pa, pb, 1.0f), 1.0f);
            const bool inter = pr[2] == 1.0f;
            f32x16 lo, hi;
#pragma unroll
            for (int i = 0; i < 4; ++i)
#pragma unroll
                for (int e = 0; e < 4; ++e) {
                    const int j = 4 * i + e;
                    const float lin_lo = v[i][e], lin_hi = v[4 + i][e];
                    const float il_lo = v[(2 * j) >> 2][(2 * j) & 3], il_hi = v[(2 * j + 1) >> 2][(2 * j + 1) & 3];
                    lo[j] = (inter ? il_lo : lin_lo) * sc; hi[j] = (inter ? il_hi : lin_hi) * sc;
                }
            const u32x6 w = __builtin_amdgcn_cvt_scalef32_2xpk16_fp6_f32(lo, hi, 1.0f);
            unsigned char* dst = p.ws + WS_U6 + ((size_t)layer * 16384 + row) * 768;
            u32x4 w0; w0[0] = w[0]; w0[1] = w[1]; w0[2] = w[2]; w0[3] = w[3]; u32x2 w1; w1[0] = w[4]; w1[1] = w[5];
            *(u32x4*)(dst + li * 16) = w0; *(u32x2*)(dst + 512 + li * 8) = w1;
        } else {
            const f32x2 pr4 = __builtin_amdgcn_cvt_scalef32_pk_f32_fp4(__builtin_amdgcn_cvt_scalef32_pk_fp4_f32(0u, 1.0f, 0.0f, 1.0f, 0), 1.0f, 0);
            const bool swp = pr4[0] != 1.0f;
            u32x4 w;
#pragma unroll
            for (int d = 0; d < 4; ++d) { unsigned x = 0u;
                x = __builtin_amdgcn_cvt_scalef32_pk_fp4_f32(x, (swp ? v[2 * d][1] : v[2 * d][0]) * sc, (swp ? v[2 * d][0] : v[2 * d][1]) * sc, 1.0f, 0);
                x = __builtin_amdgcn_cvt_scalef32_pk_fp4_f32(x, (swp ? v[2 * d][3] : v[2 * d][2]) * sc, (swp ? v[2 * d][2] : v[2 * d][3]) * sc, 1.0f, 1);
                x = __builtin_amdgcn_cvt_scalef32_pk_fp4_f32(x, (swp ? v[2 * d + 1][1] : v[2 * d + 1][0]) * sc, (swp ? v[2 * d + 1][0] : v[2 * d + 1][1]) * sc, 1.0f, 2);
                x = __builtin_amdgcn_cvt_scalef32_pk_fp4_f32(x, (swp ? v[2 * d + 1][3] : v[2 * d + 1][2]) * sc, (swp ? v[2 * d + 1][2] : v[2 * d + 1][3]) * sc, 1.0f, 3);
                w[d] = x; }
            *(u32x4*)(p.ws + WS_V4 + ((size_t)layer * 16384 + row) * 512 + li * 16) = w;
        }
        if (li == 0) ((float*)(p.ws + WS_S8))[tab * 16384 + row] = mx > 0.f ? mx / top : 1.f;
    }
}
DEV void p0_filter(const Params& p, int set, int chunk, int cb, unsigned char* smem) {
    const int Ls = set ? LC : L, l0 = chunk * 64, tid = tidx();
    float* z = (float*)smem;
    float* hd1 = z + 64 * 34;
    float* hd2 = hd1 + 64 * 65;
    const float* w1 = p.in[I_HYW1]; const float* b1 = p.in[I_HYB1]; const float* w2 = p.in[I_HYW2]; const float* b2 = p.in[I_HYB2];
    const float* w3 = p.in[I_HYW3]; const float* fq = p.in[I_HYFREQ];
    for (int i = tid; i < 64 * 33; i += NT) {
        const int pp = i / 33, f = i % 33, l = l0 + pp; float val;
        if (f == 0) val = (float)l / (float)(Ls - 1);
        else { const int jb = (f - 1) & 15; const float fj = 1e-4f + (float)jb * ((15.f - 1e-4f) / 15.f); const float a = fj * (6.283185307179586f * (float)l / (float)Ls); val = f <= 16 ? __cosf(a) : -__sinf(a); }
        z[pp * 34 + f] = val;
    }
    __syncthreads();
    {
        const int j = tid & 63, p0 = tid >> 6;
        float wc[64], acc[8];
#pragma unroll
        for (int f = 0; f < 33; ++f) wc[f] = w1[f * 64 + j];
#pragma unroll
        for (int m = 0; m < 8; ++m) { float sacc = b1[j];
#pragma unroll
            for (int f = 0; f < 33; ++f) sacc = fmaf(z[(p0 + 8 * m) * 34 + f], wc[f], sacc);
            acc[m] = sacc; }
#pragma unroll
        for (int m = 0; m < 8; ++m) hd1[(p0 + 8 * m) * 65 + j] = __sinf(fq[j] * acc[m]);
        __syncthreads();
#pragma unroll
        for (int f = 0; f < 64; ++f) wc[f] = w2[f * 64 + j];
#pragma unroll
        for (int m = 0; m < 8; ++m) { float sacc = b2[j];
#pragma unroll
            for (int f = 0; f < 64; ++f) sacc = fmaf(hd1[(p0 + 8 * m) * 65 + f], wc[f], sacc);
            acc[m] = sacc; }
#pragma unroll
        for (int m = 0; m < 8; ++m) hd2[(p0 + 8 * m) * 65 + j] = __sinf(fq[j] * acc[m]);
        __syncthreads();
    }
    const float max_decay = -15.350567286626973f, min_decay = -3.0701134573253945f;
    float* hraw = (float*)(p.ws + WS_F + (set ? F_HRAW_CTX : F_HRAW_LAT));
    float* hyn = (float*)(p.ws + WS_F + (set ? F_HYP_CTX : F_HYP_LAT)) + (size_t)chunk * 2048;
    {
        const int o = cb * NT + tid;
        const int c = o & 511; const float delta = fabsf(min_decay + (float)c * ((max_decay - min_decay) / 511.f));
        float asum = 0.f;
        float* dst = hraw + (size_t)o * Ls + l0;
        for (int ph = 0; ph < 2; ++ph) {
            float acc[32];
#pragma unroll
            for (int pp = 0; pp < 32; ++pp) acc[pp] = 0.f;
#pragma unroll 1
            for (int j0 = 0; j0 < 64; j0 += 16) {
                float wv[16];
#pragma unroll
                for (int j = 0; j < 16; ++j) wv[j] = w3[(j0 + j) * 2048 + o];
#pragma unroll
                for (int j = 0; j < 16; ++j) {
#pragma unroll
                    for (int pp = 0; pp < 32; ++pp) acc[pp] = fmaf(hd2[(ph * 32 + pp) * 65 + j0 + j], wv[j], acc[pp]);
                    SCHED_FENCE();
                }
            }
#pragma unroll
            for (int q4 = 0; q4 < 8; ++q4) {
                f32x4 v;
#pragma unroll
                for (int e = 0; e < 4; ++e) { const int pp = q4 * 4 + e; const float tl = (float)(l0 + ph * 32 + pp) / (float)(Ls - 1); const float val = acc[pp] * expf(-tl * delta); v[e] = val; asum += fabsf(val); }
                *(f32x4*)(dst + ph * 32 + q4 * 4) = v;
            }
        }
        hyn[o] = asum;
    }
    __syncthreads();
}

constexpr int P0_MOD = 192, P0_TR_IN0 = 16 * 9, P0_TR_OUT0 = 64, P0_TR_IN1 = 16 * 20, P0_TR_OUT1 = 64, P0_TR_Q = 16 * 8, P0_KEYS = 32, P0_TAB = 512,
              P0_FILT = 4 * (L / 64 + LC / 64);
DEV void phase0(const Params& p, unsigned char* smem) {
    bf16_t* W = (bf16_t*)(p.ws + WS_W);
    const int total = P0_MOD + P0_FILT + P0_TR_IN0 + P0_TR_OUT0 + P0_TR_IN1 + P0_TR_OUT1 + 2 * P0_TR_Q + P0_KEYS;
    for (int it = blockIdx.x; it < total; it += gridDim.x) {
        int i = it;
        if (i < P0_MOD) { p0_mod(p, i, smem); continue; } i -= P0_MOD;
        if (i < P0_FILT) { const int ch = i >> 2, cb = i & 3; if (ch < L / 64) p0_filter(p, 0, ch, cb, smem); else p0_filter(p, 1, ch - L / 64, cb, smem); continue; } i -= P0_FILT;
        if (i < P0_TR_IN0) { p0_transpose(p.in[I_ABWIN], W + W_IN0 / 2, 2304, i, smem); continue; } i -= P0_TR_IN0;
        if (i < P0_TR_OUT0) { p0_transpose(p.in[I_ABWOUT], W + W_OUT0 / 2, 1024, i, smem); continue; } i -= P0_TR_OUT0;
        if (i < P0_TR_IN1) { p0_transpose(p.in[I_HGWIN], W + W_IN1 / 2, 5120, i, smem); continue; } i -= P0_TR_IN1;
        if (i < P0_TR_OUT1) { p0_transpose(p.in[I_HGWOUT], W + W_OUT1 / 2, 1024, i, smem); continue; } i -= P0_TR_OUT1;
        if (i < P0_TR_Q) { p0_transpose(p.in[I_PWQ], W + W_Q0 / 2, 2048, i, smem); continue; } i -= P0_TR_Q;
        if (i < P0_TR_Q) { p0_transpose(p.in[I_PWQ] + (size_t)1024 * 2048, W + W_Q1 / 2, 2048, i, smem); continue; } i -= P0_TR_Q;
        p0_convert(p.in[I_PKEYS], W + W_KEYS / 2, i);
    }
}

DEV const float* h_row(const Params& p, int layer_src_inputs, int tok) {
    if (layer_src_inputs) return tok < TL ? p.in[I_X] + (size_t)tok * 1024 : p.in[I_CTX] + (size_t)(tok - TL) * 1024;
    return (const float*)(p.ws + WS_H) + (size_t)tok * 1024;
}
DEV void norm_row_store(const Params& p, const f32x4 (&v)[4], int tok, const float* g, int layer, int sh_off, int lane) {
    float ss = 0.f;
#pragma unroll
    for (int i = 0; i < 4; ++i) ss += v[i][0] * v[i][0] + v[i][1] * v[i][1] + v[i][2] * v[i][2] + v[i][3] * v[i][3];
    ss = wave_sum(ss);
    const float rstd = rsqrtf(ss * (1.f / 1024.f) + 1e-6f);
    const float* mod = (const float*)(p.ws + WS_MOD) + ((size_t)layer * NR + mod_row(tok)) * 6144 + sh_off;
    bf16_t* A = (bf16_t*)(p.ws + WS_A) + (size_t)tok * 1024;
#pragma unroll
    for (int i = 0; i < 4; ++i) {
        const int c = i * 256 + lane * 4;
        const f32x4 gg = *(const f32x4*)(g + c), sh = *(const f32x4*)(mod + c), sc = *(const f32x4*)(mod + 1024 + c);
        u32x2 o;
        o[0] = pk2(v[i][0] * rstd * gg[0] * (1.f + sc[0]) + sh[0], v[i][1] * rstd * gg[1] * (1.f + sc[1]) + sh[1]);
        o[1] = pk2(v[i][2] * rstd * gg[2] * (1.f + sc[2]) + sh[2], v[i][3] * rstd * gg[3] * (1.f + sc[3]) + sh[3]);
        *(u32x2*)(A + c) = o;
    }
}
DEV void norm_rows_item(const Params& p, int item, int from_inputs, const float* g, int layer, int sh_off) {
    const int tok = item * 8 + (tidx() >> 6), lane = tidx() & 63;
    const float* src = h_row(p, from_inputs, tok);
    f32x4 v[4];
#pragma unroll
    for (int i = 0; i < 4; ++i) v[i] = *(const f32x4*)(src + i * 256 + lane * 4);
    norm_row_store(p, v, tok, g, layer, sh_off, lane);
}

DEV cf2 cmul(cf2 a, cf2 b) { cf2 r; r.x = a.x * b.x - a.y * b.y; r.y = a.x * b.y + a.y * b.x; return r; }
DEV cf2 twid(int k, float invN) { cf2 r; const float a = (float)k * invN; r.x = __builtin_amdgcn_cosf(a); r.y = -__builtin_amdgcn_sinf(a); return r; }
DEV int fsw(int i) { return i ^ ((i >> 4) & 15) ^ (((i >> 8) & 1) << 4); }
DEV void bfly4_fwd(cf2& a0, cf2& a1, cf2& a2, cf2& a3) {
    cf2 t0, t1, t2, t3; t0.x = a0.x + a2.x; t0.y = a0.y + a2.y; t1.x = a0.x - a2.x; t1.y = a0.y - a2.y; t2.x = a1.x + a3.x; t2.y = a1.y + a3.y;
    const float dx = a1.x - a3.x, dy = a1.y - a3.y; t3.x = dy; t3.y = -dx;
    a0.x = t0.x + t2.x; a0.y = t0.y + t2.y; a1.x = t1.x + t3.x; a1.y = t1.y + t3.y; a2.x = t0.x - t2.x; a2.y = t0.y - t2.y; a3.x = t1.x - t3.x; a3.y = t1.y - t3.y;
}
DEV void bfly4_inv(cf2& c0, cf2& c1, cf2& c2, cf2& c3) {
    cf2 t0, t1, t2, t3; t0.x = c0.x + c2.x; t0.y = c0.y + c2.y; t1.x = c0.x - c2.x; t1.y = c0.y - c2.y; t2.x = c1.x + c3.x; t2.y = c1.y + c3.y;
    const float dx = c1.x - c3.x, dy = c1.y - c3.y; t3.x = -dy; t3.y = dx;
    c0.x = t0.x + t2.x; c0.y = t0.y + t2.y; c1.x = t1.x + t3.x; c1.y = t1.y + t3.y; c2.x = t0.x - t2.x; c2.y = t0.y - t2.y; c3.x = t1.x - t3.x; c3.y = t1.y - t3.y;
}
DEV void fft_stage4(cf2* buf, int S, int s, int g, int G, bool inv) {
    const int N = 1 << (2 * S); const float invN = 1.f / (float)N;
    const int lm = 2 * (S - s), m = 1 << lm, q = m >> 2;
    for (int bf = g; bf < (N >> 2); bf += G) {
        const int j = bf & (q - 1), base = ((bf >> (lm - 2)) << lm) + j, tw = j << (2 * s);
        cf2 a0 = buf[fsw(base)], a1 = buf[fsw(base + q)], a2 = buf[fsw(base + 2 * q)], a3 = buf[fsw(base + 3 * q)];
        if (!inv) { bfly4_fwd(a0, a1, a2, a3); a1 = cmul(a1, twid(tw, invN)); a2 = cmul(a2, twid(2 * tw, invN)); a3 = cmul(a3, twid(3 * tw, invN)); }
        else { cf2 w1 = twid(tw, invN), w2 = twid(2 * tw, invN), w3 = twid(3 * tw, invN); w1.y = -w1.y; w2.y = -w2.y; w3.y = -w3.y; a1 = cmul(a1, w1); a2 = cmul(a2, w2); a3 = cmul(a3, w3); bfly4_inv(a0, a1, a2, a3); }
        buf[fsw(base)] = a0; buf[fsw(base + q)] = a1; buf[fsw(base + 2 * q)] = a2; buf[fsw(base + 3 * q)] = a3;
    }
}
DEV void fft_stage16(cf2* buf, int S, int s, int g, int G, bool inv) {
    const int N = 1 << (2 * S); const float invN = 1.f / (float)N;
    const int lm = 2 * (S - s), m = 1 << lm, q = m >> 2, q2 = q >> 2;
    for (int u = g; u < (N >> 4); u += G) {
        const int j2 = u & (q2 - 1), base = ((u >> (lm - 4)) << lm) + j2;
        cf2 x[4][4];
#pragma unroll
        for (int c = 0; c < 4; ++c)
#pragma unroll
            for (int c2 = 0; c2 < 4; ++c2) x[c][c2] = buf[fsw(base + c * q + c2 * q2)];
        if (!inv) {
#pragma unroll
            for (int c2 = 0; c2 < 4; ++c2) {
                const int tw = (j2 + c2 * q2) << (2 * s);
                bfly4_fwd(x[0][c2], x[1][c2], x[2][c2], x[3][c2]);
                x[1][c2] = cmul(x[1][c2], twid(tw, invN)); x[2][c2] = cmul(x[2][c2], twid(2 * tw, invN)); x[3][c2] = cmul(x[3][c2], twid(3 * tw, invN));
            }
            const int tw2 = j2 << (2 * (s + 1));
            const cf2 v1 = twid(tw2, invN), v2 = twid(2 * tw2, invN), v3 = twid(3 * tw2, invN);
#pragma unroll
            for (int c = 0; c < 4; ++c) {
                bfly4_fwd(x[c][0], x[c][1], x[c][2], x[c][3]);
                x[c][1] = cmul(x[c][1], v1); x[c][2] = cmul(x[c][2], v2); x[c][3] = cmul(x[c][3], v3);
            }
        } else {
            const int tw2 = j2 << (2 * (s + 1));
            cf2 v1 = twid(tw2, invN), v2 = twid(2 * tw2, invN), v3 = twid(3 * tw2, invN); v1.y = -v1.y; v2.y = -v2.y; v3.y = -v3.y;
#pragma unroll
            for (int c = 0; c < 4; ++c) {
                x[c][1] = cmul(x[c][1], v1); x[c][2] = cmul(x[c][2], v2); x[c][3] = cmul(x[c][3], v3);
                bfly4_inv(x[c][0], x[c][1], x[c][2], x[c][3]);
            }
#pragma unroll
            for (int c2 = 0; c2 < 4; ++c2) {
                const int tw = (j2 + c2 * q2) << (2 * s);
                cf2 w1 = twid(tw, invN), w2 = twid(2 * tw, invN), w3 = twid(3 * tw, invN); w1.y = -w1.y; w2.y = -w2.y; w3.y = -w3.y;
                x[1][c2] = cmul(x[1][c2], w1); x[2][c2] = cmul(x[2][c2], w2); x[3][c2] = cmul(x[3][c2], w3);
                bfly4_inv(x[0][c2], x[1][c2], x[2][c2], x[3][c2]);
            }
        }
#pragma unroll
        for (int c = 0; c < 4; ++c)
#pragma unroll
            for (int c2 = 0; c2 < 4; ++c2) buf[fsw(base + c * q + c2 * q2)] = x[c][c2];
    }
}
DEV void fft_fwd(cf2* buf, int S, int g, int G) {
    int s = 0;
    for (; s + 1 < S; s += 2) { fft_stage16(buf, S, s, g, G, false); __syncthreads(); }
    if (s < S) { fft_stage4(buf, S, s, g, G, false); __syncthreads(); }
}
DEV void fft_inv(cf2* buf, int S, int g, int G) {
    int s = S - 1;
    if (S & 1) { fft_stage4(buf, S, s, g, G, true); __syncthreads(); --s; }
    for (; s >= 1; s -= 2) { fft_stage16(buf, S, s - 1, g, G, true); __syncthreads(); }
}
DEV void hf_item(const Params& p, int set, int pi, unsigned char* smem) {
    const int Ls = set ? LC : L, S = set ? FS_CTX : FS_LAT, N = 1 << (2 * S);
    const int gi = tidx() >> 8, g = tidx() & 255, idx = pi * 2 + gi, o = idx >> 9, c = idx & 511;
    cf2* buf = (cf2*)smem + (size_t)gi * N;
    const float* hraw = (const float*)(p.ws + WS_F + (set ? F_HRAW_CTX : F_HRAW_LAT));
    const float* hyn = (const float*)(p.ws + WS_F + (set ? F_HYP_CTX : F_HYP_LAT));
    float nsum = 0.f;
    for (int ch = 0; ch < Ls / 64; ++ch) nsum += hyn[(size_t)ch * 2048 + o * 1024 + c] + hyn[(size_t)ch * 2048 + o * 1024 + 512 + c];
    const float inv = 1.f / nsum;
    const float* hf = hraw + (size_t)(o * 1024 + c) * Ls; const float* hb = hraw + (size_t)(o * 1024 + 512 + c) * Ls;
#pragma unroll 4
    for (int k = g; k < N; k += 256) { float re = 0.f; if (k < Ls) re = hf[k] * inv; else if (k > N - Ls) re = hb[N - k] * inv; cf2 v; v.x = re; v.y = 0.f; buf[fsw(k)] = v; }
    __syncthreads();
    fft_fwd(buf, S, g, 256);
    cf2* HF = (cf2*)(p.ws + WS_F + (set ? F_HF_CTX : F_HF_LAT)) + (size_t)(o * 512 + c) * N;
    for (int k = g; k < N; k += 256) HF[k] = buf[fsw(k)];
    __syncthreads();
}
constexpr int P1_NORM = T / 8, P1_HF = 512;
DEV void phase1(const Params& p, unsigned char* smem) {
    const int total = P1_NORM + 2 * P1_HF;
    for (int it = blockIdx.x; it < total; it += gridDim.x) {
        if (it < P1_NORM) norm_rows_item(p, it, 1, p.in[I_N1G], 0, 0);
        else if (it < P1_NORM + P1_HF) hf_item(p, 0, it - P1_NORM, smem);
        else hf_item(p, 1, it - P1_NORM - P1_HF, smem);
    }
}

constexpr int G_LDA = 72;
template <class Epi>
DEV void gemm_tile(const bf16_t* __restrict__ A, const bf16_t* __restrict__ Wt, int m0, int n0, unsigned char* smem, const Epi& epi, int var = 0) {
    bf16_t* As = (bf16_t*)smem;
    bf16_t* Bs = As + 2 * 256 * G_LDA;
    const int tid = tidx(), lane = tid & 63, w = tid >> 6, wm = w >> 1, wn = w & 1;
    f32x16 acc[2][2];
#pragma unroll
    for (int i = 0; i < 2; ++i)
#pragma unroll
        for (int j = 0; j < 2; ++j)
#pragma unroll
            for (int r = 0; r < 16; ++r) acc[i][j][r] = 0.f;
    u32x4 ra[4], rb[2];
    const bf16_t* Ag = A + (size_t)m0 * 1024; const bf16_t* Bg = Wt + (size_t)n0 * 1024;
#define GLOAD(k0) do { \
        _Pragma("unroll") for (int i = 0; i < 4; ++i) { const int id = tid + NT * i, row = id >> 3, kc = id & 7; ra[i] = *(const u32x4*)(Ag + (size_t)row * 1024 + (k0) + kc * 8); } \
        _Pragma("unroll") for (int i = 0; i < 2; ++i) { const int id = tid + NT * i, row = id >> 3, kc = id & 7; rb[i] = *(const u32x4*)(Bg + (size_t)row * 1024 + (k0) + kc * 8); } } while (0)
#define LSTORE(buf_) do { \
        _Pragma("unroll") for (int i = 0; i < 4; ++i) { const int id = tid + NT * i, row = id >> 3, kc = id & 7; *(u32x4*)(As + ((buf_) * 256 + row) * G_LDA + kc * 8) = ra[i]; } \
        _Pragma("unroll") for (int i = 0; i < 2; ++i) { const int id = tid + NT * i, row = id >> 3, kc = id & 7; *(u32x4*)(Bs + ((buf_) * 128 + row) * G_LDA + kc * 8) = rb[i]; } } while (0)
    GLOAD(0); LSTORE(0); __syncthreads();
    for (int kt = 0; kt < (var == 2 ? 1 : 16); ++kt) {
        const int buf = kt & 1;
        if (kt + 1 < 16) GLOAD((kt + 1) * 64);
        const bf16_t* as = As + (buf * 256 + wm * 64 + (lane & 31)) * G_LDA + 8 * (lane >> 5);
        const bf16_t* bs = Bs + (buf * 128 + wn * 64 + (lane & 31)) * G_LDA + 8 * (lane >> 5);
#pragma unroll
        for (int kk = 0; kk < 4; ++kk) {
            const bf16x8 a0 = *(const bf16x8*)(as + kk * 16), a1 = *(const bf16x8*)(as + 32 * G_LDA + kk * 16);
            const bf16x8 b0 = *(const bf16x8*)(bs + kk * 16), b1 = *(const bf16x8*)(bs + 32 * G_LDA + kk * 16);
            acc[0][0] = __builtin_amdgcn_mfma_f32_32x32x16_bf16(a0, b0, acc[0][0], 0, 0, 0);
            acc[0][1] = __builtin_amdgcn_mfma_f32_32x32x16_bf16(a0, b1, acc[0][1], 0, 0, 0);
            acc[1][0] = __builtin_amdgcn_mfma_f32_32x32x16_bf16(a1, b0, acc[1][0], 0, 0, 0);
            acc[1][1] = __builtin_amdgcn_mfma_f32_32x32x16_bf16(a1, b1, acc[1][1], 0, 0, 0);
        }
        if (kt + 1 < 16) LSTORE(buf ^ 1);
        __syncthreads();
    }
#ifndef HOST_EMU
    if (var == 1) { asm volatile("" :: "v"(acc[0][0]), "v"(acc[0][1]), "v"(acc[1][0]), "v"(acc[1][1])); return; }
#endif
#pragma unroll
    for (int mi = 0; mi < 2; ++mi)
#pragma unroll
        for (int ni = 0; ni < 2; ++ni)
#pragma unroll
            for (int rg = 0; rg < 4; ++rg) {
                const int row = m0 + wm * 64 + mi * 32 + 8 * rg + 4 * (lane >> 5), col = n0 + wn * 64 + ni * 32 + (lane & 31);
                epi(row, col, acc[mi][ni][rg * 4 + 0], acc[mi][ni][rg * 4 + 1], acc[mi][ni][rg * 4 + 2], acc[mi][ni][rg * 4 + 3]);
            }
}
template <class Epi>
DEV void gemm_tile256(const bf16_t* __restrict__ A, const bf16_t* __restrict__ Wt, int m0, int n0, unsigned char* smem, const Epi& epi) {
    bf16_t* As = (bf16_t*)smem;
    bf16_t* Bs = As + 2 * 256 * G_LDA;
    const int tid = tidx(), lane = tid & 63, w = tid >> 6, wm = w >> 2, wn = w & 3;
    f32x16 acc[4][2];
#pragma unroll
    for (int i = 0; i < 4; ++i)
#pragma unroll
        for (int j = 0; j < 2; ++j)
#pragma unroll
            for (int r = 0; r < 16; ++r) acc[i][j][r] = 0.f;
    u32x4 ra[4], rb[4];
    const bf16_t* Ag = A + (size_t)m0 * 1024; const bf16_t* Bg = Wt + (size_t)n0 * 1024;
#define GLOAD2(k0) do { \
        _Pragma("unroll") for (int i = 0; i < 4; ++i) { const int id = tid + NT * i, row = id >> 3, kc = id & 7; ra[i] = *(const u32x4*)(Ag + (size_t)row * 1024 + (k0) + kc * 8); rb[i] = *(const u32x4*)(Bg + (size_t)row * 1024 + (k0) + kc * 8); } } while (0)
#define LSTORE2(buf_) do { \
        _Pragma("unroll") for (int i = 0; i < 4; ++i) { const int id = tid + NT * i, row = id >> 3, kc = id & 7; *(u32x4*)(As + ((buf_) * 256 + row) * G_LDA + kc * 8) = ra[i]; *(u32x4*)(Bs + ((buf_) * 256 + row) * G_LDA + kc * 8) = rb[i]; } } while (0)
    GLOAD2(0); LSTORE2(0); __syncthreads();
    for (int kt = 0; kt < 16; ++kt) {
        const int buf = kt & 1;
        if (kt + 1 < 16) GLOAD2((kt + 1) * 64);
        const bf16_t* as = As + (buf * 256 + wm * 128 + (lane & 31)) * G_LDA + 8 * (lane >> 5);
        const bf16_t* bs = Bs + (buf * 256 + wn * 64 + (lane & 31)) * G_LDA + 8 * (lane >> 5);
#pragma unroll
        for (int kk = 0; kk < 4; ++kk) {
            bf16x8 af[4], bfr[2];
#pragma unroll
            for (int i = 0; i < 4; ++i) af[i] = *(const bf16x8*)(as + i * 32 * G_LDA + kk * 16);
#pragma unroll
            for (int j = 0; j < 2; ++j) bfr[j] = *(const bf16x8*)(bs + j * 32 * G_LDA + kk * 16);
#pragma unroll
            for (int i = 0; i < 4; ++i)
#pragma unroll
                for (int j = 0; j < 2; ++j) acc[i][j] = __builtin_amdgcn_mfma_f32_32x32x16_bf16(af[i], bfr[j], acc[i][j], 0, 0, 0);
        }
        if (kt + 1 < 16) LSTORE2(buf ^ 1);
        __syncthreads();
    }
#undef GLOAD2
#undef LSTORE2
#pragma unroll
    for (int mi = 0; mi < 4; ++mi)
#pragma unroll
        for (int ni = 0; ni < 2; ++ni)
#pragma unroll
            for (int rg = 0; rg < 4; ++rg) {
                const int row = m0 + wm * 128 + mi * 32 + 8 * rg + 4 * (lane >> 5), col = n0 + wn * 64 + ni * 32 + (lane & 31);
                epi(row, col, acc[mi][ni][rg * 4 + 0], acc[mi][ni][rg * 4 + 1], acc[mi][ni][rg * 4 + 2], acc[mi][ni][rg * 4 + 3]);
            }
}
namespace pg8 {
#ifndef HOST_EMU
#define PG8_LAS __attribute__((address_space(3)))
#else
#define PG8_LAS
#endif
typedef unsigned short bf16_t;
constexpr int BM = 256, BK = 64, HALF = 128, HTB = HALF * BK * 2  , STAGE_BYTES = 8 * HTB, NXCD = 8, WGM = 8;

__host__ __device__ __forceinline__ int lds_byte(int r, int c) { const int st = (r >> 4) * 2 + (c >> 5), rr = r & 15, cc = c & 31, ob = rr * 64 + cc * 2; return st * 1024 + (ob ^ (((ob >> 9) & 1) << 5)); }
__host__ __device__ __forceinline__ void stage_rc(int b, int& R, int& C) { const int st = b / 1024, sb = b % 1024, swz = sb ^ (((sb >> 9) & 1) << 5); R = (st >> 1) * 16 + swz / 64; C = (st & 1) * 32 + (swz % 64) / 2; }
__host__ __device__ __forceinline__ int perm32(int rho) { const int n = rho >> 4, i = rho & 15; return 8 * (i >> 2) + 4 * n + (i & 3); }

struct Unit { int pm, pn; };
struct Gemm { const bf16_t* A; const bf16_t* Bt; int M, N, K; };

struct StaticOrder {
    int nM, nN, nwg, G, c;
    __host__ __device__ void init(int M, int N, int G_, int c_) { nM = M / BM; nN = N / BM; nwg = nM * nN; G = G_; c = c_; }
    __host__ __device__ bool next(int i, Unit& u) const {
        const long L = (long)i * G + c; if (L >= nwg) return false;
        int wgid = (int)L; { const int q = nwg / NXCD, r = nwg % NXCD, xcd = wgid % NXCD, off = wgid / NXCD; wgid = (xcd < r ? xcd * (q + 1) : r * (q + 1) + (xcd - r) * q) + off; }
        const int nig = WGM * nN, gid = wgid / nig, fm = gid * WGM, gsz = (nM - fm) < WGM ? (nM - fm) : WGM;
        u.pm = fm + ((wgid % nig) % gsz); u.pn = (wgid % nig) / gsz; return true;
    }
    __device__ __forceinline__ void a_ready(const Unit&) const {}
    __device__ __forceinline__ void done(const Unit&) const {}
};
template <class Epi, class Sched, bool STAMP = false>
__device__ __forceinline__ void gemm_phase(PG8_LAS unsigned char* lds, const Gemm g, const Sched& S, const Epi& E, unsigned long long* stamps = nullptr) {
    const int tid = tidx(), wid = __builtin_amdgcn_readfirstlane(tid >> 6), lane = tid & 63, wr = wid >> 2, wc = wid & 3, fr = lane & 15, fq = lane >> 4;
    const int K = g.K, nt = K / BK;
    int ts_lo = 0, ts_hi = 0, nts = 0; const unsigned long long rt_entry = 0ull; (void)rt_entry; (void)ts_lo; (void)ts_hi; (void)nts;
#define PG8_STAMP() do { if (STAMP && wid == 0 && nts < 64) { const unsigned long long _c = 0ull; \
        ts_lo = (lane == nts) ? (int)(unsigned)_c : ts_lo; ts_hi = (lane == nts) ? (int)(unsigned)(_c >> 32) : ts_hi; ++nts; } } while (0)
    PG8_STAMP();
    unsigned voffA[2], voffB[2];
#pragma unroll
    for (int i = 0; i < 2; ++i) { int R, C; stage_rc(tid * 16 + i * 8192, R, C); const int Rb = Epi::PERM ? ((R & ~31) + perm32(R & 31)) : R;
        voffA[i] = (unsigned)(R * K + C) * 2u; voffB[i] = (unsigned)(Rb * K + C) * 2u; }
    const size_t kstep = (size_t)(BK * 2);
    const size_t hstep = (size_t)HALF * K * 2;
    const size_t tstep = 2 * hstep;
    const unsigned ldsw = (unsigned)wid * 1024u;
    const int aoff = lds_byte(wr * 64 + fr, fq * 8), boff = lds_byte(wc * 32 + fr, fq * 8);
#define PG8_SA(b, h) (((b) * 2 + (h)) * HTB)
#define PG8_SB(b, h) ((4 + (b) * 2 + (h)) * HTB)
#define PG8_STAGE(bufoff, gbase, voff) do { _Pragma("unroll") for (int _i = 0; _i < 2; ++_i) \
        __builtin_amdgcn_global_load_lds((const unsigned*)((const char*)(gbase) + (voff)[_i]), (PG8_LAS unsigned*)(lds + (bufoff) + ldsw + _i * 8192), 16, 0, 0); } while (0)
#define PG8_LDA(dst, b, h) do { _Pragma("unroll") for (int m = 0; m < 4; ++m) _Pragma("unroll") for (int k = 0; k < 2; ++k) dst[m][k] = *(const PG8_LAS bf16x8*)(lds + PG8_SA(b, h) + aoff + m * 2048 + k * 1024); } while (0)
#define PG8_LDB(dst, b, h) do { _Pragma("unroll") for (int n = 0; n < 2; ++n) _Pragma("unroll") for (int k = 0; k < 2; ++k) dst[n][k] = *(const PG8_LAS bf16x8*)(lds + PG8_SB(b, h) + boff + n * 2048 + k * 1024); } while (0)
#define PG8_MMA(ai, bj, At, Bt) do { __builtin_amdgcn_s_setprio(1); _Pragma("unroll") for (int m = 0; m < 4; ++m) _Pragma("unroll") for (int n = 0; n < 2; ++n) _Pragma("unroll") for (int k = 0; k < 2; ++k) \
        acc[ai][bj][m][n] = __builtin_amdgcn_mfma_f32_16x16x32_bf16(Bt[n][k], At[m][k], acc[ai][bj][m][n], 0, 0, 0); __builtin_amdgcn_s_setprio(0); } while (0)
#ifndef HOST_EMU
#define PG8_WAIT_V(n) asm volatile("s_waitcnt vmcnt(" #n ")" ::: "memory")
#define PG8_WAIT_L(n) asm volatile("s_waitcnt lgkmcnt(" #n ")" ::: "memory")
#else
#define PG8_WAIT_V(n) do {} while (0)
#define PG8_WAIT_L(n) do {} while (0)
#endif
#define PG8_BAR __builtin_amdgcn_s_barrier()
#define PG8_SCHED __builtin_amdgcn_sched_barrier(0)
    Unit cur, nxt; int ui = 0;
    if (!S.next(0, cur)) return;
    f32x4 acc[2][2][4][2];
#pragma unroll
    for (int a = 0; a < 2; ++a)
#pragma unroll
        for (int b = 0; b < 2; ++b)
#pragma unroll
            for (int m = 0; m < 4; ++m)
#pragma unroll
                for (int n = 0; n < 2; ++n) acc[a][b][m][n] = (f32x4){0.f, 0.f, 0.f, 0.f};
    bf16x8 At[4][2], B0[2][2], B1[2][2];
    const char* cA = (const char*)g.A + (size_t)cur.pm * tstep; const char* cB = (const char*)g.Bt + (size_t)cur.pn * tstep;
    S.a_ready(cur);
    PG8_STAGE(PG8_SB(0, 0), cB, voffB); PG8_STAGE(PG8_SA(0, 0), cA, voffA); PG8_STAGE(PG8_SB(0, 1), cB + hstep, voffB); PG8_STAGE(PG8_SA(0, 1), cA + hstep, voffA);
    if (wr == 1) PG8_BAR;
    PG8_WAIT_V(4); PG8_BAR;
    PG8_STAGE(PG8_SB(1, 0), cB + kstep, voffB); PG8_STAGE(PG8_SA(1, 0), cA + kstep, voffA); PG8_STAGE(PG8_SB(1, 1), cB + hstep + kstep, voffB);
    PG8_WAIT_V(6); PG8_BAR;
    PG8_STAMP();
    for (;;) {
        const bool has_next = S.next(ui + 1, nxt);
        const char* nA = has_next ? (const char*)g.A + (size_t)nxt.pm * tstep : cA; const char* nB = has_next ? (const char*)g.Bt + (size_t)nxt.pn * tstep : cB;
        for (int t = 0; t < nt; t += 2) {
            const bool last = (t == nt - 2);
            const char* a1 = cA + (size_t)(t + 1) * kstep;
            const char* a2 = last ? nA : cA + (size_t)(t + 2) * kstep; const char* b2 = last ? nB : cB + (size_t)(t + 2) * kstep;
            const char* a3 = a2 + kstep; const char* b3 = b2 + kstep;
            if (last && has_next) S.a_ready(nxt);
            PG8_LDB(B0, 0, 0); PG8_SCHED; PG8_LDA(At, 0, 0); PG8_STAGE(PG8_SA(1, 1), a1 + hstep, voffA);
            PG8_WAIT_L(8); PG8_BAR; PG8_WAIT_L(0); PG8_MMA(0, 0, At, B0); PG8_BAR; PG8_SCHED;
            PG8_LDB(B1, 0, 1); PG8_STAGE(PG8_SB(0, 0), b2, voffB);
            PG8_BAR; PG8_WAIT_L(0); PG8_MMA(0, 1, At, B1); PG8_BAR;
            PG8_LDA(At, 0, 1); PG8_STAGE(PG8_SA(0, 0), a2, voffA);
            PG8_BAR; PG8_WAIT_L(0); PG8_MMA(1, 0, At, B0); PG8_BAR; PG8_SCHED;
            PG8_STAGE(PG8_SB(0, 1), b2 + hstep, voffB);
            PG8_WAIT_V(6); PG8_BAR; PG8_MMA(1, 1, At, B1); PG8_BAR;
            PG8_LDB(B0, 1, 0); PG8_SCHED; PG8_LDA(At, 1, 0); PG8_STAGE(PG8_SA(0, 1), a2 + hstep, voffA);
            PG8_WAIT_L(8); PG8_BAR; PG8_WAIT_L(0); PG8_MMA(0, 0, At, B0); PG8_BAR; PG8_SCHED;
            PG8_LDB(B1, 1, 1); PG8_STAGE(PG8_SB(1, 0), b3, voffB);
            PG8_BAR; PG8_WAIT_L(0); PG8_MMA(0, 1, At, B1); PG8_BAR;
            PG8_LDA(At, 1, 1); PG8_STAGE(PG8_SA(1, 0), a3, voffA);
            PG8_BAR; PG8_WAIT_L(0); PG8_MMA(1, 0, At, B0); PG8_BAR; PG8_SCHED;
            PG8_STAGE(PG8_SB(1, 1), b3 + hstep, voffB);
            PG8_WAIT_V(6); PG8_BAR; PG8_MMA(1, 1, At, B1); PG8_BAR;
        }
        PG8_STAMP();
        if constexpr (!Epi::AFTER_DRAIN) { E(acc, cur, wr, wc, fr, fq); S.done(cur); }
        PG8_STAMP();
        if (!has_next) break;
#pragma unroll
        for (int a = 0; a < 2; ++a)
#pragma unroll
            for (int b = 0; b < 2; ++b)
#pragma unroll
                for (int m = 0; m < 4; ++m)
#pragma unroll
                    for (int n = 0; n < 2; ++n) acc[a][b][m][n] = (f32x4){0.f, 0.f, 0.f, 0.f};
        cur = nxt; cA = nA; cB = nB; ++ui;
    }
    PG8_WAIT_V(0);
    if (wr == 0) PG8_BAR;
    PG8_BAR;
    if constexpr (Epi::AFTER_DRAIN) { E.fused(acc, cur, wr, wc, fr, fq, lds, wid, lane); S.done(cur); }
    PG8_STAMP();
    if (STAMP && wid == 0) { stamps[lane] = lane < nts ? (((unsigned long long)(unsigned)ts_hi << 32) | (unsigned)ts_lo) : 0ull;
        if (lane == 62) stamps[62] = rt_entry; if (lane == 63) stamps[63] = 0ull; }
#undef PG8_STAMP
#undef PG8_SA
#undef PG8_SB
#undef PG8_STAGE
#undef PG8_LDA
#undef PG8_LDB
#undef PG8_MMA
#undef PG8_WAIT_V
#undef PG8_WAIT_L
#undef PG8_BAR
#undef PG8_SCHED
}
}
template <class Epi> struct PgEpiT {
    static constexpr bool PERM = true, AFTER_DRAIN = false;
    Epi e;
    DEV void operator()(const f32x4 (&acc)[2][2][4][2], const pg8::Unit& u, int wr, int wc, int fr, int fq) const {
#pragma unroll
        for (int ai = 0; ai < 2; ++ai)
#pragma unroll
            for (int m = 0; m < 4; ++m) {
#pragma unroll
                for (int bj = 0; bj < 2; ++bj) {
                    const int wcol = u.pm * 256 + ai * 128 + wr * 64 + m * 16 + fr, tok0 = u.pn * 256 + bj * 128 + wc * 32 + 8 * fq;
                    const float v[8] = {acc[ai][bj][m][0][0], acc[ai][bj][m][0][1], acc[ai][bj][m][0][2], acc[ai][bj][m][0][3], acc[ai][bj][m][1][0], acc[ai][bj][m][1][1], acc[ai][bj][m][1][2], acc[ai][bj][m][1][3]};
                    e.tok8(tok0, wcol, v);
                }
                if (m & 1) SCHED_FENCE();
            }
    }
};
template <class Epi> struct PgEpiN {
    static constexpr bool PERM = true, AFTER_DRAIN = false;
    Epi e;
    DEV void operator()(const f32x4 (&acc)[2][2][4][2], const pg8::Unit& u, int wr, int wc, int fr, int fq) const {
#pragma unroll
        for (int ai = 0; ai < 2; ++ai)
#pragma unroll
            for (int m = 0; m < 4; ++m) {
#pragma unroll
                for (int bj = 0; bj < 2; ++bj) {
                    const int tok = u.pm * 256 + ai * 128 + wr * 64 + m * 16 + fr, wcol0 = u.pn * 256 + bj * 128 + wc * 32 + 8 * fq;
                    const float v[8] = {acc[ai][bj][m][0][0], acc[ai][bj][m][0][1], acc[ai][bj][m][0][2], acc[ai][bj][m][0][3], acc[ai][bj][m][1][0], acc[ai][bj][m][1][1], acc[ai][bj][m][1][2], acc[ai][bj][m][1][3]};
                    e.col8(tok, wcol0, v);
                }
                if (m & 1) SCHED_FENCE();
            }
    }
};
template <class Epi>
DEV void gemm_pg8_T(const bf16_t* A, const bf16_t* Wt, int Mtok, int N, unsigned char* smem, const Epi& epi) {
    pg8::Gemm g{Wt, A, N, Mtok, 1024};
    pg8::StaticOrder S; S.init(N, Mtok, (int)gridDim.x, (int)blockIdx.x);
    PgEpiT<Epi> E{epi};
    pg8::gemm_phase<PgEpiT<Epi>, pg8::StaticOrder, false>((PG8_LAS unsigned char*)smem, g, S, E);
    __syncthreads();
}
template <class Epi>
DEV void gemm_pg8_N(const bf16_t* A, const bf16_t* Wt, int Mtok, int N, unsigned char* smem, const Epi& epi) {
    pg8::Gemm g{A, Wt, Mtok, N, 1024};
    pg8::StaticOrder S; S.init(Mtok, N, (int)gridDim.x, (int)blockIdx.x);
    PgEpiN<Epi> E{epi};
    pg8::gemm_phase<PgEpiN<Epi>, pg8::StaticOrder, false>((PG8_LAS unsigned char*)smem, g, S, E);
    __syncthreads();
}
struct EpiL0In {
    unsigned char* ws;
    DEV void operator()(int row, int col, float v0, float v1, float v2, float v3) const {
        u32x2 o; o[0] = pk2(v0, v1); o[1] = pk2(v2, v3);
        const bool lat = row < TL; const int b = lat ? row / L : (row - TL) / LC, t = lat ? row - b * L : (row - TL) - b * LC, Lx = lat ? L : LC;
        const int cu = __builtin_amdgcn_readfirstlane(col & ~127);
        if (cu < 1536) { bf16_t* d = (bf16_t*)(ws + WS_P + (lat ? P_HYT_LAT : P_HYT_CTX)) + ((size_t)b * 1536 + col) * Lx + t; *(u32x2*)d = o; }
        else if (cu < 2048) { bf16_t* d = (bf16_t*)(ws + WS_P + P_Q0) + (size_t)row * 512 + (col - 1536); d[0] = (bf16_t)f2bf(v0); d[512] = (bf16_t)f2bf(v1); d[1024] = (bf16_t)f2bf(v2); d[1536] = (bf16_t)f2bf(v3); }
        else if (cu < 2176) { bf16_t* d = (bf16_t*)(ws + WS_P + P_K0) + (size_t)row * 128 + (col - 2048); d[0] = (bf16_t)f2bf(v0); d[128] = (bf16_t)f2bf(v1); d[256] = (bf16_t)f2bf(v2); d[384] = (bf16_t)f2bf(v3); }
        else { bf16_t* d = (bf16_t*)(ws + WS_P + (lat ? P_VT_LAT : P_VT_CTX)) + ((size_t)b * 128 + (col - 2176)) * Lx + t; *(u32x2*)d = o; }
    }
};
struct EpiL0InT {
    unsigned char* ws;
    DEV void tok8(int row, int col, const float (&v)[8]) const {
        const bool lat = row < TL; const int b = lat ? row / L : (row - TL) / LC, t = lat ? row - b * L : (row - TL) - b * LC, Lx = lat ? L : LC;
        u32x4 o; o[0] = pk2(v[0], v[1]); o[1] = pk2(v[2], v[3]); o[2] = pk2(v[4], v[5]); o[3] = pk2(v[6], v[7]);
        if (col < 1536) { *(u32x4*)((bf16_t*)(ws + WS_P + (lat ? P_HYT_LAT : P_HYT_CTX)) + ((size_t)b * 1536 + col) * Lx + t) = o; }
        else if (col < 2048) { bf16_t* d = (bf16_t*)(ws + WS_P + P_Q0) + (size_t)row * 512 + (col - 1536);
#pragma unroll
            for (int i = 0; i < 8; ++i) d[i * 512] = (bf16_t)f2bf(v[i]); }
        else if (col < 2176) { bf16_t* d = (bf16_t*)(ws + WS_P + P_K0) + (size_t)row * 128 + (col - 2048);
#pragma unroll
            for (int i = 0; i < 8; ++i) d[i * 128] = (bf16_t)f2bf(v[i]); }
        else { *(u32x4*)((bf16_t*)(ws + WS_P + (lat ? P_VT_LAT : P_VT_CTX)) + ((size_t)b * 128 + (col - 2176)) * Lx + t) = o; }
    }
};
struct EpiBf16 {
    bf16_t* out; int ld;
    DEV void col8(int row, int col0, const float (&v)[8]) const { u32x4 o; o[0] = pk2(v[0], v[1]); o[1] = pk2(v[2], v[3]); o[2] = pk2(v[4], v[5]); o[3] = pk2(v[6], v[7]); *(u32x4*)(out + (size_t)row * ld + col0) = o; }
    DEV void operator()(int row, int col, float v0, float v1, float v2, float v3) const {
        bf16_t* d = out + (size_t)row * ld + col; d[0] = (bf16_t)f2bf(v0); d[ld] = (bf16_t)f2bf(v1); d[2 * ld] = (bf16_t)f2bf(v2); d[3 * ld] = (bf16_t)f2bf(v3);
    }
};
struct EpiHg {
    unsigned char* ws; const float* lg;
    DEV void operator()(int row, int col, float v0, float v1, float v2, float v3) const {
        float vv[4] = {v0, v1, v2, v3};
        const bool lat = row < TL; const int b = lat ? row / L : (row - TL) / LC, t = lat ? row - b * L : (row - TL) - b * LC, Lx = lat ? L : LC;
        const int cu = __builtin_amdgcn_readfirstlane(col & ~255);
        if (cu >= 3072 && cu < 4096) {
            bf16_t* d = (bf16_t*)(ws + WS_M) + (lat ? (size_t)0 : (size_t)NB * 1024 * L) + ((size_t)b * 1024 + (col - 3072)) * Lx + t;
            u32x2 o; o[0] = pk2(v0, v1); o[1] = pk2(v2, v3); *(u32x2*)d = o;
            return;
        }
        if (cu < 1024 || cu >= 4096) {
#pragma unroll
            for (int i = 0; i < 4; ++i) vv[i] = silu_f(vv[i]);
        } else {
            const int c = col - 1024;
            const float oml = 1.f - 1.f / (1.f + __expf(lg[c] - lg[2048 + c]));
#pragma unroll
            for (int i = 0; i < 4; ++i) vv[i] = oml / (1.f + __expf(vv[i]));
        }
        if (cu < 3072) {
            bf16_t* d = (bf16_t*)(ws + WS_P + (lat ? P1_KQT_LAT : P1_KQT_CTX)) + ((size_t)b * 3072 + col) * Lx + t;
            u32x2 o; o[0] = pk2(vv[0], vv[1]); o[1] = pk2(vv[2], vv[3]); *(u32x2*)d = o;
        } else {
            if (!lat) return;
            bf16_t* d = (bf16_t*)(ws + WS_P + P1_G) + (size_t)row * 1024 + (col - 4096); d[0] = (bf16_t)f2bf(vv[0]); d[1024] = (bf16_t)f2bf(vv[1]); d[2048] = (bf16_t)f2bf(vv[2]); d[3072] = (bf16_t)f2bf(vv[3]);
        }
    }
};
struct EpiHgT {
    unsigned char* ws; const float* lg;
    DEV void tok8(int row, int col, const float (&v)[8]) const {
        const bool lat = row < TL; const int b = lat ? row / L : (row - TL) / LC, t = lat ? row - b * L : (row - TL) - b * LC, Lx = lat ? L : LC;
        const int cu = __builtin_amdgcn_readfirstlane(col & ~255);
        float vv[8];
#pragma unroll
        for (int i = 0; i < 8; ++i) vv[i] = v[i];
        if (cu >= 3072 && cu < 4096) {
            u32x4 o; o[0] = pk2(vv[0], vv[1]); o[1] = pk2(vv[2], vv[3]); o[2] = pk2(vv[4], vv[5]); o[3] = pk2(vv[6], vv[7]);
            *(u32x4*)((bf16_t*)(ws + WS_M) + (lat ? (size_t)0 : (size_t)NB * 1024 * L) + ((size_t)b * 1024 + (col - 3072)) * Lx + t) = o;
            return;
        }
        if (cu < 1024 || cu >= 4096) {
#pragma unroll
            for (int i = 0; i < 8; ++i) vv[i] = silu_f(vv[i]);
        } else {
            const int c = col - 1024;
            const float oml = 1.f - 1.f / (1.f + __expf(lg[c] - lg[2048 + c]));
#pragma unroll
            for (int i = 0; i < 8; ++i) vv[i] = oml / (1.f + __expf(vv[i]));
        }
        if (cu < 3072) {
            u32x4 o; o[0] = pk2(vv[0], vv[1]); o[1] = pk2(vv[2], vv[3]); o[2] = pk2(vv[4], vv[5]); o[3] = pk2(vv[6], vv[7]);
            *(u32x4*)((bf16_t*)(ws + WS_P + (lat ? P1_KQT_LAT : P1_KQT_CTX)) + ((size_t)b * 3072 + col) * Lx + t) = o;
        } else {
            if (!lat) return;
            bf16_t* d = (bf16_t*)(ws + WS_P + P1_G) + (size_t)row * 1024 + (col - 4096);
#pragma unroll
            for (int i = 0; i < 8; ++i) d[i * 1024] = (bf16_t)f2bf(vv[i]);
        }
    }
};
struct EpiRes {
    const Params* p; int from_inputs, layer, goff;
    DEV void col8(int row, int col0, const float (&v)[8]) const {
        float* H = (float*)(p->ws + WS_H) + (size_t)row * 1024 + col0; const float* hin = h_row(*p, from_inputs, row) + col0;
        const float* gt = (const float*)(p->ws + WS_MOD) + ((size_t)layer * NR + mod_row(row)) * 6144 + goff + col0;
        const f32x4 h0 = *(const f32x4*)hin, h1 = *(const f32x4*)(hin + 4), g0 = *(const f32x4*)gt, g1 = *(const f32x4*)(gt + 4);
        f32x4 o0, o1;
#pragma unroll
        for (int i = 0; i < 4; ++i) { o0[i] = h0[i] + g0[i] * v[i]; o1[i] = h1[i] + g1[i] * v[4 + i]; }
        *(f32x4*)H = o0; *(f32x4*)(H + 4) = o1;
    }
    DEV void operator()(int row, int col, float v0, float v1, float v2, float v3) const {
        float* H = (float*)(p->ws + WS_H) + (size_t)row * 1024 + col;
        const float* hin = h_row(*p, from_inputs, row) + col;
        const float gt = ((const float*)(p->ws + WS_MOD))[((size_t)layer * NR + mod_row(row)) * 6144 + goff + col];
        const float h0 = hin[0], h1 = hin[1024], h2 = hin[2048], h3 = hin[3072];
        H[0] = h0 + gt * v0; H[1024] = h1 + gt * v1; H[2048] = h2 + gt * v2; H[3072] = h3 + gt * v3;
    }
};

DEV float hy_u(const bf16_t* row, int t, int Lx, float w0, float w1, float w2, float b) {
    const float xm = t > 0 ? bf2f(row[t - 1]) : 0.f, x0 = bf2f(row[t]), xp = t + 1 < Lx ? bf2f(row[t + 1]) : 0.f;
    return w0 * xm + w1 * x0 + w2 * xp + b;
}
DEV void hyena_item(const Params& p, int set, int item, unsigned char* smem) {
    const int Ls = set ? LC : L, S = set ? FS_CTX : FS_LAT, N = 1 << (2 * S);
    const int gi = tidx() >> 8, g = tidx() & 255;
    const int bp = item >> 8, c = (item & 255) * 2 + gi, ba = bp * 2, bb = ba + 1;
    cf2* buf = (cf2*)smem + (size_t)gi * N;
    cf2* zk = (cf2*)smem + (size_t)2 * N + (size_t)gi * Ls;
    const bf16_t* hy = (const bf16_t*)(p.ws + WS_P + (set ? P_HYT_CTX : P_HYT_LAT));
    const float* cw = p.in[I_HYCW]; const float* cb = p.in[I_HYCB];
    const cf2* HF = (const cf2*)(p.ws + WS_F + (set ? F_HF_CTX : F_HF_LAT));
    const float invN = 1.f / (float)N;
    {
        const float w0 = cw[c], w1 = cw[1536 + c], w2 = cw[3072 + c], b = cb[c];
        const bf16_t* ra = hy + ((size_t)ba * 1536 + c) * Ls; const bf16_t* rb = hy + ((size_t)bb * 1536 + c) * Ls;
#pragma unroll 4
        for (int t = g; t < N; t += 256) { cf2 v; v.x = 0.f; v.y = 0.f; if (t < Ls) { v.x = hy_u(ra, t, Ls, w0, w1, w2, b); v.y = hy_u(rb, t, Ls, w0, w1, w2, b); zk[t] = v; } buf[fsw(t)] = v; }
    }
    __syncthreads();
    for (int n = 0; n < 2; ++n) {
        fft_fwd(buf, S, g, 256);
        const cf2* hf = HF + (size_t)(n * 512 + c) * N;
        for (int k0 = g; k0 < N; k0 += 1024) {
            cf2 hv[4];
#pragma unroll
            for (int u = 0; u < 4; ++u) { hv[u].x = 0.f; hv[u].y = 0.f; if (k0 + 256 * u < N) hv[u] = hf[k0 + 256 * u]; }
#pragma unroll
            for (int u = 0; u < 4; ++u) { const int k = k0 + 256 * u; if (k < N) buf[fsw(k)] = cmul(buf[fsw(k)], hv[u]); }
        }
        __syncthreads();
        fft_inv(buf, S, g, 256);
        const int gc = (n + 1) * 512 + c;
        const float w0 = cw[gc], w1 = cw[1536 + gc], w2 = cw[3072 + gc], b = cb[gc], dsk = p.in[I_HYSKIP][n * 512 + c];
        const bf16_t* ra = hy + ((size_t)ba * 1536 + gc) * Ls; const bf16_t* rb = hy + ((size_t)bb * 1536 + gc) * Ls;
        bf16_t* M = (bf16_t*)(p.ws + WS_M);
#pragma unroll 4
        for (int t = g; t < N; t += 256) {
            cf2 v; v.x = 0.f; v.y = 0.f;
            if (t < Ls) {
                const cf2 cv = buf[fsw(t)], zo = zk[t];
                v.x = hy_u(ra, t, Ls, w0, w1, w2, b) * (cv.x * invN + dsk * zo.x); v.y = hy_u(rb, t, Ls, w0, w1, w2, b) * (cv.y * invN + dsk * zo.y);
                if (n == 0) zk[t] = v;
                else { const size_t ta = set ? (size_t)TL + (size_t)ba * LC + t : (size_t)ba * L + t, tb = set ? (size_t)TL + (size_t)bb * LC + t : (size_t)bb * L + t;
                       M[ta * 1024 + c] = (bf16_t)f2bf(v.x); M[tb * 1024 + c] = (bf16_t)f2bf(v.y); }
            }
            if (n == 0) buf[fsw(t)] = v;
        }
        __syncthreads();
    }
}
DEV void rope_store(const bf16_t* src, bf16_t* dst, int pos, bool rope, float scale, int ph, int sub) {
    const u32x4 ua = *(const u32x4*)(src + ph * 32 + sub * 8), ub = *(const u32x4*)(src + ph * 32 + 16 + sub * 8);
    float a[8], b[8];
#pragma unroll
    for (int i = 0; i < 4; ++i) { a[2 * i] = bflo(ua[i]); a[2 * i + 1] = bfhi(ua[i]); b[2 * i] = bflo(ub[i]); b[2 * i + 1] = bfhi(ub[i]); }
    if (rope) {
        const float pv = (float)(ph == 0 ? pos / 64 : pos % 64);
#pragma unroll
        for (int e = 0; e < 8; ++e) {
            const float inv = exp2f(-(float)(sub * 8 + e) * (13.287712379549449f / 16.f));
            const float ang = pv * inv, cs = __cosf(ang), sn = __sinf(ang);
            const float na = a[e] * cs - b[e] * sn, nb = b[e] * cs + a[e] * sn; a[e] = na; b[e] = nb;
        }
    }
    u32x4 oa, ob;
#pragma unroll
    for (int i = 0; i < 4; ++i) { oa[i] = pk2(a[2 * i] * scale, a[2 * i + 1] * scale); ob[i] = pk2(b[2 * i] * scale, b[2 * i + 1] * scale); }
    *(u32x4*)(dst + ph * 32 + sub * 8) = oa; *(u32x4*)(dst + ph * 32 + 16 + sub * 8) = ob;
}
constexpr int A_LDQ = 72, A_LDV = 136;
DEV void attn_item(const Params& p, int set, int item, unsigned char* smem) {
    bf16_t* Qs = (bf16_t*)smem;
    bf16_t* Ks = Qs + 128 * A_LDQ;
    bf16_t* Vt = Ks + 128 * A_LDQ;
    const int tid = tidx(), lane = tid & 63, w = tid >> 6, l15 = lane & 15, lg = lane >> 4;
    const int nqb = set ? LC / 128 : L / 128;
    const int h = item & 7, qb = (item >> 3) % nqb, b = (item >> 3) / nqb, kvh = h >> 2;
    const bf16_t* Q0 = (const bf16_t*)(p.ws + WS_P + P_Q0); const bf16_t* K0 = (const bf16_t*)(p.ws + WS_P + P_K0);
    const int qtok0 = set ? TL + b * LC + qb * 128 : b * L + qb * 128;
    { const int row = tid >> 2, ph = (tid >> 1) & 1, sub = tid & 1;
      rope_store(Q0 + (size_t)(qtok0 + row) * 512 + h * 64, Qs + row * A_LDQ, qb * 128 + row, set == 0, 0.125f, ph, sub); }
    __syncthreads();
    bf16x8 qf[2];
    qf[0] = *(const bf16x8*)(Qs + (w * 16 + l15) * A_LDQ + 8 * lg); qf[1] = *(const bf16x8*)(Qs + (w * 16 + l15) * A_LDQ + 32 + 8 * lg);
    float m_run = p.in[I_SINK][h], l_run = 1.f;
    f32x4 O[4];
#pragma unroll
    for (int i = 0; i < 4; ++i) O[i] = (f32x4){0.f, 0.f, 0.f, 0.f};
    const int nwin = set ? 0 : 3, nctx = LC / 128;
    for (int kbi = 0; kbi < nwin + nctx; ++kbi) {
        const bool win = kbi < nwin; const int kb = win ? qb - 1 + kbi : kbi - nwin;
        if (win && (kb < 0 || kb >= L / 128)) continue;
        const int ktok0 = win ? b * L + kb * 128 : TL + b * LC + kb * 128;
        __syncthreads();
        { const int row = tid >> 2, ph = (tid >> 1) & 1, sub = tid & 1;
          rope_store(K0 + (size_t)(ktok0 + row) * 128 + kvh * 64, Ks + row * A_LDQ, kb * 128 + row, win, 1.f, ph, sub); }
        { const bf16_t* vt = (const bf16_t*)(p.ws + WS_P + (win ? P_VT_LAT : P_VT_CTX)); const int Lx = win ? L : LC;
#pragma unroll
          for (int i = 0; i < 2; ++i) { const int id = tid + NT * i, d = id >> 4, kc = id & 15;
              *(u32x4*)(Vt + d * A_LDV + kc * 8) = *(const u32x4*)(vt + ((size_t)b * 128 + kvh * 64 + d) * Lx + kb * 128 + kc * 8); } }
        __syncthreads();
#pragma unroll
        for (int ch = 0; ch < 2; ++ch) {
            f32x4 st[4];
#pragma unroll
            for (int u = 0; u < 4; ++u) {
                const bf16_t* kr = Ks + ((ch * 4 + u) * 16 + l15) * A_LDQ + 8 * lg;
                f32x4 z = (f32x4){0.f, 0.f, 0.f, 0.f};
                z = __builtin_amdgcn_mfma_f32_16x16x32_bf16(*(const bf16x8*)kr, qf[0], z, 0, 0, 0);
                z = __builtin_amdgcn_mfma_f32_16x16x32_bf16(*(const bf16x8*)(kr + 32), qf[1], z, 0, 0, 0);
                st[u] = z;
            }
            float cmax = -INFINITY;
            if (win) {
                const int qpos = qb * 128 + w * 16 + l15;
#pragma unroll
                for (int u = 0; u < 4; ++u)
#pragma unroll
                    for (int r = 0; r < 4; ++r) { const int kpos = kb * 128 + (ch * 4 + u) * 16 + 4 * lg + r; const int dd = qpos - kpos; if (dd > 128 || dd < -128) st[u][r] = -INFINITY; }
            }
#pragma unroll
            for (int u = 0; u < 4; ++u)
#pragma unroll
                for (int r = 0; r < 4; ++r) cmax = fmaxf(cmax, st[u][r]);
            cmax = fmaxf(cmax, __shfl_xor(cmax, 16)); cmax = fmaxf(cmax, __shfl_xor(cmax, 32));
            const float m_new = fmaxf(m_run, cmax), alpha = __expf(m_run - m_new);
            float ls = 0.f;
#pragma unroll
            for (int u = 0; u < 4; ++u)
#pragma unroll
                for (int r = 0; r < 4; ++r) { const float e = __expf(st[u][r] - m_new); st[u][r] = e; ls += e; }
            ls += __shfl_xor(ls, 16); ls += __shfl_xor(ls, 32);
            l_run = l_run * alpha + ls; m_run = m_new;
#pragma unroll
            for (int i = 0; i < 4; ++i) { O[i][0] *= alpha; O[i][1] *= alpha; O[i][2] *= alpha; O[i][3] *= alpha; }
#pragma unroll
            for (int ss = 0; ss < 2; ++ss) {
                u32x4 pu; pu[0] = pk2(st[2 * ss][0], st[2 * ss][1]); pu[1] = pk2(st[2 * ss][2], st[2 * ss][3]); pu[2] = pk2(st[2 * ss + 1][0], st[2 * ss + 1][1]); pu[3] = pk2(st[2 * ss + 1][2], st[2 * ss + 1][3]);
                const bf16x8 pf = __builtin_bit_cast(bf16x8, pu);
                const int key0 = (ch * 4 + 2 * ss) * 16 + 4 * lg;
#pragma unroll
                for (int dt = 0; dt < 4; ++dt) {
                    const bf16_t* vr = Vt + (dt * 16 + l15) * A_LDV + key0;
                    u32x4 vu; const u32x2 v0 = *(const u32x2*)vr, v1 = *(const u32x2*)(vr + 16); vu[0] = v0[0]; vu[1] = v0[1]; vu[2] = v1[0]; vu[3] = v1[1];
                    O[dt] = __builtin_amdgcn_mfma_f32_16x16x32_bf16(__builtin_bit_cast(bf16x8, vu), pf, O[dt], 0, 0, 0);
                }
            }
        }
    }
    const float il = 1.f / l_run;
    bf16_t* M = (bf16_t*)(p.ws + WS_M) + (size_t)(qtok0 + w * 16 + l15) * 1024 + 512 + h * 64;
#pragma unroll
    for (int dt = 0; dt < 4; ++dt) { u32x2 o; o[0] = pk2(O[dt][0] * il, O[dt][1] * il); o[1] = pk2(O[dt][2] * il, O[dt][3] * il); *(u32x2*)(M + dt * 16 + 4 * lg) = o; }
    __syncthreads();
}
constexpr int P3_HY_LAT = (NB / 2) * 256, P3_HY_CTX = (NB / 2) * 256, P3_AT_LAT = NB * (L / 128) * 8, P3_AT_CTX = NB * (LC / 128) * 8;
DEV void phase3(const Params& p, unsigned char* smem, int var = 0) {
    const int total = P3_HY_LAT + P3_AT_LAT + P3_HY_CTX + P3_AT_CTX;
    for (int it = blockIdx.x; it < total; it += gridDim.x) {
        int i = it;
        if (var == 1 && !(i < P3_HY_LAT || (i >= P3_HY_LAT + P3_AT_LAT && i < P3_HY_LAT + P3_AT_LAT + P3_HY_CTX))) continue;
        if (var == 2 && (i < P3_HY_LAT || (i >= P3_HY_LAT + P3_AT_LAT && i < P3_HY_LAT + P3_AT_LAT + P3_HY_CTX))) continue;
        if (i < P3_HY_LAT) { hyena_item(p, 0, i, smem); continue; } i -= P3_HY_LAT;
        if (i < P3_AT_LAT) { attn_item(p, 0, i, smem); continue; } i -= P3_AT_LAT;
        if (i < P3_HY_CTX) { hyena_item(p, 1, i, smem); continue; } i -= P3_HY_CTX;
        attn_item(p, 1, i, smem);
    }
}

constexpr int K_LDK = 136, K_LDS = 129, K_LDC = 52;
DEV unsigned fkey(float f) { const unsigned u = __builtin_bit_cast(unsigned, f); return (u & 0x80000000u) ? ~u : (u | 0x80000000u); }
constexpr int cand_off(int i) { int o = 0; for (int k = 0; k < i; ++k) o += 16 / (k + 1); return o; }
DEV void topk_load_keys(const Params& p, int layer, int h, unsigned char* smem) {
    bf16_t* Ks = (bf16_t*)smem;
    const bf16_t* keys = (const bf16_t*)(p.ws + WS_W + W_KEYS) + (size_t)layer * 262144 + (size_t)h * 32768;
    const int tid = tidx();
#pragma unroll
    for (int i = 0; i < 8; ++i) { const int id = tid + NT * i, row = id >> 4, kc = id & 15; *(u32x4*)(Ks + row * K_LDK + kc * 8) = *(const u32x4*)(keys + (size_t)row * 128 + kc * 8); }
    __syncthreads();
}
#ifndef HOST_EMU
template <int CTRL> DEV unsigned dpp_u32(unsigned v) { return (unsigned)__builtin_amdgcn_update_dpp(0, (int)v, CTRL, 0xF, 0xF, true); }
#else
template <int CTRL> DEV unsigned dpp_u32(unsigned v) { const int lane = tidx() & 63; const int src = CTRL == 0xB1 ? (lane ^ 1) : CTRL == 0x4E ? (lane ^ 2) : ((lane & ~7) | (7 - (lane & 7))); return emu_shfl(v, src); }
#endif
DEV unsigned max8_u32(unsigned v) { unsigned t = dpp_u32<0xB1>(v); v = v > t ? v : t; t = dpp_u32<0x4E>(v); v = v > t ? v : t; t = dpp_u32<0x141>(v); return v > t ? v : t; }
DEV float sum8_f32(float v) { v += __builtin_bit_cast(float, dpp_u32<0xB1>(__builtin_bit_cast(unsigned, v))); v += __builtin_bit_cast(float, dpp_u32<0x4E>(__builtin_bit_cast(unsigned, v))); v += __builtin_bit_cast(float, dpp_u32<0x141>(__builtin_bit_cast(unsigned, v))); return v; }
DEV float unkey(unsigned k) { const unsigned u = (k & 0x80000000u) ? (k & 0x7fffffffu) : ~k; return __builtin_bit_cast(float, u); }
template <int N> DEV void bitonic_desc(unsigned (&a)[N]) {
#pragma unroll
    for (int k = 2; k <= N; k <<= 1)
#pragma unroll
        for (int j = k >> 1; j > 0; j >>= 1)
#pragma unroll
            for (int i = 0; i < N; ++i) { const int l = i ^ j; if (l > i) { const unsigned x = a[i], y = a[l]; const unsigned hi = x > y ? x : y, lo = x > y ? y : x; if ((i & k) == 0) { a[i] = hi; a[l] = lo; } else { a[i] = lo; a[l] = hi; } } }
}
DEV void merge16(const unsigned* lst, int nlist, unsigned first, int sub, unsigned& r0, unsigned& r1) {
    unsigned cur = first; int head = 0; r0 = 0u; r1 = 0u;
#pragma unroll
    for (int it = 0; it < 16; ++it) {
        const unsigned m = max8_u32(cur);
        if (sub == (it & 7)) { if (it < 8) r0 = m; else r1 = m; }
        if (cur == m) { ++head; cur = head < nlist ? lst[head] : 0u; }
    }
}
DEV void topk_item(const Params& p, int h, int tok0, unsigned char* smem) {
    bf16_t* Ks = (bf16_t*)smem;
    float* Sc = (float*)(Ks + 2 * 128 * K_LDK);
    unsigned* s12 = (unsigned*)Sc + 64 * 8 * 17;
    unsigned* cl = s12 + 64 * 32;
    const int tid = tidx(), lane = tid & 63, w = tid >> 6;
    const int row = tid >> 3, sub = tid & 7;
    const bf16_t* PQ = (const bf16_t*)(p.ws + WS_P);
    for (int part = 0; part < 2; ++part) {
        { const int mi = w >> 2, ni = w & 3;
          f32x16 acc;
#pragma unroll
          for (int r = 0; r < 16; ++r) acc[r] = 0.f;
          const bf16_t* ag = PQ + (size_t)(tok0 + mi * 32 + (lane & 31)) * 2048 + h * 256 + part * 128 + 8 * (lane >> 5);
          const bf16_t* bs = Ks + (part * 128 + ni * 32 + (lane & 31)) * K_LDK + 8 * (lane >> 5);
          bf16x8 af[8];
#pragma unroll
          for (int kk = 0; kk < 8; ++kk) af[kk] = *(const bf16x8*)(ag + kk * 16);
#pragma unroll
          for (int kk = 0; kk < 8; ++kk) acc = __builtin_amdgcn_mfma_f32_32x32x16_bf16(af[kk], *(const bf16x8*)(bs + kk * 16), acc, 0, 0, 0);
#pragma unroll
          for (int r = 0; r < 16; ++r) Sc[(mi * 32 + (r & 3) + 8 * (r >> 2) + 4 * (lane >> 5)) * K_LDS + ni * 32 + (lane & 31)] = acc[r]; }
        __syncthreads();
        unsigned mk[16];
#pragma unroll
        for (int i = 0; i < 16; ++i) mk[i] = (fkey(Sc[row * K_LDS + sub * 16 + i]) & ~127u) | (unsigned)(127 - (sub * 16 + i));
        bitonic_desc<16>(mk);
        __syncthreads();
        unsigned* lst = (unsigned*)Sc + (row * 8 + sub) * 17;
#pragma unroll
        for (int i = 0; i < 16; ++i) lst[i] = mk[i];
        unsigned r0, r1;
        merge16(lst, 16, mk[0], sub, r0, r1);
        s12[(row * 2 + part) * 16 + sub] = r0; s12[(row * 2 + part) * 16 + 8 + sub] = r1;
        __syncthreads();
    }
    {
        const unsigned* k1 = s12 + row * 32; const unsigned* k2 = k1 + 16;
        unsigned ck[8];
#pragma unroll
        for (int m = 0; m < 8; ++m) {
            const int cc = sub + 8 * m; int ci = 0, off = 0;
#pragma unroll
            for (int i = 0; i < 15; ++i) { const bool ge = cc >= cand_off(i + 1); ci += ge ? 1 : 0; off += ge ? 16 / (i + 1) : 0; }
            const int cj = cc - off;
            ck[m] = 0u;
            if (cc < 50) ck[m] = (fkey(unkey((k1[ci] & ~127u) | 64u) + unkey((k2[cj] & ~127u) | 64u)) & ~63u) | (unsigned)(63 - cc);
        }
        bitonic_desc<8>(ck);
        unsigned* lst = cl + (row * 8 + sub) * 9;
#pragma unroll
        for (int m = 0; m < 8; ++m) lst[m] = ck[m];
        unsigned r0, r1;
        merge16(lst, 8, ck[0], sub, r0, r1);
        const float a = unkey((r0 & ~63u) | 32u), b = unkey((r1 & ~63u) | 32u);
        const unsigned kmax = max8_u32(r0 > r1 ? r0 : r1); const float vmax = unkey((kmax & ~63u) | 32u);
        const float ea = __expf(a - vmax), eb = __expf(b - vmax);
        const float inv = 1.f / sum8_f32(ea + eb);
        int eidx[2];
#pragma unroll
        for (int q = 0; q < 2; ++q) {
            const int cc = 63 - (int)((q ? r1 : r0) & 63u); int ci = 0, off = 0;
#pragma unroll
            for (int i = 0; i < 15; ++i) { const bool ge = cc >= cand_off(i + 1); ci += ge ? 1 : 0; off += ge ? 16 / (i + 1) : 0; }
            const int cj = cc - off;
            eidx[q] = (127 - (int)(k1[ci] & 127u)) * 128 + (127 - (int)(k2[cj] & 127u));
        }
        int* IDX = (int*)(p.ws + WS_IDX) + (size_t)(tok0 + row) * 128 + h * 16; float* GT = (float*)(p.ws + WS_GATE) + (size_t)(tok0 + row) * 128 + h * 16;
        IDX[sub] = eidx[0]; IDX[8 + sub] = eidx[1]; GT[sub] = ea * inv; GT[8 + sub] = eb * inv;
    }
    __syncthreads();
}
DEV void topk_phase(const Params& p, int layer, int ntok, unsigned char* smem) {
    const int G = gridDim.x, bid = blockIdx.x, h = bid & 7;
    const int nt = ntok / 64;
    if ((G & 7) == 0) {
        if ((bid >> 3) < nt) topk_load_keys(p, layer, h, smem);
        for (int tt = bid >> 3; tt < nt; tt += (G >> 3)) topk_item(p, h, tt * 64, smem);
    } else {
        for (int it = bid; it < nt * 8; it += G) { __syncthreads(); topk_load_keys(p, layer, it & 7, smem); topk_item(p, it & 7, (it >> 3) * 64, smem); }
    }
}

DEV float gelu_f(float x) { return 0.5f * x * (1.f + erff(x * 0.70710678118654752f)); }
DEV void peer_item(const Params& p, int layer, int item, int var = 0) {
    (void)var;
    const int tok = item * 8 + (tidx() >> 6), lane = tidx() & 63, li = lane & 31, half = lane >> 5;
    const bf16_t* A = (const bf16_t*)(p.ws + WS_A) + (size_t)tok * 1024 + li * 32;
    const unsigned char* U6 = p.ws + WS_U6 + (size_t)layer * 16384 * 768; const unsigned char* V4 = p.ws + WS_V4 + (size_t)layer * 16384 * 512;
    const float* SU = (const float*)(p.ws + WS_S8) + (size_t)(layer * 2) * 16384; const float* SV = SU + 16384;
    float x[32], y[32];
#pragma unroll
    for (int q = 0; q < 4; ++q) { const u32x4 a = *(const u32x4*)(A + 8 * q);
#pragma unroll
        for (int i = 0; i < 4; ++i) { x[8 * q + 2 * i] = bflo(a[i]); x[8 * q + 2 * i + 1] = bfhi(a[i]); } }
#pragma unroll
    for (int i = 0; i < 32; ++i) y[i] = 0.f;
    const int* IDX = (const int*)(p.ws + WS_IDX) + (size_t)tok * 128; const float* GT = (const float*)(p.ws + WS_GATE) + (size_t)tok * 128;
    const int i_lo = IDX[lane], i_hi = IDX[64 + lane]; const float g_lo = GT[lane], g_hi = GT[64 + lane];
    const int sl = ((li >> 4) & 1) * 2 + ((li >> 3) & 1);
    u32x4 ulo[4], vq[4]; u32x2 uhi[4];
#define PG_LOADU(g) do { _Pragma("unroll") for (int s_ = 0; s_ < 4; ++s_) { const int e_ = __shfl((g) < 8 ? i_lo : i_hi, (((g) & 7) << 3) + 2 * s_ + half); \
        const unsigned char* r_ = U6 + (size_t)e_ * 768; ulo[s_] = *(const u32x4*)(r_ + li * 16); uhi[s_] = *(const u32x2*)(r_ + 512 + li * 8); } } while (0)
#define PG_LOADV(g) do { _Pragma("unroll") for (int s_ = 0; s_ < 4; ++s_) { const int e_ = __shfl((g) < 8 ? i_lo : i_hi, (((g) & 7) << 3) + 2 * s_ + half); \
        vq[s_] = *(const u32x4*)(V4 + (size_t)e_ * 512 + li * 16); } } while (0)
    PG_LOADU(0); PG_LOADV(0);
    for (int g = 0; g < 16; ++g) {
        const int mk = ((g & 7) << 3) + 2 * sl + half; const int me = __shfl(g < 8 ? i_lo : i_hi, mk); const float mg = __shfl(g < 8 ? g_lo : g_hi, mk);
        const float su = SU[me], sv = SV[me];
        float d[4];
#pragma unroll
        for (int s4 = 0; s4 < 4; ++s4) {
            u32x6 w; w[0] = ulo[s4][0]; w[1] = ulo[s4][1]; w[2] = ulo[s4][2]; w[3] = ulo[s4][3]; w[4] = uhi[s4][0]; w[5] = uhi[s4][1];
            const f32x32 f = __builtin_amdgcn_cvt_scalef32_pk32_f32_fp6(w, 1.0f);
            float a = 0.f;
#pragma unroll
            for (int i = 0; i < 32; ++i) a = fmaf(f[i], x[i], a);
            d[s4] = a; SCHED_FENCE(); }
        if (g + 1 < 16) PG_LOADU(g + 1);
        float r2[2], r1;
        { const bool hi = (li & 16) != 0;
#pragma unroll
          for (int j = 0; j < 2; ++j) { const float send = hi ? d[j] : d[2 + j], keep = hi ? d[2 + j] : d[j]; r2[j] = keep + __shfl_xor(send, 16); } }
        { const bool hi = (li & 8) != 0; const float send = hi ? r2[0] : r2[1], keep = hi ? r2[1] : r2[0]; r1 = keep + __shfl_xor(send, 8); }
        r1 += __shfl_xor(r1, 4); r1 += __shfl_xor(r1, 2); r1 += __shfl_xor(r1, 1);
        const float act = gelu_f(r1 * su) * mg * sv;
#pragma unroll
        for (int s4 = 0; s4 < 4; ++s4) {
            const float aj = __shfl(act, (lane & 32) + 16 * (s4 >> 1) + 8 * (s4 & 1));
#pragma unroll
            for (int dw = 0; dw < 4; ++dw) {
                const f32x2 f0 = __builtin_amdgcn_cvt_scalef32_pk_f32_fp4(vq[s4][dw], 1.0f, 0), f1 = __builtin_amdgcn_cvt_scalef32_pk_f32_fp4(vq[s4][dw], 1.0f, 1),
                            f2 = __builtin_amdgcn_cvt_scalef32_pk_f32_fp4(vq[s4][dw], 1.0f, 2), f3 = __builtin_amdgcn_cvt_scalef32_pk_f32_fp4(vq[s4][dw], 1.0f, 3);
                const int e0 = dw * 8;
                y[e0] = fmaf(aj, f0[0], y[e0]); y[e0 + 1] = fmaf(aj, f0[1], y[e0 + 1]); y[e0 + 2] = fmaf(aj, f1[0], y[e0 + 2]); y[e0 + 3] = fmaf(aj, f1[1], y[e0 + 3]);
                y[e0 + 4] = fmaf(aj, f2[0], y[e0 + 4]); y[e0 + 5] = fmaf(aj, f2[1], y[e0 + 5]); y[e0 + 6] = fmaf(aj, f3[0], y[e0 + 6]); y[e0 + 7] = fmaf(aj, f3[1], y[e0 + 7]);
            }
            SCHED_FENCE(); }
        if (g + 1 < 16) PG_LOADV(g + 1);
    }
#undef PG_LOADU
#undef PG_LOADV
    float yy[16];
#pragma unroll
    for (int i = 0; i < 16; ++i) { const float send = half ? y[i] : y[16 + i], keep = half ? y[16 + i] : y[i]; yy[i] = keep + __shfl_xor(send, 32); }
    const int c0 = li * 32 + half * 16;
    float* H = (float*)(p.ws + WS_H) + (size_t)tok * 1024 + c0;
    const float* g2 = (const float*)(p.ws + WS_MOD) + ((size_t)layer * NR + mod_row(tok)) * 6144 + 5120 + c0;
    float hv[16]; float ss = 0.f;
#pragma unroll
    for (int i = 0; i < 4; ++i) { const f32x4 hh = *(const f32x4*)(H + 4 * i), gg = *(const f32x4*)(g2 + 4 * i);
#pragma unroll
        for (int j = 0; j < 4; ++j) { const float v = hh[j] + gg[j] * yy[4 * i + j]; hv[4 * i + j] = v; ss += v * v; } }
    ss = wave_sum(ss);
    const float rstd = rsqrtf(ss * (1.f / 1024.f) + 1e-6f);
    if (layer == 0) {
#pragma unroll
        for (int i = 0; i < 4; ++i) { f32x4 o; o[0] = hv[4 * i]; o[1] = hv[4 * i + 1]; o[2] = hv[4 * i + 2]; o[3] = hv[4 * i + 3]; *(f32x4*)(H + 4 * i) = o; }
        const float* g = p.in[I_N1G] + 1024 + c0;
        const float* mod = (const float*)(p.ws + WS_MOD) + ((size_t)1 * NR + mod_row(tok)) * 6144 + c0;
        bf16_t* Ao = (bf16_t*)(p.ws + WS_A) + (size_t)tok * 1024 + c0;
        u32x4 o0, o1; float r[16];
#pragma unroll
        for (int i = 0; i < 16; ++i) r[i] = hv[i] * rstd * g[i] * (1.f + mod[1024 + i]) + mod[i];
#pragma unroll
        for (int i = 0; i < 4; ++i) { o0[i] = pk2(r[2 * i], r[2 * i + 1]); o1[i] = pk2(r[8 + 2 * i], r[8 + 2 * i + 1]); }
        *(u32x4*)Ao = o0; *(u32x4*)(Ao + 8) = o1;
    } else {
        const float* g = p.in[I_FG] + c0; float* out = p.out + (size_t)tok * 1024 + c0;
#pragma unroll
        for (int i = 0; i < 4; ++i) { f32x4 o; o[0] = hv[4 * i] * rstd * g[4 * i]; o[1] = hv[4 * i + 1] * rstd * g[4 * i + 1]; o[2] = hv[4 * i + 2] * rstd * g[4 * i + 2]; o[3] = hv[4 * i + 3] * rstd * g[4 * i + 3]; *(f32x4*)(out + 4 * i) = o; }
    }
}

constexpr int S3_LD = 136, S3_LDT = 24, S3_LDV = 72;
constexpr int S3_Q = 0, S3_K = S3_Q + 64 * S3_LD * 2, S3_KT = S3_K + 64 * S3_LD * 2, S3_D = S3_KT + 4 * 128 * S3_LDT * 2, S3_V = S3_D + 4 * 128 * 4, S3_ST = S3_V + 64 * S3_LDV * 2,
              S3_P = S3_ST + 2 * 64 * S3_LD * 2, S3_END = S3_P + 4 * 16 * S3_LDT * 2;
static_assert(S3_END <= SMEM_BYTES, "scan LDS");
DEV void scan_block(const Params& p, int bi, unsigned char* smem, int var = 0) {
    const int tid = tidx(), lane = tid & 63, w = tid >> 6, l15 = lane & 15, lg4 = lane >> 4, l31 = lane & 31, lh = lane >> 5;
    const int half = bi & 1, dir = (bi >> 1) & 1, h = (bi >> 2) & 7, b = bi >> 5;
    const bf16_t* P1 = (const bf16_t*)(p.ws + WS_P);
    const bf16_t* IT = (const bf16_t*)(p.ws + WS_M);
    bf16_t* Oo = (bf16_t*)(p.ws + WS_F + (dir ? F_OB : F_OF));
    bf16_t* Qs = (bf16_t*)(smem + S3_Q); bf16_t* Ks = (bf16_t*)(smem + S3_K); bf16_t* KT = (bf16_t*)(smem + S3_KT); float* Ds = (float*)(smem + S3_D);
    bf16_t* Vs = (bf16_t*)(smem + S3_V); bf16_t* ST = (bf16_t*)(smem + S3_ST); bf16_t* Ps = (bf16_t*)(smem + S3_P);
    const int NCH = (LC + L) / 64;
    const int kt = w >> 1, vt = w & 1;
    f32x16 S;
#pragma unroll
    for (int r = 0; r < 16; ++r) S[r] = 0.f;
    for (int i = tid; i < 64 * S3_LD / 2; i += NT) ((unsigned*)ST)[i] = 0u;
    const int pk = tid & 127, pblk = tid >> 7;
    u32x4 ka[2], qa[2], va, kb2[2], qb2[2], vb2;
    const int kcol = 1024 * (1 + dir) + h * 128 + pk, qcol = h * 128 + pk;
#define S3_T0(c) ((c) * 64 < LC ? (dir ? LC - 64 - (c) * 64 : (c) * 64) : (dir ? L - 64 - ((c) * 64 - LC) : (c) * 64 - LC))
#define S3_LOAD(c, KR, QR, VR) do { const bool lat_ = (c) * 64 >= LC; const int t0_ = S3_T0(c); const int Lx_ = lat_ ? L : LC; \
        const bf16_t* kq_ = (const bf16_t*)(p.ws + WS_P + (lat_ ? P1_KQT_LAT : P1_KQT_CTX)) + (size_t)b * 3072 * Lx_ + t0_ + pblk * 16; \
        KR[0] = *(const u32x4*)(kq_ + (size_t)kcol * Lx_); KR[1] = *(const u32x4*)(kq_ + (size_t)kcol * Lx_ + 8); \
        if (lat_) { QR[0] = *(const u32x4*)(kq_ + (size_t)qcol * Lx_); QR[1] = *(const u32x4*)(kq_ + (size_t)qcol * Lx_ + 8); } else { QR[0] = (u32x4){0u, 0u, 0u, 0u}; QR[1] = QR[0]; } \
        { const int v_ = tid >> 3, c8_ = tid & 7; const bf16_t* it_ = IT + (lat_ ? (size_t)0 : (size_t)NB * 1024 * L) + ((size_t)b * 1024 + h * 128 + half * 64 + v_) * Lx_ + t0_ + c8_ * 8; VR = *(const u32x4*)it_; } } while (0)
#define S3_PREP(KR, QR, VR) do { \
            float bsum = 0.f; unsigned short kt16[16]; \
            _Pragma("unroll") for (int rr = 0; rr < 16; ++rr) { \
                const int tl = dir ? 15 - rr : rr; \
                const unsigned ku_ = dir ? KR[(15 - rr) >> 3][((15 - rr) & 7) >> 1] : KR[rr >> 3][(rr & 7) >> 1]; const unsigned qu_ = dir ? QR[(15 - rr) >> 3][((15 - rr) & 7) >> 1] : QR[rr >> 3][(rr & 7) >> 1]; \
                const bool odd_ = dir ? (((15 - rr) & 1) != 0) : ((rr & 1) != 0); \
                const float kv = odd_ ? bfhi(ku_) : bflo(ku_), qv = odd_ ? bfhi(qu_) : bflo(qu_); \
                bsum += __logf(1.f - kv); \
                const float eb = __expf(bsum), ieb = __expf(fminf(-bsum, 80.f)); \
                const unsigned short qt = (unsigned short)f2bf(qv * eb), ktv = (unsigned short)f2bf(kv * ieb); \
                Qs[(pblk * 16 + tl) * S3_LD + pk] = qt; Ks[(pblk * 16 + tl) * S3_LD + pk] = ktv; \
                if (dir) kt16[15 - rr] = ktv; else kt16[rr] = ktv; \
            } \
            u32x4 o0, o1; \
            _Pragma("unroll") for (int i = 0; i < 4; ++i) { o0[i] = (unsigned)kt16[2 * i] | ((unsigned)kt16[2 * i + 1] << 16); o1[i] = (unsigned)kt16[8 + 2 * i] | ((unsigned)kt16[8 + 2 * i + 1] << 16); } \
            *(u32x4*)(KT + (pblk * 128 + pk) * S3_LDT) = o0; *(u32x4*)(KT + (pblk * 128 + pk) * S3_LDT + 8) = o1; \
            Ds[pblk * 128 + pk] = __expf(bsum); \
            { const int v_ = tid >> 3, c8_ = tid & 7; *(u32x4*)(Vs + v_ * S3_LDV + c8_ * 8) = VR; } } while (0)
    S3_LOAD(0, ka, qa, va);
    for (int c = 0; c < NCH; ++c) {
        const bool lat = c * 64 >= LC; const int t0 = S3_T0(c); const size_t tokb = lat ? (size_t)b * L + t0 : (size_t)TL + (size_t)b * LC + t0;
        if ((c & 1) == 0) { if (c + 1 < NCH) S3_LOAD(c + 1, kb2, qb2, vb2); } else { if (c + 1 < NCH) S3_LOAD(c + 1, ka, qa, va); }
        lds_barrier();
        if (var != 1) { if ((c & 1) == 0) S3_PREP(ka, qa, va); else S3_PREP(kb2, qb2, vb2); }
        lds_barrier();

        if (lat && w < 4) {
            f32x4 pt = (f32x4){0.f, 0.f, 0.f, 0.f};
#pragma unroll
            for (int kk = 0; kk < 4; ++kk)
                pt = __builtin_amdgcn_mfma_f32_16x16x32_bf16(*(const bf16x8*)(Ks + (w * 16 + l15) * S3_LD + kk * 32 + 8 * lg4), *(const bf16x8*)(Qs + (w * 16 + l15) * S3_LD + kk * 32 + 8 * lg4), pt, 0, 0, 0);
            float pm[4];
#pragma unroll
            for (int r = 0; r < 4; ++r) { const int sl = 4 * lg4 + r; const bool keep = dir ? (sl >= l15) : (sl <= l15); pm[r] = keep ? pt[r] : 0.f; }
            u32x2 o; o[0] = pk2(pm[0], pm[1]); o[1] = pk2(pm[2], pm[3]);
            *(u32x2*)(Ps + (w * 16 + l15) * S3_LDT + 4 * lg4) = o;
        }
        lds_barrier();
        for (int ib = 0; ib < (var == 2 ? 0 : 4); ++ib) {
            const int blk = dir ? 3 - ib : ib;
            const int cur = (c * 4 + ib) & 1;
            { const bf16x8 a = *(const bf16x8*)(KT + (blk * 128 + 32 * kt + l31) * S3_LDT + 8 * lh);
              const bf16x8 bb = *(const bf16x8*)(Vs + (32 * vt + l31) * S3_LDV + blk * 16 + 8 * lh);
              S = __builtin_amdgcn_mfma_f32_32x32x16_bf16(a, bb, S, 0, 0, 0);
#pragma unroll
              for (int g = 0; g < 4; ++g) { const f32x4 dv = *(const f32x4*)(Ds + blk * 128 + 32 * kt + 8 * g + 4 * lh);
                  S[4 * g] *= dv[0]; S[4 * g + 1] *= dv[1]; S[4 * g + 2] *= dv[2]; S[4 * g + 3] *= dv[3];
                  u32x2 o; o[0] = pk2(S[4 * g], S[4 * g + 1]); o[1] = pk2(S[4 * g + 2], S[4 * g + 3]);
                  *(u32x2*)(ST + ((cur ^ 1) * 64 + 32 * vt + l31) * S3_LD + 32 * kt + 8 * g + 4 * lh) = o; } }
            if (lat && w < 4) {
                f32x4 o = (f32x4){0.f, 0.f, 0.f, 0.f};
#pragma unroll
                for (int kk = 0; kk < 4; ++kk)
                    o = __builtin_amdgcn_mfma_f32_16x16x32_bf16(*(const bf16x8*)(ST + (cur * 64 + 16 * w + l15) * S3_LD + kk * 32 + 8 * lg4), *(const bf16x8*)(Qs + (blk * 16 + l15) * S3_LD + kk * 32 + 8 * lg4), o, 0, 0, 0);
                bf16x8 va = (bf16x8){0, 0, 0, 0, 0, 0, 0, 0}, pb = va;
                if (lg4 < 2) { va = *(const bf16x8*)(Vs + (16 * w + l15) * S3_LDV + blk * 16 + 8 * lg4); pb = *(const bf16x8*)(Ps + (blk * 16 + l15) * S3_LDT + 8 * lg4); }
                o = __builtin_amdgcn_mfma_f32_16x16x32_bf16(va, pb, o, 0, 0, 0);
                u32x2 ou; ou[0] = pk2(o[0], o[1]); ou[1] = pk2(o[2], o[3]);
                *(u32x2*)(Oo + (tokb + blk * 16 + l15) * 1024 + h * 128 + half * 64 + 16 * w + 4 * lg4) = ou;
            }
            lds_barrier();
        }
    }
    lds_barrier();
#undef S3_T0
#undef S3_LOAD
#undef S3_PREP
}
DEV void readout_item(const Params& p, int item) {
    const int tok = item * 8 + (tidx() >> 6), lane = tidx() & 63;
    const bf16_t* of = (const bf16_t*)(p.ws + WS_F + F_OF) + (size_t)tok * 1024 + lane * 16; const bf16_t* ob = (const bf16_t*)(p.ws + WS_F + F_OB) + (size_t)tok * 1024 + lane * 16;
    const bf16_t* gp = (const bf16_t*)(p.ws + WS_P + P1_G) + (size_t)tok * 1024 + lane * 16;
    const float* on = p.in[I_HGON] + (lane & 7) * 16;
    float o[16], gg[16]; float ss = 0.f;
    { const u32x4 a0 = *(const u32x4*)of, a1 = *(const u32x4*)(of + 8), b0 = *(const u32x4*)ob, b1 = *(const u32x4*)(ob + 8), g0 = *(const u32x4*)gp, g1 = *(const u32x4*)(gp + 8);
#pragma unroll
      for (int i = 0; i < 4; ++i) { o[2 * i] = bflo(a0[i]) + bflo(b0[i]); o[2 * i + 1] = bfhi(a0[i]) + bfhi(b0[i]); o[8 + 2 * i] = bflo(a1[i]) + bflo(b1[i]); o[8 + 2 * i + 1] = bfhi(a1[i]) + bfhi(b1[i]);
          gg[2 * i] = bflo(g0[i]); gg[2 * i + 1] = bfhi(g0[i]); gg[8 + 2 * i] = bflo(g1[i]); gg[8 + 2 * i + 1] = bfhi(g1[i]); } }
#pragma unroll
    for (int i = 0; i < 16; ++i) ss += o[i] * o[i];
    ss += __shfl_xor(ss, 1); ss += __shfl_xor(ss, 2); ss += __shfl_xor(ss, 4);
    const float rstd = rsqrtf(ss * (1.f / 128.f) + 1e-6f);
    bf16_t* M = (bf16_t*)(p.ws + WS_M) + (size_t)tok * 1024 + lane * 16;
    u32x4 o0, o1; float r[16];
#pragma unroll
    for (int i = 0; i < 16; ++i) r[i] = o[i] * rstd * on[i] * gg[i];
#pragma unroll
    for (int i = 0; i < 4; ++i) { o0[i] = pk2(r[2 * i], r[2 * i + 1]); o1[i] = pk2(r[8 + 2 * i], r[8 + 2 * i + 1]); }
    *(u32x4*)M = o0; *(u32x4*)(M + 8) = o1;
}

#ifndef HOST_EMU
#define XB_TMO      128
#define XB_XCNT(j)  (256  + 64 * (j))
#define XB_XSUB(j)  (1280 + 64 * (j))
#define XB_XGEN(j)  (2304 + 64 * (j))
#define XB_TOP      3328
#define XB_TOPGEN   3392
#define XCD_BAR_WORDS 3456
#define XB_SPIN_CAP (1u << 18)
#define LAS __attribute__((address_space(3)))

__device__ __forceinline__ unsigned xb_ld(unsigned* p)              { return __hip_atomic_load(p, __ATOMIC_RELAXED, __HIP_MEMORY_SCOPE_AGENT); }
__device__ __forceinline__ unsigned xb_add(unsigned* p, unsigned v) { return __hip_atomic_fetch_add(p, v, __ATOMIC_RELAXED, __HIP_MEMORY_SCOPE_AGENT); }
__device__ __forceinline__ unsigned xb_xcc_id() { return (unsigned)__builtin_amdgcn_s_getreg((3 << 11) | 20) & 0xFu; }
#define XB_SPIN(cond, bar) do { unsigned _sp = 0; while (cond) { __builtin_amdgcn_s_sleep(1); \
    if ((++_sp & 255u) == 0u) { if (xb_ld(&(bar)[XB_TMO])) break; if (_sp > XB_SPIN_CAP) { atomicAdd(&(bar)[XB_TMO], 1u); break; } } } } while (0)

struct XcdBarrier {
    unsigned* bar; unsigned x;
    volatile LAS unsigned* st;
};

__device__ __forceinline__ XcdBarrier xcd_barrier_post(unsigned* bar, volatile LAS unsigned* st) {
    XcdBarrier b; b.bar = bar; b.x = xb_xcc_id(); b.st = st;
    if (threadIdx.x == 0) (void)xb_add(&bar[XB_XCNT(b.x)], 1u);
    return b;
}
__device__ __forceinline__ void xcd_barrier_complete(unsigned* bar, unsigned x, unsigned& nloc, unsigned& nx) {
    const unsigned G = gridDim.x * gridDim.y * gridDim.z;
    unsigned sum, cnt, mine, sp = 0u;
    for (;;) {
        sum = 0u; cnt = 0u; mine = 0u;
#pragma unroll
        for (unsigned j = 0; j < 16; ++j) { const unsigned c = xb_ld(&bar[XB_XCNT(j)]); sum += c; cnt += (c > 0u) ? 1u : 0u; mine = (j == x) ? c : mine; }
        if (sum == G) break;
        __builtin_amdgcn_s_sleep(1);
        if ((++sp & 255u) == 0u) { if (xb_ld(&bar[XB_TMO])) break; if (sp > XB_SPIN_CAP) { atomicAdd(&bar[XB_TMO], 1u); break; } }
    }
    nloc = mine > 0u ? mine : 1u; nx = cnt > 0u ? cnt : 1u;
}

__device__ __forceinline__ void xcd_barrier(const XcdBarrier& b) {
    asm volatile("s_waitcnt vmcnt(0)" ::: "memory");
    __syncthreads();
    if (threadIdx.x == 0) {
        unsigned* bar = b.bar;
        __builtin_amdgcn_s_waitcnt(0);
        unsigned nloc = b.st[0], nx = b.st[1];
        if (nloc == 0u) { xcd_barrier_complete(bar, b.x, nloc, nx); b.st[0] = nloc; b.st[1] = nx; }
        const unsigned old = xb_add(&bar[XB_XSUB(b.x)], 1u);
        const unsigned gen = old / nloc;
        if (old + 1u == (gen + 1u) * nloc) {
            __builtin_amdgcn_fence(__ATOMIC_RELEASE, "agent");
            asm volatile("s_waitcnt vmcnt(0)" ::: "memory");
            const unsigned og = xb_add(&bar[XB_TOP], 1u);
            const unsigned tg = og / nx;
            if (og + 1u == (tg + 1u) * nx) xb_add(&bar[XB_TOPGEN], 1u);
            else XB_SPIN(xb_ld(&bar[XB_TOPGEN]) == tg, bar);
            __builtin_amdgcn_fence(__ATOMIC_ACQUIRE, "agent");
            xb_add(&bar[XB_XGEN(b.x)], 1u);
            asm volatile("s_waitcnt vmcnt(0)" ::: "memory");
        } else {
            XB_SPIN(xb_ld(&bar[XB_XGEN(b.x)]) == gen, bar);
            __builtin_amdgcn_fence(__ATOMIC_ACQUIRE, "agent");
            asm volatile("s_waitcnt vmcnt(0)" ::: "memory");
        }
    }
    __syncthreads();
}

#endif
#ifdef NOINLINE_PHASES
#define NOINL __device__ __attribute__((noinline))
#else
#define NOINL __device__ __forceinline__
#endif
__shared__ __attribute__((aligned(16))) unsigned char g_smem[SMEM_BYTES + 16];
#define PH_COMMON const int G = gridDim.x, bid = blockIdx.x; unsigned char* smem = g_smem; (void)smem; (void)G; (void)bid; \
    const bf16_t* A = (const bf16_t*)(p.ws + WS_A); const bf16_t* Mx = (const bf16_t*)(p.ws + WS_M); const bf16_t* W = (const bf16_t*)(p.ws + WS_W); (void)A; (void)Mx; (void)W;
DEV void tables_in_gemm_tail(const Params& p, int layer, int nunits) {
    const int G = gridDim.x, bid = blockIdx.x, busy = nunits % G;
    if (busy == 0) { for (int it = bid; it < 2 * P0_TAB; it += G) p0_table(p, layer * 2 + it / P0_TAB, it % P0_TAB); return; }
    if (bid < busy) return;
    for (int it = bid - busy; it < 2 * P0_TAB; it += G - busy) p0_table(p, layer * 2 + it / P0_TAB, it % P0_TAB);
}
NOINL void ph0(const Params& p) { PH_COMMON phase0(p, smem); }
NOINL void ph1(const Params& p) { PH_COMMON phase1(p, smem); }
NOINL void ph2(const Params& p) { PH_COMMON EpiL0InT e{p.ws}; gemm_pg8_T(A, W + W_IN0 / 2, T, 2304, smem, e); tables_in_gemm_tail(p, 0, (T / 256) * 9); }
NOINL void ph3(const Params& p, int var = 0) { PH_COMMON phase3(p, smem, var); }
NOINL void ph4(const Params& p) { PH_COMMON EpiRes e{&p, 1, 0, 2048}; gemm_pg8_N(Mx, W + W_OUT0 / 2, T, 1024, smem, e); tables_in_gemm_tail(p, 1, (T / 256) * 4); }
NOINL void ph5(const Params& p) { PH_COMMON for (int it = bid; it < T / 8; it += G) norm_rows_item(p, it, 0, p.in[I_N2G], 0, 3072); }
NOINL void ph6(const Params& p, int var = 0) { PH_COMMON (void)var; EpiBf16 e{(bf16_t*)(p.ws + WS_P), 2048}; gemm_pg8_N(A, W + W_Q0 / 2, T, 2048, smem, e); }
NOINL void ph7(const Params& p) { PH_COMMON topk_phase(p, 0, T, smem); }
NOINL void ph8(const Params& p) { PH_COMMON for (int it = bid; it < T / 8; it += G) peer_item(p, 0, it); }
NOINL void ph9(const Params& p) { PH_COMMON EpiHgT e{p.ws, p.in[I_HGLB]}; gemm_pg8_T(A, W + W_IN1 / 2, T, 5120, smem, e); }
NOINL void ph10(const Params& p, int var = 0) { PH_COMMON for (int bi = bid; bi < NB * 32; bi += G) scan_block(p, bi, smem, var); }
NOINL void ph11(const Params& p) { PH_COMMON for (int it = bid; it < TL / 8; it += G) readout_item(p, it); }
NOINL void ph12(const Params& p) { PH_COMMON EpiRes e{&p, 0, 1, 2048}; gemm_pg8_N(Mx, W + W_OUT1 / 2, TL, 1024, smem, e); }
NOINL void ph13(const Params& p) { PH_COMMON for (int it = bid; it < TL / 8; it += G) norm_rows_item(p, it, 0, p.in[I_N2G] + 1024, 1, 3072); }
NOINL void ph14(const Params& p) { PH_COMMON EpiBf16 e{(bf16_t*)(p.ws + WS_P), 2048}; gemm_pg8_N(A, W + W_Q1 / 2, TL, 2048, smem, e); }
NOINL void ph15(const Params& p) { PH_COMMON topk_phase(p, 1, TL, smem); }
NOINL void ph16(const Params& p, int var = 0) { PH_COMMON for (int it = bid; it < TL / 8; it += G) peer_item(p, 1, it, var); }

constexpr int NPHASE = 17;
__global__ void __launch_bounds__(NT, 2) mega(Params p_in) {
    const int ph_lo = p_in.ph_lo, ph_hi = p_in.ph_hi;
#ifndef HOST_EMU
#define GBAR_MAKE() XcdBarrier gbar; gbar.bar = (unsigned*)(p_in.ws + WS_CTRL); gbar.x = xb_xcc_id(); gbar.st = (volatile LAS unsigned*)(LAS unsigned char*)(g_smem + SMEM_BYTES);
    if (ph_hi - ph_lo > 1) {
        volatile LAS unsigned* st = (volatile LAS unsigned*)(LAS unsigned char*)(g_smem + SMEM_BYTES);
        if (threadIdx.x == 0) { st[0] = 0u; st[1] = 0u; }
        __syncthreads();
        (void)xcd_barrier_post((unsigned*)(p_in.ws + WS_CTRL), st);
    }
#endif
    for (int ph = ph_lo; ph < ph_hi; ++ph) {
        if (ph > ph_lo) {
#ifndef HOST_EMU
            { GBAR_MAKE(); xcd_barrier(gbar); }
#endif
        }
#ifndef HOST_EMU
        unsigned long long kp = (unsigned long long)__builtin_amdgcn_kernarg_segment_ptr();
        asm volatile("" : "+s"(kp) :: "memory");
        const Params& p = *(const Params*)(const __attribute__((address_space(4))) Params*)kp;
#else
        const Params& p = p_in;
#endif
#ifdef REPEAT_MASK
        for (int rep_ = ((REPEAT_MASK >> ph) & 1); rep_ >= 0; --rep_) { if (rep_ == 0 && ((REPEAT_MASK >> ph) & 1)) { GBAR_MAKE(); xcd_barrier(gbar); }
#else
        {
#endif
#ifdef ONLY_PHASE
        if (ph != ONLY_PHASE) continue;
        switch (ONLY_PHASE) {
#else
        switch (ph) {
#endif
        case 0: ph0(p); break; case 1: ph1(p); break; case 2: ph2(p); break; case 3:
#if defined(REPEAT_MASK) && defined(P3_VAR)
            ph3(p, rep_ == 1 ? P3_VAR : 0);
#else
            ph3(p);
#endif
            break; case 4: ph4(p); break; case 5: ph5(p); break;
        case 6:
#if defined(REPEAT_MASK) && defined(G_VAR)
            ph6(p, rep_ == 1 ? G_VAR : 0);
#else
            ph6(p);
#endif
            break; case 7: ph7(p); break; case 8: ph8(p); break; case 9: ph9(p); break; case 10:
#if defined(REPEAT_MASK) && defined(SCAN_VAR)
            ph10(p, rep_ == 1 ? SCAN_VAR : 0);
#else
            ph10(p);
#endif
            break; case 11: ph11(p); break;
        case 12: ph12(p); break; case 13: ph13(p); break; case 14: ph14(p); break; case 15: ph15(p); break; case 16:
#if defined(REPEAT_MASK) && defined(PG_VAR)
            ph16(p, rep_ == 1 ? PG_VAR : 0);
#else
            ph16(p);
#endif
            break;
        default: break;
        }
        }
    }
}

#ifndef HOST_EMU
extern "C" void kernel_launch(void* const* d_in, const int* in_sizes, int n_in, void* d_out, int out_size, void* d_ws, size_t ws_size, hipStream_t stream) {
    if (n_in != 29 || ws_size < WS_END || out_size != TL * 1024) { fprintf(stderr, "kernel_launch: unexpected sizes (n_in %d, ws %zu need %zu, out %d)\n", n_in, ws_size, (size_t)WS_END, out_size); return; }
    static int grid = 0;
    if (!grid) { int dev = 0, cus = 0; hipGetDevice(&dev); hipDeviceGetAttribute(&cus, hipDeviceAttributeMultiprocessorCount, dev); grid = cus > 0 ? cus : 256; }
    hipMemsetAsync((unsigned char*)d_ws + WS_CTRL, 0, CTRL_BYTES, stream);
    Params p{};
    for (int i = 0; i < 29; ++i) p.in[i] = (const float*)d_in[i];
    p.out = (float*)d_out; p.ws = (unsigned char*)d_ws;
#ifdef MULTI_LAUNCH
    for (int ph = 0; ph < NPHASE; ++ph) { p.ph_lo = ph; p.ph_hi = ph + 1; hipLaunchKernelGGL(mega, dim3(grid), dim3(NT), 0, stream, p); }
#else
    p.ph_lo = 0; p.ph_hi = NPHASE;
    hipLaunchKernelGGL(mega, dim3(grid), dim3(NT), 0, stream, p);
#endif
}
#endif
```

```cpp
#ifndef HOST_EMU
#include <hip/hip_runtime.h>
#include <cstdio>
#endif

#ifndef CFG_B
#define CFG_B 8
#define CFG_L 2048
#define CFG_LC 256
#endif
#define DEV __device__ __forceinline__
#ifndef HOST_EMU
#define SCHED_FENCE() __builtin_amdgcn_sched_barrier(0)
#endif
#ifdef HOST_EMU
#define SCHED_FENCE() do {} while (0)
#define __expf expf
#define __logf logf
#define __sinf sinf
#define __cosf cosf
#endif

typedef unsigned short bf16_t;
typedef short bf16x8 __attribute__((ext_vector_type(8)));
typedef float f32x16 __attribute__((ext_vector_type(16)));
typedef float f32x4 __attribute__((ext_vector_type(4)));
typedef unsigned u32x4 __attribute__((ext_vector_type(4)));
typedef unsigned u32x2 __attribute__((ext_vector_type(2)));
struct cf2 { float x, y; };

constexpr int NB = CFG_B, L = CFG_L, LC = CFG_LC, D = 1024;
constexpr int TL = NB * L, TC = NB * LC, T = TL + TC;
constexpr int NT = 512;
constexpr int NR = NB + 1;
constexpr int log4ceil(int n) { int s = 0, v = 1; while (v < n) { v *= 4; ++s; } return s; }
constexpr int FS_LAT = log4ceil(2 * L - 1), FS_CTX = log4ceil(2 * LC - 1);
constexpr int NF_LAT = 1 << (2 * FS_LAT), NF_CTX = 1 << (2 * FS_CTX);
static_assert(T % 256 == 0 && TL % 256 == 0 && L % 128 == 0 && LC % 128 == 0 && NB % 2 == 0, "shape");

constexpr size_t al256(size_t x) { return (x + 255) & ~(size_t)255; }
constexpr size_t WS_CTRL = 0, CTRL_BYTES = 65536;
constexpr size_t CTRL_HYNORM = 4096;
constexpr size_t WS_MOD = WS_CTRL + CTRL_BYTES;
constexpr size_t WS_H = al256(WS_MOD + (size_t)2 * NR * 6144 * 4);
constexpr size_t WS_A = al256(WS_H + (size_t)T * 1024 * 4);
constexpr size_t WS_P = al256(WS_A + (size_t)T * 1024 * 2);
constexpr size_t P_BYTES = (size_t)T * 5120 * 2;
constexpr size_t P_HYT_LAT = 0;
constexpr size_t P_HYT_CTX = P_HYT_LAT + (size_t)NB * 1536 * L * 2;
constexpr size_t P_Q0 = P_HYT_CTX + (size_t)NB * 1536 * LC * 2;
constexpr size_t P_K0 = P_Q0 + (size_t)T * 512 * 2;
constexpr size_t P_VT_LAT = P_K0 + (size_t)T * 128 * 2;
constexpr size_t P_VT_CTX = P_VT_LAT + (size_t)NB * 128 * L * 2;
static_assert(P_VT_CTX + (size_t)NB * 128 * LC * 2 <= P_BYTES, "P region");
constexpr size_t P1_KQT_LAT = 0;
constexpr size_t P1_KQT_CTX = P1_KQT_LAT + (size_t)NB * 3072 * L * 2;
constexpr size_t P1_G = P1_KQT_CTX + (size_t)NB * 3072 * LC * 2;
static_assert(P1_G + (size_t)TL * 1024 * 2 <= P_BYTES, "P region (layer 1)");
constexpr size_t WS_M = al256(WS_P + P_BYTES);
constexpr size_t WS_IDX = al256(WS_M + (size_t)T * 1024 * 2);
constexpr size_t WS_GATE = al256(WS_IDX + (size_t)T * 128 * 4);
constexpr size_t WS_U6 = al256(WS_GATE + (size_t)T * 128 * 4);
constexpr size_t WS_V4 = WS_U6 + (size_t)2 * 16384 * 768;
constexpr size_t WS_S8 = WS_V4 + (size_t)2 * 16384 * 512;
constexpr size_t WS_W = al256(WS_S8 + (size_t)4 * 16384 * 4);
constexpr size_t W_IN0 = 0, W_OUT0 = W_IN0 + (size_t)2304 * 1024 * 2, W_IN1 = W_OUT0 + (size_t)1024 * 1024 * 2,
                 W_OUT1 = W_IN1 + (size_t)5120 * 1024 * 2, W_Q0 = W_OUT1 + (size_t)1024 * 1024 * 2, W_Q1 = W_Q0 + (size_t)2048 * 1024 * 2,
                 W_KEYS = W_Q1 + (size_t)2048 * 1024 * 2, W_BYTES = W_KEYS + (size_t)2 * 8 * 2 * 128 * 128 * 2;
constexpr size_t WS_F = al256(WS_W + W_BYTES);
constexpr size_t F_HRAW_LAT = 0;
constexpr size_t F_HRAW_CTX = F_HRAW_LAT + (size_t)2048 * L * 4;
constexpr size_t F_HF_LAT = F_HRAW_CTX + (size_t)2048 * LC * 4;
constexpr size_t F_HF_CTX = F_HF_LAT + (size_t)1024 * NF_LAT * 8;
constexpr size_t F_HYP_LAT = F_HF_CTX + (size_t)1024 * NF_CTX * 8;
constexpr size_t F_HYP_CTX = F_HYP_LAT + (size_t)(L / 64) * 2048 * 4;
constexpr size_t F_END = F_HYP_CTX + (size_t)(LC / 64) * 2048 * 4;
constexpr size_t F_OF = 0, F_OB = (size_t)TL * 1024 * 2;
constexpr size_t F_BYTES = F_END > 2 * F_OB ? F_END : 2 * F_OB;
constexpr size_t WS_END = al256(WS_F + F_BYTES);

struct Params { const float* in[29]; float* out; unsigned char* ws; int ph_lo, ph_hi; };
enum { I_X = 0, I_C, I_CTX, I_CCTX, I_ADAW, I_ADAB, I_N1G, I_N2G, I_FG, I_ABWIN, I_ABWOUT, I_HYCW, I_HYCB, I_HYW1, I_HYB1, I_HYW2, I_HYB2, I_HYW3,
       I_HYFREQ, I_HYSKIP, I_SINK, I_HGWIN, I_HGWOUT, I_HGLB, I_HGON, I_PWQ, I_PKEYS, I_PU, I_PV };

constexpr int SMEM_BYTES = 147456;

#ifndef HOST_EMU
DEV int tidx() { int t = threadIdx.x; asm volatile("" : "+v"(t)); return t; }
#else
DEV int tidx() { return (int)threadIdx.x; }
#endif
#ifndef HOST_EMU
DEV void lds_barrier() { asm volatile("s_waitcnt lgkmcnt(0)" ::: "memory"); __builtin_amdgcn_s_barrier(); asm volatile("" ::: "memory"); }
#else
DEV void lds_barrier() { __syncthreads(); }
#endif
#ifndef HOST_EMU
typedef __bf16 bf16n2 __attribute__((ext_vector_type(2)));
DEV unsigned pk2(float lo, float hi) { bf16n2 v; v[0] = (__bf16)lo; v[1] = (__bf16)hi; return __builtin_bit_cast(unsigned, v); }
DEV unsigned f2bf(float f) { return (unsigned)__builtin_bit_cast(unsigned short, (__bf16)f); }
#else
DEV unsigned f2bf(float f) { unsigned u = __builtin_bit_cast(unsigned, f); return (u + 0x7fffu + ((u >> 16) & 1u)) >> 16; }
DEV unsigned pk2(float lo, float hi) { return f2bf(lo) | (f2bf(hi) << 16); }
#endif
DEV float bf2f(unsigned h) { return __builtin_bit_cast(float, (h & 0xffffu) << 16); }
DEV float bflo(unsigned u) { return __builtin_bit_cast(float, u << 16); }
DEV float bfhi(unsigned u) { return __builtin_bit_cast(float, u & 0xffff0000u); }
DEV float silu_f(float x) { return x / (1.f + __expf(-x)); }
DEV float sigmoid_f(float x) { return 1.f / (1.f + __expf(-x)); }
DEV float wave_sum(float v) {
#pragma unroll
    for (int m = 32; m >= 1; m >>= 1) v += __shfl_xor(v, m);
    return v;
}
DEV int mod_row(int tok) { return tok < TL ? tok / L : NB; }

DEV void p0_mod(const Params& p, int item, unsigned char* smem) {
    const int l = item / 96, col0 = (item % 96) * 64, tid = tidx();
    float* sc = (float*)smem;
    float* red = sc + NR * 1024;
    for (int i = tid; i < NR * 1024; i += NT) { const int r = i >> 10, k = i & 1023; const float c = r < NB ? p.in[I_C][r * 1024 + k] : p.in[I_CCTX][k]; sc[i] = c / (1.f + expf(-c)); }
    __syncthreads();
    const int kq = tid >> 6, col = tid & 63;
    float acc[NR];
#pragma unroll
    for (int r = 0; r < NR; ++r) acc[r] = 0.f;
    const float* w = p.in[I_ADAW] + (size_t)l * 1024 * 6144 + col0 + col;
#pragma unroll 16
    for (int k = kq * 128; k < kq * 128 + 128; ++k) {
        const float wv = w[(size_t)k * 6144];
#pragma unroll
        for (int r = 0; r < NR; ++r) acc[r] += sc[r * 1024 + k] * wv;
    }
#pragma unroll
    for (int r = 0; r < NR; ++r) red[(kq * NR + r) * 64 + col] = acc[r];
    __syncthreads();
    float* mod = (float*)(p.ws + WS_MOD);
    for (int i = tid; i < NR * 64; i += NT) {
        const int r = i >> 6, c = i & 63; float s = 0.f;
        for (int q = 0; q < 8; ++q) s += red[(q * NR + r) * 64 + c];
        mod[((size_t)l * NR + r) * 6144 + col0 + c] = s + p.in[I_ADAB][l * 6144 + col0 + c];
    }
    __syncthreads();
}
DEV void p0_transpose(const float* W, bf16_t* Wt, int N, int tile, unsigned char* smem) {
    float* ts = (float*)smem;
    const int ntn = N / 256, kt = tile / ntn, nt = tile % ntn, k0 = kt * 64, n0 = nt * 256, tid = tidx();
    f32x4 rv[8];
#pragma unroll
    for (int m = 0; m < 8; ++m) { const int i = tid + NT * m, kk = i >> 6, c4 = i & 63; rv[m] = *(const f32x4*)(W + (size_t)(k0 + kk) * N + n0 + c4 * 4); }
#pragma unroll
    for (int m = 0; m < 8; ++m) { const int i = tid + NT * m, kk = i >> 6, c4 = i & 63; *(f32x4*)(ts + kk * 260 + c4 * 4) = rv[m]; }
    __syncthreads();
#pragma unroll
    for (int m = 0; m < 4; ++m) { const int i = tid + NT * m, nn = i >> 3, k8 = i & 7;
        u32x4 o;
#pragma unroll
        for (int e = 0; e < 4; ++e) o[e] = pk2(ts[(k8 * 8 + 2 * e) * 260 + nn], ts[(k8 * 8 + 2 * e + 1) * 260 + nn]);
        *(u32x4*)(Wt + (size_t)(n0 + nn) * 1024 + k0 + k8 * 8) = o; }
    __syncthreads();
}
DEV void p0_convert(const float* src, bf16_t* dst, int item) {
    const int tid = tidx();
#pragma unroll
    for (int i = 0; i < 8; ++i) {
        const size_t e = (size_t)item * 16384 + (size_t)(i * NT + tid) * 4;
        const f32x4 v = *(const f32x4*)(src + e);
        u32x2 o; o[0] = pk2(v[0], v[1]); o[1] = pk2(v[2], v[3]);
        *(u32x2*)(dst + e) = o;
    }
}
typedef float f32x2 __attribute__((ext_vector_type(2)));
typedef float f32x32 __attribute__((ext_vector_type(32)));
typedef unsigned u32x6 __attribute__((ext_vector_type(6)));
DEV void p0_table(const Params& p, int tab, int item) {
    const int lane = tidx() & 63, li = lane & 31, half = lane >> 5, layer = tab >> 1, isv = tab & 1;
#pragma unroll 1
    for (int pass = 0; pass < 2; ++pass) {
        const int row = item * 32 + pass * 16 + (tidx() >> 6) * 2 + half;
        const float* src = (isv ? p.in[I_PV] : p.in[I_PU]) + ((size_t)layer * 16384 + row) * 1024 + li * 32;
        f32x4 v[8]; float mx = 0.f;
#pragma unroll
        for (int i = 0; i < 8; ++i) { v[i] = *(const f32x4*)(src + 4 * i); mx = fmaxf(mx, fmaxf(fmaxf(fabsf(v[i][0]), fabsf(v[i][1])), fmaxf(fabsf(v[i][2]), fabsf(v[i][3])))); }
#pragma unroll
        for (int m = 16; m >= 1; m >>= 1) mx = fmaxf(mx, __shfl_xor(mx, m));
        const float top = isv ? 6.f : 7.5f;
        const float sc = mx > 0.f ? top / mx : 1.f;
        if (!isv) {
            f32x16 pa, pb;
#pragma unroll
            for (int i = 0; i < 16; ++i) { pa[i] = 0.f; pb[i] = 0.f; }
            pa[1] = 1.0f;
            const f32x32 pr = __builtin_amdgcn_cvt_scalef32_pk32_f32_fp6(__builtin_amdgcn_cvt_scalef32_2xpk16_fp6_f32(pa, pb, 1.0f), 1.0f);
            const bool inter = pr[2] == 1.0f;
            f32x16 lo, hi;
#pragma unroll
            for (int i = 0; i < 4; ++i)
#pragma unroll
                for (int e = 0; e < 4; ++e) {
                    const int j = 4 * i + e;
                    const float lin_lo = v[i][e], lin_hi = v[4 + i][e];
                    const float il_lo = v[(2 * j) >> 2][(2 * j) & 3], il_hi = v[(2 * j + 1) >> 2][(2 * j + 1) & 3];
                    lo[j] = (inter ? il_lo : lin_lo) * sc; hi[j] = (inter ? il_hi : lin_hi) * sc;
                }
            const u32x6 w = __builtin_amdgcn_cvt_scalef32_2xpk16_fp6_f32(lo, hi, 1.0f);
            unsigned char* dst = p.ws + WS_U6 + ((size_t)layer * 16384 + row) * 768;
            u32x4 w0; w0[0] = w[0]; w0[1] = w[1]; w0[2] = w[2]; w0[3] = w[3]; u32x2 w1; w1[0] = w[4]; w1[1] = w[5];
            *(u32x4*)(dst + li * 16) = w0; *(u32x2*)(dst + 512 + li * 8) = w1;
        } else {
            const f32x2 pr4 = __builtin_amdgcn_cvt_scalef32_pk_f32_fp4(__builtin_amdgcn_cvt_scalef32_pk_fp4_f32(0u, 1.0f, 0.0f, 1.0f, 0), 1.0f, 0);
            const bool swp = pr4[0] != 1.0f;
            u32x4 w;
#pragma unroll
            for (int d = 0; d < 4; ++d) { unsigned x = 0u;
                x = __builtin_amdgcn_cvt_scalef32_pk_fp4_f32(x, (swp ? v[2 * d][1] : v[2 * d][0]) * sc, (swp ? v[2 * d][0] : v[2 * d][1]) * sc, 1.0f, 0);
                x = __builtin_amdgcn_cvt_scalef32_pk_fp4_f32(x, (swp ? v[2 * d][3] : v[2 * d][2]) * sc, (swp ? v[2 * d][2] : v[2 * d][3]) * sc, 1.0f, 1);
                x = __builtin_amdgcn_cvt_scalef32_pk_fp4_f32(x, (swp ? v[2 * d + 1][1] : v[2 * d + 1][0]) * sc, (swp ? v[2 * d + 1][0] : v[2 * d + 1][1]) * sc, 1.0f, 2);
                x = __builtin_amdgcn_cvt_scalef32_pk_fp4_f32(x, (swp ? v[2 * d + 1][3] : v[2 * d + 1][2]) * sc, (swp ? v[2 * d + 1][2] : v[2 * d + 1][3]) * sc, 1.0f, 3);
                w[d] = x; }
            *(u32x4*)(p.ws + WS_V4 + ((size_t)layer * 16384 + row) * 512 + li * 16) = w;
        }
        if (li == 0) ((float*)(p.ws + WS_S8))[tab * 16384 + row] = mx > 0.f ? mx / top : 1.f;
    }
}
DEV void p0_filter(const Params& p, int set, int chunk, int cb, unsigned char* smem) {
    const int Ls = set ? LC : L, l0 = chunk * 64, tid = tidx();
    float* z = (float*)smem;
    float* hd1 = z + 64 * 34;
    float* hd2 = hd1 + 64 * 65;
    const float* w1 = p.in[I_HYW1]; const float* b1 = p.in[I_HYB1]; const float* w2 = p.in[I_HYW2]; const float* b2 = p.in[I_HYB2];
    const float* w3 = p.in[I_HYW3]; const float* fq = p.in[I_HYFREQ];
    for (int i = tid; i < 64 * 33; i += NT) {
        const int pp = i / 33, f = i % 33, l = l0 + pp; float val;
        if (f == 0) val = (float)l / (float)(Ls - 1);
        else { const int jb = (f - 1) & 15; const float fj = 1e-4f + (float)jb * ((15.f - 1e-4f) / 15.f); const float a = fj * (6.283185307179586f * (float)l / (float)Ls); val = f <= 16 ? __cosf(a) : -__sinf(a); }
        z[pp * 34 + f] = val;
    }
    __syncthreads();
    {
        const int j = tid & 63, p0 = tid >> 6;
        float wc[64], acc[8];
#pragma unroll
        for (int f = 0; f < 33; ++f) wc[f] = w1[f * 64 + j];
#pragma unroll
        for (int m = 0; m < 8; ++m) { float sacc = b1[j];
#pragma unroll
            for (int f = 0; f < 33; ++f) sacc = fmaf(z[(p0 + 8 * m) * 34 + f], wc[f], sacc);
            acc[m] = sacc; }
#pragma unroll
        for (int m = 0; m < 8; ++m) hd1[(p0 + 8 * m) * 65 + j] = __sinf(fq[j] * acc[m]);
        __syncthreads();
#pragma unroll
        for (int f = 0; f < 64; ++f) wc[f] = w2[f * 64 + j];
#pragma unroll
        for (int m = 0; m < 8; ++m) { float sacc = b2[j];
#pragma unroll
            for (int f = 0; f < 64; ++f) sacc = fmaf(hd1[(p0 + 8 * m) * 65 + f], wc[f], sacc);
            acc[m] = sacc; }
#pragma unroll
        for (int m = 0; m < 8; ++m) hd2[(p0 + 8 * m) * 65 + j] = __sinf(fq[j] * acc[m]);
        __syncthreads();
    }
    const float max_decay = -15.350567286626973f, min_decay = -3.0701134573253945f;
    float* hraw = (float*)(p.ws + WS_F + (set ? F_HRAW_CTX : F_HRAW_LAT));
    float* hyn = (float*)(p.ws + WS_F + (set ? F_HYP_CTX : F_HYP_LAT)) + (size_t)chunk * 2048;
    {
        const int o = cb * NT + tid;
        const int c = o & 511; const float delta = fabsf(min_decay + (float)c * ((max_decay - min_decay) / 511.f));
        float asum = 0.f;
        float* dst = hraw + (size_t)o * Ls + l0;
        for (int ph = 0; ph < 2; ++ph) {
            float acc[32];
#pragma unroll
            for (int pp = 0; pp < 32; ++pp) acc[pp] = 0.f;
#pragma unroll 1
            for (int j0 = 0; j0 < 64; j0 += 16) {
                float wv[16];
#pragma unroll
                for (int j = 0; j < 16; ++j) wv[j] = w3[(j0 + j) * 2048 + o];
#pragma unroll
                for (int j = 0; j < 16; ++j) {
#pragma unroll
                    for (int pp = 0; pp < 32; ++pp) acc[pp] = fmaf(hd2[(ph * 32 + pp) * 65 + j0 + j], wv[j], acc[pp]);
                    SCHED_FENCE();
                }
            }
#pragma unroll
            for (int q4 = 0; q4 < 8; ++q4) {
                f32x4 v;
#pragma unroll
                for (int e = 0; e < 4; ++e) { const int pp = q4 * 4 + e; const float tl = (float)(l0 + ph * 32 + pp) / (float)(Ls - 1); const float val = acc[pp] * expf(-tl * delta); v[e] = val; asum += fabsf(val); }
                *(f32x4*)(dst + ph * 32 + q4 * 4) = v;
            }
        }
        hyn[o] = asum;
    }
    __syncthreads();
}

constexpr int P0_MOD = 192, P0_TR_IN0 = 16 * 9, P0_TR_OUT0 = 64, P0_TR_IN1 = 16 * 20, P0_TR_OUT1 = 64, P0_TR_Q = 16 * 8, P0_KEYS = 32, P0_TAB = 512,
              P0_FILT = 4 * (L / 64 + LC / 64);
DEV void phase0(const Params& p, unsigned char* smem) {
    bf16_t* W = (bf16_t*)(p.ws + WS_W);
    const int total = P0_MOD + P0_FILT + P0_TR_IN0 + P0_TR_OUT0 + P0_TR_IN1 + P0_TR_OUT1 + 2 * P0_TR_Q + P0_KEYS;
    for (int it = blockIdx.x; it < total; it += gridDim.x) {
        int i = it;
        if (i < P0_MOD) { p0_mod(p, i, smem); continue; } i -= P0_MOD;
        if (i < P0_FILT) { const int ch = i >> 2, cb = i & 3; if (ch < L / 64) p0_filter(p, 0, ch, cb, smem); else p0_filter(p, 1, ch - L / 64, cb, smem); continue; } i -= P0_FILT;
        if (i < P0_TR_IN0) { p0_transpose(p.in[I_ABWIN], W + W_IN0 / 2, 2304, i, smem); continue; } i -= P0_TR_IN0;
        if (i < P0_TR_OUT0) { p0_transpose(p.in[I_ABWOUT], W + W_OUT0 / 2, 1024, i, smem); continue; } i -= P0_TR_OUT0;
        if (i < P0_TR_IN1) { p0_transpose(p.in[I_HGWIN], W + W_IN1 / 2, 5120, i, smem); continue; } i -= P0_TR_IN1;
        if (i < P0_TR_OUT1) { p0_transpose(p.in[I_HGWOUT], W + W_OUT1 / 2, 1024, i, smem); continue; } i -= P0_TR_OUT1;
        if (i < P0_TR_Q) { p0_transpose(p.in[I_PWQ], W + W_Q0 / 2, 2048, i, smem); continue; } i -= P0_TR_Q;
        if (i < P0_TR_Q) { p0_transpose(p.in[I_PWQ] + (size_t)1024 * 2048, W + W_Q1 / 2, 2048, i, smem); continue; } i -= P0_TR_Q;
        p0_convert(p.in[I_PKEYS], W + W_KEYS / 2, i);
    }
}

DEV const float* h_row(const Params& p, int layer_src_inputs, int tok) {
    if (layer_src_inputs) return tok < TL ? p.in[I_X] + (size_t)tok * 1024 : p.in[I_CTX] + (size_t)(tok - TL) * 1024;
    return (const float*)(p.ws + WS_H) + (size_t)tok * 1024;
}
DEV void norm_row_store(const Params& p, const f32x4 (&v)[4], int tok, const float* g, int layer, int sh_off, int lane) {
    float ss = 0.f;
#pragma unroll
    for (int i = 0; i < 4; ++i) ss += v[i][0] * v[i][0] + v[i][1] * v[i][1] + v[i][2] * v[i][2] + v[i][3] * v[i][3];
    ss = wave_sum(ss);
    const float rstd = rsqrtf(ss * (1.f / 1024.f) + 1e-6f);
    const float* mod = (const float*)(p.ws + WS_MOD) + ((size_t)layer * NR + mod_row(tok)) * 6144 + sh_off;
    bf16_t* A = (bf16_t*)(p.ws + WS_A) + (size_t)tok * 1024;
#pragma unroll
    for (int i = 0; i < 4; ++i) {
        const int c = i * 256 + lane * 4;
        const f32x4 gg = *(const f32x4*)(g + c), sh = *(const f32x4*)(mod + c), sc = *(const f32x4*)(mod + 1024 + c);
        u32x2 o;
        o[0] = pk2(v[i][0] * rstd * gg[0] * (1.f + sc[0]) + sh[0], v[i][1] * rstd * gg[1] * (1.f + sc[1]) + sh[1]);
        o[1] = pk2(v[i][2] * rstd * gg[2] * (1.f + sc[2]) + sh[2], v[i][3] * rstd * gg[3] * (1.f + sc[3]) + sh[3]);
        *(u32x2*)(A + c) = o;
    }
}
DEV void norm_rows_item(const Params& p, int item, int from_inputs, const float* g, int layer, int sh_off) {
    const int tok = item * 8 + (tidx() >> 6), lane = tidx() & 63;
    const float* src = h_row(p, from_inputs, tok);
    f32x4 v[4];
#pragma unroll
    for (int i = 0; i < 4; ++i) v[i] = *(const f32x4*)(src + i * 256 + lane * 4);
    norm_row_store(p, v, tok, g, layer, sh_off, lane);
}

DEV cf2 cmul(cf2 a, cf2 b) { cf2 r; r.x = a.x * b.x - a.y * b.y; r.y = a.x * b.y + a.y * b.x; return r; }
DEV cf2 twid(int k, float invN) { cf2 r; const float a = (float)k * invN; r.x = __builtin_amdgcn_cosf(a); r.y = -__builtin_amdgcn_sinf(a); return r; }
DEV int fsw(int i) { return i ^ ((i >> 4) & 15) ^ (((i >> 8) & 1) << 4); }
DEV void bfly4_fwd(cf2& a0, cf2& a1, cf2& a2, cf2& a3) {
    cf2 t0, t1, t2, t3; t0.x = a0.x + a2.x; t0.y = a0.y + a2.y; t1.x = a0.x - a2.x; t1.y = a0.y - a2.y; t2.x = a1.x + a3.x; t2.y = a1.y + a3.y;
    const float dx = a1.x - a3.x, dy = a1.y - a3.y; t3.x = dy; t3.y = -dx;
    a0.x = t0.x + t2.x; a0.y = t0.y + t2.y; a1.x = t1.x + t3.x; a1.y = t1.y + t3.y; a2.x = t0.x - t2.x; a2.y = t0.y - t2.y; a3.x = t1.x - t3.x; a3.y = t1.y - t3.y;
}
DEV void bfly4_inv(cf2& c0, cf2& c1, cf2& c2, cf2& c3) {
    cf2 t0, t1, t2, t3; t0.x = c0.x + c2.x; t0.y = c0.y + c2.y; t1.x = c0.x - c2.x; t1.y = c0.y - c2.y; t2.x = c1.x + c3.x; t2.y = c1.y + c3.y;
    const float dx = c1.x - c3.x, dy = c1.y - c3.y; t3.x = -dy; t3.y = dx;
    c0.x = t0.x + t2.x; c0.y = t0.y + t2.y; c1.x = t1.x + t3.x; c1.y = t1.y + t3.y; c2.x = t0.x - t2.x; c2.y = t0.y - t2.y; c3.x = t1.x - t3.x; c3.y = t1.y - t3.y;
}
DEV void fft_stage4(cf2* buf, int S, int s, int g, int G, bool inv) {
    const int N = 1 << (2 * S); const float invN = 1.f / (float)N;
    const int lm = 2 * (S - s), m = 1 << lm, q = m >> 2;
    for (int bf = g; bf < (N >> 2); bf += G) {
        const int j = bf & (q - 1), base = ((bf >> (lm - 2)) << lm) + j, tw = j << (2 * s);
        cf2 a0 = buf[fsw(base)], a1 = buf[fsw(base + q)], a2 = buf[fsw(base + 2 * q)], a3 = buf[fsw(base + 3 * q)];
        if (!inv) { bfly4_fwd(a0, a1, a2, a3); a1 = cmul(a1, twid(tw, invN)); a2 = cmul(a2, twid(2 * tw, invN)); a3 = cmul(a3, twid(3 * tw, invN)); }
        else { cf2 w1 = twid(tw, invN), w2 = twid(2 * tw, invN), w3 = twid(3 * tw, invN); w1.y = -w1.y; w2.y = -w2.y; w3.y = -w3.y; a1 = cmul(a1, w1); a2 = cmul(a2, w2); a3 = cmul(a3, w3); bfly4_inv(a0, a1, a2, a3); }
        buf[fsw(base)] = a0; buf[fsw(base + q)] = a1; buf[fsw(base + 2 * q)] = a2; buf[fsw(base + 3 * q)] = a3;
    }
}
DEV void fft_stage16(cf2* buf, int S, int s, int g, int G, bool inv) {
    const int N = 1 << (2 * S); const float invN = 1.f / (float)N;
    const int lm = 2 * (S - s), m = 1 << lm, q = m >> 2, q2 = q >> 2;
    for (int u = g; u < (N >> 4); u += G) {
        const int j2 = u & (q2 - 1), base = ((u >> (lm - 4)) << lm) + j2;
        cf2 x[4][4];
#pragma unroll
        for (int c = 0; c < 4; ++c)
#pragma unroll
            for (int c2 = 0; c2 < 4; ++c2) x[c][c2] = buf[fsw(base + c * q + c2 * q2)];
        if (!inv) {
#pragma unroll
            for (int c2 = 0; c2 < 4; ++c2) {
                const int tw = (j2 + c2 * q2) << (2 * s);
                bfly4_fwd(x[0][c2], x[1][c2], x[2][c2], x[3][c2]);
                x[1][c2] = cmul(x[1][c2], twid(tw, invN)); x[2][c2] = cmul(x[2][c2], twid(2 * tw, invN)); x[3][c2] = cmul(x[3][c2], twid(3 * tw, invN));
            }
            const int tw2 = j2 << (2 * (s + 1));
            const cf2 v1 = twid(tw2, invN), v2 = twid(2 * tw2, invN), v3 = twid(3 * tw2, invN);
#pragma unroll
            for (int c = 0; c < 4; ++c) {
                bfly4_fwd(x[c][0], x[c][1], x[c][2], x[c][3]);
                x[c][1] = cmul(x[c][1], v1); x[c][2] = cmul(x[c][2], v2); x[c][3] = cmul(x[c][3], v3);
            }
        } else {
            const int tw2 = j2 << (2 * (s + 1));
            cf2 v1 = twid(tw2, invN), v2 = twid(2 * tw2, invN), v3 = twid(3 * tw2, invN); v1.y = -v1.y; v2.y = -v2.y; v3.y = -v3.y;
#pragma unroll
            for (int c = 0; c < 4; ++c) {
                x[c][1] = cmul(x[c][1], v1); x[c][2] = cmul(x[c][2], v2); x[c][3] = cmul(x[c][3], v3);
                bfly4_inv(x[c][0], x[c][1], x[c][2], x[c][3]);
            }
#pragma unroll
            for (int c2 = 0; c2 < 4; ++c2) {
                const int tw = (j2 + c2 * q2) << (2 * s);
                cf2 w1 = twid(tw, invN), w2 = twid(2 * tw, invN), w3 = twid(3 * tw, invN); w1.y = -w1.y; w2.y = -w2.y; w3.y = -w3.y;
                x[1][c2] = cmul(x[1][c2], w1); x[2][c2] = cmul(x[2][c2], w2); x[3][c2] = cmul(x[3][c2], w3);
                bfly4_inv(x[0][c2], x[1][c2], x[2][c2], x[3][c2]);
            }
        }
#pragma unroll
        for (int c = 0; c < 4; ++c)
#pragma unroll
            for (int c2 = 0; c2 < 4; ++c2) buf[fsw(base + c * q + c2 * q2)] = x[c][c2];
    }
}
DEV void fft_fwd(cf2* buf, int S, int g, int G) {
    int s = 0;
    for (; s + 1 < S; s += 2) { fft_stage16(buf, S, s, g, G, false); __syncthreads(); }
    if (s < S) { fft_stage4(buf, S, s, g, G, false); __syncthreads(); }
}
DEV void fft_inv(cf2* buf, int S, int g, int G) {
    int s = S - 1;
    if (S & 1) { fft_stage4(buf, S, s, g, G, true); __syncthreads(); --s; }
    for (; s >= 1; s -= 2) { fft_stage16(buf, S, s - 1, g, G, true); __syncthreads(); }
}
DEV void hf_item(const Params& p, int set, int pi, unsigned char* smem) {
    const int Ls = set ? LC : L, S = set ? FS_CTX : FS_LAT, N = 1 << (2 * S);
    const int gi = tidx() >> 8, g = tidx() & 255, idx = pi * 2 + gi, o = idx >> 9, c = idx & 511;
    cf2* buf = (cf2*)smem + (size_t)gi * N;
    const float* hraw = (const float*)(p.ws + WS_F + (set ? F_HRAW_CTX : F_HRAW_LAT));
    const float* hyn = (const float*)(p.ws + WS_F + (set ? F_HYP_CTX : F_HYP_LAT));
    float nsum = 0.f;
    for (int ch = 0; ch < Ls / 64; ++ch) nsum += hyn[(size_t)ch * 2048 + o * 1024 + c] + hyn[(size_t)ch * 2048 + o * 1024 + 512 + c];
    const float inv = 1.f / nsum;
    const float* hf = hraw + (size_t)(o * 1024 + c) * Ls; const float* hb = hraw + (size_t)(o * 1024 + 512 + c) * Ls;
#pragma unroll 4
    for (int k = g; k < N; k += 256) { float re = 0.f; if (k < Ls) re = hf[k] * inv; else if (k > N - Ls) re = hb[N - k] * inv; cf2 v; v.x = re; v.y = 0.f; buf[fsw(k)] = v; }
    __syncthreads();
    fft_fwd(buf, S, g, 256);
    cf2* HF = (cf2*)(p.ws + WS_F + (set ? F_HF_CTX : F_HF_LAT)) + (size_t)(o * 512 + c) * N;
    for (int k = g; k < N; k += 256) HF[k] = buf[fsw(k)];
    __syncthreads();
}
constexpr int P1_NORM = T / 8, P1_HF = 512;
DEV void phase1(const Params& p, unsigned char* smem) {
    const int total = P1_NORM + 2 * P1_HF;
    for (int it = blockIdx.x; it < total; it += gridDim.x) {
        if (it < P1_NORM) norm_rows_item(p, it, 1, p.in[I_N1G], 0, 0);
        else if (it < P1_NORM + P1_HF) hf_item(p, 0, it - P1_NORM, smem);
        else hf_item(p, 1, it - P1_NORM - P1_HF, smem);
    }
}

constexpr int G_LDA = 72;
template <class Epi>
DEV void gemm_tile(const bf16_t* __restrict__ A, const bf16_t* __restrict__ Wt, int m0, int n0, unsigned char* smem, const Epi& epi, int var = 0) {
    bf16_t* As = (bf16_t*)smem;
    bf16_t* Bs = As + 2 * 256 * G_LDA;
    const int tid = tidx(), lane = tid & 63, w = tid >> 6, wm = w >> 1, wn = w & 1;
    f32x16 acc[2][2];
#pragma unroll
    for (int i = 0; i < 2; ++i)
#pragma unroll
        for (int j = 0; j < 2; ++j)
#pragma unroll
            for (int r = 0; r < 16; ++r) acc[i][j][r] = 0.f;
    u32x4 ra[4], rb[2];
    const bf16_t* Ag = A + (size_t)m0 * 1024; const bf16_t* Bg = Wt + (size_t)n0 * 1024;
#define GLOAD(k0) do { \
        _Pragma("unroll") for (int i = 0; i < 4; ++i) { const int id = tid + NT * i, row = id >> 3, kc = id & 7; ra[i] = *(const u32x4*)(Ag + (size_t)row * 1024 + (k0) + kc * 8); } \
        _Pragma("unroll") for (int i = 0; i < 2; ++i) { const int id = tid + NT * i, row = id >> 3, kc = id & 7; rb[i] = *(const u32x4*)(Bg + (size_t)row * 1024 + (k0) + kc * 8); } } while (0)
#define LSTORE(buf_) do { \
        _Pragma("unroll") for (int i = 0; i < 4; ++i) { const int id = tid + NT * i, row = id >> 3, kc = id & 7; *(u32x4*)(As + ((buf_) * 256 + row) * G_LDA + kc * 8) = ra[i]; } \
        _Pragma("unroll") for (int i = 0; i < 2; ++i) { const int id = tid + NT * i, row = id >> 3, kc = id & 7; *(u32x4*)(Bs + ((buf_) * 128 + row) * G_LDA + kc * 8) = rb[i]; } } while (0)
    GLOAD(0); LSTORE(0); __syncthreads();
    for (int kt = 0; kt < (var == 2 ? 1 : 16); ++kt) {
        const int buf = kt & 1;
        if (kt + 1 < 16) GLOAD((kt + 1) * 64);
        const bf16_t* as = As + (buf * 256 + wm * 64 + (lane & 31)) * G_LDA + 8 * (lane >> 5);
        const bf16_t* bs = Bs + (buf * 128 + wn * 64 + (lane & 31)) * G_LDA + 8 * (lane >> 5);
#pragma unroll
        for (int kk = 0; kk < 4; ++kk) {
            const bf16x8 a0 = *(const bf16x8*)(as + kk * 16), a1 = *(const bf16x8*)(as + 32 * G_LDA + kk * 16);
            const bf16x8 b0 = *(const bf16x8*)(bs + kk * 16), b1 = *(const bf16x8*)(bs + 32 * G_LDA + kk * 16);
            acc[0][0] = __builtin_amdgcn_mfma_f32_32x32x16_bf16(a0, b0, acc[0][0], 0, 0, 0);
            acc[0][1] = __builtin_amdgcn_mfma_f32_32x32x16_bf16(a0, b1, acc[0][1], 0, 0, 0);
            acc[1][0] = __builtin_amdgcn_mfma_f32_32x32x16_bf16(a1, b0, acc[1][0], 0, 0, 0);
            acc[1][1] = __builtin_amdgcn_mfma_f32_32x32x16_bf16(a1, b1, acc[1][1], 0, 0, 0);
        }
        if (kt + 1 < 16) LSTORE(buf ^ 1);
        __syncthreads();
    }
#ifndef HOST_EMU
    if (var == 1) { asm volatile("" :: "v"(acc[0][0]), "v"(acc[0][1]), "v"(acc[1][0]), "v"(acc[1][1])); return; }
#endif
#pragma unroll
    for (int mi = 0; mi < 2; ++mi)
#pragma unroll
        for (int ni = 0; ni < 2; ++ni)
#pragma unroll
            for (int rg = 0; rg < 4; ++rg) {
                const int row = m0 + wm * 64 + mi * 32 + 8 * rg + 4 * (lane >> 5), col = n0 + wn * 64 + ni * 32 + (lane & 31);
                epi(row, col, acc[mi][ni][rg * 4 + 0], acc[mi][ni][rg * 4 + 1], acc[mi][ni][rg * 4 + 2], acc[mi][ni][rg * 4 + 3]);
            }
}
template <class Epi>
DEV void gemm_tile256(const bf16_t* __restrict__ A, const bf16_t* __restrict__ Wt, int m0, int n0, unsigned char* smem, const Epi& epi) {
    bf16_t* As = (bf16_t*)smem;
    bf16_t* Bs = As + 2 * 256 * G_LDA;
    const int tid = tidx(), lane = tid & 63, w = tid >> 6, wm = w >> 2, wn = w & 3;
    f32x16 acc[4][2];
#pragma unroll
    for (int i = 0; i < 4; ++i)
#pragma unroll
        for (int j = 0; j < 2; ++j)
#pragma unroll
            for (int r = 0; r < 16; ++r) acc[i][j][r] = 0.f;
    u32x4 ra[4], rb[4];
    const bf16_t* Ag = A + (size_t)m0 * 1024; const bf16_t* Bg = Wt + (size_t)n0 * 1024;
#define GLOAD2(k0) do { \
        _Pragma("unroll") for (int i = 0; i < 4; ++i) { const int id = tid + NT * i, row = id >> 3, kc = id & 7; ra[i] = *(const u32x4*)(Ag + (size_t)row * 1024 + (k0) + kc * 8); rb[i] = *(const u32x4*)(Bg + (size_t)row * 1024 + (k0) + kc * 8); } } while (0)
#define LSTORE2(buf_) do { \
        _Pragma("unroll") for (int i = 0; i < 4; ++i) { const int id = tid + NT * i, row = id >> 3, kc = id & 7; *(u32x4*)(As + ((buf_) * 256 + row) * G_LDA + kc * 8) = ra[i]; *(u32x4*)(Bs + ((buf_) * 256 + row) * G_LDA + kc * 8) = rb[i]; } } while (0)
    GLOAD2(0); LSTORE2(0); __syncthreads();
    for (int kt = 0; kt < 16; ++kt) {
        const int buf = kt & 1;
        if (kt + 1 < 16) GLOAD2((kt + 1) * 64);
        const bf16_t* as = As + (buf * 256 + wm * 128 + (lane & 31)) * G_LDA + 8 * (lane >> 5);
        const bf16_t* bs = Bs + (buf * 256 + wn * 64 + (lane & 31)) * G_LDA + 8 * (lane >> 5);
#pragma unroll
        for (int kk = 0; kk < 4; ++kk) {
            bf16x8 af[4], bfr[2];
#pragma unroll
            for (int i = 0; i < 4; ++i) af[i] = *(const bf16x8*)(as + i * 32 * G_LDA + kk * 16);
#pragma unroll
            for (int j = 0; j < 2; ++j) bfr[j] = *(const bf16x8*)(bs + j * 32 * G_LDA + kk * 16);
#pragma unroll
            for (int i = 0; i < 4; ++i)
#pragma unroll
                for (int j = 0; j < 2; ++j) acc[i][j] = __builtin_amdgcn_mfma_f32_32x32x16_bf16(af[i], bfr[j], acc[i][j], 0, 0, 0);
        }
        if (kt + 1 < 16) LSTORE2(buf ^ 1);
        __syncthreads();
    }
#undef GLOAD2
#undef LSTORE2
#pragma unroll
    for (int mi = 0; mi < 4; ++mi)
#pragma unroll
        for (int ni = 0; ni < 2; ++ni)
#pragma unroll
            for (int rg = 0; rg < 4; ++rg) {
                const int row = m0 + wm * 128 + mi * 32 + 8 * rg + 4 * (lane >> 5), col = n0 + wn * 64 + ni * 32 + (lane & 31);
                epi(row, col, acc[mi][ni][rg * 4 + 0], acc[mi][ni][rg * 4 + 1], acc[mi][ni][rg * 4 + 2], acc[mi][ni][rg * 4 + 3]);
            }
}
namespace pg8 {
#ifndef HOST_EMU
#define PG8_LAS __attribute__((address_space(3)))
#else
#define PG8_LAS
#endif
typedef unsigned short bf16_t;
constexpr int BM = 256, BK = 64, HALF = 128, HTB = HALF * BK * 2  , STAGE_BYTES = 8 * HTB, NXCD = 8, WGM = 8;

__host__ __device__ __forceinline__ int lds_byte(int r, int c) { const int st = (r >> 4) * 2 + (c >> 5), rr = r & 15, cc = c & 31, ob = rr * 64 + cc * 2; return st * 1024 + (ob ^ (((ob >> 9) & 1) << 5)); }
__host__ __device__ __forceinline__ void stage_rc(int b, int& R, int& C) { const int st = b / 1024, sb = b % 1024, swz = sb ^ (((sb >> 9) & 1) << 5); R = (st >> 1) * 16 + swz / 64; C = (st & 1) * 32 + (swz % 64) / 2; }
__host__ __device__ __forceinline__ int perm32(int rho) { const int n = rho >> 4, i = rho & 15; return 8 * (i >> 2) + 4 * n + (i & 3); }

struct Unit { int pm, pn; };
struct Gemm { const bf16_t* A; const bf16_t* Bt; int M, N, K; };

struct StaticOrder {
    int nM, nN, nwg, G, c;
    __host__ __device__ void init(int M, int N, int G_, int c_) { nM = M / BM; nN = N / BM; nwg = nM * nN; G = G_; c = c_; }
    __host__ __device__ bool next(int i, Unit& u) const {
        const long L = (long)i * G + c; if (L >= nwg) return false;
        int wgid = (int)L; { const int q = nwg / NXCD, r = nwg % NXCD, xcd = wgid % NXCD, off = wgid / NXCD; wgid = (xcd < r ? xcd * (q + 1) : r * (q + 1) + (xcd - r) * q) + off; }
        const int nig = WGM * nN, gid = wgid / nig, fm = gid * WGM, gsz = (nM - fm) < WGM ? (nM - fm) : WGM;
        u.pm = fm + ((wgid % nig) % gsz); u.pn = (wgid % nig) / gsz; return true;
    }
    __device__ __forceinline__ void a_ready(const Unit&) const {}
    __device__ __forceinline__ void done(const Unit&) const {}
};
template <class Epi, class Sched, bool STAMP = false>
__device__ __forceinline__ void gemm_phase(PG8_LAS unsigned char* lds, const Gemm g, const Sched& S, const Epi& E, unsigned long long* stamps = nullptr) {
    const int tid = tidx(), wid = __builtin_amdgcn_readfirstlane(tid >> 6), lane = tid & 63, wr = wid >> 2, wc = wid & 3, fr = lane & 15, fq = lane >> 4;
    const int K = g.K, nt = K / BK;
    int ts_lo = 0, ts_hi = 0, nts = 0; const unsigned long long rt_entry = 0ull; (void)rt_entry; (void)ts_lo; (void)ts_hi; (void)nts;
#define PG8_STAMP() do { if (STAMP && wid == 0 && nts < 64) { const unsigned long long _c = 0ull; \
        ts_lo = (lane == nts) ? (int)(unsigned)_c : ts_lo; ts_hi = (lane == nts) ? (int)(unsigned)(_c >> 32) : ts_hi; ++nts; } } while (0)
    PG8_STAMP();
    unsigned voffA[2], voffB[2];
#pragma unroll
    for (int i = 0; i < 2; ++i) { int R, C; stage_rc(tid * 16 + i * 8192, R, C); const int Rb = Epi::PERM ? ((R & ~31) + perm32(R & 31)) : R;
        voffA[i] = (unsigned)(R * K + C) * 2u; voffB[i] = (unsigned)(Rb * K + C) * 2u; }
    const size_t kstep = (size_t)(BK * 2);
    const size_t hstep = (size_t)HALF * K * 2;
    const size_t tstep = 2 * hstep;
    const unsigned ldsw = (unsigned)wid * 1024u;
    const int aoff = lds_byte(wr * 64 + fr, fq * 8), boff = lds_byte(wc * 32 + fr, fq * 8);
#define PG8_SA(b, h) (((b) * 2 + (h)) * HTB)
#define PG8_SB(b, h) ((4 + (b) * 2 + (h)) * HTB)
#define PG8_STAGE(bufoff, gbase, voff) do { _Pragma("unroll") for (int _i = 0; _i < 2; ++_i) \
        __builtin_amdgcn_global_load_lds((const unsigned*)((const char*)(gbase) + (voff)[_i]), (PG8_LAS unsigned*)(lds + (bufoff) + ldsw + _i * 8192), 16, 0, 0); } while (0)
#define PG8_LDA(dst, b, h) do { _Pragma("unroll") for (int m = 0; m < 4; ++m) _Pragma("unroll") for (int k = 0; k < 2; ++k) dst[m][k] = *(const PG8_LAS bf16x8*)(lds + PG8_SA(b, h) + aoff + m * 2048 + k * 1024); } while (0)
#define PG8_LDB(dst, b, h) do { _Pragma("unroll") for (int n = 0; n < 2; ++n) _Pragma("unroll") for (int k = 0; k < 2; ++k) dst[n][k] = *(const PG8_LAS bf16x8*)(lds + PG8_SB(b, h) + boff + n * 2048 + k * 1024); } while (0)
#define PG8_MMA(ai, bj, At, Bt) do { __builtin_amdgcn_s_setprio(1); _Pragma("unroll") for (int m = 0; m < 4; ++m) _Pragma("unroll") for (int n = 0; n < 2; ++n) _Pragma("unroll") for (int k = 0; k < 2; ++k) \
        acc[ai][bj][m][n] = __builtin_amdgcn_mfma_f32_16x16x32_bf16(Bt[n][k], At[m][k], acc[ai][bj][m][n], 0, 0, 0); __builtin_amdgcn_s_setprio(0); } while (0)
#ifndef HOST_EMU
#define PG8_WAIT_V(n) asm volatile("s_waitcnt vmcnt(" #n ")" ::: "memory")
#define PG8_WAIT_L(n) asm volatile("s_waitcnt lgkmcnt(" #n ")" ::: "memory")
#else
#define PG8_WAIT_V(n) do {} while (0)
#define PG8_WAIT_L(n) do {} while (0)
#endif
#define PG8_BAR __builtin_amdgcn_s_barrier()
#define PG8_SCHED __builtin_amdgcn_sched_barrier(0)
    Unit cur, nxt; int ui = 0;
    if (!S.next(0, cur)) return;
    f32x4 acc[2][2][4][2];
#pragma unroll
    for (int a = 0; a < 2; ++a)
#pragma unroll
        for (int b = 0; b < 2; ++b)
#pragma unroll
            for (int m = 0; m < 4; ++m)
#pragma unroll
                for (int n = 0; n < 2; ++n) acc[a][b][m][n] = (f32x4){0.f, 0.f, 0.f, 0.f};
    bf16x8 At[4][2], B0[2][2], B1[2][2];
    const char* cA = (const char*)g.A + (size_t)cur.pm * tstep; const char* cB = (const char*)g.Bt + (size_t)cur.pn * tstep;
    S.a_ready(cur);
    PG8_STAGE(PG8_SB(0, 0), cB, voffB); PG8_STAGE(PG8_SA(0, 0), cA, voffA); PG8_STAGE(PG8_SB(0, 1), cB + hstep, voffB); PG8_STAGE(PG8_SA(0, 1), cA + hstep, voffA);
    if (wr == 1) PG8_BAR;
    PG8_WAIT_V(4); PG8_BAR;
    PG8_STAGE(PG8_SB(1, 0), cB + kstep, voffB); PG8_STAGE(PG8_SA(1, 0), cA + kstep, voffA); PG8_STAGE(PG8_SB(1, 1), cB + hstep + kstep, voffB);
    PG8_WAIT_V(6); PG8_BAR;
    PG8_STAMP();
    for (;;) {
        const bool has_next = S.next(ui + 1, nxt);
        const char* nA = has_next ? (const char*)g.A + (size_t)nxt.pm * tstep : cA; const char* nB = has_next ? (const char*)g.Bt + (size_t)nxt.pn * tstep : cB;
        for (int t = 0; t < nt; t += 2) {
            const bool last = (t == nt - 2);
            const char* a1 = cA + (size_t)(t + 1) * kstep;
            const char* a2 = last ? nA : cA + (size_t)(t + 2) * kstep; const char* b2 = last ? nB : cB + (size_t)(t + 2) * kstep;
            const char* a3 = a2 + kstep; const char* b3 = b2 + kstep;
            if (last && has_next) S.a_ready(nxt);
            PG8_LDB(B0, 0, 0); PG8_SCHED; PG8_LDA(At, 0, 0); PG8_STAGE(PG8_SA(1, 1), a1 + hstep, voffA);
            PG8_WAIT_L(8); PG8_BAR; PG8_WAIT_L(0); PG8_MMA(0, 0, At, B0); PG8_BAR; PG8_SCHED;
            PG8_LDB(B1, 0, 1); PG8_STAGE(PG8_SB(0, 0), b2, voffB);
            PG8_BAR; PG8_WAIT_L(0); PG8_MMA(0, 1, At, B1); PG8_BAR;
            PG8_LDA(At, 0, 1); PG8_STAGE(PG8_SA(0, 0), a2, voffA);
            PG8_BAR; PG8_WAIT_L(0); PG8_MMA(1, 0, At, B0); PG8_BAR; PG8_SCHED;
            PG8_STAGE(PG8_SB(0, 1), b2 + hstep, voffB);
            PG8_WAIT_V(6); PG8_BAR; PG8_MMA(1, 1, At, B1); PG8_BAR;
            PG8_LDB(B0, 1, 0); PG8_SCHED; PG8_LDA(At, 1, 0); PG8_STAGE(PG8_SA(0, 1), a2 + hstep, voffA);
            PG8_WAIT_L(8); PG8_BAR; PG8_WAIT_L(0); PG8_MMA(0, 0, At, B0); PG8_BAR; PG8_SCHED;
            PG8_LDB(B1, 1, 1); PG8_STAGE(PG8_SB(1, 0), b3, voffB);
            PG8_BAR; PG8_WAIT_L(0); PG8_MMA(0, 1, At, B1); PG8_BAR;
            PG8_LDA(At, 1, 1); PG8_STAGE(PG8_SA(1, 0), a3, voffA);
            PG8_BAR; PG8_WAIT_L(0); PG8_MMA(1, 0, At, B0); PG8_BAR; PG8_SCHED;
            PG8_STAGE(PG8_SB(1, 1), b3 + hstep, voffB);
            PG8_WAIT_V(6); PG8_BAR; PG8_MMA(1, 1, At, B1); PG8_BAR;
        }
        PG8_STAMP();
        if constexpr (!Epi::AFTER_DRAIN) { E(acc, cur, wr, wc, fr, fq); S.done(cur); }
        PG8_STAMP();
        if (!has_next) break;
#pragma unroll
        for (int a = 0; a < 2; ++a)
#pragma unroll
            for (int b = 0; b < 2; ++b)
#pragma unroll
                for (int m = 0; m < 4; ++m)
#pragma unroll
                    for (int n = 0; n < 2; ++n) acc[a][b][m][n] = (f32x4){0.f, 0.f, 0.f, 0.f};
        cur = nxt; cA = nA; cB = nB; ++ui;
    }
    PG8_WAIT_V(0);
    if (wr == 0) PG8_BAR;
    PG8_BAR;
    if constexpr (Epi::AFTER_DRAIN) { E.fused(acc, cur, wr, wc, fr, fq, lds, wid, lane); S.done(cur); }
    PG8_STAMP();
    if (STAMP && wid == 0) { stamps[lane] = lane < nts ? (((unsigned long long)(unsigned)ts_hi << 32) | (unsigned)ts_lo) : 0ull;
        if (lane == 62) stamps[62] = rt_entry; if (lane == 63) stamps[63] = 0ull; }
#undef PG8_STAMP
#undef PG8_SA
#undef PG8_SB
#undef PG8_STAGE
#undef PG8_LDA
#undef PG8_LDB
#undef PG8_MMA
#undef PG8_WAIT_V
#undef PG8_WAIT_L
#undef PG8_BAR
#undef PG8_SCHED
}
}
template <class Epi> struct PgEpiT {
    static constexpr bool PERM = true, AFTER_DRAIN = false;
    Epi e;
    DEV void operator()(const f32x4 (&acc)[2][2][4][2], const pg8::Unit& u, int wr, int wc, int fr, int fq) const {
#pragma unroll
        for (int ai = 0; ai < 2; ++ai)
#pragma unroll
            for (int m = 0; m < 4; ++m) {
#pragma unroll
                for (int bj = 0; bj < 2; ++bj) {
                    const int wcol = u.pm * 256 + ai * 128 + wr * 64 + m * 16 + fr, tok0 = u.pn * 256 + bj * 128 + wc * 32 + 8 * fq;
                    const float v[8] = {acc[ai][bj][m][0][0], acc[ai][bj][m][0][1], acc[ai][bj][m][0][2], acc[ai][bj][m][0][3], acc[ai][bj][m][1][0], acc[ai][bj][m][1][1], acc[ai][bj][m][1][2], acc[ai][bj][m][1][3]};
                    e.tok8(tok0, wcol, v);
                }
                if (m & 1) SCHED_FENCE();
            }
    }
};
template <class Epi> struct PgEpiN {
    static constexpr bool PERM = true, AFTER_DRAIN = false;
    Epi e;
    DEV void operator()(const f32x4 (&acc)[2][2][4][2], const pg8::Unit& u, int wr, int wc, int fr, int fq) const {
#pragma unroll
        for (int ai = 0; ai < 2; ++ai)
#pragma unroll
            for (int m = 0; m < 4; ++m) {
#pragma unroll
                for (int bj = 0; bj < 2; ++bj) {
                    const int tok = u.pm * 256 + ai * 128 + wr * 64 + m * 16 + fr, wcol0 = u.pn * 256 + bj * 128 + wc * 32 + 8 * fq;
                    const float v[8] = {acc[ai][bj][m][0][0], acc[ai][bj][m][0][1], acc[ai][bj][m][0][2], acc[ai][bj][m][0][3], acc[ai][bj][m][1][0], acc[ai][bj][m][1][1], acc[ai][bj][m][1][2], acc[ai][bj][m][1][3]};
                    e.col8(tok, wcol0, v);
                }
                if (m & 1) SCHED_FENCE();
            }
    }
};
template <class Epi>
DEV void gemm_pg8_T(const bf16_t* A, const bf16_t* Wt, int Mtok, int N, unsigned char* smem, const Epi& epi) {
    pg8::Gemm g{Wt, A, N, Mtok, 1024};
    pg8::StaticOrder S; S.init(N, Mtok, (int)gridDim.x, (int)blockIdx.x);
    PgEpiT<Epi> E{epi};
    pg8::gemm_phase<PgEpiT<Epi>, pg8::StaticOrder, false>((PG8_LAS unsigned char*)smem, g, S, E);
    __syncthreads();
}
template <class Epi>
DEV void gemm_pg8_N(const bf16_t* A, const bf16_t* Wt, int Mtok, int N, unsigned char* smem, const Epi& epi) {
    pg8::Gemm g{A, Wt, Mtok, N, 1024};
    pg8::StaticOrder S; S.init(Mtok, N, (int)gridDim.x, (int)blockIdx.x);
    PgEpiN<Epi> E{epi};
    pg8::gemm_phase<PgEpiN<Epi>, pg8::StaticOrder, false>((PG8_LAS unsigned char*)smem, g, S, E);
    __syncthreads();
}
struct EpiL0In {
    unsigned char* ws;
    DEV void operator()(int row, int col, float v0, float v1, float v2, float v3) const {
        u32x2 o; o[0] = pk2(v0, v1); o[1] = pk2(v2, v3);
        const bool lat = row < TL; const int b = lat ? row / L : (row - TL) / LC, t = lat ? row - b * L : (row - TL) - b * LC, Lx = lat ? L : LC;
        const int cu = __builtin_amdgcn_readfirstlane(col & ~127);
        if (cu < 1536) { bf16_t* d = (bf16_t*)(ws + WS_P + (lat ? P_HYT_LAT : P_HYT_CTX)) + ((size_t)b * 1536 + col) * Lx + t; *(u32x2*)d = o; }
        else if (cu < 2048) { bf16_t* d = (bf16_t*)(ws + WS_P + P_Q0) + (size_t)row * 512 + (col - 1536); d[0] = (bf16_t)f2bf(v0); d[512] = (bf16_t)f2bf(v1); d[1024] = (bf16_t)f2bf(v2); d[1536] = (bf16_t)f2bf(v3); }
        else if (cu < 2176) { bf16_t* d = (bf16_t*)(ws + WS_P + P_K0) + (size_t)row * 128 + (col - 2048); d[0] = (bf16_t)f2bf(v0); d[128] = (bf16_t)f2bf(v1); d[256] = (bf16_t)f2bf(v2); d[384] = (bf16_t)f2bf(v3); }
        else { bf16_t* d = (bf16_t*)(ws + WS_P + (lat ? P_VT_LAT : P_VT_CTX)) + ((size_t)b * 128 + (col - 2176)) * Lx + t; *(u32x2*)d = o; }
    }
};
struct EpiL0InT {
    unsigned char* ws;
    DEV void tok8(int row, int col, const float (&v)[8]) const {
        const bool lat = row < TL; const int b = lat ? row / L : (row - TL) / LC, t = lat ? row - b * L : (row - TL) - b * LC, Lx = lat ? L : LC;
        u32x4 o; o[0] = pk2(v[0], v[1]); o[1] = pk2(v[2], v[3]); o[2] = pk2(v[4], v[5]); o[3] = pk2(v[6], v[7]);
        if (col < 1536) { *(u32x4*)((bf16_t*)(ws + WS_P + (lat ? P_HYT_LAT : P_HYT_CTX)) + ((size_t)b * 1536 + col) * Lx + t) = o; }
        else if (col < 2048) { bf16_t* d = (bf16_t*)(ws + WS_P + P_Q0) + (size_t)row * 512 + (col - 1536);
#pragma unroll
            for (int i = 0; i < 8; ++i) d[i * 512] = (bf16_t)f2bf(v[i]); }
        else if (col < 2176) { bf16_t* d = (bf16_t*)(ws + WS_P + P_K0) + (size_t)row * 128 + (col - 2048);
#pragma unroll
            for (int i = 0; i < 8; ++i) d[i * 128] = (bf16_t)f2bf(v[i]); }
        else { *(u32x4*)((bf16_t*)(ws + WS_P + (lat ? P_VT_LAT : P_VT_CTX)) + ((size_t)b * 128 + (col - 2176)) * Lx + t) = o; }
    }
};
struct EpiBf16 {
    bf16_t* out; int ld;
    DEV void col8(int row, int col0, const float (&v)[8]) const { u32x4 o; o[0] = pk2(v[0], v[1]); o[1] = pk2(v[2], v[3]); o[2] = pk2(v[4], v[5]); o[3] = pk2(v[6], v[7]); *(u32x4*)(out + (size_t)row * ld + col0) = o; }
    DEV void operator()(int row, int col, float v0, float v1, float v2, float v3) const {
        bf16_t* d = out + (size_t)row * ld + col; d[0] = (bf16_t)f2bf(v0); d[ld] = (bf16_t)f2bf(v1); d[2 * ld] = (bf16_t)f2bf(v2); d[3 * ld] = (bf16_t)f2bf(v3);
    }
};
struct EpiHg {
    unsigned char* ws; const float* lg;
    DEV void operator()(int row, int col, float v0, float v1, float v2, float v3) const {
        float vv[4] = {v0, v1, v2, v3};
        const bool lat = row < TL; const int b = lat ? row / L : (row - TL) / LC, t = lat ? row - b * L : (row - TL) - b * LC, Lx = lat ? L : LC;
        const int cu = __builtin_amdgcn_readfirstlane(col & ~255);
        if (cu >= 3072 && cu < 4096) {
            bf16_t* d = (bf16_t*)(ws + WS_M) + (lat ? (size_t)0 : (size_t)NB * 1024 * L) + ((size_t)b * 1024 + (col - 3072)) * Lx + t;
            u32x2 o; o[0] = pk2(v0, v1); o[1] = pk2(v2, v3); *(u32x2*)d = o;
            return;
        }
        if (cu < 1024 || cu >= 4096) {
#pragma unroll
            for (int i = 0; i < 4; ++i) vv[i] = silu_f(vv[i]);
        } else {
            const int c = col - 1024;
            const float oml = 1.f - 1.f / (1.f + __expf(lg[c] - lg[2048 + c]));
#pragma unroll
            for (int i = 0; i < 4; ++i) vv[i] = oml / (1.f + __expf(vv[i]));
        }
        if (cu < 3072) {
            bf16_t* d = (bf16_t*)(ws + WS_P + (lat ? P1_KQT_LAT : P1_KQT_CTX)) + ((size_t)b * 3072 + col) * Lx + t;
            u32x2 o; o[0] = pk2(vv[0], vv[1]); o[1] = pk2(vv[2], vv[3]); *(u32x2*)d = o;
        } else {
            if (!lat) return;
            bf16_t* d = (bf16_t*)(ws + WS_P + P1_G) + (size_t)row * 1024 + (col - 4096); d[0] = (bf16_t)f2bf(vv[0]); d[1024] = (bf16_t)f2bf(vv[1]); d[2048] = (bf16_t)f2bf(vv[2]); d[3072] = (bf16_t)f2bf(vv[3]);
        }
    }
};
struct EpiHgT {
    unsigned char* ws; const float* lg;
    DEV void tok8(int row, int col, const float (&v)[8]) const {
        const bool lat = row < TL; const int b = lat ? row / L : (row - TL) / LC, t = lat ? row - b * L : (row - TL) - b * LC, Lx = lat ? L : LC;
        const int cu = __builtin_amdgcn_readfirstlane(col & ~255);
        float vv[8];
#pragma unroll
        for (int i = 0; i < 8; ++i) vv[i] = v[i];
        if (cu >= 3072 && cu < 4096) {
            u32x4 o; o[0] = pk2(vv[0], vv[1]); o[1] = pk2(vv[2], vv[3]); o[2] = pk2(vv[4], vv[5]); o[3] = pk2(vv[6], vv[7]);
            *(u32x4*)((bf16_t*)(ws + WS_M) + (lat ? (size_t)0 : (size_t)NB * 1024 * L) + ((size_t)b * 1024 + (col - 3072)) * Lx + t) = o;
            return;
        }
        if (cu < 1024 || cu >= 4096) {
#pragma unroll
            for (int i = 0; i < 8; ++i) vv[i] = silu_f(vv[i]);
        } else {
            const int c = col - 1024;
            const float oml = 1.f - 1.f / (1.f + __expf(lg[c] - lg[2048 + c]));
#pragma unroll
            for (int i = 0; i < 8; ++i) vv[i] = oml / (1.f + __expf(vv[i]));
        }
        if (cu < 3072) {
            u32x4 o; o[0] = pk2(vv[0], vv[1]); o[1] = pk2(vv[2], vv[3]); o[2] = pk2(vv[4], vv[5]); o[3] = pk2(vv[6], vv[7]);
            *(u32x4*)((bf16_t*)(ws + WS_P + (lat ? P1_KQT_LAT : P1_KQT_CTX)) + ((size_t)b * 3072 + col) * Lx + t) = o;
        } else {
            if (!lat) return;
            bf16_t* d = (bf16_t*)(ws + WS_P + P1_G) + (size_t)row * 1024 + (col - 4096);
#pragma unroll
            for (int i = 0; i < 8; ++i) d[i * 1024] = (bf16_t)f2bf(vv[i]);
        }
    }
};
struct EpiRes {
    const Params* p; int from_inputs, layer, goff;
    DEV void col8(int row, int col0, const float (&v)[8]) const {
        float* H = (float*)(p->ws + WS_H) + (size_t)row * 1024 + col0; const float* hin = h_row(*p, from_inputs, row) + col0;
        const float* gt = (const float*)(p->ws + WS_MOD) + ((size_t)layer * NR + mod_row(row)) * 6144 + goff + col0;
        const f32x4 h0 = *(const f32x4*)hin, h1 = *(const f32x4*)(hin + 4), g0 = *(const f32x4*)gt, g1 = *(const f32x4*)(gt + 4);
        f32x4 o0, o1;
#pragma unroll
        for (int i = 0; i < 4; ++i) { o0[i] = h0[i] + g0[i] * v[i]; o1[i] = h1[i] + g1[i] * v[4 + i]; }
        *(f32x4*)H = o0; *(f32x4*)(H + 4) = o1;
    }
    DEV void operator()(int row, int col, float v0, float v1, float v2, float v3) const {
        float* H = (float*)(p->ws + WS_H) + (size_t)row * 1024 + col;
        const float* hin = h_row(*p, from_inputs, row) + col;
        const float gt = ((const float*)(p->ws + WS_MOD))[((size_t)layer * NR + mod_row(row)) * 6144 + goff + col];
        const float h0 = hin[0], h1 = hin[1024], h2 = hin[2048], h3 = hin[3072];
        H[0] = h0 + gt * v0; H[1024] = h1 + gt * v1; H[2048] = h2 + gt * v2; H[3072] = h3 + gt * v3;
    }
};

struct HyRaw { u32x4 mid; unsigned short lft, rgt; };
DEV HyRaw hy_load(const bf16_t* row, int t0, int Lx) { HyRaw r; r.mid = *(const u32x4*)(row + t0); r.lft = t0 > 0 ? row[t0 - 1] : (unsigned short)0; r.rgt = t0 + 8 < Lx ? row[t0 + 8] : (unsigned short)0; return r; }
DEV void hy_conv8(const HyRaw& r, float w0, float w1, float w2, float b, float (&o)[8]) {
    float x[10]; x[0] = bf2f(r.lft); x[9] = bf2f(r.rgt);
#pragma unroll
    for (int i = 0; i < 4; ++i) { x[1 + 2 * i] = bflo(r.mid[i]); x[2 + 2 * i] = bfhi(r.mid[i]); }
#pragma unroll
    for (int i = 0; i < 8; ++i) o[i] = w0 * x[i] + w1 * x[i + 1] + w2 * x[i + 2] + b;
}
DEV void hyena_item(const Params& p, int set, int item, unsigned char* smem) {
    const int Ls = set ? LC : L, S = set ? FS_CTX : FS_LAT, N = 1 << (2 * S);
    const int gi = tidx() >> 8, g = tidx() & 255;
    const int bp = item >> 8, c = (item & 255) * 2 + gi, ba = bp * 2, bb = ba + 1;
    cf2* buf = (cf2*)smem + (size_t)gi * N;
    const bf16_t* hy = (const bf16_t*)(p.ws + WS_P + (set ? P_HYT_CTX : P_HYT_LAT));
    const float* cw = p.in[I_HYCW]; const float* cb = p.in[I_HYCB];
    const cf2* HF = (const cf2*)(p.ws + WS_F + (set ? F_HF_CTX : F_HF_LAT));
    const float invN = 1.f / (float)N;
    const int t0 = g * 8; const bool own = t0 < Ls;
    HyRaw rv[2], rx1[2];
    if (own) {
        rv[0] = hy_load(hy + ((size_t)ba * 1536 + c) * Ls, t0, Ls); rv[1] = hy_load(hy + ((size_t)bb * 1536 + c) * Ls, t0, Ls);
        rx1[0] = hy_load(hy + ((size_t)ba * 1536 + 512 + c) * Ls, t0, Ls); rx1[1] = hy_load(hy + ((size_t)bb * 1536 + 512 + c) * Ls, t0, Ls);
    }
    cf2 hfr[16];
#pragma unroll
    for (int u = 0; u < 16; ++u) { hfr[u].x = 0.f; hfr[u].y = 0.f; if (g + 256 * u < N) hfr[u] = HF[(size_t)c * N + g + 256 * u]; }
    float za[8], zb[8];
    if (own) { hy_conv8(rv[0], cw[c], cw[1536 + c], cw[3072 + c], cb[c], za); hy_conv8(rv[1], cw[c], cw[1536 + c], cw[3072 + c], cb[c], zb); }
    for (int t = g; t < N; t += 256) { if (t >= Ls) { cf2 z; z.x = 0.f; z.y = 0.f; buf[fsw(t)] = z; } }
    if (own) {
#pragma unroll
        for (int i = 0; i < 8; ++i) { cf2 v; v.x = za[i]; v.y = zb[i]; buf[fsw(t0 + i)] = v; }
    }
    __syncthreads();
#pragma unroll
    for (int n = 0; n < 2; ++n) {
        fft_fwd(buf, S, g, 256);
#pragma unroll
        for (int u = 0; u < 16; ++u) { const int k = g + 256 * u; if (k < N) buf[fsw(k)] = cmul(buf[fsw(k)], hfr[u]); }
        if (n == 0) {
#pragma unroll
            for (int u = 0; u < 16; ++u) if (g + 256 * u < N) hfr[u] = HF[(size_t)(512 + c) * N + g + 256 * u];
        }
        __syncthreads();
        fft_inv(buf, S, g, 256);
        const int gc = (n + 1) * 512 + c;
        const float w0 = cw[gc], w1 = cw[1536 + gc], w2 = cw[3072 + gc], b = cb[gc], dsk = p.in[I_HYSKIP][n * 512 + c];
        if (own) {
            float ga[8], gb[8];
            hy_conv8(rx1[0], w0, w1, w2, b, ga); hy_conv8(rx1[1], w0, w1, w2, b, gb);
            if (n == 0) { rx1[0] = hy_load(hy + ((size_t)ba * 1536 + 1024 + c) * Ls, t0, Ls); rx1[1] = hy_load(hy + ((size_t)bb * 1536 + 1024 + c) * Ls, t0, Ls); }
#pragma unroll
            for (int i = 0; i < 8; ++i) { const cf2 cv = buf[fsw(t0 + i)]; za[i] = ga[i] * (cv.x * invN + dsk * za[i]); zb[i] = gb[i] * (cv.y * invN + dsk * zb[i]); }
        }
        if (n == 0) {
            __syncthreads();
            for (int t = g; t < N; t += 256) { if (t >= Ls) { cf2 z; z.x = 0.f; z.y = 0.f; buf[fsw(t)] = z; } }
            if (own) {
#pragma unroll
                for (int i = 0; i < 8; ++i) { cf2 v; v.x = za[i]; v.y = zb[i]; buf[fsw(t0 + i)] = v; }
            }
            __syncthreads();
        } else if (own) {
            bf16_t* M = (bf16_t*)(p.ws + WS_M);
            const size_t ta = set ? (size_t)TL + (size_t)ba * LC + t0 : (size_t)ba * L + t0, tb = set ? (size_t)TL + (size_t)bb * LC + t0 : (size_t)bb * L + t0;
#pragma unroll
            for (int i = 0; i < 8; ++i) { M[(ta + i) * 1024 + c] = (bf16_t)f2bf(za[i]); M[(tb + i) * 1024 + c] = (bf16_t)f2bf(zb[i]); }
        }
    }
    __syncthreads();
}
DEV void rope_apply_store(u32x4 ua, u32x4 ub, bf16_t* dst, int pos, bool rope, float scale, int ph, int sub) {
    float a[8], b[8];
#pragma unroll
    for (int i = 0; i < 4; ++i) { a[2 * i] = bflo(ua[i]); a[2 * i + 1] = bfhi(ua[i]); b[2 * i] = bflo(ub[i]); b[2 * i + 1] = bfhi(ub[i]); }
    if (rope) {
        const float pv = (float)(ph == 0 ? pos / 64 : pos % 64);
#pragma unroll
        for (int e = 0; e < 8; ++e) {
            const float inv = exp2f(-(float)(sub * 8 + e) * (13.287712379549449f / 16.f));
            const float ang = pv * inv, cs = __cosf(ang), sn = __sinf(ang);
            const float na = a[e] * cs - b[e] * sn, nb = b[e] * cs + a[e] * sn; a[e] = na; b[e] = nb;
        }
    }
    u32x4 oa, ob;
#pragma unroll
    for (int i = 0; i < 4; ++i) { oa[i] = pk2(a[2 * i] * scale, a[2 * i + 1] * scale); ob[i] = pk2(b[2 * i] * scale, b[2 * i + 1] * scale); }
    *(u32x4*)(dst + ph * 32 + sub * 8) = oa; *(u32x4*)(dst + ph * 32 + 16 + sub * 8) = ob;
}
DEV void rope_store(const bf16_t* src, bf16_t* dst, int pos, bool rope, float scale, int ph, int sub) {
    rope_apply_store(*(const u32x4*)(src + ph * 32 + sub * 8), *(const u32x4*)(src + ph * 32 + 16 + sub * 8), dst, pos, rope, scale, ph, sub);
}
constexpr int A_LDQ = 72, A_LDV = 136;
DEV void attn_item(const Params& p, int set, int item, unsigned char* smem) {
    bf16_t* Qs = (bf16_t*)smem;
    bf16_t* Ks = Qs + 128 * A_LDQ;
    bf16_t* Vt = Ks + 128 * A_LDQ;
    const int tid = tidx(), lane = tid & 63, w = tid >> 6, l15 = lane & 15, lg = lane >> 4;
    const int nqb = set ? LC / 128 : L / 128;
    const int h = item & 7, qb = (item >> 3) % nqb, b = (item >> 3) / nqb, kvh = h >> 2;
    const bf16_t* Q0 = (const bf16_t*)(p.ws + WS_P + P_Q0); const bf16_t* K0 = (const bf16_t*)(p.ws + WS_P + P_K0);
    const int qtok0 = set ? TL + b * LC + qb * 128 : b * L + qb * 128;
    { const int row = tid >> 2, ph = (tid >> 1) & 1, sub = tid & 1;
      rope_store(Q0 + (size_t)(qtok0 + row) * 512 + h * 64, Qs + row * A_LDQ, qb * 128 + row, set == 0, 0.125f, ph, sub); }
    __syncthreads();
    bf16x8 qf[2];
    qf[0] = *(const bf16x8*)(Qs + (w * 16 + l15) * A_LDQ + 8 * lg); qf[1] = *(const bf16x8*)(Qs + (w * 16 + l15) * A_LDQ + 32 + 8 * lg);
    float m_run = p.in[I_SINK][h], l_run = 1.f;
    f32x4 O[4];
#pragma unroll
    for (int i = 0; i < 4; ++i) O[i] = (f32x4){0.f, 0.f, 0.f, 0.f};
    const int nwin = set ? 0 : 3, nctx = LC / 128;
    u32x4 nka, nkb, nv0, nv1;
#define AT_VALID(kbi_) (!((kbi_) < nwin && (qb - 1 + (kbi_) < 0 || qb - 1 + (kbi_) >= L / 128)))
#define AT_FETCH(kbi_) do { const bool win_ = (kbi_) < nwin; const int kb_ = win_ ? qb - 1 + (kbi_) : (kbi_) - nwin; const int ktok_ = win_ ? b * L + kb_ * 128 : TL + b * LC + kb_ * 128; \
        const int row_ = tid >> 2, ph_ = (tid >> 1) & 1, sub_ = tid & 1; const bf16_t* ks_ = K0 + (size_t)(ktok_ + row_) * 128 + kvh * 64; \
        nka = *(const u32x4*)(ks_ + ph_ * 32 + sub_ * 8); nkb = *(const u32x4*)(ks_ + ph_ * 32 + 16 + sub_ * 8); \
        const bf16_t* vt_ = (const bf16_t*)(p.ws + WS_P + (win_ ? P_VT_LAT : P_VT_CTX)); const int Lx_ = win_ ? L : LC; \
        nv0 = *(const u32x4*)(vt_ + ((size_t)b * 128 + kvh * 64 + (tid >> 4)) * Lx_ + kb_ * 128 + (tid & 15) * 8); \
        nv1 = *(const u32x4*)(vt_ + ((size_t)b * 128 + kvh * 64 + 32 + (tid >> 4)) * Lx_ + kb_ * 128 + (tid & 15) * 8); } while (0)
    int kbi = 0; while (kbi < nwin + nctx && !AT_VALID(kbi)) ++kbi;
    if (kbi < nwin + nctx) AT_FETCH(kbi);
    while (kbi < nwin + nctx) {
        const bool win = kbi < nwin; const int kb = win ? qb - 1 + kbi : kbi - nwin;
        __syncthreads();
        { const int row = tid >> 2, ph = (tid >> 1) & 1, sub = tid & 1;
          rope_apply_store(nka, nkb, Ks + row * A_LDQ, kb * 128 + row, win, 1.f, ph, sub);
          *(u32x4*)(Vt + (tid >> 4) * A_LDV + (tid & 15) * 8) = nv0; *(u32x4*)(Vt + (32 + (tid >> 4)) * A_LDV + (tid & 15) * 8) = nv1; }
        int nxt = kbi + 1; while (nxt < nwin + nctx && !AT_VALID(nxt)) ++nxt;
        if (nxt < nwin + nctx) AT_FETCH(nxt);
        __syncthreads();
#pragma unroll
        for (int ch = 0; ch < 2; ++ch) {
            f32x4 st[4];
#pragma unroll
            for (int u = 0; u < 4; ++u) {
                const bf16_t* kr = Ks + ((ch * 4 + u) * 16 + l15) * A_LDQ + 8 * lg;
                f32x4 z = (f32x4){0.f, 0.f, 0.f, 0.f};
                z = __builtin_amdgcn_mfma_f32_16x16x32_bf16(*(const bf16x8*)kr, qf[0], z, 0, 0, 0);
                z = __builtin_amdgcn_mfma_f32_16x16x32_bf16(*(const bf16x8*)(kr + 32), qf[1], z, 0, 0, 0);
                st[u] = z;
            }
            float cmax = -INFINITY;
            if (win) {
                const int qpos = qb * 128 + w * 16 + l15;
#pragma unroll
                for (int u = 0; u < 4; ++u)
#pragma unroll
                    for (int r = 0; r < 4; ++r) { const int kpos = kb * 128 + (ch * 4 + u) * 16 + 4 * lg + r; const int dd = qpos - kpos; if (dd > 128 || dd < -128) st[u][r] = -INFINITY; }
            }
#pragma unroll
            for (int u = 0; u < 4; ++u)
#pragma unroll
                for (int r = 0; r < 4; ++r) cmax = fmaxf(cmax, st[u][r]);
            cmax = fmaxf(cmax, __shfl_xor(cmax, 16)); cmax = fmaxf(cmax, __shfl_xor(cmax, 32));
            const float m_new = fmaxf(m_run, cmax), alpha = __expf(m_run - m_new);
            float ls = 0.f;
#pragma unroll
            for (int u = 0; u < 4; ++u)
#pragma unroll
                for (int r = 0; r < 4; ++r) { const float e = __expf(st[u][r] - m_new); st[u][r] = e; ls += e; }
            ls += __shfl_xor(ls, 16); ls += __shfl_xor(ls, 32);
            l_run = l_run * alpha + ls; m_run = m_new;
#pragma unroll
            for (int i = 0; i < 4; ++i) { O[i][0] *= alpha; O[i][1] *= alpha; O[i][2] *= alpha; O[i][3] *= alpha; }
#pragma unroll
            for (int ss = 0; ss < 2; ++ss) {
                u32x4 pu; pu[0] = pk2(st[2 * ss][0], st[2 * ss][1]); pu[1] = pk2(st[2 * ss][2], st[2 * ss][3]); pu[2] = pk2(st[2 * ss + 1][0], st[2 * ss + 1][1]); pu[3] = pk2(st[2 * ss + 1][2], st[2 * ss + 1][3]);
                const bf16x8 pf = __builtin_bit_cast(bf16x8, pu);
                const int key0 = (ch * 4 + 2 * ss) * 16 + 4 * lg;
#pragma unroll
                for (int dt = 0; dt < 4; ++dt) {
                    const bf16_t* vr = Vt + (dt * 16 + l15) * A_LDV + key0;
                    u32x4 vu; const u32x2 v0 = *(const u32x2*)vr, v1 = *(const u32x2*)(vr + 16); vu[0] = v0[0]; vu[1] = v0[1]; vu[2] = v1[0]; vu[3] = v1[1];
                    O[dt] = __builtin_amdgcn_mfma_f32_16x16x32_bf16(__builtin_bit_cast(bf16x8, vu), pf, O[dt], 0, 0, 0);
                }
            }
        }
        kbi = nxt;
    }
#undef AT_VALID
#undef AT_FETCH
    const float il = 1.f / l_run;
    bf16_t* M = (bf16_t*)(p.ws + WS_M) + (size_t)(qtok0 + w * 16 + l15) * 1024 + 512 + h * 64;
#pragma unroll
    for (int dt = 0; dt < 4; ++dt) { u32x2 o; o[0] = pk2(O[dt][0] * il, O[dt][1] * il); o[1] = pk2(O[dt][2] * il, O[dt][3] * il); *(u32x2*)(M + dt * 16 + 4 * lg) = o; }
    __syncthreads();
}
constexpr int P3_HY_LAT = (NB / 2) * 256, P3_HY_CTX = (NB / 2) * 256, P3_AT_LAT = NB * (L / 128) * 8, P3_AT_CTX = NB * (LC / 128) * 8;
DEV void phase3(const Params& p, unsigned char* smem, int var = 0) {
    const int total = P3_HY_LAT + P3_AT_LAT + P3_HY_CTX + P3_AT_CTX;
    for (int it = blockIdx.x; it < total; it += gridDim.x) {
        int i = it;
        if (var == 1 && !(i < P3_HY_LAT || (i >= P3_HY_LAT + P3_AT_LAT && i < P3_HY_LAT + P3_AT_LAT + P3_HY_CTX))) continue;
        if (var == 2 && (i < P3_HY_LAT || (i >= P3_HY_LAT + P3_AT_LAT && i < P3_HY_LAT + P3_AT_LAT + P3_HY_CTX))) continue;
        if (i < P3_HY_LAT) { hyena_item(p, 0, i, smem); continue; } i -= P3_HY_LAT;
        if (i < P3_AT_LAT) { attn_item(p, 0, i, smem); continue; } i -= P3_AT_LAT;
        if (i < P3_HY_CTX) { hyena_item(p, 1, i, smem); continue; } i -= P3_HY_CTX;
        attn_item(p, 1, i, smem);
    }
}

constexpr int K_LDK = 136, K_LDS = 129, K_LDC = 52;
DEV unsigned fkey(float f) { const unsigned u = __builtin_bit_cast(unsigned, f); return (u & 0x80000000u) ? ~u : (u | 0x80000000u); }
constexpr int cand_off(int i) { int o = 0; for (int k = 0; k < i; ++k) o += 16 / (k + 1); return o; }
DEV void topk_load_keys(const Params& p, int layer, int h, unsigned char* smem) {
    bf16_t* Ks = (bf16_t*)smem;
    const bf16_t* keys = (const bf16_t*)(p.ws + WS_W + W_KEYS) + (size_t)layer * 262144 + (size_t)h * 32768;
    const int tid = tidx();
#pragma unroll
    for (int i = 0; i < 8; ++i) { const int id = tid + NT * i, row = id >> 4, kc = id & 15; *(u32x4*)(Ks + row * K_LDK + kc * 8) = *(const u32x4*)(keys + (size_t)row * 128 + kc * 8); }
    __syncthreads();
}
#ifndef HOST_EMU
template <int CTRL> DEV unsigned dpp_u32(unsigned v) { return (unsigned)__builtin_amdgcn_update_dpp(0, (int)v, CTRL, 0xF, 0xF, true); }
#else
template <int CTRL> DEV unsigned dpp_u32(unsigned v) { const int lane = tidx() & 63; const int src = CTRL == 0xB1 ? (lane ^ 1) : CTRL == 0x4E ? (lane ^ 2) : ((lane & ~7) | (7 - (lane & 7))); return emu_shfl(v, src); }
#endif
DEV unsigned max8_u32(unsigned v) { unsigned t = dpp_u32<0xB1>(v); v = v > t ? v : t; t = dpp_u32<0x4E>(v); v = v > t ? v : t; t = dpp_u32<0x141>(v); return v > t ? v : t; }
DEV float sum8_f32(float v) { v += __builtin_bit_cast(float, dpp_u32<0xB1>(__builtin_bit_cast(unsigned, v))); v += __builtin_bit_cast(float, dpp_u32<0x4E>(__builtin_bit_cast(unsigned, v))); v += __builtin_bit_cast(float, dpp_u32<0x141>(__builtin_bit_cast(unsigned, v))); return v; }
DEV float unkey(unsigned k) { const unsigned u = (k & 0x80000000u) ? (k & 0x7fffffffu) : ~k; return __builtin_bit_cast(float, u); }
template <int N> DEV void bitonic_desc(unsigned (&a)[N]) {
#pragma unroll
    for (int k = 2; k <= N; k <<= 1)
#pragma unroll
        for (int j = k >> 1; j > 0; j >>= 1)
#pragma unroll
            for (int i = 0; i < N; ++i) { const int l = i ^ j; if (l > i) { const unsigned x = a[i], y = a[l]; const unsigned hi = x > y ? x : y, lo = x > y ? y : x; if ((i & k) == 0) { a[i] = hi; a[l] = lo; } else { a[i] = lo; a[l] = hi; } } }
}
DEV void merge16(const unsigned* lst, int nlist, unsigned first, int sub, unsigned& r0, unsigned& r1) {
    unsigned cur = first; int head = 0; r0 = 0u; r1 = 0u;
#pragma unroll
    for (int it = 0; it < 16; ++it) {
        const unsigned m = max8_u32(cur);
        if (sub == (it & 7)) { if (it < 8) r0 = m; else r1 = m; }
        if (cur == m) { ++head; cur = head < nlist ? lst[head] : 0u; }
    }
}
DEV void topk_item(const Params& p, int h, int tok0, unsigned char* smem, const bf16x8 (&afr)[16]) {
    bf16_t* Ks = (bf16_t*)smem;
    float* Sc = (float*)(Ks + 2 * 128 * K_LDK);
    unsigned* s12 = (unsigned*)Sc + 64 * 8 * 17;
    unsigned* cl = s12 + 64 * 32;
    const int tid = tidx(), lane = tid & 63, w = tid >> 6;
    const int row = tid >> 3, sub = tid & 7;
#pragma unroll
    for (int part = 0; part < 2; ++part) {
        { const int mi = w >> 2, ni = w & 3;
          f32x16 acc;
#pragma unroll
          for (int r = 0; r < 16; ++r) acc[r] = 0.f;
          const bf16_t* bs = Ks + (part * 128 + ni * 32 + (lane & 31)) * K_LDK + 8 * (lane >> 5);
#pragma unroll
          for (int kk = 0; kk < 8; ++kk) acc = __builtin_amdgcn_mfma_f32_32x32x16_bf16(part ? afr[8 + kk] : afr[kk], *(const bf16x8*)(bs + kk * 16), acc, 0, 0, 0);
#pragma unroll
          for (int r = 0; r < 16; ++r) Sc[(mi * 32 + (r & 3) + 8 * (r >> 2) + 4 * (lane >> 5)) * K_LDS + ni * 32 + (lane & 31)] = acc[r]; }
        __syncthreads();
        unsigned mk[16];
#pragma unroll
        for (int i = 0; i < 16; ++i) mk[i] = (fkey(Sc[row * K_LDS + sub * 16 + i]) & ~127u) | (unsigned)(127 - (sub * 16 + i));
        bitonic_desc<16>(mk);
        __syncthreads();
        unsigned* lst = (unsigned*)Sc + (row * 8 + sub) * 17;
#pragma unroll
        for (int i = 0; i < 16; ++i) lst[i] = mk[i];
        unsigned r0, r1;
        merge16(lst, 16, mk[0], sub, r0, r1);
        s12[(row * 2 + part) * 16 + sub] = r0; s12[(row * 2 + part) * 16 + 8 + sub] = r1;
        __syncthreads();
    }
    {
        const unsigned* k1 = s12 + row * 32; const unsigned* k2 = k1 + 16;
        unsigned ck[8];
#pragma unroll
        for (int m = 0; m < 8; ++m) {
            const int cc = sub + 8 * m; int ci = 0, off = 0;
#pragma unroll
            for (int i = 0; i < 15; ++i) { const bool ge = cc >= cand_off(i + 1); ci += ge ? 1 : 0; off += ge ? 16 / (i + 1) : 0; }
            const int cj = cc - off;
            ck[m] = 0u;
            if (cc < 50) ck[m] = (fkey(unkey((k1[ci] & ~127u) | 64u) + unkey((k2[cj] & ~127u) | 64u)) & ~63u) | (unsigned)(63 - cc);
        }
        bitonic_desc<8>(ck);
        unsigned* lst = cl + (row * 8 + sub) * 9;
#pragma unroll
        for (int m = 0; m < 8; ++m) lst[m] = ck[m];
        unsigned r0, r1;
        merge16(lst, 8, ck[0], sub, r0, r1);
        const float a = unkey((r0 & ~63u) | 32u), b = unkey((r1 & ~63u) | 32u);
        const unsigned kmax = max8_u32(r0 > r1 ? r0 : r1); const float vmax = unkey((kmax & ~63u) | 32u);
        const float ea = __expf(a - vmax), eb = __expf(b - vmax);
        const float inv = 1.f / sum8_f32(ea + eb);
        int eidx[2];
#pragma unroll
        for (int q = 0; q < 2; ++q) {
            const int cc = 63 - (int)((q ? r1 : r0) & 63u); int ci = 0, off = 0;
#pragma unroll
            for (int i = 0; i < 15; ++i) { const bool ge = cc >= cand_off(i + 1); ci += ge ? 1 : 0; off += ge ? 16 / (i + 1) : 0; }
            const int cj = cc - off;
            eidx[q] = (127 - (int)(k1[ci] & 127u)) * 128 + (127 - (int)(k2[cj] & 127u));
        }
        int* IDX = (int*)(p.ws + WS_IDX) + (size_t)(tok0 + row) * 128 + h * 16; float* GT = (float*)(p.ws + WS_GATE) + (size_t)(tok0 + row) * 128 + h * 16;
        IDX[sub] = eidx[0]; IDX[8 + sub] = eidx[1]; GT[sub] = ea * inv; GT[8 + sub] = eb * inv;
    }
    __syncthreads();
}
#define TOPK_LOAD(AF, tok0_, h_) do { const int lane_ = tidx() & 63, w_ = tidx() >> 6; \
        const bf16_t* ag_ = (const bf16_t*)(p.ws + WS_P) + (size_t)((tok0_) + (w_ >> 2) * 32 + (lane_ & 31)) * 2048 + (h_) * 256 + 8 * (lane_ >> 5); \
        _Pragma("unroll") for (int q_ = 0; q_ < 16; ++q_) AF[q_] = *(const bf16x8*)(ag_ + (q_ >> 3) * 128 + (q_ & 7) * 16); } while (0)
DEV void topk_phase(const Params& p, int layer, int ntok, unsigned char* smem) {
    const int G = gridDim.x, bid = blockIdx.x, h = bid & 7;
    const int nt = ntok / 64;
    bf16x8 afA[16], afB[16];
    if ((G & 7) == 0) {
        const int st = G >> 3; int tt = bid >> 3;
        if (tt < nt) { TOPK_LOAD(afA, tt * 64, h); topk_load_keys(p, layer, h, smem); }
        while (tt < nt) {
            if (tt + st < nt) TOPK_LOAD(afB, (tt + st) * 64, h);
            topk_item(p, h, tt * 64, smem, afA);
            tt += st; if (tt >= nt) break;
            if (tt + st < nt) TOPK_LOAD(afA, (tt + st) * 64, h);
            topk_item(p, h, tt * 64, smem, afB);
            tt += st;
        }
    } else {
        for (int it = bid; it < nt * 8; it += G) { __syncthreads(); TOPK_LOAD(afA, (it >> 3) * 64, it & 7); topk_load_keys(p, layer, it & 7, smem); topk_item(p, it & 7, (it >> 3) * 64, smem, afA); }
    }
}
#undef TOPK_LOAD

DEV float gelu_f(float x) { return 0.5f * x * (1.f + erff(x * 0.70710678118654752f)); }
DEV void peer_item(const Params& p, int layer, int item, int var = 0) {
    (void)var;
    const int tok = item * 8 + (tidx() >> 6), lane = tidx() & 63, li = lane & 31, half = lane >> 5;
    const bf16_t* A = (const bf16_t*)(p.ws + WS_A) + (size_t)tok * 1024 + li * 32;
    const unsigned char* U6 = p.ws + WS_U6 + (size_t)layer * 16384 * 768; const unsigned char* V4 = p.ws + WS_V4 + (size_t)layer * 16384 * 512;
    const float* SU = (const float*)(p.ws + WS_S8) + (size_t)(layer * 2) * 16384; const float* SV = SU + 16384;
    float x[32], y[32];
#pragma unroll
    for (int q = 0; q < 4; ++q) { const u32x4 a = *(const u32x4*)(A + 8 * q);
#pragma unroll
        for (int i = 0; i < 4; ++i) { x[8 * q + 2 * i] = bflo(a[i]); x[8 * q + 2 * i + 1] = bfhi(a[i]); } }
#pragma unroll
    for (int i = 0; i < 32; ++i) y[i] = 0.f;
    const int* IDX = (const int*)(p.ws + WS_IDX) + (size_t)tok * 128; const float* GT = (const float*)(p.ws + WS_GATE) + (size_t)tok * 128;
    const int i_lo = IDX[lane], i_hi = IDX[64 + lane]; const float g_lo = GT[lane], g_hi = GT[64 + lane];
    const int sl = ((li >> 4) & 1) * 2 + ((li >> 3) & 1);
    u32x4 ulo[4], vq[4]; u32x2 uhi[4];
#define PG_LOADU(g) do { _Pragma("unroll") for (int s_ = 0; s_ < 4; ++s_) { const int e_ = __shfl((g) < 8 ? i_lo : i_hi, (((g) & 7) << 3) + 2 * s_ + half); \
        const unsigned char* r_ = U6 + (size_t)e_ * 768; ulo[s_] = *(const u32x4*)(r_ + li * 16); uhi[s_] = *(const u32x2*)(r_ + 512 + li * 8); } } while (0)
#define PG_LOADV(g) do { _Pragma("unroll") for (int s_ = 0; s_ < 4; ++s_) { const int e_ = __shfl((g) < 8 ? i_lo : i_hi, (((g) & 7) << 3) + 2 * s_ + half); \
        vq[s_] = *(const u32x4*)(V4 + (size_t)e_ * 512 + li * 16); } } while (0)
    PG_LOADU(0); PG_LOADV(0);
    for (int g = 0; g < 16; ++g) {
        const int mk = ((g & 7) << 3) + 2 * sl + half; const int me = __shfl(g < 8 ? i_lo : i_hi, mk); const float mg = __shfl(g < 8 ? g_lo : g_hi, mk);
        const float su = SU[me], sv = SV[me];
        float d[4];
#pragma unroll
        for (int s4 = 0; s4 < 4; ++s4) {
            u32x6 w; w[0] = ulo[s4][0]; w[1] = ulo[s4][1]; w[2] = ulo[s4][2]; w[3] = ulo[s4][3]; w[4] = uhi[s4][0]; w[5] = uhi[s4][1];
            const f32x32 f = __builtin_amdgcn_cvt_scalef32_pk32_f32_fp6(w, 1.0f);
            float a = 0.f;
#pragma unroll
            for (int i = 0; i < 32; ++i) a = fmaf(f[i], x[i], a);
            d[s4] = a; SCHED_FENCE(); }
        if (g + 1 < 16) PG_LOADU(g + 1);
        float r2[2], r1;
        { const bool hi = (li & 16) != 0;
#pragma unroll
          for (int j = 0; j < 2; ++j) { const float send = hi ? d[j] : d[2 + j], keep = hi ? d[2 + j] : d[j]; r2[j] = keep + __shfl_xor(send, 16); } }
        { const bool hi = (li & 8) != 0; const float send = hi ? r2[0] : r2[1], keep = hi ? r2[1] : r2[0]; r1 = keep + __shfl_xor(send, 8); }
        r1 += __shfl_xor(r1, 4); r1 += __shfl_xor(r1, 2); r1 += __shfl_xor(r1, 1);
        const float act = gelu_f(r1 * su) * mg * sv;
#pragma unroll
        for (int s4 = 0; s4 < 4; ++s4) {
            const float aj = __shfl(act, (lane & 32) + 16 * (s4 >> 1) + 8 * (s4 & 1));
#pragma unroll
            for (int dw = 0; dw < 4; ++dw) {
                const f32x2 f0 = __builtin_amdgcn_cvt_scalef32_pk_f32_fp4(vq[s4][dw], 1.0f, 0), f1 = __builtin_amdgcn_cvt_scalef32_pk_f32_fp4(vq[s4][dw], 1.0f, 1),
                            f2 = __builtin_amdgcn_cvt_scalef32_pk_f32_fp4(vq[s4][dw], 1.0f, 2), f3 = __builtin_amdgcn_cvt_scalef32_pk_f32_fp4(vq[s4][dw], 1.0f, 3);
                const int e0 = dw * 8;
                y[e0] = fmaf(aj, f0[0], y[e0]); y[e0 + 1] = fmaf(aj, f0[1], y[e0 + 1]); y[e0 + 2] = fmaf(aj, f1[0], y[e0 + 2]); y[e0 + 3] = fmaf(aj, f1[1], y[e0 + 3]);
                y[e0 + 4] = fmaf(aj, f2[0], y[e0 + 4]); y[e0 + 5] = fmaf(aj, f2[1], y[e0 + 5]); y[e0 + 6] = fmaf(aj, f3[0], y[e0 + 6]); y[e0 + 7] = fmaf(aj, f3[1], y[e0 + 7]);
            }
            SCHED_FENCE(); }
        if (g + 1 < 16) PG_LOADV(g + 1);
    }
#undef PG_LOADU
#undef PG_LOADV
    float yy[16];
#pragma unroll
    for (int i = 0; i < 16; ++i) { const float send = half ? y[i] : y[16 + i], keep = half ? y[16 + i] : y[i]; yy[i] = keep + __shfl_xor(send, 32); }
    const int c0 = li * 32 + half * 16;
    float* H = (float*)(p.ws + WS_H) + (size_t)tok * 1024 + c0;
    const float* g2 = (const float*)(p.ws + WS_MOD) + ((size_t)layer * NR + mod_row(tok)) * 6144 + 5120 + c0;
    float hv[16]; float ss = 0.f;
#pragma unroll
    for (int i = 0; i < 4; ++i) { const f32x4 hh = *(const f32x4*)(H + 4 * i), gg = *(const f32x4*)(g2 + 4 * i);
#pragma unroll
        for (int j = 0; j < 4; ++j) { const float v = hh[j] + gg[j] * yy[4 * i + j]; hv[4 * i + j] = v; ss += v * v; } }
    ss = wave_sum(ss);
    const float rstd = rsqrtf(ss * (1.f / 1024.f) + 1e-6f);
    if (layer == 0) {
#pragma unroll
        for (int i = 0; i < 4; ++i) { f32x4 o; o[0] = hv[4 * i]; o[1] = hv[4 * i + 1]; o[2] = hv[4 * i + 2]; o[3] = hv[4 * i + 3]; *(f32x4*)(H + 4 * i) = o; }
        const float* g = p.in[I_N1G] + 1024 + c0;
        const float* mod = (const float*)(p.ws + WS_MOD) + ((size_t)1 * NR + mod_row(tok)) * 6144 + c0;
        bf16_t* Ao = (bf16_t*)(p.ws + WS_A) + (size_t)tok * 1024 + c0;
        u32x4 o0, o1; float r[16];
#pragma unroll
        for (int i = 0; i < 16; ++i) r[i] = hv[i] * rstd * g[i] * (1.f + mod[1024 + i]) + mod[i];
#pragma unroll
        for (int i = 0; i < 4; ++i) { o0[i] = pk2(r[2 * i], r[2 * i + 1]); o1[i] = pk2(r[8 + 2 * i], r[8 + 2 * i + 1]); }
        *(u32x4*)Ao = o0; *(u32x4*)(Ao + 8) = o1;
    } else {
        const float* g = p.in[I_FG] + c0; float* out = p.out + (size_t)tok * 1024 + c0;
#pragma unroll
        for (int i = 0; i < 4; ++i) { f32x4 o; o[0] = hv[4 * i] * rstd * g[4 * i]; o[1] = hv[4 * i + 1] * rstd * g[4 * i + 1]; o[2] = hv[4 * i + 2] * rstd * g[4 * i + 2]; o[3] = hv[4 * i + 3] * rstd * g[4 * i + 3]; *(f32x4*)(out + 4 * i) = o; }
    }
}

constexpr int S3_LD = 136, S3_LDT = 24, S3_LDV = 72;
constexpr int S3_Q = 0, S3_K = S3_Q + 64 * S3_LD * 2, S3_KT = S3_K + 64 * S3_LD * 2, S3_D = S3_KT + 4 * 128 * S3_LDT * 2, S3_V = S3_D + 4 * 128 * 4, S3_ST = S3_V + 64 * S3_LDV * 2,
              S3_P = S3_ST + 2 * 64 * S3_LD * 2, S3_END = S3_P + 4 * 16 * S3_LDT * 2;
static_assert(S3_END <= SMEM_BYTES, "scan LDS");
DEV void scan_block(const Params& p, int bi, unsigned char* smem, int var = 0) {
    const int tid = tidx(), lane = tid & 63, w = tid >> 6, l15 = lane & 15, lg4 = lane >> 4, l31 = lane & 31, lh = lane >> 5;
    const int half = bi & 1, dir = (bi >> 1) & 1, h = (bi >> 2) & 7, b = bi >> 5;
    const bf16_t* P1 = (const bf16_t*)(p.ws + WS_P);
    const bf16_t* IT = (const bf16_t*)(p.ws + WS_M);
    bf16_t* Oo = (bf16_t*)(p.ws + WS_F + (dir ? F_OB : F_OF));
    bf16_t* Qs = (bf16_t*)(smem + S3_Q); bf16_t* Ks = (bf16_t*)(smem + S3_K); bf16_t* KT = (bf16_t*)(smem + S3_KT); float* Ds = (float*)(smem + S3_D);
    bf16_t* Vs = (bf16_t*)(smem + S3_V); bf16_t* ST = (bf16_t*)(smem + S3_ST); bf16_t* Ps = (bf16_t*)(smem + S3_P);
    const int NCH = (LC + L) / 64;
    const int kt = w >> 1, vt = w & 1;
    f32x16 S;
#pragma unroll
    for (int r = 0; r < 16; ++r) S[r] = 0.f;
    for (int i = tid; i < 64 * S3_LD / 2; i += NT) ((unsigned*)ST)[i] = 0u;
    const int pk = tid & 127, pblk = tid >> 7;
    u32x4 ka[2], qa[2], va, kb2[2], qb2[2], vb2;
    const int kcol = 1024 * (1 + dir) + h * 128 + pk, qcol = h * 128 + pk;
#define S3_T0(c) ((c) * 64 < LC ? (dir ? LC - 64 - (c) * 64 : (c) * 64) : (dir ? L - 64 - ((c) * 64 - LC) : (c) * 64 - LC))
#define S3_LOAD(c, KR, QR, VR) do { const bool lat_ = (c) * 64 >= LC; const int t0_ = S3_T0(c); const int Lx_ = lat_ ? L : LC; \
        const bf16_t* kq_ = (const bf16_t*)(p.ws + WS_P + (lat_ ? P1_KQT_LAT : P1_KQT_CTX)) + (size_t)b * 3072 * Lx_ + t0_ + pblk * 16; \
        KR[0] = *(const u32x4*)(kq_ + (size_t)kcol * Lx_); KR[1] = *(const u32x4*)(kq_ + (size_t)kcol * Lx_ + 8); \
        if (lat_) { QR[0] = *(const u32x4*)(kq_ + (size_t)qcol * Lx_); QR[1] = *(const u32x4*)(kq_ + (size_t)qcol * Lx_ + 8); } else { QR[0] = (u32x4){0u, 0u, 0u, 0u}; QR[1] = QR[0]; } \
        { const int v_ = tid >> 3, c8_ = tid & 7; const bf16_t* it_ = IT + (lat_ ? (size_t)0 : (size_t)NB * 1024 * L) + ((size_t)b * 1024 + h * 128 + half * 64 + v_) * Lx_ + t0_ + c8_ * 8; VR = *(const u32x4*)it_; } } while (0)
#define S3_PREP(KR, QR, VR) do { \
            float bsum = 0.f; unsigned short kt16[16]; \
            _Pragma("unroll") for (int rr = 0; rr < 16; ++rr) { \
                const int tl = dir ? 15 - rr : rr; \
                const unsigned ku_ = dir ? KR[(15 - rr) >> 3][((15 - rr) & 7) >> 1] : KR[rr >> 3][(rr & 7) >> 1]; const unsigned qu_ = dir ? QR[(15 - rr) >> 3][((15 - rr) & 7) >> 1] : QR[rr >> 3][(rr & 7) >> 1]; \
                const bool odd_ = dir ? (((15 - rr) & 1) != 0) : ((rr & 1) != 0); \
                const float kv = odd_ ? bfhi(ku_) : bflo(ku_), qv = odd_ ? bfhi(qu_) : bflo(qu_); \
                bsum += __logf(1.f - kv); \
                const float eb = __expf(bsum), ieb = __expf(fminf(-bsum, 80.f)); \
                const unsigned short qt = (unsigned short)f2bf(qv * eb), ktv = (unsigned short)f2bf(kv * ieb); \
                Qs[(pblk * 16 + tl) * S3_LD + pk] = qt; Ks[(pblk * 16 + tl) * S3_LD + pk] = ktv; \
                if (dir) kt16[15 - rr] = ktv; else kt16[rr] = ktv; \
            } \
            u32x4 o0, o1; \
            _Pragma("unroll") for (int i = 0; i < 4; ++i) { o0[i] = (unsigned)kt16[2 * i] | ((unsigned)kt16[2 * i + 1] << 16); o1[i] = (unsigned)kt16[8 + 2 * i] | ((unsigned)kt16[8 + 2 * i + 1] << 16); } \
            *(u32x4*)(KT + (pblk * 128 + pk) * S3_LDT) = o0; *(u32x4*)(KT + (pblk * 128 + pk) * S3_LDT + 8) = o1; \
            Ds[pblk * 128 + pk] = __expf(bsum); \
            { const int v_ = tid >> 3, c8_ = tid & 7; *(u32x4*)(Vs + v_ * S3_LDV + c8_ * 8) = VR; } } while (0)
    S3_LOAD(0, ka, qa, va);
    for (int c = 0; c < NCH; ++c) {
        const bool lat = c * 64 >= LC; const int t0 = S3_T0(c); const size_t tokb = lat ? (size_t)b * L + t0 : (size_t)TL + (size_t)b * LC + t0;
        if ((c & 1) == 0) { if (c + 1 < NCH) S3_LOAD(c + 1, kb2, qb2, vb2); } else { if (c + 1 < NCH) S3_LOAD(c + 1, ka, qa, va); }
        lds_barrier();
        if (var != 1) { if ((c & 1) == 0) S3_PREP(ka, qa, va); else S3_PREP(kb2, qb2, vb2); }
        lds_barrier();

        if (lat && w < 4) {
            f32x4 pt = (f32x4){0.f, 0.f, 0.f, 0.f};
#pragma unroll
            for (int kk = 0; kk < 4; ++kk)
                pt = __builtin_amdgcn_mfma_f32_16x16x32_bf16(*(const bf16x8*)(Ks + (w * 16 + l15) * S3_LD + kk * 32 + 8 * lg4), *(const bf16x8*)(Qs + (w * 16 + l15) * S3_LD + kk * 32 + 8 * lg4), pt, 0, 0, 0);
            float pm[4];
#pragma unroll
            for (int r = 0; r < 4; ++r) { const int sl = 4 * lg4 + r; const bool keep = dir ? (sl >= l15) : (sl <= l15); pm[r] = keep ? pt[r] : 0.f; }
            u32x2 o; o[0] = pk2(pm[0], pm[1]); o[1] = pk2(pm[2], pm[3]);
            *(u32x2*)(Ps + (w * 16 + l15) * S3_LDT + 4 * lg4) = o;
        }
        lds_barrier();
        for (int ib = 0; ib < (var == 2 ? 0 : 4); ++ib) {
            const int blk = dir ? 3 - ib : ib;
            const int cur = (c * 4 + ib) & 1;
            { const bf16x8 a = *(const bf16x8*)(KT + (blk * 128 + 32 * kt + l31) * S3_LDT + 8 * lh);
              const bf16x8 bb = *(const bf16x8*)(Vs + (32 * vt + l31) * S3_LDV + blk * 16 + 8 * lh);
              S = __builtin_amdgcn_mfma_f32_32x32x16_bf16(a, bb, S, 0, 0, 0);
#pragma unroll
              for (int g = 0; g < 4; ++g) { const f32x4 dv = *(const f32x4*)(Ds + blk * 128 + 32 * kt + 8 * g + 4 * lh);
                  S[4 * g] *= dv[0]; S[4 * g + 1] *= dv[1]; S[4 * g + 2] *= dv[2]; S[4 * g + 3] *= dv[3];
                  u32x2 o; o[0] = pk2(S[4 * g], S[4 * g + 1]); o[1] = pk2(S[4 * g + 2], S[4 * g + 3]);
                  *(u32x2*)(ST + ((cur ^ 1) * 64 + 32 * vt + l31) * S3_LD + 32 * kt + 8 * g + 4 * lh) = o; } }
            if (lat && w < 4) {
                f32x4 o = (f32x4){0.f, 0.f, 0.f, 0.f};
#pragma unroll
                for (int kk = 0; kk < 4; ++kk)
                    o = __builtin_amdgcn_mfma_f32_16x16x32_bf16(*(const bf16x8*)(ST + (cur * 64 + 16 * w + l15) * S3_LD + kk * 32 + 8 * lg4), *(const bf16x8*)(Qs + (blk * 16 + l15) * S3_LD + kk * 32 + 8 * lg4), o, 0, 0, 0);
                bf16x8 va = (bf16x8){0, 0, 0, 0, 0, 0, 0, 0}, pb = va;
                if (lg4 < 2) { va = *(const bf16x8*)(Vs + (16 * w + l15) * S3_LDV + blk * 16 + 8 * lg4); pb = *(const bf16x8*)(Ps + (blk * 16 + l15) * S3_LDT + 8 * lg4); }
                o = __builtin_amdgcn_mfma_f32_16x16x32_bf16(va, pb, o, 0, 0, 0);
                u32x2 ou; ou[0] = pk2(o[0], o[1]); ou[1] = pk2(o[2], o[3]);
                *(u32x2*)(Oo + (tokb + blk * 16 + l15) * 1024 + h * 128 + half * 64 + 16 * w + 4 * lg4) = ou;
            }
            lds_barrier();
        }
    }
    lds_barrier();
#undef S3_T0
#undef S3_LOAD
#undef S3_PREP
}
DEV void readout_item(const Params& p, int item) {
    const int tok = item * 8 + (tidx() >> 6), lane = tidx() & 63;
    const bf16_t* of = (const bf16_t*)(p.ws + WS_F + F_OF) + (size_t)tok * 1024 + lane * 16; const bf16_t* ob = (const bf16_t*)(p.ws + WS_F + F_OB) + (size_t)tok * 1024 + lane * 16;
    const bf16_t* gp = (const bf16_t*)(p.ws + WS_P + P1_G) + (size_t)tok * 1024 + lane * 16;
    const float* on = p.in[I_HGON] + (lane & 7) * 16;
    float o[16], gg[16]; float ss = 0.f;
    { const u32x4 a0 = *(const u32x4*)of, a1 = *(const u32x4*)(of + 8), b0 = *(const u32x4*)ob, b1 = *(const u32x4*)(ob + 8), g0 = *(const u32x4*)gp, g1 = *(const u32x4*)(gp + 8);
#pragma unroll
      for (int i = 0; i < 4; ++i) { o[2 * i] = bflo(a0[i]) + bflo(b0[i]); o[2 * i + 1] = bfhi(a0[i]) + bfhi(b0[i]); o[8 + 2 * i] = bflo(a1[i]) + bflo(b1[i]); o[8 + 2 * i + 1] = bfhi(a1[i]) + bfhi(b1[i]);
          gg[2 * i] = bflo(g0[i]); gg[2 * i + 1] = bfhi(g0[i]); gg[8 + 2 * i] = bflo(g1[i]); gg[8 + 2 * i + 1] = bfhi(g1[i]); } }
#pragma unroll
    for (int i = 0; i < 16; ++i) ss += o[i] * o[i];
    ss += __shfl_xor(ss, 1); ss += __shfl_xor(ss, 2); ss += __shfl_xor(ss, 4);
    const float rstd = rsqrtf(ss * (1.f / 128.f) + 1e-6f);
    bf16_t* M = (bf16_t*)(p.ws + WS_M) + (size_t)tok * 1024 + lane * 16;
    u32x4 o0, o1; float r[16];
#pragma unroll
    for (int i = 0; i < 16; ++i) r[i] = o[i] * rstd * on[i] * gg[i];
#pragma unroll
    for (int i = 0; i < 4; ++i) { o0[i] = pk2(r[2 * i], r[2 * i + 1]); o1[i] = pk2(r[8 + 2 * i], r[8 + 2 * i + 1]); }
    *(u32x4*)M = o0; *(u32x4*)(M + 8) = o1;
}

#ifndef HOST_EMU
#define XB_TMO      128
#define XB_XCNT(j)  (256  + 64 * (j))
#define XB_XSUB(j)  (1280 + 64 * (j))
#define XB_XGEN(j)  (2304 + 64 * (j))
#define XB_TOP      3328
#define XB_TOPGEN   3392
#define XCD_BAR_WORDS 3456
#define XB_SPIN_CAP (1u << 18)
#define LAS __attribute__((address_space(3)))

__device__ __forceinline__ unsigned xb_ld(unsigned* p)              { return __hip_atomic_load(p, __ATOMIC_RELAXED, __HIP_MEMORY_SCOPE_AGENT); }
__device__ __forceinline__ unsigned xb_add(unsigned* p, unsigned v) { return __hip_atomic_fetch_add(p, v, __ATOMIC_RELAXED, __HIP_MEMORY_SCOPE_AGENT); }
__device__ __forceinline__ unsigned xb_xcc_id() { return (unsigned)__builtin_amdgcn_s_getreg((3 << 11) | 20) & 0xFu; }
#define XB_SPIN(cond, bar) do { unsigned _sp = 0; while (cond) { __builtin_amdgcn_s_sleep(1); \
    if ((++_sp & 255u) == 0u) { if (xb_ld(&(bar)[XB_TMO])) break; if (_sp > XB_SPIN_CAP) { atomicAdd(&(bar)[XB_TMO], 1u); break; } } } } while (0)

struct XcdBarrier {
    unsigned* bar; unsigned x;
    volatile LAS unsigned* st;
};

__device__ __forceinline__ XcdBarrier xcd_barrier_post(unsigned* bar, volatile LAS unsigned* st) {
    XcdBarrier b; b.bar = bar; b.x = xb_xcc_id(); b.st = st;
    if (threadIdx.x == 0) (void)xb_add(&bar[XB_XCNT(b.x)], 1u);
    return b;
}
__device__ __forceinline__ void xcd_barrier_complete(unsigned* bar, unsigned x, unsigned& nloc, unsigned& nx) {
    const unsigned G = gridDim.x * gridDim.y * gridDim.z;
    unsigned sum, cnt, mine, sp = 0u;
    for (;;) {
        sum = 0u; cnt = 0u; mine = 0u;
#pragma unroll
        for (unsigned j = 0; j < 16; ++j) { const unsigned c = xb_ld(&bar[XB_XCNT(j)]); sum += c; cnt += (c > 0u) ? 1u : 0u; mine = (j == x) ? c : mine; }
        if (sum == G) break;
        __builtin_amdgcn_s_sleep(1);
        if ((++sp & 255u) == 0u) { if (xb_ld(&bar[XB_TMO])) break; if (sp > XB_SPIN_CAP) { atomicAdd(&bar[XB_TMO], 1u); break; } }
    }
    nloc = mine > 0u ? mine : 1u; nx = cnt > 0u ? cnt : 1u;
}

__device__ __forceinline__ void xcd_barrier(const XcdBarrier& b) {
    asm volatile("s_waitcnt vmcnt(0)" ::: "memory");
    __syncthreads();
    if (threadIdx.x == 0) {
        unsigned* bar = b.bar;
        __builtin_amdgcn_s_waitcnt(0);
        unsigned nloc = b.st[0], nx = b.st[1];
        if (nloc == 0u) { xcd_barrier_complete(bar, b.x, nloc, nx); b.st[0] = nloc; b.st[1] = nx; }
        const unsigned old = xb_add(&bar[XB_XSUB(b.x)], 1u);
        const unsigned gen = old / nloc;
        if (old + 1u == (gen + 1u) * nloc) {
            __builtin_amdgcn_fence(__ATOMIC_RELEASE, "agent");
            asm volatile("s_waitcnt vmcnt(0)" ::: "memory");
            const unsigned og = xb_add(&bar[XB_TOP], 1u);
            const unsigned tg = og / nx;
            if (og + 1u == (tg + 1u) * nx) xb_add(&bar[XB_TOPGEN], 1u);
            else XB_SPIN(xb_ld(&bar[XB_TOPGEN]) == tg, bar);
            __builtin_amdgcn_fence(__ATOMIC_ACQUIRE, "agent");
            xb_add(&bar[XB_XGEN(b.x)], 1u);
            asm volatile("s_waitcnt vmcnt(0)" ::: "memory");
        } else {
            XB_SPIN(xb_ld(&bar[XB_XGEN(b.x)]) == gen, bar);
            __builtin_amdgcn_fence(__ATOMIC_ACQUIRE, "agent");
            asm volatile("s_waitcnt vmcnt(0)" ::: "memory");
        }
    }
    __syncthreads();
}

#endif
#ifdef NOINLINE_PHASES
#define NOINL __device__ __attribute__((noinline))
#else
#define NOINL __device__ __forceinline__
#endif
__shared__ __attribute__((aligned(16))) unsigned char g_smem[SMEM_BYTES + 16];
#define PH_COMMON const int G = gridDim.x, bid = blockIdx.x; unsigned char* smem = g_smem; (void)smem; (void)G; (void)bid; \
    const bf16_t* A = (const bf16_t*)(p.ws + WS_A); const bf16_t* Mx = (const bf16_t*)(p.ws + WS_M); const bf16_t* W = (const bf16_t*)(p.ws + WS_W); (void)A; (void)Mx; (void)W;
DEV void tables_in_gemm_tail(const Params& p, int layer, int nunits) {
    const int G = gridDim.x, bid = blockIdx.x, busy = nunits % G;
    if (busy == 0) { for (int it = bid; it < 2 * P0_TAB; it += G) p0_table(p, layer * 2 + it / P0_TAB, it % P0_TAB); return; }
    if (bid < busy) return;
    for (int it = bid - busy; it < 2 * P0_TAB; it += G - busy) p0_table(p, layer * 2 + it / P0_TAB, it % P0_TAB);
}
NOINL void ph0(const Params& p) { PH_COMMON phase0(p, smem); }
NOINL void ph1(const Params& p) { PH_COMMON phase1(p, smem); }
NOINL void ph2(const Params& p) { PH_COMMON EpiL0InT e{p.ws}; gemm_pg8_T(A, W + W_IN0 / 2, T, 2304, smem, e); tables_in_gemm_tail(p, 0, (T / 256) * 9); }
NOINL void ph3(const Params& p, int var = 0) { PH_COMMON phase3(p, smem, var); }
NOINL void ph4(const Params& p) { PH_COMMON EpiRes e{&p, 1, 0, 2048}; gemm_pg8_N(Mx, W + W_OUT0 / 2, T, 1024, smem, e); tables_in_gemm_tail(p, 1, (T / 256) * 4); }
NOINL void ph5(const Params& p) { PH_COMMON for (int it = bid; it < T / 8; it += G) norm_rows_item(p, it, 0, p.in[I_N2G], 0, 3072); }
NOINL void ph6(const Params& p, int var = 0) { PH_COMMON (void)var; EpiBf16 e{(bf16_t*)(p.ws + WS_P), 2048}; gemm_pg8_N(A, W + W_Q0 / 2, T, 2048, smem, e); }
NOINL void ph7(const Params& p) { PH_COMMON topk_phase(p, 0, T, smem); }
NOINL void ph8(const Params& p) { PH_COMMON for (int it = bid; it < T / 8; it += G) peer_item(p, 0, it); }
NOINL void ph9(const Params& p) { PH_COMMON EpiHgT e{p.ws, p.in[I_HGLB]}; gemm_pg8_T(A, W + W_IN1 / 2, T, 5120, smem, e); }
NOINL void ph10(const Params& p, int var = 0) { PH_COMMON for (int bi = bid; bi < NB * 32; bi += G) scan_block(p, bi, smem, var); }
NOINL void ph11(const Params& p) { PH_COMMON for (int it = bid; it < TL / 8; it += G) readout_item(p, it); }
NOINL void ph12(const Params& p) { PH_COMMON EpiRes e{&p, 0, 1, 2048}; gemm_pg8_N(Mx, W + W_OUT1 / 2, TL, 1024, smem, e); }
NOINL void ph13(const Params& p) { PH_COMMON for (int it = bid; it < TL / 8; it += G) norm_rows_item(p, it, 0, p.in[I_N2G] + 1024, 1, 3072); }
NOINL void ph14(const Params& p) { PH_COMMON EpiBf16 e{(bf16_t*)(p.ws + WS_P), 2048}; gemm_pg8_N(A, W + W_Q1 / 2, TL, 2048, smem, e); }
NOINL void ph15(const Params& p) { PH_COMMON topk_phase(p, 1, TL, smem); }
NOINL void ph16(const Params& p, int var = 0) { PH_COMMON for (int it = bid; it < TL / 8; it += G) peer_item(p, 1, it, var); }

constexpr int NPHASE = 17;
__global__ void __launch_bounds__(NT, 2) mega(Params p_in) {
    const int ph_lo = p_in.ph_lo, ph_hi = p_in.ph_hi;
#ifndef HOST_EMU
#define GBAR_MAKE() XcdBarrier gbar; gbar.bar = (unsigned*)(p_in.ws + WS_CTRL); gbar.x = xb_xcc_id(); gbar.st = (volatile LAS unsigned*)(LAS unsigned char*)(g_smem + SMEM_BYTES);
    if (ph_hi - ph_lo > 1) {
        volatile LAS unsigned* st = (volatile LAS unsigned*)(LAS unsigned char*)(g_smem + SMEM_BYTES);
        if (threadIdx.x == 0) { st[0] = 0u; st[1] = 0u; }
        __syncthreads();
        (void)xcd_barrier_post((unsigned*)(p_in.ws + WS_CTRL), st);
    }
#endif
    for (int ph = ph_lo; ph < ph_hi; ++ph) {
        if (ph > ph_lo) {
#ifndef HOST_EMU
            { GBAR_MAKE(); xcd_barrier(gbar); }
#endif
        }
#ifndef HOST_EMU
        unsigned long long kp = (unsigned long long)__builtin_amdgcn_kernarg_segment_ptr();
        asm volatile("" : "+s"(kp) :: "memory");
        const Params& p = *(const Params*)(const __attribute__((address_space(4))) Params*)kp;
#else
        const Params& p = p_in;
#endif
#ifdef REPEAT_MASK
        for (int rep_ = ((REPEAT_MASK >> ph) & 1); rep_ >= 0; --rep_) { if (rep_ == 0 && ((REPEAT_MASK >> ph) & 1)) { GBAR_MAKE(); xcd_barrier(gbar); }
#else
        {
#endif
#ifdef ONLY_PHASE
        if (ph != ONLY_PHASE) continue;
        switch (ONLY_PHASE) {
#else
        switch (ph) {
#endif
        case 0: ph0(p); break; case 1: ph1(p); break; case 2: ph2(p); break; case 3:
#if defined(REPEAT_MASK) && defined(P3_VAR)
            ph3(p, rep_ == 1 ? P3_VAR : 0);
#else
            ph3(p);
#endif
            break; case 4: ph4(p); break; case 5: ph5(p); break;
        case 6:
#if defined(REPEAT_MASK) && defined(G_VAR)
            ph6(p, rep_ == 1 ? G_VAR : 0);
#else
            ph6(p);
#endif
            break; case 7: ph7(p); break; case 8: ph8(p); break; case 9: ph9(p); break; case 10:
#if defined(REPEAT_MASK) && defined(SCAN_VAR)
            ph10(p, rep_ == 1 ? SCAN_VAR : 0);
#else
            ph10(p);
#endif
            break; case 11: ph11(p); break;
        case 12: ph12(p); break; case 13: ph13(p); break; case 14: ph14(p); break; case 15: ph15(p); break; case 16:
#if defined(REPEAT_MASK) && defined(PG_VAR)
            ph16(p, rep_ == 1 ? PG_VAR : 0);
#else
            ph16(p);
#endif
            break;
        default: break;
        }
        }
    }
}

#ifndef HOST_EMU
extern "C" void kernel_launch(void* const* d_in, const int* in_sizes, int n_in, void* d_out, int out_size, void* d_ws, size_t ws_size, hipStream_t stream) {
    if (n_in != 29 || ws_size < WS_END || out_size != TL * 1024) { fprintf(stderr, "kernel_launch: unexpected sizes (n_in %d, ws %zu need %zu, out %d)\n", n_in, ws_size, (size_t)WS_END, out_size); return; }
    static int grid = 0;
    if (!grid) { int dev = 0, cus = 0; hipGetDevice(&dev); hipDeviceGetAttribute(&cus, hipDeviceAttributeMultiprocessorCount, dev); grid = cus > 0 ? cus : 256; }
    hipMemsetAsync((unsigned char*)d_ws + WS_CTRL, 0, CTRL_BYTES, stream);
    Params p{};
    for (int i = 0; i < 29; ++i) p.in[i] = (const float*)d_in[i];
    p.out = (float*)d_out; p.ws = (unsigned char*)d_ws;
#ifdef MULTI_LAUNCH
    for (int ph = 0; ph < NPHASE; ++ph) { p.ph_lo = ph; p.ph_hi = ph + 1; hipLaunchKernelGGL(mega, dim3(grid), dim3(NT), 0, stream, p); }
#else
    p.ph_lo = 0; p.ph_hi = NPHASE;
    hipLaunchKernelGGL(mega, dim3(grid), dim3(NT), 0, stream, p);
#endif
}
#endif
```

```cpp
#ifndef HOST_EMU
#include <hip/hip_runtime.h>
#include <cstdio>
#endif

#ifndef CFG_B
#define CFG_B 8
#define CFG_L 2048
#define CFG_LC 256
#endif
#define DEV __device__ __forceinline__
#ifndef HOST_EMU
#define SCHED_FENCE() __builtin_amdgcn_sched_barrier(0)
#endif
#ifdef HOST_EMU
#define SCHED_FENCE() do {} while (0)
#define __expf expf
#define __logf logf
#define __sinf sinf
#define __cosf cosf
#endif

typedef unsigned short bf16_t;
typedef short bf16x8 __attribute__((ext_vector_type(8)));
typedef float f32x16 __attribute__((ext_vector_type(16)));
typedef float f32x4 __attribute__((ext_vector_type(4)));
typedef unsigned u32x4 __attribute__((ext_vector_type(4)));
typedef unsigned u32x2 __attribute__((ext_vector_type(2)));
struct cf2 { float x, y; };

constexpr int NB = CFG_B, L = CFG_L, LC = CFG_LC, D = 1024;
constexpr int TL = NB * L, TC = NB * LC, T = TL + TC;
constexpr int NT = 512;
constexpr int NR = NB + 1;
constexpr int log4ceil(int n) { int s = 0, v = 1; while (v < n) { v *= 4; ++s; } return s; }
constexpr int FS_LAT = log4ceil(2 * L - 1), FS_CTX = log4ceil(2 * LC - 1);
constexpr int NF_LAT = 1 << (2 * FS_LAT), NF_CTX = 1 << (2 * FS_CTX);
static_assert(T % 256 == 0 && TL % 256 == 0 && L % 128 == 0 && LC % 128 == 0 && NB % 2 == 0, "shape");

constexpr size_t al256(size_t x) { return (x + 255) & ~(size_t)255; }
constexpr size_t WS_CTRL = 0, CTRL_BYTES = 65536;
constexpr size_t CTRL_HYNORM = 4096;
constexpr size_t WS_MOD = WS_CTRL + CTRL_BYTES;
constexpr size_t WS_H = al256(WS_MOD + (size_t)2 * NR * 6144 * 4);
constexpr size_t WS_A = al256(WS_H + (size_t)T * 1024 * 4);
constexpr size_t WS_P = al256(WS_A + (size_t)T * 1024 * 2);
constexpr size_t P_BYTES = (size_t)T * 5120 * 2;
constexpr size_t P_HYT_LAT = 0;
constexpr size_t P_HYT_CTX = P_HYT_LAT + (size_t)NB * 1536 * L * 2;
constexpr size_t P_Q0 = P_HYT_CTX + (size_t)NB * 1536 * LC * 2;
constexpr size_t P_K0 = P_Q0 + (size_t)T * 512 * 2;
constexpr size_t P_VT_LAT = P_K0 + (size_t)T * 128 * 2;
constexpr size_t P_VT_CTX = P_VT_LAT + (size_t)NB * 128 * L * 2;
static_assert(P_VT_CTX + (size_t)NB * 128 * LC * 2 <= P_BYTES, "P region");
constexpr size_t P1_KQT_LAT = 0;
constexpr size_t P1_KQT_CTX = P1_KQT_LAT + (size_t)NB * 3072 * L * 2;
constexpr size_t P1_G = P1_KQT_CTX + (size_t)NB * 3072 * LC * 2;
static_assert(P1_G + (size_t)TL * 1024 * 2 <= P_BYTES, "P region (layer 1)");
constexpr size_t WS_M = al256(WS_P + P_BYTES);
constexpr size_t WS_IDX = al256(WS_M + (size_t)T * 1024 * 2);
constexpr size_t WS_GATE = al256(WS_IDX + (size_t)T * 128 * 4);
constexpr size_t WS_U6 = al256(WS_GATE + (size_t)T * 128 * 4);
constexpr size_t WS_V4 = WS_U6 + (size_t)2 * 16384 * 768;
constexpr size_t WS_S8 = WS_V4 + (size_t)2 * 16384 * 512;
constexpr size_t WS_W = al256(WS_S8 + (size_t)4 * 16384 * 4);
constexpr size_t W_IN0 = 0, W_OUT0 = W_IN0 + (size_t)2304 * 1024 * 2, W_IN1 = W_OUT0 + (size_t)1024 * 1024 * 2,
                 W_OUT1 = W_IN1 + (size_t)5120 * 1024 * 2, W_Q0 = W_OUT1 + (size_t)1024 * 1024 * 2, W_Q1 = W_Q0 + (size_t)2048 * 1024 * 2,
                 W_KEYS = W_Q1 + (size_t)2048 * 1024 * 2, W_BYTES = W_KEYS + (size_t)2 * 8 * 2 * 128 * 128 * 2;
constexpr size_t WS_F = al256(WS_W + W_BYTES);
constexpr size_t F_HRAW_LAT = 0;
constexpr size_t F_HRAW_CTX = F_HRAW_LAT + (size_t)2048 * L * 4;
constexpr size_t F_HF_LAT = F_HRAW_CTX + (size_t)2048 * LC * 4;
constexpr size_t F_HF_CTX = F_HF_LAT + (size_t)1024 * NF_LAT * 8;
constexpr size_t F_HYP_LAT = F_HF_CTX + (size_t)1024 * NF_CTX * 8;
constexpr size_t F_HYP_CTX = F_HYP_LAT + (size_t)(L / 64) * 2048 * 4;
constexpr size_t F_END = F_HYP_CTX + (size_t)(LC / 64) * 2048 * 4;
constexpr size_t F_OF = 0, F_OB = (size_t)TL * 1024 * 2;
constexpr size_t F_BYTES = F_END > 2 * F_OB ? F_END : 2 * F_OB;
constexpr size_t WS_END = al256(WS_F + F_BYTES);

struct Params { const float* in[29]; float* out; unsigned char* ws; int ph_lo, ph_hi; };
enum { I_X = 0, I_C, I_CTX, I_CCTX, I_ADAW, I_ADAB, I_N1G, I_N2G, I_FG, I_ABWIN, I_ABWOUT, I_HYCW, I_HYCB, I_HYW1, I_HYB1, I_HYW2, I_HYB2, I_HYW3,
       I_HYFREQ, I_HYSKIP, I_SINK, I_HGWIN, I_HGWOUT, I_HGLB, I_HGON, I_PWQ, I_PKEYS, I_PU, I_PV };

constexpr int SMEM_BYTES = 147456;

#ifndef HOST_EMU
DEV int tidx() { int t = threadIdx.x; asm volatile("" : "+v"(t)); return t; }
#else
DEV int tidx() { return (int)threadIdx.x; }
#endif
#ifndef HOST_EMU
DEV void lds_barrier() { asm volatile("s_waitcnt lgkmcnt(0)" ::: "memory"); __builtin_amdgcn_s_barrier(); asm volatile("" ::: "memory"); }
#else
DEV void lds_barrier() { __syncthreads(); }
#endif
#ifndef HOST_EMU
typedef __bf16 bf16n2 __attribute__((ext_vector_type(2)));
DEV unsigned pk2(float lo, float hi) { bf16n2 v; v[0] = (__bf16)lo; v[1] = (__bf16)hi; return __builtin_bit_cast(unsigned, v); }
DEV unsigned f2bf(float f) { return (unsigned)__builtin_bit_cast(unsigned short, (__bf16)f); }
#else
DEV unsigned f2bf(float f) { unsigned u = __builtin_bit_cast(unsigned, f); return (u + 0x7fffu + ((u >> 16) & 1u)) >> 16; }
DEV unsigned pk2(float lo, float hi) { return f2bf(lo) | (f2bf(hi) << 16); }
#endif
DEV float bf2f(unsigned h) { return __builtin_bit_cast(float, (h & 0xffffu) << 16); }
DEV float bflo(unsigned u) { return __builtin_bit_cast(float, u << 16); }
DEV float bfhi(unsigned u) { return __builtin_bit_cast(float, u & 0xffff0000u); }
DEV float silu_f(float x) { return x / (1.f + __expf(-x)); }
DEV float sigmoid_f(float x) { return 1.f / (1.f + __expf(-x)); }
DEV float wave_sum(float v) {
#pragma unroll
    for (int m = 32; m >= 1; m >>= 1) v += __shfl_xor(v, m);
    return v;
}
DEV int mod_row(int tok) { return tok < TL ? tok / L : NB; }

DEV void p0_mod(const Params& p, int item, unsigned char* smem) {
    const int l = item / 96, col0 = (item % 96) * 64, tid = tidx();
    float* sc = (float*)smem;
    float* red = sc + NR * 1024;
    for (int i = tid; i < NR * 1024; i += NT) { const int r = i >> 10, k = i & 1023; const float c = r < NB ? p.in[I_C][r * 1024 + k] : p.in[I_CCTX][k]; sc[i] = c / (1.f + expf(-c)); }
    __syncthreads();
    const int kq = tid >> 6, col = tid & 63;
    float acc[NR];
#pragma unroll
    for (int r = 0; r < NR; ++r) acc[r] = 0.f;
    const float* w = p.in[I_ADAW] + (size_t)l * 1024 * 6144 + col0 + col;
#pragma unroll 16
    for (int k = kq * 128; k < kq * 128 + 128; ++k) {
        const float wv = w[(size_t)k * 6144];
#pragma unroll
        for (int r = 0; r < NR; ++r) acc[r] += sc[r * 1024 + k] * wv;
    }
#pragma unroll
    for (int r = 0; r < NR; ++r) red[(kq * NR + r) * 64 + col] = acc[r];
    __syncthreads();
    float* mod = (float*)(p.ws + WS_MOD);
    for (int i = tid; i < NR * 64; i += NT) {
        const int r = i >> 6, c = i & 63; float s = 0.f;
        for (int q = 0; q < 8; ++q) s += red[(q * NR + r) * 64 + c];
        mod[((size_t)l * NR + r) * 6144 + col0 + c] = s + p.in[I_ADAB][l * 6144 + col0 + c];
    }
    __syncthreads();
}
DEV void p0_transpose(const float* W, bf16_t* Wt, int N, int tile, unsigned char* smem) {
    float* ts = (float*)smem;
    const int ntn = N / 256, kt = tile / ntn, nt = tile % ntn, k0 = kt * 64, n0 = nt * 256, tid = tidx();
    f32x4 rv[8];
#pragma unroll
    for (int m = 0; m < 8; ++m) { const int i = tid + NT * m, kk = i >> 6, c4 = i & 63; rv[m] = *(const f32x4*)(W + (size_t)(k0 + kk) * N + n0 + c4 * 4); }
#pragma unroll
    for (int m = 0; m < 8; ++m) { const int i = tid + NT * m, kk = i >> 6, c4 = i & 63; *(f32x4*)(ts + kk * 260 + c4 * 4) = rv[m]; }
    __syncthreads();
#pragma unroll
    for (int m = 0; m < 4; ++m) { const int i = tid + NT * m, nn = i >> 3, k8 = i & 7;
        u32x4 o;
#pragma unroll
        for (int e = 0; e < 4; ++e) o[e] = pk2(ts[(k8 * 8 + 2 * e) * 260 + nn], ts[(k8 * 8 + 2 * e + 1) * 260 + nn]);
        *(u32x4*)(Wt + (size_t)(n0 + nn) * 1024 + k0 + k8 * 8) = o; }
    __syncthreads();
}
DEV void p0_convert(const float* src, bf16_t* dst, int item) {
    const int tid = tidx();
#pragma unroll
    for (int i = 0; i < 8; ++i) {
        const size_t e = (size_t)item * 16384 + (size_t)(i * NT + tid) * 4;
        const f32x4 v = *(const f32x4*)(src + e);
        u32x2 o; o[0] = pk2(v[0], v[1]); o[1] = pk2(v[2], v[3]);
        *(u32x2*)(dst + e) = o;
    }
}
typedef float f32x2 __attribute__((ext_vector_type(2)));
typedef float f32x32 __attribute__((ext_vector_type(32)));
typedef unsigned u32x6 __attribute__((ext_vector_type(6)));
DEV void p0_table(const Params& p, int tab, int item) {
    const int lane = tidx() & 63, li = lane & 31, half = lane >> 5, layer = tab >> 1, isv = tab & 1;
#pragma unroll 1
    for (int pass = 0; pass < 2; ++pass) {
        const int row = item * 32 + pass * 16 + (tidx() >> 6) * 2 + half;
        const float* src = (isv ? p.in[I_PV] : p.in[I_PU]) + ((size_t)layer * 16384 + row) * 1024 + li * 32;
        f32x4 v[8]; float mx = 0.f;
#pragma unroll
        for (int i = 0; i < 8; ++i) { v[i] = *(const f32x4*)(src + 4 * i); mx = fmaxf(mx, fmaxf(fmaxf(fabsf(v[i][0]), fabsf(v[i][1])), fmaxf(fabsf(v[i][2]), fabsf(v[i][3])))); }
#pragma unroll
        for (int m = 16; m >= 1; m >>= 1) mx = fmaxf(mx, __shfl_xor(mx, m));
        const float top = isv ? 6.f : 7.5f;
        const float sc = mx > 0.f ? top / mx : 1.f;
        if (!isv) {
            f32x16 pa, pb;
#pragma unroll
            for (int i = 0; i < 16; ++i) { pa[i] = 0.f; pb[i] = 0.f; }
            pa[1] = 1.0f;
            const f32x32 pr = __builtin_amdgcn_cvt_scalef32_pk32_f32_fp6(__builtin_amdgcn_cvt_scalef32_2xpk16_fp6_f32(pa, pb, 1.0f), 1.0f);
            const bool inter = pr[2] == 1.0f;
            f32x16 lo, hi;
#pragma unroll
            for (int i = 0; i < 4; ++i)
#pragma unroll
                for (int e = 0; e < 4; ++e) {
                    const int j = 4 * i + e;
                    const float lin_lo = v[i][e], lin_hi = v[4 + i][e];
                    const float il_lo = v[(2 * j) >> 2][(2 * j) & 3], il_hi = v[(2 * j + 1) >> 2][(2 * j + 1) & 3];
                    lo[j] = (inter ? il_lo : lin_lo) * sc; hi[j] = (inter ? il_hi : lin_hi) * sc;
                }
            const u32x6 w = __builtin_amdgcn_cvt_scalef32_2xpk16_fp6_f32(lo, hi, 1.0f);
            unsigned char* dst = p.ws + WS_U6 + ((size_t)layer * 16384 + row) * 768;
            u32x4 w0; w0[0] = w[0]; w0[1] = w[1]; w0[2] = w[2]; w0[3] = w[3]; u32x2 w1; w1[0] = w[4]; w1[1] = w[5];
            *(u32x4*)(dst + li * 16) = w0; *(u32x2*)(dst + 512 + li * 8) = w1;
        } else {
            const f32x2 pr4 = __builtin_amdgcn_cvt_scalef32_pk_f32_fp4(__builtin_amdgcn_cvt_scalef32_pk_fp4_f32(0u, 1.0f, 0.0f, 1.0f, 0), 1.0f, 0);
            const bool swp = pr4[0] != 1.0f;
            u32x4 w;
#pragma unroll
            for (int d = 0; d < 4; ++d) { unsigned x = 0u;
                x = __builtin_amdgcn_cvt_scalef32_pk_fp4_f32(x, (swp ? v[2 * d][1] : v[2 * d][0]) * sc, (swp ? v[2 * d][0] : v[2 * d][1]) * sc, 1.0f, 0);
                x = __builtin_amdgcn_cvt_scalef32_pk_fp4_f32(x, (swp ? v[2 * d][3] : v[2 * d][2]) * sc, (swp ? v[2 * d][2] : v[2 * d][3]) * sc, 1.0f, 1);
                x = __builtin_amdgcn_cvt_scalef32_pk_fp4_f32(x, (swp ? v[2 * d + 1][1] : v[2 * d + 1][0]) * sc, (swp ? v[2 * d + 1][0] : v[2 * d + 1][1]) * sc, 1.0f, 2);
                x = __builtin_amdgcn_cvt_scalef32_pk_fp4_f32(x, (swp ? v[2 * d + 1][3] : v[2 * d + 1][2]) * sc, (swp ? v[2 * d + 1][2] : v[2 * d + 1][3]) * sc, 1.0f, 3);
                w[d] = x; }
            *(u32x4*)(p.ws + WS_V4 + ((size_t)layer * 16384 + row) * 512 + li * 16) = w;
        }
        if (li == 0) ((float*)(p.ws + WS_S8))[tab * 16384 + row] = mx > 0.f ? mx / top : 1.f;
    }
}
DEV void p0_filter(const Params& p, int set, int chunk, int cb, unsigned char* smem) {
    const int Ls = set ? LC : L, l0 = chunk * 64, tid = tidx();
    float* z = (float*)smem;
    float* hd1 = z + 64 * 34;
    float* hd2 = hd1 + 64 * 65;
    const float* w1 = p.in[I_HYW1]; const float* b1 = p.in[I_HYB1]; const float* w2 = p.in[I_HYW2]; const float* b2 = p.in[I_HYB2];
    const float* w3 = p.in[I_HYW3]; const float* fq = p.in[I_HYFREQ];
    for (int i = tid; i < 64 * 33; i += NT) {
        const int pp = i / 33, f = i % 33, l = l0 + pp; float val;
        if (f == 0) val = (float)l / (float)(Ls - 1);
        else { const int jb = (f - 1) & 15; const float fj = 1e-4f + (float)jb * ((15.f - 1e-4f) / 15.f); const float a = fj * (6.283185307179586f * (float)l / (float)Ls); val = f <= 16 ? __cosf(a) : -__sinf(a); }
        z[pp * 34 + f] = val;
    }
    __syncthreads();
    {
        const int j = tid & 63, p0 = tid >> 6;
        float wc[64], acc[8];
#pragma unroll
        for (int f = 0; f < 33; ++f) wc[f] = w1[f * 64 + j];
#pragma unroll
        for (int m = 0; m < 8; ++m) { float sacc = b1[j];
#pragma unroll
            for (int f = 0; f < 33; ++f) sacc = fmaf(z[(p0 + 8 * m) * 34 + f], wc[f], sacc);
            acc[m] = sacc; }
#pragma unroll
        for (int m = 0; m < 8; ++m) hd1[(p0 + 8 * m) * 65 + j] = __sinf(fq[j] * acc[m]);
        __syncthreads();
#pragma unroll
        for (int f = 0; f < 64; ++f) wc[f] = w2[f * 64 + j];
#pragma unroll
        for (int m = 0; m < 8; ++m) { float sacc = b2[j];
#pragma unroll
            for (int f = 0; f < 64; ++f) sacc = fmaf(hd1[(p0 + 8 * m) * 65 + f], wc[f], sacc);
            acc[m] = sacc; }
#pragma unroll
        for (int m = 0; m < 8; ++m) hd2[(p0 + 8 * m) * 65 + j] = __sinf(fq[j] * acc[m]);
        __syncthreads();
    }
    const float max_decay = -15.350567286626973f, min_decay = -3.0701134573253945f;
    float* hraw = (float*)(p.ws + WS_F + (set ? F_HRAW_CTX : F_HRAW_LAT));
    float* hyn = (float*)(p.ws + WS_F + (set ? F_HYP_CTX : F_HYP_LAT)) + (size_t)chunk * 2048;
    {
        const int o = cb * NT + tid;
        const int c = o & 511; const float delta = fabsf(min_decay + (float)c * ((max_decay - min_decay) / 511.f));
        float asum = 0.f;
        float* dst = hraw + (size_t)o * Ls + l0;
        for (int ph = 0; ph < 2; ++ph) {
            float acc[32];
#pragma unroll
            for (int pp = 0; pp < 32; ++pp) acc[pp] = 0.f;
#pragma unroll 1
            for (int j0 = 0; j0 < 64; j0 += 16) {
                float wv[16];
#pragma unroll
                for (int j = 0; j < 16; ++j) wv[j] = w3[(j0 + j) * 2048 + o];
#pragma unroll
                for (int j = 0; j < 16; ++j) {
#pragma unroll
                    for (int pp = 0; pp < 32; ++pp) acc[pp] = fmaf(hd2[(ph * 32 + pp) * 65 + j0 + j], wv[j], acc[pp]);
                    SCHED_FENCE();
                }
            }
#pragma unroll
            for (int q4 = 0; q4 < 8; ++q4) {
                f32x4 v;
#pragma unroll
                for (int e = 0; e < 4; ++e) { const int pp = q4 * 4 + e; const float tl = (float)(l0 + ph * 32 + pp) / (float)(Ls - 1); const float val = acc[pp] * expf(-tl * delta); v[e] = val; asum += fabsf(val); }
                *(f32x4*)(dst + ph * 32 + q4 * 4) = v;
            }
        }
        hyn[o] = asum;
    }
    __syncthreads();
}

constexpr int P0_MOD = 192, P0_TR_IN0 = 16 * 9, P0_TR_OUT0 = 64, P0_TR_IN1 = 16 * 20, P0_TR_OUT1 = 64, P0_TR_Q = 16 * 8, P0_KEYS = 32, P0_TAB = 512,
              P0_FILT = 4 * (L / 64 + LC / 64);
DEV void phase0(const Params& p, unsigned char* smem) {
    bf16_t* W = (bf16_t*)(p.ws + WS_W);
    const int total = P0_MOD + P0_FILT + P0_TR_IN0 + P0_TR_OUT0 + P0_TR_IN1 + P0_TR_OUT1 + 2 * P0_TR_Q + P0_KEYS;
    for (int it = blockIdx.x; it < total; it += gridDim.x) {
        int i = it;
        if (i < P0_MOD) { p0_mod(p, i, smem); continue; } i -= P0_MOD;
        if (i < P0_FILT) { const int ch = i >> 2, cb = i & 3; if (ch < L / 64) p0_filter(p, 0, ch, cb, smem); else p0_filter(p, 1, ch - L / 64, cb, smem); continue; } i -= P0_FILT;
        if (i < P0_TR_IN0) { p0_transpose(p.in[I_ABWIN], W + W_IN0 / 2, 2304, i, smem); continue; } i -= P0_TR_IN0;
        if (i < P0_TR_OUT0) { p0_transpose(p.in[I_ABWOUT], W + W_OUT0 / 2, 1024, i, smem); continue; } i -= P0_TR_OUT0;
        if (i < P0_TR_IN1) { p0_transpose(p.in[I_HGWIN], W + W_IN1 / 2, 5120, i, smem); continue; } i -= P0_TR_IN1;
        if (i < P0_TR_OUT1) { p0_transpose(p.in[I_HGWOUT], W + W_OUT1 / 2, 1024, i, smem); continue; } i -= P0_TR_OUT1;
        if (i < P0_TR_Q) { p0_transpose(p.in[I_PWQ], W + W_Q0 / 2, 2048, i, smem); continue; } i -= P0_TR_Q;
        if (i < P0_TR_Q) { p0_transpose(p.in[I_PWQ] + (size_t)1024 * 2048, W + W_Q1 / 2, 2048, i, smem); continue; } i -= P0_TR_Q;
        p0_convert(p.in[I_PKEYS], W + W_KEYS / 2, i);
    }
}

DEV const float* h_row(const Params& p, int layer_src_inputs, int tok) {
    if (layer_src_inputs) return tok < TL ? p.in[I_X] + (size_t)tok * 1024 : p.in[I_CTX] + (size_t)(tok - TL) * 1024;
    return (const float*)(p.ws + WS_H) + (size_t)tok * 1024;
}
DEV void norm_row_store(const Params& p, const f32x4 (&v)[4], int tok, const float* g, int layer, int sh_off, int lane) {
    float ss = 0.f;
#pragma unroll
    for (int i = 0; i < 4; ++i) ss += v[i][0] * v[i][0] + v[i][1] * v[i][1] + v[i][2] * v[i][2] + v[i][3] * v[i][3];
    ss = wave_sum(ss);
    const float rstd = rsqrtf(ss * (1.f / 1024.f) + 1e-6f);
    const float* mod = (const float*)(p.ws + WS_MOD) + ((size_t)layer * NR + mod_row(tok)) * 6144 + sh_off;
    bf16_t* A = (bf16_t*)(p.ws + WS_A) + (size_t)tok * 1024;
#pragma unroll
    for (int i = 0; i < 4; ++i) {
        const int c = i * 256 + lane * 4;
        const f32x4 gg = *(const f32x4*)(g + c), sh = *(const f32x4*)(mod + c), sc = *(const f32x4*)(mod + 1024 + c);
        u32x2 o;
        o[0] = pk2(v[i][0] * rstd * gg[0] * (1.f + sc[0]) + sh[0], v[i][1] * rstd * gg[1] * (1.f + sc[1]) + sh[1]);
        o[1] = pk2(v[i][2] * rstd * gg[2] * (1.f + sc[2]) + sh[2], v[i][3] * rstd * gg[3] * (1.f + sc[3]) + sh[3]);
        *(u32x2*)(A + c) = o;
    }
}
DEV void norm_rows_item(const Params& p, int item, int from_inputs, const float* g, int layer, int sh_off) {
    const int tok = item * 8 + (tidx() >> 6), lane = tidx() & 63;
    const float* src = h_row(p, from_inputs, tok);
    f32x4 v[4];
#pragma unroll
    for (int i = 0; i < 4; ++i) v[i] = *(const f32x4*)(src + i * 256 + lane * 4);
    norm_row_store(p, v, tok, g, layer, sh_off, lane);
}

DEV cf2 cmul(cf2 a, cf2 b) { cf2 r; r.x = a.x * b.x - a.y * b.y; r.y = a.x * b.y + a.y * b.x; return r; }
DEV cf2 twid(int k, float invN) { cf2 r; const float a = (float)k * invN; r.x = __builtin_amdgcn_cosf(a); r.y = -__builtin_amdgcn_sinf(a); return r; }
DEV int fsw(int i) { return i ^ ((i >> 4) & 15) ^ (((i >> 8) & 1) << 4); }
DEV void bfly4_fwd(cf2& a0, cf2& a1, cf2& a2, cf2& a3) {
    cf2 t0, t1, t2, t3; t0.x = a0.x + a2.x; t0.y = a0.y + a2.y; t1.x = a0.x - a2.x; t1.y = a0.y - a2.y; t2.x = a1.x + a3.x; t2.y = a1.y + a3.y;
    const float dx = a1.x - a3.x, dy = a1.y - a3.y; t3.x = dy; t3.y = -dx;
    a0.x = t0.x + t2.x; a0.y = t0.y + t2.y; a1.x = t1.x + t3.x; a1.y = t1.y + t3.y; a2.x = t0.x - t2.x; a2.y = t0.y - t2.y; a3.x = t1.x - t3.x; a3.y = t1.y - t3.y;
}
DEV void bfly4_inv(cf2& c0, cf2& c1, cf2& c2, cf2& c3) {
    cf2 t0, t1, t2, t3; t0.x = c0.x + c2.x; t0.y = c0.y + c2.y; t1.x = c0.x - c2.x; t1.y = c0.y - c2.y; t2.x = c1.x + c3.x; t2.y = c1.y + c3.y;
    const float dx = c1.x - c3.x, dy = c1.y - c3.y; t3.x = -dy; t3.y = dx;
    c0.x = t0.x + t2.x; c0.y = t0.y + t2.y; c1.x = t1.x + t3.x; c1.y = t1.y + t3.y; c2.x = t0.x - t2.x; c2.y = t0.y - t2.y; c3.x = t1.x - t3.x; c3.y = t1.y - t3.y;
}
DEV void fft_stage4(cf2* buf, int S, int s, int g, int G, bool inv) {
    const int N = 1 << (2 * S); const float invN = 1.f / (float)N;
    const int lm = 2 * (S - s), m = 1 << lm, q = m >> 2;
    for (int bf = g; bf < (N >> 2); bf += G) {
        const int j = bf & (q - 1), base = ((bf >> (lm - 2)) << lm) + j, tw = j << (2 * s);
        cf2 a0 = buf[fsw(base)], a1 = buf[fsw(base + q)], a2 = buf[fsw(base + 2 * q)], a3 = buf[fsw(base + 3 * q)];
        if (!inv) { bfly4_fwd(a0, a1, a2, a3); a1 = cmul(a1, twid(tw, invN)); a2 = cmul(a2, twid(2 * tw, invN)); a3 = cmul(a3, twid(3 * tw, invN)); }
        else { cf2 w1 = twid(tw, invN), w2 = twid(2 * tw, invN), w3 = twid(3 * tw, invN); w1.y = -w1.y; w2.y = -w2.y; w3.y = -w3.y; a1 = cmul(a1, w1); a2 = cmul(a2, w2); a3 = cmul(a3, w3); bfly4_inv(a0, a1, a2, a3); }
        buf[fsw(base)] = a0; buf[fsw(base + q)] = a1; buf[fsw(base + 2 * q)] = a2; buf[fsw(base + 3 * q)] = a3;
    }
}
DEV void fft_stage16(cf2* buf, int S, int s, int g, int G, bool inv) {
    const int N = 1 << (2 * S); const float invN = 1.f / (float)N;
    const int lm = 2 * (S - s), m = 1 << lm, q = m >> 2, q2 = q >> 2;
    for (int u = g; u < (N >> 4); u += G) {
        const int j2 = u & (q2 - 1), base = ((u >> (lm - 4)) << lm) + j2;
        cf2 x[4][4];
#pragma unroll
        for (int c = 0; c < 4; ++c)
#pragma unroll
            for (int c2 = 0; c2 < 4; ++c2) x[c][c2] = buf[fsw(base + c * q + c2 * q2)];
        if (!inv) {
#pragma unroll
            for (int c2 = 0; c2 < 4; ++c2) {
                const int tw = (j2 + c2 * q2) << (2 * s);
                bfly4_fwd(x[0][c2], x[1][c2], x[2][c2], x[3][c2]);
                x[1][c2] = cmul(x[1][c2], twid(tw, invN)); x[2][c2] = cmul(x[2][c2], twid(2 * tw, invN)); x[3][c2] = cmul(x[3][c2], twid(3 * tw, invN));
                SCHED_FENCE();
            }
            const int tw2 = j2 << (2 * (s + 1));
            const cf2 v1 = twid(tw2, invN), v2 = twid(2 * tw2, invN), v3 = twid(3 * tw2, invN);
#pragma unroll
            for (int c = 0; c < 4; ++c) {
                bfly4_fwd(x[c][0], x[c][1], x[c][2], x[c][3]);
                x[c][1] = cmul(x[c][1], v1); x[c][2] = cmul(x[c][2], v2); x[c][3] = cmul(x[c][3], v3);
            }
        } else {
            const int tw2 = j2 << (2 * (s + 1));
            cf2 v1 = twid(tw2, invN), v2 = twid(2 * tw2, invN), v3 = twid(3 * tw2, invN); v1.y = -v1.y; v2.y = -v2.y; v3.y = -v3.y;
#pragma unroll
            for (int c = 0; c < 4; ++c) {
                x[c][1] = cmul(x[c][1], v1); x[c][2] = cmul(x[c][2], v2); x[c][3] = cmul(x[c][3], v3);
                bfly4_inv(x[c][0], x[c][1], x[c][2], x[c][3]);
            }
#pragma unroll
            for (int c2 = 0; c2 < 4; ++c2) {
                const int tw = (j2 + c2 * q2) << (2 * s);
                cf2 w1 = twid(tw, invN), w2 = twid(2 * tw, invN), w3 = twid(3 * tw, invN); w1.y = -w1.y; w2.y = -w2.y; w3.y = -w3.y;
                x[1][c2] = cmul(x[1][c2], w1); x[2][c2] = cmul(x[2][c2], w2); x[3][c2] = cmul(x[3][c2], w3);
                bfly4_inv(x[0][c2], x[1][c2], x[2][c2], x[3][c2]);
                SCHED_FENCE();
            }
        }
#pragma unroll
        for (int c = 0; c < 4; ++c)
#pragma unroll
            for (int c2 = 0; c2 < 4; ++c2) buf[fsw(base + c * q + c2 * q2)] = x[c][c2];
    }
}
DEV void fft_fwd(cf2* buf, int S, int g, int G) {
    int s = 0;
    for (; s + 1 < S; s += 2) { fft_stage16(buf, S, s, g, G, false); __syncthreads(); }
    if (s < S) { fft_stage4(buf, S, s, g, G, false); __syncthreads(); }
}
DEV void fft_inv(cf2* buf, int S, int g, int G) {
    int s = S - 1;
    if (S & 1) { fft_stage4(buf, S, s, g, G, true); __syncthreads(); --s; }
    for (; s >= 1; s -= 2) { fft_stage16(buf, S, s - 1, g, G, true); __syncthreads(); }
}
DEV void hf_item(const Params& p, int set, int pi, unsigned char* smem) {
    const int Ls = set ? LC : L, S = set ? FS_CTX : FS_LAT, N = 1 << (2 * S);
    const int gi = tidx() >> 8, g = tidx() & 255, idx = pi * 2 + gi, o = idx >> 9, c = idx & 511;
    cf2* buf = (cf2*)smem + (size_t)gi * N;
    const float* hraw = (const float*)(p.ws + WS_F + (set ? F_HRAW_CTX : F_HRAW_LAT));
    const float* hyn = (const float*)(p.ws + WS_F + (set ? F_HYP_CTX : F_HYP_LAT));
    float nsum = 0.f;
    for (int ch = 0; ch < Ls / 64; ++ch) nsum += hyn[(size_t)ch * 2048 + o * 1024 + c] + hyn[(size_t)ch * 2048 + o * 1024 + 512 + c];
    const float inv = 1.f / nsum;
    const float* hf = hraw + (size_t)(o * 1024 + c) * Ls; const float* hb = hraw + (size_t)(o * 1024 + 512 + c) * Ls;
#pragma unroll 4
    for (int k = g; k < N; k += 256) { float re = 0.f; if (k < Ls) re = hf[k] * inv; else if (k > N - Ls) re = hb[N - k] * inv; cf2 v; v.x = re; v.y = 0.f; buf[fsw(k)] = v; }
    __syncthreads();
    fft_fwd(buf, S, g, 256);
    cf2* HF = (cf2*)(p.ws + WS_F + (set ? F_HF_CTX : F_HF_LAT)) + (size_t)(o * 512 + c) * N;
    for (int k = g; k < N; k += 256) HF[k] = buf[fsw(k)];
    __syncthreads();
}
constexpr int P1_NORM = T / 8, P1_HF = 512;
DEV void phase1(const Params& p, unsigned char* smem) {
    const int total = P1_NORM + 2 * P1_HF;
    for (int it = blockIdx.x; it < total; it += gridDim.x) {
        if (it < P1_NORM) norm_rows_item(p, it, 1, p.in[I_N1G], 0, 0);
        else if (it < P1_NORM + P1_HF) hf_item(p, 0, it - P1_NORM, smem);
        else hf_item(p, 1, it - P1_NORM - P1_HF, smem);
    }
}

constexpr int G_LDA = 72;
template <class Epi>
DEV void gemm_tile(const bf16_t* __restrict__ A, const bf16_t* __restrict__ Wt, int m0, int n0, unsigned char* smem, const Epi& epi, int var = 0) {
    bf16_t* As = (bf16_t*)smem;
    bf16_t* Bs = As + 2 * 256 * G_LDA;
    const int tid = tidx(), lane = tid & 63, w = tid >> 6, wm = w >> 1, wn = w & 1;
    f32x16 acc[2][2];
#pragma unroll
    for (int i = 0; i < 2; ++i)
#pragma unroll
        for (int j = 0; j < 2; ++j)
#pragma unroll
            for (int r = 0; r < 16; ++r) acc[i][j][r] = 0.f;
    u32x4 ra[4], rb[2];
    const bf16_t* Ag = A + (size_t)m0 * 1024; const bf16_t* Bg = Wt + (size_t)n0 * 1024;
#define GLOAD(k0) do { \
        _Pragma("unroll") for (int i = 0; i < 4; ++i) { const int id = tid + NT * i, row = id >> 3, kc = id & 7; ra[i] = *(const u32x4*)(Ag + (size_t)row * 1024 + (k0) + kc * 8); } \
        _Pragma("unroll") for (int i = 0; i < 2; ++i) { const int id = tid + NT * i, row = id >> 3, kc = id & 7; rb[i] = *(const u32x4*)(Bg + (size_t)row * 1024 + (k0) + kc * 8); } } while (0)
#define LSTORE(buf_) do { \
        _Pragma("unroll") for (int i = 0; i < 4; ++i) { const int id = tid + NT * i, row = id >> 3, kc = id & 7; *(u32x4*)(As + ((buf_) * 256 + row) * G_LDA + kc * 8) = ra[i]; } \
        _Pragma("unroll") for (int i = 0; i < 2; ++i) { const int id = tid + NT * i, row = id >> 3, kc = id & 7; *(u32x4*)(Bs + ((buf_) * 128 + row) * G_LDA + kc * 8) = rb[i]; } } while (0)
    GLOAD(0); LSTORE(0); __syncthreads();
    for (int kt = 0; kt < (var == 2 ? 1 : 16); ++kt) {
        const int buf = kt & 1;
        if (kt + 1 < 16) GLOAD((kt + 1) * 64);
        const bf16_t* as = As + (buf * 256 + wm * 64 + (lane & 31)) * G_LDA + 8 * (lane >> 5);
        const bf16_t* bs = Bs + (buf * 128 + wn * 64 + (lane & 31)) * G_LDA + 8 * (lane >> 5);
#pragma unroll
        for (int kk = 0; kk < 4; ++kk) {
            const bf16x8 a0 = *(const bf16x8*)(as + kk * 16), a1 = *(const bf16x8*)(as + 32 * G_LDA + kk * 16);
            const bf16x8 b0 = *(const bf16x8*)(bs + kk * 16), b1 = *(const bf16x8*)(bs + 32 * G_LDA + kk * 16);
            acc[0][0] = __builtin_amdgcn_mfma_f32_32x32x16_bf16(a0, b0, acc[0][0], 0, 0, 0);
            acc[0][1] = __builtin_amdgcn_mfma_f32_32x32x16_bf16(a0, b1, acc[0][1], 0, 0, 0);
            acc[1][0] = __builtin_amdgcn_mfma_f32_32x32x16_bf16(a1, b0, acc[1][0], 0, 0, 0);
            acc[1][1] = __builtin_amdgcn_mfma_f32_32x32x16_bf16(a1, b1, acc[1][1], 0, 0, 0);
        }
        if (kt + 1 < 16) LSTORE(buf ^ 1);
        __syncthreads();
    }
#ifndef HOST_EMU
    if (var == 1) { asm volatile("" :: "v"(acc[0][0]), "v"(acc[0][1]), "v"(acc[1][0]), "v"(acc[1][1])); return; }
#endif
#pragma unroll
    for (int mi = 0; mi < 2; ++mi)
#pragma unroll
        for (int ni = 0; ni < 2; ++ni)
#pragma unroll
            for (int rg = 0; rg < 4; ++rg) {
                const int row = m0 + wm * 64 + mi * 32 + 8 * rg + 4 * (lane >> 5), col = n0 + wn * 64 + ni * 32 + (lane & 31);
                epi(row, col, acc[mi][ni][rg * 4 + 0], acc[mi][ni][rg * 4 + 1], acc[mi][ni][rg * 4 + 2], acc[mi][ni][rg * 4 + 3]);
            }
}
template <class Epi>
DEV void gemm_tile256(const bf16_t* __restrict__ A, const bf16_t* __restrict__ Wt, int m0, int n0, unsigned char* smem, const Epi& epi) {
    bf16_t* As = (bf16_t*)smem;
    bf16_t* Bs = As + 2 * 256 * G_LDA;
    const int tid = tidx(), lane = tid & 63, w = tid >> 6, wm = w >> 2, wn = w & 3;
    f32x16 acc[4][2];
#pragma unroll
    for (int i = 0; i < 4; ++i)
#pragma unroll
        for (int j = 0; j < 2; ++j)
#pragma unroll
            for (int r = 0; r < 16; ++r) acc[i][j][r] = 0.f;
    u32x4 ra[4], rb[4];
    const bf16_t* Ag = A + (size_t)m0 * 1024; const bf16_t* Bg = Wt + (size_t)n0 * 1024;
#define GLOAD2(k0) do { \
        _Pragma("unroll") for (int i = 0; i < 4; ++i) { const int id = tid + NT * i, row = id >> 3, kc = id & 7; ra[i] = *(const u32x4*)(Ag + (size_t)row * 1024 + (k0) + kc * 8); rb[i] = *(const u32x4*)(Bg + (size_t)row * 1024 + (k0) + kc * 8); } } while (0)
#define LSTORE2(buf_) do { \
        _Pragma("unroll") for (int i = 0; i < 4; ++i) { const int id = tid + NT * i, row = id >> 3, kc = id & 7; *(u32x4*)(As + ((buf_) * 256 + row) * G_LDA + kc * 8) = ra[i]; *(u32x4*)(Bs + ((buf_) * 256 + row) * G_LDA + kc * 8) = rb[i]; } } while (0)
    GLOAD2(0); LSTORE2(0); __syncthreads();
    for (int kt = 0; kt < 16; ++kt) {
        const int buf = kt & 1;
        if (kt + 1 < 16) GLOAD2((kt + 1) * 64);
        const bf16_t* as = As + (buf * 256 + wm * 128 + (lane & 31)) * G_LDA + 8 * (lane >> 5);
        const bf16_t* bs = Bs + (buf * 256 + wn * 64 + (lane & 31)) * G_LDA + 8 * (lane >> 5);
#pragma unroll
        for (int kk = 0; kk < 4; ++kk) {
            bf16x8 af[4], bfr[2];
#pragma unroll
            for (int i = 0; i < 4; ++i) af[i] = *(const bf16x8*)(as + i * 32 * G_LDA + kk * 16);
#pragma unroll
            for (int j = 0; j < 2; ++j) bfr[j] = *(const bf16x8*)(bs + j * 32 * G_LDA + kk * 16);
#pragma unroll
            for (int i = 0; i < 4; ++i)
#pragma unroll
                for (int j = 0; j < 2; ++j) acc[i][j] = __builtin_amdgcn_mfma_f32_32x32x16_bf16(af[i], bfr[j], acc[i][j], 0, 0, 0);
        }
        if (kt + 1 < 16) LSTORE2(buf ^ 1);
        __syncthreads();
    }
#undef GLOAD2
#undef LSTORE2
#pragma unroll
    for (int mi = 0; mi < 4; ++mi)
#pragma unroll
        for (int ni = 0; ni < 2; ++ni)
#pragma unroll
            for (int rg = 0; rg < 4; ++rg) {
                const int row = m0 + wm * 128 + mi * 32 + 8 * rg + 4 * (lane >> 5), col = n0 + wn * 64 + ni * 32 + (lane & 31);
                epi(row, col, acc[mi][ni][rg * 4 + 0], acc[mi][ni][rg * 4 + 1], acc[mi][ni][rg * 4 + 2], acc[mi][ni][rg * 4 + 3]);
            }
}
namespace pg8 {
#ifndef HOST_EMU
#define PG8_LAS __attribute__((address_space(3)))
#else
#define PG8_LAS
#endif
typedef unsigned short bf16_t;
constexpr int BM = 256, BK = 64, HALF = 128, HTB = HALF * BK * 2  , STAGE_BYTES = 8 * HTB, NXCD = 8, WGM = 8;

__host__ __device__ __forceinline__ int lds_byte(int r, int c) { const int st = (r >> 4) * 2 + (c >> 5), rr = r & 15, cc = c & 31, ob = rr * 64 + cc * 2; return st * 1024 + (ob ^ (((ob >> 9) & 1) << 5)); }
__host__ __device__ __forceinline__ void stage_rc(int b, int& R, int& C) { const int st = b / 1024, sb = b % 1024, swz = sb ^ (((sb >> 9) & 1) << 5); R = (st >> 1) * 16 + swz / 64; C = (st & 1) * 32 + (swz % 64) / 2; }
__host__ __device__ __forceinline__ int perm32(int rho) { const int n = rho >> 4, i = rho & 15; return 8 * (i >> 2) + 4 * n + (i & 3); }

struct Unit { int pm, pn; };
struct Gemm { const bf16_t* A; const bf16_t* Bt; int M, N, K; };

struct StaticOrder {
    int nM, nN, nwg, G, c;
    __host__ __device__ void init(int M, int N, int G_, int c_) { nM = M / BM; nN = N / BM; nwg = nM * nN; G = G_; c = c_; }
    __host__ __device__ bool next(int i, Unit& u) const {
        const long L = (long)i * G + c; if (L >= nwg) return false;
        int wgid = (int)L; { const int q = nwg / NXCD, r = nwg % NXCD, xcd = wgid % NXCD, off = wgid / NXCD; wgid = (xcd < r ? xcd * (q + 1) : r * (q + 1) + (xcd - r) * q) + off; }
        const int nig = WGM * nN, gid = wgid / nig, fm = gid * WGM, gsz = (nM - fm) < WGM ? (nM - fm) : WGM;
        u.pm = fm + ((wgid % nig) % gsz); u.pn = (wgid % nig) / gsz; return true;
    }
    __device__ __forceinline__ void a_ready(const Unit&) const {}
    __device__ __forceinline__ void done(const Unit&) const {}
};
template <class Epi, class Sched, bool STAMP = false>
__device__ __forceinline__ void gemm_phase(PG8_LAS unsigned char* lds, const Gemm g, const Sched& S, const Epi& E, unsigned long long* stamps = nullptr) {
    const int tid = tidx(), wid = __builtin_amdgcn_readfirstlane(tid >> 6), lane = tid & 63, wr = wid >> 2, wc = wid & 3, fr = lane & 15, fq = lane >> 4;
    const int K = g.K, nt = K / BK;
    int ts_lo = 0, ts_hi = 0, nts = 0; const unsigned long long rt_entry = 0ull; (void)rt_entry; (void)ts_lo; (void)ts_hi; (void)nts;
#define PG8_STAMP() do { if (STAMP && wid == 0 && nts < 64) { const unsigned long long _c = 0ull; \
        ts_lo = (lane == nts) ? (int)(unsigned)_c : ts_lo; ts_hi = (lane == nts) ? (int)(unsigned)(_c >> 32) : ts_hi; ++nts; } } while (0)
    PG8_STAMP();
    unsigned voffA[2], voffB[2];
#pragma unroll
    for (int i = 0; i < 2; ++i) { int R, C; stage_rc(tid * 16 + i * 8192, R, C); const int Rb = Epi::PERM ? ((R & ~31) + perm32(R & 31)) : R;
        voffA[i] = (unsigned)(R * K + C) * 2u; voffB[i] = (unsigned)(Rb * K + C) * 2u; }
    const size_t kstep = (size_t)(BK * 2);
    const size_t hstep = (size_t)HALF * K * 2;
    const size_t tstep = 2 * hstep;
    const unsigned ldsw = (unsigned)wid * 1024u;
    const int aoff = lds_byte(wr * 64 + fr, fq * 8), boff = lds_byte(wc * 32 + fr, fq * 8);
#define PG8_SA(b, h) (((b) * 2 + (h)) * HTB)
#define PG8_SB(b, h) ((4 + (b) * 2 + (h)) * HTB)
#define PG8_STAGE(bufoff, gbase, voff) do { _Pragma("unroll") for (int _i = 0; _i < 2; ++_i) \
        __builtin_amdgcn_global_load_lds((const unsigned*)((const char*)(gbase) + (voff)[_i]), (PG8_LAS unsigned*)(lds + (bufoff) + ldsw + _i * 8192), 16, 0, 0); } while (0)
#define PG8_LDA(dst, b, h) do { _Pragma("unroll") for (int m = 0; m < 4; ++m) _Pragma("unroll") for (int k = 0; k < 2; ++k) dst[m][k] = *(const PG8_LAS bf16x8*)(lds + PG8_SA(b, h) + aoff + m * 2048 + k * 1024); } while (0)
#define PG8_LDB(dst, b, h) do { _Pragma("unroll") for (int n = 0; n < 2; ++n) _Pragma("unroll") for (int k = 0; k < 2; ++k) dst[n][k] = *(const PG8_LAS bf16x8*)(lds + PG8_SB(b, h) + boff + n * 2048 + k * 1024); } while (0)
#define PG8_MMA(ai, bj, At, Bt) do { __builtin_amdgcn_s_setprio(1); _Pragma("unroll") for (int m = 0; m < 4; ++m) _Pragma("unroll") for (int n = 0; n < 2; ++n) _Pragma("unroll") for (int k = 0; k < 2; ++k) \
        acc[ai][bj][m][n] = __builtin_amdgcn_mfma_f32_16x16x32_bf16(Bt[n][k], At[m][k], acc[ai][bj][m][n], 0, 0, 0); __builtin_amdgcn_s_setprio(0); } while (0)
#ifndef HOST_EMU
#define PG8_WAIT_V(n) asm volatile("s_waitcnt vmcnt(" #n ")" ::: "memory")
#define PG8_WAIT_L(n) asm volatile("s_waitcnt lgkmcnt(" #n ")" ::: "memory")
#else
#define PG8_WAIT_V(n) do {} while (0)
#define PG8_WAIT_L(n) do {} while (0)
#endif
#define PG8_BAR __builtin_amdgcn_s_barrier()
#define PG8_SCHED __builtin_amdgcn_sched_barrier(0)
    Unit cur, nxt; int ui = 0;
    if (!S.next(0, cur)) return;
    f32x4 acc[2][2][4][2];
#pragma unroll
    for (int a = 0; a < 2; ++a)
#pragma unroll
        for (int b = 0; b < 2; ++b)
#pragma unroll
            for (int m = 0; m < 4; ++m)
#pragma unroll
                for (int n = 0; n < 2; ++n) acc[a][b][m][n] = (f32x4){0.f, 0.f, 0.f, 0.f};
    bf16x8 At[4][2], B0[2][2], B1[2][2];
    const char* cA = (const char*)g.A + (size_t)cur.pm * tstep; const char* cB = (const char*)g.Bt + (size_t)cur.pn * tstep;
    S.a_ready(cur);
    PG8_STAGE(PG8_SB(0, 0), cB, voffB); PG8_STAGE(PG8_SA(0, 0), cA, voffA); PG8_STAGE(PG8_SB(0, 1), cB + hstep, voffB); PG8_STAGE(PG8_SA(0, 1), cA + hstep, voffA);
    if (wr == 1) PG8_BAR;
    PG8_WAIT_V(4); PG8_BAR;
    PG8_STAGE(PG8_SB(1, 0), cB + kstep, voffB); PG8_STAGE(PG8_SA(1, 0), cA + kstep, voffA); PG8_STAGE(PG8_SB(1, 1), cB + hstep + kstep, voffB);
    PG8_WAIT_V(6); PG8_BAR;
    PG8_STAMP();
    for (;;) {
        const bool has_next = S.next(ui + 1, nxt);
        const char* nA = has_next ? (const char*)g.A + (size_t)nxt.pm * tstep : cA; const char* nB = has_next ? (const char*)g.Bt + (size_t)nxt.pn * tstep : cB;
        for (int t = 0; t < nt; t += 2) {
            const bool last = (t == nt - 2);
            const char* a1 = cA + (size_t)(t + 1) * kstep;
            const char* a2 = last ? nA : cA + (size_t)(t + 2) * kstep; const char* b2 = last ? nB : cB + (size_t)(t + 2) * kstep;
            const char* a3 = a2 + kstep; const char* b3 = b2 + kstep;
            if (last && has_next) S.a_ready(nxt);
            PG8_LDB(B0, 0, 0); PG8_SCHED; PG8_LDA(At, 0, 0); PG8_STAGE(PG8_SA(1, 1), a1 + hstep, voffA);
            PG8_WAIT_L(8); PG8_BAR; PG8_WAIT_L(0); PG8_MMA(0, 0, At, B0); PG8_BAR; PG8_SCHED;
            PG8_LDB(B1, 0, 1); PG8_STAGE(PG8_SB(0, 0), b2, voffB);
            PG8_BAR; PG8_WAIT_L(0); PG8_MMA(0, 1, At, B1); PG8_BAR;
            PG8_LDA(At, 0, 1); PG8_STAGE(PG8_SA(0, 0), a2, voffA);
            PG8_BAR; PG8_WAIT_L(0); PG8_MMA(1, 0, At, B0); PG8_BAR; PG8_SCHED;
            PG8_STAGE(PG8_SB(0, 1), b2 + hstep, voffB);
            PG8_WAIT_V(6); PG8_BAR; PG8_MMA(1, 1, At, B1); PG8_BAR;
            PG8_LDB(B0, 1, 0); PG8_SCHED; PG8_LDA(At, 1, 0); PG8_STAGE(PG8_SA(0, 1), a2 + hstep, voffA);
            PG8_WAIT_L(8); PG8_BAR; PG8_WAIT_L(0); PG8_MMA(0, 0, At, B0); PG8_BAR; PG8_SCHED;
            PG8_LDB(B1, 1, 1); PG8_STAGE(PG8_SB(1, 0), b3, voffB);
            PG8_BAR; PG8_WAIT_L(0); PG8_MMA(0, 1, At, B1); PG8_BAR;
            PG8_LDA(At, 1, 1); PG8_STAGE(PG8_SA(1, 0), a3, voffA);
            PG8_BAR; PG8_WAIT_L(0); PG8_MMA(1, 0, At, B0); PG8_BAR; PG8_SCHED;
            PG8_STAGE(PG8_SB(1, 1), b3 + hstep, voffB);
            PG8_WAIT_V(6); PG8_BAR; PG8_MMA(1, 1, At, B1); PG8_BAR;
        }
        PG8_STAMP();
        if constexpr (!Epi::AFTER_DRAIN) { E(acc, cur, wr, wc, fr, fq); S.done(cur); }
        PG8_STAMP();
        if (!has_next) break;
#pragma unroll
        for (int a = 0; a < 2; ++a)
#pragma unroll
            for (int b = 0; b < 2; ++b)
#pragma unroll
                for (int m = 0; m < 4; ++m)
#pragma unroll
                    for (int n = 0; n < 2; ++n) acc[a][b][m][n] = (f32x4){0.f, 0.f, 0.f, 0.f};
        cur = nxt; cA = nA; cB = nB; ++ui;
    }
    PG8_WAIT_V(0);
    if (wr == 0) PG8_BAR;
    PG8_BAR;
    if constexpr (Epi::AFTER_DRAIN) { E.fused(acc, cur, wr, wc, fr, fq, lds, wid, lane); S.done(cur); }
    PG8_STAMP();
    if (STAMP && wid == 0) { stamps[lane] = lane < nts ? (((unsigned long long)(unsigned)ts_hi << 32) | (unsigned)ts_lo) : 0ull;
        if (lane == 62) stamps[62] = rt_entry; if (lane == 63) stamps[63] = 0ull; }
#undef PG8_STAMP
#undef PG8_SA
#undef PG8_SB
#undef PG8_STAGE
#undef PG8_LDA
#undef PG8_LDB
#undef PG8_MMA
#undef PG8_WAIT_V
#undef PG8_WAIT_L
#undef PG8_BAR
#undef PG8_SCHED
}
}
template <class Epi> struct PgEpiT {
    static constexpr bool PERM = true, AFTER_DRAIN = false;
    Epi e;
    DEV void operator()(const f32x4 (&acc)[2][2][4][2], const pg8::Unit& u, int wr, int wc, int fr, int fq) const {
#pragma unroll
        for (int ai = 0; ai < 2; ++ai)
#pragma unroll
            for (int m = 0; m < 4; ++m) {
#pragma unroll
                for (int bj = 0; bj < 2; ++bj) {
                    const int wcol = u.pm * 256 + ai * 128 + wr * 64 + m * 16 + fr, tok0 = u.pn * 256 + bj * 128 + wc * 32 + 8 * fq;
                    const float v[8] = {acc[ai][bj][m][0][0], acc[ai][bj][m][0][1], acc[ai][bj][m][0][2], acc[ai][bj][m][0][3], acc[ai][bj][m][1][0], acc[ai][bj][m][1][1], acc[ai][bj][m][1][2], acc[ai][bj][m][1][3]};
                    e.tok8(tok0, wcol, v);
                }
                SCHED_FENCE();
            }
    }
};
template <class Epi> struct PgEpiN {
    static constexpr bool PERM = true, AFTER_DRAIN = false;
    Epi e;
    DEV void operator()(const f32x4 (&acc)[2][2][4][2], const pg8::Unit& u, int wr, int wc, int fr, int fq) const {
#pragma unroll
        for (int ai = 0; ai < 2; ++ai)
#pragma unroll
            for (int m = 0; m < 4; ++m) {
#pragma unroll
                for (int bj = 0; bj < 2; ++bj) {
                    const int tok = u.pm * 256 + ai * 128 + wr * 64 + m * 16 + fr, wcol0 = u.pn * 256 + bj * 128 + wc * 32 + 8 * fq;
                    const float v[8] = {acc[ai][bj][m][0][0], acc[ai][bj][m][0][1], acc[ai][bj][m][0][2], acc[ai][bj][m][0][3], acc[ai][bj][m][1][0], acc[ai][bj][m][1][1], acc[ai][bj][m][1][2], acc[ai][bj][m][1][3]};
                    e.col8(tok, wcol0, v);
                }
                SCHED_FENCE();
            }
    }
};
template <class Epi>
DEV void gemm_pg8_T(const bf16_t* A, const bf16_t* Wt, int Mtok, int N, unsigned char* smem, const Epi& epi) {
    pg8::Gemm g{Wt, A, N, Mtok, 1024};
    pg8::StaticOrder S; S.init(N, Mtok, (int)gridDim.x, (int)blockIdx.x);
    PgEpiT<Epi> E{epi};
    pg8::gemm_phase<PgEpiT<Epi>, pg8::StaticOrder, false>((PG8_LAS unsigned char*)smem, g, S, E);
    __syncthreads();
}
template <class Epi>
DEV void gemm_pg8_N(const bf16_t* A, const bf16_t* Wt, int Mtok, int N, unsigned char* smem, const Epi& epi) {
    pg8::Gemm g{A, Wt, Mtok, N, 1024};
    pg8::StaticOrder S; S.init(Mtok, N, (int)gridDim.x, (int)blockIdx.x);
    PgEpiN<Epi> E{epi};
    pg8::gemm_phase<PgEpiN<Epi>, pg8::StaticOrder, false>((PG8_LAS unsigned char*)smem, g, S, E);
    __syncthreads();
}
struct EpiL0In {
    unsigned char* ws;
    DEV void operator()(int row, int col, float v0, float v1, float v2, float v3) const {
        u32x2 o; o[0] = pk2(v0, v1); o[1] = pk2(v2, v3);
        const bool lat = row < TL; const int b = lat ? row / L : (row - TL) / LC, t = lat ? row - b * L : (row - TL) - b * LC, Lx = lat ? L : LC;
        const int cu = __builtin_amdgcn_readfirstlane(col & ~127);
        if (cu < 1536) { bf16_t* d = (bf16_t*)(ws + WS_P + (lat ? P_HYT_LAT : P_HYT_CTX)) + ((size_t)b * 1536 + col) * Lx + t; *(u32x2*)d = o; }
        else if (cu < 2048) { bf16_t* d = (bf16_t*)(ws + WS_P + P_Q0) + (size_t)row * 512 + (col - 1536); d[0] = (bf16_t)f2bf(v0); d[512] = (bf16_t)f2bf(v1); d[1024] = (bf16_t)f2bf(v2); d[1536] = (bf16_t)f2bf(v3); }
        else if (cu < 2176) { bf16_t* d = (bf16_t*)(ws + WS_P + P_K0) + (size_t)row * 128 + (col - 2048); d[0] = (bf16_t)f2bf(v0); d[128] = (bf16_t)f2bf(v1); d[256] = (bf16_t)f2bf(v2); d[384] = (bf16_t)f2bf(v3); }
        else { bf16_t* d = (bf16_t*)(ws + WS_P + (lat ? P_VT_LAT : P_VT_CTX)) + ((size_t)b * 128 + (col - 2176)) * Lx + t; *(u32x2*)d = o; }
    }
};
struct EpiL0InT {
    unsigned char* ws;
    DEV void tok8(int row, int col, const float (&v)[8]) const {
        const bool lat = row < TL; const int b = lat ? row / L : (row - TL) / LC, t = lat ? row - b * L : (row - TL) - b * LC, Lx = lat ? L : LC;
        u32x4 o; o[0] = pk2(v[0], v[1]); o[1] = pk2(v[2], v[3]); o[2] = pk2(v[4], v[5]); o[3] = pk2(v[6], v[7]);
        if (col < 1536) { *(u32x4*)((bf16_t*)(ws + WS_P + (lat ? P_HYT_LAT : P_HYT_CTX)) + ((size_t)b * 1536 + col) * Lx + t) = o; }
        else if (col < 2048) { bf16_t* d = (bf16_t*)(ws + WS_P + P_Q0) + (size_t)row * 512 + (col - 1536);
#pragma unroll
            for (int i = 0; i < 8; ++i) d[i * 512] = (bf16_t)f2bf(v[i]); }
        else if (col < 2176) { bf16_t* d = (bf16_t*)(ws + WS_P + P_K0) + (size_t)row * 128 + (col - 2048);
#pragma unroll
            for (int i = 0; i < 8; ++i) d[i * 128] = (bf16_t)f2bf(v[i]); }
        else { *(u32x4*)((bf16_t*)(ws + WS_P + (lat ? P_VT_LAT : P_VT_CTX)) + ((size_t)b * 128 + (col - 2176)) * Lx + t) = o; }
    }
};
struct EpiBf16 {
    bf16_t* out; int ld;
    DEV void col8(int row, int col0, const float (&v)[8]) const { u32x4 o; o[0] = pk2(v[0], v[1]); o[1] = pk2(v[2], v[3]); o[2] = pk2(v[4], v[5]); o[3] = pk2(v[6], v[7]); *(u32x4*)(out + (size_t)row * ld + col0) = o; }
    DEV void operator()(int row, int col, float v0, float v1, float v2, float v3) const {
        bf16_t* d = out + (size_t)row * ld + col; d[0] = (bf16_t)f2bf(v0); d[ld] = (bf16_t)f2bf(v1); d[2 * ld] = (bf16_t)f2bf(v2); d[3 * ld] = (bf16_t)f2bf(v3);
    }
};
struct EpiHg {
    unsigned char* ws; const float* lg;
    DEV void operator()(int row, int col, float v0, float v1, float v2, float v3) const {
        float vv[4] = {v0, v1, v2, v3};
        const bool lat = row < TL; const int b = lat ? row / L : (row - TL) / LC, t = lat ? row - b * L : (row - TL) - b * LC, Lx = lat ? L : LC;
        const int cu = __builtin_amdgcn_readfirstlane(col & ~255);
        if (cu >= 3072 && cu < 4096) {
            bf16_t* d = (bf16_t*)(ws + WS_M) + (lat ? (size_t)0 : (size_t)NB * 1024 * L) + ((size_t)b * 1024 + (col - 3072)) * Lx + t;
            u32x2 o; o[0] = pk2(v0, v1); o[1] = pk2(v2, v3); *(u32x2*)d = o;
            return;
        }
        if (cu < 1024 || cu >= 4096) {
#pragma unroll
            for (int i = 0; i < 4; ++i) vv[i] = silu_f(vv[i]);
        } else {
            const int c = col - 1024;
            const float oml = 1.f - 1.f / (1.f + __expf(lg[c] - lg[2048 + c]));
#pragma unroll
            for (int i = 0; i < 4; ++i) vv[i] = oml / (1.f + __expf(vv[i]));
        }
        if (cu < 3072) {
            bf16_t* d = (bf16_t*)(ws + WS_P + (lat ? P1_KQT_LAT : P1_KQT_CTX)) + ((size_t)b * 3072 + col) * Lx + t;
            u32x2 o; o[0] = pk2(vv[0], vv[1]); o[1] = pk2(vv[2], vv[3]); *(u32x2*)d = o;
        } else {
            if (!lat) return;
            bf16_t* d = (bf16_t*)(ws + WS_P + P1_G) + (size_t)row * 1024 + (col - 4096); d[0] = (bf16_t)f2bf(vv[0]); d[1024] = (bf16_t)f2bf(vv[1]); d[2048] = (bf16_t)f2bf(vv[2]); d[3072] = (bf16_t)f2bf(vv[3]);
        }
    }
};
struct EpiHgT {
    unsigned char* ws; const float* lg;
    DEV void tok8(int row, int col, const float (&v)[8]) const {
        const bool lat = row < TL; const int b = lat ? row / L : (row - TL) / LC, t = lat ? row - b * L : (row - TL) - b * LC, Lx = lat ? L : LC;
        const int cu = __builtin_amdgcn_readfirstlane(col & ~255);
        float vv[8];
#pragma unroll
        for (int i = 0; i < 8; ++i) vv[i] = v[i];
        if (cu >= 3072 && cu < 4096) {
            u32x4 o; o[0] = pk2(vv[0], vv[1]); o[1] = pk2(vv[2], vv[3]); o[2] = pk2(vv[4], vv[5]); o[3] = pk2(vv[6], vv[7]);
            *(u32x4*)((bf16_t*)(ws + WS_M) + (lat ? (size_t)0 : (size_t)NB * 1024 * L) + ((size_t)b * 1024 + (col - 3072)) * Lx + t) = o;
            return;
        }
        if (cu < 1024 || cu >= 4096) {
#pragma unroll
            for (int i = 0; i < 8; ++i) vv[i] = silu_f(vv[i]);
        } else {
            const int c = col - 1024;
            const float oml = 1.f - 1.f / (1.f + __expf(lg[c] - lg[2048 + c]));
#pragma unroll
            for (int i = 0; i < 8; ++i) vv[i] = oml / (1.f + __expf(vv[i]));
        }
        if (cu < 3072) {
            u32x4 o; o[0] = pk2(vv[0], vv[1]); o[1] = pk2(vv[2], vv[3]); o[2] = pk2(vv[4], vv[5]); o[3] = pk2(vv[6], vv[7]);
            *(u32x4*)((bf16_t*)(ws + WS_P + (lat ? P1_KQT_LAT : P1_KQT_CTX)) + ((size_t)b * 3072 + col) * Lx + t) = o;
        } else {
            if (!lat) return;
            bf16_t* d = (bf16_t*)(ws + WS_P + P1_G) + (size_t)row * 1024 + (col - 4096);
#pragma unroll
            for (int i = 0; i < 8; ++i) d[i * 1024] = (bf16_t)f2bf(vv[i]);
        }
    }
};
struct EpiRes {
    const Params* p; int from_inputs, layer, goff;
    DEV void col8(int row, int col0, const float (&v)[8]) const {
        float* H = (float*)(p->ws + WS_H) + (size_t)row * 1024 + col0; const float* hin = h_row(*p, from_inputs, row) + col0;
        const float* gt = (const float*)(p->ws + WS_MOD) + ((size_t)layer * NR + mod_row(row)) * 6144 + goff + col0;
        const f32x4 h0 = *(const f32x4*)hin, h1 = *(const f32x4*)(hin + 4), g0 = *(const f32x4*)gt, g1 = *(const f32x4*)(gt + 4);
        f32x4 o0, o1;
#pragma unroll
        for (int i = 0; i < 4; ++i) { o0[i] = h0[i] + g0[i] * v[i]; o1[i] = h1[i] + g1[i] * v[4 + i]; }
        *(f32x4*)H = o0; *(f32x4*)(H + 4) = o1;
    }
    DEV void operator()(int row, int col, float v0, float v1, float v2, float v3) const {
        float* H = (float*)(p->ws + WS_H) + (size_t)row * 1024 + col;
        const float* hin = h_row(*p, from_inputs, row) + col;
        const float gt = ((const float*)(p->ws + WS_MOD))[((size_t)layer * NR + mod_row(row)) * 6144 + goff + col];
        const float h0 = hin[0], h1 = hin[1024], h2 = hin[2048], h3 = hin[3072];
        H[0] = h0 + gt * v0; H[1024] = h1 + gt * v1; H[2048] = h2 + gt * v2; H[3072] = h3 + gt * v3;
    }
};

struct HyRaw { u32x4 mid; unsigned short lft, rgt; };
DEV HyRaw hy_load(const bf16_t* row, int t0, int Lx) { HyRaw r; r.mid = *(const u32x4*)(row + t0); r.lft = t0 > 0 ? row[t0 - 1] : (unsigned short)0; r.rgt = t0 + 8 < Lx ? row[t0 + 8] : (unsigned short)0; return r; }
DEV void hy_conv8(const HyRaw& r, float w0, float w1, float w2, float b, float (&o)[8]) {
    float x[10]; x[0] = bf2f(r.lft); x[9] = bf2f(r.rgt);
#pragma unroll
    for (int i = 0; i < 4; ++i) { x[1 + 2 * i] = bflo(r.mid[i]); x[2 + 2 * i] = bfhi(r.mid[i]); }
#pragma unroll
    for (int i = 0; i < 8; ++i) o[i] = w0 * x[i] + w1 * x[i + 1] + w2 * x[i + 2] + b;
}
template <int TPC>
DEV void hyena_item(const Params& p, int set, int item, unsigned char* smem) {
    const int Ls = set ? LC : L, S = set ? FS_CTX : FS_LAT, N = 1 << (2 * S);
    constexpr int CPI = NT / TPC, IPB = 512 / CPI;
    const int gi = tidx() / TPC, g = tidx() % TPC;
    const int bp = item / IPB, c = (item % IPB) * CPI + gi, ba = bp * 2, bb = ba + 1;
    cf2* buf = (cf2*)smem + (size_t)gi * N;
    const bf16_t* hy = (const bf16_t*)(p.ws + WS_P + (set ? P_HYT_CTX : P_HYT_LAT));
    const float* cw = p.in[I_HYCW]; const float* cb = p.in[I_HYCB];
    const cf2* HF = (const cf2*)(p.ws + WS_F + (set ? F_HF_CTX : F_HF_LAT));
    const float invN = 1.f / (float)N;
    const int t0 = g * 8; const bool own = t0 < Ls;
    HyRaw rv[2], rx1[2];
    if (own) {
        rv[0] = hy_load(hy + ((size_t)ba * 1536 + c) * Ls, t0, Ls); rv[1] = hy_load(hy + ((size_t)bb * 1536 + c) * Ls, t0, Ls);
        rx1[0] = hy_load(hy + ((size_t)ba * 1536 + 512 + c) * Ls, t0, Ls); rx1[1] = hy_load(hy + ((size_t)bb * 1536 + 512 + c) * Ls, t0, Ls);
    }
    cf2 hfr[16];
#pragma unroll
    for (int u = 0; u < 16; ++u) { hfr[u].x = 0.f; hfr[u].y = 0.f; if (g + TPC * u < N) hfr[u] = HF[(size_t)c * N + g + TPC * u]; }
    float za[8], zb[8];
    if (own) { hy_conv8(rv[0], cw[c], cw[1536 + c], cw[3072 + c], cb[c], za); hy_conv8(rv[1], cw[c], cw[1536 + c], cw[3072 + c], cb[c], zb); }
    for (int t = g; t < N; t += TPC) { if (t >= Ls) { cf2 z; z.x = 0.f; z.y = 0.f; buf[fsw(t)] = z; } }
    if (own) {
#pragma unroll
        for (int i = 0; i < 8; ++i) { cf2 v; v.x = za[i]; v.y = zb[i]; buf[fsw(t0 + i)] = v; }
    }
    __syncthreads();
#pragma unroll
    for (int n = 0; n < 2; ++n) {
        fft_fwd(buf, S, g, TPC);
#pragma unroll
        for (int u = 0; u < 16; ++u) { const int k = g + TPC * u; if (k < N) buf[fsw(k)] = cmul(buf[fsw(k)], hfr[u]); }
        if (n == 0) {
#pragma unroll
            for (int u = 0; u < 16; ++u) if (g + TPC * u < N) hfr[u] = HF[(size_t)(512 + c) * N + g + TPC * u];
        }
        __syncthreads();
        fft_inv(buf, S, g, TPC);
        const int gc = (n + 1) * 512 + c;
        if (own) {
            const float w0 = cw[gc], w1 = cw[1536 + gc], w2 = cw[3072 + gc], b = cb[gc], dsk = p.in[I_HYSKIP][n * 512 + c];
            float ga[8], gb[8];
            hy_conv8(rx1[0], w0, w1, w2, b, ga); hy_conv8(rx1[1], w0, w1, w2, b, gb);
            if (n == 0) { rx1[0] = hy_load(hy + ((size_t)ba * 1536 + 1024 + c) * Ls, t0, Ls); rx1[1] = hy_load(hy + ((size_t)bb * 1536 + 1024 + c) * Ls, t0, Ls); }
#pragma unroll
            for (int i = 0; i < 8; ++i) { const cf2 cv = buf[fsw(t0 + i)]; za[i] = ga[i] * (cv.x * invN + dsk * za[i]); zb[i] = gb[i] * (cv.y * invN + dsk * zb[i]); }
        }
        if (n == 0) {
            __syncthreads();
            for (int t = g; t < N; t += TPC) { if (t >= Ls) { cf2 z; z.x = 0.f; z.y = 0.f; buf[fsw(t)] = z; } }
            if (own) {
#pragma unroll
                for (int i = 0; i < 8; ++i) { cf2 v; v.x = za[i]; v.y = zb[i]; buf[fsw(t0 + i)] = v; }
            }
            __syncthreads();
        } else if (own) {
            bf16_t* M = (bf16_t*)(p.ws + WS_M);
            const size_t ta = set ? (size_t)TL + (size_t)ba * LC + t0 : (size_t)ba * L + t0, tb = set ? (size_t)TL + (size_t)bb * LC + t0 : (size_t)bb * L + t0;
#pragma unroll
            for (int i = 0; i < 8; ++i) { M[(ta + i) * 1024 + c] = (bf16_t)f2bf(za[i]); M[(tb + i) * 1024 + c] = (bf16_t)f2bf(zb[i]); }
        }
    }
    __syncthreads();
}
DEV void rope_store(const bf16_t* src, bf16_t* dst, int pos, bool rope, float scale, int ph, int sub) {
    const u32x4 ua = *(const u32x4*)(src + ph * 32 + sub * 8), ub = *(const u32x4*)(src + ph * 32 + 16 + sub * 8);
    float a[8], b[8];
#pragma unroll
    for (int i = 0; i < 4; ++i) { a[2 * i] = bflo(ua[i]); a[2 * i + 1] = bfhi(ua[i]); b[2 * i] = bflo(ub[i]); b[2 * i + 1] = bfhi(ub[i]); }
    if (rope) {
        const float pv = (float)(ph == 0 ? pos / 64 : pos % 64);
#pragma unroll
        for (int e = 0; e < 8; ++e) {
            const float inv = exp2f(-(float)(sub * 8 + e) * (13.287712379549449f / 16.f));
            const float ang = pv * inv, cs = __cosf(ang), sn = __sinf(ang);
            const float na = a[e] * cs - b[e] * sn, nb = b[e] * cs + a[e] * sn; a[e] = na; b[e] = nb;
        }
    }
    u32x4 oa, ob;
#pragma unroll
    for (int i = 0; i < 4; ++i) { oa[i] = pk2(a[2 * i] * scale, a[2 * i + 1] * scale); ob[i] = pk2(b[2 * i] * scale, b[2 * i + 1] * scale); }
    *(u32x4*)(dst + ph * 32 + sub * 8) = oa; *(u32x4*)(dst + ph * 32 + 16 + sub * 8) = ob;
}
constexpr int A_LDQ = 72, A_LDV = 136;
DEV void attn_item(const Params& p, int set, int item, unsigned char* smem) {
    bf16_t* Qs = (bf16_t*)smem;
    bf16_t* Ks = Qs + 128 * A_LDQ;
    bf16_t* Vt = Ks + 128 * A_LDQ;
    const int tid = tidx(), lane = tid & 63, w = tid >> 6, l15 = lane & 15, lg = lane >> 4;
    const int nqb = set ? LC / 128 : L / 128;
    const int h = item & 7, qb = (item >> 3) % nqb, b = (item >> 3) / nqb, kvh = h >> 2;
    const bf16_t* Q0 = (const bf16_t*)(p.ws + WS_P + P_Q0); const bf16_t* K0 = (const bf16_t*)(p.ws + WS_P + P_K0);
    const int qtok0 = set ? TL + b * LC + qb * 128 : b * L + qb * 128;
    { const int row = tid >> 2, ph = (tid >> 1) & 1, sub = tid & 1;
      rope_store(Q0 + (size_t)(qtok0 + row) * 512 + h * 64, Qs + row * A_LDQ, qb * 128 + row, set == 0, 0.125f, ph, sub); }
    __syncthreads();
    bf16x8 qf[2];
    qf[0] = *(const bf16x8*)(Qs + (w * 16 + l15) * A_LDQ + 8 * lg); qf[1] = *(const bf16x8*)(Qs + (w * 16 + l15) * A_LDQ + 32 + 8 * lg);
    float m_run = p.in[I_SINK][h], l_run = 1.f;
    f32x4 O[4];
#pragma unroll
    for (int i = 0; i < 4; ++i) O[i] = (f32x4){0.f, 0.f, 0.f, 0.f};
    const int nwin = set ? 0 : 3, nctx = LC / 128;
    for (int kbi = 0; kbi < nwin + nctx; ++kbi) {
        const bool win = kbi < nwin; const int kb = win ? qb - 1 + kbi : kbi - nwin;
        if (win && (kb < 0 || kb >= L / 128)) continue;
        const int ktok0 = win ? b * L + kb * 128 : TL + b * LC + kb * 128;
        __syncthreads();
        { const int row = tid >> 2, ph = (tid >> 1) & 1, sub = tid & 1;
          rope_store(K0 + (size_t)(ktok0 + row) * 128 + kvh * 64, Ks + row * A_LDQ, kb * 128 + row, win, 1.f, ph, sub); }
        { const bf16_t* vt = (const bf16_t*)(p.ws + WS_P + (win ? P_VT_LAT : P_VT_CTX)); const int Lx = win ? L : LC;
#pragma unroll
          for (int i = 0; i < 2; ++i) { const int id = tid + NT * i, d = id >> 4, kc = id & 15;
              *(u32x4*)(Vt + d * A_LDV + kc * 8) = *(const u32x4*)(vt + ((size_t)b * 128 + kvh * 64 + d) * Lx + kb * 128 + kc * 8); } }
        __syncthreads();
#pragma unroll
        for (int ch = 0; ch < 2; ++ch) {
            f32x4 st[4];
#pragma unroll
            for (int u = 0; u < 4; ++u) {
                const bf16_t* kr = Ks + ((ch * 4 + u) * 16 + l15) * A_LDQ + 8 * lg;
                f32x4 z = (f32x4){0.f, 0.f, 0.f, 0.f};
                z = __builtin_amdgcn_mfma_f32_16x16x32_bf16(*(const bf16x8*)kr, qf[0], z, 0, 0, 0);
                z = __builtin_amdgcn_mfma_f32_16x16x32_bf16(*(const bf16x8*)(kr + 32), qf[1], z, 0, 0, 0);
                st[u] = z;
            }
            float cmax = -INFINITY;
            if (win) {
                const int qpos = qb * 128 + w * 16 + l15;
#pragma unroll
                for (int u = 0; u < 4; ++u)
#pragma unroll
                    for (int r = 0; r < 4; ++r) { const int kpos = kb * 128 + (ch * 4 + u) * 16 + 4 * lg + r; const int dd = qpos - kpos; if (dd > 128 || dd < -128) st[u][r] = -INFINITY; }
            }
#pragma unroll
            for (int u = 0; u < 4; ++u)
#pragma unroll
                for (int r = 0; r < 4; ++r) cmax = fmaxf(cmax, st[u][r]);
            cmax = fmaxf(cmax, __shfl_xor(cmax, 16)); cmax = fmaxf(cmax, __shfl_xor(cmax, 32));
            const float m_new = fmaxf(m_run, cmax), alpha = __expf(m_run - m_new);
            float ls = 0.f;
#pragma unroll
            for (int u = 0; u < 4; ++u)
#pragma unroll
                for (int r = 0; r < 4; ++r) { const float e = __expf(st[u][r] - m_new); st[u][r] = e; ls += e; }
            ls += __shfl_xor(ls, 16); ls += __shfl_xor(ls, 32);
            l_run = l_run * alpha + ls; m_run = m_new;
#pragma unroll
            for (int i = 0; i < 4; ++i) { O[i][0] *= alpha; O[i][1] *= alpha; O[i][2] *= alpha; O[i][3] *= alpha; }
#pragma unroll
            for (int ss = 0; ss < 2; ++ss) {
                u32x4 pu; pu[0] = pk2(st[2 * ss][0], st[2 * ss][1]); pu[1] = pk2(st[2 * ss][2], st[2 * ss][3]); pu[2] = pk2(st[2 * ss + 1][0], st[2 * ss + 1][1]); pu[3] = pk2(st[2 * ss + 1][2], st[2 * ss + 1][3]);
                const bf16x8 pf = __builtin_bit_cast(bf16x8, pu);
                const int key0 = (ch * 4 + 2 * ss) * 16 + 4 * lg;
#pragma unroll
                for (int dt = 0; dt < 4; ++dt) {
                    const bf16_t* vr = Vt + (dt * 16 + l15) * A_LDV + key0;
                    u32x4 vu; const u32x2 v0 = *(const u32x2*)vr, v1 = *(const u32x2*)(vr + 16); vu[0] = v0[0]; vu[1] = v0[1]; vu[2] = v1[0]; vu[3] = v1[1];
                    O[dt] = __builtin_amdgcn_mfma_f32_16x16x32_bf16(__builtin_bit_cast(bf16x8, vu), pf, O[dt], 0, 0, 0);
                }
            }
        }
    }
    const float il = 1.f / l_run;
    bf16_t* M = (bf16_t*)(p.ws + WS_M) + (size_t)(qtok0 + w * 16 + l15) * 1024 + 512 + h * 64;
#pragma unroll
    for (int dt = 0; dt < 4; ++dt) { u32x2 o; o[0] = pk2(O[dt][0] * il, O[dt][1] * il); o[1] = pk2(O[dt][2] * il, O[dt][3] * il); *(u32x2*)(M + dt * 16 + 4 * lg) = o; }
    __syncthreads();
}
static_assert(NF_LAT / 256 <= 16 && NF_CTX / 64 <= 16 && L / 8 <= 256 && LC / 8 <= 64, "hyena item geometry");
constexpr int P3_HY_LAT = (NB / 2) * 256, P3_HY_CTX = (NB / 2) * 64, P3_AT_LAT = NB * (L / 128) * 8, P3_AT_CTX = NB * (LC / 128) * 8;
DEV void phase3(const Params& p, unsigned char* smem, int var = 0) {
    const int total = P3_HY_LAT + P3_AT_LAT + P3_HY_CTX + P3_AT_CTX;
    for (int it = blockIdx.x; it < total; it += gridDim.x) {
        int i = it;
        if (var == 1 && !(i < P3_HY_LAT || (i >= P3_HY_LAT + P3_AT_LAT && i < P3_HY_LAT + P3_AT_LAT + P3_HY_CTX))) continue;
        if (var == 2 && (i < P3_HY_LAT || (i >= P3_HY_LAT + P3_AT_LAT && i < P3_HY_LAT + P3_AT_LAT + P3_HY_CTX))) continue;
        if (i < P3_HY_LAT) { hyena_item<256>(p, 0, i, smem); continue; } i -= P3_HY_LAT;
        if (i < P3_AT_LAT) { attn_item(p, 0, i, smem); continue; } i -= P3_AT_LAT;
        if (i < P3_HY_CTX) { hyena_item<64>(p, 1, i, smem); continue; } i -= P3_HY_CTX;
        attn_item(p, 1, i, smem);
    }
}

constexpr int K_LDK = 136, K_LDS = 129, K_LDC = 52;
DEV unsigned fkey(float f) { const unsigned u = __builtin_bit_cast(unsigned, f); return (u & 0x80000000u) ? ~u : (u | 0x80000000u); }
constexpr int cand_off(int i) { int o = 0; for (int k = 0; k < i; ++k) o += 16 / (k + 1); return o; }
DEV void topk_load_keys(const Params& p, int layer, int h, unsigned char* smem) {
    bf16_t* Ks = (bf16_t*)smem;
    const bf16_t* keys = (const bf16_t*)(p.ws + WS_W + W_KEYS) + (size_t)layer * 262144 + (size_t)h * 32768;
    const int tid = tidx();
#pragma unroll
    for (int i = 0; i < 8; ++i) { const int id = tid + NT * i, row = id >> 4, kc = id & 15; *(u32x4*)(Ks + row * K_LDK + kc * 8) = *(const u32x4*)(keys + (size_t)row * 128 + kc * 8); }
    __syncthreads();
}
#ifndef HOST_EMU
template <int CTRL> DEV unsigned dpp_u32(unsigned v) { return (unsigned)__builtin_amdgcn_update_dpp(0, (int)v, CTRL, 0xF, 0xF, true); }
#else
template <int CTRL> DEV unsigned dpp_u32(unsigned v) { const int lane = tidx() & 63; const int src = CTRL == 0xB1 ? (lane ^ 1) : CTRL == 0x4E ? (lane ^ 2) : ((lane & ~7) | (7 - (lane & 7))); return emu_shfl(v, src); }
#endif
DEV unsigned max8_u32(unsigned v) { unsigned t = dpp_u32<0xB1>(v); v = v > t ? v : t; t = dpp_u32<0x4E>(v); v = v > t ? v : t; t = dpp_u32<0x141>(v); return v > t ? v : t; }
DEV float sum8_f32(float v) { v += __builtin_bit_cast(float, dpp_u32<0xB1>(__builtin_bit_cast(unsigned, v))); v += __builtin_bit_cast(float, dpp_u32<0x4E>(__builtin_bit_cast(unsigned, v))); v += __builtin_bit_cast(float, dpp_u32<0x141>(__builtin_bit_cast(unsigned, v))); return v; }
DEV float unkey(unsigned k) { const unsigned u = (k & 0x80000000u) ? (k & 0x7fffffffu) : ~k; return __builtin_bit_cast(float, u); }
template <int N> DEV void bitonic_desc(unsigned (&a)[N]) {
#pragma unroll
    for (int k = 2; k <= N; k <<= 1)
#pragma unroll
        for (int j = k >> 1; j > 0; j >>= 1)
#pragma unroll
            for (int i = 0; i < N; ++i) { const int l = i ^ j; if (l > i) { const unsigned x = a[i], y = a[l]; const unsigned hi = x > y ? x : y, lo = x > y ? y : x; if ((i & k) == 0) { a[i] = hi; a[l] = lo; } else { a[i] = lo; a[l] = hi; } } }
}
DEV void merge16(const unsigned* lst, int nlist, unsigned first, int sub, unsigned& r0, unsigned& r1) {
    unsigned cur = first; int head = 0; r0 = 0u; r1 = 0u;
#pragma unroll
    for (int it = 0; it < 16; ++it) {
        const unsigned m = max8_u32(cur);
        if (sub == (it & 7)) { if (it < 8) r0 = m; else r1 = m; }
        if (cur == m) { ++head; cur = head < nlist ? lst[head] : 0u; }
    }
}
DEV void topk_item(const Params& p, int h, int tok0, unsigned char* smem, const bf16x8 (&afr)[16]) {
    bf16_t* Ks = (bf16_t*)smem;
    float* Sc = (float*)(Ks + 2 * 128 * K_LDK);
    unsigned* s12 = (unsigned*)Sc + 64 * 8 * 17;
    unsigned* cl = s12 + 64 * 32;
    const int tid = tidx(), lane = tid & 63, w = tid >> 6;
    const int row = tid >> 3, sub = tid & 7;
#pragma unroll
    for (int part = 0; part < 2; ++part) {
        { const int mi = w >> 2, ni = w & 3;
          f32x16 acc;
#pragma unroll
          for (int r = 0; r < 16; ++r) acc[r] = 0.f;
          const bf16_t* bs = Ks + (part * 128 + ni * 32 + (lane & 31)) * K_LDK + 8 * (lane >> 5);
#pragma unroll
          for (int kk = 0; kk < 8; ++kk) acc = __builtin_amdgcn_mfma_f32_32x32x16_bf16(part ? afr[8 + kk] : afr[kk], *(const bf16x8*)(bs + kk * 16), acc, 0, 0, 0);
#pragma unroll
          for (int r = 0; r < 16; ++r) Sc[(mi * 32 + (r & 3) + 8 * (r >> 2) + 4 * (lane >> 5)) * K_LDS + ni * 32 + (lane & 31)] = acc[r]; }
        __syncthreads();
        unsigned mk[16];
#pragma unroll
        for (int i = 0; i < 16; ++i) mk[i] = (fkey(Sc[row * K_LDS + sub * 16 + i]) & ~127u) | (unsigned)(127 - (sub * 16 + i));
        bitonic_desc<16>(mk);
        __syncthreads();
        unsigned* lst = (unsigned*)Sc + (row * 8 + sub) * 17;
#pragma unroll
        for (int i = 0; i < 16; ++i) lst[i] = mk[i];
        unsigned r0, r1;
        merge16(lst, 16, mk[0], sub, r0, r1);
        s12[(row * 2 + part) * 16 + sub] = r0; s12[(row * 2 + part) * 16 + 8 + sub] = r1;
        __syncthreads();
    }
    {
        const unsigned* k1 = s12 + row * 32; const unsigned* k2 = k1 + 16;
        unsigned ck[8];
#pragma unroll
        for (int m = 0; m < 8; ++m) {
            const int cc = sub + 8 * m; int ci = 0, off = 0;
#pragma unroll
            for (int i = 0; i < 15; ++i) { const bool ge = cc >= cand_off(i + 1); ci += ge ? 1 : 0; off += ge ? 16 / (i + 1) : 0; }
            const int cj = cc - off;
            ck[m] = 0u;
            if (cc < 50) ck[m] = (fkey(unkey((k1[ci] & ~127u) | 64u) + unkey((k2[cj] & ~127u) | 64u)) & ~63u) | (unsigned)(63 - cc);
        }
        bitonic_desc<8>(ck);
        unsigned* lst = cl + (row * 8 + sub) * 9;
#pragma unroll
        for (int m = 0; m < 8; ++m) lst[m] = ck[m];
        unsigned r0, r1;
        merge16(lst, 8, ck[0], sub, r0, r1);
        const float a = unkey((r0 & ~63u) | 32u), b = unkey((r1 & ~63u) | 32u);
        const unsigned kmax = max8_u32(r0 > r1 ? r0 : r1); const float vmax = unkey((kmax & ~63u) | 32u);
        const float ea = __expf(a - vmax), eb = __expf(b - vmax);
        const float inv = 1.f / sum8_f32(ea + eb);
        int eidx[2];
#pragma unroll
        for (int q = 0; q < 2; ++q) {
            const int cc = 63 - (int)((q ? r1 : r0) & 63u); int ci = 0, off = 0;
#pragma unroll
            for (int i = 0; i < 15; ++i) { const bool ge = cc >= cand_off(i + 1); ci += ge ? 1 : 0; off += ge ? 16 / (i + 1) : 0; }
            const int cj = cc - off;
            eidx[q] = (127 - (int)(k1[ci] & 127u)) * 128 + (127 - (int)(k2[cj] & 127u));
        }
        int* IDX = (int*)(p.ws + WS_IDX) + (size_t)(tok0 + row) * 128 + h * 16; float* GT = (float*)(p.ws + WS_GATE) + (size_t)(tok0 + row) * 128 + h * 16;
        IDX[sub] = eidx[0]; IDX[8 + sub] = eidx[1]; GT[sub] = ea * inv; GT[8 + sub] = eb * inv;
    }
    __syncthreads();
}
#define TOPK_LOAD(AF, tok0_, h_) do { const int lane_ = tidx() & 63, w_ = tidx() >> 6; \
        const bf16_t* ag_ = (const bf16_t*)(p.ws + WS_P) + (size_t)((tok0_) + (w_ >> 2) * 32 + (lane_ & 31)) * 2048 + (h_) * 256 + 8 * (lane_ >> 5); \
        _Pragma("unroll") for (int q_ = 0; q_ < 16; ++q_) AF[q_] = *(const bf16x8*)(ag_ + (q_ >> 3) * 128 + (q_ & 7) * 16); } while (0)
DEV void topk_phase(const Params& p, int layer, int ntok, unsigned char* smem) {
    const int G = gridDim.x, bid = blockIdx.x, h = bid & 7;
    const int nt = ntok / 64;
    bf16x8 afA[16], afB[16];
    if ((G & 7) == 0) {
        const int st = G >> 3; int tt = bid >> 3;
        if (tt < nt) { TOPK_LOAD(afA, tt * 64, h); topk_load_keys(p, layer, h, smem); }
        while (tt < nt) {
            if (tt + st < nt) TOPK_LOAD(afB, (tt + st) * 64, h);
            topk_item(p, h, tt * 64, smem, afA);
            tt += st; if (tt >= nt) break;
            if (tt + st < nt) TOPK_LOAD(afA, (tt + st) * 64, h);
            topk_item(p, h, tt * 64, smem, afB);
            tt += st;
        }
    } else {
        for (int it = bid; it < nt * 8; it += G) { __syncthreads(); TOPK_LOAD(afA, (it >> 3) * 64, it & 7); topk_load_keys(p, layer, it & 7, smem); topk_item(p, it & 7, (it >> 3) * 64, smem, afA); }
    }
}
#undef TOPK_LOAD

DEV float gelu_f(float x) { return 0.5f * x * (1.f + erff(x * 0.70710678118654752f)); }
DEV void peer_item(const Params& p, int layer, int item, int var = 0) {
    (void)var;
    const int tok = item * 8 + (tidx() >> 6), lane = tidx() & 63, li = lane & 31, half = lane >> 5;
    const bf16_t* A = (const bf16_t*)(p.ws + WS_A) + (size_t)tok * 1024 + li * 32;
    const unsigned char* U6 = p.ws + WS_U6 + (size_t)layer * 16384 * 768; const unsigned char* V4 = p.ws + WS_V4 + (size_t)layer * 16384 * 512;
    const float* SU = (const float*)(p.ws + WS_S8) + (size_t)(layer * 2) * 16384; const float* SV = SU + 16384;
    float x[32], y[32];
#pragma unroll
    for (int q = 0; q < 4; ++q) { const u32x4 a = *(const u32x4*)(A + 8 * q);
#pragma unroll
        for (int i = 0; i < 4; ++i) { x[8 * q + 2 * i] = bflo(a[i]); x[8 * q + 2 * i + 1] = bfhi(a[i]); } }
#pragma unroll
    for (int i = 0; i < 32; ++i) y[i] = 0.f;
    const int* IDX = (const int*)(p.ws + WS_IDX) + (size_t)tok * 128; const float* GT = (const float*)(p.ws + WS_GATE) + (size_t)tok * 128;
    const int i_lo = IDX[lane], i_hi = IDX[64 + lane]; const float g_lo = GT[lane], g_hi = GT[64 + lane];
    const int sl = ((li >> 4) & 1) * 2 + ((li >> 3) & 1);
    u32x4 ulo[4], vq[4]; u32x2 uhi[4];
#define PG_LOADU(g) do { _Pragma("unroll") for (int s_ = 0; s_ < 4; ++s_) { const int e_ = __shfl((g) < 8 ? i_lo : i_hi, (((g) & 7) << 3) + 2 * s_ + half); \
        const unsigned char* r_ = U6 + (size_t)e_ * 768; ulo[s_] = *(const u32x4*)(r_ + li * 16); uhi[s_] = *(const u32x2*)(r_ + 512 + li * 8); } } while (0)
#define PG_LOADV(g) do { _Pragma("unroll") for (int s_ = 0; s_ < 4; ++s_) { const int e_ = __shfl((g) < 8 ? i_lo : i_hi, (((g) & 7) << 3) + 2 * s_ + half); \
        vq[s_] = *(const u32x4*)(V4 + (size_t)e_ * 512 + li * 16); } } while (0)
    PG_LOADU(0); PG_LOADV(0);
    for (int g = 0; g < 16; ++g) {
        const int mk = ((g & 7) << 3) + 2 * sl + half; const int me = __shfl(g < 8 ? i_lo : i_hi, mk); const float mg = __shfl(g < 8 ? g_lo : g_hi, mk);
        const float su = SU[me], sv = SV[me];
        float d[4];
#pragma unroll
        for (int s4 = 0; s4 < 4; ++s4) {
            u32x6 w; w[0] = ulo[s4][0]; w[1] = ulo[s4][1]; w[2] = ulo[s4][2]; w[3] = ulo[s4][3]; w[4] = uhi[s4][0]; w[5] = uhi[s4][1];
            const f32x32 f = __builtin_amdgcn_cvt_scalef32_pk32_f32_fp6(w, 1.0f);
            float a = 0.f;
#pragma unroll
            for (int i = 0; i < 32; ++i) a = fmaf(f[i], x[i], a);
            d[s4] = a; SCHED_FENCE(); }
        if (g + 1 < 16) PG_LOADU(g + 1);
        float r2[2], r1;
        { const bool hi = (li & 16) != 0;
#pragma unroll
          for (int j = 0; j < 2; ++j) { const float send = hi ? d[j] : d[2 + j], keep = hi ? d[2 + j] : d[j]; r2[j] = keep + __shfl_xor(send, 16); } }
        { const bool hi = (li & 8) != 0; const float send = hi ? r2[0] : r2[1], keep = hi ? r2[1] : r2[0]; r1 = keep + __shfl_xor(send, 8); }
        r1 += __shfl_xor(r1, 4); r1 += __shfl_xor(r1, 2); r1 += __shfl_xor(r1, 1);
        const float act = gelu_f(r1 * su) * mg * sv;
#pragma unroll
        for (int s4 = 0; s4 < 4; ++s4) {
            const float aj = __shfl(act, (lane & 32) + 16 * (s4 >> 1) + 8 * (s4 & 1));
#pragma unroll
            for (int dw = 0; dw < 4; ++dw) {
                const f32x2 f0 = __builtin_amdgcn_cvt_scalef32_pk_f32_fp4(vq[s4][dw], 1.0f, 0), f1 = __builtin_amdgcn_cvt_scalef32_pk_f32_fp4(vq[s4][dw], 1.0f, 1),
                            f2 = __builtin_amdgcn_cvt_scalef32_pk_f32_fp4(vq[s4][dw], 1.0f, 2), f3 = __builtin_amdgcn_cvt_scalef32_pk_f32_fp4(vq[s4][dw], 1.0f, 3);
                const int e0 = dw * 8;
                y[e0] = fmaf(aj, f0[0], y[e0]); y[e0 + 1] = fmaf(aj, f0[1], y[e0 + 1]); y[e0 + 2] = fmaf(aj, f1[0], y[e0 + 2]); y[e0 + 3] = fmaf(aj, f1[1], y[e0 + 3]);
                y[e0 + 4] = fmaf(aj, f2[0], y[e0 + 4]); y[e0 + 5] = fmaf(aj, f2[1], y[e0 + 5]); y[e0 + 6] = fmaf(aj, f3[0], y[e0 + 6]); y[e0 + 7] = fmaf(aj, f3[1], y[e0 + 7]);
            }
            SCHED_FENCE(); }
        if (g + 1 < 16) PG_LOADV(g + 1);
    }
#undef PG_LOADU
#undef PG_LOADV
    float yy[16];
#pragma unroll
    for (int i = 0; i < 16; ++i) { const float send = half ? y[i] : y[16 + i], keep = half ? y[16 + i] : y[i]; yy[i] = keep + __shfl_xor(send, 32); }
    const int c0 = li * 32 + half * 16;
    float* H = (float*)(p.ws + WS_H) + (size_t)tok * 1024 + c0;
    const float* g2 = (const float*)(p.ws + WS_MOD) + ((size_t)layer * NR + mod_row(tok)) * 6144 + 5120 + c0;
    float hv[16]; float ss = 0.f;
#pragma unroll
    for (int i = 0; i < 4; ++i) { const f32x4 hh = *(const f32x4*)(H + 4 * i), gg = *(const f32x4*)(g2 + 4 * i);
#pragma unroll
        for (int j = 0; j < 4; ++j) { const float v = hh[j] + gg[j] * yy[4 * i + j]; hv[4 * i + j] = v; ss += v * v; } }
    ss = wave_sum(ss);
    const float rstd = rsqrtf(ss * (1.f / 1024.f) + 1e-6f);
    if (layer == 0) {
#pragma unroll
        for (int i = 0; i < 4; ++i) { f32x4 o; o[0] = hv[4 * i]; o[1] = hv[4 * i + 1]; o[2] = hv[4 * i + 2]; o[3] = hv[4 * i + 3]; *(f32x4*)(H + 4 * i) = o; }
        const float* g = p.in[I_N1G] + 1024 + c0;
        const float* mod = (const float*)(p.ws + WS_MOD) + ((size_t)1 * NR + mod_row(tok)) * 6144 + c0;
        bf16_t* Ao = (bf16_t*)(p.ws + WS_A) + (size_t)tok * 1024 + c0;
        u32x4 o0, o1; float r[16];
#pragma unroll
        for (int i = 0; i < 16; ++i) r[i] = hv[i] * rstd * g[i] * (1.f + mod[1024 + i]) + mod[i];
#pragma unroll
        for (int i = 0; i < 4; ++i) { o0[i] = pk2(r[2 * i], r[2 * i + 1]); o1[i] = pk2(r[8 + 2 * i], r[8 + 2 * i + 1]); }
        *(u32x4*)Ao = o0; *(u32x4*)(Ao + 8) = o1;
    } else {
        const float* g = p.in[I_FG] + c0; float* out = p.out + (size_t)tok * 1024 + c0;
#pragma unroll
        for (int i = 0; i < 4; ++i) { f32x4 o; o[0] = hv[4 * i] * rstd * g[4 * i]; o[1] = hv[4 * i + 1] * rstd * g[4 * i + 1]; o[2] = hv[4 * i + 2] * rstd * g[4 * i + 2]; o[3] = hv[4 * i + 3] * rstd * g[4 * i + 3]; *(f32x4*)(out + 4 * i) = o; }
    }
}

constexpr int S3_LD = 136, S3_LDT = 24, S3_LDV = 72;
constexpr int S3_Q = 0, S3_K = S3_Q + 64 * S3_LD * 2, S3_KT = S3_K + 64 * S3_LD * 2, S3_D = S3_KT + 4 * 128 * S3_LDT * 2, S3_V = S3_D + 4 * 128 * 4, S3_ST = S3_V + 64 * S3_LDV * 2,
              S3_P = S3_ST + 2 * 64 * S3_LD * 2, S3_END = S3_P + 4 * 16 * S3_LDT * 2;
static_assert(S3_END <= SMEM_BYTES, "scan LDS");
DEV void scan_block(const Params& p, int bi, unsigned char* smem, int var = 0) {
    const int tid = tidx(), lane = tid & 63, w = tid >> 6, l15 = lane & 15, lg4 = lane >> 4, l31 = lane & 31, lh = lane >> 5;
    const int half = bi & 1, dir = (bi >> 1) & 1, h = (bi >> 2) & 7, b = bi >> 5;
    const bf16_t* P1 = (const bf16_t*)(p.ws + WS_P);
    const bf16_t* IT = (const bf16_t*)(p.ws + WS_M);
    bf16_t* Oo = (bf16_t*)(p.ws + WS_F + (dir ? F_OB : F_OF));
    bf16_t* Qs = (bf16_t*)(smem + S3_Q); bf16_t* Ks = (bf16_t*)(smem + S3_K); bf16_t* KT = (bf16_t*)(smem + S3_KT); float* Ds = (float*)(smem + S3_D);
    bf16_t* Vs = (bf16_t*)(smem + S3_V); bf16_t* ST = (bf16_t*)(smem + S3_ST); bf16_t* Ps = (bf16_t*)(smem + S3_P);
    const int NCH = (LC + L) / 64;
    const int kt = w >> 1, vt = w & 1;
    f32x16 S;
#pragma unroll
    for (int r = 0; r < 16; ++r) S[r] = 0.f;
    for (int i = tid; i < 64 * S3_LD / 2; i += NT) ((unsigned*)ST)[i] = 0u;
    const int pk = tid & 127, pblk = tid >> 7;
    u32x4 ka[2], qa[2], va, kb2[2], qb2[2], vb2;
    const int kcol = 1024 * (1 + dir) + h * 128 + pk, qcol = h * 128 + pk;
#define S3_T0(c) ((c) * 64 < LC ? (dir ? LC - 64 - (c) * 64 : (c) * 64) : (dir ? L - 64 - ((c) * 64 - LC) : (c) * 64 - LC))
#define S3_LOAD(c, KR, QR, VR) do { const bool lat_ = (c) * 64 >= LC; const int t0_ = S3_T0(c); const int Lx_ = lat_ ? L : LC; \
        const bf16_t* kq_ = (const bf16_t*)(p.ws + WS_P + (lat_ ? P1_KQT_LAT : P1_KQT_CTX)) + (size_t)b * 3072 * Lx_ + t0_ + pblk * 16; \
        KR[0] = *(const u32x4*)(kq_ + (size_t)kcol * Lx_); KR[1] = *(const u32x4*)(kq_ + (size_t)kcol * Lx_ + 8); \
        if (lat_) { QR[0] = *(const u32x4*)(kq_ + (size_t)qcol * Lx_); QR[1] = *(const u32x4*)(kq_ + (size_t)qcol * Lx_ + 8); } else { QR[0] = (u32x4){0u, 0u, 0u, 0u}; QR[1] = QR[0]; } \
        { const int v_ = tid >> 3, c8_ = tid & 7; const bf16_t* it_ = IT + (lat_ ? (size_t)0 : (size_t)NB * 1024 * L) + ((size_t)b * 1024 + h * 128 + half * 64 + v_) * Lx_ + t0_ + c8_ * 8; VR = *(const u32x4*)it_; } } while (0)
#define S3_PREP(KR, QR, VR) do { \
            float bsum = 0.f; unsigned short kt16[16]; \
            _Pragma("unroll") for (int rr = 0; rr < 16; ++rr) { \
                const int tl = dir ? 15 - rr : rr; \
                const unsigned ku_ = dir ? KR[(15 - rr) >> 3][((15 - rr) & 7) >> 1] : KR[rr >> 3][(rr & 7) >> 1]; const unsigned qu_ = dir ? QR[(15 - rr) >> 3][((15 - rr) & 7) >> 1] : QR[rr >> 3][(rr & 7) >> 1]; \
                const bool odd_ = dir ? (((15 - rr) & 1) != 0) : ((rr & 1) != 0); \
                const float kv = odd_ ? bfhi(ku_) : bflo(ku_), qv = odd_ ? bfhi(qu_) : bflo(qu_); \
                bsum += __logf(1.f - kv); \
                const float eb = __expf(bsum), ieb = __expf(fminf(-bsum, 80.f)); \
                const unsigned short qt = (unsigned short)f2bf(qv * eb), ktv = (unsigned short)f2bf(kv * ieb); \
                Qs[(pblk * 16 + tl) * S3_LD + pk] = qt; Ks[(pblk * 16 + tl) * S3_LD + pk] = ktv; \
                if (dir) kt16[15 - rr] = ktv; else kt16[rr] = ktv; \
            } \
            u32x4 o0, o1; \
            _Pragma("unroll") for (int i = 0; i < 4; ++i) { o0[i] = (unsigned)kt16[2 * i] | ((unsigned)kt16[2 * i + 1] << 16); o1[i] = (unsigned)kt16[8 + 2 * i] | ((unsigned)kt16[8 + 2 * i + 1] << 16); } \
            *(u32x4*)(KT + (pblk * 128 + pk) * S3_LDT) = o0; *(u32x4*)(KT + (pblk * 128 + pk) * S3_LDT + 8) = o1; \
            Ds[pblk * 128 + pk] = __expf(bsum); \
            { const int v_ = tid >> 3, c8_ = tid & 7; *(u32x4*)(Vs + v_ * S3_LDV + c8_ * 8) = VR; } } while (0)
    S3_LOAD(0, ka, qa, va);
    for (int c = 0; c < NCH; ++c) {
        const bool lat = c * 64 >= LC; const int t0 = S3_T0(c); const size_t tokb = lat ? (size_t)b * L + t0 : (size_t)TL + (size_t)b * LC + t0;
        if ((c & 1) == 0) { if (c + 1 < NCH) S3_LOAD(c + 1, kb2, qb2, vb2); } else { if (c + 1 < NCH) S3_LOAD(c + 1, ka, qa, va); }
        lds_barrier();
        if (var != 1) { if ((c & 1) == 0) S3_PREP(ka, qa, va); else S3_PREP(kb2, qb2, vb2); }
        lds_barrier();

        if (lat && w < 4) {
            f32x4 pt = (f32x4){0.f, 0.f, 0.f, 0.f};
#pragma unroll
            for (int kk = 0; kk < 4; ++kk)
                pt = __builtin_amdgcn_mfma_f32_16x16x32_bf16(*(const bf16x8*)(Ks + (w * 16 + l15) * S3_LD + kk * 32 + 8 * lg4), *(const bf16x8*)(Qs + (w * 16 + l15) * S3_LD + kk * 32 + 8 * lg4), pt, 0, 0, 0);
            float pm[4];
#pragma unroll
            for (int r = 0; r < 4; ++r) { const int sl = 4 * lg4 + r; const bool keep = dir ? (sl >= l15) : (sl <= l15); pm[r] = keep ? pt[r] : 0.f; }
            u32x2 o; o[0] = pk2(pm[0], pm[1]); o[1] = pk2(pm[2], pm[3]);
            *(u32x2*)(Ps + (w * 16 + l15) * S3_LDT + 4 * lg4) = o;
        }
        lds_barrier();
        for (int ib = 0; ib < (var == 2 ? 0 : 4); ++ib) {
            const int blk = dir ? 3 - ib : ib;
            const int cur = (c * 4 + ib) & 1;
            { const bf16x8 a = *(const bf16x8*)(KT + (blk * 128 + 32 * kt + l31) * S3_LDT + 8 * lh);
              const bf16x8 bb = *(const bf16x8*)(Vs + (32 * vt + l31) * S3_LDV + blk * 16 + 8 * lh);
              S = __builtin_amdgcn_mfma_f32_32x32x16_bf16(a, bb, S, 0, 0, 0);
#pragma unroll
              for (int g = 0; g < 4; ++g) { const f32x4 dv = *(const f32x4*)(Ds + blk * 128 + 32 * kt + 8 * g + 4 * lh);
                  S[4 * g] *= dv[0]; S[4 * g + 1] *= dv[1]; S[4 * g + 2] *= dv[2]; S[4 * g + 3] *= dv[3];
                  u32x2 o; o[0] = pk2(S[4 * g], S[4 * g + 1]); o[1] = pk2(S[4 * g + 2], S[4 * g + 3]);
                  *(u32x2*)(ST + ((cur ^ 1) * 64 + 32 * vt + l31) * S3_LD + 32 * kt + 8 * g + 4 * lh) = o; } }
            if (lat && w < 4) {
                f32x4 o = (f32x4){0.f, 0.f, 0.f, 0.f};
#pragma unroll
                for (int kk = 0; kk < 4; ++kk)
                    o = __builtin_amdgcn_mfma_f32_16x16x32_bf16(*(const bf16x8*)(ST + (cur * 64 + 16 * w + l15) * S3_LD + kk * 32 + 8 * lg4), *(const bf16x8*)(Qs + (blk * 16 + l15) * S3_LD + kk * 32 + 8 * lg4), o, 0, 0, 0);
                bf16x8 va = (bf16x8){0, 0, 0, 0, 0, 0, 0, 0}, pb = va;
                if (lg4 < 2) { va = *(const bf16x8*)(Vs + (16 * w + l15) * S3_LDV + blk * 16 + 8 * lg4); pb = *(const bf16x8*)(Ps + (blk * 16 + l15) * S3_LDT + 8 * lg4); }
                o = __builtin_amdgcn_mfma_f32_16x16x32_bf16(va, pb, o, 0, 0, 0);
                u32x2 ou; ou[0] = pk2(o[0], o[1]); ou[1] = pk2(o[2], o[3]);
                *(u32x2*)(Oo + (tokb + blk * 16 + l15) * 1024 + h * 128 + half * 64 + 16 * w + 4 * lg4) = ou;
            }
            lds_barrier();
        }
    }
    lds_barrier();
#undef S3_T0
#undef S3_LOAD
#undef S3_PREP
}
DEV void readout_item(const Params& p, int item) {
    const int tok = item * 8 + (tidx() >> 6), lane = tidx() & 63;
    const bf16_t* of = (const bf16_t*)(p.ws + WS_F + F_OF) + (size_t)tok * 1024 + lane * 16; const bf16_t* ob = (const bf16_t*)(p.ws + WS_F + F_OB) + (size_t)tok * 1024 + lane * 16;
    const bf16_t* gp = (const bf16_t*)(p.ws + WS_P + P1_G) + (size_t)tok * 1024 + lane * 16;
    const float* on = p.in[I_HGON] + (lane & 7) * 16;
    float o[16], gg[16]; float ss = 0.f;
    { const u32x4 a0 = *(const u32x4*)of, a1 = *(const u32x4*)(of + 8), b0 = *(const u32x4*)ob, b1 = *(const u32x4*)(ob + 8), g0 = *(const u32x4*)gp, g1 = *(const u32x4*)(gp + 8);
#pragma unroll
      for (int i = 0; i < 4; ++i) { o[2 * i] = bflo(a0[i]) + bflo(b0[i]); o[2 * i + 1] = bfhi(a0[i]) + bfhi(b0[i]); o[8 + 2 * i] = bflo(a1[i]) + bflo(b1[i]); o[8 + 2 * i + 1] = bfhi(a1[i]) + bfhi(b1[i]);
          gg[2 * i] = bflo(g0[i]); gg[2 * i + 1] = bfhi(g0[i]); gg[8 + 2 * i] = bflo(g1[i]); gg[8 + 2 * i + 1] = bfhi(g1[i]); } }
#pragma unroll
    for (int i = 0; i < 16; ++i) ss += o[i] * o[i];
    ss += __shfl_xor(ss, 1); ss += __shfl_xor(ss, 2); ss += __shfl_xor(ss, 4);
    const float rstd = rsqrtf(ss * (1.f / 128.f) + 1e-6f);
    bf16_t* M = (bf16_t*)(p.ws + WS_M) + (size_t)tok * 1024 + lane * 16;
    u32x4 o0, o1; float r[16];
#pragma unroll
    for (int i = 0; i < 16; ++i) r[i] = o[i] * rstd * on[i] * gg[i];
#pragma unroll
    for (int i = 0; i < 4; ++i) { o0[i] = pk2(r[2 * i], r[2 * i + 1]); o1[i] = pk2(r[8 + 2 * i], r[8 + 2 * i + 1]); }
    *(u32x4*)M = o0; *(u32x4*)(M + 8) = o1;
}

#ifndef HOST_EMU
#define XB_TMO      128
#define XB_XCNT(j)  (256  + 64 * (j))
#define XB_XSUB(j)  (1280 + 64 * (j))
#define XB_XGEN(j)  (2304 + 64 * (j))
#define XB_TOP      3328
#define XB_TOPGEN   3392
#define XCD_BAR_WORDS 3456
#define XB_SPIN_CAP (1u << 18)
#define LAS __attribute__((address_space(3)))

__device__ __forceinline__ unsigned xb_ld(unsigned* p)              { return __hip_atomic_load(p, __ATOMIC_RELAXED, __HIP_MEMORY_SCOPE_AGENT); }
__device__ __forceinline__ unsigned xb_add(unsigned* p, unsigned v) { return __hip_atomic_fetch_add(p, v, __ATOMIC_RELAXED, __HIP_MEMORY_SCOPE_AGENT); }
__device__ __forceinline__ unsigned xb_xcc_id() { return (unsigned)__builtin_amdgcn_s_getreg((3 << 11) | 20) & 0xFu; }
#define XB_SPIN(cond, bar) do { unsigned _sp = 0; while (cond) { __builtin_amdgcn_s_sleep(1); \
    if ((++_sp & 255u) == 0u) { if (xb_ld(&(bar)[XB_TMO])) break; if (_sp > XB_SPIN_CAP) { atomicAdd(&(bar)[XB_TMO], 1u); break; } } } } while (0)

struct XcdBarrier {
    unsigned* bar; unsigned x;
    volatile LAS unsigned* st;
};

__device__ __forceinline__ XcdBarrier xcd_barrier_post(unsigned* bar, volatile LAS unsigned* st) {
    XcdBarrier b; b.bar = bar; b.x = xb_xcc_id(); b.st = st;
    if (threadIdx.x == 0) (void)xb_add(&bar[XB_XCNT(b.x)], 1u);
    return b;
}
__device__ __forceinline__ void xcd_barrier_complete(unsigned* bar, unsigned x, unsigned& nloc, unsigned& nx) {
    const unsigned G = gridDim.x * gridDim.y * gridDim.z;
    unsigned sum, cnt, mine, sp = 0u;
    for (;;) {
        sum = 0u; cnt = 0u; mine = 0u;
#pragma unroll
        for (unsigned j = 0; j < 16; ++j) { const unsigned c = xb_ld(&bar[XB_XCNT(j)]); sum += c; cnt += (c > 0u) ? 1u : 0u; mine = (j == x) ? c : mine; }
        if (sum == G) break;
        __builtin_amdgcn_s_sleep(1);
        if ((++sp & 255u) == 0u) { if (xb_ld(&bar[XB_TMO])) break; if (sp > XB_SPIN_CAP) { atomicAdd(&bar[XB_TMO], 1u); break; } }
    }
    nloc = mine > 0u ? mine : 1u; nx = cnt > 0u ? cnt : 1u;
}

__device__ __forceinline__ void xcd_barrier(const XcdBarrier& b) {
    asm volatile("s_waitcnt vmcnt(0)" ::: "memory");
    __syncthreads();
    if (threadIdx.x == 0) {
        unsigned* bar = b.bar;
        __builtin_amdgcn_s_waitcnt(0);
        unsigned nloc = b.st[0], nx = b.st[1];
        if (nloc == 0u) { xcd_barrier_complete(bar, b.x, nloc, nx); b.st[0] = nloc; b.st[1] = nx; }
        const unsigned old = xb_add(&bar[XB_XSUB(b.x)], 1u);
        const unsigned gen = old / nloc;
        if (old + 1u == (gen + 1u) * nloc) {
            __builtin_amdgcn_fence(__ATOMIC_RELEASE, "agent");
            asm volatile("s_waitcnt vmcnt(0)" ::: "memory");
            const unsigned og = xb_add(&bar[XB_TOP], 1u);
            const unsigned tg = og / nx;
            if (og + 1u == (tg + 1u) * nx) xb_add(&bar[XB_TOPGEN], 1u);
            else XB_SPIN(xb_ld(&bar[XB_TOPGEN]) == tg, bar);
            __builtin_amdgcn_fence(__ATOMIC_ACQUIRE, "agent");
            xb_add(&bar[XB_XGEN(b.x)], 1u);
            asm volatile("s_waitcnt vmcnt(0)" ::: "memory");
        } else {
            XB_SPIN(xb_ld(&bar[XB_XGEN(b.x)]) == gen, bar);
            __builtin_amdgcn_fence(__ATOMIC_ACQUIRE, "agent");
            asm volatile("s_waitcnt vmcnt(0)" ::: "memory");
        }
    }
    __syncthreads();
}

#endif
#ifdef NOINLINE_PHASES
#define NOINL __device__ __attribute__((noinline))
#else
#define NOINL __device__ __forceinline__
#endif
__shared__ __attribute__((aligned(16))) unsigned char g_smem[SMEM_BYTES + 16];
#define PH_COMMON const int G = gridDim.x, bid = blockIdx.x; unsigned char* smem = g_smem; (void)smem; (void)G; (void)bid; \
    const bf16_t* A = (const bf16_t*)(p.ws + WS_A); const bf16_t* Mx = (const bf16_t*)(p.ws + WS_M); const bf16_t* W = (const bf16_t*)(p.ws + WS_W); (void)A; (void)Mx; (void)W;
DEV void tables_in_gemm_tail(const Params& p, int layer, int nunits) {
    const int G = gridDim.x, bid = blockIdx.x, busy = nunits % G;
    if (busy == 0) { for (int it = bid; it < 2 * P0_TAB; it += G) p0_table(p, layer * 2 + it / P0_TAB, it % P0_TAB); return; }
    if (bid < busy) return;
    for (int it = bid - busy; it < 2 * P0_TAB; it += G - busy) p0_table(p, layer * 2 + it / P0_TAB, it % P0_TAB);
}
NOINL void ph0(const Params& p) { PH_COMMON phase0(p, smem); }
NOINL void ph1(const Params& p) { PH_COMMON phase1(p, smem); }
NOINL void ph2(const Params& p) { PH_COMMON EpiL0InT e{p.ws}; gemm_pg8_T(A, W + W_IN0 / 2, T, 2304, smem, e); tables_in_gemm_tail(p, 0, (T / 256) * 9); }
NOINL void ph3(const Params& p, int var = 0) { PH_COMMON phase3(p, smem, var); }
NOINL void ph4(const Params& p) { PH_COMMON EpiRes e{&p, 1, 0, 2048}; gemm_pg8_N(Mx, W + W_OUT0 / 2, T, 1024, smem, e); tables_in_gemm_tail(p, 1, (T / 256) * 4); }
NOINL void ph5(const Params& p) { PH_COMMON for (int it = bid; it < T / 8; it += G) norm_rows_item(p, it, 0, p.in[I_N2G], 0, 3072); }
NOINL void ph6(const Params& p, int var = 0) { PH_COMMON (void)var; EpiBf16 e{(bf16_t*)(p.ws + WS_P), 2048}; gemm_pg8_N(A, W + W_Q0 / 2, T, 2048, smem, e); }
NOINL void ph7(const Params& p) { PH_COMMON topk_phase(p, 0, T, smem); }
NOINL void ph8(const Params& p) { PH_COMMON for (int it = bid; it < T / 8; it += G) peer_item(p, 0, it); }
NOINL void ph9(const Params& p) { PH_COMMON EpiHgT e{p.ws, p.in[I_HGLB]}; gemm_pg8_T(A, W + W_IN1 / 2, T, 5120, smem, e); }
NOINL void ph10(const Params& p, int var = 0) { PH_COMMON for (int bi = bid; bi < NB * 32; bi += G) scan_block(p, bi, smem, var); }
NOINL void ph11(const Params& p) { PH_COMMON for (int it = bid; it < TL / 8; it += G) readout_item(p, it); }
NOINL void ph12(const Params& p) { PH_COMMON EpiRes e{&p, 0, 1, 2048}; gemm_pg8_N(Mx, W + W_OUT1 / 2, TL, 1024, smem, e); }
NOINL void ph13(const Params& p) { PH_COMMON for (int it = bid; it < TL / 8; it += G) norm_rows_item(p, it, 0, p.in[I_N2G] + 1024, 1, 3072); }
NOINL void ph14(const Params& p) { PH_COMMON EpiBf16 e{(bf16_t*)(p.ws + WS_P), 2048}; gemm_pg8_N(A, W + W_Q1 / 2, TL, 2048, smem, e); }
NOINL void ph15(const Params& p) { PH_COMMON topk_phase(p, 1, TL, smem); }
NOINL void ph16(const Params& p, int var = 0) { PH_COMMON for (int it = bid; it < TL / 8; it += G) peer_item(p, 1, it, var); }

constexpr int NPHASE = 17;
__global__ void __launch_bounds__(NT, 2) mega(Params p_in) {
    const int ph_lo = p_in.ph_lo, ph_hi = p_in.ph_hi;
#ifndef HOST_EMU
#define GBAR_MAKE() XcdBarrier gbar; gbar.bar = (unsigned*)(p_in.ws + WS_CTRL); gbar.x = xb_xcc_id(); gbar.st = (volatile LAS unsigned*)(LAS unsigned char*)(g_smem + SMEM_BYTES);
    if (ph_hi - ph_lo > 1) {
        volatile LAS unsigned* st = (volatile LAS unsigned*)(LAS unsigned char*)(g_smem + SMEM_BYTES);
        if (threadIdx.x == 0) { st[0] = 0u; st[1] = 0u; }
        __syncthreads();
        (void)xcd_barrier_post((unsigned*)(p_in.ws + WS_CTRL), st);
    }
#endif
#ifndef HOST_EMU
#define PH_BARRIER() do { GBAR_MAKE(); xcd_barrier(gbar); } while (0)
#define PH_PARAMS() unsigned long long kp = (unsigned long long)__builtin_amdgcn_kernarg_segment_ptr(); asm volatile("" : "+s"(kp) :: "memory"); \
        const Params& p = *(const Params*)(const __attribute__((address_space(4))) Params*)kp;
#else
#define PH_BARRIER() do {} while (0)
#define PH_PARAMS() const Params& p = p_in;
#endif
#ifdef REPEAT_MASK
#define PH_REPEAT(k, CALL) if ((REPEAT_MASK >> (k)) & 1) { PH_BARRIER(); { PH_PARAMS(); CALL; } }
#else
#define PH_REPEAT(k, CALL)
#endif
#ifdef ONLY_PHASE
#define PH_ON(k) ((k) == ONLY_PHASE)
#else
#define PH_ON(k) true
#endif
#define RUN_PHASE(k, CALL) if (PH_ON(k) && ph_lo <= (k) && (k) < ph_hi) { if ((k) > ph_lo) PH_BARRIER(); { PH_PARAMS(); CALL; } PH_REPEAT(k, CALL) }
    RUN_PHASE(0, ph0(p))  RUN_PHASE(1, ph1(p))  RUN_PHASE(2, ph2(p))  RUN_PHASE(3, ph3(p))  RUN_PHASE(4, ph4(p))  RUN_PHASE(5, ph5(p))
    RUN_PHASE(6, ph6(p))  RUN_PHASE(7, ph7(p))  RUN_PHASE(8, ph8(p))  RUN_PHASE(9, ph9(p))  RUN_PHASE(10, ph10(p)) RUN_PHASE(11, ph11(p))
    RUN_PHASE(12, ph12(p)) RUN_PHASE(13, ph13(p)) RUN_PHASE(14, ph14(p)) RUN_PHASE(15, ph15(p)) RUN_PHASE(16, ph16(p))
}

#ifndef HOST_EMU
extern "C" void kernel_launch(void* const* d_in, const int* in_sizes, int n_in, void* d_out, int out_size, void* d_ws, size_t ws_size, hipStream_t stream) {
    if (n_in != 29 || ws_size < WS_END || out_size != TL * 1024) { fprintf(stderr, "kernel_launch: unexpected sizes (n_in %d, ws %zu need %zu, out %d)\n", n_in, ws_size, (size_t)WS_END, out_size); return; }
    static int grid = 0;
    if (!grid) { int dev = 0, cus = 0; hipGetDevice(&dev); hipDeviceGetAttribute(&cus, hipDeviceAttributeMultiprocessorCount, dev); grid = cus > 0 ? cus : 256; }
    hipMemsetAsync((unsigned char*)d_ws + WS_CTRL, 0, CTRL_BYTES, stream);
    Params p{};
    for (int i = 0; i < 29; ++i) p.in[i] = (const float*)d_in[i];
    p.out = (float*)d_out; p.ws = (unsigned char*)d_ws;
#ifdef MULTI_LAUNCH
    for (int ph = 0; ph < NPHASE; ++ph) { p.ph_lo = ph; p.ph_hi = ph + 1; hipLaunchKernelGGL(mega, dim3(grid), dim3(NT), 0, stream, p); }
#else
    p.ph_lo = 0; p.ph_hi = NPHASE;
    hipLaunchKernelGGL(mega, dim3(grid), dim3(NT), 0, stream, p);
#endif
}
#endif
```

```cpp
#ifndef HOST_EMU
#include <hip/hip_runtime.h>
#include <cstdio>
#endif

#ifndef CFG_B
#define CFG_B 8
#define CFG_L 2048
#define CFG_LC 256
#endif
#define DEV __device__ __forceinline__
#ifndef HOST_EMU
#define SCHED_FENCE() __builtin_amdgcn_sched_barrier(0)
#endif
#ifdef HOST_EMU
#define SCHED_FENCE() do {} while (0)
#define __expf expf
#define __logf logf
#define __sinf sinf
#define __cosf cosf
#endif

typedef unsigned short bf16_t;
typedef short bf16x8 __attribute__((ext_vector_type(8)));
typedef float f32x16 __attribute__((ext_vector_type(16)));
typedef float f32x4 __attribute__((ext_vector_type(4)));
typedef unsigned u32x4 __attribute__((ext_vector_type(4)));
typedef unsigned u32x2 __attribute__((ext_vector_type(2)));
struct cf2 { float x, y; };

constexpr int NB = CFG_B, L = CFG_L, LC = CFG_LC, D = 1024;
constexpr int TL = NB * L, TC = NB * LC, T = TL + TC;
constexpr int NT = 512;
constexpr int NR = NB + 1;
constexpr int log4ceil(int n) { int s = 0, v = 1; while (v < n) { v *= 4; ++s; } return s; }
constexpr int FS_LAT = log4ceil(2 * L - 1), FS_CTX = log4ceil(2 * LC - 1);
constexpr int NF_LAT = 1 << (2 * FS_LAT), NF_CTX = 1 << (2 * FS_CTX);
static_assert(T % 256 == 0 && TL % 256 == 0 && L % 128 == 0 && LC % 128 == 0 && NB % 2 == 0, "shape");

constexpr size_t al256(size_t x) { return (x + 255) & ~(size_t)255; }
constexpr size_t WS_CTRL = 0, CTRL_BYTES = 65536;
constexpr size_t CTRL_HYNORM = 4096;
constexpr size_t WS_MOD = WS_CTRL + CTRL_BYTES;
constexpr size_t WS_H = al256(WS_MOD + (size_t)2 * NR * 6144 * 4);
constexpr size_t WS_A = al256(WS_H + (size_t)T * 1024 * 4);
constexpr size_t WS_P = al256(WS_A + (size_t)T * 1024 * 2);
constexpr size_t P_BYTES = (size_t)T * 5120 * 2;
constexpr size_t P_HYT_LAT = 0;
constexpr size_t P_HYT_CTX = P_HYT_LAT + (size_t)NB * 1536 * L * 2;
constexpr size_t P_Q0 = P_HYT_CTX + (size_t)NB * 1536 * LC * 2;
constexpr size_t P_K0 = P_Q0 + (size_t)T * 512 * 2;
constexpr size_t P_VT_LAT = P_K0 + (size_t)T * 128 * 2;
constexpr size_t P_VT_CTX = P_VT_LAT + (size_t)NB * 128 * L * 2;
static_assert(P_VT_CTX + (size_t)NB * 128 * LC * 2 <= P_BYTES, "P region");
constexpr size_t P1_KQT_LAT = 0;
constexpr size_t P1_KQT_CTX = P1_KQT_LAT + (size_t)NB * 3072 * L * 2;
constexpr size_t P1_G = P1_KQT_CTX + (size_t)NB * 3072 * LC * 2;
static_assert(P1_G + (size_t)TL * 1024 * 2 <= P_BYTES, "P region (layer 1)");
constexpr size_t WS_M = al256(WS_P + P_BYTES);
constexpr size_t WS_IDX = al256(WS_M + (size_t)T * 1024 * 2);
constexpr size_t WS_GATE = al256(WS_IDX + (size_t)T * 128 * 4);
constexpr size_t WS_U6 = al256(WS_GATE + (size_t)T * 128 * 4);
constexpr size_t WS_V4 = WS_U6 + (size_t)2 * 16384 * 768;
constexpr size_t WS_S8 = WS_V4 + (size_t)2 * 16384 * 512;
constexpr size_t WS_W = al256(WS_S8 + (size_t)4 * 16384 * 4);
constexpr size_t W_IN0 = 0, W_OUT0 = W_IN0 + (size_t)2304 * 1024 * 2, W_IN1 = W_OUT0 + (size_t)1024 * 1024 * 2,
                 W_OUT1 = W_IN1 + (size_t)5120 * 1024 * 2, W_Q0 = W_OUT1 + (size_t)1024 * 1024 * 2, W_Q1 = W_Q0 + (size_t)2048 * 1024 * 2,
                 W_KEYS = W_Q1 + (size_t)2048 * 1024 * 2, W_BYTES = W_KEYS + (size_t)2 * 8 * 2 * 128 * 128 * 2;
constexpr size_t WS_F = al256(WS_W + W_BYTES);
constexpr size_t F_HRAW_LAT = 0;
constexpr size_t F_HRAW_CTX = F_HRAW_LAT + (size_t)2048 * L * 4;
constexpr size_t F_HF_LAT = F_HRAW_CTX + (size_t)2048 * LC * 4;
constexpr size_t F_HF_CTX = F_HF_LAT + (size_t)1024 * NF_LAT * 8;
constexpr size_t F_HYP_LAT = F_HF_CTX + (size_t)1024 * NF_CTX * 8;
constexpr size_t F_HYP_CTX = F_HYP_LAT + (size_t)(L / 64) * 2048 * 4;
constexpr size_t F_END = F_HYP_CTX + (size_t)(LC / 64) * 2048 * 4;
constexpr size_t F_OF = 0, F_OB = (size_t)TL * 1024 * 2;
constexpr size_t F_BYTES = F_END > 2 * F_OB ? F_END : 2 * F_OB;
constexpr size_t WS_END = al256(WS_F + F_BYTES);

struct Params { const float* in[29]; float* out; unsigned char* ws; int ph_lo, ph_hi; };
enum { I_X = 0, I_C, I_CTX, I_CCTX, I_ADAW, I_ADAB, I_N1G, I_N2G, I_FG, I_ABWIN, I_ABWOUT, I_HYCW, I_HYCB, I_HYW1, I_HYB1, I_HYW2, I_HYB2, I_HYW3,
       I_HYFREQ, I_HYSKIP, I_SINK, I_HGWIN, I_HGWOUT, I_HGLB, I_HGON, I_PWQ, I_PKEYS, I_PU, I_PV };

constexpr int SMEM_BYTES = 147456;

#ifndef HOST_EMU
DEV int tidx() { int t = threadIdx.x; asm volatile("" : "+v"(t)); return t; }
#else
DEV int tidx() { return (int)threadIdx.x; }
#endif
#ifndef HOST_EMU
DEV void lds_barrier() { asm volatile("s_waitcnt lgkmcnt(0)" ::: "memory"); __builtin_amdgcn_s_barrier(); asm volatile("" ::: "memory"); }
#else
DEV void lds_barrier() { __syncthreads(); }
#endif
#ifndef HOST_EMU
typedef __bf16 bf16n2 __attribute__((ext_vector_type(2)));
DEV unsigned pk2(float lo, float hi) { bf16n2 v; v[0] = (__bf16)lo; v[1] = (__bf16)hi; return __builtin_bit_cast(unsigned, v); }
DEV unsigned f2bf(float f) { return (unsigned)__builtin_bit_cast(unsigned short, (__bf16)f); }
#else
DEV unsigned f2bf(float f) { unsigned u = __builtin_bit_cast(unsigned, f); return (u + 0x7fffu + ((u >> 16) & 1u)) >> 16; }
DEV unsigned pk2(float lo, float hi) { return f2bf(lo) | (f2bf(hi) << 16); }
#endif
DEV float bf2f(unsigned h) { return __builtin_bit_cast(float, (h & 0xffffu) << 16); }
DEV float bflo(unsigned u) { return __builtin_bit_cast(float, u << 16); }
DEV float bfhi(unsigned u) { return __builtin_bit_cast(float, u & 0xffff0000u); }
DEV float silu_f(float x) { return x * __builtin_amdgcn_rcpf(1.f + __expf(-x)); }
DEV float sigmoid_f(float x) { return __builtin_amdgcn_rcpf(1.f + __expf(-x)); }
DEV float wave_sum(float v) {
#pragma unroll
    for (int m = 32; m >= 1; m >>= 1) v += __shfl_xor(v, m);
    return v;
}
DEV int mod_row(int tok) { return tok < TL ? tok / L : NB; }

DEV void p0_mod(const Params& p, int item, unsigned char* smem) {
    const int l = item / 96, col0 = (item % 96) * 64, tid = tidx();
    float* sc = (float*)smem;
    float* red = sc + NR * 1024;
    for (int i = tid; i < NR * 1024; i += NT) { const int r = i >> 10, k = i & 1023; const float c = r < NB ? p.in[I_C][r * 1024 + k] : p.in[I_CCTX][k]; sc[i] = c / (1.f + expf(-c)); }
    __syncthreads();
    const int kq = tid >> 6, col = tid & 63;
    float acc[NR];
#pragma unroll
    for (int r = 0; r < NR; ++r) acc[r] = 0.f;
    const float* w = p.in[I_ADAW] + (size_t)l * 1024 * 6144 + col0 + col;
#pragma unroll 16
    for (int k = kq * 128; k < kq * 128 + 128; ++k) {
        const float wv = w[(size_t)k * 6144];
#pragma unroll
        for (int r = 0; r < NR; ++r) acc[r] += sc[r * 1024 + k] * wv;
    }
#pragma unroll
    for (int r = 0; r < NR; ++r) red[(kq * NR + r) * 64 + col] = acc[r];
    __syncthreads();
    float* mod = (float*)(p.ws + WS_MOD);
    for (int i = tid; i < NR * 64; i += NT) {
        const int r = i >> 6, c = i & 63; float s = 0.f;
        for (int q = 0; q < 8; ++q) s += red[(q * NR + r) * 64 + c];
        mod[((size_t)l * NR + r) * 6144 + col0 + c] = s + p.in[I_ADAB][l * 6144 + col0 + c];
    }
    __syncthreads();
}
DEV void p0_transpose(const float* W, bf16_t* Wt, int N, int tile, unsigned char* smem) {
    float* ts = (float*)smem;
    const int ntn = N / 256, kt = tile / ntn, nt = tile % ntn, k0 = kt * 64, n0 = nt * 256, tid = tidx();
    f32x4 rv[8];
#pragma unroll
    for (int m = 0; m < 8; ++m) { const int i = tid + NT * m, kk = i >> 6, c4 = i & 63; rv[m] = *(const f32x4*)(W + (size_t)(k0 + kk) * N + n0 + c4 * 4); }
#pragma unroll
    for (int m = 0; m < 8; ++m) { const int i = tid + NT * m, kk = i >> 6, c4 = i & 63; *(f32x4*)(ts + kk * 260 + c4 * 4) = rv[m]; }
    __syncthreads();
#pragma unroll
    for (int m = 0; m < 4; ++m) { const int i = tid + NT * m, nn = i >> 3, k8 = i & 7;
        u32x4 o;
#pragma unroll
        for (int e = 0; e < 4; ++e) o[e] = pk2(ts[(k8 * 8 + 2 * e) * 260 + nn], ts[(k8 * 8 + 2 * e + 1) * 260 + nn]);
        *(u32x4*)(Wt + (size_t)(n0 + nn) * 1024 + k0 + k8 * 8) = o; }
    __syncthreads();
}
DEV void p0_convert(const float* src, bf16_t* dst, int item) {
    const int tid = tidx();
#pragma unroll
    for (int i = 0; i < 8; ++i) {
        const size_t e = (size_t)item * 16384 + (size_t)(i * NT + tid) * 4;
        const f32x4 v = *(const f32x4*)(src + e);
        u32x2 o; o[0] = pk2(v[0], v[1]); o[1] = pk2(v[2], v[3]);
        *(u32x2*)(dst + e) = o;
    }
}
typedef float f32x2 __attribute__((ext_vector_type(2)));
typedef float f32x32 __attribute__((ext_vector_type(32)));
typedef unsigned u32x6 __attribute__((ext_vector_type(6)));
DEV void p0_table(const Params& p, int tab, int item) {
    const int lane = tidx() & 63, li = lane & 31, half = lane >> 5, layer = tab >> 1, isv = tab & 1;
#pragma unroll 1
    for (int pass = 0; pass < 2; ++pass) {
        const int row = item * 32 + pass * 16 + (tidx() >> 6) * 2 + half;
        const float* src = (isv ? p.in[I_PV] : p.in[I_PU]) + ((size_t)layer * 16384 + row) * 1024 + li * 32;
        f32x4 v[8]; float mx = 0.f;
#pragma unroll
        for (int i = 0; i < 8; ++i) { v[i] = *(const f32x4*)(src + 4 * i); mx = fmaxf(mx, fmaxf(fmaxf(fabsf(v[i][0]), fabsf(v[i][1])), fmaxf(fabsf(v[i][2]), fabsf(v[i][3])))); }
#pragma unroll
        for (int m = 16; m >= 1; m >>= 1) mx = fmaxf(mx, __shfl_xor(mx, m));
        const float top = isv ? 6.f : 7.5f;
        const float sc = mx > 0.f ? top / mx : 1.f;
        if (!isv) {
            f32x16 pa, pb;
#pragma unroll
            for (int i = 0; i < 16; ++i) { pa[i] = 0.f; pb[i] = 0.f; }
            pa[1] = 1.0f;
            const f32x32 pr = __builtin_amdgcn_cvt_scalef32_pk32_f32_fp6(__builtin_amdgcn_cvt_scalef32_2xpk16_fp6_f32(pa, pb, 1.0f), 1.0f);
            const bool inter = pr[2] == 1.0f;
            f32x16 lo, hi;
#pragma unroll
            for (int i = 0; i < 4; ++i)
#pragma unroll
                for (int e = 0; e < 4; ++e) {
                    const int j = 4 * i + e;
                    const float lin_lo = v[i][e], lin_hi = v[4 + i][e];
                    const float il_lo = v[(2 * j) >> 2][(2 * j) & 3], il_hi = v[(2 * j + 1) >> 2][(2 * j + 1) & 3];
                    lo[j] = (inter ? il_lo : lin_lo) * sc; hi[j] = (inter ? il_hi : lin_hi) * sc;
                }
            const u32x6 w = __builtin_amdgcn_cvt_scalef32_2xpk16_fp6_f32(lo, hi, 1.0f);
            unsigned char* dst = p.ws + WS_U6 + ((size_t)layer * 16384 + row) * 768;
            u32x4 w0; w0[0] = w[0]; w0[1] = w[1]; w0[2] = w[2]; w0[3] = w[3]; u32x2 w1; w1[0] = w[4]; w1[1] = w[5];
            *(u32x4*)(dst + li * 16) = w0; *(u32x2*)(dst + 512 + li * 8) = w1;
        } else {
            const f32x2 pr4 = __builtin_amdgcn_cvt_scalef32_pk_f32_fp4(__builtin_amdgcn_cvt_scalef32_pk_fp4_f32(0u, 1.0f, 0.0f, 1.0f, 0), 1.0f, 0);
            const bool swp = pr4[0] != 1.0f;
            u32x4 w;
#pragma unroll
            for (int d = 0; d < 4; ++d) { unsigned x = 0u;
                x = __builtin_amdgcn_cvt_scalef32_pk_fp4_f32(x, (swp ? v[2 * d][1] : v[2 * d][0]) * sc, (swp ? v[2 * d][0] : v[2 * d][1]) * sc, 1.0f, 0);
                x = __builtin_amdgcn_cvt_scalef32_pk_fp4_f32(x, (swp ? v[2 * d][3] : v[2 * d][2]) * sc, (swp ? v[2 * d][2] : v[2 * d][3]) * sc, 1.0f, 1);
                x = __builtin_amdgcn_cvt_scalef32_pk_fp4_f32(x, (swp ? v[2 * d + 1][1] : v[2 * d + 1][0]) * sc, (swp ? v[2 * d + 1][0] : v[2 * d + 1][1]) * sc, 1.0f, 2);
                x = __builtin_amdgcn_cvt_scalef32_pk_fp4_f32(x, (swp ? v[2 * d + 1][3] : v[2 * d + 1][2]) * sc, (swp ? v[2 * d + 1][2] : v[2 * d + 1][3]) * sc, 1.0f, 3);
                w[d] = x; }
            *(u32x4*)(p.ws + WS_V4 + ((size_t)layer * 16384 + row) * 512 + li * 16) = w;
        }
        if (li == 0) ((float*)(p.ws + WS_S8))[tab * 16384 + row] = mx > 0.f ? mx / top : 1.f;
    }
}
DEV void p0_filter(const Params& p, int set, int chunk, int cb, unsigned char* smem) {
    const int Ls = set ? LC : L, l0 = chunk * 64, tid = tidx();
    float* z = (float*)smem;
    float* hd1 = z + 64 * 34;
    float* hd2 = hd1 + 64 * 65;
    const float* w1 = p.in[I_HYW1]; const float* b1 = p.in[I_HYB1]; const float* w2 = p.in[I_HYW2]; const float* b2 = p.in[I_HYB2];
    const float* w3 = p.in[I_HYW3]; const float* fq = p.in[I_HYFREQ];
    for (int i = tid; i < 64 * 33; i += NT) {
        const int pp = i / 33, f = i % 33, l = l0 + pp; float val;
        if (f == 0) val = (float)l / (float)(Ls - 1);
        else { const int jb = (f - 1) & 15; const float fj = 1e-4f + (float)jb * ((15.f - 1e-4f) / 15.f); const float a = fj * (6.283185307179586f * (float)l / (float)Ls); val = f <= 16 ? __cosf(a) : -__sinf(a); }
        z[pp * 34 + f] = val;
    }
    __syncthreads();
    {
        const int j = tid & 63, p0 = tid >> 6;
        float wc[64], acc[8];
#pragma unroll
        for (int f = 0; f < 33; ++f) wc[f] = w1[f * 64 + j];
#pragma unroll
        for (int m = 0; m < 8; ++m) { float sacc = b1[j];
#pragma unroll
            for (int f = 0; f < 33; ++f) sacc = fmaf(z[(p0 + 8 * m) * 34 + f], wc[f], sacc);
            acc[m] = sacc; }
#pragma unroll
        for (int m = 0; m < 8; ++m) hd1[(p0 + 8 * m) * 65 + j] = __sinf(fq[j] * acc[m]);
        __syncthreads();
#pragma unroll
        for (int f = 0; f < 64; ++f) wc[f] = w2[f * 64 + j];
#pragma unroll
        for (int m = 0; m < 8; ++m) { float sacc = b2[j];
#pragma unroll
            for (int f = 0; f < 64; ++f) sacc = fmaf(hd1[(p0 + 8 * m) * 65 + f], wc[f], sacc);
            acc[m] = sacc; }
#pragma unroll
        for (int m = 0; m < 8; ++m) hd2[(p0 + 8 * m) * 65 + j] = __sinf(fq[j] * acc[m]);
        __syncthreads();
    }
    const float max_decay = -15.350567286626973f, min_decay = -3.0701134573253945f;
    float* hraw = (float*)(p.ws + WS_F + (set ? F_HRAW_CTX : F_HRAW_LAT));
    float* hyn = (float*)(p.ws + WS_F + (set ? F_HYP_CTX : F_HYP_LAT)) + (size_t)chunk * 2048;
    {
        const int o = cb * NT + tid;
        const int c = o & 511; const float delta = fabsf(min_decay + (float)c * ((max_decay - min_decay) / 511.f));
        float asum = 0.f;
        float* dst = hraw + (size_t)o * Ls + l0;
        for (int ph = 0; ph < 2; ++ph) {
            float acc[32];
#pragma unroll
            for (int pp = 0; pp < 32; ++pp) acc[pp] = 0.f;
#pragma unroll 1
            for (int j0 = 0; j0 < 64; j0 += 16) {
                float wv[16];
#pragma unroll
                for (int j = 0; j < 16; ++j) wv[j] = w3[(j0 + j) * 2048 + o];
#pragma unroll
                for (int j = 0; j < 16; ++j) {
#pragma unroll
                    for (int pp = 0; pp < 32; ++pp) acc[pp] = fmaf(hd2[(ph * 32 + pp) * 65 + j0 + j], wv[j], acc[pp]);
                    SCHED_FENCE();
                }
            }
#pragma unroll
            for (int q4 = 0; q4 < 8; ++q4) {
                f32x4 v;
#pragma unroll
                for (int e = 0; e < 4; ++e) { const int pp = q4 * 4 + e; const float tl = (float)(l0 + ph * 32 + pp) / (float)(Ls - 1); const float val = acc[pp] * expf(-tl * delta); v[e] = val; asum += fabsf(val); }
                *(f32x4*)(dst + ph * 32 + q4 * 4) = v;
            }
        }
        hyn[o] = asum;
    }
    __syncthreads();
}

constexpr int P0_MOD = 192, P0_TR_IN0 = 16 * 9, P0_TR_OUT0 = 64, P0_TR_IN1 = 16 * 20, P0_TR_OUT1 = 64, P0_TR_Q = 16 * 8, P0_KEYS = 32, P0_TAB = 512,
              P0_FILT = 4 * (L / 64 + LC / 64);
DEV void phase0(const Params& p, unsigned char* smem) {
    bf16_t* W = (bf16_t*)(p.ws + WS_W);
    const int total = P0_MOD + P0_FILT + P0_TR_IN0 + P0_TR_OUT0 + P0_TR_IN1 + P0_TR_OUT1 + 2 * P0_TR_Q + P0_KEYS;
    for (int it = blockIdx.x; it < total; it += gridDim.x) {
        int i = it;
        if (i < P0_MOD) { p0_mod(p, i, smem); continue; } i -= P0_MOD;
        if (i < P0_FILT) { const int ch = i >> 2, cb = i & 3; if (ch < L / 64) p0_filter(p, 0, ch, cb, smem); else p0_filter(p, 1, ch - L / 64, cb, smem); continue; } i -= P0_FILT;
        if (i < P0_TR_IN0) { p0_transpose(p.in[I_ABWIN], W + W_IN0 / 2, 2304, i, smem); continue; } i -= P0_TR_IN0;
        if (i < P0_TR_OUT0) { p0_transpose(p.in[I_ABWOUT], W + W_OUT0 / 2, 1024, i, smem); continue; } i -= P0_TR_OUT0;
        if (i < P0_TR_IN1) { p0_transpose(p.in[I_HGWIN], W + W_IN1 / 2, 5120, i, smem); continue; } i -= P0_TR_IN1;
        if (i < P0_TR_OUT1) { p0_transpose(p.in[I_HGWOUT], W + W_OUT1 / 2, 1024, i, smem); continue; } i -= P0_TR_OUT1;
        if (i < P0_TR_Q) { p0_transpose(p.in[I_PWQ], W + W_Q0 / 2, 2048, i, smem); continue; } i -= P0_TR_Q;
        if (i < P0_TR_Q) { p0_transpose(p.in[I_PWQ] + (size_t)1024 * 2048, W + W_Q1 / 2, 2048, i, smem); continue; } i -= P0_TR_Q;
        p0_convert(p.in[I_PKEYS], W + W_KEYS / 2, i);
    }
}

DEV const float* h_row(const Params& p, int layer_src_inputs, int tok) {
    if (layer_src_inputs) return tok < TL ? p.in[I_X] + (size_t)tok * 1024 : p.in[I_CTX] + (size_t)(tok - TL) * 1024;
    return (const float*)(p.ws + WS_H) + (size_t)tok * 1024;
}
DEV void norm_row_store(const Params& p, const f32x4 (&v)[4], int tok, const float* g, int layer, int sh_off, int lane) {
    float ss = 0.f;
#pragma unroll
    for (int i = 0; i < 4; ++i) ss += v[i][0] * v[i][0] + v[i][1] * v[i][1] + v[i][2] * v[i][2] + v[i][3] * v[i][3];
    ss = wave_sum(ss);
    const float rstd = rsqrtf(ss * (1.f / 1024.f) + 1e-6f);
    const float* mod = (const float*)(p.ws + WS_MOD) + ((size_t)layer * NR + mod_row(tok)) * 6144 + sh_off;
    bf16_t* A = (bf16_t*)(p.ws + WS_A) + (size_t)tok * 1024;
#pragma unroll
    for (int i = 0; i < 4; ++i) {
        const int c = i * 256 + lane * 4;
        const f32x4 gg = *(const f32x4*)(g + c), sh = *(const f32x4*)(mod + c), sc = *(const f32x4*)(mod + 1024 + c);
        u32x2 o;
        o[0] = pk2(v[i][0] * rstd * gg[0] * (1.f + sc[0]) + sh[0], v[i][1] * rstd * gg[1] * (1.f + sc[1]) + sh[1]);
        o[1] = pk2(v[i][2] * rstd * gg[2] * (1.f + sc[2]) + sh[2], v[i][3] * rstd * gg[3] * (1.f + sc[3]) + sh[3]);
        *(u32x2*)(A + c) = o;
    }
}
DEV void norm_rows_item(const Params& p, int item, int from_inputs, const float* g, int layer, int sh_off) {
    const int tok = item * 8 + (tidx() >> 6), lane = tidx() & 63;
    const float* src = h_row(p, from_inputs, tok);
    f32x4 v[4];
#pragma unroll
    for (int i = 0; i < 4; ++i) v[i] = *(const f32x4*)(src + i * 256 + lane * 4);
    norm_row_store(p, v, tok, g, layer, sh_off, lane);
}

DEV cf2 cmul(cf2 a, cf2 b) { cf2 r; r.x = a.x * b.x - a.y * b.y; r.y = a.x * b.y + a.y * b.x; return r; }
DEV cf2 twid(int k, float invN) { cf2 r; const float a = (float)k * invN; r.x = __builtin_amdgcn_cosf(a); r.y = -__builtin_amdgcn_sinf(a); return r; }
DEV int fsw(int i) { return i ^ ((i >> 4) & 15) ^ (((i >> 8) & 1) << 4); }
DEV void bfly4_fwd(cf2& a0, cf2& a1, cf2& a2, cf2& a3) {
    cf2 t0, t1, t2, t3; t0.x = a0.x + a2.x; t0.y = a0.y + a2.y; t1.x = a0.x - a2.x; t1.y = a0.y - a2.y; t2.x = a1.x + a3.x; t2.y = a1.y + a3.y;
    const float dx = a1.x - a3.x, dy = a1.y - a3.y; t3.x = dy; t3.y = -dx;
    a0.x = t0.x + t2.x; a0.y = t0.y + t2.y; a1.x = t1.x + t3.x; a1.y = t1.y + t3.y; a2.x = t0.x - t2.x; a2.y = t0.y - t2.y; a3.x = t1.x - t3.x; a3.y = t1.y - t3.y;
}
DEV void bfly4_inv(cf2& c0, cf2& c1, cf2& c2, cf2& c3) {
    cf2 t0, t1, t2, t3; t0.x = c0.x + c2.x; t0.y = c0.y + c2.y; t1.x = c0.x - c2.x; t1.y = c0.y - c2.y; t2.x = c1.x + c3.x; t2.y = c1.y + c3.y;
    const float dx = c1.x - c3.x, dy = c1.y - c3.y; t3.x = -dy; t3.y = dx;
    c0.x = t0.x + t2.x; c0.y = t0.y + t2.y; c1.x = t1.x + t3.x; c1.y = t1.y + t3.y; c2.x = t0.x - t2.x; c2.y = t0.y - t2.y; c3.x = t1.x - t3.x; c3.y = t1.y - t3.y;
}
DEV void fft_stage4(cf2* buf, int S, int s, int g, int G, bool inv) {
    const int N = 1 << (2 * S); const float invN = 1.f / (float)N;
    const int lm = 2 * (S - s), m = 1 << lm, q = m >> 2;
    for (int bf = g; bf < (N >> 2); bf += G) {
        const int j = bf & (q - 1), base = ((bf >> (lm - 2)) << lm) + j, tw = j << (2 * s);
        cf2 a0 = buf[fsw(base)], a1 = buf[fsw(base + q)], a2 = buf[fsw(base + 2 * q)], a3 = buf[fsw(base + 3 * q)];
        if (!inv) { bfly4_fwd(a0, a1, a2, a3); a1 = cmul(a1, twid(tw, invN)); a2 = cmul(a2, twid(2 * tw, invN)); a3 = cmul(a3, twid(3 * tw, invN)); }
        else { cf2 w1 = twid(tw, invN), w2 = twid(2 * tw, invN), w3 = twid(3 * tw, invN); w1.y = -w1.y; w2.y = -w2.y; w3.y = -w3.y; a1 = cmul(a1, w1); a2 = cmul(a2, w2); a3 = cmul(a3, w3); bfly4_inv(a0, a1, a2, a3); }
        buf[fsw(base)] = a0; buf[fsw(base + q)] = a1; buf[fsw(base + 2 * q)] = a2; buf[fsw(base + 3 * q)] = a3;
    }
}
DEV void fft_stage16(cf2* buf, int S, int s, int g, int G, bool inv) {
    const int N = 1 << (2 * S); const float invN = 1.f / (float)N;
    const int lm = 2 * (S - s), m = 1 << lm, q = m >> 2, q2 = q >> 2;
    for (int u = g; u < (N >> 4); u += G) {
        const int j2 = u & (q2 - 1), base = ((u >> (lm - 4)) << lm) + j2;
        cf2 x[4][4];
#pragma unroll
        for (int c = 0; c < 4; ++c)
#pragma unroll
            for (int c2 = 0; c2 < 4; ++c2) x[c][c2] = buf[fsw(base + c * q + c2 * q2)];
        if (!inv) {
#pragma unroll
            for (int c2 = 0; c2 < 4; ++c2) {
                const int tw = (j2 + c2 * q2) << (2 * s);
                bfly4_fwd(x[0][c2], x[1][c2], x[2][c2], x[3][c2]);
                x[1][c2] = cmul(x[1][c2], twid(tw, invN)); x[2][c2] = cmul(x[2][c2], twid(2 * tw, invN)); x[3][c2] = cmul(x[3][c2], twid(3 * tw, invN));
                SCHED_FENCE();
            }
            const int tw2 = j2 << (2 * (s + 1));
            const cf2 v1 = twid(tw2, invN), v2 = twid(2 * tw2, invN), v3 = twid(3 * tw2, invN);
#pragma unroll
            for (int c = 0; c < 4; ++c) {
                bfly4_fwd(x[c][0], x[c][1], x[c][2], x[c][3]);
                x[c][1] = cmul(x[c][1], v1); x[c][2] = cmul(x[c][2], v2); x[c][3] = cmul(x[c][3], v3);
            }
        } else {
            const int tw2 = j2 << (2 * (s + 1));
            cf2 v1 = twid(tw2, invN), v2 = twid(2 * tw2, invN), v3 = twid(3 * tw2, invN); v1.y = -v1.y; v2.y = -v2.y; v3.y = -v3.y;
#pragma unroll
            for (int c = 0; c < 4; ++c) {
                x[c][1] = cmul(x[c][1], v1); x[c][2] = cmul(x[c][2], v2); x[c][3] = cmul(x[c][3], v3);
                bfly4_inv(x[c][0], x[c][1], x[c][2], x[c][3]);
            }
#pragma unroll
            for (int c2 = 0; c2 < 4; ++c2) {
                const int tw = (j2 + c2 * q2) << (2 * s);
                cf2 w1 = twid(tw, invN), w2 = twid(2 * tw, invN), w3 = twid(3 * tw, invN); w1.y = -w1.y; w2.y = -w2.y; w3.y = -w3.y;
                x[1][c2] = cmul(x[1][c2], w1); x[2][c2] = cmul(x[2][c2], w2); x[3][c2] = cmul(x[3][c2], w3);
                bfly4_inv(x[0][c2], x[1][c2], x[2][c2], x[3][c2]);
                SCHED_FENCE();
            }
        }
#pragma unroll
        for (int c = 0; c < 4; ++c)
#pragma unroll
            for (int c2 = 0; c2 < 4; ++c2) buf[fsw(base + c * q + c2 * q2)] = x[c][c2];
    }
}
DEV void fft_fwd(cf2* buf, int S, int g, int G) {
    int s = 0;
    for (; s + 1 < S; s += 2) { fft_stage16(buf, S, s, g, G, false); __syncthreads(); }
    if (s < S) { fft_stage4(buf, S, s, g, G, false); __syncthreads(); }
}
DEV void fft_inv(cf2* buf, int S, int g, int G) {
    int s = S - 1;
    if (S & 1) { fft_stage4(buf, S, s, g, G, true); __syncthreads(); --s; }
    for (; s >= 1; s -= 2) { fft_stage16(buf, S, s - 1, g, G, true); __syncthreads(); }
}
DEV void hf_item(const Params& p, int set, int pi, unsigned char* smem) {
    const int Ls = set ? LC : L, S = set ? FS_CTX : FS_LAT, N = 1 << (2 * S);
    const int gi = tidx() >> 8, g = tidx() & 255, idx = pi * 2 + gi, o = idx >> 9, c = idx & 511;
    cf2* buf = (cf2*)smem + (size_t)gi * N;
    const float* hraw = (const float*)(p.ws + WS_F + (set ? F_HRAW_CTX : F_HRAW_LAT));
    const float* hyn = (const float*)(p.ws + WS_F + (set ? F_HYP_CTX : F_HYP_LAT));
    float nsum = 0.f;
    for (int ch = 0; ch < Ls / 64; ++ch) nsum += hyn[(size_t)ch * 2048 + o * 1024 + c] + hyn[(size_t)ch * 2048 + o * 1024 + 512 + c];
    const float inv = 1.f / nsum;
    const float* hf = hraw + (size_t)(o * 1024 + c) * Ls; const float* hb = hraw + (size_t)(o * 1024 + 512 + c) * Ls;
#pragma unroll 4
    for (int k = g; k < N; k += 256) { float re = 0.f; if (k < Ls) re = hf[k] * inv; else if (k > N - Ls) re = hb[N - k] * inv; cf2 v; v.x = re; v.y = 0.f; buf[fsw(k)] = v; }
    __syncthreads();
    fft_fwd(buf, S, g, 256);
    cf2* HF = (cf2*)(p.ws + WS_F + (set ? F_HF_CTX : F_HF_LAT)) + (size_t)(o * 512 + c) * N;
    for (int k = g; k < N; k += 256) HF[k] = buf[fsw(k)];
    __syncthreads();
}
constexpr int P1_NORM = T / 8, P1_HF = 512;
DEV void phase1(const Params& p, unsigned char* smem) {
    const int total = P1_NORM + 2 * P1_HF;
    for (int it = blockIdx.x; it < total; it += gridDim.x) {
        if (it < P1_NORM) norm_rows_item(p, it, 1, p.in[I_N1G], 0, 0);
        else if (it < P1_NORM + P1_HF) hf_item(p, 0, it - P1_NORM, smem);
        else hf_item(p, 1, it - P1_NORM - P1_HF, smem);
    }
}

constexpr int G_LDA = 72;
template <class Epi>
DEV void gemm_tile(const bf16_t* __restrict__ A, const bf16_t* __restrict__ Wt, int m0, int n0, unsigned char* smem, const Epi& epi, int var = 0) {
    bf16_t* As = (bf16_t*)smem;
    bf16_t* Bs = As + 2 * 256 * G_LDA;
    const int tid = tidx(), lane = tid & 63, w = tid >> 6, wm = w >> 1, wn = w & 1;
    f32x16 acc[2][2];
#pragma unroll
    for (int i = 0; i < 2; ++i)
#pragma unroll
        for (int j = 0; j < 2; ++j)
#pragma unroll
            for (int r = 0; r < 16; ++r) acc[i][j][r] = 0.f;
    u32x4 ra[4], rb[2];
    const bf16_t* Ag = A + (size_t)m0 * 1024; const bf16_t* Bg = Wt + (size_t)n0 * 1024;
#define GLOAD(k0) do { \
        _Pragma("unroll") for (int i = 0; i < 4; ++i) { const int id = tid + NT * i, row = id >> 3, kc = id & 7; ra[i] = *(const u32x4*)(Ag + (size_t)row * 1024 + (k0) + kc * 8); } \
        _Pragma("unroll") for (int i = 0; i < 2; ++i) { const int id = tid + NT * i, row = id >> 3, kc = id & 7; rb[i] = *(const u32x4*)(Bg + (size_t)row * 1024 + (k0) + kc * 8); } } while (0)
#define LSTORE(buf_) do { \
        _Pragma("unroll") for (int i = 0; i < 4; ++i) { const int id = tid + NT * i, row = id >> 3, kc = id & 7; *(u32x4*)(As + ((buf_) * 256 + row) * G_LDA + kc * 8) = ra[i]; } \
        _Pragma("unroll") for (int i = 0; i < 2; ++i) { const int id = tid + NT * i, row = id >> 3, kc = id & 7; *(u32x4*)(Bs + ((buf_) * 128 + row) * G_LDA + kc * 8) = rb[i]; } } while (0)
    GLOAD(0); LSTORE(0); __syncthreads();
    for (int kt = 0; kt < (var == 2 ? 1 : 16); ++kt) {
        const int buf = kt & 1;
        if (kt + 1 < 16) GLOAD((kt + 1) * 64);
        const bf16_t* as = As + (buf * 256 + wm * 64 + (lane & 31)) * G_LDA + 8 * (lane >> 5);
        const bf16_t* bs = Bs + (buf * 128 + wn * 64 + (lane & 31)) * G_LDA + 8 * (lane >> 5);
#pragma unroll
        for (int kk = 0; kk < 4; ++kk) {
            const bf16x8 a0 = *(const bf16x8*)(as + kk * 16), a1 = *(const bf16x8*)(as + 32 * G_LDA + kk * 16);
            const bf16x8 b0 = *(const bf16x8*)(bs + kk * 16), b1 = *(const bf16x8*)(bs + 32 * G_LDA + kk * 16);
            acc[0][0] = __builtin_amdgcn_mfma_f32_32x32x16_bf16(a0, b0, acc[0][0], 0, 0, 0);
            acc[0][1] = __builtin_amdgcn_mfma_f32_32x32x16_bf16(a0, b1, acc[0][1], 0, 0, 0);
            acc[1][0] = __builtin_amdgcn_mfma_f32_32x32x16_bf16(a1, b0, acc[1][0], 0, 0, 0);
            acc[1][1] = __builtin_amdgcn_mfma_f32_32x32x16_bf16(a1, b1, acc[1][1], 0, 0, 0);
        }
        if (kt + 1 < 16) LSTORE(buf ^ 1);
        __syncthreads();
    }
#ifndef HOST_EMU
    if (var == 1) { asm volatile("" :: "v"(acc[0][0]), "v"(acc[0][1]), "v"(acc[1][0]), "v"(acc[1][1])); return; }
#endif
#pragma unroll
    for (int mi = 0; mi < 2; ++mi)
#pragma unroll
        for (int ni = 0; ni < 2; ++ni)
#pragma unroll
            for (int rg = 0; rg < 4; ++rg) {
                const int row = m0 + wm * 64 + mi * 32 + 8 * rg + 4 * (lane >> 5), col = n0 + wn * 64 + ni * 32 + (lane & 31);
                epi(row, col, acc[mi][ni][rg * 4 + 0], acc[mi][ni][rg * 4 + 1], acc[mi][ni][rg * 4 + 2], acc[mi][ni][rg * 4 + 3]);
            }
}
template <class Epi>
DEV void gemm_tile256(const bf16_t* __restrict__ A, const bf16_t* __restrict__ Wt, int m0, int n0, unsigned char* smem, const Epi& epi) {
    bf16_t* As = (bf16_t*)smem;
    bf16_t* Bs = As + 2 * 256 * G_LDA;
    const int tid = tidx(), lane = tid & 63, w = tid >> 6, wm = w >> 2, wn = w & 3;
    f32x16 acc[4][2];
#pragma unroll
    for (int i = 0; i < 4; ++i)
#pragma unroll
        for (int j = 0; j < 2; ++j)
#pragma unroll
            for (int r = 0; r < 16; ++r) acc[i][j][r] = 0.f;
    u32x4 ra[4], rb[4];
    const bf16_t* Ag = A + (size_t)m0 * 1024; const bf16_t* Bg = Wt + (size_t)n0 * 1024;
#define GLOAD2(k0) do { \
        _Pragma("unroll") for (int i = 0; i < 4; ++i) { const int id = tid + NT * i, row = id >> 3, kc = id & 7; ra[i] = *(const u32x4*)(Ag + (size_t)row * 1024 + (k0) + kc * 8); rb[i] = *(const u32x4*)(Bg + (size_t)row * 1024 + (k0) + kc * 8); } } while (0)
#define LSTORE2(buf_) do { \
        _Pragma("unroll") for (int i = 0; i < 4; ++i) { const int id = tid + NT * i, row = id >> 3, kc = id & 7; *(u32x4*)(As + ((buf_) * 256 + row) * G_LDA + kc * 8) = ra[i]; *(u32x4*)(Bs + ((buf_) * 256 + row) * G_LDA + kc * 8) = rb[i]; } } while (0)
    GLOAD2(0); LSTORE2(0); __syncthreads();
    for (int kt = 0; kt < 16; ++kt) {
        const int buf = kt & 1;
        if (kt + 1 < 16) GLOAD2((kt + 1) * 64);
        const bf16_t* as = As + (buf * 256 + wm * 128 + (lane & 31)) * G_LDA + 8 * (lane >> 5);
        const bf16_t* bs = Bs + (buf * 256 + wn * 64 + (lane & 31)) * G_LDA + 8 * (lane >> 5);
#pragma unroll
        for (int kk = 0; kk < 4; ++kk) {
            bf16x8 af[4], bfr[2];
#pragma unroll
            for (int i = 0; i < 4; ++i) af[i] = *(const bf16x8*)(as + i * 32 * G_LDA + kk * 16);
#pragma unroll
            for (int j = 0; j < 2; ++j) bfr[j] = *(const bf16x8*)(bs + j * 32 * G_LDA + kk * 16);
#pragma unroll
            for (int i = 0; i < 4; ++i)
#pragma unroll
                for (int j = 0; j < 2; ++j) acc[i][j] = __builtin_amdgcn_mfma_f32_32x32x16_bf16(af[i], bfr[j], acc[i][j], 0, 0, 0);
        }
        if (kt + 1 < 16) LSTORE2(buf ^ 1);
        __syncthreads();
    }
#undef GLOAD2
#undef LSTORE2
#pragma unroll
    for (int mi = 0; mi < 4; ++mi)
#pragma unroll
        for (int ni = 0; ni < 2; ++ni)
#pragma unroll
            for (int rg = 0; rg < 4; ++rg) {
                const int row = m0 + wm * 128 + mi * 32 + 8 * rg + 4 * (lane >> 5), col = n0 + wn * 64 + ni * 32 + (lane & 31);
                epi(row, col, acc[mi][ni][rg * 4 + 0], acc[mi][ni][rg * 4 + 1], acc[mi][ni][rg * 4 + 2], acc[mi][ni][rg * 4 + 3]);
            }
}
namespace pg8 {
#ifndef HOST_EMU
#define PG8_LAS __attribute__((address_space(3)))
#else
#define PG8_LAS
#endif
typedef unsigned short bf16_t;
constexpr int BM = 256, BK = 64, HALF = 128, HTB = HALF * BK * 2  , STAGE_BYTES = 8 * HTB, NXCD = 8, WGM = 8;

__host__ __device__ __forceinline__ int lds_byte(int r, int c) { const int st = (r >> 4) * 2 + (c >> 5), rr = r & 15, cc = c & 31, ob = rr * 64 + cc * 2; return st * 1024 + (ob ^ (((ob >> 9) & 1) << 5)); }
__host__ __device__ __forceinline__ void stage_rc(int b, int& R, int& C) { const int st = b / 1024, sb = b % 1024, swz = sb ^ (((sb >> 9) & 1) << 5); R = (st >> 1) * 16 + swz / 64; C = (st & 1) * 32 + (swz % 64) / 2; }
__host__ __device__ __forceinline__ int perm32(int rho) { const int n = rho >> 4, i = rho & 15; return 8 * (i >> 2) + 4 * n + (i & 3); }

struct Unit { int pm, pn; };
struct Gemm { const bf16_t* A; const bf16_t* Bt; int M, N, K; };

struct StaticOrder {
    int nM, nN, nwg, G, c;
    __host__ __device__ void init(int M, int N, int G_, int c_) { nM = M / BM; nN = N / BM; nwg = nM * nN; G = G_; c = c_; }
    __host__ __device__ bool next(int i, Unit& u) const {
        const long L = (long)i * G + c; if (L >= nwg) return false;
        int wgid = (int)L; { const int q = nwg / NXCD, r = nwg % NXCD, xcd = wgid % NXCD, off = wgid / NXCD; wgid = (xcd < r ? xcd * (q + 1) : r * (q + 1) + (xcd - r) * q) + off; }
        const int nig = WGM * nN, gid = wgid / nig, fm = gid * WGM, gsz = (nM - fm) < WGM ? (nM - fm) : WGM;
        u.pm = fm + ((wgid % nig) % gsz); u.pn = (wgid % nig) / gsz; return true;
    }
    __device__ __forceinline__ void a_ready(const Unit&) const {}
    __device__ __forceinline__ void done(const Unit&) const {}
};
template <class Epi, class Sched, bool STAMP = false>
__device__ __forceinline__ void gemm_phase(PG8_LAS unsigned char* lds, const Gemm g, const Sched& S, const Epi& E, unsigned long long* stamps = nullptr) {
    const int tid = tidx(), wid = __builtin_amdgcn_readfirstlane(tid >> 6), lane = tid & 63, wr = wid >> 2, wc = wid & 3, fr = lane & 15, fq = lane >> 4;
    const int K = g.K, nt = K / BK;
    int ts_lo = 0, ts_hi = 0, nts = 0; const unsigned long long rt_entry = 0ull; (void)rt_entry; (void)ts_lo; (void)ts_hi; (void)nts;
#define PG8_STAMP() do { if (STAMP && wid == 0 && nts < 64) { const unsigned long long _c = 0ull; \
        ts_lo = (lane == nts) ? (int)(unsigned)_c : ts_lo; ts_hi = (lane == nts) ? (int)(unsigned)(_c >> 32) : ts_hi; ++nts; } } while (0)
    PG8_STAMP();
    unsigned voffA[2], voffB[2];
#pragma unroll
    for (int i = 0; i < 2; ++i) { int R, C; stage_rc(tid * 16 + i * 8192, R, C); const int Rb = Epi::PERM ? ((R & ~31) + perm32(R & 31)) : R;
        voffA[i] = (unsigned)(R * K + C) * 2u; voffB[i] = (unsigned)(Rb * K + C) * 2u; }
    const size_t kstep = (size_t)(BK * 2);
    const size_t hstep = (size_t)HALF * K * 2;
    const size_t tstep = 2 * hstep;
    const unsigned ldsw = (unsigned)wid * 1024u;
    const int aoff = lds_byte(wr * 64 + fr, fq * 8), boff = lds_byte(wc * 32 + fr, fq * 8);
#define PG8_SA(b, h) (((b) * 2 + (h)) * HTB)
#define PG8_SB(b, h) ((4 + (b) * 2 + (h)) * HTB)
#define PG8_STAGE(bufoff, gbase, voff) do { _Pragma("unroll") for (int _i = 0; _i < 2; ++_i) \
        __builtin_amdgcn_global_load_lds((const unsigned*)((const char*)(gbase) + (voff)[_i]), (PG8_LAS unsigned*)(lds + (bufoff) + ldsw + _i * 8192), 16, 0, 0); } while (0)
#define PG8_LDA(dst, b, h) do { _Pragma("unroll") for (int m = 0; m < 4; ++m) _Pragma("unroll") for (int k = 0; k < 2; ++k) dst[m][k] = *(const PG8_LAS bf16x8*)(lds + PG8_SA(b, h) + aoff + m * 2048 + k * 1024); } while (0)
#define PG8_LDB(dst, b, h) do { _Pragma("unroll") for (int n = 0; n < 2; ++n) _Pragma("unroll") for (int k = 0; k < 2; ++k) dst[n][k] = *(const PG8_LAS bf16x8*)(lds + PG8_SB(b, h) + boff + n * 2048 + k * 1024); } while (0)
#define PG8_MMA(ai, bj, At, Bt) do { __builtin_amdgcn_s_setprio(1); _Pragma("unroll") for (int m = 0; m < 4; ++m) _Pragma("unroll") for (int n = 0; n < 2; ++n) _Pragma("unroll") for (int k = 0; k < 2; ++k) \
        acc[ai][bj][m][n] = __builtin_amdgcn_mfma_f32_16x16x32_bf16(Bt[n][k], At[m][k], acc[ai][bj][m][n], 0, 0, 0); __builtin_amdgcn_s_setprio(0); } while (0)
#ifndef HOST_EMU
#define PG8_WAIT_V(n) asm volatile("s_waitcnt vmcnt(" #n ")" ::: "memory")
#define PG8_WAIT_L(n) asm volatile("s_waitcnt lgkmcnt(" #n ")" ::: "memory")
#else
#define PG8_WAIT_V(n) do {} while (0)
#define PG8_WAIT_L(n) do {} while (0)
#endif
#define PG8_BAR __builtin_amdgcn_s_barrier()
#define PG8_SCHED __builtin_amdgcn_sched_barrier(0)
    Unit cur, nxt; int ui = 0;
    if (!S.next(0, cur)) return;
    f32x4 acc[2][2][4][2];
#pragma unroll
    for (int a = 0; a < 2; ++a)
#pragma unroll
        for (int b = 0; b < 2; ++b)
#pragma unroll
            for (int m = 0; m < 4; ++m)
#pragma unroll
                for (int n = 0; n < 2; ++n) acc[a][b][m][n] = (f32x4){0.f, 0.f, 0.f, 0.f};
    bf16x8 At[4][2], B0[2][2], B1[2][2];
    const char* cA = (const char*)g.A + (size_t)cur.pm * tstep; const char* cB = (const char*)g.Bt + (size_t)cur.pn * tstep;
    S.a_ready(cur);
    PG8_STAGE(PG8_SB(0, 0), cB, voffB); PG8_STAGE(PG8_SA(0, 0), cA, voffA); PG8_STAGE(PG8_SB(0, 1), cB + hstep, voffB); PG8_STAGE(PG8_SA(0, 1), cA + hstep, voffA);
    if (wr == 1) PG8_BAR;
    PG8_WAIT_V(4); PG8_BAR;
    PG8_STAGE(PG8_SB(1, 0), cB + kstep, voffB); PG8_STAGE(PG8_SA(1, 0), cA + kstep, voffA); PG8_STAGE(PG8_SB(1, 1), cB + hstep + kstep, voffB);
    PG8_WAIT_V(6); PG8_BAR;
    PG8_STAMP();
    for (;;) {
        const bool has_next = S.next(ui + 1, nxt);
        const char* nA = has_next ? (const char*)g.A + (size_t)nxt.pm * tstep : cA; const char* nB = has_next ? (const char*)g.Bt + (size_t)nxt.pn * tstep : cB;
        for (int t = 0; t < nt; t += 2) {
            const bool last = (t == nt - 2);
            const char* a1 = cA + (size_t)(t + 1) * kstep;
            const char* a2 = last ? nA : cA + (size_t)(t + 2) * kstep; const char* b2 = last ? nB : cB + (size_t)(t + 2) * kstep;
            const char* a3 = a2 + kstep; const char* b3 = b2 + kstep;
            if (last && has_next) S.a_ready(nxt);
            PG8_LDB(B0, 0, 0); PG8_SCHED; PG8_LDA(At, 0, 0); PG8_STAGE(PG8_SA(1, 1), a1 + hstep, voffA);
            PG8_WAIT_L(8); PG8_BAR; PG8_WAIT_L(0); PG8_MMA(0, 0, At, B0); PG8_BAR; PG8_SCHED;
            PG8_LDB(B1, 0, 1); PG8_STAGE(PG8_SB(0, 0), b2, voffB);
            PG8_BAR; PG8_WAIT_L(0); PG8_MMA(0, 1, At, B1); PG8_BAR;
            PG8_LDA(At, 0, 1); PG8_STAGE(PG8_SA(0, 0), a2, voffA);
            PG8_BAR; PG8_WAIT_L(0); PG8_MMA(1, 0, At, B0); PG8_BAR; PG8_SCHED;
            PG8_STAGE(PG8_SB(0, 1), b2 + hstep, voffB);
            PG8_WAIT_V(6); PG8_BAR; PG8_MMA(1, 1, At, B1); PG8_BAR;
            PG8_LDB(B0, 1, 0); PG8_SCHED; PG8_LDA(At, 1, 0); PG8_STAGE(PG8_SA(0, 1), a2 + hstep, voffA);
            PG8_WAIT_L(8); PG8_BAR; PG8_WAIT_L(0); PG8_MMA(0, 0, At, B0); PG8_BAR; PG8_SCHED;
            PG8_LDB(B1, 1, 1); PG8_STAGE(PG8_SB(1, 0), b3, voffB);
            PG8_BAR; PG8_WAIT_L(0); PG8_MMA(0, 1, At, B1); PG8_BAR;
            PG8_LDA(At, 1, 1); PG8_STAGE(PG8_SA(1, 0), a3, voffA);
            PG8_BAR; PG8_WAIT_L(0); PG8_MMA(1, 0, At, B0); PG8_BAR; PG8_SCHED;
            PG8_STAGE(PG8_SB(1, 1), b3 + hstep, voffB);
            PG8_WAIT_V(6); PG8_BAR; PG8_MMA(1, 1, At, B1); PG8_BAR;
        }
        PG8_STAMP();
        if constexpr (!Epi::AFTER_DRAIN) { E(acc, cur, wr, wc, fr, fq); S.done(cur); }
        PG8_STAMP();
        if (!has_next) break;
#pragma unroll
        for (int a = 0; a < 2; ++a)
#pragma unroll
            for (int b = 0; b < 2; ++b)
#pragma unroll
                for (int m = 0; m < 4; ++m)
#pragma unroll
                    for (int n = 0; n < 2; ++n) acc[a][b][m][n] = (f32x4){0.f, 0.f, 0.f, 0.f};
        cur = nxt; cA = nA; cB = nB; ++ui;
    }
    PG8_WAIT_V(0);
    if (wr == 0) PG8_BAR;
    PG8_BAR;
    if constexpr (Epi::AFTER_DRAIN) { E.fused(acc, cur, wr, wc, fr, fq, lds, wid, lane); S.done(cur); }
    PG8_STAMP();
    if (STAMP && wid == 0) { stamps[lane] = lane < nts ? (((unsigned long long)(unsigned)ts_hi << 32) | (unsigned)ts_lo) : 0ull;
        if (lane == 62) stamps[62] = rt_entry; if (lane == 63) stamps[63] = 0ull; }
#undef PG8_STAMP
#undef PG8_SA
#undef PG8_SB
#undef PG8_STAGE
#undef PG8_LDA
#undef PG8_LDB
#undef PG8_MMA
#undef PG8_WAIT_V
#undef PG8_WAIT_L
#undef PG8_BAR
#undef PG8_SCHED
}
}
template <class Epi> struct PgEpiT {
    static constexpr bool PERM = true, AFTER_DRAIN = false;
    Epi e;
    DEV void operator()(const f32x4 (&acc)[2][2][4][2], const pg8::Unit& u, int wr, int wc, int fr, int fq) const {
        float pre[2][4];
#pragma unroll
        for (int ai = 0; ai < 2; ++ai)
#pragma unroll
            for (int m = 0; m < 4; ++m) pre[ai][m] = e.colpre(u.pm * 256 + ai * 128 + wr * 64 + m * 16 + fr);
#pragma unroll
        for (int ai = 0; ai < 2; ++ai)
#pragma unroll
            for (int m = 0; m < 4; ++m) {
#pragma unroll
                for (int bj = 0; bj < 2; ++bj) {
                    const int wcol = u.pm * 256 + ai * 128 + wr * 64 + m * 16 + fr, tok0 = u.pn * 256 + bj * 128 + wc * 32 + 8 * fq;
                    const float v[8] = {acc[ai][bj][m][0][0], acc[ai][bj][m][0][1], acc[ai][bj][m][0][2], acc[ai][bj][m][0][3], acc[ai][bj][m][1][0], acc[ai][bj][m][1][1], acc[ai][bj][m][1][2], acc[ai][bj][m][1][3]};
                    e.tok8(tok0, wcol, v, pre[ai][m]);
                }
                SCHED_FENCE();
            }
    }
};
template <class Epi> struct PgEpiN {
    static constexpr bool PERM = true, AFTER_DRAIN = false;
    Epi e;
    DEV void operator()(const f32x4 (&acc)[2][2][4][2], const pg8::Unit& u, int wr, int wc, int fr, int fq) const {
#pragma unroll
        for (int ai = 0; ai < 2; ++ai)
#pragma unroll
            for (int m = 0; m < 4; ++m) {
#pragma unroll
                for (int bj = 0; bj < 2; ++bj) {
                    const int tok = u.pm * 256 + ai * 128 + wr * 64 + m * 16 + fr, wcol0 = u.pn * 256 + bj * 128 + wc * 32 + 8 * fq;
                    const float v[8] = {acc[ai][bj][m][0][0], acc[ai][bj][m][0][1], acc[ai][bj][m][0][2], acc[ai][bj][m][0][3], acc[ai][bj][m][1][0], acc[ai][bj][m][1][1], acc[ai][bj][m][1][2], acc[ai][bj][m][1][3]};
                    e.col8(tok, wcol0, v);
                }
                SCHED_FENCE();
            }
    }
};
template <class Epi>
DEV void gemm_pg8_T(const bf16_t* A, const bf16_t* Wt, int Mtok, int N, unsigned char* smem, const Epi& epi) {
    pg8::Gemm g{Wt, A, N, Mtok, 1024};
    pg8::StaticOrder S; S.init(N, Mtok, (int)gridDim.x, (int)blockIdx.x);
    PgEpiT<Epi> E{epi};
    pg8::gemm_phase<PgEpiT<Epi>, pg8::StaticOrder, false>((PG8_LAS unsigned char*)smem, g, S, E);
    __syncthreads();
}
template <class Epi>
DEV void gemm_pg8_N(const bf16_t* A, const bf16_t* Wt, int Mtok, int N, unsigned char* smem, const Epi& epi) {
    pg8::Gemm g{A, Wt, Mtok, N, 1024};
    pg8::StaticOrder S; S.init(Mtok, N, (int)gridDim.x, (int)blockIdx.x);
    PgEpiN<Epi> E{epi};
    pg8::gemm_phase<PgEpiN<Epi>, pg8::StaticOrder, false>((PG8_LAS unsigned char*)smem, g, S, E);
    __syncthreads();
}
struct EpiL0In {
    unsigned char* ws;
    DEV void operator()(int row, int col, float v0, float v1, float v2, float v3) const {
        u32x2 o; o[0] = pk2(v0, v1); o[1] = pk2(v2, v3);
        const bool lat = row < TL; const int b = lat ? row / L : (row - TL) / LC, t = lat ? row - b * L : (row - TL) - b * LC, Lx = lat ? L : LC;
        const int cu = __builtin_amdgcn_readfirstlane(col & ~127);
        if (cu < 1536) { bf16_t* d = (bf16_t*)(ws + WS_P + (lat ? P_HYT_LAT : P_HYT_CTX)) + ((size_t)b * 1536 + col) * Lx + t; *(u32x2*)d = o; }
        else if (cu < 2048) { bf16_t* d = (bf16_t*)(ws + WS_P + P_Q0) + (size_t)row * 512 + (col - 1536); d[0] = (bf16_t)f2bf(v0); d[512] = (bf16_t)f2bf(v1); d[1024] = (bf16_t)f2bf(v2); d[1536] = (bf16_t)f2bf(v3); }
        else if (cu < 2176) { bf16_t* d = (bf16_t*)(ws + WS_P + P_K0) + (size_t)row * 128 + (col - 2048); d[0] = (bf16_t)f2bf(v0); d[128] = (bf16_t)f2bf(v1); d[256] = (bf16_t)f2bf(v2); d[384] = (bf16_t)f2bf(v3); }
        else { bf16_t* d = (bf16_t*)(ws + WS_P + (lat ? P_VT_LAT : P_VT_CTX)) + ((size_t)b * 128 + (col - 2176)) * Lx + t; *(u32x2*)d = o; }
    }
};
struct EpiL0InT {
    unsigned char* ws;
    DEV float colpre(int) const { return 0.f; }
    DEV void tok8(int row, int col, const float (&v)[8], float) const {
        const bool lat = row < TL; const int b = lat ? row / L : (row - TL) / LC, t = lat ? row - b * L : (row - TL) - b * LC, Lx = lat ? L : LC;
        u32x4 o; o[0] = pk2(v[0], v[1]); o[1] = pk2(v[2], v[3]); o[2] = pk2(v[4], v[5]); o[3] = pk2(v[6], v[7]);
        if (col < 1536) { *(u32x4*)((bf16_t*)(ws + WS_P + (lat ? P_HYT_LAT : P_HYT_CTX)) + ((size_t)b * 1536 + col) * Lx + t) = o; }
        else if (col < 2048) { bf16_t* d = (bf16_t*)(ws + WS_P + P_Q0) + (size_t)row * 512 + (col - 1536);
#pragma unroll
            for (int i = 0; i < 8; ++i) d[i * 512] = (bf16_t)f2bf(v[i]); }
        else if (col < 2176) { bf16_t* d = (bf16_t*)(ws + WS_P + P_K0) + (size_t)row * 128 + (col - 2048);
#pragma unroll
            for (int i = 0; i < 8; ++i) d[i * 128] = (bf16_t)f2bf(v[i]); }
        else { *(u32x4*)((bf16_t*)(ws + WS_P + (lat ? P_VT_LAT : P_VT_CTX)) + ((size_t)b * 128 + (col - 2176)) * Lx + t) = o; }
    }
};
struct EpiBf16 {
    bf16_t* out; int ld;
    DEV void col8(int row, int col0, const float (&v)[8]) const { u32x4 o; o[0] = pk2(v[0], v[1]); o[1] = pk2(v[2], v[3]); o[2] = pk2(v[4], v[5]); o[3] = pk2(v[6], v[7]); *(u32x4*)(out + (size_t)row * ld + col0) = o; }
    DEV void operator()(int row, int col, float v0, float v1, float v2, float v3) const {
        bf16_t* d = out + (size_t)row * ld + col; d[0] = (bf16_t)f2bf(v0); d[ld] = (bf16_t)f2bf(v1); d[2 * ld] = (bf16_t)f2bf(v2); d[3 * ld] = (bf16_t)f2bf(v3);
    }
};
struct EpiHg {
    unsigned char* ws; const float* lg;
    DEV void operator()(int row, int col, float v0, float v1, float v2, float v3) const {
        float vv[4] = {v0, v1, v2, v3};
        const bool lat = row < TL; const int b = lat ? row / L : (row - TL) / LC, t = lat ? row - b * L : (row - TL) - b * LC, Lx = lat ? L : LC;
        const int cu = __builtin_amdgcn_readfirstlane(col & ~255);
        if (cu >= 3072 && cu < 4096) {
            bf16_t* d = (bf16_t*)(ws + WS_M) + (lat ? (size_t)0 : (size_t)NB * 1024 * L) + ((size_t)b * 1024 + (col - 3072)) * Lx + t;
            u32x2 o; o[0] = pk2(v0, v1); o[1] = pk2(v2, v3); *(u32x2*)d = o;
            return;
        }
        if (cu < 1024 || cu >= 4096) {
#pragma unroll
            for (int i = 0; i < 4; ++i) vv[i] = silu_f(vv[i]);
        } else {
            const int c = col - 1024;
            const float oml = 1.f - 1.f / (1.f + __expf(lg[c] - lg[2048 + c]));
#pragma unroll
            for (int i = 0; i < 4; ++i) vv[i] = oml * __builtin_amdgcn_rcpf(1.f + __expf(vv[i]));
        }
        if (cu < 3072) {
            bf16_t* d = (bf16_t*)(ws + WS_P + (lat ? P1_KQT_LAT : P1_KQT_CTX)) + ((size_t)b * 3072 + col) * Lx + t;
            u32x2 o; o[0] = pk2(vv[0], vv[1]); o[1] = pk2(vv[2], vv[3]); *(u32x2*)d = o;
        } else {
            if (!lat) return;
            bf16_t* d = (bf16_t*)(ws + WS_P + P1_G) + (size_t)row * 1024 + (col - 4096); d[0] = (bf16_t)f2bf(vv[0]); d[1024] = (bf16_t)f2bf(vv[1]); d[2048] = (bf16_t)f2bf(vv[2]); d[3072] = (bf16_t)f2bf(vv[3]);
        }
    }
};
struct EpiHgT {
    unsigned char* ws; const float* lg; int plain;
    DEV float colpre(int col) const {
        const int cu = __builtin_amdgcn_readfirstlane(col & ~255);
        if (cu < 1024 || cu >= 3072) return 0.f;
        const int c = col - 1024; return 1.f - __builtin_amdgcn_rcpf(1.f + __expf(lg[c] - lg[2048 + c]));
    }
    DEV void tok8(int row, int col, const float (&v)[8], float oml) const {
        const bool lat = row < TL; const int b = lat ? row / L : (row - TL) / LC, t = lat ? row - b * L : (row - TL) - b * LC, Lx = lat ? L : LC;
        const int cu = __builtin_amdgcn_readfirstlane(col & ~255);
        float vv[8];
#pragma unroll
        for (int i = 0; i < 8; ++i) vv[i] = v[i];
        if (cu >= 3072 && cu < 4096) {
            u32x4 o; o[0] = pk2(vv[0], vv[1]); o[1] = pk2(vv[2], vv[3]); o[2] = pk2(vv[4], vv[5]); o[3] = pk2(vv[6], vv[7]);
            *(u32x4*)((bf16_t*)(ws + WS_M) + (lat ? (size_t)0 : (size_t)NB * 1024 * L) + ((size_t)b * 1024 + (col - 3072)) * Lx + t) = o;
            return;
        }
        if (plain) {} else if (cu < 1024 || cu >= 4096) {
#pragma unroll
            for (int i = 0; i < 8; ++i) vv[i] = silu_f(vv[i]);
        } else {
#pragma unroll
            for (int i = 0; i < 8; ++i) vv[i] = oml * __builtin_amdgcn_rcpf(1.f + __expf(vv[i]));
        }
        if (cu < 3072) {
            u32x4 o; o[0] = pk2(vv[0], vv[1]); o[1] = pk2(vv[2], vv[3]); o[2] = pk2(vv[4], vv[5]); o[3] = pk2(vv[6], vv[7]);
            *(u32x4*)((bf16_t*)(ws + WS_P + (lat ? P1_KQT_LAT : P1_KQT_CTX)) + ((size_t)b * 3072 + col) * Lx + t) = o;
        } else {
            if (!lat) return;
            bf16_t* d = (bf16_t*)(ws + WS_P + P1_G) + (size_t)row * 1024 + (col - 4096);
#pragma unroll
            for (int i = 0; i < 8; ++i) d[i * 1024] = (bf16_t)f2bf(vv[i]);
        }
    }
};
struct EpiRes {
    const Params* p; int from_inputs, layer, goff;
    DEV void col8(int row, int col0, const float (&v)[8]) const {
        float* H = (float*)(p->ws + WS_H) + (size_t)row * 1024 + col0; const float* hin = h_row(*p, from_inputs, row) + col0;
        const float* gt = (const float*)(p->ws + WS_MOD) + ((size_t)layer * NR + mod_row(row)) * 6144 + goff + col0;
        const f32x4 h0 = *(const f32x4*)hin, h1 = *(const f32x4*)(hin + 4), g0 = *(const f32x4*)gt, g1 = *(const f32x4*)(gt + 4);
        f32x4 o0, o1;
#pragma unroll
        for (int i = 0; i < 4; ++i) { o0[i] = h0[i] + g0[i] * v[i]; o1[i] = h1[i] + g1[i] * v[4 + i]; }
        *(f32x4*)H = o0; *(f32x4*)(H + 4) = o1;
    }
    DEV void operator()(int row, int col, float v0, float v1, float v2, float v3) const {
        float* H = (float*)(p->ws + WS_H) + (size_t)row * 1024 + col;
        const float* hin = h_row(*p, from_inputs, row) + col;
        const float gt = ((const float*)(p->ws + WS_MOD))[((size_t)layer * NR + mod_row(row)) * 6144 + goff + col];
        const float h0 = hin[0], h1 = hin[1024], h2 = hin[2048], h3 = hin[3072];
        H[0] = h0 + gt * v0; H[1024] = h1 + gt * v1; H[2048] = h2 + gt * v2; H[3072] = h3 + gt * v3;
    }
};

struct HyRaw { u32x4 mid; unsigned short lft, rgt; };
DEV HyRaw hy_load(const bf16_t* row, int t0, int Lx) { HyRaw r; r.mid = *(const u32x4*)(row + t0); r.lft = t0 > 0 ? row[t0 - 1] : (unsigned short)0; r.rgt = t0 + 8 < Lx ? row[t0 + 8] : (unsigned short)0; return r; }
DEV void hy_conv8(const HyRaw& r, float w0, float w1, float w2, float b, float (&o)[8]) {
    float x[10]; x[0] = bf2f(r.lft); x[9] = bf2f(r.rgt);
#pragma unroll
    for (int i = 0; i < 4; ++i) { x[1 + 2 * i] = bflo(r.mid[i]); x[2 + 2 * i] = bfhi(r.mid[i]); }
#pragma unroll
    for (int i = 0; i < 8; ++i) o[i] = w0 * x[i] + w1 * x[i + 1] + w2 * x[i + 2] + b;
}
template <int TPC>
DEV void hyena_item(const Params& p, int set, int item, unsigned char* smem, bool nofft = false, bool nostore = false) {
    const int Ls = set ? LC : L, S = set ? FS_CTX : FS_LAT, N = 1 << (2 * S);
    constexpr int CPR = NT / TPC, NR8 = 8 / CPR;
    const int gi = tidx() / TPC, g = tidx() % TPC;
    const int bp = item >> 6, c0 = (item & 63) * 8, ba = bp * 2, bb = ba + 1;
    cf2* buf = (cf2*)smem + (size_t)gi * N;
    bf16_t* stg = (bf16_t*)(smem + (size_t)CPR * N * 8);
    const bf16_t* hy = (const bf16_t*)(p.ws + WS_P + (set ? P_HYT_CTX : P_HYT_LAT));
    const float* cw = p.in[I_HYCW]; const float* cb = p.in[I_HYCB];
    const cf2* HF = (const cf2*)(p.ws + WS_F + (set ? F_HF_CTX : F_HF_LAT));
    const float invN = 1.f / (float)N;
    const int t0 = g * 8; const bool own = t0 < Ls;
    HyRaw rv[2], rx1[2];
    cf2 hfr[16];
#define HY_FETCH(cc) do { if (own) { \
        rv[0] = hy_load(hy + ((size_t)ba * 1536 + (cc)) * Ls, t0, Ls); rv[1] = hy_load(hy + ((size_t)bb * 1536 + (cc)) * Ls, t0, Ls); \
        rx1[0] = hy_load(hy + ((size_t)ba * 1536 + 512 + (cc)) * Ls, t0, Ls); rx1[1] = hy_load(hy + ((size_t)bb * 1536 + 512 + (cc)) * Ls, t0, Ls); } } while (0)
    HY_FETCH(c0 + gi);
#pragma unroll 1
    for (int rd = 0; rd < NR8; ++rd) {
        const int cs = rd * CPR + gi, c = c0 + cs;
#pragma unroll
        for (int u = 0; u < 16; ++u) { hfr[u].x = 0.f; hfr[u].y = 0.f; if (g + TPC * u < N) hfr[u] = HF[(size_t)c * N + g + TPC * u]; }
        float za[8], zb[8];
        if (own) { hy_conv8(rv[0], cw[c], cw[1536 + c], cw[3072 + c], cb[c], za); hy_conv8(rv[1], cw[c], cw[1536 + c], cw[3072 + c], cb[c], zb); }
        for (int t = g; t < N; t += TPC) { if (t >= Ls) { cf2 z; z.x = 0.f; z.y = 0.f; buf[fsw(t)] = z; } }
        if (own) {
#pragma unroll
            for (int i = 0; i < 8; ++i) { cf2 v; v.x = za[i]; v.y = zb[i]; buf[fsw(t0 + i)] = v; }
        }
        __syncthreads();
#pragma unroll
        for (int n = 0; n < 2; ++n) {
            if (!nofft) fft_fwd(buf, S, g, TPC);
#pragma unroll
            for (int u = 0; u < 16; ++u) { const int k = g + TPC * u; if (k < N) buf[fsw(k)] = cmul(buf[fsw(k)], hfr[u]); }
            if (n == 0) {
#pragma unroll
                for (int u = 0; u < 16; ++u) if (g + TPC * u < N) hfr[u] = HF[(size_t)(512 + c) * N + g + TPC * u];
            }
            __syncthreads();
            if (!nofft) fft_inv(buf, S, g, TPC);
            const int gc = (n + 1) * 512 + c;
            if (own) {
                const float w0 = cw[gc], w1 = cw[1536 + gc], w2 = cw[3072 + gc], b = cb[gc], dsk = p.in[I_HYSKIP][n * 512 + c];
                float ga[8], gb[8];
                hy_conv8(rx1[0], w0, w1, w2, b, ga); hy_conv8(rx1[1], w0, w1, w2, b, gb);
                if (n == 0) { rx1[0] = hy_load(hy + ((size_t)ba * 1536 + 1024 + c) * Ls, t0, Ls); rx1[1] = hy_load(hy + ((size_t)bb * 1536 + 1024 + c) * Ls, t0, Ls); }
#pragma unroll
                for (int i = 0; i < 8; ++i) { const cf2 cv = buf[fsw(t0 + i)]; za[i] = ga[i] * (cv.x * invN + dsk * za[i]); zb[i] = gb[i] * (cv.y * invN + dsk * zb[i]); }
            }
            if (n == 0) {
                __syncthreads();
                for (int t = g; t < N; t += TPC) { if (t >= Ls) { cf2 z; z.x = 0.f; z.y = 0.f; buf[fsw(t)] = z; } }
                if (own) {
#pragma unroll
                    for (int i = 0; i < 8; ++i) { cf2 v; v.x = za[i]; v.y = zb[i]; buf[fsw(t0 + i)] = v; }
                }
                __syncthreads();
            } else {
                if (rd + 1 < NR8) HY_FETCH(c0 + (rd + 1) * CPR + gi);
                if (own) {
#pragma unroll
                    for (int i = 0; i < 8; ++i) {
                        const int ra = t0 + i, rb = Ls + t0 + i;
                        stg[(size_t)(ra + (ra >> 3)) * 8 + cs] = (bf16_t)f2bf(za[i]); stg[(size_t)(rb + (rb >> 3)) * 8 + cs] = (bf16_t)f2bf(zb[i]); }
                }
            }
        }
        __syncthreads();
    }
#undef HY_FETCH
    if (!nostore) {
        bf16_t* M = (bf16_t*)(p.ws + WS_M);
        for (int i = tidx(); i < 2 * Ls; i += NT) {
            const int bsel = i >= Ls, t = bsel ? i - Ls : i, bx = bsel ? bb : ba;
            const size_t tok = set ? (size_t)TL + (size_t)bx * LC + t : (size_t)bx * L + t;
            *(u32x4*)(M + tok * 1024 + c0) = *(const u32x4*)(stg + (size_t)(i + (i >> 3)) * 8);
        }
    }
    __syncthreads();
}
DEV void rope_store(const bf16_t* src, bf16_t* dst, int pos, bool rope, float scale, int ph, int sub) {
    const u32x4 ua = *(const u32x4*)(src + ph * 32 + sub * 8), ub = *(const u32x4*)(src + ph * 32 + 16 + sub * 8);
    float a[8], b[8];
#pragma unroll
    for (int i = 0; i < 4; ++i) { a[2 * i] = bflo(ua[i]); a[2 * i + 1] = bfhi(ua[i]); b[2 * i] = bflo(ub[i]); b[2 * i + 1] = bfhi(ub[i]); }
    if (rope) {
        const float pv = (float)(ph == 0 ? pos / 64 : pos % 64);
#pragma unroll
        for (int e = 0; e < 8; ++e) {
            const float inv = exp2f(-(float)(sub * 8 + e) * (13.287712379549449f / 16.f));
            const float ang = pv * inv, cs = __cosf(ang), sn = __sinf(ang);
            const float na = a[e] * cs - b[e] * sn, nb = b[e] * cs + a[e] * sn; a[e] = na; b[e] = nb;
        }
    }
    u32x4 oa, ob;
#pragma unroll
    for (int i = 0; i < 4; ++i) { oa[i] = pk2(a[2 * i] * scale, a[2 * i + 1] * scale); ob[i] = pk2(b[2 * i] * scale, b[2 * i + 1] * scale); }
    *(u32x4*)(dst + ph * 32 + sub * 8) = oa; *(u32x4*)(dst + ph * 32 + 16 + sub * 8) = ob;
}
constexpr int A_LDQ = 72, A_LDV = 136;
DEV void attn_item(const Params& p, int set, int item, unsigned char* smem) {
    bf16_t* Qs = (bf16_t*)smem;
    bf16_t* Ks = Qs + 128 * A_LDQ;
    bf16_t* Vt = Ks + 128 * A_LDQ;
    const int tid = tidx(), lane = tid & 63, w = tid >> 6, l15 = lane & 15, lg = lane >> 4;
    const int nqb = set ? LC / 128 : L / 128;
    const int h = item & 7, qb = (item >> 3) % nqb, b = (item >> 3) / nqb, kvh = h >> 2;
    const bf16_t* Q0 = (const bf16_t*)(p.ws + WS_P + P_Q0); const bf16_t* K0 = (const bf16_t*)(p.ws + WS_P + P_K0);
    const int qtok0 = set ? TL + b * LC + qb * 128 : b * L + qb * 128;
    { const int row = tid >> 2, ph = (tid >> 1) & 1, sub = tid & 1;
      rope_store(Q0 + (size_t)(qtok0 + row) * 512 + h * 64, Qs + row * A_LDQ, qb * 128 + row, set == 0, 0.125f, ph, sub); }
    __syncthreads();
    bf16x8 qf[2];
    qf[0] = *(const bf16x8*)(Qs + (w * 16 + l15) * A_LDQ + 8 * lg); qf[1] = *(const bf16x8*)(Qs + (w * 16 + l15) * A_LDQ + 32 + 8 * lg);
    float m_run = p.in[I_SINK][h], l_run = 1.f;
    f32x4 O[4];
#pragma unroll
    for (int i = 0; i < 4; ++i) O[i] = (f32x4){0.f, 0.f, 0.f, 0.f};
    const int nwin = set ? 0 : 3, nctx = LC / 128;
    for (int kbi = 0; kbi < nwin + nctx; ++kbi) {
        const bool win = kbi < nwin; const int kb = win ? qb - 1 + kbi : kbi - nwin;
        if (win && (kb < 0 || kb >= L / 128)) continue;
        const int ktok0 = win ? b * L + kb * 128 : TL + b * LC + kb * 128;
        __syncthreads();
        { const int row = tid >> 2, ph = (tid >> 1) & 1, sub = tid & 1;
          rope_store(K0 + (size_t)(ktok0 + row) * 128 + kvh * 64, Ks + row * A_LDQ, kb * 128 + row, win, 1.f, ph, sub); }
        { const bf16_t* vt = (const bf16_t*)(p.ws + WS_P + (win ? P_VT_LAT : P_VT_CTX)); const int Lx = win ? L : LC;
#pragma unroll
          for (int i = 0; i < 2; ++i) { const int id = tid + NT * i, d = id >> 4, kc = id & 15;
              *(u32x4*)(Vt + d * A_LDV + kc * 8) = *(const u32x4*)(vt + ((size_t)b * 128 + kvh * 64 + d) * Lx + kb * 128 + kc * 8); } }
        __syncthreads();
#pragma unroll
        for (int ch = 0; ch < 2; ++ch) {
            f32x4 st[4];
#pragma unroll
            for (int u = 0; u < 4; ++u) {
                const bf16_t* kr = Ks + ((ch * 4 + u) * 16 + l15) * A_LDQ + 8 * lg;
                f32x4 z = (f32x4){0.f, 0.f, 0.f, 0.f};
                z = __builtin_amdgcn_mfma_f32_16x16x32_bf16(*(const bf16x8*)kr, qf[0], z, 0, 0, 0);
                z = __builtin_amdgcn_mfma_f32_16x16x32_bf16(*(const bf16x8*)(kr + 32), qf[1], z, 0, 0, 0);
                st[u] = z;
            }
            float cmax = -INFINITY;
            if (win) {
                const int qpos = qb * 128 + w * 16 + l15;
#pragma unroll
                for (int u = 0; u < 4; ++u)
#pragma unroll
                    for (int r = 0; r < 4; ++r) { const int kpos = kb * 128 + (ch * 4 + u) * 16 + 4 * lg + r; const int dd = qpos - kpos; if (dd > 128 || dd < -128) st[u][r] = -INFINITY; }
            }
#pragma unroll
            for (int u = 0; u < 4; ++u)
#pragma unroll
                for (int r = 0; r < 4; ++r) cmax = fmaxf(cmax, st[u][r]);
            cmax = fmaxf(cmax, __shfl_xor(cmax, 16)); cmax = fmaxf(cmax, __shfl_xor(cmax, 32));
            const float m_new = fmaxf(m_run, cmax), alpha = __expf(m_run - m_new);
            float ls = 0.f;
#pragma unroll
            for (int u = 0; u < 4; ++u)
#pragma unroll
                for (int r = 0; r < 4; ++r) { const float e = __expf(st[u][r] - m_new); st[u][r] = e; ls += e; }
            ls += __shfl_xor(ls, 16); ls += __shfl_xor(ls, 32);
            l_run = l_run * alpha + ls; m_run = m_new;
#pragma unroll
            for (int i = 0; i < 4; ++i) { O[i][0] *= alpha; O[i][1] *= alpha; O[i][2] *= alpha; O[i][3] *= alpha; }
#pragma unroll
            for (int ss = 0; ss < 2; ++ss) {
                u32x4 pu; pu[0] = pk2(st[2 * ss][0], st[2 * ss][1]); pu[1] = pk2(st[2 * ss][2], st[2 * ss][3]); pu[2] = pk2(st[2 * ss + 1][0], st[2 * ss + 1][1]); pu[3] = pk2(st[2 * ss + 1][2], st[2 * ss + 1][3]);
                const bf16x8 pf = __builtin_bit_cast(bf16x8, pu);
                const int key0 = (ch * 4 + 2 * ss) * 16 + 4 * lg;
#pragma unroll
                for (int dt = 0; dt < 4; ++dt) {
                    const bf16_t* vr = Vt + (dt * 16 + l15) * A_LDV + key0;
                    u32x4 vu; const u32x2 v0 = *(const u32x2*)vr, v1 = *(const u32x2*)(vr + 16); vu[0] = v0[0]; vu[1] = v0[1]; vu[2] = v1[0]; vu[3] = v1[1];
                    O[dt] = __builtin_amdgcn_mfma_f32_16x16x32_bf16(__builtin_bit_cast(bf16x8, vu), pf, O[dt], 0, 0, 0);
                }
            }
        }
    }
    const float il = 1.f / l_run;
    bf16_t* M = (bf16_t*)(p.ws + WS_M) + (size_t)(qtok0 + w * 16 + l15) * 1024 + 512 + h * 64;
#pragma unroll
    for (int dt = 0; dt < 4; ++dt) { u32x2 o; o[0] = pk2(O[dt][0] * il, O[dt][1] * il); o[1] = pk2(O[dt][2] * il, O[dt][3] * il); *(u32x2*)(M + dt * 16 + 4 * lg) = o; }
    __syncthreads();
}
static_assert(NF_LAT / 256 <= 16 && NF_CTX / 64 <= 16 && L / 8 <= 256 && LC / 8 <= 64 && 2 * NF_LAT * 8 + 2 * L * 18 <= SMEM_BYTES && 8 * NF_CTX * 8 + 2 * LC * 18 <= SMEM_BYTES, "hyena item geometry");
constexpr int P3_HY_LAT = (NB / 2) * 64, P3_HY_CTX = (NB / 2) * 64, P3_AT_LAT = NB * (L / 128) * 8, P3_AT_CTX = NB * (LC / 128) * 8;
DEV void phase3(const Params& p, unsigned char* smem, int var = 0) {
    const int total = P3_HY_LAT + P3_AT_LAT + P3_HY_CTX + P3_AT_CTX;
    for (int it = blockIdx.x; it < total; it += gridDim.x) {
        int i = it;
        if ((var == 1 || var == 3 || var == 4) && !(i < P3_HY_LAT || (i >= P3_HY_LAT + P3_AT_LAT && i < P3_HY_LAT + P3_AT_LAT + P3_HY_CTX))) continue;
        if (var == 2 && (i < P3_HY_LAT || (i >= P3_HY_LAT + P3_AT_LAT && i < P3_HY_LAT + P3_AT_LAT + P3_HY_CTX))) continue;
        if (i < P3_HY_LAT) { hyena_item<256>(p, 0, i, smem, var == 3, var == 4); continue; } i -= P3_HY_LAT;
        if (i < P3_AT_LAT) { attn_item(p, 0, i, smem); continue; } i -= P3_AT_LAT;
        if (i < P3_HY_CTX) { hyena_item<64>(p, 1, i, smem, var == 3, var == 4); continue; } i -= P3_HY_CTX;
        attn_item(p, 1, i, smem);
    }
}

constexpr int K_LDK = 136, K_LDS = 129, K_LDC = 52;
DEV unsigned fkey(float f) { const unsigned u = __builtin_bit_cast(unsigned, f); return (u & 0x80000000u) ? ~u : (u | 0x80000000u); }
constexpr int cand_off(int i) { int o = 0; for (int k = 0; k < i; ++k) o += 16 / (k + 1); return o; }
DEV void topk_load_keys(const Params& p, int layer, int h, unsigned char* smem) {
    bf16_t* Ks = (bf16_t*)smem;
    const bf16_t* keys = (const bf16_t*)(p.ws + WS_W + W_KEYS) + (size_t)layer * 262144 + (size_t)h * 32768;
    const int tid = tidx();
#pragma unroll
    for (int i = 0; i < 8; ++i) { const int id = tid + NT * i, row = id >> 4, kc = id & 15; *(u32x4*)(Ks + row * K_LDK + kc * 8) = *(const u32x4*)(keys + (size_t)row * 128 + kc * 8); }
    __syncthreads();
}
#ifndef HOST_EMU
template <int CTRL> DEV unsigned dpp_u32(unsigned v) { return (unsigned)__builtin_amdgcn_update_dpp(0, (int)v, CTRL, 0xF, 0xF, true); }
#else
template <int CTRL> DEV unsigned dpp_u32(unsigned v) { const int lane = tidx() & 63; const int src = CTRL == 0xB1 ? (lane ^ 1) : CTRL == 0x4E ? (lane ^ 2) : ((lane & ~7) | (7 - (lane & 7))); return emu_shfl(v, src); }
#endif
DEV unsigned max8_u32(unsigned v) { unsigned t = dpp_u32<0xB1>(v); v = v > t ? v : t; t = dpp_u32<0x4E>(v); v = v > t ? v : t; t = dpp_u32<0x141>(v); return v > t ? v : t; }
DEV float sum8_f32(float v) { v += __builtin_bit_cast(float, dpp_u32<0xB1>(__builtin_bit_cast(unsigned, v))); v += __builtin_bit_cast(float, dpp_u32<0x4E>(__builtin_bit_cast(unsigned, v))); v += __builtin_bit_cast(float, dpp_u32<0x141>(__builtin_bit_cast(unsigned, v))); return v; }
DEV float unkey(unsigned k) { const unsigned u = (k & 0x80000000u) ? (k & 0x7fffffffu) : ~k; return __builtin_bit_cast(float, u); }
template <int N> DEV void bitonic_desc(unsigned (&a)[N]) {
#pragma unroll
    for (int k = 2; k <= N; k <<= 1)
#pragma unroll
        for (int j = k >> 1; j > 0; j >>= 1)
#pragma unroll
            for (int i = 0; i < N; ++i) { const int l = i ^ j; if (l > i) { const unsigned x = a[i], y = a[l]; const unsigned hi = x > y ? x : y, lo = x > y ? y : x; if ((i & k) == 0) { a[i] = hi; a[l] = lo; } else { a[i] = lo; a[l] = hi; } } }
}
DEV void merge16(const unsigned* lst, int nlist, unsigned first, int sub, unsigned& r0, unsigned& r1) {
    unsigned cur = first; int head = 0; r0 = 0u; r1 = 0u;
#pragma unroll
    for (int it = 0; it < 16; ++it) {
        const unsigned m = max8_u32(cur);
        if (sub == (it & 7)) { if (it < 8) r0 = m; else r1 = m; }
        if (cur == m) { ++head; cur = head < nlist ? lst[head] : 0u; }
    }
}
DEV void topk_item(const Params& p, int h, int tok0, unsigned char* smem, const bf16x8 (&afr)[16]) {
    bf16_t* Ks = (bf16_t*)smem;
    float* Sc = (float*)(Ks + 2 * 128 * K_LDK);
    unsigned* s12 = (unsigned*)Sc + 64 * 8 * 17;
    unsigned* cl = s12 + 64 * 32;
    const int tid = tidx(), lane = tid & 63, w = tid >> 6;
    const int row = tid >> 3, sub = tid & 7;
#pragma unroll
    for (int part = 0; part < 2; ++part) {
        { const int mi = w >> 2, ni = w & 3;
          f32x16 acc;
#pragma unroll
          for (int r = 0; r < 16; ++r) acc[r] = 0.f;
          const bf16_t* bs = Ks + (part * 128 + ni * 32 + (lane & 31)) * K_LDK + 8 * (lane >> 5);
#pragma unroll
          for (int kk = 0; kk < 8; ++kk) acc = __builtin_amdgcn_mfma_f32_32x32x16_bf16(part ? afr[8 + kk] : afr[kk], *(const bf16x8*)(bs + kk * 16), acc, 0, 0, 0);
#pragma unroll
          for (int r = 0; r < 16; ++r) Sc[(mi * 32 + (r & 3) + 8 * (r >> 2) + 4 * (lane >> 5)) * K_LDS + ni * 32 + (lane & 31)] = acc[r]; }
        __syncthreads();
        unsigned mk[16];
#pragma unroll
        for (int i = 0; i < 16; ++i) mk[i] = (fkey(Sc[row * K_LDS + sub * 16 + i]) & ~127u) | (unsigned)(127 - (sub * 16 + i));
        bitonic_desc<16>(mk);
        __syncthreads();
        unsigned* lst = (unsigned*)Sc + (row * 8 + sub) * 17;
#pragma unroll
        for (int i = 0; i < 16; ++i) lst[i] = mk[i];
        unsigned r0, r1;
        merge16(lst, 16, mk[0], sub, r0, r1);
        s12[(row * 2 + part) * 16 + sub] = r0; s12[(row * 2 + part) * 16 + 8 + sub] = r1;
        __syncthreads();
    }
    {
        const unsigned* k1 = s12 + row * 32; const unsigned* k2 = k1 + 16;
        unsigned ck[8];
#pragma unroll
        for (int m = 0; m < 8; ++m) {
            const int cc = sub + 8 * m; int ci = 0, off = 0;
#pragma unroll
            for (int i = 0; i < 15; ++i) { const bool ge = cc >= cand_off(i + 1); ci += ge ? 1 : 0; off += ge ? 16 / (i + 1) : 0; }
            const int cj = cc - off;
            ck[m] = 0u;
            if (cc < 50) ck[m] = (fkey(unkey((k1[ci] & ~127u) | 64u) + unkey((k2[cj] & ~127u) | 64u)) & ~63u) | (unsigned)(63 - cc);
        }
        bitonic_desc<8>(ck);
        unsigned* lst = cl + (row * 8 + sub) * 9;
#pragma unroll
        for (int m = 0; m < 8; ++m) lst[m] = ck[m];
        unsigned r0, r1;
        merge16(lst, 8, ck[0], sub, r0, r1);
        const float a = unkey((r0 & ~63u) | 32u), b = unkey((r1 & ~63u) | 32u);
        const unsigned kmax = max8_u32(r0 > r1 ? r0 : r1); const float vmax = unkey((kmax & ~63u) | 32u);
        const float ea = __expf(a - vmax), eb = __expf(b - vmax);
        const float inv = 1.f / sum8_f32(ea + eb);
        int eidx[2];
#pragma unroll
        for (int q = 0; q < 2; ++q) {
            const int cc = 63 - (int)((q ? r1 : r0) & 63u); int ci = 0, off = 0;
#pragma unroll
            for (int i = 0; i < 15; ++i) { const bool ge = cc >= cand_off(i + 1); ci += ge ? 1 : 0; off += ge ? 16 / (i + 1) : 0; }
            const int cj = cc - off;
            eidx[q] = (127 - (int)(k1[ci] & 127u)) * 128 + (127 - (int)(k2[cj] & 127u));
        }
        int* IDX = (int*)(p.ws + WS_IDX) + (size_t)(tok0 + row) * 128 + h * 16; float* GT = (float*)(p.ws + WS_GATE) + (size_t)(tok0 + row) * 128 + h * 16;
        IDX[sub] = eidx[0]; IDX[8 + sub] = eidx[1]; GT[sub] = ea * inv; GT[8 + sub] = eb * inv;
    }
    __syncthreads();
}
#define TOPK_LOAD(AF, tok0_, h_) do { const int lane_ = tidx() & 63, w_ = tidx() >> 6; \
        const bf16_t* ag_ = (const bf16_t*)(p.ws + WS_P) + (size_t)((tok0_) + (w_ >> 2) * 32 + (lane_ & 31)) * 2048 + (h_) * 256 + 8 * (lane_ >> 5); \
        _Pragma("unroll") for (int q_ = 0; q_ < 16; ++q_) AF[q_] = *(const bf16x8*)(ag_ + (q_ >> 3) * 128 + (q_ & 7) * 16); } while (0)
DEV void topk_phase(const Params& p, int layer, int ntok, unsigned char* smem) {
    const int G = gridDim.x, bid = blockIdx.x, h = bid & 7;
    const int nt = ntok / 64;
    bf16x8 afA[16], afB[16];
    if ((G & 7) == 0) {
        const int st = G >> 3; int tt = bid >> 3;
        if (tt < nt) { TOPK_LOAD(afA, tt * 64, h); topk_load_keys(p, layer, h, smem); }
        while (tt < nt) {
            if (tt + st < nt) TOPK_LOAD(afB, (tt + st) * 64, h);
            topk_item(p, h, tt * 64, smem, afA);
            tt += st; if (tt >= nt) break;
            if (tt + st < nt) TOPK_LOAD(afA, (tt + st) * 64, h);
            topk_item(p, h, tt * 64, smem, afB);
            tt += st;
        }
    } else {
        for (int it = bid; it < nt * 8; it += G) { __syncthreads(); TOPK_LOAD(afA, (it >> 3) * 64, it & 7); topk_load_keys(p, layer, it & 7, smem); topk_item(p, it & 7, (it >> 3) * 64, smem, afA); }
    }
}
#undef TOPK_LOAD

DEV float gelu_f(float x) { return 0.5f * x * (1.f + erff(x * 0.70710678118654752f)); }
DEV void peer_item(const Params& p, int layer, int item, int var = 0) {
    (void)var;
    const int tok = item * 8 + (tidx() >> 6), lane = tidx() & 63, li = lane & 31, half = lane >> 5;
    const bf16_t* A = (const bf16_t*)(p.ws + WS_A) + (size_t)tok * 1024 + li * 32;
    const unsigned char* U6 = p.ws + WS_U6 + (size_t)layer * 16384 * 768; const unsigned char* V4 = p.ws + WS_V4 + (size_t)layer * 16384 * 512;
    const float* SU = (const float*)(p.ws + WS_S8) + (size_t)(layer * 2) * 16384; const float* SV = SU + 16384;
    float x[32], y[32];
#pragma unroll
    for (int q = 0; q < 4; ++q) { const u32x4 a = *(const u32x4*)(A + 8 * q);
#pragma unroll
        for (int i = 0; i < 4; ++i) { x[8 * q + 2 * i] = bflo(a[i]); x[8 * q + 2 * i + 1] = bfhi(a[i]); } }
#pragma unroll
    for (int i = 0; i < 32; ++i) y[i] = 0.f;
    const int* IDX = (const int*)(p.ws + WS_IDX) + (size_t)tok * 128; const float* GT = (const float*)(p.ws + WS_GATE) + (size_t)tok * 128;
    const int i_lo = IDX[lane], i_hi = IDX[64 + lane]; const float g_lo = GT[lane], g_hi = GT[64 + lane];
    const int sl = ((li >> 4) & 1) * 2 + ((li >> 3) & 1);
    u32x4 ulo[4], vq[4]; u32x2 uhi[4];
#define PG_LOADU(g) do { _Pragma("unroll") for (int s_ = 0; s_ < 4; ++s_) { const int e_ = __shfl((g) < 8 ? i_lo : i_hi, (((g) & 7) << 3) + 2 * s_ + half); \
        const unsigned char* r_ = U6 + (size_t)e_ * 768; ulo[s_] = *(const u32x4*)(r_ + li * 16); uhi[s_] = *(const u32x2*)(r_ + 512 + li * 8); } } while (0)
#define PG_LOADV(g) do { _Pragma("unroll") for (int s_ = 0; s_ < 4; ++s_) { const int e_ = __shfl((g) < 8 ? i_lo : i_hi, (((g) & 7) << 3) + 2 * s_ + half); \
        vq[s_] = *(const u32x4*)(V4 + (size_t)e_ * 512 + li * 16); } } while (0)
    PG_LOADU(0); PG_LOADV(0);
    for (int g = 0; g < 16; ++g) {
        const int mk = ((g & 7) << 3) + 2 * sl + half; const int me = __shfl(g < 8 ? i_lo : i_hi, mk); const float mg = __shfl(g < 8 ? g_lo : g_hi, mk);
        const float su = SU[me], sv = SV[me];
        float d[4];
#pragma unroll
        for (int s4 = 0; s4 < 4; ++s4) {
            u32x6 w; w[0] = ulo[s4][0]; w[1] = ulo[s4][1]; w[2] = ulo[s4][2]; w[3] = ulo[s4][3]; w[4] = uhi[s4][0]; w[5] = uhi[s4][1];
            const f32x32 f = __builtin_amdgcn_cvt_scalef32_pk32_f32_fp6(w, 1.0f);
            float a = 0.f;
#pragma unroll
            for (int i = 0; i < 32; ++i) a = fmaf(f[i], x[i], a);
            d[s4] = a; SCHED_FENCE(); }
        if (g + 1 < 16) PG_LOADU(g + 1);
        float r2[2], r1;
        { const bool hi = (li & 16) != 0;
#pragma unroll
          for (int j = 0; j < 2; ++j) { const float send = hi ? d[j] : d[2 + j], keep = hi ? d[2 + j] : d[j]; r2[j] = keep + __shfl_xor(send, 16); } }
        { const bool hi = (li & 8) != 0; const float send = hi ? r2[0] : r2[1], keep = hi ? r2[1] : r2[0]; r1 = keep + __shfl_xor(send, 8); }
        r1 += __shfl_xor(r1, 4); r1 += __shfl_xor(r1, 2); r1 += __shfl_xor(r1, 1);
        const float act = gelu_f(r1 * su) * mg * sv;
#pragma unroll
        for (int s4 = 0; s4 < 4; ++s4) {
            const float aj = __shfl(act, (lane & 32) + 16 * (s4 >> 1) + 8 * (s4 & 1));
#pragma unroll
            for (int dw = 0; dw < 4; ++dw) {
                const f32x2 f0 = __builtin_amdgcn_cvt_scalef32_pk_f32_fp4(vq[s4][dw], 1.0f, 0), f1 = __builtin_amdgcn_cvt_scalef32_pk_f32_fp4(vq[s4][dw], 1.0f, 1),
                            f2 = __builtin_amdgcn_cvt_scalef32_pk_f32_fp4(vq[s4][dw], 1.0f, 2), f3 = __builtin_amdgcn_cvt_scalef32_pk_f32_fp4(vq[s4][dw], 1.0f, 3);
                const int e0 = dw * 8;
                y[e0] = fmaf(aj, f0[0], y[e0]); y[e0 + 1] = fmaf(aj, f0[1], y[e0 + 1]); y[e0 + 2] = fmaf(aj, f1[0], y[e0 + 2]); y[e0 + 3] = fmaf(aj, f1[1], y[e0 + 3]);
                y[e0 + 4] = fmaf(aj, f2[0], y[e0 + 4]); y[e0 + 5] = fmaf(aj, f2[1], y[e0 + 5]); y[e0 + 6] = fmaf(aj, f3[0], y[e0 + 6]); y[e0 + 7] = fmaf(aj, f3[1], y[e0 + 7]);
            }
            SCHED_FENCE(); }
        if (g + 1 < 16) PG_LOADV(g + 1);
    }
#undef PG_LOADU
#undef PG_LOADV
    float yy[16];
#pragma unroll
    for (int i = 0; i < 16; ++i) { const float send = half ? y[i] : y[16 + i], keep = half ? y[16 + i] : y[i]; yy[i] = keep + __shfl_xor(send, 32); }
    const int c0 = li * 32 + half * 16;
    float* H = (float*)(p.ws + WS_H) + (size_t)tok * 1024 + c0;
    const float* g2 = (const float*)(p.ws + WS_MOD) + ((size_t)layer * NR + mod_row(tok)) * 6144 + 5120 + c0;
    float hv[16]; float ss = 0.f;
#pragma unroll
    for (int i = 0; i < 4; ++i) { const f32x4 hh = *(const f32x4*)(H + 4 * i), gg = *(const f32x4*)(g2 + 4 * i);
#pragma unroll
        for (int j = 0; j < 4; ++j) { const float v = hh[j] + gg[j] * yy[4 * i + j]; hv[4 * i + j] = v; ss += v * v; } }
    ss = wave_sum(ss);
    const float rstd = rsqrtf(ss * (1.f / 1024.f) + 1e-6f);
    if (layer == 0) {
#pragma unroll
        for (int i = 0; i < 4; ++i) { f32x4 o; o[0] = hv[4 * i]; o[1] = hv[4 * i + 1]; o[2] = hv[4 * i + 2]; o[3] = hv[4 * i + 3]; *(f32x4*)(H + 4 * i) = o; }
        const float* g = p.in[I_N1G] + 1024 + c0;
        const float* mod = (const float*)(p.ws + WS_MOD) + ((size_t)1 * NR + mod_row(tok)) * 6144 + c0;
        bf16_t* Ao = (bf16_t*)(p.ws + WS_A) + (size_t)tok * 1024 + c0;
        u32x4 o0, o1; float r[16];
#pragma unroll
        for (int i = 0; i < 16; ++i) r[i] = hv[i] * rstd * g[i] * (1.f + mod[1024 + i]) + mod[i];
#pragma unroll
        for (int i = 0; i < 4; ++i) { o0[i] = pk2(r[2 * i], r[2 * i + 1]); o1[i] = pk2(r[8 + 2 * i], r[8 + 2 * i + 1]); }
        *(u32x4*)Ao = o0; *(u32x4*)(Ao + 8) = o1;
    } else {
        const float* g = p.in[I_FG] + c0; float* out = p.out + (size_t)tok * 1024 + c0;
#pragma unroll
        for (int i = 0; i < 4; ++i) { f32x4 o; o[0] = hv[4 * i] * rstd * g[4 * i]; o[1] = hv[4 * i + 1] * rstd * g[4 * i + 1]; o[2] = hv[4 * i + 2] * rstd * g[4 * i + 2]; o[3] = hv[4 * i + 3] * rstd * g[4 * i + 3]; *(f32x4*)(out + 4 * i) = o; }
    }
}

constexpr int S3_LD = 136, S3_LDT = 24, S3_LDV = 72;
constexpr int S3_Q = 0, S3_K = S3_Q + 64 * S3_LD * 2, S3_KT = S3_K + 64 * S3_LD * 2, S3_D = S3_KT + 4 * 128 * S3_LDT * 2, S3_V = S3_D + 4 * 128 * 4, S3_ST = S3_V + 64 * S3_LDV * 2,
              S3_P = S3_ST + 2 * 64 * S3_LD * 2, S3_END = S3_P + 4 * 16 * S3_LDT * 2;
static_assert(S3_END <= SMEM_BYTES, "scan LDS");
DEV void scan_block(const Params& p, int bi, unsigned char* smem, int var = 0) {
    const int tid = tidx(), lane = tid & 63, w = tid >> 6, l15 = lane & 15, lg4 = lane >> 4, l31 = lane & 31, lh = lane >> 5;
    const int half = bi & 1, dir = (bi >> 1) & 1, h = (bi >> 2) & 7, b = bi >> 5;
    const bf16_t* P1 = (const bf16_t*)(p.ws + WS_P);
    const bf16_t* IT = (const bf16_t*)(p.ws + WS_M);
    bf16_t* Oo = (bf16_t*)(p.ws + WS_F + (dir ? F_OB : F_OF));
    bf16_t* Qs = (bf16_t*)(smem + S3_Q); bf16_t* Ks = (bf16_t*)(smem + S3_K); bf16_t* KT = (bf16_t*)(smem + S3_KT); float* Ds = (float*)(smem + S3_D);
    bf16_t* Vs = (bf16_t*)(smem + S3_V); bf16_t* ST = (bf16_t*)(smem + S3_ST); bf16_t* Ps = (bf16_t*)(smem + S3_P);
    const int NCH = (LC + L) / 64;
    const int kt = w >> 1, vt = w & 1;
    f32x16 S;
#pragma unroll
    for (int r = 0; r < 16; ++r) S[r] = 0.f;
    for (int i = tid; i < 64 * S3_LD / 2; i += NT) ((unsigned*)ST)[i] = 0u;
    const int pk = tid & 127, pblk = tid >> 7;
    u32x4 ka[2], qa[2], va, kb2[2], qb2[2], vb2;
    const int kcol = 1024 * (1 + dir) + h * 128 + pk, qcol = h * 128 + pk;
#define S3_T0(c) ((c) * 64 < LC ? (dir ? LC - 64 - (c) * 64 : (c) * 64) : (dir ? L - 64 - ((c) * 64 - LC) : (c) * 64 - LC))
#define S3_LOAD(c, KR, QR, VR) do { const bool lat_ = (c) * 64 >= LC; const int t0_ = S3_T0(c); const int Lx_ = lat_ ? L : LC; \
        const bf16_t* kq_ = (const bf16_t*)(p.ws + WS_P + (lat_ ? P1_KQT_LAT : P1_KQT_CTX)) + (size_t)b * 3072 * Lx_ + t0_ + pblk * 16; \
        KR[0] = *(const u32x4*)(kq_ + (size_t)kcol * Lx_); KR[1] = *(const u32x4*)(kq_ + (size_t)kcol * Lx_ + 8); \
        if (lat_) { QR[0] = *(const u32x4*)(kq_ + (size_t)qcol * Lx_); QR[1] = *(const u32x4*)(kq_ + (size_t)qcol * Lx_ + 8); } else { QR[0] = (u32x4){0u, 0u, 0u, 0u}; QR[1] = QR[0]; } \
        { const int v_ = tid >> 3, c8_ = tid & 7; const bf16_t* it_ = IT + (lat_ ? (size_t)0 : (size_t)NB * 1024 * L) + ((size_t)b * 1024 + h * 128 + half * 64 + v_) * Lx_ + t0_ + c8_ * 8; VR = *(const u32x4*)it_; } } while (0)
#define S3_PREP(KR, QR, VR) do { \
            float bsum = 0.f; unsigned short kt16[16]; \
            _Pragma("unroll") for (int rr = 0; rr < 16; ++rr) { \
                const int tl = dir ? 15 - rr : rr; \
                const unsigned ku_ = dir ? KR[(15 - rr) >> 3][((15 - rr) & 7) >> 1] : KR[rr >> 3][(rr & 7) >> 1]; const unsigned qu_ = dir ? QR[(15 - rr) >> 3][((15 - rr) & 7) >> 1] : QR[rr >> 3][(rr & 7) >> 1]; \
                const bool odd_ = dir ? (((15 - rr) & 1) != 0) : ((rr & 1) != 0); \
                const float kv = odd_ ? bfhi(ku_) : bflo(ku_), qv = odd_ ? bfhi(qu_) : bflo(qu_); \
                bsum += __logf(1.f - kv); \
                const float eb = __expf(bsum), ieb = __expf(fminf(-bsum, 80.f)); \
                const unsigned short qt = (unsigned short)f2bf(qv * eb), ktv = (unsigned short)f2bf(kv * ieb); \
                Qs[(pblk * 16 + tl) * S3_LD + pk] = qt; Ks[(pblk * 16 + tl) * S3_LD + pk] = ktv; \
                if (dir) kt16[15 - rr] = ktv; else kt16[rr] = ktv; \
            } \
            u32x4 o0, o1; \
            _Pragma("unroll") for (int i = 0; i < 4; ++i) { o0[i] = (unsigned)kt16[2 * i] | ((unsigned)kt16[2 * i + 1] << 16); o1[i] = (unsigned)kt16[8 + 2 * i] | ((unsigned)kt16[8 + 2 * i + 1] << 16); } \
            *(u32x4*)(KT + (pblk * 128 + pk) * S3_LDT) = o0; *(u32x4*)(KT + (pblk * 128 + pk) * S3_LDT + 8) = o1; \
            Ds[pblk * 128 + pk] = __expf(bsum); \
            { const int v_ = tid >> 3, c8_ = tid & 7; *(u32x4*)(Vs + v_ * S3_LDV + c8_ * 8) = VR; } } while (0)
    S3_LOAD(0, ka, qa, va);
    for (int c = 0; c < NCH; ++c) {
        const bool lat = c * 64 >= LC; const int t0 = S3_T0(c); const size_t tokb = lat ? (size_t)b * L + t0 : (size_t)TL + (size_t)b * LC + t0;
        if ((c & 1) == 0) { if (c + 1 < NCH) S3_LOAD(c + 1, kb2, qb2, vb2); } else { if (c + 1 < NCH) S3_LOAD(c + 1, ka, qa, va); }
        lds_barrier();
        if (var != 1) { if ((c & 1) == 0) S3_PREP(ka, qa, va); else S3_PREP(kb2, qb2, vb2); }
        lds_barrier();

        if (lat && w < 4) {
            f32x4 pt = (f32x4){0.f, 0.f, 0.f, 0.f};
#pragma unroll
            for (int kk = 0; kk < 4; ++kk)
                pt = __builtin_amdgcn_mfma_f32_16x16x32_bf16(*(const bf16x8*)(Ks + (w * 16 + l15) * S3_LD + kk * 32 + 8 * lg4), *(const bf16x8*)(Qs + (w * 16 + l15) * S3_LD + kk * 32 + 8 * lg4), pt, 0, 0, 0);
            float pm[4];
#pragma unroll
            for (int r = 0; r < 4; ++r) { const int sl = 4 * lg4 + r; const bool keep = dir ? (sl >= l15) : (sl <= l15); pm[r] = keep ? pt[r] : 0.f; }
            u32x2 o; o[0] = pk2(pm[0], pm[1]); o[1] = pk2(pm[2], pm[3]);
            *(u32x2*)(Ps + (w * 16 + l15) * S3_LDT + 4 * lg4) = o;
        }
        lds_barrier();
        for (int ib = 0; ib < (var == 2 ? 0 : 4); ++ib) {
            const int blk = dir ? 3 - ib : ib;
            const int cur = (c * 4 + ib) & 1;
            { const bf16x8 a = *(const bf16x8*)(KT + (blk * 128 + 32 * kt + l31) * S3_LDT + 8 * lh);
              const bf16x8 bb = *(const bf16x8*)(Vs + (32 * vt + l31) * S3_LDV + blk * 16 + 8 * lh);
              S = __builtin_amdgcn_mfma_f32_32x32x16_bf16(a, bb, S, 0, 0, 0);
#pragma unroll
              for (int g = 0; g < 4; ++g) { const f32x4 dv = *(const f32x4*)(Ds + blk * 128 + 32 * kt + 8 * g + 4 * lh);
                  S[4 * g] *= dv[0]; S[4 * g + 1] *= dv[1]; S[4 * g + 2] *= dv[2]; S[4 * g + 3] *= dv[3];
                  u32x2 o; o[0] = pk2(S[4 * g], S[4 * g + 1]); o[1] = pk2(S[4 * g + 2], S[4 * g + 3]);
                  *(u32x2*)(ST + ((cur ^ 1) * 64 + 32 * vt + l31) * S3_LD + 32 * kt + 8 * g + 4 * lh) = o; } }
            if (lat && w < 4) {
                f32x4 o = (f32x4){0.f, 0.f, 0.f, 0.f};
#pragma unroll
                for (int kk = 0; kk < 4; ++kk)
                    o = __builtin_amdgcn_mfma_f32_16x16x32_bf16(*(const bf16x8*)(ST + (cur * 64 + 16 * w + l15) * S3_LD + kk * 32 + 8 * lg4), *(const bf16x8*)(Qs + (blk * 16 + l15) * S3_LD + kk * 32 + 8 * lg4), o, 0, 0, 0);
                bf16x8 va = (bf16x8){0, 0, 0, 0, 0, 0, 0, 0}, pb = va;
                if (lg4 < 2) { va = *(const bf16x8*)(Vs + (16 * w + l15) * S3_LDV + blk * 16 + 8 * lg4); pb = *(const bf16x8*)(Ps + (blk * 16 + l15) * S3_LDT + 8 * lg4); }
                o = __builtin_amdgcn_mfma_f32_16x16x32_bf16(va, pb, o, 0, 0, 0);
                u32x2 ou; ou[0] = pk2(o[0], o[1]); ou[1] = pk2(o[2], o[3]);
                *(u32x2*)(Oo + (tokb + blk * 16 + l15) * 1024 + h * 128 + half * 64 + 16 * w + 4 * lg4) = ou;
            }
            lds_barrier();
        }
    }
    lds_barrier();
#undef S3_T0
#undef S3_LOAD
#undef S3_PREP
}
DEV void readout_item(const Params& p, int item) {
    const int tok = item * 8 + (tidx() >> 6), lane = tidx() & 63;
    const bf16_t* of = (const bf16_t*)(p.ws + WS_F + F_OF) + (size_t)tok * 1024 + lane * 16; const bf16_t* ob = (const bf16_t*)(p.ws + WS_F + F_OB) + (size_t)tok * 1024 + lane * 16;
    const bf16_t* gp = (const bf16_t*)(p.ws + WS_P + P1_G) + (size_t)tok * 1024 + lane * 16;
    const float* on = p.in[I_HGON] + (lane & 7) * 16;
    float o[16], gg[16]; float ss = 0.f;
    { const u32x4 a0 = *(const u32x4*)of, a1 = *(const u32x4*)(of + 8), b0 = *(const u32x4*)ob, b1 = *(const u32x4*)(ob + 8), g0 = *(const u32x4*)gp, g1 = *(const u32x4*)(gp + 8);
#pragma unroll
      for (int i = 0; i < 4; ++i) { o[2 * i] = bflo(a0[i]) + bflo(b0[i]); o[2 * i + 1] = bfhi(a0[i]) + bfhi(b0[i]); o[8 + 2 * i] = bflo(a1[i]) + bflo(b1[i]); o[8 + 2 * i + 1] = bfhi(a1[i]) + bfhi(b1[i]);
          gg[2 * i] = bflo(g0[i]); gg[2 * i + 1] = bfhi(g0[i]); gg[8 + 2 * i] = bflo(g1[i]); gg[8 + 2 * i + 1] = bfhi(g1[i]); } }
#pragma unroll
    for (int i = 0; i < 16; ++i) ss += o[i] * o[i];
    ss += __shfl_xor(ss, 1); ss += __shfl_xor(ss, 2); ss += __shfl_xor(ss, 4);
    const float rstd = rsqrtf(ss * (1.f / 128.f) + 1e-6f);
    bf16_t* M = (bf16_t*)(p.ws + WS_M) + (size_t)tok * 1024 + lane * 16;
    u32x4 o0, o1; float r[16];
#pragma unroll
    for (int i = 0; i < 16; ++i) r[i] = o[i] * rstd * on[i] * gg[i];
#pragma unroll
    for (int i = 0; i < 4; ++i) { o0[i] = pk2(r[2 * i], r[2 * i + 1]); o1[i] = pk2(r[8 + 2 * i], r[8 + 2 * i + 1]); }
    *(u32x4*)M = o0; *(u32x4*)(M + 8) = o1;
}

#ifndef HOST_EMU
#define XB_TMO      128
#define XB_XCNT(j)  (256  + 64 * (j))
#define XB_XSUB(j)  (1280 + 64 * (j))
#define XB_XGEN(j)  (2304 + 64 * (j))
#define XB_TOP      3328
#define XB_TOPGEN   3392
#define XCD_BAR_WORDS 3456
#define XB_SPIN_CAP (1u << 18)
#define LAS __attribute__((address_space(3)))

__device__ __forceinline__ unsigned xb_ld(unsigned* p)              { return __hip_atomic_load(p, __ATOMIC_RELAXED, __HIP_MEMORY_SCOPE_AGENT); }
__device__ __forceinline__ unsigned xb_add(unsigned* p, unsigned v) { return __hip_atomic_fetch_add(p, v, __ATOMIC_RELAXED, __HIP_MEMORY_SCOPE_AGENT); }
__device__ __forceinline__ unsigned xb_xcc_id() { return (unsigned)__builtin_amdgcn_s_getreg((3 << 11) | 20) & 0xFu; }
#define XB_SPIN(cond, bar) do { unsigned _sp = 0; while (cond) { __builtin_amdgcn_s_sleep(1); \
    if ((++_sp & 255u) == 0u) { if (xb_ld(&(bar)[XB_TMO])) break; if (_sp > XB_SPIN_CAP) { atomicAdd(&(bar)[XB_TMO], 1u); break; } } } } while (0)

struct XcdBarrier {
    unsigned* bar; unsigned x;
    volatile LAS unsigned* st;
};

__device__ __forceinline__ XcdBarrier xcd_barrier_post(unsigned* bar, volatile LAS unsigned* st) {
    XcdBarrier b; b.bar = bar; b.x = xb_xcc_id(); b.st = st;
    if (threadIdx.x == 0) (void)xb_add(&bar[XB_XCNT(b.x)], 1u);
    return b;
}
__device__ __forceinline__ void xcd_barrier_complete(unsigned* bar, unsigned x, unsigned& nloc, unsigned& nx) {
    const unsigned G = gridDim.x * gridDim.y * gridDim.z;
    unsigned sum, cnt, mine, sp = 0u;
    for (;;) {
        sum = 0u; cnt = 0u; mine = 0u;
#pragma unroll
        for (unsigned j = 0; j < 16; ++j) { const unsigned c = xb_ld(&bar[XB_XCNT(j)]); sum += c; cnt += (c > 0u) ? 1u : 0u; mine = (j == x) ? c : mine; }
        if (sum == G) break;
        __builtin_amdgcn_s_sleep(1);
        if ((++sp & 255u) == 0u) { if (xb_ld(&bar[XB_TMO])) break; if (sp > XB_SPIN_CAP) { atomicAdd(&bar[XB_TMO], 1u); break; } }
    }
    nloc = mine > 0u ? mine : 1u; nx = cnt > 0u ? cnt : 1u;
}

__device__ __forceinline__ void xcd_barrier(const XcdBarrier& b) {
    asm volatile("s_waitcnt vmcnt(0)" ::: "memory");
    __syncthreads();
    if (threadIdx.x == 0) {
        unsigned* bar = b.bar;
        __builtin_amdgcn_s_waitcnt(0);
        unsigned nloc = b.st[0], nx = b.st[1];
        if (nloc == 0u) { xcd_barrier_complete(bar, b.x, nloc, nx); b.st[0] = nloc; b.st[1] = nx; }
        const unsigned old = xb_add(&bar[XB_XSUB(b.x)], 1u);
        const unsigned gen = old / nloc;
        if (old + 1u == (gen + 1u) * nloc) {
            __builtin_amdgcn_fence(__ATOMIC_RELEASE, "agent");
            asm volatile("s_waitcnt vmcnt(0)" ::: "memory");
            const unsigned og = xb_add(&bar[XB_TOP], 1u);
            const unsigned tg = og / nx;
            if (og + 1u == (tg + 1u) * nx) xb_add(&bar[XB_TOPGEN], 1u);
            else XB_SPIN(xb_ld(&bar[XB_TOPGEN]) == tg, bar);
            __builtin_amdgcn_fence(__ATOMIC_ACQUIRE, "agent");
            xb_add(&bar[XB_XGEN(b.x)], 1u);
            asm volatile("s_waitcnt vmcnt(0)" ::: "memory");
        } else {
            XB_SPIN(xb_ld(&bar[XB_XGEN(b.x)]) == gen, bar);
            __builtin_amdgcn_fence(__ATOMIC_ACQUIRE, "agent");
            asm volatile("s_waitcnt vmcnt(0)" ::: "memory");
        }
    }
    __syncthreads();
}

#endif
#ifdef NOINLINE_PHASES
#define NOINL __device__ __attribute__((noinline))
#else
#define NOINL __device__ __forceinline__
#endif
__shared__ __attribute__((aligned(16))) unsigned char g_smem[SMEM_BYTES + 16];
#define PH_COMMON const int G = gridDim.x, bid = blockIdx.x; unsigned char* smem = g_smem; (void)smem; (void)G; (void)bid; \
    const bf16_t* A = (const bf16_t*)(p.ws + WS_A); const bf16_t* Mx = (const bf16_t*)(p.ws + WS_M); const bf16_t* W = (const bf16_t*)(p.ws + WS_W); (void)A; (void)Mx; (void)W;
DEV void tables_in_gemm_tail(const Params& p, int layer, int nunits) {
    const int G = gridDim.x, bid = blockIdx.x, busy = nunits % G;
    if (busy == 0) { for (int it = bid; it < 2 * P0_TAB; it += G) p0_table(p, layer * 2 + it / P0_TAB, it % P0_TAB); return; }
    if (bid < busy) return;
    for (int it = bid - busy; it < 2 * P0_TAB; it += G - busy) p0_table(p, layer * 2 + it / P0_TAB, it % P0_TAB);
}
NOINL void ph0(const Params& p) { PH_COMMON phase0(p, smem); }
NOINL void ph1(const Params& p) { PH_COMMON phase1(p, smem); }
NOINL void ph2(const Params& p) { PH_COMMON EpiL0InT e{p.ws}; gemm_pg8_T(A, W + W_IN0 / 2, T, 2304, smem, e); tables_in_gemm_tail(p, 0, (T / 256) * 9); }
NOINL void ph3(const Params& p, int var = 0) { PH_COMMON phase3(p, smem, var); }
NOINL void ph4(const Params& p) { PH_COMMON EpiRes e{&p, 1, 0, 2048}; gemm_pg8_N(Mx, W + W_OUT0 / 2, T, 1024, smem, e); tables_in_gemm_tail(p, 1, (T / 256) * 4); }
NOINL void ph5(const Params& p) { PH_COMMON for (int it = bid; it < T / 8; it += G) norm_rows_item(p, it, 0, p.in[I_N2G], 0, 3072); }
NOINL void ph6(const Params& p, int var = 0) { PH_COMMON (void)var; EpiBf16 e{(bf16_t*)(p.ws + WS_P), 2048}; gemm_pg8_N(A, W + W_Q0 / 2, T, 2048, smem, e); }
NOINL void ph7(const Params& p) { PH_COMMON topk_phase(p, 0, T, smem); }
NOINL void ph8(const Params& p) { PH_COMMON for (int it = bid; it < T / 8; it += G) peer_item(p, 0, it); }
NOINL void ph9(const Params& p, int var = 0) { PH_COMMON EpiHgT e{p.ws, p.in[I_HGLB], var}; gemm_pg8_T(A, W + W_IN1 / 2, T, 5120, smem, e); }
NOINL void ph10(const Params& p, int var = 0) { PH_COMMON for (int bi = bid; bi < NB * 32; bi += G) scan_block(p, bi, smem, var); }
NOINL void ph11(const Params& p) { PH_COMMON for (int it = bid; it < TL / 8; it += G) readout_item(p, it); }
NOINL void ph12(const Params& p) { PH_COMMON EpiRes e{&p, 0, 1, 2048}; gemm_pg8_N(Mx, W + W_OUT1 / 2, TL, 1024, smem, e); }
NOINL void ph13(const Params& p) { PH_COMMON for (int it = bid; it < TL / 8; it += G) norm_rows_item(p, it, 0, p.in[I_N2G] + 1024, 1, 3072); }
NOINL void ph14(const Params& p) { PH_COMMON EpiBf16 e{(bf16_t*)(p.ws + WS_P), 2048}; gemm_pg8_N(A, W + W_Q1 / 2, TL, 2048, smem, e); }
NOINL void ph15(const Params& p) { PH_COMMON topk_phase(p, 1, TL, smem); }
NOINL void ph16(const Params& p, int var = 0) { PH_COMMON for (int it = bid; it < TL / 8; it += G) peer_item(p, 1, it, var); }

constexpr int NPHASE = 17;
__global__ void __launch_bounds__(NT, 2) mega(Params p_in) {
    const int ph_lo = p_in.ph_lo, ph_hi = p_in.ph_hi;
#ifndef HOST_EMU
#define GBAR_MAKE() XcdBarrier gbar; gbar.bar = (unsigned*)(p_in.ws + WS_CTRL); gbar.x = xb_xcc_id(); gbar.st = (volatile LAS unsigned*)(LAS unsigned char*)(g_smem + SMEM_BYTES);
    if (ph_hi - ph_lo > 1) {
        volatile LAS unsigned* st = (volatile LAS unsigned*)(LAS unsigned char*)(g_smem + SMEM_BYTES);
        if (threadIdx.x == 0) { st[0] = 0u; st[1] = 0u; }
        __syncthreads();
        (void)xcd_barrier_post((unsigned*)(p_in.ws + WS_CTRL), st);
    }
#endif
#ifndef HOST_EMU
#define PH_BARRIER() do { GBAR_MAKE(); xcd_barrier(gbar); } while (0)
#define PH_PARAMS() unsigned long long kp = (unsigned long long)__builtin_amdgcn_kernarg_segment_ptr(); asm volatile("" : "+s"(kp) :: "memory"); \
        const Params& p = *(const Params*)(const __attribute__((address_space(4))) Params*)kp;
#else
#define PH_BARRIER() do {} while (0)
#define PH_PARAMS() const Params& p = p_in;
#endif
#ifdef REPEAT_MASK
#define PH_REPEAT(k, CALL) if ((REPEAT_MASK >> (k)) & 1) { PH_BARRIER(); { PH_PARAMS(); CALL; } }
#else
#define PH_REPEAT(k, CALL)
#endif
#ifdef ONLY_PHASE
#define PH_ON(k) ((k) == ONLY_PHASE)
#else
#define PH_ON(k) true
#endif
#if defined(REPEAT_MASK) && defined(HG_VAR)
#define RUN_PHASE9() if (ph_lo <= 9 && 9 < ph_hi) { if (9 > ph_lo) PH_BARRIER(); { PH_PARAMS(); ph9(p, HG_VAR); } PH_BARRIER(); { PH_PARAMS(); ph9(p, 0); } }
#else
#define RUN_PHASE9() RUN_PHASE(9, ph9(p))
#endif
#if defined(REPEAT_MASK) && defined(P3_VAR)
#define RUN_PHASE3() if (ph_lo <= 3 && 3 < ph_hi) { if (3 > ph_lo) PH_BARRIER(); { PH_PARAMS(); ph3(p, P3_VAR); } PH_BARRIER(); { PH_PARAMS(); ph3(p, 0); } }
#else
#define RUN_PHASE3() RUN_PHASE(3, ph3(p))
#endif
#define RUN_PHASE(k, CALL) if (PH_ON(k) && ph_lo <= (k) && (k) < ph_hi) { if ((k) > ph_lo) PH_BARRIER(); { PH_PARAMS(); CALL; } PH_REPEAT(k, CALL) }
    RUN_PHASE(0, ph0(p))  RUN_PHASE(1, ph1(p))  RUN_PHASE(2, ph2(p))  RUN_PHASE3()  RUN_PHASE(4, ph4(p))  RUN_PHASE(5, ph5(p))
    RUN_PHASE(6, ph6(p))  RUN_PHASE(7, ph7(p))  RUN_PHASE(8, ph8(p))  RUN_PHASE9()  RUN_PHASE(10, ph10(p)) RUN_PHASE(11, ph11(p))
    RUN_PHASE(12, ph12(p)) RUN_PHASE(13, ph13(p)) RUN_PHASE(14, ph14(p)) RUN_PHASE(15, ph15(p)) RUN_PHASE(16, ph16(p))
}

#ifndef HOST_EMU
extern "C" void kernel_launch(void* const* d_in, const int* in_sizes, int n_in, void* d_out, int out_size, void* d_ws, size_t ws_size, hipStream_t stream) {
    if (n_in != 29 || ws_size < WS_END || out_size != TL * 1024) { fprintf(stderr, "kernel_launch: unexpected sizes (n_in %d, ws %zu need %zu, out %d)\n", n_in, ws_size, (size_t)WS_END, out_size); return; }
    static int grid = 0;
    if (!grid) { int dev = 0, cus = 0; hipGetDevice(&dev); hipDeviceGetAttribute(&cus, hipDeviceAttributeMultiprocessorCount, dev); grid = cus > 0 ? cus : 256; }
    hipMemsetAsync((unsigned char*)d_ws + WS_CTRL, 0, CTRL_BYTES, stream);
    Params p{};
    for (int i = 0; i < 29; ++i) p.in[i] = (const float*)d_in[i];
    p.out = (float*)d_out; p.ws = (unsigned char*)d_ws;
#ifdef MULTI_LAUNCH
    for (int ph = 0; ph < NPHASE; ++ph) { p.ph_lo = ph; p.ph_hi = ph + 1; hipLaunchKernelGGL(mega, dim3(grid), dim3(NT), 0, stream, p); }
#else
    p.ph_lo = 0; p.ph_hi = NPHASE;
    hipLaunchKernelGGL(mega, dim3(grid), dim3(NT), 0, stream, p);
#endif
}
#endif
```

```cpp
#ifndef HOST_EMU
#include <hip/hip_runtime.h>
#include <cstdio>
#endif

#ifndef CFG_B
#define CFG_B 8
#define CFG_L 2048
#define CFG_LC 256
#endif
#define DEV __device__ __forceinline__
#ifndef HOST_EMU
#define SCHED_FENCE() __builtin_amdgcn_sched_barrier(0)
#endif
#ifdef HOST_EMU
#define SCHED_FENCE() do {} while (0)
#define __expf expf
#define __logf logf
#define __log2f log2f
#define __exp2f exp2f
#define __sinf sinf
#define __cosf cosf
#endif

typedef unsigned short bf16_t;
typedef short bf16x8 __attribute__((ext_vector_type(8)));
typedef float f32x16 __attribute__((ext_vector_type(16)));
typedef float f32x4 __attribute__((ext_vector_type(4)));
typedef unsigned u32x4 __attribute__((ext_vector_type(4)));
typedef unsigned u32x2 __attribute__((ext_vector_type(2)));
struct cf2 { float x, y; };

constexpr int NB = CFG_B, L = CFG_L, LC = CFG_LC, D = 1024;
constexpr int TL = NB * L, TC = NB * LC, T = TL + TC;
constexpr int NT = 512;
constexpr int NR = NB + 1;
constexpr int log4ceil(int n) { int s = 0, v = 1; while (v < n) { v *= 4; ++s; } return s; }
constexpr int FS_LAT = log4ceil(2 * L - 1), FS_CTX = log4ceil(2 * LC - 1);
constexpr int NF_LAT = 1 << (2 * FS_LAT), NF_CTX = 1 << (2 * FS_CTX);
static_assert(T % 256 == 0 && TL % 256 == 0 && L % 128 == 0 && LC % 128 == 0 && NB % 2 == 0, "shape");

constexpr size_t al256(size_t x) { return (x + 255) & ~(size_t)255; }
constexpr size_t WS_CTRL = 0, CTRL_BYTES = 65536;
constexpr size_t CTRL_HYNORM = 4096;
constexpr size_t WS_MOD = WS_CTRL + CTRL_BYTES;
constexpr size_t WS_H = al256(WS_MOD + (size_t)2 * NR * 6144 * 4);
constexpr size_t WS_A = al256(WS_H + (size_t)T * 1024 * 4);
constexpr size_t WS_P = al256(WS_A + (size_t)T * 1024 * 2);
constexpr size_t P_BYTES = (size_t)T * 5120 * 2;
constexpr size_t P_HYT_LAT = 0;
constexpr size_t P_HYT_CTX = P_HYT_LAT + (size_t)NB * 1536 * L * 2;
constexpr size_t P_Q0 = P_HYT_CTX + (size_t)NB * 1536 * LC * 2;
constexpr size_t P_K0 = P_Q0 + (size_t)T * 512 * 2;
constexpr size_t P_VT_LAT = P_K0 + (size_t)T * 128 * 2;
constexpr size_t P_VT_CTX = P_VT_LAT + (size_t)NB * 128 * L * 2;
static_assert(P_VT_CTX + (size_t)NB * 128 * LC * 2 <= P_BYTES, "P region");
constexpr size_t P1_KQT_LAT = 0;
constexpr size_t P1_KQT_CTX = P1_KQT_LAT + (size_t)NB * 3072 * L * 2;
constexpr size_t P1_G = P1_KQT_CTX + (size_t)NB * 3072 * LC * 2;
static_assert(P1_G + (size_t)TL * 1024 * 2 <= P_BYTES, "P region (layer 1)");
constexpr size_t WS_M = al256(WS_P + P_BYTES);
constexpr size_t WS_IDX = al256(WS_M + (size_t)T * 1024 * 2);
constexpr size_t WS_GATE = al256(WS_IDX + (size_t)T * 128 * 4);
constexpr size_t WS_U6 = al256(WS_GATE + (size_t)T * 128 * 4);
constexpr size_t WS_V4 = WS_U6 + (size_t)2 * 16384 * 768;
constexpr size_t WS_S8 = WS_V4 + (size_t)2 * 16384 * 512;
constexpr size_t WS_W = al256(WS_S8 + (size_t)4 * 16384 * 4);
constexpr size_t W_IN0 = 0, W_OUT0 = W_IN0 + (size_t)2304 * 1024 * 2, W_IN1 = W_OUT0 + (size_t)1024 * 1024 * 2,
                 W_OUT1 = W_IN1 + (size_t)5120 * 1024 * 2, W_Q0 = W_OUT1 + (size_t)1024 * 1024 * 2, W_Q1 = W_Q0 + (size_t)2048 * 1024 * 2,
                 W_KEYS = W_Q1 + (size_t)2048 * 1024 * 2, W_BYTES = W_KEYS + (size_t)2 * 8 * 2 * 128 * 128 * 2;
constexpr size_t WS_F = al256(WS_W + W_BYTES);
constexpr size_t F_HRAW_LAT = 0;
constexpr size_t F_HRAW_CTX = F_HRAW_LAT + (size_t)2048 * L * 4;
constexpr size_t F_HF_LAT = F_HRAW_CTX + (size_t)2048 * LC * 4;
constexpr size_t F_HF_CTX = F_HF_LAT + (size_t)1024 * NF_LAT * 8;
constexpr size_t F_HYP_LAT = F_HF_CTX + (size_t)1024 * NF_CTX * 8;
constexpr size_t F_HYP_CTX = F_HYP_LAT + (size_t)(L / 64) * 2048 * 4;
constexpr size_t F_END = F_HYP_CTX + (size_t)(LC / 64) * 2048 * 4;
constexpr size_t F_OF = 0, F_OB = (size_t)TL * 1024 * 2;
constexpr size_t F_BYTES = F_END > 2 * F_OB ? F_END : 2 * F_OB;
constexpr size_t WS_END = al256(WS_F + F_BYTES);

struct Params { const float* in[29]; float* out; unsigned char* ws; int ph_lo, ph_hi; };
enum { I_X = 0, I_C, I_CTX, I_CCTX, I_ADAW, I_ADAB, I_N1G, I_N2G, I_FG, I_ABWIN, I_ABWOUT, I_HYCW, I_HYCB, I_HYW1, I_HYB1, I_HYW2, I_HYB2, I_HYW3,
       I_HYFREQ, I_HYSKIP, I_SINK, I_HGWIN, I_HGWOUT, I_HGLB, I_HGON, I_PWQ, I_PKEYS, I_PU, I_PV };

constexpr int SMEM_BYTES = 147456;

#ifndef HOST_EMU
DEV int tidx() { int t = threadIdx.x; asm volatile("" : "+v"(t)); return t; }
#else
DEV int tidx() { return (int)threadIdx.x; }
#endif
#ifndef HOST_EMU
DEV void lds_barrier() { asm volatile("s_waitcnt lgkmcnt(0)" ::: "memory"); __builtin_amdgcn_s_barrier(); asm volatile("" ::: "memory"); }
#else
DEV void lds_barrier() { __syncthreads(); }
#endif
#ifndef HOST_EMU
typedef __bf16 bf16n2 __attribute__((ext_vector_type(2)));
DEV unsigned pk2(float lo, float hi) { bf16n2 v; v[0] = (__bf16)lo; v[1] = (__bf16)hi; return __builtin_bit_cast(unsigned, v); }
DEV unsigned f2bf(float f) { return (unsigned)__builtin_bit_cast(unsigned short, (__bf16)f); }
#else
DEV unsigned f2bf(float f) { unsigned u = __builtin_bit_cast(unsigned, f); return (u + 0x7fffu + ((u >> 16) & 1u)) >> 16; }
DEV unsigned pk2(float lo, float hi) { return f2bf(lo) | (f2bf(hi) << 16); }
#endif
DEV float bf2f(unsigned h) { return __builtin_bit_cast(float, (h & 0xffffu) << 16); }
DEV float bflo(unsigned u) { return __builtin_bit_cast(float, u << 16); }
DEV float bfhi(unsigned u) { return __builtin_bit_cast(float, u & 0xffff0000u); }
DEV float silu_f(float x) { return x * __builtin_amdgcn_rcpf(1.f + __expf(-x)); }
DEV float sigmoid_f(float x) { return __builtin_amdgcn_rcpf(1.f + __expf(-x)); }
DEV float wave_sum(float v) {
#pragma unroll
    for (int m = 32; m >= 1; m >>= 1) v += __shfl_xor(v, m);
    return v;
}
DEV int mod_row(int tok) { return tok < TL ? tok / L : NB; }

DEV void p0_mod(const Params& p, int item, unsigned char* smem) {
    const int l = item / 96, col0 = (item % 96) * 64, tid = tidx();
    float* sc = (float*)smem;
    float* red = sc + NR * 1024;
    for (int i = tid; i < NR * 1024; i += NT) { const int r = i >> 10, k = i & 1023; const float c = r < NB ? p.in[I_C][r * 1024 + k] : p.in[I_CCTX][k]; sc[i] = c / (1.f + expf(-c)); }
    __syncthreads();
    const int kq = tid >> 6, col = tid & 63;
    float acc[NR];
#pragma unroll
    for (int r = 0; r < NR; ++r) acc[r] = 0.f;
    const float* w = p.in[I_ADAW] + (size_t)l * 1024 * 6144 + col0 + col;
#pragma unroll 16
    for (int k = kq * 128; k < kq * 128 + 128; ++k) {
        const float wv = w[(size_t)k * 6144];
#pragma unroll
        for (int r = 0; r < NR; ++r) acc[r] += sc[r * 1024 + k] * wv;
    }
#pragma unroll
    for (int r = 0; r < NR; ++r) red[(kq * NR + r) * 64 + col] = acc[r];
    __syncthreads();
    float* mod = (float*)(p.ws + WS_MOD);
    for (int i = tid; i < NR * 64; i += NT) {
        const int r = i >> 6, c = i & 63; float s = 0.f;
        for (int q = 0; q < 8; ++q) s += red[(q * NR + r) * 64 + c];
        mod[((size_t)l * NR + r) * 6144 + col0 + c] = s + p.in[I_ADAB][l * 6144 + col0 + c];
    }
    __syncthreads();
}
DEV void p0_transpose(const float* W, bf16_t* Wt, int N, int tile, unsigned char* smem) {
    float* ts = (float*)smem;
    const int ntn = N / 256, kt = tile / ntn, nt = tile % ntn, k0 = kt * 64, n0 = nt * 256, tid = tidx();
    f32x4 rv[8];
#pragma unroll
    for (int m = 0; m < 8; ++m) { const int i = tid + NT * m, kk = i >> 6, c4 = i & 63; rv[m] = *(const f32x4*)(W + (size_t)(k0 + kk) * N + n0 + c4 * 4); }
#pragma unroll
    for (int m = 0; m < 8; ++m) { const int i = tid + NT * m, kk = i >> 6, c4 = i & 63; *(f32x4*)(ts + kk * 260 + c4 * 4) = rv[m]; }
    __syncthreads();
#pragma unroll
    for (int m = 0; m < 4; ++m) { const int i = tid + NT * m, nn = i >> 3, k8 = i & 7;
        u32x4 o;
#pragma unroll
        for (int e = 0; e < 4; ++e) o[e] = pk2(ts[(k8 * 8 + 2 * e) * 260 + nn], ts[(k8 * 8 + 2 * e + 1) * 260 + nn]);
        *(u32x4*)(Wt + (size_t)(n0 + nn) * 1024 + k0 + k8 * 8) = o; }
    __syncthreads();
}
DEV void p0_convert(const float* src, bf16_t* dst, int item) {
    const int tid = tidx();
#pragma unroll
    for (int i = 0; i < 8; ++i) {
        const size_t e = (size_t)item * 16384 + (size_t)(i * NT + tid) * 4;
        const f32x4 v = *(const f32x4*)(src + e);
        u32x2 o; o[0] = pk2(v[0], v[1]); o[1] = pk2(v[2], v[3]);
        *(u32x2*)(dst + e) = o;
    }
}
typedef float f32x2 __attribute__((ext_vector_type(2)));
typedef float f32x32 __attribute__((ext_vector_type(32)));
typedef unsigned u32x6 __attribute__((ext_vector_type(6)));
DEV void p0_table(const Params& p, int tab, int item) {
    const int lane = tidx() & 63, li = lane & 31, half = lane >> 5, layer = tab >> 1, isv = tab & 1;
#pragma unroll 1
    for (int pass = 0; pass < 2; ++pass) {
        const int row = item * 32 + pass * 16 + (tidx() >> 6) * 2 + half;
        const float* src = (isv ? p.in[I_PV] : p.in[I_PU]) + ((size_t)layer * 16384 + row) * 1024 + li * 32;
        f32x4 v[8]; float mx = 0.f;
#pragma unroll
        for (int i = 0; i < 8; ++i) { v[i] = *(const f32x4*)(src + 4 * i); mx = fmaxf(mx, fmaxf(fmaxf(fabsf(v[i][0]), fabsf(v[i][1])), fmaxf(fabsf(v[i][2]), fabsf(v[i][3])))); }
#pragma unroll
        for (int m = 16; m >= 1; m >>= 1) mx = fmaxf(mx, __shfl_xor(mx, m));
        const float top = isv ? 6.f : 7.5f;
        const float sc = mx > 0.f ? top / mx : 1.f;
        if (!isv) {
            f32x16 pa, pb;
#pragma unroll
            for (int i = 0; i < 16; ++i) { pa[i] = 0.f; pb[i] = 0.f; }
            pa[1] = 1.0f;
            const f32x32 pr = __builtin_amdgcn_cvt_scalef32_pk32_f32_fp6(__builtin_amdgcn_cvt_scalef32_2xpk16_fp6_f32(pa, pb, 1.0f), 1.0f);
            const bool inter = pr[2] == 1.0f;
            f32x16 lo, hi;
#pragma unroll
            for (int i = 0; i < 4; ++i)
#pragma unroll
                for (int e = 0; e < 4; ++e) {
                    const int j = 4 * i + e;
                    const float lin_lo = v[i][e], lin_hi = v[4 + i][e];
                    const float il_lo = v[(2 * j) >> 2][(2 * j) & 3], il_hi = v[(2 * j + 1) >> 2][(2 * j + 1) & 3];
                    lo[j] = (inter ? il_lo : lin_lo) * sc; hi[j] = (inter ? il_hi : lin_hi) * sc;
                }
            const u32x6 w = __builtin_amdgcn_cvt_scalef32_2xpk16_fp6_f32(lo, hi, 1.0f);
            unsigned char* dst = p.ws + WS_U6 + ((size_t)layer * 16384 + row) * 768;
            u32x4 w0; w0[0] = w[0]; w0[1] = w[1]; w0[2] = w[2]; w0[3] = w[3]; u32x2 w1; w1[0] = w[4]; w1[1] = w[5];
            *(u32x4*)(dst + li * 16) = w0; *(u32x2*)(dst + 512 + li * 8) = w1;
        } else {
            const f32x2 pr4 = __builtin_amdgcn_cvt_scalef32_pk_f32_fp4(__builtin_amdgcn_cvt_scalef32_pk_fp4_f32(0u, 1.0f, 0.0f, 1.0f, 0), 1.0f, 0);
            const bool swp = pr4[0] != 1.0f;
            u32x4 w;
#pragma unroll
            for (int d = 0; d < 4; ++d) { unsigned x = 0u;
                x = __builtin_amdgcn_cvt_scalef32_pk_fp4_f32(x, (swp ? v[2 * d][1] : v[2 * d][0]) * sc, (swp ? v[2 * d][0] : v[2 * d][1]) * sc, 1.0f, 0);
                x = __builtin_amdgcn_cvt_scalef32_pk_fp4_f32(x, (swp ? v[2 * d][3] : v[2 * d][2]) * sc, (swp ? v[2 * d][2] : v[2 * d][3]) * sc, 1.0f, 1);
                x = __builtin_amdgcn_cvt_scalef32_pk_fp4_f32(x, (swp ? v[2 * d + 1][1] : v[2 * d + 1][0]) * sc, (swp ? v[2 * d + 1][0] : v[2 * d + 1][1]) * sc, 1.0f, 2);
                x = __builtin_amdgcn_cvt_scalef32_pk_fp4_f32(x, (swp ? v[2 * d + 1][3] : v[2 * d + 1][2]) * sc, (swp ? v[2 * d + 1][2] : v[2 * d + 1][3]) * sc, 1.0f, 3);
                w[d] = x; }
            *(u32x4*)(p.ws + WS_V4 + ((size_t)layer * 16384 + row) * 512 + li * 16) = w;
        }
        if (li == 0) ((float*)(p.ws + WS_S8))[tab * 16384 + row] = mx > 0.f ? mx / top : 1.f;
    }
}
DEV void p0_filter(const Params& p, int set, int chunk, int cb, unsigned char* smem) {
    const int Ls = set ? LC : L, l0 = chunk * 64, tid = tidx();
    float* z = (float*)smem;
    float* hd1 = z + 64 * 34;
    float* hd2 = hd1 + 64 * 65;
    const float* w1 = p.in[I_HYW1]; const float* b1 = p.in[I_HYB1]; const float* w2 = p.in[I_HYW2]; const float* b2 = p.in[I_HYB2];
    const float* w3 = p.in[I_HYW3]; const float* fq = p.in[I_HYFREQ];
    for (int i = tid; i < 64 * 33; i += NT) {
        const int pp = i / 33, f = i % 33, l = l0 + pp; float val;
        if (f == 0) val = (float)l / (float)(Ls - 1);
        else { const int jb = (f - 1) & 15; const float fj = 1e-4f + (float)jb * ((15.f - 1e-4f) / 15.f); const float a = fj * (6.283185307179586f * (float)l / (float)Ls); val = f <= 16 ? __cosf(a) : -__sinf(a); }
        z[pp * 34 + f] = val;
    }
    __syncthreads();
    {
        const int j = tid & 63, p0 = tid >> 6;
        float wc[64], acc[8];
#pragma unroll
        for (int f = 0; f < 33; ++f) wc[f] = w1[f * 64 + j];
#pragma unroll
        for (int m = 0; m < 8; ++m) { float sacc = b1[j];
#pragma unroll
            for (int f = 0; f < 33; ++f) sacc = fmaf(z[(p0 + 8 * m) * 34 + f], wc[f], sacc);
            acc[m] = sacc; }
#pragma unroll
        for (int m = 0; m < 8; ++m) hd1[(p0 + 8 * m) * 65 + j] = __sinf(fq[j] * acc[m]);
        __syncthreads();
#pragma unroll
        for (int f = 0; f < 64; ++f) wc[f] = w2[f * 64 + j];
#pragma unroll
        for (int m = 0; m < 8; ++m) { float sacc = b2[j];
#pragma unroll
            for (int f = 0; f < 64; ++f) sacc = fmaf(hd1[(p0 + 8 * m) * 65 + f], wc[f], sacc);
            acc[m] = sacc; }
#pragma unroll
        for (int m = 0; m < 8; ++m) hd2[(p0 + 8 * m) * 65 + j] = __sinf(fq[j] * acc[m]);
        __syncthreads();
    }
    const float max_decay = -15.350567286626973f, min_decay = -3.0701134573253945f;
    float* hraw = (float*)(p.ws + WS_F + (set ? F_HRAW_CTX : F_HRAW_LAT));
    float* hyn = (float*)(p.ws + WS_F + (set ? F_HYP_CTX : F_HYP_LAT)) + (size_t)chunk * 2048;
    {
        const int o = cb * NT + tid;
        const int c = o & 511; const float delta = fabsf(min_decay + (float)c * ((max_decay - min_decay) / 511.f));
        float asum = 0.f;
        float* dst = hraw + (size_t)o * Ls + l0;
        for (int ph = 0; ph < 2; ++ph) {
            float acc[32];
#pragma unroll
            for (int pp = 0; pp < 32; ++pp) acc[pp] = 0.f;
#pragma unroll 1
            for (int j0 = 0; j0 < 64; j0 += 16) {
                float wv[16];
#pragma unroll
                for (int j = 0; j < 16; ++j) wv[j] = w3[(j0 + j) * 2048 + o];
#pragma unroll
                for (int j = 0; j < 16; ++j) {
#pragma unroll
                    for (int pp = 0; pp < 32; ++pp) acc[pp] = fmaf(hd2[(ph * 32 + pp) * 65 + j0 + j], wv[j], acc[pp]);
                    SCHED_FENCE();
                }
            }
#pragma unroll
            for (int q4 = 0; q4 < 8; ++q4) {
                f32x4 v;
#pragma unroll
                for (int e = 0; e < 4; ++e) { const int pp = q4 * 4 + e; const float tl = (float)(l0 + ph * 32 + pp) / (float)(Ls - 1); const float val = acc[pp] * expf(-tl * delta); v[e] = val; asum += fabsf(val); }
                *(f32x4*)(dst + ph * 32 + q4 * 4) = v;
            }
        }
        hyn[o] = asum;
    }
    __syncthreads();
}

constexpr int P0_MOD = 192, P0_TR_IN0 = 16 * 9, P0_TR_OUT0 = 64, P0_TR_IN1 = 16 * 20, P0_TR_OUT1 = 64, P0_TR_Q = 16 * 8, P0_KEYS = 32, P0_TAB = 512,
              P0_FILT = 4 * (L / 64 + LC / 64);
DEV void phase0(const Params& p, unsigned char* smem) {
    bf16_t* W = (bf16_t*)(p.ws + WS_W);
    const int total = P0_MOD + P0_FILT + P0_TR_IN0 + P0_TR_OUT0 + P0_TR_IN1 + P0_TR_OUT1 + 2 * P0_TR_Q + P0_KEYS;
    for (int it = blockIdx.x; it < total; it += gridDim.x) {
        int i = it;
        if (i < P0_MOD) { p0_mod(p, i, smem); continue; } i -= P0_MOD;
        if (i < P0_FILT) { const int ch = i >> 2, cb = i & 3; if (ch < L / 64) p0_filter(p, 0, ch, cb, smem); else p0_filter(p, 1, ch - L / 64, cb, smem); continue; } i -= P0_FILT;
        if (i < P0_TR_IN0) { p0_transpose(p.in[I_ABWIN], W + W_IN0 / 2, 2304, i, smem); continue; } i -= P0_TR_IN0;
        if (i < P0_TR_OUT0) { p0_transpose(p.in[I_ABWOUT], W + W_OUT0 / 2, 1024, i, smem); continue; } i -= P0_TR_OUT0;
        if (i < P0_TR_IN1) { p0_transpose(p.in[I_HGWIN], W + W_IN1 / 2, 5120, i, smem); continue; } i -= P0_TR_IN1;
        if (i < P0_TR_OUT1) { p0_transpose(p.in[I_HGWOUT], W + W_OUT1 / 2, 1024, i, smem); continue; } i -= P0_TR_OUT1;
        if (i < P0_TR_Q) { p0_transpose(p.in[I_PWQ], W + W_Q0 / 2, 2048, i, smem); continue; } i -= P0_TR_Q;
        if (i < P0_TR_Q) { p0_transpose(p.in[I_PWQ] + (size_t)1024 * 2048, W + W_Q1 / 2, 2048, i, smem); continue; } i -= P0_TR_Q;
        p0_convert(p.in[I_PKEYS], W + W_KEYS / 2, i);
    }
}

DEV const float* h_row(const Params& p, int layer_src_inputs, int tok) {
    if (layer_src_inputs) return tok < TL ? p.in[I_X] + (size_t)tok * 1024 : p.in[I_CTX] + (size_t)(tok - TL) * 1024;
    return (const float*)(p.ws + WS_H) + (size_t)tok * 1024;
}
DEV void norm_row_store(const Params& p, const f32x4 (&v)[4], int tok, const float* g, int layer, int sh_off, int lane) {
    float ss = 0.f;
#pragma unroll
    for (int i = 0; i < 4; ++i) ss += v[i][0] * v[i][0] + v[i][1] * v[i][1] + v[i][2] * v[i][2] + v[i][3] * v[i][3];
    ss = wave_sum(ss);
    const float rstd = rsqrtf(ss * (1.f / 1024.f) + 1e-6f);
    const float* mod = (const float*)(p.ws + WS_MOD) + ((size_t)layer * NR + mod_row(tok)) * 6144 + sh_off;
    bf16_t* A = (bf16_t*)(p.ws + WS_A) + (size_t)tok * 1024;
#pragma unroll
    for (int i = 0; i < 4; ++i) {
        const int c = i * 256 + lane * 4;
        const f32x4 gg = *(const f32x4*)(g + c), sh = *(const f32x4*)(mod + c), sc = *(const f32x4*)(mod + 1024 + c);
        u32x2 o;
        o[0] = pk2(v[i][0] * rstd * gg[0] * (1.f + sc[0]) + sh[0], v[i][1] * rstd * gg[1] * (1.f + sc[1]) + sh[1]);
        o[1] = pk2(v[i][2] * rstd * gg[2] * (1.f + sc[2]) + sh[2], v[i][3] * rstd * gg[3] * (1.f + sc[3]) + sh[3]);
        *(u32x2*)(A + c) = o;
    }
}
DEV void norm_rows_item(const Params& p, int item, int from_inputs, const float* g, int layer, int sh_off) {
    const int tok = item * 8 + (tidx() >> 6), lane = tidx() & 63;
    const float* src = h_row(p, from_inputs, tok);
    f32x4 v[4];
#pragma unroll
    for (int i = 0; i < 4; ++i) v[i] = *(const f32x4*)(src + i * 256 + lane * 4);
    norm_row_store(p, v, tok, g, layer, sh_off, lane);
}

DEV cf2 cmul(cf2 a, cf2 b) { cf2 r; r.x = a.x * b.x - a.y * b.y; r.y = a.x * b.y + a.y * b.x; return r; }
DEV cf2 twid(int k, float invN) { cf2 r; const float a = (float)k * invN; r.x = __builtin_amdgcn_cosf(a); r.y = -__builtin_amdgcn_sinf(a); return r; }
DEV int fsw(int i) { return i ^ ((i >> 4) & 15) ^ (((i >> 8) & 1) << 4); }
DEV void bfly4_fwd(cf2& a0, cf2& a1, cf2& a2, cf2& a3) {
    cf2 t0, t1, t2, t3; t0.x = a0.x + a2.x; t0.y = a0.y + a2.y; t1.x = a0.x - a2.x; t1.y = a0.y - a2.y; t2.x = a1.x + a3.x; t2.y = a1.y + a3.y;
    const float dx = a1.x - a3.x, dy = a1.y - a3.y; t3.x = dy; t3.y = -dx;
    a0.x = t0.x + t2.x; a0.y = t0.y + t2.y; a1.x = t1.x + t3.x; a1.y = t1.y + t3.y; a2.x = t0.x - t2.x; a2.y = t0.y - t2.y; a3.x = t1.x - t3.x; a3.y = t1.y - t3.y;
}
DEV void bfly4_inv(cf2& c0, cf2& c1, cf2& c2, cf2& c3) {
    cf2 t0, t1, t2, t3; t0.x = c0.x + c2.x; t0.y = c0.y + c2.y; t1.x = c0.x - c2.x; t1.y = c0.y - c2.y; t2.x = c1.x + c3.x; t2.y = c1.y + c3.y;
    const float dx = c1.x - c3.x, dy = c1.y - c3.y; t3.x = -dy; t3.y = dx;
    c0.x = t0.x + t2.x; c0.y = t0.y + t2.y; c1.x = t1.x + t3.x; c1.y = t1.y + t3.y; c2.x = t0.x - t2.x; c2.y = t0.y - t2.y; c3.x = t1.x - t3.x; c3.y = t1.y - t3.y;
}
DEV void fft_stage4(cf2* buf, int S, int s, int g, int G, bool inv) {
    const int N = 1 << (2 * S); const float invN = 1.f / (float)N;
    const int lm = 2 * (S - s), m = 1 << lm, q = m >> 2;
    for (int bf = g; bf < (N >> 2); bf += G) {
        const int j = bf & (q - 1), base = ((bf >> (lm - 2)) << lm) + j, tw = j << (2 * s);
        cf2 a0 = buf[fsw(base)], a1 = buf[fsw(base + q)], a2 = buf[fsw(base + 2 * q)], a3 = buf[fsw(base + 3 * q)];
        if (!inv) { bfly4_fwd(a0, a1, a2, a3); a1 = cmul(a1, twid(tw, invN)); a2 = cmul(a2, twid(2 * tw, invN)); a3 = cmul(a3, twid(3 * tw, invN)); }
        else { cf2 w1 = twid(tw, invN), w2 = twid(2 * tw, invN), w3 = twid(3 * tw, invN); w1.y = -w1.y; w2.y = -w2.y; w3.y = -w3.y; a1 = cmul(a1, w1); a2 = cmul(a2, w2); a3 = cmul(a3, w3); bfly4_inv(a0, a1, a2, a3); }
        buf[fsw(base)] = a0; buf[fsw(base + q)] = a1; buf[fsw(base + 2 * q)] = a2; buf[fsw(base + 3 * q)] = a3;
    }
}
DEV void fft_stage16(cf2* buf, int S, int s, int g, int G, bool inv) {
    const int N = 1 << (2 * S); const float invN = 1.f / (float)N;
    const int lm = 2 * (S - s), m = 1 << lm, q = m >> 2, q2 = q >> 2;
    for (int u = g; u < (N >> 4); u += G) {
        const int j2 = u & (q2 - 1), base = ((u >> (lm - 4)) << lm) + j2;
        cf2 x[4][4];
#pragma unroll
        for (int c = 0; c < 4; ++c)
#pragma unroll
            for (int c2 = 0; c2 < 4; ++c2) x[c][c2] = buf[fsw(base + c * q + c2 * q2)];
        if (!inv) {
#pragma unroll
            for (int c2 = 0; c2 < 4; ++c2) {
                const int tw = (j2 + c2 * q2) << (2 * s);
                bfly4_fwd(x[0][c2], x[1][c2], x[2][c2], x[3][c2]);
                x[1][c2] = cmul(x[1][c2], twid(tw, invN)); x[2][c2] = cmul(x[2][c2], twid(2 * tw, invN)); x[3][c2] = cmul(x[3][c2], twid(3 * tw, invN));
                SCHED_FENCE();
            }
            const int tw2 = j2 << (2 * (s + 1));
            const cf2 v1 = twid(tw2, invN), v2 = twid(2 * tw2, invN), v3 = twid(3 * tw2, invN);
#pragma unroll
            for (int c = 0; c < 4; ++c) {
                bfly4_fwd(x[c][0], x[c][1], x[c][2], x[c][3]);
                x[c][1] = cmul(x[c][1], v1); x[c][2] = cmul(x[c][2], v2); x[c][3] = cmul(x[c][3], v3);
            }
        } else {
            const int tw2 = j2 << (2 * (s + 1));
            cf2 v1 = twid(tw2, invN), v2 = twid(2 * tw2, invN), v3 = twid(3 * tw2, invN); v1.y = -v1.y; v2.y = -v2.y; v3.y = -v3.y;
#pragma unroll
            for (int c = 0; c < 4; ++c) {
                x[c][1] = cmul(x[c][1], v1); x[c][2] = cmul(x[c][2], v2); x[c][3] = cmul(x[c][3], v3);
                bfly4_inv(x[c][0], x[c][1], x[c][2], x[c][3]);
            }
#pragma unroll
            for (int c2 = 0; c2 < 4; ++c2) {
                const int tw = (j2 + c2 * q2) << (2 * s);
                cf2 w1 = twid(tw, invN), w2 = twid(2 * tw, invN), w3 = twid(3 * tw, invN); w1.y = -w1.y; w2.y = -w2.y; w3.y = -w3.y;
                x[1][c2] = cmul(x[1][c2], w1); x[2][c2] = cmul(x[2][c2], w2); x[3][c2] = cmul(x[3][c2], w3);
                bfly4_inv(x[0][c2], x[1][c2], x[2][c2], x[3][c2]);
                SCHED_FENCE();
            }
        }
#pragma unroll
        for (int c = 0; c < 4; ++c)
#pragma unroll
            for (int c2 = 0; c2 < 4; ++c2) buf[fsw(base + c * q + c2 * q2)] = x[c][c2];
    }
}
DEV void fft_fwd(cf2* buf, int S, int g, int G) {
    int s = 0;
    for (; s + 1 < S; s += 2) { fft_stage16(buf, S, s, g, G, false); __syncthreads(); }
    if (s < S) { fft_stage4(buf, S, s, g, G, false); __syncthreads(); }
}
DEV void fft_inv(cf2* buf, int S, int g, int G) {
    int s = S - 1;
    if (S & 1) { fft_stage4(buf, S, s, g, G, true); __syncthreads(); --s; }
    for (; s >= 1; s -= 2) { fft_stage16(buf, S, s - 1, g, G, true); __syncthreads(); }
}
DEV void hf_item(const Params& p, int set, int pi, unsigned char* smem) {
    const int Ls = set ? LC : L, S = set ? FS_CTX : FS_LAT, N = 1 << (2 * S);
    const int gi = tidx() >> 8, g = tidx() & 255, idx = pi * 2 + gi, o = idx >> 9, c = idx & 511;
    cf2* buf = (cf2*)smem + (size_t)gi * N;
    const float* hraw = (const float*)(p.ws + WS_F + (set ? F_HRAW_CTX : F_HRAW_LAT));
    const float* hyn = (const float*)(p.ws + WS_F + (set ? F_HYP_CTX : F_HYP_LAT));
    float nsum = 0.f;
    for (int ch = 0; ch < Ls / 64; ++ch) nsum += hyn[(size_t)ch * 2048 + o * 1024 + c] + hyn[(size_t)ch * 2048 + o * 1024 + 512 + c];
    const float inv = 1.f / nsum;
    const float* hf = hraw + (size_t)(o * 1024 + c) * Ls; const float* hb = hraw + (size_t)(o * 1024 + 512 + c) * Ls;
#pragma unroll 4
    for (int k = g; k < N; k += 256) { float re = 0.f; if (k < Ls) re = hf[k] * inv; else if (k > N - Ls) re = hb[N - k] * inv; cf2 v; v.x = re; v.y = 0.f; buf[fsw(k)] = v; }
    __syncthreads();
    fft_fwd(buf, S, g, 256);
    cf2* HF = (cf2*)(p.ws + WS_F + (set ? F_HF_CTX : F_HF_LAT)) + (size_t)(o * 512 + c) * N;
    for (int k = g; k < N; k += 256) HF[k] = buf[fsw(k)];
    __syncthreads();
}
constexpr int P1_NORM = T / 8, P1_HF = 512;
DEV void phase1(const Params& p, unsigned char* smem) {
    const int total = P1_NORM + 2 * P1_HF;
    for (int it = blockIdx.x; it < total; it += gridDim.x) {
        if (it < P1_NORM) norm_rows_item(p, it, 1, p.in[I_N1G], 0, 0);
        else if (it < P1_NORM + P1_HF) hf_item(p, 0, it - P1_NORM, smem);
        else hf_item(p, 1, it - P1_NORM - P1_HF, smem);
    }
}

constexpr int G_LDA = 72;
template <class Epi>
DEV void gemm_tile(const bf16_t* __restrict__ A, const bf16_t* __restrict__ Wt, int m0, int n0, unsigned char* smem, const Epi& epi, int var = 0) {
    bf16_t* As = (bf16_t*)smem;
    bf16_t* Bs = As + 2 * 256 * G_LDA;
    const int tid = tidx(), lane = tid & 63, w = tid >> 6, wm = w >> 1, wn = w & 1;
    f32x16 acc[2][2];
#pragma unroll
    for (int i = 0; i < 2; ++i)
#pragma unroll
        for (int j = 0; j < 2; ++j)
#pragma unroll
            for (int r = 0; r < 16; ++r) acc[i][j][r] = 0.f;
    u32x4 ra[4], rb[2];
    const bf16_t* Ag = A + (size_t)m0 * 1024; const bf16_t* Bg = Wt + (size_t)n0 * 1024;
#define GLOAD(k0) do { \
        _Pragma("unroll") for (int i = 0; i < 4; ++i) { const int id = tid + NT * i, row = id >> 3, kc = id & 7; ra[i] = *(const u32x4*)(Ag + (size_t)row * 1024 + (k0) + kc * 8); } \
        _Pragma("unroll") for (int i = 0; i < 2; ++i) { const int id = tid + NT * i, row = id >> 3, kc = id & 7; rb[i] = *(const u32x4*)(Bg + (size_t)row * 1024 + (k0) + kc * 8); } } while (0)
#define LSTORE(buf_) do { \
        _Pragma("unroll") for (int i = 0; i < 4; ++i) { const int id = tid + NT * i, row = id >> 3, kc = id & 7; *(u32x4*)(As + ((buf_) * 256 + row) * G_LDA + kc * 8) = ra[i]; } \
        _Pragma("unroll") for (int i = 0; i < 2; ++i) { const int id = tid + NT * i, row = id >> 3, kc = id & 7; *(u32x4*)(Bs + ((buf_) * 128 + row) * G_LDA + kc * 8) = rb[i]; } } while (0)
    GLOAD(0); LSTORE(0); __syncthreads();
    for (int kt = 0; kt < (var == 2 ? 1 : 16); ++kt) {
        const int buf = kt & 1;
        if (kt + 1 < 16) GLOAD((kt + 1) * 64);
        const bf16_t* as = As + (buf * 256 + wm * 64 + (lane & 31)) * G_LDA + 8 * (lane >> 5);
        const bf16_t* bs = Bs + (buf * 128 + wn * 64 + (lane & 31)) * G_LDA + 8 * (lane >> 5);
#pragma unroll
        for (int kk = 0; kk < 4; ++kk) {
            const bf16x8 a0 = *(const bf16x8*)(as + kk * 16), a1 = *(const bf16x8*)(as + 32 * G_LDA + kk * 16);
            const bf16x8 b0 = *(const bf16x8*)(bs + kk * 16), b1 = *(const bf16x8*)(bs + 32 * G_LDA + kk * 16);
            acc[0][0] = __builtin_amdgcn_mfma_f32_32x32x16_bf16(a0, b0, acc[0][0], 0, 0, 0);
            acc[0][1] = __builtin_amdgcn_mfma_f32_32x32x16_bf16(a0, b1, acc[0][1], 0, 0, 0);
            acc[1][0] = __builtin_amdgcn_mfma_f32_32x32x16_bf16(a1, b0, acc[1][0], 0, 0, 0);
            acc[1][1] = __builtin_amdgcn_mfma_f32_32x32x16_bf16(a1, b1, acc[1][1], 0, 0, 0);
        }
        if (kt + 1 < 16) LSTORE(buf ^ 1);
        __syncthreads();
    }
#ifndef HOST_EMU
    if (var == 1) { asm volatile("" :: "v"(acc[0][0]), "v"(acc[0][1]), "v"(acc[1][0]), "v"(acc[1][1])); return; }
#endif
#pragma unroll
    for (int mi = 0; mi < 2; ++mi)
#pragma unroll
        for (int ni = 0; ni < 2; ++ni)
#pragma unroll
            for (int rg = 0; rg < 4; ++rg) {
                const int row = m0 + wm * 64 + mi * 32 + 8 * rg + 4 * (lane >> 5), col = n0 + wn * 64 + ni * 32 + (lane & 31);
                epi(row, col, acc[mi][ni][rg * 4 + 0], acc[mi][ni][rg * 4 + 1], acc[mi][ni][rg * 4 + 2], acc[mi][ni][rg * 4 + 3]);
            }
}
template <class Epi>
DEV void gemm_tile256(const bf16_t* __restrict__ A, const bf16_t* __restrict__ Wt, int m0, int n0, unsigned char* smem, const Epi& epi) {
    bf16_t* As = (bf16_t*)smem;
    bf16_t* Bs = As + 2 * 256 * G_LDA;
    const int tid = tidx(), lane = tid & 63, w = tid >> 6, wm = w >> 2, wn = w & 3;
    f32x16 acc[4][2];
#pragma unroll
    for (int i = 0; i < 4; ++i)
#pragma unroll
        for (int j = 0; j < 2; ++j)
#pragma unroll
            for (int r = 0; r < 16; ++r) acc[i][j][r] = 0.f;
    u32x4 ra[4], rb[4];
    const bf16_t* Ag = A + (size_t)m0 * 1024; const bf16_t* Bg = Wt + (size_t)n0 * 1024;
#define GLOAD2(k0) do { \
        _Pragma("unroll") for (int i = 0; i < 4; ++i) { const int id = tid + NT * i, row = id >> 3, kc = id & 7; ra[i] = *(const u32x4*)(Ag + (size_t)row * 1024 + (k0) + kc * 8); rb[i] = *(const u32x4*)(Bg + (size_t)row * 1024 + (k0) + kc * 8); } } while (0)
#define LSTORE2(buf_) do { \
        _Pragma("unroll") for (int i = 0; i < 4; ++i) { const int id = tid + NT * i, row = id >> 3, kc = id & 7; *(u32x4*)(As + ((buf_) * 256 + row) * G_LDA + kc * 8) = ra[i]; *(u32x4*)(Bs + ((buf_) * 256 + row) * G_LDA + kc * 8) = rb[i]; } } while (0)
    GLOAD2(0); LSTORE2(0); __syncthreads();
    for (int kt = 0; kt < 16; ++kt) {
        const int buf = kt & 1;
        if (kt + 1 < 16) GLOAD2((kt + 1) * 64);
        const bf16_t* as = As + (buf * 256 + wm * 128 + (lane & 31)) * G_LDA + 8 * (lane >> 5);
        const bf16_t* bs = Bs + (buf * 256 + wn * 64 + (lane & 31)) * G_LDA + 8 * (lane >> 5);
#pragma unroll
        for (int kk = 0; kk < 4; ++kk) {
            bf16x8 af[4], bfr[2];
#pragma unroll
            for (int i = 0; i < 4; ++i) af[i] = *(const bf16x8*)(as + i * 32 * G_LDA + kk * 16);
#pragma unroll
            for (int j = 0; j < 2; ++j) bfr[j] = *(const bf16x8*)(bs + j * 32 * G_LDA + kk * 16);
#pragma unroll
            for (int i = 0; i < 4; ++i)
#pragma unroll
                for (int j = 0; j < 2; ++j) acc[i][j] = __builtin_amdgcn_mfma_f32_32x32x16_bf16(af[i], bfr[j], acc[i][j], 0, 0, 0);
        }
        if (kt + 1 < 16) LSTORE2(buf ^ 1);
        __syncthreads();
    }
#undef GLOAD2
#undef LSTORE2
#pragma unroll
    for (int mi = 0; mi < 4; ++mi)
#pragma unroll
        for (int ni = 0; ni < 2; ++ni)
#pragma unroll
            for (int rg = 0; rg < 4; ++rg) {
                const int row = m0 + wm * 128 + mi * 32 + 8 * rg + 4 * (lane >> 5), col = n0 + wn * 64 + ni * 32 + (lane & 31);
                epi(row, col, acc[mi][ni][rg * 4 + 0], acc[mi][ni][rg * 4 + 1], acc[mi][ni][rg * 4 + 2], acc[mi][ni][rg * 4 + 3]);
            }
}
namespace pg8 {
#ifndef HOST_EMU
#define PG8_LAS __attribute__((address_space(3)))
#else
#define PG8_LAS
#endif
typedef unsigned short bf16_t;
constexpr int BM = 256, BK = 64, HALF = 128, HTB = HALF * BK * 2  , STAGE_BYTES = 8 * HTB, NXCD = 8, WGM = 8;

__host__ __device__ __forceinline__ int lds_byte(int r, int c) { const int st = (r >> 4) * 2 + (c >> 5), rr = r & 15, cc = c & 31, ob = rr * 64 + cc * 2; return st * 1024 + (ob ^ (((ob >> 9) & 1) << 5)); }
__host__ __device__ __forceinline__ void stage_rc(int b, int& R, int& C) { const int st = b / 1024, sb = b % 1024, swz = sb ^ (((sb >> 9) & 1) << 5); R = (st >> 1) * 16 + swz / 64; C = (st & 1) * 32 + (swz % 64) / 2; }
__host__ __device__ __forceinline__ int perm32(int rho) { const int n = rho >> 4, i = rho & 15; return 8 * (i >> 2) + 4 * n + (i & 3); }

struct Unit { int pm, pn; };
struct Gemm { const bf16_t* A; const bf16_t* Bt; int M, N, K; };

struct StaticOrder {
    int nM, nN, nwg, G, c;
    __host__ __device__ void init(int M, int N, int G_, int c_) { nM = M / BM; nN = N / BM; nwg = nM * nN; G = G_; c = c_; }
    __host__ __device__ bool next(int i, Unit& u) const {
        const long L = (long)i * G + c; if (L >= nwg) return false;
        int wgid = (int)L; { const int q = nwg / NXCD, r = nwg % NXCD, xcd = wgid % NXCD, off = wgid / NXCD; wgid = (xcd < r ? xcd * (q + 1) : r * (q + 1) + (xcd - r) * q) + off; }
        const int nig = WGM * nN, gid = wgid / nig, fm = gid * WGM, gsz = (nM - fm) < WGM ? (nM - fm) : WGM;
        u.pm = fm + ((wgid % nig) % gsz); u.pn = (wgid % nig) / gsz; return true;
    }
    __device__ __forceinline__ void a_ready(const Unit&) const {}
    __device__ __forceinline__ void done(const Unit&) const {}
};
template <class Epi, class Sched, bool STAMP = false>
__device__ __forceinline__ void gemm_phase(PG8_LAS unsigned char* lds, const Gemm g, const Sched& S, const Epi& E, unsigned long long* stamps = nullptr) {
    const int tid = tidx(), wid = __builtin_amdgcn_readfirstlane(tid >> 6), lane = tid & 63, wr = wid >> 2, wc = wid & 3, fr = lane & 15, fq = lane >> 4;
    const int K = g.K, nt = K / BK;
    int ts_lo = 0, ts_hi = 0, nts = 0; const unsigned long long rt_entry = 0ull; (void)rt_entry; (void)ts_lo; (void)ts_hi; (void)nts;
#define PG8_STAMP() do { if (STAMP && wid == 0 && nts < 64) { const unsigned long long _c = 0ull; \
        ts_lo = (lane == nts) ? (int)(unsigned)_c : ts_lo; ts_hi = (lane == nts) ? (int)(unsigned)(_c >> 32) : ts_hi; ++nts; } } while (0)
    PG8_STAMP();
    unsigned voffA[2], voffB[2];
#pragma unroll
    for (int i = 0; i < 2; ++i) { int R, C; stage_rc(tid * 16 + i * 8192, R, C); const int Rb = Epi::PERM ? ((R & ~31) + perm32(R & 31)) : R;
        voffA[i] = (unsigned)(R * K + C) * 2u; voffB[i] = (unsigned)(Rb * K + C) * 2u; }
    const size_t kstep = (size_t)(BK * 2);
    const size_t hstep = (size_t)HALF * K * 2;
    const size_t tstep = 2 * hstep;
    const unsigned ldsw = (unsigned)wid * 1024u;
    const int aoff = lds_byte(wr * 64 + fr, fq * 8), boff = lds_byte(wc * 32 + fr, fq * 8);
#define PG8_SA(b, h) (((b) * 2 + (h)) * HTB)
#define PG8_SB(b, h) ((4 + (b) * 2 + (h)) * HTB)
#define PG8_STAGE(bufoff, gbase, voff) do { _Pragma("unroll") for (int _i = 0; _i < 2; ++_i) \
        __builtin_amdgcn_global_load_lds((const unsigned*)((const char*)(gbase) + (voff)[_i]), (PG8_LAS unsigned*)(lds + (bufoff) + ldsw + _i * 8192), 16, 0, 0); } while (0)
#define PG8_LDA(dst, b, h) do { _Pragma("unroll") for (int m = 0; m < 4; ++m) _Pragma("unroll") for (int k = 0; k < 2; ++k) dst[m][k] = *(const PG8_LAS bf16x8*)(lds + PG8_SA(b, h) + aoff + m * 2048 + k * 1024); } while (0)
#define PG8_LDB(dst, b, h) do { _Pragma("unroll") for (int n = 0; n < 2; ++n) _Pragma("unroll") for (int k = 0; k < 2; ++k) dst[n][k] = *(const PG8_LAS bf16x8*)(lds + PG8_SB(b, h) + boff + n * 2048 + k * 1024); } while (0)
#define PG8_MMA(ai, bj, At, Bt) do { __builtin_amdgcn_s_setprio(1); _Pragma("unroll") for (int m = 0; m < 4; ++m) _Pragma("unroll") for (int n = 0; n < 2; ++n) _Pragma("unroll") for (int k = 0; k < 2; ++k) \
        acc[ai][bj][m][n] = __builtin_amdgcn_mfma_f32_16x16x32_bf16(Bt[n][k], At[m][k], acc[ai][bj][m][n], 0, 0, 0); __builtin_amdgcn_s_setprio(0); } while (0)
#ifndef HOST_EMU
#define PG8_WAIT_V(n) asm volatile("s_waitcnt vmcnt(" #n ")" ::: "memory")
#define PG8_WAIT_L(n) asm volatile("s_waitcnt lgkmcnt(" #n ")" ::: "memory")
#else
#define PG8_WAIT_V(n) do {} while (0)
#define PG8_WAIT_L(n) do {} while (0)
#endif
#define PG8_BAR __builtin_amdgcn_s_barrier()
#define PG8_SCHED __builtin_amdgcn_sched_barrier(0)
    Unit cur, nxt; int ui = 0;
    if (!S.next(0, cur)) return;
    f32x4 acc[2][2][4][2];
#pragma unroll
    for (int a = 0; a < 2; ++a)
#pragma unroll
        for (int b = 0; b < 2; ++b)
#pragma unroll
            for (int m = 0; m < 4; ++m)
#pragma unroll
                for (int n = 0; n < 2; ++n) acc[a][b][m][n] = (f32x4){0.f, 0.f, 0.f, 0.f};
    bf16x8 At[4][2], B0[2][2], B1[2][2];
    const char* cA = (const char*)g.A + (size_t)cur.pm * tstep; const char* cB = (const char*)g.Bt + (size_t)cur.pn * tstep;
    S.a_ready(cur);
    PG8_STAGE(PG8_SB(0, 0), cB, voffB); PG8_STAGE(PG8_SA(0, 0), cA, voffA); PG8_STAGE(PG8_SB(0, 1), cB + hstep, voffB); PG8_STAGE(PG8_SA(0, 1), cA + hstep, voffA);
    if (wr == 1) PG8_BAR;
    PG8_WAIT_V(4); PG8_BAR;
    PG8_STAGE(PG8_SB(1, 0), cB + kstep, voffB); PG8_STAGE(PG8_SA(1, 0), cA + kstep, voffA); PG8_STAGE(PG8_SB(1, 1), cB + hstep + kstep, voffB);
    PG8_WAIT_V(6); PG8_BAR;
    PG8_STAMP();
    for (;;) {
        const bool has_next = S.next(ui + 1, nxt);
        const char* nA = has_next ? (const char*)g.A + (size_t)nxt.pm * tstep : cA; const char* nB = has_next ? (const char*)g.Bt + (size_t)nxt.pn * tstep : cB;
        for (int t = 0; t < nt; t += 2) {
            const bool last = (t == nt - 2);
            const char* a1 = cA + (size_t)(t + 1) * kstep;
            const char* a2 = last ? nA : cA + (size_t)(t + 2) * kstep; const char* b2 = last ? nB : cB + (size_t)(t + 2) * kstep;
            const char* a3 = a2 + kstep; const char* b3 = b2 + kstep;
            if (last && has_next) S.a_ready(nxt);
            PG8_LDB(B0, 0, 0); PG8_SCHED; PG8_LDA(At, 0, 0); PG8_STAGE(PG8_SA(1, 1), a1 + hstep, voffA);
            PG8_WAIT_L(8); PG8_BAR; PG8_WAIT_L(0); PG8_MMA(0, 0, At, B0); PG8_BAR; PG8_SCHED;
            PG8_LDB(B1, 0, 1); PG8_STAGE(PG8_SB(0, 0), b2, voffB);
            PG8_BAR; PG8_WAIT_L(0); PG8_MMA(0, 1, At, B1); PG8_BAR;
            PG8_LDA(At, 0, 1); PG8_STAGE(PG8_SA(0, 0), a2, voffA);
            PG8_BAR; PG8_WAIT_L(0); PG8_MMA(1, 0, At, B0); PG8_BAR; PG8_SCHED;
            PG8_STAGE(PG8_SB(0, 1), b2 + hstep, voffB);
            PG8_WAIT_V(6); PG8_BAR; PG8_MMA(1, 1, At, B1); PG8_BAR;
            PG8_LDB(B0, 1, 0); PG8_SCHED; PG8_LDA(At, 1, 0); PG8_STAGE(PG8_SA(0, 1), a2 + hstep, voffA);
            PG8_WAIT_L(8); PG8_BAR; PG8_WAIT_L(0); PG8_MMA(0, 0, At, B0); PG8_BAR; PG8_SCHED;
            PG8_LDB(B1, 1, 1); PG8_STAGE(PG8_SB(1, 0), b3, voffB);
            PG8_BAR; PG8_WAIT_L(0); PG8_MMA(0, 1, At, B1); PG8_BAR;
            PG8_LDA(At, 1, 1); PG8_STAGE(PG8_SA(1, 0), a3, voffA);
            PG8_BAR; PG8_WAIT_L(0); PG8_MMA(1, 0, At, B0); PG8_BAR; PG8_SCHED;
            PG8_STAGE(PG8_SB(1, 1), b3 + hstep, voffB);
            PG8_WAIT_V(6); PG8_BAR; PG8_MMA(1, 1, At, B1); PG8_BAR;
        }
        PG8_STAMP();
        if constexpr (!Epi::AFTER_DRAIN) { E(acc, cur, wr, wc, fr, fq); S.done(cur); }
        PG8_STAMP();
        if (!has_next) break;
#pragma unroll
        for (int a = 0; a < 2; ++a)
#pragma unroll
            for (int b = 0; b < 2; ++b)
#pragma unroll
                for (int m = 0; m < 4; ++m)
#pragma unroll
                    for (int n = 0; n < 2; ++n) acc[a][b][m][n] = (f32x4){0.f, 0.f, 0.f, 0.f};
        cur = nxt; cA = nA; cB = nB; ++ui;
    }
    PG8_WAIT_V(0);
    if (wr == 0) PG8_BAR;
    PG8_BAR;
    if constexpr (Epi::AFTER_DRAIN) { E.fused(acc, cur, wr, wc, fr, fq, lds, wid, lane); S.done(cur); }
    PG8_STAMP();
    if (STAMP && wid == 0) { stamps[lane] = lane < nts ? (((unsigned long long)(unsigned)ts_hi << 32) | (unsigned)ts_lo) : 0ull;
        if (lane == 62) stamps[62] = rt_entry; if (lane == 63) stamps[63] = 0ull; }
#undef PG8_STAMP
#undef PG8_SA
#undef PG8_SB
#undef PG8_STAGE
#undef PG8_LDA
#undef PG8_LDB
#undef PG8_MMA
#undef PG8_WAIT_V
#undef PG8_WAIT_L
#undef PG8_BAR
#undef PG8_SCHED
}
}
template <class Epi> struct PgEpiT {
    static constexpr bool PERM = true, AFTER_DRAIN = false;
    Epi e;
    DEV void operator()(const f32x4 (&acc)[2][2][4][2], const pg8::Unit& u, int wr, int wc, int fr, int fq) const {
        float pre[2][4];
#pragma unroll
        for (int ai = 0; ai < 2; ++ai)
#pragma unroll
            for (int m = 0; m < 4; ++m) pre[ai][m] = e.colpre(u.pm * 256 + ai * 128 + wr * 64 + m * 16 + fr);
#pragma unroll
        for (int ai = 0; ai < 2; ++ai)
#pragma unroll
            for (int m = 0; m < 4; ++m) {
#pragma unroll
                for (int bj = 0; bj < 2; ++bj) {
                    const int wcol = u.pm * 256 + ai * 128 + wr * 64 + m * 16 + fr, tok0 = u.pn * 256 + bj * 128 + wc * 32 + 8 * fq;
                    const float v[8] = {acc[ai][bj][m][0][0], acc[ai][bj][m][0][1], acc[ai][bj][m][0][2], acc[ai][bj][m][0][3], acc[ai][bj][m][1][0], acc[ai][bj][m][1][1], acc[ai][bj][m][1][2], acc[ai][bj][m][1][3]};
                    e.tok8(tok0, wcol, v, pre[ai][m]);
                }
                SCHED_FENCE();
            }
    }
};
template <class Epi> struct PgEpiN {
    static constexpr bool PERM = true, AFTER_DRAIN = false;
    Epi e;
    DEV void operator()(const f32x4 (&acc)[2][2][4][2], const pg8::Unit& u, int wr, int wc, int fr, int fq) const {
#pragma unroll
        for (int ai = 0; ai < 2; ++ai)
#pragma unroll
            for (int m = 0; m < 4; ++m) {
#pragma unroll
                for (int bj = 0; bj < 2; ++bj) {
                    const int tok = u.pm * 256 + ai * 128 + wr * 64 + m * 16 + fr, wcol0 = u.pn * 256 + bj * 128 + wc * 32 + 8 * fq;
                    const float v[8] = {acc[ai][bj][m][0][0], acc[ai][bj][m][0][1], acc[ai][bj][m][0][2], acc[ai][bj][m][0][3], acc[ai][bj][m][1][0], acc[ai][bj][m][1][1], acc[ai][bj][m][1][2], acc[ai][bj][m][1][3]};
                    e.col8(tok, wcol0, v);
                }
                SCHED_FENCE();
            }
    }
};
template <class Epi>
DEV void gemm_pg8_T(const bf16_t* A, const bf16_t* Wt, int Mtok, int N, unsigned char* smem, const Epi& epi) {
    pg8::Gemm g{Wt, A, N, Mtok, 1024};
    pg8::StaticOrder S; S.init(N, Mtok, (int)gridDim.x, (int)blockIdx.x);
    PgEpiT<Epi> E{epi};
    pg8::gemm_phase<PgEpiT<Epi>, pg8::StaticOrder, false>((PG8_LAS unsigned char*)smem, g, S, E);
    __syncthreads();
}
template <class Epi>
DEV void gemm_pg8_N(const bf16_t* A, const bf16_t* Wt, int Mtok, int N, unsigned char* smem, const Epi& epi) {
    pg8::Gemm g{A, Wt, Mtok, N, 1024};
    pg8::StaticOrder S; S.init(Mtok, N, (int)gridDim.x, (int)blockIdx.x);
    PgEpiN<Epi> E{epi};
    pg8::gemm_phase<PgEpiN<Epi>, pg8::StaticOrder, false>((PG8_LAS unsigned char*)smem, g, S, E);
    __syncthreads();
}
struct EpiL0In {
    unsigned char* ws;
    DEV void operator()(int row, int col, float v0, float v1, float v2, float v3) const {
        u32x2 o; o[0] = pk2(v0, v1); o[1] = pk2(v2, v3);
        const bool lat = row < TL; const int b = lat ? row / L : (row - TL) / LC, t = lat ? row - b * L : (row - TL) - b * LC, Lx = lat ? L : LC;
        const int cu = __builtin_amdgcn_readfirstlane(col & ~127);
        if (cu < 1536) { bf16_t* d = (bf16_t*)(ws + WS_P + (lat ? P_HYT_LAT : P_HYT_CTX)) + ((size_t)b * 1536 + col) * Lx + t; *(u32x2*)d = o; }
        else if (cu < 2048) { bf16_t* d = (bf16_t*)(ws + WS_P + P_Q0) + (size_t)row * 512 + (col - 1536); d[0] = (bf16_t)f2bf(v0); d[512] = (bf16_t)f2bf(v1); d[1024] = (bf16_t)f2bf(v2); d[1536] = (bf16_t)f2bf(v3); }
        else if (cu < 2176) { bf16_t* d = (bf16_t*)(ws + WS_P + P_K0) + (size_t)row * 128 + (col - 2048); d[0] = (bf16_t)f2bf(v0); d[128] = (bf16_t)f2bf(v1); d[256] = (bf16_t)f2bf(v2); d[384] = (bf16_t)f2bf(v3); }
        else { bf16_t* d = (bf16_t*)(ws + WS_P + (lat ? P_VT_LAT : P_VT_CTX)) + ((size_t)b * 128 + (col - 2176)) * Lx + t; *(u32x2*)d = o; }
    }
};
struct EpiL0InT {
    unsigned char* ws;
    DEV float colpre(int) const { return 0.f; }
    DEV void tok8(int row, int col, const float (&v)[8], float) const {
        const bool lat = row < TL; const int b = lat ? row / L : (row - TL) / LC, t = lat ? row - b * L : (row - TL) - b * LC, Lx = lat ? L : LC;
        u32x4 o; o[0] = pk2(v[0], v[1]); o[1] = pk2(v[2], v[3]); o[2] = pk2(v[4], v[5]); o[3] = pk2(v[6], v[7]);
        if (col < 1536) { *(u32x4*)((bf16_t*)(ws + WS_P + (lat ? P_HYT_LAT : P_HYT_CTX)) + ((size_t)b * 1536 + col) * Lx + t) = o; }
        else if (col < 2048) { bf16_t* d = (bf16_t*)(ws + WS_P + P_Q0) + (size_t)row * 512 + (col - 1536);
#pragma unroll
            for (int i = 0; i < 8; ++i) d[i * 512] = (bf16_t)f2bf(v[i]); }
        else if (col < 2176) { bf16_t* d = (bf16_t*)(ws + WS_P + P_K0) + (size_t)row * 128 + (col - 2048);
#pragma unroll
            for (int i = 0; i < 8; ++i) d[i * 128] = (bf16_t)f2bf(v[i]); }
        else { *(u32x4*)((bf16_t*)(ws + WS_P + (lat ? P_VT_LAT : P_VT_CTX)) + ((size_t)b * 128 + (col - 2176)) * Lx + t) = o; }
    }
};
struct EpiBf16 {
    bf16_t* out; int ld;
    DEV void col8(int row, int col0, const float (&v)[8]) const { u32x4 o; o[0] = pk2(v[0], v[1]); o[1] = pk2(v[2], v[3]); o[2] = pk2(v[4], v[5]); o[3] = pk2(v[6], v[7]); *(u32x4*)(out + (size_t)row * ld + col0) = o; }
    DEV void operator()(int row, int col, float v0, float v1, float v2, float v3) const {
        bf16_t* d = out + (size_t)row * ld + col; d[0] = (bf16_t)f2bf(v0); d[ld] = (bf16_t)f2bf(v1); d[2 * ld] = (bf16_t)f2bf(v2); d[3 * ld] = (bf16_t)f2bf(v3);
    }
};
struct EpiHg {
    unsigned char* ws; const float* lg;
    DEV void operator()(int row, int col, float v0, float v1, float v2, float v3) const {
        float vv[4] = {v0, v1, v2, v3};
        const bool lat = row < TL; const int b = lat ? row / L : (row - TL) / LC, t = lat ? row - b * L : (row - TL) - b * LC, Lx = lat ? L : LC;
        const int cu = __builtin_amdgcn_readfirstlane(col & ~255);
        if (cu >= 3072 && cu < 4096) {
            bf16_t* d = (bf16_t*)(ws + WS_M) + (lat ? (size_t)0 : (size_t)NB * 1024 * L) + ((size_t)b * 1024 + (col - 3072)) * Lx + t;
            u32x2 o; o[0] = pk2(v0, v1); o[1] = pk2(v2, v3); *(u32x2*)d = o;
            return;
        }
        if (cu < 1024 || cu >= 4096) {
#pragma unroll
            for (int i = 0; i < 4; ++i) vv[i] = silu_f(vv[i]);
        } else {
            const int c = col - 1024;
            const float oml = 1.f - 1.f / (1.f + __expf(lg[c] - lg[2048 + c]));
#pragma unroll
            for (int i = 0; i < 4; ++i) vv[i] = oml * __builtin_amdgcn_rcpf(1.f + __expf(vv[i]));
        }
        if (cu < 3072) {
            bf16_t* d = (bf16_t*)(ws + WS_P + (lat ? P1_KQT_LAT : P1_KQT_CTX)) + ((size_t)b * 3072 + col) * Lx + t;
            u32x2 o; o[0] = pk2(vv[0], vv[1]); o[1] = pk2(vv[2], vv[3]); *(u32x2*)d = o;
        } else {
            if (!lat) return;
            bf16_t* d = (bf16_t*)(ws + WS_P + P1_G) + (size_t)row * 1024 + (col - 4096); d[0] = (bf16_t)f2bf(vv[0]); d[1024] = (bf16_t)f2bf(vv[1]); d[2048] = (bf16_t)f2bf(vv[2]); d[3072] = (bf16_t)f2bf(vv[3]);
        }
    }
};
struct EpiHgT {
    unsigned char* ws; const float* lg; int plain;
    DEV float colpre(int col) const {
        const int cu = __builtin_amdgcn_readfirstlane(col & ~255);
        if (cu < 1024 || cu >= 3072) return 0.f;
        const int c = col - 1024; return 1.f - __builtin_amdgcn_rcpf(1.f + __expf(lg[c] - lg[2048 + c]));
    }
    DEV void tok8(int row, int col, const float (&v)[8], float oml) const {
        const bool lat = row < TL; const int b = lat ? row / L : (row - TL) / LC, t = lat ? row - b * L : (row - TL) - b * LC, Lx = lat ? L : LC;
        const int cu = __builtin_amdgcn_readfirstlane(col & ~255);
        float vv[8];
#pragma unroll
        for (int i = 0; i < 8; ++i) vv[i] = v[i];
        if (cu >= 3072 && cu < 4096) {
            u32x4 o; o[0] = pk2(vv[0], vv[1]); o[1] = pk2(vv[2], vv[3]); o[2] = pk2(vv[4], vv[5]); o[3] = pk2(vv[6], vv[7]);
            *(u32x4*)((bf16_t*)(ws + WS_M) + (lat ? (size_t)0 : (size_t)NB * 1024 * L) + ((size_t)b * 1024 + (col - 3072)) * Lx + t) = o;
            return;
        }
        if (plain) {} else if (cu < 1024 || cu >= 4096) {
#pragma unroll
            for (int i = 0; i < 8; ++i) vv[i] = silu_f(vv[i]);
        } else {
#pragma unroll
            for (int i = 0; i < 8; ++i) vv[i] = oml * __builtin_amdgcn_rcpf(1.f + __expf(vv[i]));
        }
        if (cu < 3072) {
            u32x4 o; o[0] = pk2(vv[0], vv[1]); o[1] = pk2(vv[2], vv[3]); o[2] = pk2(vv[4], vv[5]); o[3] = pk2(vv[6], vv[7]);
            *(u32x4*)((bf16_t*)(ws + WS_P + (lat ? P1_KQT_LAT : P1_KQT_CTX)) + ((size_t)b * 3072 + col) * Lx + t) = o;
        } else {
            if (!lat) return;
            bf16_t* d = (bf16_t*)(ws + WS_P + P1_G) + (size_t)row * 1024 + (col - 4096);
#pragma unroll
            for (int i = 0; i < 8; ++i) d[i * 1024] = (bf16_t)f2bf(vv[i]);
        }
    }
};
struct EpiRes {
    const Params* p; int from_inputs, layer, goff;
    DEV void col8(int row, int col0, const float (&v)[8]) const {
        float* H = (float*)(p->ws + WS_H) + (size_t)row * 1024 + col0; const float* hin = h_row(*p, from_inputs, row) + col0;
        const float* gt = (const float*)(p->ws + WS_MOD) + ((size_t)layer * NR + mod_row(row)) * 6144 + goff + col0;
        const f32x4 h0 = *(const f32x4*)hin, h1 = *(const f32x4*)(hin + 4), g0 = *(const f32x4*)gt, g1 = *(const f32x4*)(gt + 4);
        f32x4 o0, o1;
#pragma unroll
        for (int i = 0; i < 4; ++i) { o0[i] = h0[i] + g0[i] * v[i]; o1[i] = h1[i] + g1[i] * v[4 + i]; }
        *(f32x4*)H = o0; *(f32x4*)(H + 4) = o1;
    }
    DEV void operator()(int row, int col, float v0, float v1, float v2, float v3) const {
        float* H = (float*)(p->ws + WS_H) + (size_t)row * 1024 + col;
        const float* hin = h_row(*p, from_inputs, row) + col;
        const float gt = ((const float*)(p->ws + WS_MOD))[((size_t)layer * NR + mod_row(row)) * 6144 + goff + col];
        const float h0 = hin[0], h1 = hin[1024], h2 = hin[2048], h3 = hin[3072];
        H[0] = h0 + gt * v0; H[1024] = h1 + gt * v1; H[2048] = h2 + gt * v2; H[3072] = h3 + gt * v3;
    }
};

struct HyRaw { u32x4 mid; unsigned short lft, rgt; };
DEV HyRaw hy_load(const bf16_t* row, int t0, int Lx) { HyRaw r; r.mid = *(const u32x4*)(row + t0); r.lft = t0 > 0 ? row[t0 - 1] : (unsigned short)0; r.rgt = t0 + 8 < Lx ? row[t0 + 8] : (unsigned short)0; return r; }
DEV void hy_conv8(const HyRaw& r, float w0, float w1, float w2, float b, float (&o)[8]) {
    float x[10]; x[0] = bf2f(r.lft); x[9] = bf2f(r.rgt);
#pragma unroll
    for (int i = 0; i < 4; ++i) { x[1 + 2 * i] = bflo(r.mid[i]); x[2 + 2 * i] = bfhi(r.mid[i]); }
#pragma unroll
    for (int i = 0; i < 8; ++i) o[i] = w0 * x[i] + w1 * x[i + 1] + w2 * x[i + 2] + b;
}
template <int TPC>
DEV void hyena_item(const Params& p, int set, int item, unsigned char* smem, bool nofft = false, bool nostore = false) {
    const int Ls = set ? LC : L, S = set ? FS_CTX : FS_LAT, N = 1 << (2 * S);
    constexpr int CPR = NT / TPC, NR8 = 8 / CPR;
    const int gi = tidx() / TPC, g = tidx() % TPC;
    const int bp = item >> 6, c0 = (item & 63) * 8, ba = bp * 2, bb = ba + 1;
    cf2* buf = (cf2*)smem + (size_t)gi * N;
    bf16_t* stg = (bf16_t*)(smem + (size_t)CPR * N * 8);
    const bf16_t* hy = (const bf16_t*)(p.ws + WS_P + (set ? P_HYT_CTX : P_HYT_LAT));
    const float* cw = p.in[I_HYCW]; const float* cb = p.in[I_HYCB];
    const cf2* HF = (const cf2*)(p.ws + WS_F + (set ? F_HF_CTX : F_HF_LAT));
    const float invN = 1.f / (float)N;
    const int t0 = g * 8; const bool own = t0 < Ls;
    HyRaw rv[2], rx1[2];
    cf2 hfr[16];
#define HY_FETCH(cc) do { if (own) { \
        rv[0] = hy_load(hy + ((size_t)ba * 1536 + (cc)) * Ls, t0, Ls); rv[1] = hy_load(hy + ((size_t)bb * 1536 + (cc)) * Ls, t0, Ls); \
        rx1[0] = hy_load(hy + ((size_t)ba * 1536 + 512 + (cc)) * Ls, t0, Ls); rx1[1] = hy_load(hy + ((size_t)bb * 1536 + 512 + (cc)) * Ls, t0, Ls); } } while (0)
    HY_FETCH(c0 + gi);
#pragma unroll 1
    for (int rd = 0; rd < NR8; ++rd) {
        const int cs = rd * CPR + gi, c = c0 + cs;
#pragma unroll
        for (int u = 0; u < 16; ++u) { hfr[u].x = 0.f; hfr[u].y = 0.f; if (g + TPC * u < N) hfr[u] = HF[(size_t)c * N + g + TPC * u]; }
        float za[8], zb[8];
        if (own) { hy_conv8(rv[0], cw[c], cw[1536 + c], cw[3072 + c], cb[c], za); hy_conv8(rv[1], cw[c], cw[1536 + c], cw[3072 + c], cb[c], zb); }
        for (int t = g; t < N; t += TPC) { if (t >= Ls) { cf2 z; z.x = 0.f; z.y = 0.f; buf[fsw(t)] = z; } }
        if (own) {
#pragma unroll
            for (int i = 0; i < 8; ++i) { cf2 v; v.x = za[i]; v.y = zb[i]; buf[fsw(t0 + i)] = v; }
        }
        __syncthreads();
#pragma unroll
        for (int n = 0; n < 2; ++n) {
            if (!nofft) fft_fwd(buf, S, g, TPC);
#pragma unroll
            for (int u = 0; u < 16; ++u) { const int k = g + TPC * u; if (k < N) buf[fsw(k)] = cmul(buf[fsw(k)], hfr[u]); }
            if (n == 0) {
#pragma unroll
                for (int u = 0; u < 16; ++u) if (g + TPC * u < N) hfr[u] = HF[(size_t)(512 + c) * N + g + TPC * u];
            }
            __syncthreads();
            if (!nofft) fft_inv(buf, S, g, TPC);
            const int gc = (n + 1) * 512 + c;
            if (own) {
                const float w0 = cw[gc], w1 = cw[1536 + gc], w2 = cw[3072 + gc], b = cb[gc], dsk = p.in[I_HYSKIP][n * 512 + c];
                float ga[8], gb[8];
                hy_conv8(rx1[0], w0, w1, w2, b, ga); hy_conv8(rx1[1], w0, w1, w2, b, gb);
                if (n == 0) { rx1[0] = hy_load(hy + ((size_t)ba * 1536 + 1024 + c) * Ls, t0, Ls); rx1[1] = hy_load(hy + ((size_t)bb * 1536 + 1024 + c) * Ls, t0, Ls); }
#pragma unroll
                for (int i = 0; i < 8; ++i) { const cf2 cv = buf[fsw(t0 + i)]; za[i] = ga[i] * (cv.x * invN + dsk * za[i]); zb[i] = gb[i] * (cv.y * invN + dsk * zb[i]); }
            }
            if (n == 0) {
                __syncthreads();
                for (int t = g; t < N; t += TPC) { if (t >= Ls) { cf2 z; z.x = 0.f; z.y = 0.f; buf[fsw(t)] = z; } }
                if (own) {
#pragma unroll
                    for (int i = 0; i < 8; ++i) { cf2 v; v.x = za[i]; v.y = zb[i]; buf[fsw(t0 + i)] = v; }
                }
                __syncthreads();
            } else {
                if (rd + 1 < NR8) HY_FETCH(c0 + (rd + 1) * CPR + gi);
                if (own) {
#pragma unroll
                    for (int i = 0; i < 8; ++i) {
                        const int ra = t0 + i, rb = Ls + t0 + i;
                        stg[(size_t)(ra + (ra >> 3)) * 8 + cs] = (bf16_t)f2bf(za[i]); stg[(size_t)(rb + (rb >> 3)) * 8 + cs] = (bf16_t)f2bf(zb[i]); }
                }
            }
        }
        __syncthreads();
    }
#undef HY_FETCH
    if (!nostore) {
        bf16_t* M = (bf16_t*)(p.ws + WS_M);
        for (int i = tidx(); i < 2 * Ls; i += NT) {
            const int bsel = i >= Ls, t = bsel ? i - Ls : i, bx = bsel ? bb : ba;
            const size_t tok = set ? (size_t)TL + (size_t)bx * LC + t : (size_t)bx * L + t;
            *(u32x4*)(M + tok * 1024 + c0) = *(const u32x4*)(stg + (size_t)(i + (i >> 3)) * 8);
        }
    }
    __syncthreads();
}
DEV void rope_store(const bf16_t* src, bf16_t* dst, int pos, bool rope, float scale, int ph, int sub) {
    const u32x4 ua = *(const u32x4*)(src + ph * 32 + sub * 8), ub = *(const u32x4*)(src + ph * 32 + 16 + sub * 8);
    float a[8], b[8];
#pragma unroll
    for (int i = 0; i < 4; ++i) { a[2 * i] = bflo(ua[i]); a[2 * i + 1] = bfhi(ua[i]); b[2 * i] = bflo(ub[i]); b[2 * i + 1] = bfhi(ub[i]); }
    if (rope) {
        const float pv = (float)(ph == 0 ? pos / 64 : pos % 64);
#pragma unroll
        for (int e = 0; e < 8; ++e) {
            const float inv = exp2f(-(float)(sub * 8 + e) * (13.287712379549449f / 16.f));
            const float ang = pv * inv, cs = __cosf(ang), sn = __sinf(ang);
            const float na = a[e] * cs - b[e] * sn, nb = b[e] * cs + a[e] * sn; a[e] = na; b[e] = nb;
        }
    }
    u32x4 oa, ob;
#pragma unroll
    for (int i = 0; i < 4; ++i) { oa[i] = pk2(a[2 * i] * scale, a[2 * i + 1] * scale); ob[i] = pk2(b[2 * i] * scale, b[2 * i + 1] * scale); }
    *(u32x4*)(dst + ph * 32 + sub * 8) = oa; *(u32x4*)(dst + ph * 32 + 16 + sub * 8) = ob;
}
constexpr int A_LDQ = 72, A_LDV = 136;
DEV void attn_item(const Params& p, int set, int item, unsigned char* smem) {
    bf16_t* Qs = (bf16_t*)smem;
    bf16_t* Ks = Qs + 128 * A_LDQ;
    bf16_t* Vt = Ks + 128 * A_LDQ;
    const int tid = tidx(), lane = tid & 63, w = tid >> 6, l15 = lane & 15, lg = lane >> 4;
    const int nqb = set ? LC / 128 : L / 128;
    const int h = item & 7, qb = (item >> 3) % nqb, b = (item >> 3) / nqb, kvh = h >> 2;
    const bf16_t* Q0 = (const bf16_t*)(p.ws + WS_P + P_Q0); const bf16_t* K0 = (const bf16_t*)(p.ws + WS_P + P_K0);
    const int qtok0 = set ? TL + b * LC + qb * 128 : b * L + qb * 128;
    { const int row = tid >> 2, ph = (tid >> 1) & 1, sub = tid & 1;
      rope_store(Q0 + (size_t)(qtok0 + row) * 512 + h * 64, Qs + row * A_LDQ, qb * 128 + row, set == 0, 0.125f, ph, sub); }
    __syncthreads();
    bf16x8 qf[2];
    qf[0] = *(const bf16x8*)(Qs + (w * 16 + l15) * A_LDQ + 8 * lg); qf[1] = *(const bf16x8*)(Qs + (w * 16 + l15) * A_LDQ + 32 + 8 * lg);
    float m_run = p.in[I_SINK][h], l_run = 1.f;
    f32x4 O[4];
#pragma unroll
    for (int i = 0; i < 4; ++i) O[i] = (f32x4){0.f, 0.f, 0.f, 0.f};
    const int nwin = set ? 0 : 3, nctx = LC / 128;
    for (int kbi = 0; kbi < nwin + nctx; ++kbi) {
        const bool win = kbi < nwin; const int kb = win ? qb - 1 + kbi : kbi - nwin;
        if (win && (kb < 0 || kb >= L / 128)) continue;
        const int ktok0 = win ? b * L + kb * 128 : TL + b * LC + kb * 128;
        __syncthreads();
        { const int row = tid >> 2, ph = (tid >> 1) & 1, sub = tid & 1;
          rope_store(K0 + (size_t)(ktok0 + row) * 128 + kvh * 64, Ks + row * A_LDQ, kb * 128 + row, win, 1.f, ph, sub); }
        { const bf16_t* vt = (const bf16_t*)(p.ws + WS_P + (win ? P_VT_LAT : P_VT_CTX)); const int Lx = win ? L : LC;
#pragma unroll
          for (int i = 0; i < 2; ++i) { const int id = tid + NT * i, d = id >> 4, kc = id & 15;
              *(u32x4*)(Vt + d * A_LDV + kc * 8) = *(const u32x4*)(vt + ((size_t)b * 128 + kvh * 64 + d) * Lx + kb * 128 + kc * 8); } }
        __syncthreads();
#pragma unroll
        for (int ch = 0; ch < 2; ++ch) {
            f32x4 st[4];
#pragma unroll
            for (int u = 0; u < 4; ++u) {
                const bf16_t* kr = Ks + ((ch * 4 + u) * 16 + l15) * A_LDQ + 8 * lg;
                f32x4 z = (f32x4){0.f, 0.f, 0.f, 0.f};
                z = __builtin_amdgcn_mfma_f32_16x16x32_bf16(*(const bf16x8*)kr, qf[0], z, 0, 0, 0);
                z = __builtin_amdgcn_mfma_f32_16x16x32_bf16(*(const bf16x8*)(kr + 32), qf[1], z, 0, 0, 0);
                st[u] = z;
            }
            float cmax = -INFINITY;
            if (win) {
                const int qpos = qb * 128 + w * 16 + l15;
#pragma unroll
                for (int u = 0; u < 4; ++u)
#pragma unroll
                    for (int r = 0; r < 4; ++r) { const int kpos = kb * 128 + (ch * 4 + u) * 16 + 4 * lg + r; const int dd = qpos - kpos; if (dd > 128 || dd < -128) st[u][r] = -INFINITY; }
            }
#pragma unroll
            for (int u = 0; u < 4; ++u)
#pragma unroll
                for (int r = 0; r < 4; ++r) cmax = fmaxf(cmax, st[u][r]);
            cmax = fmaxf(cmax, __shfl_xor(cmax, 16)); cmax = fmaxf(cmax, __shfl_xor(cmax, 32));
            const float m_new = fmaxf(m_run, cmax), alpha = __expf(m_run - m_new);
            float ls = 0.f;
#pragma unroll
            for (int u = 0; u < 4; ++u)
#pragma unroll
                for (int r = 0; r < 4; ++r) { const float e = __expf(st[u][r] - m_new); st[u][r] = e; ls += e; }
            ls += __shfl_xor(ls, 16); ls += __shfl_xor(ls, 32);
            l_run = l_run * alpha + ls; m_run = m_new;
#pragma unroll
            for (int i = 0; i < 4; ++i) { O[i][0] *= alpha; O[i][1] *= alpha; O[i][2] *= alpha; O[i][3] *= alpha; }
#pragma unroll
            for (int ss = 0; ss < 2; ++ss) {
                u32x4 pu; pu[0] = pk2(st[2 * ss][0], st[2 * ss][1]); pu[1] = pk2(st[2 * ss][2], st[2 * ss][3]); pu[2] = pk2(st[2 * ss + 1][0], st[2 * ss + 1][1]); pu[3] = pk2(st[2 * ss + 1][2], st[2 * ss + 1][3]);
                const bf16x8 pf = __builtin_bit_cast(bf16x8, pu);
                const int key0 = (ch * 4 + 2 * ss) * 16 + 4 * lg;
#pragma unroll
                for (int dt = 0; dt < 4; ++dt) {
                    const bf16_t* vr = Vt + (dt * 16 + l15) * A_LDV + key0;
                    u32x4 vu; const u32x2 v0 = *(const u32x2*)vr, v1 = *(const u32x2*)(vr + 16); vu[0] = v0[0]; vu[1] = v0[1]; vu[2] = v1[0]; vu[3] = v1[1];
                    O[dt] = __builtin_amdgcn_mfma_f32_16x16x32_bf16(__builtin_bit_cast(bf16x8, vu), pf, O[dt], 0, 0, 0);
                }
            }
        }
    }
    const float il = 1.f / l_run;
    bf16_t* M = (bf16_t*)(p.ws + WS_M) + (size_t)(qtok0 + w * 16 + l15) * 1024 + 512 + h * 64;
#pragma unroll
    for (int dt = 0; dt < 4; ++dt) { u32x2 o; o[0] = pk2(O[dt][0] * il, O[dt][1] * il); o[1] = pk2(O[dt][2] * il, O[dt][3] * il); *(u32x2*)(M + dt * 16 + 4 * lg) = o; }
    __syncthreads();
}
static_assert(NF_LAT / 256 <= 16 && NF_CTX / 64 <= 16 && L / 8 <= 256 && LC / 8 <= 64 && 2 * NF_LAT * 8 + 2 * L * 18 <= SMEM_BYTES && 8 * NF_CTX * 8 + 2 * LC * 18 <= SMEM_BYTES, "hyena item geometry");
constexpr int P3_HY_LAT = (NB / 2) * 64, P3_HY_CTX = (NB / 2) * 64, P3_AT_LAT = NB * (L / 128) * 8, P3_AT_CTX = NB * (LC / 128) * 8;
DEV void phase3(const Params& p, unsigned char* smem, int var = 0) {
    const int total = P3_HY_LAT + P3_AT_LAT + P3_HY_CTX + P3_AT_CTX;
    for (int it = blockIdx.x; it < total; it += gridDim.x) {
        int i = it;
        if ((var == 1 || var == 3 || var == 4) && !(i < P3_HY_LAT || (i >= P3_HY_LAT + P3_AT_LAT && i < P3_HY_LAT + P3_AT_LAT + P3_HY_CTX))) continue;
        if (var == 2 && (i < P3_HY_LAT || (i >= P3_HY_LAT + P3_AT_LAT && i < P3_HY_LAT + P3_AT_LAT + P3_HY_CTX))) continue;
        if (i < P3_HY_LAT) { hyena_item<256>(p, 0, i, smem, var == 3, var == 4); continue; } i -= P3_HY_LAT;
        if (i < P3_AT_LAT) { attn_item(p, 0, i, smem); continue; } i -= P3_AT_LAT;
        if (i < P3_HY_CTX) { hyena_item<64>(p, 1, i, smem, var == 3, var == 4); continue; } i -= P3_HY_CTX;
        attn_item(p, 1, i, smem);
    }
}

constexpr int K_LDK = 136, K_LDS = 129, K_LDC = 52;
DEV unsigned fkey(float f) { const unsigned u = __builtin_bit_cast(unsigned, f); return (u & 0x80000000u) ? ~u : (u | 0x80000000u); }
constexpr int cand_off(int i) { int o = 0; for (int k = 0; k < i; ++k) o += 16 / (k + 1); return o; }
DEV void topk_load_keys(const Params& p, int layer, int h, unsigned char* smem) {
    bf16_t* Ks = (bf16_t*)smem;
    const bf16_t* keys = (const bf16_t*)(p.ws + WS_W + W_KEYS) + (size_t)layer * 262144 + (size_t)h * 32768;
    const int tid = tidx();
#pragma unroll
    for (int i = 0; i < 8; ++i) { const int id = tid + NT * i, row = id >> 4, kc = id & 15; *(u32x4*)(Ks + row * K_LDK + kc * 8) = *(const u32x4*)(keys + (size_t)row * 128 + kc * 8); }
    __syncthreads();
}
#ifndef HOST_EMU
template <int CTRL> DEV unsigned dpp_u32(unsigned v) { return (unsigned)__builtin_amdgcn_update_dpp(0, (int)v, CTRL, 0xF, 0xF, true); }
#else
template <int CTRL> DEV unsigned dpp_u32(unsigned v) { const int lane = tidx() & 63; const int src = CTRL == 0xB1 ? (lane ^ 1) : CTRL == 0x4E ? (lane ^ 2) : ((lane & ~7) | (7 - (lane & 7))); return emu_shfl(v, src); }
#endif
DEV unsigned max8_u32(unsigned v) { unsigned t = dpp_u32<0xB1>(v); v = v > t ? v : t; t = dpp_u32<0x4E>(v); v = v > t ? v : t; t = dpp_u32<0x141>(v); return v > t ? v : t; }
DEV float sum8_f32(float v) { v += __builtin_bit_cast(float, dpp_u32<0xB1>(__builtin_bit_cast(unsigned, v))); v += __builtin_bit_cast(float, dpp_u32<0x4E>(__builtin_bit_cast(unsigned, v))); v += __builtin_bit_cast(float, dpp_u32<0x141>(__builtin_bit_cast(unsigned, v))); return v; }
DEV float unkey(unsigned k) { const unsigned u = (k & 0x80000000u) ? (k & 0x7fffffffu) : ~k; return __builtin_bit_cast(float, u); }
template <int N> DEV void bitonic_desc(unsigned (&a)[N]) {
#pragma unroll
    for (int k = 2; k <= N; k <<= 1)
#pragma unroll
        for (int j = k >> 1; j > 0; j >>= 1)
#pragma unroll
            for (int i = 0; i < N; ++i) { const int l = i ^ j; if (l > i) { const unsigned x = a[i], y = a[l]; const unsigned hi = x > y ? x : y, lo = x > y ? y : x; if ((i & k) == 0) { a[i] = hi; a[l] = lo; } else { a[i] = lo; a[l] = hi; } } }
}
DEV void merge16(const unsigned* lst, int nlist, unsigned first, int sub, unsigned& r0, unsigned& r1) {
    unsigned cur = first; int head = 0; r0 = 0u; r1 = 0u;
#pragma unroll
    for (int it = 0; it < 16; ++it) {
        const unsigned m = max8_u32(cur);
        if (sub == (it & 7)) { if (it < 8) r0 = m; else r1 = m; }
        if (cur == m) { ++head; cur = head < nlist ? lst[head] : 0u; }
    }
}
DEV void topk_item(const Params& p, int h, int tok0, unsigned char* smem, const bf16x8 (&afr)[16]) {
    bf16_t* Ks = (bf16_t*)smem;
    float* Sc = (float*)(Ks + 2 * 128 * K_LDK);
    unsigned* s12 = (unsigned*)Sc + 64 * 8 * 17;
    unsigned* cl = s12 + 64 * 32;
    const int tid = tidx(), lane = tid & 63, w = tid >> 6;
    const int row = tid >> 3, sub = tid & 7;
#pragma unroll
    for (int part = 0; part < 2; ++part) {
        { const int mi = w >> 2, ni = w & 3;
          f32x16 acc;
#pragma unroll
          for (int r = 0; r < 16; ++r) acc[r] = 0.f;
          const bf16_t* bs = Ks + (part * 128 + ni * 32 + (lane & 31)) * K_LDK + 8 * (lane >> 5);
#pragma unroll
          for (int kk = 0; kk < 8; ++kk) acc = __builtin_amdgcn_mfma_f32_32x32x16_bf16(part ? afr[8 + kk] : afr[kk], *(const bf16x8*)(bs + kk * 16), acc, 0, 0, 0);
#pragma unroll
          for (int r = 0; r < 16; ++r) Sc[(mi * 32 + (r & 3) + 8 * (r >> 2) + 4 * (lane >> 5)) * K_LDS + ni * 32 + (lane & 31)] = acc[r]; }
        __syncthreads();
        unsigned mk[16];
#pragma unroll
        for (int i = 0; i < 16; ++i) mk[i] = (fkey(Sc[row * K_LDS + sub * 16 + i]) & ~127u) | (unsigned)(127 - (sub * 16 + i));
        bitonic_desc<16>(mk);
        __syncthreads();
        unsigned* lst = (unsigned*)Sc + (row * 8 + sub) * 17;
#pragma unroll
        for (int i = 0; i < 16; ++i) lst[i] = mk[i];
        unsigned r0, r1;
        merge16(lst, 16, mk[0], sub, r0, r1);
        s12[(row * 2 + part) * 16 + sub] = r0; s12[(row * 2 + part) * 16 + 8 + sub] = r1;
        __syncthreads();
    }
    {
        const unsigned* k1 = s12 + row * 32; const unsigned* k2 = k1 + 16;
        unsigned ck[8];
#pragma unroll
        for (int m = 0; m < 8; ++m) {
            const int cc = sub + 8 * m; int ci = 0, off = 0;
#pragma unroll
            for (int i = 0; i < 15; ++i) { const bool ge = cc >= cand_off(i + 1); ci += ge ? 1 : 0; off += ge ? 16 / (i + 1) : 0; }
            const int cj = cc - off;
            ck[m] = 0u;
            if (cc < 50) ck[m] = (fkey(unkey((k1[ci] & ~127u) | 64u) + unkey((k2[cj] & ~127u) | 64u)) & ~63u) | (unsigned)(63 - cc);
        }
        bitonic_desc<8>(ck);
        unsigned* lst = cl + (row * 8 + sub) * 9;
#pragma unroll
        for (int m = 0; m < 8; ++m) lst[m] = ck[m];
        unsigned r0, r1;
        merge16(lst, 8, ck[0], sub, r0, r1);
        const float a = unkey((r0 & ~63u) | 32u), b = unkey((r1 & ~63u) | 32u);
        const unsigned kmax = max8_u32(r0 > r1 ? r0 : r1); const float vmax = unkey((kmax & ~63u) | 32u);
        const float ea = __expf(a - vmax), eb = __expf(b - vmax);
        const float inv = 1.f / sum8_f32(ea + eb);
        int eidx[2];
#pragma unroll
        for (int q = 0; q < 2; ++q) {
            const int cc = 63 - (int)((q ? r1 : r0) & 63u); int ci = 0, off = 0;
#pragma unroll
            for (int i = 0; i < 15; ++i) { const bool ge = cc >= cand_off(i + 1); ci += ge ? 1 : 0; off += ge ? 16 / (i + 1) : 0; }
            const int cj = cc - off;
            eidx[q] = (127 - (int)(k1[ci] & 127u)) * 128 + (127 - (int)(k2[cj] & 127u));
        }
        int* IDX = (int*)(p.ws + WS_IDX) + (size_t)(tok0 + row) * 128 + h * 16; float* GT = (float*)(p.ws + WS_GATE) + (size_t)(tok0 + row) * 128 + h * 16;
        IDX[sub] = eidx[0]; IDX[8 + sub] = eidx[1]; GT[sub] = ea * inv; GT[8 + sub] = eb * inv;
    }
    __syncthreads();
}
#define TOPK_LOAD(AF, tok0_, h_) do { const int lane_ = tidx() & 63, w_ = tidx() >> 6; \
        const bf16_t* ag_ = (const bf16_t*)(p.ws + WS_P) + (size_t)((tok0_) + (w_ >> 2) * 32 + (lane_ & 31)) * 2048 + (h_) * 256 + 8 * (lane_ >> 5); \
        _Pragma("unroll") for (int q_ = 0; q_ < 16; ++q_) AF[q_] = *(const bf16x8*)(ag_ + (q_ >> 3) * 128 + (q_ & 7) * 16); } while (0)
DEV void topk_phase(const Params& p, int layer, int ntok, unsigned char* smem) {
    const int G = gridDim.x, bid = blockIdx.x, h = bid & 7;
    const int nt = ntok / 64;
    bf16x8 afA[16], afB[16];
    if ((G & 7) == 0) {
        const int st = G >> 3; int tt = bid >> 3;
        if (tt < nt) { TOPK_LOAD(afA, tt * 64, h); topk_load_keys(p, layer, h, smem); }
        while (tt < nt) {
            if (tt + st < nt) TOPK_LOAD(afB, (tt + st) * 64, h);
            topk_item(p, h, tt * 64, smem, afA);
            tt += st; if (tt >= nt) break;
            if (tt + st < nt) TOPK_LOAD(afA, (tt + st) * 64, h);
            topk_item(p, h, tt * 64, smem, afB);
            tt += st;
        }
    } else {
        for (int it = bid; it < nt * 8; it += G) { __syncthreads(); TOPK_LOAD(afA, (it >> 3) * 64, it & 7); topk_load_keys(p, layer, it & 7, smem); topk_item(p, it & 7, (it >> 3) * 64, smem, afA); }
    }
}
#undef TOPK_LOAD

DEV float gelu_f(float x) { return 0.5f * x * (1.f + erff(x * 0.70710678118654752f)); }
DEV void peer_item(const Params& p, int layer, int item, int var = 0) {
    (void)var;
    const int tok = item * 8 + (tidx() >> 6), lane = tidx() & 63, li = lane & 31, half = lane >> 5;
    const bf16_t* A = (const bf16_t*)(p.ws + WS_A) + (size_t)tok * 1024 + li * 32;
    const unsigned char* U6 = p.ws + WS_U6 + (size_t)layer * 16384 * 768; const unsigned char* V4 = p.ws + WS_V4 + (size_t)layer * 16384 * 512;
    const float* SU = (const float*)(p.ws + WS_S8) + (size_t)(layer * 2) * 16384; const float* SV = SU + 16384;
    float x[32], y[32];
#pragma unroll
    for (int q = 0; q < 4; ++q) { const u32x4 a = *(const u32x4*)(A + 8 * q);
#pragma unroll
        for (int i = 0; i < 4; ++i) { x[8 * q + 2 * i] = bflo(a[i]); x[8 * q + 2 * i + 1] = bfhi(a[i]); } }
#pragma unroll
    for (int i = 0; i < 32; ++i) y[i] = 0.f;
    const int* IDX = (const int*)(p.ws + WS_IDX) + (size_t)tok * 128; const float* GT = (const float*)(p.ws + WS_GATE) + (size_t)tok * 128;
    const int i_lo = IDX[lane], i_hi = IDX[64 + lane]; const float g_lo = GT[lane], g_hi = GT[64 + lane];
    const int sl = ((li >> 4) & 1) * 2 + ((li >> 3) & 1);
    u32x4 ulo[4], vq[4]; u32x2 uhi[4];
#define PG_LOADU(g) do { _Pragma("unroll") for (int s_ = 0; s_ < 4; ++s_) { const int e_ = __shfl((g) < 8 ? i_lo : i_hi, (((g) & 7) << 3) + 2 * s_ + half); \
        const unsigned char* r_ = U6 + (size_t)e_ * 768; ulo[s_] = *(const u32x4*)(r_ + li * 16); uhi[s_] = *(const u32x2*)(r_ + 512 + li * 8); } } while (0)
#define PG_LOADV(g) do { _Pragma("unroll") for (int s_ = 0; s_ < 4; ++s_) { const int e_ = __shfl((g) < 8 ? i_lo : i_hi, (((g) & 7) << 3) + 2 * s_ + half); \
        vq[s_] = *(const u32x4*)(V4 + (size_t)e_ * 512 + li * 16); } } while (0)
    PG_LOADU(0); PG_LOADV(0);
    for (int g = 0; g < 16; ++g) {
        const int mk = ((g & 7) << 3) + 2 * sl + half; const int me = __shfl(g < 8 ? i_lo : i_hi, mk); const float mg = __shfl(g < 8 ? g_lo : g_hi, mk);
        const float su = SU[me], sv = SV[me];
        float d[4];
#pragma unroll
        for (int s4 = 0; s4 < 4; ++s4) {
            u32x6 w; w[0] = ulo[s4][0]; w[1] = ulo[s4][1]; w[2] = ulo[s4][2]; w[3] = ulo[s4][3]; w[4] = uhi[s4][0]; w[5] = uhi[s4][1];
            const f32x32 f = __builtin_amdgcn_cvt_scalef32_pk32_f32_fp6(w, 1.0f);
            float a = 0.f;
#pragma unroll
            for (int i = 0; i < 32; ++i) a = fmaf(f[i], x[i], a);
            d[s4] = a; SCHED_FENCE(); }
        if (g + 1 < 16) PG_LOADU(g + 1);
        float r2[2], r1;
        { const bool hi = (li & 16) != 0;
#pragma unroll
          for (int j = 0; j < 2; ++j) { const float send = hi ? d[j] : d[2 + j], keep = hi ? d[2 + j] : d[j]; r2[j] = keep + __shfl_xor(send, 16); } }
        { const bool hi = (li & 8) != 0; const float send = hi ? r2[0] : r2[1], keep = hi ? r2[1] : r2[0]; r1 = keep + __shfl_xor(send, 8); }
        r1 += __shfl_xor(r1, 4); r1 += __shfl_xor(r1, 2); r1 += __shfl_xor(r1, 1);
        const float act = gelu_f(r1 * su) * mg * sv;
#pragma unroll
        for (int s4 = 0; s4 < 4; ++s4) {
            const float aj = __shfl(act, (lane & 32) + 16 * (s4 >> 1) + 8 * (s4 & 1));
#pragma unroll
            for (int dw = 0; dw < 4; ++dw) {
                const f32x2 f0 = __builtin_amdgcn_cvt_scalef32_pk_f32_fp4(vq[s4][dw], 1.0f, 0), f1 = __builtin_amdgcn_cvt_scalef32_pk_f32_fp4(vq[s4][dw], 1.0f, 1),
                            f2 = __builtin_amdgcn_cvt_scalef32_pk_f32_fp4(vq[s4][dw], 1.0f, 2), f3 = __builtin_amdgcn_cvt_scalef32_pk_f32_fp4(vq[s4][dw], 1.0f, 3);
                const int e0 = dw * 8;
                y[e0] = fmaf(aj, f0[0], y[e0]); y[e0 + 1] = fmaf(aj, f0[1], y[e0 + 1]); y[e0 + 2] = fmaf(aj, f1[0], y[e0 + 2]); y[e0 + 3] = fmaf(aj, f1[1], y[e0 + 3]);
                y[e0 + 4] = fmaf(aj, f2[0], y[e0 + 4]); y[e0 + 5] = fmaf(aj, f2[1], y[e0 + 5]); y[e0 + 6] = fmaf(aj, f3[0], y[e0 + 6]); y[e0 + 7] = fmaf(aj, f3[1], y[e0 + 7]);
            }
            SCHED_FENCE(); }
        if (g + 1 < 16) PG_LOADV(g + 1);
    }
#undef PG_LOADU
#undef PG_LOADV
    float yy[16];
#pragma unroll
    for (int i = 0; i < 16; ++i) { const float send = half ? y[i] : y[16 + i], keep = half ? y[16 + i] : y[i]; yy[i] = keep + __shfl_xor(send, 32); }
    const int c0 = li * 32 + half * 16;
    float* H = (float*)(p.ws + WS_H) + (size_t)tok * 1024 + c0;
    const float* g2 = (const float*)(p.ws + WS_MOD) + ((size_t)layer * NR + mod_row(tok)) * 6144 + 5120 + c0;
    float hv[16]; float ss = 0.f;
#pragma unroll
    for (int i = 0; i < 4; ++i) { const f32x4 hh = *(const f32x4*)(H + 4 * i), gg = *(const f32x4*)(g2 + 4 * i);
#pragma unroll
        for (int j = 0; j < 4; ++j) { const float v = hh[j] + gg[j] * yy[4 * i + j]; hv[4 * i + j] = v; ss += v * v; } }
    ss = wave_sum(ss);
    const float rstd = rsqrtf(ss * (1.f / 1024.f) + 1e-6f);
    if (layer == 0) {
#pragma unroll
        for (int i = 0; i < 4; ++i) { f32x4 o; o[0] = hv[4 * i]; o[1] = hv[4 * i + 1]; o[2] = hv[4 * i + 2]; o[3] = hv[4 * i + 3]; *(f32x4*)(H + 4 * i) = o; }
        const float* g = p.in[I_N1G] + 1024 + c0;
        const float* mod = (const float*)(p.ws + WS_MOD) + ((size_t)1 * NR + mod_row(tok)) * 6144 + c0;
        bf16_t* Ao = (bf16_t*)(p.ws + WS_A) + (size_t)tok * 1024 + c0;
        u32x4 o0, o1; float r[16];
#pragma unroll
        for (int i = 0; i < 16; ++i) r[i] = hv[i] * rstd * g[i] * (1.f + mod[1024 + i]) + mod[i];
#pragma unroll
        for (int i = 0; i < 4; ++i) { o0[i] = pk2(r[2 * i], r[2 * i + 1]); o1[i] = pk2(r[8 + 2 * i], r[8 + 2 * i + 1]); }
        *(u32x4*)Ao = o0; *(u32x4*)(Ao + 8) = o1;
    } else {
        const float* g = p.in[I_FG] + c0; float* out = p.out + (size_t)tok * 1024 + c0;
#pragma unroll
        for (int i = 0; i < 4; ++i) { f32x4 o; o[0] = hv[4 * i] * rstd * g[4 * i]; o[1] = hv[4 * i + 1] * rstd * g[4 * i + 1]; o[2] = hv[4 * i + 2] * rstd * g[4 * i + 2]; o[3] = hv[4 * i + 3] * rstd * g[4 * i + 3]; *(f32x4*)(out + 4 * i) = o; }
    }
}

constexpr int S3_LD = 136, S3_LDT = 24, S3_LDV = 72;
constexpr int S3_Q = 0, S3_K = S3_Q + 64 * S3_LD * 2, S3_KT = S3_K + 64 * S3_LD * 2, S3_D = S3_KT + 4 * 128 * S3_LDT * 2, S3_V = S3_D + 4 * 128 * 4, S3_ST = S3_V + 64 * S3_LDV * 2,
              S3_P = S3_ST + 2 * 64 * S3_LD * 2, S3_END = S3_P + 4 * 16 * S3_LDT * 2;
static_assert(S3_END <= SMEM_BYTES, "scan LDS");
DEV void scan_block(const Params& p, int bi, unsigned char* smem, int var = 0) {
    const int tid = tidx(), lane = tid & 63, w = tid >> 6, l15 = lane & 15, lg4 = lane >> 4, l31 = lane & 31, lh = lane >> 5;
    const int half = bi & 1, dir = (bi >> 1) & 1, h = (bi >> 2) & 7, b = bi >> 5;
    const bf16_t* P1 = (const bf16_t*)(p.ws + WS_P);
    const bf16_t* IT = (const bf16_t*)(p.ws + WS_M);
    bf16_t* Oo = (bf16_t*)(p.ws + WS_F + (dir ? F_OB : F_OF));
    bf16_t* Qs = (bf16_t*)(smem + S3_Q); bf16_t* Ks = (bf16_t*)(smem + S3_K); bf16_t* KT = (bf16_t*)(smem + S3_KT); float* Ds = (float*)(smem + S3_D);
    bf16_t* Vs = (bf16_t*)(smem + S3_V); bf16_t* ST = (bf16_t*)(smem + S3_ST); bf16_t* Ps = (bf16_t*)(smem + S3_P);
    const int NCH = (LC + L) / 64;
    const int kt = w >> 1, vt = w & 1;
    f32x16 S;
#pragma unroll
    for (int r = 0; r < 16; ++r) S[r] = 0.f;
    for (int i = tid; i < 64 * S3_LD / 2; i += NT) ((unsigned*)ST)[i] = 0u;
    const int pk = tid & 127, pblk = tid >> 7;
    u32x4 ka[2], qa[2], va, kb2[2], qb2[2], vb2;
    const int kcol = 1024 * (1 + dir) + h * 128 + pk, qcol = h * 128 + pk;
#define S3_T0(c) ((c) * 64 < LC ? (dir ? LC - 64 - (c) * 64 : (c) * 64) : (dir ? L - 64 - ((c) * 64 - LC) : (c) * 64 - LC))
#define S3_LOAD(c, KR, QR, VR) do { const bool lat_ = (c) * 64 >= LC; const int t0_ = S3_T0(c); const int Lx_ = lat_ ? L : LC; \
        const bf16_t* kq_ = (const bf16_t*)(p.ws + WS_P + (lat_ ? P1_KQT_LAT : P1_KQT_CTX)) + (size_t)b * 3072 * Lx_ + t0_ + pblk * 16; \
        KR[0] = *(const u32x4*)(kq_ + (size_t)kcol * Lx_); KR[1] = *(const u32x4*)(kq_ + (size_t)kcol * Lx_ + 8); \
        if (lat_) { QR[0] = *(const u32x4*)(kq_ + (size_t)qcol * Lx_); QR[1] = *(const u32x4*)(kq_ + (size_t)qcol * Lx_ + 8); } else { QR[0] = (u32x4){0u, 0u, 0u, 0u}; QR[1] = QR[0]; } \
        { const int v_ = tid >> 3, c8_ = tid & 7; const bf16_t* it_ = IT + (lat_ ? (size_t)0 : (size_t)NB * 1024 * L) + ((size_t)b * 1024 + h * 128 + half * 64 + v_) * Lx_ + t0_ + c8_ * 8; VR = *(const u32x4*)it_; } } while (0)
#define S3_PREP(KR, QR, VR) do { \
            float bsum = 0.f; unsigned short kt16[16]; \
            _Pragma("unroll") for (int rr = 0; rr < 16; ++rr) { \
                const int tl = dir ? 15 - rr : rr; \
                const unsigned ku_ = dir ? KR[(15 - rr) >> 3][((15 - rr) & 7) >> 1] : KR[rr >> 3][(rr & 7) >> 1]; const unsigned qu_ = dir ? QR[(15 - rr) >> 3][((15 - rr) & 7) >> 1] : QR[rr >> 3][(rr & 7) >> 1]; \
                const bool odd_ = dir ? (((15 - rr) & 1) != 0) : ((rr & 1) != 0); \
                const float kv = odd_ ? bfhi(ku_) : bflo(ku_), qv = odd_ ? bfhi(qu_) : bflo(qu_); \
                bsum += __log2f(1.f - kv); \
                const float eb = __builtin_amdgcn_exp2f(bsum), ieb = __builtin_amdgcn_exp2f(fminf(-bsum, 115.f)); \
                const unsigned short qt = (unsigned short)f2bf(qv * eb), ktv = (unsigned short)f2bf(kv * ieb); \
                Qs[(pblk * 16 + tl) * S3_LD + pk] = qt; Ks[(pblk * 16 + tl) * S3_LD + pk] = ktv; \
                if (dir) kt16[15 - rr] = ktv; else kt16[rr] = ktv; \
            } \
            u32x4 o0, o1; \
            _Pragma("unroll") for (int i = 0; i < 4; ++i) { o0[i] = (unsigned)kt16[2 * i] | ((unsigned)kt16[2 * i + 1] << 16); o1[i] = (unsigned)kt16[8 + 2 * i] | ((unsigned)kt16[8 + 2 * i + 1] << 16); } \
            *(u32x4*)(KT + (pblk * 128 + pk) * S3_LDT) = o0; *(u32x4*)(KT + (pblk * 128 + pk) * S3_LDT + 8) = o1; \
            Ds[pblk * 128 + pk] = __builtin_amdgcn_exp2f(bsum); \
            { const int v_ = tid >> 3, c8_ = tid & 7; *(u32x4*)(Vs + v_ * S3_LDV + c8_ * 8) = VR; } } while (0)
    S3_LOAD(0, ka, qa, va);
    for (int c = 0; c < NCH; ++c) {
        const bool lat = c * 64 >= LC; const int t0 = S3_T0(c); const size_t tokb = lat ? (size_t)b * L + t0 : (size_t)TL + (size_t)b * LC + t0;
        if ((c & 1) == 0) { if (c + 1 < NCH) S3_LOAD(c + 1, kb2, qb2, vb2); } else { if (c + 1 < NCH) S3_LOAD(c + 1, ka, qa, va); }
        lds_barrier();
        if (var != 1) { if ((c & 1) == 0) S3_PREP(ka, qa, va); else S3_PREP(kb2, qb2, vb2); }
        lds_barrier();

        if (lat && w < 4) {
            f32x4 pt = (f32x4){0.f, 0.f, 0.f, 0.f};
#pragma unroll
            for (int kk = 0; kk < 4; ++kk)
                pt = __builtin_amdgcn_mfma_f32_16x16x32_bf16(*(const bf16x8*)(Ks + (w * 16 + l15) * S3_LD + kk * 32 + 8 * lg4), *(const bf16x8*)(Qs + (w * 16 + l15) * S3_LD + kk * 32 + 8 * lg4), pt, 0, 0, 0);
            float pm[4];
#pragma unroll
            for (int r = 0; r < 4; ++r) { const int sl = 4 * lg4 + r; const bool keep = dir ? (sl >= l15) : (sl <= l15); pm[r] = keep ? pt[r] : 0.f; }
            u32x2 o; o[0] = pk2(pm[0], pm[1]); o[1] = pk2(pm[2], pm[3]);
            *(u32x2*)(Ps + (w * 16 + l15) * S3_LDT + 4 * lg4) = o;
        }
        lds_barrier();
        for (int ib = 0; ib < (var == 2 ? 0 : 4); ++ib) {
            const int blk = dir ? 3 - ib : ib;
            const int cur = (c * 4 + ib) & 1;
            { const bf16x8 a = *(const bf16x8*)(KT + (blk * 128 + 32 * kt + l31) * S3_LDT + 8 * lh);
              const bf16x8 bb = *(const bf16x8*)(Vs + (32 * vt + l31) * S3_LDV + blk * 16 + 8 * lh);
              S = __builtin_amdgcn_mfma_f32_32x32x16_bf16(a, bb, S, 0, 0, 0);
#pragma unroll
              for (int g = 0; g < 4; ++g) { const f32x4 dv = *(const f32x4*)(Ds + blk * 128 + 32 * kt + 8 * g + 4 * lh);
                  S[4 * g] *= dv[0]; S[4 * g + 1] *= dv[1]; S[4 * g + 2] *= dv[2]; S[4 * g + 3] *= dv[3];
                  u32x2 o; o[0] = pk2(S[4 * g], S[4 * g + 1]); o[1] = pk2(S[4 * g + 2], S[4 * g + 3]);
                  *(u32x2*)(ST + ((cur ^ 1) * 64 + 32 * vt + l31) * S3_LD + 32 * kt + 8 * g + 4 * lh) = o; } }
            if (lat && w < 4) {
                f32x4 o = (f32x4){0.f, 0.f, 0.f, 0.f};
#pragma unroll
                for (int kk = 0; kk < 4; ++kk)
                    o = __builtin_amdgcn_mfma_f32_16x16x32_bf16(*(const bf16x8*)(ST + (cur * 64 + 16 * w + l15) * S3_LD + kk * 32 + 8 * lg4), *(const bf16x8*)(Qs + (blk * 16 + l15) * S3_LD + kk * 32 + 8 * lg4), o, 0, 0, 0);
                bf16x8 va = (bf16x8){0, 0, 0, 0, 0, 0, 0, 0}, pb = va;
                if (lg4 < 2) { va = *(const bf16x8*)(Vs + (16 * w + l15) * S3_LDV + blk * 16 + 8 * lg4); pb = *(const bf16x8*)(Ps + (blk * 16 + l15) * S3_LDT + 8 * lg4); }
                o = __builtin_amdgcn_mfma_f32_16x16x32_bf16(va, pb, o, 0, 0, 0);
                u32x2 ou; ou[0] = pk2(o[0], o[1]); ou[1] = pk2(o[2], o[3]);
                *(u32x2*)(Oo + (tokb + blk * 16 + l15) * 1024 + h * 128 + half * 64 + 16 * w + 4 * lg4) = ou;
            }
            lds_barrier();
        }
    }
    lds_barrier();
#undef S3_T0
#undef S3_LOAD
#undef S3_PREP
}
DEV void readout_item(const Params& p, int item) {
    const int tok = item * 8 + (tidx() >> 6), lane = tidx() & 63;
    const bf16_t* of = (const bf16_t*)(p.ws + WS_F + F_OF) + (size_t)tok * 1024 + lane * 16; const bf16_t* ob = (const bf16_t*)(p.ws + WS_F + F_OB) + (size_t)tok * 1024 + lane * 16;
    const bf16_t* gp = (const bf16_t*)(p.ws + WS_P + P1_G) + (size_t)tok * 1024 + lane * 16;
    const float* on = p.in[I_HGON] + (lane & 7) * 16;
    float o[16], gg[16]; float ss = 0.f;
    { const u32x4 a0 = *(const u32x4*)of, a1 = *(const u32x4*)(of + 8), b0 = *(const u32x4*)ob, b1 = *(const u32x4*)(ob + 8), g0 = *(const u32x4*)gp, g1 = *(const u32x4*)(gp + 8);
#pragma unroll
      for (int i = 0; i < 4; ++i) { o[2 * i] = bflo(a0[i]) + bflo(b0[i]); o[2 * i + 1] = bfhi(a0[i]) + bfhi(b0[i]); o[8 + 2 * i] = bflo(a1[i]) + bflo(b1[i]); o[8 + 2 * i + 1] = bfhi(a1[i]) + bfhi(b1[i]);
          gg[2 * i] = bflo(g0[i]); gg[2 * i + 1] = bfhi(g0[i]); gg[8 + 2 * i] = bflo(g1[i]); gg[8 + 2 * i + 1] = bfhi(g1[i]); } }
#pragma unroll
    for (int i = 0; i < 16; ++i) ss += o[i] * o[i];
    ss += __shfl_xor(ss, 1); ss += __shfl_xor(ss, 2); ss += __shfl_xor(ss, 4);
    const float rstd = rsqrtf(ss * (1.f / 128.f) + 1e-6f);
    bf16_t* M = (bf16_t*)(p.ws + WS_M) + (size_t)tok * 1024 + lane * 16;
    u32x4 o0, o1; float r[16];
#pragma unroll
    for (int i = 0; i < 16; ++i) r[i] = o[i] * rstd * on[i] * gg[i];
#pragma unroll
    for (int i = 0; i < 4; ++i) { o0[i] = pk2(r[2 * i], r[2 * i + 1]); o1[i] = pk2(r[8 + 2 * i], r[8 + 2 * i + 1]); }
    *(u32x4*)M = o0; *(u32x4*)(M + 8) = o1;
}

#ifndef HOST_EMU
#define XB_TMO      128
#define XB_XCNT(j)  (256  + 64 * (j))
#define XB_XSUB(j)  (1280 + 64 * (j))
#define XB_XGEN(j)  (2304 + 64 * (j))
#define XB_TOP      3328
#define XB_TOPGEN   3392
#define XCD_BAR_WORDS 3456
#define XB_SPIN_CAP (1u << 18)
#define LAS __attribute__((address_space(3)))

__device__ __forceinline__ unsigned xb_ld(unsigned* p)              { return __hip_atomic_load(p, __ATOMIC_RELAXED, __HIP_MEMORY_SCOPE_AGENT); }
__device__ __forceinline__ unsigned xb_add(unsigned* p, unsigned v) { return __hip_atomic_fetch_add(p, v, __ATOMIC_RELAXED, __HIP_MEMORY_SCOPE_AGENT); }
__device__ __forceinline__ unsigned xb_xcc_id() { return (unsigned)__builtin_amdgcn_s_getreg((3 << 11) | 20) & 0xFu; }
#define XB_SPIN(cond, bar) do { unsigned _sp = 0; while (cond) { __builtin_amdgcn_s_sleep(1); \
    if ((++_sp & 255u) == 0u) { if (xb_ld(&(bar)[XB_TMO])) break; if (_sp > XB_SPIN_CAP) { atomicAdd(&(bar)[XB_TMO], 1u); break; } } } } while (0)

struct XcdBarrier {
    unsigned* bar; unsigned x;
    volatile LAS unsigned* st;
};

__device__ __forceinline__ XcdBarrier xcd_barrier_post(unsigned* bar, volatile LAS unsigned* st) {
    XcdBarrier b; b.bar = bar; b.x = xb_xcc_id(); b.st = st;
    if (threadIdx.x == 0) (void)xb_add(&bar[XB_XCNT(b.x)], 1u);
    return b;
}
__device__ __forceinline__ void xcd_barrier_complete(unsigned* bar, unsigned x, unsigned& nloc, unsigned& nx) {
    const unsigned G = gridDim.x * gridDim.y * gridDim.z;
    unsigned sum, cnt, mine, sp = 0u;
    for (;;) {
        sum = 0u; cnt = 0u; mine = 0u;
#pragma unroll
        for (unsigned j = 0; j < 16; ++j) { const unsigned c = xb_ld(&bar[XB_XCNT(j)]); sum += c; cnt += (c > 0u) ? 1u : 0u; mine = (j == x) ? c : mine; }
        if (sum == G) break;
        __builtin_amdgcn_s_sleep(1);
        if ((++sp & 255u) == 0u) { if (xb_ld(&bar[XB_TMO])) break; if (sp > XB_SPIN_CAP) { atomicAdd(&bar[XB_TMO], 1u); break; } }
    }
    nloc = mine > 0u ? mine : 1u; nx = cnt > 0u ? cnt : 1u;
}

__device__ __forceinline__ void xcd_barrier(const XcdBarrier& b) {
    asm volatile("s_waitcnt vmcnt(0)" ::: "memory");
    __syncthreads();
    if (threadIdx.x == 0) {
        unsigned* bar = b.bar;
        __builtin_amdgcn_s_waitcnt(0);
        unsigned nloc = b.st[0], nx = b.st[1];
        if (nloc == 0u) { xcd_barrier_complete(bar, b.x, nloc, nx); b.st[0] = nloc; b.st[1] = nx; }
        const unsigned old = xb_add(&bar[XB_XSUB(b.x)], 1u);
        const unsigned gen = old / nloc;
        if (old + 1u == (gen + 1u) * nloc) {
            __builtin_amdgcn_fence(__ATOMIC_RELEASE, "agent");
            asm volatile("s_waitcnt vmcnt(0)" ::: "memory");
            const unsigned og = xb_add(&bar[XB_TOP], 1u);
            const unsigned tg = og / nx;
            if (og + 1u == (tg + 1u) * nx) xb_add(&bar[XB_TOPGEN], 1u);
            else XB_SPIN(xb_ld(&bar[XB_TOPGEN]) == tg, bar);
            __builtin_amdgcn_fence(__ATOMIC_ACQUIRE, "agent");
            xb_add(&bar[XB_XGEN(b.x)], 1u);
            asm volatile("s_waitcnt vmcnt(0)" ::: "memory");
        } else {
            XB_SPIN(xb_ld(&bar[XB_XGEN(b.x)]) == gen, bar);
            __builtin_amdgcn_fence(__ATOMIC_ACQUIRE, "agent");
            asm volatile("s_waitcnt vmcnt(0)" ::: "memory");
        }
    }
    __syncthreads();
}

#endif
#ifdef NOINLINE_PHASES
#define NOINL __device__ __attribute__((noinline))
#else
#define NOINL __device__ __forceinline__
#endif
__shared__ __attribute__((aligned(16))) unsigned char g_smem[SMEM_BYTES + 16];
#define PH_COMMON const int G = gridDim.x, bid = blockIdx.x; unsigned char* smem = g_smem; (void)smem; (void)G; (void)bid; \
    const bf16_t* A = (const bf16_t*)(p.ws + WS_A); const bf16_t* Mx = (const bf16_t*)(p.ws + WS_M); const bf16_t* W = (const bf16_t*)(p.ws + WS_W); (void)A; (void)Mx; (void)W;
DEV void tables_in_gemm_tail(const Params& p, int tab0, int ntab, int nunits) {
    const int G = gridDim.x, bid = blockIdx.x, busy = nunits % G;
    if (busy == 0) { for (int it = bid; it < ntab * P0_TAB; it += G) p0_table(p, tab0 + it / P0_TAB, it % P0_TAB); return; }
    if (bid < busy) return;
    for (int it = bid - busy; it < ntab * P0_TAB; it += G - busy) p0_table(p, tab0 + it / P0_TAB, it % P0_TAB);
}
NOINL void ph0(const Params& p) { PH_COMMON phase0(p, smem); }
NOINL void ph1(const Params& p) { PH_COMMON phase1(p, smem); }
NOINL void ph2(const Params& p) { PH_COMMON EpiL0InT e{p.ws}; gemm_pg8_T(A, W + W_IN0 / 2, T, 2304, smem, e); tables_in_gemm_tail(p, 0, 1, (T / 256) * 9); }
NOINL void ph3(const Params& p, int var = 0) { PH_COMMON phase3(p, smem, var); }
NOINL void ph4(const Params& p) { PH_COMMON EpiRes e{&p, 1, 0, 2048}; gemm_pg8_N(Mx, W + W_OUT0 / 2, T, 1024, smem, e); tables_in_gemm_tail(p, 1, 2, (T / 256) * 4); }
NOINL void ph5(const Params& p) { PH_COMMON for (int it = bid; it < T / 8; it += G) norm_rows_item(p, it, 0, p.in[I_N2G], 0, 3072); }
NOINL void ph6(const Params& p, int var = 0) { PH_COMMON (void)var; EpiBf16 e{(bf16_t*)(p.ws + WS_P), 2048}; gemm_pg8_N(A, W + W_Q0 / 2, T, 2048, smem, e); tables_in_gemm_tail(p, 3, 1, (T / 256) * 8); }
NOINL void ph7(const Params& p) { PH_COMMON topk_phase(p, 0, T, smem); }
NOINL void ph8(const Params& p) { PH_COMMON for (int it = bid; it < T / 8; it += G) peer_item(p, 0, it); }
NOINL void ph9(const Params& p, int var = 0) { PH_COMMON EpiHgT e{p.ws, p.in[I_HGLB], var}; gemm_pg8_T(A, W + W_IN1 / 2, T, 5120, smem, e); }
NOINL void ph10(const Params& p, int var = 0) { PH_COMMON for (int bi = bid; bi < NB * 32; bi += G) scan_block(p, bi, smem, var); }
NOINL void ph11(const Params& p) { PH_COMMON for (int it = bid; it < TL / 8; it += G) readout_item(p, it); }
NOINL void ph12(const Params& p) { PH_COMMON EpiRes e{&p, 0, 1, 2048}; gemm_pg8_N(Mx, W + W_OUT1 / 2, TL, 1024, smem, e); }
NOINL void ph13(const Params& p) { PH_COMMON for (int it = bid; it < TL / 8; it += G) norm_rows_item(p, it, 0, p.in[I_N2G] + 1024, 1, 3072); }
NOINL void ph14(const Params& p) { PH_COMMON EpiBf16 e{(bf16_t*)(p.ws + WS_P), 2048}; gemm_pg8_N(A, W + W_Q1 / 2, TL, 2048, smem, e); }
NOINL void ph15(const Params& p) { PH_COMMON topk_phase(p, 1, TL, smem); }
NOINL void ph16(const Params& p, int var = 0) { PH_COMMON for (int it = bid; it < TL / 8; it += G) peer_item(p, 1, it, var); }

constexpr int NPHASE = 17;
__global__ void __launch_bounds__(NT, 2) mega(Params p_in) {
    const int ph_lo = p_in.ph_lo, ph_hi = p_in.ph_hi;
#ifndef HOST_EMU
#define GBAR_MAKE() XcdBarrier gbar; gbar.bar = (unsigned*)(p_in.ws + WS_CTRL); gbar.x = xb_xcc_id(); gbar.st = (volatile LAS unsigned*)(LAS unsigned char*)(g_smem + SMEM_BYTES);
    if (ph_hi - ph_lo > 1) {
        volatile LAS unsigned* st = (volatile LAS unsigned*)(LAS unsigned char*)(g_smem + SMEM_BYTES);
        if (threadIdx.x == 0) { st[0] = 0u; st[1] = 0u; }
        __syncthreads();
        (void)xcd_barrier_post((unsigned*)(p_in.ws + WS_CTRL), st);
    }
#endif
#ifndef HOST_EMU
#define PH_BARRIER() do { GBAR_MAKE(); xcd_barrier(gbar); } while (0)
#define PH_PARAMS() unsigned long long kp = (unsigned long long)__builtin_amdgcn_kernarg_segment_ptr(); asm volatile("" : "+s"(kp) :: "memory"); \
        const Params& p = *(const Params*)(const __attribute__((address_space(4))) Params*)kp;
#else
#define PH_BARRIER() do {} while (0)
#define PH_PARAMS() const Params& p = p_in;
#endif
#ifdef REPEAT_MASK
#define PH_REPEAT(k, CALL) if ((REPEAT_MASK >> (k)) & 1) { PH_BARRIER(); { PH_PARAMS(); CALL; } }
#else
#define PH_REPEAT(k, CALL)
#endif
#ifdef ONLY_PHASE
#define PH_ON(k) ((k) == ONLY_PHASE)
#else
#define PH_ON(k) true
#endif
#if defined(REPEAT_MASK) && defined(HG_VAR)
#define RUN_PHASE9() if (ph_lo <= 9 && 9 < ph_hi) { if (9 > ph_lo) PH_BARRIER(); { PH_PARAMS(); ph9(p, HG_VAR); } PH_BARRIER(); { PH_PARAMS(); ph9(p, 0); } }
#else
#define RUN_PHASE9() RUN_PHASE(9, ph9(p))
#endif
#if defined(REPEAT_MASK) && defined(P3_VAR)
#define RUN_PHASE3() if (ph_lo <= 3 && 3 < ph_hi) { if (3 > ph_lo) PH_BARRIER(); { PH_PARAMS(); ph3(p, P3_VAR); } PH_BARRIER(); { PH_PARAMS(); ph3(p, 0); } }
#else
#define RUN_PHASE3() RUN_PHASE(3, ph3(p))
#endif
#define RUN_PHASE(k, CALL) if (PH_ON(k) && ph_lo <= (k) && (k) < ph_hi) { if ((k) > ph_lo) PH_BARRIER(); { PH_PARAMS(); CALL; } PH_REPEAT(k, CALL) }
    RUN_PHASE(0, ph0(p))  RUN_PHASE(1, ph1(p))  RUN_PHASE(2, ph2(p))  RUN_PHASE3()  RUN_PHASE(4, ph4(p))  RUN_PHASE(5, ph5(p))
    RUN_PHASE(6, ph6(p))  RUN_PHASE(7, ph7(p))  RUN_PHASE(8, ph8(p))  RUN_PHASE9()  RUN_PHASE(10, ph10(p)) RUN_PHASE(11, ph11(p))
    RUN_PHASE(12, ph12(p)) RUN_PHASE(13, ph13(p)) RUN_PHASE(14, ph14(p)) RUN_PHASE(15, ph15(p)) RUN_PHASE(16, ph16(p))
}

#ifndef HOST_EMU
extern "C" void kernel_launch(void* const* d_in, const int* in_sizes, int n_in, void* d_out, int out_size, void* d_ws, size_t ws_size, hipStream_t stream) {
    if (n_in != 29 || ws_size < WS_END || out_size != TL * 1024) { fprintf(stderr, "kernel_launch: unexpected sizes (n_in %d, ws %zu need %zu, out %d)\n", n_in, ws_size, (size_t)WS_END, out_size); return; }
    static int grid = 0;
    if (!grid) { int dev = 0, cus = 0; hipGetDevice(&dev); hipDeviceGetAttribute(&cus, hipDeviceAttributeMultiprocessorCount, dev); grid = cus > 0 ? cus : 256; }
    hipMemsetAsync((unsigned char*)d_ws + WS_CTRL, 0, CTRL_BYTES, stream);
    Params p{};
    for (int i = 0; i < 29; ++i) p.in[i] = (const float*)d_in[i];
    p.out = (float*)d_out; p.ws = (unsigned char*)d_ws;
#ifdef MULTI_LAUNCH
    for (int ph = 0; ph < NPHASE; ++ph) { p.ph_lo = ph; p.ph_hi = ph + 1; hipLaunchKernelGGL(mega, dim3(grid), dim3(NT), 0, stream, p); }
#else
    p.ph_lo = 0; p.ph_hi = NPHASE;
    hipLaunchKernelGGL(mega, dim3(grid), dim3(NT), 0, stream, p);
#endif
}
#endif
```

```cpp
#ifndef HOST_EMU
#include <hip/hip_runtime.h>
#include <cstdio>
#endif

#ifndef CFG_B
#define CFG_B 8
#define CFG_L 2048
#define CFG_LC 256
#endif
#define DEV __device__ __forceinline__
#ifndef HOST_EMU
#define SCHED_FENCE() __builtin_amdgcn_sched_barrier(0)
#endif
#ifdef HOST_EMU
#define SCHED_FENCE() do {} while (0)
#define __expf expf
#define __logf logf
#define __log2f log2f
#define __exp2f exp2f
#define __sinf sinf
#define __cosf cosf
#endif

typedef unsigned short bf16_t;
typedef short bf16x8 __attribute__((ext_vector_type(8)));
typedef float f32x16 __attribute__((ext_vector_type(16)));
typedef float f32x4 __attribute__((ext_vector_type(4)));
typedef unsigned u32x4 __attribute__((ext_vector_type(4)));
typedef unsigned u32x2 __attribute__((ext_vector_type(2)));
struct cf2 { float x, y; };

constexpr int NB = CFG_B, L = CFG_L, LC = CFG_LC, D = 1024;
constexpr int TL = NB * L, TC = NB * LC, T = TL + TC;
constexpr int NT = 512;
constexpr int NR = NB + 1;
constexpr int log4ceil(int n) { int s = 0, v = 1; while (v < n) { v *= 4; ++s; } return s; }
constexpr int FS_LAT = log4ceil(2 * L - 1), FS_CTX = log4ceil(2 * LC - 1);
constexpr int NF_LAT = 1 << (2 * FS_LAT), NF_CTX = 1 << (2 * FS_CTX);
static_assert(T % 256 == 0 && TL % 256 == 0 && L % 128 == 0 && LC % 128 == 0 && NB % 2 == 0, "shape");

constexpr size_t al256(size_t x) { return (x + 255) & ~(size_t)255; }
constexpr size_t WS_CTRL = 0, CTRL_BYTES = 65536;
constexpr size_t CTRL_HYNORM = 4096;
constexpr size_t WS_MOD = WS_CTRL + CTRL_BYTES;
constexpr size_t WS_H = al256(WS_MOD + (size_t)2 * NR * 6144 * 4);
constexpr size_t WS_A = al256(WS_H + (size_t)T * 1024 * 4);
constexpr size_t WS_P = al256(WS_A + (size_t)T * 1024 * 2);
constexpr size_t P_BYTES = (size_t)T * 5120 * 2;
constexpr size_t P_HYT_LAT = 0;
constexpr size_t P_HYT_CTX = P_HYT_LAT + (size_t)NB * 1536 * L * 2;
constexpr size_t P_Q0 = P_HYT_CTX + (size_t)NB * 1536 * LC * 2;
constexpr size_t P_K0 = P_Q0 + (size_t)T * 512 * 2;
constexpr size_t P_VT_LAT = P_K0 + (size_t)T * 128 * 2;
constexpr size_t P_VT_CTX = P_VT_LAT + (size_t)NB * 128 * L * 2;
static_assert(P_VT_CTX + (size_t)NB * 128 * LC * 2 <= P_BYTES, "P region");
constexpr size_t P1_KQT_LAT = 0;
constexpr size_t P1_KQT_CTX = P1_KQT_LAT + (size_t)NB * 3072 * L * 2;
constexpr size_t P1_G = P1_KQT_CTX + (size_t)NB * 3072 * LC * 2;
static_assert(P1_G + (size_t)TL * 1024 * 2 <= P_BYTES, "P region (layer 1)");
constexpr size_t WS_M = al256(WS_P + P_BYTES);
constexpr size_t WS_IDX = al256(WS_M + (size_t)T * 1024 * 2);
constexpr size_t WS_GATE = al256(WS_IDX + (size_t)T * 128 * 4);
constexpr size_t WS_UV = al256(WS_GATE + (size_t)T * 128 * 4);
constexpr size_t WS_S8 = WS_UV + (size_t)2 * 16384 * 1024;
constexpr size_t WS_W = al256(WS_S8 + (size_t)4 * 16384 * 4);
constexpr size_t W_IN0 = 0, W_OUT0 = W_IN0 + (size_t)2304 * 1024 * 2, W_IN1 = W_OUT0 + (size_t)1024 * 1024 * 2,
                 W_OUT1 = W_IN1 + (size_t)5120 * 1024 * 2, W_Q0 = W_OUT1 + (size_t)1024 * 1024 * 2, W_Q1 = W_Q0 + (size_t)2048 * 1024 * 2,
                 W_KEYS = W_Q1 + (size_t)2048 * 1024 * 2, W_BYTES = W_KEYS + (size_t)2 * 8 * 2 * 128 * 128 * 2;
constexpr size_t WS_F = al256(WS_W + W_BYTES);
constexpr size_t F_HRAW_LAT = 0;
constexpr size_t F_HRAW_CTX = F_HRAW_LAT + (size_t)2048 * L * 4;
constexpr size_t F_HF_LAT = F_HRAW_CTX + (size_t)2048 * LC * 4;
constexpr size_t F_HF_CTX = F_HF_LAT + (size_t)1024 * NF_LAT * 8;
constexpr size_t F_HYP_LAT = F_HF_CTX + (size_t)1024 * NF_CTX * 8;
constexpr size_t F_HYP_CTX = F_HYP_LAT + (size_t)(L / 64) * 2048 * 4;
constexpr size_t F_END = F_HYP_CTX + (size_t)(LC / 64) * 2048 * 4;
constexpr size_t F_OF = 0, F_OB = (size_t)TL * 1024 * 2;
constexpr size_t F_BYTES = F_END > 2 * F_OB ? F_END : 2 * F_OB;
constexpr size_t WS_END = al256(WS_F + F_BYTES);

struct Params { const float* in[29]; float* out; unsigned char* ws; int ph_lo, ph_hi; };
enum { I_X = 0, I_C, I_CTX, I_CCTX, I_ADAW, I_ADAB, I_N1G, I_N2G, I_FG, I_ABWIN, I_ABWOUT, I_HYCW, I_HYCB, I_HYW1, I_HYB1, I_HYW2, I_HYB2, I_HYW3,
       I_HYFREQ, I_HYSKIP, I_SINK, I_HGWIN, I_HGWOUT, I_HGLB, I_HGON, I_PWQ, I_PKEYS, I_PU, I_PV };

constexpr int SMEM_BYTES = 147456;

#ifndef HOST_EMU
DEV int tidx() { int t = threadIdx.x; asm volatile("" : "+v"(t)); return t; }
#else
DEV int tidx() { return (int)threadIdx.x; }
#endif
#ifndef HOST_EMU
DEV void lds_barrier() { asm volatile("s_waitcnt lgkmcnt(0)" ::: "memory"); __builtin_amdgcn_s_barrier(); asm volatile("" ::: "memory"); }
#else
DEV void lds_barrier() { __syncthreads(); }
#endif
#ifndef HOST_EMU
typedef __bf16 bf16n2 __attribute__((ext_vector_type(2)));
DEV unsigned pk2(float lo, float hi) { bf16n2 v; v[0] = (__bf16)lo; v[1] = (__bf16)hi; return __builtin_bit_cast(unsigned, v); }
DEV unsigned f2bf(float f) { return (unsigned)__builtin_bit_cast(unsigned short, (__bf16)f); }
#else
DEV unsigned f2bf(float f) { unsigned u = __builtin_bit_cast(unsigned, f); return (u + 0x7fffu + ((u >> 16) & 1u)) >> 16; }
DEV unsigned pk2(float lo, float hi) { return f2bf(lo) | (f2bf(hi) << 16); }
#endif
DEV float bf2f(unsigned h) { return __builtin_bit_cast(float, (h & 0xffffu) << 16); }
DEV float bflo(unsigned u) { return __builtin_bit_cast(float, u << 16); }
DEV float bfhi(unsigned u) { return __builtin_bit_cast(float, u & 0xffff0000u); }
DEV float silu_f(float x) { return x * __builtin_amdgcn_rcpf(1.f + __expf(-x)); }
DEV float sigmoid_f(float x) { return __builtin_amdgcn_rcpf(1.f + __expf(-x)); }
DEV float wave_sum(float v) {
#pragma unroll
    for (int m = 32; m >= 1; m >>= 1) v += __shfl_xor(v, m);
    return v;
}
DEV int mod_row(int tok) { return tok < TL ? tok / L : NB; }

DEV void p0_mod(const Params& p, int item, unsigned char* smem) {
    const int l = item / 96, col0 = (item % 96) * 64, tid = tidx();
    float* sc = (float*)smem;
    float* red = sc + NR * 1024;
    for (int i = tid; i < NR * 1024; i += NT) { const int r = i >> 10, k = i & 1023; const float c = r < NB ? p.in[I_C][r * 1024 + k] : p.in[I_CCTX][k]; sc[i] = c / (1.f + expf(-c)); }
    __syncthreads();
    const int kq = tid >> 6, col = tid & 63;
    float acc[NR];
#pragma unroll
    for (int r = 0; r < NR; ++r) acc[r] = 0.f;
    const float* w = p.in[I_ADAW] + (size_t)l * 1024 * 6144 + col0 + col;
#pragma unroll 16
    for (int k = kq * 128; k < kq * 128 + 128; ++k) {
        const float wv = w[(size_t)k * 6144];
#pragma unroll
        for (int r = 0; r < NR; ++r) acc[r] += sc[r * 1024 + k] * wv;
    }
#pragma unroll
    for (int r = 0; r < NR; ++r) red[(kq * NR + r) * 64 + col] = acc[r];
    __syncthreads();
    float* mod = (float*)(p.ws + WS_MOD);
    for (int i = tid; i < NR * 64; i += NT) {
        const int r = i >> 6, c = i & 63; float s = 0.f;
        for (int q = 0; q < 8; ++q) s += red[(q * NR + r) * 64 + c];
        mod[((size_t)l * NR + r) * 6144 + col0 + c] = s + p.in[I_ADAB][l * 6144 + col0 + c];
    }
    __syncthreads();
}
DEV void p0_transpose(const float* W, bf16_t* Wt, int N, int tile, unsigned char* smem) {
    float* ts = (float*)smem;
    const int ntn = N / 256, kt = tile / ntn, nt = tile % ntn, k0 = kt * 64, n0 = nt * 256, tid = tidx();
    f32x4 rv[8];
#pragma unroll
    for (int m = 0; m < 8; ++m) { const int i = tid + NT * m, kk = i >> 6, c4 = i & 63; rv[m] = *(const f32x4*)(W + (size_t)(k0 + kk) * N + n0 + c4 * 4); }
#pragma unroll
    for (int m = 0; m < 8; ++m) { const int i = tid + NT * m, kk = i >> 6, c4 = i & 63; *(f32x4*)(ts + kk * 260 + c4 * 4) = rv[m]; }
    __syncthreads();
#pragma unroll
    for (int m = 0; m < 4; ++m) { const int i = tid + NT * m, nn = i >> 3, k8 = i & 7;
        u32x4 o;
#pragma unroll
        for (int e = 0; e < 4; ++e) o[e] = pk2(ts[(k8 * 8 + 2 * e) * 260 + nn], ts[(k8 * 8 + 2 * e + 1) * 260 + nn]);
        *(u32x4*)(Wt + (size_t)(n0 + nn) * 1024 + k0 + k8 * 8) = o; }
    __syncthreads();
}
DEV void p0_convert(const float* src, bf16_t* dst, int item) {
    const int tid = tidx();
#pragma unroll
    for (int i = 0; i < 8; ++i) {
        const size_t e = (size_t)item * 16384 + (size_t)(i * NT + tid) * 4;
        const f32x4 v = *(const f32x4*)(src + e);
        u32x2 o; o[0] = pk2(v[0], v[1]); o[1] = pk2(v[2], v[3]);
        *(u32x2*)(dst + e) = o;
    }
}
typedef float f32x2 __attribute__((ext_vector_type(2)));
typedef float f32x32 __attribute__((ext_vector_type(32)));
typedef unsigned u32x6 __attribute__((ext_vector_type(6)));
DEV void p0_table(const Params& p, int tab, int item) {
    const int lane = tidx() & 63, li = lane & 31, half = lane >> 5, layer = tab >> 1, isv = tab & 1;
#pragma unroll 1
    for (int pass = 0; pass < 2; ++pass) {
        const int row = item * 32 + pass * 16 + (tidx() >> 6) * 2 + half;
        const float* src = (isv ? p.in[I_PV] : p.in[I_PU]) + ((size_t)layer * 16384 + row) * 1024 + li * 32;
        f32x4 v[8]; float mx = 0.f;
#pragma unroll
        for (int i = 0; i < 8; ++i) { v[i] = *(const f32x4*)(src + 4 * i); mx = fmaxf(mx, fmaxf(fmaxf(fabsf(v[i][0]), fabsf(v[i][1])), fmaxf(fabsf(v[i][2]), fabsf(v[i][3])))); }
#pragma unroll
        for (int m = 16; m >= 1; m >>= 1) mx = fmaxf(mx, __shfl_xor(mx, m));
        const float top = 6.f;
        const float sc = mx > 0.f ? top / mx : 1.f;
        {
            const f32x2 pr4 = __builtin_amdgcn_cvt_scalef32_pk_f32_fp4(__builtin_amdgcn_cvt_scalef32_pk_fp4_f32(0u, 1.0f, 0.0f, 1.0f, 0), 1.0f, 0);
            const bool swp = pr4[0] != 1.0f;
            u32x4 w;
#pragma unroll
            for (int d = 0; d < 4; ++d) { unsigned x = 0u;
                x = __builtin_amdgcn_cvt_scalef32_pk_fp4_f32(x, (swp ? v[2 * d][1] : v[2 * d][0]) * sc, (swp ? v[2 * d][0] : v[2 * d][1]) * sc, 1.0f, 0);
                x = __builtin_amdgcn_cvt_scalef32_pk_fp4_f32(x, (swp ? v[2 * d][3] : v[2 * d][2]) * sc, (swp ? v[2 * d][2] : v[2 * d][3]) * sc, 1.0f, 1);
                x = __builtin_amdgcn_cvt_scalef32_pk_fp4_f32(x, (swp ? v[2 * d + 1][1] : v[2 * d + 1][0]) * sc, (swp ? v[2 * d + 1][0] : v[2 * d + 1][1]) * sc, 1.0f, 2);
                x = __builtin_amdgcn_cvt_scalef32_pk_fp4_f32(x, (swp ? v[2 * d + 1][3] : v[2 * d + 1][2]) * sc, (swp ? v[2 * d + 1][2] : v[2 * d + 1][3]) * sc, 1.0f, 3);
                w[d] = x; }
            *(u32x4*)(p.ws + WS_UV + ((size_t)layer * 16384 + row) * 1024 + isv * 512 + li * 16) = w;
        }
        if (li == 0) ((float*)(p.ws + WS_S8))[tab * 16384 + row] = mx > 0.f ? mx / top : 1.f;
    }
}
DEV void p0_filter(const Params& p, int set, int chunk, int cb, unsigned char* smem) {
    const int Ls = set ? LC : L, l0 = chunk * 64, tid = tidx();
    float* z = (float*)smem;
    float* hd1 = z + 64 * 34;
    float* hd2 = hd1 + 64 * 65;
    const float* w1 = p.in[I_HYW1]; const float* b1 = p.in[I_HYB1]; const float* w2 = p.in[I_HYW2]; const float* b2 = p.in[I_HYB2];
    const float* w3 = p.in[I_HYW3]; const float* fq = p.in[I_HYFREQ];
    for (int i = tid; i < 64 * 33; i += NT) {
        const int pp = i / 33, f = i % 33, l = l0 + pp; float val;
        if (f == 0) val = (float)l / (float)(Ls - 1);
        else { const int jb = (f - 1) & 15; const float fj = 1e-4f + (float)jb * ((15.f - 1e-4f) / 15.f); const float a = fj * (6.283185307179586f * (float)l / (float)Ls); val = f <= 16 ? __cosf(a) : -__sinf(a); }
        z[pp * 34 + f] = val;
    }
    __syncthreads();
    {
        const int j = tid & 63, p0 = tid >> 6;
        float wc[64], acc[8];
#pragma unroll
        for (int f = 0; f < 33; ++f) wc[f] = w1[f * 64 + j];
#pragma unroll
        for (int m = 0; m < 8; ++m) { float sacc = b1[j];
#pragma unroll
            for (int f = 0; f < 33; ++f) sacc = fmaf(z[(p0 + 8 * m) * 34 + f], wc[f], sacc);
            acc[m] = sacc; }
#pragma unroll
        for (int m = 0; m < 8; ++m) hd1[(p0 + 8 * m) * 65 + j] = __sinf(fq[j] * acc[m]);
        __syncthreads();
#pragma unroll
        for (int f = 0; f < 64; ++f) wc[f] = w2[f * 64 + j];
#pragma unroll
        for (int m = 0; m < 8; ++m) { float sacc = b2[j];
#pragma unroll
            for (int f = 0; f < 64; ++f) sacc = fmaf(hd1[(p0 + 8 * m) * 65 + f], wc[f], sacc);
            acc[m] = sacc; }
#pragma unroll
        for (int m = 0; m < 8; ++m) hd2[(p0 + 8 * m) * 65 + j] = __sinf(fq[j] * acc[m]);
        __syncthreads();
    }
    const float max_decay = -15.350567286626973f, min_decay = -3.0701134573253945f;
    float* hraw = (float*)(p.ws + WS_F + (set ? F_HRAW_CTX : F_HRAW_LAT));
    float* hyn = (float*)(p.ws + WS_F + (set ? F_HYP_CTX : F_HYP_LAT)) + (size_t)chunk * 2048;
    {
        const int o = cb * NT + tid;
        const int c = o & 511; const float delta = fabsf(min_decay + (float)c * ((max_decay - min_decay) / 511.f));
        float asum = 0.f;
        float* dst = hraw + (size_t)o * Ls + l0;
        for (int ph = 0; ph < 2; ++ph) {
            float acc[32];
#pragma unroll
            for (int pp = 0; pp < 32; ++pp) acc[pp] = 0.f;
#pragma unroll 1
            for (int j0 = 0; j0 < 64; j0 += 16) {
                float wv[16];
#pragma unroll
                for (int j = 0; j < 16; ++j) wv[j] = w3[(j0 + j) * 2048 + o];
#pragma unroll
                for (int j = 0; j < 16; ++j) {
#pragma unroll
                    for (int pp = 0; pp < 32; ++pp) acc[pp] = fmaf(hd2[(ph * 32 + pp) * 65 + j0 + j], wv[j], acc[pp]);
                    SCHED_FENCE();
                }
            }
#pragma unroll
            for (int q4 = 0; q4 < 8; ++q4) {
                f32x4 v;
#pragma unroll
                for (int e = 0; e < 4; ++e) { const int pp = q4 * 4 + e; const float tl = (float)(l0 + ph * 32 + pp) / (float)(Ls - 1); const float val = acc[pp] * expf(-tl * delta); v[e] = val; asum += fabsf(val); }
                *(f32x4*)(dst + ph * 32 + q4 * 4) = v;
            }
        }
        hyn[o] = asum;
    }
    __syncthreads();
}

constexpr int P0_MOD = 192, P0_TR_IN0 = 16 * 9, P0_TR_OUT0 = 64, P0_TR_IN1 = 16 * 20, P0_TR_OUT1 = 64, P0_TR_Q = 16 * 8, P0_KEYS = 32, P0_TAB = 512,
              P0_FILT = 4 * (L / 64 + LC / 64);
DEV void phase0(const Params& p, unsigned char* smem) {
    bf16_t* W = (bf16_t*)(p.ws + WS_W);
    const int total = P0_MOD + P0_FILT + P0_TR_IN0 + P0_TR_OUT0 + P0_TR_IN1 + P0_TR_OUT1 + 2 * P0_TR_Q + P0_KEYS;
    for (int it = blockIdx.x; it < total; it += gridDim.x) {
        int i = it;
        if (i < P0_MOD) { p0_mod(p, i, smem); continue; } i -= P0_MOD;
        if (i < P0_FILT) { const int ch = i >> 2, cb = i & 3; if (ch < L / 64) p0_filter(p, 0, ch, cb, smem); else p0_filter(p, 1, ch - L / 64, cb, smem); continue; } i -= P0_FILT;
        if (i < P0_TR_IN0) { p0_transpose(p.in[I_ABWIN], W + W_IN0 / 2, 2304, i, smem); continue; } i -= P0_TR_IN0;
        if (i < P0_TR_OUT0) { p0_transpose(p.in[I_ABWOUT], W + W_OUT0 / 2, 1024, i, smem); continue; } i -= P0_TR_OUT0;
        if (i < P0_TR_IN1) { p0_transpose(p.in[I_HGWIN], W + W_IN1 / 2, 5120, i, smem); continue; } i -= P0_TR_IN1;
        if (i < P0_TR_OUT1) { p0_transpose(p.in[I_HGWOUT], W + W_OUT1 / 2, 1024, i, smem); continue; } i -= P0_TR_OUT1;
        if (i < P0_TR_Q) { p0_transpose(p.in[I_PWQ], W + W_Q0 / 2, 2048, i, smem); continue; } i -= P0_TR_Q;
        if (i < P0_TR_Q) { p0_transpose(p.in[I_PWQ] + (size_t)1024 * 2048, W + W_Q1 / 2, 2048, i, smem); continue; } i -= P0_TR_Q;
        p0_convert(p.in[I_PKEYS], W + W_KEYS / 2, i);
    }
}

DEV const float* h_row(const Params& p, int layer_src_inputs, int tok) {
    if (layer_src_inputs) return tok < TL ? p.in[I_X] + (size_t)tok * 1024 : p.in[I_CTX] + (size_t)(tok - TL) * 1024;
    return (const float*)(p.ws + WS_H) + (size_t)tok * 1024;
}
DEV void norm_row_store(const Params& p, const f32x4 (&v)[4], int tok, const float* g, int layer, int sh_off, int lane) {
    float ss = 0.f;
#pragma unroll
    for (int i = 0; i < 4; ++i) ss += v[i][0] * v[i][0] + v[i][1] * v[i][1] + v[i][2] * v[i][2] + v[i][3] * v[i][3];
    ss = wave_sum(ss);
    const float rstd = rsqrtf(ss * (1.f / 1024.f) + 1e-6f);
    const float* mod = (const float*)(p.ws + WS_MOD) + ((size_t)layer * NR + mod_row(tok)) * 6144 + sh_off;
    bf16_t* A = (bf16_t*)(p.ws + WS_A) + (size_t)tok * 1024;
#pragma unroll
    for (int i = 0; i < 4; ++i) {
        const int c = i * 256 + lane * 4;
        const f32x4 gg = *(const f32x4*)(g + c), sh = *(const f32x4*)(mod + c), sc = *(const f32x4*)(mod + 1024 + c);
        u32x2 o;
        o[0] = pk2(v[i][0] * rstd * gg[0] * (1.f + sc[0]) + sh[0], v[i][1] * rstd * gg[1] * (1.f + sc[1]) + sh[1]);
        o[1] = pk2(v[i][2] * rstd * gg[2] * (1.f + sc[2]) + sh[2], v[i][3] * rstd * gg[3] * (1.f + sc[3]) + sh[3]);
        *(u32x2*)(A + c) = o;
    }
}
DEV void norm_rows_item(const Params& p, int item, int from_inputs, const float* g, int layer, int sh_off) {
    const int tok = item * 8 + (tidx() >> 6), lane = tidx() & 63;
    const float* src = h_row(p, from_inputs, tok);
    f32x4 v[4];
#pragma unroll
    for (int i = 0; i < 4; ++i) v[i] = *(const f32x4*)(src + i * 256 + lane * 4);
    norm_row_store(p, v, tok, g, layer, sh_off, lane);
}

DEV cf2 cmul(cf2 a, cf2 b) { cf2 r; r.x = a.x * b.x - a.y * b.y; r.y = a.x * b.y + a.y * b.x; return r; }
DEV cf2 twid(int k, float invN) { cf2 r; const float a = (float)k * invN; r.x = __builtin_amdgcn_cosf(a); r.y = -__builtin_amdgcn_sinf(a); return r; }
DEV int fsw(int i) { return i ^ ((i >> 4) & 15) ^ (((i >> 8) & 1) << 4); }
DEV void bfly4_fwd(cf2& a0, cf2& a1, cf2& a2, cf2& a3) {
    cf2 t0, t1, t2, t3; t0.x = a0.x + a2.x; t0.y = a0.y + a2.y; t1.x = a0.x - a2.x; t1.y = a0.y - a2.y; t2.x = a1.x + a3.x; t2.y = a1.y + a3.y;
    const float dx = a1.x - a3.x, dy = a1.y - a3.y; t3.x = dy; t3.y = -dx;
    a0.x = t0.x + t2.x; a0.y = t0.y + t2.y; a1.x = t1.x + t3.x; a1.y = t1.y + t3.y; a2.x = t0.x - t2.x; a2.y = t0.y - t2.y; a3.x = t1.x - t3.x; a3.y = t1.y - t3.y;
}
DEV void bfly4_inv(cf2& c0, cf2& c1, cf2& c2, cf2& c3) {
    cf2 t0, t1, t2, t3; t0.x = c0.x + c2.x; t0.y = c0.y + c2.y; t1.x = c0.x - c2.x; t1.y = c0.y - c2.y; t2.x = c1.x + c3.x; t2.y = c1.y + c3.y;
    const float dx = c1.x - c3.x, dy = c1.y - c3.y; t3.x = -dy; t3.y = dx;
    c0.x = t0.x + t2.x; c0.y = t0.y + t2.y; c1.x = t1.x + t3.x; c1.y = t1.y + t3.y; c2.x = t0.x - t2.x; c2.y = t0.y - t2.y; c3.x = t1.x - t3.x; c3.y = t1.y - t3.y;
}
DEV void fft_stage4(cf2* buf, int S, int s, int g, int G, bool inv) {
    const int N = 1 << (2 * S); const float invN = 1.f / (float)N;
    const int lm = 2 * (S - s), m = 1 << lm, q = m >> 2;
    for (int bf = g; bf < (N >> 2); bf += G) {
        const int j = bf & (q - 1), base = ((bf >> (lm - 2)) << lm) + j, tw = j << (2 * s);
        cf2 a0 = buf[fsw(base)], a1 = buf[fsw(base + q)], a2 = buf[fsw(base + 2 * q)], a3 = buf[fsw(base + 3 * q)];
        if (!inv) { bfly4_fwd(a0, a1, a2, a3); a1 = cmul(a1, twid(tw, invN)); a2 = cmul(a2, twid(2 * tw, invN)); a3 = cmul(a3, twid(3 * tw, invN)); }
        else { cf2 w1 = twid(tw, invN), w2 = twid(2 * tw, invN), w3 = twid(3 * tw, invN); w1.y = -w1.y; w2.y = -w2.y; w3.y = -w3.y; a1 = cmul(a1, w1); a2 = cmul(a2, w2); a3 = cmul(a3, w3); bfly4_inv(a0, a1, a2, a3); }
        buf[fsw(base)] = a0; buf[fsw(base + q)] = a1; buf[fsw(base + 2 * q)] = a2; buf[fsw(base + 3 * q)] = a3;
    }
}
DEV void fft_stage16(cf2* buf, int S, int s, int g, int G, bool inv) {
    const int N = 1 << (2 * S); const float invN = 1.f / (float)N;
    const int lm = 2 * (S - s), m = 1 << lm, q = m >> 2, q2 = q >> 2;
    for (int u = g; u < (N >> 4); u += G) {
        const int j2 = u & (q2 - 1), base = ((u >> (lm - 4)) << lm) + j2;
        cf2 x[4][4];
#pragma unroll
        for (int c = 0; c < 4; ++c)
#pragma unroll
            for (int c2 = 0; c2 < 4; ++c2) x[c][c2] = buf[fsw(base + c * q + c2 * q2)];
        if (!inv) {
#pragma unroll
            for (int c2 = 0; c2 < 4; ++c2) {
                const int tw = (j2 + c2 * q2) << (2 * s);
                bfly4_fwd(x[0][c2], x[1][c2], x[2][c2], x[3][c2]);
                x[1][c2] = cmul(x[1][c2], twid(tw, invN)); x[2][c2] = cmul(x[2][c2], twid(2 * tw, invN)); x[3][c2] = cmul(x[3][c2], twid(3 * tw, invN));
                SCHED_FENCE();
            }
            const int tw2 = j2 << (2 * (s + 1));
            const cf2 v1 = twid(tw2, invN), v2 = twid(2 * tw2, invN), v3 = twid(3 * tw2, invN);
#pragma unroll
            for (int c = 0; c < 4; ++c) {
                bfly4_fwd(x[c][0], x[c][1], x[c][2], x[c][3]);
                x[c][1] = cmul(x[c][1], v1); x[c][2] = cmul(x[c][2], v2); x[c][3] = cmul(x[c][3], v3);
            }
        } else {
            const int tw2 = j2 << (2 * (s + 1));
            cf2 v1 = twid(tw2, invN), v2 = twid(2 * tw2, invN), v3 = twid(3 * tw2, invN); v1.y = -v1.y; v2.y = -v2.y; v3.y = -v3.y;
#pragma unroll
            for (int c = 0; c < 4; ++c) {
                x[c][1] = cmul(x[c][1], v1); x[c][2] = cmul(x[c][2], v2); x[c][3] = cmul(x[c][3], v3);
                bfly4_inv(x[c][0], x[c][1], x[c][2], x[c][3]);
            }
#pragma unroll
            for (int c2 = 0; c2 < 4; ++c2) {
                const int tw = (j2 + c2 * q2) << (2 * s);
                cf2 w1 = twid(tw, invN), w2 = twid(2 * tw, invN), w3 = twid(3 * tw, invN); w1.y = -w1.y; w2.y = -w2.y; w3.y = -w3.y;
                x[1][c2] = cmul(x[1][c2], w1); x[2][c2] = cmul(x[2][c2], w2); x[3][c2] = cmul(x[3][c2], w3);
                bfly4_inv(x[0][c2], x[1][c2], x[2][c2], x[3][c2]);
                SCHED_FENCE();
            }
        }
#pragma unroll
        for (int c = 0; c < 4; ++c)
#pragma unroll
            for (int c2 = 0; c2 < 4; ++c2) buf[fsw(base + c * q + c2 * q2)] = x[c][c2];
    }
}
DEV void fft_fwd(cf2* buf, int S, int g, int G) {
    int s = 0;
    for (; s + 1 < S; s += 2) { fft_stage16(buf, S, s, g, G, false); __syncthreads(); }
    if (s < S) { fft_stage4(buf, S, s, g, G, false); __syncthreads(); }
}
DEV void fft_inv(cf2* buf, int S, int g, int G) {
    int s = S - 1;
    if (S & 1) { fft_stage4(buf, S, s, g, G, true); __syncthreads(); --s; }
    for (; s >= 1; s -= 2) { fft_stage16(buf, S, s - 1, g, G, true); __syncthreads(); }
}
DEV void hf_item(const Params& p, int set, int pi, unsigned char* smem) {
    const int Ls = set ? LC : L, S = set ? FS_CTX : FS_LAT, N = 1 << (2 * S);
    const int gi = tidx() >> 8, g = tidx() & 255, idx = pi * 2 + gi, o = idx >> 9, c = idx & 511;
    cf2* buf = (cf2*)smem + (size_t)gi * N;
    const float* hraw = (const float*)(p.ws + WS_F + (set ? F_HRAW_CTX : F_HRAW_LAT));
    const float* hyn = (const float*)(p.ws + WS_F + (set ? F_HYP_CTX : F_HYP_LAT));
    float nsum = 0.f;
    for (int ch = 0; ch < Ls / 64; ++ch) nsum += hyn[(size_t)ch * 2048 + o * 1024 + c] + hyn[(size_t)ch * 2048 + o * 1024 + 512 + c];
    const float inv = 1.f / nsum;
    const float* hf = hraw + (size_t)(o * 1024 + c) * Ls; const float* hb = hraw + (size_t)(o * 1024 + 512 + c) * Ls;
#pragma unroll 4
    for (int k = g; k < N; k += 256) { float re = 0.f; if (k < Ls) re = hf[k] * inv; else if (k > N - Ls) re = hb[N - k] * inv; cf2 v; v.x = re; v.y = 0.f; buf[fsw(k)] = v; }
    __syncthreads();
    fft_fwd(buf, S, g, 256);
    cf2* HF = (cf2*)(p.ws + WS_F + (set ? F_HF_CTX : F_HF_LAT)) + (size_t)(o * 512 + c) * N;
    for (int k = g; k < N; k += 256) HF[k] = buf[fsw(k)];
    __syncthreads();
}
constexpr int P1_NORM = T / 8, P1_HF = 512;
DEV void phase1(const Params& p, unsigned char* smem) {
    const int total = P1_NORM + 2 * P1_HF;
    for (int it = blockIdx.x; it < total; it += gridDim.x) {
        if (it < P1_NORM) norm_rows_item(p, it, 1, p.in[I_N1G], 0, 0);
        else if (it < P1_NORM + P1_HF) hf_item(p, 0, it - P1_NORM, smem);
        else hf_item(p, 1, it - P1_NORM - P1_HF, smem);
    }
}

constexpr int G_LDA = 72;
template <class Epi>
DEV void gemm_tile(const bf16_t* __restrict__ A, const bf16_t* __restrict__ Wt, int m0, int n0, unsigned char* smem, const Epi& epi, int var = 0) {
    bf16_t* As = (bf16_t*)smem;
    bf16_t* Bs = As + 2 * 256 * G_LDA;
    const int tid = tidx(), lane = tid & 63, w = tid >> 6, wm = w >> 1, wn = w & 1;
    f32x16 acc[2][2];
#pragma unroll
    for (int i = 0; i < 2; ++i)
#pragma unroll
        for (int j = 0; j < 2; ++j)
#pragma unroll
            for (int r = 0; r < 16; ++r) acc[i][j][r] = 0.f;
    u32x4 ra[4], rb[2];
    const bf16_t* Ag = A + (size_t)m0 * 1024; const bf16_t* Bg = Wt + (size_t)n0 * 1024;
#define GLOAD(k0) do { \
        _Pragma("unroll") for (int i = 0; i < 4; ++i) { const int id = tid + NT * i, row = id >> 3, kc = id & 7; ra[i] = *(const u32x4*)(Ag + (size_t)row * 1024 + (k0) + kc * 8); } \
        _Pragma("unroll") for (int i = 0; i < 2; ++i) { const int id = tid + NT * i, row = id >> 3, kc = id & 7; rb[i] = *(const u32x4*)(Bg + (size_t)row * 1024 + (k0) + kc * 8); } } while (0)
#define LSTORE(buf_) do { \
        _Pragma("unroll") for (int i = 0; i < 4; ++i) { const int id = tid + NT * i, row = id >> 3, kc = id & 7; *(u32x4*)(As + ((buf_) * 256 + row) * G_LDA + kc * 8) = ra[i]; } \
        _Pragma("unroll") for (int i = 0; i < 2; ++i) { const int id = tid + NT * i, row = id >> 3, kc = id & 7; *(u32x4*)(Bs + ((buf_) * 128 + row) * G_LDA + kc * 8) = rb[i]; } } while (0)
    GLOAD(0); LSTORE(0); __syncthreads();
    for (int kt = 0; kt < (var == 2 ? 1 : 16); ++kt) {
        const int buf = kt & 1;
        if (kt + 1 < 16) GLOAD((kt + 1) * 64);
        const bf16_t* as = As + (buf * 256 + wm * 64 + (lane & 31)) * G_LDA + 8 * (lane >> 5);
        const bf16_t* bs = Bs + (buf * 128 + wn * 64 + (lane & 31)) * G_LDA + 8 * (lane >> 5);
#pragma unroll
        for (int kk = 0; kk < 4; ++kk) {
            const bf16x8 a0 = *(const bf16x8*)(as + kk * 16), a1 = *(const bf16x8*)(as + 32 * G_LDA + kk * 16);
            const bf16x8 b0 = *(const bf16x8*)(bs + kk * 16), b1 = *(const bf16x8*)(bs + 32 * G_LDA + kk * 16);
            acc[0][0] = __builtin_amdgcn_mfma_f32_32x32x16_bf16(a0, b0, acc[0][0], 0, 0, 0);
            acc[0][1] = __builtin_amdgcn_mfma_f32_32x32x16_bf16(a0, b1, acc[0][1], 0, 0, 0);
            acc[1][0] = __builtin_amdgcn_mfma_f32_32x32x16_bf16(a1, b0, acc[1][0], 0, 0, 0);
            acc[1][1] = __builtin_amdgcn_mfma_f32_32x32x16_bf16(a1, b1, acc[1][1], 0, 0, 0);
        }
        if (kt + 1 < 16) LSTORE(buf ^ 1);
        __syncthreads();
    }
#ifndef HOST_EMU
    if (var == 1) { asm volatile("" :: "v"(acc[0][0]), "v"(acc[0][1]), "v"(acc[1][0]), "v"(acc[1][1])); return; }
#endif
#pragma unroll
    for (int mi = 0; mi < 2; ++mi)
#pragma unroll
        for (int ni = 0; ni < 2; ++ni)
#pragma unroll
            for (int rg = 0; rg < 4; ++rg) {
                const int row = m0 + wm * 64 + mi * 32 + 8 * rg + 4 * (lane >> 5), col = n0 + wn * 64 + ni * 32 + (lane & 31);
                epi(row, col, acc[mi][ni][rg * 4 + 0], acc[mi][ni][rg * 4 + 1], acc[mi][ni][rg * 4 + 2], acc[mi][ni][rg * 4 + 3]);
            }
}
template <class Epi>
DEV void gemm_tile256(const bf16_t* __restrict__ A, const bf16_t* __restrict__ Wt, int m0, int n0, unsigned char* smem, const Epi& epi) {
    bf16_t* As = (bf16_t*)smem;
    bf16_t* Bs = As + 2 * 256 * G_LDA;
    const int tid = tidx(), lane = tid & 63, w = tid >> 6, wm = w >> 2, wn = w & 3;
    f32x16 acc[4][2];
#pragma unroll
    for (int i = 0; i < 4; ++i)
#pragma unroll
        for (int j = 0; j < 2; ++j)
#pragma unroll
            for (int r = 0; r < 16; ++r) acc[i][j][r] = 0.f;
    u32x4 ra[4], rb[4];
    const bf16_t* Ag = A + (size_t)m0 * 1024; const bf16_t* Bg = Wt + (size_t)n0 * 1024;
#define GLOAD2(k0) do { \
        _Pragma("unroll") for (int i = 0; i < 4; ++i) { const int id = tid + NT * i, row = id >> 3, kc = id & 7; ra[i] = *(const u32x4*)(Ag + (size_t)row * 1024 + (k0) + kc * 8); rb[i] = *(const u32x4*)(Bg + (size_t)row * 1024 + (k0) + kc * 8); } } while (0)
#define LSTORE2(buf_) do { \
        _Pragma("unroll") for (int i = 0; i < 4; ++i) { const int id = tid + NT * i, row = id >> 3, kc = id & 7; *(u32x4*)(As + ((buf_) * 256 + row) * G_LDA + kc * 8) = ra[i]; *(u32x4*)(Bs + ((buf_) * 256 + row) * G_LDA + kc * 8) = rb[i]; } } while (0)
    GLOAD2(0); LSTORE2(0); __syncthreads();
    for (int kt = 0; kt < 16; ++kt) {
        const int buf = kt & 1;
        if (kt + 1 < 16) GLOAD2((kt + 1) * 64);
        const bf16_t* as = As + (buf * 256 + wm * 128 + (lane & 31)) * G_LDA + 8 * (lane >> 5);
        const bf16_t* bs = Bs + (buf * 256 + wn * 64 + (lane & 31)) * G_LDA + 8 * (lane >> 5);
#pragma unroll
        for (int kk = 0; kk < 4; ++kk) {
            bf16x8 af[4], bfr[2];
#pragma unroll
            for (int i = 0; i < 4; ++i) af[i] = *(const bf16x8*)(as + i * 32 * G_LDA + kk * 16);
#pragma unroll
            for (int j = 0; j < 2; ++j) bfr[j] = *(const bf16x8*)(bs + j * 32 * G_LDA + kk * 16);
#pragma unroll
            for (int i = 0; i < 4; ++i)
#pragma unroll
                for (int j = 0; j < 2; ++j) acc[i][j] = __builtin_amdgcn_mfma_f32_32x32x16_bf16(af[i], bfr[j], acc[i][j], 0, 0, 0);
        }
        if (kt + 1 < 16) LSTORE2(buf ^ 1);
        __syncthreads();
    }
#undef GLOAD2
#undef LSTORE2
#pragma unroll
    for (int mi = 0; mi < 4; ++mi)
#pragma unroll
        for (int ni = 0; ni < 2; ++ni)
#pragma unroll
            for (int rg = 0; rg < 4; ++rg) {
                const int row = m0 + wm * 128 + mi * 32 + 8 * rg + 4 * (lane >> 5), col = n0 + wn * 64 + ni * 32 + (lane & 31);
                epi(row, col, acc[mi][ni][rg * 4 + 0], acc[mi][ni][rg * 4 + 1], acc[mi][ni][rg * 4 + 2], acc[mi][ni][rg * 4 + 3]);
            }
}
namespace pg8 {
#ifndef HOST_EMU
#define PG8_LAS __attribute__((address_space(3)))
#else
#define PG8_LAS
#endif
typedef unsigned short bf16_t;
constexpr int BM = 256, BK = 64, HALF = 128, HTB = HALF * BK * 2  , STAGE_BYTES = 8 * HTB, NXCD = 8, WGM = 8;

__host__ __device__ __forceinline__ int lds_byte(int r, int c) { const int st = (r >> 4) * 2 + (c >> 5), rr = r & 15, cc = c & 31, ob = rr * 64 + cc * 2; return st * 1024 + (ob ^ (((ob >> 9) & 1) << 5)); }
__host__ __device__ __forceinline__ void stage_rc(int b, int& R, int& C) { const int st = b / 1024, sb = b % 1024, swz = sb ^ (((sb >> 9) & 1) << 5); R = (st >> 1) * 16 + swz / 64; C = (st & 1) * 32 + (swz % 64) / 2; }
__host__ __device__ __forceinline__ int perm32(int rho) { const int n = rho >> 4, i = rho & 15; return 8 * (i >> 2) + 4 * n + (i & 3); }

struct Unit { int pm, pn; };
struct Gemm { const bf16_t* A; const bf16_t* Bt; int M, N, K; };

struct StaticOrder {
    int nM, nN, nwg, G, c;
    __host__ __device__ void init(int M, int N, int G_, int c_) { nM = M / BM; nN = N / BM; nwg = nM * nN; G = G_; c = c_; }
    __host__ __device__ bool next(int i, Unit& u) const {
        const long L = (long)i * G + c; if (L >= nwg) return false;
        int wgid = (int)L; { const int q = nwg / NXCD, r = nwg % NXCD, xcd = wgid % NXCD, off = wgid / NXCD; wgid = (xcd < r ? xcd * (q + 1) : r * (q + 1) + (xcd - r) * q) + off; }
        const int nig = WGM * nN, gid = wgid / nig, fm = gid * WGM, gsz = (nM - fm) < WGM ? (nM - fm) : WGM;
        u.pm = fm + ((wgid % nig) % gsz); u.pn = (wgid % nig) / gsz; return true;
    }
    __device__ __forceinline__ void a_ready(const Unit&) const {}
    __device__ __forceinline__ void done(const Unit&) const {}
};
template <class Epi, class Sched, bool STAMP = false>
__device__ __forceinline__ void gemm_phase(PG8_LAS unsigned char* lds, const Gemm g, const Sched& S, const Epi& E, unsigned long long* stamps = nullptr) {
    const int tid = tidx(), wid = __builtin_amdgcn_readfirstlane(tid >> 6), lane = tid & 63, wr = wid >> 2, wc = wid & 3, fr = lane & 15, fq = lane >> 4;
    const int K = g.K, nt = K / BK;
    int ts_lo = 0, ts_hi = 0, nts = 0; const unsigned long long rt_entry = 0ull; (void)rt_entry; (void)ts_lo; (void)ts_hi; (void)nts;
#define PG8_STAMP() do { if (STAMP && wid == 0 && nts < 64) { const unsigned long long _c = 0ull; \
        ts_lo = (lane == nts) ? (int)(unsigned)_c : ts_lo; ts_hi = (lane == nts) ? (int)(unsigned)(_c >> 32) : ts_hi; ++nts; } } while (0)
    PG8_STAMP();
    unsigned voffA[2], voffB[2];
#pragma unroll
    for (int i = 0; i < 2; ++i) { int R, C; stage_rc(tid * 16 + i * 8192, R, C); const int Rb = Epi::PERM ? ((R & ~31) + perm32(R & 31)) : R;
        voffA[i] = (unsigned)(R * K + C) * 2u; voffB[i] = (unsigned)(Rb * K + C) * 2u; }
    const size_t kstep = (size_t)(BK * 2);
    const size_t hstep = (size_t)HALF * K * 2;
    const size_t tstep = 2 * hstep;
    const unsigned ldsw = (unsigned)wid * 1024u;
    const int aoff = lds_byte(wr * 64 + fr, fq * 8), boff = lds_byte(wc * 32 + fr, fq * 8);
#define PG8_SA(b, h) (((b) * 2 + (h)) * HTB)
#define PG8_SB(b, h) ((4 + (b) * 2 + (h)) * HTB)
#define PG8_STAGE(bufoff, gbase, voff) do { _Pragma("unroll") for (int _i = 0; _i < 2; ++_i) \
        __builtin_amdgcn_global_load_lds((const unsigned*)((const char*)(gbase) + (voff)[_i]), (PG8_LAS unsigned*)(lds + (bufoff) + ldsw + _i * 8192), 16, 0, 0); } while (0)
#define PG8_LDA(dst, b, h) do { _Pragma("unroll") for (int m = 0; m < 4; ++m) _Pragma("unroll") for (int k = 0; k < 2; ++k) dst[m][k] = *(const PG8_LAS bf16x8*)(lds + PG8_SA(b, h) + aoff + m * 2048 + k * 1024); } while (0)
#define PG8_LDB(dst, b, h) do { _Pragma("unroll") for (int n = 0; n < 2; ++n) _Pragma("unroll") for (int k = 0; k < 2; ++k) dst[n][k] = *(const PG8_LAS bf16x8*)(lds + PG8_SB(b, h) + boff + n * 2048 + k * 1024); } while (0)
#define PG8_MMA(ai, bj, At, Bt) do { __builtin_amdgcn_s_setprio(1); _Pragma("unroll") for (int m = 0; m < 4; ++m) _Pragma("unroll") for (int n = 0; n < 2; ++n) _Pragma("unroll") for (int k = 0; k < 2; ++k) \
        acc[ai][bj][m][n] = __builtin_amdgcn_mfma_f32_16x16x32_bf16(Bt[n][k], At[m][k], acc[ai][bj][m][n], 0, 0, 0); __builtin_amdgcn_s_setprio(0); } while (0)
#ifndef HOST_EMU
#define PG8_WAIT_V(n) asm volatile("s_waitcnt vmcnt(" #n ")" ::: "memory")
#define PG8_WAIT_L(n) asm volatile("s_waitcnt lgkmcnt(" #n ")" ::: "memory")
#else
#define PG8_WAIT_V(n) do {} while (0)
#define PG8_WAIT_L(n) do {} while (0)
#endif
#define PG8_BAR __builtin_amdgcn_s_barrier()
#define PG8_SCHED __builtin_amdgcn_sched_barrier(0)
    Unit cur, nxt; int ui = 0;
    if (!S.next(0, cur)) return;
    f32x4 acc[2][2][4][2];
#pragma unroll
    for (int a = 0; a < 2; ++a)
#pragma unroll
        for (int b = 0; b < 2; ++b)
#pragma unroll
            for (int m = 0; m < 4; ++m)
#pragma unroll
                for (int n = 0; n < 2; ++n) acc[a][b][m][n] = (f32x4){0.f, 0.f, 0.f, 0.f};
    bf16x8 At[4][2], B0[2][2], B1[2][2];
    const char* cA = (const char*)g.A + (size_t)cur.pm * tstep; const char* cB = (const char*)g.Bt + (size_t)cur.pn * tstep;
    S.a_ready(cur);
    PG8_STAGE(PG8_SB(0, 0), cB, voffB); PG8_STAGE(PG8_SA(0, 0), cA, voffA); PG8_STAGE(PG8_SB(0, 1), cB + hstep, voffB); PG8_STAGE(PG8_SA(0, 1), cA + hstep, voffA);
    if (wr == 1) PG8_BAR;
    PG8_WAIT_V(4); PG8_BAR;
    PG8_STAGE(PG8_SB(1, 0), cB + kstep, voffB); PG8_STAGE(PG8_SA(1, 0), cA + kstep, voffA); PG8_STAGE(PG8_SB(1, 1), cB + hstep + kstep, voffB);
    PG8_WAIT_V(6); PG8_BAR;
    PG8_STAMP();
    for (;;) {
        const bool has_next = S.next(ui + 1, nxt);
        const char* nA = has_next ? (const char*)g.A + (size_t)nxt.pm * tstep : cA; const char* nB = has_next ? (const char*)g.Bt + (size_t)nxt.pn * tstep : cB;
        for (int t = 0; t < nt; t += 2) {
            const bool last = (t == nt - 2);
            const char* a1 = cA + (size_t)(t + 1) * kstep;
            const char* a2 = last ? nA : cA + (size_t)(t + 2) * kstep; const char* b2 = last ? nB : cB + (size_t)(t + 2) * kstep;
            const char* a3 = a2 + kstep; const char* b3 = b2 + kstep;
            if (last && has_next) S.a_ready(nxt);
            PG8_LDB(B0, 0, 0); PG8_SCHED; PG8_LDA(At, 0, 0); PG8_STAGE(PG8_SA(1, 1), a1 + hstep, voffA);
            PG8_WAIT_L(8); PG8_BAR; PG8_WAIT_L(0); PG8_MMA(0, 0, At, B0); PG8_BAR; PG8_SCHED;
            PG8_LDB(B1, 0, 1); PG8_STAGE(PG8_SB(0, 0), b2, voffB);
            PG8_BAR; PG8_WAIT_L(0); PG8_MMA(0, 1, At, B1); PG8_BAR;
            PG8_LDA(At, 0, 1); PG8_STAGE(PG8_SA(0, 0), a2, voffA);
            PG8_BAR; PG8_WAIT_L(0); PG8_MMA(1, 0, At, B0); PG8_BAR; PG8_SCHED;
            PG8_STAGE(PG8_SB(0, 1), b2 + hstep, voffB);
            PG8_WAIT_V(6); PG8_BAR; PG8_MMA(1, 1, At, B1); PG8_BAR;
            PG8_LDB(B0, 1, 0); PG8_SCHED; PG8_LDA(At, 1, 0); PG8_STAGE(PG8_SA(0, 1), a2 + hstep, voffA);
            PG8_WAIT_L(8); PG8_BAR; PG8_WAIT_L(0); PG8_MMA(0, 0, At, B0); PG8_BAR; PG8_SCHED;
            PG8_LDB(B1, 1, 1); PG8_STAGE(PG8_SB(1, 0), b3, voffB);
            PG8_BAR; PG8_WAIT_L(0); PG8_MMA(0, 1, At, B1); PG8_BAR;
            PG8_LDA(At, 1, 1); PG8_STAGE(PG8_SA(1, 0), a3, voffA);
            PG8_BAR; PG8_WAIT_L(0); PG8_MMA(1, 0, At, B0); PG8_BAR; PG8_SCHED;
            PG8_STAGE(PG8_SB(1, 1), b3 + hstep, voffB);
            PG8_WAIT_V(6); PG8_BAR; PG8_MMA(1, 1, At, B1); PG8_BAR;
        }
        PG8_STAMP();
        if constexpr (!Epi::AFTER_DRAIN) { E(acc, cur, wr, wc, fr, fq); S.done(cur); }
        PG8_STAMP();
        if (!has_next) break;
#pragma unroll
        for (int a = 0; a < 2; ++a)
#pragma unroll
            for (int b = 0; b < 2; ++b)
#pragma unroll
                for (int m = 0; m < 4; ++m)
#pragma unroll
                    for (int n = 0; n < 2; ++n) acc[a][b][m][n] = (f32x4){0.f, 0.f, 0.f, 0.f};
        cur = nxt; cA = nA; cB = nB; ++ui;
    }
    PG8_WAIT_V(0);
    if (wr == 0) PG8_BAR;
    PG8_BAR;
    if constexpr (Epi::AFTER_DRAIN) { E.fused(acc, cur, wr, wc, fr, fq, lds, wid, lane); S.done(cur); }
    PG8_STAMP();
    if (STAMP && wid == 0) { stamps[lane] = lane < nts ? (((unsigned long long)(unsigned)ts_hi << 32) | (unsigned)ts_lo) : 0ull;
        if (lane == 62) stamps[62] = rt_entry; if (lane == 63) stamps[63] = 0ull; }
#undef PG8_STAMP
#undef PG8_SA
#undef PG8_SB
#undef PG8_STAGE
#undef PG8_LDA
#undef PG8_LDB
#undef PG8_MMA
#undef PG8_WAIT_V
#undef PG8_WAIT_L
#undef PG8_BAR
#undef PG8_SCHED
}
}
template <class Epi> struct PgEpiT {
    static constexpr bool PERM = true, AFTER_DRAIN = false;
    Epi e;
    DEV void operator()(const f32x4 (&acc)[2][2][4][2], const pg8::Unit& u, int wr, int wc, int fr, int fq) const {
        float pre[2][4];
#pragma unroll
        for (int ai = 0; ai < 2; ++ai)
#pragma unroll
            for (int m = 0; m < 4; ++m) pre[ai][m] = e.colpre(u.pm * 256 + ai * 128 + wr * 64 + m * 16 + fr);
#pragma unroll
        for (int ai = 0; ai < 2; ++ai)
#pragma unroll
            for (int m = 0; m < 4; ++m) {
#pragma unroll
                for (int bj = 0; bj < 2; ++bj) {
                    const int wcol = u.pm * 256 + ai * 128 + wr * 64 + m * 16 + fr, tok0 = u.pn * 256 + bj * 128 + wc * 32 + 8 * fq;
                    const float v[8] = {acc[ai][bj][m][0][0], acc[ai][bj][m][0][1], acc[ai][bj][m][0][2], acc[ai][bj][m][0][3], acc[ai][bj][m][1][0], acc[ai][bj][m][1][1], acc[ai][bj][m][1][2], acc[ai][bj][m][1][3]};
                    e.tok8(tok0, wcol, v, pre[ai][m]);
                }
                SCHED_FENCE();
            }
    }
};
template <class Epi> struct PgEpiN {
    static constexpr bool PERM = true, AFTER_DRAIN = false;
    Epi e;
    DEV void operator()(const f32x4 (&acc)[2][2][4][2], const pg8::Unit& u, int wr, int wc, int fr, int fq) const {
#pragma unroll
        for (int ai = 0; ai < 2; ++ai)
#pragma unroll
            for (int m = 0; m < 4; ++m) {
#pragma unroll
                for (int bj = 0; bj < 2; ++bj) {
                    const int tok = u.pm * 256 + ai * 128 + wr * 64 + m * 16 + fr, wcol0 = u.pn * 256 + bj * 128 + wc * 32 + 8 * fq;
                    const float v[8] = {acc[ai][bj][m][0][0], acc[ai][bj][m][0][1], acc[ai][bj][m][0][2], acc[ai][bj][m][0][3], acc[ai][bj][m][1][0], acc[ai][bj][m][1][1], acc[ai][bj][m][1][2], acc[ai][bj][m][1][3]};
                    e.col8(tok, wcol0, v);
                }
                SCHED_FENCE();
            }
    }
};
template <class Epi>
DEV void gemm_pg8_T(const bf16_t* A, const bf16_t* Wt, int Mtok, int N, unsigned char* smem, const Epi& epi) {
    pg8::Gemm g{Wt, A, N, Mtok, 1024};
    pg8::StaticOrder S; S.init(N, Mtok, (int)gridDim.x, (int)blockIdx.x);
    PgEpiT<Epi> E{epi};
    pg8::gemm_phase<PgEpiT<Epi>, pg8::StaticOrder, false>((PG8_LAS unsigned char*)smem, g, S, E);
    __syncthreads();
}
template <class Epi>
DEV void gemm_pg8_N(const bf16_t* A, const bf16_t* Wt, int Mtok, int N, unsigned char* smem, const Epi& epi) {
    pg8::Gemm g{A, Wt, Mtok, N, 1024};
    pg8::StaticOrder S; S.init(Mtok, N, (int)gridDim.x, (int)blockIdx.x);
    PgEpiN<Epi> E{epi};
    pg8::gemm_phase<PgEpiN<Epi>, pg8::StaticOrder, false>((PG8_LAS unsigned char*)smem, g, S, E);
    __syncthreads();
}
struct EpiL0In {
    unsigned char* ws;
    DEV void operator()(int row, int col, float v0, float v1, float v2, float v3) const {
        u32x2 o; o[0] = pk2(v0, v1); o[1] = pk2(v2, v3);
        const bool lat = row < TL; const int b = lat ? row / L : (row - TL) / LC, t = lat ? row - b * L : (row - TL) - b * LC, Lx = lat ? L : LC;
        const int cu = __builtin_amdgcn_readfirstlane(col & ~127);
        if (cu < 1536) { bf16_t* d = (bf16_t*)(ws + WS_P + (lat ? P_HYT_LAT : P_HYT_CTX)) + ((size_t)b * 1536 + col) * Lx + t; *(u32x2*)d = o; }
        else if (cu < 2048) { bf16_t* d = (bf16_t*)(ws + WS_P + P_Q0) + (size_t)row * 512 + (col - 1536); d[0] = (bf16_t)f2bf(v0); d[512] = (bf16_t)f2bf(v1); d[1024] = (bf16_t)f2bf(v2); d[1536] = (bf16_t)f2bf(v3); }
        else if (cu < 2176) { bf16_t* d = (bf16_t*)(ws + WS_P + P_K0) + (size_t)row * 128 + (col - 2048); d[0] = (bf16_t)f2bf(v0); d[128] = (bf16_t)f2bf(v1); d[256] = (bf16_t)f2bf(v2); d[384] = (bf16_t)f2bf(v3); }
        else { bf16_t* d = (bf16_t*)(ws + WS_P + (lat ? P_VT_LAT : P_VT_CTX)) + ((size_t)b * 128 + (col - 2176)) * Lx + t; *(u32x2*)d = o; }
    }
};
struct EpiL0InT {
    unsigned char* ws;
    DEV float colpre(int) const { return 0.f; }
    DEV void tok8(int row, int col, const float (&v)[8], float) const {
        const bool lat = row < TL; const int b = lat ? row / L : (row - TL) / LC, t = lat ? row - b * L : (row - TL) - b * LC, Lx = lat ? L : LC;
        u32x4 o; o[0] = pk2(v[0], v[1]); o[1] = pk2(v[2], v[3]); o[2] = pk2(v[4], v[5]); o[3] = pk2(v[6], v[7]);
        if (col < 1536) { *(u32x4*)((bf16_t*)(ws + WS_P + (lat ? P_HYT_LAT : P_HYT_CTX)) + ((size_t)b * 1536 + col) * Lx + t) = o; }
        else if (col < 2048) { bf16_t* d = (bf16_t*)(ws + WS_P + P_Q0) + (size_t)row * 512 + (col - 1536);
#pragma unroll
            for (int i = 0; i < 8; ++i) d[i * 512] = (bf16_t)f2bf(v[i]); }
        else if (col < 2176) { bf16_t* d = (bf16_t*)(ws + WS_P + P_K0) + (size_t)row * 128 + (col - 2048);
#pragma unroll
            for (int i = 0; i < 8; ++i) d[i * 128] = (bf16_t)f2bf(v[i]); }
        else { *(u32x4*)((bf16_t*)(ws + WS_P + (lat ? P_VT_LAT : P_VT_CTX)) + ((size_t)b * 128 + (col - 2176)) * Lx + t) = o; }
    }
};
struct EpiBf16 {
    bf16_t* out; int ld;
    DEV void col8(int row, int col0, const float (&v)[8]) const { u32x4 o; o[0] = pk2(v[0], v[1]); o[1] = pk2(v[2], v[3]); o[2] = pk2(v[4], v[5]); o[3] = pk2(v[6], v[7]); *(u32x4*)(out + (size_t)row * ld + col0) = o; }
    DEV void operator()(int row, int col, float v0, float v1, float v2, float v3) const {
        bf16_t* d = out + (size_t)row * ld + col; d[0] = (bf16_t)f2bf(v0); d[ld] = (bf16_t)f2bf(v1); d[2 * ld] = (bf16_t)f2bf(v2); d[3 * ld] = (bf16_t)f2bf(v3);
    }
};
struct EpiHg {
    unsigned char* ws; const float* lg;
    DEV void operator()(int row, int col, float v0, float v1, float v2, float v3) const {
        float vv[4] = {v0, v1, v2, v3};
        const bool lat = row < TL; const int b = lat ? row / L : (row - TL) / LC, t = lat ? row - b * L : (row - TL) - b * LC, Lx = lat ? L : LC;
        const int cu = __builtin_amdgcn_readfirstlane(col & ~255);
        if (cu >= 3072 && cu < 4096) {
            bf16_t* d = (bf16_t*)(ws + WS_M) + (lat ? (size_t)0 : (size_t)NB * 1024 * L) + ((size_t)b * 1024 + (col - 3072)) * Lx + t;
            u32x2 o; o[0] = pk2(v0, v1); o[1] = pk2(v2, v3); *(u32x2*)d = o;
            return;
        }
        if (cu < 1024 || cu >= 4096) {
#pragma unroll
            for (int i = 0; i < 4; ++i) vv[i] = silu_f(vv[i]);
        } else {
            const int c = col - 1024;
            const float oml = 1.f - 1.f / (1.f + __expf(lg[c] - lg[2048 + c]));
#pragma unroll
            for (int i = 0; i < 4; ++i) vv[i] = oml * __builtin_amdgcn_rcpf(1.f + __expf(vv[i]));
        }
        if (cu < 3072) {
            bf16_t* d = (bf16_t*)(ws + WS_P + (lat ? P1_KQT_LAT : P1_KQT_CTX)) + ((size_t)b * 3072 + col) * Lx + t;
            u32x2 o; o[0] = pk2(vv[0], vv[1]); o[1] = pk2(vv[2], vv[3]); *(u32x2*)d = o;
        } else {
            if (!lat) return;
            bf16_t* d = (bf16_t*)(ws + WS_P + P1_G) + (size_t)row * 1024 + (col - 4096); d[0] = (bf16_t)f2bf(vv[0]); d[1024] = (bf16_t)f2bf(vv[1]); d[2048] = (bf16_t)f2bf(vv[2]); d[3072] = (bf16_t)f2bf(vv[3]);
        }
    }
};
struct EpiHgT {
    unsigned char* ws; const float* lg; int plain;
    DEV float colpre(int col) const {
        const int cu = __builtin_amdgcn_readfirstlane(col & ~255);
        if (cu < 1024 || cu >= 3072) return 0.f;
        const int c = col - 1024; return 1.f - __builtin_amdgcn_rcpf(1.f + __expf(lg[c] - lg[2048 + c]));
    }
    DEV void tok8(int row, int col, const float (&v)[8], float oml) const {
        const bool lat = row < TL; const int b = lat ? row / L : (row - TL) / LC, t = lat ? row - b * L : (row - TL) - b * LC, Lx = lat ? L : LC;
        const int cu = __builtin_amdgcn_readfirstlane(col & ~255);
        float vv[8];
#pragma unroll
        for (int i = 0; i < 8; ++i) vv[i] = v[i];
        if (cu >= 3072 && cu < 4096) {
            u32x4 o; o[0] = pk2(vv[0], vv[1]); o[1] = pk2(vv[2], vv[3]); o[2] = pk2(vv[4], vv[5]); o[3] = pk2(vv[6], vv[7]);
            *(u32x4*)((bf16_t*)(ws + WS_M) + (lat ? (size_t)0 : (size_t)NB * 1024 * L) + ((size_t)b * 1024 + (col - 3072)) * Lx + t) = o;
            return;
        }
        if (plain) {} else if (cu < 1024 || cu >= 4096) {
#pragma unroll
            for (int i = 0; i < 8; ++i) vv[i] = silu_f(vv[i]);
        } else {
#pragma unroll
            for (int i = 0; i < 8; ++i) vv[i] = oml * __builtin_amdgcn_rcpf(1.f + __expf(vv[i]));
        }
        if (cu < 3072) {
            u32x4 o; o[0] = pk2(vv[0], vv[1]); o[1] = pk2(vv[2], vv[3]); o[2] = pk2(vv[4], vv[5]); o[3] = pk2(vv[6], vv[7]);
            *(u32x4*)((bf16_t*)(ws + WS_P + (lat ? P1_KQT_LAT : P1_KQT_CTX)) + ((size_t)b * 3072 + col) * Lx + t) = o;
        } else {
            if (!lat) return;
            bf16_t* d = (bf16_t*)(ws + WS_P + P1_G) + (size_t)row * 1024 + (col - 4096);
#pragma unroll
            for (int i = 0; i < 8; ++i) d[i * 1024] = (bf16_t)f2bf(vv[i]);
        }
    }
};
struct EpiRes {
    const Params* p; int from_inputs, layer, goff;
    DEV void col8(int row, int col0, const float (&v)[8]) const {
        float* H = (float*)(p->ws + WS_H) + (size_t)row * 1024 + col0; const float* hin = h_row(*p, from_inputs, row) + col0;
        const float* gt = (const float*)(p->ws + WS_MOD) + ((size_t)layer * NR + mod_row(row)) * 6144 + goff + col0;
        const f32x4 h0 = *(const f32x4*)hin, h1 = *(const f32x4*)(hin + 4), g0 = *(const f32x4*)gt, g1 = *(const f32x4*)(gt + 4);
        f32x4 o0, o1;
#pragma unroll
        for (int i = 0; i < 4; ++i) { o0[i] = h0[i] + g0[i] * v[i]; o1[i] = h1[i] + g1[i] * v[4 + i]; }
        *(f32x4*)H = o0; *(f32x4*)(H + 4) = o1;
    }
    DEV void operator()(int row, int col, float v0, float v1, float v2, float v3) const {
        float* H = (float*)(p->ws + WS_H) + (size_t)row * 1024 + col;
        const float* hin = h_row(*p, from_inputs, row) + col;
        const float gt = ((const float*)(p->ws + WS_MOD))[((size_t)layer * NR + mod_row(row)) * 6144 + goff + col];
        const float h0 = hin[0], h1 = hin[1024], h2 = hin[2048], h3 = hin[3072];
        H[0] = h0 + gt * v0; H[1024] = h1 + gt * v1; H[2048] = h2 + gt * v2; H[3072] = h3 + gt * v3;
    }
};

struct HyRaw { u32x4 mid; unsigned short lft, rgt; };
DEV HyRaw hy_load(const bf16_t* row, int t0, int Lx) { HyRaw r; r.mid = *(const u32x4*)(row + t0); r.lft = t0 > 0 ? row[t0 - 1] : (unsigned short)0; r.rgt = t0 + 8 < Lx ? row[t0 + 8] : (unsigned short)0; return r; }
DEV void hy_conv8(const HyRaw& r, float w0, float w1, float w2, float b, float (&o)[8]) {
    float x[10]; x[0] = bf2f(r.lft); x[9] = bf2f(r.rgt);
#pragma unroll
    for (int i = 0; i < 4; ++i) { x[1 + 2 * i] = bflo(r.mid[i]); x[2 + 2 * i] = bfhi(r.mid[i]); }
#pragma unroll
    for (int i = 0; i < 8; ++i) o[i] = w0 * x[i] + w1 * x[i + 1] + w2 * x[i + 2] + b;
}
template <int TPC>
DEV void hyena_item(const Params& p, int set, int item, unsigned char* smem, bool nofft = false, bool nostore = false) {
    const int Ls = set ? LC : L, S = set ? FS_CTX : FS_LAT, N = 1 << (2 * S);
    constexpr int CPR = NT / TPC, NR8 = 8 / CPR;
    const int gi = tidx() / TPC, g = tidx() % TPC;
    const int bp = item >> 6, c0 = (item & 63) * 8, ba = bp * 2, bb = ba + 1;
    cf2* buf = (cf2*)smem + (size_t)gi * N;
    bf16_t* stg = (bf16_t*)(smem + (size_t)CPR * N * 8);
    const bf16_t* hy = (const bf16_t*)(p.ws + WS_P + (set ? P_HYT_CTX : P_HYT_LAT));
    const float* cw = p.in[I_HYCW]; const float* cb = p.in[I_HYCB];
    const cf2* HF = (const cf2*)(p.ws + WS_F + (set ? F_HF_CTX : F_HF_LAT));
    const float invN = 1.f / (float)N;
    const int t0 = g * 8; const bool own = t0 < Ls;
    HyRaw rv[2], rx1[2];
    cf2 hfr[16];
#define HY_FETCH(cc) do { if (own) { \
        rv[0] = hy_load(hy + ((size_t)ba * 1536 + (cc)) * Ls, t0, Ls); rv[1] = hy_load(hy + ((size_t)bb * 1536 + (cc)) * Ls, t0, Ls); \
        rx1[0] = hy_load(hy + ((size_t)ba * 1536 + 512 + (cc)) * Ls, t0, Ls); rx1[1] = hy_load(hy + ((size_t)bb * 1536 + 512 + (cc)) * Ls, t0, Ls); } } while (0)
    HY_FETCH(c0 + gi);
#pragma unroll 1
    for (int rd = 0; rd < NR8; ++rd) {
        const int cs = rd * CPR + gi, c = c0 + cs;
#pragma unroll
        for (int u = 0; u < 16; ++u) { hfr[u].x = 0.f; hfr[u].y = 0.f; if (g + TPC * u < N) hfr[u] = HF[(size_t)c * N + g + TPC * u]; }
        float za[8], zb[8];
        if (own) { hy_conv8(rv[0], cw[c], cw[1536 + c], cw[3072 + c], cb[c], za); hy_conv8(rv[1], cw[c], cw[1536 + c], cw[3072 + c], cb[c], zb); }
        for (int t = g; t < N; t += TPC) { if (t >= Ls) { cf2 z; z.x = 0.f; z.y = 0.f; buf[fsw(t)] = z; } }
        if (own) {
#pragma unroll
            for (int i = 0; i < 8; ++i) { cf2 v; v.x = za[i]; v.y = zb[i]; buf[fsw(t0 + i)] = v; }
        }
        __syncthreads();
#pragma unroll
        for (int n = 0; n < 2; ++n) {
            if (!nofft) fft_fwd(buf, S, g, TPC);
#pragma unroll
            for (int u = 0; u < 16; ++u) { const int k = g + TPC * u; if (k < N) buf[fsw(k)] = cmul(buf[fsw(k)], hfr[u]); }
            if (n == 0) {
#pragma unroll
                for (int u = 0; u < 16; ++u) if (g + TPC * u < N) hfr[u] = HF[(size_t)(512 + c) * N + g + TPC * u];
            }
            __syncthreads();
            if (!nofft) fft_inv(buf, S, g, TPC);
            const int gc = (n + 1) * 512 + c;
            if (own) {
                const float w0 = cw[gc], w1 = cw[1536 + gc], w2 = cw[3072 + gc], b = cb[gc], dsk = p.in[I_HYSKIP][n * 512 + c];
                float ga[8], gb[8];
                hy_conv8(rx1[0], w0, w1, w2, b, ga); hy_conv8(rx1[1], w0, w1, w2, b, gb);
                if (n == 0) { rx1[0] = hy_load(hy + ((size_t)ba * 1536 + 1024 + c) * Ls, t0, Ls); rx1[1] = hy_load(hy + ((size_t)bb * 1536 + 1024 + c) * Ls, t0, Ls); }
#pragma unroll
                for (int i = 0; i < 8; ++i) { const cf2 cv = buf[fsw(t0 + i)]; za[i] = ga[i] * (cv.x * invN + dsk * za[i]); zb[i] = gb[i] * (cv.y * invN + dsk * zb[i]); }
            }
            if (n == 0) {
                __syncthreads();
                for (int t = g; t < N; t += TPC) { if (t >= Ls) { cf2 z; z.x = 0.f; z.y = 0.f; buf[fsw(t)] = z; } }
                if (own) {
#pragma unroll
                    for (int i = 0; i < 8; ++i) { cf2 v; v.x = za[i]; v.y = zb[i]; buf[fsw(t0 + i)] = v; }
                }
                __syncthreads();
            } else {
                if (rd + 1 < NR8) HY_FETCH(c0 + (rd + 1) * CPR + gi);
                if (own) {
#pragma unroll
                    for (int i = 0; i < 8; ++i) {
                        const int ra = t0 + i, rb = Ls + t0 + i;
                        stg[(size_t)(ra + (ra >> 3)) * 8 + cs] = (bf16_t)f2bf(za[i]); stg[(size_t)(rb + (rb >> 3)) * 8 + cs] = (bf16_t)f2bf(zb[i]); }
                }
            }
        }
        __syncthreads();
    }
#undef HY_FETCH
    if (!nostore) {
        bf16_t* M = (bf16_t*)(p.ws + WS_M);
        for (int i = tidx(); i < 2 * Ls; i += NT) {
            const int bsel = i >= Ls, t = bsel ? i - Ls : i, bx = bsel ? bb : ba;
            const size_t tok = set ? (size_t)TL + (size_t)bx * LC + t : (size_t)bx * L + t;
            *(u32x4*)(M + tok * 1024 + c0) = *(const u32x4*)(stg + (size_t)(i + (i >> 3)) * 8);
        }
    }
    __syncthreads();
}
DEV void rope_store(const bf16_t* src, bf16_t* dst, int pos, bool rope, float scale, int ph, int sub) {
    const u32x4 ua = *(const u32x4*)(src + ph * 32 + sub * 8), ub = *(const u32x4*)(src + ph * 32 + 16 + sub * 8);
    float a[8], b[8];
#pragma unroll
    for (int i = 0; i < 4; ++i) { a[2 * i] = bflo(ua[i]); a[2 * i + 1] = bfhi(ua[i]); b[2 * i] = bflo(ub[i]); b[2 * i + 1] = bfhi(ub[i]); }
    if (rope) {
        const float pv = (float)(ph == 0 ? pos / 64 : pos % 64);
#pragma unroll
        for (int e = 0; e < 8; ++e) {
            const float inv = exp2f(-(float)(sub * 8 + e) * (13.287712379549449f / 16.f));
            const float ang = pv * inv, cs = __cosf(ang), sn = __sinf(ang);
            const float na = a[e] * cs - b[e] * sn, nb = b[e] * cs + a[e] * sn; a[e] = na; b[e] = nb;
        }
    }
    u32x4 oa, ob;
#pragma unroll
    for (int i = 0; i < 4; ++i) { oa[i] = pk2(a[2 * i] * scale, a[2 * i + 1] * scale); ob[i] = pk2(b[2 * i] * scale, b[2 * i + 1] * scale); }
    *(u32x4*)(dst + ph * 32 + sub * 8) = oa; *(u32x4*)(dst + ph * 32 + 16 + sub * 8) = ob;
}
constexpr int A_LDQ = 72, A_LDV = 136;
DEV void attn_item(const Params& p, int set, int item, unsigned char* smem) {
    bf16_t* Qs = (bf16_t*)smem;
    bf16_t* Ks = Qs + 128 * A_LDQ;
    bf16_t* Vt = Ks + 128 * A_LDQ;
    const int tid = tidx(), lane = tid & 63, w = tid >> 6, l15 = lane & 15, lg = lane >> 4;
    const int nqb = set ? LC / 128 : L / 128;
    const int h = item & 7, qb = (item >> 3) % nqb, b = (item >> 3) / nqb, kvh = h >> 2;
    const bf16_t* Q0 = (const bf16_t*)(p.ws + WS_P + P_Q0); const bf16_t* K0 = (const bf16_t*)(p.ws + WS_P + P_K0);
    const int qtok0 = set ? TL + b * LC + qb * 128 : b * L + qb * 128;
    { const int row = tid >> 2, ph = (tid >> 1) & 1, sub = tid & 1;
      rope_store(Q0 + (size_t)(qtok0 + row) * 512 + h * 64, Qs + row * A_LDQ, qb * 128 + row, set == 0, 0.125f, ph, sub); }
    __syncthreads();
    bf16x8 qf[2];
    qf[0] = *(const bf16x8*)(Qs + (w * 16 + l15) * A_LDQ + 8 * lg); qf[1] = *(const bf16x8*)(Qs + (w * 16 + l15) * A_LDQ + 32 + 8 * lg);
    float m_run = p.in[I_SINK][h], l_run = 1.f;
    f32x4 O[4];
#pragma unroll
    for (int i = 0; i < 4; ++i) O[i] = (f32x4){0.f, 0.f, 0.f, 0.f};
    const int nwin = set ? 0 : 3, nctx = LC / 128;
    for (int kbi = 0; kbi < nwin + nctx; ++kbi) {
        const bool win = kbi < nwin; const int kb = win ? qb - 1 + kbi : kbi - nwin;
        if (win && (kb < 0 || kb >= L / 128)) continue;
        const int ktok0 = win ? b * L + kb * 128 : TL + b * LC + kb * 128;
        __syncthreads();
        { const int row = tid >> 2, ph = (tid >> 1) & 1, sub = tid & 1;
          rope_store(K0 + (size_t)(ktok0 + row) * 128 + kvh * 64, Ks + row * A_LDQ, kb * 128 + row, win, 1.f, ph, sub); }
        { const bf16_t* vt = (const bf16_t*)(p.ws + WS_P + (win ? P_VT_LAT : P_VT_CTX)); const int Lx = win ? L : LC;
#pragma unroll
          for (int i = 0; i < 2; ++i) { const int id = tid + NT * i, d = id >> 4, kc = id & 15;
              *(u32x4*)(Vt + d * A_LDV + kc * 8) = *(const u32x4*)(vt + ((size_t)b * 128 + kvh * 64 + d) * Lx + kb * 128 + kc * 8); } }
        __syncthreads();
#pragma unroll
        for (int ch = 0; ch < 2; ++ch) {
            f32x4 st[4];
#pragma unroll
            for (int u = 0; u < 4; ++u) {
                const bf16_t* kr = Ks + ((ch * 4 + u) * 16 + l15) * A_LDQ + 8 * lg;
                f32x4 z = (f32x4){0.f, 0.f, 0.f, 0.f};
                z = __builtin_amdgcn_mfma_f32_16x16x32_bf16(*(const bf16x8*)kr, qf[0], z, 0, 0, 0);
                z = __builtin_amdgcn_mfma_f32_16x16x32_bf16(*(const bf16x8*)(kr + 32), qf[1], z, 0, 0, 0);
                st[u] = z;
            }
            float cmax = -INFINITY;
            if (win) {
                const int qpos = qb * 128 + w * 16 + l15;
#pragma unroll
                for (int u = 0; u < 4; ++u)
#pragma unroll
                    for (int r = 0; r < 4; ++r) { const int kpos = kb * 128 + (ch * 4 + u) * 16 + 4 * lg + r; const int dd = qpos - kpos; if (dd > 128 || dd < -128) st[u][r] = -INFINITY; }
            }
#pragma unroll
            for (int u = 0; u < 4; ++u)
#pragma unroll
                for (int r = 0; r < 4; ++r) cmax = fmaxf(cmax, st[u][r]);
            cmax = fmaxf(cmax, __shfl_xor(cmax, 16)); cmax = fmaxf(cmax, __shfl_xor(cmax, 32));
            const float m_new = fmaxf(m_run, cmax), alpha = __expf(m_run - m_new);
            float ls = 0.f;
#pragma unroll
            for (int u = 0; u < 4; ++u)
#pragma unroll
                for (int r = 0; r < 4; ++r) { const float e = __expf(st[u][r] - m_new); st[u][r] = e; ls += e; }
            ls += __shfl_xor(ls, 16); ls += __shfl_xor(ls, 32);
            l_run = l_run * alpha + ls; m_run = m_new;
#pragma unroll
            for (int i = 0; i < 4; ++i) { O[i][0] *= alpha; O[i][1] *= alpha; O[i][2] *= alpha; O[i][3] *= alpha; }
#pragma unroll
            for (int ss = 0; ss < 2; ++ss) {
                u32x4 pu; pu[0] = pk2(st[2 * ss][0], st[2 * ss][1]); pu[1] = pk2(st[2 * ss][2], st[2 * ss][3]); pu[2] = pk2(st[2 * ss + 1][0], st[2 * ss + 1][1]); pu[3] = pk2(st[2 * ss + 1][2], st[2 * ss + 1][3]);
                const bf16x8 pf = __builtin_bit_cast(bf16x8, pu);
                const int key0 = (ch * 4 + 2 * ss) * 16 + 4 * lg;
#pragma unroll
                for (int dt = 0; dt < 4; ++dt) {
                    const bf16_t* vr = Vt + (dt * 16 + l15) * A_LDV + key0;
                    u32x4 vu; const u32x2 v0 = *(const u32x2*)vr, v1 = *(const u32x2*)(vr + 16); vu[0] = v0[0]; vu[1] = v0[1]; vu[2] = v1[0]; vu[3] = v1[1];
                    O[dt] = __builtin_amdgcn_mfma_f32_16x16x32_bf16(__builtin_bit_cast(bf16x8, vu), pf, O[dt], 0, 0, 0);
                }
            }
        }
    }
    const float il = 1.f / l_run;
    bf16_t* M = (bf16_t*)(p.ws + WS_M) + (size_t)(qtok0 + w * 16 + l15) * 1024 + 512 + h * 64;
#pragma unroll
    for (int dt = 0; dt < 4; ++dt) { u32x2 o; o[0] = pk2(O[dt][0] * il, O[dt][1] * il); o[1] = pk2(O[dt][2] * il, O[dt][3] * il); *(u32x2*)(M + dt * 16 + 4 * lg) = o; }
    __syncthreads();
}
static_assert(NF_LAT / 256 <= 16 && NF_CTX / 64 <= 16 && L / 8 <= 256 && LC / 8 <= 64 && 2 * NF_LAT * 8 + 2 * L * 18 <= SMEM_BYTES && 8 * NF_CTX * 8 + 2 * LC * 18 <= SMEM_BYTES, "hyena item geometry");
constexpr int P3_HY_LAT = (NB / 2) * 64, P3_HY_CTX = (NB / 2) * 64, P3_AT_LAT = NB * (L / 128) * 8, P3_AT_CTX = NB * (LC / 128) * 8;
DEV void phase3(const Params& p, unsigned char* smem, int var = 0) {
    const int total = P3_HY_LAT + P3_AT_LAT + P3_HY_CTX + P3_AT_CTX;
    for (int it = blockIdx.x; it < total; it += gridDim.x) {
        int i = it;
        if ((var == 1 || var == 3 || var == 4) && !(i < P3_HY_LAT || (i >= P3_HY_LAT + P3_AT_LAT && i < P3_HY_LAT + P3_AT_LAT + P3_HY_CTX))) continue;
        if (var == 2 && (i < P3_HY_LAT || (i >= P3_HY_LAT + P3_AT_LAT && i < P3_HY_LAT + P3_AT_LAT + P3_HY_CTX))) continue;
        if (i < P3_HY_LAT) { hyena_item<256>(p, 0, i, smem, var == 3, var == 4); continue; } i -= P3_HY_LAT;
        if (i < P3_AT_LAT) { attn_item(p, 0, i, smem); continue; } i -= P3_AT_LAT;
        if (i < P3_HY_CTX) { hyena_item<64>(p, 1, i, smem, var == 3, var == 4); continue; } i -= P3_HY_CTX;
        attn_item(p, 1, i, smem);
    }
}

constexpr int K_LDK = 136, K_LDS = 129, K_LDC = 52;
DEV unsigned fkey(float f) { const unsigned u = __builtin_bit_cast(unsigned, f); return (u & 0x80000000u) ? ~u : (u | 0x80000000u); }
constexpr int cand_off(int i) { int o = 0; for (int k = 0; k < i; ++k) o += 16 / (k + 1); return o; }
DEV void topk_load_keys(const Params& p, int layer, int h, unsigned char* smem) {
    bf16_t* Ks = (bf16_t*)smem;
    const bf16_t* keys = (const bf16_t*)(p.ws + WS_W + W_KEYS) + (size_t)layer * 262144 + (size_t)h * 32768;
    const int tid = tidx();
#pragma unroll
    for (int i = 0; i < 8; ++i) { const int id = tid + NT * i, row = id >> 4, kc = id & 15; *(u32x4*)(Ks + row * K_LDK + kc * 8) = *(const u32x4*)(keys + (size_t)row * 128 + kc * 8); }
    __syncthreads();
}
#ifndef HOST_EMU
template <int CTRL> DEV unsigned dpp_u32(unsigned v) { return (unsigned)__builtin_amdgcn_update_dpp(0, (int)v, CTRL, 0xF, 0xF, true); }
#else
template <int CTRL> DEV unsigned dpp_u32(unsigned v) { const int lane = tidx() & 63; const int src = CTRL == 0xB1 ? (lane ^ 1) : CTRL == 0x4E ? (lane ^ 2) : ((lane & ~7) | (7 - (lane & 7))); return emu_shfl(v, src); }
#endif
DEV unsigned max8_u32(unsigned v) { unsigned t = dpp_u32<0xB1>(v); v = v > t ? v : t; t = dpp_u32<0x4E>(v); v = v > t ? v : t; t = dpp_u32<0x141>(v); return v > t ? v : t; }
DEV float sum8_f32(float v) { v += __builtin_bit_cast(float, dpp_u32<0xB1>(__builtin_bit_cast(unsigned, v))); v += __builtin_bit_cast(float, dpp_u32<0x4E>(__builtin_bit_cast(unsigned, v))); v += __builtin_bit_cast(float, dpp_u32<0x141>(__builtin_bit_cast(unsigned, v))); return v; }
DEV float unkey(unsigned k) { const unsigned u = (k & 0x80000000u) ? (k & 0x7fffffffu) : ~k; return __builtin_bit_cast(float, u); }
template <int N> DEV void bitonic_desc(unsigned (&a)[N]) {
#pragma unroll
    for (int k = 2; k <= N; k <<= 1)
#pragma unroll
        for (int j = k >> 1; j > 0; j >>= 1)
#pragma unroll
            for (int i = 0; i < N; ++i) { const int l = i ^ j; if (l > i) { const unsigned x = a[i], y = a[l]; const unsigned hi = x > y ? x : y, lo = x > y ? y : x; if ((i & k) == 0) { a[i] = hi; a[l] = lo; } else { a[i] = lo; a[l] = hi; } } }
}
DEV void merge16(const unsigned* lst, int nlist, unsigned first, int sub, unsigned& r0, unsigned& r1) {
    unsigned cur = first; int head = 0; r0 = 0u; r1 = 0u;
#pragma unroll
    for (int it = 0; it < 16; ++it) {
        const unsigned m = max8_u32(cur);
        if (sub == (it & 7)) { if (it < 8) r0 = m; else r1 = m; }
        if (cur == m) { ++head; cur = head < nlist ? lst[head] : 0u; }
    }
}
DEV void topk_item(const Params& p, int h, int tok0, unsigned char* smem, const bf16x8 (&afr)[16]) {
    bf16_t* Ks = (bf16_t*)smem;
    float* Sc = (float*)(Ks + 2 * 128 * K_LDK);
    unsigned* s12 = (unsigned*)Sc + 64 * 8 * 17;
    unsigned* cl = s12 + 64 * 32;
    const int tid = tidx(), lane = tid & 63, w = tid >> 6;
    const int row = tid >> 3, sub = tid & 7;
#pragma unroll
    for (int part = 0; part < 2; ++part) {
        { const int mi = w >> 2, ni = w & 3;
          f32x16 acc;
#pragma unroll
          for (int r = 0; r < 16; ++r) acc[r] = 0.f;
          const bf16_t* bs = Ks + (part * 128 + ni * 32 + (lane & 31)) * K_LDK + 8 * (lane >> 5);
#pragma unroll
          for (int kk = 0; kk < 8; ++kk) acc = __builtin_amdgcn_mfma_f32_32x32x16_bf16(part ? afr[8 + kk] : afr[kk], *(const bf16x8*)(bs + kk * 16), acc, 0, 0, 0);
#pragma unroll
          for (int r = 0; r < 16; ++r) Sc[(mi * 32 + (r & 3) + 8 * (r >> 2) + 4 * (lane >> 5)) * K_LDS + ni * 32 + (lane & 31)] = acc[r]; }
        __syncthreads();
        unsigned mk[16];
#pragma unroll
        for (int i = 0; i < 16; ++i) mk[i] = (fkey(Sc[row * K_LDS + sub * 16 + i]) & ~127u) | (unsigned)(127 - (sub * 16 + i));
        bitonic_desc<16>(mk);
        __syncthreads();
        unsigned* lst = (unsigned*)Sc + (row * 8 + sub) * 17;
#pragma unroll
        for (int i = 0; i < 16; ++i) lst[i] = mk[i];
        unsigned r0, r1;
        merge16(lst, 16, mk[0], sub, r0, r1);
        s12[(row * 2 + part) * 16 + sub] = r0; s12[(row * 2 + part) * 16 + 8 + sub] = r1;
        __syncthreads();
    }
    {
        const unsigned* k1 = s12 + row * 32; const unsigned* k2 = k1 + 16;
        unsigned ck[8];
#pragma unroll
        for (int m = 0; m < 8; ++m) {
            const int cc = sub + 8 * m; int ci = 0, off = 0;
#pragma unroll
            for (int i = 0; i < 15; ++i) { const bool ge = cc >= cand_off(i + 1); ci += ge ? 1 : 0; off += ge ? 16 / (i + 1) : 0; }
            const int cj = cc - off;
            ck[m] = 0u;
            if (cc < 50) ck[m] = (fkey(unkey((k1[ci] & ~127u) | 64u) + unkey((k2[cj] & ~127u) | 64u)) & ~63u) | (unsigned)(63 - cc);
        }
        bitonic_desc<8>(ck);
        unsigned* lst = cl + (row * 8 + sub) * 9;
#pragma unroll
        for (int m = 0; m < 8; ++m) lst[m] = ck[m];
        unsigned r0, r1;
        merge16(lst, 8, ck[0], sub, r0, r1);
        const float a = unkey((r0 & ~63u) | 32u), b = unkey((r1 & ~63u) | 32u);
        const unsigned kmax = max8_u32(r0 > r1 ? r0 : r1); const float vmax = unkey((kmax & ~63u) | 32u);
        const float ea = __expf(a - vmax), eb = __expf(b - vmax);
        const float inv = 1.f / sum8_f32(ea + eb);
        int eidx[2];
#pragma unroll
        for (int q = 0; q < 2; ++q) {
            const int cc = 63 - (int)((q ? r1 : r0) & 63u); int ci = 0, off = 0;
#pragma unroll
            for (int i = 0; i < 15; ++i) { const bool ge = cc >= cand_off(i + 1); ci += ge ? 1 : 0; off += ge ? 16 / (i + 1) : 0; }
            const int cj = cc - off;
            eidx[q] = (127 - (int)(k1[ci] & 127u)) * 128 + (127 - (int)(k2[cj] & 127u));
        }
        int* IDX = (int*)(p.ws + WS_IDX) + (size_t)(tok0 + row) * 128 + h * 16; float* GT = (float*)(p.ws + WS_GATE) + (size_t)(tok0 + row) * 128 + h * 16;
        IDX[sub] = eidx[0]; IDX[8 + sub] = eidx[1]; GT[sub] = ea * inv; GT[8 + sub] = eb * inv;
    }
    __syncthreads();
}
#define TOPK_LOAD(AF, tok0_, h_) do { const int lane_ = tidx() & 63, w_ = tidx() >> 6; \
        const bf16_t* ag_ = (const bf16_t*)(p.ws + WS_P) + (size_t)((tok0_) + (w_ >> 2) * 32 + (lane_ & 31)) * 2048 + (h_) * 256 + 8 * (lane_ >> 5); \
        _Pragma("unroll") for (int q_ = 0; q_ < 16; ++q_) AF[q_] = *(const bf16x8*)(ag_ + (q_ >> 3) * 128 + (q_ & 7) * 16); } while (0)
DEV void topk_phase(const Params& p, int layer, int ntok, unsigned char* smem) {
    const int G = gridDim.x, bid = blockIdx.x, h = bid & 7;
    const int nt = ntok / 64;
    bf16x8 afA[16], afB[16];
    if ((G & 7) == 0) {
        const int st = G >> 3; int tt = bid >> 3;
        if (tt < nt) { TOPK_LOAD(afA, tt * 64, h); topk_load_keys(p, layer, h, smem); }
        while (tt < nt) {
            if (tt + st < nt) TOPK_LOAD(afB, (tt + st) * 64, h);
            topk_item(p, h, tt * 64, smem, afA);
            tt += st; if (tt >= nt) break;
            if (tt + st < nt) TOPK_LOAD(afA, (tt + st) * 64, h);
            topk_item(p, h, tt * 64, smem, afB);
            tt += st;
        }
    } else {
        for (int it = bid; it < nt * 8; it += G) { __syncthreads(); TOPK_LOAD(afA, (it >> 3) * 64, it & 7); topk_load_keys(p, layer, it & 7, smem); topk_item(p, it & 7, (it >> 3) * 64, smem, afA); }
    }
}
#undef TOPK_LOAD

DEV float gelu_f(float x) { return 0.5f * x * (1.f + erff(x * 0.70710678118654752f)); }
DEV void peer_item(const Params& p, int layer, int item, int var = 0) {
    (void)var;
    const int tok = item * 8 + (tidx() >> 6), lane = tidx() & 63, li = lane & 31, half = lane >> 5;
    const bf16_t* A = (const bf16_t*)(p.ws + WS_A) + (size_t)tok * 1024 + li * 32;
    const unsigned char* UV = p.ws + WS_UV + (size_t)layer * 16384 * 1024;
    const float* SU = (const float*)(p.ws + WS_S8) + (size_t)(layer * 2) * 16384; const float* SV = SU + 16384;
    float x[32], y[32];
#pragma unroll
    for (int q = 0; q < 4; ++q) { const u32x4 a = *(const u32x4*)(A + 8 * q);
#pragma unroll
        for (int i = 0; i < 4; ++i) { x[8 * q + 2 * i] = bflo(a[i]); x[8 * q + 2 * i + 1] = bfhi(a[i]); } }
#pragma unroll
    for (int i = 0; i < 32; ++i) y[i] = 0.f;
    const int* IDX = (const int*)(p.ws + WS_IDX) + (size_t)tok * 128; const float* GT = (const float*)(p.ws + WS_GATE) + (size_t)tok * 128;
    const int i_lo = IDX[lane], i_hi = IDX[64 + lane]; const float g_lo = GT[lane], g_hi = GT[64 + lane];
    const int sl = ((li >> 4) & 1) * 2 + ((li >> 3) & 1);
    u32x4 uq[4], vq[4];
#define PG_LOADU(g) do { _Pragma("unroll") for (int s_ = 0; s_ < 4; ++s_) { const int e_ = __shfl((g) < 8 ? i_lo : i_hi, (((g) & 7) << 3) + 2 * s_ + half); \
        uq[s_] = *(const u32x4*)(UV + (size_t)e_ * 1024 + li * 16); } } while (0)
#define PG_LOADV(g) do { _Pragma("unroll") for (int s_ = 0; s_ < 4; ++s_) { const int e_ = __shfl((g) < 8 ? i_lo : i_hi, (((g) & 7) << 3) + 2 * s_ + half); \
        vq[s_] = *(const u32x4*)(UV + (size_t)e_ * 1024 + 512 + li * 16); } } while (0)
    PG_LOADU(0); PG_LOADV(0);
    for (int g = 0; g < 16; ++g) {
        const int mk = ((g & 7) << 3) + 2 * sl + half; const int me = __shfl(g < 8 ? i_lo : i_hi, mk); const float mg = __shfl(g < 8 ? g_lo : g_hi, mk);
        const float su = SU[me], sv = SV[me];
        float d[4];
#pragma unroll
        for (int s4 = 0; s4 < 4; ++s4) {
            float a = 0.f;
#pragma unroll
            for (int dw = 0; dw < 4; ++dw) {
                const f32x2 f0 = __builtin_amdgcn_cvt_scalef32_pk_f32_fp4(uq[s4][dw], 1.0f, 0), f1 = __builtin_amdgcn_cvt_scalef32_pk_f32_fp4(uq[s4][dw], 1.0f, 1),
                            f2 = __builtin_amdgcn_cvt_scalef32_pk_f32_fp4(uq[s4][dw], 1.0f, 2), f3 = __builtin_amdgcn_cvt_scalef32_pk_f32_fp4(uq[s4][dw], 1.0f, 3);
                const int e0 = dw * 8;
                a = fmaf(f0[0], x[e0], a); a = fmaf(f0[1], x[e0 + 1], a); a = fmaf(f1[0], x[e0 + 2], a); a = fmaf(f1[1], x[e0 + 3], a);
                a = fmaf(f2[0], x[e0 + 4], a); a = fmaf(f2[1], x[e0 + 5], a); a = fmaf(f3[0], x[e0 + 6], a); a = fmaf(f3[1], x[e0 + 7], a);
            }
            d[s4] = a; SCHED_FENCE(); }
        if (g + 1 < 16) PG_LOADU(g + 1);
        float r2[2], r1;
        { const bool hi = (li & 16) != 0;
#pragma unroll
          for (int j = 0; j < 2; ++j) { const float send = hi ? d[j] : d[2 + j], keep = hi ? d[2 + j] : d[j]; r2[j] = keep + __shfl_xor(send, 16); } }
        { const bool hi = (li & 8) != 0; const float send = hi ? r2[0] : r2[1], keep = hi ? r2[1] : r2[0]; r1 = keep + __shfl_xor(send, 8); }
        r1 += __shfl_xor(r1, 4); r1 += __shfl_xor(r1, 2); r1 += __shfl_xor(r1, 1);
        const float act = gelu_f(r1 * su) * mg * sv;
#pragma unroll
        for (int s4 = 0; s4 < 4; ++s4) {
            const float aj = __shfl(act, (lane & 32) + 16 * (s4 >> 1) + 8 * (s4 & 1));
#pragma unroll
            for (int dw = 0; dw < 4; ++dw) {
                const f32x2 f0 = __builtin_amdgcn_cvt_scalef32_pk_f32_fp4(vq[s4][dw], 1.0f, 0), f1 = __builtin_amdgcn_cvt_scalef32_pk_f32_fp4(vq[s4][dw], 1.0f, 1),
                            f2 = __builtin_amdgcn_cvt_scalef32_pk_f32_fp4(vq[s4][dw], 1.0f, 2), f3 = __builtin_amdgcn_cvt_scalef32_pk_f32_fp4(vq[s4][dw], 1.0f, 3);
                const int e0 = dw * 8;
                y[e0] = fmaf(aj, f0[0], y[e0]); y[e0 + 1] = fmaf(aj, f0[1], y[e0 + 1]); y[e0 + 2] = fmaf(aj, f1[0], y[e0 + 2]); y[e0 + 3] = fmaf(aj, f1[1], y[e0 + 3]);
                y[e0 + 4] = fmaf(aj, f2[0], y[e0 + 4]); y[e0 + 5] = fmaf(aj, f2[1], y[e0 + 5]); y[e0 + 6] = fmaf(aj, f3[0], y[e0 + 6]); y[e0 + 7] = fmaf(aj, f3[1], y[e0 + 7]);
            }
            SCHED_FENCE(); }
        if (g + 1 < 16) PG_LOADV(g + 1);
    }
#undef PG_LOADU
#undef PG_LOADV
    float yy[16];
#pragma unroll
    for (int i = 0; i < 16; ++i) { const float send = half ? y[i] : y[16 + i], keep = half ? y[16 + i] : y[i]; yy[i] = keep + __shfl_xor(send, 32); }
    const int c0 = li * 32 + half * 16;
    float* H = (float*)(p.ws + WS_H) + (size_t)tok * 1024 + c0;
    const float* g2 = (const float*)(p.ws + WS_MOD) + ((size_t)layer * NR + mod_row(tok)) * 6144 + 5120 + c0;
    float hv[16]; float ss = 0.f;
#pragma unroll
    for (int i = 0; i < 4; ++i) { const f32x4 hh = *(const f32x4*)(H + 4 * i), gg = *(const f32x4*)(g2 + 4 * i);
#pragma unroll
        for (int j = 0; j < 4; ++j) { const float v = hh[j] + gg[j] * yy[4 * i + j]; hv[4 * i + j] = v; ss += v * v; } }
    ss = wave_sum(ss);
    const float rstd = rsqrtf(ss * (1.f / 1024.f) + 1e-6f);
    if (layer == 0) {
#pragma unroll
        for (int i = 0; i < 4; ++i) { f32x4 o; o[0] = hv[4 * i]; o[1] = hv[4 * i + 1]; o[2] = hv[4 * i + 2]; o[3] = hv[4 * i + 3]; *(f32x4*)(H + 4 * i) = o; }
        const float* g = p.in[I_N1G] + 1024 + c0;
        const float* mod = (const float*)(p.ws + WS_MOD) + ((size_t)1 * NR + mod_row(tok)) * 6144 + c0;
        bf16_t* Ao = (bf16_t*)(p.ws + WS_A) + (size_t)tok * 1024 + c0;
        u32x4 o0, o1; float r[16];
#pragma unroll
        for (int i = 0; i < 16; ++i) r[i] = hv[i] * rstd * g[i] * (1.f + mod[1024 + i]) + mod[i];
#pragma unroll
        for (int i = 0; i < 4; ++i) { o0[i] = pk2(r[2 * i], r[2 * i + 1]); o1[i] = pk2(r[8 + 2 * i], r[8 + 2 * i + 1]); }
        *(u32x4*)Ao = o0; *(u32x4*)(Ao + 8) = o1;
    } else {
        const float* g = p.in[I_FG] + c0; float* out = p.out + (size_t)tok * 1024 + c0;
#pragma unroll
        for (int i = 0; i < 4; ++i) { f32x4 o; o[0] = hv[4 * i] * rstd * g[4 * i]; o[1] = hv[4 * i + 1] * rstd * g[4 * i + 1]; o[2] = hv[4 * i + 2] * rstd * g[4 * i + 2]; o[3] = hv[4 * i + 3] * rstd * g[4 * i + 3]; *(f32x4*)(out + 4 * i) = o; }
    }
}

constexpr int S3_LD = 136, S3_LDT = 24, S3_LDV = 72;
constexpr int S3_Q = 0, S3_K = S3_Q + 64 * S3_LD * 2, S3_KT = S3_K + 64 * S3_LD * 2, S3_D = S3_KT + 4 * 128 * S3_LDT * 2, S3_V = S3_D + 4 * 128 * 4, S3_ST = S3_V + 64 * S3_LDV * 2,
              S3_P = S3_ST + 2 * 64 * S3_LD * 2, S3_END = S3_P + 4 * 16 * S3_LDT * 2;
static_assert(S3_END <= SMEM_BYTES, "scan LDS");
DEV void scan_block(const Params& p, int bi, unsigned char* smem, int var = 0) {
    const int tid = tidx(), lane = tid & 63, w = tid >> 6, l15 = lane & 15, lg4 = lane >> 4, l31 = lane & 31, lh = lane >> 5;
    const int half = bi & 1, dir = (bi >> 1) & 1, h = (bi >> 2) & 7, b = bi >> 5;
    const bf16_t* P1 = (const bf16_t*)(p.ws + WS_P);
    const bf16_t* IT = (const bf16_t*)(p.ws + WS_M);
    bf16_t* Oo = (bf16_t*)(p.ws + WS_F + (dir ? F_OB : F_OF));
    bf16_t* Qs = (bf16_t*)(smem + S3_Q); bf16_t* Ks = (bf16_t*)(smem + S3_K); bf16_t* KT = (bf16_t*)(smem + S3_KT); float* Ds = (float*)(smem + S3_D);
    bf16_t* Vs = (bf16_t*)(smem + S3_V); bf16_t* ST = (bf16_t*)(smem + S3_ST); bf16_t* Ps = (bf16_t*)(smem + S3_P);
    const int NCH = (LC + L) / 64;
    const int kt = w >> 1, vt = w & 1;
    f32x16 S;
#pragma unroll
    for (int r = 0; r < 16; ++r) S[r] = 0.f;
    for (int i = tid; i < 64 * S3_LD / 2; i += NT) ((unsigned*)ST)[i] = 0u;
    const int pk = tid & 127, pblk = tid >> 7;
    u32x4 ka[2], qa[2], va, kb2[2], qb2[2], vb2;
    const int kcol = 1024 * (1 + dir) + h * 128 + pk, qcol = h * 128 + pk;
#define S3_T0(c) ((c) * 64 < LC ? (dir ? LC - 64 - (c) * 64 : (c) * 64) : (dir ? L - 64 - ((c) * 64 - LC) : (c) * 64 - LC))
#define S3_LOAD(c, KR, QR, VR) do { const bool lat_ = (c) * 64 >= LC; const int t0_ = S3_T0(c); const int Lx_ = lat_ ? L : LC; \
        const bf16_t* kq_ = (const bf16_t*)(p.ws + WS_P + (lat_ ? P1_KQT_LAT : P1_KQT_CTX)) + (size_t)b * 3072 * Lx_ + t0_ + pblk * 16; \
        KR[0] = *(const u32x4*)(kq_ + (size_t)kcol * Lx_); KR[1] = *(const u32x4*)(kq_ + (size_t)kcol * Lx_ + 8); \
        if (lat_) { QR[0] = *(const u32x4*)(kq_ + (size_t)qcol * Lx_); QR[1] = *(const u32x4*)(kq_ + (size_t)qcol * Lx_ + 8); } else { QR[0] = (u32x4){0u, 0u, 0u, 0u}; QR[1] = QR[0]; } \
        { const int v_ = tid >> 3, c8_ = tid & 7; const bf16_t* it_ = IT + (lat_ ? (size_t)0 : (size_t)NB * 1024 * L) + ((size_t)b * 1024 + h * 128 + half * 64 + v_) * Lx_ + t0_ + c8_ * 8; VR = *(const u32x4*)it_; } } while (0)
#define S3_PREP(KR, QR, VR) do { \
            float bsum = 0.f; unsigned short kt16[16]; \
            _Pragma("unroll") for (int rr = 0; rr < 16; ++rr) { \
                const int tl = dir ? 15 - rr : rr; \
                const unsigned ku_ = dir ? KR[(15 - rr) >> 3][((15 - rr) & 7) >> 1] : KR[rr >> 3][(rr & 7) >> 1]; const unsigned qu_ = dir ? QR[(15 - rr) >> 3][((15 - rr) & 7) >> 1] : QR[rr >> 3][(rr & 7) >> 1]; \
                const bool odd_ = dir ? (((15 - rr) & 1) != 0) : ((rr & 1) != 0); \
                const float kv = odd_ ? bfhi(ku_) : bflo(ku_), qv = odd_ ? bfhi(qu_) : bflo(qu_); \
                bsum += __log2f(1.f - kv); \
                const float eb = __builtin_amdgcn_exp2f(bsum), ieb = __builtin_amdgcn_exp2f(fminf(-bsum, 115.f)); \
                const unsigned short qt = (unsigned short)f2bf(qv * eb), ktv = (unsigned short)f2bf(kv * ieb); \
                Qs[(pblk * 16 + tl) * S3_LD + pk] = qt; Ks[(pblk * 16 + tl) * S3_LD + pk] = ktv; \
                if (dir) kt16[15 - rr] = ktv; else kt16[rr] = ktv; \
            } \
            u32x4 o0, o1; \
            _Pragma("unroll") for (int i = 0; i < 4; ++i) { o0[i] = (unsigned)kt16[2 * i] | ((unsigned)kt16[2 * i + 1] << 16); o1[i] = (unsigned)kt16[8 + 2 * i] | ((unsigned)kt16[8 + 2 * i + 1] << 16); } \
            *(u32x4*)(KT + (pblk * 128 + pk) * S3_LDT) = o0; *(u32x4*)(KT + (pblk * 128 + pk) * S3_LDT + 8) = o1; \
            Ds[pblk * 128 + pk] = __builtin_amdgcn_exp2f(bsum); \
            { const int v_ = tid >> 3, c8_ = tid & 7; *(u32x4*)(Vs + v_ * S3_LDV + c8_ * 8) = VR; } } while (0)
    S3_LOAD(0, ka, qa, va);
    for (int c = 0; c < NCH; ++c) {
        const bool lat = c * 64 >= LC; const int t0 = S3_T0(c); const size_t tokb = lat ? (size_t)b * L + t0 : (size_t)TL + (size_t)b * LC + t0;
        if ((c & 1) == 0) { if (c + 1 < NCH) S3_LOAD(c + 1, kb2, qb2, vb2); } else { if (c + 1 < NCH) S3_LOAD(c + 1, ka, qa, va); }
        lds_barrier();
        if (var != 1) { if ((c & 1) == 0) S3_PREP(ka, qa, va); else S3_PREP(kb2, qb2, vb2); }
        lds_barrier();

        if (lat && w < 4) {
            f32x4 pt = (f32x4){0.f, 0.f, 0.f, 0.f};
#pragma unroll
            for (int kk = 0; kk < 4; ++kk)
                pt = __builtin_amdgcn_mfma_f32_16x16x32_bf16(*(const bf16x8*)(Ks + (w * 16 + l15) * S3_LD + kk * 32 + 8 * lg4), *(const bf16x8*)(Qs + (w * 16 + l15) * S3_LD + kk * 32 + 8 * lg4), pt, 0, 0, 0);
            float pm[4];
#pragma unroll
            for (int r = 0; r < 4; ++r) { const int sl = 4 * lg4 + r; const bool keep = dir ? (sl >= l15) : (sl <= l15); pm[r] = keep ? pt[r] : 0.f; }
            u32x2 o; o[0] = pk2(pm[0], pm[1]); o[1] = pk2(pm[2], pm[3]);
            *(u32x2*)(Ps + (w * 16 + l15) * S3_LDT + 4 * lg4) = o;
        }
        lds_barrier();
        for (int ib = 0; ib < (var == 2 ? 0 : 4); ++ib) {
            const int blk = dir ? 3 - ib : ib;
            const int cur = (c * 4 + ib) & 1;
            { const bf16x8 a = *(const bf16x8*)(KT + (blk * 128 + 32 * kt + l31) * S3_LDT + 8 * lh);
              const bf16x8 bb = *(const bf16x8*)(Vs + (32 * vt + l31) * S3_LDV + blk * 16 + 8 * lh);
              S = __builtin_amdgcn_mfma_f32_32x32x16_bf16(a, bb, S, 0, 0, 0);
#pragma unroll
              for (int g = 0; g < 4; ++g) { const f32x4 dv = *(const f32x4*)(Ds + blk * 128 + 32 * kt + 8 * g + 4 * lh);
                  S[4 * g] *= dv[0]; S[4 * g + 1] *= dv[1]; S[4 * g + 2] *= dv[2]; S[4 * g + 3] *= dv[3];
                  u32x2 o; o[0] = pk2(S[4 * g], S[4 * g + 1]); o[1] = pk2(S[4 * g + 2], S[4 * g + 3]);
                  *(u32x2*)(ST + ((cur ^ 1) * 64 + 32 * vt + l31) * S3_LD + 32 * kt + 8 * g + 4 * lh) = o; } }
            if (lat && w < 4) {
                f32x4 o = (f32x4){0.f, 0.f, 0.f, 0.f};
#pragma unroll
                for (int kk = 0; kk < 4; ++kk)
                    o = __builtin_amdgcn_mfma_f32_16x16x32_bf16(*(const bf16x8*)(ST + (cur * 64 + 16 * w + l15) * S3_LD + kk * 32 + 8 * lg4), *(const bf16x8*)(Qs + (blk * 16 + l15) * S3_LD + kk * 32 + 8 * lg4), o, 0, 0, 0);
                bf16x8 va = (bf16x8){0, 0, 0, 0, 0, 0, 0, 0}, pb = va;
                if (lg4 < 2) { va = *(const bf16x8*)(Vs + (16 * w + l15) * S3_LDV + blk * 16 + 8 * lg4); pb = *(const bf16x8*)(Ps + (blk * 16 + l15) * S3_LDT + 8 * lg4); }
                o = __builtin_amdgcn_mfma_f32_16x16x32_bf16(va, pb, o, 0, 0, 0);
                u32x2 ou; ou[0] = pk2(o[0], o[1]); ou[1] = pk2(o[2], o[3]);
                *(u32x2*)(Oo + (tokb + blk * 16 + l15) * 1024 + h * 128 + half * 64 + 16 * w + 4 * lg4) = ou;
            }
            lds_barrier();
        }
    }
    lds_barrier();
#undef S3_T0
#undef S3_LOAD
#undef S3_PREP
}
DEV void readout_item(const Params& p, int item) {
    const int tok = item * 8 + (tidx() >> 6), lane = tidx() & 63;
    const bf16_t* of = (const bf16_t*)(p.ws + WS_F + F_OF) + (size_t)tok * 1024 + lane * 16; const bf16_t* ob = (const bf16_t*)(p.ws + WS_F + F_OB) + (size_t)tok * 1024 + lane * 16;
    const bf16_t* gp = (const bf16_t*)(p.ws + WS_P + P1_G) + (size_t)tok * 1024 + lane * 16;
    const float* on = p.in[I_HGON] + (lane & 7) * 16;
    float o[16], gg[16]; float ss = 0.f;
    { const u32x4 a0 = *(const u32x4*)of, a1 = *(const u32x4*)(of + 8), b0 = *(const u32x4*)ob, b1 = *(const u32x4*)(ob + 8), g0 = *(const u32x4*)gp, g1 = *(const u32x4*)(gp + 8);
#pragma unroll
      for (int i = 0; i < 4; ++i) { o[2 * i] = bflo(a0[i]) + bflo(b0[i]); o[2 * i + 1] = bfhi(a0[i]) + bfhi(b0[i]); o[8 + 2 * i] = bflo(a1[i]) + bflo(b1[i]); o[8 + 2 * i + 1] = bfhi(a1[i]) + bfhi(b1[i]);
          gg[2 * i] = bflo(g0[i]); gg[2 * i + 1] = bfhi(g0[i]); gg[8 + 2 * i] = bflo(g1[i]); gg[8 + 2 * i + 1] = bfhi(g1[i]); } }
#pragma unroll
    for (int i = 0; i < 16; ++i) ss += o[i] * o[i];
    ss += __shfl_xor(ss, 1); ss += __shfl_xor(ss, 2); ss += __shfl_xor(ss, 4);
    const float rstd = rsqrtf(ss * (1.f / 128.f) + 1e-6f);
    bf16_t* M = (bf16_t*)(p.ws + WS_M) + (size_t)tok * 1024 + lane * 16;
    u32x4 o0, o1; float r[16];
#pragma unroll
    for (int i = 0; i < 16; ++i) r[i] = o[i] * rstd * on[i] * gg[i];
#pragma unroll
    for (int i = 0; i < 4; ++i) { o0[i] = pk2(r[2 * i], r[2 * i + 1]); o1[i] = pk2(r[8 + 2 * i], r[8 + 2 * i + 1]); }
    *(u32x4*)M = o0; *(u32x4*)(M + 8) = o1;
}

#ifndef HOST_EMU
#define XB_TMO      128
#define XB_XCNT(j)  (256  + 64 * (j))
#define XB_XSUB(j)  (1280 + 64 * (j))
#define XB_XGEN(j)  (2304 + 64 * (j))
#define XB_TOP      3328
#define XB_TOPGEN   3392
#define XCD_BAR_WORDS 3456
#define XB_SPIN_CAP (1u << 18)
#define LAS __attribute__((address_space(3)))

__device__ __forceinline__ unsigned xb_ld(unsigned* p)              { return __hip_atomic_load(p, __ATOMIC_RELAXED, __HIP_MEMORY_SCOPE_AGENT); }
__device__ __forceinline__ unsigned xb_add(unsigned* p, unsigned v) { return __hip_atomic_fetch_add(p, v, __ATOMIC_RELAXED, __HIP_MEMORY_SCOPE_AGENT); }
__device__ __forceinline__ unsigned xb_xcc_id() { return (unsigned)__builtin_amdgcn_s_getreg((3 << 11) | 20) & 0xFu; }
#define XB_SPIN(cond, bar) do { unsigned _sp = 0; while (cond) { __builtin_amdgcn_s_sleep(1); \
    if ((++_sp & 255u) == 0u) { if (xb_ld(&(bar)[XB_TMO])) break; if (_sp > XB_SPIN_CAP) { atomicAdd(&(bar)[XB_TMO], 1u); break; } } } } while (0)

struct XcdBarrier {
    unsigned* bar; unsigned x;
    volatile LAS unsigned* st;
};

__device__ __forceinline__ XcdBarrier xcd_barrier_post(unsigned* bar, volatile LAS unsigned* st) {
    XcdBarrier b; b.bar = bar; b.x = xb_xcc_id(); b.st = st;
    if (threadIdx.x == 0) (void)xb_add(&bar[XB_XCNT(b.x)], 1u);
    return b;
}
__device__ __forceinline__ void xcd_barrier_complete(unsigned* bar, unsigned x, unsigned& nloc, unsigned& nx) {
    const unsigned G = gridDim.x * gridDim.y * gridDim.z;
    unsigned sum, cnt, mine, sp = 0u;
    for (;;) {
        sum = 0u; cnt = 0u; mine = 0u;
#pragma unroll
        for (unsigned j = 0; j < 16; ++j) { const unsigned c = xb_ld(&bar[XB_XCNT(j)]); sum += c; cnt += (c > 0u) ? 1u : 0u; mine = (j == x) ? c : mine; }
        if (sum == G) break;
        __builtin_amdgcn_s_sleep(1);
        if ((++sp & 255u) == 0u) { if (xb_ld(&bar[XB_TMO])) break; if (sp > XB_SPIN_CAP) { atomicAdd(&bar[XB_TMO], 1u); break; } }
    }
    nloc = mine > 0u ? mine : 1u; nx = cnt > 0u ? cnt : 1u;
}

__device__ __forceinline__ void xcd_barrier(const XcdBarrier& b) {
    asm volatile("s_waitcnt vmcnt(0)" ::: "memory");
    __syncthreads();
    if (threadIdx.x == 0) {
        unsigned* bar = b.bar;
        __builtin_amdgcn_s_waitcnt(0);
        unsigned nloc = b.st[0], nx = b.st[1];
        if (nloc == 0u) { xcd_barrier_complete(bar, b.x, nloc, nx); b.st[0] = nloc; b.st[1] = nx; }
        const unsigned old = xb_add(&bar[XB_XSUB(b.x)], 1u);
        const unsigned gen = old / nloc;
        if (old + 1u == (gen + 1u) * nloc) {
            __builtin_amdgcn_fence(__ATOMIC_RELEASE, "agent");
            asm volatile("s_waitcnt vmcnt(0)" ::: "memory");
            const unsigned og = xb_add(&bar[XB_TOP], 1u);
            const unsigned tg = og / nx;
            if (og + 1u == (tg + 1u) * nx) xb_add(&bar[XB_TOPGEN], 1u);
            else XB_SPIN(xb_ld(&bar[XB_TOPGEN]) == tg, bar);
            __builtin_amdgcn_fence(__ATOMIC_ACQUIRE, "agent");
            xb_add(&bar[XB_XGEN(b.x)], 1u);
            asm volatile("s_waitcnt vmcnt(0)" ::: "memory");
        } else {
            XB_SPIN(xb_ld(&bar[XB_XGEN(b.x)]) == gen, bar);
            __builtin_amdgcn_fence(__ATOMIC_ACQUIRE, "agent");
            asm volatile("s_waitcnt vmcnt(0)" ::: "memory");
        }
    }
    __syncthreads();
}

#endif
#ifdef NOINLINE_PHASES
#define NOINL __device__ __attribute__((noinline))
#else
#define NOINL __device__ __forceinline__
#endif
__shared__ __attribute__((aligned(16))) unsigned char g_smem[SMEM_BYTES + 16];
#define PH_COMMON const int G = gridDim.x, bid = blockIdx.x; unsigned char* smem = g_smem; (void)smem; (void)G; (void)bid; \
    const bf16_t* A = (const bf16_t*)(p.ws + WS_A); const bf16_t* Mx = (const bf16_t*)(p.ws + WS_M); const bf16_t* W = (const bf16_t*)(p.ws + WS_W); (void)A; (void)Mx; (void)W;
DEV void tables_in_gemm_tail(const Params& p, int tab0, int ntab, int nunits) {
    const int G = gridDim.x, bid = blockIdx.x, busy = nunits % G;
    if (busy == 0) { for (int it = bid; it < ntab * P0_TAB; it += G) p0_table(p, tab0 + it / P0_TAB, it % P0_TAB); return; }
    if (bid < busy) return;
    for (int it = bid - busy; it < ntab * P0_TAB; it += G - busy) p0_table(p, tab0 + it / P0_TAB, it % P0_TAB);
}
NOINL void ph0(const Params& p) { PH_COMMON phase0(p, smem); }
NOINL void ph1(const Params& p) { PH_COMMON phase1(p, smem); }
NOINL void ph2(const Params& p) { PH_COMMON EpiL0InT e{p.ws}; gemm_pg8_T(A, W + W_IN0 / 2, T, 2304, smem, e); tables_in_gemm_tail(p, 0, 1, (T / 256) * 9); }
NOINL void ph3(const Params& p, int var = 0) { PH_COMMON phase3(p, smem, var); }
NOINL void ph4(const Params& p) { PH_COMMON EpiRes e{&p, 1, 0, 2048}; gemm_pg8_N(Mx, W + W_OUT0 / 2, T, 1024, smem, e); tables_in_gemm_tail(p, 1, 2, (T / 256) * 4); }
NOINL void ph5(const Params& p) { PH_COMMON for (int it = bid; it < T / 8; it += G) norm_rows_item(p, it, 0, p.in[I_N2G], 0, 3072); }
NOINL void ph6(const Params& p, int var = 0) { PH_COMMON (void)var; EpiBf16 e{(bf16_t*)(p.ws + WS_P), 2048}; gemm_pg8_N(A, W + W_Q0 / 2, T, 2048, smem, e); tables_in_gemm_tail(p, 3, 1, (T / 256) * 8); }
NOINL void ph7(const Params& p) { PH_COMMON topk_phase(p, 0, T, smem); }
NOINL void ph8(const Params& p) { PH_COMMON for (int it = bid; it < T / 8; it += G) peer_item(p, 0, it); }
NOINL void ph9(const Params& p, int var = 0) { PH_COMMON EpiHgT e{p.ws, p.in[I_HGLB], var}; gemm_pg8_T(A, W + W_IN1 / 2, T, 5120, smem, e); }
NOINL void ph10(const Params& p, int var = 0) { PH_COMMON for (int bi = bid; bi < NB * 32; bi += G) scan_block(p, bi, smem, var); }
NOINL void ph11(const Params& p) { PH_COMMON for (int it = bid; it < TL / 8; it += G) readout_item(p, it); }
NOINL void ph12(const Params& p) { PH_COMMON EpiRes e{&p, 0, 1, 2048}; gemm_pg8_N(Mx, W + W_OUT1 / 2, TL, 1024, smem, e); }
NOINL void ph13(const Params& p) { PH_COMMON for (int it = bid; it < TL / 8; it += G) norm_rows_item(p, it, 0, p.in[I_N2G] + 1024, 1, 3072); }
NOINL void ph14(const Params& p) { PH_COMMON EpiBf16 e{(bf16_t*)(p.ws + WS_P), 2048}; gemm_pg8_N(A, W + W_Q1 / 2, TL, 2048, smem, e); }
NOINL void ph15(const Params& p) { PH_COMMON topk_phase(p, 1, TL, smem); }
NOINL void ph16(const Params& p, int var = 0) { PH_COMMON for (int it = bid; it < TL / 8; it += G) peer_item(p, 1, it, var); }

constexpr int NPHASE = 17;
__global__ void __launch_bounds__(NT, 2) mega(Params p_in) {
    const int ph_lo = p_in.ph_lo, ph_hi = p_in.ph_hi;
#ifndef HOST_EMU
#define GBAR_MAKE() XcdBarrier gbar; gbar.bar = (unsigned*)(p_in.ws + WS_CTRL); gbar.x = xb_xcc_id(); gbar.st = (volatile LAS unsigned*)(LAS unsigned char*)(g_smem + SMEM_BYTES);
    if (ph_hi - ph_lo > 1) {
        volatile LAS unsigned* st = (volatile LAS unsigned*)(LAS unsigned char*)(g_smem + SMEM_BYTES);
        if (threadIdx.x == 0) { st[0] = 0u; st[1] = 0u; }
        __syncthreads();
        (void)xcd_barrier_post((unsigned*)(p_in.ws + WS_CTRL), st);
    }
#endif
#ifndef HOST_EMU
#define PH_BARRIER() do { GBAR_MAKE(); xcd_barrier(gbar); } while (0)
#define PH_PARAMS() unsigned long long kp = (unsigned long long)__builtin_amdgcn_kernarg_segment_ptr(); asm volatile("" : "+s"(kp) :: "memory"); \
        const Params& p = *(const Params*)(const __attribute__((address_space(4))) Params*)kp;
#else
#define PH_BARRIER() do {} while (0)
#define PH_PARAMS() const Params& p = p_in;
#endif
#ifdef REPEAT_MASK
#define PH_REPEAT(k, CALL) if ((REPEAT_MASK >> (k)) & 1) { PH_BARRIER(); { PH_PARAMS(); CALL; } }
#else
#define PH_REPEAT(k, CALL)
#endif
#ifdef ONLY_PHASE
#define PH_ON(k) ((k) == ONLY_PHASE)
#else
#define PH_ON(k) true
#endif
#if defined(REPEAT_MASK) && defined(HG_VAR)
#define RUN_PHASE9() if (ph_lo <= 9 && 9 < ph_hi) { if (9 > ph_lo) PH_BARRIER(); { PH_PARAMS(); ph9(p, HG_VAR); } PH_BARRIER(); { PH_PARAMS(); ph9(p, 0); } }
#else
#define RUN_PHASE9() RUN_PHASE(9, ph9(p))
#endif
#if defined(REPEAT_MASK) && defined(P3_VAR)
#define RUN_PHASE3() if (ph_lo <= 3 && 3 < ph_hi) { if (3 > ph_lo) PH_BARRIER(); { PH_PARAMS(); ph3(p, P3_VAR); } PH_BARRIER(); { PH_PARAMS(); ph3(p, 0); } }
#else
#define RUN_PHASE3() RUN_PHASE(3, ph3(p))
#endif
#define RUN_PHASE(k, CALL) if (PH_ON(k) && ph_lo <= (k) && (k) < ph_hi) { if ((k) > ph_lo) PH_BARRIER(); { PH_PARAMS(); CALL; } PH_REPEAT(k, CALL) }
    RUN_PHASE(0, ph0(p))  RUN_PHASE(1, ph1(p))  RUN_PHASE(2, ph2(p))  RUN_PHASE3()  RUN_PHASE(4, ph4(p))  RUN_PHASE(5, ph5(p))
    RUN_PHASE(6, ph6(p))  RUN_PHASE(7, ph7(p))  RUN_PHASE(8, ph8(p))  RUN_PHASE9()  RUN_PHASE(10, ph10(p)) RUN_PHASE(11, ph11(p))
    RUN_PHASE(12, ph12(p)) RUN_PHASE(13, ph13(p)) RUN_PHASE(14, ph14(p)) RUN_PHASE(15, ph15(p)) RUN_PHASE(16, ph16(p))
}

#ifndef HOST_EMU
extern "C" void kernel_launch(void* const* d_in, const int* in_sizes, int n_in, void* d_out, int out_size, void* d_ws, size_t ws_size, hipStream_t stream) {
    if (n_in != 29 || ws_size < WS_END || out_size != TL * 1024) { fprintf(stderr, "kernel_launch: unexpected sizes (n_in %d, ws %zu need %zu, out %d)\n", n_in, ws_size, (size_t)WS_END, out_size); return; }
    static int grid = 0;
    if (!grid) { int dev = 0, cus = 0; hipGetDevice(&dev); hipDeviceGetAttribute(&cus, hipDeviceAttributeMultiprocessorCount, dev); grid = cus > 0 ? cus : 256; }
    hipMemsetAsync((unsigned char*)d_ws + WS_CTRL, 0, CTRL_BYTES, stream);
    Params p{};
    for (int i = 0; i < 29; ++i) p.in[i] = (const float*)d_in[i];
    p.out = (float*)d_out; p.ws = (unsigned char*)d_ws;
#ifdef MULTI_LAUNCH
    for (int ph = 0; ph < NPHASE; ++ph) { p.ph_lo = ph; p.ph_hi = ph + 1; hipLaunchKernelGGL(mega, dim3(grid), dim3(NT), 0, stream, p); }
#else
    p.ph_lo = 0; p.ph_hi = NPHASE;
    hipLaunchKernelGGL(mega, dim3(grid), dim3(NT), 0, stream, p);
#endif
}
#endif
```

```cpp
#ifndef HOST_EMU
#include <hip/hip_runtime.h>
#include <cstdio>
#endif

#ifndef CFG_B
#define CFG_B 8
#define CFG_L 2048
#define CFG_LC 256
#endif
#define DEV __device__ __forceinline__
#ifndef HOST_EMU
#define SCHED_FENCE() __builtin_amdgcn_sched_barrier(0)
#endif
#ifdef HOST_EMU
#define SCHED_FENCE() do {} while (0)
#define __expf expf
#define __logf logf
#define __log2f log2f
#define __exp2f exp2f
#define __sinf sinf
#define __cosf cosf
#endif

typedef unsigned short bf16_t;
typedef short bf16x8 __attribute__((ext_vector_type(8)));
typedef float f32x16 __attribute__((ext_vector_type(16)));
typedef float f32x4 __attribute__((ext_vector_type(4)));
typedef unsigned u32x4 __attribute__((ext_vector_type(4)));
typedef unsigned u32x2 __attribute__((ext_vector_type(2)));
struct cf2 { float x, y; };

constexpr int NB = CFG_B, L = CFG_L, LC = CFG_LC, D = 1024;
constexpr int TL = NB * L, TC = NB * LC, T = TL + TC;
constexpr int NT = 512;
constexpr int NR = NB + 1;
constexpr int log4ceil(int n) { int s = 0, v = 1; while (v < n) { v *= 4; ++s; } return s; }
constexpr int FS_LAT = log4ceil(2 * L - 1), FS_CTX = log4ceil(2 * LC - 1);
constexpr int NF_LAT = 1 << (2 * FS_LAT), NF_CTX = 1 << (2 * FS_CTX);
static_assert(T % 256 == 0 && TL % 256 == 0 && L % 128 == 0 && LC % 128 == 0 && NB % 2 == 0, "shape");

constexpr size_t al256(size_t x) { return (x + 255) & ~(size_t)255; }
constexpr size_t WS_CTRL = 0, CTRL_BYTES = 65536;
constexpr size_t CTRL_HYNORM = 4096;
constexpr size_t WS_MOD = WS_CTRL + CTRL_BYTES;
constexpr size_t WS_H = al256(WS_MOD + (size_t)2 * NR * 6144 * 4);
constexpr size_t WS_A = al256(WS_H + (size_t)T * 1024 * 4);
constexpr size_t WS_P = al256(WS_A + (size_t)T * 1024 * 2);
constexpr size_t P_BYTES = (size_t)T * 5120 * 2;
constexpr size_t P_HYT_LAT = 0;
constexpr size_t P_HYT_CTX = P_HYT_LAT + (size_t)NB * 1536 * L * 2;
constexpr size_t P_Q0 = P_HYT_CTX + (size_t)NB * 1536 * LC * 2;
constexpr size_t P_K0 = P_Q0 + (size_t)T * 512 * 2;
constexpr size_t P_VT_LAT = P_K0 + (size_t)T * 128 * 2;
constexpr size_t P_VT_CTX = P_VT_LAT + (size_t)NB * 128 * L * 2;
static_assert(P_VT_CTX + (size_t)NB * 128 * LC * 2 <= P_BYTES, "P region");
constexpr size_t P1_KQT_LAT = 0;
constexpr size_t P1_KQT_CTX = P1_KQT_LAT + (size_t)NB * 3072 * L * 2;
constexpr size_t P1_G = P1_KQT_CTX + (size_t)NB * 3072 * LC * 2;
static_assert(P1_G + (size_t)TL * 1024 * 2 <= P_BYTES, "P region (layer 1)");
constexpr size_t WS_M = al256(WS_P + P_BYTES);
constexpr size_t WS_IDX = al256(WS_M + (size_t)T * 1024 * 2);
constexpr size_t WS_GATE = al256(WS_IDX + (size_t)T * 128 * 4);
constexpr size_t WS_UV = al256(WS_GATE + (size_t)T * 128 * 4);
constexpr size_t WS_S8 = WS_UV + (size_t)2 * 16384 * 1024;
constexpr size_t WS_W = al256(WS_S8 + (size_t)4 * 16384 * 4);
constexpr size_t W_IN0 = 0, W_OUT0 = W_IN0 + (size_t)2304 * 1024 * 2, W_IN1 = W_OUT0 + (size_t)1024 * 1024 * 2,
                 W_OUT1 = W_IN1 + (size_t)5120 * 1024 * 2, W_Q0 = W_OUT1 + (size_t)1024 * 1024 * 2, W_Q1 = W_Q0 + (size_t)2048 * 1024 * 2,
                 W_KEYS = W_Q1 + (size_t)2048 * 1024 * 2, W_BYTES = W_KEYS + (size_t)2 * 8 * 2 * 128 * 128 * 2;
constexpr size_t WS_F = al256(WS_W + W_BYTES);
constexpr size_t F_HRAW_LAT = 0;
constexpr size_t F_HRAW_CTX = F_HRAW_LAT + (size_t)2048 * L * 4;
constexpr size_t F_HF_LAT = F_HRAW_CTX + (size_t)2048 * LC * 4;
constexpr size_t F_HF_CTX = F_HF_LAT + (size_t)1024 * NF_LAT * 8;
constexpr size_t F_HYP_LAT = F_HF_CTX + (size_t)1024 * NF_CTX * 8;
constexpr size_t F_HYP_CTX = F_HYP_LAT + (size_t)(L / 64) * 2048 * 4;
constexpr size_t F_END = F_HYP_CTX + (size_t)(LC / 64) * 2048 * 4;
constexpr size_t F_OF = 0, F_OB = (size_t)TL * 1024 * 2;
constexpr size_t F_BYTES = F_END > 2 * F_OB ? F_END : 2 * F_OB;
constexpr size_t WS_END = al256(WS_F + F_BYTES);

struct Params { const float* in[29]; float* out; unsigned char* ws; int ph_lo, ph_hi; };
enum { I_X = 0, I_C, I_CTX, I_CCTX, I_ADAW, I_ADAB, I_N1G, I_N2G, I_FG, I_ABWIN, I_ABWOUT, I_HYCW, I_HYCB, I_HYW1, I_HYB1, I_HYW2, I_HYB2, I_HYW3,
       I_HYFREQ, I_HYSKIP, I_SINK, I_HGWIN, I_HGWOUT, I_HGLB, I_HGON, I_PWQ, I_PKEYS, I_PU, I_PV };

constexpr int SMEM_BYTES = 147456;

#ifndef HOST_EMU
DEV int tidx() { int t = threadIdx.x; asm volatile("" : "+v"(t)); return t; }
#else
DEV int tidx() { return (int)threadIdx.x; }
#endif
#ifndef HOST_EMU
DEV void lds_barrier() { asm volatile("s_waitcnt lgkmcnt(0)" ::: "memory"); __builtin_amdgcn_s_barrier(); asm volatile("" ::: "memory"); }
#else
DEV void lds_barrier() { __syncthreads(); }
#endif
#ifndef HOST_EMU
typedef __bf16 bf16n2 __attribute__((ext_vector_type(2)));
DEV unsigned pk2(float lo, float hi) { bf16n2 v; v[0] = (__bf16)lo; v[1] = (__bf16)hi; return __builtin_bit_cast(unsigned, v); }
DEV unsigned f2bf(float f) { return (unsigned)__builtin_bit_cast(unsigned short, (__bf16)f); }
#else
DEV unsigned f2bf(float f) { unsigned u = __builtin_bit_cast(unsigned, f); return (u + 0x7fffu + ((u >> 16) & 1u)) >> 16; }
DEV unsigned pk2(float lo, float hi) { return f2bf(lo) | (f2bf(hi) << 16); }
#endif
#ifndef HOST_EMU
template <int B> DEV float dot2_fp4(unsigned w, unsigned xp, float acc) { return __builtin_amdgcn_fdot2_f32_bf16(__builtin_amdgcn_cvt_scalef32_pk_bf16_fp4(w, 1.0f, B), __builtin_bit_cast(bf16n2, xp), acc, false); }
#else
template <int B> DEV float dot2_fp4(unsigned w, unsigned xp, float acc) { const auto f = __builtin_amdgcn_cvt_scalef32_pk_f32_fp4(w, 1.0f, B);
    return fmaf(f[1], __builtin_bit_cast(float, xp & 0xffff0000u), fmaf(f[0], __builtin_bit_cast(float, xp << 16), acc)); }
#endif
DEV float bf2f(unsigned h) { return __builtin_bit_cast(float, (h & 0xffffu) << 16); }
DEV float bflo(unsigned u) { return __builtin_bit_cast(float, u << 16); }
DEV float bfhi(unsigned u) { return __builtin_bit_cast(float, u & 0xffff0000u); }
DEV float silu_f(float x) { return x * __builtin_amdgcn_rcpf(1.f + __expf(-x)); }
DEV float sigmoid_f(float x) { return __builtin_amdgcn_rcpf(1.f + __expf(-x)); }
DEV float wave_sum(float v) {
#pragma unroll
    for (int m = 32; m >= 1; m >>= 1) v += __shfl_xor(v, m);
    return v;
}
DEV int mod_row(int tok) { return tok < TL ? tok / L : NB; }

DEV void p0_mod(const Params& p, int item, unsigned char* smem) {
    const int l = item / 96, col0 = (item % 96) * 64, tid = tidx();
    float* sc = (float*)smem;
    float* red = sc + NR * 1024;
    for (int i = tid; i < NR * 1024; i += NT) { const int r = i >> 10, k = i & 1023; const float c = r < NB ? p.in[I_C][r * 1024 + k] : p.in[I_CCTX][k]; sc[i] = c / (1.f + expf(-c)); }
    __syncthreads();
    const int kq = tid >> 6, col = tid & 63;
    float acc[NR];
#pragma unroll
    for (int r = 0; r < NR; ++r) acc[r] = 0.f;
    const float* w = p.in[I_ADAW] + (size_t)l * 1024 * 6144 + col0 + col;
#pragma unroll 16
    for (int k = kq * 128; k < kq * 128 + 128; ++k) {
        const float wv = w[(size_t)k * 6144];
#pragma unroll
        for (int r = 0; r < NR; ++r) acc[r] += sc[r * 1024 + k] * wv;
    }
#pragma unroll
    for (int r = 0; r < NR; ++r) red[(kq * NR + r) * 64 + col] = acc[r];
    __syncthreads();
    float* mod = (float*)(p.ws + WS_MOD);
    for (int i = tid; i < NR * 64; i += NT) {
        const int r = i >> 6, c = i & 63; float s = 0.f;
        for (int q = 0; q < 8; ++q) s += red[(q * NR + r) * 64 + c];
        mod[((size_t)l * NR + r) * 6144 + col0 + c] = s + p.in[I_ADAB][l * 6144 + col0 + c];
    }
    __syncthreads();
}
DEV void p0_transpose(const float* W, bf16_t* Wt, int N, int tile, unsigned char* smem) {
    float* ts = (float*)smem;
    const int ntn = N / 256, kt = tile / ntn, nt = tile % ntn, k0 = kt * 64, n0 = nt * 256, tid = tidx();
    f32x4 rv[8];
#pragma unroll
    for (int m = 0; m < 8; ++m) { const int i = tid + NT * m, kk = i >> 6, c4 = i & 63; rv[m] = *(const f32x4*)(W + (size_t)(k0 + kk) * N + n0 + c4 * 4); }
#pragma unroll
    for (int m = 0; m < 8; ++m) { const int i = tid + NT * m, kk = i >> 6, c4 = i & 63; *(f32x4*)(ts + kk * 260 + c4 * 4) = rv[m]; }
    __syncthreads();
#pragma unroll
    for (int m = 0; m < 4; ++m) { const int i = tid + NT * m, nn = i >> 3, k8 = i & 7;
        u32x4 o;
#pragma unroll
        for (int e = 0; e < 4; ++e) o[e] = pk2(ts[(k8 * 8 + 2 * e) * 260 + nn], ts[(k8 * 8 + 2 * e + 1) * 260 + nn]);
        *(u32x4*)(Wt + (size_t)(n0 + nn) * 1024 + k0 + k8 * 8) = o; }
    __syncthreads();
}
DEV void p0_convert(const float* src, bf16_t* dst, int item) {
    const int tid = tidx();
#pragma unroll
    for (int i = 0; i < 8; ++i) {
        const size_t e = (size_t)item * 16384 + (size_t)(i * NT + tid) * 4;
        const f32x4 v = *(const f32x4*)(src + e);
        u32x2 o; o[0] = pk2(v[0], v[1]); o[1] = pk2(v[2], v[3]);
        *(u32x2*)(dst + e) = o;
    }
}
typedef float f32x2 __attribute__((ext_vector_type(2)));
typedef float f32x32 __attribute__((ext_vector_type(32)));
typedef unsigned u32x6 __attribute__((ext_vector_type(6)));
DEV void p0_table(const Params& p, int tab, int item) {
    const int lane = tidx() & 63, li = lane & 31, half = lane >> 5, layer = tab >> 1, isv = tab & 1;
#pragma unroll 1
    for (int pass = 0; pass < 2; ++pass) {
        const int row = item * 32 + pass * 16 + (tidx() >> 6) * 2 + half;
        const float* src = (isv ? p.in[I_PV] : p.in[I_PU]) + ((size_t)layer * 16384 + row) * 1024 + li * 32;
        f32x4 v[8]; float mx = 0.f;
#pragma unroll
        for (int i = 0; i < 8; ++i) { v[i] = *(const f32x4*)(src + 4 * i); mx = fmaxf(mx, fmaxf(fmaxf(fabsf(v[i][0]), fabsf(v[i][1])), fmaxf(fabsf(v[i][2]), fabsf(v[i][3])))); }
#pragma unroll
        for (int m = 16; m >= 1; m >>= 1) mx = fmaxf(mx, __shfl_xor(mx, m));
        const float top = 6.f;
        const float sc = mx > 0.f ? top / mx : 1.f;
        {
            const f32x2 pr4 = __builtin_amdgcn_cvt_scalef32_pk_f32_fp4(__builtin_amdgcn_cvt_scalef32_pk_fp4_f32(0u, 1.0f, 0.0f, 1.0f, 0), 1.0f, 0);
            const bool swp = pr4[0] != 1.0f;
            u32x4 w;
#pragma unroll
            for (int d = 0; d < 4; ++d) { unsigned x = 0u;
                x = __builtin_amdgcn_cvt_scalef32_pk_fp4_f32(x, (swp ? v[2 * d][1] : v[2 * d][0]) * sc, (swp ? v[2 * d][0] : v[2 * d][1]) * sc, 1.0f, 0);
                x = __builtin_amdgcn_cvt_scalef32_pk_fp4_f32(x, (swp ? v[2 * d][3] : v[2 * d][2]) * sc, (swp ? v[2 * d][2] : v[2 * d][3]) * sc, 1.0f, 1);
                x = __builtin_amdgcn_cvt_scalef32_pk_fp4_f32(x, (swp ? v[2 * d + 1][1] : v[2 * d + 1][0]) * sc, (swp ? v[2 * d + 1][0] : v[2 * d + 1][1]) * sc, 1.0f, 2);
                x = __builtin_amdgcn_cvt_scalef32_pk_fp4_f32(x, (swp ? v[2 * d + 1][3] : v[2 * d + 1][2]) * sc, (swp ? v[2 * d + 1][2] : v[2 * d + 1][3]) * sc, 1.0f, 3);
                w[d] = x; }
            *(u32x4*)(p.ws + WS_UV + ((size_t)layer * 16384 + row) * 1024 + isv * 512 + li * 16) = w;
        }
        if (li == 0) ((float*)(p.ws + WS_S8))[tab * 16384 + row] = mx > 0.f ? mx / top : 1.f;
    }
}
DEV void p0_filter(const Params& p, int set, int chunk, int cb, unsigned char* smem) {
    const int Ls = set ? LC : L, l0 = chunk * 64, tid = tidx();
    float* z = (float*)smem;
    float* hd1 = z + 64 * 34;
    float* hd2 = hd1 + 64 * 65;
    const float* w1 = p.in[I_HYW1]; const float* b1 = p.in[I_HYB1]; const float* w2 = p.in[I_HYW2]; const float* b2 = p.in[I_HYB2];
    const float* w3 = p.in[I_HYW3]; const float* fq = p.in[I_HYFREQ];
    for (int i = tid; i < 64 * 33; i += NT) {
        const int pp = i / 33, f = i % 33, l = l0 + pp; float val;
        if (f == 0) val = (float)l / (float)(Ls - 1);
        else { const int jb = (f - 1) & 15; const float fj = 1e-4f + (float)jb * ((15.f - 1e-4f) / 15.f); const float a = fj * (6.283185307179586f * (float)l / (float)Ls); val = f <= 16 ? __cosf(a) : -__sinf(a); }
        z[pp * 34 + f] = val;
    }
    __syncthreads();
    {
        const int j = tid & 63, p0 = tid >> 6;
        float wc[64], acc[8];
#pragma unroll
        for (int f = 0; f < 33; ++f) wc[f] = w1[f * 64 + j];
#pragma unroll
        for (int m = 0; m < 8; ++m) { float sacc = b1[j];
#pragma unroll
            for (int f = 0; f < 33; ++f) sacc = fmaf(z[(p0 + 8 * m) * 34 + f], wc[f], sacc);
            acc[m] = sacc; }
#pragma unroll
        for (int m = 0; m < 8; ++m) hd1[(p0 + 8 * m) * 65 + j] = __sinf(fq[j] * acc[m]);
        __syncthreads();
#pragma unroll
        for (int f = 0; f < 64; ++f) wc[f] = w2[f * 64 + j];
#pragma unroll
        for (int m = 0; m < 8; ++m) { float sacc = b2[j];
#pragma unroll
            for (int f = 0; f < 64; ++f) sacc = fmaf(hd1[(p0 + 8 * m) * 65 + f], wc[f], sacc);
            acc[m] = sacc; }
#pragma unroll
        for (int m = 0; m < 8; ++m) hd2[(p0 + 8 * m) * 65 + j] = __sinf(fq[j] * acc[m]);
        __syncthreads();
    }
    const float max_decay = -15.350567286626973f, min_decay = -3.0701134573253945f;
    float* hraw = (float*)(p.ws + WS_F + (set ? F_HRAW_CTX : F_HRAW_LAT));
    float* hyn = (float*)(p.ws + WS_F + (set ? F_HYP_CTX : F_HYP_LAT)) + (size_t)chunk * 2048;
    {
        const int o = cb * NT + tid;
        const int c = o & 511; const float delta = fabsf(min_decay + (float)c * ((max_decay - min_decay) / 511.f));
        float asum = 0.f;
        float* dst = hraw + (size_t)o * Ls + l0;
        for (int ph = 0; ph < 2; ++ph) {
            float acc[32];
#pragma unroll
            for (int pp = 0; pp < 32; ++pp) acc[pp] = 0.f;
#pragma unroll 1
            for (int j0 = 0; j0 < 64; j0 += 16) {
                float wv[16];
#pragma unroll
                for (int j = 0; j < 16; ++j) wv[j] = w3[(j0 + j) * 2048 + o];
#pragma unroll
                for (int j = 0; j < 16; ++j) {
#pragma unroll
                    for (int pp = 0; pp < 32; ++pp) acc[pp] = fmaf(hd2[(ph * 32 + pp) * 65 + j0 + j], wv[j], acc[pp]);
                    SCHED_FENCE();
                }
            }
#pragma unroll
            for (int q4 = 0; q4 < 8; ++q4) {
                f32x4 v;
#pragma unroll
                for (int e = 0; e < 4; ++e) { const int pp = q4 * 4 + e; const float tl = (float)(l0 + ph * 32 + pp) / (float)(Ls - 1); const float val = acc[pp] * expf(-tl * delta); v[e] = val; asum += fabsf(val); }
                *(f32x4*)(dst + ph * 32 + q4 * 4) = v;
            }
        }
        hyn[o] = asum;
    }
    __syncthreads();
}

constexpr int P0_MOD = 192, P0_TR_IN0 = 16 * 9, P0_TR_OUT0 = 64, P0_TR_IN1 = 16 * 20, P0_TR_OUT1 = 64, P0_TR_Q = 16 * 8, P0_KEYS = 32, P0_TAB = 512,
              P0_FILT = 4 * (L / 64 + LC / 64);
DEV void phase0(const Params& p, unsigned char* smem) {
    bf16_t* W = (bf16_t*)(p.ws + WS_W);
    const int total = P0_MOD + P0_FILT + P0_TR_IN0 + P0_TR_OUT0 + P0_TR_IN1 + P0_TR_OUT1 + 2 * P0_TR_Q + P0_KEYS;
    for (int it = blockIdx.x; it < total; it += gridDim.x) {
        int i = it;
        if (i < P0_MOD) { p0_mod(p, i, smem); continue; } i -= P0_MOD;
        if (i < P0_FILT) { const int ch = i >> 2, cb = i & 3; if (ch < L / 64) p0_filter(p, 0, ch, cb, smem); else p0_filter(p, 1, ch - L / 64, cb, smem); continue; } i -= P0_FILT;
        if (i < P0_TR_IN0) { p0_transpose(p.in[I_ABWIN], W + W_IN0 / 2, 2304, i, smem); continue; } i -= P0_TR_IN0;
        if (i < P0_TR_OUT0) { p0_transpose(p.in[I_ABWOUT], W + W_OUT0 / 2, 1024, i, smem); continue; } i -= P0_TR_OUT0;
        if (i < P0_TR_IN1) { p0_transpose(p.in[I_HGWIN], W + W_IN1 / 2, 5120, i, smem); continue; } i -= P0_TR_IN1;
        if (i < P0_TR_OUT1) { p0_transpose(p.in[I_HGWOUT], W + W_OUT1 / 2, 1024, i, smem); continue; } i -= P0_TR_OUT1;
        if (i < P0_TR_Q) { p0_transpose(p.in[I_PWQ], W + W_Q0 / 2, 2048, i, smem); continue; } i -= P0_TR_Q;
        if (i < P0_TR_Q) { p0_transpose(p.in[I_PWQ] + (size_t)1024 * 2048, W + W_Q1 / 2, 2048, i, smem); continue; } i -= P0_TR_Q;
        p0_convert(p.in[I_PKEYS], W + W_KEYS / 2, i);
    }
}

DEV const float* h_row(const Params& p, int layer_src_inputs, int tok) {
    if (layer_src_inputs) return tok < TL ? p.in[I_X] + (size_t)tok * 1024 : p.in[I_CTX] + (size_t)(tok - TL) * 1024;
    return (const float*)(p.ws + WS_H) + (size_t)tok * 1024;
}
DEV void norm_row_store(const Params& p, const f32x4 (&v)[4], int tok, const float* g, int layer, int sh_off, int lane) {
    float ss = 0.f;
#pragma unroll
    for (int i = 0; i < 4; ++i) ss += v[i][0] * v[i][0] + v[i][1] * v[i][1] + v[i][2] * v[i][2] + v[i][3] * v[i][3];
    ss = wave_sum(ss);
    const float rstd = rsqrtf(ss * (1.f / 1024.f) + 1e-6f);
    const float* mod = (const float*)(p.ws + WS_MOD) + ((size_t)layer * NR + mod_row(tok)) * 6144 + sh_off;
    bf16_t* A = (bf16_t*)(p.ws + WS_A) + (size_t)tok * 1024;
#pragma unroll
    for (int i = 0; i < 4; ++i) {
        const int c = i * 256 + lane * 4;
        const f32x4 gg = *(const f32x4*)(g + c), sh = *(const f32x4*)(mod + c), sc = *(const f32x4*)(mod + 1024 + c);
        u32x2 o;
        o[0] = pk2(v[i][0] * rstd * gg[0] * (1.f + sc[0]) + sh[0], v[i][1] * rstd * gg[1] * (1.f + sc[1]) + sh[1]);
        o[1] = pk2(v[i][2] * rstd * gg[2] * (1.f + sc[2]) + sh[2], v[i][3] * rstd * gg[3] * (1.f + sc[3]) + sh[3]);
        *(u32x2*)(A + c) = o;
    }
}
DEV void norm_rows_item(const Params& p, int item, int from_inputs, const float* g, int layer, int sh_off) {
    const int tok = item * 8 + (tidx() >> 6), lane = tidx() & 63;
    const float* src = h_row(p, from_inputs, tok);
    f32x4 v[4];
#pragma unroll
    for (int i = 0; i < 4; ++i) v[i] = *(const f32x4*)(src + i * 256 + lane * 4);
    norm_row_store(p, v, tok, g, layer, sh_off, lane);
}

DEV cf2 cmul(cf2 a, cf2 b) { cf2 r; r.x = a.x * b.x - a.y * b.y; r.y = a.x * b.y + a.y * b.x; return r; }
DEV cf2 twid(int k, float invN) { cf2 r; const float a = (float)k * invN; r.x = __builtin_amdgcn_cosf(a); r.y = -__builtin_amdgcn_sinf(a); return r; }
DEV int fsw(int i) { return i ^ ((i >> 4) & 15) ^ (((i >> 8) & 1) << 4); }
DEV void bfly4_fwd(cf2& a0, cf2& a1, cf2& a2, cf2& a3) {
    cf2 t0, t1, t2, t3; t0.x = a0.x + a2.x; t0.y = a0.y + a2.y; t1.x = a0.x - a2.x; t1.y = a0.y - a2.y; t2.x = a1.x + a3.x; t2.y = a1.y + a3.y;
    const float dx = a1.x - a3.x, dy = a1.y - a3.y; t3.x = dy; t3.y = -dx;
    a0.x = t0.x + t2.x; a0.y = t0.y + t2.y; a1.x = t1.x + t3.x; a1.y = t1.y + t3.y; a2.x = t0.x - t2.x; a2.y = t0.y - t2.y; a3.x = t1.x - t3.x; a3.y = t1.y - t3.y;
}
DEV void bfly4_inv(cf2& c0, cf2& c1, cf2& c2, cf2& c3) {
    cf2 t0, t1, t2, t3; t0.x = c0.x + c2.x; t0.y = c0.y + c2.y; t1.x = c0.x - c2.x; t1.y = c0.y - c2.y; t2.x = c1.x + c3.x; t2.y = c1.y + c3.y;
    const float dx = c1.x - c3.x, dy = c1.y - c3.y; t3.x = -dy; t3.y = dx;
    c0.x = t0.x + t2.x; c0.y = t0.y + t2.y; c1.x = t1.x + t3.x; c1.y = t1.y + t3.y; c2.x = t0.x - t2.x; c2.y = t0.y - t2.y; c3.x = t1.x - t3.x; c3.y = t1.y - t3.y;
}
DEV void fft_stage4(cf2* buf, int S, int s, int g, int G, bool inv) {
    const int N = 1 << (2 * S); const float invN = 1.f / (float)N;
    const int lm = 2 * (S - s), m = 1 << lm, q = m >> 2;
    for (int bf = g; bf < (N >> 2); bf += G) {
        const int j = bf & (q - 1), base = ((bf >> (lm - 2)) << lm) + j, tw = j << (2 * s);
        cf2 a0 = buf[fsw(base)], a1 = buf[fsw(base + q)], a2 = buf[fsw(base + 2 * q)], a3 = buf[fsw(base + 3 * q)];
        if (!inv) { bfly4_fwd(a0, a1, a2, a3); a1 = cmul(a1, twid(tw, invN)); a2 = cmul(a2, twid(2 * tw, invN)); a3 = cmul(a3, twid(3 * tw, invN)); }
        else { cf2 w1 = twid(tw, invN), w2 = twid(2 * tw, invN), w3 = twid(3 * tw, invN); w1.y = -w1.y; w2.y = -w2.y; w3.y = -w3.y; a1 = cmul(a1, w1); a2 = cmul(a2, w2); a3 = cmul(a3, w3); bfly4_inv(a0, a1, a2, a3); }
        buf[fsw(base)] = a0; buf[fsw(base + q)] = a1; buf[fsw(base + 2 * q)] = a2; buf[fsw(base + 3 * q)] = a3;
    }
}
DEV void fft_stage16(cf2* buf, int S, int s, int g, int G, bool inv) {
    const int N = 1 << (2 * S); const float invN = 1.f / (float)N;
    const int lm = 2 * (S - s), m = 1 << lm, q = m >> 2, q2 = q >> 2;
    for (int u = g; u < (N >> 4); u += G) {
        const int j2 = u & (q2 - 1), base = ((u >> (lm - 4)) << lm) + j2;
        cf2 x[4][4];
#pragma unroll
        for (int c = 0; c < 4; ++c)
#pragma unroll
            for (int c2 = 0; c2 < 4; ++c2) x[c][c2] = buf[fsw(base + c * q + c2 * q2)];
        if (!inv) {
#pragma unroll
            for (int c2 = 0; c2 < 4; ++c2) {
                const int tw = (j2 + c2 * q2) << (2 * s);
                bfly4_fwd(x[0][c2], x[1][c2], x[2][c2], x[3][c2]);
                x[1][c2] = cmul(x[1][c2], twid(tw, invN)); x[2][c2] = cmul(x[2][c2], twid(2 * tw, invN)); x[3][c2] = cmul(x[3][c2], twid(3 * tw, invN));
                SCHED_FENCE();
            }
            const int tw2 = j2 << (2 * (s + 1));
            const cf2 v1 = twid(tw2, invN), v2 = twid(2 * tw2, invN), v3 = twid(3 * tw2, invN);
#pragma unroll
            for (int c = 0; c < 4; ++c) {
                bfly4_fwd(x[c][0], x[c][1], x[c][2], x[c][3]);
                x[c][1] = cmul(x[c][1], v1); x[c][2] = cmul(x[c][2], v2); x[c][3] = cmul(x[c][3], v3);
            }
        } else {
            const int tw2 = j2 << (2 * (s + 1));
            cf2 v1 = twid(tw2, invN), v2 = twid(2 * tw2, invN), v3 = twid(3 * tw2, invN); v1.y = -v1.y; v2.y = -v2.y; v3.y = -v3.y;
#pragma unroll
            for (int c = 0; c < 4; ++c) {
                x[c][1] = cmul(x[c][1], v1); x[c][2] = cmul(x[c][2], v2); x[c][3] = cmul(x[c][3], v3);
                bfly4_inv(x[c][0], x[c][1], x[c][2], x[c][3]);
            }
#pragma unroll
            for (int c2 = 0; c2 < 4; ++c2) {
                const int tw = (j2 + c2 * q2) << (2 * s);
                cf2 w1 = twid(tw, invN), w2 = twid(2 * tw, invN), w3 = twid(3 * tw, invN); w1.y = -w1.y; w2.y = -w2.y; w3.y = -w3.y;
                x[1][c2] = cmul(x[1][c2], w1); x[2][c2] = cmul(x[2][c2], w2); x[3][c2] = cmul(x[3][c2], w3);
                bfly4_inv(x[0][c2], x[1][c2], x[2][c2], x[3][c2]);
                SCHED_FENCE();
            }
        }
#pragma unroll
        for (int c = 0; c < 4; ++c)
#pragma unroll
            for (int c2 = 0; c2 < 4; ++c2) buf[fsw(base + c * q + c2 * q2)] = x[c][c2];
    }
}
DEV void fft_fwd(cf2* buf, int S, int g, int G) {
    int s = 0;
    for (; s + 1 < S; s += 2) { fft_stage16(buf, S, s, g, G, false); __syncthreads(); }
    if (s < S) { fft_stage4(buf, S, s, g, G, false); __syncthreads(); }
}
DEV void fft_inv(cf2* buf, int S, int g, int G) {
    int s = S - 1;
    if (S & 1) { fft_stage4(buf, S, s, g, G, true); __syncthreads(); --s; }
    for (; s >= 1; s -= 2) { fft_stage16(buf, S, s - 1, g, G, true); __syncthreads(); }
}
DEV void hf_item(const Params& p, int set, int pi, unsigned char* smem) {
    const int Ls = set ? LC : L, S = set ? FS_CTX : FS_LAT, N = 1 << (2 * S);
    const int gi = tidx() >> 8, g = tidx() & 255, idx = pi * 2 + gi, o = idx >> 9, c = idx & 511;
    cf2* buf = (cf2*)smem + (size_t)gi * N;
    const float* hraw = (const float*)(p.ws + WS_F + (set ? F_HRAW_CTX : F_HRAW_LAT));
    const float* hyn = (const float*)(p.ws + WS_F + (set ? F_HYP_CTX : F_HYP_LAT));
    float nsum = 0.f;
    for (int ch = 0; ch < Ls / 64; ++ch) nsum += hyn[(size_t)ch * 2048 + o * 1024 + c] + hyn[(size_t)ch * 2048 + o * 1024 + 512 + c];
    const float inv = 1.f / nsum;
    const float* hf = hraw + (size_t)(o * 1024 + c) * Ls; const float* hb = hraw + (size_t)(o * 1024 + 512 + c) * Ls;
#pragma unroll 4
    for (int k = g; k < N; k += 256) { float re = 0.f; if (k < Ls) re = hf[k] * inv; else if (k > N - Ls) re = hb[N - k] * inv; cf2 v; v.x = re; v.y = 0.f; buf[fsw(k)] = v; }
    __syncthreads();
    fft_fwd(buf, S, g, 256);
    cf2* HF = (cf2*)(p.ws + WS_F + (set ? F_HF_CTX : F_HF_LAT)) + (size_t)(o * 512 + c) * N;
    for (int k = g; k < N; k += 256) HF[k] = buf[fsw(k)];
    __syncthreads();
}
constexpr int P1_NORM = T / 8, P1_HF = 512;
DEV void phase1(const Params& p, unsigned char* smem) {
    const int total = P1_NORM + 2 * P1_HF;
    for (int it = blockIdx.x; it < total; it += gridDim.x) {
        if (it < P1_NORM) norm_rows_item(p, it, 1, p.in[I_N1G], 0, 0);
        else if (it < P1_NORM + P1_HF) hf_item(p, 0, it - P1_NORM, smem);
        else hf_item(p, 1, it - P1_NORM - P1_HF, smem);
    }
}

constexpr int G_LDA = 72;
template <class Epi>
DEV void gemm_tile(const bf16_t* __restrict__ A, const bf16_t* __restrict__ Wt, int m0, int n0, unsigned char* smem, const Epi& epi, int var = 0) {
    bf16_t* As = (bf16_t*)smem;
    bf16_t* Bs = As + 2 * 256 * G_LDA;
    const int tid = tidx(), lane = tid & 63, w = tid >> 6, wm = w >> 1, wn = w & 1;
    f32x16 acc[2][2];
#pragma unroll
    for (int i = 0; i < 2; ++i)
#pragma unroll
        for (int j = 0; j < 2; ++j)
#pragma unroll
            for (int r = 0; r < 16; ++r) acc[i][j][r] = 0.f;
    u32x4 ra[4], rb[2];
    const bf16_t* Ag = A + (size_t)m0 * 1024; const bf16_t* Bg = Wt + (size_t)n0 * 1024;
#define GLOAD(k0) do { \
        _Pragma("unroll") for (int i = 0; i < 4; ++i) { const int id = tid + NT * i, row = id >> 3, kc = id & 7; ra[i] = *(const u32x4*)(Ag + (size_t)row * 1024 + (k0) + kc * 8); } \
        _Pragma("unroll") for (int i = 0; i < 2; ++i) { const int id = tid + NT * i, row = id >> 3, kc = id & 7; rb[i] = *(const u32x4*)(Bg + (size_t)row * 1024 + (k0) + kc * 8); } } while (0)
#define LSTORE(buf_) do { \
        _Pragma("unroll") for (int i = 0; i < 4; ++i) { const int id = tid + NT * i, row = id >> 3, kc = id & 7; *(u32x4*)(As + ((buf_) * 256 + row) * G_LDA + kc * 8) = ra[i]; } \
        _Pragma("unroll") for (int i = 0; i < 2; ++i) { const int id = tid + NT * i, row = id >> 3, kc = id & 7; *(u32x4*)(Bs + ((buf_) * 128 + row) * G_LDA + kc * 8) = rb[i]; } } while (0)
    GLOAD(0); LSTORE(0); __syncthreads();
    for (int kt = 0; kt < (var == 2 ? 1 : 16); ++kt) {
        const int buf = kt & 1;
        if (kt + 1 < 16) GLOAD((kt + 1) * 64);
        const bf16_t* as = As + (buf * 256 + wm * 64 + (lane & 31)) * G_LDA + 8 * (lane >> 5);
        const bf16_t* bs = Bs + (buf * 128 + wn * 64 + (lane & 31)) * G_LDA + 8 * (lane >> 5);
#pragma unroll
        for (int kk = 0; kk < 4; ++kk) {
            const bf16x8 a0 = *(const bf16x8*)(as + kk * 16), a1 = *(const bf16x8*)(as + 32 * G_LDA + kk * 16);
            const bf16x8 b0 = *(const bf16x8*)(bs + kk * 16), b1 = *(const bf16x8*)(bs + 32 * G_LDA + kk * 16);
            acc[0][0] = __builtin_amdgcn_mfma_f32_32x32x16_bf16(a0, b0, acc[0][0], 0, 0, 0);
            acc[0][1] = __builtin_amdgcn_mfma_f32_32x32x16_bf16(a0, b1, acc[0][1], 0, 0, 0);
            acc[1][0] = __builtin_amdgcn_mfma_f32_32x32x16_bf16(a1, b0, acc[1][0], 0, 0, 0);
            acc[1][1] = __builtin_amdgcn_mfma_f32_32x32x16_bf16(a1, b1, acc[1][1], 0, 0, 0);
        }
        if (kt + 1 < 16) LSTORE(buf ^ 1);
        __syncthreads();
    }
#ifndef HOST_EMU
    if (var == 1) { asm volatile("" :: "v"(acc[0][0]), "v"(acc[0][1]), "v"(acc[1][0]), "v"(acc[1][1])); return; }
#endif
#pragma unroll
    for (int mi = 0; mi < 2; ++mi)
#pragma unroll
        for (int ni = 0; ni < 2; ++ni)
#pragma unroll
            for (int rg = 0; rg < 4; ++rg) {
                const int row = m0 + wm * 64 + mi * 32 + 8 * rg + 4 * (lane >> 5), col = n0 + wn * 64 + ni * 32 + (lane & 31);
                epi(row, col, acc[mi][ni][rg * 4 + 0], acc[mi][ni][rg * 4 + 1], acc[mi][ni][rg * 4 + 2], acc[mi][ni][rg * 4 + 3]);
            }
}
template <class Epi>
DEV void gemm_tile256(const bf16_t* __restrict__ A, const bf16_t* __restrict__ Wt, int m0, int n0, unsigned char* smem, const Epi& epi) {
    bf16_t* As = (bf16_t*)smem;
    bf16_t* Bs = As + 2 * 256 * G_LDA;
    const int tid = tidx(), lane = tid & 63, w = tid >> 6, wm = w >> 2, wn = w & 3;
    f32x16 acc[4][2];
#pragma unroll
    for (int i = 0; i < 4; ++i)
#pragma unroll
        for (int j = 0; j < 2; ++j)
#pragma unroll
            for (int r = 0; r < 16; ++r) acc[i][j][r] = 0.f;
    u32x4 ra[4], rb[4];
    const bf16_t* Ag = A + (size_t)m0 * 1024; const bf16_t* Bg = Wt + (size_t)n0 * 1024;
#define GLOAD2(k0) do { \
        _Pragma("unroll") for (int i = 0; i < 4; ++i) { const int id = tid + NT * i, row = id >> 3, kc = id & 7; ra[i] = *(const u32x4*)(Ag + (size_t)row * 1024 + (k0) + kc * 8); rb[i] = *(const u32x4*)(Bg + (size_t)row * 1024 + (k0) + kc * 8); } } while (0)
#define LSTORE2(buf_) do { \
        _Pragma("unroll") for (int i = 0; i < 4; ++i) { const int id = tid + NT * i, row = id >> 3, kc = id & 7; *(u32x4*)(As + ((buf_) * 256 + row) * G_LDA + kc * 8) = ra[i]; *(u32x4*)(Bs + ((buf_) * 256 + row) * G_LDA + kc * 8) = rb[i]; } } while (0)
    GLOAD2(0); LSTORE2(0); __syncthreads();
    for (int kt = 0; kt < 16; ++kt) {
        const int buf = kt & 1;
        if (kt + 1 < 16) GLOAD2((kt + 1) * 64);
        const bf16_t* as = As + (buf * 256 + wm * 128 + (lane & 31)) * G_LDA + 8 * (lane >> 5);
        const bf16_t* bs = Bs + (buf * 256 + wn * 64 + (lane & 31)) * G_LDA + 8 * (lane >> 5);
#pragma unroll
        for (int kk = 0; kk < 4; ++kk) {
            bf16x8 af[4], bfr[2];
#pragma unroll
            for (int i = 0; i < 4; ++i) af[i] = *(const bf16x8*)(as + i * 32 * G_LDA + kk * 16);
#pragma unroll
            for (int j = 0; j < 2; ++j) bfr[j] = *(const bf16x8*)(bs + j * 32 * G_LDA + kk * 16);
#pragma unroll
            for (int i = 0; i < 4; ++i)
#pragma unroll
                for (int j = 0; j < 2; ++j) acc[i][j] = __builtin_amdgcn_mfma_f32_32x32x16_bf16(af[i], bfr[j], acc[i][j], 0, 0, 0);
        }
        if (kt + 1 < 16) LSTORE2(buf ^ 1);
        __syncthreads();
    }
#undef GLOAD2
#undef LSTORE2
#pragma unroll
    for (int mi = 0; mi < 4; ++mi)
#pragma unroll
        for (int ni = 0; ni < 2; ++ni)
#pragma unroll
            for (int rg = 0; rg < 4; ++rg) {
                const int row = m0 + wm * 128 + mi * 32 + 8 * rg + 4 * (lane >> 5), col = n0 + wn * 64 + ni * 32 + (lane & 31);
                epi(row, col, acc[mi][ni][rg * 4 + 0], acc[mi][ni][rg * 4 + 1], acc[mi][ni][rg * 4 + 2], acc[mi][ni][rg * 4 + 3]);
            }
}
namespace pg8 {
#ifndef HOST_EMU
#define PG8_LAS __attribute__((address_space(3)))
#else
#define PG8_LAS
#endif
typedef unsigned short bf16_t;
constexpr int BM = 256, BK = 64, HALF = 128, HTB = HALF * BK * 2  , STAGE_BYTES = 8 * HTB, NXCD = 8, WGM = 8;

__host__ __device__ __forceinline__ int lds_byte(int r, int c) { const int st = (r >> 4) * 2 + (c >> 5), rr = r & 15, cc = c & 31, ob = rr * 64 + cc * 2; return st * 1024 + (ob ^ (((ob >> 9) & 1) << 5)); }
__host__ __device__ __forceinline__ void stage_rc(int b, int& R, int& C) { const int st = b / 1024, sb = b % 1024, swz = sb ^ (((sb >> 9) & 1) << 5); R = (st >> 1) * 16 + swz / 64; C = (st & 1) * 32 + (swz % 64) / 2; }
__host__ __device__ __forceinline__ int perm32(int rho) { const int n = rho >> 4, i = rho & 15; return 8 * (i >> 2) + 4 * n + (i & 3); }

struct Unit { int pm, pn; };
struct Gemm { const bf16_t* A; const bf16_t* Bt; int M, N, K; };

struct StaticOrder {
    int nM, nN, nwg, G, c;
    __host__ __device__ void init(int M, int N, int G_, int c_) { nM = M / BM; nN = N / BM; nwg = nM * nN; G = G_; c = c_; }
    __host__ __device__ bool next(int i, Unit& u) const {
        const long L = (long)i * G + c; if (L >= nwg) return false;
        int wgid = (int)L; { const int q = nwg / NXCD, r = nwg % NXCD, xcd = wgid % NXCD, off = wgid / NXCD; wgid = (xcd < r ? xcd * (q + 1) : r * (q + 1) + (xcd - r) * q) + off; }
        const int nig = WGM * nN, gid = wgid / nig, fm = gid * WGM, gsz = (nM - fm) < WGM ? (nM - fm) : WGM;
        u.pm = fm + ((wgid % nig) % gsz); u.pn = (wgid % nig) / gsz; return true;
    }
    __device__ __forceinline__ void a_ready(const Unit&) const {}
    __device__ __forceinline__ void done(const Unit&) const {}
};
template <class Epi, class Sched, bool STAMP = false>
__device__ __forceinline__ void gemm_phase(PG8_LAS unsigned char* lds, const Gemm g, const Sched& S, const Epi& E, unsigned long long* stamps = nullptr) {
    const int tid = tidx(), wid = __builtin_amdgcn_readfirstlane(tid >> 6), lane = tid & 63, wr = wid >> 2, wc = wid & 3, fr = lane & 15, fq = lane >> 4;
    const int K = g.K, nt = K / BK;
    int ts_lo = 0, ts_hi = 0, nts = 0; const unsigned long long rt_entry = 0ull; (void)rt_entry; (void)ts_lo; (void)ts_hi; (void)nts;
#define PG8_STAMP() do { if (STAMP && wid == 0 && nts < 64) { const unsigned long long _c = 0ull; \
        ts_lo = (lane == nts) ? (int)(unsigned)_c : ts_lo; ts_hi = (lane == nts) ? (int)(unsigned)(_c >> 32) : ts_hi; ++nts; } } while (0)
    PG8_STAMP();
    unsigned voffA[2], voffB[2];
#pragma unroll
    for (int i = 0; i < 2; ++i) { int R, C; stage_rc(tid * 16 + i * 8192, R, C); const int Rb = Epi::PERM ? ((R & ~31) + perm32(R & 31)) : R;
        voffA[i] = (unsigned)(R * K + C) * 2u; voffB[i] = (unsigned)(Rb * K + C) * 2u; }
    const size_t kstep = (size_t)(BK * 2);
    const size_t hstep = (size_t)HALF * K * 2;
    const size_t tstep = 2 * hstep;
    const unsigned ldsw = (unsigned)wid * 1024u;
    const int aoff = lds_byte(wr * 64 + fr, fq * 8), boff = lds_byte(wc * 32 + fr, fq * 8);
#define PG8_SA(b, h) (((b) * 2 + (h)) * HTB)
#define PG8_SB(b, h) ((4 + (b) * 2 + (h)) * HTB)
#define PG8_STAGE(bufoff, gbase, voff) do { _Pragma("unroll") for (int _i = 0; _i < 2; ++_i) \
        __builtin_amdgcn_global_load_lds((const unsigned*)((const char*)(gbase) + (voff)[_i]), (PG8_LAS unsigned*)(lds + (bufoff) + ldsw + _i * 8192), 16, 0, 0); } while (0)
#define PG8_LDA(dst, b, h) do { _Pragma("unroll") for (int m = 0; m < 4; ++m) _Pragma("unroll") for (int k = 0; k < 2; ++k) dst[m][k] = *(const PG8_LAS bf16x8*)(lds + PG8_SA(b, h) + aoff + m * 2048 + k * 1024); } while (0)
#define PG8_LDB(dst, b, h) do { _Pragma("unroll") for (int n = 0; n < 2; ++n) _Pragma("unroll") for (int k = 0; k < 2; ++k) dst[n][k] = *(const PG8_LAS bf16x8*)(lds + PG8_SB(b, h) + boff + n * 2048 + k * 1024); } while (0)
#define PG8_MMA(ai, bj, At, Bt) do { __builtin_amdgcn_s_setprio(1); _Pragma("unroll") for (int m = 0; m < 4; ++m) _Pragma("unroll") for (int n = 0; n < 2; ++n) _Pragma("unroll") for (int k = 0; k < 2; ++k) \
        acc[ai][bj][m][n] = __builtin_amdgcn_mfma_f32_16x16x32_bf16(Bt[n][k], At[m][k], acc[ai][bj][m][n], 0, 0, 0); __builtin_amdgcn_s_setprio(0); } while (0)
#ifndef HOST_EMU
#define PG8_WAIT_V(n) asm volatile("s_waitcnt vmcnt(" #n ")" ::: "memory")
#define PG8_WAIT_L(n) asm volatile("s_waitcnt lgkmcnt(" #n ")" ::: "memory")
#else
#define PG8_WAIT_V(n) do {} while (0)
#define PG8_WAIT_L(n) do {} while (0)
#endif
#define PG8_BAR __builtin_amdgcn_s_barrier()
#define PG8_SCHED __builtin_amdgcn_sched_barrier(0)
    Unit cur, nxt; int ui = 0;
    if (!S.next(0, cur)) return;
    f32x4 acc[2][2][4][2];
#pragma unroll
    for (int a = 0; a < 2; ++a)
#pragma unroll
        for (int b = 0; b < 2; ++b)
#pragma unroll
            for (int m = 0; m < 4; ++m)
#pragma unroll
                for (int n = 0; n < 2; ++n) acc[a][b][m][n] = (f32x4){0.f, 0.f, 0.f, 0.f};
    bf16x8 At[4][2], B0[2][2], B1[2][2];
    const char* cA = (const char*)g.A + (size_t)cur.pm * tstep; const char* cB = (const char*)g.Bt + (size_t)cur.pn * tstep;
    S.a_ready(cur);
    PG8_STAGE(PG8_SB(0, 0), cB, voffB); PG8_STAGE(PG8_SA(0, 0), cA, voffA); PG8_STAGE(PG8_SB(0, 1), cB + hstep, voffB); PG8_STAGE(PG8_SA(0, 1), cA + hstep, voffA);
    if (wr == 1) PG8_BAR;
    PG8_WAIT_V(4); PG8_BAR;
    PG8_STAGE(PG8_SB(1, 0), cB + kstep, voffB); PG8_STAGE(PG8_SA(1, 0), cA + kstep, voffA); PG8_STAGE(PG8_SB(1, 1), cB + hstep + kstep, voffB);
    PG8_WAIT_V(6); PG8_BAR;
    PG8_STAMP();
    for (;;) {
        const bool has_next = S.next(ui + 1, nxt);
        const char* nA = has_next ? (const char*)g.A + (size_t)nxt.pm * tstep : cA; const char* nB = has_next ? (const char*)g.Bt + (size_t)nxt.pn * tstep : cB;
        for (int t = 0; t < nt; t += 2) {
            const bool last = (t == nt - 2);
            const char* a1 = cA + (size_t)(t + 1) * kstep;
            const char* a2 = last ? nA : cA + (size_t)(t + 2) * kstep; const char* b2 = last ? nB : cB + (size_t)(t + 2) * kstep;
            const char* a3 = a2 + kstep; const char* b3 = b2 + kstep;
            if (last && has_next) S.a_ready(nxt);
            PG8_LDB(B0, 0, 0); PG8_SCHED; PG8_LDA(At, 0, 0); PG8_STAGE(PG8_SA(1, 1), a1 + hstep, voffA);
            PG8_WAIT_L(8); PG8_BAR; PG8_WAIT_L(0); PG8_MMA(0, 0, At, B0); PG8_BAR; PG8_SCHED;
            PG8_LDB(B1, 0, 1); PG8_STAGE(PG8_SB(0, 0), b2, voffB);
            PG8_BAR; PG8_WAIT_L(0); PG8_MMA(0, 1, At, B1); PG8_BAR;
            PG8_LDA(At, 0, 1); PG8_STAGE(PG8_SA(0, 0), a2, voffA);
            PG8_BAR; PG8_WAIT_L(0); PG8_MMA(1, 0, At, B0); PG8_BAR; PG8_SCHED;
            PG8_STAGE(PG8_SB(0, 1), b2 + hstep, voffB);
            PG8_WAIT_V(6); PG8_BAR; PG8_MMA(1, 1, At, B1); PG8_BAR;
            PG8_LDB(B0, 1, 0); PG8_SCHED; PG8_LDA(At, 1, 0); PG8_STAGE(PG8_SA(0, 1), a2 + hstep, voffA);
            PG8_WAIT_L(8); PG8_BAR; PG8_WAIT_L(0); PG8_MMA(0, 0, At, B0); PG8_BAR; PG8_SCHED;
            PG8_LDB(B1, 1, 1); PG8_STAGE(PG8_SB(1, 0), b3, voffB);
            PG8_BAR; PG8_WAIT_L(0); PG8_MMA(0, 1, At, B1); PG8_BAR;
            PG8_LDA(At, 1, 1); PG8_STAGE(PG8_SA(1, 0), a3, voffA);
            PG8_BAR; PG8_WAIT_L(0); PG8_MMA(1, 0, At, B0); PG8_BAR; PG8_SCHED;
            PG8_STAGE(PG8_SB(1, 1), b3 + hstep, voffB);
            PG8_WAIT_V(6); PG8_BAR; PG8_MMA(1, 1, At, B1); PG8_BAR;
        }
        PG8_STAMP();
        if constexpr (!Epi::AFTER_DRAIN) { E(acc, cur, wr, wc, fr, fq); S.done(cur); }
        PG8_STAMP();
        if (!has_next) break;
#pragma unroll
        for (int a = 0; a < 2; ++a)
#pragma unroll
            for (int b = 0; b < 2; ++b)
#pragma unroll
                for (int m = 0; m < 4; ++m)
#pragma unroll
                    for (int n = 0; n < 2; ++n) acc[a][b][m][n] = (f32x4){0.f, 0.f, 0.f, 0.f};
        cur = nxt; cA = nA; cB = nB; ++ui;
    }
    PG8_WAIT_V(0);
    if (wr == 0) PG8_BAR;
    PG8_BAR;
    if constexpr (Epi::AFTER_DRAIN) { E.fused(acc, cur, wr, wc, fr, fq, lds, wid, lane); S.done(cur); }
    PG8_STAMP();
    if (STAMP && wid == 0) { stamps[lane] = lane < nts ? (((unsigned long long)(unsigned)ts_hi << 32) | (unsigned)ts_lo) : 0ull;
        if (lane == 62) stamps[62] = rt_entry; if (lane == 63) stamps[63] = 0ull; }
#undef PG8_STAMP
#undef PG8_SA
#undef PG8_SB
#undef PG8_STAGE
#undef PG8_LDA
#undef PG8_LDB
#undef PG8_MMA
#undef PG8_WAIT_V
#undef PG8_WAIT_L
#undef PG8_BAR
#undef PG8_SCHED
}
}
template <class Epi> struct PgEpiT {
    static constexpr bool PERM = true, AFTER_DRAIN = false;
    Epi e;
    DEV void operator()(const f32x4 (&acc)[2][2][4][2], const pg8::Unit& u, int wr, int wc, int fr, int fq) const {
        float pre[2][4];
#pragma unroll
        for (int ai = 0; ai < 2; ++ai)
#pragma unroll
            for (int m = 0; m < 4; ++m) pre[ai][m] = e.colpre(u.pm * 256 + ai * 128 + wr * 64 + m * 16 + fr);
#pragma unroll
        for (int ai = 0; ai < 2; ++ai)
#pragma unroll
            for (int m = 0; m < 4; ++m) {
#pragma unroll
                for (int bj = 0; bj < 2; ++bj) {
                    const int wcol = u.pm * 256 + ai * 128 + wr * 64 + m * 16 + fr, tok0 = u.pn * 256 + bj * 128 + wc * 32 + 8 * fq;
                    const float v[8] = {acc[ai][bj][m][0][0], acc[ai][bj][m][0][1], acc[ai][bj][m][0][2], acc[ai][bj][m][0][3], acc[ai][bj][m][1][0], acc[ai][bj][m][1][1], acc[ai][bj][m][1][2], acc[ai][bj][m][1][3]};
                    e.tok8(tok0, wcol, v, pre[ai][m]);
                }
                SCHED_FENCE();
            }
    }
};
template <class Epi> struct PgEpiN {
    static constexpr bool PERM = true, AFTER_DRAIN = false;
    Epi e;
    DEV void operator()(const f32x4 (&acc)[2][2][4][2], const pg8::Unit& u, int wr, int wc, int fr, int fq) const {
#pragma unroll
        for (int ai = 0; ai < 2; ++ai)
#pragma unroll
            for (int m = 0; m < 4; ++m) {
#pragma unroll
                for (int bj = 0; bj < 2; ++bj) {
                    const int tok = u.pm * 256 + ai * 128 + wr * 64 + m * 16 + fr, wcol0 = u.pn * 256 + bj * 128 + wc * 32 + 8 * fq;
                    const float v[8] = {acc[ai][bj][m][0][0], acc[ai][bj][m][0][1], acc[ai][bj][m][0][2], acc[ai][bj][m][0][3], acc[ai][bj][m][1][0], acc[ai][bj][m][1][1], acc[ai][bj][m][1][2], acc[ai][bj][m][1][3]};
                    e.col8(tok, wcol0, v);
                }
                SCHED_FENCE();
            }
    }
};
template <class Epi>
DEV void gemm_pg8_T(const bf16_t* A, const bf16_t* Wt, int Mtok, int N, unsigned char* smem, const Epi& epi) {
    pg8::Gemm g{Wt, A, N, Mtok, 1024};
    pg8::StaticOrder S; S.init(N, Mtok, (int)gridDim.x, (int)blockIdx.x);
    PgEpiT<Epi> E{epi};
    pg8::gemm_phase<PgEpiT<Epi>, pg8::StaticOrder, false>((PG8_LAS unsigned char*)smem, g, S, E);
    __syncthreads();
}
template <class Epi>
DEV void gemm_pg8_N(const bf16_t* A, const bf16_t* Wt, int Mtok, int N, unsigned char* smem, const Epi& epi) {
    pg8::Gemm g{A, Wt, Mtok, N, 1024};
    pg8::StaticOrder S; S.init(Mtok, N, (int)gridDim.x, (int)blockIdx.x);
    PgEpiN<Epi> E{epi};
    pg8::gemm_phase<PgEpiN<Epi>, pg8::StaticOrder, false>((PG8_LAS unsigned char*)smem, g, S, E);
    __syncthreads();
}
struct EpiL0In {
    unsigned char* ws;
    DEV void operator()(int row, int col, float v0, float v1, float v2, float v3) const {
        u32x2 o; o[0] = pk2(v0, v1); o[1] = pk2(v2, v3);
        const bool lat = row < TL; const int b = lat ? row / L : (row - TL) / LC, t = lat ? row - b * L : (row - TL) - b * LC, Lx = lat ? L : LC;
        const int cu = __builtin_amdgcn_readfirstlane(col & ~127);
        if (cu < 1536) { bf16_t* d = (bf16_t*)(ws + WS_P + (lat ? P_HYT_LAT : P_HYT_CTX)) + ((size_t)b * 1536 + col) * Lx + t; *(u32x2*)d = o; }
        else if (cu < 2048) { bf16_t* d = (bf16_t*)(ws + WS_P + P_Q0) + (size_t)row * 512 + (col - 1536); d[0] = (bf16_t)f2bf(v0); d[512] = (bf16_t)f2bf(v1); d[1024] = (bf16_t)f2bf(v2); d[1536] = (bf16_t)f2bf(v3); }
        else if (cu < 2176) { bf16_t* d = (bf16_t*)(ws + WS_P + P_K0) + (size_t)row * 128 + (col - 2048); d[0] = (bf16_t)f2bf(v0); d[128] = (bf16_t)f2bf(v1); d[256] = (bf16_t)f2bf(v2); d[384] = (bf16_t)f2bf(v3); }
        else { bf16_t* d = (bf16_t*)(ws + WS_P + (lat ? P_VT_LAT : P_VT_CTX)) + ((size_t)b * 128 + (col - 2176)) * Lx + t; *(u32x2*)d = o; }
    }
};
struct EpiL0InT {
    unsigned char* ws;
    DEV float colpre(int) const { return 0.f; }
    DEV void tok8(int row, int col, const float (&v)[8], float) const {
        const bool lat = row < TL; const int b = lat ? row / L : (row - TL) / LC, t = lat ? row - b * L : (row - TL) - b * LC, Lx = lat ? L : LC;
        u32x4 o; o[0] = pk2(v[0], v[1]); o[1] = pk2(v[2], v[3]); o[2] = pk2(v[4], v[5]); o[3] = pk2(v[6], v[7]);
        if (col < 1536) { *(u32x4*)((bf16_t*)(ws + WS_P + (lat ? P_HYT_LAT : P_HYT_CTX)) + ((size_t)b * 1536 + col) * Lx + t) = o; }
        else if (col < 2048) { bf16_t* d = (bf16_t*)(ws + WS_P + P_Q0) + (size_t)row * 512 + (col - 1536);
#pragma unroll
            for (int i = 0; i < 8; ++i) d[i * 512] = (bf16_t)f2bf(v[i]); }
        else if (col < 2176) { bf16_t* d = (bf16_t*)(ws + WS_P + P_K0) + (size_t)row * 128 + (col - 2048);
#pragma unroll
            for (int i = 0; i < 8; ++i) d[i * 128] = (bf16_t)f2bf(v[i]); }
        else { *(u32x4*)((bf16_t*)(ws + WS_P + (lat ? P_VT_LAT : P_VT_CTX)) + ((size_t)b * 128 + (col - 2176)) * Lx + t) = o; }
    }
};
struct EpiBf16 {
    bf16_t* out; int ld;
    DEV void col8(int row, int col0, const float (&v)[8]) const { u32x4 o; o[0] = pk2(v[0], v[1]); o[1] = pk2(v[2], v[3]); o[2] = pk2(v[4], v[5]); o[3] = pk2(v[6], v[7]); *(u32x4*)(out + (size_t)row * ld + col0) = o; }
    DEV void operator()(int row, int col, float v0, float v1, float v2, float v3) const {
        bf16_t* d = out + (size_t)row * ld + col; d[0] = (bf16_t)f2bf(v0); d[ld] = (bf16_t)f2bf(v1); d[2 * ld] = (bf16_t)f2bf(v2); d[3 * ld] = (bf16_t)f2bf(v3);
    }
};
struct EpiHg {
    unsigned char* ws; const float* lg;
    DEV void operator()(int row, int col, float v0, float v1, float v2, float v3) const {
        float vv[4] = {v0, v1, v2, v3};
        const bool lat = row < TL; const int b = lat ? row / L : (row - TL) / LC, t = lat ? row - b * L : (row - TL) - b * LC, Lx = lat ? L : LC;
        const int cu = __builtin_amdgcn_readfirstlane(col & ~255);
        if (cu >= 3072 && cu < 4096) {
            bf16_t* d = (bf16_t*)(ws + WS_M) + (lat ? (size_t)0 : (size_t)NB * 1024 * L) + ((size_t)b * 1024 + (col - 3072)) * Lx + t;
            u32x2 o; o[0] = pk2(v0, v1); o[1] = pk2(v2, v3); *(u32x2*)d = o;
            return;
        }
        if (cu < 1024 || cu >= 4096) {
#pragma unroll
            for (int i = 0; i < 4; ++i) vv[i] = silu_f(vv[i]);
        } else {
            const int c = col - 1024;
            const float oml = 1.f - 1.f / (1.f + __expf(lg[c] - lg[2048 + c]));
#pragma unroll
            for (int i = 0; i < 4; ++i) vv[i] = oml * __builtin_amdgcn_rcpf(1.f + __expf(vv[i]));
        }
        if (cu < 3072) {
            bf16_t* d = (bf16_t*)(ws + WS_P + (lat ? P1_KQT_LAT : P1_KQT_CTX)) + ((size_t)b * 3072 + col) * Lx + t;
            u32x2 o; o[0] = pk2(vv[0], vv[1]); o[1] = pk2(vv[2], vv[3]); *(u32x2*)d = o;
        } else {
            if (!lat) return;
            bf16_t* d = (bf16_t*)(ws + WS_P + P1_G) + (size_t)row * 1024 + (col - 4096); d[0] = (bf16_t)f2bf(vv[0]); d[1024] = (bf16_t)f2bf(vv[1]); d[2048] = (bf16_t)f2bf(vv[2]); d[3072] = (bf16_t)f2bf(vv[3]);
        }
    }
};
struct EpiHgT {
    unsigned char* ws; const float* lg; int plain;
    DEV float colpre(int col) const {
        const int cu = __builtin_amdgcn_readfirstlane(col & ~255);
        if (cu < 1024 || cu >= 3072) return 0.f;
        const int c = col - 1024; return 1.f - __builtin_amdgcn_rcpf(1.f + __expf(lg[c] - lg[2048 + c]));
    }
    DEV void tok8(int row, int col, const float (&v)[8], float oml) const {
        const bool lat = row < TL; const int b = lat ? row / L : (row - TL) / LC, t = lat ? row - b * L : (row - TL) - b * LC, Lx = lat ? L : LC;
        const int cu = __builtin_amdgcn_readfirstlane(col & ~255);
        float vv[8];
#pragma unroll
        for (int i = 0; i < 8; ++i) vv[i] = v[i];
        if (cu >= 3072 && cu < 4096) {
            u32x4 o; o[0] = pk2(vv[0], vv[1]); o[1] = pk2(vv[2], vv[3]); o[2] = pk2(vv[4], vv[5]); o[3] = pk2(vv[6], vv[7]);
            *(u32x4*)((bf16_t*)(ws + WS_M) + (lat ? (size_t)0 : (size_t)NB * 1024 * L) + ((size_t)b * 1024 + (col - 3072)) * Lx + t) = o;
            return;
        }
        if (plain) {} else if (cu < 1024 || cu >= 4096) {
#pragma unroll
            for (int i = 0; i < 8; ++i) vv[i] = silu_f(vv[i]);
        } else {
#pragma unroll
            for (int i = 0; i < 8; ++i) vv[i] = oml * __builtin_amdgcn_rcpf(1.f + __expf(vv[i]));
        }
        if (cu < 3072) {
            u32x4 o; o[0] = pk2(vv[0], vv[1]); o[1] = pk2(vv[2], vv[3]); o[2] = pk2(vv[4], vv[5]); o[3] = pk2(vv[6], vv[7]);
            *(u32x4*)((bf16_t*)(ws + WS_P + (lat ? P1_KQT_LAT : P1_KQT_CTX)) + ((size_t)b * 3072 + col) * Lx + t) = o;
        } else {
            if (!lat) return;
            bf16_t* d = (bf16_t*)(ws + WS_P + P1_G) + (size_t)row * 1024 + (col - 4096);
#pragma unroll
            for (int i = 0; i < 8; ++i) d[i * 1024] = (bf16_t)f2bf(vv[i]);
        }
    }
};
struct EpiRes {
    const Params* p; int from_inputs, layer, goff;
    DEV void col8(int row, int col0, const float (&v)[8]) const {
        float* H = (float*)(p->ws + WS_H) + (size_t)row * 1024 + col0; const float* hin = h_row(*p, from_inputs, row) + col0;
        const float* gt = (const float*)(p->ws + WS_MOD) + ((size_t)layer * NR + mod_row(row)) * 6144 + goff + col0;
        const f32x4 h0 = *(const f32x4*)hin, h1 = *(const f32x4*)(hin + 4), g0 = *(const f32x4*)gt, g1 = *(const f32x4*)(gt + 4);
        f32x4 o0, o1;
#pragma unroll
        for (int i = 0; i < 4; ++i) { o0[i] = h0[i] + g0[i] * v[i]; o1[i] = h1[i] + g1[i] * v[4 + i]; }
        *(f32x4*)H = o0; *(f32x4*)(H + 4) = o1;
    }
    DEV void operator()(int row, int col, float v0, float v1, float v2, float v3) const {
        float* H = (float*)(p->ws + WS_H) + (size_t)row * 1024 + col;
        const float* hin = h_row(*p, from_inputs, row) + col;
        const float gt = ((const float*)(p->ws + WS_MOD))[((size_t)layer * NR + mod_row(row)) * 6144 + goff + col];
        const float h0 = hin[0], h1 = hin[1024], h2 = hin[2048], h3 = hin[3072];
        H[0] = h0 + gt * v0; H[1024] = h1 + gt * v1; H[2048] = h2 + gt * v2; H[3072] = h3 + gt * v3;
    }
};

struct HyRaw { u32x4 mid; unsigned short lft, rgt; };
DEV HyRaw hy_load(const bf16_t* row, int t0, int Lx) { HyRaw r; r.mid = *(const u32x4*)(row + t0); r.lft = t0 > 0 ? row[t0 - 1] : (unsigned short)0; r.rgt = t0 + 8 < Lx ? row[t0 + 8] : (unsigned short)0; return r; }
DEV void hy_conv8(const HyRaw& r, float w0, float w1, float w2, float b, float (&o)[8]) {
    float x[10]; x[0] = bf2f(r.lft); x[9] = bf2f(r.rgt);
#pragma unroll
    for (int i = 0; i < 4; ++i) { x[1 + 2 * i] = bflo(r.mid[i]); x[2 + 2 * i] = bfhi(r.mid[i]); }
#pragma unroll
    for (int i = 0; i < 8; ++i) o[i] = w0 * x[i] + w1 * x[i + 1] + w2 * x[i + 2] + b;
}
template <int TPC>
DEV void hyena_item(const Params& p, int set, int item, unsigned char* smem, bool nofft = false, bool nostore = false) {
    const int Ls = set ? LC : L, S = set ? FS_CTX : FS_LAT, N = 1 << (2 * S);
    constexpr int CPR = NT / TPC, NR8 = 8 / CPR;
    const int gi = tidx() / TPC, g = tidx() % TPC;
    const int bp = item >> 6, c0 = (item & 63) * 8, ba = bp * 2, bb = ba + 1;
    cf2* buf = (cf2*)smem + (size_t)gi * N;
    bf16_t* stg = (bf16_t*)(smem + (size_t)CPR * N * 8);
    const bf16_t* hy = (const bf16_t*)(p.ws + WS_P + (set ? P_HYT_CTX : P_HYT_LAT));
    const float* cw = p.in[I_HYCW]; const float* cb = p.in[I_HYCB];
    const cf2* HF = (const cf2*)(p.ws + WS_F + (set ? F_HF_CTX : F_HF_LAT));
    const float invN = 1.f / (float)N;
    const int t0 = g * 8; const bool own = t0 < Ls;
    HyRaw rv[2], rx1[2];
    cf2 hfr[16];
#define HY_FETCH(cc) do { if (own) { \
        rv[0] = hy_load(hy + ((size_t)ba * 1536 + (cc)) * Ls, t0, Ls); rv[1] = hy_load(hy + ((size_t)bb * 1536 + (cc)) * Ls, t0, Ls); \
        rx1[0] = hy_load(hy + ((size_t)ba * 1536 + 512 + (cc)) * Ls, t0, Ls); rx1[1] = hy_load(hy + ((size_t)bb * 1536 + 512 + (cc)) * Ls, t0, Ls); } } while (0)
    HY_FETCH(c0 + gi);
#pragma unroll 1
    for (int rd = 0; rd < NR8; ++rd) {
        const int cs = rd * CPR + gi, c = c0 + cs;
#pragma unroll
        for (int u = 0; u < 16; ++u) { hfr[u].x = 0.f; hfr[u].y = 0.f; if (g + TPC * u < N) hfr[u] = HF[(size_t)c * N + g + TPC * u]; }
        float za[8], zb[8];
        if (own) { hy_conv8(rv[0], cw[c], cw[1536 + c], cw[3072 + c], cb[c], za); hy_conv8(rv[1], cw[c], cw[1536 + c], cw[3072 + c], cb[c], zb); }
        for (int t = g; t < N; t += TPC) { if (t >= Ls) { cf2 z; z.x = 0.f; z.y = 0.f; buf[fsw(t)] = z; } }
        if (own) {
#pragma unroll
            for (int i = 0; i < 8; ++i) { cf2 v; v.x = za[i]; v.y = zb[i]; buf[fsw(t0 + i)] = v; }
        }
        __syncthreads();
#pragma unroll
        for (int n = 0; n < 2; ++n) {
            if (!nofft) fft_fwd(buf, S, g, TPC);
#pragma unroll
            for (int u = 0; u < 16; ++u) { const int k = g + TPC * u; if (k < N) buf[fsw(k)] = cmul(buf[fsw(k)], hfr[u]); }
            if (n == 0) {
#pragma unroll
                for (int u = 0; u < 16; ++u) if (g + TPC * u < N) hfr[u] = HF[(size_t)(512 + c) * N + g + TPC * u];
            }
            __syncthreads();
            if (!nofft) fft_inv(buf, S, g, TPC);
            const int gc = (n + 1) * 512 + c;
            if (own) {
                const float w0 = cw[gc], w1 = cw[1536 + gc], w2 = cw[3072 + gc], b = cb[gc], dsk = p.in[I_HYSKIP][n * 512 + c];
                float ga[8], gb[8];
                hy_conv8(rx1[0], w0, w1, w2, b, ga); hy_conv8(rx1[1], w0, w1, w2, b, gb);
                if (n == 0) { rx1[0] = hy_load(hy + ((size_t)ba * 1536 + 1024 + c) * Ls, t0, Ls); rx1[1] = hy_load(hy + ((size_t)bb * 1536 + 1024 + c) * Ls, t0, Ls); }
#pragma unroll
                for (int i = 0; i < 8; ++i) { const cf2 cv = buf[fsw(t0 + i)]; za[i] = ga[i] * (cv.x * invN + dsk * za[i]); zb[i] = gb[i] * (cv.y * invN + dsk * zb[i]); }
            }
            if (n == 0) {
                __syncthreads();
                for (int t = g; t < N; t += TPC) { if (t >= Ls) { cf2 z; z.x = 0.f; z.y = 0.f; buf[fsw(t)] = z; } }
                if (own) {
#pragma unroll
                    for (int i = 0; i < 8; ++i) { cf2 v; v.x = za[i]; v.y = zb[i]; buf[fsw(t0 + i)] = v; }
                }
                __syncthreads();
            } else {
                if (rd + 1 < NR8) HY_FETCH(c0 + (rd + 1) * CPR + gi);
                if (own) {
#pragma unroll
                    for (int i = 0; i < 8; ++i) {
                        const int ra = t0 + i, rb = Ls + t0 + i;
                        stg[(size_t)(ra + (ra >> 3)) * 8 + cs] = (bf16_t)f2bf(za[i]); stg[(size_t)(rb + (rb >> 3)) * 8 + cs] = (bf16_t)f2bf(zb[i]); }
                }
            }
        }
        __syncthreads();
    }
#undef HY_FETCH
    if (!nostore) {
        bf16_t* M = (bf16_t*)(p.ws + WS_M);
        for (int i = tidx(); i < 2 * Ls; i += NT) {
            const int bsel = i >= Ls, t = bsel ? i - Ls : i, bx = bsel ? bb : ba;
            const size_t tok = set ? (size_t)TL + (size_t)bx * LC + t : (size_t)bx * L + t;
            *(u32x4*)(M + tok * 1024 + c0) = *(const u32x4*)(stg + (size_t)(i + (i >> 3)) * 8);
        }
    }
    __syncthreads();
}
DEV void rope_store(const bf16_t* src, bf16_t* dst, int pos, bool rope, float scale, int ph, int sub) {
    const u32x4 ua = *(const u32x4*)(src + ph * 32 + sub * 8), ub = *(const u32x4*)(src + ph * 32 + 16 + sub * 8);
    float a[8], b[8];
#pragma unroll
    for (int i = 0; i < 4; ++i) { a[2 * i] = bflo(ua[i]); a[2 * i + 1] = bfhi(ua[i]); b[2 * i] = bflo(ub[i]); b[2 * i + 1] = bfhi(ub[i]); }
    if (rope) {
        const float pv = (float)(ph == 0 ? pos / 64 : pos % 64);
#pragma unroll
        for (int e = 0; e < 8; ++e) {
            const float inv = exp2f(-(float)(sub * 8 + e) * (13.287712379549449f / 16.f));
            const float ang = pv * inv, cs = __cosf(ang), sn = __sinf(ang);
            const float na = a[e] * cs - b[e] * sn, nb = b[e] * cs + a[e] * sn; a[e] = na; b[e] = nb;
        }
    }
    u32x4 oa, ob;
#pragma unroll
    for (int i = 0; i < 4; ++i) { oa[i] = pk2(a[2 * i] * scale, a[2 * i + 1] * scale); ob[i] = pk2(b[2 * i] * scale, b[2 * i + 1] * scale); }
    *(u32x4*)(dst + ph * 32 + sub * 8) = oa; *(u32x4*)(dst + ph * 32 + 16 + sub * 8) = ob;
}
constexpr int A_LDQ = 72, A_LDV = 136;
DEV void attn_item(const Params& p, int set, int item, unsigned char* smem) {
    bf16_t* Qs = (bf16_t*)smem;
    bf16_t* Ks = Qs + 128 * A_LDQ;
    bf16_t* Vt = Ks + 128 * A_LDQ;
    const int tid = tidx(), lane = tid & 63, w = tid >> 6, l15 = lane & 15, lg = lane >> 4;
    const int nqb = set ? LC / 128 : L / 128;
    const int h = item & 7, qb = (item >> 3) % nqb, b = (item >> 3) / nqb, kvh = h >> 2;
    const bf16_t* Q0 = (const bf16_t*)(p.ws + WS_P + P_Q0); const bf16_t* K0 = (const bf16_t*)(p.ws + WS_P + P_K0);
    const int qtok0 = set ? TL + b * LC + qb * 128 : b * L + qb * 128;
    { const int row = tid >> 2, ph = (tid >> 1) & 1, sub = tid & 1;
      rope_store(Q0 + (size_t)(qtok0 + row) * 512 + h * 64, Qs + row * A_LDQ, qb * 128 + row, set == 0, 0.125f, ph, sub); }
    __syncthreads();
    bf16x8 qf[2];
    qf[0] = *(const bf16x8*)(Qs + (w * 16 + l15) * A_LDQ + 8 * lg); qf[1] = *(const bf16x8*)(Qs + (w * 16 + l15) * A_LDQ + 32 + 8 * lg);
    float m_run = p.in[I_SINK][h], l_run = 1.f;
    f32x4 O[4];
#pragma unroll
    for (int i = 0; i < 4; ++i) O[i] = (f32x4){0.f, 0.f, 0.f, 0.f};
    const int nwin = set ? 0 : 3, nctx = LC / 128;
    for (int kbi = 0; kbi < nwin + nctx; ++kbi) {
        const bool win = kbi < nwin; const int kb = win ? qb - 1 + kbi : kbi - nwin;
        if (win && (kb < 0 || kb >= L / 128)) continue;
        const int ktok0 = win ? b * L + kb * 128 : TL + b * LC + kb * 128;
        __syncthreads();
        { const int row = tid >> 2, ph = (tid >> 1) & 1, sub = tid & 1;
          rope_store(K0 + (size_t)(ktok0 + row) * 128 + kvh * 64, Ks + row * A_LDQ, kb * 128 + row, win, 1.f, ph, sub); }
        { const bf16_t* vt = (const bf16_t*)(p.ws + WS_P + (win ? P_VT_LAT : P_VT_CTX)); const int Lx = win ? L : LC;
#pragma unroll
          for (int i = 0; i < 2; ++i) { const int id = tid + NT * i, d = id >> 4, kc = id & 15;
              *(u32x4*)(Vt + d * A_LDV + kc * 8) = *(const u32x4*)(vt + ((size_t)b * 128 + kvh * 64 + d) * Lx + kb * 128 + kc * 8); } }
        __syncthreads();
#pragma unroll
        for (int ch = 0; ch < 2; ++ch) {
            f32x4 st[4];
#pragma unroll
            for (int u = 0; u < 4; ++u) {
                const bf16_t* kr = Ks + ((ch * 4 + u) * 16 + l15) * A_LDQ + 8 * lg;
                f32x4 z = (f32x4){0.f, 0.f, 0.f, 0.f};
                z = __builtin_amdgcn_mfma_f32_16x16x32_bf16(*(const bf16x8*)kr, qf[0], z, 0, 0, 0);
                z = __builtin_amdgcn_mfma_f32_16x16x32_bf16(*(const bf16x8*)(kr + 32), qf[1], z, 0, 0, 0);
                st[u] = z;
            }
            float cmax = -INFINITY;
            if (win) {
                const int qpos = qb * 128 + w * 16 + l15;
#pragma unroll
                for (int u = 0; u < 4; ++u)
#pragma unroll
                    for (int r = 0; r < 4; ++r) { const int kpos = kb * 128 + (ch * 4 + u) * 16 + 4 * lg + r; const int dd = qpos - kpos; if (dd > 128 || dd < -128) st[u][r] = -INFINITY; }
            }
#pragma unroll
            for (int u = 0; u < 4; ++u)
#pragma unroll
                for (int r = 0; r < 4; ++r) cmax = fmaxf(cmax, st[u][r]);
            cmax = fmaxf(cmax, __shfl_xor(cmax, 16)); cmax = fmaxf(cmax, __shfl_xor(cmax, 32));
            const float m_new = fmaxf(m_run, cmax), alpha = __expf(m_run - m_new);
            float ls = 0.f;
#pragma unroll
            for (int u = 0; u < 4; ++u)
#pragma unroll
                for (int r = 0; r < 4; ++r) { const float e = __expf(st[u][r] - m_new); st[u][r] = e; ls += e; }
            ls += __shfl_xor(ls, 16); ls += __shfl_xor(ls, 32);
            l_run = l_run * alpha + ls; m_run = m_new;
#pragma unroll
            for (int i = 0; i < 4; ++i) { O[i][0] *= alpha; O[i][1] *= alpha; O[i][2] *= alpha; O[i][3] *= alpha; }
#pragma unroll
            for (int ss = 0; ss < 2; ++ss) {
                u32x4 pu; pu[0] = pk2(st[2 * ss][0], st[2 * ss][1]); pu[1] = pk2(st[2 * ss][2], st[2 * ss][3]); pu[2] = pk2(st[2 * ss + 1][0], st[2 * ss + 1][1]); pu[3] = pk2(st[2 * ss + 1][2], st[2 * ss + 1][3]);
                const bf16x8 pf = __builtin_bit_cast(bf16x8, pu);
                const int key0 = (ch * 4 + 2 * ss) * 16 + 4 * lg;
#pragma unroll
                for (int dt = 0; dt < 4; ++dt) {
                    const bf16_t* vr = Vt + (dt * 16 + l15) * A_LDV + key0;
                    u32x4 vu; const u32x2 v0 = *(const u32x2*)vr, v1 = *(const u32x2*)(vr + 16); vu[0] = v0[0]; vu[1] = v0[1]; vu[2] = v1[0]; vu[3] = v1[1];
                    O[dt] = __builtin_amdgcn_mfma_f32_16x16x32_bf16(__builtin_bit_cast(bf16x8, vu), pf, O[dt], 0, 0, 0);
                }
            }
        }
    }
    const float il = 1.f / l_run;
    bf16_t* M = (bf16_t*)(p.ws + WS_M) + (size_t)(qtok0 + w * 16 + l15) * 1024 + 512 + h * 64;
#pragma unroll
    for (int dt = 0; dt < 4; ++dt) { u32x2 o; o[0] = pk2(O[dt][0] * il, O[dt][1] * il); o[1] = pk2(O[dt][2] * il, O[dt][3] * il); *(u32x2*)(M + dt * 16 + 4 * lg) = o; }
    __syncthreads();
}
static_assert(NF_LAT / 256 <= 16 && NF_CTX / 64 <= 16 && L / 8 <= 256 && LC / 8 <= 64 && 2 * NF_LAT * 8 + 2 * L * 18 <= SMEM_BYTES && 8 * NF_CTX * 8 + 2 * LC * 18 <= SMEM_BYTES, "hyena item geometry");
constexpr int P3_HY_LAT = (NB / 2) * 64, P3_HY_CTX = (NB / 2) * 64, P3_AT_LAT = NB * (L / 128) * 8, P3_AT_CTX = NB * (LC / 128) * 8;
DEV void phase3(const Params& p, unsigned char* smem, int var = 0) {
    const int total = P3_HY_LAT + P3_AT_LAT + P3_HY_CTX + P3_AT_CTX;
    for (int it = blockIdx.x; it < total; it += gridDim.x) {
        int i = it;
        if ((var == 1 || var == 3 || var == 4) && !(i < P3_HY_LAT || (i >= P3_HY_LAT + P3_AT_LAT && i < P3_HY_LAT + P3_AT_LAT + P3_HY_CTX))) continue;
        if (var == 2 && (i < P3_HY_LAT || (i >= P3_HY_LAT + P3_AT_LAT && i < P3_HY_LAT + P3_AT_LAT + P3_HY_CTX))) continue;
        if (i < P3_HY_LAT) { hyena_item<256>(p, 0, i, smem, var == 3, var == 4); continue; } i -= P3_HY_LAT;
        if (i < P3_AT_LAT) { attn_item(p, 0, i, smem); continue; } i -= P3_AT_LAT;
        if (i < P3_HY_CTX) { hyena_item<64>(p, 1, i, smem, var == 3, var == 4); continue; } i -= P3_HY_CTX;
        attn_item(p, 1, i, smem);
    }
}

constexpr int K_LDK = 136, K_LDS = 129, K_LDC = 52;
DEV unsigned fkey(float f) { const unsigned u = __builtin_bit_cast(unsigned, f); return (u & 0x80000000u) ? ~u : (u | 0x80000000u); }
constexpr int cand_off(int i) { int o = 0; for (int k = 0; k < i; ++k) o += 16 / (k + 1); return o; }
DEV void topk_load_keys(const Params& p, int layer, int h, unsigned char* smem) {
    bf16_t* Ks = (bf16_t*)smem;
    const bf16_t* keys = (const bf16_t*)(p.ws + WS_W + W_KEYS) + (size_t)layer * 262144 + (size_t)h * 32768;
    const int tid = tidx();
#pragma unroll
    for (int i = 0; i < 8; ++i) { const int id = tid + NT * i, row = id >> 4, kc = id & 15; *(u32x4*)(Ks + row * K_LDK + kc * 8) = *(const u32x4*)(keys + (size_t)row * 128 + kc * 8); }
    __syncthreads();
}
#ifndef HOST_EMU
template <int CTRL> DEV unsigned dpp_u32(unsigned v) { return (unsigned)__builtin_amdgcn_update_dpp(0, (int)v, CTRL, 0xF, 0xF, true); }
#else
template <int CTRL> DEV unsigned dpp_u32(unsigned v) { const int lane = tidx() & 63; const int src = CTRL == 0xB1 ? (lane ^ 1) : CTRL == 0x4E ? (lane ^ 2) : ((lane & ~7) | (7 - (lane & 7))); return emu_shfl(v, src); }
#endif
DEV unsigned max8_u32(unsigned v) { unsigned t = dpp_u32<0xB1>(v); v = v > t ? v : t; t = dpp_u32<0x4E>(v); v = v > t ? v : t; t = dpp_u32<0x141>(v); return v > t ? v : t; }
DEV float sum8_f32(float v) { v += __builtin_bit_cast(float, dpp_u32<0xB1>(__builtin_bit_cast(unsigned, v))); v += __builtin_bit_cast(float, dpp_u32<0x4E>(__builtin_bit_cast(unsigned, v))); v += __builtin_bit_cast(float, dpp_u32<0x141>(__builtin_bit_cast(unsigned, v))); return v; }
DEV float unkey(unsigned k) { const unsigned u = (k & 0x80000000u) ? (k & 0x7fffffffu) : ~k; return __builtin_bit_cast(float, u); }
template <int N> DEV void bitonic_desc(unsigned (&a)[N]) {
#pragma unroll
    for (int k = 2; k <= N; k <<= 1)
#pragma unroll
        for (int j = k >> 1; j > 0; j >>= 1)
#pragma unroll
            for (int i = 0; i < N; ++i) { const int l = i ^ j; if (l > i) { const unsigned x = a[i], y = a[l]; const unsigned hi = x > y ? x : y, lo = x > y ? y : x; if ((i & k) == 0) { a[i] = hi; a[l] = lo; } else { a[i] = lo; a[l] = hi; } } }
}
DEV void merge16(const unsigned* lst, int nlist, unsigned first, int sub, unsigned& r0, unsigned& r1) {
    unsigned cur = first; int head = 0; r0 = 0u; r1 = 0u;
#pragma unroll
    for (int it = 0; it < 16; ++it) {
        const unsigned m = max8_u32(cur);
        if (sub == (it & 7)) { if (it < 8) r0 = m; else r1 = m; }
        if (cur == m) { ++head; cur = head < nlist ? lst[head] : 0u; }
    }
}
DEV void topk_item(const Params& p, int h, int tok0, unsigned char* smem, const bf16x8 (&afr)[16]) {
    bf16_t* Ks = (bf16_t*)smem;
    float* Sc = (float*)(Ks + 2 * 128 * K_LDK);
    unsigned* s12 = (unsigned*)Sc + 64 * 8 * 17;
    unsigned* cl = s12 + 64 * 32;
    const int tid = tidx(), lane = tid & 63, w = tid >> 6;
    const int row = tid >> 3, sub = tid & 7;
#pragma unroll
    for (int part = 0; part < 2; ++part) {
        { const int mi = w >> 2, ni = w & 3;
          f32x16 acc;
#pragma unroll
          for (int r = 0; r < 16; ++r) acc[r] = 0.f;
          const bf16_t* bs = Ks + (part * 128 + ni * 32 + (lane & 31)) * K_LDK + 8 * (lane >> 5);
#pragma unroll
          for (int kk = 0; kk < 8; ++kk) acc = __builtin_amdgcn_mfma_f32_32x32x16_bf16(part ? afr[8 + kk] : afr[kk], *(const bf16x8*)(bs + kk * 16), acc, 0, 0, 0);
#pragma unroll
          for (int r = 0; r < 16; ++r) Sc[(mi * 32 + (r & 3) + 8 * (r >> 2) + 4 * (lane >> 5)) * K_LDS + ni * 32 + (lane & 31)] = acc[r]; }
        __syncthreads();
        unsigned mk[16];
#pragma unroll
        for (int i = 0; i < 16; ++i) mk[i] = (fkey(Sc[row * K_LDS + sub * 16 + i]) & ~127u) | (unsigned)(127 - (sub * 16 + i));
        bitonic_desc<16>(mk);
        __syncthreads();
        unsigned* lst = (unsigned*)Sc + (row * 8 + sub) * 17;
#pragma unroll
        for (int i = 0; i < 16; ++i) lst[i] = mk[i];
        unsigned r0, r1;
        merge16(lst, 16, mk[0], sub, r0, r1);
        s12[(row * 2 + part) * 16 + sub] = r0; s12[(row * 2 + part) * 16 + 8 + sub] = r1;
        __syncthreads();
    }
    {
        const unsigned* k1 = s12 + row * 32; const unsigned* k2 = k1 + 16;
        unsigned ck[8];
#pragma unroll
        for (int m = 0; m < 8; ++m) {
            const int cc = sub + 8 * m; int ci = 0, off = 0;
#pragma unroll
            for (int i = 0; i < 15; ++i) { const bool ge = cc >= cand_off(i + 1); ci += ge ? 1 : 0; off += ge ? 16 / (i + 1) : 0; }
            const int cj = cc - off;
            ck[m] = 0u;
            if (cc < 50) ck[m] = (fkey(unkey((k1[ci] & ~127u) | 64u) + unkey((k2[cj] & ~127u) | 64u)) & ~63u) | (unsigned)(63 - cc);
        }
        bitonic_desc<8>(ck);
        unsigned* lst = cl + (row * 8 + sub) * 9;
#pragma unroll
        for (int m = 0; m < 8; ++m) lst[m] = ck[m];
        unsigned r0, r1;
        merge16(lst, 8, ck[0], sub, r0, r1);
        const float a = unkey((r0 & ~63u) | 32u), b = unkey((r1 & ~63u) | 32u);
        const unsigned kmax = max8_u32(r0 > r1 ? r0 : r1); const float vmax = unkey((kmax & ~63u) | 32u);
        const float ea = __expf(a - vmax), eb = __expf(b - vmax);
        const float inv = 1.f / sum8_f32(ea + eb);
        int eidx[2];
#pragma unroll
        for (int q = 0; q < 2; ++q) {
            const int cc = 63 - (int)((q ? r1 : r0) & 63u); int ci = 0, off = 0;
#pragma unroll
            for (int i = 0; i < 15; ++i) { const bool ge = cc >= cand_off(i + 1); ci += ge ? 1 : 0; off += ge ? 16 / (i + 1) : 0; }
            const int cj = cc - off;
            eidx[q] = (127 - (int)(k1[ci] & 127u)) * 128 + (127 - (int)(k2[cj] & 127u));
        }
        int* IDX = (int*)(p.ws + WS_IDX) + (size_t)(tok0 + row) * 128 + h * 16; float* GT = (float*)(p.ws + WS_GATE) + (size_t)(tok0 + row) * 128 + h * 16;
        IDX[sub] = eidx[0]; IDX[8 + sub] = eidx[1]; GT[sub] = ea * inv; GT[8 + sub] = eb * inv;
    }
    __syncthreads();
}
#define TOPK_LOAD(AF, tok0_, h_) do { const int lane_ = tidx() & 63, w_ = tidx() >> 6; \
        const bf16_t* ag_ = (const bf16_t*)(p.ws + WS_P) + (size_t)((tok0_) + (w_ >> 2) * 32 + (lane_ & 31)) * 2048 + (h_) * 256 + 8 * (lane_ >> 5); \
        _Pragma("unroll") for (int q_ = 0; q_ < 16; ++q_) AF[q_] = *(const bf16x8*)(ag_ + (q_ >> 3) * 128 + (q_ & 7) * 16); } while (0)
DEV void topk_phase(const Params& p, int layer, int ntok, unsigned char* smem) {
    const int G = gridDim.x, bid = blockIdx.x, h = bid & 7;
    const int nt = ntok / 64;
    bf16x8 afA[16], afB[16];
    if ((G & 7) == 0) {
        const int st = G >> 3; int tt = bid >> 3;
        if (tt < nt) { TOPK_LOAD(afA, tt * 64, h); topk_load_keys(p, layer, h, smem); }
        while (tt < nt) {
            if (tt + st < nt) TOPK_LOAD(afB, (tt + st) * 64, h);
            topk_item(p, h, tt * 64, smem, afA);
            tt += st; if (tt >= nt) break;
            if (tt + st < nt) TOPK_LOAD(afA, (tt + st) * 64, h);
            topk_item(p, h, tt * 64, smem, afB);
            tt += st;
        }
    } else {
        for (int it = bid; it < nt * 8; it += G) { __syncthreads(); TOPK_LOAD(afA, (it >> 3) * 64, it & 7); topk_load_keys(p, layer, it & 7, smem); topk_item(p, it & 7, (it >> 3) * 64, smem, afA); }
    }
}
#undef TOPK_LOAD

DEV float gelu_f(float x) { return 0.5f * x * (1.f + erff(x * 0.70710678118654752f)); }
DEV void peer_item(const Params& p, int layer, int item, int var = 0) {
    (void)var;
    const int tok = item * 8 + (tidx() >> 6), lane = tidx() & 63, li = lane & 31, half = lane >> 5;
    const bf16_t* A = (const bf16_t*)(p.ws + WS_A) + (size_t)tok * 1024 + li * 32;
    const unsigned char* UV = p.ws + WS_UV + (size_t)layer * 16384 * 1024;
    const float* SU = (const float*)(p.ws + WS_S8) + (size_t)(layer * 2) * 16384; const float* SV = SU + 16384;
    unsigned xp[16]; float y[32];
#pragma unroll
    for (int q = 0; q < 4; ++q) { const u32x4 a = *(const u32x4*)(A + 8 * q);
#pragma unroll
        for (int i = 0; i < 4; ++i) xp[4 * q + i] = a[i]; }
#pragma unroll
    for (int i = 0; i < 32; ++i) y[i] = 0.f;
    const int* IDX = (const int*)(p.ws + WS_IDX) + (size_t)tok * 128; const float* GT = (const float*)(p.ws + WS_GATE) + (size_t)tok * 128;
    const int i_lo = IDX[lane], i_hi = IDX[64 + lane]; const float g_lo = GT[lane], g_hi = GT[64 + lane];
    const int sl = ((li >> 4) & 1) * 2 + ((li >> 3) & 1);
    u32x4 uq[4], vq[4];
#define PG_LOADU(g) do { _Pragma("unroll") for (int s_ = 0; s_ < 4; ++s_) { const int e_ = __shfl((g) < 8 ? i_lo : i_hi, (((g) & 7) << 3) + 2 * s_ + half); \
        uq[s_] = *(const u32x4*)(UV + (size_t)e_ * 1024 + li * 16); } } while (0)
#define PG_LOADV(g) do { _Pragma("unroll") for (int s_ = 0; s_ < 4; ++s_) { const int e_ = __shfl((g) < 8 ? i_lo : i_hi, (((g) & 7) << 3) + 2 * s_ + half); \
        vq[s_] = *(const u32x4*)(UV + (size_t)e_ * 1024 + 512 + li * 16); } } while (0)
    PG_LOADU(0); PG_LOADV(0);
    for (int g = 0; g < 16; ++g) {
        const int mk = ((g & 7) << 3) + 2 * sl + half; const int me = __shfl(g < 8 ? i_lo : i_hi, mk); const float mg = __shfl(g < 8 ? g_lo : g_hi, mk);
        const float su = SU[me], sv = SV[me];
        float d[4];
#pragma unroll
        for (int s4 = 0; s4 < 4; ++s4) {
            float a = 0.f;
#pragma unroll
            for (int dw = 0; dw < 4; ++dw) {
                a = dot2_fp4<0>(uq[s4][dw], xp[4 * dw], a); a = dot2_fp4<1>(uq[s4][dw], xp[4 * dw + 1], a);
                a = dot2_fp4<2>(uq[s4][dw], xp[4 * dw + 2], a); a = dot2_fp4<3>(uq[s4][dw], xp[4 * dw + 3], a);
            }
            d[s4] = a; SCHED_FENCE(); }
        if (g + 1 < 16) PG_LOADU(g + 1);
        float r2[2], r1;
        { const bool hi = (li & 16) != 0;
#pragma unroll
          for (int j = 0; j < 2; ++j) { const float send = hi ? d[j] : d[2 + j], keep = hi ? d[2 + j] : d[j]; r2[j] = keep + __shfl_xor(send, 16); } }
        { const bool hi = (li & 8) != 0; const float send = hi ? r2[0] : r2[1], keep = hi ? r2[1] : r2[0]; r1 = keep + __shfl_xor(send, 8); }
        r1 += __shfl_xor(r1, 4); r1 += __shfl_xor(r1, 2); r1 += __shfl_xor(r1, 1);
        const float act = gelu_f(r1 * su) * mg * sv;
#pragma unroll
        for (int s4 = 0; s4 < 4; ++s4) {
            const float aj = __shfl(act, (lane & 32) + 16 * (s4 >> 1) + 8 * (s4 & 1));
#pragma unroll
            for (int dw = 0; dw < 4; ++dw) {
                const f32x2 f0 = __builtin_amdgcn_cvt_scalef32_pk_f32_fp4(vq[s4][dw], 1.0f, 0), f1 = __builtin_amdgcn_cvt_scalef32_pk_f32_fp4(vq[s4][dw], 1.0f, 1),
                            f2 = __builtin_amdgcn_cvt_scalef32_pk_f32_fp4(vq[s4][dw], 1.0f, 2), f3 = __builtin_amdgcn_cvt_scalef32_pk_f32_fp4(vq[s4][dw], 1.0f, 3);
                const int e0 = dw * 8;
                y[e0] = fmaf(aj, f0[0], y[e0]); y[e0 + 1] = fmaf(aj, f0[1], y[e0 + 1]); y[e0 + 2] = fmaf(aj, f1[0], y[e0 + 2]); y[e0 + 3] = fmaf(aj, f1[1], y[e0 + 3]);
                y[e0 + 4] = fmaf(aj, f2[0], y[e0 + 4]); y[e0 + 5] = fmaf(aj, f2[1], y[e0 + 5]); y[e0 + 6] = fmaf(aj, f3[0], y[e0 + 6]); y[e0 + 7] = fmaf(aj, f3[1], y[e0 + 7]);
            }
            SCHED_FENCE(); }
        if (g + 1 < 16) PG_LOADV(g + 1);
    }
#undef PG_LOADU
#undef PG_LOADV
    float yy[16];
#pragma unroll
    for (int i = 0; i < 16; ++i) { const float send = half ? y[i] : y[16 + i], keep = half ? y[16 + i] : y[i]; yy[i] = keep + __shfl_xor(send, 32); }
    const int c0 = li * 32 + half * 16;
    float* H = (float*)(p.ws + WS_H) + (size_t)tok * 1024 + c0;
    const float* g2 = (const float*)(p.ws + WS_MOD) + ((size_t)layer * NR + mod_row(tok)) * 6144 + 5120 + c0;
    float hv[16]; float ss = 0.f;
#pragma unroll
    for (int i = 0; i < 4; ++i) { const f32x4 hh = *(const f32x4*)(H + 4 * i), gg = *(const f32x4*)(g2 + 4 * i);
#pragma unroll
        for (int j = 0; j < 4; ++j) { const float v = hh[j] + gg[j] * yy[4 * i + j]; hv[4 * i + j] = v; ss += v * v; } }
    ss = wave_sum(ss);
    const float rstd = rsqrtf(ss * (1.f / 1024.f) + 1e-6f);
    if (layer == 0) {
#pragma unroll
        for (int i = 0; i < 4; ++i) { f32x4 o; o[0] = hv[4 * i]; o[1] = hv[4 * i + 1]; o[2] = hv[4 * i + 2]; o[3] = hv[4 * i + 3]; *(f32x4*)(H + 4 * i) = o; }
        const float* g = p.in[I_N1G] + 1024 + c0;
        const float* mod = (const float*)(p.ws + WS_MOD) + ((size_t)1 * NR + mod_row(tok)) * 6144 + c0;
        bf16_t* Ao = (bf16_t*)(p.ws + WS_A) + (size_t)tok * 1024 + c0;
        u32x4 o0, o1; float r[16];
#pragma unroll
        for (int i = 0; i < 16; ++i) r[i] = hv[i] * rstd * g[i] * (1.f + mod[1024 + i]) + mod[i];
#pragma unroll
        for (int i = 0; i < 4; ++i) { o0[i] = pk2(r[2 * i], r[2 * i + 1]); o1[i] = pk2(r[8 + 2 * i], r[8 + 2 * i + 1]); }
        *(u32x4*)Ao = o0; *(u32x4*)(Ao + 8) = o1;
    } else {
        const float* g = p.in[I_FG] + c0; float* out = p.out + (size_t)tok * 1024 + c0;
#pragma unroll
        for (int i = 0; i < 4; ++i) { f32x4 o; o[0] = hv[4 * i] * rstd * g[4 * i]; o[1] = hv[4 * i + 1] * rstd * g[4 * i + 1]; o[2] = hv[4 * i + 2] * rstd * g[4 * i + 2]; o[3] = hv[4 * i + 3] * rstd * g[4 * i + 3]; *(f32x4*)(out + 4 * i) = o; }
    }
}

constexpr int S3_LD = 136, S3_LDT = 24, S3_LDV = 72;
constexpr int S3_Q = 0, S3_K = S3_Q + 64 * S3_LD * 2, S3_KT = S3_K + 64 * S3_LD * 2, S3_D = S3_KT + 4 * 128 * S3_LDT * 2, S3_V = S3_D + 4 * 128 * 4, S3_ST = S3_V + 64 * S3_LDV * 2,
              S3_P = S3_ST + 2 * 64 * S3_LD * 2, S3_END = S3_P + 4 * 16 * S3_LDT * 2;
static_assert(S3_END <= SMEM_BYTES, "scan LDS");
DEV void scan_block(const Params& p, int bi, unsigned char* smem, int var = 0) {
    const int tid = tidx(), lane = tid & 63, w = tid >> 6, l15 = lane & 15, lg4 = lane >> 4, l31 = lane & 31, lh = lane >> 5;
    const int half = bi & 1, dir = (bi >> 1) & 1, h = (bi >> 2) & 7, b = bi >> 5;
    const bf16_t* P1 = (const bf16_t*)(p.ws + WS_P);
    const bf16_t* IT = (const bf16_t*)(p.ws + WS_M);
    bf16_t* Oo = (bf16_t*)(p.ws + WS_F + (dir ? F_OB : F_OF));
    bf16_t* Qs = (bf16_t*)(smem + S3_Q); bf16_t* Ks = (bf16_t*)(smem + S3_K); bf16_t* KT = (bf16_t*)(smem + S3_KT); float* Ds = (float*)(smem + S3_D);
    bf16_t* Vs = (bf16_t*)(smem + S3_V); bf16_t* ST = (bf16_t*)(smem + S3_ST); bf16_t* Ps = (bf16_t*)(smem + S3_P);
    const int NCH = (LC + L) / 64;
    const int kt = w >> 1, vt = w & 1;
    f32x16 S;
#pragma unroll
    for (int r = 0; r < 16; ++r) S[r] = 0.f;
    for (int i = tid; i < 64 * S3_LD / 2; i += NT) ((unsigned*)ST)[i] = 0u;
    const int pk = tid & 127, pblk = tid >> 7;
    u32x4 ka[2], qa[2], va, kb2[2], qb2[2], vb2;
    const int kcol = 1024 * (1 + dir) + h * 128 + pk, qcol = h * 128 + pk;
#define S3_T0(c) ((c) * 64 < LC ? (dir ? LC - 64 - (c) * 64 : (c) * 64) : (dir ? L - 64 - ((c) * 64 - LC) : (c) * 64 - LC))
#define S3_LOAD(c, KR, QR, VR) do { const bool lat_ = (c) * 64 >= LC; const int t0_ = S3_T0(c); const int Lx_ = lat_ ? L : LC; \
        const bf16_t* kq_ = (const bf16_t*)(p.ws + WS_P + (lat_ ? P1_KQT_LAT : P1_KQT_CTX)) + (size_t)b * 3072 * Lx_ + t0_ + pblk * 16; \
        KR[0] = *(const u32x4*)(kq_ + (size_t)kcol * Lx_); KR[1] = *(const u32x4*)(kq_ + (size_t)kcol * Lx_ + 8); \
        if (lat_) { QR[0] = *(const u32x4*)(kq_ + (size_t)qcol * Lx_); QR[1] = *(const u32x4*)(kq_ + (size_t)qcol * Lx_ + 8); } else { QR[0] = (u32x4){0u, 0u, 0u, 0u}; QR[1] = QR[0]; } \
        { const int v_ = tid >> 3, c8_ = tid & 7; const bf16_t* it_ = IT + (lat_ ? (size_t)0 : (size_t)NB * 1024 * L) + ((size_t)b * 1024 + h * 128 + half * 64 + v_) * Lx_ + t0_ + c8_ * 8; VR = *(const u32x4*)it_; } } while (0)
#define S3_PREP(KR, QR, VR) do { \
            float bsum = 0.f; unsigned short kt16[16]; \
            _Pragma("unroll") for (int rr = 0; rr < 16; ++rr) { \
                const int tl = dir ? 15 - rr : rr; \
                const unsigned ku_ = dir ? KR[(15 - rr) >> 3][((15 - rr) & 7) >> 1] : KR[rr >> 3][(rr & 7) >> 1]; const unsigned qu_ = dir ? QR[(15 - rr) >> 3][((15 - rr) & 7) >> 1] : QR[rr >> 3][(rr & 7) >> 1]; \
                const bool odd_ = dir ? (((15 - rr) & 1) != 0) : ((rr & 1) != 0); \
                const float kv = odd_ ? bfhi(ku_) : bflo(ku_), qv = odd_ ? bfhi(qu_) : bflo(qu_); \
                bsum += __log2f(1.f - kv); \
                const float eb = __builtin_amdgcn_exp2f(bsum), ieb = __builtin_amdgcn_exp2f(fminf(-bsum, 115.f)); \
                const unsigned short qt = (unsigned short)f2bf(qv * eb), ktv = (unsigned short)f2bf(kv * ieb); \
                Qs[(pblk * 16 + tl) * S3_LD + pk] = qt; Ks[(pblk * 16 + tl) * S3_LD + pk] = ktv; \
                if (dir) kt16[15 - rr] = ktv; else kt16[rr] = ktv; \
            } \
            u32x4 o0, o1; \
            _Pragma("unroll") for (int i = 0; i < 4; ++i) { o0[i] = (unsigned)kt16[2 * i] | ((unsigned)kt16[2 * i + 1] << 16); o1[i] = (unsigned)kt16[8 + 2 * i] | ((unsigned)kt16[8 + 2 * i + 1] << 16); } \
            *(u32x4*)(KT + (pblk * 128 + pk) * S3_LDT) = o0; *(u32x4*)(KT + (pblk * 128 + pk) * S3_LDT + 8) = o1; \
            Ds[pblk * 128 + pk] = __builtin_amdgcn_exp2f(bsum); \
            { const int v_ = tid >> 3, c8_ = tid & 7; *(u32x4*)(Vs + v_ * S3_LDV + c8_ * 8) = VR; } } while (0)
    S3_LOAD(0, ka, qa, va);
    for (int c = 0; c < NCH; ++c) {
        const bool lat = c * 64 >= LC; const int t0 = S3_T0(c); const size_t tokb = lat ? (size_t)b * L + t0 : (size_t)TL + (size_t)b * LC + t0;
        if ((c & 1) == 0) { if (c + 1 < NCH) S3_LOAD(c + 1, kb2, qb2, vb2); } else { if (c + 1 < NCH) S3_LOAD(c + 1, ka, qa, va); }
        lds_barrier();
        if (var != 1) { if ((c & 1) == 0) S3_PREP(ka, qa, va); else S3_PREP(kb2, qb2, vb2); }
        lds_barrier();

        if (lat && w < 4) {
            f32x4 pt = (f32x4){0.f, 0.f, 0.f, 0.f};
#pragma unroll
            for (int kk = 0; kk < 4; ++kk)
                pt = __builtin_amdgcn_mfma_f32_16x16x32_bf16(*(const bf16x8*)(Ks + (w * 16 + l15) * S3_LD + kk * 32 + 8 * lg4), *(const bf16x8*)(Qs + (w * 16 + l15) * S3_LD + kk * 32 + 8 * lg4), pt, 0, 0, 0);
            float pm[4];
#pragma unroll
            for (int r = 0; r < 4; ++r) { const int sl = 4 * lg4 + r; const bool keep = dir ? (sl >= l15) : (sl <= l15); pm[r] = keep ? pt[r] : 0.f; }
            u32x2 o; o[0] = pk2(pm[0], pm[1]); o[1] = pk2(pm[2], pm[3]);
            *(u32x2*)(Ps + (w * 16 + l15) * S3_LDT + 4 * lg4) = o;
        }
        lds_barrier();
        for (int ib = 0; ib < (var == 2 ? 0 : 4); ++ib) {
            const int blk = dir ? 3 - ib : ib;
            const int cur = (c * 4 + ib) & 1;
            { const bf16x8 a = *(const bf16x8*)(KT + (blk * 128 + 32 * kt + l31) * S3_LDT + 8 * lh);
              const bf16x8 bb = *(const bf16x8*)(Vs + (32 * vt + l31) * S3_LDV + blk * 16 + 8 * lh);
              S = __builtin_amdgcn_mfma_f32_32x32x16_bf16(a, bb, S, 0, 0, 0);
#pragma unroll
              for (int g = 0; g < 4; ++g) { const f32x4 dv = *(const f32x4*)(Ds + blk * 128 + 32 * kt + 8 * g + 4 * lh);
                  S[4 * g] *= dv[0]; S[4 * g + 1] *= dv[1]; S[4 * g + 2] *= dv[2]; S[4 * g + 3] *= dv[3];
                  u32x2 o; o[0] = pk2(S[4 * g], S[4 * g + 1]); o[1] = pk2(S[4 * g + 2], S[4 * g + 3]);
                  *(u32x2*)(ST + ((cur ^ 1) * 64 + 32 * vt + l31) * S3_LD + 32 * kt + 8 * g + 4 * lh) = o; } }
            if (lat && w < 4) {
                f32x4 o = (f32x4){0.f, 0.f, 0.f, 0.f};
#pragma unroll
                for (int kk = 0; kk < 4; ++kk)
                    o = __builtin_amdgcn_mfma_f32_16x16x32_bf16(*(const bf16x8*)(ST + (cur * 64 + 16 * w + l15) * S3_LD + kk * 32 + 8 * lg4), *(const bf16x8*)(Qs + (blk * 16 + l15) * S3_LD + kk * 32 + 8 * lg4), o, 0, 0, 0);
                bf16x8 va = (bf16x8){0, 0, 0, 0, 0, 0, 0, 0}, pb = va;
                if (lg4 < 2) { va = *(const bf16x8*)(Vs + (16 * w + l15) * S3_LDV + blk * 16 + 8 * lg4); pb = *(const bf16x8*)(Ps + (blk * 16 + l15) * S3_LDT + 8 * lg4); }
                o = __builtin_amdgcn_mfma_f32_16x16x32_bf16(va, pb, o, 0, 0, 0);
                u32x2 ou; ou[0] = pk2(o[0], o[1]); ou[1] = pk2(o[2], o[3]);
                *(u32x2*)(Oo + (tokb + blk * 16 + l15) * 1024 + h * 128 + half * 64 + 16 * w + 4 * lg4) = ou;
            }
            lds_barrier();
        }
    }
    lds_barrier();
#undef S3_T0
#undef S3_LOAD
#undef S3_PREP
}
DEV void readout_item(const Params& p, int item) {
    const int tok = item * 8 + (tidx() >> 6), lane = tidx() & 63;
    const bf16_t* of = (const bf16_t*)(p.ws + WS_F + F_OF) + (size_t)tok * 1024 + lane * 16; const bf16_t* ob = (const bf16_t*)(p.ws + WS_F + F_OB) + (size_t)tok * 1024 + lane * 16;
    const bf16_t* gp = (const bf16_t*)(p.ws + WS_P + P1_G) + (size_t)tok * 1024 + lane * 16;
    const float* on = p.in[I_HGON] + (lane & 7) * 16;
    float o[16], gg[16]; float ss = 0.f;
    { const u32x4 a0 = *(const u32x4*)of, a1 = *(const u32x4*)(of + 8), b0 = *(const u32x4*)ob, b1 = *(const u32x4*)(ob + 8), g0 = *(const u32x4*)gp, g1 = *(const u32x4*)(gp + 8);
#pragma unroll
      for (int i = 0; i < 4; ++i) { o[2 * i] = bflo(a0[i]) + bflo(b0[i]); o[2 * i + 1] = bfhi(a0[i]) + bfhi(b0[i]); o[8 + 2 * i] = bflo(a1[i]) + bflo(b1[i]); o[8 + 2 * i + 1] = bfhi(a1[i]) + bfhi(b1[i]);
          gg[2 * i] = bflo(g0[i]); gg[2 * i + 1] = bfhi(g0[i]); gg[8 + 2 * i] = bflo(g1[i]); gg[8 + 2 * i + 1] = bfhi(g1[i]); } }
#pragma unroll
    for (int i = 0; i < 16; ++i) ss += o[i] * o[i];
    ss += __shfl_xor(ss, 1); ss += __shfl_xor(ss, 2); ss += __shfl_xor(ss, 4);
    const float rstd = rsqrtf(ss * (1.f / 128.f) + 1e-6f);
    bf16_t* M = (bf16_t*)(p.ws + WS_M) + (size_t)tok * 1024 + lane * 16;
    u32x4 o0, o1; float r[16];
#pragma unroll
    for (int i = 0; i < 16; ++i) r[i] = o[i] * rstd * on[i] * gg[i];
#pragma unroll
    for (int i = 0; i < 4; ++i) { o0[i] = pk2(r[2 * i], r[2 * i + 1]); o1[i] = pk2(r[8 + 2 * i], r[8 + 2 * i + 1]); }
    *(u32x4*)M = o0; *(u32x4*)(M + 8) = o1;
}

#ifndef HOST_EMU
#define XB_TMO      128
#define XB_XCNT(j)  (256  + 64 * (j))
#define XB_XSUB(j)  (1280 + 64 * (j))
#define XB_XGEN(j)  (2304 + 64 * (j))
#define XB_TOP      3328
#define XB_TOPGEN   3392
#define XCD_BAR_WORDS 3456
#define XB_SPIN_CAP (1u << 18)
#define LAS __attribute__((address_space(3)))

__device__ __forceinline__ unsigned xb_ld(unsigned* p)              { return __hip_atomic_load(p, __ATOMIC_RELAXED, __HIP_MEMORY_SCOPE_AGENT); }
__device__ __forceinline__ unsigned xb_add(unsigned* p, unsigned v) { return __hip_atomic_fetch_add(p, v, __ATOMIC_RELAXED, __HIP_MEMORY_SCOPE_AGENT); }
__device__ __forceinline__ unsigned xb_xcc_id() { return (unsigned)__builtin_amdgcn_s_getreg((3 << 11) | 20) & 0xFu; }
#define XB_SPIN(cond, bar) do { unsigned _sp = 0; while (cond) { __builtin_amdgcn_s_sleep(1); \
    if ((++_sp & 255u) == 0u) { if (xb_ld(&(bar)[XB_TMO])) break; if (_sp > XB_SPIN_CAP) { atomicAdd(&(bar)[XB_TMO], 1u); break; } } } } while (0)

struct XcdBarrier {
    unsigned* bar; unsigned x;
    volatile LAS unsigned* st;
};

__device__ __forceinline__ XcdBarrier xcd_barrier_post(unsigned* bar, volatile LAS unsigned* st) {
    XcdBarrier b; b.bar = bar; b.x = xb_xcc_id(); b.st = st;
    if (threadIdx.x == 0) (void)xb_add(&bar[XB_XCNT(b.x)], 1u);
    return b;
}
__device__ __forceinline__ void xcd_barrier_complete(unsigned* bar, unsigned x, unsigned& nloc, unsigned& nx) {
    const unsigned G = gridDim.x * gridDim.y * gridDim.z;
    unsigned sum, cnt, mine, sp = 0u;
    for (;;) {
        sum = 0u; cnt = 0u; mine = 0u;
#pragma unroll
        for (unsigned j = 0; j < 16; ++j) { const unsigned c = xb_ld(&bar[XB_XCNT(j)]); sum += c; cnt += (c > 0u) ? 1u : 0u; mine = (j == x) ? c : mine; }
        if (sum == G) break;
        __builtin_amdgcn_s_sleep(1);
        if ((++sp & 255u) == 0u) { if (xb_ld(&bar[XB_TMO])) break; if (sp > XB_SPIN_CAP) { atomicAdd(&bar[XB_TMO], 1u); break; } }
    }
    nloc = mine > 0u ? mine : 1u; nx = cnt > 0u ? cnt : 1u;
}

__device__ __forceinline__ void xcd_barrier(const XcdBarrier& b) {
    asm volatile("s_waitcnt vmcnt(0)" ::: "memory");
    __syncthreads();
    if (threadIdx.x == 0) {
        unsigned* bar = b.bar;
        __builtin_amdgcn_s_waitcnt(0);
        unsigned nloc = b.st[0], nx = b.st[1];
        if (nloc == 0u) { xcd_barrier_complete(bar, b.x, nloc, nx); b.st[0] = nloc; b.st[1] = nx; }
        const unsigned old = xb_add(&bar[XB_XSUB(b.x)], 1u);
        const unsigned gen = old / nloc;
        if (old + 1u == (gen + 1u) * nloc) {
            __builtin_amdgcn_fence(__ATOMIC_RELEASE, "agent");
            asm volatile("s_waitcnt vmcnt(0)" ::: "memory");
            const unsigned og = xb_add(&bar[XB_TOP], 1u);
            const unsigned tg = og / nx;
            if (og + 1u == (tg + 1u) * nx) xb_add(&bar[XB_TOPGEN], 1u);
            else XB_SPIN(xb_ld(&bar[XB_TOPGEN]) == tg, bar);
            __builtin_amdgcn_fence(__ATOMIC_ACQUIRE, "agent");
            xb_add(&bar[XB_XGEN(b.x)], 1u);
            asm volatile("s_waitcnt vmcnt(0)" ::: "memory");
        } else {
            XB_SPIN(xb_ld(&bar[XB_XGEN(b.x)]) == gen, bar);
            __builtin_amdgcn_fence(__ATOMIC_ACQUIRE, "agent");
            asm volatile("s_waitcnt vmcnt(0)" ::: "memory");
        }
    }
    __syncthreads();
}

#endif
#ifdef NOINLINE_PHASES
#define NOINL __device__ __attribute__((noinline))
#else
#define NOINL __device__ __forceinline__
#endif
__shared__ __attribute__((aligned(16))) unsigned char g_smem[SMEM_BYTES + 16];
#define PH_COMMON const int G = gridDim.x, bid = blockIdx.x; unsigned char* smem = g_smem; (void)smem; (void)G; (void)bid; \
    const bf16_t* A = (const bf16_t*)(p.ws + WS_A); const bf16_t* Mx = (const bf16_t*)(p.ws + WS_M); const bf16_t* W = (const bf16_t*)(p.ws + WS_W); (void)A; (void)Mx; (void)W;
DEV void tables_in_gemm_tail(const Params& p, int tab0, int ntab, int nunits) {
    const int G = gridDim.x, bid = blockIdx.x, busy = nunits % G;
    if (busy == 0) { for (int it = bid; it < ntab * P0_TAB; it += G) p0_table(p, tab0 + it / P0_TAB, it % P0_TAB); return; }
    if (bid < busy) return;
    for (int it = bid - busy; it < ntab * P0_TAB; it += G - busy) p0_table(p, tab0 + it / P0_TAB, it % P0_TAB);
}
NOINL void ph0(const Params& p) { PH_COMMON phase0(p, smem); }
NOINL void ph1(const Params& p) { PH_COMMON phase1(p, smem); }
NOINL void ph2(const Params& p) { PH_COMMON EpiL0InT e{p.ws}; gemm_pg8_T(A, W + W_IN0 / 2, T, 2304, smem, e); tables_in_gemm_tail(p, 0, 1, (T / 256) * 9); }
NOINL void ph3(const Params& p, int var = 0) { PH_COMMON phase3(p, smem, var); }
NOINL void ph4(const Params& p) { PH_COMMON EpiRes e{&p, 1, 0, 2048}; gemm_pg8_N(Mx, W + W_OUT0 / 2, T, 1024, smem, e); tables_in_gemm_tail(p, 1, 2, (T / 256) * 4); }
NOINL void ph5(const Params& p) { PH_COMMON for (int it = bid; it < T / 8; it += G) norm_rows_item(p, it, 0, p.in[I_N2G], 0, 3072); }
NOINL void ph6(const Params& p, int var = 0) { PH_COMMON (void)var; EpiBf16 e{(bf16_t*)(p.ws + WS_P), 2048}; gemm_pg8_N(A, W + W_Q0 / 2, T, 2048, smem, e); tables_in_gemm_tail(p, 3, 1, (T / 256) * 8); }
NOINL void ph7(const Params& p) { PH_COMMON topk_phase(p, 0, T, smem); }
NOINL void ph8(const Params& p) { PH_COMMON for (int it = bid; it < T / 8; it += G) peer_item(p, 0, it); }
NOINL void ph9(const Params& p, int var = 0) { PH_COMMON EpiHgT e{p.ws, p.in[I_HGLB], var}; gemm_pg8_T(A, W + W_IN1 / 2, T, 5120, smem, e); }
NOINL void ph10(const Params& p, int var = 0) { PH_COMMON for (int bi = bid; bi < NB * 32; bi += G) scan_block(p, bi, smem, var); }
NOINL void ph11(const Params& p) { PH_COMMON for (int it = bid; it < TL / 8; it += G) readout_item(p, it); }
NOINL void ph12(const Params& p) { PH_COMMON EpiRes e{&p, 0, 1, 2048}; gemm_pg8_N(Mx, W + W_OUT1 / 2, TL, 1024, smem, e); }
NOINL void ph13(const Params& p) { PH_COMMON for (int it = bid; it < TL / 8; it += G) norm_rows_item(p, it, 0, p.in[I_N2G] + 1024, 1, 3072); }
NOINL void ph14(const Params& p) { PH_COMMON EpiBf16 e{(bf16_t*)(p.ws + WS_P), 2048}; gemm_pg8_N(A, W + W_Q1 / 2, TL, 2048, smem, e); }
NOINL void ph15(const Params& p) { PH_COMMON topk_phase(p, 1, TL, smem); }
NOINL void ph16(const Params& p, int var = 0) { PH_COMMON for (int it = bid; it < TL / 8; it += G) peer_item(p, 1, it, var); }

constexpr int NPHASE = 17;
__global__ void __launch_bounds__(NT, 2) mega(Params p_in) {
    const int ph_lo = p_in.ph_lo, ph_hi = p_in.ph_hi;
#ifndef HOST_EMU
#define GBAR_MAKE() XcdBarrier gbar; gbar.bar = (unsigned*)(p_in.ws + WS_CTRL); gbar.x = xb_xcc_id(); gbar.st = (volatile LAS unsigned*)(LAS unsigned char*)(g_smem + SMEM_BYTES);
    if (ph_hi - ph_lo > 1) {
        volatile LAS unsigned* st = (volatile LAS unsigned*)(LAS unsigned char*)(g_smem + SMEM_BYTES);
        if (threadIdx.x == 0) { st[0] = 0u; st[1] = 0u; }
        __syncthreads();
        (void)xcd_barrier_post((unsigned*)(p_in.ws + WS_CTRL), st);
    }
#endif
#ifndef HOST_EMU
#define PH_BARRIER() do { GBAR_MAKE(); xcd_barrier(gbar); } while (0)
#define PH_PARAMS() unsigned long long kp = (unsigned long long)__builtin_amdgcn_kernarg_segment_ptr(); asm volatile("" : "+s"(kp) :: "memory"); \
        const Params& p = *(const Params*)(const __attribute__((address_space(4))) Params*)kp;
#else
#define PH_BARRIER() do {} while (0)
#define PH_PARAMS() const Params& p = p_in;
#endif
#ifdef REPEAT_MASK
#define PH_REPEAT(k, CALL) if ((REPEAT_MASK >> (k)) & 1) { PH_BARRIER(); { PH_PARAMS(); CALL; } }
#else
#define PH_REPEAT(k, CALL)
#endif
#ifdef ONLY_PHASE
#define PH_ON(k) ((k) == ONLY_PHASE)
#else
#define PH_ON(k) true
#endif
#if defined(REPEAT_MASK) && defined(HG_VAR)
#define RUN_PHASE9() if (ph_lo <= 9 && 9 < ph_hi) { if (9 > ph_lo) PH_BARRIER(); { PH_PARAMS(); ph9(p, HG_VAR); } PH_BARRIER(); { PH_PARAMS(); ph9(p, 0); } }
#else
#define RUN_PHASE9() RUN_PHASE(9, ph9(p))
#endif
#if defined(REPEAT_MASK) && defined(P3_VAR)
#define RUN_PHASE3() if (ph_lo <= 3 && 3 < ph_hi) { if (3 > ph_lo) PH_BARRIER(); { PH_PARAMS(); ph3(p, P3_VAR); } PH_BARRIER(); { PH_PARAMS(); ph3(p, 0); } }
#else
#define RUN_PHASE3() RUN_PHASE(3, ph3(p))
#endif
#define RUN_PHASE(k, CALL) if (PH_ON(k) && ph_lo <= (k) && (k) < ph_hi) { if ((k) > ph_lo) PH_BARRIER(); { PH_PARAMS(); CALL; } PH_REPEAT(k, CALL) }
    RUN_PHASE(0, ph0(p))  RUN_PHASE(1, ph1(p))  RUN_PHASE(2, ph2(p))  RUN_PHASE3()  RUN_PHASE(4, ph4(p))  RUN_PHASE(5, ph5(p))
    RUN_PHASE(6, ph6(p))  RUN_PHASE(7, ph7(p))  RUN_PHASE(8, ph8(p))  RUN_PHASE9()  RUN_PHASE(10, ph10(p)) RUN_PHASE(11, ph11(p))
    RUN_PHASE(12, ph12(p)) RUN_PHASE(13, ph13(p)) RUN_PHASE(14, ph14(p)) RUN_PHASE(15, ph15(p)) RUN_PHASE(16, ph16(p))
}

#ifndef HOST_EMU
extern "C" void kernel_launch(void* const* d_in, const int* in_sizes, int n_in, void* d_out, int out_size, void* d_ws, size_t ws_size, hipStream_t stream) {
    if (n_in != 29 || ws_size < WS_END || out_size != TL * 1024) { fprintf(stderr, "kernel_launch: unexpected sizes (n_in %d, ws %zu need %zu, out %d)\n", n_in, ws_size, (size_t)WS_END, out_size); return; }
    static int grid = 0;
    if (!grid) { int dev = 0, cus = 0; hipGetDevice(&dev); hipDeviceGetAttribute(&cus, hipDeviceAttributeMultiprocessorCount, dev); grid = cus > 0 ? cus : 256; }
    hipMemsetAsync((unsigned char*)d_ws + WS_CTRL, 0, CTRL_BYTES, stream);
    Params p{};
    for (int i = 0; i < 29; ++i) p.in[i] = (const float*)d_in[i];
    p.out = (float*)d_out; p.ws = (unsigned char*)d_ws;
#ifdef MULTI_LAUNCH
    for (int ph = 0; ph < NPHASE; ++ph) { p.ph_lo = ph; p.ph_hi = ph + 1; hipLaunchKernelGGL(mega, dim3(grid), dim3(NT), 0, stream, p); }
#else
    p.ph_lo = 0; p.ph_hi = NPHASE;
    hipLaunchKernelGGL(mega, dim3(grid), dim3(NT), 0, stream, p);
#endif
}
#endif
```

```cpp
#ifndef HOST_EMU
#include <hip/hip_runtime.h>
#include <cstdio>
#endif

#ifndef CFG_B
#define CFG_B 8
#define CFG_L 2048
#define CFG_LC 256
#endif
#define DEV __device__ __forceinline__
#ifndef HOST_EMU
#define SCHED_FENCE() __builtin_amdgcn_sched_barrier(0)
#endif
#ifdef HOST_EMU
#define SCHED_FENCE() do {} while (0)
#define __expf expf
#define __logf logf
#define __log2f log2f
#define __exp2f exp2f
#define __sinf sinf
#define __cosf cosf
#endif

typedef unsigned short bf16_t;
typedef short bf16x8 __attribute__((ext_vector_type(8)));
typedef float f32x16 __attribute__((ext_vector_type(16)));
typedef float f32x4 __attribute__((ext_vector_type(4)));
typedef unsigned u32x4 __attribute__((ext_vector_type(4)));
typedef unsigned u32x2 __attribute__((ext_vector_type(2)));
struct cf2 { float x, y; };

constexpr int NB = CFG_B, L = CFG_L, LC = CFG_LC, D = 1024;
constexpr int TL = NB * L, TC = NB * LC, T = TL + TC;
constexpr int NT = 512;
constexpr int NR = NB + 1;
constexpr int log4ceil(int n) { int s = 0, v = 1; while (v < n) { v *= 4; ++s; } return s; }
constexpr int FS_LAT = log4ceil(2 * L - 1), FS_CTX = log4ceil(2 * LC - 1);
constexpr int NF_LAT = 1 << (2 * FS_LAT), NF_CTX = 1 << (2 * FS_CTX);
static_assert(T % 256 == 0 && TL % 256 == 0 && L % 128 == 0 && LC % 128 == 0 && NB % 2 == 0, "shape");

constexpr size_t al256(size_t x) { return (x + 255) & ~(size_t)255; }
constexpr size_t WS_CTRL = 0, CTRL_BYTES = 65536;
constexpr size_t CTRL_HYNORM = 4096;
constexpr size_t WS_MOD = WS_CTRL + CTRL_BYTES;
constexpr size_t WS_H = al256(WS_MOD + (size_t)2 * NR * 6144 * 4);
constexpr size_t WS_A = al256(WS_H + (size_t)T * 1024 * 4);
constexpr size_t WS_P = al256(WS_A + (size_t)T * 1024 * 2);
constexpr size_t P_BYTES = (size_t)T * 5120 * 2;
constexpr size_t P_HYT_LAT = 0;
constexpr size_t P_HYT_CTX = P_HYT_LAT + (size_t)NB * 1536 * L * 2;
constexpr size_t P_Q0 = P_HYT_CTX + (size_t)NB * 1536 * LC * 2;
constexpr size_t P_K0 = P_Q0 + (size_t)T * 512 * 2;
constexpr size_t P_VT_LAT = P_K0 + (size_t)T * 128 * 2;
constexpr size_t P_VT_CTX = P_VT_LAT + (size_t)NB * 128 * L * 2;
static_assert(P_VT_CTX + (size_t)NB * 128 * LC * 2 <= P_BYTES, "P region");
constexpr size_t P1_KQT_LAT = 0;
constexpr size_t P1_KQT_CTX = P1_KQT_LAT + (size_t)NB * 3072 * L * 2;
constexpr size_t P1_G = P1_KQT_CTX + (size_t)NB * 3072 * LC * 2;
static_assert(P1_G + (size_t)TL * 1024 * 2 <= P_BYTES, "P region (layer 1)");
constexpr size_t WS_M = al256(WS_P + P_BYTES);
constexpr size_t WS_IDX = al256(WS_M + (size_t)T * 1024 * 2);
constexpr size_t WS_GATE = al256(WS_IDX + (size_t)T * 128 * 4);
constexpr size_t WS_UV = al256(WS_GATE + (size_t)T * 128 * 4);
constexpr size_t WS_S8 = WS_UV + (size_t)2 * 16384 * 1024;
constexpr size_t WS_W = al256(WS_S8 + (size_t)4 * 16384 * 4);
constexpr size_t W_IN0 = 0, W_OUT0 = W_IN0 + (size_t)2304 * 1024 * 2, W_IN1 = W_OUT0 + (size_t)1024 * 1024 * 2,
                 W_OUT1 = W_IN1 + (size_t)5120 * 1024 * 2, W_Q0 = W_OUT1 + (size_t)1024 * 1024 * 2, W_Q1 = W_Q0 + (size_t)2048 * 1024 * 2,
                 W_KEYS = W_Q1 + (size_t)2048 * 1024 * 2, W_BYTES = W_KEYS + (size_t)2 * 8 * 2 * 128 * 128 * 2;
constexpr size_t WS_F = al256(WS_W + W_BYTES);
constexpr size_t F_HRAW_LAT = 0;
constexpr size_t F_HRAW_CTX = F_HRAW_LAT + (size_t)2048 * L * 4;
constexpr size_t F_HF_LAT = F_HRAW_CTX + (size_t)2048 * LC * 4;
constexpr size_t F_HF_CTX = F_HF_LAT + (size_t)1024 * NF_LAT * 8;
constexpr size_t F_HYP_LAT = F_HF_CTX + (size_t)1024 * NF_CTX * 8;
constexpr size_t F_HYP_CTX = F_HYP_LAT + (size_t)(L / 64) * 2048 * 4;
constexpr size_t F_END = F_HYP_CTX + (size_t)(LC / 64) * 2048 * 4;
constexpr size_t F_OF = 0, F_OB = (size_t)TL * 1024 * 2;
constexpr size_t F_BYTES = F_END > 2 * F_OB ? F_END : 2 * F_OB;
constexpr size_t WS_END = al256(WS_F + F_BYTES);

struct Params { const float* in[29]; float* out; unsigned char* ws; int ph_lo, ph_hi; };
enum { I_X = 0, I_C, I_CTX, I_CCTX, I_ADAW, I_ADAB, I_N1G, I_N2G, I_FG, I_ABWIN, I_ABWOUT, I_HYCW, I_HYCB, I_HYW1, I_HYB1, I_HYW2, I_HYB2, I_HYW3,
       I_HYFREQ, I_HYSKIP, I_SINK, I_HGWIN, I_HGWOUT, I_HGLB, I_HGON, I_PWQ, I_PKEYS, I_PU, I_PV };

constexpr int SMEM_BYTES = 147456;

#ifndef HOST_EMU
DEV int tidx() { int t = threadIdx.x; asm volatile("" : "+v"(t)); return t; }
#else
DEV int tidx() { return (int)threadIdx.x; }
#endif
#ifndef HOST_EMU
DEV void lds_barrier() { asm volatile("s_waitcnt lgkmcnt(0)" ::: "memory"); __builtin_amdgcn_s_barrier(); asm volatile("" ::: "memory"); }
#else
DEV void lds_barrier() { __syncthreads(); }
#endif
#ifndef HOST_EMU
typedef __bf16 bf16n2 __attribute__((ext_vector_type(2)));
DEV unsigned pk2(float lo, float hi) { bf16n2 v; v[0] = (__bf16)lo; v[1] = (__bf16)hi; return __builtin_bit_cast(unsigned, v); }
DEV unsigned f2bf(float f) { return (unsigned)__builtin_bit_cast(unsigned short, (__bf16)f); }
#else
DEV unsigned f2bf(float f) { unsigned u = __builtin_bit_cast(unsigned, f); return (u + 0x7fffu + ((u >> 16) & 1u)) >> 16; }
DEV unsigned pk2(float lo, float hi) { return f2bf(lo) | (f2bf(hi) << 16); }
#endif
DEV float bf2f(unsigned h) { return __builtin_bit_cast(float, (h & 0xffffu) << 16); }
DEV float bflo(unsigned u) { return __builtin_bit_cast(float, u << 16); }
DEV float bfhi(unsigned u) { return __builtin_bit_cast(float, u & 0xffff0000u); }
DEV float silu_f(float x) { return x * __builtin_amdgcn_rcpf(1.f + __expf(-x)); }
DEV float sigmoid_f(float x) { return __builtin_amdgcn_rcpf(1.f + __expf(-x)); }
DEV float wave_sum(float v) {
#pragma unroll
    for (int m = 32; m >= 1; m >>= 1) v += __shfl_xor(v, m);
    return v;
}
DEV int mod_row(int tok) { return tok < TL ? tok / L : NB; }

DEV void p0_mod(const Params& p, int item, unsigned char* smem) {
    const int l = item / 96, col0 = (item % 96) * 64, tid = tidx();
    float* sc = (float*)smem;
    float* red = sc + NR * 1024;
    for (int i = tid; i < NR * 1024; i += NT) { const int r = i >> 10, k = i & 1023; const float c = r < NB ? p.in[I_C][r * 1024 + k] : p.in[I_CCTX][k]; sc[i] = c / (1.f + expf(-c)); }
    __syncthreads();
    const int kq = tid >> 6, col = tid & 63;
    float acc[NR];
#pragma unroll
    for (int r = 0; r < NR; ++r) acc[r] = 0.f;
    const float* w = p.in[I_ADAW] + (size_t)l * 1024 * 6144 + col0 + col;
#pragma unroll 16
    for (int k = kq * 128; k < kq * 128 + 128; ++k) {
        const float wv = w[(size_t)k * 6144];
#pragma unroll
        for (int r = 0; r < NR; ++r) acc[r] += sc[r * 1024 + k] * wv;
    }
#pragma unroll
    for (int r = 0; r < NR; ++r) red[(kq * NR + r) * 64 + col] = acc[r];
    __syncthreads();
    float* mod = (float*)(p.ws + WS_MOD);
    for (int i = tid; i < NR * 64; i += NT) {
        const int r = i >> 6, c = i & 63; float s = 0.f;
        for (int q = 0; q < 8; ++q) s += red[(q * NR + r) * 64 + c];
        mod[((size_t)l * NR + r) * 6144 + col0 + c] = s + p.in[I_ADAB][l * 6144 + col0 + c];
    }
    __syncthreads();
}
DEV void p0_transpose(const float* W, bf16_t* Wt, int N, int tile, unsigned char* smem) {
    float* ts = (float*)smem;
    const int ntn = N / 256, kt = tile / ntn, nt = tile % ntn, k0 = kt * 64, n0 = nt * 256, tid = tidx();
    f32x4 rv[8];
#pragma unroll
    for (int m = 0; m < 8; ++m) { const int i = tid + NT * m, kk = i >> 6, c4 = i & 63; rv[m] = *(const f32x4*)(W + (size_t)(k0 + kk) * N + n0 + c4 * 4); }
#pragma unroll
    for (int m = 0; m < 8; ++m) { const int i = tid + NT * m, kk = i >> 6, c4 = i & 63; *(f32x4*)(ts + kk * 260 + c4 * 4) = rv[m]; }
    __syncthreads();
#pragma unroll
    for (int m = 0; m < 4; ++m) { const int i = tid + NT * m, nn = i >> 3, k8 = i & 7;
        u32x4 o;
#pragma unroll
        for (int e = 0; e < 4; ++e) o[e] = pk2(ts[(k8 * 8 + 2 * e) * 260 + nn], ts[(k8 * 8 + 2 * e + 1) * 260 + nn]);
        *(u32x4*)(Wt + (size_t)(n0 + nn) * 1024 + k0 + k8 * 8) = o; }
    __syncthreads();
}
DEV void p0_convert(const float* src, bf16_t* dst, int item) {
    const int tid = tidx();
#pragma unroll
    for (int i = 0; i < 8; ++i) {
        const size_t e = (size_t)item * 16384 + (size_t)(i * NT + tid) * 4;
        const f32x4 v = *(const f32x4*)(src + e);
        u32x2 o; o[0] = pk2(v[0], v[1]); o[1] = pk2(v[2], v[3]);
        *(u32x2*)(dst + e) = o;
    }
}
typedef float f32x2 __attribute__((ext_vector_type(2)));
typedef float f32x32 __attribute__((ext_vector_type(32)));
typedef unsigned u32x6 __attribute__((ext_vector_type(6)));
DEV void p0_table(const Params& p, int tab, int item) {
    const int lane = tidx() & 63, li = lane & 31, half = lane >> 5, layer = tab >> 1, isv = tab & 1;
#pragma unroll 1
    for (int pass = 0; pass < 2; ++pass) {
        const int row = item * 32 + pass * 16 + (tidx() >> 6) * 2 + half;
        const float* src = (isv ? p.in[I_PV] : p.in[I_PU]) + ((size_t)layer * 16384 + row) * 1024 + li * 32;
        f32x4 v[8]; float mx = 0.f, sq = 0.f;
#pragma unroll
        for (int i = 0; i < 8; ++i) { v[i] = *(const f32x4*)(src + 4 * i); mx = fmaxf(mx, fmaxf(fmaxf(fabsf(v[i][0]), fabsf(v[i][1])), fmaxf(fabsf(v[i][2]), fabsf(v[i][3]))));
            sq += v[i][0] * v[i][0] + v[i][1] * v[i][1] + v[i][2] * v[i][2] + v[i][3] * v[i][3]; }
#pragma unroll
        for (int m = 16; m >= 1; m >>= 1) { mx = fmaxf(mx, __shfl_xor(mx, m)); sq += __shfl_xor(sq, m); }
        float rowscale;
        if (isv) {
            const float sc = mx > 0.f ? 6.f / mx : 1.f; rowscale = mx > 0.f ? mx * (1.f / 6.f) : 1.f;
            const f32x2 pr4 = __builtin_amdgcn_cvt_scalef32_pk_f32_fp4(__builtin_amdgcn_cvt_scalef32_pk_fp4_f32(0u, 1.0f, 0.0f, 1.0f, 0), 1.0f, 0);
            const bool swp = pr4[0] != 1.0f;
            u32x4 w;
#pragma unroll
            for (int d = 0; d < 4; ++d) { unsigned x = 0u;
                x = __builtin_amdgcn_cvt_scalef32_pk_fp4_f32(x, (swp ? v[2 * d][1] : v[2 * d][0]) * sc, (swp ? v[2 * d][0] : v[2 * d][1]) * sc, 1.0f, 0);
                x = __builtin_amdgcn_cvt_scalef32_pk_fp4_f32(x, (swp ? v[2 * d][3] : v[2 * d][2]) * sc, (swp ? v[2 * d][2] : v[2 * d][3]) * sc, 1.0f, 1);
                x = __builtin_amdgcn_cvt_scalef32_pk_fp4_f32(x, (swp ? v[2 * d + 1][1] : v[2 * d + 1][0]) * sc, (swp ? v[2 * d + 1][0] : v[2 * d + 1][1]) * sc, 1.0f, 2);
                x = __builtin_amdgcn_cvt_scalef32_pk_fp4_f32(x, (swp ? v[2 * d + 1][3] : v[2 * d + 1][2]) * sc, (swp ? v[2 * d + 1][2] : v[2 * d + 1][3]) * sc, 1.0f, 3);
                w[d] = x; }
            *(u32x4*)(p.ws + WS_UV + ((size_t)layer * 16384 + row) * 1024 + 512 + li * 16) = w;
        } else {
            float step = fminf(0.3352f * sqrtf(sq * (1.f / 1024.f)), mx * (1.0001f / 7.5f)); if (!(step > 0.f)) step = 1.f;
            const float inv = 1.f / step; rowscale = 0.5f * step;
            u32x4 w;
#pragma unroll
            for (int d = 0; d < 4; ++d) { unsigned x = 0u;
#pragma unroll
                for (int e = 0; e < 8; ++e) { const float f = fminf(fmaxf(floorf(v[2 * d + (e >> 2)][e & 3] * inv), -8.f), 7.f); x |= ((unsigned)(int)f & 15u) << (4 * e); }
                w[d] = x; }
            *(u32x4*)(p.ws + WS_UV + ((size_t)layer * 16384 + row) * 1024 + li * 16) = w;
        }
        if (li == 0) ((float*)(p.ws + WS_S8))[tab * 16384 + row] = rowscale;
    }
}
DEV void p0_filter(const Params& p, int set, int chunk, int cb, unsigned char* smem) {
    const int Ls = set ? LC : L, l0 = chunk * 64, tid = tidx();
    float* z = (float*)smem;
    float* hd1 = z + 64 * 34;
    float* hd2 = hd1 + 64 * 65;
    const float* w1 = p.in[I_HYW1]; const float* b1 = p.in[I_HYB1]; const float* w2 = p.in[I_HYW2]; const float* b2 = p.in[I_HYB2];
    const float* w3 = p.in[I_HYW3]; const float* fq = p.in[I_HYFREQ];
    for (int i = tid; i < 64 * 33; i += NT) {
        const int pp = i / 33, f = i % 33, l = l0 + pp; float val;
        if (f == 0) val = (float)l / (float)(Ls - 1);
        else { const int jb = (f - 1) & 15; const float fj = 1e-4f + (float)jb * ((15.f - 1e-4f) / 15.f); const float a = fj * (6.283185307179586f * (float)l / (float)Ls); val = f <= 16 ? __cosf(a) : -__sinf(a); }
        z[pp * 34 + f] = val;
    }
    __syncthreads();
    {
        const int j = tid & 63, p0 = tid >> 6;
        float wc[64], acc[8];
#pragma unroll
        for (int f = 0; f < 33; ++f) wc[f] = w1[f * 64 + j];
#pragma unroll
        for (int m = 0; m < 8; ++m) { float sacc = b1[j];
#pragma unroll
            for (int f = 0; f < 33; ++f) sacc = fmaf(z[(p0 + 8 * m) * 34 + f], wc[f], sacc);
            acc[m] = sacc; }
#pragma unroll
        for (int m = 0; m < 8; ++m) hd1[(p0 + 8 * m) * 65 + j] = __sinf(fq[j] * acc[m]);
        __syncthreads();
#pragma unroll
        for (int f = 0; f < 64; ++f) wc[f] = w2[f * 64 + j];
#pragma unroll
        for (int m = 0; m < 8; ++m) { float sacc = b2[j];
#pragma unroll
            for (int f = 0; f < 64; ++f) sacc = fmaf(hd1[(p0 + 8 * m) * 65 + f], wc[f], sacc);
            acc[m] = sacc; }
#pragma unroll
        for (int m = 0; m < 8; ++m) hd2[(p0 + 8 * m) * 65 + j] = __sinf(fq[j] * acc[m]);
        __syncthreads();
    }
    const float max_decay = -15.350567286626973f, min_decay = -3.0701134573253945f;
    float* hraw = (float*)(p.ws + WS_F + (set ? F_HRAW_CTX : F_HRAW_LAT));
    float* hyn = (float*)(p.ws + WS_F + (set ? F_HYP_CTX : F_HYP_LAT)) + (size_t)chunk * 2048;
    {
        const int o = cb * NT + tid;
        const int c = o & 511; const float delta = fabsf(min_decay + (float)c * ((max_decay - min_decay) / 511.f));
        float asum = 0.f;
        float* dst = hraw + (size_t)o * Ls + l0;
        for (int ph = 0; ph < 2; ++ph) {
            float acc[32];
#pragma unroll
            for (int pp = 0; pp < 32; ++pp) acc[pp] = 0.f;
#pragma unroll 1
            for (int j0 = 0; j0 < 64; j0 += 16) {
                float wv[16];
#pragma unroll
                for (int j = 0; j < 16; ++j) wv[j] = w3[(j0 + j) * 2048 + o];
#pragma unroll
                for (int j = 0; j < 16; ++j) {
#pragma unroll
                    for (int pp = 0; pp < 32; ++pp) acc[pp] = fmaf(hd2[(ph * 32 + pp) * 65 + j0 + j], wv[j], acc[pp]);
                    SCHED_FENCE();
                }
            }
#pragma unroll
            for (int q4 = 0; q4 < 8; ++q4) {
                f32x4 v;
#pragma unroll
                for (int e = 0; e < 4; ++e) { const int pp = q4 * 4 + e; const float tl = (float)(l0 + ph * 32 + pp) / (float)(Ls - 1); const float val = acc[pp] * expf(-tl * delta); v[e] = val; asum += fabsf(val); }
                *(f32x4*)(dst + ph * 32 + q4 * 4) = v;
            }
        }
        hyn[o] = asum;
    }
    __syncthreads();
}

constexpr int P0_MOD = 192, P0_TR_IN0 = 16 * 9, P0_TR_OUT0 = 64, P0_TR_IN1 = 16 * 20, P0_TR_OUT1 = 64, P0_TR_Q = 16 * 8, P0_KEYS = 32, P0_TAB = 512,
              P0_FILT = 4 * (L / 64 + LC / 64);
DEV void phase0(const Params& p, unsigned char* smem) {
    bf16_t* W = (bf16_t*)(p.ws + WS_W);
    const int total = P0_MOD + P0_FILT + P0_TR_IN0 + P0_TR_OUT0 + P0_TR_IN1 + P0_TR_OUT1 + 2 * P0_TR_Q + P0_KEYS;
    for (int it = blockIdx.x; it < total; it += gridDim.x) {
        int i = it;
        if (i < P0_MOD) { p0_mod(p, i, smem); continue; } i -= P0_MOD;
        if (i < P0_FILT) { const int ch = i >> 2, cb = i & 3; if (ch < L / 64) p0_filter(p, 0, ch, cb, smem); else p0_filter(p, 1, ch - L / 64, cb, smem); continue; } i -= P0_FILT;
        if (i < P0_TR_IN0) { p0_transpose(p.in[I_ABWIN], W + W_IN0 / 2, 2304, i, smem); continue; } i -= P0_TR_IN0;
        if (i < P0_TR_OUT0) { p0_transpose(p.in[I_ABWOUT], W + W_OUT0 / 2, 1024, i, smem); continue; } i -= P0_TR_OUT0;
        if (i < P0_TR_IN1) { p0_transpose(p.in[I_HGWIN], W + W_IN1 / 2, 5120, i, smem); continue; } i -= P0_TR_IN1;
        if (i < P0_TR_OUT1) { p0_transpose(p.in[I_HGWOUT], W + W_OUT1 / 2, 1024, i, smem); continue; } i -= P0_TR_OUT1;
        if (i < P0_TR_Q) { p0_transpose(p.in[I_PWQ], W + W_Q0 / 2, 2048, i, smem); continue; } i -= P0_TR_Q;
        if (i < P0_TR_Q) { p0_transpose(p.in[I_PWQ] + (size_t)1024 * 2048, W + W_Q1 / 2, 2048, i, smem); continue; } i -= P0_TR_Q;
        p0_convert(p.in[I_PKEYS], W + W_KEYS / 2, i);
    }
}

DEV const float* h_row(const Params& p, int layer_src_inputs, int tok) {
    if (layer_src_inputs) return tok < TL ? p.in[I_X] + (size_t)tok * 1024 : p.in[I_CTX] + (size_t)(tok - TL) * 1024;
    return (const float*)(p.ws + WS_H) + (size_t)tok * 1024;
}
DEV void norm_row_store(const Params& p, const f32x4 (&v)[4], int tok, const float* g, int layer, int sh_off, int lane) {
    float ss = 0.f;
#pragma unroll
    for (int i = 0; i < 4; ++i) ss += v[i][0] * v[i][0] + v[i][1] * v[i][1] + v[i][2] * v[i][2] + v[i][3] * v[i][3];
    ss = wave_sum(ss);
    const float rstd = rsqrtf(ss * (1.f / 1024.f) + 1e-6f);
    const float* mod = (const float*)(p.ws + WS_MOD) + ((size_t)layer * NR + mod_row(tok)) * 6144 + sh_off;
    bf16_t* A = (bf16_t*)(p.ws + WS_A) + (size_t)tok * 1024;
#pragma unroll
    for (int i = 0; i < 4; ++i) {
        const int c = i * 256 + lane * 4;
        const f32x4 gg = *(const f32x4*)(g + c), sh = *(const f32x4*)(mod + c), sc = *(const f32x4*)(mod + 1024 + c);
        u32x2 o;
        o[0] = pk2(v[i][0] * rstd * gg[0] * (1.f + sc[0]) + sh[0], v[i][1] * rstd * gg[1] * (1.f + sc[1]) + sh[1]);
        o[1] = pk2(v[i][2] * rstd * gg[2] * (1.f + sc[2]) + sh[2], v[i][3] * rstd * gg[3] * (1.f + sc[3]) + sh[3]);
        *(u32x2*)(A + c) = o;
    }
}
DEV void norm_rows_item(const Params& p, int item, int from_inputs, const float* g, int layer, int sh_off) {
    const int tok = item * 8 + (tidx() >> 6), lane = tidx() & 63;
    const float* src = h_row(p, from_inputs, tok);
    f32x4 v[4];
#pragma unroll
    for (int i = 0; i < 4; ++i) v[i] = *(const f32x4*)(src + i * 256 + lane * 4);
    norm_row_store(p, v, tok, g, layer, sh_off, lane);
}

DEV cf2 cmul(cf2 a, cf2 b) { cf2 r; r.x = a.x * b.x - a.y * b.y; r.y = a.x * b.y + a.y * b.x; return r; }
DEV cf2 twid(int k, float invN) { cf2 r; const float a = (float)k * invN; r.x = __builtin_amdgcn_cosf(a); r.y = -__builtin_amdgcn_sinf(a); return r; }
DEV int fsw(int i) { return i ^ ((i >> 4) & 15) ^ (((i >> 8) & 1) << 4); }
DEV void bfly4_fwd(cf2& a0, cf2& a1, cf2& a2, cf2& a3) {
    cf2 t0, t1, t2, t3; t0.x = a0.x + a2.x; t0.y = a0.y + a2.y; t1.x = a0.x - a2.x; t1.y = a0.y - a2.y; t2.x = a1.x + a3.x; t2.y = a1.y + a3.y;
    const float dx = a1.x - a3.x, dy = a1.y - a3.y; t3.x = dy; t3.y = -dx;
    a0.x = t0.x + t2.x; a0.y = t0.y + t2.y; a1.x = t1.x + t3.x; a1.y = t1.y + t3.y; a2.x = t0.x - t2.x; a2.y = t0.y - t2.y; a3.x = t1.x - t3.x; a3.y = t1.y - t3.y;
}
DEV void bfly4_inv(cf2& c0, cf2& c1, cf2& c2, cf2& c3) {
    cf2 t0, t1, t2, t3; t0.x = c0.x + c2.x; t0.y = c0.y + c2.y; t1.x = c0.x - c2.x; t1.y = c0.y - c2.y; t2.x = c1.x + c3.x; t2.y = c1.y + c3.y;
    const float dx = c1.x - c3.x, dy = c1.y - c3.y; t3.x = -dy; t3.y = dx;
    c0.x = t0.x + t2.x; c0.y = t0.y + t2.y; c1.x = t1.x + t3.x; c1.y = t1.y + t3.y; c2.x = t0.x - t2.x; c2.y = t0.y - t2.y; c3.x = t1.x - t3.x; c3.y = t1.y - t3.y;
}
DEV void fft_stage4(cf2* buf, int S, int s, int g, int G, bool inv) {
    const int N = 1 << (2 * S); const float invN = 1.f / (float)N;
    const int lm = 2 * (S - s), m = 1 << lm, q = m >> 2;
    for (int bf = g; bf < (N >> 2); bf += G) {
        const int j = bf & (q - 1), base = ((bf >> (lm - 2)) << lm) + j, tw = j << (2 * s);
        cf2 a0 = buf[fsw(base)], a1 = buf[fsw(base + q)], a2 = buf[fsw(base + 2 * q)], a3 = buf[fsw(base + 3 * q)];
        if (!inv) { bfly4_fwd(a0, a1, a2, a3); a1 = cmul(a1, twid(tw, invN)); a2 = cmul(a2, twid(2 * tw, invN)); a3 = cmul(a3, twid(3 * tw, invN)); }
        else { cf2 w1 = twid(tw, invN), w2 = twid(2 * tw, invN), w3 = twid(3 * tw, invN); w1.y = -w1.y; w2.y = -w2.y; w3.y = -w3.y; a1 = cmul(a1, w1); a2 = cmul(a2, w2); a3 = cmul(a3, w3); bfly4_inv(a0, a1, a2, a3); }
        buf[fsw(base)] = a0; buf[fsw(base + q)] = a1; buf[fsw(base + 2 * q)] = a2; buf[fsw(base + 3 * q)] = a3;
    }
}
DEV void fft_stage16(cf2* buf, int S, int s, int g, int G, bool inv) {
    const int N = 1 << (2 * S); const float invN = 1.f / (float)N;
    const int lm = 2 * (S - s), m = 1 << lm, q = m >> 2, q2 = q >> 2;
    for (int u = g; u < (N >> 4); u += G) {
        const int j2 = u & (q2 - 1), base = ((u >> (lm - 4)) << lm) + j2;
        cf2 x[4][4];
#pragma unroll
        for (int c = 0; c < 4; ++c)
#pragma unroll
            for (int c2 = 0; c2 < 4; ++c2) x[c][c2] = buf[fsw(base + c * q + c2 * q2)];
        if (!inv) {
#pragma unroll
            for (int c2 = 0; c2 < 4; ++c2) {
                const int tw = (j2 + c2 * q2) << (2 * s);
                bfly4_fwd(x[0][c2], x[1][c2], x[2][c2], x[3][c2]);
                x[1][c2] = cmul(x[1][c2], twid(tw, invN)); x[2][c2] = cmul(x[2][c2], twid(2 * tw, invN)); x[3][c2] = cmul(x[3][c2], twid(3 * tw, invN));
                SCHED_FENCE();
            }
            const int tw2 = j2 << (2 * (s + 1));
            const cf2 v1 = twid(tw2, invN), v2 = twid(2 * tw2, invN), v3 = twid(3 * tw2, invN);
#pragma unroll
            for (int c = 0; c < 4; ++c) {
                bfly4_fwd(x[c][0], x[c][1], x[c][2], x[c][3]);
                x[c][1] = cmul(x[c][1], v1); x[c][2] = cmul(x[c][2], v2); x[c][3] = cmul(x[c][3], v3);
            }
        } else {
            const int tw2 = j2 << (2 * (s + 1));
            cf2 v1 = twid(tw2, invN), v2 = twid(2 * tw2, invN), v3 = twid(3 * tw2, invN); v1.y = -v1.y; v2.y = -v2.y; v3.y = -v3.y;
#pragma unroll
            for (int c = 0; c < 4; ++c) {
                x[c][1] = cmul(x[c][1], v1); x[c][2] = cmul(x[c][2], v2); x[c][3] = cmul(x[c][3], v3);
                bfly4_inv(x[c][0], x[c][1], x[c][2], x[c][3]);
            }
#pragma unroll
            for (int c2 = 0; c2 < 4; ++c2) {
                const int tw = (j2 + c2 * q2) << (2 * s);
                cf2 w1 = twid(tw, invN), w2 = twid(2 * tw, invN), w3 = twid(3 * tw, invN); w1.y = -w1.y; w2.y = -w2.y; w3.y = -w3.y;
                x[1][c2] = cmul(x[1][c2], w1); x[2][c2] = cmul(x[2][c2], w2); x[3][c2] = cmul(x[3][c2], w3);
                bfly4_inv(x[0][c2], x[1][c2], x[2][c2], x[3][c2]);
                SCHED_FENCE();
            }
        }
#pragma unroll
        for (int c = 0; c < 4; ++c)
#pragma unroll
            for (int c2 = 0; c2 < 4; ++c2) buf[fsw(base + c * q + c2 * q2)] = x[c][c2];
    }
}
DEV void fft_fwd(cf2* buf, int S, int g, int G) {
    int s = 0;
    for (; s + 1 < S; s += 2) { fft_stage16(buf, S, s, g, G, false); __syncthreads(); }
    if (s < S) { fft_stage4(buf, S, s, g, G, false); __syncthreads(); }
}
DEV void fft_inv(cf2* buf, int S, int g, int G) {
    int s = S - 1;
    if (S & 1) { fft_stage4(buf, S, s, g, G, true); __syncthreads(); --s; }
    for (; s >= 1; s -= 2) { fft_stage16(buf, S, s - 1, g, G, true); __syncthreads(); }
}
DEV void hf_item(const Params& p, int set, int pi, unsigned char* smem) {
    const int Ls = set ? LC : L, S = set ? FS_CTX : FS_LAT, N = 1 << (2 * S);
    const int gi = tidx() >> 8, g = tidx() & 255, idx = pi * 2 + gi, o = idx >> 9, c = idx & 511;
    cf2* buf = (cf2*)smem + (size_t)gi * N;
    const float* hraw = (const float*)(p.ws + WS_F + (set ? F_HRAW_CTX : F_HRAW_LAT));
    const float* hyn = (const float*)(p.ws + WS_F + (set ? F_HYP_CTX : F_HYP_LAT));
    float nsum = 0.f;
    for (int ch = 0; ch < Ls / 64; ++ch) nsum += hyn[(size_t)ch * 2048 + o * 1024 + c] + hyn[(size_t)ch * 2048 + o * 1024 + 512 + c];
    const float inv = 1.f / nsum;
    const float* hf = hraw + (size_t)(o * 1024 + c) * Ls; const float* hb = hraw + (size_t)(o * 1024 + 512 + c) * Ls;
#pragma unroll 4
    for (int k = g; k < N; k += 256) { float re = 0.f; if (k < Ls) re = hf[k] * inv; else if (k > N - Ls) re = hb[N - k] * inv; cf2 v; v.x = re; v.y = 0.f; buf[fsw(k)] = v; }
    __syncthreads();
    fft_fwd(buf, S, g, 256);
    cf2* HF = (cf2*)(p.ws + WS_F + (set ? F_HF_CTX : F_HF_LAT)) + (size_t)(o * 512 + c) * N;
    for (int k = g; k < N; k += 256) HF[k] = buf[fsw(k)];
    __syncthreads();
}
constexpr int P1_NORM = T / 8, P1_HF = 512;
DEV void phase1(const Params& p, unsigned char* smem) {
    const int total = P1_NORM + 2 * P1_HF;
    for (int it = blockIdx.x; it < total; it += gridDim.x) {
        if (it < P1_NORM) norm_rows_item(p, it, 1, p.in[I_N1G], 0, 0);
        else if (it < P1_NORM + P1_HF) hf_item(p, 0, it - P1_NORM, smem);
        else hf_item(p, 1, it - P1_NORM - P1_HF, smem);
    }
}

constexpr int G_LDA = 72;
template <class Epi>
DEV void gemm_tile(const bf16_t* __restrict__ A, const bf16_t* __restrict__ Wt, int m0, int n0, unsigned char* smem, const Epi& epi, int var = 0) {
    bf16_t* As = (bf16_t*)smem;
    bf16_t* Bs = As + 2 * 256 * G_LDA;
    const int tid = tidx(), lane = tid & 63, w = tid >> 6, wm = w >> 1, wn = w & 1;
    f32x16 acc[2][2];
#pragma unroll
    for (int i = 0; i < 2; ++i)
#pragma unroll
        for (int j = 0; j < 2; ++j)
#pragma unroll
            for (int r = 0; r < 16; ++r) acc[i][j][r] = 0.f;
    u32x4 ra[4], rb[2];
    const bf16_t* Ag = A + (size_t)m0 * 1024; const bf16_t* Bg = Wt + (size_t)n0 * 1024;
#define GLOAD(k0) do { \
        _Pragma("unroll") for (int i = 0; i < 4; ++i) { const int id = tid + NT * i, row = id >> 3, kc = id & 7; ra[i] = *(const u32x4*)(Ag + (size_t)row * 1024 + (k0) + kc * 8); } \
        _Pragma("unroll") for (int i = 0; i < 2; ++i) { const int id = tid + NT * i, row = id >> 3, kc = id & 7; rb[i] = *(const u32x4*)(Bg + (size_t)row * 1024 + (k0) + kc * 8); } } while (0)
#define LSTORE(buf_) do { \
        _Pragma("unroll") for (int i = 0; i < 4; ++i) { const int id = tid + NT * i, row = id >> 3, kc = id & 7; *(u32x4*)(As + ((buf_) * 256 + row) * G_LDA + kc * 8) = ra[i]; } \
        _Pragma("unroll") for (int i = 0; i < 2; ++i) { const int id = tid + NT * i, row = id >> 3, kc = id & 7; *(u32x4*)(Bs + ((buf_) * 128 + row) * G_LDA + kc * 8) = rb[i]; } } while (0)
    GLOAD(0); LSTORE(0); __syncthreads();
    for (int kt = 0; kt < (var == 2 ? 1 : 16); ++kt) {
        const int buf = kt & 1;
        if (kt + 1 < 16) GLOAD((kt + 1) * 64);
        const bf16_t* as = As + (buf * 256 + wm * 64 + (lane & 31)) * G_LDA + 8 * (lane >> 5);
        const bf16_t* bs = Bs + (buf * 128 + wn * 64 + (lane & 31)) * G_LDA + 8 * (lane >> 5);
#pragma unroll
        for (int kk = 0; kk < 4; ++kk) {
            const bf16x8 a0 = *(const bf16x8*)(as + kk * 16), a1 = *(const bf16x8*)(as + 32 * G_LDA + kk * 16);
            const bf16x8 b0 = *(const bf16x8*)(bs + kk * 16), b1 = *(const bf16x8*)(bs + 32 * G_LDA + kk * 16);
            acc[0][0] = __builtin_amdgcn_mfma_f32_32x32x16_bf16(a0, b0, acc[0][0], 0, 0, 0);
            acc[0][1] = __builtin_amdgcn_mfma_f32_32x32x16_bf16(a0, b1, acc[0][1], 0, 0, 0);
            acc[1][0] = __builtin_amdgcn_mfma_f32_32x32x16_bf16(a1, b0, acc[1][0], 0, 0, 0);
            acc[1][1] = __builtin_amdgcn_mfma_f32_32x32x16_bf16(a1, b1, acc[1][1], 0, 0, 0);
        }
        if (kt + 1 < 16) LSTORE(buf ^ 1);
        __syncthreads();
    }
#ifndef HOST_EMU
    if (var == 1) { asm volatile("" :: "v"(acc[0][0]), "v"(acc[0][1]), "v"(acc[1][0]), "v"(acc[1][1])); return; }
#endif
#pragma unroll
    for (int mi = 0; mi < 2; ++mi)
#pragma unroll
        for (int ni = 0; ni < 2; ++ni)
#pragma unroll
            for (int rg = 0; rg < 4; ++rg) {
                const int row = m0 + wm * 64 + mi * 32 + 8 * rg + 4 * (lane >> 5), col = n0 + wn * 64 + ni * 32 + (lane & 31);
                epi(row, col, acc[mi][ni][rg * 4 + 0], acc[mi][ni][rg * 4 + 1], acc[mi][ni][rg * 4 + 2], acc[mi][ni][rg * 4 + 3]);
            }
}
template <class Epi>
DEV void gemm_tile256(const bf16_t* __restrict__ A, const bf16_t* __restrict__ Wt, int m0, int n0, unsigned char* smem, const Epi& epi) {
    bf16_t* As = (bf16_t*)smem;
    bf16_t* Bs = As + 2 * 256 * G_LDA;
    const int tid = tidx(), lane = tid & 63, w = tid >> 6, wm = w >> 2, wn = w & 3;
    f32x16 acc[4][2];
#pragma unroll
    for (int i = 0; i < 4; ++i)
#pragma unroll
        for (int j = 0; j < 2; ++j)
#pragma unroll
            for (int r = 0; r < 16; ++r) acc[i][j][r] = 0.f;
    u32x4 ra[4], rb[4];
    const bf16_t* Ag = A + (size_t)m0 * 1024; const bf16_t* Bg = Wt + (size_t)n0 * 1024;
#define GLOAD2(k0) do { \
        _Pragma("unroll") for (int i = 0; i < 4; ++i) { const int id = tid + NT * i, row = id >> 3, kc = id & 7; ra[i] = *(const u32x4*)(Ag + (size_t)row * 1024 + (k0) + kc * 8); rb[i] = *(const u32x4*)(Bg + (size_t)row * 1024 + (k0) + kc * 8); } } while (0)
#define LSTORE2(buf_) do { \
        _Pragma("unroll") for (int i = 0; i < 4; ++i) { const int id = tid + NT * i, row = id >> 3, kc = id & 7; *(u32x4*)(As + ((buf_) * 256 + row) * G_LDA + kc * 8) = ra[i]; *(u32x4*)(Bs + ((buf_) * 256 + row) * G_LDA + kc * 8) = rb[i]; } } while (0)
    GLOAD2(0); LSTORE2(0); __syncthreads();
    for (int kt = 0; kt < 16; ++kt) {
        const int buf = kt & 1;
        if (kt + 1 < 16) GLOAD2((kt + 1) * 64);
        const bf16_t* as = As + (buf * 256 + wm * 128 + (lane & 31)) * G_LDA + 8 * (lane >> 5);
        const bf16_t* bs = Bs + (buf * 256 + wn * 64 + (lane & 31)) * G_LDA + 8 * (lane >> 5);
#pragma unroll
        for (int kk = 0; kk < 4; ++kk) {
            bf16x8 af[4], bfr[2];
#pragma unroll
            for (int i = 0; i < 4; ++i) af[i] = *(const bf16x8*)(as + i * 32 * G_LDA + kk * 16);
#pragma unroll
            for (int j = 0; j < 2; ++j) bfr[j] = *(const bf16x8*)(bs + j * 32 * G_LDA + kk * 16);
#pragma unroll
            for (int i = 0; i < 4; ++i)
#pragma unroll
                for (int j = 0; j < 2; ++j) acc[i][j] = __builtin_amdgcn_mfma_f32_32x32x16_bf16(af[i], bfr[j], acc[i][j], 0, 0, 0);
        }
        if (kt + 1 < 16) LSTORE2(buf ^ 1);
        __syncthreads();
    }
#undef GLOAD2
#undef LSTORE2
#pragma unroll
    for (int mi = 0; mi < 4; ++mi)
#pragma unroll
        for (int ni = 0; ni < 2; ++ni)
#pragma unroll
            for (int rg = 0; rg < 4; ++rg) {
                const int row = m0 + wm * 128 + mi * 32 + 8 * rg + 4 * (lane >> 5), col = n0 + wn * 64 + ni * 32 + (lane & 31);
                epi(row, col, acc[mi][ni][rg * 4 + 0], acc[mi][ni][rg * 4 + 1], acc[mi][ni][rg * 4 + 2], acc[mi][ni][rg * 4 + 3]);
            }
}
namespace pg8 {
#ifndef HOST_EMU
#define PG8_LAS __attribute__((address_space(3)))
#else
#define PG8_LAS
#endif
typedef unsigned short bf16_t;
constexpr int BM = 256, BK = 64, HALF = 128, HTB = HALF * BK * 2  , STAGE_BYTES = 8 * HTB, NXCD = 8, WGM = 8;

__host__ __device__ __forceinline__ int lds_byte(int r, int c) { const int st = (r >> 4) * 2 + (c >> 5), rr = r & 15, cc = c & 31, ob = rr * 64 + cc * 2; return st * 1024 + (ob ^ (((ob >> 9) & 1) << 5)); }
__host__ __device__ __forceinline__ void stage_rc(int b, int& R, int& C) { const int st = b / 1024, sb = b % 1024, swz = sb ^ (((sb >> 9) & 1) << 5); R = (st >> 1) * 16 + swz / 64; C = (st & 1) * 32 + (swz % 64) / 2; }
__host__ __device__ __forceinline__ int perm32(int rho) { const int n = rho >> 4, i = rho & 15; return 8 * (i >> 2) + 4 * n + (i & 3); }

struct Unit { int pm, pn; };
struct Gemm { const bf16_t* A; const bf16_t* Bt; int M, N, K; };

struct StaticOrder {
    int nM, nN, nwg, G, c;
    __host__ __device__ void init(int M, int N, int G_, int c_) { nM = M / BM; nN = N / BM; nwg = nM * nN; G = G_; c = c_; }
    __host__ __device__ bool next(int i, Unit& u) const {
        const long L = (long)i * G + c; if (L >= nwg) return false;
        int wgid = (int)L; { const int q = nwg / NXCD, r = nwg % NXCD, xcd = wgid % NXCD, off = wgid / NXCD; wgid = (xcd < r ? xcd * (q + 1) : r * (q + 1) + (xcd - r) * q) + off; }
        const int nig = WGM * nN, gid = wgid / nig, fm = gid * WGM, gsz = (nM - fm) < WGM ? (nM - fm) : WGM;
        u.pm = fm + ((wgid % nig) % gsz); u.pn = (wgid % nig) / gsz; return true;
    }
    __device__ __forceinline__ void a_ready(const Unit&) const {}
    __device__ __forceinline__ void done(const Unit&) const {}
};
template <class Epi, class Sched, bool STAMP = false>
__device__ __forceinline__ void gemm_phase(PG8_LAS unsigned char* lds, const Gemm g, const Sched& S, const Epi& E, unsigned long long* stamps = nullptr) {
    const int tid = tidx(), wid = __builtin_amdgcn_readfirstlane(tid >> 6), lane = tid & 63, wr = wid >> 2, wc = wid & 3, fr = lane & 15, fq = lane >> 4;
    const int K = g.K, nt = K / BK;
    int ts_lo = 0, ts_hi = 0, nts = 0; const unsigned long long rt_entry = 0ull; (void)rt_entry; (void)ts_lo; (void)ts_hi; (void)nts;
#define PG8_STAMP() do { if (STAMP && wid == 0 && nts < 64) { const unsigned long long _c = 0ull; \
        ts_lo = (lane == nts) ? (int)(unsigned)_c : ts_lo; ts_hi = (lane == nts) ? (int)(unsigned)(_c >> 32) : ts_hi; ++nts; } } while (0)
    PG8_STAMP();
    unsigned voffA[2], voffB[2];
#pragma unroll
    for (int i = 0; i < 2; ++i) { int R, C; stage_rc(tid * 16 + i * 8192, R, C); const int Rb = Epi::PERM ? ((R & ~31) + perm32(R & 31)) : R;
        voffA[i] = (unsigned)(R * K + C) * 2u; voffB[i] = (unsigned)(Rb * K + C) * 2u; }
    const size_t kstep = (size_t)(BK * 2);
    const size_t hstep = (size_t)HALF * K * 2;
    const size_t tstep = 2 * hstep;
    const unsigned ldsw = (unsigned)wid * 1024u;
    const int aoff = lds_byte(wr * 64 + fr, fq * 8), boff = lds_byte(wc * 32 + fr, fq * 8);
#define PG8_SA(b, h) (((b) * 2 + (h)) * HTB)
#define PG8_SB(b, h) ((4 + (b) * 2 + (h)) * HTB)
#define PG8_STAGE(bufoff, gbase, voff) do { _Pragma("unroll") for (int _i = 0; _i < 2; ++_i) \
        __builtin_amdgcn_global_load_lds((const unsigned*)((const char*)(gbase) + (voff)[_i]), (PG8_LAS unsigned*)(lds + (bufoff) + ldsw + _i * 8192), 16, 0, 0); } while (0)
#define PG8_LDA(dst, b, h) do { _Pragma("unroll") for (int m = 0; m < 4; ++m) _Pragma("unroll") for (int k = 0; k < 2; ++k) dst[m][k] = *(const PG8_LAS bf16x8*)(lds + PG8_SA(b, h) + aoff + m * 2048 + k * 1024); } while (0)
#define PG8_LDB(dst, b, h) do { _Pragma("unroll") for (int n = 0; n < 2; ++n) _Pragma("unroll") for (int k = 0; k < 2; ++k) dst[n][k] = *(const PG8_LAS bf16x8*)(lds + PG8_SB(b, h) + boff + n * 2048 + k * 1024); } while (0)
#define PG8_MMA(ai, bj, At, Bt) do { __builtin_amdgcn_s_setprio(1); _Pragma("unroll") for (int m = 0; m < 4; ++m) _Pragma("unroll") for (int n = 0; n < 2; ++n) _Pragma("unroll") for (int k = 0; k < 2; ++k) \
        acc[ai][bj][m][n] = __builtin_amdgcn_mfma_f32_16x16x32_bf16(Bt[n][k], At[m][k], acc[ai][bj][m][n], 0, 0, 0); __builtin_amdgcn_s_setprio(0); } while (0)
#ifndef HOST_EMU
#define PG8_WAIT_V(n) asm volatile("s_waitcnt vmcnt(" #n ")" ::: "memory")
#define PG8_WAIT_L(n) asm volatile("s_waitcnt lgkmcnt(" #n ")" ::: "memory")
#else
#define PG8_WAIT_V(n) do {} while (0)
#define PG8_WAIT_L(n) do {} while (0)
#endif
#define PG8_BAR __builtin_amdgcn_s_barrier()
#define PG8_SCHED __builtin_amdgcn_sched_barrier(0)
    Unit cur, nxt; int ui = 0;
    if (!S.next(0, cur)) return;
    f32x4 acc[2][2][4][2];
#pragma unroll
    for (int a = 0; a < 2; ++a)
#pragma unroll
        for (int b = 0; b < 2; ++b)
#pragma unroll
            for (int m = 0; m < 4; ++m)
#pragma unroll
                for (int n = 0; n < 2; ++n) acc[a][b][m][n] = (f32x4){0.f, 0.f, 0.f, 0.f};
    bf16x8 At[4][2], B0[2][2], B1[2][2];
    const char* cA = (const char*)g.A + (size_t)cur.pm * tstep; const char* cB = (const char*)g.Bt + (size_t)cur.pn * tstep;
    S.a_ready(cur);
    PG8_STAGE(PG8_SB(0, 0), cB, voffB); PG8_STAGE(PG8_SA(0, 0), cA, voffA); PG8_STAGE(PG8_SB(0, 1), cB + hstep, voffB); PG8_STAGE(PG8_SA(0, 1), cA + hstep, voffA);
    if (wr == 1) PG8_BAR;
    PG8_WAIT_V(4); PG8_BAR;
    PG8_STAGE(PG8_SB(1, 0), cB + kstep, voffB); PG8_STAGE(PG8_SA(1, 0), cA + kstep, voffA); PG8_STAGE(PG8_SB(1, 1), cB + hstep + kstep, voffB);
    PG8_WAIT_V(6); PG8_BAR;
    PG8_STAMP();
    for (;;) {
        const bool has_next = S.next(ui + 1, nxt);
        const char* nA = has_next ? (const char*)g.A + (size_t)nxt.pm * tstep : cA; const char* nB = has_next ? (const char*)g.Bt + (size_t)nxt.pn * tstep : cB;
        for (int t = 0; t < nt; t += 2) {
            const bool last = (t == nt - 2);
            const char* a1 = cA + (size_t)(t + 1) * kstep;
            const char* a2 = last ? nA : cA + (size_t)(t + 2) * kstep; const char* b2 = last ? nB : cB + (size_t)(t + 2) * kstep;
            const char* a3 = a2 + kstep; const char* b3 = b2 + kstep;
            if (last && has_next) S.a_ready(nxt);
            PG8_LDB(B0, 0, 0); PG8_SCHED; PG8_LDA(At, 0, 0); PG8_STAGE(PG8_SA(1, 1), a1 + hstep, voffA);
            PG8_WAIT_L(8); PG8_BAR; PG8_WAIT_L(0); PG8_MMA(0, 0, At, B0); PG8_BAR; PG8_SCHED;
            PG8_LDB(B1, 0, 1); PG8_STAGE(PG8_SB(0, 0), b2, voffB);
            PG8_BAR; PG8_WAIT_L(0); PG8_MMA(0, 1, At, B1); PG8_BAR;
            PG8_LDA(At, 0, 1); PG8_STAGE(PG8_SA(0, 0), a2, voffA);
            PG8_BAR; PG8_WAIT_L(0); PG8_MMA(1, 0, At, B0); PG8_BAR; PG8_SCHED;
            PG8_STAGE(PG8_SB(0, 1), b2 + hstep, voffB);
            PG8_WAIT_V(6); PG8_BAR; PG8_MMA(1, 1, At, B1); PG8_BAR;
            PG8_LDB(B0, 1, 0); PG8_SCHED; PG8_LDA(At, 1, 0); PG8_STAGE(PG8_SA(0, 1), a2 + hstep, voffA);
            PG8_WAIT_L(8); PG8_BAR; PG8_WAIT_L(0); PG8_MMA(0, 0, At, B0); PG8_BAR; PG8_SCHED;
            PG8_LDB(B1, 1, 1); PG8_STAGE(PG8_SB(1, 0), b3, voffB);
            PG8_BAR; PG8_WAIT_L(0); PG8_MMA(0, 1, At, B1); PG8_BAR;
            PG8_LDA(At, 1, 1); PG8_STAGE(PG8_SA(1, 0), a3, voffA);
            PG8_BAR; PG8_WAIT_L(0); PG8_MMA(1, 0, At, B0); PG8_BAR; PG8_SCHED;
            PG8_STAGE(PG8_SB(1, 1), b3 + hstep, voffB);
            PG8_WAIT_V(6); PG8_BAR; PG8_MMA(1, 1, At, B1); PG8_BAR;
        }
        PG8_STAMP();
        if constexpr (!Epi::AFTER_DRAIN) { E(acc, cur, wr, wc, fr, fq); S.done(cur); }
        PG8_STAMP();
        if (!has_next) break;
#pragma unroll
        for (int a = 0; a < 2; ++a)
#pragma unroll
            for (int b = 0; b < 2; ++b)
#pragma unroll
                for (int m = 0; m < 4; ++m)
#pragma unroll
                    for (int n = 0; n < 2; ++n) acc[a][b][m][n] = (f32x4){0.f, 0.f, 0.f, 0.f};
        cur = nxt; cA = nA; cB = nB; ++ui;
    }
    PG8_WAIT_V(0);
    if (wr == 0) PG8_BAR;
    PG8_BAR;
    if constexpr (Epi::AFTER_DRAIN) { E.fused(acc, cur, wr, wc, fr, fq, lds, wid, lane); S.done(cur); }
    PG8_STAMP();
    if (STAMP && wid == 0) { stamps[lane] = lane < nts ? (((unsigned long long)(unsigned)ts_hi << 32) | (unsigned)ts_lo) : 0ull;
        if (lane == 62) stamps[62] = rt_entry; if (lane == 63) stamps[63] = 0ull; }
#undef PG8_STAMP
#undef PG8_SA
#undef PG8_SB
#undef PG8_STAGE
#undef PG8_LDA
#undef PG8_LDB
#undef PG8_MMA
#undef PG8_WAIT_V
#undef PG8_WAIT_L
#undef PG8_BAR
#undef PG8_SCHED
}
}
template <class Epi> struct PgEpiT {
    static constexpr bool PERM = true, AFTER_DRAIN = false;
    Epi e;
    DEV void operator()(const f32x4 (&acc)[2][2][4][2], const pg8::Unit& u, int wr, int wc, int fr, int fq) const {
        float pre[2][4];
#pragma unroll
        for (int ai = 0; ai < 2; ++ai)
#pragma unroll
            for (int m = 0; m < 4; ++m) pre[ai][m] = e.colpre(u.pm * 256 + ai * 128 + wr * 64 + m * 16 + fr);
#pragma unroll
        for (int ai = 0; ai < 2; ++ai)
#pragma unroll
            for (int m = 0; m < 4; ++m) {
#pragma unroll
                for (int bj = 0; bj < 2; ++bj) {
                    const int wcol = u.pm * 256 + ai * 128 + wr * 64 + m * 16 + fr, tok0 = u.pn * 256 + bj * 128 + wc * 32 + 8 * fq;
                    const float v[8] = {acc[ai][bj][m][0][0], acc[ai][bj][m][0][1], acc[ai][bj][m][0][2], acc[ai][bj][m][0][3], acc[ai][bj][m][1][0], acc[ai][bj][m][1][1], acc[ai][bj][m][1][2], acc[ai][bj][m][1][3]};
                    e.tok8(tok0, wcol, v, pre[ai][m]);
                }
                SCHED_FENCE();
            }
    }
};
template <class Epi> struct PgEpiN {
    static constexpr bool PERM = true, AFTER_DRAIN = false;
    Epi e;
    DEV void operator()(const f32x4 (&acc)[2][2][4][2], const pg8::Unit& u, int wr, int wc, int fr, int fq) const {
#pragma unroll
        for (int ai = 0; ai < 2; ++ai)
#pragma unroll
            for (int m = 0; m < 4; ++m) {
#pragma unroll
                for (int bj = 0; bj < 2; ++bj) {
                    const int tok = u.pm * 256 + ai * 128 + wr * 64 + m * 16 + fr, wcol0 = u.pn * 256 + bj * 128 + wc * 32 + 8 * fq;
                    const float v[8] = {acc[ai][bj][m][0][0], acc[ai][bj][m][0][1], acc[ai][bj][m][0][2], acc[ai][bj][m][0][3], acc[ai][bj][m][1][0], acc[ai][bj][m][1][1], acc[ai][bj][m][1][2], acc[ai][bj][m][1][3]};
                    e.col8(tok, wcol0, v);
                }
                SCHED_FENCE();
            }
    }
};
template <class Epi>
DEV void gemm_pg8_T(const bf16_t* A, const bf16_t* Wt, int Mtok, int N, unsigned char* smem, const Epi& epi) {
    pg8::Gemm g{Wt, A, N, Mtok, 1024};
    pg8::StaticOrder S; S.init(N, Mtok, (int)gridDim.x, (int)blockIdx.x);
    PgEpiT<Epi> E{epi};
    pg8::gemm_phase<PgEpiT<Epi>, pg8::StaticOrder, false>((PG8_LAS unsigned char*)smem, g, S, E);
    __syncthreads();
}
template <class Epi>
DEV void gemm_pg8_N(const bf16_t* A, const bf16_t* Wt, int Mtok, int N, unsigned char* smem, const Epi& epi) {
    pg8::Gemm g{A, Wt, Mtok, N, 1024};
    pg8::StaticOrder S; S.init(Mtok, N, (int)gridDim.x, (int)blockIdx.x);
    PgEpiN<Epi> E{epi};
    pg8::gemm_phase<PgEpiN<Epi>, pg8::StaticOrder, false>((PG8_LAS unsigned char*)smem, g, S, E);
    __syncthreads();
}
struct EpiL0In {
    unsigned char* ws;
    DEV void operator()(int row, int col, float v0, float v1, float v2, float v3) const {
        u32x2 o; o[0] = pk2(v0, v1); o[1] = pk2(v2, v3);
        const bool lat = row < TL; const int b = lat ? row / L : (row - TL) / LC, t = lat ? row - b * L : (row - TL) - b * LC, Lx = lat ? L : LC;
        const int cu = __builtin_amdgcn_readfirstlane(col & ~127);
        if (cu < 1536) { bf16_t* d = (bf16_t*)(ws + WS_P + (lat ? P_HYT_LAT : P_HYT_CTX)) + ((size_t)b * 1536 + col) * Lx + t; *(u32x2*)d = o; }
        else if (cu < 2048) { bf16_t* d = (bf16_t*)(ws + WS_P + P_Q0) + (size_t)row * 512 + (col - 1536); d[0] = (bf16_t)f2bf(v0); d[512] = (bf16_t)f2bf(v1); d[1024] = (bf16_t)f2bf(v2); d[1536] = (bf16_t)f2bf(v3); }
        else if (cu < 2176) { bf16_t* d = (bf16_t*)(ws + WS_P + P_K0) + (size_t)row * 128 + (col - 2048); d[0] = (bf16_t)f2bf(v0); d[128] = (bf16_t)f2bf(v1); d[256] = (bf16_t)f2bf(v2); d[384] = (bf16_t)f2bf(v3); }
        else { bf16_t* d = (bf16_t*)(ws + WS_P + (lat ? P_VT_LAT : P_VT_CTX)) + ((size_t)b * 128 + (col - 2176)) * Lx + t; *(u32x2*)d = o; }
    }
};
struct EpiL0InT {
    unsigned char* ws;
    DEV float colpre(int) const { return 0.f; }
    DEV void tok8(int row, int col, const float (&v)[8], float) const {
        const bool lat = row < TL; const int b = lat ? row / L : (row - TL) / LC, t = lat ? row - b * L : (row - TL) - b * LC, Lx = lat ? L : LC;
        u32x4 o; o[0] = pk2(v[0], v[1]); o[1] = pk2(v[2], v[3]); o[2] = pk2(v[4], v[5]); o[3] = pk2(v[6], v[7]);
        if (col < 1536) { *(u32x4*)((bf16_t*)(ws + WS_P + (lat ? P_HYT_LAT : P_HYT_CTX)) + ((size_t)b * 1536 + col) * Lx + t) = o; }
        else if (col < 2048) { bf16_t* d = (bf16_t*)(ws + WS_P + P_Q0) + (size_t)row * 512 + (col - 1536);
#pragma unroll
            for (int i = 0; i < 8; ++i) d[i * 512] = (bf16_t)f2bf(v[i]); }
        else if (col < 2176) { bf16_t* d = (bf16_t*)(ws + WS_P + P_K0) + (size_t)row * 128 + (col - 2048);
#pragma unroll
            for (int i = 0; i < 8; ++i) d[i * 128] = (bf16_t)f2bf(v[i]); }
        else { *(u32x4*)((bf16_t*)(ws + WS_P + (lat ? P_VT_LAT : P_VT_CTX)) + ((size_t)b * 128 + (col - 2176)) * Lx + t) = o; }
    }
};
struct EpiBf16 {
    bf16_t* out; int ld;
    DEV void col8(int row, int col0, const float (&v)[8]) const { u32x4 o; o[0] = pk2(v[0], v[1]); o[1] = pk2(v[2], v[3]); o[2] = pk2(v[4], v[5]); o[3] = pk2(v[6], v[7]); *(u32x4*)(out + (size_t)row * ld + col0) = o; }
    DEV void operator()(int row, int col, float v0, float v1, float v2, float v3) const {
        bf16_t* d = out + (size_t)row * ld + col; d[0] = (bf16_t)f2bf(v0); d[ld] = (bf16_t)f2bf(v1); d[2 * ld] = (bf16_t)f2bf(v2); d[3 * ld] = (bf16_t)f2bf(v3);
    }
};
struct EpiHg {
    unsigned char* ws; const float* lg;
    DEV void operator()(int row, int col, float v0, float v1, float v2, float v3) const {
        float vv[4] = {v0, v1, v2, v3};
        const bool lat = row < TL; const int b = lat ? row / L : (row - TL) / LC, t = lat ? row - b * L : (row - TL) - b * LC, Lx = lat ? L : LC;
        const int cu = __builtin_amdgcn_readfirstlane(col & ~255);
        if (cu >= 3072 && cu < 4096) {
            bf16_t* d = (bf16_t*)(ws + WS_M) + (lat ? (size_t)0 : (size_t)NB * 1024 * L) + ((size_t)b * 1024 + (col - 3072)) * Lx + t;
            u32x2 o; o[0] = pk2(v0, v1); o[1] = pk2(v2, v3); *(u32x2*)d = o;
            return;
        }
        if (cu < 1024 || cu >= 4096) {
#pragma unroll
            for (int i = 0; i < 4; ++i) vv[i] = silu_f(vv[i]);
        } else {
            const int c = col - 1024;
            const float oml = 1.f - 1.f / (1.f + __expf(lg[c] - lg[2048 + c]));
#pragma unroll
            for (int i = 0; i < 4; ++i) vv[i] = oml * __builtin_amdgcn_rcpf(1.f + __expf(vv[i]));
        }
        if (cu < 3072) {
            bf16_t* d = (bf16_t*)(ws + WS_P + (lat ? P1_KQT_LAT : P1_KQT_CTX)) + ((size_t)b * 3072 + col) * Lx + t;
            u32x2 o; o[0] = pk2(vv[0], vv[1]); o[1] = pk2(vv[2], vv[3]); *(u32x2*)d = o;
        } else {
            if (!lat) return;
            bf16_t* d = (bf16_t*)(ws + WS_P + P1_G) + (size_t)row * 1024 + (col - 4096); d[0] = (bf16_t)f2bf(vv[0]); d[1024] = (bf16_t)f2bf(vv[1]); d[2048] = (bf16_t)f2bf(vv[2]); d[3072] = (bf16_t)f2bf(vv[3]);
        }
    }
};
struct EpiHgT {
    unsigned char* ws; const float* lg; int plain;
    DEV float colpre(int col) const {
        const int cu = __builtin_amdgcn_readfirstlane(col & ~255);
        if (cu < 1024 || cu >= 3072) return 0.f;
        const int c = col - 1024; return 1.f - __builtin_amdgcn_rcpf(1.f + __expf(lg[c] - lg[2048 + c]));
    }
    DEV void tok8(int row, int col, const float (&v)[8], float oml) const {
        const bool lat = row < TL; const int b = lat ? row / L : (row - TL) / LC, t = lat ? row - b * L : (row - TL) - b * LC, Lx = lat ? L : LC;
        const int cu = __builtin_amdgcn_readfirstlane(col & ~255);
        float vv[8];
#pragma unroll
        for (int i = 0; i < 8; ++i) vv[i] = v[i];
        if (cu >= 3072 && cu < 4096) {
            u32x4 o; o[0] = pk2(vv[0], vv[1]); o[1] = pk2(vv[2], vv[3]); o[2] = pk2(vv[4], vv[5]); o[3] = pk2(vv[6], vv[7]);
            *(u32x4*)((bf16_t*)(ws + WS_M) + (lat ? (size_t)0 : (size_t)NB * 1024 * L) + ((size_t)b * 1024 + (col - 3072)) * Lx + t) = o;
            return;
        }
        if (plain) {} else if (cu < 1024 || cu >= 4096) {
#pragma unroll
            for (int i = 0; i < 8; ++i) vv[i] = silu_f(vv[i]);
        } else {
#pragma unroll
            for (int i = 0; i < 8; ++i) vv[i] = oml * __builtin_amdgcn_rcpf(1.f + __expf(vv[i]));
        }
        if (cu < 3072) {
            u32x4 o; o[0] = pk2(vv[0], vv[1]); o[1] = pk2(vv[2], vv[3]); o[2] = pk2(vv[4], vv[5]); o[3] = pk2(vv[6], vv[7]);
            *(u32x4*)((bf16_t*)(ws + WS_P + (lat ? P1_KQT_LAT : P1_KQT_CTX)) + ((size_t)b * 3072 + col) * Lx + t) = o;
        } else {
            if (!lat) return;
            bf16_t* d = (bf16_t*)(ws + WS_P + P1_G) + (size_t)row * 1024 + (col - 4096);
#pragma unroll
            for (int i = 0; i < 8; ++i) d[i * 1024] = (bf16_t)f2bf(vv[i]);
        }
    }
};
struct EpiRes {
    const Params* p; int from_inputs, layer, goff;
    DEV void col8(int row, int col0, const float (&v)[8]) const {
        float* H = (float*)(p->ws + WS_H) + (size_t)row * 1024 + col0; const float* hin = h_row(*p, from_inputs, row) + col0;
        const float* gt = (const float*)(p->ws + WS_MOD) + ((size_t)layer * NR + mod_row(row)) * 6144 + goff + col0;
        const f32x4 h0 = *(const f32x4*)hin, h1 = *(const f32x4*)(hin + 4), g0 = *(const f32x4*)gt, g1 = *(const f32x4*)(gt + 4);
        f32x4 o0, o1;
#pragma unroll
        for (int i = 0; i < 4; ++i) { o0[i] = h0[i] + g0[i] * v[i]; o1[i] = h1[i] + g1[i] * v[4 + i]; }
        *(f32x4*)H = o0; *(f32x4*)(H + 4) = o1;
    }
    DEV void operator()(int row, int col, float v0, float v1, float v2, float v3) const {
        float* H = (float*)(p->ws + WS_H) + (size_t)row * 1024 + col;
        const float* hin = h_row(*p, from_inputs, row) + col;
        const float gt = ((const float*)(p->ws + WS_MOD))[((size_t)layer * NR + mod_row(row)) * 6144 + goff + col];
        const float h0 = hin[0], h1 = hin[1024], h2 = hin[2048], h3 = hin[3072];
        H[0] = h0 + gt * v0; H[1024] = h1 + gt * v1; H[2048] = h2 + gt * v2; H[3072] = h3 + gt * v3;
    }
};

struct HyRaw { u32x4 mid; unsigned short lft, rgt; };
DEV HyRaw hy_load(const bf16_t* row, int t0, int Lx) { HyRaw r; r.mid = *(const u32x4*)(row + t0); r.lft = t0 > 0 ? row[t0 - 1] : (unsigned short)0; r.rgt = t0 + 8 < Lx ? row[t0 + 8] : (unsigned short)0; return r; }
DEV void hy_conv8(const HyRaw& r, float w0, float w1, float w2, float b, float (&o)[8]) {
    float x[10]; x[0] = bf2f(r.lft); x[9] = bf2f(r.rgt);
#pragma unroll
    for (int i = 0; i < 4; ++i) { x[1 + 2 * i] = bflo(r.mid[i]); x[2 + 2 * i] = bfhi(r.mid[i]); }
#pragma unroll
    for (int i = 0; i < 8; ++i) o[i] = w0 * x[i] + w1 * x[i + 1] + w2 * x[i + 2] + b;
}
template <int TPC>
DEV void hyena_item(const Params& p, int set, int item, unsigned char* smem, bool nofft = false, bool nostore = false) {
    const int Ls = set ? LC : L, S = set ? FS_CTX : FS_LAT, N = 1 << (2 * S);
    constexpr int CPR = NT / TPC, NR8 = 8 / CPR;
    const int gi = tidx() / TPC, g = tidx() % TPC;
    const int bp = item >> 6, c0 = (item & 63) * 8, ba = bp * 2, bb = ba + 1;
    cf2* buf = (cf2*)smem + (size_t)gi * N;
    bf16_t* stg = (bf16_t*)(smem + (size_t)CPR * N * 8);
    const bf16_t* hy = (const bf16_t*)(p.ws + WS_P + (set ? P_HYT_CTX : P_HYT_LAT));
    const float* cw = p.in[I_HYCW]; const float* cb = p.in[I_HYCB];
    const cf2* HF = (const cf2*)(p.ws + WS_F + (set ? F_HF_CTX : F_HF_LAT));
    const float invN = 1.f / (float)N;
    const int t0 = g * 8; const bool own = t0 < Ls;
    HyRaw rv[2], rx1[2];
    cf2 hfr[16];
#define HY_FETCH(cc) do { if (own) { \
        rv[0] = hy_load(hy + ((size_t)ba * 1536 + (cc)) * Ls, t0, Ls); rv[1] = hy_load(hy + ((size_t)bb * 1536 + (cc)) * Ls, t0, Ls); \
        rx1[0] = hy_load(hy + ((size_t)ba * 1536 + 512 + (cc)) * Ls, t0, Ls); rx1[1] = hy_load(hy + ((size_t)bb * 1536 + 512 + (cc)) * Ls, t0, Ls); } } while (0)
    HY_FETCH(c0 + gi);
#pragma unroll 1
    for (int rd = 0; rd < NR8; ++rd) {
        const int cs = rd * CPR + gi, c = c0 + cs;
#pragma unroll
        for (int u = 0; u < 16; ++u) { hfr[u].x = 0.f; hfr[u].y = 0.f; if (g + TPC * u < N) hfr[u] = HF[(size_t)c * N + g + TPC * u]; }
        float za[8], zb[8];
        if (own) { hy_conv8(rv[0], cw[c], cw[1536 + c], cw[3072 + c], cb[c], za); hy_conv8(rv[1], cw[c], cw[1536 + c], cw[3072 + c], cb[c], zb); }
        for (int t = g; t < N; t += TPC) { if (t >= Ls) { cf2 z; z.x = 0.f; z.y = 0.f; buf[fsw(t)] = z; } }
        if (own) {
#pragma unroll
            for (int i = 0; i < 8; ++i) { cf2 v; v.x = za[i]; v.y = zb[i]; buf[fsw(t0 + i)] = v; }
        }
        __syncthreads();
#pragma unroll
        for (int n = 0; n < 2; ++n) {
            if (!nofft) fft_fwd(buf, S, g, TPC);
#pragma unroll
            for (int u = 0; u < 16; ++u) { const int k = g + TPC * u; if (k < N) buf[fsw(k)] = cmul(buf[fsw(k)], hfr[u]); }
            if (n == 0) {
#pragma unroll
                for (int u = 0; u < 16; ++u) if (g + TPC * u < N) hfr[u] = HF[(size_t)(512 + c) * N + g + TPC * u];
            }
            __syncthreads();
            if (!nofft) fft_inv(buf, S, g, TPC);
            const int gc = (n + 1) * 512 + c;
            if (own) {
                const float w0 = cw[gc], w1 = cw[1536 + gc], w2 = cw[3072 + gc], b = cb[gc], dsk = p.in[I_HYSKIP][n * 512 + c];
                float ga[8], gb[8];
                hy_conv8(rx1[0], w0, w1, w2, b, ga); hy_conv8(rx1[1], w0, w1, w2, b, gb);
                if (n == 0) { rx1[0] = hy_load(hy + ((size_t)ba * 1536 + 1024 + c) * Ls, t0, Ls); rx1[1] = hy_load(hy + ((size_t)bb * 1536 + 1024 + c) * Ls, t0, Ls); }
#pragma unroll
                for (int i = 0; i < 8; ++i) { const cf2 cv = buf[fsw(t0 + i)]; za[i] = ga[i] * (cv.x * invN + dsk * za[i]); zb[i] = gb[i] * (cv.y * invN + dsk * zb[i]); }
            }
            if (n == 0) {
                __syncthreads();
                for (int t = g; t < N; t += TPC) { if (t >= Ls) { cf2 z; z.x = 0.f; z.y = 0.f; buf[fsw(t)] = z; } }
                if (own) {
#pragma unroll
                    for (int i = 0; i < 8; ++i) { cf2 v; v.x = za[i]; v.y = zb[i]; buf[fsw(t0 + i)] = v; }
                }
                __syncthreads();
            } else {
                if (rd + 1 < NR8) HY_FETCH(c0 + (rd + 1) * CPR + gi);
                if (own) {
#pragma unroll
                    for (int i = 0; i < 8; ++i) {
                        const int ra = t0 + i, rb = Ls + t0 + i;
                        stg[(size_t)(ra + (ra >> 3)) * 8 + cs] = (bf16_t)f2bf(za[i]); stg[(size_t)(rb + (rb >> 3)) * 8 + cs] = (bf16_t)f2bf(zb[i]); }
                }
            }
        }
        __syncthreads();
    }
#undef HY_FETCH
    if (!nostore) {
        bf16_t* M = (bf16_t*)(p.ws + WS_M);
        for (int i = tidx(); i < 2 * Ls; i += NT) {
            const int bsel = i >= Ls, t = bsel ? i - Ls : i, bx = bsel ? bb : ba;
            const size_t tok = set ? (size_t)TL + (size_t)bx * LC + t : (size_t)bx * L + t;
            *(u32x4*)(M + tok * 1024 + c0) = *(const u32x4*)(stg + (size_t)(i + (i >> 3)) * 8);
        }
    }
    __syncthreads();
}
DEV void rope_store(const bf16_t* src, bf16_t* dst, int pos, bool rope, float scale, int ph, int sub) {
    const u32x4 ua = *(const u32x4*)(src + ph * 32 + sub * 8), ub = *(const u32x4*)(src + ph * 32 + 16 + sub * 8);
    float a[8], b[8];
#pragma unroll
    for (int i = 0; i < 4; ++i) { a[2 * i] = bflo(ua[i]); a[2 * i + 1] = bfhi(ua[i]); b[2 * i] = bflo(ub[i]); b[2 * i + 1] = bfhi(ub[i]); }
    if (rope) {
        const float pv = (float)(ph == 0 ? pos / 64 : pos % 64);
#pragma unroll
        for (int e = 0; e < 8; ++e) {
            const float inv = exp2f(-(float)(sub * 8 + e) * (13.287712379549449f / 16.f));
            const float ang = pv * inv, cs = __cosf(ang), sn = __sinf(ang);
            const float na = a[e] * cs - b[e] * sn, nb = b[e] * cs + a[e] * sn; a[e] = na; b[e] = nb;
        }
    }
    u32x4 oa, ob;
#pragma unroll
    for (int i = 0; i < 4; ++i) { oa[i] = pk2(a[2 * i] * scale, a[2 * i + 1] * scale); ob[i] = pk2(b[2 * i] * scale, b[2 * i + 1] * scale); }
    *(u32x4*)(dst + ph * 32 + sub * 8) = oa; *(u32x4*)(dst + ph * 32 + 16 + sub * 8) = ob;
}
constexpr int A_LDQ = 72, A_LDV = 136;
DEV void attn_item(const Params& p, int set, int item, unsigned char* smem) {
    bf16_t* Qs = (bf16_t*)smem;
    bf16_t* Ks = Qs + 128 * A_LDQ;
    bf16_t* Vt = Ks + 128 * A_LDQ;
    const int tid = tidx(), lane = tid & 63, w = tid >> 6, l15 = lane & 15, lg = lane >> 4;
    const int nqb = set ? LC / 128 : L / 128;
    const int h = item & 7, qb = (item >> 3) % nqb, b = (item >> 3) / nqb, kvh = h >> 2;
    const bf16_t* Q0 = (const bf16_t*)(p.ws + WS_P + P_Q0); const bf16_t* K0 = (const bf16_t*)(p.ws + WS_P + P_K0);
    const int qtok0 = set ? TL + b * LC + qb * 128 : b * L + qb * 128;
    { const int row = tid >> 2, ph = (tid >> 1) & 1, sub = tid & 1;
      rope_store(Q0 + (size_t)(qtok0 + row) * 512 + h * 64, Qs + row * A_LDQ, qb * 128 + row, set == 0, 0.125f, ph, sub); }
    __syncthreads();
    bf16x8 qf[2];
    qf[0] = *(const bf16x8*)(Qs + (w * 16 + l15) * A_LDQ + 8 * lg); qf[1] = *(const bf16x8*)(Qs + (w * 16 + l15) * A_LDQ + 32 + 8 * lg);
    float m_run = p.in[I_SINK][h], l_run = 1.f;
    f32x4 O[4];
#pragma unroll
    for (int i = 0; i < 4; ++i) O[i] = (f32x4){0.f, 0.f, 0.f, 0.f};
    const int nwin = set ? 0 : 3, nctx = LC / 128;
    for (int kbi = 0; kbi < nwin + nctx; ++kbi) {
        const bool win = kbi < nwin; const int kb = win ? qb - 1 + kbi : kbi - nwin;
        if (win && (kb < 0 || kb >= L / 128)) continue;
        const int ktok0 = win ? b * L + kb * 128 : TL + b * LC + kb * 128;
        __syncthreads();
        { const int row = tid >> 2, ph = (tid >> 1) & 1, sub = tid & 1;
          rope_store(K0 + (size_t)(ktok0 + row) * 128 + kvh * 64, Ks + row * A_LDQ, kb * 128 + row, win, 1.f, ph, sub); }
        { const bf16_t* vt = (const bf16_t*)(p.ws + WS_P + (win ? P_VT_LAT : P_VT_CTX)); const int Lx = win ? L : LC;
#pragma unroll
          for (int i = 0; i < 2; ++i) { const int id = tid + NT * i, d = id >> 4, kc = id & 15;
              *(u32x4*)(Vt + d * A_LDV + kc * 8) = *(const u32x4*)(vt + ((size_t)b * 128 + kvh * 64 + d) * Lx + kb * 128 + kc * 8); } }
        __syncthreads();
#pragma unroll
        for (int ch = 0; ch < 2; ++ch) {
            f32x4 st[4];
#pragma unroll
            for (int u = 0; u < 4; ++u) {
                const bf16_t* kr = Ks + ((ch * 4 + u) * 16 + l15) * A_LDQ + 8 * lg;
                f32x4 z = (f32x4){0.f, 0.f, 0.f, 0.f};
                z = __builtin_amdgcn_mfma_f32_16x16x32_bf16(*(const bf16x8*)kr, qf[0], z, 0, 0, 0);
                z = __builtin_amdgcn_mfma_f32_16x16x32_bf16(*(const bf16x8*)(kr + 32), qf[1], z, 0, 0, 0);
                st[u] = z;
            }
            float cmax = -INFINITY;
            if (win) {
                const int qpos = qb * 128 + w * 16 + l15;
#pragma unroll
                for (int u = 0; u < 4; ++u)
#pragma unroll
                    for (int r = 0; r < 4; ++r) { const int kpos = kb * 128 + (ch * 4 + u) * 16 + 4 * lg + r; const int dd = qpos - kpos; if (dd > 128 || dd < -128) st[u][r] = -INFINITY; }
            }
#pragma unroll
            for (int u = 0; u < 4; ++u)
#pragma unroll
                for (int r = 0; r < 4; ++r) cmax = fmaxf(cmax, st[u][r]);
            cmax = fmaxf(cmax, __shfl_xor(cmax, 16)); cmax = fmaxf(cmax, __shfl_xor(cmax, 32));
            const float m_new = fmaxf(m_run, cmax), alpha = __expf(m_run - m_new);
            float ls = 0.f;
#pragma unroll
            for (int u = 0; u < 4; ++u)
#pragma unroll
                for (int r = 0; r < 4; ++r) { const float e = __expf(st[u][r] - m_new); st[u][r] = e; ls += e; }
            ls += __shfl_xor(ls, 16); ls += __shfl_xor(ls, 32);
            l_run = l_run * alpha + ls; m_run = m_new;
#pragma unroll
            for (int i = 0; i < 4; ++i) { O[i][0] *= alpha; O[i][1] *= alpha; O[i][2] *= alpha; O[i][3] *= alpha; }
#pragma unroll
            for (int ss = 0; ss < 2; ++ss) {
                u32x4 pu; pu[0] = pk2(st[2 * ss][0], st[2 * ss][1]); pu[1] = pk2(st[2 * ss][2], st[2 * ss][3]); pu[2] = pk2(st[2 * ss + 1][0], st[2 * ss + 1][1]); pu[3] = pk2(st[2 * ss + 1][2], st[2 * ss + 1][3]);
                const bf16x8 pf = __builtin_bit_cast(bf16x8, pu);
                const int key0 = (ch * 4 + 2 * ss) * 16 + 4 * lg;
#pragma unroll
                for (int dt = 0; dt < 4; ++dt) {
                    const bf16_t* vr = Vt + (dt * 16 + l15) * A_LDV + key0;
                    u32x4 vu; const u32x2 v0 = *(const u32x2*)vr, v1 = *(const u32x2*)(vr + 16); vu[0] = v0[0]; vu[1] = v0[1]; vu[2] = v1[0]; vu[3] = v1[1];
                    O[dt] = __builtin_amdgcn_mfma_f32_16x16x32_bf16(__builtin_bit_cast(bf16x8, vu), pf, O[dt], 0, 0, 0);
                }
            }
        }
    }
    const float il = 1.f / l_run;
    bf16_t* M = (bf16_t*)(p.ws + WS_M) + (size_t)(qtok0 + w * 16 + l15) * 1024 + 512 + h * 64;
#pragma unroll
    for (int dt = 0; dt < 4; ++dt) { u32x2 o; o[0] = pk2(O[dt][0] * il, O[dt][1] * il); o[1] = pk2(O[dt][2] * il, O[dt][3] * il); *(u32x2*)(M + dt * 16 + 4 * lg) = o; }
    __syncthreads();
}
static_assert(NF_LAT / 256 <= 16 && NF_CTX / 64 <= 16 && L / 8 <= 256 && LC / 8 <= 64 && 2 * NF_LAT * 8 + 2 * L * 18 <= SMEM_BYTES && 8 * NF_CTX * 8 + 2 * LC * 18 <= SMEM_BYTES, "hyena item geometry");
constexpr int P3_HY_LAT = (NB / 2) * 64, P3_HY_CTX = (NB / 2) * 64, P3_AT_LAT = NB * (L / 128) * 8, P3_AT_CTX = NB * (LC / 128) * 8;
DEV void phase3(const Params& p, unsigned char* smem, int var = 0) {
    const int total = P3_HY_LAT + P3_AT_LAT + P3_HY_CTX + P3_AT_CTX;
    for (int it = blockIdx.x; it < total; it += gridDim.x) {
        int i = it;
        if ((var == 1 || var == 3 || var == 4) && !(i < P3_HY_LAT || (i >= P3_HY_LAT + P3_AT_LAT && i < P3_HY_LAT + P3_AT_LAT + P3_HY_CTX))) continue;
        if (var == 2 && (i < P3_HY_LAT || (i >= P3_HY_LAT + P3_AT_LAT && i < P3_HY_LAT + P3_AT_LAT + P3_HY_CTX))) continue;
        if (i < P3_HY_LAT) { hyena_item<256>(p, 0, i, smem, var == 3, var == 4); continue; } i -= P3_HY_LAT;
        if (i < P3_AT_LAT) { attn_item(p, 0, i, smem); continue; } i -= P3_AT_LAT;
        if (i < P3_HY_CTX) { hyena_item<64>(p, 1, i, smem, var == 3, var == 4); continue; } i -= P3_HY_CTX;
        attn_item(p, 1, i, smem);
    }
}

constexpr int K_LDK = 136, K_LDS = 129, K_LDC = 52;
DEV unsigned fkey(float f) { const unsigned u = __builtin_bit_cast(unsigned, f); return (u & 0x80000000u) ? ~u : (u | 0x80000000u); }
constexpr int cand_off(int i) { int o = 0; for (int k = 0; k < i; ++k) o += 16 / (k + 1); return o; }
DEV void topk_load_keys(const Params& p, int layer, int h, unsigned char* smem) {
    bf16_t* Ks = (bf16_t*)smem;
    const bf16_t* keys = (const bf16_t*)(p.ws + WS_W + W_KEYS) + (size_t)layer * 262144 + (size_t)h * 32768;
    const int tid = tidx();
#pragma unroll
    for (int i = 0; i < 8; ++i) { const int id = tid + NT * i, row = id >> 4, kc = id & 15; *(u32x4*)(Ks + row * K_LDK + kc * 8) = *(const u32x4*)(keys + (size_t)row * 128 + kc * 8); }
    __syncthreads();
}
#ifndef HOST_EMU
template <int CTRL> DEV unsigned dpp_u32(unsigned v) { return (unsigned)__builtin_amdgcn_update_dpp(0, (int)v, CTRL, 0xF, 0xF, true); }
#else
template <int CTRL> DEV unsigned dpp_u32(unsigned v) { const int lane = tidx() & 63; const int src = CTRL == 0xB1 ? (lane ^ 1) : CTRL == 0x4E ? (lane ^ 2) : ((lane & ~7) | (7 - (lane & 7))); return emu_shfl(v, src); }
#endif
DEV unsigned max8_u32(unsigned v) { unsigned t = dpp_u32<0xB1>(v); v = v > t ? v : t; t = dpp_u32<0x4E>(v); v = v > t ? v : t; t = dpp_u32<0x141>(v); return v > t ? v : t; }
DEV float sum8_f32(float v) { v += __builtin_bit_cast(float, dpp_u32<0xB1>(__builtin_bit_cast(unsigned, v))); v += __builtin_bit_cast(float, dpp_u32<0x4E>(__builtin_bit_cast(unsigned, v))); v += __builtin_bit_cast(float, dpp_u32<0x141>(__builtin_bit_cast(unsigned, v))); return v; }
DEV float unkey(unsigned k) { const unsigned u = (k & 0x80000000u) ? (k & 0x7fffffffu) : ~k; return __builtin_bit_cast(float, u); }
template <int N> DEV void bitonic_desc(unsigned (&a)[N]) {
#pragma unroll
    for (int k = 2; k <= N; k <<= 1)
#pragma unroll
        for (int j = k >> 1; j > 0; j >>= 1)
#pragma unroll
            for (int i = 0; i < N; ++i) { const int l = i ^ j; if (l > i) { const unsigned x = a[i], y = a[l]; const unsigned hi = x > y ? x : y, lo = x > y ? y : x; if ((i & k) == 0) { a[i] = hi; a[l] = lo; } else { a[i] = lo; a[l] = hi; } } }
}
DEV void merge16(const unsigned* lst, int nlist, unsigned first, int sub, unsigned& r0, unsigned& r1) {
    unsigned cur = first; int head = 0; r0 = 0u; r1 = 0u;
#pragma unroll
    for (int it = 0; it < 16; ++it) {
        const unsigned m = max8_u32(cur);
        if (sub == (it & 7)) { if (it < 8) r0 = m; else r1 = m; }
        if (cur == m) { ++head; cur = head < nlist ? lst[head] : 0u; }
    }
}
DEV void topk_item(const Params& p, int h, int tok0, unsigned char* smem, const bf16x8 (&afr)[16]) {
    bf16_t* Ks = (bf16_t*)smem;
    float* Sc = (float*)(Ks + 2 * 128 * K_LDK);
    unsigned* s12 = (unsigned*)Sc + 64 * 8 * 17;
    unsigned* cl = s12 + 64 * 32;
    const int tid = tidx(), lane = tid & 63, w = tid >> 6;
    const int row = tid >> 3, sub = tid & 7;
#pragma unroll
    for (int part = 0; part < 2; ++part) {
        { const int mi = w >> 2, ni = w & 3;
          f32x16 acc;
#pragma unroll
          for (int r = 0; r < 16; ++r) acc[r] = 0.f;
          const bf16_t* bs = Ks + (part * 128 + ni * 32 + (lane & 31)) * K_LDK + 8 * (lane >> 5);
#pragma unroll
          for (int kk = 0; kk < 8; ++kk) acc = __builtin_amdgcn_mfma_f32_32x32x16_bf16(part ? afr[8 + kk] : afr[kk], *(const bf16x8*)(bs + kk * 16), acc, 0, 0, 0);
#pragma unroll
          for (int r = 0; r < 16; ++r) Sc[(mi * 32 + (r & 3) + 8 * (r >> 2) + 4 * (lane >> 5)) * K_LDS + ni * 32 + (lane & 31)] = acc[r]; }
        __syncthreads();
        unsigned mk[16];
#pragma unroll
        for (int i = 0; i < 16; ++i) mk[i] = (fkey(Sc[row * K_LDS + sub * 16 + i]) & ~127u) | (unsigned)(127 - (sub * 16 + i));
        bitonic_desc<16>(mk);
        __syncthreads();
        unsigned* lst = (unsigned*)Sc + (row * 8 + sub) * 17;
#pragma unroll
        for (int i = 0; i < 16; ++i) lst[i] = mk[i];
        unsigned r0, r1;
        merge16(lst, 16, mk[0], sub, r0, r1);
        s12[(row * 2 + part) * 16 + sub] = r0; s12[(row * 2 + part) * 16 + 8 + sub] = r1;
        __syncthreads();
    }
    {
        const unsigned* k1 = s12 + row * 32; const unsigned* k2 = k1 + 16;
        unsigned ck[8];
#pragma unroll
        for (int m = 0; m < 8; ++m) {
            const int cc = sub + 8 * m; int ci = 0, off = 0;
#pragma unroll
            for (int i = 0; i < 15; ++i) { const bool ge = cc >= cand_off(i + 1); ci += ge ? 1 : 0; off += ge ? 16 / (i + 1) : 0; }
            const int cj = cc - off;
            ck[m] = 0u;
            if (cc < 50) ck[m] = (fkey(unkey((k1[ci] & ~127u) | 64u) + unkey((k2[cj] & ~127u) | 64u)) & ~63u) | (unsigned)(63 - cc);
        }
        bitonic_desc<8>(ck);
        unsigned* lst = cl + (row * 8 + sub) * 9;
#pragma unroll
        for (int m = 0; m < 8; ++m) lst[m] = ck[m];
        unsigned r0, r1;
        merge16(lst, 8, ck[0], sub, r0, r1);
        const float a = unkey((r0 & ~63u) | 32u), b = unkey((r1 & ~63u) | 32u);
        const unsigned kmax = max8_u32(r0 > r1 ? r0 : r1); const float vmax = unkey((kmax & ~63u) | 32u);
        const float ea = __expf(a - vmax), eb = __expf(b - vmax);
        const float inv = 1.f / sum8_f32(ea + eb);
        int eidx[2];
#pragma unroll
        for (int q = 0; q < 2; ++q) {
            const int cc = 63 - (int)((q ? r1 : r0) & 63u); int ci = 0, off = 0;
#pragma unroll
            for (int i = 0; i < 15; ++i) { const bool ge = cc >= cand_off(i + 1); ci += ge ? 1 : 0; off += ge ? 16 / (i + 1) : 0; }
            const int cj = cc - off;
            eidx[q] = (127 - (int)(k1[ci] & 127u)) * 128 + (127 - (int)(k2[cj] & 127u));
        }
        int* IDX = (int*)(p.ws + WS_IDX) + (size_t)(tok0 + row) * 128 + h * 16; float* GT = (float*)(p.ws + WS_GATE) + (size_t)(tok0 + row) * 128 + h * 16;
        IDX[sub] = eidx[0]; IDX[8 + sub] = eidx[1]; GT[sub] = ea * inv; GT[8 + sub] = eb * inv;
    }
    __syncthreads();
}
#define TOPK_LOAD(AF, tok0_, h_) do { const int lane_ = tidx() & 63, w_ = tidx() >> 6; \
        const bf16_t* ag_ = (const bf16_t*)(p.ws + WS_P) + (size_t)((tok0_) + (w_ >> 2) * 32 + (lane_ & 31)) * 2048 + (h_) * 256 + 8 * (lane_ >> 5); \
        _Pragma("unroll") for (int q_ = 0; q_ < 16; ++q_) AF[q_] = *(const bf16x8*)(ag_ + (q_ >> 3) * 128 + (q_ & 7) * 16); } while (0)
DEV void topk_phase(const Params& p, int layer, int ntok, unsigned char* smem) {
    const int G = gridDim.x, bid = blockIdx.x, h = bid & 7;
    const int nt = ntok / 64;
    bf16x8 afA[16], afB[16];
    if ((G & 7) == 0) {
        const int st = G >> 3; int tt = bid >> 3;
        if (tt < nt) { TOPK_LOAD(afA, tt * 64, h); topk_load_keys(p, layer, h, smem); }
        while (tt < nt) {
            if (tt + st < nt) TOPK_LOAD(afB, (tt + st) * 64, h);
            topk_item(p, h, tt * 64, smem, afA);
            tt += st; if (tt >= nt) break;
            if (tt + st < nt) TOPK_LOAD(afA, (tt + st) * 64, h);
            topk_item(p, h, tt * 64, smem, afB);
            tt += st;
        }
    } else {
        for (int it = bid; it < nt * 8; it += G) { __syncthreads(); TOPK_LOAD(afA, (it >> 3) * 64, it & 7); topk_load_keys(p, layer, it & 7, smem); topk_item(p, it & 7, (it >> 3) * 64, smem, afA); }
    }
}
#undef TOPK_LOAD

DEV float gelu_f(float x) { return 0.5f * x * (1.f + erff(x * 0.70710678118654752f)); }
DEV void peer_item(const Params& p, int layer, int item, int var = 0) {
    (void)var;
    const int tok = item * 8 + (tidx() >> 6), lane = tidx() & 63, li = lane & 31, half = lane >> 5;
    const bf16_t* A = (const bf16_t*)(p.ws + WS_A) + (size_t)tok * 1024 + li * 32;
    const unsigned char* UV = p.ws + WS_UV + (size_t)layer * 16384 * 1024;
    const float* SU = (const float*)(p.ws + WS_S8) + (size_t)(layer * 2) * 16384; const float* SV = SU + 16384;
    float y[32]; int xh[4], xl[4], xsum = 0; float xs;
    { float xf[32]; float amax = 0.f;
#pragma unroll
      for (int q = 0; q < 4; ++q) { const u32x4 a = *(const u32x4*)(A + 8 * q);
#pragma unroll
        for (int i = 0; i < 4; ++i) { xf[8 * q + 2 * i] = bflo(a[i]); xf[8 * q + 2 * i + 1] = bfhi(a[i]); amax = fmaxf(amax, fmaxf(fabsf(xf[8 * q + 2 * i]), fabsf(xf[8 * q + 2 * i + 1]))); } }
#pragma unroll
      for (int m = 16; m >= 1; m >>= 1) amax = fmaxf(amax, __shfl_xor(amax, m));
      xs = amax > 0.f ? amax * (1.f / 119.f) : 1.f; const float xinv = amax > 0.f ? 119.f / amax : 1.f;
#pragma unroll
      for (int d = 0; d < 4; ++d) { unsigned h = 0u, l = 0u;
#pragma unroll
        for (int e = 0; e < 8; ++e) { const int X = (int)rintf(xf[8 * d + e] * xinv); xsum += X; const int lo = ((X + 8) & 15) - 8, hi = (X - lo) >> 4; h |= ((unsigned)hi & 15u) << (4 * e); l |= ((unsigned)lo & 15u) << (4 * e); }
        xh[d] = (int)h; xl[d] = (int)l; } }
#pragma unroll
    for (int i = 0; i < 32; ++i) y[i] = 0.f;
    const int* IDX = (const int*)(p.ws + WS_IDX) + (size_t)tok * 128; const float* GT = (const float*)(p.ws + WS_GATE) + (size_t)tok * 128;
    const int i_lo = IDX[lane], i_hi = IDX[64 + lane]; const float g_lo = GT[lane], g_hi = GT[64 + lane];
    const int sl = ((li >> 4) & 1) * 2 + ((li >> 3) & 1);
    u32x4 uq[4], vq[4];
#define PG_LOADU(g) do { _Pragma("unroll") for (int s_ = 0; s_ < 4; ++s_) { const int e_ = __shfl((g) < 8 ? i_lo : i_hi, (((g) & 7) << 3) + 2 * s_ + half); \
        uq[s_] = *(const u32x4*)(UV + (size_t)e_ * 1024 + li * 16); } } while (0)
#define PG_LOADV(g) do { _Pragma("unroll") for (int s_ = 0; s_ < 4; ++s_) { const int e_ = __shfl((g) < 8 ? i_lo : i_hi, (((g) & 7) << 3) + 2 * s_ + half); \
        vq[s_] = *(const u32x4*)(UV + (size_t)e_ * 1024 + 512 + li * 16); } } while (0)
    PG_LOADU(0); PG_LOADV(0);
    for (int g = 0; g < 16; ++g) {
        const int mk = ((g & 7) << 3) + 2 * sl + half; const int me = __shfl(g < 8 ? i_lo : i_hi, mk); const float mg = __shfl(g < 8 ? g_lo : g_hi, mk);
        const float su = SU[me], sv = SV[me];
        float d[4];
#pragma unroll
        for (int s4 = 0; s4 < 4; ++s4) {
            int a1 = 0, a0 = 0;
#pragma unroll
            for (int dw = 0; dw < 4; ++dw) { a1 = __builtin_amdgcn_sdot8((int)uq[s4][dw], xh[dw], a1, false); a0 = __builtin_amdgcn_sdot8((int)uq[s4][dw], xl[dw], a0, false); }
            const float a = (float)(32 * a1 + 2 * a0 + xsum);
            d[s4] = a; SCHED_FENCE(); }
        if (g + 1 < 16) PG_LOADU(g + 1);
        float r2[2], r1;
        { const bool hi = (li & 16) != 0;
#pragma unroll
          for (int j = 0; j < 2; ++j) { const float send = hi ? d[j] : d[2 + j], keep = hi ? d[2 + j] : d[j]; r2[j] = keep + __shfl_xor(send, 16); } }
        { const bool hi = (li & 8) != 0; const float send = hi ? r2[0] : r2[1], keep = hi ? r2[1] : r2[0]; r1 = keep + __shfl_xor(send, 8); }
        r1 += __shfl_xor(r1, 4); r1 += __shfl_xor(r1, 2); r1 += __shfl_xor(r1, 1);
        const float act = gelu_f(r1 * (su * xs)) * mg * sv;
#pragma unroll
        for (int s4 = 0; s4 < 4; ++s4) {
            const float aj = __shfl(act, (lane & 32) + 16 * (s4 >> 1) + 8 * (s4 & 1));
#pragma unroll
            for (int dw = 0; dw < 4; ++dw) {
                const f32x2 f0 = __builtin_amdgcn_cvt_scalef32_pk_f32_fp4(vq[s4][dw], 1.0f, 0), f1 = __builtin_amdgcn_cvt_scalef32_pk_f32_fp4(vq[s4][dw], 1.0f, 1),
                            f2 = __builtin_amdgcn_cvt_scalef32_pk_f32_fp4(vq[s4][dw], 1.0f, 2), f3 = __builtin_amdgcn_cvt_scalef32_pk_f32_fp4(vq[s4][dw], 1.0f, 3);
                const int e0 = dw * 8;
                y[e0] = fmaf(aj, f0[0], y[e0]); y[e0 + 1] = fmaf(aj, f0[1], y[e0 + 1]); y[e0 + 2] = fmaf(aj, f1[0], y[e0 + 2]); y[e0 + 3] = fmaf(aj, f1[1], y[e0 + 3]);
                y[e0 + 4] = fmaf(aj, f2[0], y[e0 + 4]); y[e0 + 5] = fmaf(aj, f2[1], y[e0 + 5]); y[e0 + 6] = fmaf(aj, f3[0], y[e0 + 6]); y[e0 + 7] = fmaf(aj, f3[1], y[e0 + 7]);
            }
            SCHED_FENCE(); }
        if (g + 1 < 16) PG_LOADV(g + 1);
    }
#undef PG_LOADU
#undef PG_LOADV
    float yy[16];
#pragma unroll
    for (int i = 0; i < 16; ++i) { const float send = half ? y[i] : y[16 + i], keep = half ? y[16 + i] : y[i]; yy[i] = keep + __shfl_xor(send, 32); }
    const int c0 = li * 32 + half * 16;
    float* H = (float*)(p.ws + WS_H) + (size_t)tok * 1024 + c0;
    const float* g2 = (const float*)(p.ws + WS_MOD) + ((size_t)layer * NR + mod_row(tok)) * 6144 + 5120 + c0;
    float hv[16]; float ss = 0.f;
#pragma unroll
    for (int i = 0; i < 4; ++i) { const f32x4 hh = *(const f32x4*)(H + 4 * i), gg = *(const f32x4*)(g2 + 4 * i);
#pragma unroll
        for (int j = 0; j < 4; ++j) { const float v = hh[j] + gg[j] * yy[4 * i + j]; hv[4 * i + j] = v; ss += v * v; } }
    ss = wave_sum(ss);
    const float rstd = rsqrtf(ss * (1.f / 1024.f) + 1e-6f);
    if (layer == 0) {
#pragma unroll
        for (int i = 0; i < 4; ++i) { f32x4 o; o[0] = hv[4 * i]; o[1] = hv[4 * i + 1]; o[2] = hv[4 * i + 2]; o[3] = hv[4 * i + 3]; *(f32x4*)(H + 4 * i) = o; }
        const float* g = p.in[I_N1G] + 1024 + c0;
        const float* mod = (const float*)(p.ws + WS_MOD) + ((size_t)1 * NR + mod_row(tok)) * 6144 + c0;
        bf16_t* Ao = (bf16_t*)(p.ws + WS_A) + (size_t)tok * 1024 + c0;
        u32x4 o0, o1; float r[16];
#pragma unroll
        for (int i = 0; i < 16; ++i) r[i] = hv[i] * rstd * g[i] * (1.f + mod[1024 + i]) + mod[i];
#pragma unroll
        for (int i = 0; i < 4; ++i) { o0[i] = pk2(r[2 * i], r[2 * i + 1]); o1[i] = pk2(r[8 + 2 * i], r[8 + 2 * i + 1]); }
        *(u32x4*)Ao = o0; *(u32x4*)(Ao + 8) = o1;
    } else {
        const float* g = p.in[I_FG] + c0; float* out = p.out + (size_t)tok * 1024 + c0;
#pragma unroll
        for (int i = 0; i < 4; ++i) { f32x4 o; o[0] = hv[4 * i] * rstd * g[4 * i]; o[1] = hv[4 * i + 1] * rstd * g[4 * i + 1]; o[2] = hv[4 * i + 2] * rstd * g[4 * i + 2]; o[3] = hv[4 * i + 3] * rstd * g[4 * i + 3]; *(f32x4*)(out + 4 * i) = o; }
    }
}

constexpr int S3_LD = 136, S3_LDT = 24, S3_LDV = 72;
constexpr int S3_Q = 0, S3_K = S3_Q + 64 * S3_LD * 2, S3_KT = S3_K + 64 * S3_LD * 2, S3_D = S3_KT + 4 * 128 * S3_LDT * 2, S3_V = S3_D + 4 * 128 * 4, S3_ST = S3_V + 64 * S3_LDV * 2,
              S3_P = S3_ST + 2 * 64 * S3_LD * 2, S3_END = S3_P + 4 * 16 * S3_LDT * 2;
static_assert(S3_END <= SMEM_BYTES, "scan LDS");
DEV void scan_block(const Params& p, int bi, unsigned char* smem, int var = 0) {
    const int tid = tidx(), lane = tid & 63, w = tid >> 6, l15 = lane & 15, lg4 = lane >> 4, l31 = lane & 31, lh = lane >> 5;
    const int half = bi & 1, dir = (bi >> 1) & 1, h = (bi >> 2) & 7, b = bi >> 5;
    const bf16_t* P1 = (const bf16_t*)(p.ws + WS_P);
    const bf16_t* IT = (const bf16_t*)(p.ws + WS_M);
    bf16_t* Oo = (bf16_t*)(p.ws + WS_F + (dir ? F_OB : F_OF));
    bf16_t* Qs = (bf16_t*)(smem + S3_Q); bf16_t* Ks = (bf16_t*)(smem + S3_K); bf16_t* KT = (bf16_t*)(smem + S3_KT); float* Ds = (float*)(smem + S3_D);
    bf16_t* Vs = (bf16_t*)(smem + S3_V); bf16_t* ST = (bf16_t*)(smem + S3_ST); bf16_t* Ps = (bf16_t*)(smem + S3_P);
    const int NCH = (LC + L) / 64;
    const int kt = w >> 1, vt = w & 1;
    f32x16 S;
#pragma unroll
    for (int r = 0; r < 16; ++r) S[r] = 0.f;
    for (int i = tid; i < 64 * S3_LD / 2; i += NT) ((unsigned*)ST)[i] = 0u;
    const int pk = tid & 127, pblk = tid >> 7;
    u32x4 ka[2], qa[2], va, kb2[2], qb2[2], vb2;
    const int kcol = 1024 * (1 + dir) + h * 128 + pk, qcol = h * 128 + pk;
#define S3_T0(c) ((c) * 64 < LC ? (dir ? LC - 64 - (c) * 64 : (c) * 64) : (dir ? L - 64 - ((c) * 64 - LC) : (c) * 64 - LC))
#define S3_LOAD(c, KR, QR, VR) do { const bool lat_ = (c) * 64 >= LC; const int t0_ = S3_T0(c); const int Lx_ = lat_ ? L : LC; \
        const bf16_t* kq_ = (const bf16_t*)(p.ws + WS_P + (lat_ ? P1_KQT_LAT : P1_KQT_CTX)) + (size_t)b * 3072 * Lx_ + t0_ + pblk * 16; \
        KR[0] = *(const u32x4*)(kq_ + (size_t)kcol * Lx_); KR[1] = *(const u32x4*)(kq_ + (size_t)kcol * Lx_ + 8); \
        if (lat_) { QR[0] = *(const u32x4*)(kq_ + (size_t)qcol * Lx_); QR[1] = *(const u32x4*)(kq_ + (size_t)qcol * Lx_ + 8); } else { QR[0] = (u32x4){0u, 0u, 0u, 0u}; QR[1] = QR[0]; } \
        { const int v_ = tid >> 3, c8_ = tid & 7; const bf16_t* it_ = IT + (lat_ ? (size_t)0 : (size_t)NB * 1024 * L) + ((size_t)b * 1024 + h * 128 + half * 64 + v_) * Lx_ + t0_ + c8_ * 8; VR = *(const u32x4*)it_; } } while (0)
#define S3_PREP(KR, QR, VR) do { \
            float bsum = 0.f; unsigned short kt16[16]; \
            _Pragma("unroll") for (int rr = 0; rr < 16; ++rr) { \
                const int tl = dir ? 15 - rr : rr; \
                const unsigned ku_ = dir ? KR[(15 - rr) >> 3][((15 - rr) & 7) >> 1] : KR[rr >> 3][(rr & 7) >> 1]; const unsigned qu_ = dir ? QR[(15 - rr) >> 3][((15 - rr) & 7) >> 1] : QR[rr >> 3][(rr & 7) >> 1]; \
                const bool odd_ = dir ? (((15 - rr) & 1) != 0) : ((rr & 1) != 0); \
                const float kv = odd_ ? bfhi(ku_) : bflo(ku_), qv = odd_ ? bfhi(qu_) : bflo(qu_); \
                bsum += __log2f(1.f - kv); \
                const float eb = __builtin_amdgcn_exp2f(bsum), ieb = __builtin_amdgcn_exp2f(fminf(-bsum, 115.f)); \
                const unsigned short qt = (unsigned short)f2bf(qv * eb), ktv = (unsigned short)f2bf(kv * ieb); \
                Qs[(pblk * 16 + tl) * S3_LD + pk] = qt; Ks[(pblk * 16 + tl) * S3_LD + pk] = ktv; \
                if (dir) kt16[15 - rr] = ktv; else kt16[rr] = ktv; \
            } \
            u32x4 o0, o1; \
            _Pragma("unroll") for (int i = 0; i < 4; ++i) { o0[i] = (unsigned)kt16[2 * i] | ((unsigned)kt16[2 * i + 1] << 16); o1[i] = (unsigned)kt16[8 + 2 * i] | ((unsigned)kt16[8 + 2 * i + 1] << 16); } \
            *(u32x4*)(KT + (pblk * 128 + pk) * S3_LDT) = o0; *(u32x4*)(KT + (pblk * 128 + pk) * S3_LDT + 8) = o1; \
            Ds[pblk * 128 + pk] = __builtin_amdgcn_exp2f(bsum); \
            { const int v_ = tid >> 3, c8_ = tid & 7; *(u32x4*)(Vs + v_ * S3_LDV + c8_ * 8) = VR; } } while (0)
    S3_LOAD(0, ka, qa, va);
    for (int c = 0; c < NCH; ++c) {
        const bool lat = c * 64 >= LC; const int t0 = S3_T0(c); const size_t tokb = lat ? (size_t)b * L + t0 : (size_t)TL + (size_t)b * LC + t0;
        if ((c & 1) == 0) { if (c + 1 < NCH) S3_LOAD(c + 1, kb2, qb2, vb2); } else { if (c + 1 < NCH) S3_LOAD(c + 1, ka, qa, va); }
        lds_barrier();
        if (var != 1) { if ((c & 1) == 0) S3_PREP(ka, qa, va); else S3_PREP(kb2, qb2, vb2); }
        lds_barrier();

        if (lat && w < 4) {
            f32x4 pt = (f32x4){0.f, 0.f, 0.f, 0.f};
#pragma unroll
            for (int kk = 0; kk < 4; ++kk)
                pt = __builtin_amdgcn_mfma_f32_16x16x32_bf16(*(const bf16x8*)(Ks + (w * 16 + l15) * S3_LD + kk * 32 + 8 * lg4), *(const bf16x8*)(Qs + (w * 16 + l15) * S3_LD + kk * 32 + 8 * lg4), pt, 0, 0, 0);
            float pm[4];
#pragma unroll
            for (int r = 0; r < 4; ++r) { const int sl = 4 * lg4 + r; const bool keep = dir ? (sl >= l15) : (sl <= l15); pm[r] = keep ? pt[r] : 0.f; }
            u32x2 o; o[0] = pk2(pm[0], pm[1]); o[1] = pk2(pm[2], pm[3]);
            *(u32x2*)(Ps + (w * 16 + l15) * S3_LDT + 4 * lg4) = o;
        }
        lds_barrier();
        for (int ib = 0; ib < (var == 2 ? 0 : 4); ++ib) {
            const int blk = dir ? 3 - ib : ib;
            const int cur = (c * 4 + ib) & 1;
            { const bf16x8 a = *(const bf16x8*)(KT + (blk * 128 + 32 * kt + l31) * S3_LDT + 8 * lh);
              const bf16x8 bb = *(const bf16x8*)(Vs + (32 * vt + l31) * S3_LDV + blk * 16 + 8 * lh);
              S = __builtin_amdgcn_mfma_f32_32x32x16_bf16(a, bb, S, 0, 0, 0);
#pragma unroll
              for (int g = 0; g < 4; ++g) { const f32x4 dv = *(const f32x4*)(Ds + blk * 128 + 32 * kt + 8 * g + 4 * lh);
                  S[4 * g] *= dv[0]; S[4 * g + 1] *= dv[1]; S[4 * g + 2] *= dv[2]; S[4 * g + 3] *= dv[3];
                  u32x2 o; o[0] = pk2(S[4 * g], S[4 * g + 1]); o[1] = pk2(S[4 * g + 2], S[4 * g + 3]);
                  *(u32x2*)(ST + ((cur ^ 1) * 64 + 32 * vt + l31) * S3_LD + 32 * kt + 8 * g + 4 * lh) = o; } }
            if (lat && w < 4) {
                f32x4 o = (f32x4){0.f, 0.f, 0.f, 0.f};
#pragma unroll
                for (int kk = 0; kk < 4; ++kk)
                    o = __builtin_amdgcn_mfma_f32_16x16x32_bf16(*(const bf16x8*)(ST + (cur * 64 + 16 * w + l15) * S3_LD + kk * 32 + 8 * lg4), *(const bf16x8*)(Qs + (blk * 16 + l15) * S3_LD + kk * 32 + 8 * lg4), o, 0, 0, 0);
                bf16x8 va = (bf16x8){0, 0, 0, 0, 0, 0, 0, 0}, pb = va;
                if (lg4 < 2) { va = *(const bf16x8*)(Vs + (16 * w + l15) * S3_LDV + blk * 16 + 8 * lg4); pb = *(const bf16x8*)(Ps + (blk * 16 + l15) * S3_LDT + 8 * lg4); }
                o = __builtin_amdgcn_mfma_f32_16x16x32_bf16(va, pb, o, 0, 0, 0);
                u32x2 ou; ou[0] = pk2(o[0], o[1]); ou[1] = pk2(o[2], o[3]);
                *(u32x2*)(Oo + (tokb + blk * 16 + l15) * 1024 + h * 128 + half * 64 + 16 * w + 4 * lg4) = ou;
            }
            lds_barrier();
        }
    }
    lds_barrier();
#undef S3_T0
#undef S3_LOAD
#undef S3_PREP
}
DEV void readout_item(const Params& p, int item) {
    const int tok = item * 8 + (tidx() >> 6), lane = tidx() & 63;
    const bf16_t* of = (const bf16_t*)(p.ws + WS_F + F_OF) + (size_t)tok * 1024 + lane * 16; const bf16_t* ob = (const bf16_t*)(p.ws + WS_F + F_OB) + (size_t)tok * 1024 + lane * 16;
    const bf16_t* gp = (const bf16_t*)(p.ws + WS_P + P1_G) + (size_t)tok * 1024 + lane * 16;
    const float* on = p.in[I_HGON] + (lane & 7) * 16;
    float o[16], gg[16]; float ss = 0.f;
    { const u32x4 a0 = *(const u32x4*)of, a1 = *(const u32x4*)(of + 8), b0 = *(const u32x4*)ob, b1 = *(const u32x4*)(ob + 8), g0 = *(const u32x4*)gp, g1 = *(const u32x4*)(gp + 8);
#pragma unroll
      for (int i = 0; i < 4; ++i) { o[2 * i] = bflo(a0[i]) + bflo(b0[i]); o[2 * i + 1] = bfhi(a0[i]) + bfhi(b0[i]); o[8 + 2 * i] = bflo(a1[i]) + bflo(b1[i]); o[8 + 2 * i + 1] = bfhi(a1[i]) + bfhi(b1[i]);
          gg[2 * i] = bflo(g0[i]); gg[2 * i + 1] = bfhi(g0[i]); gg[8 + 2 * i] = bflo(g1[i]); gg[8 + 2 * i + 1] = bfhi(g1[i]); } }
#pragma unroll
    for (int i = 0; i < 16; ++i) ss += o[i] * o[i];
    ss += __shfl_xor(ss, 1); ss += __shfl_xor(ss, 2); ss += __shfl_xor(ss, 4);
    const float rstd = rsqrtf(ss * (1.f / 128.f) + 1e-6f);
    bf16_t* M = (bf16_t*)(p.ws + WS_M) + (size_t)tok * 1024 + lane * 16;
    u32x4 o0, o1; float r[16];
#pragma unroll
    for (int i = 0; i < 16; ++i) r[i] = o[i] * rstd * on[i] * gg[i];
#pragma unroll
    for (int i = 0; i < 4; ++i) { o0[i] = pk2(r[2 * i], r[2 * i + 1]); o1[i] = pk2(r[8 + 2 * i], r[8 + 2 * i + 1]); }
    *(u32x4*)M = o0; *(u32x4*)(M + 8) = o1;
}

#ifndef HOST_EMU
#define XB_TMO      128
#define XB_XCNT(j)  (256  + 64 * (j))
#define XB_XSUB(j)  (1280 + 64 * (j))
#define XB_XGEN(j)  (2304 + 64 * (j))
#define XB_TOP      3328
#define XB_TOPGEN   3392
#define XCD_BAR_WORDS 3456
#define XB_SPIN_CAP (1u << 18)
#define LAS __attribute__((address_space(3)))

__device__ __forceinline__ unsigned xb_ld(unsigned* p)              { return __hip_atomic_load(p, __ATOMIC_RELAXED, __HIP_MEMORY_SCOPE_AGENT); }
__device__ __forceinline__ unsigned xb_add(unsigned* p, unsigned v) { return __hip_atomic_fetch_add(p, v, __ATOMIC_RELAXED, __HIP_MEMORY_SCOPE_AGENT); }
__device__ __forceinline__ unsigned xb_xcc_id() { return (unsigned)__builtin_amdgcn_s_getreg((3 << 11) | 20) & 0xFu; }
#define XB_SPIN(cond, bar) do { unsigned _sp = 0; while (cond) { __builtin_amdgcn_s_sleep(1); \
    if ((++_sp & 255u) == 0u) { if (xb_ld(&(bar)[XB_TMO])) break; if (_sp > XB_SPIN_CAP) { atomicAdd(&(bar)[XB_TMO], 1u); break; } } } } while (0)

struct XcdBarrier {
    unsigned* bar; unsigned x;
    volatile LAS unsigned* st;
};

__device__ __forceinline__ XcdBarrier xcd_barrier_post(unsigned* bar, volatile LAS unsigned* st) {
    XcdBarrier b; b.bar = bar; b.x = xb_xcc_id(); b.st = st;
    if (threadIdx.x == 0) (void)xb_add(&bar[XB_XCNT(b.x)], 1u);
    return b;
}
__device__ __forceinline__ void xcd_barrier_complete(unsigned* bar, unsigned x, unsigned& nloc, unsigned& nx) {
    const unsigned G = gridDim.x * gridDim.y * gridDim.z;
    unsigned sum, cnt, mine, sp = 0u;
    for (;;) {
        sum = 0u; cnt = 0u; mine = 0u;
#pragma unroll
        for (unsigned j = 0; j < 16; ++j) { const unsigned c = xb_ld(&bar[XB_XCNT(j)]); sum += c; cnt += (c > 0u) ? 1u : 0u; mine = (j == x) ? c : mine; }
        if (sum == G) break;
        __builtin_amdgcn_s_sleep(1);
        if ((++sp & 255u) == 0u) { if (xb_ld(&bar[XB_TMO])) break; if (sp > XB_SPIN_CAP) { atomicAdd(&bar[XB_TMO], 1u); break; } }
    }
    nloc = mine > 0u ? mine : 1u; nx = cnt > 0u ? cnt : 1u;
}

__device__ __forceinline__ void xcd_barrier(const XcdBarrier& b) {
    asm volatile("s_waitcnt vmcnt(0)" ::: "memory");
    __syncthreads();
    if (threadIdx.x == 0) {
        unsigned* bar = b.bar;
        __builtin_amdgcn_s_waitcnt(0);
        unsigned nloc = b.st[0], nx = b.st[1];
        if (nloc == 0u) { xcd_barrier_complete(bar, b.x, nloc, nx); b.st[0] = nloc; b.st[1] = nx; }
        const unsigned old = xb_add(&bar[XB_XSUB(b.x)], 1u);
        const unsigned gen = old / nloc;
        if (old + 1u == (gen + 1u) * nloc) {
            __builtin_amdgcn_fence(__ATOMIC_RELEASE, "agent");
            asm volatile("s_waitcnt vmcnt(0)" ::: "memory");
            const unsigned og = xb_add(&bar[XB_TOP], 1u);
            const unsigned tg = og / nx;
            if (og + 1u == (tg + 1u) * nx) xb_add(&bar[XB_TOPGEN], 1u);
            else XB_SPIN(xb_ld(&bar[XB_TOPGEN]) == tg, bar);
            __builtin_amdgcn_fence(__ATOMIC_ACQUIRE, "agent");
            xb_add(&bar[XB_XGEN(b.x)], 1u);
            asm volatile("s_waitcnt vmcnt(0)" ::: "memory");
        } else {
            XB_SPIN(xb_ld(&bar[XB_XGEN(b.x)]) == gen, bar);
            __builtin_amdgcn_fence(__ATOMIC_ACQUIRE, "agent");
            asm volatile("s_waitcnt vmcnt(0)" ::: "memory");
        }
    }
    __syncthreads();
}

#endif
#ifdef NOINLINE_PHASES
#define NOINL __device__ __attribute__((noinline))
#else
#define NOINL __device__ __forceinline__
#endif
__shared__ __attribute__((aligned(16))) unsigned char g_smem[SMEM_BYTES + 16];
#define PH_COMMON const int G = gridDim.x, bid = blockIdx.x; unsigned char* smem = g_smem; (void)smem; (void)G; (void)bid; \
    const bf16_t* A = (const bf16_t*)(p.ws + WS_A); const bf16_t* Mx = (const bf16_t*)(p.ws + WS_M); const bf16_t* W = (const bf16_t*)(p.ws + WS_W); (void)A; (void)Mx; (void)W;
DEV void tables_in_gemm_tail(const Params& p, int tab0, int ntab, int nunits) {
    const int G = gridDim.x, bid = blockIdx.x, busy = nunits % G;
    if (busy == 0) { for (int it = bid; it < ntab * P0_TAB; it += G) p0_table(p, tab0 + it / P0_TAB, it % P0_TAB); return; }
    if (bid < busy) return;
    for (int it = bid - busy; it < ntab * P0_TAB; it += G - busy) p0_table(p, tab0 + it / P0_TAB, it % P0_TAB);
}
NOINL void ph0(const Params& p) { PH_COMMON phase0(p, smem); }
NOINL void ph1(const Params& p) { PH_COMMON phase1(p, smem); }
NOINL void ph2(const Params& p) { PH_COMMON EpiL0InT e{p.ws}; gemm_pg8_T(A, W + W_IN0 / 2, T, 2304, smem, e); tables_in_gemm_tail(p, 0, 1, (T / 256) * 9); }
NOINL void ph3(const Params& p, int var = 0) { PH_COMMON phase3(p, smem, var); }
NOINL void ph4(const Params& p) { PH_COMMON EpiRes e{&p, 1, 0, 2048}; gemm_pg8_N(Mx, W + W_OUT0 / 2, T, 1024, smem, e); tables_in_gemm_tail(p, 1, 2, (T / 256) * 4); }
NOINL void ph5(const Params& p) { PH_COMMON for (int it = bid; it < T / 8; it += G) norm_rows_item(p, it, 0, p.in[I_N2G], 0, 3072); }
NOINL void ph6(const Params& p, int var = 0) { PH_COMMON (void)var; EpiBf16 e{(bf16_t*)(p.ws + WS_P), 2048}; gemm_pg8_N(A, W + W_Q0 / 2, T, 2048, smem, e); tables_in_gemm_tail(p, 3, 1, (T / 256) * 8); }
NOINL void ph7(const Params& p) { PH_COMMON topk_phase(p, 0, T, smem); }
NOINL void ph8(const Params& p) { PH_COMMON for (int it = bid; it < T / 8; it += G) peer_item(p, 0, it); }
NOINL void ph9(const Params& p, int var = 0) { PH_COMMON EpiHgT e{p.ws, p.in[I_HGLB], var}; gemm_pg8_T(A, W + W_IN1 / 2, T, 5120, smem, e); }
NOINL void ph10(const Params& p, int var = 0) { PH_COMMON for (int bi = bid; bi < NB * 32; bi += G) scan_block(p, bi, smem, var); }
NOINL void ph11(const Params& p) { PH_COMMON for (int it = bid; it < TL / 8; it += G) readout_item(p, it); }
NOINL void ph12(const Params& p) { PH_COMMON EpiRes e{&p, 0, 1, 2048}; gemm_pg8_N(Mx, W + W_OUT1 / 2, TL, 1024, smem, e); }
NOINL void ph13(const Params& p) { PH_COMMON for (int it = bid; it < TL / 8; it += G) norm_rows_item(p, it, 0, p.in[I_N2G] + 1024, 1, 3072); }
NOINL void ph14(const Params& p) { PH_COMMON EpiBf16 e{(bf16_t*)(p.ws + WS_P), 2048}; gemm_pg8_N(A, W + W_Q1 / 2, TL, 2048, smem, e); }
NOINL void ph15(const Params& p) { PH_COMMON topk_phase(p, 1, TL, smem); }
NOINL void ph16(const Params& p, int var = 0) { PH_COMMON for (int it = bid; it < TL / 8; it += G) peer_item(p, 1, it, var); }

constexpr int NPHASE = 17;
__global__ void __launch_bounds__(NT, 2) mega(Params p_in) {
    const int ph_lo = p_in.ph_lo, ph_hi = p_in.ph_hi;
#ifndef HOST_EMU
#define GBAR_MAKE() XcdBarrier gbar; gbar.bar = (unsigned*)(p_in.ws + WS_CTRL); gbar.x = xb_xcc_id(); gbar.st = (volatile LAS unsigned*)(LAS unsigned char*)(g_smem + SMEM_BYTES);
    if (ph_hi - ph_lo > 1) {
        volatile LAS unsigned* st = (volatile LAS unsigned*)(LAS unsigned char*)(g_smem + SMEM_BYTES);
        if (threadIdx.x == 0) { st[0] = 0u; st[1] = 0u; }
        __syncthreads();
        (void)xcd_barrier_post((unsigned*)(p_in.ws + WS_CTRL), st);
    }
#endif
#ifndef HOST_EMU
#define PH_BARRIER() do { GBAR_MAKE(); xcd_barrier(gbar); } while (0)
#define PH_PARAMS() unsigned long long kp = (unsigned long long)__builtin_amdgcn_kernarg_segment_ptr(); asm volatile("" : "+s"(kp) :: "memory"); \
        const Params& p = *(const Params*)(const __attribute__((address_space(4))) Params*)kp;
#else
#define PH_BARRIER() do {} while (0)
#define PH_PARAMS() const Params& p = p_in;
#endif
#ifdef REPEAT_MASK
#define PH_REPEAT(k, CALL) if ((REPEAT_MASK >> (k)) & 1) { PH_BARRIER(); { PH_PARAMS(); CALL; } }
#else
#define PH_REPEAT(k, CALL)
#endif
#ifdef ONLY_PHASE
#define PH_ON(k) ((k) == ONLY_PHASE)
#else
#define PH_ON(k) true
#endif
#if defined(REPEAT_MASK) && defined(HG_VAR)
#define RUN_PHASE9() if (ph_lo <= 9 && 9 < ph_hi) { if (9 > ph_lo) PH_BARRIER(); { PH_PARAMS(); ph9(p, HG_VAR); } PH_BARRIER(); { PH_PARAMS(); ph9(p, 0); } }
#else
#define RUN_PHASE9() RUN_PHASE(9, ph9(p))
#endif
#if defined(REPEAT_MASK) && defined(P3_VAR)
#define RUN_PHASE3() if (ph_lo <= 3 && 3 < ph_hi) { if (3 > ph_lo) PH_BARRIER(); { PH_PARAMS(); ph3(p, P3_VAR); } PH_BARRIER(); { PH_PARAMS(); ph3(p, 0); } }
#else
#define RUN_PHASE3() RUN_PHASE(3, ph3(p))
#endif
#define RUN_PHASE(k, CALL) if (PH_ON(k) && ph_lo <= (k) && (k) < ph_hi) { if ((k) > ph_lo) PH_BARRIER(); { PH_PARAMS(); CALL; } PH_REPEAT(k, CALL) }
    RUN_PHASE(0, ph0(p))  RUN_PHASE(1, ph1(p))  RUN_PHASE(2, ph2(p))  RUN_PHASE3()  RUN_PHASE(4, ph4(p))  RUN_PHASE(5, ph5(p))
    RUN_PHASE(6, ph6(p))  RUN_PHASE(7, ph7(p))  RUN_PHASE(8, ph8(p))  RUN_PHASE9()  RUN_PHASE(10, ph10(p)) RUN_PHASE(11, ph11(p))
    RUN_PHASE(12, ph12(p)) RUN_PHASE(13, ph13(p)) RUN_PHASE(14, ph14(p)) RUN_PHASE(15, ph15(p)) RUN_PHASE(16, ph16(p))
}

#ifndef HOST_EMU
extern "C" void kernel_launch(void* const* d_in, const int* in_sizes, int n_in, void* d_out, int out_size, void* d_ws, size_t ws_size, hipStream_t stream) {
    if (n_in != 29 || ws_size < WS_END || out_size != TL * 1024) { fprintf(stderr, "kernel_launch: unexpected sizes (n_in %d, ws %zu need %zu, out %d)\n", n_in, ws_size, (size_t)WS_END, out_size); return; }
    static int grid = 0;
    if (!grid) { int dev = 0, cus = 0; hipGetDevice(&dev); hipDeviceGetAttribute(&cus, hipDeviceAttributeMultiprocessorCount, dev); grid = cus > 0 ? cus : 256; }
    hipMemsetAsync((unsigned char*)d_ws + WS_CTRL, 0, CTRL_BYTES, stream);
    Params p{};
    for (int i = 0; i < 29; ++i) p.in[i] = (const float*)d_in[i];
    p.out = (float*)d_out; p.ws = (unsigned char*)d_ws;
#ifdef MULTI_LAUNCH
    for (int ph = 0; ph < NPHASE; ++ph) { p.ph_lo = ph; p.ph_hi = ph + 1; hipLaunchKernelGGL(mega, dim3(grid), dim3(NT), 0, stream, p); }
#else
    p.ph_lo = 0; p.ph_hi = NPHASE;
    hipLaunchKernelGGL(mega, dim3(grid), dim3(NT), 0, stream, p);
#endif
}
#endif
```

```cpp
#ifndef HOST_EMU
#include <hip/hip_runtime.h>
#include <cstdio>
#endif

#ifndef CFG_B
#define CFG_B 8
#define CFG_L 2048
#define CFG_LC 256
#endif
#define DEV __device__ __forceinline__
#ifndef HOST_EMU
#define SCHED_FENCE() __builtin_amdgcn_sched_barrier(0)
#endif
#ifdef HOST_EMU
#define SCHED_FENCE() do {} while (0)
#define __expf expf
#define __logf logf
#define __log2f log2f
#define __exp2f exp2f
#define __sinf sinf
#define __cosf cosf
#endif

typedef unsigned short bf16_t;
typedef short bf16x8 __attribute__((ext_vector_type(8)));
typedef float f32x16 __attribute__((ext_vector_type(16)));
typedef float f32x4 __attribute__((ext_vector_type(4)));
typedef unsigned u32x4 __attribute__((ext_vector_type(4)));
typedef unsigned u32x2 __attribute__((ext_vector_type(2)));
struct cf2 { float x, y; };

constexpr int NB = CFG_B, L = CFG_L, LC = CFG_LC, D = 1024;
constexpr int TL = NB * L, TC = NB * LC, T = TL + TC;
constexpr int NT = 512;
constexpr int NR = NB + 1;
constexpr int log4ceil(int n) { int s = 0, v = 1; while (v < n) { v *= 4; ++s; } return s; }
constexpr int FS_LAT = log4ceil(2 * L - 1), FS_CTX = log4ceil(2 * LC - 1);
constexpr int NF_LAT = 1 << (2 * FS_LAT), NF_CTX = 1 << (2 * FS_CTX);
static_assert(T % 256 == 0 && TL % 256 == 0 && L % 128 == 0 && LC % 128 == 0 && NB % 2 == 0, "shape");

constexpr size_t al256(size_t x) { return (x + 255) & ~(size_t)255; }
constexpr size_t WS_CTRL = 0, CTRL_BYTES = 65536;
constexpr size_t CTRL_HYNORM = 4096;
constexpr size_t CTRL_TG = 16384;
constexpr size_t WS_MOD = WS_CTRL + CTRL_BYTES;
constexpr size_t WS_H = al256(WS_MOD + (size_t)2 * NR * 6144 * 4);
constexpr size_t WS_A = al256(WS_H + (size_t)T * 1024 * 4);
constexpr size_t WS_P = al256(WS_A + (size_t)T * 1024 * 2);
constexpr size_t P_BYTES = (size_t)T * 5120 * 2;
constexpr size_t P_HYT_LAT = 0;
constexpr size_t P_HYT_CTX = P_HYT_LAT + (size_t)NB * 1536 * L * 2;
constexpr size_t P_Q0 = P_HYT_CTX + (size_t)NB * 1536 * LC * 2;
constexpr size_t P_K0 = P_Q0 + (size_t)T * 512 * 2;
constexpr size_t P_VT_LAT = P_K0 + (size_t)T * 128 * 2;
constexpr size_t P_VT_CTX = P_VT_LAT + (size_t)NB * 128 * L * 2;
static_assert(P_VT_CTX + (size_t)NB * 128 * LC * 2 <= P_BYTES, "P region");
constexpr size_t P1_KQT_LAT = 0;
constexpr size_t P1_KQT_CTX = P1_KQT_LAT + (size_t)NB * 3072 * L * 2;
constexpr size_t P1_G = P1_KQT_CTX + (size_t)NB * 3072 * LC * 2;
static_assert(P1_G + (size_t)TL * 1024 * 2 <= P_BYTES, "P region (layer 1)");
constexpr size_t WS_M = al256(WS_P + P_BYTES);
constexpr size_t WS_IDX = al256(WS_M + (size_t)T * 1024 * 2);
constexpr size_t WS_GATE = al256(WS_IDX + (size_t)T * 128 * 4);
constexpr size_t WS_UV = al256(WS_GATE + (size_t)T * 128 * 4);
constexpr size_t WS_S8 = WS_UV + (size_t)2 * 16384 * 1024;
constexpr size_t WS_W = al256(WS_S8 + (size_t)4 * 16384 * 4);
constexpr size_t W_IN0 = 0, W_OUT0 = W_IN0 + (size_t)2304 * 1024 * 2, W_IN1 = W_OUT0 + (size_t)1024 * 1024 * 2,
                 W_OUT1 = W_IN1 + (size_t)5120 * 1024 * 2, W_Q0 = W_OUT1 + (size_t)1024 * 1024 * 2, W_Q1 = W_Q0 + (size_t)2048 * 1024 * 2,
                 W_KEYS = W_Q1 + (size_t)2048 * 1024 * 2, W_BYTES = W_KEYS + (size_t)2 * 8 * 2 * 128 * 128 * 2;
constexpr size_t WS_F = al256(WS_W + W_BYTES);
constexpr size_t F_HRAW_LAT = 0;
constexpr size_t F_HRAW_CTX = F_HRAW_LAT + (size_t)2048 * L * 4;
constexpr size_t F_HF_LAT = F_HRAW_CTX + (size_t)2048 * LC * 4;
constexpr size_t F_HF_CTX = F_HF_LAT + (size_t)1024 * NF_LAT * 8;
constexpr size_t F_HYP_LAT = F_HF_CTX + (size_t)1024 * NF_CTX * 8;
constexpr size_t F_HYP_CTX = F_HYP_LAT + (size_t)(L / 64) * 2048 * 4;
constexpr size_t F_END = F_HYP_CTX + (size_t)(LC / 64) * 2048 * 4;
constexpr size_t F_OF = 0, F_OB = (size_t)TL * 1024 * 2;
constexpr size_t F_BYTES = F_END > 2 * F_OB ? F_END : 2 * F_OB;
constexpr size_t WS_END = al256(WS_F + F_BYTES);

struct Params { const float* in[29]; float* out; unsigned char* ws; int ph_lo, ph_hi; };
enum { I_X = 0, I_C, I_CTX, I_CCTX, I_ADAW, I_ADAB, I_N1G, I_N2G, I_FG, I_ABWIN, I_ABWOUT, I_HYCW, I_HYCB, I_HYW1, I_HYB1, I_HYW2, I_HYB2, I_HYW3,
       I_HYFREQ, I_HYSKIP, I_SINK, I_HGWIN, I_HGWOUT, I_HGLB, I_HGON, I_PWQ, I_PKEYS, I_PU, I_PV };

constexpr int SMEM_BYTES = 147456;

#ifndef HOST_EMU
DEV int tidx() { int t = threadIdx.x; asm volatile("" : "+v"(t)); return t; }
#else
DEV int tidx() { return (int)threadIdx.x; }
#endif
#ifndef HOST_EMU
DEV void lds_barrier() { asm volatile("s_waitcnt lgkmcnt(0)" ::: "memory"); __builtin_amdgcn_s_barrier(); asm volatile("" ::: "memory"); }
#else
DEV void lds_barrier() { __syncthreads(); }
#endif
#ifndef HOST_EMU
typedef __bf16 bf16n2 __attribute__((ext_vector_type(2)));
DEV unsigned pk2(float lo, float hi) { bf16n2 v; v[0] = (__bf16)lo; v[1] = (__bf16)hi; return __builtin_bit_cast(unsigned, v); }
DEV unsigned f2bf(float f) { return (unsigned)__builtin_bit_cast(unsigned short, (__bf16)f); }
#else
DEV unsigned f2bf(float f) { unsigned u = __builtin_bit_cast(unsigned, f); return (u + 0x7fffu + ((u >> 16) & 1u)) >> 16; }
DEV unsigned pk2(float lo, float hi) { return f2bf(lo) | (f2bf(hi) << 16); }
#endif
DEV float bf2f(unsigned h) { return __builtin_bit_cast(float, (h & 0xffffu) << 16); }
DEV float bflo(unsigned u) { return __builtin_bit_cast(float, u << 16); }
DEV float bfhi(unsigned u) { return __builtin_bit_cast(float, u & 0xffff0000u); }
DEV float silu_f(float x) { return x * __builtin_amdgcn_rcpf(1.f + __expf(-x)); }
DEV float sigmoid_f(float x) { return __builtin_amdgcn_rcpf(1.f + __expf(-x)); }
DEV float wave_sum(float v) {
#pragma unroll
    for (int m = 32; m >= 1; m >>= 1) v += __shfl_xor(v, m);
    return v;
}
DEV int mod_row(int tok) { return tok < TL ? tok / L : NB; }

DEV void p0_mod(const Params& p, int item, unsigned char* smem) {
    const int l = item / 96, col0 = (item % 96) * 64, tid = tidx();
    float* sc = (float*)smem;
    float* red = sc + NR * 1024;
    for (int i = tid; i < NR * 1024; i += NT) { const int r = i >> 10, k = i & 1023; const float c = r < NB ? p.in[I_C][r * 1024 + k] : p.in[I_CCTX][k]; sc[i] = c / (1.f + expf(-c)); }
    __syncthreads();
    const int kq = tid >> 6, col = tid & 63;
    float acc[NR];
#pragma unroll
    for (int r = 0; r < NR; ++r) acc[r] = 0.f;
    const float* w = p.in[I_ADAW] + (size_t)l * 1024 * 6144 + col0 + col;
#pragma unroll 16
    for (int k = kq * 128; k < kq * 128 + 128; ++k) {
        const float wv = w[(size_t)k * 6144];
#pragma unroll
        for (int r = 0; r < NR; ++r) acc[r] += sc[r * 1024 + k] * wv;
    }
#pragma unroll
    for (int r = 0; r < NR; ++r) red[(kq * NR + r) * 64 + col] = acc[r];
    __syncthreads();
    float* mod = (float*)(p.ws + WS_MOD);
    for (int i = tid; i < NR * 64; i += NT) {
        const int r = i >> 6, c = i & 63; float s = 0.f;
        for (int q = 0; q < 8; ++q) s += red[(q * NR + r) * 64 + c];
        mod[((size_t)l * NR + r) * 6144 + col0 + c] = s + p.in[I_ADAB][l * 6144 + col0 + c];
    }
    __syncthreads();
}
DEV void p0_transpose(const float* W, bf16_t* Wt, int N, int tile, unsigned char* smem) {
    float* ts = (float*)smem;
    const int ntn = N / 256, kt = tile / ntn, nt = tile % ntn, k0 = kt * 64, n0 = nt * 256, tid = tidx();
    f32x4 rv[8];
#pragma unroll
    for (int m = 0; m < 8; ++m) { const int i = tid + NT * m, kk = i >> 6, c4 = i & 63; rv[m] = *(const f32x4*)(W + (size_t)(k0 + kk) * N + n0 + c4 * 4); }
#pragma unroll
    for (int m = 0; m < 8; ++m) { const int i = tid + NT * m, kk = i >> 6, c4 = i & 63; *(f32x4*)(ts + kk * 260 + c4 * 4) = rv[m]; }
    __syncthreads();
#pragma unroll
    for (int m = 0; m < 4; ++m) { const int i = tid + NT * m, nn = i >> 3, k8 = i & 7;
        u32x4 o;
#pragma unroll
        for (int e = 0; e < 4; ++e) o[e] = pk2(ts[(k8 * 8 + 2 * e) * 260 + nn], ts[(k8 * 8 + 2 * e + 1) * 260 + nn]);
        *(u32x4*)(Wt + (size_t)(n0 + nn) * 1024 + k0 + k8 * 8) = o; }
    __syncthreads();
}
DEV void p0_convert(const float* src, bf16_t* dst, int item) {
    const int tid = tidx();
#pragma unroll
    for (int i = 0; i < 8; ++i) {
        const size_t e = (size_t)item * 16384 + (size_t)(i * NT + tid) * 4;
        const f32x4 v = *(const f32x4*)(src + e);
        u32x2 o; o[0] = pk2(v[0], v[1]); o[1] = pk2(v[2], v[3]);
        *(u32x2*)(dst + e) = o;
    }
}
typedef float f32x2 __attribute__((ext_vector_type(2)));
typedef float f32x32 __attribute__((ext_vector_type(32)));
typedef unsigned u32x6 __attribute__((ext_vector_type(6)));
DEV void p0_table(const Params& p, int tab, int item) {
    const int lane = tidx() & 63, li = lane & 31, half = lane >> 5, layer = tab >> 1, isv = tab & 1;
#pragma unroll 1
    for (int pass = 0; pass < 2; ++pass) {
        const int row = item * 32 + pass * 16 + (tidx() >> 6) * 2 + half;
        const float* src = (isv ? p.in[I_PV] : p.in[I_PU]) + ((size_t)layer * 16384 + row) * 1024 + li * 32;
        f32x4 v[8]; float mx = 0.f, sq = 0.f;
#pragma unroll
        for (int i = 0; i < 8; ++i) { v[i] = *(const f32x4*)(src + 4 * i); mx = fmaxf(mx, fmaxf(fmaxf(fabsf(v[i][0]), fabsf(v[i][1])), fmaxf(fabsf(v[i][2]), fabsf(v[i][3]))));
            sq += v[i][0] * v[i][0] + v[i][1] * v[i][1] + v[i][2] * v[i][2] + v[i][3] * v[i][3]; }
#pragma unroll
        for (int m = 16; m >= 1; m >>= 1) { mx = fmaxf(mx, __shfl_xor(mx, m)); sq += __shfl_xor(sq, m); }
        float rowscale;
        if (isv) {
            const float sc = mx > 0.f ? 6.f / mx : 1.f; rowscale = mx > 0.f ? mx * (1.f / 6.f) : 1.f;
            const f32x2 pr4 = __builtin_amdgcn_cvt_scalef32_pk_f32_fp4(__builtin_amdgcn_cvt_scalef32_pk_fp4_f32(0u, 1.0f, 0.0f, 1.0f, 0), 1.0f, 0);
            const bool swp = pr4[0] != 1.0f;
            u32x4 w;
#pragma unroll
            for (int d = 0; d < 4; ++d) { unsigned x = 0u;
                x = __builtin_amdgcn_cvt_scalef32_pk_fp4_f32(x, (swp ? v[2 * d][1] : v[2 * d][0]) * sc, (swp ? v[2 * d][0] : v[2 * d][1]) * sc, 1.0f, 0);
                x = __builtin_amdgcn_cvt_scalef32_pk_fp4_f32(x, (swp ? v[2 * d][3] : v[2 * d][2]) * sc, (swp ? v[2 * d][2] : v[2 * d][3]) * sc, 1.0f, 1);
                x = __builtin_amdgcn_cvt_scalef32_pk_fp4_f32(x, (swp ? v[2 * d + 1][1] : v[2 * d + 1][0]) * sc, (swp ? v[2 * d + 1][0] : v[2 * d + 1][1]) * sc, 1.0f, 2);
                x = __builtin_amdgcn_cvt_scalef32_pk_fp4_f32(x, (swp ? v[2 * d + 1][3] : v[2 * d + 1][2]) * sc, (swp ? v[2 * d + 1][2] : v[2 * d + 1][3]) * sc, 1.0f, 3);
                w[d] = x; }
            *(u32x4*)(p.ws + WS_UV + ((size_t)layer * 16384 + row) * 1024 + 512 + li * 16) = w;
        } else {
            float step = fminf(0.3352f * sqrtf(sq * (1.f / 1024.f)), mx * (1.0001f / 7.5f)); if (!(step > 0.f)) step = 1.f;
            const float inv = 1.f / step; rowscale = 0.5f * step;
            u32x4 w;
#pragma unroll
            for (int d = 0; d < 4; ++d) { unsigned x = 0u;
#pragma unroll
                for (int e = 0; e < 8; ++e) { const float f = fminf(fmaxf(floorf(v[2 * d + (e >> 2)][e & 3] * inv), -8.f), 7.f); x |= ((unsigned)(int)f & 15u) << (4 * e); }
                w[d] = x; }
            *(u32x4*)(p.ws + WS_UV + ((size_t)layer * 16384 + row) * 1024 + li * 16) = w;
        }
        if (li == 0) ((float*)(p.ws + WS_S8))[tab * 16384 + row] = rowscale;
    }
}
DEV void p0_filter(const Params& p, int set, int chunk, int cb, unsigned char* smem) {
    const int Ls = set ? LC : L, l0 = chunk * 64, tid = tidx();
    float* z = (float*)smem;
    float* hd1 = z + 64 * 34;
    float* hd2 = hd1 + 64 * 65;
    const float* w1 = p.in[I_HYW1]; const float* b1 = p.in[I_HYB1]; const float* w2 = p.in[I_HYW2]; const float* b2 = p.in[I_HYB2];
    const float* w3 = p.in[I_HYW3]; const float* fq = p.in[I_HYFREQ];
    for (int i = tid; i < 64 * 33; i += NT) {
        const int pp = i / 33, f = i % 33, l = l0 + pp; float val;
        if (f == 0) val = (float)l / (float)(Ls - 1);
        else { const int jb = (f - 1) & 15; const float fj = 1e-4f + (float)jb * ((15.f - 1e-4f) / 15.f); const float a = fj * (6.283185307179586f * (float)l / (float)Ls); val = f <= 16 ? __cosf(a) : -__sinf(a); }
        z[pp * 34 + f] = val;
    }
    __syncthreads();
    {
        const int j = tid & 63, p0 = tid >> 6;
        float wc[64], acc[8];
#pragma unroll
        for (int f = 0; f < 33; ++f) wc[f] = w1[f * 64 + j];
#pragma unroll
        for (int m = 0; m < 8; ++m) { float sacc = b1[j];
#pragma unroll
            for (int f = 0; f < 33; ++f) sacc = fmaf(z[(p0 + 8 * m) * 34 + f], wc[f], sacc);
            acc[m] = sacc; }
#pragma unroll
        for (int m = 0; m < 8; ++m) hd1[(p0 + 8 * m) * 65 + j] = __sinf(fq[j] * acc[m]);
        __syncthreads();
#pragma unroll
        for (int f = 0; f < 64; ++f) wc[f] = w2[f * 64 + j];
#pragma unroll
        for (int m = 0; m < 8; ++m) { float sacc = b2[j];
#pragma unroll
            for (int f = 0; f < 64; ++f) sacc = fmaf(hd1[(p0 + 8 * m) * 65 + f], wc[f], sacc);
            acc[m] = sacc; }
#pragma unroll
        for (int m = 0; m < 8; ++m) hd2[(p0 + 8 * m) * 65 + j] = __sinf(fq[j] * acc[m]);
        __syncthreads();
    }
    const float max_decay = -15.350567286626973f, min_decay = -3.0701134573253945f;
    float* hraw = (float*)(p.ws + WS_F + (set ? F_HRAW_CTX : F_HRAW_LAT));
    float* hyn = (float*)(p.ws + WS_F + (set ? F_HYP_CTX : F_HYP_LAT)) + (size_t)chunk * 2048;
    {
        const int o = cb * NT + tid;
        const int c = o & 511; const float delta = fabsf(min_decay + (float)c * ((max_decay - min_decay) / 511.f));
        float asum = 0.f;
        float* dst = hraw + (size_t)o * Ls + l0;
        for (int ph = 0; ph < 2; ++ph) {
            float acc[32];
#pragma unroll
            for (int pp = 0; pp < 32; ++pp) acc[pp] = 0.f;
#pragma unroll 1
            for (int j0 = 0; j0 < 64; j0 += 16) {
                float wv[16];
#pragma unroll
                for (int j = 0; j < 16; ++j) wv[j] = w3[(j0 + j) * 2048 + o];
#pragma unroll
                for (int j = 0; j < 16; ++j) {
#pragma unroll
                    for (int pp = 0; pp < 32; ++pp) acc[pp] = fmaf(hd2[(ph * 32 + pp) * 65 + j0 + j], wv[j], acc[pp]);
                    SCHED_FENCE();
                }
            }
#pragma unroll
            for (int q4 = 0; q4 < 8; ++q4) {
                f32x4 v;
#pragma unroll
                for (int e = 0; e < 4; ++e) { const int pp = q4 * 4 + e; const float tl = (float)(l0 + ph * 32 + pp) / (float)(Ls - 1); const float val = acc[pp] * expf(-tl * delta); v[e] = val; asum += fabsf(val); }
                *(f32x4*)(dst + ph * 32 + q4 * 4) = v;
            }
        }
        hyn[o] = asum;
    }
    __syncthreads();
}

constexpr int P0_MOD = 192, P0_TR_IN0 = 16 * 9, P0_TR_OUT0 = 64, P0_TR_IN1 = 16 * 20, P0_TR_OUT1 = 64, P0_TR_Q = 16 * 8, P0_KEYS = 32, P0_TAB = 512,
              P0_FILT = 4 * (L / 64 + LC / 64);
DEV void phase0(const Params& p, unsigned char* smem) {
    bf16_t* W = (bf16_t*)(p.ws + WS_W);
    const int total = P0_MOD + P0_FILT + P0_TR_IN0 + P0_TR_OUT0 + P0_TR_IN1 + P0_TR_OUT1 + 2 * P0_TR_Q + P0_KEYS;
    for (int it = blockIdx.x; it < total; it += gridDim.x) {
        int i = it;
        if (i < P0_MOD) { p0_mod(p, i, smem); continue; } i -= P0_MOD;
        if (i < P0_FILT) { const int ch = i >> 2, cb = i & 3; if (ch < L / 64) p0_filter(p, 0, ch, cb, smem); else p0_filter(p, 1, ch - L / 64, cb, smem); continue; } i -= P0_FILT;
        if (i < P0_TR_IN0) { p0_transpose(p.in[I_ABWIN], W + W_IN0 / 2, 2304, i, smem); continue; } i -= P0_TR_IN0;
        if (i < P0_TR_OUT0) { p0_transpose(p.in[I_ABWOUT], W + W_OUT0 / 2, 1024, i, smem); continue; } i -= P0_TR_OUT0;
        if (i < P0_TR_IN1) { p0_transpose(p.in[I_HGWIN], W + W_IN1 / 2, 5120, i, smem); continue; } i -= P0_TR_IN1;
        if (i < P0_TR_OUT1) { p0_transpose(p.in[I_HGWOUT], W + W_OUT1 / 2, 1024, i, smem); continue; } i -= P0_TR_OUT1;
        if (i < P0_TR_Q) { p0_transpose(p.in[I_PWQ], W + W_Q0 / 2, 2048, i, smem); continue; } i -= P0_TR_Q;
        if (i < P0_TR_Q) { p0_transpose(p.in[I_PWQ] + (size_t)1024 * 2048, W + W_Q1 / 2, 2048, i, smem); continue; } i -= P0_TR_Q;
        p0_convert(p.in[I_PKEYS], W + W_KEYS / 2, i);
    }
}

DEV const float* h_row(const Params& p, int layer_src_inputs, int tok) {
    if (layer_src_inputs) return tok < TL ? p.in[I_X] + (size_t)tok * 1024 : p.in[I_CTX] + (size_t)(tok - TL) * 1024;
    return (const float*)(p.ws + WS_H) + (size_t)tok * 1024;
}
DEV void norm_row_store(const Params& p, const f32x4 (&v)[4], int tok, const float* g, int layer, int sh_off, int lane) {
    float ss = 0.f;
#pragma unroll
    for (int i = 0; i < 4; ++i) ss += v[i][0] * v[i][0] + v[i][1] * v[i][1] + v[i][2] * v[i][2] + v[i][3] * v[i][3];
    ss = wave_sum(ss);
    const float rstd = rsqrtf(ss * (1.f / 1024.f) + 1e-6f);
    const float* mod = (const float*)(p.ws + WS_MOD) + ((size_t)layer * NR + mod_row(tok)) * 6144 + sh_off;
    bf16_t* A = (bf16_t*)(p.ws + WS_A) + (size_t)tok * 1024;
#pragma unroll
    for (int i = 0; i < 4; ++i) {
        const int c = i * 256 + lane * 4;
        const f32x4 gg = *(const f32x4*)(g + c), sh = *(const f32x4*)(mod + c), sc = *(const f32x4*)(mod + 1024 + c);
        u32x2 o;
        o[0] = pk2(v[i][0] * rstd * gg[0] * (1.f + sc[0]) + sh[0], v[i][1] * rstd * gg[1] * (1.f + sc[1]) + sh[1]);
        o[1] = pk2(v[i][2] * rstd * gg[2] * (1.f + sc[2]) + sh[2], v[i][3] * rstd * gg[3] * (1.f + sc[3]) + sh[3]);
        *(u32x2*)(A + c) = o;
    }
}
DEV void norm_rows_item(const Params& p, int item, int from_inputs, const float* g, int layer, int sh_off) {
    const int tok = item * 8 + (tidx() >> 6), lane = tidx() & 63;
    const float* src = h_row(p, from_inputs, tok);
    f32x4 v[4];
#pragma unroll
    for (int i = 0; i < 4; ++i) v[i] = *(const f32x4*)(src + i * 256 + lane * 4);
    norm_row_store(p, v, tok, g, layer, sh_off, lane);
}

DEV cf2 cmul(cf2 a, cf2 b) { cf2 r; r.x = a.x * b.x - a.y * b.y; r.y = a.x * b.y + a.y * b.x; return r; }
DEV cf2 twid(int k, float invN) { cf2 r; const float a = (float)k * invN; r.x = __builtin_amdgcn_cosf(a); r.y = -__builtin_amdgcn_sinf(a); return r; }
DEV int fsw(int i) { return i ^ ((i >> 4) & 15) ^ (((i >> 8) & 1) << 4); }
DEV void bfly4_fwd(cf2& a0, cf2& a1, cf2& a2, cf2& a3) {
    cf2 t0, t1, t2, t3; t0.x = a0.x + a2.x; t0.y = a0.y + a2.y; t1.x = a0.x - a2.x; t1.y = a0.y - a2.y; t2.x = a1.x + a3.x; t2.y = a1.y + a3.y;
    const float dx = a1.x - a3.x, dy = a1.y - a3.y; t3.x = dy; t3.y = -dx;
    a0.x = t0.x + t2.x; a0.y = t0.y + t2.y; a1.x = t1.x + t3.x; a1.y = t1.y + t3.y; a2.x = t0.x - t2.x; a2.y = t0.y - t2.y; a3.x = t1.x - t3.x; a3.y = t1.y - t3.y;
}
DEV void bfly4_inv(cf2& c0, cf2& c1, cf2& c2, cf2& c3) {
    cf2 t0, t1, t2, t3; t0.x = c0.x + c2.x; t0.y = c0.y + c2.y; t1.x = c0.x - c2.x; t1.y = c0.y - c2.y; t2.x = c1.x + c3.x; t2.y = c1.y + c3.y;
    const float dx = c1.x - c3.x, dy = c1.y - c3.y; t3.x = -dy; t3.y = dx;
    c0.x = t0.x + t2.x; c0.y = t0.y + t2.y; c1.x = t1.x + t3.x; c1.y = t1.y + t3.y; c2.x = t0.x - t2.x; c2.y = t0.y - t2.y; c3.x = t1.x - t3.x; c3.y = t1.y - t3.y;
}
DEV void fft_stage4(cf2* buf, int S, int s, int g, int G, bool inv) {
    const int N = 1 << (2 * S); const float invN = 1.f / (float)N;
    const int lm = 2 * (S - s), m = 1 << lm, q = m >> 2;
    for (int bf = g; bf < (N >> 2); bf += G) {
        const int j = bf & (q - 1), base = ((bf >> (lm - 2)) << lm) + j, tw = j << (2 * s);
        cf2 a0 = buf[fsw(base)], a1 = buf[fsw(base + q)], a2 = buf[fsw(base + 2 * q)], a3 = buf[fsw(base + 3 * q)];
        if (!inv) { bfly4_fwd(a0, a1, a2, a3); a1 = cmul(a1, twid(tw, invN)); a2 = cmul(a2, twid(2 * tw, invN)); a3 = cmul(a3, twid(3 * tw, invN)); }
        else { cf2 w1 = twid(tw, invN), w2 = twid(2 * tw, invN), w3 = twid(3 * tw, invN); w1.y = -w1.y; w2.y = -w2.y; w3.y = -w3.y; a1 = cmul(a1, w1); a2 = cmul(a2, w2); a3 = cmul(a3, w3); bfly4_inv(a0, a1, a2, a3); }
        buf[fsw(base)] = a0; buf[fsw(base + q)] = a1; buf[fsw(base + 2 * q)] = a2; buf[fsw(base + 3 * q)] = a3;
    }
}
DEV void fft_stage16(cf2* buf, int S, int s, int g, int G, bool inv) {
    const int N = 1 << (2 * S); const float invN = 1.f / (float)N;
    const int lm = 2 * (S - s), m = 1 << lm, q = m >> 2, q2 = q >> 2;
    for (int u = g; u < (N >> 4); u += G) {
        const int j2 = u & (q2 - 1), base = ((u >> (lm - 4)) << lm) + j2;
        cf2 x[4][4];
#pragma unroll
        for (int c = 0; c < 4; ++c)
#pragma unroll
            for (int c2 = 0; c2 < 4; ++c2) x[c][c2] = buf[fsw(base + c * q + c2 * q2)];
        if (!inv) {
#pragma unroll
            for (int c2 = 0; c2 < 4; ++c2) {
                const int tw = (j2 + c2 * q2) << (2 * s);
                bfly4_fwd(x[0][c2], x[1][c2], x[2][c2], x[3][c2]);
                x[1][c2] = cmul(x[1][c2], twid(tw, invN)); x[2][c2] = cmul(x[2][c2], twid(2 * tw, invN)); x[3][c2] = cmul(x[3][c2], twid(3 * tw, invN));
                SCHED_FENCE();
            }
            const int tw2 = j2 << (2 * (s + 1));
            const cf2 v1 = twid(tw2, invN), v2 = twid(2 * tw2, invN), v3 = twid(3 * tw2, invN);
#pragma unroll
            for (int c = 0; c < 4; ++c) {
                bfly4_fwd(x[c][0], x[c][1], x[c][2], x[c][3]);
                x[c][1] = cmul(x[c][1], v1); x[c][2] = cmul(x[c][2], v2); x[c][3] = cmul(x[c][3], v3);
            }
        } else {
            const int tw2 = j2 << (2 * (s + 1));
            cf2 v1 = twid(tw2, invN), v2 = twid(2 * tw2, invN), v3 = twid(3 * tw2, invN); v1.y = -v1.y; v2.y = -v2.y; v3.y = -v3.y;
#pragma unroll
            for (int c = 0; c < 4; ++c) {
                x[c][1] = cmul(x[c][1], v1); x[c][2] = cmul(x[c][2], v2); x[c][3] = cmul(x[c][3], v3);
                bfly4_inv(x[c][0], x[c][1], x[c][2], x[c][3]);
            }
#pragma unroll
            for (int c2 = 0; c2 < 4; ++c2) {
                const int tw = (j2 + c2 * q2) << (2 * s);
                cf2 w1 = twid(tw, invN), w2 = twid(2 * tw, invN), w3 = twid(3 * tw, invN); w1.y = -w1.y; w2.y = -w2.y; w3.y = -w3.y;
                x[1][c2] = cmul(x[1][c2], w1); x[2][c2] = cmul(x[2][c2], w2); x[3][c2] = cmul(x[3][c2], w3);
                bfly4_inv(x[0][c2], x[1][c2], x[2][c2], x[3][c2]);
                SCHED_FENCE();
            }
        }
#pragma unroll
        for (int c = 0; c < 4; ++c)
#pragma unroll
            for (int c2 = 0; c2 < 4; ++c2) buf[fsw(base + c * q + c2 * q2)] = x[c][c2];
    }
}
DEV void fft_fwd(cf2* buf, int S, int g, int G) {
    int s = 0;
    for (; s + 1 < S; s += 2) { fft_stage16(buf, S, s, g, G, false); __syncthreads(); }
    if (s < S) { fft_stage4(buf, S, s, g, G, false); __syncthreads(); }
}
DEV void fft_inv(cf2* buf, int S, int g, int G) {
    int s = S - 1;
    if (S & 1) { fft_stage4(buf, S, s, g, G, true); __syncthreads(); --s; }
    for (; s >= 1; s -= 2) { fft_stage16(buf, S, s - 1, g, G, true); __syncthreads(); }
}
DEV void hf_item(const Params& p, int set, int pi, unsigned char* smem) {
    const int Ls = set ? LC : L, S = set ? FS_CTX : FS_LAT, N = 1 << (2 * S);
    const int gi = tidx() >> 8, g = tidx() & 255, idx = pi * 2 + gi, o = idx >> 9, c = idx & 511;
    cf2* buf = (cf2*)smem + (size_t)gi * N;
    const float* hraw = (const float*)(p.ws + WS_F + (set ? F_HRAW_CTX : F_HRAW_LAT));
    const float* hyn = (const float*)(p.ws + WS_F + (set ? F_HYP_CTX : F_HYP_LAT));
    float nsum = 0.f;
    for (int ch = 0; ch < Ls / 64; ++ch) nsum += hyn[(size_t)ch * 2048 + o * 1024 + c] + hyn[(size_t)ch * 2048 + o * 1024 + 512 + c];
    const float inv = 1.f / nsum;
    const float* hf = hraw + (size_t)(o * 1024 + c) * Ls; const float* hb = hraw + (size_t)(o * 1024 + 512 + c) * Ls;
#pragma unroll 4
    for (int k = g; k < N; k += 256) { float re = 0.f; if (k < Ls) re = hf[k] * inv; else if (k > N - Ls) re = hb[N - k] * inv; cf2 v; v.x = re; v.y = 0.f; buf[fsw(k)] = v; }
    __syncthreads();
    fft_fwd(buf, S, g, 256);
    cf2* HF = (cf2*)(p.ws + WS_F + (set ? F_HF_CTX : F_HF_LAT)) + (size_t)(o * 512 + c) * N;
    for (int k = g; k < N; k += 256) HF[k] = buf[fsw(k)];
    __syncthreads();
}
constexpr int P1_NORM = T / 8, P1_HF = 512;
DEV void phase1(const Params& p, unsigned char* smem) {
    const int total = P1_NORM + 2 * P1_HF;
    for (int it = blockIdx.x; it < total; it += gridDim.x) {
        if (it < P1_NORM) norm_rows_item(p, it, 1, p.in[I_N1G], 0, 0);
        else if (it < P1_NORM + P1_HF) hf_item(p, 0, it - P1_NORM, smem);
        else hf_item(p, 1, it - P1_NORM - P1_HF, smem);
    }
}

constexpr int G_LDA = 72;
template <class Epi>
DEV void gemm_tile(const bf16_t* __restrict__ A, const bf16_t* __restrict__ Wt, int m0, int n0, unsigned char* smem, const Epi& epi, int var = 0) {
    bf16_t* As = (bf16_t*)smem;
    bf16_t* Bs = As + 2 * 256 * G_LDA;
    const int tid = tidx(), lane = tid & 63, w = tid >> 6, wm = w >> 1, wn = w & 1;
    f32x16 acc[2][2];
#pragma unroll
    for (int i = 0; i < 2; ++i)
#pragma unroll
        for (int j = 0; j < 2; ++j)
#pragma unroll
            for (int r = 0; r < 16; ++r) acc[i][j][r] = 0.f;
    u32x4 ra[4], rb[2];
    const bf16_t* Ag = A + (size_t)m0 * 1024; const bf16_t* Bg = Wt + (size_t)n0 * 1024;
#define GLOAD(k0) do { \
        _Pragma("unroll") for (int i = 0; i < 4; ++i) { const int id = tid + NT * i, row = id >> 3, kc = id & 7; ra[i] = *(const u32x4*)(Ag + (size_t)row * 1024 + (k0) + kc * 8); } \
        _Pragma("unroll") for (int i = 0; i < 2; ++i) { const int id = tid + NT * i, row = id >> 3, kc = id & 7; rb[i] = *(const u32x4*)(Bg + (size_t)row * 1024 + (k0) + kc * 8); } } while (0)
#define LSTORE(buf_) do { \
        _Pragma("unroll") for (int i = 0; i < 4; ++i) { const int id = tid + NT * i, row = id >> 3, kc = id & 7; *(u32x4*)(As + ((buf_) * 256 + row) * G_LDA + kc * 8) = ra[i]; } \
        _Pragma("unroll") for (int i = 0; i < 2; ++i) { const int id = tid + NT * i, row = id >> 3, kc = id & 7; *(u32x4*)(Bs + ((buf_) * 128 + row) * G_LDA + kc * 8) = rb[i]; } } while (0)
    GLOAD(0); LSTORE(0); __syncthreads();
    for (int kt = 0; kt < (var == 2 ? 1 : 16); ++kt) {
        const int buf = kt & 1;
        if (kt + 1 < 16) GLOAD((kt + 1) * 64);
        const bf16_t* as = As + (buf * 256 + wm * 64 + (lane & 31)) * G_LDA + 8 * (lane >> 5);
        const bf16_t* bs = Bs + (buf * 128 + wn * 64 + (lane & 31)) * G_LDA + 8 * (lane >> 5);
#pragma unroll
        for (int kk = 0; kk < 4; ++kk) {
            const bf16x8 a0 = *(const bf16x8*)(as + kk * 16), a1 = *(const bf16x8*)(as + 32 * G_LDA + kk * 16);
            const bf16x8 b0 = *(const bf16x8*)(bs + kk * 16), b1 = *(const bf16x8*)(bs + 32 * G_LDA + kk * 16);
            acc[0][0] = __builtin_amdgcn_mfma_f32_32x32x16_bf16(a0, b0, acc[0][0], 0, 0, 0);
            acc[0][1] = __builtin_amdgcn_mfma_f32_32x32x16_bf16(a0, b1, acc[0][1], 0, 0, 0);
            acc[1][0] = __builtin_amdgcn_mfma_f32_32x32x16_bf16(a1, b0, acc[1][0], 0, 0, 0);
            acc[1][1] = __builtin_amdgcn_mfma_f32_32x32x16_bf16(a1, b1, acc[1][1], 0, 0, 0);
        }
        if (kt + 1 < 16) LSTORE(buf ^ 1);
        __syncthreads();
    }
#ifndef HOST_EMU
    if (var == 1) { asm volatile("" :: "v"(acc[0][0]), "v"(acc[0][1]), "v"(acc[1][0]), "v"(acc[1][1])); return; }
#endif
#pragma unroll
    for (int mi = 0; mi < 2; ++mi)
#pragma unroll
        for (int ni = 0; ni < 2; ++ni)
#pragma unroll
            for (int rg = 0; rg < 4; ++rg) {
                const int row = m0 + wm * 64 + mi * 32 + 8 * rg + 4 * (lane >> 5), col = n0 + wn * 64 + ni * 32 + (lane & 31);
                epi(row, col, acc[mi][ni][rg * 4 + 0], acc[mi][ni][rg * 4 + 1], acc[mi][ni][rg * 4 + 2], acc[mi][ni][rg * 4 + 3]);
            }
}
template <class Epi>
DEV void gemm_tile256(const bf16_t* __restrict__ A, const bf16_t* __restrict__ Wt, int m0, int n0, unsigned char* smem, const Epi& epi) {
    bf16_t* As = (bf16_t*)smem;
    bf16_t* Bs = As + 2 * 256 * G_LDA;
    const int tid = tidx(), lane = tid & 63, w = tid >> 6, wm = w >> 2, wn = w & 3;
    f32x16 acc[4][2];
#pragma unroll
    for (int i = 0; i < 4; ++i)
#pragma unroll
        for (int j = 0; j < 2; ++j)
#pragma unroll
            for (int r = 0; r < 16; ++r) acc[i][j][r] = 0.f;
    u32x4 ra[4], rb[4];
    const bf16_t* Ag = A + (size_t)m0 * 1024; const bf16_t* Bg = Wt + (size_t)n0 * 1024;
#define GLOAD2(k0) do { \
        _Pragma("unroll") for (int i = 0; i < 4; ++i) { const int id = tid + NT * i, row = id >> 3, kc = id & 7; ra[i] = *(const u32x4*)(Ag + (size_t)row * 1024 + (k0) + kc * 8); rb[i] = *(const u32x4*)(Bg + (size_t)row * 1024 + (k0) + kc * 8); } } while (0)
#define LSTORE2(buf_) do { \
        _Pragma("unroll") for (int i = 0; i < 4; ++i) { const int id = tid + NT * i, row = id >> 3, kc = id & 7; *(u32x4*)(As + ((buf_) * 256 + row) * G_LDA + kc * 8) = ra[i]; *(u32x4*)(Bs + ((buf_) * 256 + row) * G_LDA + kc * 8) = rb[i]; } } while (0)
    GLOAD2(0); LSTORE2(0); __syncthreads();
    for (int kt = 0; kt < 16; ++kt) {
        const int buf = kt & 1;
        if (kt + 1 < 16) GLOAD2((kt + 1) * 64);
        const bf16_t* as = As + (buf * 256 + wm * 128 + (lane & 31)) * G_LDA + 8 * (lane >> 5);
        const bf16_t* bs = Bs + (buf * 256 + wn * 64 + (lane & 31)) * G_LDA + 8 * (lane >> 5);
#pragma unroll
        for (int kk = 0; kk < 4; ++kk) {
            bf16x8 af[4], bfr[2];
#pragma unroll
            for (int i = 0; i < 4; ++i) af[i] = *(const bf16x8*)(as + i * 32 * G_LDA + kk * 16);
#pragma unroll
            for (int j = 0; j < 2; ++j) bfr[j] = *(const bf16x8*)(bs + j * 32 * G_LDA + kk * 16);
#pragma unroll
            for (int i = 0; i < 4; ++i)
#pragma unroll
                for (int j = 0; j < 2; ++j) acc[i][j] = __builtin_amdgcn_mfma_f32_32x32x16_bf16(af[i], bfr[j], acc[i][j], 0, 0, 0);
        }
        if (kt + 1 < 16) LSTORE2(buf ^ 1);
        __syncthreads();
    }
#undef GLOAD2
#undef LSTORE2
#pragma unroll
    for (int mi = 0; mi < 4; ++mi)
#pragma unroll
        for (int ni = 0; ni < 2; ++ni)
#pragma unroll
            for (int rg = 0; rg < 4; ++rg) {
                const int row = m0 + wm * 128 + mi * 32 + 8 * rg + 4 * (lane >> 5), col = n0 + wn * 64 + ni * 32 + (lane & 31);
                epi(row, col, acc[mi][ni][rg * 4 + 0], acc[mi][ni][rg * 4 + 1], acc[mi][ni][rg * 4 + 2], acc[mi][ni][rg * 4 + 3]);
            }
}
namespace pg8 {
#ifndef HOST_EMU
#define PG8_LAS __attribute__((address_space(3)))
#else
#define PG8_LAS
#endif
typedef unsigned short bf16_t;
constexpr int BM = 256, BK = 64, HALF = 128, HTB = HALF * BK * 2  , STAGE_BYTES = 8 * HTB, NXCD = 8, WGM = 8;

__host__ __device__ __forceinline__ int lds_byte(int r, int c) { const int st = (r >> 4) * 2 + (c >> 5), rr = r & 15, cc = c & 31, ob = rr * 64 + cc * 2; return st * 1024 + (ob ^ (((ob >> 9) & 1) << 5)); }
__host__ __device__ __forceinline__ void stage_rc(int b, int& R, int& C) { const int st = b / 1024, sb = b % 1024, swz = sb ^ (((sb >> 9) & 1) << 5); R = (st >> 1) * 16 + swz / 64; C = (st & 1) * 32 + (swz % 64) / 2; }
__host__ __device__ __forceinline__ int perm32(int rho) { const int n = rho >> 4, i = rho & 15; return 8 * (i >> 2) + 4 * n + (i & 3); }

struct Unit { int pm, pn; };
struct Gemm { const bf16_t* A; const bf16_t* Bt; int M, N, K; };

struct StaticOrder {
    int nM, nN, nwg, G, c;
    __host__ __device__ void init(int M, int N, int G_, int c_) { nM = M / BM; nN = N / BM; nwg = nM * nN; G = G_; c = c_; }
    __host__ __device__ bool next(int i, Unit& u) const {
        const long L = (long)i * G + c; if (L >= nwg) return false;
        int wgid = (int)L; { const int q = nwg / NXCD, r = nwg % NXCD, xcd = wgid % NXCD, off = wgid / NXCD; wgid = (xcd < r ? xcd * (q + 1) : r * (q + 1) + (xcd - r) * q) + off; }
        const int nig = WGM * nN, gid = wgid / nig, fm = gid * WGM, gsz = (nM - fm) < WGM ? (nM - fm) : WGM;
        u.pm = fm + ((wgid % nig) % gsz); u.pn = (wgid % nig) / gsz; return true;
    }
    __device__ __forceinline__ void a_ready(const Unit&) const {}
    __device__ __forceinline__ void done(const Unit&) const {}
};
template <class Epi, class Sched, bool STAMP = false>
__device__ __forceinline__ void gemm_phase(PG8_LAS unsigned char* lds, const Gemm g, const Sched& S, const Epi& E, unsigned long long* stamps = nullptr) {
    const int tid = tidx(), wid = __builtin_amdgcn_readfirstlane(tid >> 6), lane = tid & 63, wr = wid >> 2, wc = wid & 3, fr = lane & 15, fq = lane >> 4;
    const int K = g.K, nt = K / BK;
    int ts_lo = 0, ts_hi = 0, nts = 0; const unsigned long long rt_entry = 0ull; (void)rt_entry; (void)ts_lo; (void)ts_hi; (void)nts;
#define PG8_STAMP() do { if (STAMP && wid == 0 && nts < 64) { const unsigned long long _c = 0ull; \
        ts_lo = (lane == nts) ? (int)(unsigned)_c : ts_lo; ts_hi = (lane == nts) ? (int)(unsigned)(_c >> 32) : ts_hi; ++nts; } } while (0)
    PG8_STAMP();
    unsigned voffA[2], voffB[2];
#pragma unroll
    for (int i = 0; i < 2; ++i) { int R, C; stage_rc(tid * 16 + i * 8192, R, C); const int Rb = Epi::PERM ? ((R & ~31) + perm32(R & 31)) : R;
        voffA[i] = (unsigned)(R * K + C) * 2u; voffB[i] = (unsigned)(Rb * K + C) * 2u; }
    const size_t kstep = (size_t)(BK * 2);
    const size_t hstep = (size_t)HALF * K * 2;
    const size_t tstep = 2 * hstep;
    const unsigned ldsw = (unsigned)wid * 1024u;
    const int aoff = lds_byte(wr * 64 + fr, fq * 8), boff = lds_byte(wc * 32 + fr, fq * 8);
#define PG8_SA(b, h) (((b) * 2 + (h)) * HTB)
#define PG8_SB(b, h) ((4 + (b) * 2 + (h)) * HTB)
#define PG8_STAGE(bufoff, gbase, voff) do { _Pragma("unroll") for (int _i = 0; _i < 2; ++_i) \
        __builtin_amdgcn_global_load_lds((const unsigned*)((const char*)(gbase) + (voff)[_i]), (PG8_LAS unsigned*)(lds + (bufoff) + ldsw + _i * 8192), 16, 0, 0); } while (0)
#define PG8_LDA(dst, b, h) do { _Pragma("unroll") for (int m = 0; m < 4; ++m) _Pragma("unroll") for (int k = 0; k < 2; ++k) dst[m][k] = *(const PG8_LAS bf16x8*)(lds + PG8_SA(b, h) + aoff + m * 2048 + k * 1024); } while (0)
#define PG8_LDB(dst, b, h) do { _Pragma("unroll") for (int n = 0; n < 2; ++n) _Pragma("unroll") for (int k = 0; k < 2; ++k) dst[n][k] = *(const PG8_LAS bf16x8*)(lds + PG8_SB(b, h) + boff + n * 2048 + k * 1024); } while (0)
#define PG8_MMA(ai, bj, At, Bt) do { __builtin_amdgcn_s_setprio(1); _Pragma("unroll") for (int m = 0; m < 4; ++m) _Pragma("unroll") for (int n = 0; n < 2; ++n) _Pragma("unroll") for (int k = 0; k < 2; ++k) \
        acc[ai][bj][m][n] = __builtin_amdgcn_mfma_f32_16x16x32_bf16(Bt[n][k], At[m][k], acc[ai][bj][m][n], 0, 0, 0); __builtin_amdgcn_s_setprio(0); } while (0)
#ifndef HOST_EMU
#define PG8_WAIT_V(n) asm volatile("s_waitcnt vmcnt(" #n ")" ::: "memory")
#define PG8_WAIT_L(n) asm volatile("s_waitcnt lgkmcnt(" #n ")" ::: "memory")
#else
#define PG8_WAIT_V(n) do {} while (0)
#define PG8_WAIT_L(n) do {} while (0)
#endif
#define PG8_BAR __builtin_amdgcn_s_barrier()
#define PG8_SCHED __builtin_amdgcn_sched_barrier(0)
    Unit cur, nxt; int ui = 0;
    if (!S.next(0, cur)) return;
    f32x4 acc[2][2][4][2];
#pragma unroll
    for (int a = 0; a < 2; ++a)
#pragma unroll
        for (int b = 0; b < 2; ++b)
#pragma unroll
            for (int m = 0; m < 4; ++m)
#pragma unroll
                for (int n = 0; n < 2; ++n) acc[a][b][m][n] = (f32x4){0.f, 0.f, 0.f, 0.f};
    bf16x8 At[4][2], B0[2][2], B1[2][2];
    const char* cA = (const char*)g.A + (size_t)cur.pm * tstep; const char* cB = (const char*)g.Bt + (size_t)cur.pn * tstep;
    S.a_ready(cur);
    PG8_STAGE(PG8_SB(0, 0), cB, voffB); PG8_STAGE(PG8_SA(0, 0), cA, voffA); PG8_STAGE(PG8_SB(0, 1), cB + hstep, voffB); PG8_STAGE(PG8_SA(0, 1), cA + hstep, voffA);
    if (wr == 1) PG8_BAR;
    PG8_WAIT_V(4); PG8_BAR;
    PG8_STAGE(PG8_SB(1, 0), cB + kstep, voffB); PG8_STAGE(PG8_SA(1, 0), cA + kstep, voffA); PG8_STAGE(PG8_SB(1, 1), cB + hstep + kstep, voffB);
    PG8_WAIT_V(6); PG8_BAR;
    PG8_STAMP();
    for (;;) {
        const bool has_next = S.next(ui + 1, nxt);
        const char* nA = has_next ? (const char*)g.A + (size_t)nxt.pm * tstep : cA; const char* nB = has_next ? (const char*)g.Bt + (size_t)nxt.pn * tstep : cB;
        for (int t = 0; t < nt; t += 2) {
            const bool last = (t == nt - 2);
            const char* a1 = cA + (size_t)(t + 1) * kstep;
            const char* a2 = last ? nA : cA + (size_t)(t + 2) * kstep; const char* b2 = last ? nB : cB + (size_t)(t + 2) * kstep;
            const char* a3 = a2 + kstep; const char* b3 = b2 + kstep;
            if (last && has_next) S.a_ready(nxt);
            PG8_LDB(B0, 0, 0); PG8_SCHED; PG8_LDA(At, 0, 0); PG8_STAGE(PG8_SA(1, 1), a1 + hstep, voffA);
            PG8_WAIT_L(8); PG8_BAR; PG8_WAIT_L(0); PG8_MMA(0, 0, At, B0); PG8_BAR; PG8_SCHED;
            PG8_LDB(B1, 0, 1); PG8_STAGE(PG8_SB(0, 0), b2, voffB);
            PG8_BAR; PG8_WAIT_L(0); PG8_MMA(0, 1, At, B1); PG8_BAR;
            PG8_LDA(At, 0, 1); PG8_STAGE(PG8_SA(0, 0), a2, voffA);
            PG8_BAR; PG8_WAIT_L(0); PG8_MMA(1, 0, At, B0); PG8_BAR; PG8_SCHED;
            PG8_STAGE(PG8_SB(0, 1), b2 + hstep, voffB);
            PG8_WAIT_V(6); PG8_BAR; PG8_MMA(1, 1, At, B1); PG8_BAR;
            PG8_LDB(B0, 1, 0); PG8_SCHED; PG8_LDA(At, 1, 0); PG8_STAGE(PG8_SA(0, 1), a2 + hstep, voffA);
            PG8_WAIT_L(8); PG8_BAR; PG8_WAIT_L(0); PG8_MMA(0, 0, At, B0); PG8_BAR; PG8_SCHED;
            PG8_LDB(B1, 1, 1); PG8_STAGE(PG8_SB(1, 0), b3, voffB);
            PG8_BAR; PG8_WAIT_L(0); PG8_MMA(0, 1, At, B1); PG8_BAR;
            PG8_LDA(At, 1, 1); PG8_STAGE(PG8_SA(1, 0), a3, voffA);
            PG8_BAR; PG8_WAIT_L(0); PG8_MMA(1, 0, At, B0); PG8_BAR; PG8_SCHED;
            PG8_STAGE(PG8_SB(1, 1), b3 + hstep, voffB);
            PG8_WAIT_V(6); PG8_BAR; PG8_MMA(1, 1, At, B1); PG8_BAR;
        }
        PG8_STAMP();
        if constexpr (!Epi::AFTER_DRAIN) { E(acc, cur, wr, wc, fr, fq); S.done(cur); }
        PG8_STAMP();
        if (!has_next) break;
#pragma unroll
        for (int a = 0; a < 2; ++a)
#pragma unroll
            for (int b = 0; b < 2; ++b)
#pragma unroll
                for (int m = 0; m < 4; ++m)
#pragma unroll
                    for (int n = 0; n < 2; ++n) acc[a][b][m][n] = (f32x4){0.f, 0.f, 0.f, 0.f};
        cur = nxt; cA = nA; cB = nB; ++ui;
    }
    PG8_WAIT_V(0);
    if (wr == 0) PG8_BAR;
    PG8_BAR;
    if constexpr (Epi::AFTER_DRAIN) { E.fused(acc, cur, wr, wc, fr, fq, lds, wid, lane); S.done(cur); }
    PG8_STAMP();
    if (STAMP && wid == 0) { stamps[lane] = lane < nts ? (((unsigned long long)(unsigned)ts_hi << 32) | (unsigned)ts_lo) : 0ull;
        if (lane == 62) stamps[62] = rt_entry; if (lane == 63) stamps[63] = 0ull; }
#undef PG8_STAMP
#undef PG8_SA
#undef PG8_SB
#undef PG8_STAGE
#undef PG8_LDA
#undef PG8_LDB
#undef PG8_MMA
#undef PG8_WAIT_V
#undef PG8_WAIT_L
#undef PG8_BAR
#undef PG8_SCHED
}
}
template <class Epi> struct PgEpiT {
    static constexpr bool PERM = true, AFTER_DRAIN = false;
    Epi e;
    DEV void operator()(const f32x4 (&acc)[2][2][4][2], const pg8::Unit& u, int wr, int wc, int fr, int fq) const {
        float pre[2][4];
#pragma unroll
        for (int ai = 0; ai < 2; ++ai)
#pragma unroll
            for (int m = 0; m < 4; ++m) pre[ai][m] = e.colpre(u.pm * 256 + ai * 128 + wr * 64 + m * 16 + fr);
#pragma unroll
        for (int ai = 0; ai < 2; ++ai)
#pragma unroll
            for (int m = 0; m < 4; ++m) {
#pragma unroll
                for (int bj = 0; bj < 2; ++bj) {
                    const int wcol = u.pm * 256 + ai * 128 + wr * 64 + m * 16 + fr, tok0 = u.pn * 256 + bj * 128 + wc * 32 + 8 * fq;
                    const float v[8] = {acc[ai][bj][m][0][0], acc[ai][bj][m][0][1], acc[ai][bj][m][0][2], acc[ai][bj][m][0][3], acc[ai][bj][m][1][0], acc[ai][bj][m][1][1], acc[ai][bj][m][1][2], acc[ai][bj][m][1][3]};
                    e.tok8(tok0, wcol, v, pre[ai][m]);
                }
                SCHED_FENCE();
            }
    }
};
template <class Epi> struct PgEpiN {
    static constexpr bool PERM = true, AFTER_DRAIN = false;
    Epi e;
    DEV void operator()(const f32x4 (&acc)[2][2][4][2], const pg8::Unit& u, int wr, int wc, int fr, int fq) const {
#pragma unroll
        for (int ai = 0; ai < 2; ++ai)
#pragma unroll
            for (int m = 0; m < 4; ++m) {
#pragma unroll
                for (int bj = 0; bj < 2; ++bj) {
                    const int tok = u.pm * 256 + ai * 128 + wr * 64 + m * 16 + fr, wcol0 = u.pn * 256 + bj * 128 + wc * 32 + 8 * fq;
                    const float v[8] = {acc[ai][bj][m][0][0], acc[ai][bj][m][0][1], acc[ai][bj][m][0][2], acc[ai][bj][m][0][3], acc[ai][bj][m][1][0], acc[ai][bj][m][1][1], acc[ai][bj][m][1][2], acc[ai][bj][m][1][3]};
                    e.col8(tok, wcol0, v);
                }
                SCHED_FENCE();
            }
    }
};
template <class Epi>
DEV void gemm_pg8_T(const bf16_t* A, const bf16_t* Wt, int Mtok, int N, unsigned char* smem, const Epi& epi) {
    pg8::Gemm g{Wt, A, N, Mtok, 1024};
    pg8::StaticOrder S; S.init(N, Mtok, (int)gridDim.x, (int)blockIdx.x);
    PgEpiT<Epi> E{epi};
    pg8::gemm_phase<PgEpiT<Epi>, pg8::StaticOrder, false>((PG8_LAS unsigned char*)smem, g, S, E);
    __syncthreads();
}
template <class Epi>
DEV void gemm_pg8_N(const bf16_t* A, const bf16_t* Wt, int Mtok, int N, unsigned char* smem, const Epi& epi) {
    pg8::Gemm g{A, Wt, Mtok, N, 1024};
    pg8::StaticOrder S; S.init(Mtok, N, (int)gridDim.x, (int)blockIdx.x);
    PgEpiN<Epi> E{epi};
    pg8::gemm_phase<PgEpiN<Epi>, pg8::StaticOrder, false>((PG8_LAS unsigned char*)smem, g, S, E);
    __syncthreads();
}
struct EpiL0In {
    unsigned char* ws;
    DEV void operator()(int row, int col, float v0, float v1, float v2, float v3) const {
        u32x2 o; o[0] = pk2(v0, v1); o[1] = pk2(v2, v3);
        const bool lat = row < TL; const int b = lat ? row / L : (row - TL) / LC, t = lat ? row - b * L : (row - TL) - b * LC, Lx = lat ? L : LC;
        const int cu = __builtin_amdgcn_readfirstlane(col & ~127);
        if (cu < 1536) { bf16_t* d = (bf16_t*)(ws + WS_P + (lat ? P_HYT_LAT : P_HYT_CTX)) + ((size_t)b * 1536 + col) * Lx + t; *(u32x2*)d = o; }
        else if (cu < 2048) { bf16_t* d = (bf16_t*)(ws + WS_P + P_Q0) + (size_t)row * 512 + (col - 1536); d[0] = (bf16_t)f2bf(v0); d[512] = (bf16_t)f2bf(v1); d[1024] = (bf16_t)f2bf(v2); d[1536] = (bf16_t)f2bf(v3); }
        else if (cu < 2176) { bf16_t* d = (bf16_t*)(ws + WS_P + P_K0) + (size_t)row * 128 + (col - 2048); d[0] = (bf16_t)f2bf(v0); d[128] = (bf16_t)f2bf(v1); d[256] = (bf16_t)f2bf(v2); d[384] = (bf16_t)f2bf(v3); }
        else { bf16_t* d = (bf16_t*)(ws + WS_P + (lat ? P_VT_LAT : P_VT_CTX)) + ((size_t)b * 128 + (col - 2176)) * Lx + t; *(u32x2*)d = o; }
    }
};
struct EpiL0InT {
    unsigned char* ws;
    DEV float colpre(int) const { return 0.f; }
    DEV void tok8(int row, int col, const float (&v)[8], float) const {
        const bool lat = row < TL; const int b = lat ? row / L : (row - TL) / LC, t = lat ? row - b * L : (row - TL) - b * LC, Lx = lat ? L : LC;
        u32x4 o; o[0] = pk2(v[0], v[1]); o[1] = pk2(v[2], v[3]); o[2] = pk2(v[4], v[5]); o[3] = pk2(v[6], v[7]);
        if (col < 1536) { *(u32x4*)((bf16_t*)(ws + WS_P + (lat ? P_HYT_LAT : P_HYT_CTX)) + ((size_t)b * 1536 + col) * Lx + t) = o; }
        else if (col < 2048) { bf16_t* d = (bf16_t*)(ws + WS_P + P_Q0) + (size_t)row * 512 + (col - 1536);
#pragma unroll
            for (int i = 0; i < 8; ++i) d[i * 512] = (bf16_t)f2bf(v[i]); }
        else if (col < 2176) { bf16_t* d = (bf16_t*)(ws + WS_P + P_K0) + (size_t)row * 128 + (col - 2048);
#pragma unroll
            for (int i = 0; i < 8; ++i) d[i * 128] = (bf16_t)f2bf(v[i]); }
        else { *(u32x4*)((bf16_t*)(ws + WS_P + (lat ? P_VT_LAT : P_VT_CTX)) + ((size_t)b * 128 + (col - 2176)) * Lx + t) = o; }
    }
};
struct EpiBf16 {
    bf16_t* out; int ld;
    DEV void col8(int row, int col0, const float (&v)[8]) const { u32x4 o; o[0] = pk2(v[0], v[1]); o[1] = pk2(v[2], v[3]); o[2] = pk2(v[4], v[5]); o[3] = pk2(v[6], v[7]); *(u32x4*)(out + (size_t)row * ld + col0) = o; }
    DEV void operator()(int row, int col, float v0, float v1, float v2, float v3) const {
        bf16_t* d = out + (size_t)row * ld + col; d[0] = (bf16_t)f2bf(v0); d[ld] = (bf16_t)f2bf(v1); d[2 * ld] = (bf16_t)f2bf(v2); d[3 * ld] = (bf16_t)f2bf(v3);
    }
};
struct EpiHg {
    unsigned char* ws; const float* lg;
    DEV void operator()(int row, int col, float v0, float v1, float v2, float v3) const {
        float vv[4] = {v0, v1, v2, v3};
        const bool lat = row < TL; const int b = lat ? row / L : (row - TL) / LC, t = lat ? row - b * L : (row - TL) - b * LC, Lx = lat ? L : LC;
        const int cu = __builtin_amdgcn_readfirstlane(col & ~255);
        if (cu >= 3072 && cu < 4096) {
            bf16_t* d = (bf16_t*)(ws + WS_M) + (lat ? (size_t)0 : (size_t)NB * 1024 * L) + ((size_t)b * 1024 + (col - 3072)) * Lx + t;
            u32x2 o; o[0] = pk2(v0, v1); o[1] = pk2(v2, v3); *(u32x2*)d = o;
            return;
        }
        if (cu < 1024 || cu >= 4096) {
#pragma unroll
            for (int i = 0; i < 4; ++i) vv[i] = silu_f(vv[i]);
        } else {
            const int c = col - 1024;
            const float oml = 1.f - 1.f / (1.f + __expf(lg[c] - lg[2048 + c]));
#pragma unroll
            for (int i = 0; i < 4; ++i) vv[i] = oml * __builtin_amdgcn_rcpf(1.f + __expf(vv[i]));
        }
        if (cu < 3072) {
            bf16_t* d = (bf16_t*)(ws + WS_P + (lat ? P1_KQT_LAT : P1_KQT_CTX)) + ((size_t)b * 3072 + col) * Lx + t;
            u32x2 o; o[0] = pk2(vv[0], vv[1]); o[1] = pk2(vv[2], vv[3]); *(u32x2*)d = o;
        } else {
            if (!lat) return;
            bf16_t* d = (bf16_t*)(ws + WS_P + P1_G) + (size_t)row * 1024 + (col - 4096); d[0] = (bf16_t)f2bf(vv[0]); d[1024] = (bf16_t)f2bf(vv[1]); d[2048] = (bf16_t)f2bf(vv[2]); d[3072] = (bf16_t)f2bf(vv[3]);
        }
    }
};
struct EpiHgT {
    unsigned char* ws; const float* lg; int plain;
    DEV float colpre(int col) const {
        const int cu = __builtin_amdgcn_readfirstlane(col & ~255);
        if (cu < 1024 || cu >= 3072) return 0.f;
        const int c = col - 1024; return 1.f - __builtin_amdgcn_rcpf(1.f + __expf(lg[c] - lg[2048 + c]));
    }
    DEV void tok8(int row, int col, const float (&v)[8], float oml) const {
        const bool lat = row < TL; const int b = lat ? row / L : (row - TL) / LC, t = lat ? row - b * L : (row - TL) - b * LC, Lx = lat ? L : LC;
        const int cu = __builtin_amdgcn_readfirstlane(col & ~255);
        float vv[8];
#pragma unroll
        for (int i = 0; i < 8; ++i) vv[i] = v[i];
        if (cu >= 3072 && cu < 4096) {
            u32x4 o; o[0] = pk2(vv[0], vv[1]); o[1] = pk2(vv[2], vv[3]); o[2] = pk2(vv[4], vv[5]); o[3] = pk2(vv[6], vv[7]);
            *(u32x4*)((bf16_t*)(ws + WS_M) + (lat ? (size_t)0 : (size_t)NB * 1024 * L) + ((size_t)b * 1024 + (col - 3072)) * Lx + t) = o;
            return;
        }
        if (plain) {} else if (cu < 1024 || cu >= 4096) {
#pragma unroll
            for (int i = 0; i < 8; ++i) vv[i] = silu_f(vv[i]);
        } else {
#pragma unroll
            for (int i = 0; i < 8; ++i) vv[i] = oml * __builtin_amdgcn_rcpf(1.f + __expf(vv[i]));
        }
        if (cu < 3072) {
            u32x4 o; o[0] = pk2(vv[0], vv[1]); o[1] = pk2(vv[2], vv[3]); o[2] = pk2(vv[4], vv[5]); o[3] = pk2(vv[6], vv[7]);
            *(u32x4*)((bf16_t*)(ws + WS_P + (lat ? P1_KQT_LAT : P1_KQT_CTX)) + ((size_t)b * 3072 + col) * Lx + t) = o;
        } else {
            if (!lat) return;
            bf16_t* d = (bf16_t*)(ws + WS_P + P1_G) + (size_t)row * 1024 + (col - 4096);
#pragma unroll
            for (int i = 0; i < 8; ++i) d[i * 1024] = (bf16_t)f2bf(vv[i]);
        }
    }
};
struct EpiRes {
    const Params* p; int from_inputs, layer, goff;
    DEV void col8(int row, int col0, const float (&v)[8]) const {
        float* H = (float*)(p->ws + WS_H) + (size_t)row * 1024 + col0; const float* hin = h_row(*p, from_inputs, row) + col0;
        const float* gt = (const float*)(p->ws + WS_MOD) + ((size_t)layer * NR + mod_row(row)) * 6144 + goff + col0;
        const f32x4 h0 = *(const f32x4*)hin, h1 = *(const f32x4*)(hin + 4), g0 = *(const f32x4*)gt, g1 = *(const f32x4*)(gt + 4);
        f32x4 o0, o1;
#pragma unroll
        for (int i = 0; i < 4; ++i) { o0[i] = h0[i] + g0[i] * v[i]; o1[i] = h1[i] + g1[i] * v[4 + i]; }
        *(f32x4*)H = o0; *(f32x4*)(H + 4) = o1;
    }
    DEV void operator()(int row, int col, float v0, float v1, float v2, float v3) const {
        float* H = (float*)(p->ws + WS_H) + (size_t)row * 1024 + col;
        const float* hin = h_row(*p, from_inputs, row) + col;
        const float gt = ((const float*)(p->ws + WS_MOD))[((size_t)layer * NR + mod_row(row)) * 6144 + goff + col];
        const float h0 = hin[0], h1 = hin[1024], h2 = hin[2048], h3 = hin[3072];
        H[0] = h0 + gt * v0; H[1024] = h1 + gt * v1; H[2048] = h2 + gt * v2; H[3072] = h3 + gt * v3;
    }
};

struct HyRaw { u32x4 mid; unsigned short lft, rgt; };
DEV HyRaw hy_load(const bf16_t* row, int t0, int Lx) { HyRaw r; r.mid = *(const u32x4*)(row + t0); r.lft = t0 > 0 ? row[t0 - 1] : (unsigned short)0; r.rgt = t0 + 8 < Lx ? row[t0 + 8] : (unsigned short)0; return r; }
DEV void hy_conv8(const HyRaw& r, float w0, float w1, float w2, float b, float (&o)[8]) {
    float x[10]; x[0] = bf2f(r.lft); x[9] = bf2f(r.rgt);
#pragma unroll
    for (int i = 0; i < 4; ++i) { x[1 + 2 * i] = bflo(r.mid[i]); x[2 + 2 * i] = bfhi(r.mid[i]); }
#pragma unroll
    for (int i = 0; i < 8; ++i) o[i] = w0 * x[i] + w1 * x[i + 1] + w2 * x[i + 2] + b;
}
template <int TPC>
DEV void hyena_item(const Params& p, int set, int item, unsigned char* smem, bool nofft = false, bool nostore = false) {
    const int Ls = set ? LC : L, S = set ? FS_CTX : FS_LAT, N = 1 << (2 * S);
    constexpr int CPR = NT / TPC, NR8 = 8 / CPR;
    const int gi = tidx() / TPC, g = tidx() % TPC;
    const int bp = item >> 6, c0 = (item & 63) * 8, ba = bp * 2, bb = ba + 1;
    cf2* buf = (cf2*)smem + (size_t)gi * N;
    bf16_t* stg = (bf16_t*)(smem + (size_t)CPR * N * 8);
    const bf16_t* hy = (const bf16_t*)(p.ws + WS_P + (set ? P_HYT_CTX : P_HYT_LAT));
    const float* cw = p.in[I_HYCW]; const float* cb = p.in[I_HYCB];
    const cf2* HF = (const cf2*)(p.ws + WS_F + (set ? F_HF_CTX : F_HF_LAT));
    const float invN = 1.f / (float)N;
    const int t0 = g * 8; const bool own = t0 < Ls;
    HyRaw rv[2], rx1[2];
    cf2 hfr[16];
#define HY_FETCH(cc) do { if (own) { \
        rv[0] = hy_load(hy + ((size_t)ba * 1536 + (cc)) * Ls, t0, Ls); rv[1] = hy_load(hy + ((size_t)bb * 1536 + (cc)) * Ls, t0, Ls); \
        rx1[0] = hy_load(hy + ((size_t)ba * 1536 + 512 + (cc)) * Ls, t0, Ls); rx1[1] = hy_load(hy + ((size_t)bb * 1536 + 512 + (cc)) * Ls, t0, Ls); } } while (0)
    HY_FETCH(c0 + gi);
#pragma unroll 1
    for (int rd = 0; rd < NR8; ++rd) {
        const int cs = rd * CPR + gi, c = c0 + cs;
#pragma unroll
        for (int u = 0; u < 16; ++u) { hfr[u].x = 0.f; hfr[u].y = 0.f; if (g + TPC * u < N) hfr[u] = HF[(size_t)c * N + g + TPC * u]; }
        float za[8], zb[8];
        if (own) { hy_conv8(rv[0], cw[c], cw[1536 + c], cw[3072 + c], cb[c], za); hy_conv8(rv[1], cw[c], cw[1536 + c], cw[3072 + c], cb[c], zb); }
        for (int t = g; t < N; t += TPC) { if (t >= Ls) { cf2 z; z.x = 0.f; z.y = 0.f; buf[fsw(t)] = z; } }
        if (own) {
#pragma unroll
            for (int i = 0; i < 8; ++i) { cf2 v; v.x = za[i]; v.y = zb[i]; buf[fsw(t0 + i)] = v; }
        }
        __syncthreads();
#pragma unroll
        for (int n = 0; n < 2; ++n) {
            if (!nofft) fft_fwd(buf, S, g, TPC);
#pragma unroll
            for (int u = 0; u < 16; ++u) { const int k = g + TPC * u; if (k < N) buf[fsw(k)] = cmul(buf[fsw(k)], hfr[u]); }
            if (n == 0) {
#pragma unroll
                for (int u = 0; u < 16; ++u) if (g + TPC * u < N) hfr[u] = HF[(size_t)(512 + c) * N + g + TPC * u];
            }
            __syncthreads();
            if (!nofft) fft_inv(buf, S, g, TPC);
            const int gc = (n + 1) * 512 + c;
            if (own) {
                const float w0 = cw[gc], w1 = cw[1536 + gc], w2 = cw[3072 + gc], b = cb[gc], dsk = p.in[I_HYSKIP][n * 512 + c];
                float ga[8], gb[8];
                hy_conv8(rx1[0], w0, w1, w2, b, ga); hy_conv8(rx1[1], w0, w1, w2, b, gb);
                if (n == 0) { rx1[0] = hy_load(hy + ((size_t)ba * 1536 + 1024 + c) * Ls, t0, Ls); rx1[1] = hy_load(hy + ((size_t)bb * 1536 + 1024 + c) * Ls, t0, Ls); }
#pragma unroll
                for (int i = 0; i < 8; ++i) { const cf2 cv = buf[fsw(t0 + i)]; za[i] = ga[i] * (cv.x * invN + dsk * za[i]); zb[i] = gb[i] * (cv.y * invN + dsk * zb[i]); }
            }
            if (n == 0) {
                __syncthreads();
                for (int t = g; t < N; t += TPC) { if (t >= Ls) { cf2 z; z.x = 0.f; z.y = 0.f; buf[fsw(t)] = z; } }
                if (own) {
#pragma unroll
                    for (int i = 0; i < 8; ++i) { cf2 v; v.x = za[i]; v.y = zb[i]; buf[fsw(t0 + i)] = v; }
                }
                __syncthreads();
            } else {
                if (rd + 1 < NR8) HY_FETCH(c0 + (rd + 1) * CPR + gi);
                if (own) {
#pragma unroll
                    for (int i = 0; i < 8; ++i) {
                        const int ra = t0 + i, rb = Ls + t0 + i;
                        stg[(size_t)(ra + (ra >> 3)) * 8 + cs] = (bf16_t)f2bf(za[i]); stg[(size_t)(rb + (rb >> 3)) * 8 + cs] = (bf16_t)f2bf(zb[i]); }
                }
            }
        }
        __syncthreads();
    }
#undef HY_FETCH
    if (!nostore) {
        bf16_t* M = (bf16_t*)(p.ws + WS_M);
        for (int i = tidx(); i < 2 * Ls; i += NT) {
            const int bsel = i >= Ls, t = bsel ? i - Ls : i, bx = bsel ? bb : ba;
            const size_t tok = set ? (size_t)TL + (size_t)bx * LC + t : (size_t)bx * L + t;
            *(u32x4*)(M + tok * 1024 + c0) = *(const u32x4*)(stg + (size_t)(i + (i >> 3)) * 8);
        }
    }
    __syncthreads();
}
DEV void rope_store(const bf16_t* src, bf16_t* dst, int pos, bool rope, float scale, int ph, int sub) {
    const u32x4 ua = *(const u32x4*)(src + ph * 32 + sub * 8), ub = *(const u32x4*)(src + ph * 32 + 16 + sub * 8);
    float a[8], b[8];
#pragma unroll
    for (int i = 0; i < 4; ++i) { a[2 * i] = bflo(ua[i]); a[2 * i + 1] = bfhi(ua[i]); b[2 * i] = bflo(ub[i]); b[2 * i + 1] = bfhi(ub[i]); }
    if (rope) {
        const float pv = (float)(ph == 0 ? pos / 64 : pos % 64);
#pragma unroll
        for (int e = 0; e < 8; ++e) {
            const float inv = exp2f(-(float)(sub * 8 + e) * (13.287712379549449f / 16.f));
            const float ang = pv * inv, cs = __cosf(ang), sn = __sinf(ang);
            const float na = a[e] * cs - b[e] * sn, nb = b[e] * cs + a[e] * sn; a[e] = na; b[e] = nb;
        }
    }
    u32x4 oa, ob;
#pragma unroll
    for (int i = 0; i < 4; ++i) { oa[i] = pk2(a[2 * i] * scale, a[2 * i + 1] * scale); ob[i] = pk2(b[2 * i] * scale, b[2 * i + 1] * scale); }
    *(u32x4*)(dst + ph * 32 + sub * 8) = oa; *(u32x4*)(dst + ph * 32 + 16 + sub * 8) = ob;
}
constexpr int A_LDQ = 72, A_LDV = 136;
DEV void attn_item(const Params& p, int set, int item, unsigned char* smem) {
    bf16_t* Qs = (bf16_t*)smem;
    bf16_t* Ks = Qs + 128 * A_LDQ;
    bf16_t* Vt = Ks + 128 * A_LDQ;
    const int tid = tidx(), lane = tid & 63, w = tid >> 6, l15 = lane & 15, lg = lane >> 4;
    const int nqb = set ? LC / 128 : L / 128;
    const int h = item & 7, qb = (item >> 3) % nqb, b = (item >> 3) / nqb, kvh = h >> 2;
    const bf16_t* Q0 = (const bf16_t*)(p.ws + WS_P + P_Q0); const bf16_t* K0 = (const bf16_t*)(p.ws + WS_P + P_K0);
    const int qtok0 = set ? TL + b * LC + qb * 128 : b * L + qb * 128;
    { const int row = tid >> 2, ph = (tid >> 1) & 1, sub = tid & 1;
      rope_store(Q0 + (size_t)(qtok0 + row) * 512 + h * 64, Qs + row * A_LDQ, qb * 128 + row, set == 0, 0.125f, ph, sub); }
    __syncthreads();
    bf16x8 qf[2];
    qf[0] = *(const bf16x8*)(Qs + (w * 16 + l15) * A_LDQ + 8 * lg); qf[1] = *(const bf16x8*)(Qs + (w * 16 + l15) * A_LDQ + 32 + 8 * lg);
    float m_run = p.in[I_SINK][h], l_run = 1.f;
    f32x4 O[4];
#pragma unroll
    for (int i = 0; i < 4; ++i) O[i] = (f32x4){0.f, 0.f, 0.f, 0.f};
    const int nwin = set ? 0 : 3, nctx = LC / 128;
    for (int kbi = 0; kbi < nwin + nctx; ++kbi) {
        const bool win = kbi < nwin; const int kb = win ? qb - 1 + kbi : kbi - nwin;
        if (win && (kb < 0 || kb >= L / 128)) continue;
        const int ktok0 = win ? b * L + kb * 128 : TL + b * LC + kb * 128;
        __syncthreads();
        { const int row = tid >> 2, ph = (tid >> 1) & 1, sub = tid & 1;
          rope_store(K0 + (size_t)(ktok0 + row) * 128 + kvh * 64, Ks + row * A_LDQ, kb * 128 + row, win, 1.f, ph, sub); }
        { const bf16_t* vt = (const bf16_t*)(p.ws + WS_P + (win ? P_VT_LAT : P_VT_CTX)); const int Lx = win ? L : LC;
#pragma unroll
          for (int i = 0; i < 2; ++i) { const int id = tid + NT * i, d = id >> 4, kc = id & 15;
              *(u32x4*)(Vt + d * A_LDV + kc * 8) = *(const u32x4*)(vt + ((size_t)b * 128 + kvh * 64 + d) * Lx + kb * 128 + kc * 8); } }
        __syncthreads();
#pragma unroll
        for (int ch = 0; ch < 2; ++ch) {
            f32x4 st[4];
#pragma unroll
            for (int u = 0; u < 4; ++u) {
                const bf16_t* kr = Ks + ((ch * 4 + u) * 16 + l15) * A_LDQ + 8 * lg;
                f32x4 z = (f32x4){0.f, 0.f, 0.f, 0.f};
                z = __builtin_amdgcn_mfma_f32_16x16x32_bf16(*(const bf16x8*)kr, qf[0], z, 0, 0, 0);
                z = __builtin_amdgcn_mfma_f32_16x16x32_bf16(*(const bf16x8*)(kr + 32), qf[1], z, 0, 0, 0);
                st[u] = z;
            }
            float cmax = -INFINITY;
            if (win) {
                const int qpos = qb * 128 + w * 16 + l15;
#pragma unroll
                for (int u = 0; u < 4; ++u)
#pragma unroll
                    for (int r = 0; r < 4; ++r) { const int kpos = kb * 128 + (ch * 4 + u) * 16 + 4 * lg + r; const int dd = qpos - kpos; if (dd > 128 || dd < -128) st[u][r] = -INFINITY; }
            }
#pragma unroll
            for (int u = 0; u < 4; ++u)
#pragma unroll
                for (int r = 0; r < 4; ++r) cmax = fmaxf(cmax, st[u][r]);
            cmax = fmaxf(cmax, __shfl_xor(cmax, 16)); cmax = fmaxf(cmax, __shfl_xor(cmax, 32));
            const float m_new = fmaxf(m_run, cmax), alpha = __expf(m_run - m_new);
            float ls = 0.f;
#pragma unroll
            for (int u = 0; u < 4; ++u)
#pragma unroll
                for (int r = 0; r < 4; ++r) { const float e = __expf(st[u][r] - m_new); st[u][r] = e; ls += e; }
            ls += __shfl_xor(ls, 16); ls += __shfl_xor(ls, 32);
            l_run = l_run * alpha + ls; m_run = m_new;
#pragma unroll
            for (int i = 0; i < 4; ++i) { O[i][0] *= alpha; O[i][1] *= alpha; O[i][2] *= alpha; O[i][3] *= alpha; }
#pragma unroll
            for (int ss = 0; ss < 2; ++ss) {
                u32x4 pu; pu[0] = pk2(st[2 * ss][0], st[2 * ss][1]); pu[1] = pk2(st[2 * ss][2], st[2 * ss][3]); pu[2] = pk2(st[2 * ss + 1][0], st[2 * ss + 1][1]); pu[3] = pk2(st[2 * ss + 1][2], st[2 * ss + 1][3]);
                const bf16x8 pf = __builtin_bit_cast(bf16x8, pu);
                const int key0 = (ch * 4 + 2 * ss) * 16 + 4 * lg;
#pragma unroll
                for (int dt = 0; dt < 4; ++dt) {
                    const bf16_t* vr = Vt + (dt * 16 + l15) * A_LDV + key0;
                    u32x4 vu; const u32x2 v0 = *(const u32x2*)vr, v1 = *(const u32x2*)(vr + 16); vu[0] = v0[0]; vu[1] = v0[1]; vu[2] = v1[0]; vu[3] = v1[1];
                    O[dt] = __builtin_amdgcn_mfma_f32_16x16x32_bf16(__builtin_bit_cast(bf16x8, vu), pf, O[dt], 0, 0, 0);
                }
            }
        }
    }
    const float il = 1.f / l_run;
    bf16_t* M = (bf16_t*)(p.ws + WS_M) + (size_t)(qtok0 + w * 16 + l15) * 1024 + 512 + h * 64;
#pragma unroll
    for (int dt = 0; dt < 4; ++dt) { u32x2 o; o[0] = pk2(O[dt][0] * il, O[dt][1] * il); o[1] = pk2(O[dt][2] * il, O[dt][3] * il); *(u32x2*)(M + dt * 16 + 4 * lg) = o; }
    __syncthreads();
}
static_assert(NF_LAT / 256 <= 16 && NF_CTX / 64 <= 16 && L / 8 <= 256 && LC / 8 <= 64 && 2 * NF_LAT * 8 + 2 * L * 18 <= SMEM_BYTES && 8 * NF_CTX * 8 + 2 * LC * 18 <= SMEM_BYTES, "hyena item geometry");
constexpr int P3_HY_LAT = (NB / 2) * 64, P3_HY_CTX = (NB / 2) * 64, P3_AT_LAT = NB * (L / 128) * 8, P3_AT_CTX = NB * (LC / 128) * 8;
DEV void phase3(const Params& p, unsigned char* smem, int var = 0) {
    const int total = P3_HY_LAT + P3_AT_LAT + P3_HY_CTX + P3_AT_CTX;
    for (int it = blockIdx.x; it < total; it += gridDim.x) {
        int i = it;
        if ((var == 1 || var == 3 || var == 4) && !(i < P3_HY_LAT || (i >= P3_HY_LAT + P3_AT_LAT && i < P3_HY_LAT + P3_AT_LAT + P3_HY_CTX))) continue;
        if (var == 2 && (i < P3_HY_LAT || (i >= P3_HY_LAT + P3_AT_LAT && i < P3_HY_LAT + P3_AT_LAT + P3_HY_CTX))) continue;
        if (i < P3_HY_LAT) { hyena_item<256>(p, 0, i, smem, var == 3, var == 4); continue; } i -= P3_HY_LAT;
        if (i < P3_AT_LAT) { attn_item(p, 0, i, smem); continue; } i -= P3_AT_LAT;
        if (i < P3_HY_CTX) { hyena_item<64>(p, 1, i, smem, var == 3, var == 4); continue; } i -= P3_HY_CTX;
        attn_item(p, 1, i, smem);
    }
}

constexpr int K_LDK = 136, K_LDS = 129, K_LDC = 52;
DEV unsigned fkey(float f) { const unsigned u = __builtin_bit_cast(unsigned, f); return (u & 0x80000000u) ? ~u : (u | 0x80000000u); }
constexpr int cand_off(int i) { int o = 0; for (int k = 0; k < i; ++k) o += 16 / (k + 1); return o; }
DEV void topk_load_keys(const Params& p, int layer, int h, unsigned char* smem) {
    bf16_t* Ks = (bf16_t*)smem;
    const bf16_t* keys = (const bf16_t*)(p.ws + WS_W + W_KEYS) + (size_t)layer * 262144 + (size_t)h * 32768;
    const int tid = tidx();
#pragma unroll
    for (int i = 0; i < 8; ++i) { const int id = tid + NT * i, row = id >> 4, kc = id & 15; *(u32x4*)(Ks + row * K_LDK + kc * 8) = *(const u32x4*)(keys + (size_t)row * 128 + kc * 8); }
    __syncthreads();
}
#ifndef HOST_EMU
template <int CTRL> DEV unsigned dpp_u32(unsigned v) { return (unsigned)__builtin_amdgcn_update_dpp(0, (int)v, CTRL, 0xF, 0xF, true); }
#else
template <int CTRL> DEV unsigned dpp_u32(unsigned v) { const int lane = tidx() & 63; const int src = CTRL == 0xB1 ? (lane ^ 1) : CTRL == 0x4E ? (lane ^ 2) : CTRL == 0x128 ? (lane ^ 8) : ((lane & ~7) | (7 - (lane & 7))); return emu_shfl(v, src); }
#endif
DEV unsigned max8_u32(unsigned v) { unsigned t = dpp_u32<0xB1>(v); v = v > t ? v : t; t = dpp_u32<0x4E>(v); v = v > t ? v : t; t = dpp_u32<0x141>(v); return v > t ? v : t; }
DEV float sum8_f32(float v) { v += __builtin_bit_cast(float, dpp_u32<0xB1>(__builtin_bit_cast(unsigned, v))); v += __builtin_bit_cast(float, dpp_u32<0x4E>(__builtin_bit_cast(unsigned, v))); v += __builtin_bit_cast(float, dpp_u32<0x141>(__builtin_bit_cast(unsigned, v))); return v; }
DEV float unkey(unsigned k) { const unsigned u = (k & 0x80000000u) ? (k & 0x7fffffffu) : ~k; return __builtin_bit_cast(float, u); }
template <int N> DEV void bitonic_desc(unsigned (&a)[N]) {
#pragma unroll
    for (int k = 2; k <= N; k <<= 1)
#pragma unroll
        for (int j = k >> 1; j > 0; j >>= 1)
#pragma unroll
            for (int i = 0; i < N; ++i) { const int l = i ^ j; if (l > i) { const unsigned x = a[i], y = a[l]; const unsigned hi = x > y ? x : y, lo = x > y ? y : x; if ((i & k) == 0) { a[i] = hi; a[l] = lo; } else { a[i] = lo; a[l] = hi; } } }
}
DEV void merge16(const unsigned* lst, int nlist, unsigned first, int sub, unsigned& r0, unsigned& r1) {
    unsigned cur = first; int head = 0; r0 = 0u; r1 = 0u;
#pragma unroll
    for (int it = 0; it < 16; ++it) {
        const unsigned m = max8_u32(cur);
        if (sub == (it & 7)) { if (it < 8) r0 = m; else r1 = m; }
        if (cur == m) { ++head; cur = head < nlist ? lst[head] : 0u; }
    }
}
DEV void topk_item(const Params& p, int h, int tok0, unsigned char* smem, const bf16x8 (&afr)[16]) {
    bf16_t* Ks = (bf16_t*)smem;
    float* Sc = (float*)(Ks + 2 * 128 * K_LDK);
    unsigned* s12 = (unsigned*)Sc + 64 * 8 * 17;
    unsigned* cl = s12 + 64 * 32;
    const int tid = tidx(), lane = tid & 63, w = tid >> 6;
    const int row = tid >> 3, sub = tid & 7;
#pragma unroll
    for (int part = 0; part < 2; ++part) {
        { const int mi = w >> 2, ni = w & 3;
          f32x16 acc;
#pragma unroll
          for (int r = 0; r < 16; ++r) acc[r] = 0.f;
          const bf16_t* bs = Ks + (part * 128 + ni * 32 + (lane & 31)) * K_LDK + 8 * (lane >> 5);
#pragma unroll
          for (int kk = 0; kk < 8; ++kk) acc = __builtin_amdgcn_mfma_f32_32x32x16_bf16(part ? afr[8 + kk] : afr[kk], *(const bf16x8*)(bs + kk * 16), acc, 0, 0, 0);
#pragma unroll
          for (int r = 0; r < 16; ++r) Sc[(mi * 32 + (r & 3) + 8 * (r >> 2) + 4 * (lane >> 5)) * K_LDS + ni * 32 + (lane & 31)] = acc[r]; }
        __syncthreads();
        unsigned mk[16];
#pragma unroll
        for (int i = 0; i < 16; ++i) mk[i] = (fkey(Sc[row * K_LDS + sub * 16 + i]) & ~127u) | (unsigned)(127 - (sub * 16 + i));
        bitonic_desc<16>(mk);
        __syncthreads();
        unsigned* lst = (unsigned*)Sc + (row * 8 + sub) * 17;
#pragma unroll
        for (int i = 0; i < 16; ++i) lst[i] = mk[i];
        unsigned r0, r1;
        merge16(lst, 16, mk[0], sub, r0, r1);
        s12[(row * 2 + part) * 16 + sub] = r0; s12[(row * 2 + part) * 16 + 8 + sub] = r1;
        __syncthreads();
    }
    {
        const unsigned* k1 = s12 + row * 32; const unsigned* k2 = k1 + 16;
        unsigned ck[8];
#pragma unroll
        for (int m = 0; m < 8; ++m) {
            const int cc = sub + 8 * m; int ci = 0, off = 0;
#pragma unroll
            for (int i = 0; i < 15; ++i) { const bool ge = cc >= cand_off(i + 1); ci += ge ? 1 : 0; off += ge ? 16 / (i + 1) : 0; }
            const int cj = cc - off;
            ck[m] = 0u;
            if (cc < 50) ck[m] = (fkey(unkey((k1[ci] & ~127u) | 64u) + unkey((k2[cj] & ~127u) | 64u)) & ~63u) | (unsigned)(63 - cc);
        }
        bitonic_desc<8>(ck);
        unsigned* lst = cl + (row * 8 + sub) * 9;
#pragma unroll
        for (int m = 0; m < 8; ++m) lst[m] = ck[m];
        unsigned r0, r1;
        merge16(lst, 8, ck[0], sub, r0, r1);
        const float a = unkey((r0 & ~63u) | 32u), b = unkey((r1 & ~63u) | 32u);
        const unsigned kmax = max8_u32(r0 > r1 ? r0 : r1); const float vmax = unkey((kmax & ~63u) | 32u);
        const float ea = __expf(a - vmax), eb = __expf(b - vmax);
        const float inv = 1.f / sum8_f32(ea + eb);
        int eidx[2];
#pragma unroll
        for (int q = 0; q < 2; ++q) {
            const int cc = 63 - (int)((q ? r1 : r0) & 63u); int ci = 0, off = 0;
#pragma unroll
            for (int i = 0; i < 15; ++i) { const bool ge = cc >= cand_off(i + 1); ci += ge ? 1 : 0; off += ge ? 16 / (i + 1) : 0; }
            const int cj = cc - off;
            eidx[q] = (127 - (int)(k1[ci] & 127u)) * 128 + (127 - (int)(k2[cj] & 127u));
        }
        unsigned* ost = cl + 64 * 8 * 9 + row * 32;
        ost[sub] = (unsigned)eidx[0]; ost[8 + sub] = (unsigned)eidx[1]; ost[16 + sub] = __builtin_bit_cast(unsigned, ea * inv); ost[24 + sub] = __builtin_bit_cast(unsigned, eb * inv);
    }
    __syncthreads();
    {
        const u32x4 v = *(const u32x4*)(cl + 64 * 8 * 9 + row * 32 + sub * 4);
        unsigned char* dst = p.ws + (sub < 4 ? WS_IDX : WS_GATE) + ((size_t)(tok0 + row) * 128 + h * 16 + (sub & 3) * 4) * 4;
#ifndef HOST_EMU
        asm volatile("global_store_dwordx4 %0, %1, off sc1" :: "v"(dst), "v"(v) : "memory");
        asm volatile("s_waitcnt vmcnt(0)" ::: "memory");
#else
        *(u32x4*)dst = v;
#endif
    }
    __syncthreads();
}
#define TOPK_LOAD(AF, tok0_, h_) do { const int lane_ = tidx() & 63, w_ = tidx() >> 6; \
        const bf16_t* ag_ = (const bf16_t*)(p.ws + WS_P) + (size_t)((tok0_) + (w_ >> 2) * 32 + (lane_ & 31)) * 2048 + (h_) * 256 + 8 * (lane_ >> 5); \
        _Pragma("unroll") for (int q_ = 0; q_ < 16; ++q_) AF[q_] = *(const bf16x8*)(ag_ + (q_ >> 3) * 128 + (q_ & 7) * 16); } while (0)
DEV void topk_phase(const Params& p, int layer, int ntok, unsigned char* smem) {
    const int G = gridDim.x, bid = blockIdx.x, h = bid & 7;
    const int nt = ntok / 64;
    bf16x8 afA[16], afB[16];
    if ((G & 7) == 0) {
        const int st = G >> 3; int tt = bid >> 3;
        if (tt < nt) { TOPK_LOAD(afA, tt * 64, h); topk_load_keys(p, layer, h, smem); }
        while (tt < nt) {
            if (tt + st < nt) TOPK_LOAD(afB, (tt + st) * 64, h);
            topk_item(p, h, tt * 64, smem, afA);
            tt += st; if (tt >= nt) break;
            if (tt + st < nt) TOPK_LOAD(afA, (tt + st) * 64, h);
            topk_item(p, h, tt * 64, smem, afB);
            tt += st;
        }
    } else {
        for (int it = bid; it < nt * 8; it += G) { __syncthreads(); TOPK_LOAD(afA, (it >> 3) * 64, it & 7); topk_load_keys(p, layer, it & 7, smem); topk_item(p, it & 7, (it >> 3) * 64, smem, afA); }
    }
}
#ifndef HOST_EMU
DEV void peer_item(const Params& p, int layer, int item, const unsigned* dep, bf16x8 (&af)[16], int next_tok0, int next_h);
DEV void tg_phase(const Params& p, int layer, int ntok, unsigned char* smem) {
    const int G = gridDim.x, bid = blockIdx.x, h = bid & 7, team = bid >> 3, st = G >> 3;
    const int nblk = ntok / 64;
    unsigned* cnt = (unsigned*)(p.ws + WS_CTRL + CTRL_TG) + (size_t)layer * 320 * 16;
    const int n = team < nblk ? (nblk - team + st - 1) / st : 0;
    const int lead = (team & 1) ? 4 : 2;
    bf16x8 af[16];
    int kt = 0; bool af_ready = false;
    if (n > 0) topk_load_keys(p, layer, h, smem);
#pragma unroll 1
    for (int kg = 0; kg < n; ++kg) {
#pragma unroll 1
        while (kt < n && kt < kg + lead) {
            const int blk = team + st * kt;
            if (!af_ready) TOPK_LOAD(af, blk * 64, h);
            topk_item(p, h, blk * 64, smem, af);
            if (tidx() == 0) __hip_atomic_fetch_add(cnt + blk * 16, 1u, __ATOMIC_RELAXED, __HIP_MEMORY_SCOPE_AGENT);
            ++kt; af_ready = false;
        }
        const int blk = team + st * kg;
        af_ready = kt < n;
        peer_item(p, layer, blk * 8 + h, cnt + blk * 16, af, af_ready ? (team + st * kt) * 64 : -1, h);
    }
}
#endif

DEV float gelu_f(float x) {
    const float z = fabsf(x) * 0.70710678118654752f;
    const float t = __builtin_amdgcn_rcpf(fmaf(0.3275911f, z, 1.f));
    float pl = fmaf(1.061405429f, t, -1.453152027f); pl = fmaf(pl, t, 1.421413741f); pl = fmaf(pl, t, -0.284496736f); pl = fmaf(pl, t, 0.254829592f); pl *= t;
    const float er = fmaf(-pl, __builtin_amdgcn_exp2f(z * z * -1.4426950408889634f), 1.f);
    return 0.5f * x + 0.5f * fabsf(x) * er;
}
#ifndef HOST_EMU
DEV float swap16_add(float a, float b) { const auto r = __builtin_amdgcn_permlane16_swap(__builtin_bit_cast(unsigned, a), __builtin_bit_cast(unsigned, b), false, false);
    return __builtin_bit_cast(float, (unsigned)r[0]) + __builtin_bit_cast(float, (unsigned)r[1]); }
#else
DEV float swap16_add(float a, float b) { const int lane = tidx() & 63; const float pa = emu_shfl(a, lane ^ 16), pb = emu_shfl(b, lane ^ 16); return (lane & 16) ? pb + b : a + pa; }
#endif
#ifndef HOST_EMU
DEV void wait_count(const unsigned* c, unsigned want, unsigned* tmo) {
    unsigned sp = 0u;
    while ((unsigned)__builtin_amdgcn_readfirstlane((int)__hip_atomic_load(c, __ATOMIC_RELAXED, __HIP_MEMORY_SCOPE_AGENT)) < want) {
        __builtin_amdgcn_s_sleep(2);
        if ((++sp & 255u) == 0u) { if (__hip_atomic_load(tmo, __ATOMIC_RELAXED, __HIP_MEMORY_SCOPE_AGENT)) break; if (sp > (1u << 18)) { atomicAdd(tmo, 1u); break; } }
    }
}
#endif
DEV void peer_item(const Params& p, int layer, int item, const unsigned* dep, bf16x8 (&af)[16], int next_tok0, int next_h) {
    const int tok = item * 8 + (tidx() >> 6), lane = tidx() & 63, li = lane & 31, half = lane >> 5;
    const bf16_t* A = (const bf16_t*)(p.ws + WS_A) + (size_t)tok * 1024 + li * 32;
    const unsigned char* UV = p.ws + WS_UV + (size_t)layer * 16384 * 1024;
    const float* SU = (const float*)(p.ws + WS_S8) + (size_t)(layer * 2) * 16384; const float* SV = SU + 16384;
    float y[32]; int xh[4], xl[4], xsum = 0; float xs;
    { float xf[32]; float amax = 0.f;
#pragma unroll
      for (int q = 0; q < 4; ++q) { const u32x4 a = *(const u32x4*)(A + 8 * q);
#pragma unroll
        for (int i = 0; i < 4; ++i) { xf[8 * q + 2 * i] = bflo(a[i]); xf[8 * q + 2 * i + 1] = bfhi(a[i]); amax = fmaxf(amax, fmaxf(fabsf(xf[8 * q + 2 * i]), fabsf(xf[8 * q + 2 * i + 1]))); } }
#pragma unroll
      for (int m = 16; m >= 1; m >>= 1) amax = fmaxf(amax, __shfl_xor(amax, m));
      xs = amax > 0.f ? amax * (1.f / 119.f) : 1.f; const float xinv = amax > 0.f ? 119.f / amax : 1.f;
#pragma unroll
      for (int d = 0; d < 4; ++d) { unsigned h = 0u, l = 0u;
#pragma unroll
        for (int e = 0; e < 8; ++e) { const int X = (int)rintf(xf[8 * d + e] * xinv); xsum += X; const int lo = ((X + 8) & 15) - 8, hi = (X - lo) >> 4; h |= ((unsigned)hi & 15u) << (4 * e); l |= ((unsigned)lo & 15u) << (4 * e); }
        xh[d] = (int)h; xl[d] = (int)l; } }
#pragma unroll
    for (int i = 0; i < 32; ++i) y[i] = 0.f;
    const int* IDX = (const int*)(p.ws + WS_IDX) + (size_t)tok * 128; const float* GT = (const float*)(p.ws + WS_GATE) + (size_t)tok * 128;
#ifndef HOST_EMU
    if (dep) wait_count(dep, 8u, (unsigned*)(p.ws + WS_CTRL) + 128);
    const int i_lo = (int)__hip_atomic_load((const unsigned*)IDX + lane, __ATOMIC_RELAXED, __HIP_MEMORY_SCOPE_AGENT), i_hi = (int)__hip_atomic_load((const unsigned*)IDX + 64 + lane, __ATOMIC_RELAXED, __HIP_MEMORY_SCOPE_AGENT);
    const float gt_lo = __builtin_bit_cast(float, __hip_atomic_load((const unsigned*)GT + lane, __ATOMIC_RELAXED, __HIP_MEMORY_SCOPE_AGENT)), gt_hi = __builtin_bit_cast(float, __hip_atomic_load((const unsigned*)GT + 64 + lane, __ATOMIC_RELAXED, __HIP_MEMORY_SCOPE_AGENT));
#else
    (void)dep;
    const int i_lo = IDX[lane], i_hi = IDX[64 + lane]; const float gt_lo = GT[lane], gt_hi = GT[64 + lane];
#endif
    const float su_lo = SU[i_lo] * xs, su_hi = SU[i_hi] * xs, gs_lo = gt_lo * SV[i_lo], gs_hi = gt_hi * SV[i_hi];
    const int own_src = ((lane & 1) << 5) + (((lane >> 2) & 1) << 4) + (((lane >> 1) & 1) << 3);
    u32x4 uq[4], vq[4]; unsigned eo[4];
#define PG_IDX(g) do { _Pragma("unroll") for (int s_ = 0; s_ < 4; ++s_) eo[s_] = ((unsigned)__shfl((g) < 8 ? i_lo : i_hi, (((g) & 7) << 3) + 2 * s_ + half) << 10) + (unsigned)li * 16u; } while (0)
#define PG_LOADU() do { _Pragma("unroll") for (int s_ = 0; s_ < 4; ++s_) uq[s_] = *(const u32x4*)(UV + eo[s_]); } while (0)
#define PG_LOADV() do { _Pragma("unroll") for (int s_ = 0; s_ < 4; ++s_) vq[s_] = *(const u32x4*)(UV + eo[s_] + 512u); } while (0)
    PG_IDX(0); PG_LOADU(); PG_LOADV();
    for (int g = 0; g < 16; ++g) {
        float d[4];
#pragma unroll
        for (int s4 = 0; s4 < 4; ++s4) {
            int a1 = 0, a0 = 0;
#pragma unroll
            for (int dw = 0; dw < 4; ++dw) { a1 = __builtin_amdgcn_sdot8((int)uq[s4][dw], xh[dw], a1, false); a0 = __builtin_amdgcn_sdot8((int)uq[s4][dw], xl[dw], a0, false); }
            d[s4] = (float)(32 * a1 + 2 * a0 + xsum);
        }
        SCHED_FENCE();
        if (g + 1 < 16) { PG_IDX(g + 1); PG_LOADU(); }
        float r1;
        { const float r20 = swap16_add(d[0], d[2]), r21 = swap16_add(d[1], d[3]);
          const bool hi = (li & 8) != 0; const float send = hi ? r20 : r21, keep = hi ? r21 : r20;
          r1 = sum8_f32(keep + __builtin_bit_cast(float, dpp_u32<0x128>(__builtin_bit_cast(unsigned, send)))); }
        const float act = gelu_f(__shfl(r1, own_src) * (g < 8 ? su_lo : su_hi)) * (g < 8 ? gs_lo : gs_hi);
#pragma unroll
        for (int s4 = 0; s4 < 4; ++s4) {
            const float aj = __shfl(act, ((g & 7) << 3) + 2 * s4 + half);
#pragma unroll
            for (int dw = 0; dw < 4; ++dw) {
                const f32x2 f0 = __builtin_amdgcn_cvt_scalef32_pk_f32_fp4(vq[s4][dw], 1.0f, 0), f1 = __builtin_amdgcn_cvt_scalef32_pk_f32_fp4(vq[s4][dw], 1.0f, 1),
                            f2 = __builtin_amdgcn_cvt_scalef32_pk_f32_fp4(vq[s4][dw], 1.0f, 2), f3 = __builtin_amdgcn_cvt_scalef32_pk_f32_fp4(vq[s4][dw], 1.0f, 3);
                const int e0 = dw * 8;
                y[e0] = fmaf(aj, f0[0], y[e0]); y[e0 + 1] = fmaf(aj, f0[1], y[e0 + 1]); y[e0 + 2] = fmaf(aj, f1[0], y[e0 + 2]); y[e0 + 3] = fmaf(aj, f1[1], y[e0 + 3]);
                y[e0 + 4] = fmaf(aj, f2[0], y[e0 + 4]); y[e0 + 5] = fmaf(aj, f2[1], y[e0 + 5]); y[e0 + 6] = fmaf(aj, f3[0], y[e0 + 6]); y[e0 + 7] = fmaf(aj, f3[1], y[e0 + 7]);
            }
            SCHED_FENCE(); }
        if (g + 1 < 16) PG_LOADV();
    }
#undef PG_IDX
#undef PG_LOADU
#undef PG_LOADV
    SCHED_FENCE();
    if (next_tok0 >= 0) { TOPK_LOAD(af, next_tok0, next_h); }
    SCHED_FENCE();
    float yy[16];
#pragma unroll
    for (int i = 0; i < 16; ++i) { const float send = half ? y[i] : y[16 + i], keep = half ? y[16 + i] : y[i]; yy[i] = keep + __shfl_xor(send, 32); }
    const int c0 = li * 32 + half * 16;
    float* H = (float*)(p.ws + WS_H) + (size_t)tok * 1024 + c0;
    const float* g2 = (const float*)(p.ws + WS_MOD) + ((size_t)layer * NR + mod_row(tok)) * 6144 + 5120 + c0;
    float hv[16]; float ss = 0.f;
#pragma unroll
    for (int i = 0; i < 4; ++i) { const f32x4 hh = *(const f32x4*)(H + 4 * i), gg = *(const f32x4*)(g2 + 4 * i);
#pragma unroll
        for (int j = 0; j < 4; ++j) { const float v = hh[j] + gg[j] * yy[4 * i + j]; hv[4 * i + j] = v; ss += v * v; } }
    ss = wave_sum(ss);
    const float rstd = rsqrtf(ss * (1.f / 1024.f) + 1e-6f);
    if (layer == 0) {
#pragma unroll
        for (int i = 0; i < 4; ++i) { f32x4 o; o[0] = hv[4 * i]; o[1] = hv[4 * i + 1]; o[2] = hv[4 * i + 2]; o[3] = hv[4 * i + 3]; *(f32x4*)(H + 4 * i) = o; }
        const float* g = p.in[I_N1G] + 1024 + c0;
        const float* mod = (const float*)(p.ws + WS_MOD) + ((size_t)1 * NR + mod_row(tok)) * 6144 + c0;
        bf16_t* Ao = (bf16_t*)(p.ws + WS_A) + (size_t)tok * 1024 + c0;
        u32x4 o0, o1; float r[16];
#pragma unroll
        for (int i = 0; i < 16; ++i) r[i] = hv[i] * rstd * g[i] * (1.f + mod[1024 + i]) + mod[i];
#pragma unroll
        for (int i = 0; i < 4; ++i) { o0[i] = pk2(r[2 * i], r[2 * i + 1]); o1[i] = pk2(r[8 + 2 * i], r[8 + 2 * i + 1]); }
        *(u32x4*)Ao = o0; *(u32x4*)(Ao + 8) = o1;
    } else {
        const float* g = p.in[I_FG] + c0; float* out = p.out + (size_t)tok * 1024 + c0;
#pragma unroll
        for (int i = 0; i < 4; ++i) { f32x4 o; o[0] = hv[4 * i] * rstd * g[4 * i]; o[1] = hv[4 * i + 1] * rstd * g[4 * i + 1]; o[2] = hv[4 * i + 2] * rstd * g[4 * i + 2]; o[3] = hv[4 * i + 3] * rstd * g[4 * i + 3]; *(f32x4*)(out + 4 * i) = o; }
    }
}

#undef TOPK_LOAD

constexpr int S3_LD = 136, S3_LDT = 24, S3_LDV = 72;
constexpr int S3_Q = 0, S3_K = S3_Q + 64 * S3_LD * 2, S3_KT = S3_K + 64 * S3_LD * 2, S3_D = S3_KT + 4 * 128 * S3_LDT * 2, S3_V = S3_D + 4 * 128 * 4, S3_ST = S3_V + 64 * S3_LDV * 2,
              S3_P = S3_ST + 2 * 64 * S3_LD * 2, S3_END = S3_P + 4 * 16 * S3_LDT * 2;
static_assert(S3_END <= SMEM_BYTES, "scan LDS");
DEV void scan_block(const Params& p, int bi, unsigned char* smem, int var = 0) {
    const int tid = tidx(), lane = tid & 63, w = tid >> 6, l15 = lane & 15, lg4 = lane >> 4, l31 = lane & 31, lh = lane >> 5;
    const int half = bi & 1, dir = (bi >> 1) & 1, h = (bi >> 2) & 7, b = bi >> 5;
    const bf16_t* P1 = (const bf16_t*)(p.ws + WS_P);
    const bf16_t* IT = (const bf16_t*)(p.ws + WS_M);
    bf16_t* Oo = (bf16_t*)(p.ws + WS_F + (dir ? F_OB : F_OF));
    bf16_t* Qs = (bf16_t*)(smem + S3_Q); bf16_t* Ks = (bf16_t*)(smem + S3_K); bf16_t* KT = (bf16_t*)(smem + S3_KT); float* Ds = (float*)(smem + S3_D);
    bf16_t* Vs = (bf16_t*)(smem + S3_V); bf16_t* ST = (bf16_t*)(smem + S3_ST); bf16_t* Ps = (bf16_t*)(smem + S3_P);
    const int NCH = (LC + L) / 64;
    const int kt = w >> 1, vt = w & 1;
    f32x16 S;
#pragma unroll
    for (int r = 0; r < 16; ++r) S[r] = 0.f;
    for (int i = tid; i < 64 * S3_LD / 2; i += NT) ((unsigned*)ST)[i] = 0u;
    const int pk = tid & 127, pblk = tid >> 7;
    u32x4 ka[2], qa[2], va, kb2[2], qb2[2], vb2;
    const int kcol = 1024 * (1 + dir) + h * 128 + pk, qcol = h * 128 + pk;
#define S3_T0(c) ((c) * 64 < LC ? (dir ? LC - 64 - (c) * 64 : (c) * 64) : (dir ? L - 64 - ((c) * 64 - LC) : (c) * 64 - LC))
#define S3_LOAD(c, KR, QR, VR) do { const bool lat_ = (c) * 64 >= LC; const int t0_ = S3_T0(c); const int Lx_ = lat_ ? L : LC; \
        const bf16_t* kq_ = (const bf16_t*)(p.ws + WS_P + (lat_ ? P1_KQT_LAT : P1_KQT_CTX)) + (size_t)b * 3072 * Lx_ + t0_ + pblk * 16; \
        KR[0] = *(const u32x4*)(kq_ + (size_t)kcol * Lx_); KR[1] = *(const u32x4*)(kq_ + (size_t)kcol * Lx_ + 8); \
        if (lat_) { QR[0] = *(const u32x4*)(kq_ + (size_t)qcol * Lx_); QR[1] = *(const u32x4*)(kq_ + (size_t)qcol * Lx_ + 8); } else { QR[0] = (u32x4){0u, 0u, 0u, 0u}; QR[1] = QR[0]; } \
        { const int v_ = tid >> 3, c8_ = tid & 7; const bf16_t* it_ = IT + (lat_ ? (size_t)0 : (size_t)NB * 1024 * L) + ((size_t)b * 1024 + h * 128 + half * 64 + v_) * Lx_ + t0_ + c8_ * 8; VR = *(const u32x4*)it_; } } while (0)
#define S3_PREP(KR, QR, VR) do { \
            float bsum = 0.f; unsigned short kt16[16]; \
            _Pragma("unroll") for (int rr = 0; rr < 16; ++rr) { \
                const int tl = dir ? 15 - rr : rr; \
                const unsigned ku_ = dir ? KR[(15 - rr) >> 3][((15 - rr) & 7) >> 1] : KR[rr >> 3][(rr & 7) >> 1]; const unsigned qu_ = dir ? QR[(15 - rr) >> 3][((15 - rr) & 7) >> 1] : QR[rr >> 3][(rr & 7) >> 1]; \
                const bool odd_ = dir ? (((15 - rr) & 1) != 0) : ((rr & 1) != 0); \
                const float kv = odd_ ? bfhi(ku_) : bflo(ku_), qv = odd_ ? bfhi(qu_) : bflo(qu_); \
                bsum += __log2f(1.f - kv); \
                const float eb = __builtin_amdgcn_exp2f(bsum), ieb = __builtin_amdgcn_exp2f(fminf(-bsum, 115.f)); \
                const unsigned short qt = (unsigned short)f2bf(qv * eb), ktv = (unsigned short)f2bf(kv * ieb); \
                Qs[(pblk * 16 + tl) * S3_LD + pk] = qt; Ks[(pblk * 16 + tl) * S3_LD + pk] = ktv; \
                if (dir) kt16[15 - rr] = ktv; else kt16[rr] = ktv; \
            } \
            u32x4 o0, o1; \
            _Pragma("unroll") for (int i = 0; i < 4; ++i) { o0[i] = (unsigned)kt16[2 * i] | ((unsigned)kt16[2 * i + 1] << 16); o1[i] = (unsigned)kt16[8 + 2 * i] | ((unsigned)kt16[8 + 2 * i + 1] << 16); } \
            *(u32x4*)(KT + (pblk * 128 + pk) * S3_LDT) = o0; *(u32x4*)(KT + (pblk * 128 + pk) * S3_LDT + 8) = o1; \
            Ds[pblk * 128 + pk] = __builtin_amdgcn_exp2f(bsum); \
            { const int v_ = tid >> 3, c8_ = tid & 7; *(u32x4*)(Vs + v_ * S3_LDV + c8_ * 8) = VR; } } while (0)
    S3_LOAD(0, ka, qa, va);
    for (int c = 0; c < NCH; ++c) {
        const bool lat = c * 64 >= LC; const int t0 = S3_T0(c); const size_t tokb = lat ? (size_t)b * L + t0 : (size_t)TL + (size_t)b * LC + t0;
        if ((c & 1) == 0) { if (c + 1 < NCH) S3_LOAD(c + 1, kb2, qb2, vb2); } else { if (c + 1 < NCH) S3_LOAD(c + 1, ka, qa, va); }
        lds_barrier();
        if (var != 1) { if ((c & 1) == 0) S3_PREP(ka, qa, va); else S3_PREP(kb2, qb2, vb2); }
        lds_barrier();

        if (lat && w < 4) {
            f32x4 pt = (f32x4){0.f, 0.f, 0.f, 0.f};
#pragma unroll
            for (int kk = 0; kk < 4; ++kk)
                pt = __builtin_amdgcn_mfma_f32_16x16x32_bf16(*(const bf16x8*)(Ks + (w * 16 + l15) * S3_LD + kk * 32 + 8 * lg4), *(const bf16x8*)(Qs + (w * 16 + l15) * S3_LD + kk * 32 + 8 * lg4), pt, 0, 0, 0);
            float pm[4];
#pragma unroll
            for (int r = 0; r < 4; ++r) { const int sl = 4 * lg4 + r; const bool keep = dir ? (sl >= l15) : (sl <= l15); pm[r] = keep ? pt[r] : 0.f; }
            u32x2 o; o[0] = pk2(pm[0], pm[1]); o[1] = pk2(pm[2], pm[3]);
            *(u32x2*)(Ps + (w * 16 + l15) * S3_LDT + 4 * lg4) = o;
        }
        lds_barrier();
        for (int ib = 0; ib < (var == 2 ? 0 : 4); ++ib) {
            const int blk = dir ? 3 - ib : ib;
            const int cur = (c * 4 + ib) & 1;
            { const bf16x8 a = *(const bf16x8*)(KT + (blk * 128 + 32 * kt + l31) * S3_LDT + 8 * lh);
              const bf16x8 bb = *(const bf16x8*)(Vs + (32 * vt + l31) * S3_LDV + blk * 16 + 8 * lh);
              S = __builtin_amdgcn_mfma_f32_32x32x16_bf16(a, bb, S, 0, 0, 0);
#pragma unroll
              for (int g = 0; g < 4; ++g) { const f32x4 dv = *(const f32x4*)(Ds + blk * 128 + 32 * kt + 8 * g + 4 * lh);
                  S[4 * g] *= dv[0]; S[4 * g + 1] *= dv[1]; S[4 * g + 2] *= dv[2]; S[4 * g + 3] *= dv[3];
                  u32x2 o; o[0] = pk2(S[4 * g], S[4 * g + 1]); o[1] = pk2(S[4 * g + 2], S[4 * g + 3]);
                  *(u32x2*)(ST + ((cur ^ 1) * 64 + 32 * vt + l31) * S3_LD + 32 * kt + 8 * g + 4 * lh) = o; } }
            if (lat && w < 4) {
                f32x4 o = (f32x4){0.f, 0.f, 0.f, 0.f};
#pragma unroll
                for (int kk = 0; kk < 4; ++kk)
                    o = __builtin_amdgcn_mfma_f32_16x16x32_bf16(*(const bf16x8*)(ST + (cur * 64 + 16 * w + l15) * S3_LD + kk * 32 + 8 * lg4), *(const bf16x8*)(Qs + (blk * 16 + l15) * S3_LD + kk * 32 + 8 * lg4), o, 0, 0, 0);
                bf16x8 va = (bf16x8){0, 0, 0, 0, 0, 0, 0, 0}, pb = va;
                if (lg4 < 2) { va = *(const bf16x8*)(Vs + (16 * w + l15) * S3_LDV + blk * 16 + 8 * lg4); pb = *(const bf16x8*)(Ps + (blk * 16 + l15) * S3_LDT + 8 * lg4); }
                o = __builtin_amdgcn_mfma_f32_16x16x32_bf16(va, pb, o, 0, 0, 0);
                u32x2 ou; ou[0] = pk2(o[0], o[1]); ou[1] = pk2(o[2], o[3]);
                *(u32x2*)(Oo + (tokb + blk * 16 + l15) * 1024 + h * 128 + half * 64 + 16 * w + 4 * lg4) = ou;
            }
            lds_barrier();
        }
    }
    lds_barrier();
#undef S3_T0
#undef S3_LOAD
#undef S3_PREP
}
DEV void readout_item(const Params& p, int item) {
    const int tok = item * 8 + (tidx() >> 6), lane = tidx() & 63;
    const bf16_t* of = (const bf16_t*)(p.ws + WS_F + F_OF) + (size_t)tok * 1024 + lane * 16; const bf16_t* ob = (const bf16_t*)(p.ws + WS_F + F_OB) + (size_t)tok * 1024 + lane * 16;
    const bf16_t* gp = (const bf16_t*)(p.ws + WS_P + P1_G) + (size_t)tok * 1024 + lane * 16;
    const float* on = p.in[I_HGON] + (lane & 7) * 16;
    float o[16], gg[16]; float ss = 0.f;
    { const u32x4 a0 = *(const u32x4*)of, a1 = *(const u32x4*)(of + 8), b0 = *(const u32x4*)ob, b1 = *(const u32x4*)(ob + 8), g0 = *(const u32x4*)gp, g1 = *(const u32x4*)(gp + 8);
#pragma unroll
      for (int i = 0; i < 4; ++i) { o[2 * i] = bflo(a0[i]) + bflo(b0[i]); o[2 * i + 1] = bfhi(a0[i]) + bfhi(b0[i]); o[8 + 2 * i] = bflo(a1[i]) + bflo(b1[i]); o[8 + 2 * i + 1] = bfhi(a1[i]) + bfhi(b1[i]);
          gg[2 * i] = bflo(g0[i]); gg[2 * i + 1] = bfhi(g0[i]); gg[8 + 2 * i] = bflo(g1[i]); gg[8 + 2 * i + 1] = bfhi(g1[i]); } }
#pragma unroll
    for (int i = 0; i < 16; ++i) ss += o[i] * o[i];
    ss += __shfl_xor(ss, 1); ss += __shfl_xor(ss, 2); ss += __shfl_xor(ss, 4);
    const float rstd = rsqrtf(ss * (1.f / 128.f) + 1e-6f);
    bf16_t* M = (bf16_t*)(p.ws + WS_M) + (size_t)tok * 1024 + lane * 16;
    u32x4 o0, o1; float r[16];
#pragma unroll
    for (int i = 0; i < 16; ++i) r[i] = o[i] * rstd * on[i] * gg[i];
#pragma unroll
    for (int i = 0; i < 4; ++i) { o0[i] = pk2(r[2 * i], r[2 * i + 1]); o1[i] = pk2(r[8 + 2 * i], r[8 + 2 * i + 1]); }
    *(u32x4*)M = o0; *(u32x4*)(M + 8) = o1;
}

#ifndef HOST_EMU
#define XB_TMO      128
#define XB_XCNT(j)  (256  + 64 * (j))
#define XB_XSUB(j)  (1280 + 64 * (j))
#define XB_XGEN(j)  (2304 + 64 * (j))
#define XB_TOP      3328
#define XB_TOPGEN   3392
#define XCD_BAR_WORDS 3456
#define XB_SPIN_CAP (1u << 18)
#define LAS __attribute__((address_space(3)))

__device__ __forceinline__ unsigned xb_ld(unsigned* p)              { return __hip_atomic_load(p, __ATOMIC_RELAXED, __HIP_MEMORY_SCOPE_AGENT); }
__device__ __forceinline__ unsigned xb_add(unsigned* p, unsigned v) { return __hip_atomic_fetch_add(p, v, __ATOMIC_RELAXED, __HIP_MEMORY_SCOPE_AGENT); }
__device__ __forceinline__ unsigned xb_xcc_id() { return (unsigned)__builtin_amdgcn_s_getreg((3 << 11) | 20) & 0xFu; }
#define XB_SPIN(cond, bar) do { unsigned _sp = 0; while (cond) { __builtin_amdgcn_s_sleep(1); \
    if ((++_sp & 255u) == 0u) { if (xb_ld(&(bar)[XB_TMO])) break; if (_sp > XB_SPIN_CAP) { atomicAdd(&(bar)[XB_TMO], 1u); break; } } } } while (0)

struct XcdBarrier {
    unsigned* bar; unsigned x;
    volatile LAS unsigned* st;
};

__device__ __forceinline__ XcdBarrier xcd_barrier_post(unsigned* bar, volatile LAS unsigned* st) {
    XcdBarrier b; b.bar = bar; b.x = xb_xcc_id(); b.st = st;
    if (threadIdx.x == 0) (void)xb_add(&bar[XB_XCNT(b.x)], 1u);
    return b;
}
__device__ __forceinline__ void xcd_barrier_complete(unsigned* bar, unsigned x, unsigned& nloc, unsigned& nx) {
    const unsigned G = gridDim.x * gridDim.y * gridDim.z;
    unsigned sum, cnt, mine, sp = 0u;
    for (;;) {
        sum = 0u; cnt = 0u; mine = 0u;
#pragma unroll
        for (unsigned j = 0; j < 16; ++j) { const unsigned c = xb_ld(&bar[XB_XCNT(j)]); sum += c; cnt += (c > 0u) ? 1u : 0u; mine = (j == x) ? c : mine; }
        if (sum == G) break;
        __builtin_amdgcn_s_sleep(1);
        if ((++sp & 255u) == 0u) { if (xb_ld(&bar[XB_TMO])) break; if (sp > XB_SPIN_CAP) { atomicAdd(&bar[XB_TMO], 1u); break; } }
    }
    nloc = mine > 0u ? mine : 1u; nx = cnt > 0u ? cnt : 1u;
}

__device__ __forceinline__ void xcd_barrier(const XcdBarrier& b) {
    asm volatile("s_waitcnt vmcnt(0)" ::: "memory");
    __syncthreads();
    if (threadIdx.x == 0) {
        unsigned* bar = b.bar;
        __builtin_amdgcn_s_waitcnt(0);
        unsigned nloc = b.st[0], nx = b.st[1];
        if (nloc == 0u) { xcd_barrier_complete(bar, b.x, nloc, nx); b.st[0] = nloc; b.st[1] = nx; }
        const unsigned old = xb_add(&bar[XB_XSUB(b.x)], 1u);
        const unsigned gen = old / nloc;
        if (old + 1u == (gen + 1u) * nloc) {
            __builtin_amdgcn_fence(__ATOMIC_RELEASE, "agent");
            asm volatile("s_waitcnt vmcnt(0)" ::: "memory");
            const unsigned og = xb_add(&bar[XB_TOP], 1u);
            const unsigned tg = og / nx;
            if (og + 1u == (tg + 1u) * nx) xb_add(&bar[XB_TOPGEN], 1u);
            else XB_SPIN(xb_ld(&bar[XB_TOPGEN]) == tg, bar);
            __builtin_amdgcn_fence(__ATOMIC_ACQUIRE, "agent");
            xb_add(&bar[XB_XGEN(b.x)], 1u);
            asm volatile("s_waitcnt vmcnt(0)" ::: "memory");
        } else {
            XB_SPIN(xb_ld(&bar[XB_XGEN(b.x)]) == gen, bar);
            __builtin_amdgcn_fence(__ATOMIC_ACQUIRE, "agent");
            asm volatile("s_waitcnt vmcnt(0)" ::: "memory");
        }
    }
    __syncthreads();
}

#endif
#ifdef NOINLINE_PHASES
#define NOINL __device__ __attribute__((noinline))
#else
#define NOINL __device__ __forceinline__
#endif
__shared__ __attribute__((aligned(16))) unsigned char g_smem[SMEM_BYTES + 16];
#define PH_COMMON const int G = gridDim.x, bid = blockIdx.x; unsigned char* smem = g_smem; (void)smem; (void)G; (void)bid; \
    const bf16_t* A = (const bf16_t*)(p.ws + WS_A); const bf16_t* Mx = (const bf16_t*)(p.ws + WS_M); const bf16_t* W = (const bf16_t*)(p.ws + WS_W); (void)A; (void)Mx; (void)W;
DEV void tables_in_gemm_tail(const Params& p, int tab0, int ntab, int nunits) {
    const int G = gridDim.x, bid = blockIdx.x, busy = nunits % G;
    if (busy == 0) { for (int it = bid; it < ntab * P0_TAB; it += G) p0_table(p, tab0 + it / P0_TAB, it % P0_TAB); return; }
    if (bid < busy) return;
    for (int it = bid - busy; it < ntab * P0_TAB; it += G - busy) p0_table(p, tab0 + it / P0_TAB, it % P0_TAB);
}
NOINL void ph0(const Params& p) { PH_COMMON phase0(p, smem); }
NOINL void ph1(const Params& p) { PH_COMMON phase1(p, smem); }
NOINL void ph2(const Params& p) { PH_COMMON EpiL0InT e{p.ws}; gemm_pg8_T(A, W + W_IN0 / 2, T, 2304, smem, e); tables_in_gemm_tail(p, 0, 1, (T / 256) * 9); }
NOINL void ph3(const Params& p, int var = 0) { PH_COMMON phase3(p, smem, var); }
NOINL void ph4(const Params& p) { PH_COMMON EpiRes e{&p, 1, 0, 2048}; gemm_pg8_N(Mx, W + W_OUT0 / 2, T, 1024, smem, e); tables_in_gemm_tail(p, 1, 2, (T / 256) * 4); }
NOINL void ph5(const Params& p) { PH_COMMON for (int it = bid; it < T / 8; it += G) norm_rows_item(p, it, 0, p.in[I_N2G], 0, 3072); }
NOINL void ph6(const Params& p, int var = 0) { PH_COMMON (void)var; EpiBf16 e{(bf16_t*)(p.ws + WS_P), 2048}; gemm_pg8_N(A, W + W_Q0 / 2, T, 2048, smem, e); tables_in_gemm_tail(p, 3, 1, (T / 256) * 8); }
#ifndef HOST_EMU
NOINL void ph7(const Params& p) { PH_COMMON tg_phase(p, 0, T, smem); }
#else
NOINL void ph7(const Params& p) { PH_COMMON topk_phase(p, 0, T, smem); }
#endif
NOINL void ph8(const Params& p) { PH_COMMON bf16x8 af[16]; for (int it = bid; it < T / 8; it += G) peer_item(p, 0, it, nullptr, af, -1, 0); }
NOINL void ph9(const Params& p, int var = 0) { PH_COMMON EpiHgT e{p.ws, p.in[I_HGLB], var}; gemm_pg8_T(A, W + W_IN1 / 2, T, 5120, smem, e); }
NOINL void ph10(const Params& p, int var = 0) { PH_COMMON for (int bi = bid; bi < NB * 32; bi += G) scan_block(p, bi, smem, var); }
NOINL void ph11(const Params& p) { PH_COMMON for (int it = bid; it < TL / 8; it += G) readout_item(p, it); }
NOINL void ph12(const Params& p) { PH_COMMON EpiRes e{&p, 0, 1, 2048}; gemm_pg8_N(Mx, W + W_OUT1 / 2, TL, 1024, smem, e); }
NOINL void ph13(const Params& p) { PH_COMMON for (int it = bid; it < TL / 8; it += G) norm_rows_item(p, it, 0, p.in[I_N2G] + 1024, 1, 3072); }
NOINL void ph14(const Params& p) { PH_COMMON EpiBf16 e{(bf16_t*)(p.ws + WS_P), 2048}; gemm_pg8_N(A, W + W_Q1 / 2, TL, 2048, smem, e); }
#ifndef HOST_EMU
NOINL void ph15(const Params& p) { PH_COMMON tg_phase(p, 1, TL, smem); }
#else
NOINL void ph15(const Params& p) { PH_COMMON topk_phase(p, 1, TL, smem); }
#endif
NOINL void ph16(const Params& p) { PH_COMMON bf16x8 af[16]; for (int it = bid; it < TL / 8; it += G) peer_item(p, 1, it, nullptr, af, -1, 0); }

constexpr int NPHASE = 17;
__global__ void __launch_bounds__(NT, 2) mega(Params p_in) {
    const int ph_lo = p_in.ph_lo, ph_hi = p_in.ph_hi;
#ifndef HOST_EMU
#define GBAR_MAKE() XcdBarrier gbar; gbar.bar = (unsigned*)(p_in.ws + WS_CTRL); gbar.x = xb_xcc_id(); gbar.st = (volatile LAS unsigned*)(LAS unsigned char*)(g_smem + SMEM_BYTES);
    if (ph_hi - ph_lo > 1) {
        volatile LAS unsigned* st = (volatile LAS unsigned*)(LAS unsigned char*)(g_smem + SMEM_BYTES);
        if (threadIdx.x == 0) { st[0] = 0u; st[1] = 0u; }
        __syncthreads();
        (void)xcd_barrier_post((unsigned*)(p_in.ws + WS_CTRL), st);
    }
#endif
#ifndef HOST_EMU
#define PH_BARRIER() do { GBAR_MAKE(); xcd_barrier(gbar); } while (0)
#define PH_PARAMS() unsigned long long kp = (unsigned long long)__builtin_amdgcn_kernarg_segment_ptr(); asm volatile("" : "+s"(kp) :: "memory"); \
        const Params& p = *(const Params*)(const __attribute__((address_space(4))) Params*)kp;
#else
#define PH_BARRIER() do {} while (0)
#define PH_PARAMS() const Params& p = p_in;
#endif
#ifdef REPEAT_MASK
#define PH_REPEAT(k, CALL) if ((REPEAT_MASK >> (k)) & 1) { PH_BARRIER(); { PH_PARAMS(); CALL; } }
#else
#define PH_REPEAT(k, CALL)
#endif
#ifdef ONLY_PHASE
#define PH_ON(k) ((k) == ONLY_PHASE)
#else
#define PH_ON(k) true
#endif
#if defined(REPEAT_MASK) && defined(HG_VAR)
#define RUN_PHASE9() if (ph_lo <= 9 && 9 < ph_hi) { if (9 > ph_lo) PH_BARRIER(); { PH_PARAMS(); ph9(p, HG_VAR); } PH_BARRIER(); { PH_PARAMS(); ph9(p, 0); } }
#else
#define RUN_PHASE9() RUN_PHASE(9, ph9(p))
#endif
#if defined(REPEAT_MASK) && defined(P3_VAR)
#define RUN_PHASE3() if (ph_lo <= 3 && 3 < ph_hi) { if (3 > ph_lo) PH_BARRIER(); { PH_PARAMS(); ph3(p, P3_VAR); } PH_BARRIER(); { PH_PARAMS(); ph3(p, 0); } }
#else
#define RUN_PHASE3() RUN_PHASE(3, ph3(p))
#endif
#ifdef HOST_EMU
#define RUN_PHASE_EMU(k, CALL) RUN_PHASE(k, CALL)
#else
#define RUN_PHASE_EMU(k, CALL)
#endif
#define RUN_PHASE(k, CALL) if (PH_ON(k) && ph_lo <= (k) && (k) < ph_hi) { if ((k) > ph_lo) PH_BARRIER(); { PH_PARAMS(); CALL; } PH_REPEAT(k, CALL) }
    RUN_PHASE(0, ph0(p))  RUN_PHASE(1, ph1(p))  RUN_PHASE(2, ph2(p))  RUN_PHASE3()  RUN_PHASE(4, ph4(p))  RUN_PHASE(5, ph5(p))
    RUN_PHASE(6, ph6(p))  RUN_PHASE(7, ph7(p))  RUN_PHASE_EMU(8, ph8(p))  RUN_PHASE9()  RUN_PHASE(10, ph10(p)) RUN_PHASE(11, ph11(p))
    RUN_PHASE(12, ph12(p)) RUN_PHASE(13, ph13(p)) RUN_PHASE(14, ph14(p)) RUN_PHASE(15, ph15(p)) RUN_PHASE_EMU(16, ph16(p))
}

#ifndef HOST_EMU
extern "C" void kernel_launch(void* const* d_in, const int* in_sizes, int n_in, void* d_out, int out_size, void* d_ws, size_t ws_size, hipStream_t stream) {
    if (n_in != 29 || ws_size < WS_END || out_size != TL * 1024) { fprintf(stderr, "kernel_launch: unexpected sizes (n_in %d, ws %zu need %zu, out %d)\n", n_in, ws_size, (size_t)WS_END, out_size); return; }
    static int grid = 0;
    if (!grid) { int dev = 0, cus = 0; hipGetDevice(&dev); hipDeviceGetAttribute(&cus, hipDeviceAttributeMultiprocessorCount, dev); grid = cus >= 8 ? (cus & ~7) : 256; }
    hipMemsetAsync((unsigned char*)d_ws + WS_CTRL, 0, CTRL_BYTES, stream);
    Params p{};
    for (int i = 0; i < 29; ++i) p.in[i] = (const float*)d_in[i];
    p.out = (float*)d_out; p.ws = (unsigned char*)d_ws;
#ifdef MULTI_LAUNCH
    for (int ph = 0; ph < NPHASE; ++ph) { p.ph_lo = ph; p.ph_hi = ph + 1; hipLaunchKernelGGL(mega, dim3(grid), dim3(NT), 0, stream, p); }
#else
    p.ph_lo = 0; p.ph_hi = NPHASE;
    hipLaunchKernelGGL(mega, dim3(grid), dim3(NT), 0, stream, p);
#endif
}
#endif
```

```cpp
#ifndef HOST_EMU
#include <hip/hip_runtime.h>
#include <cstdio>
#endif

#ifndef CFG_B
#define CFG_B 8
#define CFG_L 2048
#define CFG_LC 256
#endif
#define DEV __device__ __forceinline__
#ifndef HOST_EMU
#define SCHED_FENCE() __builtin_amdgcn_sched_barrier(0)
#endif
#ifdef HOST_EMU
#define SCHED_FENCE() do {} while (0)
#define __expf expf
#define __logf logf
#define __log2f log2f
#define __exp2f exp2f
#define __sinf sinf
#define __cosf cosf
#endif

typedef unsigned short bf16_t;
typedef short bf16x8 __attribute__((ext_vector_type(8)));
typedef float f32x16 __attribute__((ext_vector_type(16)));
typedef float f32x4 __attribute__((ext_vector_type(4)));
typedef unsigned u32x4 __attribute__((ext_vector_type(4)));
typedef unsigned u32x2 __attribute__((ext_vector_type(2)));
struct cf2 { float x, y; };

constexpr int NB = CFG_B, L = CFG_L, LC = CFG_LC, D = 1024;
constexpr int TL = NB * L, TC = NB * LC, T = TL + TC;
constexpr int NT = 512;
constexpr int NR = NB + 1;
constexpr int log4ceil(int n) { int s = 0, v = 1; while (v < n) { v *= 4; ++s; } return s; }
constexpr int FS_LAT = log4ceil(2 * L - 1), FS_CTX = log4ceil(2 * LC - 1);
constexpr int NF_LAT = 1 << (2 * FS_LAT), NF_CTX = 1 << (2 * FS_CTX);
static_assert(T % 256 == 0 && TL % 256 == 0 && L % 128 == 0 && LC % 128 == 0 && NB % 2 == 0, "shape");

constexpr size_t al256(size_t x) { return (x + 255) & ~(size_t)255; }
constexpr size_t WS_CTRL = 0, CTRL_BYTES = 65536;
constexpr size_t CTRL_HYNORM = 4096;
constexpr size_t CTRL_TG = 16384;
constexpr size_t WS_MOD = WS_CTRL + CTRL_BYTES;
constexpr size_t WS_H = al256(WS_MOD + (size_t)2 * NR * 6144 * 4);
constexpr size_t WS_A = al256(WS_H + (size_t)T * 1024 * 4);
constexpr size_t WS_P = al256(WS_A + (size_t)T * 1024 * 2);
constexpr size_t P_BYTES = (size_t)T * 5120 * 2;
constexpr size_t P_HYT_LAT = 0;
constexpr size_t P_HYT_CTX = P_HYT_LAT + (size_t)NB * 1536 * L * 2;
constexpr size_t P_Q0 = P_HYT_CTX + (size_t)NB * 1536 * LC * 2;
constexpr size_t P_K0 = P_Q0 + (size_t)T * 512 * 2;
constexpr size_t P_VT_LAT = P_K0 + (size_t)T * 128 * 2;
constexpr size_t P_VT_CTX = P_VT_LAT + (size_t)NB * 128 * L * 2;
static_assert(P_VT_CTX + (size_t)NB * 128 * LC * 2 <= P_BYTES, "P region");
constexpr size_t P1_KQT_LAT = 0;
constexpr size_t P1_KQT_CTX = P1_KQT_LAT + (size_t)NB * 3072 * L * 2;
constexpr size_t P1_G = P1_KQT_CTX + (size_t)NB * 3072 * LC * 2;
static_assert(P1_G + (size_t)TL * 1024 * 2 <= P_BYTES, "P region (layer 1)");
constexpr size_t WS_M = al256(WS_P + P_BYTES);
constexpr size_t WS_IDX = al256(WS_M + (size_t)T * 1024 * 2);
constexpr size_t WS_GATE = al256(WS_IDX + (size_t)T * 128 * 4);
constexpr size_t WS_UV = al256(WS_GATE + (size_t)T * 128 * 4);
constexpr size_t WS_S8 = WS_UV + (size_t)2 * 16384 * 1024;
constexpr size_t WS_W = al256(WS_S8 + (size_t)4 * 16384 * 4);
constexpr size_t W_IN0 = 0, W_OUT0 = W_IN0 + (size_t)2304 * 1024 * 2, W_IN1 = W_OUT0 + (size_t)1024 * 1024 * 2,
                 W_OUT1 = W_IN1 + (size_t)5120 * 1024 * 2, W_Q0 = W_OUT1 + (size_t)1024 * 1024 * 2, W_Q1 = W_Q0 + (size_t)2048 * 1024 * 2,
                 W_KEYS = W_Q1 + (size_t)2048 * 1024 * 2, W_BYTES = W_KEYS + (size_t)2 * 8 * 2 * 128 * 128 * 2;
constexpr size_t WS_F = al256(WS_W + W_BYTES);
constexpr size_t F_HRAW_LAT = 0;
constexpr size_t F_HRAW_CTX = F_HRAW_LAT + (size_t)2048 * L * 4;
constexpr size_t F_HF_LAT = F_HRAW_CTX + (size_t)2048 * LC * 4;
constexpr size_t F_HF_CTX = F_HF_LAT + (size_t)1024 * NF_LAT * 8;
constexpr size_t F_HYP_LAT = F_HF_CTX + (size_t)1024 * NF_CTX * 8;
constexpr size_t F_HYP_CTX = F_HYP_LAT + (size_t)(L / 64) * 2048 * 4;
constexpr size_t F_END = F_HYP_CTX + (size_t)(LC / 64) * 2048 * 4;
constexpr size_t F_OF = 0, F_OB = (size_t)TL * 1024 * 2;
constexpr size_t F_BYTES = F_END > 2 * F_OB ? F_END : 2 * F_OB;
constexpr size_t WS_END = al256(WS_F + F_BYTES);

struct Params { const float* in[29]; float* out; unsigned char* ws; int ph_lo, ph_hi; };
enum { I_X = 0, I_C, I_CTX, I_CCTX, I_ADAW, I_ADAB, I_N1G, I_N2G, I_FG, I_ABWIN, I_ABWOUT, I_HYCW, I_HYCB, I_HYW1, I_HYB1, I_HYW2, I_HYB2, I_HYW3,
       I_HYFREQ, I_HYSKIP, I_SINK, I_HGWIN, I_HGWOUT, I_HGLB, I_HGON, I_PWQ, I_PKEYS, I_PU, I_PV };

constexpr int SMEM_BYTES = 147456;

#ifndef HOST_EMU
DEV int tidx() { int t = threadIdx.x; asm volatile("" : "+v"(t)); return t; }
#else
DEV int tidx() { return (int)threadIdx.x; }
#endif
#ifndef HOST_EMU
DEV void lds_barrier() { asm volatile("s_waitcnt lgkmcnt(0)" ::: "memory"); __builtin_amdgcn_s_barrier(); asm volatile("" ::: "memory"); }
#else
DEV void lds_barrier() { __syncthreads(); }
#endif
#ifndef HOST_EMU
typedef __bf16 bf16n2 __attribute__((ext_vector_type(2)));
DEV unsigned pk2(float lo, float hi) { bf16n2 v; v[0] = (__bf16)lo; v[1] = (__bf16)hi; return __builtin_bit_cast(unsigned, v); }
DEV unsigned f2bf(float f) { return (unsigned)__builtin_bit_cast(unsigned short, (__bf16)f); }
#else
DEV unsigned f2bf(float f) { unsigned u = __builtin_bit_cast(unsigned, f); return (u + 0x7fffu + ((u >> 16) & 1u)) >> 16; }
DEV unsigned pk2(float lo, float hi) { return f2bf(lo) | (f2bf(hi) << 16); }
#endif
DEV float bf2f(unsigned h) { return __builtin_bit_cast(float, (h & 0xffffu) << 16); }
DEV float bflo(unsigned u) { return __builtin_bit_cast(float, u << 16); }
DEV float bfhi(unsigned u) { return __builtin_bit_cast(float, u & 0xffff0000u); }
DEV float silu_f(float x) { return x * __builtin_amdgcn_rcpf(1.f + __expf(-x)); }
DEV float sigmoid_f(float x) { return __builtin_amdgcn_rcpf(1.f + __expf(-x)); }
DEV float wave_sum(float v) {
#pragma unroll
    for (int m = 32; m >= 1; m >>= 1) v += __shfl_xor(v, m);
    return v;
}
DEV int mod_row(int tok) { return tok < TL ? tok / L : NB; }

DEV void p0_mod(const Params& p, int item, unsigned char* smem) {
    const int l = item / 96, col0 = (item % 96) * 64, tid = tidx();
    float* sc = (float*)smem;
    float* red = sc + NR * 1024;
    for (int i = tid; i < NR * 1024; i += NT) { const int r = i >> 10, k = i & 1023; const float c = r < NB ? p.in[I_C][r * 1024 + k] : p.in[I_CCTX][k]; sc[i] = c / (1.f + expf(-c)); }
    __syncthreads();
    const int kq = tid >> 6, col = tid & 63;
    float acc[NR];
#pragma unroll
    for (int r = 0; r < NR; ++r) acc[r] = 0.f;
    const float* w = p.in[I_ADAW] + (size_t)l * 1024 * 6144 + col0 + col;
#pragma unroll 16
    for (int k = kq * 128; k < kq * 128 + 128; ++k) {
        const float wv = w[(size_t)k * 6144];
#pragma unroll
        for (int r = 0; r < NR; ++r) acc[r] += sc[r * 1024 + k] * wv;
    }
#pragma unroll
    for (int r = 0; r < NR; ++r) red[(kq * NR + r) * 64 + col] = acc[r];
    __syncthreads();
    float* mod = (float*)(p.ws + WS_MOD);
    for (int i = tid; i < NR * 64; i += NT) {
        const int r = i >> 6, c = i & 63; float s = 0.f;
        for (int q = 0; q < 8; ++q) s += red[(q * NR + r) * 64 + c];
        mod[((size_t)l * NR + r) * 6144 + col0 + c] = s + p.in[I_ADAB][l * 6144 + col0 + c];
    }
    __syncthreads();
}
DEV void p0_transpose(const float* W, bf16_t* Wt, int N, int tile, unsigned char* smem) {
    float* ts = (float*)smem;
    const int ntn = N / 256, kt = tile / ntn, nt = tile % ntn, k0 = kt * 64, n0 = nt * 256, tid = tidx();
    f32x4 rv[8];
#pragma unroll
    for (int m = 0; m < 8; ++m) { const int i = tid + NT * m, kk = i >> 6, c4 = i & 63; rv[m] = *(const f32x4*)(W + (size_t)(k0 + kk) * N + n0 + c4 * 4); }
#pragma unroll
    for (int m = 0; m < 8; ++m) { const int i = tid + NT * m, kk = i >> 6, c4 = i & 63; *(f32x4*)(ts + kk * 260 + c4 * 4) = rv[m]; }
    __syncthreads();
#pragma unroll
    for (int m = 0; m < 4; ++m) { const int i = tid + NT * m, nn = i >> 3, k8 = i & 7;
        u32x4 o;
#pragma unroll
        for (int e = 0; e < 4; ++e) o[e] = pk2(ts[(k8 * 8 + 2 * e) * 260 + nn], ts[(k8 * 8 + 2 * e + 1) * 260 + nn]);
        *(u32x4*)(Wt + (size_t)(n0 + nn) * 1024 + k0 + k8 * 8) = o; }
    __syncthreads();
}
DEV void p0_convert(const float* src, bf16_t* dst, int item) {
    const int tid = tidx();
#pragma unroll
    for (int i = 0; i < 8; ++i) {
        const size_t e = (size_t)item * 16384 + (size_t)(i * NT + tid) * 4;
        const f32x4 v = *(const f32x4*)(src + e);
        u32x2 o; o[0] = pk2(v[0], v[1]); o[1] = pk2(v[2], v[3]);
        *(u32x2*)(dst + e) = o;
    }
}
typedef float f32x2 __attribute__((ext_vector_type(2)));
typedef float f32x32 __attribute__((ext_vector_type(32)));
typedef unsigned u32x6 __attribute__((ext_vector_type(6)));
DEV void p0_table(const Params& p, int tab, int item) {
    const int lane = tidx() & 63, li = lane & 31, half = lane >> 5, layer = tab >> 1, isv = tab & 1;
#pragma unroll 1
    for (int pass = 0; pass < 2; ++pass) {
        const int row = item * 32 + pass * 16 + (tidx() >> 6) * 2 + half;
        const float* src = (isv ? p.in[I_PV] : p.in[I_PU]) + ((size_t)layer * 16384 + row) * 1024 + li * 32;
        f32x4 v[8]; float mx = 0.f, sq = 0.f;
#pragma unroll
        for (int i = 0; i < 8; ++i) { v[i] = *(const f32x4*)(src + 4 * i); mx = fmaxf(mx, fmaxf(fmaxf(fabsf(v[i][0]), fabsf(v[i][1])), fmaxf(fabsf(v[i][2]), fabsf(v[i][3]))));
            sq += v[i][0] * v[i][0] + v[i][1] * v[i][1] + v[i][2] * v[i][2] + v[i][3] * v[i][3]; }
#pragma unroll
        for (int m = 16; m >= 1; m >>= 1) { mx = fmaxf(mx, __shfl_xor(mx, m)); sq += __shfl_xor(sq, m); }
        float rowscale;
        if (isv) {
            const float sc = mx > 0.f ? 6.f / mx : 1.f; rowscale = mx > 0.f ? mx * (1.f / 6.f) : 1.f;
            const f32x2 pr4 = __builtin_amdgcn_cvt_scalef32_pk_f32_fp4(__builtin_amdgcn_cvt_scalef32_pk_fp4_f32(0u, 1.0f, 0.0f, 1.0f, 0), 1.0f, 0);
            const bool swp = pr4[0] != 1.0f;
            u32x4 w;
#pragma unroll
            for (int d = 0; d < 4; ++d) { unsigned x = 0u;
                x = __builtin_amdgcn_cvt_scalef32_pk_fp4_f32(x, (swp ? v[2 * d][1] : v[2 * d][0]) * sc, (swp ? v[2 * d][0] : v[2 * d][1]) * sc, 1.0f, 0);
                x = __builtin_amdgcn_cvt_scalef32_pk_fp4_f32(x, (swp ? v[2 * d][3] : v[2 * d][2]) * sc, (swp ? v[2 * d][2] : v[2 * d][3]) * sc, 1.0f, 1);
                x = __builtin_amdgcn_cvt_scalef32_pk_fp4_f32(x, (swp ? v[2 * d + 1][1] : v[2 * d + 1][0]) * sc, (swp ? v[2 * d + 1][0] : v[2 * d + 1][1]) * sc, 1.0f, 2);
                x = __builtin_amdgcn_cvt_scalef32_pk_fp4_f32(x, (swp ? v[2 * d + 1][3] : v[2 * d + 1][2]) * sc, (swp ? v[2 * d + 1][2] : v[2 * d + 1][3]) * sc, 1.0f, 3);
                w[d] = x; }
            *(u32x4*)(p.ws + WS_UV + ((size_t)layer * 16384 + row) * 1024 + 512 + li * 16) = w;
        } else {
            float step = fminf(0.3352f * sqrtf(sq * (1.f / 1024.f)), mx * (1.0001f / 7.5f)); if (!(step > 0.f)) step = 1.f;
            const float inv = 1.f / step; rowscale = 0.5f * step;
            u32x4 w;
#pragma unroll
            for (int d = 0; d < 4; ++d) { unsigned x = 0u;
#pragma unroll
                for (int e = 0; e < 8; ++e) { const float f = fminf(fmaxf(floorf(v[2 * d + (e >> 2)][e & 3] * inv), -8.f), 7.f); x |= ((unsigned)(int)f & 15u) << (4 * e); }
                w[d] = x; }
            *(u32x4*)(p.ws + WS_UV + ((size_t)layer * 16384 + row) * 1024 + li * 16) = w;
        }
        if (li == 0) ((float*)(p.ws + WS_S8))[tab * 16384 + row] = rowscale;
    }
}
DEV void p0_filter(const Params& p, int set, int chunk, int cb, unsigned char* smem) {
    const int Ls = set ? LC : L, l0 = chunk * 64, tid = tidx();
    float* z = (float*)smem;
    float* hd1 = z + 64 * 34;
    float* hd2 = hd1 + 64 * 65;
    const float* w1 = p.in[I_HYW1]; const float* b1 = p.in[I_HYB1]; const float* w2 = p.in[I_HYW2]; const float* b2 = p.in[I_HYB2];
    const float* w3 = p.in[I_HYW3]; const float* fq = p.in[I_HYFREQ];
    for (int i = tid; i < 64 * 33; i += NT) {
        const int pp = i / 33, f = i % 33, l = l0 + pp; float val;
        if (f == 0) val = (float)l / (float)(Ls - 1);
        else { const int jb = (f - 1) & 15; const float fj = 1e-4f + (float)jb * ((15.f - 1e-4f) / 15.f); const float a = fj * (6.283185307179586f * (float)l / (float)Ls); val = f <= 16 ? __cosf(a) : -__sinf(a); }
        z[pp * 34 + f] = val;
    }
    __syncthreads();
    {
        const int j = tid & 63, p0 = tid >> 6;
        float wc[64], acc[8];
#pragma unroll
        for (int f = 0; f < 33; ++f) wc[f] = w1[f * 64 + j];
#pragma unroll
        for (int m = 0; m < 8; ++m) { float sacc = b1[j];
#pragma unroll
            for (int f = 0; f < 33; ++f) sacc = fmaf(z[(p0 + 8 * m) * 34 + f], wc[f], sacc);
            acc[m] = sacc; }
#pragma unroll
        for (int m = 0; m < 8; ++m) hd1[(p0 + 8 * m) * 65 + j] = __sinf(fq[j] * acc[m]);
        __syncthreads();
#pragma unroll
        for (int f = 0; f < 64; ++f) wc[f] = w2[f * 64 + j];
#pragma unroll
        for (int m = 0; m < 8; ++m) { float sacc = b2[j];
#pragma unroll
            for (int f = 0; f < 64; ++f) sacc = fmaf(hd1[(p0 + 8 * m) * 65 + f], wc[f], sacc);
            acc[m] = sacc; }
#pragma unroll
        for (int m = 0; m < 8; ++m) hd2[(p0 + 8 * m) * 65 + j] = __sinf(fq[j] * acc[m]);
        __syncthreads();
    }
    const float max_decay = -15.350567286626973f, min_decay = -3.0701134573253945f;
    float* hraw = (float*)(p.ws + WS_F + (set ? F_HRAW_CTX : F_HRAW_LAT));
    float* hyn = (float*)(p.ws + WS_F + (set ? F_HYP_CTX : F_HYP_LAT)) + (size_t)chunk * 2048;
    {
        const int o = cb * NT + tid;
        const int c = o & 511; const float delta = fabsf(min_decay + (float)c * ((max_decay - min_decay) / 511.f));
        float asum = 0.f;
        float* dst = hraw + (size_t)o * Ls + l0;
        for (int ph = 0; ph < 2; ++ph) {
            float acc[32];
#pragma unroll
            for (int pp = 0; pp < 32; ++pp) acc[pp] = 0.f;
#pragma unroll 1
            for (int j0 = 0; j0 < 64; j0 += 16) {
                float wv[16];
#pragma unroll
                for (int j = 0; j < 16; ++j) wv[j] = w3[(j0 + j) * 2048 + o];
#pragma unroll
                for (int j = 0; j < 16; ++j) {
#pragma unroll
                    for (int pp = 0; pp < 32; ++pp) acc[pp] = fmaf(hd2[(ph * 32 + pp) * 65 + j0 + j], wv[j], acc[pp]);
                    SCHED_FENCE();
                }
            }
#pragma unroll
            for (int q4 = 0; q4 < 8; ++q4) {
                f32x4 v;
#pragma unroll
                for (int e = 0; e < 4; ++e) { const int pp = q4 * 4 + e; const float tl = (float)(l0 + ph * 32 + pp) / (float)(Ls - 1); const float val = acc[pp] * expf(-tl * delta); v[e] = val; asum += fabsf(val); }
                *(f32x4*)(dst + ph * 32 + q4 * 4) = v;
            }
        }
        hyn[o] = asum;
    }
    __syncthreads();
}

constexpr int P0_MOD = 192, P0_TR_IN0 = 16 * 9, P0_TR_OUT0 = 64, P0_TR_IN1 = 16 * 20, P0_TR_OUT1 = 64, P0_TR_Q = 16 * 8, P0_KEYS = 32, P0_TAB = 512,
              P0_FILT = 4 * (L / 64 + LC / 64);
DEV void phase0(const Params& p, unsigned char* smem) {
    bf16_t* W = (bf16_t*)(p.ws + WS_W);
    const int total = P0_MOD + P0_FILT + P0_TR_IN0 + P0_TR_OUT0 + P0_TR_IN1 + P0_TR_OUT1 + 2 * P0_TR_Q + P0_KEYS;
    for (int it = blockIdx.x; it < total; it += gridDim.x) {
        int i = it;
        if (i < P0_MOD) { p0_mod(p, i, smem); continue; } i -= P0_MOD;
        if (i < P0_FILT) { const int ch = i >> 2, cb = i & 3; if (ch < L / 64) p0_filter(p, 0, ch, cb, smem); else p0_filter(p, 1, ch - L / 64, cb, smem); continue; } i -= P0_FILT;
        if (i < P0_TR_IN0) { p0_transpose(p.in[I_ABWIN], W + W_IN0 / 2, 2304, i, smem); continue; } i -= P0_TR_IN0;
        if (i < P0_TR_OUT0) { p0_transpose(p.in[I_ABWOUT], W + W_OUT0 / 2, 1024, i, smem); continue; } i -= P0_TR_OUT0;
        if (i < P0_TR_IN1) { p0_transpose(p.in[I_HGWIN], W + W_IN1 / 2, 5120, i, smem); continue; } i -= P0_TR_IN1;
        if (i < P0_TR_OUT1) { p0_transpose(p.in[I_HGWOUT], W + W_OUT1 / 2, 1024, i, smem); continue; } i -= P0_TR_OUT1;
        if (i < P0_TR_Q) { p0_transpose(p.in[I_PWQ], W + W_Q0 / 2, 2048, i, smem); continue; } i -= P0_TR_Q;
        if (i < P0_TR_Q) { p0_transpose(p.in[I_PWQ] + (size_t)1024 * 2048, W + W_Q1 / 2, 2048, i, smem); continue; } i -= P0_TR_Q;
        p0_convert(p.in[I_PKEYS], W + W_KEYS / 2, i);
    }
}

DEV const float* h_row(const Params& p, int layer_src_inputs, int tok) {
    if (layer_src_inputs) return tok < TL ? p.in[I_X] + (size_t)tok * 1024 : p.in[I_CTX] + (size_t)(tok - TL) * 1024;
    return (const float*)(p.ws + WS_H) + (size_t)tok * 1024;
}
DEV void norm_row_store(const Params& p, const f32x4 (&v)[4], int tok, const float* g, int layer, int sh_off, int lane) {
    float ss = 0.f;
#pragma unroll
    for (int i = 0; i < 4; ++i) ss += v[i][0] * v[i][0] + v[i][1] * v[i][1] + v[i][2] * v[i][2] + v[i][3] * v[i][3];
    ss = wave_sum(ss);
    const float rstd = rsqrtf(ss * (1.f / 1024.f) + 1e-6f);
    const float* mod = (const float*)(p.ws + WS_MOD) + ((size_t)layer * NR + mod_row(tok)) * 6144 + sh_off;
    bf16_t* A = (bf16_t*)(p.ws + WS_A) + (size_t)tok * 1024;
#pragma unroll
    for (int i = 0; i < 4; ++i) {
        const int c = i * 256 + lane * 4;
        const f32x4 gg = *(const f32x4*)(g + c), sh = *(const f32x4*)(mod + c), sc = *(const f32x4*)(mod + 1024 + c);
        u32x2 o;
        o[0] = pk2(v[i][0] * rstd * gg[0] * (1.f + sc[0]) + sh[0], v[i][1] * rstd * gg[1] * (1.f + sc[1]) + sh[1]);
        o[1] = pk2(v[i][2] * rstd * gg[2] * (1.f + sc[2]) + sh[2], v[i][3] * rstd * gg[3] * (1.f + sc[3]) + sh[3]);
        *(u32x2*)(A + c) = o;
    }
}
DEV void norm_rows_item(const Params& p, int item, int from_inputs, const float* g, int layer, int sh_off) {
    const int tok = item * 8 + (tidx() >> 6), lane = tidx() & 63;
    const float* src = h_row(p, from_inputs, tok);
    f32x4 v[4];
#pragma unroll
    for (int i = 0; i < 4; ++i) v[i] = *(const f32x4*)(src + i * 256 + lane * 4);
    norm_row_store(p, v, tok, g, layer, sh_off, lane);
}

DEV cf2 cmul(cf2 a, cf2 b) { cf2 r; r.x = a.x * b.x - a.y * b.y; r.y = a.x * b.y + a.y * b.x; return r; }
DEV cf2 twid(int k, float invN) { cf2 r; const float a = (float)k * invN; r.x = __builtin_amdgcn_cosf(a); r.y = -__builtin_amdgcn_sinf(a); return r; }
DEV int fsw(int i) { return i ^ ((i >> 4) & 15) ^ (((i >> 8) & 1) << 4); }
DEV void bfly4_fwd(cf2& a0, cf2& a1, cf2& a2, cf2& a3) {
    cf2 t0, t1, t2, t3; t0.x = a0.x + a2.x; t0.y = a0.y + a2.y; t1.x = a0.x - a2.x; t1.y = a0.y - a2.y; t2.x = a1.x + a3.x; t2.y = a1.y + a3.y;
    const float dx = a1.x - a3.x, dy = a1.y - a3.y; t3.x = dy; t3.y = -dx;
    a0.x = t0.x + t2.x; a0.y = t0.y + t2.y; a1.x = t1.x + t3.x; a1.y = t1.y + t3.y; a2.x = t0.x - t2.x; a2.y = t0.y - t2.y; a3.x = t1.x - t3.x; a3.y = t1.y - t3.y;
}
DEV void bfly4_inv(cf2& c0, cf2& c1, cf2& c2, cf2& c3) {
    cf2 t0, t1, t2, t3; t0.x = c0.x + c2.x; t0.y = c0.y + c2.y; t1.x = c0.x - c2.x; t1.y = c0.y - c2.y; t2.x = c1.x + c3.x; t2.y = c1.y + c3.y;
    const float dx = c1.x - c3.x, dy = c1.y - c3.y; t3.x = -dy; t3.y = dx;
    c0.x = t0.x + t2.x; c0.y = t0.y + t2.y; c1.x = t1.x + t3.x; c1.y = t1.y + t3.y; c2.x = t0.x - t2.x; c2.y = t0.y - t2.y; c3.x = t1.x - t3.x; c3.y = t1.y - t3.y;
}
DEV void fft_stage4(cf2* buf, int S, int s, int g, int G, bool inv) {
    const int N = 1 << (2 * S); const float invN = 1.f / (float)N;
    const int lm = 2 * (S - s), m = 1 << lm, q = m >> 2;
    for (int bf = g; bf < (N >> 2); bf += G) {
        const int j = bf & (q - 1), base = ((bf >> (lm - 2)) << lm) + j, tw = j << (2 * s);
        cf2 a0 = buf[fsw(base)], a1 = buf[fsw(base + q)], a2 = buf[fsw(base + 2 * q)], a3 = buf[fsw(base + 3 * q)];
        if (!inv) { bfly4_fwd(a0, a1, a2, a3); a1 = cmul(a1, twid(tw, invN)); a2 = cmul(a2, twid(2 * tw, invN)); a3 = cmul(a3, twid(3 * tw, invN)); }
        else { cf2 w1 = twid(tw, invN), w2 = twid(2 * tw, invN), w3 = twid(3 * tw, invN); w1.y = -w1.y; w2.y = -w2.y; w3.y = -w3.y; a1 = cmul(a1, w1); a2 = cmul(a2, w2); a3 = cmul(a3, w3); bfly4_inv(a0, a1, a2, a3); }
        buf[fsw(base)] = a0; buf[fsw(base + q)] = a1; buf[fsw(base + 2 * q)] = a2; buf[fsw(base + 3 * q)] = a3;
    }
}
DEV void fft_stage16(cf2* buf, int S, int s, int g, int G, bool inv) {
    const int N = 1 << (2 * S); const float invN = 1.f / (float)N;
    const int lm = 2 * (S - s), m = 1 << lm, q = m >> 2, q2 = q >> 2;
    for (int u = g; u < (N >> 4); u += G) {
        const int j2 = u & (q2 - 1), base = ((u >> (lm - 4)) << lm) + j2;
        cf2 x[4][4];
#pragma unroll
        for (int c = 0; c < 4; ++c)
#pragma unroll
            for (int c2 = 0; c2 < 4; ++c2) x[c][c2] = buf[fsw(base + c * q + c2 * q2)];
        if (!inv) {
#pragma unroll
            for (int c2 = 0; c2 < 4; ++c2) {
                const int tw = (j2 + c2 * q2) << (2 * s);
                bfly4_fwd(x[0][c2], x[1][c2], x[2][c2], x[3][c2]);
                x[1][c2] = cmul(x[1][c2], twid(tw, invN)); x[2][c2] = cmul(x[2][c2], twid(2 * tw, invN)); x[3][c2] = cmul(x[3][c2], twid(3 * tw, invN));
                SCHED_FENCE();
            }
            const int tw2 = j2 << (2 * (s + 1));
            const cf2 v1 = twid(tw2, invN), v2 = twid(2 * tw2, invN), v3 = twid(3 * tw2, invN);
#pragma unroll
            for (int c = 0; c < 4; ++c) {
                bfly4_fwd(x[c][0], x[c][1], x[c][2], x[c][3]);
                x[c][1] = cmul(x[c][1], v1); x[c][2] = cmul(x[c][2], v2); x[c][3] = cmul(x[c][3], v3);
            }
        } else {
            const int tw2 = j2 << (2 * (s + 1));
            cf2 v1 = twid(tw2, invN), v2 = twid(2 * tw2, invN), v3 = twid(3 * tw2, invN); v1.y = -v1.y; v2.y = -v2.y; v3.y = -v3.y;
#pragma unroll
            for (int c = 0; c < 4; ++c) {
                x[c][1] = cmul(x[c][1], v1); x[c][2] = cmul(x[c][2], v2); x[c][3] = cmul(x[c][3], v3);
                bfly4_inv(x[c][0], x[c][1], x[c][2], x[c][3]);
            }
#pragma unroll
            for (int c2 = 0; c2 < 4; ++c2) {
                const int tw = (j2 + c2 * q2) << (2 * s);
                cf2 w1 = twid(tw, invN), w2 = twid(2 * tw, invN), w3 = twid(3 * tw, invN); w1.y = -w1.y; w2.y = -w2.y; w3.y = -w3.y;
                x[1][c2] = cmul(x[1][c2], w1); x[2][c2] = cmul(x[2][c2], w2); x[3][c2] = cmul(x[3][c2], w3);
                bfly4_inv(x[0][c2], x[1][c2], x[2][c2], x[3][c2]);
                SCHED_FENCE();
            }
        }
#pragma unroll
        for (int c = 0; c < 4; ++c)
#pragma unroll
            for (int c2 = 0; c2 < 4; ++c2) buf[fsw(base + c * q + c2 * q2)] = x[c][c2];
    }
}
DEV void fft_fwd(cf2* buf, int S, int g, int G) {
    int s = 0;
    for (; s + 1 < S; s += 2) { fft_stage16(buf, S, s, g, G, false); __syncthreads(); }
    if (s < S) { fft_stage4(buf, S, s, g, G, false); __syncthreads(); }
}
DEV void fft_inv(cf2* buf, int S, int g, int G) {
    int s = S - 1;
    if (S & 1) { fft_stage4(buf, S, s, g, G, true); __syncthreads(); --s; }
    for (; s >= 1; s -= 2) { fft_stage16(buf, S, s - 1, g, G, true); __syncthreads(); }
}
DEV void hf_item(const Params& p, int set, int pi, unsigned char* smem) {
    const int Ls = set ? LC : L, S = set ? FS_CTX : FS_LAT, N = 1 << (2 * S);
    const int gi = tidx() >> 8, g = tidx() & 255, idx = pi * 2 + gi, o = idx >> 9, c = idx & 511;
    cf2* buf = (cf2*)smem + (size_t)gi * N;
    const float* hraw = (const float*)(p.ws + WS_F + (set ? F_HRAW_CTX : F_HRAW_LAT));
    const float* hyn = (const float*)(p.ws + WS_F + (set ? F_HYP_CTX : F_HYP_LAT));
    float nsum = 0.f;
    for (int ch = 0; ch < Ls / 64; ++ch) nsum += hyn[(size_t)ch * 2048 + o * 1024 + c] + hyn[(size_t)ch * 2048 + o * 1024 + 512 + c];
    const float inv = 1.f / nsum;
    const float* hf = hraw + (size_t)(o * 1024 + c) * Ls; const float* hb = hraw + (size_t)(o * 1024 + 512 + c) * Ls;
#pragma unroll 4
    for (int k = g; k < N; k += 256) { float re = 0.f; if (k < Ls) re = hf[k] * inv; else if (k > N - Ls) re = hb[N - k] * inv; cf2 v; v.x = re; v.y = 0.f; buf[fsw(k)] = v; }
    __syncthreads();
    fft_fwd(buf, S, g, 256);
    cf2* HF = (cf2*)(p.ws + WS_F + (set ? F_HF_CTX : F_HF_LAT)) + (size_t)(o * 512 + c) * N;
    for (int k = g; k < N; k += 256) HF[k] = buf[fsw(k)];
    __syncthreads();
}
constexpr int P1_NORM = T / 8, P1_HF = 512;
DEV void phase1(const Params& p, unsigned char* smem) {
    const int total = P1_NORM + 2 * P1_HF;
    for (int it = blockIdx.x; it < total; it += gridDim.x) {
        if (it < P1_NORM) norm_rows_item(p, it, 1, p.in[I_N1G], 0, 0);
        else if (it < P1_NORM + P1_HF) hf_item(p, 0, it - P1_NORM, smem);
        else hf_item(p, 1, it - P1_NORM - P1_HF, smem);
    }
}

constexpr int G_LDA = 72;
template <class Epi>
DEV void gemm_tile(const bf16_t* __restrict__ A, const bf16_t* __restrict__ Wt, int m0, int n0, unsigned char* smem, const Epi& epi, int var = 0) {
    bf16_t* As = (bf16_t*)smem;
    bf16_t* Bs = As + 2 * 256 * G_LDA;
    const int tid = tidx(), lane = tid & 63, w = tid >> 6, wm = w >> 1, wn = w & 1;
    f32x16 acc[2][2];
#pragma unroll
    for (int i = 0; i < 2; ++i)
#pragma unroll
        for (int j = 0; j < 2; ++j)
#pragma unroll
            for (int r = 0; r < 16; ++r) acc[i][j][r] = 0.f;
    u32x4 ra[4], rb[2];
    const bf16_t* Ag = A + (size_t)m0 * 1024; const bf16_t* Bg = Wt + (size_t)n0 * 1024;
#define GLOAD(k0) do { \
        _Pragma("unroll") for (int i = 0; i < 4; ++i) { const int id = tid + NT * i, row = id >> 3, kc = id & 7; ra[i] = *(const u32x4*)(Ag + (size_t)row * 1024 + (k0) + kc * 8); } \
        _Pragma("unroll") for (int i = 0; i < 2; ++i) { const int id = tid + NT * i, row = id >> 3, kc = id & 7; rb[i] = *(const u32x4*)(Bg + (size_t)row * 1024 + (k0) + kc * 8); } } while (0)
#define LSTORE(buf_) do { \
        _Pragma("unroll") for (int i = 0; i < 4; ++i) { const int id = tid + NT * i, row = id >> 3, kc = id & 7; *(u32x4*)(As + ((buf_) * 256 + row) * G_LDA + kc * 8) = ra[i]; } \
        _Pragma("unroll") for (int i = 0; i < 2; ++i) { const int id = tid + NT * i, row = id >> 3, kc = id & 7; *(u32x4*)(Bs + ((buf_) * 128 + row) * G_LDA + kc * 8) = rb[i]; } } while (0)
    GLOAD(0); LSTORE(0); __syncthreads();
    for (int kt = 0; kt < (var == 2 ? 1 : 16); ++kt) {
        const int buf = kt & 1;
        if (kt + 1 < 16) GLOAD((kt + 1) * 64);
        const bf16_t* as = As + (buf * 256 + wm * 64 + (lane & 31)) * G_LDA + 8 * (lane >> 5);
        const bf16_t* bs = Bs + (buf * 128 + wn * 64 + (lane & 31)) * G_LDA + 8 * (lane >> 5);
#pragma unroll
        for (int kk = 0; kk < 4; ++kk) {
            const bf16x8 a0 = *(const bf16x8*)(as + kk * 16), a1 = *(const bf16x8*)(as + 32 * G_LDA + kk * 16);
            const bf16x8 b0 = *(const bf16x8*)(bs + kk * 16), b1 = *(const bf16x8*)(bs + 32 * G_LDA + kk * 16);
            acc[0][0] = __builtin_amdgcn_mfma_f32_32x32x16_bf16(a0, b0, acc[0][0], 0, 0, 0);
            acc[0][1] = __builtin_amdgcn_mfma_f32_32x32x16_bf16(a0, b1, acc[0][1], 0, 0, 0);
            acc[1][0] = __builtin_amdgcn_mfma_f32_32x32x16_bf16(a1, b0, acc[1][0], 0, 0, 0);
            acc[1][1] = __builtin_amdgcn_mfma_f32_32x32x16_bf16(a1, b1, acc[1][1], 0, 0, 0);
        }
        if (kt + 1 < 16) LSTORE(buf ^ 1);
        __syncthreads();
    }
#ifndef HOST_EMU
    if (var == 1) { asm volatile("" :: "v"(acc[0][0]), "v"(acc[0][1]), "v"(acc[1][0]), "v"(acc[1][1])); return; }
#endif
#pragma unroll
    for (int mi = 0; mi < 2; ++mi)
#pragma unroll
        for (int ni = 0; ni < 2; ++ni)
#pragma unroll
            for (int rg = 0; rg < 4; ++rg) {
                const int row = m0 + wm * 64 + mi * 32 + 8 * rg + 4 * (lane >> 5), col = n0 + wn * 64 + ni * 32 + (lane & 31);
                epi(row, col, acc[mi][ni][rg * 4 + 0], acc[mi][ni][rg * 4 + 1], acc[mi][ni][rg * 4 + 2], acc[mi][ni][rg * 4 + 3]);
            }
}
template <class Epi>
DEV void gemm_tile256(const bf16_t* __restrict__ A, const bf16_t* __restrict__ Wt, int m0, int n0, unsigned char* smem, const Epi& epi) {
    bf16_t* As = (bf16_t*)smem;
    bf16_t* Bs = As + 2 * 256 * G_LDA;
    const int tid = tidx(), lane = tid & 63, w = tid >> 6, wm = w >> 2, wn = w & 3;
    f32x16 acc[4][2];
#pragma unroll
    for (int i = 0; i < 4; ++i)
#pragma unroll
        for (int j = 0; j < 2; ++j)
#pragma unroll
            for (int r = 0; r < 16; ++r) acc[i][j][r] = 0.f;
    u32x4 ra[4], rb[4];
    const bf16_t* Ag = A + (size_t)m0 * 1024; const bf16_t* Bg = Wt + (size_t)n0 * 1024;
#define GLOAD2(k0) do { \
        _Pragma("unroll") for (int i = 0; i < 4; ++i) { const int id = tid + NT * i, row = id >> 3, kc = id & 7; ra[i] = *(const u32x4*)(Ag + (size_t)row * 1024 + (k0) + kc * 8); rb[i] = *(const u32x4*)(Bg + (size_t)row * 1024 + (k0) + kc * 8); } } while (0)
#define LSTORE2(buf_) do { \
        _Pragma("unroll") for (int i = 0; i < 4; ++i) { const int id = tid + NT * i, row = id >> 3, kc = id & 7; *(u32x4*)(As + ((buf_) * 256 + row) * G_LDA + kc * 8) = ra[i]; *(u32x4*)(Bs + ((buf_) * 256 + row) * G_LDA + kc * 8) = rb[i]; } } while (0)
    GLOAD2(0); LSTORE2(0); __syncthreads();
    for (int kt = 0; kt < 16; ++kt) {
        const int buf = kt & 1;
        if (kt + 1 < 16) GLOAD2((kt + 1) * 64);
        const bf16_t* as = As + (buf * 256 + wm * 128 + (lane & 31)) * G_LDA + 8 * (lane >> 5);
        const bf16_t* bs = Bs + (buf * 256 + wn * 64 + (lane & 31)) * G_LDA + 8 * (lane >> 5);
#pragma unroll
        for (int kk = 0; kk < 4; ++kk) {
            bf16x8 af[4], bfr[2];
#pragma unroll
            for (int i = 0; i < 4; ++i) af[i] = *(const bf16x8*)(as + i * 32 * G_LDA + kk * 16);
#pragma unroll
            for (int j = 0; j < 2; ++j) bfr[j] = *(const bf16x8*)(bs + j * 32 * G_LDA + kk * 16);
#pragma unroll
            for (int i = 0; i < 4; ++i)
#pragma unroll
                for (int j = 0; j < 2; ++j) acc[i][j] = __builtin_amdgcn_mfma_f32_32x32x16_bf16(af[i], bfr[j], acc[i][j], 0, 0, 0);
        }
        if (kt + 1 < 16) LSTORE2(buf ^ 1);
        __syncthreads();
    }
#undef GLOAD2
#undef LSTORE2
#pragma unroll
    for (int mi = 0; mi < 4; ++mi)
#pragma unroll
        for (int ni = 0; ni < 2; ++ni)
#pragma unroll
            for (int rg = 0; rg < 4; ++rg) {
                const int row = m0 + wm * 128 + mi * 32 + 8 * rg + 4 * (lane >> 5), col = n0 + wn * 64 + ni * 32 + (lane & 31);
                epi(row, col, acc[mi][ni][rg * 4 + 0], acc[mi][ni][rg * 4 + 1], acc[mi][ni][rg * 4 + 2], acc[mi][ni][rg * 4 + 3]);
            }
}
namespace pg8 {
#ifndef HOST_EMU
#define PG8_LAS __attribute__((address_space(3)))
#else
#define PG8_LAS
#endif
typedef unsigned short bf16_t;
constexpr int BM = 256, BK = 64, HALF = 128, HTB = HALF * BK * 2  , STAGE_BYTES = 8 * HTB, NXCD = 8, WGM = 8;

__host__ __device__ __forceinline__ int lds_byte(int r, int c) { const int st = (r >> 4) * 2 + (c >> 5), rr = r & 15, cc = c & 31, ob = rr * 64 + cc * 2; return st * 1024 + (ob ^ (((ob >> 9) & 1) << 5)); }
__host__ __device__ __forceinline__ void stage_rc(int b, int& R, int& C) { const int st = b / 1024, sb = b % 1024, swz = sb ^ (((sb >> 9) & 1) << 5); R = (st >> 1) * 16 + swz / 64; C = (st & 1) * 32 + (swz % 64) / 2; }
__host__ __device__ __forceinline__ int perm32(int rho) { const int n = rho >> 4, i = rho & 15; return 8 * (i >> 2) + 4 * n + (i & 3); }

struct Unit { int pm, pn; };
struct Gemm { const bf16_t* A; const bf16_t* Bt; int M, N, K; };

struct StaticOrder {
    int nM, nN, nwg, G, c;
    __host__ __device__ void init(int M, int N, int G_, int c_) { nM = M / BM; nN = N / BM; nwg = nM * nN; G = G_; c = c_; }
    __host__ __device__ bool next(int i, Unit& u) const {
        const long L = (long)i * G + c; if (L >= nwg) return false;
        int wgid = (int)L; { const int q = nwg / NXCD, r = nwg % NXCD, xcd = wgid % NXCD, off = wgid / NXCD; wgid = (xcd < r ? xcd * (q + 1) : r * (q + 1) + (xcd - r) * q) + off; }
        const int nig = WGM * nN, gid = wgid / nig, fm = gid * WGM, gsz = (nM - fm) < WGM ? (nM - fm) : WGM;
        u.pm = fm + ((wgid % nig) % gsz); u.pn = (wgid % nig) / gsz; return true;
    }
    __device__ __forceinline__ void a_ready(const Unit&) const {}
    __device__ __forceinline__ void done(const Unit&) const {}
};
template <class Epi, class Sched, bool STAMP = false>
__device__ __forceinline__ void gemm_phase(PG8_LAS unsigned char* lds, const Gemm g, const Sched& S, const Epi& E, unsigned long long* stamps = nullptr) {
    const int tid = tidx(), wid = __builtin_amdgcn_readfirstlane(tid >> 6), lane = tid & 63, wr = wid >> 2, wc = wid & 3, fr = lane & 15, fq = lane >> 4;
    const int K = g.K, nt = K / BK;
    int ts_lo = 0, ts_hi = 0, nts = 0; const unsigned long long rt_entry = 0ull; (void)rt_entry; (void)ts_lo; (void)ts_hi; (void)nts;
#define PG8_STAMP() do { if (STAMP && wid == 0 && nts < 64) { const unsigned long long _c = 0ull; \
        ts_lo = (lane == nts) ? (int)(unsigned)_c : ts_lo; ts_hi = (lane == nts) ? (int)(unsigned)(_c >> 32) : ts_hi; ++nts; } } while (0)
    PG8_STAMP();
    unsigned voffA[2], voffB[2];
#pragma unroll
    for (int i = 0; i < 2; ++i) { int R, C; stage_rc(tid * 16 + i * 8192, R, C); const int Rb = Epi::PERM ? ((R & ~31) + perm32(R & 31)) : R;
        voffA[i] = (unsigned)(R * K + C) * 2u; voffB[i] = (unsigned)(Rb * K + C) * 2u; }
    const size_t kstep = (size_t)(BK * 2);
    const size_t hstep = (size_t)HALF * K * 2;
    const size_t tstep = 2 * hstep;
    const unsigned ldsw = (unsigned)wid * 1024u;
    const int aoff = lds_byte(wr * 64 + fr, fq * 8), boff = lds_byte(wc * 32 + fr, fq * 8);
#define PG8_SA(b, h) (((b) * 2 + (h)) * HTB)
#define PG8_SB(b, h) ((4 + (b) * 2 + (h)) * HTB)
#define PG8_STAGE(bufoff, gbase, voff) do { _Pragma("unroll") for (int _i = 0; _i < 2; ++_i) \
        __builtin_amdgcn_global_load_lds((const unsigned*)((const char*)(gbase) + (voff)[_i]), (PG8_LAS unsigned*)(lds + (bufoff) + ldsw + _i * 8192), 16, 0, 0); } while (0)
#define PG8_LDA(dst, b, h) do { _Pragma("unroll") for (int m = 0; m < 4; ++m) _Pragma("unroll") for (int k = 0; k < 2; ++k) dst[m][k] = *(const PG8_LAS bf16x8*)(lds + PG8_SA(b, h) + aoff + m * 2048 + k * 1024); } while (0)
#define PG8_LDB(dst, b, h) do { _Pragma("unroll") for (int n = 0; n < 2; ++n) _Pragma("unroll") for (int k = 0; k < 2; ++k) dst[n][k] = *(const PG8_LAS bf16x8*)(lds + PG8_SB(b, h) + boff + n * 2048 + k * 1024); } while (0)
#define PG8_MMA(ai, bj, At, Bt) do { __builtin_amdgcn_s_setprio(1); _Pragma("unroll") for (int m = 0; m < 4; ++m) _Pragma("unroll") for (int n = 0; n < 2; ++n) _Pragma("unroll") for (int k = 0; k < 2; ++k) \
        acc[ai][bj][m][n] = __builtin_amdgcn_mfma_f32_16x16x32_bf16(Bt[n][k], At[m][k], acc[ai][bj][m][n], 0, 0, 0); __builtin_amdgcn_s_setprio(0); } while (0)
#ifndef HOST_EMU
#define PG8_WAIT_V(n) asm volatile("s_waitcnt vmcnt(" #n ")" ::: "memory")
#define PG8_WAIT_L(n) asm volatile("s_waitcnt lgkmcnt(" #n ")" ::: "memory")
#else
#define PG8_WAIT_V(n) do {} while (0)
#define PG8_WAIT_L(n) do {} while (0)
#endif
#define PG8_BAR __builtin_amdgcn_s_barrier()
#define PG8_SCHED __builtin_amdgcn_sched_barrier(0)
    Unit cur, nxt; int ui = 0;
    if (!S.next(0, cur)) return;
    f32x4 acc[2][2][4][2];
#pragma unroll
    for (int a = 0; a < 2; ++a)
#pragma unroll
        for (int b = 0; b < 2; ++b)
#pragma unroll
            for (int m = 0; m < 4; ++m)
#pragma unroll
                for (int n = 0; n < 2; ++n) acc[a][b][m][n] = (f32x4){0.f, 0.f, 0.f, 0.f};
    bf16x8 At[4][2], B0[2][2], B1[2][2];
    const char* cA = (const char*)g.A + (size_t)cur.pm * tstep; const char* cB = (const char*)g.Bt + (size_t)cur.pn * tstep;
    S.a_ready(cur);
    PG8_STAGE(PG8_SB(0, 0), cB, voffB); PG8_STAGE(PG8_SA(0, 0), cA, voffA); PG8_STAGE(PG8_SB(0, 1), cB + hstep, voffB); PG8_STAGE(PG8_SA(0, 1), cA + hstep, voffA);
    if (wr == 1) PG8_BAR;
    PG8_WAIT_V(4); PG8_BAR;
    PG8_STAGE(PG8_SB(1, 0), cB + kstep, voffB); PG8_STAGE(PG8_SA(1, 0), cA + kstep, voffA); PG8_STAGE(PG8_SB(1, 1), cB + hstep + kstep, voffB);
    PG8_WAIT_V(6); PG8_BAR;
    PG8_STAMP();
    for (;;) {
        const bool has_next = S.next(ui + 1, nxt);
        const char* nA = has_next ? (const char*)g.A + (size_t)nxt.pm * tstep : cA; const char* nB = has_next ? (const char*)g.Bt + (size_t)nxt.pn * tstep : cB;
        for (int t = 0; t < nt; t += 2) {
            const bool last = (t == nt - 2);
            const char* a1 = cA + (size_t)(t + 1) * kstep;
            const char* a2 = last ? nA : cA + (size_t)(t + 2) * kstep; const char* b2 = last ? nB : cB + (size_t)(t + 2) * kstep;
            const char* a3 = a2 + kstep; const char* b3 = b2 + kstep;
            if (last && has_next) S.a_ready(nxt);
            PG8_LDB(B0, 0, 0); PG8_SCHED; PG8_LDA(At, 0, 0); PG8_STAGE(PG8_SA(1, 1), a1 + hstep, voffA);
            PG8_WAIT_L(8); PG8_BAR; PG8_WAIT_L(0); PG8_MMA(0, 0, At, B0); PG8_BAR; PG8_SCHED;
            PG8_LDB(B1, 0, 1); PG8_STAGE(PG8_SB(0, 0), b2, voffB);
            PG8_BAR; PG8_WAIT_L(0); PG8_MMA(0, 1, At, B1); PG8_BAR;
            PG8_LDA(At, 0, 1); PG8_STAGE(PG8_SA(0, 0), a2, voffA);
            PG8_BAR; PG8_WAIT_L(0); PG8_MMA(1, 0, At, B0); PG8_BAR; PG8_SCHED;
            PG8_STAGE(PG8_SB(0, 1), b2 + hstep, voffB);
            PG8_WAIT_V(6); PG8_BAR; PG8_MMA(1, 1, At, B1); PG8_BAR;
            PG8_LDB(B0, 1, 0); PG8_SCHED; PG8_LDA(At, 1, 0); PG8_STAGE(PG8_SA(0, 1), a2 + hstep, voffA);
            PG8_WAIT_L(8); PG8_BAR; PG8_WAIT_L(0); PG8_MMA(0, 0, At, B0); PG8_BAR; PG8_SCHED;
            PG8_LDB(B1, 1, 1); PG8_STAGE(PG8_SB(1, 0), b3, voffB);
            PG8_BAR; PG8_WAIT_L(0); PG8_MMA(0, 1, At, B1); PG8_BAR;
            PG8_LDA(At, 1, 1); PG8_STAGE(PG8_SA(1, 0), a3, voffA);
            PG8_BAR; PG8_WAIT_L(0); PG8_MMA(1, 0, At, B0); PG8_BAR; PG8_SCHED;
            PG8_STAGE(PG8_SB(1, 1), b3 + hstep, voffB);
            PG8_WAIT_V(6); PG8_BAR; PG8_MMA(1, 1, At, B1); PG8_BAR;
        }
        PG8_STAMP();
        if constexpr (!Epi::AFTER_DRAIN) { E(acc, cur, wr, wc, fr, fq); S.done(cur); }
        PG8_STAMP();
        if (!has_next) break;
#pragma unroll
        for (int a = 0; a < 2; ++a)
#pragma unroll
            for (int b = 0; b < 2; ++b)
#pragma unroll
                for (int m = 0; m < 4; ++m)
#pragma unroll
                    for (int n = 0; n < 2; ++n) acc[a][b][m][n] = (f32x4){0.f, 0.f, 0.f, 0.f};
        cur = nxt; cA = nA; cB = nB; ++ui;
    }
    PG8_WAIT_V(0);
    if (wr == 0) PG8_BAR;
    PG8_BAR;
    if constexpr (Epi::AFTER_DRAIN) { E.fused(acc, cur, wr, wc, fr, fq, lds, wid, lane); S.done(cur); }
    PG8_STAMP();
    if (STAMP && wid == 0) { stamps[lane] = lane < nts ? (((unsigned long long)(unsigned)ts_hi << 32) | (unsigned)ts_lo) : 0ull;
        if (lane == 62) stamps[62] = rt_entry; if (lane == 63) stamps[63] = 0ull; }
#undef PG8_STAMP
#undef PG8_SA
#undef PG8_SB
#undef PG8_STAGE
#undef PG8_LDA
#undef PG8_LDB
#undef PG8_MMA
#undef PG8_WAIT_V
#undef PG8_WAIT_L
#undef PG8_BAR
#undef PG8_SCHED
}
}
template <class Epi> struct PgEpiT {
    static constexpr bool PERM = true, AFTER_DRAIN = false;
    Epi e;
    DEV void operator()(const f32x4 (&acc)[2][2][4][2], const pg8::Unit& u, int wr, int wc, int fr, int fq) const {
        float pre[2][4];
#pragma unroll
        for (int ai = 0; ai < 2; ++ai)
#pragma unroll
            for (int m = 0; m < 4; ++m) pre[ai][m] = e.colpre(u.pm * 256 + ai * 128 + wr * 64 + m * 16 + fr);
#pragma unroll
        for (int ai = 0; ai < 2; ++ai)
#pragma unroll
            for (int m = 0; m < 4; ++m) {
#pragma unroll
                for (int bj = 0; bj < 2; ++bj) {
                    const int wcol = u.pm * 256 + ai * 128 + wr * 64 + m * 16 + fr, tok0 = u.pn * 256 + bj * 128 + wc * 32 + 8 * fq;
                    const float v[8] = {acc[ai][bj][m][0][0], acc[ai][bj][m][0][1], acc[ai][bj][m][0][2], acc[ai][bj][m][0][3], acc[ai][bj][m][1][0], acc[ai][bj][m][1][1], acc[ai][bj][m][1][2], acc[ai][bj][m][1][3]};
                    e.tok8(tok0, wcol, v, pre[ai][m]);
                }
                SCHED_FENCE();
            }
    }
};
template <class Epi> struct PgEpiN {
    static constexpr bool PERM = true, AFTER_DRAIN = false;
    Epi e;
    DEV void operator()(const f32x4 (&acc)[2][2][4][2], const pg8::Unit& u, int wr, int wc, int fr, int fq) const {
#pragma unroll
        for (int ai = 0; ai < 2; ++ai)
#pragma unroll
            for (int m = 0; m < 4; ++m) {
#pragma unroll
                for (int bj = 0; bj < 2; ++bj) {
                    const int tok = u.pm * 256 + ai * 128 + wr * 64 + m * 16 + fr, wcol0 = u.pn * 256 + bj * 128 + wc * 32 + 8 * fq;
                    const float v[8] = {acc[ai][bj][m][0][0], acc[ai][bj][m][0][1], acc[ai][bj][m][0][2], acc[ai][bj][m][0][3], acc[ai][bj][m][1][0], acc[ai][bj][m][1][1], acc[ai][bj][m][1][2], acc[ai][bj][m][1][3]};
                    e.col8(tok, wcol0, v);
                }
                SCHED_FENCE();
            }
    }
};
template <class Epi>
DEV void gemm_pg8_T(const bf16_t* A, const bf16_t* Wt, int Mtok, int N, unsigned char* smem, const Epi& epi) {
    pg8::Gemm g{Wt, A, N, Mtok, 1024};
    pg8::StaticOrder S; S.init(N, Mtok, (int)gridDim.x, (int)blockIdx.x);
    PgEpiT<Epi> E{epi};
    pg8::gemm_phase<PgEpiT<Epi>, pg8::StaticOrder, false>((PG8_LAS unsigned char*)smem, g, S, E);
    __syncthreads();
}
template <class Epi>
DEV void gemm_pg8_N(const bf16_t* A, const bf16_t* Wt, int Mtok, int N, unsigned char* smem, const Epi& epi) {
    pg8::Gemm g{A, Wt, Mtok, N, 1024};
    pg8::StaticOrder S; S.init(Mtok, N, (int)gridDim.x, (int)blockIdx.x);
    PgEpiN<Epi> E{epi};
    pg8::gemm_phase<PgEpiN<Epi>, pg8::StaticOrder, false>((PG8_LAS unsigned char*)smem, g, S, E);
    __syncthreads();
}
struct EpiL0In {
    unsigned char* ws;
    DEV void operator()(int row, int col, float v0, float v1, float v2, float v3) const {
        u32x2 o; o[0] = pk2(v0, v1); o[1] = pk2(v2, v3);
        const bool lat = row < TL; const int b = lat ? row / L : (row - TL) / LC, t = lat ? row - b * L : (row - TL) - b * LC, Lx = lat ? L : LC;
        const int cu = __builtin_amdgcn_readfirstlane(col & ~127);
        if (cu < 1536) { bf16_t* d = (bf16_t*)(ws + WS_P + (lat ? P_HYT_LAT : P_HYT_CTX)) + ((size_t)b * 1536 + col) * Lx + t; *(u32x2*)d = o; }
        else if (cu < 2048) { bf16_t* d = (bf16_t*)(ws + WS_P + P_Q0) + (size_t)row * 512 + (col - 1536); d[0] = (bf16_t)f2bf(v0); d[512] = (bf16_t)f2bf(v1); d[1024] = (bf16_t)f2bf(v2); d[1536] = (bf16_t)f2bf(v3); }
        else if (cu < 2176) { bf16_t* d = (bf16_t*)(ws + WS_P + P_K0) + (size_t)row * 128 + (col - 2048); d[0] = (bf16_t)f2bf(v0); d[128] = (bf16_t)f2bf(v1); d[256] = (bf16_t)f2bf(v2); d[384] = (bf16_t)f2bf(v3); }
        else { bf16_t* d = (bf16_t*)(ws + WS_P + (lat ? P_VT_LAT : P_VT_CTX)) + ((size_t)b * 128 + (col - 2176)) * Lx + t; *(u32x2*)d = o; }
    }
};
struct EpiL0InT {
    unsigned char* ws;
    DEV float colpre(int) const { return 0.f; }
    DEV void tok8(int row, int col, const float (&v)[8], float) const {
        const bool lat = row < TL; const int b = lat ? row / L : (row - TL) / LC, t = lat ? row - b * L : (row - TL) - b * LC, Lx = lat ? L : LC;
        u32x4 o; o[0] = pk2(v[0], v[1]); o[1] = pk2(v[2], v[3]); o[2] = pk2(v[4], v[5]); o[3] = pk2(v[6], v[7]);
        if (col < 1536) { *(u32x4*)((bf16_t*)(ws + WS_P + (lat ? P_HYT_LAT : P_HYT_CTX)) + ((size_t)b * 1536 + col) * Lx + t) = o; }
        else if (col < 2048) { bf16_t* d = (bf16_t*)(ws + WS_P + P_Q0) + (size_t)row * 512 + (col - 1536);
#pragma unroll
            for (int i = 0; i < 8; ++i) d[i * 512] = (bf16_t)f2bf(v[i]); }
        else if (col < 2176) { bf16_t* d = (bf16_t*)(ws + WS_P + P_K0) + (size_t)row * 128 + (col - 2048);
#pragma unroll
            for (int i = 0; i < 8; ++i) d[i * 128] = (bf16_t)f2bf(v[i]); }
        else { *(u32x4*)((bf16_t*)(ws + WS_P + (lat ? P_VT_LAT : P_VT_CTX)) + ((size_t)b * 128 + (col - 2176)) * Lx + t) = o; }
    }
};
struct EpiBf16 {
    bf16_t* out; int ld;
    DEV void col8(int row, int col0, const float (&v)[8]) const { u32x4 o; o[0] = pk2(v[0], v[1]); o[1] = pk2(v[2], v[3]); o[2] = pk2(v[4], v[5]); o[3] = pk2(v[6], v[7]); *(u32x4*)(out + (size_t)row * ld + col0) = o; }
    DEV void operator()(int row, int col, float v0, float v1, float v2, float v3) const {
        bf16_t* d = out + (size_t)row * ld + col; d[0] = (bf16_t)f2bf(v0); d[ld] = (bf16_t)f2bf(v1); d[2 * ld] = (bf16_t)f2bf(v2); d[3 * ld] = (bf16_t)f2bf(v3);
    }
};
struct EpiHg {
    unsigned char* ws; const float* lg;
    DEV void operator()(int row, int col, float v0, float v1, float v2, float v3) const {
        float vv[4] = {v0, v1, v2, v3};
        const bool lat = row < TL; const int b = lat ? row / L : (row - TL) / LC, t = lat ? row - b * L : (row - TL) - b * LC, Lx = lat ? L : LC;
        const int cu = __builtin_amdgcn_readfirstlane(col & ~255);
        if (cu >= 3072 && cu < 4096) {
            bf16_t* d = (bf16_t*)(ws + WS_M) + (lat ? (size_t)0 : (size_t)NB * 1024 * L) + ((size_t)b * 1024 + (col - 3072)) * Lx + t;
            u32x2 o; o[0] = pk2(v0, v1); o[1] = pk2(v2, v3); *(u32x2*)d = o;
            return;
        }
        if (cu < 1024 || cu >= 4096) {
#pragma unroll
            for (int i = 0; i < 4; ++i) vv[i] = silu_f(vv[i]);
        } else {
            const int c = col - 1024;
            const float oml = 1.f - 1.f / (1.f + __expf(lg[c] - lg[2048 + c]));
#pragma unroll
            for (int i = 0; i < 4; ++i) vv[i] = oml * __builtin_amdgcn_rcpf(1.f + __expf(vv[i]));
        }
        if (cu < 3072) {
            bf16_t* d = (bf16_t*)(ws + WS_P + (lat ? P1_KQT_LAT : P1_KQT_CTX)) + ((size_t)b * 3072 + col) * Lx + t;
            u32x2 o; o[0] = pk2(vv[0], vv[1]); o[1] = pk2(vv[2], vv[3]); *(u32x2*)d = o;
        } else {
            if (!lat) return;
            bf16_t* d = (bf16_t*)(ws + WS_P + P1_G) + (size_t)row * 1024 + (col - 4096); d[0] = (bf16_t)f2bf(vv[0]); d[1024] = (bf16_t)f2bf(vv[1]); d[2048] = (bf16_t)f2bf(vv[2]); d[3072] = (bf16_t)f2bf(vv[3]);
        }
    }
};
struct EpiHgT {
    unsigned char* ws; const float* lg; int plain;
    DEV float colpre(int col) const {
        const int cu = __builtin_amdgcn_readfirstlane(col & ~255);
        if (cu < 1024 || cu >= 3072) return 0.f;
        const int c = col - 1024; return 1.f - __builtin_amdgcn_rcpf(1.f + __expf(lg[c] - lg[2048 + c]));
    }
    DEV void tok8(int row, int col, const float (&v)[8], float oml) const {
        const bool lat = row < TL; const int b = lat ? row / L : (row - TL) / LC, t = lat ? row - b * L : (row - TL) - b * LC, Lx = lat ? L : LC;
        const int cu = __builtin_amdgcn_readfirstlane(col & ~255);
        float vv[8];
#pragma unroll
        for (int i = 0; i < 8; ++i) vv[i] = v[i];
        if (cu >= 3072 && cu < 4096) {
            u32x4 o; o[0] = pk2(vv[0], vv[1]); o[1] = pk2(vv[2], vv[3]); o[2] = pk2(vv[4], vv[5]); o[3] = pk2(vv[6], vv[7]);
            *(u32x4*)((bf16_t*)(ws + WS_M) + (lat ? (size_t)0 : (size_t)NB * 1024 * L) + ((size_t)b * 1024 + (col - 3072)) * Lx + t) = o;
            return;
        }
        if (plain) {} else if (cu < 1024 || cu >= 4096) {
#pragma unroll
            for (int i = 0; i < 8; ++i) vv[i] = silu_f(vv[i]);
        } else {
#pragma unroll
            for (int i = 0; i < 8; ++i) vv[i] = oml * __builtin_amdgcn_rcpf(1.f + __expf(vv[i]));
        }
        if (cu < 3072) {
            u32x4 o; o[0] = pk2(vv[0], vv[1]); o[1] = pk2(vv[2], vv[3]); o[2] = pk2(vv[4], vv[5]); o[3] = pk2(vv[6], vv[7]);
            *(u32x4*)((bf16_t*)(ws + WS_P + (lat ? P1_KQT_LAT : P1_KQT_CTX)) + ((size_t)b * 3072 + col) * Lx + t) = o;
        } else {
            if (!lat) return;
            bf16_t* d = (bf16_t*)(ws + WS_P + P1_G) + (size_t)row * 1024 + (col - 4096);
#pragma unroll
            for (int i = 0; i < 8; ++i) d[i * 1024] = (bf16_t)f2bf(vv[i]);
        }
    }
};
struct EpiRes {
    const Params* p; int from_inputs, layer, goff;
    DEV void col8(int row, int col0, const float (&v)[8]) const {
        float* H = (float*)(p->ws + WS_H) + (size_t)row * 1024 + col0; const float* hin = h_row(*p, from_inputs, row) + col0;
        const float* gt = (const float*)(p->ws + WS_MOD) + ((size_t)layer * NR + mod_row(row)) * 6144 + goff + col0;
        const f32x4 h0 = *(const f32x4*)hin, h1 = *(const f32x4*)(hin + 4), g0 = *(const f32x4*)gt, g1 = *(const f32x4*)(gt + 4);
        f32x4 o0, o1;
#pragma unroll
        for (int i = 0; i < 4; ++i) { o0[i] = h0[i] + g0[i] * v[i]; o1[i] = h1[i] + g1[i] * v[4 + i]; }
        *(f32x4*)H = o0; *(f32x4*)(H + 4) = o1;
    }
    DEV void operator()(int row, int col, float v0, float v1, float v2, float v3) const {
        float* H = (float*)(p->ws + WS_H) + (size_t)row * 1024 + col;
        const float* hin = h_row(*p, from_inputs, row) + col;
        const float gt = ((const float*)(p->ws + WS_MOD))[((size_t)layer * NR + mod_row(row)) * 6144 + goff + col];
        const float h0 = hin[0], h1 = hin[1024], h2 = hin[2048], h3 = hin[3072];
        H[0] = h0 + gt * v0; H[1024] = h1 + gt * v1; H[2048] = h2 + gt * v2; H[3072] = h3 + gt * v3;
    }
};

struct HyRaw { u32x4 mid; unsigned short lft, rgt; };
DEV HyRaw hy_load(const bf16_t* row, int t0, int Lx) { HyRaw r; r.mid = *(const u32x4*)(row + t0); r.lft = t0 > 0 ? row[t0 - 1] : (unsigned short)0; r.rgt = t0 + 8 < Lx ? row[t0 + 8] : (unsigned short)0; return r; }
DEV void hy_conv8(const HyRaw& r, float w0, float w1, float w2, float b, float (&o)[8]) {
    float x[10]; x[0] = bf2f(r.lft); x[9] = bf2f(r.rgt);
#pragma unroll
    for (int i = 0; i < 4; ++i) { x[1 + 2 * i] = bflo(r.mid[i]); x[2 + 2 * i] = bfhi(r.mid[i]); }
#pragma unroll
    for (int i = 0; i < 8; ++i) o[i] = w0 * x[i] + w1 * x[i + 1] + w2 * x[i + 2] + b;
}
template <int TPC>
DEV void hyena_item(const Params& p, int set, int item, unsigned char* smem, bool nofft = false, bool nostore = false) {
    const int Ls = set ? LC : L, S = set ? FS_CTX : FS_LAT, N = 1 << (2 * S);
    constexpr int CPR = NT / TPC, NR8 = 8 / CPR;
    const int gi = tidx() / TPC, g = tidx() % TPC;
    const int bp = item >> 6, c0 = (item & 63) * 8, ba = bp * 2, bb = ba + 1;
    cf2* buf = (cf2*)smem + (size_t)gi * N;
    bf16_t* stg = (bf16_t*)(smem + (size_t)CPR * N * 8);
    const bf16_t* hy = (const bf16_t*)(p.ws + WS_P + (set ? P_HYT_CTX : P_HYT_LAT));
    const float* cw = p.in[I_HYCW]; const float* cb = p.in[I_HYCB];
    const cf2* HF = (const cf2*)(p.ws + WS_F + (set ? F_HF_CTX : F_HF_LAT));
    const float invN = 1.f / (float)N;
    const int t0 = g * 8; const bool own = t0 < Ls;
    HyRaw rv[2], rx1[2];
    cf2 hfr[16];
#define HY_FETCH(cc) do { if (own) { \
        rv[0] = hy_load(hy + ((size_t)ba * 1536 + (cc)) * Ls, t0, Ls); rv[1] = hy_load(hy + ((size_t)bb * 1536 + (cc)) * Ls, t0, Ls); \
        rx1[0] = hy_load(hy + ((size_t)ba * 1536 + 512 + (cc)) * Ls, t0, Ls); rx1[1] = hy_load(hy + ((size_t)bb * 1536 + 512 + (cc)) * Ls, t0, Ls); } } while (0)
    HY_FETCH(c0 + gi);
#pragma unroll 1
    for (int rd = 0; rd < NR8; ++rd) {
        const int cs = rd * CPR + gi, c = c0 + cs;
#pragma unroll
        for (int u = 0; u < 16; ++u) { hfr[u].x = 0.f; hfr[u].y = 0.f; if (g + TPC * u < N) hfr[u] = HF[(size_t)c * N + g + TPC * u]; }
        float za[8], zb[8];
        if (own) { hy_conv8(rv[0], cw[c], cw[1536 + c], cw[3072 + c], cb[c], za); hy_conv8(rv[1], cw[c], cw[1536 + c], cw[3072 + c], cb[c], zb); }
        for (int t = g; t < N; t += TPC) { if (t >= Ls) { cf2 z; z.x = 0.f; z.y = 0.f; buf[fsw(t)] = z; } }
        if (own) {
#pragma unroll
            for (int i = 0; i < 8; ++i) { cf2 v; v.x = za[i]; v.y = zb[i]; buf[fsw(t0 + i)] = v; }
        }
        __syncthreads();
#pragma unroll
        for (int n = 0; n < 2; ++n) {
            if (!nofft) fft_fwd(buf, S, g, TPC);
#pragma unroll
            for (int u = 0; u < 16; ++u) { const int k = g + TPC * u; if (k < N) buf[fsw(k)] = cmul(buf[fsw(k)], hfr[u]); }
            if (n == 0) {
#pragma unroll
                for (int u = 0; u < 16; ++u) if (g + TPC * u < N) hfr[u] = HF[(size_t)(512 + c) * N + g + TPC * u];
            }
            __syncthreads();
            if (!nofft) fft_inv(buf, S, g, TPC);
            const int gc = (n + 1) * 512 + c;
            if (own) {
                const float w0 = cw[gc], w1 = cw[1536 + gc], w2 = cw[3072 + gc], b = cb[gc], dsk = p.in[I_HYSKIP][n * 512 + c];
                float ga[8], gb[8];
                hy_conv8(rx1[0], w0, w1, w2, b, ga); hy_conv8(rx1[1], w0, w1, w2, b, gb);
                if (n == 0) { rx1[0] = hy_load(hy + ((size_t)ba * 1536 + 1024 + c) * Ls, t0, Ls); rx1[1] = hy_load(hy + ((size_t)bb * 1536 + 1024 + c) * Ls, t0, Ls); }
#pragma unroll
                for (int i = 0; i < 8; ++i) { const cf2 cv = buf[fsw(t0 + i)]; za[i] = ga[i] * (cv.x * invN + dsk * za[i]); zb[i] = gb[i] * (cv.y * invN + dsk * zb[i]); }
            }
            if (n == 0) {
                __syncthreads();
                for (int t = g; t < N; t += TPC) { if (t >= Ls) { cf2 z; z.x = 0.f; z.y = 0.f; buf[fsw(t)] = z; } }
                if (own) {
#pragma unroll
                    for (int i = 0; i < 8; ++i) { cf2 v; v.x = za[i]; v.y = zb[i]; buf[fsw(t0 + i)] = v; }
                }
                __syncthreads();
            } else {
                if (rd + 1 < NR8) HY_FETCH(c0 + (rd + 1) * CPR + gi);
                if (own) {
#pragma unroll
                    for (int i = 0; i < 8; ++i) {
                        const int ra = t0 + i, rb = Ls + t0 + i;
                        stg[(size_t)(ra + (ra >> 3)) * 8 + cs] = (bf16_t)f2bf(za[i]); stg[(size_t)(rb + (rb >> 3)) * 8 + cs] = (bf16_t)f2bf(zb[i]); }
                }
            }
        }
        __syncthreads();
    }
#undef HY_FETCH
    if (!nostore) {
        bf16_t* M = (bf16_t*)(p.ws + WS_M);
        for (int i = tidx(); i < 2 * Ls; i += NT) {
            const int bsel = i >= Ls, t = bsel ? i - Ls : i, bx = bsel ? bb : ba;
            const size_t tok = set ? (size_t)TL + (size_t)bx * LC + t : (size_t)bx * L + t;
            *(u32x4*)(M + tok * 1024 + c0) = *(const u32x4*)(stg + (size_t)(i + (i >> 3)) * 8);
        }
    }
    __syncthreads();
}
DEV void rope_store(const bf16_t* src, bf16_t* dst, int pos, bool rope, float scale, int ph, int sub) {
    const u32x4 ua = *(const u32x4*)(src + ph * 32 + sub * 8), ub = *(const u32x4*)(src + ph * 32 + 16 + sub * 8);
    float a[8], b[8];
#pragma unroll
    for (int i = 0; i < 4; ++i) { a[2 * i] = bflo(ua[i]); a[2 * i + 1] = bfhi(ua[i]); b[2 * i] = bflo(ub[i]); b[2 * i + 1] = bfhi(ub[i]); }
    if (rope) {
        const float pv = (float)(ph == 0 ? pos / 64 : pos % 64);
#pragma unroll
        for (int e = 0; e < 8; ++e) {
            const float inv = exp2f(-(float)(sub * 8 + e) * (13.287712379549449f / 16.f));
            const float ang = pv * inv, cs = __cosf(ang), sn = __sinf(ang);
            const float na = a[e] * cs - b[e] * sn, nb = b[e] * cs + a[e] * sn; a[e] = na; b[e] = nb;
        }
    }
    u32x4 oa, ob;
#pragma unroll
    for (int i = 0; i < 4; ++i) { oa[i] = pk2(a[2 * i] * scale, a[2 * i + 1] * scale); ob[i] = pk2(b[2 * i] * scale, b[2 * i + 1] * scale); }
    *(u32x4*)(dst + ph * 32 + sub * 8) = oa; *(u32x4*)(dst + ph * 32 + 16 + sub * 8) = ob;
}
constexpr int A_LDQ = 72, A_LDV = 136;
DEV void attn_item(const Params& p, int set, int item, unsigned char* smem) {
    bf16_t* Qs = (bf16_t*)smem;
    bf16_t* Ks = Qs + 128 * A_LDQ;
    bf16_t* Vt = Ks + 128 * A_LDQ;
    const int tid = tidx(), lane = tid & 63, w = tid >> 6, l15 = lane & 15, lg = lane >> 4;
    const int nqb = set ? LC / 128 : L / 128;
    const int h = item & 7, qb = (item >> 3) % nqb, b = (item >> 3) / nqb, kvh = h >> 2;
    const bf16_t* Q0 = (const bf16_t*)(p.ws + WS_P + P_Q0); const bf16_t* K0 = (const bf16_t*)(p.ws + WS_P + P_K0);
    const int qtok0 = set ? TL + b * LC + qb * 128 : b * L + qb * 128;
    { const int row = tid >> 2, ph = (tid >> 1) & 1, sub = tid & 1;
      rope_store(Q0 + (size_t)(qtok0 + row) * 512 + h * 64, Qs + row * A_LDQ, qb * 128 + row, set == 0, 0.125f, ph, sub); }
    __syncthreads();
    bf16x8 qf[2];
    qf[0] = *(const bf16x8*)(Qs + (w * 16 + l15) * A_LDQ + 8 * lg); qf[1] = *(const bf16x8*)(Qs + (w * 16 + l15) * A_LDQ + 32 + 8 * lg);
    float m_run = p.in[I_SINK][h], l_run = 1.f;
    f32x4 O[4];
#pragma unroll
    for (int i = 0; i < 4; ++i) O[i] = (f32x4){0.f, 0.f, 0.f, 0.f};
    const int nwin = set ? 0 : 3, nctx = LC / 128;
    for (int kbi = 0; kbi < nwin + nctx; ++kbi) {
        const bool win = kbi < nwin; const int kb = win ? qb - 1 + kbi : kbi - nwin;
        if (win && (kb < 0 || kb >= L / 128)) continue;
        const int ktok0 = win ? b * L + kb * 128 : TL + b * LC + kb * 128;
        __syncthreads();
        { const int row = tid >> 2, ph = (tid >> 1) & 1, sub = tid & 1;
          rope_store(K0 + (size_t)(ktok0 + row) * 128 + kvh * 64, Ks + row * A_LDQ, kb * 128 + row, win, 1.f, ph, sub); }
        { const bf16_t* vt = (const bf16_t*)(p.ws + WS_P + (win ? P_VT_LAT : P_VT_CTX)); const int Lx = win ? L : LC;
#pragma unroll
          for (int i = 0; i < 2; ++i) { const int id = tid + NT * i, d = id >> 4, kc = id & 15;
              *(u32x4*)(Vt + d * A_LDV + kc * 8) = *(const u32x4*)(vt + ((size_t)b * 128 + kvh * 64 + d) * Lx + kb * 128 + kc * 8); } }
        __syncthreads();
#pragma unroll
        for (int ch = 0; ch < 2; ++ch) {
            f32x4 st[4];
#pragma unroll
            for (int u = 0; u < 4; ++u) {
                const bf16_t* kr = Ks + ((ch * 4 + u) * 16 + l15) * A_LDQ + 8 * lg;
                f32x4 z = (f32x4){0.f, 0.f, 0.f, 0.f};
                z = __builtin_amdgcn_mfma_f32_16x16x32_bf16(*(const bf16x8*)kr, qf[0], z, 0, 0, 0);
                z = __builtin_amdgcn_mfma_f32_16x16x32_bf16(*(const bf16x8*)(kr + 32), qf[1], z, 0, 0, 0);
                st[u] = z;
            }
            float cmax = -INFINITY;
            if (win) {
                const int qpos = qb * 128 + w * 16 + l15;
#pragma unroll
                for (int u = 0; u < 4; ++u)
#pragma unroll
                    for (int r = 0; r < 4; ++r) { const int kpos = kb * 128 + (ch * 4 + u) * 16 + 4 * lg + r; const int dd = qpos - kpos; if (dd > 128 || dd < -128) st[u][r] = -INFINITY; }
            }
#pragma unroll
            for (int u = 0; u < 4; ++u)
#pragma unroll
                for (int r = 0; r < 4; ++r) cmax = fmaxf(cmax, st[u][r]);
            cmax = fmaxf(cmax, __shfl_xor(cmax, 16)); cmax = fmaxf(cmax, __shfl_xor(cmax, 32));
            const float m_new = fmaxf(m_run, cmax), alpha = __expf(m_run - m_new);
            float ls = 0.f;
#pragma unroll
            for (int u = 0; u < 4; ++u)
#pragma unroll
                for (int r = 0; r < 4; ++r) { const float e = __expf(st[u][r] - m_new); st[u][r] = e; ls += e; }
            ls += __shfl_xor(ls, 16); ls += __shfl_xor(ls, 32);
            l_run = l_run * alpha + ls; m_run = m_new;
#pragma unroll
            for (int i = 0; i < 4; ++i) { O[i][0] *= alpha; O[i][1] *= alpha; O[i][2] *= alpha; O[i][3] *= alpha; }
#pragma unroll
            for (int ss = 0; ss < 2; ++ss) {
                u32x4 pu; pu[0] = pk2(st[2 * ss][0], st[2 * ss][1]); pu[1] = pk2(st[2 * ss][2], st[2 * ss][3]); pu[2] = pk2(st[2 * ss + 1][0], st[2 * ss + 1][1]); pu[3] = pk2(st[2 * ss + 1][2], st[2 * ss + 1][3]);
                const bf16x8 pf = __builtin_bit_cast(bf16x8, pu);
                const int key0 = (ch * 4 + 2 * ss) * 16 + 4 * lg;
#pragma unroll
                for (int dt = 0; dt < 4; ++dt) {
                    const bf16_t* vr = Vt + (dt * 16 + l15) * A_LDV + key0;
                    u32x4 vu; const u32x2 v0 = *(const u32x2*)vr, v1 = *(const u32x2*)(vr + 16); vu[0] = v0[0]; vu[1] = v0[1]; vu[2] = v1[0]; vu[3] = v1[1];
                    O[dt] = __builtin_amdgcn_mfma_f32_16x16x32_bf16(__builtin_bit_cast(bf16x8, vu), pf, O[dt], 0, 0, 0);
                }
            }
        }
    }
    const float il = 1.f / l_run;
    bf16_t* M = (bf16_t*)(p.ws + WS_M) + (size_t)(qtok0 + w * 16 + l15) * 1024 + 512 + h * 64;
#pragma unroll
    for (int dt = 0; dt < 4; ++dt) { u32x2 o; o[0] = pk2(O[dt][0] * il, O[dt][1] * il); o[1] = pk2(O[dt][2] * il, O[dt][3] * il); *(u32x2*)(M + dt * 16 + 4 * lg) = o; }
    __syncthreads();
}
static_assert(NF_LAT / 256 <= 16 && NF_CTX / 64 <= 16 && L / 8 <= 256 && LC / 8 <= 64 && 2 * NF_LAT * 8 + 2 * L * 18 <= SMEM_BYTES && 8 * NF_CTX * 8 + 2 * LC * 18 <= SMEM_BYTES, "hyena item geometry");
constexpr int P3_HY_LAT = (NB / 2) * 64, P3_HY_CTX = (NB / 2) * 64, P3_AT_LAT = NB * (L / 128) * 8, P3_AT_CTX = NB * (LC / 128) * 8;
DEV void phase3(const Params& p, unsigned char* smem, int var = 0) {
    const int total = P3_HY_LAT + P3_AT_LAT + P3_HY_CTX + P3_AT_CTX;
    for (int it = blockIdx.x; it < total; it += gridDim.x) {
        int i = it;
        if ((var == 1 || var == 3 || var == 4) && !(i < P3_HY_LAT || (i >= P3_HY_LAT + P3_AT_LAT && i < P3_HY_LAT + P3_AT_LAT + P3_HY_CTX))) continue;
        if (var == 2 && (i < P3_HY_LAT || (i >= P3_HY_LAT + P3_AT_LAT && i < P3_HY_LAT + P3_AT_LAT + P3_HY_CTX))) continue;
        if (i < P3_HY_LAT) { hyena_item<256>(p, 0, i, smem, var == 3, var == 4); continue; } i -= P3_HY_LAT;
        if (i < P3_AT_LAT) { attn_item(p, 0, i, smem); continue; } i -= P3_AT_LAT;
        if (i < P3_HY_CTX) { hyena_item<64>(p, 1, i, smem, var == 3, var == 4); continue; } i -= P3_HY_CTX;
        attn_item(p, 1, i, smem);
    }
}

constexpr int K_LDK = 136, K_LDS = 129, K_LDC = 52;
DEV unsigned fkey(float f) { const unsigned u = __builtin_bit_cast(unsigned, f); return (u & 0x80000000u) ? ~u : (u | 0x80000000u); }
constexpr int cand_off(int i) { int o = 0; for (int k = 0; k < i; ++k) o += 16 / (k + 1); return o; }
DEV void topk_load_keys(const Params& p, int layer, int h, unsigned char* smem) {
    bf16_t* Ks = (bf16_t*)smem;
    const bf16_t* keys = (const bf16_t*)(p.ws + WS_W + W_KEYS) + (size_t)layer * 262144 + (size_t)h * 32768;
    const int tid = tidx();
#pragma unroll
    for (int i = 0; i < 8; ++i) { const int id = tid + NT * i, row = id >> 4, kc = id & 15; *(u32x4*)(Ks + row * K_LDK + kc * 8) = *(const u32x4*)(keys + (size_t)row * 128 + kc * 8); }
    __syncthreads();
}
#ifndef HOST_EMU
template <int CTRL> DEV unsigned dpp_u32(unsigned v) { return (unsigned)__builtin_amdgcn_update_dpp(0, (int)v, CTRL, 0xF, 0xF, true); }
#else
template <int CTRL> DEV unsigned dpp_u32(unsigned v) { const int lane = tidx() & 63; const int src = CTRL == 0xB1 ? (lane ^ 1) : CTRL == 0x4E ? (lane ^ 2) : CTRL == 0x128 ? (lane ^ 8) : ((lane & ~7) | (7 - (lane & 7))); return emu_shfl(v, src); }
#endif
DEV unsigned max8_u32(unsigned v) { unsigned t = dpp_u32<0xB1>(v); v = v > t ? v : t; t = dpp_u32<0x4E>(v); v = v > t ? v : t; t = dpp_u32<0x141>(v); return v > t ? v : t; }
DEV float sum8_f32(float v) { v += __builtin_bit_cast(float, dpp_u32<0xB1>(__builtin_bit_cast(unsigned, v))); v += __builtin_bit_cast(float, dpp_u32<0x4E>(__builtin_bit_cast(unsigned, v))); v += __builtin_bit_cast(float, dpp_u32<0x141>(__builtin_bit_cast(unsigned, v))); return v; }
DEV float unkey(unsigned k) { const unsigned u = (k & 0x80000000u) ? (k & 0x7fffffffu) : ~k; return __builtin_bit_cast(float, u); }
template <int N> DEV void bitonic_desc(unsigned (&a)[N]) {
#pragma unroll
    for (int k = 2; k <= N; k <<= 1)
#pragma unroll
        for (int j = k >> 1; j > 0; j >>= 1)
#pragma unroll
            for (int i = 0; i < N; ++i) { const int l = i ^ j; if (l > i) { const unsigned x = a[i], y = a[l]; const unsigned hi = x > y ? x : y, lo = x > y ? y : x; if ((i & k) == 0) { a[i] = hi; a[l] = lo; } else { a[i] = lo; a[l] = hi; } } }
}
DEV void merge16(const unsigned* lst, int nlist, unsigned first, int sub, unsigned& r0, unsigned& r1) {
    unsigned cur = first; int head = 0; r0 = 0u; r1 = 0u;
#pragma unroll
    for (int it = 0; it < 16; ++it) {
        const unsigned m = max8_u32(cur);
        if (sub == (it & 7)) { if (it < 8) r0 = m; else r1 = m; }
        if (cur == m) { ++head; cur = head < nlist ? lst[head] : 0u; }
    }
}
DEV void topk_item(const Params& p, int h, int tok0, unsigned char* smem, const bf16x8 (&afr)[16]) {
    bf16_t* Ks = (bf16_t*)smem;
    float* Sc = (float*)(Ks + 2 * 128 * K_LDK);
    unsigned* s12 = (unsigned*)Sc + 64 * 8 * 17;
    unsigned* cl = s12 + 64 * 32;
    const int tid = tidx(), lane = tid & 63, w = tid >> 6;
    const int row = tid >> 3, sub = tid & 7;
#pragma unroll
    for (int part = 0; part < 2; ++part) {
        { const int mi = w >> 2, ni = w & 3;
          f32x16 acc;
#pragma unroll
          for (int r = 0; r < 16; ++r) acc[r] = 0.f;
          const bf16_t* bs = Ks + (part * 128 + ni * 32 + (lane & 31)) * K_LDK + 8 * (lane >> 5);
#pragma unroll
          for (int kk = 0; kk < 8; ++kk) acc = __builtin_amdgcn_mfma_f32_32x32x16_bf16(part ? afr[8 + kk] : afr[kk], *(const bf16x8*)(bs + kk * 16), acc, 0, 0, 0);
#pragma unroll
          for (int r = 0; r < 16; ++r) Sc[(mi * 32 + (r & 3) + 8 * (r >> 2) + 4 * (lane >> 5)) * K_LDS + ni * 32 + (lane & 31)] = acc[r]; }
        __syncthreads();
        unsigned mk[16];
#pragma unroll
        for (int i = 0; i < 16; ++i) mk[i] = (fkey(Sc[row * K_LDS + sub * 16 + i]) & ~127u) | (unsigned)(127 - (sub * 16 + i));
        bitonic_desc<16>(mk);
        __syncthreads();
        unsigned* lst = (unsigned*)Sc + (row * 8 + sub) * 17;
#pragma unroll
        for (int i = 0; i < 16; ++i) lst[i] = mk[i];
        unsigned r0, r1;
        merge16(lst, 16, mk[0], sub, r0, r1);
        s12[(row * 2 + part) * 16 + sub] = r0; s12[(row * 2 + part) * 16 + 8 + sub] = r1;
        __syncthreads();
    }
    {
        const unsigned* k1 = s12 + row * 32; const unsigned* k2 = k1 + 16;
        unsigned ck[8];
#pragma unroll
        for (int m = 0; m < 8; ++m) {
            const int cc = sub + 8 * m; int ci = 0, off = 0;
#pragma unroll
            for (int i = 0; i < 15; ++i) { const bool ge = cc >= cand_off(i + 1); ci += ge ? 1 : 0; off += ge ? 16 / (i + 1) : 0; }
            const int cj = cc - off;
            ck[m] = 0u;
            if (cc < 50) ck[m] = (fkey(unkey((k1[ci] & ~127u) | 64u) + unkey((k2[cj] & ~127u) | 64u)) & ~63u) | (unsigned)(63 - cc);
        }
        bitonic_desc<8>(ck);
        unsigned* lst = cl + (row * 8 + sub) * 9;
#pragma unroll
        for (int m = 0; m < 8; ++m) lst[m] = ck[m];
        unsigned r0, r1;
        merge16(lst, 8, ck[0], sub, r0, r1);
        const float a = unkey((r0 & ~63u) | 32u), b = unkey((r1 & ~63u) | 32u);
        const unsigned kmax = max8_u32(r0 > r1 ? r0 : r1); const float vmax = unkey((kmax & ~63u) | 32u);
        const float ea = __expf(a - vmax), eb = __expf(b - vmax);
        const float inv = 1.f / sum8_f32(ea + eb);
        int eidx[2];
#pragma unroll
        for (int q = 0; q < 2; ++q) {
            const int cc = 63 - (int)((q ? r1 : r0) & 63u); int ci = 0, off = 0;
#pragma unroll
            for (int i = 0; i < 15; ++i) { const bool ge = cc >= cand_off(i + 1); ci += ge ? 1 : 0; off += ge ? 16 / (i + 1) : 0; }
            const int cj = cc - off;
            eidx[q] = (127 - (int)(k1[ci] & 127u)) * 128 + (127 - (int)(k2[cj] & 127u));
        }
        unsigned* ost = cl + 64 * 8 * 9 + row * 32;
        ost[sub] = (unsigned)eidx[0]; ost[8 + sub] = (unsigned)eidx[1]; ost[16 + sub] = __builtin_bit_cast(unsigned, ea * inv); ost[24 + sub] = __builtin_bit_cast(unsigned, eb * inv);
    }
    __syncthreads();
    {
        const u32x4 v = *(const u32x4*)(cl + 64 * 8 * 9 + row * 32 + sub * 4);
        unsigned char* dst = p.ws + (sub < 4 ? WS_IDX : WS_GATE) + ((size_t)(tok0 + row) * 128 + h * 16 + (sub & 3) * 4) * 4;
#ifndef HOST_EMU
        asm volatile("global_store_dwordx4 %0, %1, off sc1" :: "v"(dst), "v"(v) : "memory");
        asm volatile("s_waitcnt vmcnt(0)" ::: "memory");
#else
        *(u32x4*)dst = v;
#endif
    }
    __syncthreads();
}
#define TOPK_LOAD_PART(AF, tok0_, h_, part_) do { const int lane_ = tidx() & 63, w_ = tidx() >> 6; \
        const bf16_t* ag_ = (const bf16_t*)(p.ws + WS_P) + (size_t)((tok0_) + (w_ >> 2) * 32 + (lane_ & 31)) * 2048 + (h_) * 256 + 8 * (lane_ >> 5) + (part_) * 128; \
        _Pragma("unroll") for (int q_ = 0; q_ < 8; ++q_) AF[(part_) * 8 + q_] = *(const bf16x8*)(ag_ + q_ * 16); } while (0)
#define TOPK_LOAD(AF, tok0_, h_) do { TOPK_LOAD_PART(AF, tok0_, h_, 0); TOPK_LOAD_PART(AF, tok0_, h_, 1); } while (0)
DEV void topk_phase(const Params& p, int layer, int ntok, unsigned char* smem) {
    const int G = gridDim.x, bid = blockIdx.x, h = bid & 7;
    const int nt = ntok / 64;
    bf16x8 afA[16], afB[16];
    if ((G & 7) == 0) {
        const int st = G >> 3; int tt = bid >> 3;
        if (tt < nt) { TOPK_LOAD(afA, tt * 64, h); topk_load_keys(p, layer, h, smem); }
        while (tt < nt) {
            if (tt + st < nt) TOPK_LOAD(afB, (tt + st) * 64, h);
            topk_item(p, h, tt * 64, smem, afA);
            tt += st; if (tt >= nt) break;
            if (tt + st < nt) TOPK_LOAD(afA, (tt + st) * 64, h);
            topk_item(p, h, tt * 64, smem, afB);
            tt += st;
        }
    } else {
        for (int it = bid; it < nt * 8; it += G) { __syncthreads(); TOPK_LOAD(afA, (it >> 3) * 64, it & 7); topk_load_keys(p, layer, it & 7, smem); topk_item(p, it & 7, (it >> 3) * 64, smem, afA); }
    }
}
#ifndef HOST_EMU
DEV void peer_item(const Params& p, int layer, int item, const unsigned* dep, bf16x8 (&af)[16], int next_tok0, int next_h);
DEV void tg_phase(const Params& p, int layer, int ntok, unsigned char* smem) {
    const int G = gridDim.x, bid = blockIdx.x, h = bid & 7, team = bid >> 3, st = G >> 3;
    const int nblk = ntok / 64;
    unsigned* cnt = (unsigned*)(p.ws + WS_CTRL + CTRL_TG) + (size_t)layer * 320 * 16;
    const int n = team < nblk ? (nblk - team + st - 1) / st : 0;
    const int lead = (team & 1) ? 4 : 2;
    if (n > 0) topk_load_keys(p, layer, h, smem);
#pragma unroll 1
    for (int step = -lead; step < n; ++step) {
        const int kt = step + lead; const bool more = kt < n;
        bf16x8 af[16];
        if (step >= 0) { const int blk = team + st * step; peer_item(p, layer, blk * 8 + h, cnt + blk * 16, af, more ? (team + st * kt) * 64 : -1, h); }
        if (more) {
            const int blk = team + st * kt;
            if (step < 0) TOPK_LOAD_PART(af, blk * 64, h, 0);
            TOPK_LOAD_PART(af, blk * 64, h, 1);
            topk_item(p, h, blk * 64, smem, af);
            if (tidx() == 0) __hip_atomic_fetch_add(cnt + blk * 16, 1u, __ATOMIC_RELAXED, __HIP_MEMORY_SCOPE_AGENT);
        }
    }
}
#endif

DEV float gelu_f(float x) {
    const float z = fabsf(x) * 0.70710678118654752f;
    const float t = __builtin_amdgcn_rcpf(fmaf(0.3275911f, z, 1.f));
    float pl = fmaf(1.061405429f, t, -1.453152027f); pl = fmaf(pl, t, 1.421413741f); pl = fmaf(pl, t, -0.284496736f); pl = fmaf(pl, t, 0.254829592f); pl *= t;
    const float er = fmaf(-pl, __builtin_amdgcn_exp2f(z * z * -1.4426950408889634f), 1.f);
    return 0.5f * x + 0.5f * fabsf(x) * er;
}
#ifndef HOST_EMU
DEV float swap16_add(float a, float b) { const auto r = __builtin_amdgcn_permlane16_swap(__builtin_bit_cast(unsigned, a), __builtin_bit_cast(unsigned, b), false, false);
    return __builtin_bit_cast(float, (unsigned)r[0]) + __builtin_bit_cast(float, (unsigned)r[1]); }
#else
DEV float swap16_add(float a, float b) { const int lane = tidx() & 63; const float pa = emu_shfl(a, lane ^ 16), pb = emu_shfl(b, lane ^ 16); return (lane & 16) ? pb + b : a + pa; }
#endif
#ifndef HOST_EMU
DEV void wait_count(const unsigned* c, unsigned want, unsigned* tmo) {
    unsigned sp = 0u;
    while ((unsigned)__builtin_amdgcn_readfirstlane((int)__hip_atomic_load(c, __ATOMIC_RELAXED, __HIP_MEMORY_SCOPE_AGENT)) < want) {
        __builtin_amdgcn_s_sleep(2);
        if ((++sp & 255u) == 0u) { if (__hip_atomic_load(tmo, __ATOMIC_RELAXED, __HIP_MEMORY_SCOPE_AGENT)) break; if (sp > (1u << 18)) { atomicAdd(tmo, 1u); break; } }
    }
}
#endif
DEV void peer_item(const Params& p, int layer, int item, const unsigned* dep, bf16x8 (&af)[16], int next_tok0, int next_h) {
    const int tok = item * 8 + (tidx() >> 6), lane = tidx() & 63, li = lane & 31, half = lane >> 5;
    const bf16_t* A = (const bf16_t*)(p.ws + WS_A) + (size_t)tok * 1024 + li * 32;
    const unsigned char* UV = p.ws + WS_UV + (size_t)layer * 16384 * 1024;
    const float* SU = (const float*)(p.ws + WS_S8) + (size_t)(layer * 2) * 16384; const float* SV = SU + 16384;
    float y[32]; int xh[4], xl[4], xsum = 0; float xs;
    { float xf[32]; float amax = 0.f;
#pragma unroll
      for (int q = 0; q < 4; ++q) { const u32x4 a = *(const u32x4*)(A + 8 * q);
#pragma unroll
        for (int i = 0; i < 4; ++i) { xf[8 * q + 2 * i] = bflo(a[i]); xf[8 * q + 2 * i + 1] = bfhi(a[i]); amax = fmaxf(amax, fmaxf(fabsf(xf[8 * q + 2 * i]), fabsf(xf[8 * q + 2 * i + 1]))); } }
#pragma unroll
      for (int m = 16; m >= 1; m >>= 1) amax = fmaxf(amax, __shfl_xor(amax, m));
      xs = amax > 0.f ? amax * (1.f / 119.f) : 1.f; const float xinv = amax > 0.f ? 119.f / amax : 1.f;
#pragma unroll
      for (int d = 0; d < 4; ++d) { unsigned h = 0u, l = 0u;
#pragma unroll
        for (int e = 0; e < 8; ++e) { const int X = (int)rintf(xf[8 * d + e] * xinv); xsum += X; const int lo = ((X + 8) & 15) - 8, hi = (X - lo) >> 4; h |= ((unsigned)hi & 15u) << (4 * e); l |= ((unsigned)lo & 15u) << (4 * e); }
        xh[d] = (int)h; xl[d] = (int)l; } }
#pragma unroll
    for (int i = 0; i < 32; ++i) y[i] = 0.f;
    const int* IDX = (const int*)(p.ws + WS_IDX) + (size_t)tok * 128; const float* GT = (const float*)(p.ws + WS_GATE) + (size_t)tok * 128;
#ifndef HOST_EMU
    if (dep) wait_count(dep, 8u, (unsigned*)(p.ws + WS_CTRL) + 128);
    const int i_lo = (int)__hip_atomic_load((const unsigned*)IDX + lane, __ATOMIC_RELAXED, __HIP_MEMORY_SCOPE_AGENT), i_hi = (int)__hip_atomic_load((const unsigned*)IDX + 64 + lane, __ATOMIC_RELAXED, __HIP_MEMORY_SCOPE_AGENT);
    const float gt_lo = __builtin_bit_cast(float, __hip_atomic_load((const unsigned*)GT + lane, __ATOMIC_RELAXED, __HIP_MEMORY_SCOPE_AGENT)), gt_hi = __builtin_bit_cast(float, __hip_atomic_load((const unsigned*)GT + 64 + lane, __ATOMIC_RELAXED, __HIP_MEMORY_SCOPE_AGENT));
#else
    (void)dep;
    const int i_lo = IDX[lane], i_hi = IDX[64 + lane]; const float gt_lo = GT[lane], gt_hi = GT[64 + lane];
#endif
    const float su_lo = SU[i_lo] * xs, su_hi = SU[i_hi] * xs, gs_lo = gt_lo * SV[i_lo], gs_hi = gt_hi * SV[i_hi];
    const int own_src = ((lane & 1) << 5) + (((lane >> 2) & 1) << 4) + (((lane >> 1) & 1) << 3);
    u32x4 uq[4], vqA[4], vqB[4]; unsigned eo[4];
#define PG_IDX(g, eo) do { _Pragma("unroll") for (int s_ = 0; s_ < 4; ++s_) eo[s_] = ((unsigned)__shfl((g) < 8 ? i_lo : i_hi, (((g) & 7) << 3) + 2 * s_ + half) << 10) + (unsigned)li * 16u; } while (0)
#define PG_LOADU(uq, eo) do { _Pragma("unroll") for (int s_ = 0; s_ < 4; ++s_) uq[s_] = *(const u32x4*)(UV + eo[s_]); } while (0)
#define PG_LOADV(vq, eo) do { _Pragma("unroll") for (int s_ = 0; s_ < 4; ++s_) vq[s_] = *(const u32x4*)(UV + eo[s_] + 512u); } while (0)
#define PG_STEP(g, vq, vqn) do { \
        float d[4]; \
        _Pragma("unroll") for (int s4 = 0; s4 < 4; ++s4) { \
            int a1 = 0, a0 = 0; \
            _Pragma("unroll") for (int dw = 0; dw < 4; ++dw) { a1 = __builtin_amdgcn_sdot8((int)uq[s4][dw], xh[dw], a1, false); a0 = __builtin_amdgcn_sdot8((int)uq[s4][dw], xl[dw], a0, false); } \
            d[s4] = (float)(32 * a1 + 2 * a0 + xsum);             \
        } \
        SCHED_FENCE(); \
        if ((g) + 1 < 16) { PG_IDX((g) + 1, eo); PG_LOADU(uq, eo); PG_LOADV(vqn, eo); } \
          \
        float r1; \
        { const float r20 = swap16_add(d[0], d[2]), r21 = swap16_add(d[1], d[3]); \
          const bool hi = (li & 8) != 0; const float send = hi ? r20 : r21, keep = hi ? r21 : r20; \
          r1 = sum8_f32(keep + __builtin_bit_cast(float, dpp_u32<0x128>(__builtin_bit_cast(unsigned, send)))); } \
        const float act = gelu_f(__shfl(r1, own_src) * ((g) < 8 ? su_lo : su_hi)) * ((g) < 8 ? gs_lo : gs_hi); \
        _Pragma("unroll") for (int s4 = 0; s4 < 4; ++s4) { \
            const float aj = __shfl(act, (((g) & 7) << 3) + 2 * s4 + half); \
            _Pragma("unroll") for (int dw = 0; dw < 4; ++dw) { \
                const f32x2 f0 = __builtin_amdgcn_cvt_scalef32_pk_f32_fp4(vq[s4][dw], 1.0f, 0), f1 = __builtin_amdgcn_cvt_scalef32_pk_f32_fp4(vq[s4][dw], 1.0f, 1), \
                            f2 = __builtin_amdgcn_cvt_scalef32_pk_f32_fp4(vq[s4][dw], 1.0f, 2), f3 = __builtin_amdgcn_cvt_scalef32_pk_f32_fp4(vq[s4][dw], 1.0f, 3); \
                const int e0 = dw * 8; \
                y[e0] = fmaf(aj, f0[0], y[e0]); y[e0 + 1] = fmaf(aj, f0[1], y[e0 + 1]); y[e0 + 2] = fmaf(aj, f1[0], y[e0 + 2]); y[e0 + 3] = fmaf(aj, f1[1], y[e0 + 3]); \
                y[e0 + 4] = fmaf(aj, f2[0], y[e0 + 4]); y[e0 + 5] = fmaf(aj, f2[1], y[e0 + 5]); y[e0 + 6] = fmaf(aj, f3[0], y[e0 + 6]); y[e0 + 7] = fmaf(aj, f3[1], y[e0 + 7]); \
            } \
            SCHED_FENCE(); } \
    } while (0)
    PG_IDX(0, eo); PG_LOADU(uq, eo); PG_LOADV(vqA, eo);
#pragma unroll 1
    for (int g = 0; g < 16; g += 2) { PG_STEP(g, vqA, vqB); PG_STEP(g + 1, vqB, vqA); }
#undef PG_STEP
#undef PG_IDX
#undef PG_LOADU
#undef PG_LOADV
    SCHED_FENCE();
    if (next_tok0 >= 0) { TOPK_LOAD_PART(af, next_tok0, next_h, 0); }
    SCHED_FENCE();
    float yy[16];
#pragma unroll
    for (int i = 0; i < 16; ++i) { const float send = half ? y[i] : y[16 + i], keep = half ? y[16 + i] : y[i]; yy[i] = keep + __shfl_xor(send, 32); }
    const int c0 = li * 32 + half * 16;
    float* H = (float*)(p.ws + WS_H) + (size_t)tok * 1024 + c0;
    const float* g2 = (const float*)(p.ws + WS_MOD) + ((size_t)layer * NR + mod_row(tok)) * 6144 + 5120 + c0;
    float hv[16]; float ss = 0.f;
#pragma unroll
    for (int i = 0; i < 4; ++i) { const f32x4 hh = *(const f32x4*)(H + 4 * i), gg = *(const f32x4*)(g2 + 4 * i);
#pragma unroll
        for (int j = 0; j < 4; ++j) { const float v = hh[j] + gg[j] * yy[4 * i + j]; hv[4 * i + j] = v; ss += v * v; } }
    ss = wave_sum(ss);
    const float rstd = rsqrtf(ss * (1.f / 1024.f) + 1e-6f);
    if (layer == 0) {
#pragma unroll
        for (int i = 0; i < 4; ++i) { f32x4 o; o[0] = hv[4 * i]; o[1] = hv[4 * i + 1]; o[2] = hv[4 * i + 2]; o[3] = hv[4 * i + 3]; *(f32x4*)(H + 4 * i) = o; }
        const float* g = p.in[I_N1G] + 1024 + c0;
        const float* mod = (const float*)(p.ws + WS_MOD) + ((size_t)1 * NR + mod_row(tok)) * 6144 + c0;
        bf16_t* Ao = (bf16_t*)(p.ws + WS_A) + (size_t)tok * 1024 + c0;
        u32x4 o0, o1; float r[16];
#pragma unroll
        for (int i = 0; i < 16; ++i) r[i] = hv[i] * rstd * g[i] * (1.f + mod[1024 + i]) + mod[i];
#pragma unroll
        for (int i = 0; i < 4; ++i) { o0[i] = pk2(r[2 * i], r[2 * i + 1]); o1[i] = pk2(r[8 + 2 * i], r[8 + 2 * i + 1]); }
        *(u32x4*)Ao = o0; *(u32x4*)(Ao + 8) = o1;
    } else {
        const float* g = p.in[I_FG] + c0; float* out = p.out + (size_t)tok * 1024 + c0;
#pragma unroll
        for (int i = 0; i < 4; ++i) { f32x4 o; o[0] = hv[4 * i] * rstd * g[4 * i]; o[1] = hv[4 * i + 1] * rstd * g[4 * i + 1]; o[2] = hv[4 * i + 2] * rstd * g[4 * i + 2]; o[3] = hv[4 * i + 3] * rstd * g[4 * i + 3]; *(f32x4*)(out + 4 * i) = o; }
    }
}

#undef TOPK_LOAD
#undef TOPK_LOAD_PART

constexpr int S3_LD = 136, S3_LDT = 24, S3_LDV = 72;
constexpr int S3_Q = 0, S3_K = S3_Q + 64 * S3_LD * 2, S3_KT = S3_K + 64 * S3_LD * 2, S3_D = S3_KT + 4 * 128 * S3_LDT * 2, S3_V = S3_D + 4 * 128 * 4, S3_ST = S3_V + 64 * S3_LDV * 2,
              S3_P = S3_ST + 2 * 64 * S3_LD * 2, S3_END = S3_P + 4 * 16 * S3_LDT * 2;
static_assert(S3_END <= SMEM_BYTES, "scan LDS");
DEV void scan_block(const Params& p, int bi, unsigned char* smem, int var = 0) {
    const int tid = tidx(), lane = tid & 63, w = tid >> 6, l15 = lane & 15, lg4 = lane >> 4, l31 = lane & 31, lh = lane >> 5;
    const int half = bi & 1, dir = (bi >> 1) & 1, h = (bi >> 2) & 7, b = bi >> 5;
    const bf16_t* P1 = (const bf16_t*)(p.ws + WS_P);
    const bf16_t* IT = (const bf16_t*)(p.ws + WS_M);
    bf16_t* Oo = (bf16_t*)(p.ws + WS_F + (dir ? F_OB : F_OF));
    bf16_t* Qs = (bf16_t*)(smem + S3_Q); bf16_t* Ks = (bf16_t*)(smem + S3_K); bf16_t* KT = (bf16_t*)(smem + S3_KT); float* Ds = (float*)(smem + S3_D);
    bf16_t* Vs = (bf16_t*)(smem + S3_V); bf16_t* ST = (bf16_t*)(smem + S3_ST); bf16_t* Ps = (bf16_t*)(smem + S3_P);
    const int NCH = (LC + L) / 64;
    const int kt = w >> 1, vt = w & 1;
    f32x16 S;
#pragma unroll
    for (int r = 0; r < 16; ++r) S[r] = 0.f;
    for (int i = tid; i < 64 * S3_LD / 2; i += NT) ((unsigned*)ST)[i] = 0u;
    const int pk = tid & 127, pblk = tid >> 7;
    u32x4 ka[2], qa[2], va, kb2[2], qb2[2], vb2;
    const int kcol = 1024 * (1 + dir) + h * 128 + pk, qcol = h * 128 + pk;
#define S3_T0(c) ((c) * 64 < LC ? (dir ? LC - 64 - (c) * 64 : (c) * 64) : (dir ? L - 64 - ((c) * 64 - LC) : (c) * 64 - LC))
#define S3_LOAD(c, KR, QR, VR) do { const bool lat_ = (c) * 64 >= LC; const int t0_ = S3_T0(c); const int Lx_ = lat_ ? L : LC; \
        const bf16_t* kq_ = (const bf16_t*)(p.ws + WS_P + (lat_ ? P1_KQT_LAT : P1_KQT_CTX)) + (size_t)b * 3072 * Lx_ + t0_ + pblk * 16; \
        KR[0] = *(const u32x4*)(kq_ + (size_t)kcol * Lx_); KR[1] = *(const u32x4*)(kq_ + (size_t)kcol * Lx_ + 8); \
        if (lat_) { QR[0] = *(const u32x4*)(kq_ + (size_t)qcol * Lx_); QR[1] = *(const u32x4*)(kq_ + (size_t)qcol * Lx_ + 8); } else { QR[0] = (u32x4){0u, 0u, 0u, 0u}; QR[1] = QR[0]; } \
        { const int v_ = tid >> 3, c8_ = tid & 7; const bf16_t* it_ = IT + (lat_ ? (size_t)0 : (size_t)NB * 1024 * L) + ((size_t)b * 1024 + h * 128 + half * 64 + v_) * Lx_ + t0_ + c8_ * 8; VR = *(const u32x4*)it_; } } while (0)
#define S3_PREP(KR, QR, VR) do { \
            float bsum = 0.f; unsigned short kt16[16]; \
            _Pragma("unroll") for (int rr = 0; rr < 16; ++rr) { \
                const int tl = dir ? 15 - rr : rr; \
                const unsigned ku_ = dir ? KR[(15 - rr) >> 3][((15 - rr) & 7) >> 1] : KR[rr >> 3][(rr & 7) >> 1]; const unsigned qu_ = dir ? QR[(15 - rr) >> 3][((15 - rr) & 7) >> 1] : QR[rr >> 3][(rr & 7) >> 1]; \
                const bool odd_ = dir ? (((15 - rr) & 1) != 0) : ((rr & 1) != 0); \
                const float kv = odd_ ? bfhi(ku_) : bflo(ku_), qv = odd_ ? bfhi(qu_) : bflo(qu_); \
                bsum += __log2f(1.f - kv); \
                const float eb = __builtin_amdgcn_exp2f(bsum), ieb = __builtin_amdgcn_exp2f(fminf(-bsum, 115.f)); \
                const unsigned short qt = (unsigned short)f2bf(qv * eb), ktv = (unsigned short)f2bf(kv * ieb); \
                Qs[(pblk * 16 + tl) * S3_LD + pk] = qt; Ks[(pblk * 16 + tl) * S3_LD + pk] = ktv; \
                if (dir) kt16[15 - rr] = ktv; else kt16[rr] = ktv; \
            } \
            u32x4 o0, o1; \
            _Pragma("unroll") for (int i = 0; i < 4; ++i) { o0[i] = (unsigned)kt16[2 * i] | ((unsigned)kt16[2 * i + 1] << 16); o1[i] = (unsigned)kt16[8 + 2 * i] | ((unsigned)kt16[8 + 2 * i + 1] << 16); } \
            *(u32x4*)(KT + (pblk * 128 + pk) * S3_LDT) = o0; *(u32x4*)(KT + (pblk * 128 + pk) * S3_LDT + 8) = o1; \
            Ds[pblk * 128 + pk] = __builtin_amdgcn_exp2f(bsum); \
            { const int v_ = tid >> 3, c8_ = tid & 7; *(u32x4*)(Vs + v_ * S3_LDV + c8_ * 8) = VR; } } while (0)
    S3_LOAD(0, ka, qa, va);
    for (int c = 0; c < NCH; ++c) {
        const bool lat = c * 64 >= LC; const int t0 = S3_T0(c); const size_t tokb = lat ? (size_t)b * L + t0 : (size_t)TL + (size_t)b * LC + t0;
        if ((c & 1) == 0) { if (c + 1 < NCH) S3_LOAD(c + 1, kb2, qb2, vb2); } else { if (c + 1 < NCH) S3_LOAD(c + 1, ka, qa, va); }
        lds_barrier();
        if (var != 1) { if ((c & 1) == 0) S3_PREP(ka, qa, va); else S3_PREP(kb2, qb2, vb2); }
        lds_barrier();

        if (lat && w < 4) {
            f32x4 pt = (f32x4){0.f, 0.f, 0.f, 0.f};
#pragma unroll
            for (int kk = 0; kk < 4; ++kk)
                pt = __builtin_amdgcn_mfma_f32_16x16x32_bf16(*(const bf16x8*)(Ks + (w * 16 + l15) * S3_LD + kk * 32 + 8 * lg4), *(const bf16x8*)(Qs + (w * 16 + l15) * S3_LD + kk * 32 + 8 * lg4), pt, 0, 0, 0);
            float pm[4];
#pragma unroll
            for (int r = 0; r < 4; ++r) { const int sl = 4 * lg4 + r; const bool keep = dir ? (sl >= l15) : (sl <= l15); pm[r] = keep ? pt[r] : 0.f; }
            u32x2 o; o[0] = pk2(pm[0], pm[1]); o[1] = pk2(pm[2], pm[3]);
            *(u32x2*)(Ps + (w * 16 + l15) * S3_LDT + 4 * lg4) = o;
        }
        lds_barrier();
        for (int ib = 0; ib < (var == 2 ? 0 : 4); ++ib) {
            const int blk = dir ? 3 - ib : ib;
            const int cur = (c * 4 + ib) & 1;
            { const bf16x8 a = *(const bf16x8*)(KT + (blk * 128 + 32 * kt + l31) * S3_LDT + 8 * lh);
              const bf16x8 bb = *(const bf16x8*)(Vs + (32 * vt + l31) * S3_LDV + blk * 16 + 8 * lh);
              S = __builtin_amdgcn_mfma_f32_32x32x16_bf16(a, bb, S, 0, 0, 0);
#pragma unroll
              for (int g = 0; g < 4; ++g) { const f32x4 dv = *(const f32x4*)(Ds + blk * 128 + 32 * kt + 8 * g + 4 * lh);
                  S[4 * g] *= dv[0]; S[4 * g + 1] *= dv[1]; S[4 * g + 2] *= dv[2]; S[4 * g + 3] *= dv[3];
                  u32x2 o; o[0] = pk2(S[4 * g], S[4 * g + 1]); o[1] = pk2(S[4 * g + 2], S[4 * g + 3]);
                  *(u32x2*)(ST + ((cur ^ 1) * 64 + 32 * vt + l31) * S3_LD + 32 * kt + 8 * g + 4 * lh) = o; } }
            if (lat && w < 4) {
                f32x4 o = (f32x4){0.f, 0.f, 0.f, 0.f};
#pragma unroll
                for (int kk = 0; kk < 4; ++kk)
                    o = __builtin_amdgcn_mfma_f32_16x16x32_bf16(*(const bf16x8*)(ST + (cur * 64 + 16 * w + l15) * S3_LD + kk * 32 + 8 * lg4), *(const bf16x8*)(Qs + (blk * 16 + l15) * S3_LD + kk * 32 + 8 * lg4), o, 0, 0, 0);
                bf16x8 va = (bf16x8){0, 0, 0, 0, 0, 0, 0, 0}, pb = va;
                if (lg4 < 2) { va = *(const bf16x8*)(Vs + (16 * w + l15) * S3_LDV + blk * 16 + 8 * lg4); pb = *(const bf16x8*)(Ps + (blk * 16 + l15) * S3_LDT + 8 * lg4); }
                o = __builtin_amdgcn_mfma_f32_16x16x32_bf16(va, pb, o, 0, 0, 0);
                u32x2 ou; ou[0] = pk2(o[0], o[1]); ou[1] = pk2(o[2], o[3]);
                *(u32x2*)(Oo + (tokb + blk * 16 + l15) * 1024 + h * 128 + half * 64 + 16 * w + 4 * lg4) = ou;
            }
            lds_barrier();
        }
    }
    lds_barrier();
#undef S3_T0
#undef S3_LOAD
#undef S3_PREP
}
DEV void readout_item(const Params& p, int item) {
    const int tok = item * 8 + (tidx() >> 6), lane = tidx() & 63;
    const bf16_t* of = (const bf16_t*)(p.ws + WS_F + F_OF) + (size_t)tok * 1024 + lane * 16; const bf16_t* ob = (const bf16_t*)(p.ws + WS_F + F_OB) + (size_t)tok * 1024 + lane * 16;
    const bf16_t* gp = (const bf16_t*)(p.ws + WS_P + P1_G) + (size_t)tok * 1024 + lane * 16;
    const float* on = p.in[I_HGON] + (lane & 7) * 16;
    float o[16], gg[16]; float ss = 0.f;
    { const u32x4 a0 = *(const u32x4*)of, a1 = *(const u32x4*)(of + 8), b0 = *(const u32x4*)ob, b1 = *(const u32x4*)(ob + 8), g0 = *(const u32x4*)gp, g1 = *(const u32x4*)(gp + 8);
#pragma unroll
      for (int i = 0; i < 4; ++i) { o[2 * i] = bflo(a0[i]) + bflo(b0[i]); o[2 * i + 1] = bfhi(a0[i]) + bfhi(b0[i]); o[8 + 2 * i] = bflo(a1[i]) + bflo(b1[i]); o[8 + 2 * i + 1] = bfhi(a1[i]) + bfhi(b1[i]);
          gg[2 * i] = bflo(g0[i]); gg[2 * i + 1] = bfhi(g0[i]); gg[8 + 2 * i] = bflo(g1[i]); gg[8 + 2 * i + 1] = bfhi(g1[i]); } }
#pragma unroll
    for (int i = 0; i < 16; ++i) ss += o[i] * o[i];
    ss += __shfl_xor(ss, 1); ss += __shfl_xor(ss, 2); ss += __shfl_xor(ss, 4);
    const float rstd = rsqrtf(ss * (1.f / 128.f) + 1e-6f);
    bf16_t* M = (bf16_t*)(p.ws + WS_M) + (size_t)tok * 1024 + lane * 16;
    u32x4 o0, o1; float r[16];
#pragma unroll
    for (int i = 0; i < 16; ++i) r[i] = o[i] * rstd * on[i] * gg[i];
#pragma unroll
    for (int i = 0; i < 4; ++i) { o0[i] = pk2(r[2 * i], r[2 * i + 1]); o1[i] = pk2(r[8 + 2 * i], r[8 + 2 * i + 1]); }
    *(u32x4*)M = o0; *(u32x4*)(M + 8) = o1;
}

#ifndef HOST_EMU
#define XB_TMO      128
#define XB_XCNT(j)  (256  + 64 * (j))
#define XB_XSUB(j)  (1280 + 64 * (j))
#define XB_XGEN(j)  (2304 + 64 * (j))
#define XB_TOP      3328
#define XB_TOPGEN   3392
#define XCD_BAR_WORDS 3456
#define XB_SPIN_CAP (1u << 18)
#define LAS __attribute__((address_space(3)))

__device__ __forceinline__ unsigned xb_ld(unsigned* p)              { return __hip_atomic_load(p, __ATOMIC_RELAXED, __HIP_MEMORY_SCOPE_AGENT); }
__device__ __forceinline__ unsigned xb_add(unsigned* p, unsigned v) { return __hip_atomic_fetch_add(p, v, __ATOMIC_RELAXED, __HIP_MEMORY_SCOPE_AGENT); }
__device__ __forceinline__ unsigned xb_xcc_id() { return (unsigned)__builtin_amdgcn_s_getreg((3 << 11) | 20) & 0xFu; }
#define XB_SPIN(cond, bar) do { unsigned _sp = 0; while (cond) { __builtin_amdgcn_s_sleep(1); \
    if ((++_sp & 255u) == 0u) { if (xb_ld(&(bar)[XB_TMO])) break; if (_sp > XB_SPIN_CAP) { atomicAdd(&(bar)[XB_TMO], 1u); break; } } } } while (0)

struct XcdBarrier {
    unsigned* bar; unsigned x;
    volatile LAS unsigned* st;
};

__device__ __forceinline__ XcdBarrier xcd_barrier_post(unsigned* bar, volatile LAS unsigned* st) {
    XcdBarrier b; b.bar = bar; b.x = xb_xcc_id(); b.st = st;
    if (threadIdx.x == 0) (void)xb_add(&bar[XB_XCNT(b.x)], 1u);
    return b;
}
__device__ __forceinline__ void xcd_barrier_complete(unsigned* bar, unsigned x, unsigned& nloc, unsigned& nx) {
    const unsigned G = gridDim.x * gridDim.y * gridDim.z;
    unsigned sum, cnt, mine, sp = 0u;
    for (;;) {
        sum = 0u; cnt = 0u; mine = 0u;
#pragma unroll
        for (unsigned j = 0; j < 16; ++j) { const unsigned c = xb_ld(&bar[XB_XCNT(j)]); sum += c; cnt += (c > 0u) ? 1u : 0u; mine = (j == x) ? c : mine; }
        if (sum == G) break;
        __builtin_amdgcn_s_sleep(1);
        if ((++sp & 255u) == 0u) { if (xb_ld(&bar[XB_TMO])) break; if (sp > XB_SPIN_CAP) { atomicAdd(&bar[XB_TMO], 1u); break; } }
    }
    nloc = mine > 0u ? mine : 1u; nx = cnt > 0u ? cnt : 1u;
}

__device__ __forceinline__ void xcd_barrier(const XcdBarrier& b) {
    asm volatile("s_waitcnt vmcnt(0)" ::: "memory");
    __syncthreads();
    if (threadIdx.x == 0) {
        unsigned* bar = b.bar;
        __builtin_amdgcn_s_waitcnt(0);
        unsigned nloc = b.st[0], nx = b.st[1];
        if (nloc == 0u) { xcd_barrier_complete(bar, b.x, nloc, nx); b.st[0] = nloc; b.st[1] = nx; }
        const unsigned old = xb_add(&bar[XB_XSUB(b.x)], 1u);
        const unsigned gen = old / nloc;
        if (old + 1u == (gen + 1u) * nloc) {
            __builtin_amdgcn_fence(__ATOMIC_RELEASE, "agent");
            asm volatile("s_waitcnt vmcnt(0)" ::: "memory");
            const unsigned og = xb_add(&bar[XB_TOP], 1u);
            const unsigned tg = og / nx;
            if (og + 1u == (tg + 1u) * nx) xb_add(&bar[XB_TOPGEN], 1u);
            else XB_SPIN(xb_ld(&bar[XB_TOPGEN]) == tg, bar);
            __builtin_amdgcn_fence(__ATOMIC_ACQUIRE, "agent");
            xb_add(&bar[XB_XGEN(b.x)], 1u);
            asm volatile("s_waitcnt vmcnt(0)" ::: "memory");
        } else {
            XB_SPIN(xb_ld(&bar[XB_XGEN(b.x)]) == gen, bar);
            __builtin_amdgcn_fence(__ATOMIC_ACQUIRE, "agent");
            asm volatile("s_waitcnt vmcnt(0)" ::: "memory");
        }
    }
    __syncthreads();
}

#endif
#ifdef NOINLINE_PHASES
#define NOINL __device__ __attribute__((noinline))
#else
#define NOINL __device__ __forceinline__
#endif
__shared__ __attribute__((aligned(16))) unsigned char g_smem[SMEM_BYTES + 16];
#define PH_COMMON const int G = gridDim.x, bid = blockIdx.x; unsigned char* smem = g_smem; (void)smem; (void)G; (void)bid; \
    const bf16_t* A = (const bf16_t*)(p.ws + WS_A); const bf16_t* Mx = (const bf16_t*)(p.ws + WS_M); const bf16_t* W = (const bf16_t*)(p.ws + WS_W); (void)A; (void)Mx; (void)W;
DEV void tables_in_gemm_tail(const Params& p, int tab0, int ntab, int nunits) {
    const int G = gridDim.x, bid = blockIdx.x, busy = nunits % G;
    if (busy == 0) { for (int it = bid; it < ntab * P0_TAB; it += G) p0_table(p, tab0 + it / P0_TAB, it % P0_TAB); return; }
    if (bid < busy) return;
    for (int it = bid - busy; it < ntab * P0_TAB; it += G - busy) p0_table(p, tab0 + it / P0_TAB, it % P0_TAB);
}
NOINL void ph0(const Params& p) { PH_COMMON phase0(p, smem); }
NOINL void ph1(const Params& p) { PH_COMMON phase1(p, smem); }
NOINL void ph2(const Params& p) { PH_COMMON EpiL0InT e{p.ws}; gemm_pg8_T(A, W + W_IN0 / 2, T, 2304, smem, e); tables_in_gemm_tail(p, 0, 1, (T / 256) * 9); }
NOINL void ph3(const Params& p, int var = 0) { PH_COMMON phase3(p, smem, var); }
NOINL void ph4(const Params& p) { PH_COMMON EpiRes e{&p, 1, 0, 2048}; gemm_pg8_N(Mx, W + W_OUT0 / 2, T, 1024, smem, e); tables_in_gemm_tail(p, 1, 2, (T / 256) * 4); }
NOINL void ph5(const Params& p) { PH_COMMON for (int it = bid; it < T / 8; it += G) norm_rows_item(p, it, 0, p.in[I_N2G], 0, 3072); }
NOINL void ph6(const Params& p, int var = 0) { PH_COMMON (void)var; EpiBf16 e{(bf16_t*)(p.ws + WS_P), 2048}; gemm_pg8_N(A, W + W_Q0 / 2, T, 2048, smem, e); tables_in_gemm_tail(p, 3, 1, (T / 256) * 8); }
#ifndef HOST_EMU
NOINL void ph7(const Params& p) { PH_COMMON tg_phase(p, 0, T, smem); }
#else
NOINL void ph7(const Params& p) { PH_COMMON topk_phase(p, 0, T, smem); }
#endif
NOINL void ph8(const Params& p) { PH_COMMON bf16x8 af[16]; for (int it = bid; it < T / 8; it += G) peer_item(p, 0, it, nullptr, af, -1, 0); }
NOINL void ph9(const Params& p, int var = 0) { PH_COMMON EpiHgT e{p.ws, p.in[I_HGLB], var}; gemm_pg8_T(A, W + W_IN1 / 2, T, 5120, smem, e); }
NOINL void ph10(const Params& p, int var = 0) { PH_COMMON for (int bi = bid; bi < NB * 32; bi += G) scan_block(p, bi, smem, var); }
NOINL void ph11(const Params& p) { PH_COMMON for (int it = bid; it < TL / 8; it += G) readout_item(p, it); }
NOINL void ph12(const Params& p) { PH_COMMON EpiRes e{&p, 0, 1, 2048}; gemm_pg8_N(Mx, W + W_OUT1 / 2, TL, 1024, smem, e); }
NOINL void ph13(const Params& p) { PH_COMMON for (int it = bid; it < TL / 8; it += G) norm_rows_item(p, it, 0, p.in[I_N2G] + 1024, 1, 3072); }
NOINL void ph14(const Params& p) { PH_COMMON EpiBf16 e{(bf16_t*)(p.ws + WS_P), 2048}; gemm_pg8_N(A, W + W_Q1 / 2, TL, 2048, smem, e); }
#ifndef HOST_EMU
NOINL void ph15(const Params& p) { PH_COMMON tg_phase(p, 1, TL, smem); }
#else
NOINL void ph15(const Params& p) { PH_COMMON topk_phase(p, 1, TL, smem); }
#endif
NOINL void ph16(const Params& p) { PH_COMMON bf16x8 af[16]; for (int it = bid; it < TL / 8; it += G) peer_item(p, 1, it, nullptr, af, -1, 0); }

constexpr int NPHASE = 17;
__global__ void __launch_bounds__(NT, 2) mega(Params p_in) {
    const int ph_lo = p_in.ph_lo, ph_hi = p_in.ph_hi;
#ifndef HOST_EMU
#define GBAR_MAKE() XcdBarrier gbar; gbar.bar = (unsigned*)(p_in.ws + WS_CTRL); gbar.x = xb_xcc_id(); gbar.st = (volatile LAS unsigned*)(LAS unsigned char*)(g_smem + SMEM_BYTES);
    if (ph_hi - ph_lo > 1) {
        volatile LAS unsigned* st = (volatile LAS unsigned*)(LAS unsigned char*)(g_smem + SMEM_BYTES);
        if (threadIdx.x == 0) { st[0] = 0u; st[1] = 0u; }
        __syncthreads();
        (void)xcd_barrier_post((unsigned*)(p_in.ws + WS_CTRL), st);
    }
#endif
#ifndef HOST_EMU
#define PH_BARRIER() do { GBAR_MAKE(); xcd_barrier(gbar); } while (0)
#define PH_PARAMS() unsigned long long kp = (unsigned long long)__builtin_amdgcn_kernarg_segment_ptr(); asm volatile("" : "+s"(kp) :: "memory"); \
        const Params& p = *(const Params*)(const __attribute__((address_space(4))) Params*)kp;
#else
#define PH_BARRIER() do {} while (0)
#define PH_PARAMS() const Params& p = p_in;
#endif
#ifdef REPEAT_MASK
#define PH_REPEAT(k, CALL) if ((REPEAT_MASK >> (k)) & 1) { PH_BARRIER(); { PH_PARAMS(); CALL; } }
#else
#define PH_REPEAT(k, CALL)
#endif
#ifdef ONLY_PHASE
#define PH_ON(k) ((k) == ONLY_PHASE)
#else
#define PH_ON(k) true
#endif
#if defined(REPEAT_MASK) && defined(HG_VAR)
#define RUN_PHASE9() if (ph_lo <= 9 && 9 < ph_hi) { if (9 > ph_lo) PH_BARRIER(); { PH_PARAMS(); ph9(p, HG_VAR); } PH_BARRIER(); { PH_PARAMS(); ph9(p, 0); } }
#else
#define RUN_PHASE9() RUN_PHASE(9, ph9(p))
#endif
#if defined(REPEAT_MASK) && defined(P3_VAR)
#define RUN_PHASE3() if (ph_lo <= 3 && 3 < ph_hi) { if (3 > ph_lo) PH_BARRIER(); { PH_PARAMS(); ph3(p, P3_VAR); } PH_BARRIER(); { PH_PARAMS(); ph3(p, 0); } }
#else
#define RUN_PHASE3() RUN_PHASE(3, ph3(p))
#endif
#ifdef HOST_EMU
#define RUN_PHASE_EMU(k, CALL) RUN_PHASE(k, CALL)
#else
#define RUN_PHASE_EMU(k, CALL)
#endif
#define RUN_PHASE(k, CALL) if (PH_ON(k) && ph_lo <= (k) && (k) < ph_hi) { if ((k) > ph_lo) PH_BARRIER(); { PH_PARAMS(); CALL; } PH_REPEAT(k, CALL) }
    RUN_PHASE(0, ph0(p))  RUN_PHASE(1, ph1(p))  RUN_PHASE(2, ph2(p))  RUN_PHASE3()  RUN_PHASE(4, ph4(p))  RUN_PHASE(5, ph5(p))
    RUN_PHASE(6, ph6(p))  RUN_PHASE(7, ph7(p))  RUN_PHASE_EMU(8, ph8(p))  RUN_PHASE9()  RUN_PHASE(10, ph10(p)) RUN_PHASE(11, ph11(p))
    RUN_PHASE(12, ph12(p)) RUN_PHASE(13, ph13(p)) RUN_PHASE(14, ph14(p)) RUN_PHASE(15, ph15(p)) RUN_PHASE_EMU(16, ph16(p))
}

#ifndef HOST_EMU
extern "C" void kernel_launch(void* const* d_in, const int* in_sizes, int n_in, void* d_out, int out_size, void* d_ws, size_t ws_size, hipStream_t stream) {
    if (n_in != 29 || ws_size < WS_END || out_size != TL * 1024) { fprintf(stderr, "kernel_launch: unexpected sizes (n_in %d, ws %zu need %zu, out %d)\n", n_in, ws_size, (size_t)WS_END, out_size); return; }
    static int grid = 0;
    if (!grid) { int dev = 0, cus = 0; hipGetDevice(&dev); hipDeviceGetAttribute(&cus, hipDeviceAttributeMultiprocessorCount, dev); grid = cus >= 8 ? (cus & ~7) : 256; }
    hipMemsetAsync((unsigned char*)d_ws + WS_CTRL, 0, CTRL_BYTES, stream);
    Params p{};
    for (int i = 0; i < 29; ++i) p.in[i] = (const float*)d_in[i];
    p.out = (float*)d_out; p.ws = (unsigned char*)d_ws;
#ifdef MULTI_LAUNCH
    for (int ph = 0; ph < NPHASE; ++ph) { p.ph_lo = ph; p.ph_hi = ph + 1; hipLaunchKernelGGL(mega, dim3(grid), dim3(NT), 0, stream, p); }
#else
    p.ph_lo = 0; p.ph_hi = NPHASE;
    hipLaunchKernelGGL(mega, dim3(grid), dim3(NT), 0, stream, p);
#endif
}
#endif
```
